# Optimizing an MI355X kernel written in HIP

```python
import math
import jax, jax.numpy as jnp
from jax import lax
import numpy as np

D_MODEL = 1024
BATCH = 1
SEQ = 16384
DEPTH = 4

HD = 64
BLK = 128
MEM_LEN = 256
NEG_INF = -1e30
TINY = 1e-30
EPS = 1e-6

A_HEADS = 8
A_KV = 2
CMP_LEN = 32
CMP_STRIDE = 16
CMP_HIDDEN = 128
SEL_BLK = 64
SEL_TOPK = 16
A_WINDOW = 512
SEL_FORCE = 1e4
B_HEADS = 8
B_HEADDIM = 64
B_GROUPS = 2
B_STATE = 128
B_CONV = 4
B_CHUNK = 128
B_INNER = B_HEADS * B_HEADDIM
B_CONV_DIM = B_INNER + 2 * B_GROUPS * B_STATE
C_HEADS = 8
C_KV = 2
C_WINDOW = 128
ROPE_THETA = 150000.0
D_SLOTS = 8
D_PATTERNS = ((128, 1), (512, 4), (2048, 16))
D_NPAT = 3
M_HEADS = 4
N_BUCKETS = 32
MAX_DIST = 2048
N_BIAS_HEADS = A_HEADS + D_NPAT * D_SLOTS

IN_SPLITS = (
    A_HEADS * HD, 6 * A_KV * HD, 3 * A_HEADS, A_HEADS * HD,
    B_CONV_DIM, B_HEADS, B_INNER,
    C_HEADS * HD, 2 * C_KV * HD, C_HEADS * HD,
    D_NPAT * D_SLOTS * HD, 2 * D_SLOTS * HD, D_SLOTS * HD,
    M_HEADS * HD, M_HEADS * HD,
)
D_IN = 8224
MIX_WIDTH = A_HEADS * HD + B_INNER + C_HEADS * HD + D_SLOTS * HD + M_HEADS * HD

kernel_name = "hymba_parallel_hybrid_nsa_ssd_swa_dilated"


def rms_norm(x, w):
    xf = x.astype(jnp.float32)
    y = xf * lax.rsqrt(jnp.mean(xf * xf, axis=-1, keepdims=True) + EPS)
    return (y * w.astype(jnp.float32)).astype(x.dtype)


def t5_bucket(dist):
    dist = jnp.maximum(dist, 0)
    exact = N_BUCKETS // 2
    rel = jnp.maximum(dist, exact).astype(jnp.float32)
    large = exact + (jnp.log(rel / exact) / math.log(MAX_DIST / exact) * (N_BUCKETS - exact)).astype(jnp.int32)
    return jnp.where(dist < exact, dist, jnp.minimum(large, N_BUCKETS - 1))


def masked_softmax(s, mask):
    s = jnp.where(mask, s, NEG_INF)
    p = jnp.where(mask, jnp.exp(s - jnp.max(s, axis=-1, keepdims=True)), 0.0)
    return p / jnp.maximum(jnp.sum(p, axis=-1, keepdims=True), TINY)


def rope(t, positions):
    half = HD // 2
    inv = ROPE_THETA ** (-jnp.arange(half, dtype=jnp.float32) / half)
    ang = positions.astype(jnp.float32)[..., None] * inv
    cos, sin = jnp.cos(ang)[:, :, None, :], jnp.sin(ang)[:, :, None, :]
    t1, t2 = t[..., :half].astype(jnp.float32), t[..., half:].astype(jnp.float32)
    return jnp.concatenate([t1 * cos - t2 * sin, t2 * cos + t1 * sin], axis=-1).astype(t.dtype)


def banded_attention(q, k, v, max_dist, rel_cols=None, dist_scale=1, sinks=None):
    b, L, hq, hd = q.shape
    hkv = k.shape[2]
    g = hq // hkv
    nb = L // BLK
    n_prev = -(-max_dist // BLK)
    kw = (n_prev + 1) * BLK
    qb = q.reshape(b, nb, BLK, hkv, g, hd)

    def windows(t):
        tp = jnp.pad(t, ((0, 0), (n_prev * BLK, 0), (0, 0), (0, 0))).reshape(b, nb + n_prev, BLK, hkv, hd)
        return jnp.concatenate([tp[:, o:o + nb] for o in range(n_prev + 1)], axis=2)

    kb, vb = windows(k), windows(v)
    s = jnp.einsum('bnqhgd,bnkhd->bnhgqk', qb, kb, preferred_element_type=jnp.float32) * hd ** -0.5
    qi = jnp.arange(BLK)[:, None]
    kj = jnp.arange(kw)[None, :]
    dist = n_prev * BLK + qi - kj
    kpos = (jnp.arange(nb)[:, None, None] - n_prev) * BLK + kj[None]
    mask = (dist >= 0) & (dist <= max_dist) & (kpos >= 0)
    if rel_cols is not None:
        bias = jnp.transpose(rel_cols[t5_bucket(dist * dist_scale)], (2, 0, 1)).reshape(hkv, g, BLK, kw)
        s = s + bias.astype(jnp.float32)
    s = jnp.where(mask[None, :, None, None], s, NEG_INF)
    m = jnp.max(s, axis=-1, keepdims=True)
    if sinks is not None:
        sk = sinks.astype(jnp.float32).reshape(1, 1, hkv, g, 1, 1)
        m = jnp.maximum(m, sk)
    p = jnp.where(mask[None, :, None, None], jnp.exp(s - m), 0.0)
    denom = jnp.sum(p, axis=-1, keepdims=True)
    if sinks is not None:
        denom = denom + jnp.exp(sk - m)
    o = jnp.einsum('bnhgqk,bnkhd->bnqhgd', (p / denom).astype(v.dtype), vb)
    lse = (m + jnp.log(denom))[..., 0]
    return o.reshape(b, L, hq, hd), jnp.transpose(lse, (0, 1, 4, 2, 3)).reshape(b, L, hq)


def compress(t, pe, w1, w2):
    b, s, hkv, hd = t.shape
    r = CMP_LEN // CMP_STRIDE
    ncmp = s // CMP_STRIDE
    u = jnp.pad(t, ((0, 0), (0, (r - 1) * CMP_STRIDE), (0, 0), (0, 0))).reshape(b, ncmp + r - 1, CMP_STRIDE, hkv, hd)
    blocks = jnp.concatenate([u[:, i:i + ncmp] for i in range(r)], axis=2) + pe[:, None, :]
    flat = jnp.transpose(blocks, (0, 1, 3, 2, 4)).reshape(b, ncmp, hkv, CMP_LEN * hd)
    return jax.nn.gelu(flat @ w1) @ w2


def nsa_mixer(q, k_c, v_c, k_s, v_s, k_w, v_w, gate_logits, pe, w1, w2, rel_a):
    b, s, hq, hd = q.shape
    g = hq // A_KV
    nb = s // BLK
    nsel = s // SEL_BLK
    n_top = min(SEL_TOPK, nsel)
    r = CMP_LEN // CMP_STRIDE
    scale = hd ** -0.5
    kc = compress(k_c, pe[0], w1[0], w2[0])
    vc = compress(v_c, pe[1], w1[1], w2[1])
    ncmp = kc.shape[1]
    cmp_end = jnp.arange(ncmp) * CMP_STRIDE + (CMP_LEN - 1)
    ksb = jnp.transpose(k_s.reshape(b, nsel, SEL_BLK, A_KV, hd), (0, 3, 1, 2, 4))
    vsb = jnp.transpose(v_s.reshape(b, nsel, SEL_BLK, A_KV, hd), (0, 3, 1, 2, 4))
    kwp = jnp.pad(k_w, ((0, 0), (A_WINDOW, 0), (0, 0), (0, 0)))
    vwp = jnp.pad(v_w, ((0, 0), (A_WINDOW, 0), (0, 0), (0, 0)))
    qg = q.reshape(b, s, A_KV, g, hd)
    gates = jax.nn.sigmoid(gate_logits.astype(jnp.float32)).reshape(b, s, A_KV, g, 3)
    rel3 = rel_a.reshape(N_BUCKETS, A_KV, g)
    gather = jax.vmap(jax.vmap(lambda tb, ix: tb[ix]))
    lookup = jax.vmap(lambda tab, bk: tab[bk], in_axes=(1, 1), out_axes=1)

    def head_bias(dist):
        return jnp.transpose(rel_a[t5_bucket(dist)], (2, 0, 1)).reshape(A_KV, g, *dist.shape).astype(jnp.float32)

    def block(n):
        t0 = n * BLK
        pos = t0 + jnp.arange(BLK)
        qb = lax.dynamic_slice_in_dim(qg, t0, BLK, axis=1)
        dist_c = pos[:, None] - cmp_end[None, :]
        s_c = jnp.einsum('bqhgd,bjhd->bhgqj', qb, kc, preferred_element_type=jnp.float32) * scale + head_bias(dist_c)
        p_c = masked_softmax(s_c, dist_c >= 0)
        o_c = jnp.einsum('bhgqj,bjhd->bqhgd', p_c.astype(vc.dtype), vc)
        pcs = jnp.pad(jnp.sum(p_c, axis=2), ((0, 0), (0, 0), (0, 0), (r - 1, 0)))
        unit = sum(pcs[..., r - 1 - i:r - 1 - i + ncmp] for i in range(r))
        imp = unit.reshape(b, A_KV, BLK, nsel, SEL_BLK // CMP_STRIDE).sum(-1)
        blk_ids = jnp.arange(nsel)[None, :]
        forced = (blk_ids == (pos // SEL_BLK)[:, None]) | (blk_ids == 0)
        valid = blk_ids * SEL_BLK <= pos[:, None]
        imp = jnp.where(forced, SEL_FORCE, jnp.where(valid, imp, -1.0))
        top_val, idx = lax.top_k(imp, n_top)
        kg = gather(ksb, idx)
        vg = gather(vsb, idx)
        kpos = idx[..., None] * SEL_BLK + jnp.arange(SEL_BLK)
        dist_s = pos[:, None, None] - kpos
        mask_s = (dist_s >= 0) & (top_val >= 0)[..., None]
        bias_s = jnp.transpose(lookup(rel3, t5_bucket(dist_s)), (0, 1, 5, 2, 3, 4)).astype(jnp.float32)
        s_s = jnp.einsum('bqhgd,bhqnld->bhgqnl', qb, kg, preferred_element_type=jnp.float32) * scale + bias_s
        nk = n_top * SEL_BLK
        p_s = masked_softmax(s_s.reshape(b, A_KV, g, BLK, nk), mask_s.reshape(b, A_KV, 1, BLK, nk))
        o_s = jnp.einsum('bhgqk,bhqkd->bqhgd', p_s.astype(vg.dtype), vg.reshape(b, A_KV, BLK, nk, hd))
        kw = lax.dynamic_slice_in_dim(kwp, t0, BLK + A_WINDOW, axis=1)
        vw = lax.dynamic_slice_in_dim(vwp, t0, BLK + A_WINDOW, axis=1)
        kpos_w = t0 - A_WINDOW + jnp.arange(BLK + A_WINDOW)
        dist_w = pos[:, None] - kpos_w[None, :]
        mask_w = (dist_w >= 0) & (dist_w < A_WINDOW) & (kpos_w[None, :] >= 0)
        s_w = jnp.einsum('bqhgd,bkhd->bhgqk', qb, kw, preferred_element_type=jnp.float32) * scale + head_bias(dist_w)
        p_w = masked_softmax(s_w, mask_w)
        o_w = jnp.einsum('bhgqk,bkhd->bqhgd', p_w.astype(vw.dtype), vw)
        gb = lax.dynamic_slice_in_dim(gates, t0, BLK, axis=1)
        o = gb[..., 0:1] * o_c + gb[..., 1:2] * o_s + gb[..., 2:3] * o_w
        return o.reshape(b, BLK, hq, hd).astype(q.dtype)

    out = lax.map(block, jnp.arange(nb))
    return jnp.transpose(out, (1, 0, 2, 3, 4)).reshape(b, s, hq, hd)


def causal_depthwise_conv(x, w, bias):
    out = lax.conv_general_dilated(x, w.astype(x.dtype)[:, None, :], window_strides=(1,),
                                   padding=[(B_CONV - 1, 0)], dimension_numbers=('NWC', 'WIO', 'NWC'),
                                   feature_group_count=x.shape[-1])
    return out + bias


def ssd_scan(xdt, adt, bm, cm):
    b, s, G, J, P = xdt.shape
    N = bm.shape[-1]
    L = B_CHUNK
    nc = s // L
    x = xdt.reshape(b, nc, L, G, J, P)
    bm = bm.reshape(b, nc, L, G, N)
    cm = cm.reshape(b, nc, L, G, N)
    acs = jnp.cumsum(jnp.transpose(adt.reshape(b, nc, L, G, J), (0, 1, 3, 4, 2)).astype(jnp.float32), axis=-1)
    causal = jnp.tril(jnp.ones((L, L), dtype=bool))
    decay = jnp.exp(jnp.where(causal, acs[..., :, None] - acs[..., None, :], NEG_INF))
    cb = jnp.einsum('bclgn,bcsgn->bcgls', cm, bm, preferred_element_type=jnp.float32)
    y_diag = jnp.einsum('bcgls,bcgjls,bcsgjp->bclgjp', cb, decay, x)
    states = jnp.einsum('bclgn,bcgjl,bclgjp->bcgjpn', bm, jnp.exp(acs[..., -1:] - acs), x).astype(jnp.float32)

    def step(h, inp):
        st, dec = inp
        return h * dec[..., None, None] + st, h

    init = jnp.zeros((b, G, J, P, N), jnp.float32)
    _, prev = lax.scan(step, init, (jnp.moveaxis(states, 1, 0), jnp.moveaxis(jnp.exp(acs[..., -1]), 1, 0)))
    y_off = jnp.einsum('bclgn,bcgjpn,bcgjl->bclgjp', cm, jnp.moveaxis(prev, 0, 1), jnp.exp(acs))
    return (y_diag + y_off).reshape(b, s, G, J, P)


def ssd_mixer(xbc, dt_raw, z, conv_w, conv_b, dt_bias, a_log, d_skip, norm_w):
    b, s, _ = xbc.shape
    J = B_HEADS // B_GROUPS
    xbc = jax.nn.silu(causal_depthwise_conv(xbc, conv_w, conv_b))
    xs = xbc[..., :B_INNER].reshape(b, s, B_GROUPS, J, B_HEADDIM)
    bm = xbc[..., B_INNER:B_INNER + B_GROUPS * B_STATE].reshape(b, s, B_GROUPS, B_STATE)
    cm = xbc[..., B_INNER + B_GROUPS * B_STATE:].reshape(b, s, B_GROUPS, B_STATE)
    dt = jax.nn.softplus(dt_raw.astype(jnp.float32) + dt_bias).reshape(b, s, B_GROUPS, J)
    a = -jnp.exp(a_log.astype(jnp.float32)).reshape(B_GROUPS, J)
    y = ssd_scan(xs * dt[..., None], dt * a, bm, cm) + xs * d_skip.reshape(B_GROUPS, J)[:, :, None]
    yz = y.reshape(b, s, B_GROUPS, J * B_HEADDIM) * jax.nn.silu(z.reshape(b, s, B_GROUPS, J * B_HEADDIM))
    return rms_norm(yz, norm_w.reshape(B_GROUPS, J * B_HEADDIM)).reshape(b, s, B_INNER)


def strided_window_attention(q, k, v, dil, steps, rel_cols):
    b, s, h, hd = q.shape
    L = s // dil
    Lp = -(-L // BLK) * BLK

    def to_sub(t):
        t = jnp.transpose(t.reshape(b, L, dil, t.shape[2], hd), (0, 2, 1, 3, 4)).reshape(b * dil, L, t.shape[2], hd)
        return jnp.pad(t, ((0, 0), (0, Lp - L), (0, 0), (0, 0)))

    o, lse = banded_attention(to_sub(q), to_sub(k), to_sub(v), steps, rel_cols=rel_cols, dist_scale=dil)
    o = jnp.transpose(o[:, :L].reshape(b, dil, L, h, hd), (0, 2, 1, 3, 4)).reshape(b, s, h, hd)
    lse = jnp.transpose(lse[:, :L].reshape(b, dil, L, h), (0, 2, 1, 3)).reshape(b, s, h)
    return o, lse


def dilated_mixer(q, k, v, rel_d):
    outs, lses = [], []
    for gi, (window, dil) in enumerate(D_PATTERNS):
        o, lse = strided_window_attention(q[:, :, gi], k, v, dil, window // dil,
                                          rel_d[:, gi * D_SLOTS:(gi + 1) * D_SLOTS])
        outs.append(o)
        lses.append(lse)
    alpha = jax.nn.softmax(jnp.stack(lses, axis=2), axis=2)
    return jnp.einsum('bsph,bsphd->bshd', alpha.astype(q.dtype), jnp.stack(outs, axis=2))


def memory_attention(q, mem, norm_w, w_kv):
    b, s, h, hd = q.shape
    kv = jnp.einsum('bmd,de->bme', rms_norm(mem, norm_w), w_kv).reshape(b, mem.shape[1], 2, h, hd)
    sc = jnp.einsum('bshd,bmhd->bhsm', q, kv[:, :, 0], preferred_element_type=jnp.float32) * hd ** -0.5
    p = jax.nn.softmax(sc, axis=-1)
    return jnp.einsum('bhsm,bmhd->bshd', p.astype(kv.dtype), kv[:, :, 1])


def setup_inputs(seed: int = 0) -> dict:
    key = jax.random.key(seed)
    ks = jax.random.split(key, 20)
    f32 = jnp.float32

    def nrm(k, shape, scale):
        return jax.random.normal(k, shape, f32) * scale

    dt = jnp.exp(jax.random.uniform(ks[12], (DEPTH, B_HEADS), f32, math.log(1e-3), math.log(1e-1)))
    return {
        "x": nrm(ks[0], (BATCH, SEQ, D_MODEL), 1.0),
        "mem": nrm(ks[1], (BATCH, MEM_LEN, D_MODEL), 1.0),
        "positions": (jax.random.randint(ks[2], (BATCH, 1), 0, 4096) + jnp.arange(SEQ, dtype=jnp.int32)[None, :]).astype(jnp.int32),
        "pre_norm": 1.0 + nrm(ks[3], (DEPTH, D_MODEL), 0.02),
        "post_norm": 1.0 + nrm(ks[4], (DEPTH, D_MODEL), 0.02),
        "w_in": nrm(ks[5], (DEPTH, D_MODEL, D_IN), D_MODEL ** -0.5),
        "w_out": nrm(ks[6], (DEPTH, MIX_WIDTH, D_MODEL), MIX_WIDTH ** -0.5),
        "rel_bias": nrm(ks[7], (N_BUCKETS, N_BIAS_HEADS), 0.1),
        "a_cmp_pos": nrm(ks[8], (DEPTH, 2, CMP_LEN, HD), 0.02),
        "a_cmp_w1": nrm(ks[9], (DEPTH, 2, CMP_LEN * HD, CMP_HIDDEN), (CMP_LEN * HD) ** -0.5),
        "a_cmp_w2": nrm(ks[10], (DEPTH, 2, CMP_HIDDEN, HD), CMP_HIDDEN ** -0.5),
        "b_conv_w": nrm(ks[11], (DEPTH, B_CONV, B_CONV_DIM), B_CONV ** -0.5),
        "b_conv_b": nrm(ks[13], (DEPTH, B_CONV_DIM), 0.01),
        "b_dt_bias": dt + jnp.log(-jnp.expm1(-dt)),
        "b_a_log": jnp.log(jax.random.uniform(ks[14], (DEPTH, B_HEADS), f32, 1.0, 16.0)),
        "b_d": 1.0 + nrm(ks[15], (DEPTH, B_HEADS), 0.1),
        "b_norm": 1.0 + nrm(ks[16], (DEPTH, B_INNER), 0.02),
        "c_sinks": nrm(ks[17], (DEPTH, C_HEADS), 0.5),
        "m_norm": 1.0 + nrm(ks[18], (DEPTH, D_MODEL), 0.02),
        "m_w_kv": nrm(ks[19], (DEPTH, D_MODEL, 2 * M_HEADS * HD), D_MODEL ** -0.5),
    }


def reference(x, mem, positions, pre_norm, post_norm, w_in, w_out, rel_bias, a_cmp_pos, a_cmp_w1, a_cmp_w2,
              b_conv_w, b_conv_b, b_dt_bias, b_a_log, b_d, b_norm, c_sinks, m_norm, m_w_kv):
    b, s, _ = x.shape
    offsets = [int(o) for o in np.cumsum(IN_SPLITS)[:-1]]
    rel_a = rel_bias[:, :A_HEADS]
    rel_d = rel_bias[:, A_HEADS:]
    silu = jax.nn.silu
    for layer in range(DEPTH):
        h = rms_norm(x, pre_norm[layer])
        proj = jnp.einsum('bsd,de->bse', h, w_in[layer])
        (a_q, a_kv, a_gate, a_z, b_xbc, b_dt, b_z, c_q, c_kv, c_z,
         d_q, d_kv, d_z, m_q, m_z) = jnp.split(proj, offsets, axis=-1)
        a_kv = a_kv.reshape(b, s, 6, A_KV, HD)
        a_out = nsa_mixer(a_q.reshape(b, s, A_HEADS, HD), a_kv[:, :, 0], a_kv[:, :, 1], a_kv[:, :, 2],
                          a_kv[:, :, 3], a_kv[:, :, 4], a_kv[:, :, 5], a_gate.reshape(b, s, A_HEADS, 3),
                          a_cmp_pos[layer], a_cmp_w1[layer], a_cmp_w2[layer], rel_a)
        b_out = ssd_mixer(b_xbc, b_dt, b_z, b_conv_w[layer], b_conv_b[layer], b_dt_bias[layer],
                          b_a_log[layer], b_d[layer], b_norm[layer])
        c_kv = c_kv.reshape(b, s, 2, C_KV, HD)
        c_out, _ = banded_attention(rope(c_q.reshape(b, s, C_HEADS, HD), positions), rope(c_kv[:, :, 0], positions),
                                    c_kv[:, :, 1], C_WINDOW - 1, sinks=c_sinks[layer])
        d_kv = d_kv.reshape(b, s, 2, D_SLOTS, HD)
        d_out = dilated_mixer(d_q.reshape(b, s, D_NPAT, D_SLOTS, HD), d_kv[:, :, 0], d_kv[:, :, 1], rel_d)
        m_out = memory_attention(m_q.reshape(b, s, M_HEADS, HD), mem, m_norm[layer], m_w_kv[layer])
        mix = jnp.concatenate([
            a_out.reshape(b, s, -1) * silu(a_z),
            b_out,
            c_out.reshape(b, s, -1) * silu(c_z),
            d_out.reshape(b, s, -1) * silu(d_z),
            m_out.reshape(b, s, -1) * silu(m_z),
        ], axis=-1)
        x = x + rms_norm(jnp.einsum('bse,ed->bsd', mix, w_out[layer]), post_norm[layer])
    return x
```

```cpp
#include <hip/hip_runtime.h>
#include <hip/hip_cooperative_groups.h>
#include <cstdio>
#include <cstdint>
#include <cstring>
namespace cg = cooperative_groups;
#define HD_ __device__ __forceinline__
#ifndef HD_
#define HD_ inline
#endif
#ifdef SB_IS_FLOAT
typedef float SB;
HD_ float ldf(const SB* p) { return *p; }
HD_ void stf(SB* p, float v) { *p = v; }
#else
typedef unsigned short SB;
HD_ float bf2f(unsigned short b) { unsigned u = ((unsigned)b) << 16; float f; __builtin_memcpy(&f, &u, 4); return f; }
HD_ unsigned short f2bf(float f) { unsigned u; __builtin_memcpy(&u, &f, 4); u += 0x7fffu + ((u >> 16) & 1u); return (unsigned short)(u >> 16); }
HD_ float ldf(const SB* p) { return bf2f(*p); }
HD_ void stf(SB* p, float v) { *p = f2bf(v); }
#endif

#define DM 1024
#define NPROJ 5888
#define NMIX 2304
#define NSMALL 32
#define PA_Q 0
#define PA_KV 512
#define PB_X 1280
#define PC_Q 2304
#define PC_KV 2816
#define PD_Q 3072
#define PD_KV 4608
#define PM_Q 5632
#define MX_A 0
#define MX_B 512
#define MX_C 1024
#define MX_D 1536
#define MX_M 2048
#define TABA_N 2048
#define TABD_N 132

struct Params {
  int S; int pad0;
  const float *x, *mem; const int* pos;
  const float *pre_norm, *post_norm, *w_in, *w_out, *rel_bias, *cmp_pos, *cmp_w1, *cmp_w2, *conv_w, *conv_b, *dt_bias, *a_log, *b_d,
      *b_norm, *sinks, *m_norm, *m_wkv;
  float* out;
  unsigned short* wt_in;
  unsigned short* wt_out;
  SB* h;
  SB* proj;
  float* small;
  SB* mix;
  float* y;
  float *rope_cs, *rope_sn;
  float *tabA, *tabD;
  SB* memkv;
  float* hid;
  SB* kvc;
  float* imp;
  float* cml;
  int* idx;
  SB *oc, *ow;
  SB* dop;
  float* dlse;
  SB* xconv;
  float *dt, *acs;
  float* cb;
  float* states;
  float* ybuf;
  unsigned* bar;
};

HD_ float silu_f(float x) { return x / (1.f + expf(-x)); }
HD_ float sigmoid_f(float x) { return 1.f / (1.f + expf(-x)); }
HD_ float gelu_f(float x) { return 0.5f * x * (1.f + tanhf(0.7978845608028654f * (x + 0.044715f * x * x * x))); }
HD_ float softplus_f(float x) { return fmaxf(x, 0.f) + log1pf(expf(-fabsf(x))); }

HD_ int t5_bucket(int d) {
  if (d < 16) return d < 0 ? 0 : d;
  const int thr[15] = {22, 30, 40, 54, 73, 99, 134, 182, 246, 332, 450, 609, 825, 1117, 1513};
  int b = 16;
  for (int k = 0; k < 15; ++k) b += (d >= thr[k]) ? 1 : 0;
  return b;
}

HD_ void ph_rope(const Params& p, long gid) {
  int s = (int)(gid >> 5), i = (int)(gid & 31);
  float inv = powf(150000.f, -(float)i / 32.f);
  float ang = (float)p.pos[s] * inv;
  p.rope_cs[gid] = cosf(ang); p.rope_sn[gid] = sinf(ang);
}
HD_ void ph_tabs(const Params& p, long gid) {
  if (gid < 8 * TABA_N) { int h = (int)(gid / TABA_N), d = (int)(gid % TABA_N); p.tabA[gid] = p.rel_bias[t5_bucket(d) * 32 + h]; }
  else { long g2 = gid - 8 * TABA_N; int hh = (int)(g2 / TABD_N), d = (int)(g2 % TABD_N); int gi = hh >> 3;
    int dil = gi == 0 ? 1 : (gi == 1 ? 4 : 16); p.tabD[g2] = p.rel_bias[t5_bucket(d * dil) * 32 + 8 + hh]; }
}
HD_ void ph_memkv(const Params& p, long gid) {
  int e = (int)(gid & 511), m = (int)((gid >> 9) & 255), l = (int)(gid >> 17);
  const float* row = p.mem + (long)m * DM;
  float ss = 0.f; for (int d = 0; d < DM; ++d) ss += row[d] * row[d];
  float r = 1.f / sqrtf(ss / DM + 1e-6f);
  float acc = 0.f;
  for (int d = 0; d < DM; ++d) acc += row[d] * r * p.m_norm[l * DM + d] * p.m_wkv[((long)l * DM + d) * 512 + e];
  stf(&p.memkv[gid], acc);
}
HD_ void ph_norm_row(const Params& p, int layer, int t, bool do_h) {
  const float* xin = (layer == 0) ? p.x + (long)t * DM : p.out + (long)t * DM;
  float* xo = p.out + (long)t * DM;
  float r1 = 0.f;
  if (layer > 0) { const float* y = p.y + (long)t * DM; float ss = 0.f; for (int d = 0; d < DM; ++d) ss += y[d] * y[d]; r1 = 1.f / sqrtf(ss / DM + 1e-6f); }
  float ss2 = 0.f;
  for (int d = 0; d < DM; ++d) { float v = xin[d]; if (layer > 0) v += p.y[(long)t * DM + d] * r1 * p.post_norm[(layer - 1) * DM + d]; xo[d] = v; ss2 += v * v; }
  if (!do_h) return;
  float r2 = 1.f / sqrtf(ss2 / DM + 1e-6f);
  for (int d = 0; d < DM; ++d) stf(&p.h[(long)t * DM + d], xo[d] * r2 * p.pre_norm[layer * DM + d]);
}

HD_ void ph_cmp_hid(const Params& p, int layer, long gid) {
  int u = (int)(gid & 127), hk = (int)((gid >> 7) & 1); long r = gid >> 8; int ncmp = p.S / 16; int j = (int)(r % ncmp), kv = (int)(r / ncmp);
  const float* w1 = p.cmp_w1 + ((long)(layer * 2 + kv) * 2048) * 128;
  const float* pe = p.cmp_pos + (long)(layer * 2 + kv) * 32 * 64;
  float acc = 0.f;
  for (int t = 0; t < 32; ++t) { int tok = 16 * j + t;
    for (int d = 0; d < 64; ++d) { float v = pe[t * 64 + d]; if (tok < p.S) v += ldf(&p.proj[(long)tok * NPROJ + PA_KV + kv * 128 + hk * 64 + d]);
      acc += v * w1[(long)(t * 64 + d) * 128 + u]; } }
  p.hid[gid] = gelu_f(acc);
}
HD_ void ph_cmp_out(const Params& p, int layer, long gid) {
  int d = (int)(gid & 63), hk = (int)((gid >> 6) & 1); long r = gid >> 7; int ncmp = p.S / 16; int j = (int)(r % ncmp), kv = (int)(r / ncmp);
  const float* w2 = p.cmp_w2 + (long)(layer * 2 + kv) * 128 * 64;
  const float* hd = p.hid + (((long)kv * ncmp + j) * 2 + hk) * 128;
  float acc = 0.f; for (int u = 0; u < 128; ++u) acc += hd[u] * w2[u * 64 + d];
  stf(&p.kvc[gid], acc);
}
HD_ void ph_a_cmp1(const Params& p, long gid) {
  int h = (int)(gid & 7), q = (int)(gid >> 3), g = h >> 2; int ncmp = p.S / 16;
  int jn = (q >= 31) ? ((q - 31) / 16 + 1) : 0;
  const SB* kc = p.kvc; const SB* vc = p.kvc + (long)ncmp * 128;
  float qv[64], o[64]; for (int d = 0; d < 64; ++d) { qv[d] = ldf(&p.proj[(long)q * NPROJ + PA_Q + h * 64 + d]); o[d] = 0.f; }
  float m = -1e30f, l = 0.f;
  for (int j = 0; j < jn; ++j) { const SB* kr = &kc[((long)j * 2 + g) * 64]; const SB* vr = &vc[((long)j * 2 + g) * 64];
    float s = 0.f; for (int d = 0; d < 64; ++d) s += qv[d] * ldf(&kr[d]);
    int dist = q - (16 * j + 31); s = s * 0.125f + p.tabA[h * TABA_N + (dist < TABA_N ? dist : TABA_N - 1)];
    float mn = fmaxf(m, s), a = expf(m - mn), pr = expf(s - mn); l = l * a + pr; for (int d = 0; d < 64; ++d) o[d] = o[d] * a + pr * ldf(&vr[d]); m = mn; }
  float il = jn > 0 ? 1.f / l : 0.f; for (int d = 0; d < 64; ++d) stf(&p.oc[(long)q * 512 + h * 64 + d], o[d] * il);
  p.cml[gid * 2] = m; p.cml[gid * 2 + 1] = il;
}
HD_ void ph_a_cmp2(const Params& p, long gid) {
  int g = (int)(gid & 1), q = (int)(gid >> 1); int ncmp = p.S / 16;
  float* imp = p.imp + gid * 256; for (int b = 0; b < 256; ++b) imp[b] = 0.f;
  int jn = (q >= 31) ? ((q - 31) / 16 + 1) : 0; const SB* kc = p.kvc;
  for (int hh = 0; hh < 4; ++hh) { int h = g * 4 + hh; float qv[64]; for (int d = 0; d < 64; ++d) qv[d] = ldf(&p.proj[(long)q * NPROJ + PA_Q + h * 64 + d]);
    float m = p.cml[((long)q * 8 + h) * 2], il = p.cml[((long)q * 8 + h) * 2 + 1];
    for (int j = 0; j < jn; ++j) { const SB* kr = &kc[((long)j * 2 + g) * 64]; float s = 0.f; for (int d = 0; d < 64; ++d) s += qv[d] * ldf(&kr[d]);
      int dist = q - (16 * j + 31); s = s * 0.125f + p.tabA[h * TABA_N + (dist < TABA_N ? dist : TABA_N - 1)]; float pr = expf(s - m) * il;
      imp[j >> 2] += pr; if (j + 1 < ncmp) imp[(j + 1) >> 2] += pr; } }
}
HD_ void ph_a_topk(const Params& p, long gid) {
  int q = (int)(gid >> 1); float* imp = p.imp + gid * 256; int* idx = p.idx + gid * 16; int cur = q >> 6;
  imp[0] = 1e4f; imp[cur] = 1e4f;
  for (int k = 0; k < 16; ++k) { int best = -1; float bv = -1.f;
    for (int b = 0; b <= cur; ++b) { float v = imp[b]; if (v > bv) { bv = v; best = b; } }
    idx[k] = best; if (best >= 0) imp[best] = -2.f; }
}
HD_ void ph_a_win(const Params& p, long gid) {
  int h = (int)(gid & 7), q = (int)(gid >> 3), hk = h >> 2;
  float qv[64], o[64]; for (int d = 0; d < 64; ++d) { qv[d] = ldf(&p.proj[(long)q * NPROJ + PA_Q + h * 64 + d]); o[d] = 0.f; }
  float m = -1e30f, l = 0.f; int lo = q - 511 < 0 ? 0 : q - 511;
  for (int t = lo; t <= q; ++t) { const SB* kr = &p.proj[(long)t * NPROJ + PA_KV + 4 * 128 + hk * 64]; const SB* vr = kr + 128;
    float s = 0.f; for (int d = 0; d < 64; ++d) s += qv[d] * ldf(&kr[d]); s = s * 0.125f + p.tabA[h * TABA_N + (q - t)];
    float mn = fmaxf(m, s), a = expf(m - mn), pr = expf(s - mn); l = l * a + pr; for (int d = 0; d < 64; ++d) o[d] = o[d] * a + pr * ldf(&vr[d]); m = mn; }
  float il = 1.f / l; for (int d = 0; d < 64; ++d) stf(&p.ow[(long)q * 512 + h * 64 + d], o[d] * il);
}
HD_ void ph_a_sel(const Params& p, long gid) {
  int h = (int)(gid & 7), q = (int)(gid >> 3), hk = h >> 2; const int* idx = p.idx + ((long)q * 2 + hk) * 16;
  float qv[64], o[64]; for (int d = 0; d < 64; ++d) { qv[d] = ldf(&p.proj[(long)q * NPROJ + PA_Q + h * 64 + d]); o[d] = 0.f; }
  float m = -1e30f, l = 0.f;
  for (int k = 0; k < 16; ++k) { int b = idx[k]; if (b < 0) continue;
    for (int i = 0; i < 64; ++i) { int t = b * 64 + i; if (t > q) break;
      const SB* kr = &p.proj[(long)t * NPROJ + PA_KV + 2 * 128 + hk * 64]; const SB* vr = kr + 128;
      float s = 0.f; for (int d = 0; d < 64; ++d) s += qv[d] * ldf(&kr[d]); int dist = q - t; s = s * 0.125f + p.tabA[h * TABA_N + (dist < TABA_N ? dist : TABA_N - 1)];
      float mn = fmaxf(m, s), a = expf(m - mn), pr = expf(s - mn); l = l * a + pr; for (int d = 0; d < 64; ++d) o[d] = o[d] * a + pr * ldf(&vr[d]); m = mn; } }
  float il = 1.f / l; const float* gl = p.small + (long)q * NSMALL + h * 3;
  float g0 = sigmoid_f(gl[0]), g1 = sigmoid_f(gl[1]), g2 = sigmoid_f(gl[2]);
  for (int d = 0; d < 64; ++d) { long c = (long)q * 512 + h * 64 + d; float a = g0 * ldf(&p.oc[c]) + g1 * o[d] * il + g2 * ldf(&p.ow[c]);
    SB* mp = &p.mix[(long)q * NMIX + MX_A + h * 64 + d]; stf(mp, a * ldf(mp)); }
}
HD_ void ph_c(const Params& p, int layer, long gid) {
  int h = (int)(gid & 7), q = (int)(gid >> 3), hk = h >> 2;
  float qv[64], o[64]; for (int d = 0; d < 64; ++d) { qv[d] = ldf(&p.proj[(long)q * NPROJ + PC_Q + h * 64 + d]); o[d] = 0.f; }
  float m = p.sinks[layer * 8 + h], l = 1.f; int lo = q - 127 < 0 ? 0 : q - 127;
  for (int t = lo; t <= q; ++t) { const SB* kr = &p.proj[(long)t * NPROJ + PC_KV + hk * 64]; const SB* vr = kr + 128;
    float s = 0.f; for (int d = 0; d < 64; ++d) s += qv[d] * ldf(&kr[d]); s *= 0.125f;
    float mn = fmaxf(m, s), a = expf(m - mn), pr = expf(s - mn); l = l * a + pr; for (int d = 0; d < 64; ++d) o[d] = o[d] * a + pr * ldf(&vr[d]); m = mn; }
  float il = 1.f / l; for (int d = 0; d < 64; ++d) { SB* mp = &p.mix[(long)q * NMIX + MX_C + h * 64 + d]; stf(mp, o[d] * il * ldf(mp)); }
}
HD_ void ph_d(const Params& p, long gid) {
  int h = (int)(gid & 7); long r = gid >> 3; int q = (int)(r % p.S), gi = (int)(r / p.S); int dil = gi == 0 ? 1 : (gi == 1 ? 4 : 16);
  float qv[64], o[64]; for (int d = 0; d < 64; ++d) { qv[d] = ldf(&p.proj[(long)q * NPROJ + PD_Q + gi * 512 + h * 64 + d]); o[d] = 0.f; }
  float m = -1e30f, l = 0.f;
  for (int dd = 0; dd <= 128; ++dd) { int t = q - dil * dd; if (t < 0) break;
    const SB* kr = &p.proj[(long)t * NPROJ + PD_KV + h * 64]; const SB* vr = kr + 512;
    float s = 0.f; for (int d = 0; d < 64; ++d) s += qv[d] * ldf(&kr[d]); s = s * 0.125f + p.tabD[(gi * 8 + h) * TABD_N + dd];
    float mn = fmaxf(m, s), a = expf(m - mn), pr = expf(s - mn); l = l * a + pr; for (int d = 0; d < 64; ++d) o[d] = o[d] * a + pr * ldf(&vr[d]); m = mn; }
  float il = 1.f / l; for (int d = 0; d < 64; ++d) stf(&p.dop[((long)gi * p.S + q) * 512 + h * 64 + d], o[d] * il);
  p.dlse[((long)gi * p.S + q) * 8 + h] = m + logf(l);
}
HD_ void ph_d_merge(const Params& p, long gid) {
  int h = (int)(gid & 7), q = (int)(gid >> 3);
  float l0 = p.dlse[((long)0 * p.S + q) * 8 + h], l1 = p.dlse[((long)1 * p.S + q) * 8 + h], l2 = p.dlse[((long)2 * p.S + q) * 8 + h];
  float mm = fmaxf(l0, fmaxf(l1, l2)); float e0 = expf(l0 - mm), e1 = expf(l1 - mm), e2 = expf(l2 - mm), is = 1.f / (e0 + e1 + e2);
  for (int d = 0; d < 64; ++d) { long c = (long)q * 512 + h * 64 + d;
    float v = (e0 * ldf(&p.dop[c]) + e1 * ldf(&p.dop[(long)p.S * 512 + c]) + e2 * ldf(&p.dop[(long)2 * p.S * 512 + c])) * is;
    SB* mp = &p.mix[(long)q * NMIX + MX_D + h * 64 + d]; stf(mp, v * ldf(mp)); }
}
HD_ void ph_m(const Params& p, int layer, long gid) {
  int h = (int)(gid & 3), q = (int)(gid >> 2);
  float qv[64], o[64]; for (int d = 0; d < 64; ++d) { qv[d] = ldf(&p.proj[(long)q * NPROJ + PM_Q + h * 64 + d]); o[d] = 0.f; }
  float m = -1e30f, l = 0.f; const SB* kvb = p.memkv + (long)layer * 256 * 512;
  for (int t = 0; t < 256; ++t) { const SB* kr = kvb + (long)t * 512 + h * 64; const SB* vr = kr + 256;
    float s = 0.f; for (int d = 0; d < 64; ++d) s += qv[d] * ldf(&kr[d]); s *= 0.125f;
    float mn = fmaxf(m, s), a = expf(m - mn), pr = expf(s - mn); l = l * a + pr; for (int d = 0; d < 64; ++d) o[d] = o[d] * a + pr * ldf(&vr[d]); m = mn; }
  float il = 1.f / l; for (int d = 0; d < 64; ++d) { SB* mp = &p.mix[(long)q * NMIX + MX_M + h * 64 + d]; stf(mp, o[d] * il * ldf(mp)); }
}
HD_ void ph_b_conv(const Params& p, int layer, long gid) {
  int c = (int)(gid & 1023), t = (int)(gid >> 10); const float* w = p.conv_w + (long)layer * 4 * 1024;
  float acc = p.conv_b[layer * 1024 + c];
  for (int i = 0; i < 4; ++i) { int tt = t - 3 + i; if (tt >= 0) acc += w[i * 1024 + c] * ldf(&p.proj[(long)tt * NPROJ + PB_X + c]); }
  stf(&p.xconv[gid], silu_f(acc));
}
HD_ void ph_b_dt(const Params& p, int layer, long gid) {
  int hd = (int)(gid & 7), c = (int)(gid >> 3); float a = -expf(p.a_log[layer * 8 + hd]); float cs = 0.f;
  for (int l = 0; l < 128; ++l) { int t = c * 128 + l; float dt = softplus_f(p.small[(long)t * NSMALL + 24 + hd] + p.dt_bias[layer * 8 + hd]);
    cs += dt * a; p.dt[(long)t * 8 + hd] = dt; p.acs[(long)t * 8 + hd] = cs; }
}
HD_ void ph_b_cb(const Params& p, long gid) {
  int s = (int)(gid & 127), l = (int)((gid >> 7) & 127), g = (int)((gid >> 14) & 1), c = (int)(gid >> 15);
  if (s > l) { p.cb[gid] = 0.f; return; }
  const SB* cm = &p.xconv[(long)(c * 128 + l) * 1024 + 768 + g * 128]; const SB* bm = &p.xconv[(long)(c * 128 + s) * 1024 + 512 + g * 128];
  float acc = 0.f; for (int n = 0; n < 128; ++n) acc += ldf(&cm[n]) * ldf(&bm[n]);
  p.cb[gid] = acc;
}
HD_ void ph_b_states(const Params& p, long gid) {
  int n = (int)(gid & 127), pp = (int)((gid >> 7) & 63), hd = (int)((gid >> 13) & 7), c = (int)(gid >> 16), g = hd >> 2;
  float last = p.acs[(long)(c * 128 + 127) * 8 + hd]; float acc = 0.f;
  for (int l = 0; l < 128; ++l) { long t = c * 128 + l;
    acc += ldf(&p.xconv[t * 1024 + 512 + g * 128 + n]) * expf(last - p.acs[t * 8 + hd]) * ldf(&p.xconv[t * 1024 + hd * 64 + pp]) * p.dt[t * 8 + hd]; }
  p.states[gid] = acc;
}
HD_ void ph_b_scan(const Params& p, long gid) {
  int hd = (int)(gid >> 13); int nc = p.S / 128; float h = 0.f;
  for (int c = 0; c < nc; ++c) { float* sp = &p.states[(long)c * 65536 + gid]; float st = *sp; *sp = h; h = h * expf(p.acs[(long)(c * 128 + 127) * 8 + hd]) + st; }
}
HD_ void ph_b_out(const Params& p, int layer, long gid) {
  int pp = (int)(gid & 63), hd = (int)((gid >> 6) & 7), t = (int)(gid >> 9), g = hd >> 2, c = t >> 7, l = t & 127;
  float al = p.acs[(long)t * 8 + hd]; float acc = 0.f;
  const float* cbr = &p.cb[(((long)c * 2 + g) * 128 + l) * 128];
  for (int s = 0; s <= l; ++s) { long ts = c * 128 + s; acc += cbr[s] * expf(al - p.acs[ts * 8 + hd]) * ldf(&p.xconv[ts * 1024 + hd * 64 + pp]) * p.dt[ts * 8 + hd]; }
  float acc2 = 0.f; const float* pr = &p.states[(long)c * 65536 + ((long)hd * 64 + pp) * 128]; const SB* cm = &p.xconv[(long)t * 1024 + 768 + g * 128];
  for (int n = 0; n < 128; ++n) acc2 += ldf(&cm[n]) * pr[n];
  p.ybuf[gid] = acc + expf(al) * acc2 + ldf(&p.xconv[(long)t * 1024 + hd * 64 + pp]) * p.b_d[layer * 8 + hd];
}
HD_ void ph_b_norm(const Params& p, int layer, long gid) {
  int g = (int)(gid & 1), t = (int)(gid >> 1); float ss = 0.f;
  for (int i = 0; i < 256; ++i) { float v = p.ybuf[(long)t * 512 + g * 256 + i] * ldf(&p.mix[(long)t * NMIX + MX_B + g * 256 + i]); ss += v * v; }
  float r = 1.f / sqrtf(ss / 256.f + 1e-6f);
  for (int i = 0; i < 256; ++i) { SB* mp = &p.mix[(long)t * NMIX + MX_B + g * 256 + i]; float v = p.ybuf[(long)t * 512 + g * 256 + i] * ldf(mp);
    stf(mp, v * r * p.b_norm[layer * 512 + g * 256 + i]); }
}

#define SEQ 16384
#define DEPTH 4
typedef __attribute__((ext_vector_type(8))) short bf16x8;
typedef __attribute__((ext_vector_type(16))) float f32x16;

__device__ __forceinline__ int n2o(int n) {
  if (n < 1280) return n;
  if (n < 2304) return n - 1280 + 1816;
  if (n < 2816) return n - 2304 + 3360;
  if (n < 3072) return n - 2816 + 3872;
  if (n < 4608) return n - 3072 + 4640;
  if (n < 5632) return n - 4608 + 6176;
  if (n < 5888) return n - 5632 + 7712;
  n -= 5888;
  if (n < 512) return 1304 + n;
  if (n < 1024) return 2848 + n - 512;
  if (n < 1536) return 4128 + n - 1024;
  if (n < 2048) return 7200 + n - 1536;
  if (n < 2304) return 7968 + n - 2048;
  n -= 2304;
  if (n < 24) return 1280 + n;
  if (n < 32) return 2840 + n - 24;
  return -1;
}

template <bool MAP>
__device__ __forceinline__ void cvt_tile(const float* __restrict__ src, int lds_, unsigned short* __restrict__ dst, int ldd, int k0, int n0, float* tile  ) {
  const int tid = threadIdx.x;
  __syncthreads();
#pragma unroll
  for (int e = 0; e < 16; ++e) { int idx = tid + 256 * e, kk = idx >> 6, nn = idx & 63; int oc = MAP ? n2o(n0 + nn) : (n0 + nn);
    tile[kk * 65 + nn] = (oc >= 0) ? src[(long)(k0 + kk) * lds_ + oc] : 0.f; }
  __syncthreads();
#pragma unroll
  for (int e = 0; e < 16; ++e) { int idx = tid + 256 * e, nn = idx >> 6, kk = idx & 63; dst[(long)(n0 + nn) * ldd + k0 + kk] = f2bf(tile[kk * 65 + nn]); }
}

__device__ __forceinline__ float wave_sum(float v) {
#pragma unroll
  for (int o = 32; o > 0; o >>= 1) v += __shfl_xor(v, o);
  return v;
}

__device__ __forceinline__ void norm_row_wave(const Params& p, int layer, int t, bool do_h, int lane) {
  const float* xin = (layer == 0) ? p.x + (long)t * DM : p.out + (long)t * DM;
  float4 xv[4], yv[4];
#pragma unroll
  for (int i = 0; i < 4; ++i) xv[i] = *(const float4*)(xin + i * 256 + lane * 4);
  if (layer > 0) {
    float ss = 0.f;
#pragma unroll
    for (int i = 0; i < 4; ++i) { yv[i] = *(const float4*)(p.y + (long)t * DM + i * 256 + lane * 4); ss += yv[i].x * yv[i].x + yv[i].y * yv[i].y + yv[i].z * yv[i].z + yv[i].w * yv[i].w; }
    ss = wave_sum(ss); float r1 = 1.f / sqrtf(ss / DM + 1e-6f);
#pragma unroll
    for (int i = 0; i < 4; ++i) { float4 w = *(const float4*)(p.post_norm + (layer - 1) * DM + i * 256 + lane * 4);
      xv[i].x += yv[i].x * r1 * w.x; xv[i].y += yv[i].y * r1 * w.y; xv[i].z += yv[i].z * r1 * w.z; xv[i].w += yv[i].w * r1 * w.w; }
  }
  float ss2 = 0.f;
#pragma unroll
  for (int i = 0; i < 4; ++i) { *(float4*)(p.out + (long)t * DM + i * 256 + lane * 4) = xv[i]; ss2 += xv[i].x * xv[i].x + xv[i].y * xv[i].y + xv[i].z * xv[i].z + xv[i].w * xv[i].w; }
  if (!do_h) return;
  ss2 = wave_sum(ss2); float r2 = 1.f / sqrtf(ss2 / DM + 1e-6f);
#pragma unroll
  for (int i = 0; i < 4; ++i) { float4 w = *(const float4*)(p.pre_norm + layer * DM + i * 256 + lane * 4);
    ushort4 o; o.x = f2bf(xv[i].x * r2 * w.x); o.y = f2bf(xv[i].y * r2 * w.y); o.z = f2bf(xv[i].z * r2 * w.z); o.w = f2bf(xv[i].w * r2 * w.w);
    *(ushort4*)(p.h + (long)t * DM + i * 256 + lane * 4) = o; }
}

#define GBK 32
#define GLD 40
struct GemmSmem { unsigned short a[2][128 * GLD]; unsigned short b[2][128 * GLD]; };

template <int EPI>
__device__ __forceinline__ void gemm_tile(const Params& p, const unsigned short* __restrict__ A, int lda, const unsigned short* __restrict__ Bt, int ldb, int K, int m0, int n0, GemmSmem& sm) {
  const int tid = threadIdx.x, lane = tid & 63, wid = tid >> 6, wr = wid >> 1, wc = wid & 1, r = lane & 31, h = lane >> 5;
  f32x16 acc[2][2];
#pragma unroll
  for (int i = 0; i < 2; ++i)
#pragma unroll
    for (int j = 0; j < 2; ++j)
#pragma unroll
      for (int e = 0; e < 16; ++e) acc[i][j][e] = 0.f;
  const int c0row = tid >> 2, c0k = (tid & 3) * 8;
  const unsigned short* ga0 = A + (long)(m0 + c0row) * lda + c0k;
  const unsigned short* ga1 = A + (long)(m0 + c0row + 64) * lda + c0k;
  const unsigned short* gb0 = Bt + (long)(n0 + c0row) * ldb + c0k;
  const unsigned short* gb1 = Bt + (long)(n0 + c0row + 64) * ldb + c0k;
  uint4 ra0 = *(const uint4*)ga0, ra1 = *(const uint4*)ga1, rb0 = *(const uint4*)gb0, rb1 = *(const uint4*)gb1;
  __syncthreads();
  *(uint4*)&sm.a[0][c0row * GLD + c0k] = ra0; *(uint4*)&sm.a[0][(c0row + 64) * GLD + c0k] = ra1;
  *(uint4*)&sm.b[0][c0row * GLD + c0k] = rb0; *(uint4*)&sm.b[0][(c0row + 64) * GLD + c0k] = rb1;
  __syncthreads();
  const int nk = K / GBK;
  for (int kt = 0; kt < nk; ++kt) {
    const int cur = kt & 1;
    if (kt + 1 < nk) { const int ko = (kt + 1) * GBK; ra0 = *(const uint4*)(ga0 + ko); ra1 = *(const uint4*)(ga1 + ko); rb0 = *(const uint4*)(gb0 + ko); rb1 = *(const uint4*)(gb1 + ko); }
#pragma unroll
    for (int ks = 0; ks < 2; ++ks) {
      bf16x8 af[2], bfr[2];
#pragma unroll
      for (int i = 0; i < 2; ++i) af[i] = *(const bf16x8*)&sm.a[cur][(wr * 64 + i * 32 + r) * GLD + ks * 16 + h * 8];
#pragma unroll
      for (int j = 0; j < 2; ++j) bfr[j] = *(const bf16x8*)&sm.b[cur][(wc * 64 + j * 32 + r) * GLD + ks * 16 + h * 8];
#pragma unroll
      for (int i = 0; i < 2; ++i)
#pragma unroll
        for (int j = 0; j < 2; ++j) acc[i][j] = __builtin_amdgcn_mfma_f32_32x32x16_bf16(af[i], bfr[j], acc[i][j], 0, 0, 0);
    }
    if (kt + 1 < nk) {
      const int nx = cur ^ 1;
      *(uint4*)&sm.a[nx][c0row * GLD + c0k] = ra0; *(uint4*)&sm.a[nx][(c0row + 64) * GLD + c0k] = ra1;
      *(uint4*)&sm.b[nx][c0row * GLD + c0k] = rb0; *(uint4*)&sm.b[nx][(c0row + 64) * GLD + c0k] = rb1;
    }
    __syncthreads();
  }
  const int ncol0 = n0 + wc * 64;
  if (EPI == 1) {
#pragma unroll
    for (int i = 0; i < 2; ++i)
#pragma unroll
      for (int j = 0; j < 2; ++j)
#pragma unroll
        for (int e = 0; e < 16; ++e) { int row = m0 + wr * 64 + i * 32 + (e & 3) + 8 * (e >> 2) + 4 * h; p.y[(long)row * DM + ncol0 + j * 32 + r] = acc[i][j][e]; }
  } else {
    if (ncol0 < NPROJ) {
      const bool rope = (ncol0 >= PC_Q && ncol0 < PC_KV + 128);
#pragma unroll
      for (int i = 0; i < 2; ++i)
#pragma unroll
        for (int e = 0; e < 16; ++e) { int row = m0 + wr * 64 + i * 32 + (e & 3) + 8 * (e >> 2) + 4 * h; float v0 = acc[i][0][e], v1 = acc[i][1][e];
          if (rope) { float c = p.rope_cs[row * 32 + r], s = p.rope_sn[row * 32 + r]; float t1 = v0, t2 = v1; v0 = t1 * c - t2 * s; v1 = t2 * c + t1 * s; }
          p.proj[(long)row * NPROJ + ncol0 + r] = f2bf(v0); p.proj[(long)row * NPROJ + ncol0 + 32 + r] = f2bf(v1); }
    } else if (ncol0 < 8192) {
#pragma unroll
      for (int i = 0; i < 2; ++i)
#pragma unroll
        for (int j = 0; j < 2; ++j)
#pragma unroll
          for (int e = 0; e < 16; ++e) { int row = m0 + wr * 64 + i * 32 + (e & 3) + 8 * (e >> 2) + 4 * h; p.mix[(long)row * NMIX + (ncol0 - NPROJ) + j * 32 + r] = f2bf(silu_f(acc[i][j][e])); }
    } else if (ncol0 == 8192) {
#pragma unroll
      for (int i = 0; i < 2; ++i)
#pragma unroll
        for (int e = 0; e < 16; ++e) { int row = m0 + wr * 64 + i * 32 + (e & 3) + 8 * (e >> 2) + 4 * h; p.small[(long)row * NSMALL + r] = acc[i][0][e]; }
    }
  }
}

__device__ __forceinline__ int gw0(int g) { asm volatile("" : "+v"(g)); return g; }
__device__ __forceinline__ int bid0() { int b = blockIdx.x; asm volatile("" : "+s"(b)); return b; }
__global__ void __launch_bounds__(256, 1) mega(Params p) {
  cg::grid_group grid = cg::this_grid();
  __shared__ __attribute__((aligned(16))) char smem_raw[sizeof(GemmSmem)];
  GemmSmem& gsm = *(GemmSmem*)smem_raw;
  float* ftile = (float*)smem_raw;
  const int tid = threadIdx.x, lane = tid & 63;
  const long gtid = (long)blockIdx.x * 256 + tid, gsz = (long)gridDim.x * 256;
  const int gwave = (int)(gtid >> 6), nwave = (int)(gsz >> 6);
  const int S = p.S, ncmp = S / 16, nc = S / 128;
#define GS(N, body) { long g0_ = gtid; asm volatile("" : "+v"(g0_)); for (long gid = g0_; gid < (long)(N); gid += gsz) { body; } }
#define OPQS(v) asm volatile("" : "+s"(v))
  GS((long)S * 32, ph_rope(p, gid));
  GS(8 * TABA_N + 24 * TABD_N, ph_tabs(p, gid));
  GS((long)DEPTH * 256 * 512, ph_memkv(p, gid));
  for (int layer = 0; layer < DEPTH; ++layer) {
    for (int t = gw0(gwave); t < S; t += nwave) norm_row_wave(p, layer, t, true, lane);
    { const float* wi = p.w_in + (long)layer * 1024 * 8224;
      for (int tl = bid0(); tl < 16 * 130; tl += gridDim.x) cvt_tile<true>(wi, 8224, p.wt_in, 1024, (tl & 15) * 64, (tl >> 4) * 64, ftile);
      const float* wo = p.w_out + (long)layer * 2304 * 1024;
      for (int tl = bid0(); tl < 36 * 16; tl += gridDim.x) cvt_tile<false>(wo, 1024, p.wt_out, 2304, (tl % 36) * 64, (tl / 36) * 64, ftile); }
    grid.sync();
    for (int tl = bid0(); tl < (S / 128) * 65; tl += gridDim.x) { int mt = tl % (S / 128), nt = tl / (S / 128); gemm_tile<0>(p, p.h, DM, p.wt_in, DM, DM, mt * 128, nt * 128, gsm); }
    grid.sync();
    GS((long)2 * ncmp * 256, ph_cmp_hid(p, layer, gid));
    GS((long)S * 1024, ph_b_conv(p, layer, gid));
    GS((long)nc * 8, ph_b_dt(p, layer, gid));
    GS((long)S * 8, ph_a_win(p, gid));
    GS((long)S * 8, ph_c(p, layer, gid));
    GS((long)3 * S * 8, ph_d(p, gid));
    GS((long)S * 4, ph_m(p, layer, gid));
    grid.sync();
    GS((long)2 * ncmp * 128, ph_cmp_out(p, layer, gid));
    GS((long)nc * 2 * 128 * 128, ph_b_cb(p, gid));
    GS((long)nc * 65536, ph_b_states(p, gid));
    GS((long)S * 8, ph_d_merge(p, gid));
    grid.sync();
    GS((long)S * 8, ph_a_cmp1(p, gid));
    GS(65536, ph_b_scan(p, gid));
    grid.sync();
    GS((long)S * 2, { ph_a_cmp2(p, gid); ph_a_topk(p, gid); });
    GS((long)S * 512, ph_b_out(p, layer, gid));
    grid.sync();
    GS((long)S * 8, ph_a_sel(p, gid));
    GS((long)S * 2, ph_b_norm(p, layer, gid));
    grid.sync();
    for (int tl = bid0(); tl < (S / 128) * 8; tl += gridDim.x) { int mt = tl % (S / 128), nt = tl / (S / 128); gemm_tile<1>(p, p.mix, NMIX, p.wt_out, NMIX, NMIX, mt * 128, nt * 128, gsm); }
    grid.sync();
  }
  for (int t = gw0(gwave); t < S; t += nwave) norm_row_wave(p, DEPTH, t, false, lane);
}

extern "C" void kernel_launch(void* const* d_in, const int* in_sizes, int n_in, void* d_out, int out_size, void* d_ws, size_t ws_size, hipStream_t stream) {
  Params p; memset(&p, 0, sizeof(p));
  p.S = SEQ;
  p.x = (const float*)d_in[0]; p.mem = (const float*)d_in[1]; p.pos = (const int*)d_in[2]; p.pre_norm = (const float*)d_in[3]; p.post_norm = (const float*)d_in[4];
  p.w_in = (const float*)d_in[5]; p.w_out = (const float*)d_in[6]; p.rel_bias = (const float*)d_in[7]; p.cmp_pos = (const float*)d_in[8]; p.cmp_w1 = (const float*)d_in[9];
  p.cmp_w2 = (const float*)d_in[10]; p.conv_w = (const float*)d_in[11]; p.conv_b = (const float*)d_in[12]; p.dt_bias = (const float*)d_in[13]; p.a_log = (const float*)d_in[14];
  p.b_d = (const float*)d_in[15]; p.b_norm = (const float*)d_in[16]; p.sinks = (const float*)d_in[17]; p.m_norm = (const float*)d_in[18]; p.m_wkv = (const float*)d_in[19];
  p.out = (float*)d_out;
  char* w = (char*)d_ws; size_t off = 0;
  auto take = [&](size_t bytes) { char* r = w + off; off += (bytes + 255) & ~(size_t)255; return r; };
  const size_t S = SEQ, ncmp = S / 16, nc = S / 128;
  p.wt_in = (unsigned short*)take(8320 * 1024 * 2); p.wt_out = (unsigned short*)take(1024 * 2304 * 2);
  p.h = (SB*)take(S * 1024 * 2);    p.ybuf = (float*)p.h;
  p.proj = (SB*)take(S * NPROJ * 2); p.y = (float*)p.proj;
  p.small = (float*)take(S * 32 * 4); p.mix = (SB*)take(S * NMIX * 2);
  p.rope_cs = (float*)take(S * 32 * 4); p.rope_sn = (float*)take(S * 32 * 4); p.tabA = (float*)take(8 * TABA_N * 4); p.tabD = (float*)take(24 * TABD_N * 4);
  p.memkv = (SB*)take(4 * 256 * 512 * 2); p.hid = (float*)take(2 * ncmp * 256 * 4); p.kvc = (SB*)take(2 * ncmp * 128 * 2);
  p.cml = (float*)take(S * 16 * 4); p.idx = (int*)take(S * 32 * 4); p.oc = (SB*)take(S * 512 * 2); p.ow = (SB*)take(S * 512 * 2);
  p.dop = (SB*)take(3 * S * 512 * 2); p.imp = (float*)p.dop;    p.dlse = (float*)take(3 * S * 8 * 4); p.xconv = (SB*)take(S * 1024 * 2);
  p.dt = (float*)take(S * 8 * 4); p.acs = (float*)take(S * 8 * 4); p.cb = (float*)take(nc * 2 * 128 * 128 * 4); p.states = (float*)take(nc * 65536 * 4);
  p.bar = (unsigned*)take(16384);
  if (off > ws_size) { fprintf(stderr, "workspace too small: need %zu have %zu\n", off, ws_size); return; }
  static int grid_blocks = 0;
  if (!grid_blocks) { int dev = 0, cus = 0, per_cu = 0; hipGetDevice(&dev); hipDeviceGetAttribute(&cus, hipDeviceAttributeMultiprocessorCount, dev);
    hipOccupancyMaxActiveBlocksPerMultiprocessor(&per_cu, mega, 256, 0); if (per_cu > 1) per_cu = 1; if (per_cu < 1) per_cu = 1; grid_blocks = cus * per_cu; }
  void* args[] = {&p};
  hipError_t e = hipLaunchCooperativeKernel((void*)mega, dim3(grid_blocks), dim3(256), args, 0, stream);
  if (e != hipSuccess) fprintf(stderr, "cooperative launch failed: %s (grid %d)\n", hipGetErrorString(e), grid_blocks);
}
```

```cpp
#include <hip/hip_runtime.h>
#include <hip/hip_cooperative_groups.h>
#include <cstdio>
#include <cstdint>
#include <cstring>
namespace cg = cooperative_groups;
#define HD_ __device__ __forceinline__
#ifndef CHKSEL
#define CHKSEL -1
#endif
#ifndef LB2
#define LB2 2
#endif
#ifndef HD_
#define HD_ inline
#endif
#ifdef SB_IS_FLOAT
typedef float SB;
HD_ float ldf(const SB* p) { return *p; }
HD_ void stf(SB* p, float v) { *p = v; }
#else
typedef unsigned short SB;
HD_ float bf2f(unsigned short b) { unsigned u = ((unsigned)b) << 16; float f; __builtin_memcpy(&f, &u, 4); return f; }
HD_ unsigned short f2bf(float f) { unsigned u; __builtin_memcpy(&u, &f, 4); u += 0x7fffu + ((u >> 16) & 1u); return (unsigned short)(u >> 16); }
HD_ float ldf(const SB* p) { return bf2f(*p); }
HD_ void stf(SB* p, float v) { *p = f2bf(v); }
#endif

#define DM 1024
#define NPROJ 5888
#define NMIX 2304
#define NSMALL 32
#define PA_Q 0
#define PA_KV 512
#define PB_X 1280
#define PC_Q 2304
#define PC_KV 2816
#define PD_Q 3072
#define PD_KV 4608
#define PM_Q 5632
#define MX_A 0
#define MX_B 512
#define MX_C 1024
#define MX_D 1536
#define MX_M 2048
#define TABA_N 2048
#define TABD_N 132

struct Params {
  int S; int pad0;
  const float *x, *mem; const int* pos;
  const float *pre_norm, *post_norm, *w_in, *w_out, *rel_bias, *cmp_pos, *cmp_w1, *cmp_w2, *conv_w, *conv_b, *dt_bias, *a_log, *b_d,
      *b_norm, *sinks, *m_norm, *m_wkv;
  float* out;
  unsigned short* wt_in;
  unsigned short* wt_out;
  unsigned short *w1t, *w2t;
  SB* h;
  SB* proj;
  float* small;
  SB* mix;
  float* y;
  float *rope_cs, *rope_sn;
  float *tabA, *tabD;
  SB* memkv;
  float* hid;
  SB* kvc;
  float* imp;
  float* cml;
  int* idx;
  SB *oc, *ow;
  SB* dop;
  float* dlse;
  SB* xconv;
  float *dt, *acs;
  float* wst;
  float* cb;
  float* states;
  float* ybuf;
  unsigned* bar;
};

HD_ float silu_f(float x) { return x / (1.f + expf(-x)); }
HD_ float sigmoid_f(float x) { return 1.f / (1.f + expf(-x)); }
HD_ float gelu_f(float x) { return 0.5f * x * (1.f + tanhf(0.7978845608028654f * (x + 0.044715f * x * x * x))); }
HD_ float softplus_f(float x) { return fmaxf(x, 0.f) + log1pf(expf(-fabsf(x))); }

HD_ int t5_bucket(int d) {
  if (d < 16) return d < 0 ? 0 : d;
  const int thr[15] = {22, 30, 40, 54, 73, 99, 134, 182, 246, 332, 450, 609, 825, 1117, 1513};
  int b = 16;
  for (int k = 0; k < 15; ++k) b += (d >= thr[k]) ? 1 : 0;
  return b;
}

HD_ void ph_rope(const Params& p, long gid) {
  int s = (int)(gid >> 5), i = (int)(gid & 31);
  float inv = powf(150000.f, -(float)i / 32.f);
  float ang = (float)p.pos[s] * inv;
  p.rope_cs[gid] = cosf(ang); p.rope_sn[gid] = sinf(ang);
}
HD_ void ph_tabs(const Params& p, long gid) {
  if (gid < 8 * TABA_N) { int h = (int)(gid / TABA_N), d = (int)(gid % TABA_N); p.tabA[gid] = p.rel_bias[t5_bucket(d) * 32 + h]; }
  else { long g2 = gid - 8 * TABA_N; int hh = (int)(g2 / TABD_N), d = (int)(g2 % TABD_N); int gi = hh >> 3;
    int dil = gi == 0 ? 1 : (gi == 1 ? 4 : 16); p.tabD[g2] = p.rel_bias[t5_bucket(d * dil) * 32 + 8 + hh]; }
}
HD_ void ph_memkv(const Params& p, long gid) {
  int e = (int)(gid & 511), m = (int)((gid >> 9) & 255), l = (int)(gid >> 17);
  const float* row = p.mem + (long)m * DM;
  float ss = 0.f; _Pragma("unroll 16") for (int d = 0; d < DM; ++d) ss += row[d] * row[d];
  float r = 1.f / sqrtf(ss / DM + 1e-6f);
  float acc = 0.f;
  _Pragma("unroll 16") for (int d = 0; d < DM; ++d) acc += row[d] * r * p.m_norm[l * DM + d] * p.m_wkv[((long)l * DM + d) * 512 + e];
  stf(&p.memkv[gid], acc);
}
HD_ void ph_norm_row(const Params& p, int layer, int t, bool do_h) {
  const float* xin = (layer == 0) ? p.x + (long)t * DM : p.out + (long)t * DM;
  float* xo = p.out + (long)t * DM;
  float r1 = 0.f;
  if (layer > 0) { const float* y = p.y + (long)t * DM; float ss = 0.f; for (int d = 0; d < DM; ++d) ss += y[d] * y[d]; r1 = 1.f / sqrtf(ss / DM + 1e-6f); }
  float ss2 = 0.f;
  for (int d = 0; d < DM; ++d) { float v = xin[d]; if (layer > 0) v += p.y[(long)t * DM + d] * r1 * p.post_norm[(layer - 1) * DM + d]; xo[d] = v; ss2 += v * v; }
  if (!do_h) return;
  float r2 = 1.f / sqrtf(ss2 / DM + 1e-6f);
  for (int d = 0; d < DM; ++d) stf(&p.h[(long)t * DM + d], xo[d] * r2 * p.pre_norm[layer * DM + d]);
}

HD_ void ph_cmp_hid(const Params& p, int layer, long gid) {
  int u = (int)(gid & 127), hk = (int)((gid >> 7) & 1); long r = gid >> 8; int ncmp = p.S / 16; int j = (int)(r % ncmp), kv = (int)(r / ncmp);
  const float* w1 = p.cmp_w1 + ((long)(layer * 2 + kv) * 2048) * 128;
  const float* pe = p.cmp_pos + (long)(layer * 2 + kv) * 32 * 64;
  float acc = 0.f;
  for (int t = 0; t < 32; ++t) { int tok = 16 * j + t;
    _Pragma("unroll 16") for (int d = 0; d < 64; ++d) { float v = pe[t * 64 + d]; if (tok < p.S) v += ldf(&p.proj[(long)tok * NPROJ + PA_KV + kv * 128 + hk * 64 + d]);
      acc += v * w1[(long)(t * 64 + d) * 128 + u]; } }
  p.hid[gid] = gelu_f(acc);
}
HD_ void ph_cmp_out(const Params& p, int layer, long gid) {
  int d = (int)(gid & 63), hk = (int)((gid >> 6) & 1); long r = gid >> 7; int ncmp = p.S / 16; int j = (int)(r % ncmp), kv = (int)(r / ncmp);
  const float* w2 = p.cmp_w2 + (long)(layer * 2 + kv) * 128 * 64;
  const float* hd = p.hid + (((long)kv * ncmp + j) * 2 + hk) * 128;
  float acc = 0.f; for (int u = 0; u < 128; ++u) acc += hd[u] * w2[u * 64 + d];
  stf(&p.kvc[gid], acc);
}
HD_ void ph_a_cmp1(const Params& p, long gid) {
  int h = (int)(gid & 7), q = (int)(gid >> 3), g = h >> 2; int ncmp = p.S / 16;
  int jn = (q >= 31) ? ((q - 31) / 16 + 1) : 0;
  const SB* kc = p.kvc; const SB* vc = p.kvc + (long)ncmp * 128;
  float qv[64], o[64]; for (int d = 0; d < 64; ++d) { qv[d] = ldf(&p.proj[(long)q * NPROJ + PA_Q + h * 64 + d]); o[d] = 0.f; }
  float m = -1e30f, l = 0.f;
  for (int j = 0; j < jn; ++j) { const SB* kr = &kc[((long)j * 2 + g) * 64]; const SB* vr = &vc[((long)j * 2 + g) * 64];
    float s = 0.f; for (int d = 0; d < 64; ++d) s += qv[d] * ldf(&kr[d]);
    int dist = q - (16 * j + 31); s = s * 0.125f + p.tabA[h * TABA_N + (dist < TABA_N ? dist : TABA_N - 1)];
    float mn = fmaxf(m, s), a = expf(m - mn), pr = expf(s - mn); l = l * a + pr; for (int d = 0; d < 64; ++d) o[d] = o[d] * a + pr * ldf(&vr[d]); m = mn; }
  float il = jn > 0 ? 1.f / l : 0.f; for (int d = 0; d < 64; ++d) stf(&p.oc[(long)q * 512 + h * 64 + d], o[d] * il);
  p.cml[gid * 2] = m; p.cml[gid * 2 + 1] = il;
}
HD_ void ph_a_cmp2(const Params& p, long gid) {
  int g = (int)(gid & 1), q = (int)(gid >> 1); int ncmp = p.S / 16;
  float* imp = p.imp + gid * 256; for (int b = 0; b < 256; ++b) imp[b] = 0.f;
  int jn = (q >= 31) ? ((q - 31) / 16 + 1) : 0; const SB* kc = p.kvc;
  for (int hh = 0; hh < 4; ++hh) { int h = g * 4 + hh; float qv[64]; for (int d = 0; d < 64; ++d) qv[d] = ldf(&p.proj[(long)q * NPROJ + PA_Q + h * 64 + d]);
    float m = p.cml[((long)q * 8 + h) * 2], il = p.cml[((long)q * 8 + h) * 2 + 1];
    for (int j = 0; j < jn; ++j) { const SB* kr = &kc[((long)j * 2 + g) * 64]; float s = 0.f; for (int d = 0; d < 64; ++d) s += qv[d] * ldf(&kr[d]);
      int dist = q - (16 * j + 31); s = s * 0.125f + p.tabA[h * TABA_N + (dist < TABA_N ? dist : TABA_N - 1)]; float pr = expf(s - m) * il;
      imp[j >> 2] += pr; if (j + 1 < ncmp) imp[(j + 1) >> 2] += pr; } }
}
HD_ void ph_a_topk(const Params& p, long gid) {
  int q = (int)(gid >> 1); float* imp = p.imp + gid * 256; int* idx = p.idx + gid * 16; int cur = q >> 6;
  imp[0] = 1e4f; imp[cur] = 1e4f;
  for (int k = 0; k < 16; ++k) { int best = -1; float bv = -1.f;
    for (int b = 0; b <= cur; ++b) { float v = imp[b]; if (v > bv) { bv = v; best = b; } }
    idx[k] = best; if (best >= 0) imp[best] = -2.f; }
}
HD_ void ph_a_win(const Params& p, long gid) {
  int h = (int)(gid & 7), q = (int)(gid >> 3), hk = h >> 2;
  float qv[64], o[64]; for (int d = 0; d < 64; ++d) { qv[d] = ldf(&p.proj[(long)q * NPROJ + PA_Q + h * 64 + d]); o[d] = 0.f; }
  float m = -1e30f, l = 0.f; int lo = q - 511 < 0 ? 0 : q - 511;
  for (int t = lo; t <= q; ++t) { const SB* kr = &p.proj[(long)t * NPROJ + PA_KV + 4 * 128 + hk * 64]; const SB* vr = kr + 128;
    float s = 0.f; for (int d = 0; d < 64; ++d) s += qv[d] * ldf(&kr[d]); s = s * 0.125f + p.tabA[h * TABA_N + (q - t)];
    float mn = fmaxf(m, s), a = expf(m - mn), pr = expf(s - mn); l = l * a + pr; for (int d = 0; d < 64; ++d) o[d] = o[d] * a + pr * ldf(&vr[d]); m = mn; }
  float il = 1.f / l; for (int d = 0; d < 64; ++d) stf(&p.ow[(long)q * 512 + h * 64 + d], o[d] * il);
}
HD_ void ph_a_sel(const Params& p, long gid) {
  int h = (int)(gid & 7), q = (int)(gid >> 3), hk = h >> 2; const int* idx = p.idx + ((long)q * 2 + hk) * 16;
  float qv[64], o[64]; for (int d = 0; d < 64; ++d) { qv[d] = ldf(&p.proj[(long)q * NPROJ + PA_Q + h * 64 + d]); o[d] = 0.f; }
  float m = -1e30f, l = 0.f;
  for (int k = 0; k < 16; ++k) { int b = idx[k]; if (b < 0) continue;
    for (int i = 0; i < 64; ++i) { int t = b * 64 + i; if (t > q) break;
      const SB* kr = &p.proj[(long)t * NPROJ + PA_KV + 2 * 128 + hk * 64]; const SB* vr = kr + 128;
      float s = 0.f; for (int d = 0; d < 64; ++d) s += qv[d] * ldf(&kr[d]); int dist = q - t; s = s * 0.125f + p.tabA[h * TABA_N + (dist < TABA_N ? dist : TABA_N - 1)];
      float mn = fmaxf(m, s), a = expf(m - mn), pr = expf(s - mn); l = l * a + pr; for (int d = 0; d < 64; ++d) o[d] = o[d] * a + pr * ldf(&vr[d]); m = mn; } }
  float il = 1.f / l; const float* gl = p.small + (long)q * NSMALL + h * 3;
  float g0 = sigmoid_f(gl[0]), g1 = sigmoid_f(gl[1]), g2 = sigmoid_f(gl[2]);
  for (int d = 0; d < 64; ++d) { long c = (long)q * 512 + h * 64 + d; float a = g0 * ldf(&p.oc[c]) + g1 * o[d] * il + g2 * ldf(&p.ow[c]);
    SB* mp = &p.mix[(long)q * NMIX + MX_A + h * 64 + d]; stf(mp, a * ldf(mp)); }
}
HD_ void ph_c(const Params& p, int layer, long gid) {
  int h = (int)(gid & 7), q = (int)(gid >> 3), hk = h >> 2;
  float qv[64], o[64]; for (int d = 0; d < 64; ++d) { qv[d] = ldf(&p.proj[(long)q * NPROJ + PC_Q + h * 64 + d]); o[d] = 0.f; }
  float m = p.sinks[layer * 8 + h], l = 1.f; int lo = q - 127 < 0 ? 0 : q - 127;
  for (int t = lo; t <= q; ++t) { const SB* kr = &p.proj[(long)t * NPROJ + PC_KV + hk * 64]; const SB* vr = kr + 128;
    float s = 0.f; for (int d = 0; d < 64; ++d) s += qv[d] * ldf(&kr[d]); s *= 0.125f;
    float mn = fmaxf(m, s), a = expf(m - mn), pr = expf(s - mn); l = l * a + pr; for (int d = 0; d < 64; ++d) o[d] = o[d] * a + pr * ldf(&vr[d]); m = mn; }
  float il = 1.f / l; for (int d = 0; d < 64; ++d) { SB* mp = &p.mix[(long)q * NMIX + MX_C + h * 64 + d]; stf(mp, o[d] * il * ldf(mp)); }
}
HD_ void ph_d(const Params& p, long gid) {
  int h = (int)(gid & 7); long r = gid >> 3; int q = (int)(r % p.S), gi = (int)(r / p.S); int dil = gi == 0 ? 1 : (gi == 1 ? 4 : 16);
  float qv[64], o[64]; for (int d = 0; d < 64; ++d) { qv[d] = ldf(&p.proj[(long)q * NPROJ + PD_Q + gi * 512 + h * 64 + d]); o[d] = 0.f; }
  float m = -1e30f, l = 0.f;
  for (int dd = 0; dd <= 128; ++dd) { int t = q - dil * dd; if (t < 0) break;
    const SB* kr = &p.proj[(long)t * NPROJ + PD_KV + h * 64]; const SB* vr = kr + 512;
    float s = 0.f; for (int d = 0; d < 64; ++d) s += qv[d] * ldf(&kr[d]); s = s * 0.125f + p.tabD[(gi * 8 + h) * TABD_N + dd];
    float mn = fmaxf(m, s), a = expf(m - mn), pr = expf(s - mn); l = l * a + pr; for (int d = 0; d < 64; ++d) o[d] = o[d] * a + pr * ldf(&vr[d]); m = mn; }
  float il = 1.f / l; for (int d = 0; d < 64; ++d) stf(&p.dop[((long)gi * p.S + q) * 512 + h * 64 + d], o[d] * il);
  p.dlse[((long)gi * p.S + q) * 8 + h] = m + logf(l);
}
HD_ void ph_d_merge(const Params& p, long gid) {
  int h = (int)(gid & 7), q = (int)(gid >> 3);
  float l0 = p.dlse[((long)0 * p.S + q) * 8 + h], l1 = p.dlse[((long)1 * p.S + q) * 8 + h], l2 = p.dlse[((long)2 * p.S + q) * 8 + h];
  float mm = fmaxf(l0, fmaxf(l1, l2)); float e0 = expf(l0 - mm), e1 = expf(l1 - mm), e2 = expf(l2 - mm), is = 1.f / (e0 + e1 + e2);
  for (int d = 0; d < 64; ++d) { long c = (long)q * 512 + h * 64 + d;
    float v = (e0 * ldf(&p.dop[c]) + e1 * ldf(&p.dop[(long)p.S * 512 + c]) + e2 * ldf(&p.dop[(long)2 * p.S * 512 + c])) * is;
    SB* mp = &p.mix[(long)q * NMIX + MX_D + h * 64 + d]; stf(mp, v * ldf(mp)); }
}
HD_ void ph_m(const Params& p, int layer, long gid) {
  int h = (int)(gid & 3), q = (int)(gid >> 2);
  float qv[64], o[64]; for (int d = 0; d < 64; ++d) { qv[d] = ldf(&p.proj[(long)q * NPROJ + PM_Q + h * 64 + d]); o[d] = 0.f; }
  float m = -1e30f, l = 0.f; const SB* kvb = p.memkv + (long)layer * 256 * 512;
  for (int t = 0; t < 256; ++t) { const SB* kr = kvb + (long)t * 512 + h * 64; const SB* vr = kr + 256;
    float s = 0.f; for (int d = 0; d < 64; ++d) s += qv[d] * ldf(&kr[d]); s *= 0.125f;
    float mn = fmaxf(m, s), a = expf(m - mn), pr = expf(s - mn); l = l * a + pr; for (int d = 0; d < 64; ++d) o[d] = o[d] * a + pr * ldf(&vr[d]); m = mn; }
  float il = 1.f / l; for (int d = 0; d < 64; ++d) { SB* mp = &p.mix[(long)q * NMIX + MX_M + h * 64 + d]; stf(mp, o[d] * il * ldf(mp)); }
}
HD_ void ph_b_conv(const Params& p, int layer, long gid) {
  int c = (int)(gid & 1023), t = (int)(gid >> 10); const float* w = p.conv_w + (long)layer * 4 * 1024;
  float acc = p.conv_b[layer * 1024 + c];
  for (int i = 0; i < 4; ++i) { int tt = t - 3 + i; if (tt >= 0) acc += w[i * 1024 + c] * ldf(&p.proj[(long)tt * NPROJ + PB_X + c]); }
  stf(&p.xconv[gid], silu_f(acc));
}
HD_ void ph_b_dt(const Params& p, int layer, long gid) {
  int hd = (int)(gid & 7), c = (int)(gid >> 3); float a = -expf(p.a_log[layer * 8 + hd]); float cs = 0.f;
  for (int l = 0; l < 128; ++l) { int t = c * 128 + l; float dt = softplus_f(p.small[(long)t * NSMALL + 24 + hd] + p.dt_bias[layer * 8 + hd]);
    cs += dt * a; p.dt[(long)t * 8 + hd] = dt; p.acs[(long)t * 8 + hd] = cs; }
}
HD_ void ph_b_cb(const Params& p, long gid) {
  int s = (int)(gid & 127), l = (int)((gid >> 7) & 127), g = (int)((gid >> 14) & 1), c = (int)(gid >> 15);
  if (s > l) { p.cb[gid] = 0.f; return; }
  const SB* cm = &p.xconv[(long)(c * 128 + l) * 1024 + 768 + g * 128]; const SB* bm = &p.xconv[(long)(c * 128 + s) * 1024 + 512 + g * 128];
  float acc = 0.f; for (int n = 0; n < 128; ++n) acc += ldf(&cm[n]) * ldf(&bm[n]);
  p.cb[gid] = acc;
}
HD_ void ph_b_states(const Params& p, long gid) {
  int n = (int)(gid & 127), pp = (int)((gid >> 7) & 63), hd = (int)((gid >> 13) & 7), c = (int)(gid >> 16), g = hd >> 2;
  float last = p.acs[(long)(c * 128 + 127) * 8 + hd]; float acc = 0.f;
  for (int l = 0; l < 128; ++l) { long t = c * 128 + l;
    acc += ldf(&p.xconv[t * 1024 + 512 + g * 128 + n]) * expf(last - p.acs[t * 8 + hd]) * ldf(&p.xconv[t * 1024 + hd * 64 + pp]) * p.dt[t * 8 + hd]; }
  p.states[gid] = acc;
}
HD_ void ph_b_scan(const Params& p, long gid) {
  int hd = (int)(gid >> 13); int nc = p.S / 128; float h = 0.f;
  for (int c0 = 0; c0 < nc; c0 += 8) { float st[8], dc[8];
    for (int i = 0; i < 8; ++i) { st[i] = p.states[(long)(c0 + i) * 65536 + gid]; dc[i] = p.acs[(long)((c0 + i) * 128 + 127) * 8 + hd]; }
    for (int i = 0; i < 8; ++i) { p.states[(long)(c0 + i) * 65536 + gid] = h; h = h * expf(dc[i]) + st[i]; } }
}
HD_ void ph_b_out(const Params& p, int layer, long gid) {
  int pp = (int)(gid & 63), hd = (int)((gid >> 6) & 7), t = (int)(gid >> 9), g = hd >> 2, c = t >> 7, l = t & 127;
  float al = p.acs[(long)t * 8 + hd]; float acc = 0.f;
  const float* cbr = &p.cb[(((long)c * 2 + g) * 128 + l) * 128];
  for (int s = 0; s <= l; ++s) { long ts = c * 128 + s; acc += cbr[s] * expf(al - p.acs[ts * 8 + hd]) * ldf(&p.xconv[ts * 1024 + hd * 64 + pp]) * p.dt[ts * 8 + hd]; }
  float acc2 = 0.f; const float* pr = &p.states[(long)c * 65536 + ((long)hd * 64 + pp) * 128]; const SB* cm = &p.xconv[(long)t * 1024 + 768 + g * 128];
  for (int n = 0; n < 128; ++n) acc2 += ldf(&cm[n]) * pr[n];
  p.ybuf[gid] = acc + expf(al) * acc2 + ldf(&p.xconv[(long)t * 1024 + hd * 64 + pp]) * p.b_d[layer * 8 + hd];
}
HD_ void ph_b_norm(const Params& p, int layer, long gid) {
  int g = (int)(gid & 1), t = (int)(gid >> 1); float ss = 0.f;
  for (int i = 0; i < 256; ++i) { float v = p.ybuf[(long)t * 512 + g * 256 + i] * ldf(&p.mix[(long)t * NMIX + MX_B + g * 256 + i]); ss += v * v; }
  float r = 1.f / sqrtf(ss / 256.f + 1e-6f);
  for (int i = 0; i < 256; ++i) { SB* mp = &p.mix[(long)t * NMIX + MX_B + g * 256 + i]; float v = p.ybuf[(long)t * 512 + g * 256 + i] * ldf(mp);
    stf(mp, v * r * p.b_norm[layer * 512 + g * 256 + i]); }
}

HD_ void ph_b_dt2(const Params& p, int layer, long gid) {
  int hd = (int)(gid & 7), c = (int)(gid >> 3); float a = -expf(p.a_log[layer * 8 + hd]); float cs = 0.f;
  for (int l = 0; l < 128; ++l) { int t = c * 128 + l; float dt = softplus_f(p.small[(long)t * NSMALL + 24 + hd] + p.dt_bias[layer * 8 + hd]);
    cs += dt * a; p.dt[(long)t * 8 + hd] = dt; p.acs[(long)t * 8 + hd] = cs; }
  for (int l = 0; l < 128; ++l) { long t = c * 128 + l; p.wst[t * 8 + hd] = p.dt[t * 8 + hd] * expf(cs - p.acs[t * 8 + hd]); }
}
HD_ void ph_b_states2(const Params& p, long gid) {
  int pp = (int)(gid & 63), n = (int)((gid >> 6) & 127), hd = (int)((gid >> 13) & 7), c = (int)(gid >> 16), g = hd >> 2;
  float acc = 0.f;
  _Pragma("unroll 16") for (int l = 0; l < 128; ++l) { long t = c * 128 + l; acc += ldf(&p.xconv[t * 1024 + 512 + g * 128 + n]) * p.wst[t * 8 + hd] * ldf(&p.xconv[t * 1024 + hd * 64 + pp]); }
  p.states[gid] = acc;
}
HD_ void ph_b_out2(const Params& p, int layer, long gid) {
  int pp = (int)(gid & 63), hd = (int)((gid >> 6) & 7), t = (int)(gid >> 9), g = hd >> 2, c = t >> 7, l = t & 127;
  float al = p.acs[(long)t * 8 + hd]; float acc = 0.f;
  const float* cbr = &p.cb[(((long)c * 2 + g) * 128 + l) * 128];
  _Pragma("unroll 8") for (int s = 0; s <= l; ++s) { long ts = c * 128 + s; acc += cbr[s] * expf(al - p.acs[ts * 8 + hd]) * p.dt[ts * 8 + hd] * ldf(&p.xconv[ts * 1024 + hd * 64 + pp]); }
  float acc2 = 0.f; const float* pr = &p.states[(long)c * 65536 + (long)hd * 8192 + pp]; const SB* cm = &p.xconv[(long)t * 1024 + 768 + g * 128];
  _Pragma("unroll 16") for (int n = 0; n < 128; ++n) acc2 += ldf(&cm[n]) * pr[n * 64];
  p.ybuf[gid] = acc + expf(al) * acc2 + ldf(&p.xconv[(long)t * 1024 + hd * 64 + pp]) * p.b_d[layer * 8 + hd];
}

typedef __attribute__((ext_vector_type(8))) short bf16x8;
typedef __attribute__((ext_vector_type(16))) float f32x16;
typedef short v4i16_t __attribute__((ext_vector_type(4)));
typedef __bf16 bf2_t __attribute__((ext_vector_type(2)));
typedef float f2_t __attribute__((ext_vector_type(2)));
typedef unsigned u32x4 __attribute__((ext_vector_type(4)));
#define LDS3 __attribute__((address_space(3)))
#define L2E 1.4426950408889634f
#define LN2 0.6931471805599453f
#define QSC (0.125f * L2E)
#ifndef FTHR
#define FTHR 8.0f
#endif
#define NINF (-__builtin_huge_valf())

struct WaveLds { unsigned short v[2048]; float tab[640]; float xch[32]; float pad[32]; };

__device__ __forceinline__ unsigned pk2(float a, float b) { f2_t v = {a, b}; bf2_t r = __builtin_convertvector(v, bf2_t); return __builtin_bit_cast(unsigned, r); }
__device__ __forceinline__ int crow(int e, int hi) { return (e & 3) + 8 * (e >> 2) + 4 * hi; }
__device__ __forceinline__ bf16x8 pack8(const f32x16& s, int o) {
  u32x4 r; r[0] = pk2(s[o], s[o + 1]); r[1] = pk2(s[o + 2], s[o + 3]); r[2] = pk2(s[o + 4], s[o + 5]); r[3] = pk2(s[o + 6], s[o + 7]); return __builtin_bit_cast(bf16x8, r); }
__device__ __forceinline__ f32x16 zero16() { f32x16 z;
#pragma unroll
  for (int e = 0; e < 16; ++e) z[e] = 0.f; return z; }
#define MFMA32(a, b, c) __builtin_amdgcn_mfma_f32_32x32x16_bf16((a), (b), (c), 0, 0, 0)

struct FlashState { f32x16 o0, o1; float m, l; };
__device__ __forceinline__ float wave_sum_f(float v) {
#pragma unroll
  for (int o = 32; o > 0; o >>= 1) v += __shfl_xor(v, o);
  return v; }

template <class VRow, class Fix>
__device__ __forceinline__ void flash_tile(FlashState& st, const bf16x8 (&qf)[4], const SB* kp, VRow vrow, Fix fix, WaveLds* L, int lane) {
  const int r32 = lane & 31, hi = lane >> 5;
  bf16x8 kf[4];
#pragma unroll
  for (int d0 = 0; d0 < 4; ++d0) kf[d0] = *(const bf16x8*)(kp + d0 * 16 + hi * 8);
#pragma unroll
  for (int i = 0; i < 4; ++i) { const int c = lane + 64 * i, key = c >> 3, ch = c & 7; const SB* vp = vrow(key); const uint4 vv = *(const uint4*)(vp + ch * 8);
    *(uint4*)&L->v[(ch >> 2) * 1024 + key * 32 + (ch & 3) * 8] = vv; }
  f32x16 s = zero16();
#pragma unroll
  for (int d0 = 0; d0 < 4; ++d0) s = MFMA32(kf[d0], qf[d0], s);
  fix(s);
  float mx = s[0];
#pragma unroll
  for (int e = 1; e < 16; ++e) mx = fmaxf(mx, s[e]);
  mx = fmaxf(mx, __shfl_xor(mx, 32));
  if (__any(mx > st.m + FTHR)) {
    const float mn = fmaxf(st.m, mx); const float al = __builtin_amdgcn_exp2f(st.m - mn); st.m = mn; st.l *= al; L->xch[r32] = al;
#pragma unroll
    for (int e = 0; e < 16; ++e) { const float a = L->xch[crow(e, hi)]; st.o0[e] *= a; st.o1[e] *= a; }
  }
  float ps = 0.f;
#pragma unroll
  for (int e = 0; e < 16; ++e) { s[e] = __builtin_amdgcn_exp2f(s[e] - st.m); ps += s[e]; }
  st.l += ps;
  const bf16x8 pa0 = pack8(s, 0), pa1 = pack8(s, 8);
  const unsigned short* vb = L->v + (4 * hi + ((lane & 15) >> 2)) * 32 + ((lane >> 4) & 1) * 16 + (lane & 3) * 4;
#pragma unroll
  for (int s2 = 0; s2 < 2; ++s2) {
#pragma unroll
    for (int db = 0; db < 2; ++db) {
      const v4i16_t lo = __builtin_amdgcn_ds_read_tr16_b64_v4i16((LDS3 v4i16_t*)(vb + db * 1024 + s2 * 512));
      const v4i16_t hh = __builtin_amdgcn_ds_read_tr16_b64_v4i16((LDS3 v4i16_t*)(vb + db * 1024 + s2 * 512 + 256));
      const bf16x8 vf = {lo[0], lo[1], lo[2], lo[3], hh[0], hh[1], hh[2], hh[3]};
      if (db == 0) st.o0 = MFMA32(s2 ? pa1 : pa0, vf, st.o0); else st.o1 = MFMA32(s2 ? pa1 : pa0, vf, st.o1);
    }
  }
}
__device__ __forceinline__ float flash_finish(FlashState& st, WaveLds* L, int lane) {
  const int r32 = lane & 31, hi = lane >> 5;
  const float lt = st.l + __shfl_xor(st.l, 32); const float inv = lt > 0.f ? 1.f / lt : 0.f;
  L->xch[r32] = inv;
#pragma unroll
  for (int e = 0; e < 16; ++e) { const float a = L->xch[crow(e, hi)]; st.o0[e] *= a; st.o1[e] *= a; }
  return (st.m + __builtin_amdgcn_logf(lt)) * LN2;
}
__device__ __forceinline__ void load_q(bf16x8 (&qf)[4], const SB* qp, int hi) {
#pragma unroll
  for (int d0 = 0; d0 < 4; ++d0) qf[d0] = *(const bf16x8*)(qp + d0 * 16 + hi * 8);
}
__device__ __forceinline__ void fix_tab(f32x16& s, const WaveLds* L, int base, int lane, bool chk, int kb) {
  const int r32 = lane & 31, hi = lane >> 5; const float* tp = L->tab + base + r32 + 32 - 4 * hi;
#pragma unroll
  for (int e = 0; e < 16; ++e) { const int kk = (e & 3) + 8 * (e >> 2); float v = s[e] * QSC + tp[-kk]; if (chk && (kb + kk + 4 * hi < 0)) v = NINF; s[e] = v; }
}

__device__ __forceinline__ void unit_c(const Params& p, int layer, int u, WaveLds* L, int lane) {
  const int h = u & 7, qt = u >> 3, q0 = qt * 32, hk = h >> 2, r32 = lane & 31, hi = lane >> 5;
  for (int x = lane; x < 192; x += 64) { const int dist = x - 32; L->tab[x] = (dist >= 0 && dist <= 127) ? 0.f : NINF; }
  bf16x8 qf[4]; load_q(qf, p.proj + (long)(q0 + r32) * NPROJ + PC_Q + h * 64, hi);
  FlashState st; st.o0 = zero16(); st.o1 = zero16(); st.m = p.sinks[layer * 8 + h] * L2E; st.l = hi ? 0.f : 1.f;
  const SB* kvb = p.proj + PC_KV + hk * 64; const bool chk = q0 < 128;
  for (int t = 0; t < 5; ++t) { const int kb = q0 - 128 + 32 * t; int tok = kb + r32; tok = tok < 0 ? 0 : tok;
    flash_tile(st, qf, kvb + (long)tok * NPROJ, [&](int key) { int tk = kb + key; tk = tk < 0 ? 0 : tk; return kvb + 128 + (long)tk * NPROJ; },
               [&](f32x16& s) { fix_tab(s, L, 128 - 32 * t, lane, chk, kb); }, L, lane); }
  flash_finish(st, L, lane);
#pragma unroll
  for (int e = 0; e < 16; ++e) { SB* mp = p.mix + (long)(q0 + crow(e, hi)) * NMIX + MX_C + h * 64 + r32; mp[0] = f2bf(st.o0[e] * bf2f(mp[0])); mp[32] = f2bf(st.o1[e] * bf2f(mp[32])); }
}
__device__ __forceinline__ void unit_m(const Params& p, int layer, int u, WaveLds* L, int lane) {
  const int h = u & 3, qt = u >> 2, q0 = qt * 32, r32 = lane & 31, hi = lane >> 5;
  bf16x8 qf[4]; load_q(qf, p.proj + (long)(q0 + r32) * NPROJ + PM_Q + h * 64, hi);
  FlashState st; st.o0 = zero16(); st.o1 = zero16(); st.m = -1e30f; st.l = 0.f;
  const SB* kb = p.memkv + (long)layer * 256 * 512 + h * 64;
  for (int t = 0; t < 8; ++t) {
    flash_tile(st, qf, kb + (long)(32 * t + r32) * 512, [&](int key) { return kb + 256 + (long)(32 * t + key) * 512; },
               [&](f32x16& s) {
#pragma unroll
                 for (int e = 0; e < 16; ++e) s[e] *= QSC; }, L, lane); }
  flash_finish(st, L, lane);
#pragma unroll
  for (int e = 0; e < 16; ++e) { SB* mp = p.mix + (long)(q0 + crow(e, hi)) * NMIX + MX_M + h * 64 + r32; mp[0] = f2bf(st.o0[e] * bf2f(mp[0])); mp[32] = f2bf(st.o1[e] * bf2f(mp[32])); }
}
__device__ __forceinline__ void unit_awin(const Params& p, int u, WaveLds* L, int lane) {
  const int h = u & 7, qt = u >> 3, q0 = qt * 32, hk = h >> 2, r32 = lane & 31, hi = lane >> 5;
  for (int x = lane; x < 608; x += 64) { const int dist = x - 32; L->tab[x] = (dist >= 0 && dist <= 511) ? p.tabA[h * TABA_N + dist] * L2E : NINF; }
  bf16x8 qf[4]; load_q(qf, p.proj + (long)(q0 + r32) * NPROJ + PA_Q + h * 64, hi);
  FlashState st; st.o0 = zero16(); st.o1 = zero16(); st.m = -1e30f; st.l = 0.f;
  const SB* kvb = p.proj + PA_KV + 4 * 128 + hk * 64; const bool chk = q0 < 512;
  for (int t = 0; t < 17; ++t) { const int kb = q0 - 512 + 32 * t; if (kb + 31 < 0) continue; int tok = kb + r32; tok = tok < 0 ? 0 : tok;
    flash_tile(st, qf, kvb + (long)tok * NPROJ, [&](int key) { int tk = kb + key; tk = tk < 0 ? 0 : tk; return kvb + 128 + (long)tk * NPROJ; },
               [&](f32x16& s) { fix_tab(s, L, 512 - 32 * t, lane, chk, kb); }, L, lane); }
  flash_finish(st, L, lane);
#pragma unroll
  for (int e = 0; e < 16; ++e) { SB* op = p.ow + (long)(q0 + crow(e, hi)) * 512 + h * 64 + r32; op[0] = f2bf(st.o0[e]); op[32] = f2bf(st.o1[e]); }
}
__device__ __forceinline__ void unit_d(const Params& p, int u, WaveLds* L, int lane) {
  const int S = p.S, per = (S / 32) * 8; const int gi = u / per, u2 = u % per; const int h = u2 & 7, v = u2 >> 3;
  const int dil = gi == 0 ? 1 : (gi == 1 ? 4 : 16); const int tiles_per_res = (S / dil) / 32; const int r = v / tiles_per_res, it = v % tiles_per_res, i0 = it * 32;
  const int r32 = lane & 31, hi = lane >> 5;
  for (int x = lane; x < 192; x += 64) { const int dd = x - 32; L->tab[x] = (dd >= 0 && dd <= 128) ? p.tabD[(gi * 8 + h) * TABD_N + dd] * L2E : NINF; }
  bf16x8 qf[4]; load_q(qf, p.proj + (long)(r + dil * (i0 + r32)) * NPROJ + PD_Q + gi * 512 + h * 64, hi);
  FlashState st; st.o0 = zero16(); st.o1 = zero16(); st.m = -1e30f; st.l = 0.f;
  const SB* kvb = p.proj + PD_KV + h * 64; const bool chk = i0 < 128;
  for (int t = 0; t < 5; ++t) { const int jb = i0 - 128 + 32 * t; if (jb + 31 < 0) continue; int j = jb + r32; j = j < 0 ? 0 : j;
    flash_tile(st, qf, kvb + (long)(r + dil * j) * NPROJ, [&](int key) { int jj = jb + key; jj = jj < 0 ? 0 : jj; return kvb + 512 + (long)(r + dil * jj) * NPROJ; },
               [&](f32x16& s) { fix_tab(s, L, 128 - 32 * t, lane, chk, jb); }, L, lane); }
  const float lse = flash_finish(st, L, lane);
#pragma unroll
  for (int e = 0; e < 16; ++e) { const long tok = r + dil * (i0 + crow(e, hi)); SB* op = p.dop + ((long)gi * S + tok) * 512 + h * 64 + r32; op[0] = f2bf(st.o0[e]); op[32] = f2bf(st.o1[e]); }
  if (hi == 0) p.dlse[((long)gi * S + r + dil * (i0 + r32)) * 8 + h] = lse;
}
__device__ __forceinline__ void fix_cmp(f32x16& s, const Params& p, int h, int q0, int t, int lane) {
  const int r32 = lane & 31, hi = lane >> 5; const int dq = q0 + r32 - 31 - 16 * (32 * t + 4 * hi);
  const bool far = (q0 - 16 * (32 * t + 31) - 31) >= 1513; const float c31 = p.tabA[h * TABA_N + 2047] * L2E;
#pragma unroll
  for (int e = 0; e < 16; ++e) { const int kk = (e & 3) + 8 * (e >> 2); const int dist = dq - 16 * kk; float b;
    if (far) b = c31; else { const int dc = dist < 0 ? 0 : (dist > 2047 ? 2047 : dist); b = p.tabA[h * TABA_N + dc] * L2E; }
    s[e] = dist < 0 ? NINF : s[e] * QSC + b; }
}
__device__ __forceinline__ void unit_acmp1(const Params& p, int u, WaveLds* L, int lane) {
  const int h = u & 7, qt = (p.S / 32 - 1) - (u >> 3), q0 = qt * 32, g = h >> 2, r32 = lane & 31, hi = lane >> 5; const int ncmp = p.S / 16;
  bf16x8 qf[4]; load_q(qf, p.proj + (long)(q0 + r32) * NPROJ + PA_Q + h * 64, hi);
  FlashState st; st.o0 = zero16(); st.o1 = zero16(); st.m = -1e30f; st.l = 0.f;
  const int jn = q0 / 16 + 1, nt = (jn + 31) / 32; const SB* kc = p.kvc + g * 64; const SB* vc = p.kvc + (long)ncmp * 128 + g * 64;
  for (int t = 0; t < nt; ++t) { int j = 32 * t + r32; j = j >= ncmp ? ncmp - 1 : j;
    flash_tile(st, qf, kc + (long)j * 128, [&](int key) { int jj = 32 * t + key; jj = jj >= ncmp ? ncmp - 1 : jj; return vc + (long)jj * 128; },
               [&](f32x16& s) { fix_cmp(s, p, h, q0, t, lane); }, L, lane); }
  const float lt = st.l + __shfl_xor(st.l, 32); const float inv = lt > 0.f ? 1.f / lt : 0.f;
  flash_finish(st, L, lane);
#pragma unroll
  for (int e = 0; e < 16; ++e) { SB* op = p.oc + (long)(q0 + crow(e, hi)) * 512 + h * 64 + r32; op[0] = f2bf(st.o0[e]); op[32] = f2bf(st.o1[e]); }
  if (hi == 0) { p.cml[((long)(q0 + r32) * 8 + h) * 2] = st.m; p.cml[((long)(q0 + r32) * 8 + h) * 2 + 1] = inv; }
}
__device__ __forceinline__ void unit_acmp2(const Params& p, int u, int lane) {
  const int part = u & 3, g = (u >> 2) & 1, qt = (p.S / 32 - 1) - (u >> 3), q0 = qt * 32, r32 = lane & 31, hi = lane >> 5; const int ncmp = p.S / 16;
  const int jn = q0 / 16 + 1, nt = (jn + 31) / 32; const SB* kc = p.kvc + g * 64; float carry = 0.f;
  const int tper = (nt + 3) >> 2, tbeg = part * tper, tend = (tbeg + tper < nt) ? tbeg + tper : nt; if (tbeg >= nt) return;
  float* impq = p.imp + ((long)(q0 + r32) * 2 + g) * 256;
  const SB* qbase = p.proj + (long)(q0 + r32) * NPROJ + PA_Q + g * 256; const float* cmlq = p.cml + ((long)(q0 + r32) * 8 + g * 4) * 2;
  for (int t = (tbeg > 0 ? tbeg - 1 : 0); t < tend; ++t) { int j = 32 * t + r32; j = j >= ncmp ? ncmp - 1 : j; const SB* kp = kc + (long)j * 128;
    bf16x8 kf[4];
#pragma unroll
    for (int d0 = 0; d0 < 4; ++d0) kf[d0] = *(const bf16x8*)(kp + d0 * 16 + hi * 8);
    float accA[4] = {0.f, 0.f, 0.f, 0.f}, accL[4] = {0.f, 0.f, 0.f, 0.f};
#pragma unroll 1
    for (int hh = 0; hh < 4; ++hh) { bf16x8 qf[4]; load_q(qf, qbase + hh * 64, hi); const float m = cmlq[hh * 2], il = cmlq[hh * 2 + 1];
      f32x16 s = zero16();
#pragma unroll
      for (int d0 = 0; d0 < 4; ++d0) s = MFMA32(kf[d0], qf[d0], s);
      fix_cmp(s, p, g * 4 + hh, q0, t, lane);
#pragma unroll
      for (int e = 0; e < 16; ++e) { const float pr = __builtin_amdgcn_exp2f(s[e] - m) * il; accA[e >> 2] += pr; if ((e & 3) == 3) accL[e >> 2] += pr; } }
    float oth[4];
#pragma unroll
    for (int eg = 0; eg < 4; ++eg) oth[eg] = __shfl_xor(accL[eg], 32);
#pragma unroll
    for (int eg = 0; eg < 4; ++eg) { const float prev = hi ? oth[eg] : (eg > 0 ? oth[eg > 0 ? eg - 1 : 0] : carry); if (t >= tbeg) impq[8 * t + 2 * eg + hi] = 2.f * accA[eg] - accL[eg] + prev; }
    carry = oth[3]; }
}
__device__ __forceinline__ float wave_max_f(float v) {
#pragma unroll
  for (int o = 32; o > 0; o >>= 1) v = fmaxf(v, __shfl_xor(v, o));
  return v; }
__device__ __forceinline__ int wave_min_i(int v) {
#pragma unroll
  for (int o = 32; o > 0; o >>= 1) { const int w = __shfl_xor(v, o); v = w < v ? w : v; }
  return v; }
__device__ __forceinline__ void unit_topk(const Params& p, int u, int lane) {
  const int q = u >> 1, cur = q >> 6; const float* imp = p.imp + (long)u * 256; int* idx = p.idx + (long)u * 16;
  float v[4];
#pragma unroll
  for (int k = 0; k < 4; ++k) { const int b = lane + 64 * k; float x = (b <= cur) ? imp[b] : -1.f; if (b == 0 || b == cur) x = 1e4f; v[k] = x; }
  int mine = -1;
  for (int k = 0; k < 16; ++k) {
    float lm = fmaxf(fmaxf(v[0], v[1]), fmaxf(v[2], v[3])); const float m = wave_max_f(lm);
    int cand = 0x7fffffff;
#pragma unroll
    for (int kk = 3; kk >= 0; --kk) if (v[kk] == m) cand = lane + 64 * kk;
    const int bsel = wave_min_i(cand);
#pragma unroll
    for (int kk = 0; kk < 4; ++kk) if (lane + 64 * kk == bsel) v[kk] = -2.f;
    if (lane == k) mine = (m >= 0.f) ? bsel : -1;
  }
  if (lane < 16) idx[lane] = mine;
}
template <bool STORE = true>
__device__ __forceinline__ void unit_asel(const Params& p, int u, WaveLds* L, int lane) {
  const int g = u & 1, q = u >> 1, r32 = lane & 31, hi = lane >> 5, hh = r32 & 3, h = g * 4 + hh;
  bf16x8 qf[4]; load_q(qf, p.proj + (long)q * NPROJ + PA_Q + h * 64, hi);
  FlashState st; st.o0 = zero16(); st.o1 = zero16(); st.m = -1e30f; st.l = 0.f;
  const int* idx = p.idx + (long)u * 16; const SB* kvb = p.proj + PA_KV + 2 * 128 + g * 64; const float c31 = p.tabA[h * TABA_N + 2047] * L2E;
  for (int k = 0; k < 16; ++k) { const int b = __builtin_amdgcn_readfirstlane(idx[k]); if (b < 0) continue;
    for (int kt = 0; kt < 2; ++kt) { const int t0 = b * 64 + kt * 32; if (t0 > q) continue;
      const bool far = (q - (t0 + 31)) >= 1513; const bool edge = (t0 + 31 > q);
      flash_tile(st, qf, kvb + (long)(t0 + r32) * NPROJ, [&](int key) { return kvb + 128 + (long)(t0 + key) * NPROJ; },
                 [&](f32x16& s) {
#pragma unroll
                   for (int e = 0; e < 16; ++e) { const int tk = t0 + (e & 3) + 8 * (e >> 2) + 4 * hi; const int dist = q - tk; float bsv;
                     if (far) bsv = c31; else { const int dc = dist < 0 ? 0 : (dist > 2047 ? 2047 : dist); bsv = p.tabA[h * TABA_N + dc] * L2E; }
                     float vv = s[e] * QSC + bsv; if (edge && dist < 0) vv = NINF; s[e] = vv; } }, L, lane); } }
  flash_finish(st, L, lane);
  if (!STORE) { asm volatile("" :: "v"(st.o0[0]), "v"(st.o1[3])); return; }
  if (hi == 0) {
#pragma unroll
    for (int e = 0; e < 4; ++e) { const int he = g * 4 + e; const float* gl = p.small + (long)q * NSMALL + he * 3;
      const float g0 = sigmoid_f(gl[0]), g1 = sigmoid_f(gl[1]), g2 = sigmoid_f(gl[2]);
#pragma unroll
      for (int db = 0; db < 2; ++db) { const long c = (long)q * 512 + he * 64 + db * 32 + r32; const float os = db ? st.o1[e] : st.o0[e];
        const float a = g0 * bf2f(p.oc[c]) + g1 * os + g2 * bf2f(p.ow[c]); SB* mp = p.mix + (long)q * NMIX + MX_A + he * 64 + db * 32 + r32; *mp = f2bf(a * bf2f(*mp)); } }
  }
}

struct WaveLds2 { unsigned short x[2048]; unsigned short b[2048]; float acs[128]; float dtv[128]; float xch[64]; };
template <bool SCALE, class RowScale>
__device__ __forceinline__ void stage_slab(unsigned short* dst, const SB* src, long ld, RowScale rs, int lane) {
#pragma unroll
  for (int i = 0; i < 4; ++i) { const int c = lane + 64 * i, row = c >> 3, ch = c & 7; uint4 vv = *(const uint4*)(src + (long)row * ld + ch * 8);
    if (SCALE) { const float sc = rs(row); unsigned w[4] = {vv.x, vv.y, vv.z, vv.w};
#pragma unroll
      for (int k = 0; k < 4; ++k) { const float lo = __uint_as_float(w[k] << 16) * sc, hi2 = __uint_as_float(w[k] & 0xffff0000u) * sc; w[k] = pk2(lo, hi2); }
      vv.x = w[0]; vv.y = w[1]; vv.z = w[2]; vv.w = w[3]; }
    *(uint4*)&dst[(ch >> 2) * 1024 + row * 32 + (ch & 3) * 8] = vv; }
}
__device__ __forceinline__ bf16x8 slab_frag(const unsigned short* img, int cb, int s2, int lane) {
  const int hi = lane >> 5; const unsigned short* vb = img + (4 * hi + ((lane & 15) >> 2)) * 32 + ((lane >> 4) & 1) * 16 + (lane & 3) * 4 + cb * 1024 + s2 * 512;
  const v4i16_t lo = __builtin_amdgcn_ds_read_tr16_b64_v4i16((LDS3 v4i16_t*)vb);
  const v4i16_t hh = __builtin_amdgcn_ds_read_tr16_b64_v4i16((LDS3 v4i16_t*)(vb + 256));
  return (bf16x8){lo[0], lo[1], lo[2], lo[3], hh[0], hh[1], hh[2], hh[3]};
}
__device__ __forceinline__ void unit_bstates(const Params& p, int u, WaveLds2* L, int lane) {
  const int nh = u & 1, hd = (u >> 1) & 7, c = u >> 4, g = hd >> 2, r32 = lane & 31, hi = lane >> 5;
  f32x16 acc[2][2];
#pragma unroll
  for (int i = 0; i < 2; ++i)
#pragma unroll
    for (int j = 0; j < 2; ++j) acc[i][j] = zero16();
  const SB* xb = p.xconv + (long)c * 128 * 1024; const float* wst = p.wst + (long)c * 128 * 8 + hd;
  for (int q4 = 0; q4 < 4; ++q4) {
    stage_slab<true>(L->x, xb + (long)(32 * q4) * 1024 + hd * 64, 1024, [&](int row) { return wst[(32 * q4 + row) * 8]; }, lane);
    stage_slab<false>(L->b, xb + (long)(32 * q4) * 1024 + 512 + g * 128 + nh * 64, 1024, [&](int) { return 1.f; }, lane);
#pragma unroll
    for (int s2 = 0; s2 < 2; ++s2) { bf16x8 af[2], bfr[2];
#pragma unroll
      for (int i = 0; i < 2; ++i) { af[i] = slab_frag(L->x, i, s2, lane); bfr[i] = slab_frag(L->b, i, s2, lane); }
#pragma unroll
      for (int i = 0; i < 2; ++i)
#pragma unroll
        for (int j = 0; j < 2; ++j) acc[i][j] = MFMA32(af[i], bfr[j], acc[i][j]); } }
  float* so = p.states + ((long)c * 8 + hd) * 8192 + nh * 64 + r32;
#pragma unroll
  for (int i = 0; i < 2; ++i)
#pragma unroll
    for (int j = 0; j < 2; ++j)
#pragma unroll
      for (int e = 0; e < 16; ++e) so[(long)(32 * i + crow(e, hi)) * 128 + 32 * j] = acc[i][j][e];
}
__device__ __forceinline__ void unit_bout(const Params& p, int layer, int u, WaveLds2* L, int lane) {
  const int lt = u & 3, hd = (u >> 2) & 7, c = u >> 5, g = hd >> 2, r32 = lane & 31, hi = lane >> 5;
  for (int x = lane; x < 128; x += 64) { L->acs[x] = p.acs[((long)c * 128 + x) * 8 + hd]; L->dtv[x] = p.dt[((long)c * 128 + x) * 8 + hd]; }
  f32x16 acc[2] = {zero16(), zero16()}, acc2[2] = {zero16(), zero16()};
  const SB* xb = p.xconv + (long)c * 128 * 1024; const int l = 32 * lt + r32; const float al = p.acs[((long)c * 128 + l) * 8 + hd];
  const float* cbr = p.cb + ((long)c * 2 + g) * 16384 + (long)l * 128;
  for (int sc = 0; sc <= lt; ++sc) {
    stage_slab<false>(L->x, xb + (long)(32 * sc) * 1024 + hd * 64, 1024, [&](int) { return 1.f; }, lane);
#pragma unroll
    for (int s2 = 0; s2 < 2; ++s2) { float mv[8];
#pragma unroll
      for (int jj = 0; jj < 2; ++jj) { const int s0 = 32 * sc + 16 * s2 + 8 * jj + 4 * hi; const float4 cv = *(const float4*)(cbr + s0); const float4 av = *(const float4*)(&L->acs[s0]); const float4 dv = *(const float4*)(&L->dtv[s0]);
        mv[4 * jj + 0] = (s0 + 0 <= l) ? cv.x * __expf(al - av.x) * dv.x : 0.f; mv[4 * jj + 1] = (s0 + 1 <= l) ? cv.y * __expf(al - av.y) * dv.y : 0.f;
        mv[4 * jj + 2] = (s0 + 2 <= l) ? cv.z * __expf(al - av.z) * dv.z : 0.f; mv[4 * jj + 3] = (s0 + 3 <= l) ? cv.w * __expf(al - av.w) * dv.w : 0.f; }
      u32x4 aw; aw[0] = pk2(mv[0], mv[1]); aw[1] = pk2(mv[2], mv[3]); aw[2] = pk2(mv[4], mv[5]); aw[3] = pk2(mv[6], mv[7]); const bf16x8 af = __builtin_bit_cast(bf16x8, aw);
#pragma unroll
      for (int pt = 0; pt < 2; ++pt) acc[pt] = MFMA32(af, slab_frag(L->x, pt, s2, lane), acc[pt]); } }
  const SB* cmr = xb + (long)l * 1024 + 768 + g * 128; const float* prv = p.states + ((long)c * 8 + hd) * 8192;
#pragma unroll 2
  for (int ks = 0; ks < 8; ++ks) { const bf16x8 af = *(const bf16x8*)(cmr + 16 * ks + 8 * hi);
#pragma unroll
    for (int pt = 0; pt < 2; ++pt) { const float* pr = prv + (long)(32 * pt + r32) * 128 + 16 * ks + 8 * hi; const float4 a0 = *(const float4*)pr, a1 = *(const float4*)(pr + 4);
      u32x4 bw; bw[0] = pk2(a0.x, a0.y); bw[1] = pk2(a0.z, a0.w); bw[2] = pk2(a1.x, a1.y); bw[3] = pk2(a1.z, a1.w);
      acc2[pt] = MFMA32(af, __builtin_bit_cast(bf16x8, bw), acc2[pt]); } }
  const float dsk = p.b_d[layer * 8 + hd];
#pragma unroll
  for (int e = 0; e < 16; ++e) { const int lr = 32 * lt + crow(e, hi); const float ea = __expf(L->acs[lr]); const long t = (long)c * 128 + lr;
#pragma unroll
    for (int pt = 0; pt < 2; ++pt) { const int pp = 32 * pt + r32; p.ybuf[t * 512 + hd * 64 + pp] = acc[pt][e] + ea * acc2[pt][e] + dsk * bf2f(xb[(long)lr * 1024 + hd * 64 + pp]); } }
}
__device__ __forceinline__ void unit_bnorm(const Params& p, int layer, int u, int lane) {
  const int g = u & 1; const long t = u >> 1; const float4 yv = *(const float4*)(p.ybuf + t * 512 + g * 256 + lane * 4);
  SB* mp = p.mix + t * NMIX + MX_B + g * 256 + lane * 4; const ushort4 zv = *(const ushort4*)mp;
  const float v0 = yv.x * bf2f(zv.x), v1 = yv.y * bf2f(zv.y), v2 = yv.z * bf2f(zv.z), v3 = yv.w * bf2f(zv.w);
  const float ss = wave_sum_f(v0 * v0 + v1 * v1 + v2 * v2 + v3 * v3); const float r = 1.f / sqrtf(ss * (1.f / 256.f) + 1e-6f);
  const float4 w = *(const float4*)(p.b_norm + layer * 512 + g * 256 + lane * 4);
  ushort4 o; o.x = f2bf(v0 * r * w.x); o.y = f2bf(v1 * r * w.y); o.z = f2bf(v2 * r * w.z); o.w = f2bf(v3 * r * w.w); *(ushort4*)mp = o;
}
__device__ __forceinline__ void unit_bdt(const Params& p, int layer, int u, int lane) {
  const int hd = u & 7, c = u >> 3; const float a = -expf(p.a_log[layer * 8 + hd]), bias = p.dt_bias[layer * 8 + hd]; const long t0 = (long)c * 128 + 2 * lane;
  const float d0 = softplus_f(p.small[t0 * NSMALL + 24 + hd] + bias), d1 = softplus_f(p.small[(t0 + 1) * NSMALL + 24 + hd] + bias);
  float run = (d0 + d1) * a;
#pragma unroll
  for (int o = 1; o < 64; o <<= 1) { const float v = __shfl_up(run, o); if (lane >= o) run += v; }
  const float tot = __shfl(run, 63); const float c1 = run, c0 = run - d1 * a;
  p.dt[t0 * 8 + hd] = d0; p.dt[(t0 + 1) * 8 + hd] = d1; p.acs[t0 * 8 + hd] = c0; p.acs[(t0 + 1) * 8 + hd] = c1;
  p.wst[t0 * 8 + hd] = d0 * expf(tot - c0); p.wst[(t0 + 1) * 8 + hd] = d1 * expf(tot - c1);
}
__device__ __forceinline__ void item_bconv(const Params& p, int layer, long gid) {
  const int cg = (int)(gid & 127) * 8; const long t = gid >> 7; const float* w = p.conv_w + (long)layer * 4 * 1024 + cg; const float* bb = p.conv_b + layer * 1024 + cg;
  float acc[8];
#pragma unroll
  for (int k = 0; k < 8; ++k) acc[k] = bb[k];
#pragma unroll
  for (int i = 0; i < 4; ++i) { const long tt = t - 3 + i; if (tt >= 0) { const uint4 vv = *(const uint4*)(p.proj + tt * NPROJ + PB_X + cg); const unsigned wd[4] = {vv.x, vv.y, vv.z, vv.w};
#pragma unroll
      for (int k = 0; k < 4; ++k) { acc[2 * k] += w[i * 1024 + 2 * k] * __uint_as_float(wd[k] << 16); acc[2 * k + 1] += w[i * 1024 + 2 * k + 1] * __uint_as_float(wd[k] & 0xffff0000u); } } }
  uint4 o; o.x = pk2(silu_f(acc[0]), silu_f(acc[1])); o.y = pk2(silu_f(acc[2]), silu_f(acc[3])); o.z = pk2(silu_f(acc[4]), silu_f(acc[5])); o.w = pk2(silu_f(acc[6]), silu_f(acc[7]));
  *(uint4*)(p.xconv + t * 1024 + cg) = o;
}
__device__ __forceinline__ void unit_cmp(const Params& p, int layer, int u, int lane) {
  const int ncmp = p.S / 16, ntile = ncmp * 2 / 32; const int kv = u / ntile, rt = u % ntile, r32 = lane & 31, hi = lane >> 5;
  const int r = 32 * rt + r32, j = r >> 1, hk = r & 1;
  const unsigned short* w1t = p.w1t + (long)kv * 128 * 2048; const unsigned short* w2t = p.w2t + kv * 64 * 128; const float* pe = p.cmp_pos + (long)(layer * 2 + kv) * 32 * 64;
  const SB* src = p.proj + PA_KV + kv * 128 + hk * 64;
  f32x16 acc[4] = {zero16(), zero16(), zero16(), zero16()};
#pragma unroll 4
  for (int ks = 0; ks < 128; ++ks) { const int t = ks >> 2, d = (ks & 3) * 16 + 8 * hi; const long tok = 16 * j + t;
    const float4 p0 = *(const float4*)(pe + t * 64 + d), p1 = *(const float4*)(pe + t * 64 + d + 4); float v[8] = {p0.x, p0.y, p0.z, p0.w, p1.x, p1.y, p1.z, p1.w};
    if (tok < p.S) { const uint4 vv = *(const uint4*)(src + tok * NPROJ + d); const unsigned wd[4] = {vv.x, vv.y, vv.z, vv.w};
#pragma unroll
      for (int k = 0; k < 4; ++k) { v[2 * k] += __uint_as_float(wd[k] << 16); v[2 * k + 1] += __uint_as_float(wd[k] & 0xffff0000u); } }
    u32x4 bw; bw[0] = pk2(v[0], v[1]); bw[1] = pk2(v[2], v[3]); bw[2] = pk2(v[4], v[5]); bw[3] = pk2(v[6], v[7]); const bf16x8 bfr = __builtin_bit_cast(bf16x8, bw);
#pragma unroll
    for (int ut = 0; ut < 4; ++ut) { const bf16x8 af = *(const bf16x8*)(w1t + (long)(32 * ut + r32) * 2048 + 16 * ks + 8 * hi); acc[ut] = MFMA32(af, bfr, acc[ut]); } }
  f32x16 o2[2] = {zero16(), zero16()};
#pragma unroll
  for (int ut = 0; ut < 4; ++ut) {
#pragma unroll
    for (int e = 0; e < 16; ++e) acc[ut][e] = gelu_f(acc[ut][e]);
#pragma unroll
    for (int s2 = 0; s2 < 2; ++s2) { const bf16x8 hb = pack8(acc[ut], 8 * s2);
#pragma unroll
      for (int dt = 0; dt < 2; ++dt) { const unsigned short* wr = w2t + (32 * dt + r32) * 128 + 32 * ut + 16 * s2 + 4 * hi; const uint2 x0 = *(const uint2*)wr, x1 = *(const uint2*)(wr + 8);
        u32x4 aw; aw[0] = x0.x; aw[1] = x0.y; aw[2] = x1.x; aw[3] = x1.y; o2[dt] = MFMA32(__builtin_bit_cast(bf16x8, aw), hb, o2[dt]); } } }
  SB* dst = p.kvc + ((long)kv * ncmp * 2 + r) * 64;
#pragma unroll
  for (int dt = 0; dt < 2; ++dt)
#pragma unroll
    for (int e = 0; e < 16; ++e) dst[32 * dt + crow(e, hi)] = f2bf(o2[dt][e]);
}

struct AselLds { unsigned short k[2][4096]; unsigned short v[2][4096]; unsigned sel[64][8]; unsigned anyb[8]; int nlist; int pad[7]; unsigned char blist[256]; float xch[4][32]; };
__device__ __forceinline__ void asel_issue(uint4 (&r)[4], const SB* kvb, int b, int tid) {
#pragma unroll
  for (int i = 0; i < 2; ++i) { const int idx = tid + 256 * i, row = idx >> 3, ch = idx & 7; const SB* src = kvb + (long)(b * 64 + row) * NPROJ + ch * 8; r[i] = *(const uint4*)src; r[2 + i] = *(const uint4*)(src + 128); }
}
__device__ __forceinline__ void asel_commit(const uint4 (&r)[4], AselLds* A, int stage, int tid) {
#pragma unroll
  for (int i = 0; i < 2; ++i) { const int idx = tid + 256 * i, row = idx >> 3, ch = idx & 7;
    *(uint4*)&A->k[stage][row * 64 + ((ch ^ (row & 7)) * 8)] = r[i];
    *(uint4*)&A->v[stage][(ch >> 2) * 2048 + row * 32 + (ch & 3) * 8] = r[2 + i]; }
}
__device__ __forceinline__ void asel_coltile(const Params& p, FlashState& S_, const bf16x8 (&qf)[4], AselLds* A, float* xch, int stage, int b, int cur, int q0, int qbase, int h, float c31, int lane) {
  const int r32 = lane & 31, hi = lane >> 5; const int ql = qbase + (r32 >> 2); const int q = q0 + ql;
  const bool selq = (A->sel[ql][b >> 5] >> (b & 31)) & 1u;
  if (!__any(selq)) return;
  const bool far = (q0 - (b * 64 + 63)) >= 1513; const bool edge = (b == cur);
#pragma unroll 1
  for (int kt = 0; kt < 2; ++kt) { const int t0 = b * 64 + 32 * kt; if (edge && t0 > q0 + qbase + 7) continue;
    bf16x8 kf[4]; { const int row = 32 * kt + r32;
#pragma unroll
      for (int d0 = 0; d0 < 4; ++d0) kf[d0] = *(const bf16x8*)&A->k[stage][row * 64 + (((2 * d0 + hi) ^ ((row >> 1) & 7)) * 8)]; }
    f32x16 s = zero16();
#pragma unroll
    for (int d0 = 0; d0 < 4; ++d0) s = MFMA32(kf[d0], qf[d0], s);
#pragma unroll
    for (int e = 0; e < 16; ++e) { const int tk = t0 + (e & 3) + 8 * (e >> 2) + 4 * hi; const int dist = q - tk; float bsv;
      if (far) bsv = c31; else { const int dc = dist < 0 ? 0 : (dist > 2047 ? 2047 : dist); bsv = p.tabA[h * TABA_N + dc] * L2E; }
      float vv = s[e] * QSC + bsv; if (!selq || (edge && dist < 0)) vv = NINF; s[e] = vv; }
    float mx = s[0];
#pragma unroll
    for (int e = 1; e < 16; ++e) mx = fmaxf(mx, s[e]);
    mx = fmaxf(mx, __shfl_xor(mx, 32));
    if (__any(mx > S_.m + FTHR)) { const float mn = fmaxf(S_.m, mx); const float al = __builtin_amdgcn_exp2f(S_.m - mn); S_.m = mn; S_.l *= al; xch[r32] = al;
#pragma unroll
      for (int e = 0; e < 16; ++e) { const float a = xch[crow(e, hi)]; S_.o0[e] *= a; S_.o1[e] *= a; } }
    float ps = 0.f;
#pragma unroll
    for (int e = 0; e < 16; ++e) { s[e] = __builtin_amdgcn_exp2f(s[e] - S_.m); ps += s[e]; }
    S_.l += ps;
    const bf16x8 pa0 = pack8(s, 0), pa1 = pack8(s, 8);
    const unsigned short* vb = A->v[stage] + (32 * kt + 4 * hi + ((lane & 15) >> 2)) * 32 + ((lane >> 4) & 1) * 16 + (lane & 3) * 4;
#pragma unroll
    for (int s2 = 0; s2 < 2; ++s2) {
#pragma unroll
      for (int db = 0; db < 2; ++db) {
        const v4i16_t lo = __builtin_amdgcn_ds_read_tr16_b64_v4i16((LDS3 v4i16_t*)(vb + db * 2048 + s2 * 512));
        const v4i16_t h2 = __builtin_amdgcn_ds_read_tr16_b64_v4i16((LDS3 v4i16_t*)(vb + db * 2048 + s2 * 512 + 256));
        const bf16x8 vf = {lo[0], lo[1], lo[2], lo[3], h2[0], h2[1], h2[2], h2[3]};
        if (db == 0) S_.o0 = MFMA32(s2 ? pa1 : pa0, vf, S_.o0); else S_.o1 = MFMA32(s2 ? pa1 : pa0, vf, S_.o1); } }
  }
}
__device__ __forceinline__ void asel_store(const Params& p, FlashState& S_, float* xch, int q0, int qbase, int g, int lane) {
  const int r32 = lane & 31, hi = lane >> 5;
  const float lt = S_.l + __shfl_xor(S_.l, 32); const float inv = lt > 0.f ? 1.f / lt : 0.f; xch[r32] = inv;
#pragma unroll
  for (int e = 0; e < 16; ++e) { const int j = crow(e, hi); const float a = xch[j]; const int q = q0 + qbase + (j >> 2), he = g * 4 + (j & 3);
    const float* gl = p.small + (long)q * NSMALL + he * 3; const float g0 = sigmoid_f(gl[0]), g1 = sigmoid_f(gl[1]), g2 = sigmoid_f(gl[2]);
#pragma unroll
    for (int db = 0; db < 2; ++db) { const long c = (long)q * 512 + he * 64 + db * 32 + r32; const float os = (db ? S_.o1[e] : S_.o0[e]) * a;
      const float av = g0 * bf2f(p.oc[c]) + g1 * os + g2 * bf2f(p.ow[c]); SB* mp = p.mix + (long)q * NMIX + MX_A + he * 64 + db * 32 + r32; *mp = f2bf(av * bf2f(*mp)); } }
}
__device__ __forceinline__ void unit_asel_blk(const Params& p, int u, AselLds* A) {
  int tid = threadIdx.x; asm volatile("" : "+v"(tid));
  const int lane = tid & 63, w = __builtin_amdgcn_readfirstlane(tid >> 6), r32 = lane & 31, hi = lane >> 5;
  const int g = u & 1, qt = (p.S / 64 - 1) - (u >> 1), q0 = qt * 64, cur = qt;
  const SB* kvb = p.proj + PA_KV + 2 * 128 + g * 64;
  __syncthreads();
  for (int i = tid; i < 64 * 8 + 8; i += 256) ((unsigned*)A->sel)[i] = 0u;
  __syncthreads();
#pragma unroll
  for (int i = 0; i < 4; ++i) { const int e = tid + 256 * i, ql = e >> 4, kk = e & 15; const int b = p.idx[((long)(q0 + ql) * 2 + g) * 16 + kk];
    if (b >= 0) { atomicOr(&A->sel[ql][b >> 5], 1u << (b & 31)); atomicOr(&A->anyb[b >> 5], 1u << (b & 31)); } }
  __syncthreads();
  if (tid == 0) { int n = 0; for (int b = 0; b <= cur; ++b) if ((A->anyb[b >> 5] >> (b & 31)) & 1u) A->blist[n++] = (unsigned char)b; A->nlist = n; }
  __syncthreads();
  const int nlist = A->nlist;
  const int hh = r32 & 3, h = g * 4 + hh; const float c31 = p.tabA[h * TABA_N + 2047] * L2E;
  bf16x8 qf0[4], qf1[4]; FlashState st0, st1;
  load_q(qf0, p.proj + (long)(q0 + 16 * w + (r32 >> 2)) * NPROJ + PA_Q + h * 64, hi);
  load_q(qf1, p.proj + (long)(q0 + 16 * w + 8 + (r32 >> 2)) * NPROJ + PA_Q + h * 64, hi);
  st0.o0 = zero16(); st0.o1 = zero16(); st0.m = -1e30f; st0.l = 0.f; st1.o0 = zero16(); st1.o1 = zero16(); st1.m = -1e30f; st1.l = 0.f;
  float* xch = A->xch[w];
  uint4 pre0, pre1, pre2, pre3;
#define ASEL_ISSUE(bb) { const int b_ = (bb); const int i0_ = tid, r0_ = i0_ >> 3, c0_ = i0_ & 7, i1_ = tid + 256, r1_ = i1_ >> 3, c1_ = i1_ & 7; \
    const SB* s0_ = kvb + (long)(b_ * 64 + r0_) * NPROJ + c0_ * 8; const SB* s1_ = kvb + (long)(b_ * 64 + r1_) * NPROJ + c1_ * 8; \
    pre0 = *(const uint4*)s0_; pre2 = *(const uint4*)(s0_ + 128); pre1 = *(const uint4*)s1_; pre3 = *(const uint4*)(s1_ + 128); }
#define ASEL_COMMIT(stg) { const int i0_ = tid, r0_ = i0_ >> 3, c0_ = i0_ & 7, i1_ = tid + 256, r1_ = i1_ >> 3, c1_ = i1_ & 7; \
    *(uint4*)&A->k[stg][r0_ * 64 + ((c0_ ^ ((r0_ >> 1) & 7)) * 8)] = pre0; *(uint4*)&A->v[stg][(c0_ >> 2) * 2048 + r0_ * 32 + (c0_ & 3) * 8] = pre2; \
    *(uint4*)&A->k[stg][r1_ * 64 + ((c1_ ^ ((r1_ >> 1) & 7)) * 8)] = pre1; *(uint4*)&A->v[stg][(c1_ >> 2) * 2048 + r1_ * 32 + (c1_ & 3) * 8] = pre3; }
  if (nlist > 0) { ASEL_ISSUE(A->blist[0]); ASEL_COMMIT(0); }
  for (int it = 0; it < nlist; ++it) {
    const int stage = it & 1; const int b = A->blist[it];
    __syncthreads();
    const bool more = (it + 1 < nlist);
    if (more) ASEL_ISSUE(A->blist[it + 1]);
    asel_coltile(p, st0, qf0, A, xch, stage, b, cur, q0, 16 * w, h, c31, lane);
    asel_coltile(p, st1, qf1, A, xch, stage, b, cur, q0, 16 * w + 8, h, c31, lane);
    if (more) ASEL_COMMIT(stage ^ 1);
  }
  asel_store(p, st0, xch, q0, 16 * w, g, lane);
  asel_store(p, st1, xch, q0, 16 * w + 8, g, lane);
#undef ASEL_ISSUE
#undef ASEL_COMMIT
}

__device__ __forceinline__ void unit_topk4(const Params& p, int u, int lane) {
  float v[4][4]; int cur[4], mine[4];
#pragma unroll
  for (int r = 0; r < 4; ++r) { const int row = u * 4 + r; const int q = row >> 1; cur[r] = q >> 6; const float* imp = p.imp + (long)row * 256; mine[r] = -1;
#pragma unroll
    for (int k = 0; k < 4; ++k) { const int b = lane + 64 * k; float x = (b <= cur[r]) ? imp[b] : -1.f; if (b == 0 || b == cur[r]) x = 1e4f; v[r][k] = x; } }
  for (int k = 0; k < 16; ++k) {
    float m[4]; int cand[4];
#pragma unroll
    for (int r = 0; r < 4; ++r) m[r] = fmaxf(fmaxf(v[r][0], v[r][1]), fmaxf(v[r][2], v[r][3]));
#pragma unroll
    for (int o = 32; o > 0; o >>= 1) {
#pragma unroll
      for (int r = 0; r < 4; ++r) m[r] = fmaxf(m[r], __shfl_xor(m[r], o)); }
#pragma unroll
    for (int r = 0; r < 4; ++r) { cand[r] = 0x7fffffff;
#pragma unroll
      for (int kk = 3; kk >= 0; --kk) if (v[r][kk] == m[r]) cand[r] = lane + 64 * kk; }
#pragma unroll
    for (int o = 32; o > 0; o >>= 1) {
#pragma unroll
      for (int r = 0; r < 4; ++r) { const int w = __shfl_xor(cand[r], o); cand[r] = w < cand[r] ? w : cand[r]; } }
#pragma unroll
    for (int r = 0; r < 4; ++r) {
#pragma unroll
      for (int kk = 0; kk < 4; ++kk) if (lane + 64 * kk == cand[r]) v[r][kk] = -2.f;
      if (lane == k) mine[r] = (m[r] >= 0.f) ? cand[r] : -1; }
  }
#pragma unroll
  for (int r = 0; r < 4; ++r) if (lane < 16) p.idx[(long)(u * 4 + r) * 16 + lane] = mine[r];
}
__device__ __forceinline__ void unit_bout_blk(const Params& p, int layer, int ub, char* smem) {
  int tid = threadIdx.x; asm volatile("" : "+v"(tid));
  const int lane = tid & 63, w = __builtin_amdgcn_readfirstlane(tid >> 6), r32 = lane & 31, hi = lane >> 5;
  const int lt = ub & 3, g = (ub >> 2) & 1, c = ub >> 3, hd = g * 4 + w;
  WaveLds2* L = ((WaveLds2*)smem) + w;
  __syncthreads();
  for (int x = lane; x < 128; x += 64) { L->acs[x] = p.acs[((long)c * 128 + x) * 8 + hd]; L->dtv[x] = p.dt[((long)c * 128 + x) * 8 + hd]; }
  f32x16 acc[2] = {zero16(), zero16()}, acc2[2] = {zero16(), zero16()};
  const SB* xb = p.xconv + (long)c * 128 * 1024; const int l = 32 * lt + r32; const float al = p.acs[((long)c * 128 + l) * 8 + hd];
  const float* cbr = p.cb + ((long)c * 2 + g) * 16384 + (long)l * 128;
  for (int sc = 0; sc <= lt; ++sc) {
    stage_slab<false>(L->x, xb + (long)(32 * sc) * 1024 + hd * 64, 1024, [&](int) { return 1.f; }, lane);
#pragma unroll
    for (int s2 = 0; s2 < 2; ++s2) { float mv[8];
#pragma unroll
      for (int jj = 0; jj < 2; ++jj) { const int s0 = 32 * sc + 16 * s2 + 8 * jj + 4 * hi; const float4 cv = *(const float4*)(cbr + s0); const float4 av = *(const float4*)(&L->acs[s0]); const float4 dv = *(const float4*)(&L->dtv[s0]);
        mv[4 * jj + 0] = (s0 + 0 <= l) ? cv.x * __expf(al - av.x) * dv.x : 0.f; mv[4 * jj + 1] = (s0 + 1 <= l) ? cv.y * __expf(al - av.y) * dv.y : 0.f;
        mv[4 * jj + 2] = (s0 + 2 <= l) ? cv.z * __expf(al - av.z) * dv.z : 0.f; mv[4 * jj + 3] = (s0 + 3 <= l) ? cv.w * __expf(al - av.w) * dv.w : 0.f; }
      u32x4 aw; aw[0] = pk2(mv[0], mv[1]); aw[1] = pk2(mv[2], mv[3]); aw[2] = pk2(mv[4], mv[5]); aw[3] = pk2(mv[6], mv[7]); const bf16x8 af = __builtin_bit_cast(bf16x8, aw);
#pragma unroll
      for (int pt = 0; pt < 2; ++pt) acc[pt] = MFMA32(af, slab_frag(L->x, pt, s2, lane), acc[pt]); } }
  const SB* cmr = xb + (long)l * 1024 + 768 + g * 128; const float* prv = p.states + ((long)c * 8 + hd) * 8192;
#pragma unroll 2
  for (int ks = 0; ks < 8; ++ks) { const bf16x8 af = *(const bf16x8*)(cmr + 16 * ks + 8 * hi);
#pragma unroll
    for (int pt = 0; pt < 2; ++pt) { const float* pr = prv + (long)(32 * pt + r32) * 128 + 16 * ks + 8 * hi; const float4 a0 = *(const float4*)pr, a1 = *(const float4*)(pr + 4);
      u32x4 bw; bw[0] = pk2(a0.x, a0.y); bw[1] = pk2(a0.z, a0.w); bw[2] = pk2(a1.x, a1.y); bw[3] = pk2(a1.z, a1.w);
      acc2[pt] = MFMA32(af, __builtin_bit_cast(bf16x8, bw), acc2[pt]); } }
  const float dsk = p.b_d[layer * 8 + hd];
  float* yl = (float*)L;
#pragma unroll
  for (int e = 0; e < 16; ++e) { const int lr = crow(e, hi); const float ea = __expf(L->acs[32 * lt + lr]);
#pragma unroll
    for (int pt = 0; pt < 2; ++pt) { const int pp = 32 * pt + r32; yl[lr * 64 + pp] = acc[pt][e] + ea * acc2[pt][e] + dsk * bf2f(xb[(long)(32 * lt + lr) * 1024 + hd * 64 + pp]); } }
  __syncthreads();
  { const int row = tid >> 3, sub = tid & 7; const long t = (long)c * 128 + 32 * lt + row; SB* mp = p.mix + t * NMIX + MX_B + g * 256 + sub * 32;
    const float* ysrc = (const float*)(((WaveLds2*)smem) + (sub >> 1)) + row * 64 + (sub & 1) * 32;
    float vv[32]; float ss = 0.f;
#pragma unroll
    for (int i = 0; i < 4; ++i) { const uint4 zz = *(const uint4*)(mp + 8 * i); const unsigned zw[4] = {zz.x, zz.y, zz.z, zz.w};
#pragma unroll
      for (int k = 0; k < 4; ++k) { const float y0 = ysrc[8 * i + 2 * k] * __uint_as_float(zw[k] << 16), y1 = ysrc[8 * i + 2 * k + 1] * __uint_as_float(zw[k] & 0xffff0000u); vv[8 * i + 2 * k] = y0; vv[8 * i + 2 * k + 1] = y1; ss += y0 * y0 + y1 * y1; } }
    ss += __shfl_xor(ss, 1); ss += __shfl_xor(ss, 2); ss += __shfl_xor(ss, 4);
    const float r = 1.f / sqrtf(ss * (1.f / 256.f) + 1e-6f); const float* wn = p.b_norm + layer * 512 + g * 256 + sub * 32;
#pragma unroll
    for (int i = 0; i < 4; ++i) { uint4 o; o.x = pk2(vv[8 * i] * r * wn[8 * i], vv[8 * i + 1] * r * wn[8 * i + 1]); o.y = pk2(vv[8 * i + 2] * r * wn[8 * i + 2], vv[8 * i + 3] * r * wn[8 * i + 3]);
      o.z = pk2(vv[8 * i + 4] * r * wn[8 * i + 4], vv[8 * i + 5] * r * wn[8 * i + 5]); o.w = pk2(vv[8 * i + 6] * r * wn[8 * i + 6], vv[8 * i + 7] * r * wn[8 * i + 7]); *(uint4*)(mp + 8 * i) = o; } }
}

#define SEQ 16384
#define DEPTH 4

__device__ __forceinline__ int n2o(int n) {
  if (n < 1280) return n;
  if (n < 2304) return n - 1280 + 1816;
  if (n < 2816) return n - 2304 + 3360;
  if (n < 3072) return n - 2816 + 3872;
  if (n < 4608) return n - 3072 + 4640;
  if (n < 5632) return n - 4608 + 6176;
  if (n < 5888) return n - 5632 + 7712;
  n -= 5888;
  if (n < 512) return 1304 + n;
  if (n < 1024) return 2848 + n - 512;
  if (n < 1536) return 4128 + n - 1024;
  if (n < 2048) return 7200 + n - 1536;
  if (n < 2304) return 7968 + n - 2048;
  n -= 2304;
  if (n < 24) return 1280 + n;
  if (n < 32) return 2840 + n - 24;
  return -1;
}

template <bool MAP>
__device__ __forceinline__ void cvt_tile(const float* __restrict__ src, int lds_, unsigned short* __restrict__ dst, int ldd, int k0, int n0, float* tile  ) {
  int tid = threadIdx.x; asm volatile("" : "+v"(tid));
  __syncthreads();
#pragma unroll
  for (int e = 0; e < 16; ++e) { int idx = tid + 256 * e, kk = idx >> 6, nn = idx & 63; int oc = MAP ? n2o(n0 + nn) : (n0 + nn);
    tile[kk * 65 + nn] = (oc >= 0) ? src[(long)(k0 + kk) * lds_ + oc] : 0.f; }
  __syncthreads();
#pragma unroll
  for (int e = 0; e < 16; ++e) { int idx = tid + 256 * e, nn = idx >> 6, kk = idx & 63; dst[(long)(n0 + nn) * ldd + k0 + kk] = f2bf(tile[kk * 65 + nn]); }
}

__device__ __forceinline__ float wave_sum(float v) {
#pragma unroll
  for (int o = 32; o > 0; o >>= 1) v += __shfl_xor(v, o);
  return v;
}

__device__ __forceinline__ void norm_row_wave(const Params& p, int layer, int t, bool do_h, int lane) {
  const float* xin = (layer == 0) ? p.x + (long)t * DM : p.out + (long)t * DM;
  float4 xv[4], yv[4];
#pragma unroll
  for (int i = 0; i < 4; ++i) xv[i] = *(const float4*)(xin + i * 256 + lane * 4);
  if (layer > 0) {
    float ss = 0.f;
#pragma unroll
    for (int i = 0; i < 4; ++i) { yv[i] = *(const float4*)(p.y + (long)t * DM + i * 256 + lane * 4); ss += yv[i].x * yv[i].x + yv[i].y * yv[i].y + yv[i].z * yv[i].z + yv[i].w * yv[i].w; }
    ss = wave_sum(ss); float r1 = 1.f / sqrtf(ss / DM + 1e-6f);
#pragma unroll
    for (int i = 0; i < 4; ++i) { float4 w = *(const float4*)(p.post_norm + (layer - 1) * DM + i * 256 + lane * 4);
      xv[i].x += yv[i].x * r1 * w.x; xv[i].y += yv[i].y * r1 * w.y; xv[i].z += yv[i].z * r1 * w.z; xv[i].w += yv[i].w * r1 * w.w; }
  }
  float ss2 = 0.f;
#pragma unroll
  for (int i = 0; i < 4; ++i) { *(float4*)(p.out + (long)t * DM + i * 256 + lane * 4) = xv[i]; ss2 += xv[i].x * xv[i].x + xv[i].y * xv[i].y + xv[i].z * xv[i].z + xv[i].w * xv[i].w; }
  if (!do_h) return;
  ss2 = wave_sum(ss2); float r2 = 1.f / sqrtf(ss2 / DM + 1e-6f);
#pragma unroll
  for (int i = 0; i < 4; ++i) { float4 w = *(const float4*)(p.pre_norm + layer * DM + i * 256 + lane * 4);
    ushort4 o; o.x = f2bf(xv[i].x * r2 * w.x); o.y = f2bf(xv[i].y * r2 * w.y); o.z = f2bf(xv[i].z * r2 * w.z); o.w = f2bf(xv[i].w * r2 * w.w);
    *(ushort4*)(p.h + (long)t * DM + i * 256 + lane * 4) = o; }
}

struct GemmSmem { unsigned short a[2][128 * 64]; unsigned short b[2][128 * 64]; };
typedef __attribute__((address_space(1))) const void* gptr_t;
typedef __attribute__((address_space(3))) void* lptr_t;
__device__ __forceinline__ void glds16(const void* g, void* lds_wave_base) {
  __builtin_amdgcn_global_load_lds((gptr_t)g, (lptr_t)lds_wave_base, 16, 0, 0);
}
template <int EPI>
__device__ __forceinline__ void gemm_tile(const Params& p, const unsigned short* __restrict__ A, int lda, const unsigned short* __restrict__ Bt, int ldb, int K, int m0, int n0, GemmSmem& sm, float* outp = nullptr) {
  int tid = threadIdx.x; asm volatile("" : "+v"(tid));
  const int lane = tid & 63, wid = __builtin_amdgcn_readfirstlane(tid >> 6), wr = wid >> 1, wc = wid & 1, r = lane & 31, h = lane >> 5;
  f32x16 acc[2][2];
#pragma unroll
  for (int i = 0; i < 2; ++i)
#pragma unroll
    for (int j = 0; j < 2; ++j) acc[i][j] = zero16();
  const int prow = lane >> 3, pc = lane & 7;
  const unsigned short* ga[4]; const unsigned short* gb[4];
#pragma unroll
  for (int i = 0; i < 4; ++i) { const int row = (wid * 4 + i) * 8 + prow; const int lc = (pc ^ ((row >> 1) & 7)) * 8;
    ga[i] = A + (long)(m0 + row) * lda + lc; gb[i] = Bt + (long)(n0 + row) * ldb + lc; }
  __syncthreads();
#pragma unroll
  for (int i = 0; i < 4; ++i) { glds16(ga[i], &sm.a[0][(wid * 4 + i) * 512]); glds16(gb[i], &sm.b[0][(wid * 4 + i) * 512]); }
  __syncthreads();
  const int nk = K / 64;
  for (int kt = 0; kt < nk; ++kt) {
    const int cur = kt & 1;
    if (kt + 1 < nk) { const int ko = (kt + 1) * 64;
#pragma unroll
      for (int i = 0; i < 4; ++i) { glds16(ga[i] + ko, &sm.a[cur ^ 1][(wid * 4 + i) * 512]); glds16(gb[i] + ko, &sm.b[cur ^ 1][(wid * 4 + i) * 512]); } }
#pragma unroll
    for (int ks = 0; ks < 4; ++ks) {
      bf16x8 af[2], bfr[2];
#pragma unroll
      for (int i = 0; i < 2; ++i) { const int row = wr * 64 + i * 32 + r; af[i] = *(const bf16x8*)&sm.a[cur][row * 64 + (((2 * ks + h) ^ ((row >> 1) & 7)) * 8)]; }
#pragma unroll
      for (int j = 0; j < 2; ++j) { const int row = wc * 64 + j * 32 + r; bfr[j] = *(const bf16x8*)&sm.b[cur][row * 64 + (((2 * ks + h) ^ ((row >> 1) & 7)) * 8)]; }
#pragma unroll
      for (int i = 0; i < 2; ++i)
#pragma unroll
        for (int j = 0; j < 2; ++j) acc[i][j] = __builtin_amdgcn_mfma_f32_32x32x16_bf16(af[i], bfr[j], acc[i][j], 0, 0, 0);
    }
    __syncthreads();
  }
  const int ncol0 = n0 + wc * 64;
  if (EPI == 2) {
#pragma unroll
    for (int i = 0; i < 2; ++i)
#pragma unroll
      for (int j = 0; j < 2; ++j)
#pragma unroll
        for (int e = 0; e < 16; ++e) { int row = m0 + wr * 64 + i * 32 + (e & 3) + 8 * (e >> 2) + 4 * h; outp[row * 128 + ncol0 + j * 32 + r] = acc[i][j][e]; }
  } else if (EPI == 1) {
#pragma unroll
    for (int i = 0; i < 2; ++i)
#pragma unroll
      for (int j = 0; j < 2; ++j)
#pragma unroll
        for (int e = 0; e < 16; ++e) { int row = m0 + wr * 64 + i * 32 + (e & 3) + 8 * (e >> 2) + 4 * h; p.y[(long)row * DM + ncol0 + j * 32 + r] = acc[i][j][e]; }
  } else {
    if (ncol0 < NPROJ) {
      const bool rope = (ncol0 >= PC_Q && ncol0 < PC_KV + 128);
#pragma unroll
      for (int i = 0; i < 2; ++i)
#pragma unroll
        for (int e = 0; e < 16; ++e) { int row = m0 + wr * 64 + i * 32 + (e & 3) + 8 * (e >> 2) + 4 * h; float v0 = acc[i][0][e], v1 = acc[i][1][e];
          if (rope) { float c = p.rope_cs[row * 32 + r], s = p.rope_sn[row * 32 + r]; float t1 = v0, t2 = v1; v0 = t1 * c - t2 * s; v1 = t2 * c + t1 * s; }
          p.proj[(long)row * NPROJ + ncol0 + r] = f2bf(v0); p.proj[(long)row * NPROJ + ncol0 + 32 + r] = f2bf(v1); }
    } else if (ncol0 < 8192) {
#pragma unroll
      for (int i = 0; i < 2; ++i)
#pragma unroll
        for (int j = 0; j < 2; ++j)
#pragma unroll
          for (int e = 0; e < 16; ++e) { int row = m0 + wr * 64 + i * 32 + (e & 3) + 8 * (e >> 2) + 4 * h; p.mix[(long)row * NMIX + (ncol0 - NPROJ) + j * 32 + r] = f2bf(silu_f(acc[i][j][e])); }
    } else if (ncol0 == 8192) {
#pragma unroll
      for (int i = 0; i < 2; ++i)
#pragma unroll
        for (int e = 0; e < 16; ++e) { int row = m0 + wr * 64 + i * 32 + (e & 3) + 8 * (e >> 2) + 4 * h; p.small[(long)row * NSMALL + r] = acc[i][0][e]; }
    }
  }
}

__device__ __forceinline__ int gw0(int g) { asm volatile("" : "+v"(g)); return g; }
__device__ __forceinline__ int bid0() { int b = blockIdx.x; asm volatile("" : "+s"(b)); return b; }

#define XB_TMO      128
#define XB_XCNT(j)  (256  + 64 * (j))
#define XB_XSUB(j)  (1280 + 64 * (j))
#define XB_XGEN(j)  (2304 + 64 * (j))
#define XB_TOP      3328
#define XB_TOPGEN   3392
#define XCD_BAR_WORDS 3456
#define XB_SPIN_CAP (1u << 28)
__device__ __forceinline__ unsigned xb_ld(unsigned* p) { return __hip_atomic_load(p, __ATOMIC_RELAXED, __HIP_MEMORY_SCOPE_AGENT); }
__device__ __forceinline__ unsigned xb_add(unsigned* p, unsigned v) { return __hip_atomic_fetch_add(p, v, __ATOMIC_RELAXED, __HIP_MEMORY_SCOPE_AGENT); }
__device__ __forceinline__ unsigned xb_xcc_id() { return (unsigned)__builtin_amdgcn_s_getreg((3 << 11) | 20) & 0xFu; }
#define XB_SPIN(cond, bar) do { unsigned _sp = 0; while (cond) { __builtin_amdgcn_s_sleep(1); \
    if ((++_sp & 255u) == 0u) { if (xb_ld(&(bar)[XB_TMO])) break; if (_sp > XB_SPIN_CAP) { atomicAdd(&(bar)[XB_TMO], 1u); break; } } } } while (0)
struct XcdBarrier { unsigned* bar; unsigned x; volatile LDS3 unsigned* st; };
__device__ __forceinline__ XcdBarrier xcd_barrier_post(unsigned* bar, volatile LDS3 unsigned* st) {
  XcdBarrier b; b.bar = bar; b.x = xb_xcc_id(); b.st = st;
  if (threadIdx.x == 0) (void)xb_add(&bar[XB_XCNT(b.x)], 1u);
  return b;
}
__device__ __forceinline__ void xcd_barrier_complete(unsigned* bar, unsigned x, unsigned& nloc, unsigned& nx) {
  const unsigned G = gridDim.x; unsigned sum, cnt, mine, sp = 0u;
  for (;;) { sum = 0u; cnt = 0u; mine = 0u;
#pragma unroll
    for (unsigned j = 0; j < 16; ++j) { const unsigned c = xb_ld(&bar[XB_XCNT(j)]); sum += c; cnt += (c > 0u) ? 1u : 0u; mine = (j == x) ? c : mine; }
    if (sum == G) break;
    __builtin_amdgcn_s_sleep(1);
    if ((++sp & 255u) == 0u) { if (xb_ld(&bar[XB_TMO])) break; if (sp > XB_SPIN_CAP) { atomicAdd(&bar[XB_TMO], 1u); break; } } }
  nloc = mine > 0u ? mine : 1u; nx = cnt > 0u ? cnt : 1u;
}
__device__ __forceinline__ void xcd_barrier(const XcdBarrier& b) {
  asm volatile("s_waitcnt vmcnt(0)" ::: "memory");
  __syncthreads();
  if (threadIdx.x == 0) {
    unsigned* bar = b.bar;
    __builtin_amdgcn_s_waitcnt(0);
    unsigned nloc = b.st[0], nx = b.st[1];
    if (nloc == 0u) { xcd_barrier_complete(bar, b.x, nloc, nx); b.st[0] = nloc; b.st[1] = nx; }
    const unsigned old = xb_add(&bar[XB_XSUB(b.x)], 1u);
    const unsigned gen = old / nloc;
    if (old + 1u == (gen + 1u) * nloc) {
      __builtin_amdgcn_fence(__ATOMIC_RELEASE, "agent");
      asm volatile("s_waitcnt vmcnt(0)" ::: "memory");
      const unsigned og = xb_add(&bar[XB_TOP], 1u);
      const unsigned tg = og / nx;
      if (og + 1u == (tg + 1u) * nx) xb_add(&bar[XB_TOPGEN], 1u);
      else XB_SPIN(xb_ld(&bar[XB_TOPGEN]) == tg, bar);
      __builtin_amdgcn_fence(__ATOMIC_ACQUIRE, "agent");
      xb_add(&bar[XB_XGEN(b.x)], 1u);
      asm volatile("s_waitcnt vmcnt(0)" ::: "memory");
    } else {
      XB_SPIN(xb_ld(&bar[XB_XGEN(b.x)]) == gen, bar);
      __builtin_amdgcn_fence(__ATOMIC_ACQUIRE, "agent");
      asm volatile("s_waitcnt vmcnt(0)" ::: "memory");
    }
  }
  __syncthreads();
}

struct KArgs { const void* in[20]; float* out; char* ws; };
#ifdef SELFCHK
#define RUN_S 4096
#else
#define RUN_S SEQ
#endif
__host__ __device__ __forceinline__ size_t fill_ws(Params& p, Params& p2, char* w) {
  size_t off = 0;
#define TAKE(bytes) (w + ((off += (((size_t)(bytes)) + 255) & ~(size_t)255) - ((((size_t)(bytes)) + 255) & ~(size_t)255)))
  const size_t S = RUN_S, ncmp = S / 16, nc = S / 128;
  p.S = RUN_S;
  p.wt_in = (unsigned short*)TAKE(8320 * 1024 * 2); p.wt_out = (unsigned short*)TAKE(1024 * 2304 * 2); p.w1t = (unsigned short*)TAKE(2 * 128 * 2048 * 2); p.w2t = (unsigned short*)TAKE(2 * 64 * 128 * 2);
  p.h = (SB*)TAKE(S * 1024 * 2); p.ybuf = (float*)p.h;
  p.proj = (SB*)TAKE(S * NPROJ * 2); p.y = (float*)p.proj;
  p.small = (float*)TAKE(S * 32 * 4); p.mix = (SB*)TAKE(S * NMIX * 2);
  p.rope_cs = (float*)TAKE(S * 32 * 4); p.rope_sn = (float*)TAKE(S * 32 * 4); p.tabA = (float*)TAKE(8 * TABA_N * 4); p.tabD = (float*)TAKE(24 * TABD_N * 4);
  p.memkv = (SB*)TAKE(4 * 256 * 512 * 2); p.hid = (float*)TAKE(2 * ncmp * 256 * 4); p.kvc = (SB*)TAKE(2 * ncmp * 128 * 2);
  p.cml = (float*)TAKE(S * 16 * 4); p.idx = (int*)TAKE(S * 32 * 4); p.oc = (SB*)TAKE(S * 512 * 2); p.ow = (SB*)TAKE(S * 512 * 2);
  p.dop = (SB*)TAKE(3 * S * 512 * 2); p.dlse = (float*)TAKE(3 * S * 8 * 4); p.xconv = (SB*)TAKE(S * 1024 * 2);
  p.dt = (float*)TAKE(S * 8 * 4); p.acs = (float*)TAKE(S * 8 * 4); p.wst = (float*)TAKE(S * 8 * 4); p.cb = (float*)TAKE(nc * 2 * 128 * 128 * 4); p.states = (float*)TAKE(nc * 65536 * 4);
  p.bar = (unsigned*)TAKE(16384);
  p2 = p;
#ifdef SELFCHK
  p.imp = (float*)TAKE(S * 512 * 4);
  p2.mix = (SB*)TAKE(S * NMIX * 2); p2.ow = (SB*)TAKE(S * 512 * 2); p2.oc = (SB*)TAKE(S * 512 * 2); p2.dop = (SB*)TAKE(3 * S * 512 * 2); p2.dlse = (float*)TAKE(3 * S * 8 * 4);
  p2.cml = (float*)TAKE(S * 16 * 4); p2.imp = (float*)TAKE(S * 512 * 4); p2.idx = (int*)TAKE(S * 32 * 4); p2.cb = (float*)TAKE(nc * 2 * 128 * 128 * 4);
  p2.kvc = (SB*)TAKE(2 * ncmp * 128 * 2); p2.xconv = (SB*)TAKE(S * 1024 * 2); p2.dt = (float*)TAKE(S * 8 * 4); p2.acs = (float*)TAKE(S * 8 * 4); p2.wst = (float*)TAKE(S * 8 * 4);
  p2.states = (float*)TAKE(nc * 65536 * 4); p2.ybuf = (float*)TAKE(S * 512 * 4); p.ybuf = (float*)TAKE(S * 512 * 4);
#else
  p.imp = (float*)p.dop; p2 = p;
#endif
  return off;
}
__host__ __device__ __forceinline__ void fill_inputs(Params& p, const KArgs& a) {
  p.x = (const float*)a.in[0]; p.mem = (const float*)a.in[1]; p.pos = (const int*)a.in[2]; p.pre_norm = (const float*)a.in[3]; p.post_norm = (const float*)a.in[4];
  p.w_in = (const float*)a.in[5]; p.w_out = (const float*)a.in[6]; p.rel_bias = (const float*)a.in[7]; p.cmp_pos = (const float*)a.in[8]; p.cmp_w1 = (const float*)a.in[9];
  p.cmp_w2 = (const float*)a.in[10]; p.conv_w = (const float*)a.in[11]; p.conv_b = (const float*)a.in[12]; p.dt_bias = (const float*)a.in[13]; p.a_log = (const float*)a.in[14];
  p.b_d = (const float*)a.in[15]; p.b_norm = (const float*)a.in[16]; p.sinks = (const float*)a.in[17]; p.m_norm = (const float*)a.in[18]; p.m_wkv = (const float*)a.in[19];
  p.out = a.out;
}
#define GS(N, ...) { long g0_ = gtid; asm volatile("" : "+v"(g0_)); for (long gid = g0_; gid < (long)(N); gid += gsz) { __VA_ARGS__; } }
#define WU(N, ...) { for (int u_ = gw0(gwave); u_ < (int)(N); u_ += nwave) { const int u = __builtin_amdgcn_readfirstlane(u_); int lane = threadIdx.x & 63; asm volatile("" : "+v"(lane)); \
    WaveLds* WL = ((WaveLds*)smem_raw) + __builtin_amdgcn_readfirstlane((int)(threadIdx.x >> 6)); __VA_ARGS__; } }
#define GSYNC() xcd_barrier(xb)
#define KERNEL_PROLOGUE \
  Params p, p2; p.pad0 = 0; fill_inputs(p, ka); fill_ws(p, p2, ka.ws); \
  cg::grid_group grid = cg::this_grid(); \
  __shared__ __attribute__((aligned(16))) char smem_raw[sizeof(GemmSmem) + 16]; \
  volatile LDS3 unsigned* xbst = (volatile LDS3 unsigned*)(smem_raw + sizeof(GemmSmem)); \
  if (threadIdx.x < 4) xbst[threadIdx.x] = 0u; \
  __syncthreads(); \
  XcdBarrier xb = xcd_barrier_post(p.bar, xbst); \
  GemmSmem& gsm = *(GemmSmem*)smem_raw; float* ftile = (float*)smem_raw; \
  const long gtid = (long)blockIdx.x * 256 + threadIdx.x, gsz = (long)gridDim.x * 256; \
  const int gwave = (int)(gtid >> 6), nwave = (int)(gsz >> 6); \
  const int S = p.S, ncmp = S / 16, nc = S / 128, nqt = S / 32; (void)ncmp; (void)nc; (void)nqt; (void)ftile; (void)gsm; \
  GS((long)S * 32, ph_rope(p, gid)); \
  GS(8 * TABA_N + 24 * TABD_N, ph_tabs(p, gid));
#define PHASE_P1(layer) \
    GS(256 * 512, ph_memkv(p, (long)(layer) * 256 * 512 + gid)); \
    for (int t = gw0(gwave); t < S; t += nwave) { int lane = threadIdx.x & 63; asm volatile("" : "+v"(lane)); norm_row_wave(p, layer, t, true, lane); } \
    { const float* wi = p.w_in + (long)(layer) * 1024 * 8224; \
      for (int tl = bid0(); tl < 16 * 130; tl += gridDim.x) cvt_tile<true>(wi, 8224, p.wt_in, 1024, (tl & 15) * 64, (tl >> 4) * 64, ftile); \
      const float* wo = p.w_out + (long)(layer) * 2304 * 1024; \
      for (int tl = bid0(); tl < 36 * 16; tl += gridDim.x) cvt_tile<false>(wo, 1024, p.wt_out, 2304, (tl % 36) * 64, (tl / 36) * 64, ftile); \
      for (int tl = bid0(); tl < 2 * 64; tl += gridDim.x) { const int kv = tl >> 6, t6 = tl & 63; cvt_tile<false>(p.cmp_w1 + (long)((layer) * 2 + kv) * 2048 * 128, 128, p.w1t + (long)kv * 128 * 2048, 2048, (t6 >> 1) * 64, (t6 & 1) * 64, ftile); } \
      for (int tl = bid0(); tl < 2 * 2; tl += gridDim.x) { const int kv = tl >> 1; cvt_tile<false>(p.cmp_w2 + (long)((layer) * 2 + kv) * 128 * 64, 64, p.w2t + (long)kv * 64 * 128, 128, (tl & 1) * 64, 0, ftile); } }
#define PHASE_P2() \
    {   \
      const int x_ = bid0() & 7, li_ = bid0() >> 3, nl_ = (gridDim.x + 7) >> 3, mper_ = (S / 128) / 8; \
      if (mper_ != 16) { for (int tl = bid0(); tl < (S / 128) * 65; tl += gridDim.x) { int mt = tl % (S / 128), nt = tl / (S / 128); gemm_tile<0>(p, p.h, DM, p.wt_in, DM, DM, mt * 128, nt * 128, gsm); } } \
      else for (int t_ = li_; t_ < mper_ * 65; t_ += nl_) { const int half_ = t_ / 520, r_ = t_ % 520; int ml_, nt_; \
        if (r_ < 512) { ml_ = r_ & 7; nt_ = (r_ >> 6) * 8 + ((r_ & 63) >> 3); } else { ml_ = r_ - 512; nt_ = 64; } \
        const int mt_ = x_ * mper_ + half_ * 8 + ml_; gemm_tile<0>(p, p.h, DM, p.wt_in, DM, DM, mt_ * 128, nt_ * 128, gsm); } }
#define PHASE_FLASH3(layer) \
    { const int nA = nqt * 8, nM = nqt * 4, nD = 3 * nqt * 8, nC = nqt * 8; \
      WU(nA + nM + nD + nC, { if (u < nA) unit_awin(p, u, WL, lane); else if (u < nA + nM) unit_m(p, layer, u - nA, WL, lane); \
                              else if (u < nA + nM + nD) unit_d(p, u - nA - nM, WL, lane); else unit_c(p, layer, u - nA - nM - nD, WL, lane); }); }
#define WU2(N, ...) { for (int u_ = gw0(gwave); u_ < (int)(N); u_ += nwave) { const int u = __builtin_amdgcn_readfirstlane(u_); int lane = threadIdx.x & 63; asm volatile("" : "+v"(lane)); \
    WaveLds2* WL2 = ((WaveLds2*)smem_raw) + __builtin_amdgcn_readfirstlane((int)(threadIdx.x >> 6)); __VA_ARGS__; } }
#define PHASE_CB() \
    for (int tl = bid0(); tl < nc * 2; tl += gridDim.x) { const SB* xb_ = p.xconv + (long)(tl >> 1) * 128 * 1024 + (tl & 1) * 128; gemm_tile<2>(p, xb_ + 768, 1024, xb_ + 512, 1024, 128, 0, 0, gsm, p.cb + (long)tl * 16384); }

#ifndef SELFCHK
__global__ void __launch_bounds__(256, LB2) mega(KArgs ka) {
  KERNEL_PROLOGUE
#ifdef REP_PRO
  GS((long)S * 32, ph_rope(p, gid)); GS(8 * TABA_N + 24 * TABD_N, ph_tabs(p, gid));
#endif
#ifdef TSEL
  unsigned long long tlast = __builtin_amdgcn_s_memrealtime();
#define TMARK(id) { if (gtid == 0) { const unsigned long long tn = __builtin_amdgcn_s_memrealtime(); ((unsigned long long*)p.bar)[id] += tn - tlast; tlast = tn; } }
#else
#define TMARK(id)
#endif
  for (int layer = 0; layer < DEPTH; ++layer) {
    PHASE_P1(layer)
#ifdef REP_P1
    PHASE_P1(layer)
#endif
    if (layer == 0) grid.sync(); else GSYNC();
    TMARK(1)
    PHASE_P2()
#ifdef REP_G
    PHASE_P2()
#endif
    GSYNC();
    TMARK(2)
    WU(2 * (ncmp * 2 / 32), unit_cmp(p, layer, u, lane));
#ifdef REP_F3
    { const int nA = nqt * 8, nD = 3 * nqt * 8; WU(nA + nD, { if (u < nA) unit_awin(p, u, WL, lane); else unit_d(p, u - nA, WL, lane); }); }
#endif
    PHASE_FLASH3(layer)
    GS((long)S * 128, item_bconv(p, layer, gid));
    WU(nc * 8, unit_bdt(p, layer, u, lane));
#ifdef REP_P3B
    WU(2 * (ncmp * 2 / 32), unit_cmp(p, layer, u, lane));
    GS((long)S * 128, item_bconv(p, layer, gid));
    WU(nc * 8, unit_bdt(p, layer, u, lane));
#endif
    GSYNC();
    TMARK(3)
    WU(nqt * 8, unit_acmp1(p, u, WL, lane));
    __syncthreads();
    PHASE_CB()
    __syncthreads();
    WU2(nc * 16, unit_bstates(p, u, WL2, lane));
#ifdef REP_P4
    __syncthreads();
    WU(nqt * 8, unit_acmp1(p, u, WL, lane));
    __syncthreads();
    PHASE_CB()
    __syncthreads();
    WU2(nc * 16, unit_bstates(p, u, WL2, lane));
#endif
    GS((long)S * 8, ph_d_merge(p, gid));
    GSYNC();
    TMARK(4)
    WU(nqt * 8, unit_acmp2(p, u, lane));
#ifdef REP_P5A
    WU(nqt * 8, unit_acmp2(p, u, lane));
#endif
    GS(65536, ph_b_scan(p, gid));
    GSYNC();
    TMARK(5)
    WU(S * 2 / 4, unit_topk4(p, u, lane));
    GSYNC();
    TMARK(6)
    for (int ub = bid0(); ub < (S / 64) * 2; ub += gridDim.x) unit_asel_blk(p, ub, (AselLds*)smem_raw);
    for (;;) { __syncthreads(); if (threadIdx.x == 0) xbst[2] = atomicAdd(&p.bar[40 + layer], 1u); __syncthreads(); const int ub = (int)xbst[2]; if (ub >= nc * 8) break; unit_bout_blk(p, layer, ub, smem_raw); }
    GSYNC();
    TMARK(8)
    for (int tl = bid0(); tl < (S / 128) * 8; tl += gridDim.x) { int mt = tl % (S / 128), nt = tl / (S / 128); gemm_tile<1>(p, p.mix, NMIX, p.wt_out, NMIX, NMIX, mt * 128, nt * 128, gsm); }
#ifdef REP_P8
    for (int tl = bid0(); tl < (S / 128) * 8; tl += gridDim.x) { int mt = tl % (S / 128), nt = tl / (S / 128); gemm_tile<1>(p, p.mix, NMIX, p.wt_out, NMIX, NMIX, mt * 128, nt * 128, gsm); }
#endif
    GSYNC();
    TMARK(9)
  }
  for (int t = gw0(gwave); t < S; t += nwave) { int lane = threadIdx.x & 63; asm volatile("" : "+v"(lane)); norm_row_wave(p, DEPTH, t, false, lane); }
#ifdef TSEL
  GSYNC();
  { float us = 0.f; for (int k = 1; k < 10; ++k) if ((TSEL >> k) & 1) us += (float)((unsigned long long*)p.bar)[k] * 0.01f;
    const float kk = 2.f * log2f(us + 1.f);
    GS((long)S * 1024, p.out[gid] = kk); }
#endif
}
#else
__device__ __forceinline__ void chk_update(unsigned* slot, float diff, float ref) {
  atomicMax(&slot[0], __float_as_uint(fabsf(diff))); atomicMax(&slot[1], __float_as_uint(fabsf(ref)));
}
#define CMPB(slot, a, b_) chk_update(sl + (slot), bf2f(a) - bf2f(b_), bf2f(b_))
#define CMPF(slot, a, b_) chk_update(sl + (slot), (a) - (b_), (b_))
__global__ void __launch_bounds__(256, 1) mega(KArgs ka) {
  KERNEL_PROLOGUE
  if (gtid < 64) p.bar[gtid] = 0u;
  unsigned* sl = p.bar;
  const int layer = 0;
  PHASE_P1(layer)
  grid.sync();
  PHASE_P2()
  GSYNC();
  GS((long)S * NMIX, p2.mix[gid] = p.mix[gid]);
  GSYNC();
  PHASE_FLASH3(layer)
  WU(2 * (ncmp * 2 / 32), unit_cmp(p, layer, u, lane));
  GS((long)S * 128, item_bconv(p, layer, gid));
  WU(nc * 8, unit_bdt(p, layer, u, lane));
  GS((long)2 * ncmp * 256, ph_cmp_hid(p2, layer, gid));
  GS((long)S * 8, ph_a_win(p2, gid));
  GS((long)S * 8, ph_c(p2, layer, gid));
  GS((long)3 * S * 8, ph_d(p2, gid));
  GS((long)S * 4, ph_m(p2, layer, gid));
  GS((long)S * 1024, ph_b_conv(p2, layer, gid));
  GS((long)nc * 8, ph_b_dt2(p2, layer, gid));
  GSYNC();
  GS((long)2 * ncmp * 128, ph_cmp_out(p2, layer, gid));
  GSYNC();
  GS((long)2 * ncmp * 128, CMPB(20, p.kvc[gid], p2.kvc[gid]));
  GS((long)S * 1024, CMPB(22, p.xconv[gid], p2.xconv[gid]));
  GS((long)S * 8, { CMPF(24, p.dt[gid], p2.dt[gid]); CMPF(24, p.acs[gid], p2.acs[gid]); CMPF(24, p.wst[gid], p2.wst[gid]); });
  GSYNC();
  GS((long)2 * ncmp * 128, p2.kvc[gid] = p.kvc[gid]);
  GS((long)S * 1024, p2.xconv[gid] = p.xconv[gid]);
  GS((long)S * 8, { p2.dt[gid] = p.dt[gid]; p2.acs[gid] = p.acs[gid]; p2.wst[gid] = p.wst[gid]; });
  GSYNC();
  WU(nqt * 8, unit_acmp1(p, u, WL, lane));
  __syncthreads();
  PHASE_CB()
  __syncthreads();
  WU2(nc * 16, unit_bstates(p, u, WL2, lane));
  GS((long)S * 8, ph_a_cmp1(p2, gid));
  GS((long)nc * 2 * 128 * 128, ph_b_cb(p2, gid));
  GS((long)nc * 65536, ph_b_states(p2, gid));
  GSYNC();
  WU(nqt * 8, unit_acmp2(p, u, lane));
  GS((long)S * 2, ph_a_cmp2(p2, gid));
  GS((long)nc * 65536, CMPF(26, p.states[gid], p2.states[gid]));
  GS((long)nc * 2 * 128 * 128, { int s_ = (int)(gid & 127), l_ = (int)((gid >> 7) & 127); if (s_ <= l_) CMPF(18, p.cb[gid], p2.cb[gid]); });
  GSYNC();
  GS(65536, ph_b_scan(p, gid));
  GS(65536, ph_b_scan(p2, gid));
  GS((long)S * 512, { CMPB(0, p.ow[gid], p2.ow[gid]); CMPB(2, p.oc[gid], p2.oc[gid]); long t = gid >> 9, c = gid & 511; CMPB(4, p.mix[t * NMIX + MX_C + c], p2.mix[t * NMIX + MX_C + c]);
                      if (c < 256) CMPB(6, p.mix[t * NMIX + MX_M + c], p2.mix[t * NMIX + MX_M + c]); });
  GS((long)3 * S * 512, CMPB(8, p.dop[gid], p2.dop[gid]));
  GS((long)3 * S * 8, chk_update(sl + 10, p.dlse[gid] - p2.dlse[gid], 1.f));
  GS((long)S * 2 * 256, { long qg = gid >> 8; int bb = (int)(gid & 255); int q = (int)(qg >> 1); if (bb <= (q >> 6)) CMPF(12, p.imp[gid], p2.imp[gid]); });
  GSYNC();
  GS((long)S * 512, p2.imp[gid] = p.imp[gid]);
  GSYNC();
  WU(S * 2 / 4, unit_topk4(p, u, lane));
  WU2(nc * 32, unit_bout(p, layer, u, WL2, lane));
  GS((long)S * 2, ph_a_topk(p2, gid));
  GS((long)S * 512, ph_b_out(p2, layer, gid));
  GSYNC();
  GS((long)S * 2, { int q = (int)(gid >> 1); int nv = (q >> 6) + 1; nv = nv > 16 ? 16 : nv; int bad = 0;
    for (int k = 0; k < 16; ++k) { int mine = p.idx[gid * 16 + k]; bool found = false; for (int k2 = 0; k2 < 16; ++k2) found |= (p2.idx[gid * 16 + k2] == mine); if (k < nv) bad += !found || mine < 0; else bad += (mine >= 0); }
    chk_update(sl + 14, (float)bad, 1.f); });
  GS((long)S * 512, CMPF(28, p.ybuf[gid], p2.ybuf[gid]));
  GSYNC();
  GS((long)S * 32, p2.idx[gid] = p.idx[gid]);
  GS((long)S * 512, p2.ybuf[gid] = p.ybuf[gid]);
  GSYNC();
  for (int ub = bid0(); ub < (S / 64) * 2; ub += gridDim.x) unit_asel_blk(p, ub, (AselLds*)smem_raw);
  for (;;) { __syncthreads(); if (threadIdx.x == 0) xbst[2] = atomicAdd(&p.bar[40 + layer], 1u); __syncthreads(); const int ub = (int)xbst[2]; if (ub >= nc * 8) break; unit_bout_blk(p, layer, ub, smem_raw); }
  GS((long)S * 8, ph_a_sel(p2, gid));
  GS((long)S * 2, ph_b_norm(p2, layer, gid));
  GSYNC();
  GS((long)S * 512, { long t = gid >> 9, c = gid & 511; CMPB(16, p.mix[t * NMIX + MX_A + c], p2.mix[t * NMIX + MX_A + c]); CMPB(30, p.mix[t * NMIX + MX_B + c], p2.mix[t * NMIX + MX_B + c]); });
  GSYNC();
  { float R = 0.f;
    for (int k = 0; k < 16; ++k) { float d = __uint_as_float(p.bar[2 * k]), r = __uint_as_float(p.bar[2 * k + 1]); float q = d / (r + 1e-20f); if (CHKSEL < 0 || CHKSEL == k) R = fmaxf(R, q); }
    GS((long)SEQ * 1024, p.out[gid] = 1e4f * R); }
}
#endif

__global__ void zz_tail_pad(float* o) { asm volatile(".rept 512\n\ts_nop 0\n\t.endr" ::: "memory"); if (o) o[0] = 0.f; }
__global__ void fill_code(float* o, float v, long n) { long i = blockIdx.x * 256L + threadIdx.x; if (i < n) o[i] = v; }
extern "C" void kernel_launch(void* const* d_in, const int* in_sizes, int n_in, void* d_out, int out_size, void* d_ws, size_t ws_size, hipStream_t stream) {
  KArgs ka; memset(&ka, 0, sizeof(ka));
  for (int i = 0; i < 20; ++i) ka.in[i] = d_in[i];
  ka.out = (float*)d_out; ka.ws = (char*)d_ws;
  Params hp, hp2; memset(&hp, 0, sizeof(hp)); const size_t need = fill_ws(hp, hp2, (char*)d_ws);
  if (need > ws_size) { fprintf(stderr, "workspace too small: need %zu have %zu\n", need, ws_size); return; }
  static int grid_blocks = 0;
  if (!grid_blocks) { int dev = 0, cus = 0, per_cu = 0; (void)hipGetDevice(&dev); (void)hipDeviceGetAttribute(&cus, hipDeviceAttributeMultiprocessorCount, dev);
    (void)hipOccupancyMaxActiveBlocksPerMultiprocessor(&per_cu, mega, 256, 0); if (per_cu > LB2) per_cu = LB2; if (per_cu < 1) per_cu = 1; grid_blocks = cus * per_cu; }
  (void)hipMemsetAsync(hp.bar, 0, 16384, stream);
  void* args[] = {&ka};
  hipError_t e = hipLaunchCooperativeKernel((void*)mega, dim3(grid_blocks), dim3(256), args, 0, stream);
  if (e != hipSuccess) { (void)hipGetLastError(); fill_code<<<(unsigned)(((long)SEQ * 1024 + 255) / 256), 256, 0, stream>>>((float*)d_out, 1000.f * (float)(int)e + (float)grid_blocks, (long)SEQ * 1024); }
}
```

```cpp
#include <hip/hip_runtime.h>
#include <hip/hip_cooperative_groups.h>
#include <cstdio>
#include <cstdint>
#include <cstring>
namespace cg = cooperative_groups;
#define HD_ __device__ __forceinline__
#ifndef CHKSEL
#define CHKSEL -1
#endif
#ifndef LB2
#define LB2 2
#endif
#ifndef HD_
#define HD_ inline
#endif
#ifdef SB_IS_FLOAT
typedef float SB;
HD_ float ldf(const SB* p) { return *p; }
HD_ void stf(SB* p, float v) { *p = v; }
#else
typedef unsigned short SB;
HD_ float bf2f(unsigned short b) { unsigned u = ((unsigned)b) << 16; float f; __builtin_memcpy(&f, &u, 4); return f; }
HD_ unsigned short f2bf(float f) { unsigned u; __builtin_memcpy(&u, &f, 4); u += 0x7fffu + ((u >> 16) & 1u); return (unsigned short)(u >> 16); }
HD_ float ldf(const SB* p) { return bf2f(*p); }
HD_ void stf(SB* p, float v) { *p = f2bf(v); }
#endif

#define DM 1024
#define NPROJ 5888
#define NMIX 2304
#define NSMALL 32
#define PA_Q 0
#define PA_KV 512
#define PB_X 1280
#define PC_Q 2304
#define PC_KV 2816
#define PD_Q 3072
#define PD_KV 4608
#define PM_Q 5632
#define MX_A 0
#define MX_B 512
#define MX_C 1024
#define MX_D 1536
#define MX_M 2048
#define TABA_N 2048
#define TABD_N 132

struct Params {
  int S; int pad0;
  const float *x, *mem; const int* pos;
  const float *pre_norm, *post_norm, *w_in, *w_out, *rel_bias, *cmp_pos, *cmp_w1, *cmp_w2, *conv_w, *conv_b, *dt_bias, *a_log, *b_d,
      *b_norm, *sinks, *m_norm, *m_wkv;
  float* out;
  unsigned short* wt_in;
  unsigned short* wt_out;
  unsigned short *w1t, *w2t;
  SB* h;
  SB* proj;
  float* small;
  SB* mix;
  float* y;
  float *rope_cs, *rope_sn;
  float *tabA, *tabD;
  SB* memkv;
  float* hid;
  SB* kvc;
  float* imp;
  float* cml;
  int* idx;
  SB *oc, *ow;
  SB* dop;
  float* dlse;
  SB* xconv;
  float *dt, *acs;
  float* wst;
  float* cb;
  float* states;
  float* ybuf;
  unsigned* bar;
};

HD_ float silu_f(float x) { return x / (1.f + expf(-x)); }
HD_ float sigmoid_f(float x) { return 1.f / (1.f + expf(-x)); }
HD_ float gelu_f(float x) { return 0.5f * x * (1.f + tanhf(0.7978845608028654f * (x + 0.044715f * x * x * x))); }
HD_ float softplus_f(float x) { return fmaxf(x, 0.f) + log1pf(expf(-fabsf(x))); }

HD_ int t5_bucket(int d) {
  if (d < 16) return d < 0 ? 0 : d;
  const int thr[15] = {22, 30, 40, 54, 73, 99, 134, 182, 246, 332, 450, 609, 825, 1117, 1513};
  int b = 16;
  for (int k = 0; k < 15; ++k) b += (d >= thr[k]) ? 1 : 0;
  return b;
}

HD_ void ph_rope(const Params& p, long gid) {
  int s = (int)(gid >> 5), i = (int)(gid & 31);
  float inv = powf(150000.f, -(float)i / 32.f);
  float ang = (float)p.pos[s] * inv;
  p.rope_cs[gid] = cosf(ang); p.rope_sn[gid] = sinf(ang);
}
HD_ void ph_tabs(const Params& p, long gid) {
  if (gid < 8 * TABA_N) { int h = (int)(gid / TABA_N), d = (int)(gid % TABA_N); p.tabA[gid] = p.rel_bias[t5_bucket(d) * 32 + h]; }
  else { long g2 = gid - 8 * TABA_N; int hh = (int)(g2 / TABD_N), d = (int)(g2 % TABD_N); int gi = hh >> 3;
    int dil = gi == 0 ? 1 : (gi == 1 ? 4 : 16); p.tabD[g2] = p.rel_bias[t5_bucket(d * dil) * 32 + 8 + hh]; }
}
HD_ void ph_memkv(const Params& p, long gid) {
  int e = (int)(gid & 511), m = (int)((gid >> 9) & 255), l = (int)(gid >> 17);
  const float* row = p.mem + (long)m * DM;
  float ss = 0.f; _Pragma("unroll 16") for (int d = 0; d < DM; ++d) ss += row[d] * row[d];
  float r = 1.f / sqrtf(ss / DM + 1e-6f);
  float acc = 0.f;
  _Pragma("unroll 16") for (int d = 0; d < DM; ++d) acc += row[d] * r * p.m_norm[l * DM + d] * p.m_wkv[((long)l * DM + d) * 512 + e];
  stf(&p.memkv[gid], acc);
}
HD_ void ph_norm_row(const Params& p, int layer, int t, bool do_h) {
  const float* xin = (layer == 0) ? p.x + (long)t * DM : p.out + (long)t * DM;
  float* xo = p.out + (long)t * DM;
  float r1 = 0.f;
  if (layer > 0) { const float* y = p.y + (long)t * DM; float ss = 0.f; for (int d = 0; d < DM; ++d) ss += y[d] * y[d]; r1 = 1.f / sqrtf(ss / DM + 1e-6f); }
  float ss2 = 0.f;
  for (int d = 0; d < DM; ++d) { float v = xin[d]; if (layer > 0) v += p.y[(long)t * DM + d] * r1 * p.post_norm[(layer - 1) * DM + d]; xo[d] = v; ss2 += v * v; }
  if (!do_h) return;
  float r2 = 1.f / sqrtf(ss2 / DM + 1e-6f);
  for (int d = 0; d < DM; ++d) stf(&p.h[(long)t * DM + d], xo[d] * r2 * p.pre_norm[layer * DM + d]);
}

HD_ void ph_cmp_hid(const Params& p, int layer, long gid) {
  int u = (int)(gid & 127), hk = (int)((gid >> 7) & 1); long r = gid >> 8; int ncmp = p.S / 16; int j = (int)(r % ncmp), kv = (int)(r / ncmp);
  const float* w1 = p.cmp_w1 + ((long)(layer * 2 + kv) * 2048) * 128;
  const float* pe = p.cmp_pos + (long)(layer * 2 + kv) * 32 * 64;
  float acc = 0.f;
  for (int t = 0; t < 32; ++t) { int tok = 16 * j + t;
    _Pragma("unroll 16") for (int d = 0; d < 64; ++d) { float v = pe[t * 64 + d]; if (tok < p.S) v += ldf(&p.proj[(long)tok * NPROJ + PA_KV + kv * 128 + hk * 64 + d]);
      acc += v * w1[(long)(t * 64 + d) * 128 + u]; } }
  p.hid[gid] = gelu_f(acc);
}
HD_ void ph_cmp_out(const Params& p, int layer, long gid) {
  int d = (int)(gid & 63), hk = (int)((gid >> 6) & 1); long r = gid >> 7; int ncmp = p.S / 16; int j = (int)(r % ncmp), kv = (int)(r / ncmp);
  const float* w2 = p.cmp_w2 + (long)(layer * 2 + kv) * 128 * 64;
  const float* hd = p.hid + (((long)kv * ncmp + j) * 2 + hk) * 128;
  float acc = 0.f; for (int u = 0; u < 128; ++u) acc += hd[u] * w2[u * 64 + d];
  stf(&p.kvc[gid], acc);
}
HD_ void ph_a_cmp1(const Params& p, long gid) {
  int h = (int)(gid & 7), q = (int)(gid >> 3), g = h >> 2; int ncmp = p.S / 16;
  int jn = (q >= 31) ? ((q - 31) / 16 + 1) : 0;
  const SB* kc = p.kvc; const SB* vc = p.kvc + (long)ncmp * 128;
  float qv[64], o[64]; for (int d = 0; d < 64; ++d) { qv[d] = ldf(&p.proj[(long)q * NPROJ + PA_Q + h * 64 + d]); o[d] = 0.f; }
  float m = -1e30f, l = 0.f;
  for (int j = 0; j < jn; ++j) { const SB* kr = &kc[((long)j * 2 + g) * 64]; const SB* vr = &vc[((long)j * 2 + g) * 64];
    float s = 0.f; for (int d = 0; d < 64; ++d) s += qv[d] * ldf(&kr[d]);
    int dist = q - (16 * j + 31); s = s * 0.125f + p.tabA[h * TABA_N + (dist < TABA_N ? dist : TABA_N - 1)];
    float mn = fmaxf(m, s), a = expf(m - mn), pr = expf(s - mn); l = l * a + pr; for (int d = 0; d < 64; ++d) o[d] = o[d] * a + pr * ldf(&vr[d]); m = mn; }
  float il = jn > 0 ? 1.f / l : 0.f; for (int d = 0; d < 64; ++d) stf(&p.oc[(long)q * 512 + h * 64 + d], o[d] * il);
  p.cml[gid * 2] = m; p.cml[gid * 2 + 1] = il;
}
HD_ void ph_a_cmp2(const Params& p, long gid) {
  int g = (int)(gid & 1), q = (int)(gid >> 1); int ncmp = p.S / 16;
  float* imp = p.imp + gid * 256; for (int b = 0; b < 256; ++b) imp[b] = 0.f;
  int jn = (q >= 31) ? ((q - 31) / 16 + 1) : 0; const SB* kc = p.kvc;
  for (int hh = 0; hh < 4; ++hh) { int h = g * 4 + hh; float qv[64]; for (int d = 0; d < 64; ++d) qv[d] = ldf(&p.proj[(long)q * NPROJ + PA_Q + h * 64 + d]);
    float m = p.cml[((long)q * 8 + h) * 2], il = p.cml[((long)q * 8 + h) * 2 + 1];
    for (int j = 0; j < jn; ++j) { const SB* kr = &kc[((long)j * 2 + g) * 64]; float s = 0.f; for (int d = 0; d < 64; ++d) s += qv[d] * ldf(&kr[d]);
      int dist = q - (16 * j + 31); s = s * 0.125f + p.tabA[h * TABA_N + (dist < TABA_N ? dist : TABA_N - 1)]; float pr = expf(s - m) * il;
      imp[j >> 2] += pr; if (j + 1 < ncmp) imp[(j + 1) >> 2] += pr; } }
}
HD_ void ph_a_topk(const Params& p, long gid) {
  int q = (int)(gid >> 1); float* imp = p.imp + gid * 256; int* idx = p.idx + gid * 16; int cur = q >> 6;
  imp[0] = 1e4f; imp[cur] = 1e4f;
  for (int k = 0; k < 16; ++k) { int best = -1; float bv = -1.f;
    for (int b = 0; b <= cur; ++b) { float v = imp[b]; if (v > bv) { bv = v; best = b; } }
    idx[k] = best; if (best >= 0) imp[best] = -2.f; }
}
HD_ void ph_a_win(const Params& p, long gid) {
  int h = (int)(gid & 7), q = (int)(gid >> 3), hk = h >> 2;
  float qv[64], o[64]; for (int d = 0; d < 64; ++d) { qv[d] = ldf(&p.proj[(long)q * NPROJ + PA_Q + h * 64 + d]); o[d] = 0.f; }
  float m = -1e30f, l = 0.f; int lo = q - 511 < 0 ? 0 : q - 511;
  for (int t = lo; t <= q; ++t) { const SB* kr = &p.proj[(long)t * NPROJ + PA_KV + 4 * 128 + hk * 64]; const SB* vr = kr + 128;
    float s = 0.f; for (int d = 0; d < 64; ++d) s += qv[d] * ldf(&kr[d]); s = s * 0.125f + p.tabA[h * TABA_N + (q - t)];
    float mn = fmaxf(m, s), a = expf(m - mn), pr = expf(s - mn); l = l * a + pr; for (int d = 0; d < 64; ++d) o[d] = o[d] * a + pr * ldf(&vr[d]); m = mn; }
  float il = 1.f / l; for (int d = 0; d < 64; ++d) stf(&p.ow[(long)q * 512 + h * 64 + d], o[d] * il);
}
HD_ void ph_a_sel(const Params& p, long gid) {
  int h = (int)(gid & 7), q = (int)(gid >> 3), hk = h >> 2; const int* idx = p.idx + ((long)q * 2 + hk) * 16;
  float qv[64], o[64]; for (int d = 0; d < 64; ++d) { qv[d] = ldf(&p.proj[(long)q * NPROJ + PA_Q + h * 64 + d]); o[d] = 0.f; }
  float m = -1e30f, l = 0.f;
  for (int k = 0; k < 16; ++k) { int b = idx[k]; if (b < 0) continue;
    for (int i = 0; i < 64; ++i) { int t = b * 64 + i; if (t > q) break;
      const SB* kr = &p.proj[(long)t * NPROJ + PA_KV + 2 * 128 + hk * 64]; const SB* vr = kr + 128;
      float s = 0.f; for (int d = 0; d < 64; ++d) s += qv[d] * ldf(&kr[d]); int dist = q - t; s = s * 0.125f + p.tabA[h * TABA_N + (dist < TABA_N ? dist : TABA_N - 1)];
      float mn = fmaxf(m, s), a = expf(m - mn), pr = expf(s - mn); l = l * a + pr; for (int d = 0; d < 64; ++d) o[d] = o[d] * a + pr * ldf(&vr[d]); m = mn; } }
  float il = 1.f / l; const float* gl = p.small + (long)q * NSMALL + h * 3;
  float g0 = sigmoid_f(gl[0]), g1 = sigmoid_f(gl[1]), g2 = sigmoid_f(gl[2]);
  for (int d = 0; d < 64; ++d) { long c = (long)q * 512 + h * 64 + d; float a = g0 * ldf(&p.oc[c]) + g1 * o[d] * il + g2 * ldf(&p.ow[c]);
    SB* mp = &p.mix[(long)q * NMIX + MX_A + h * 64 + d]; stf(mp, a * ldf(mp)); }
}
HD_ void ph_c(const Params& p, int layer, long gid) {
  int h = (int)(gid & 7), q = (int)(gid >> 3), hk = h >> 2;
  float qv[64], o[64]; for (int d = 0; d < 64; ++d) { qv[d] = ldf(&p.proj[(long)q * NPROJ + PC_Q + h * 64 + d]); o[d] = 0.f; }
  float m = p.sinks[layer * 8 + h], l = 1.f; int lo = q - 127 < 0 ? 0 : q - 127;
  for (int t = lo; t <= q; ++t) { const SB* kr = &p.proj[(long)t * NPROJ + PC_KV + hk * 64]; const SB* vr = kr + 128;
    float s = 0.f; for (int d = 0; d < 64; ++d) s += qv[d] * ldf(&kr[d]); s *= 0.125f;
    float mn = fmaxf(m, s), a = expf(m - mn), pr = expf(s - mn); l = l * a + pr; for (int d = 0; d < 64; ++d) o[d] = o[d] * a + pr * ldf(&vr[d]); m = mn; }
  float il = 1.f / l; for (int d = 0; d < 64; ++d) { SB* mp = &p.mix[(long)q * NMIX + MX_C + h * 64 + d]; stf(mp, o[d] * il * ldf(mp)); }
}
HD_ void ph_d(const Params& p, long gid) {
  int h = (int)(gid & 7); long r = gid >> 3; int q = (int)(r % p.S), gi = (int)(r / p.S); int dil = gi == 0 ? 1 : (gi == 1 ? 4 : 16);
  float qv[64], o[64]; for (int d = 0; d < 64; ++d) { qv[d] = ldf(&p.proj[(long)q * NPROJ + PD_Q + gi * 512 + h * 64 + d]); o[d] = 0.f; }
  float m = -1e30f, l = 0.f;
  for (int dd = 0; dd <= 128; ++dd) { int t = q - dil * dd; if (t < 0) break;
    const SB* kr = &p.proj[(long)t * NPROJ + PD_KV + h * 64]; const SB* vr = kr + 512;
    float s = 0.f; for (int d = 0; d < 64; ++d) s += qv[d] * ldf(&kr[d]); s = s * 0.125f + p.tabD[(gi * 8 + h) * TABD_N + dd];
    float mn = fmaxf(m, s), a = expf(m - mn), pr = expf(s - mn); l = l * a + pr; for (int d = 0; d < 64; ++d) o[d] = o[d] * a + pr * ldf(&vr[d]); m = mn; }
  float il = 1.f / l; for (int d = 0; d < 64; ++d) stf(&p.dop[((long)gi * p.S + q) * 512 + h * 64 + d], o[d] * il);
  p.dlse[((long)gi * p.S + q) * 8 + h] = m + logf(l);
}
HD_ void ph_d_merge(const Params& p, long gid) {
  int h = (int)(gid & 7), q = (int)(gid >> 3);
  float l0 = p.dlse[((long)0 * p.S + q) * 8 + h], l1 = p.dlse[((long)1 * p.S + q) * 8 + h], l2 = p.dlse[((long)2 * p.S + q) * 8 + h];
  float mm = fmaxf(l0, fmaxf(l1, l2)); float e0 = expf(l0 - mm), e1 = expf(l1 - mm), e2 = expf(l2 - mm), is = 1.f / (e0 + e1 + e2);
  for (int d = 0; d < 64; ++d) { long c = (long)q * 512 + h * 64 + d;
    float v = (e0 * ldf(&p.dop[c]) + e1 * ldf(&p.dop[(long)p.S * 512 + c]) + e2 * ldf(&p.dop[(long)2 * p.S * 512 + c])) * is;
    SB* mp = &p.mix[(long)q * NMIX + MX_D + h * 64 + d]; stf(mp, v * ldf(mp)); }
}
HD_ void ph_m(const Params& p, int layer, long gid) {
  int h = (int)(gid & 3), q = (int)(gid >> 2);
  float qv[64], o[64]; for (int d = 0; d < 64; ++d) { qv[d] = ldf(&p.proj[(long)q * NPROJ + PM_Q + h * 64 + d]); o[d] = 0.f; }
  float m = -1e30f, l = 0.f; const SB* kvb = p.memkv + (long)layer * 256 * 512;
  for (int t = 0; t < 256; ++t) { const SB* kr = kvb + (long)t * 512 + h * 64; const SB* vr = kr + 256;
    float s = 0.f; for (int d = 0; d < 64; ++d) s += qv[d] * ldf(&kr[d]); s *= 0.125f;
    float mn = fmaxf(m, s), a = expf(m - mn), pr = expf(s - mn); l = l * a + pr; for (int d = 0; d < 64; ++d) o[d] = o[d] * a + pr * ldf(&vr[d]); m = mn; }
  float il = 1.f / l; for (int d = 0; d < 64; ++d) { SB* mp = &p.mix[(long)q * NMIX + MX_M + h * 64 + d]; stf(mp, o[d] * il * ldf(mp)); }
}
HD_ void ph_b_conv(const Params& p, int layer, long gid) {
  int c = (int)(gid & 1023), t = (int)(gid >> 10); const float* w = p.conv_w + (long)layer * 4 * 1024;
  float acc = p.conv_b[layer * 1024 + c];
  for (int i = 0; i < 4; ++i) { int tt = t - 3 + i; if (tt >= 0) acc += w[i * 1024 + c] * ldf(&p.proj[(long)tt * NPROJ + PB_X + c]); }
  stf(&p.xconv[gid], silu_f(acc));
}
HD_ void ph_b_dt(const Params& p, int layer, long gid) {
  int hd = (int)(gid & 7), c = (int)(gid >> 3); float a = -expf(p.a_log[layer * 8 + hd]); float cs = 0.f;
  for (int l = 0; l < 128; ++l) { int t = c * 128 + l; float dt = softplus_f(p.small[(long)t * NSMALL + 24 + hd] + p.dt_bias[layer * 8 + hd]);
    cs += dt * a; p.dt[(long)t * 8 + hd] = dt; p.acs[(long)t * 8 + hd] = cs; }
}
HD_ void ph_b_cb(const Params& p, long gid) {
  int s = (int)(gid & 127), l = (int)((gid >> 7) & 127), g = (int)((gid >> 14) & 1), c = (int)(gid >> 15);
  if (s > l) { p.cb[gid] = 0.f; return; }
  const SB* cm = &p.xconv[(long)(c * 128 + l) * 1024 + 768 + g * 128]; const SB* bm = &p.xconv[(long)(c * 128 + s) * 1024 + 512 + g * 128];
  float acc = 0.f; for (int n = 0; n < 128; ++n) acc += ldf(&cm[n]) * ldf(&bm[n]);
  p.cb[gid] = acc;
}
HD_ void ph_b_states(const Params& p, long gid) {
  int n = (int)(gid & 127), pp = (int)((gid >> 7) & 63), hd = (int)((gid >> 13) & 7), c = (int)(gid >> 16), g = hd >> 2;
  float last = p.acs[(long)(c * 128 + 127) * 8 + hd]; float acc = 0.f;
  for (int l = 0; l < 128; ++l) { long t = c * 128 + l;
    acc += ldf(&p.xconv[t * 1024 + 512 + g * 128 + n]) * expf(last - p.acs[t * 8 + hd]) * ldf(&p.xconv[t * 1024 + hd * 64 + pp]) * p.dt[t * 8 + hd]; }
  p.states[gid] = acc;
}
HD_ void ph_b_scan(const Params& p, long gid) {
  int hd = (int)(gid >> 13); int nc = p.S / 128; float h = 0.f;
  for (int c0 = 0; c0 < nc; c0 += 8) { float st[8], dc[8];
    for (int i = 0; i < 8; ++i) { st[i] = p.states[(long)(c0 + i) * 65536 + gid]; dc[i] = p.acs[(long)((c0 + i) * 128 + 127) * 8 + hd]; }
    for (int i = 0; i < 8; ++i) { p.states[(long)(c0 + i) * 65536 + gid] = h; h = h * expf(dc[i]) + st[i]; } }
}
HD_ void ph_b_out(const Params& p, int layer, long gid) {
  int pp = (int)(gid & 63), hd = (int)((gid >> 6) & 7), t = (int)(gid >> 9), g = hd >> 2, c = t >> 7, l = t & 127;
  float al = p.acs[(long)t * 8 + hd]; float acc = 0.f;
  const float* cbr = &p.cb[(((long)c * 2 + g) * 128 + l) * 128];
  for (int s = 0; s <= l; ++s) { long ts = c * 128 + s; acc += cbr[s] * expf(al - p.acs[ts * 8 + hd]) * ldf(&p.xconv[ts * 1024 + hd * 64 + pp]) * p.dt[ts * 8 + hd]; }
  float acc2 = 0.f; const float* pr = &p.states[(long)c * 65536 + ((long)hd * 64 + pp) * 128]; const SB* cm = &p.xconv[(long)t * 1024 + 768 + g * 128];
  for (int n = 0; n < 128; ++n) acc2 += ldf(&cm[n]) * pr[n];
  p.ybuf[gid] = acc + expf(al) * acc2 + ldf(&p.xconv[(long)t * 1024 + hd * 64 + pp]) * p.b_d[layer * 8 + hd];
}
HD_ void ph_b_norm(const Params& p, int layer, long gid) {
  int g = (int)(gid & 1), t = (int)(gid >> 1); float ss = 0.f;
  for (int i = 0; i < 256; ++i) { float v = p.ybuf[(long)t * 512 + g * 256 + i] * ldf(&p.mix[(long)t * NMIX + MX_B + g * 256 + i]); ss += v * v; }
  float r = 1.f / sqrtf(ss / 256.f + 1e-6f);
  for (int i = 0; i < 256; ++i) { SB* mp = &p.mix[(long)t * NMIX + MX_B + g * 256 + i]; float v = p.ybuf[(long)t * 512 + g * 256 + i] * ldf(mp);
    stf(mp, v * r * p.b_norm[layer * 512 + g * 256 + i]); }
}

HD_ void ph_b_dt2(const Params& p, int layer, long gid) {
  int hd = (int)(gid & 7), c = (int)(gid >> 3); float a = -expf(p.a_log[layer * 8 + hd]); float cs = 0.f;
  for (int l = 0; l < 128; ++l) { int t = c * 128 + l; float dt = softplus_f(p.small[(long)t * NSMALL + 24 + hd] + p.dt_bias[layer * 8 + hd]);
    cs += dt * a; p.dt[(long)t * 8 + hd] = dt; p.acs[(long)t * 8 + hd] = cs; }
  for (int l = 0; l < 128; ++l) { long t = c * 128 + l; p.wst[t * 8 + hd] = p.dt[t * 8 + hd] * expf(cs - p.acs[t * 8 + hd]); }
}
HD_ void ph_b_states2(const Params& p, long gid) {
  int pp = (int)(gid & 63), n = (int)((gid >> 6) & 127), hd = (int)((gid >> 13) & 7), c = (int)(gid >> 16), g = hd >> 2;
  float acc = 0.f;
  _Pragma("unroll 16") for (int l = 0; l < 128; ++l) { long t = c * 128 + l; acc += ldf(&p.xconv[t * 1024 + 512 + g * 128 + n]) * p.wst[t * 8 + hd] * ldf(&p.xconv[t * 1024 + hd * 64 + pp]); }
  p.states[gid] = acc;
}
HD_ void ph_b_out2(const Params& p, int layer, long gid) {
  int pp = (int)(gid & 63), hd = (int)((gid >> 6) & 7), t = (int)(gid >> 9), g = hd >> 2, c = t >> 7, l = t & 127;
  float al = p.acs[(long)t * 8 + hd]; float acc = 0.f;
  const float* cbr = &p.cb[(((long)c * 2 + g) * 128 + l) * 128];
  _Pragma("unroll 8") for (int s = 0; s <= l; ++s) { long ts = c * 128 + s; acc += cbr[s] * expf(al - p.acs[ts * 8 + hd]) * p.dt[ts * 8 + hd] * ldf(&p.xconv[ts * 1024 + hd * 64 + pp]); }
  float acc2 = 0.f; const float* pr = &p.states[(long)c * 65536 + (long)hd * 8192 + pp]; const SB* cm = &p.xconv[(long)t * 1024 + 768 + g * 128];
  _Pragma("unroll 16") for (int n = 0; n < 128; ++n) acc2 += ldf(&cm[n]) * pr[n * 64];
  p.ybuf[gid] = acc + expf(al) * acc2 + ldf(&p.xconv[(long)t * 1024 + hd * 64 + pp]) * p.b_d[layer * 8 + hd];
}

typedef __attribute__((ext_vector_type(8))) short bf16x8;
typedef __attribute__((ext_vector_type(16))) float f32x16;
typedef short v4i16_t __attribute__((ext_vector_type(4)));
typedef __bf16 bf2_t __attribute__((ext_vector_type(2)));
typedef float f2_t __attribute__((ext_vector_type(2)));
typedef unsigned u32x4 __attribute__((ext_vector_type(4)));
#define LDS3 __attribute__((address_space(3)))
typedef __attribute__((address_space(1))) const void* gptr_t;
typedef __attribute__((address_space(3))) void* lptr_t;
#define L2E 1.4426950408889634f
#define LN2 0.6931471805599453f
#define QSC (0.125f * L2E)
#ifndef FTHR
#define FTHR 8.0f
#endif
#define NINF (-__builtin_huge_valf())

struct WaveLds { unsigned short v[4096]; float tab[640]; float xch[32]; float pad[32]; };

__device__ __forceinline__ unsigned pk2(float a, float b) { f2_t v = {a, b}; bf2_t r = __builtin_convertvector(v, bf2_t); return __builtin_bit_cast(unsigned, r); }
__device__ __forceinline__ int crow(int e, int hi) { return (e & 3) + 8 * (e >> 2) + 4 * hi; }
__device__ __forceinline__ bf16x8 pack8(const f32x16& s, int o) {
  u32x4 r; r[0] = pk2(s[o], s[o + 1]); r[1] = pk2(s[o + 2], s[o + 3]); r[2] = pk2(s[o + 4], s[o + 5]); r[3] = pk2(s[o + 6], s[o + 7]); return __builtin_bit_cast(bf16x8, r); }
__device__ __forceinline__ f32x16 zero16() { f32x16 z;
#pragma unroll
  for (int e = 0; e < 16; ++e) z[e] = 0.f; return z; }
#define MFMA32(a, b, c) __builtin_amdgcn_mfma_f32_32x32x16_bf16((a), (b), (c), 0, 0, 0)

struct FlashState { f32x16 o0, o1; float m, l; };
__device__ __forceinline__ float wave_sum_f(float v) {
#pragma unroll
  for (int o = 32; o > 0; o >>= 1) v += __shfl_xor(v, o);
  return v; }

template <class VRow, class Fix>
__device__ __forceinline__ void flash_tile(FlashState& st, const bf16x8 (&qf)[4], const SB* kp, VRow vrow, Fix fix, WaveLds* L, int lane) {
  const int r32 = lane & 31, hi = lane >> 5;
  bf16x8 kf[4];
#pragma unroll
  for (int d0 = 0; d0 < 4; ++d0) kf[d0] = *(const bf16x8*)(kp + d0 * 16 + hi * 8);
#pragma unroll
  for (int i = 0; i < 4; ++i) { const int c = lane + 64 * i, key = c >> 3, ch = c & 7; const SB* vp = vrow(key); const uint4 vv = *(const uint4*)(vp + ch * 8);
    *(uint4*)&L->v[(ch >> 2) * 2048 + key * 32 + (ch & 3) * 8] = vv; }
  f32x16 s = zero16();
#pragma unroll
  for (int d0 = 0; d0 < 4; ++d0) s = MFMA32(kf[d0], qf[d0], s);
  fix(s);
  float mx = s[0];
#pragma unroll
  for (int e = 1; e < 16; ++e) mx = fmaxf(mx, s[e]);
  mx = fmaxf(mx, __shfl_xor(mx, 32));
  if (__any(mx > st.m + FTHR)) {
    const float mn = fmaxf(st.m, mx); const float al = __builtin_amdgcn_exp2f(st.m - mn); st.m = mn; st.l *= al; L->xch[r32] = al;
#pragma unroll
    for (int e = 0; e < 16; ++e) { const float a = L->xch[crow(e, hi)]; st.o0[e] *= a; st.o1[e] *= a; }
  }
  float ps = 0.f;
#pragma unroll
  for (int e = 0; e < 16; ++e) { s[e] = __builtin_amdgcn_exp2f(s[e] - st.m); ps += s[e]; }
  st.l += ps;
  const bf16x8 pa0 = pack8(s, 0), pa1 = pack8(s, 8);
  const unsigned short* vb = L->v + (4 * hi + ((lane & 15) >> 2)) * 32 + ((lane >> 4) & 1) * 16 + (lane & 3) * 4;
#pragma unroll
  for (int s2 = 0; s2 < 2; ++s2) {
#pragma unroll
    for (int db = 0; db < 2; ++db) {
      const v4i16_t lo = __builtin_amdgcn_ds_read_tr16_b64_v4i16((LDS3 v4i16_t*)(vb + db * 2048 + s2 * 512));
      const v4i16_t hh = __builtin_amdgcn_ds_read_tr16_b64_v4i16((LDS3 v4i16_t*)(vb + db * 2048 + s2 * 512 + 256));
      const bf16x8 vf = {lo[0], lo[1], lo[2], lo[3], hh[0], hh[1], hh[2], hh[3]};
      if (db == 0) st.o0 = MFMA32(s2 ? pa1 : pa0, vf, st.o0); else st.o1 = MFMA32(s2 ? pa1 : pa0, vf, st.o1);
    }
  }
}
__device__ __forceinline__ void flash_core2(FlashState& st, f32x16& s0, f32x16& s1, const unsigned short* vimg, float* xch, int lane) {
  const int r32 = lane & 31, hi = lane >> 5;
  float mx = fmaxf(s0[0], s1[0]);
#pragma unroll
  for (int e = 1; e < 16; ++e) mx = fmaxf(mx, fmaxf(s0[e], s1[e]));
  mx = fmaxf(mx, __shfl_xor(mx, 32));
  if (__any(mx > st.m + FTHR)) {
    const float mn = fmaxf(st.m, mx); const float al = __builtin_amdgcn_exp2f(st.m - mn); st.m = mn; st.l *= al; xch[r32] = al;
#pragma unroll
    for (int e = 0; e < 16; ++e) { const float a = xch[crow(e, hi)]; st.o0[e] *= a; st.o1[e] *= a; }
  }
  float ps = 0.f;
#pragma unroll
  for (int e = 0; e < 16; ++e) { s0[e] = __builtin_amdgcn_exp2f(s0[e] - st.m); s1[e] = __builtin_amdgcn_exp2f(s1[e] - st.m); ps += s0[e] + s1[e]; }
  st.l += ps;
  bf16x8 pa[4]; pa[0] = pack8(s0, 0); pa[1] = pack8(s0, 8); pa[2] = pack8(s1, 0); pa[3] = pack8(s1, 8);
  const unsigned short* vb = vimg + (4 * hi + ((lane & 15) >> 2)) * 32 + ((lane >> 4) & 1) * 16 + (lane & 3) * 4;
#pragma unroll
  for (int kk = 0; kk < 4; ++kk) {
#pragma unroll
    for (int db = 0; db < 2; ++db) {
      const v4i16_t lo = __builtin_amdgcn_ds_read_tr16_b64_v4i16((LDS3 v4i16_t*)(vb + db * 2048 + kk * 512));
      const v4i16_t hh = __builtin_amdgcn_ds_read_tr16_b64_v4i16((LDS3 v4i16_t*)(vb + db * 2048 + kk * 512 + 256));
      const bf16x8 vf = {lo[0], lo[1], lo[2], lo[3], hh[0], hh[1], hh[2], hh[3]};
      if (db == 0) st.o0 = MFMA32(pa[kk], vf, st.o0); else st.o1 = MFMA32(pa[kk], vf, st.o1);
    }
  }
}
template <class VRow, class Fix0, class Fix1>
__device__ __forceinline__ void flash_tile2(FlashState& st, const bf16x8 (&qf)[4], const SB* kp0, const SB* kp1, VRow vrow, Fix0 fix0, Fix1 fix1, WaveLds* L, int lane) {
  const int hi = lane >> 5;
  bf16x8 kf0[4], kf1[4];
#pragma unroll
  for (int d0 = 0; d0 < 4; ++d0) { kf0[d0] = *(const bf16x8*)(kp0 + d0 * 16 + hi * 8); kf1[d0] = *(const bf16x8*)(kp1 + d0 * 16 + hi * 8); }
#pragma unroll
  for (int i = 0; i < 8; ++i) { const int c = lane + 64 * i, key = c >> 3, ch = c & 7; const SB* vp = vrow(key); const uint4 vv = *(const uint4*)(vp + ch * 8);
    *(uint4*)&L->v[(ch >> 2) * 2048 + key * 32 + (ch & 3) * 8] = vv; }
  f32x16 s0 = zero16(), s1 = zero16();
#pragma unroll
  for (int d0 = 0; d0 < 4; ++d0) { s0 = MFMA32(kf0[d0], qf[d0], s0); s1 = MFMA32(kf1[d0], qf[d0], s1); }
  fix0(s0); fix1(s1);
  flash_core2(st, s0, s1, L->v, L->xch, lane);
}
__device__ __forceinline__ float flash_finish(FlashState& st, WaveLds* L, int lane) {
  const int r32 = lane & 31, hi = lane >> 5;
  const float lt = st.l + __shfl_xor(st.l, 32); const float inv = lt > 0.f ? 1.f / lt : 0.f;
  L->xch[r32] = inv;
#pragma unroll
  for (int e = 0; e < 16; ++e) { const float a = L->xch[crow(e, hi)]; st.o0[e] *= a; st.o1[e] *= a; }
  return (st.m + __builtin_amdgcn_logf(lt)) * LN2;
}
__device__ __forceinline__ void load_q(bf16x8 (&qf)[4], const SB* qp, int hi) {
#pragma unroll
  for (int d0 = 0; d0 < 4; ++d0) qf[d0] = *(const bf16x8*)(qp + d0 * 16 + hi * 8);
}
__device__ __forceinline__ void fix_tab(f32x16& s, const WaveLds* L, int base, int lane, bool chk, int kb) {
  const int r32 = lane & 31, hi = lane >> 5; const float* tp = L->tab + base + r32 + 32 - 4 * hi;
#pragma unroll
  for (int e = 0; e < 16; ++e) { const int kk = (e & 3) + 8 * (e >> 2); float v = s[e] * QSC + tp[-kk]; if (chk && (kb + kk + 4 * hi < 0)) v = NINF; s[e] = v; }
}

__device__ __forceinline__ void unit_c(const Params& p, int layer, int u, WaveLds* L, int lane) {
  const int h = u & 7, qt = u >> 3, q0 = qt * 32, hk = h >> 2, r32 = lane & 31, hi = lane >> 5;
  for (int x = lane; x < 192; x += 64) { const int dist = x - 32; L->tab[x] = (dist >= 0 && dist <= 127) ? 0.f : NINF; }
  bf16x8 qf[4]; load_q(qf, p.proj + (long)(q0 + r32) * NPROJ + PC_Q + h * 64, hi);
  FlashState st; st.o0 = zero16(); st.o1 = zero16(); st.m = p.sinks[layer * 8 + h] * L2E; st.l = hi ? 0.f : 1.f;
  const SB* kvb = p.proj + PC_KV + hk * 64; const bool chk = q0 < 128;
  for (int t = 0; t < 4; t += 2) { const int kb = q0 - 128 + 32 * t; int tok0 = kb + r32, tok1 = kb + 32 + r32; tok0 = tok0 < 0 ? 0 : tok0; tok1 = tok1 < 0 ? 0 : tok1;
    flash_tile2(st, qf, kvb + (long)tok0 * NPROJ, kvb + (long)tok1 * NPROJ, [&](int key) { int tk = kb + key; tk = tk < 0 ? 0 : tk; return kvb + 128 + (long)tk * NPROJ; },
                [&](f32x16& s) { fix_tab(s, L, 128 - 32 * t, lane, chk, kb); }, [&](f32x16& s) { fix_tab(s, L, 96 - 32 * t, lane, chk, kb + 32); }, L, lane); }
  { const int t = 4; const int kb = q0 - 128 + 32 * t; int tok = kb + r32; tok = tok < 0 ? 0 : tok;
    flash_tile(st, qf, kvb + (long)tok * NPROJ, [&](int key) { int tk = kb + key; tk = tk < 0 ? 0 : tk; return kvb + 128 + (long)tk * NPROJ; },
               [&](f32x16& s) { fix_tab(s, L, 128 - 32 * t, lane, chk, kb); }, L, lane); }
  flash_finish(st, L, lane);
#pragma unroll
  for (int e = 0; e < 16; ++e) { SB* mp = p.mix + (long)(q0 + crow(e, hi)) * NMIX + MX_C + h * 64 + r32; mp[0] = f2bf(st.o0[e] * bf2f(mp[0])); mp[32] = f2bf(st.o1[e] * bf2f(mp[32])); }
}
__device__ __forceinline__ void unit_m(const Params& p, int layer, int u, WaveLds* L, int lane) {
  const int h = u & 3, qt = u >> 2, q0 = qt * 32, r32 = lane & 31, hi = lane >> 5;
  bf16x8 qf[4]; load_q(qf, p.proj + (long)(q0 + r32) * NPROJ + PM_Q + h * 64, hi);
  FlashState st; st.o0 = zero16(); st.o1 = zero16(); st.m = -1e30f; st.l = 0.f;
  const SB* kb = p.memkv + (long)layer * 256 * 512 + h * 64;
  for (int t = 0; t < 8; t += 2) { auto fx = [&](f32x16& s) {
#pragma unroll
      for (int e = 0; e < 16; ++e) s[e] *= QSC; };
    flash_tile2(st, qf, kb + (long)(32 * t + r32) * 512, kb + (long)(32 * t + 32 + r32) * 512, [&](int key) { return kb + 256 + (long)(32 * t + key) * 512; }, fx, fx, L, lane); }
  flash_finish(st, L, lane);
#pragma unroll
  for (int e = 0; e < 16; ++e) { SB* mp = p.mix + (long)(q0 + crow(e, hi)) * NMIX + MX_M + h * 64 + r32; mp[0] = f2bf(st.o0[e] * bf2f(mp[0])); mp[32] = f2bf(st.o1[e] * bf2f(mp[32])); }
}
__device__ __forceinline__ void unit_awin(const Params& p, int u, WaveLds* L, int lane) {
  const int h = u & 7, qt = u >> 3, q0 = qt * 32, hk = h >> 2, r32 = lane & 31, hi = lane >> 5;
  for (int x = lane; x < 608; x += 64) { const int dist = x - 32; L->tab[x] = (dist >= 0 && dist <= 511) ? p.tabA[h * TABA_N + dist] * L2E : NINF; }
  bf16x8 qf[4]; load_q(qf, p.proj + (long)(q0 + r32) * NPROJ + PA_Q + h * 64, hi);
  FlashState st; st.o0 = zero16(); st.o1 = zero16(); st.m = -1e30f; st.l = 0.f;
  const SB* kvb = p.proj + PA_KV + 4 * 128 + hk * 64; const bool chk = q0 < 512;
  { const int t = 0; const int kb = q0 - 512; if (kb + 31 >= 0) { int tok = kb + r32; tok = tok < 0 ? 0 : tok;
    flash_tile(st, qf, kvb + (long)tok * NPROJ, [&](int key) { int tk = kb + key; tk = tk < 0 ? 0 : tk; return kvb + 128 + (long)tk * NPROJ; },
               [&](f32x16& s) { fix_tab(s, L, 512 - 32 * t, lane, chk, kb); }, L, lane); } }
  for (int t = 1; t < 17; t += 2) { const int kb = q0 - 512 + 32 * t; if (kb + 63 < 0) continue; int tok0 = kb + r32, tok1 = kb + 32 + r32; tok0 = tok0 < 0 ? 0 : tok0; tok1 = tok1 < 0 ? 0 : tok1;
    flash_tile2(st, qf, kvb + (long)tok0 * NPROJ, kvb + (long)tok1 * NPROJ, [&](int key) { int tk = kb + key; tk = tk < 0 ? 0 : tk; return kvb + 128 + (long)tk * NPROJ; },
                [&](f32x16& s) { fix_tab(s, L, 512 - 32 * t, lane, chk, kb); }, [&](f32x16& s) { fix_tab(s, L, 480 - 32 * t, lane, chk, kb + 32); }, L, lane); }
  flash_finish(st, L, lane);
#pragma unroll
  for (int e = 0; e < 16; ++e) { SB* op = p.ow + (long)(q0 + crow(e, hi)) * 512 + h * 64 + r32; op[0] = f2bf(st.o0[e]); op[32] = f2bf(st.o1[e]); }
}
__device__ __forceinline__ void unit_d(const Params& p, int u, WaveLds* L, int lane) {
  const int S = p.S, per = (S / 32) * 8; const int gi = u / per, u2 = u % per; const int h = u2 & 7, v = u2 >> 3;
  const int dil = gi == 0 ? 1 : (gi == 1 ? 4 : 16); const int tiles_per_res = (S / dil) / 32; const int r = v / tiles_per_res, it = v % tiles_per_res, i0 = it * 32;
  const int r32 = lane & 31, hi = lane >> 5;
  for (int x = lane; x < 192; x += 64) { const int dd = x - 32; L->tab[x] = (dd >= 0 && dd <= 128) ? p.tabD[(gi * 8 + h) * TABD_N + dd] * L2E : NINF; }
  bf16x8 qf[4]; load_q(qf, p.proj + (long)(r + dil * (i0 + r32)) * NPROJ + PD_Q + gi * 512 + h * 64, hi);
  FlashState st; st.o0 = zero16(); st.o1 = zero16(); st.m = -1e30f; st.l = 0.f;
  const SB* kvb = p.proj + PD_KV + h * 64; const bool chk = i0 < 128;
  for (int t = 0; t < 4; t += 2) { const int jb = i0 - 128 + 32 * t; if (jb + 63 < 0) continue; int j0 = jb + r32, j1 = jb + 32 + r32; j0 = j0 < 0 ? 0 : j0; j1 = j1 < 0 ? 0 : j1;
    flash_tile2(st, qf, kvb + (long)(r + dil * j0) * NPROJ, kvb + (long)(r + dil * j1) * NPROJ, [&](int key) { int jj = jb + key; jj = jj < 0 ? 0 : jj; return kvb + 512 + (long)(r + dil * jj) * NPROJ; },
                [&](f32x16& s) { fix_tab(s, L, 128 - 32 * t, lane, chk, jb); }, [&](f32x16& s) { fix_tab(s, L, 96 - 32 * t, lane, chk, jb + 32); }, L, lane); }
  { const int t = 4; const int jb = i0 - 128 + 32 * t; int j = jb + r32; j = j < 0 ? 0 : j;
    flash_tile(st, qf, kvb + (long)(r + dil * j) * NPROJ, [&](int key) { int jj = jb + key; jj = jj < 0 ? 0 : jj; return kvb + 512 + (long)(r + dil * jj) * NPROJ; },
               [&](f32x16& s) { fix_tab(s, L, 128 - 32 * t, lane, chk, jb); }, L, lane); }
  const float lse = flash_finish(st, L, lane);
#pragma unroll
  for (int e = 0; e < 16; ++e) { const long tok = r + dil * (i0 + crow(e, hi)); SB* op = p.dop + ((long)gi * S + tok) * 512 + h * 64 + r32; op[0] = f2bf(st.o0[e]); op[32] = f2bf(st.o1[e]); }
  if (hi == 0) p.dlse[((long)gi * S + r + dil * (i0 + r32)) * 8 + h] = lse;
}
__device__ __forceinline__ void fix_cmp(f32x16& s, const Params& p, int h, int q0, int t, int lane) {
  const int r32 = lane & 31, hi = lane >> 5; const int dq = q0 + r32 - 31 - 16 * (32 * t + 4 * hi);
  const bool far = (q0 - 16 * (32 * t + 31) - 31) >= 1513; const float c31 = p.tabA[h * TABA_N + 2047] * L2E;
#pragma unroll
  for (int e = 0; e < 16; ++e) { const int kk = (e & 3) + 8 * (e >> 2); const int dist = dq - 16 * kk; float b;
    if (far) b = c31; else { const int dc = dist < 0 ? 0 : (dist > 2047 ? 2047 : dist); b = p.tabA[h * TABA_N + dc] * L2E; }
    s[e] = dist < 0 ? NINF : s[e] * QSC + b; }
}
__device__ __forceinline__ void unit_acmp1(const Params& p, int u, WaveLds* L, int lane) {
  const int h = u & 7, qt = (p.S / 32 - 1) - (u >> 3), q0 = qt * 32, g = h >> 2, r32 = lane & 31, hi = lane >> 5; const int ncmp = p.S / 16;
  bf16x8 qf[4]; load_q(qf, p.proj + (long)(q0 + r32) * NPROJ + PA_Q + h * 64, hi);
  FlashState st; st.o0 = zero16(); st.o1 = zero16(); st.m = -1e30f; st.l = 0.f;
  const int jn = q0 / 16 + 1, nt = (jn + 31) / 32; const SB* kc = p.kvc + g * 64; const SB* vc = p.kvc + (long)ncmp * 128 + g * 64;
  int t = 0;
  for (; t + 1 < nt; t += 2) { int j0 = 32 * t + r32, j1 = j0 + 32; j0 = j0 >= ncmp ? ncmp - 1 : j0; j1 = j1 >= ncmp ? ncmp - 1 : j1;
    flash_tile2(st, qf, kc + (long)j0 * 128, kc + (long)j1 * 128, [&](int key) { int jj = 32 * t + key; jj = jj >= ncmp ? ncmp - 1 : jj; return vc + (long)jj * 128; },
                [&](f32x16& s) { fix_cmp(s, p, h, q0, t, lane); }, [&](f32x16& s) { fix_cmp(s, p, h, q0, t + 1, lane); }, L, lane); }
  if (t < nt) { int j = 32 * t + r32; j = j >= ncmp ? ncmp - 1 : j;
    flash_tile(st, qf, kc + (long)j * 128, [&](int key) { int jj = 32 * t + key; jj = jj >= ncmp ? ncmp - 1 : jj; return vc + (long)jj * 128; },
               [&](f32x16& s) { fix_cmp(s, p, h, q0, t, lane); }, L, lane); }
  const float lt = st.l + __shfl_xor(st.l, 32); const float inv = lt > 0.f ? 1.f / lt : 0.f;
  flash_finish(st, L, lane);
#pragma unroll
  for (int e = 0; e < 16; ++e) { SB* op = p.oc + (long)(q0 + crow(e, hi)) * 512 + h * 64 + r32; op[0] = f2bf(st.o0[e]); op[32] = f2bf(st.o1[e]); }
  if (hi == 0) { p.cml[((long)(q0 + r32) * 8 + h) * 2] = st.m; p.cml[((long)(q0 + r32) * 8 + h) * 2 + 1] = inv; }
}
__device__ __forceinline__ void unit_acmp2(const Params& p, int u, int lane) {
  const int part = u & 3, g = (u >> 2) & 1, qt = (p.S / 32 - 1) - (u >> 3), q0 = qt * 32, r32 = lane & 31, hi = lane >> 5; const int ncmp = p.S / 16;
  const int jn = q0 / 16 + 1, nt = (jn + 31) / 32; const SB* kc = p.kvc + g * 64; float carry = 0.f;
  const int tper = (nt + 3) >> 2, tbeg = part * tper, tend = (tbeg + tper < nt) ? tbeg + tper : nt; if (tbeg >= nt) return;
  float* impq = p.imp + ((long)(q0 + r32) * 2 + g) * 256;
  const SB* qbase = p.proj + (long)(q0 + r32) * NPROJ + PA_Q + g * 256; const float* cmlq = p.cml + ((long)(q0 + r32) * 8 + g * 4) * 2;
  for (int t = (tbeg > 0 ? tbeg - 1 : 0); t < tend; ++t) { int j = 32 * t + r32; j = j >= ncmp ? ncmp - 1 : j; const SB* kp = kc + (long)j * 128;
    bf16x8 kf[4];
#pragma unroll
    for (int d0 = 0; d0 < 4; ++d0) kf[d0] = *(const bf16x8*)(kp + d0 * 16 + hi * 8);
    float accA[4] = {0.f, 0.f, 0.f, 0.f}, accL[4] = {0.f, 0.f, 0.f, 0.f};
#pragma unroll 1
    for (int hh = 0; hh < 4; ++hh) { bf16x8 qf[4]; load_q(qf, qbase + hh * 64, hi); const float m = cmlq[hh * 2], il = cmlq[hh * 2 + 1];
      f32x16 s = zero16();
#pragma unroll
      for (int d0 = 0; d0 < 4; ++d0) s = MFMA32(kf[d0], qf[d0], s);
      fix_cmp(s, p, g * 4 + hh, q0, t, lane);
#pragma unroll
      for (int e = 0; e < 16; ++e) { const float pr = __builtin_amdgcn_exp2f(s[e] - m) * il; accA[e >> 2] += pr; if ((e & 3) == 3) accL[e >> 2] += pr; } }
    float oth[4];
#pragma unroll
    for (int eg = 0; eg < 4; ++eg) oth[eg] = __shfl_xor(accL[eg], 32);
#pragma unroll
    for (int eg = 0; eg < 4; ++eg) { const float prev = hi ? oth[eg] : (eg > 0 ? oth[eg > 0 ? eg - 1 : 0] : carry); if (t >= tbeg) impq[8 * t + 2 * eg + hi] = 2.f * accA[eg] - accL[eg] + prev; }
    carry = oth[3]; }
}
__device__ __forceinline__ float wave_max_f(float v) {
#pragma unroll
  for (int o = 32; o > 0; o >>= 1) v = fmaxf(v, __shfl_xor(v, o));
  return v; }
__device__ __forceinline__ int wave_min_i(int v) {
#pragma unroll
  for (int o = 32; o > 0; o >>= 1) { const int w = __shfl_xor(v, o); v = w < v ? w : v; }
  return v; }
__device__ __forceinline__ void unit_topk(const Params& p, int u, int lane) {
  const int q = u >> 1, cur = q >> 6; const float* imp = p.imp + (long)u * 256; int* idx = p.idx + (long)u * 16;
  float v[4];
#pragma unroll
  for (int k = 0; k < 4; ++k) { const int b = lane + 64 * k; float x = (b <= cur) ? imp[b] : -1.f; if (b == 0 || b == cur) x = 1e4f; v[k] = x; }
  int mine = -1;
  for (int k = 0; k < 16; ++k) {
    float lm = fmaxf(fmaxf(v[0], v[1]), fmaxf(v[2], v[3])); const float m = wave_max_f(lm);
    int cand = 0x7fffffff;
#pragma unroll
    for (int kk = 3; kk >= 0; --kk) if (v[kk] == m) cand = lane + 64 * kk;
    const int bsel = wave_min_i(cand);
#pragma unroll
    for (int kk = 0; kk < 4; ++kk) if (lane + 64 * kk == bsel) v[kk] = -2.f;
    if (lane == k) mine = (m >= 0.f) ? bsel : -1;
  }
  if (lane < 16) idx[lane] = mine;
}
template <bool STORE = true>
__device__ __forceinline__ void unit_asel(const Params& p, int u, WaveLds* L, int lane) {
  const int g = u & 1, q = u >> 1, r32 = lane & 31, hi = lane >> 5, hh = r32 & 3, h = g * 4 + hh;
  bf16x8 qf[4]; load_q(qf, p.proj + (long)q * NPROJ + PA_Q + h * 64, hi);
  FlashState st; st.o0 = zero16(); st.o1 = zero16(); st.m = -1e30f; st.l = 0.f;
  const int* idx = p.idx + (long)u * 16; const SB* kvb = p.proj + PA_KV + 2 * 128 + g * 64; const float c31 = p.tabA[h * TABA_N + 2047] * L2E;
  for (int k = 0; k < 16; ++k) { const int b = __builtin_amdgcn_readfirstlane(idx[k]); if (b < 0) continue;
    for (int kt = 0; kt < 2; ++kt) { const int t0 = b * 64 + kt * 32; if (t0 > q) continue;
      const bool far = (q - (t0 + 31)) >= 1513; const bool edge = (t0 + 31 > q);
      flash_tile(st, qf, kvb + (long)(t0 + r32) * NPROJ, [&](int key) { return kvb + 128 + (long)(t0 + key) * NPROJ; },
                 [&](f32x16& s) {
#pragma unroll
                   for (int e = 0; e < 16; ++e) { const int tk = t0 + (e & 3) + 8 * (e >> 2) + 4 * hi; const int dist = q - tk; float bsv;
                     if (far) bsv = c31; else { const int dc = dist < 0 ? 0 : (dist > 2047 ? 2047 : dist); bsv = p.tabA[h * TABA_N + dc] * L2E; }
                     float vv = s[e] * QSC + bsv; if (edge && dist < 0) vv = NINF; s[e] = vv; } }, L, lane); } }
  flash_finish(st, L, lane);
  if (!STORE) { asm volatile("" :: "v"(st.o0[0]), "v"(st.o1[3])); return; }
  if (hi == 0) {
#pragma unroll
    for (int e = 0; e < 4; ++e) { const int he = g * 4 + e; const float* gl = p.small + (long)q * NSMALL + he * 3;
      const float g0 = sigmoid_f(gl[0]), g1 = sigmoid_f(gl[1]), g2 = sigmoid_f(gl[2]);
#pragma unroll
      for (int db = 0; db < 2; ++db) { const long c = (long)q * 512 + he * 64 + db * 32 + r32; const float os = db ? st.o1[e] : st.o0[e];
        const float a = g0 * bf2f(p.oc[c]) + g1 * os + g2 * bf2f(p.ow[c]); SB* mp = p.mix + (long)q * NMIX + MX_A + he * 64 + db * 32 + r32; *mp = f2bf(a * bf2f(*mp)); } }
  }
}

struct WaveLds2 { unsigned short x[2048]; unsigned short b[2048]; float acs[128]; float dtv[128]; float xch[64]; };
template <bool SCALE, class RowScale>
__device__ __forceinline__ void stage_slab(unsigned short* dst, const SB* src, long ld, RowScale rs, int lane) {
#pragma unroll
  for (int i = 0; i < 4; ++i) { const int c = lane + 64 * i, row = c >> 3, ch = c & 7; uint4 vv = *(const uint4*)(src + (long)row * ld + ch * 8);
    if (SCALE) { const float sc = rs(row); unsigned w[4] = {vv.x, vv.y, vv.z, vv.w};
#pragma unroll
      for (int k = 0; k < 4; ++k) { const float lo = __uint_as_float(w[k] << 16) * sc, hi2 = __uint_as_float(w[k] & 0xffff0000u) * sc; w[k] = pk2(lo, hi2); }
      vv.x = w[0]; vv.y = w[1]; vv.z = w[2]; vv.w = w[3]; }
    *(uint4*)&dst[(ch >> 2) * 1024 + row * 32 + (ch & 3) * 8] = vv; }
}
__device__ __forceinline__ bf16x8 slab_frag(const unsigned short* img, int cb, int s2, int lane) {
  const int hi = lane >> 5; const unsigned short* vb = img + (4 * hi + ((lane & 15) >> 2)) * 32 + ((lane >> 4) & 1) * 16 + (lane & 3) * 4 + cb * 1024 + s2 * 512;
  const v4i16_t lo = __builtin_amdgcn_ds_read_tr16_b64_v4i16((LDS3 v4i16_t*)vb);
  const v4i16_t hh = __builtin_amdgcn_ds_read_tr16_b64_v4i16((LDS3 v4i16_t*)(vb + 256));
  return (bf16x8){lo[0], lo[1], lo[2], lo[3], hh[0], hh[1], hh[2], hh[3]};
}
__device__ __forceinline__ void unit_bstates(const Params& p, int u, WaveLds2* L, int lane) {
  const int nh = u & 1, hd = (u >> 1) & 7, c = u >> 4, g = hd >> 2, r32 = lane & 31, hi = lane >> 5;
  f32x16 acc[2][2];
#pragma unroll
  for (int i = 0; i < 2; ++i)
#pragma unroll
    for (int j = 0; j < 2; ++j) acc[i][j] = zero16();
  const SB* xb = p.xconv + (long)c * 128 * 1024; const float* wst = p.wst + (long)c * 128 * 8 + hd;
  for (int q4 = 0; q4 < 4; ++q4) {
    stage_slab<true>(L->x, xb + (long)(32 * q4) * 1024 + hd * 64, 1024, [&](int row) { return wst[(32 * q4 + row) * 8]; }, lane);
    stage_slab<false>(L->b, xb + (long)(32 * q4) * 1024 + 512 + g * 128 + nh * 64, 1024, [&](int) { return 1.f; }, lane);
#pragma unroll
    for (int s2 = 0; s2 < 2; ++s2) { bf16x8 af[2], bfr[2];
#pragma unroll
      for (int i = 0; i < 2; ++i) { af[i] = slab_frag(L->x, i, s2, lane); bfr[i] = slab_frag(L->b, i, s2, lane); }
#pragma unroll
      for (int i = 0; i < 2; ++i)
#pragma unroll
        for (int j = 0; j < 2; ++j) acc[i][j] = MFMA32(af[i], bfr[j], acc[i][j]); } }
  float* so = p.states + ((long)c * 8 + hd) * 8192 + nh * 64 + r32;
#pragma unroll
  for (int i = 0; i < 2; ++i)
#pragma unroll
    for (int j = 0; j < 2; ++j)
#pragma unroll
      for (int e = 0; e < 16; ++e) so[(long)(32 * i + crow(e, hi)) * 128 + 32 * j] = acc[i][j][e];
}
__device__ __forceinline__ void unit_bout(const Params& p, int layer, int u, WaveLds2* L, int lane) {
  const int lt = u & 3, hd = (u >> 2) & 7, c = u >> 5, g = hd >> 2, r32 = lane & 31, hi = lane >> 5;
  for (int x = lane; x < 128; x += 64) { L->acs[x] = p.acs[((long)c * 128 + x) * 8 + hd]; L->dtv[x] = p.dt[((long)c * 128 + x) * 8 + hd]; }
  f32x16 acc[2] = {zero16(), zero16()}, acc2[2] = {zero16(), zero16()};
  const SB* xb = p.xconv + (long)c * 128 * 1024; const int l = 32 * lt + r32; const float al = p.acs[((long)c * 128 + l) * 8 + hd];
  const float* cbr = p.cb + ((long)c * 2 + g) * 16384 + (long)l * 128;
  for (int sc = 0; sc <= lt; ++sc) {
    stage_slab<false>(L->x, xb + (long)(32 * sc) * 1024 + hd * 64, 1024, [&](int) { return 1.f; }, lane);
#pragma unroll
    for (int s2 = 0; s2 < 2; ++s2) { float mv[8];
#pragma unroll
      for (int jj = 0; jj < 2; ++jj) { const int s0 = 32 * sc + 16 * s2 + 8 * jj + 4 * hi; const float4 cv = *(const float4*)(cbr + s0); const float4 av = *(const float4*)(&L->acs[s0]); const float4 dv = *(const float4*)(&L->dtv[s0]);
        mv[4 * jj + 0] = (s0 + 0 <= l) ? cv.x * __expf(al - av.x) * dv.x : 0.f; mv[4 * jj + 1] = (s0 + 1 <= l) ? cv.y * __expf(al - av.y) * dv.y : 0.f;
        mv[4 * jj + 2] = (s0 + 2 <= l) ? cv.z * __expf(al - av.z) * dv.z : 0.f; mv[4 * jj + 3] = (s0 + 3 <= l) ? cv.w * __expf(al - av.w) * dv.w : 0.f; }
      u32x4 aw; aw[0] = pk2(mv[0], mv[1]); aw[1] = pk2(mv[2], mv[3]); aw[2] = pk2(mv[4], mv[5]); aw[3] = pk2(mv[6], mv[7]); const bf16x8 af = __builtin_bit_cast(bf16x8, aw);
#pragma unroll
      for (int pt = 0; pt < 2; ++pt) acc[pt] = MFMA32(af, slab_frag(L->x, pt, s2, lane), acc[pt]); } }
  const SB* cmr = xb + (long)l * 1024 + 768 + g * 128; const float* prv = p.states + ((long)c * 8 + hd) * 8192;
#pragma unroll 2
  for (int ks = 0; ks < 8; ++ks) { const bf16x8 af = *(const bf16x8*)(cmr + 16 * ks + 8 * hi);
#pragma unroll
    for (int pt = 0; pt < 2; ++pt) { const float* pr = prv + (long)(32 * pt + r32) * 128 + 16 * ks + 8 * hi; const float4 a0 = *(const float4*)pr, a1 = *(const float4*)(pr + 4);
      u32x4 bw; bw[0] = pk2(a0.x, a0.y); bw[1] = pk2(a0.z, a0.w); bw[2] = pk2(a1.x, a1.y); bw[3] = pk2(a1.z, a1.w);
      acc2[pt] = MFMA32(af, __builtin_bit_cast(bf16x8, bw), acc2[pt]); } }
  const float dsk = p.b_d[layer * 8 + hd];
#pragma unroll
  for (int e = 0; e < 16; ++e) { const int lr = 32 * lt + crow(e, hi); const float ea = __expf(L->acs[lr]); const long t = (long)c * 128 + lr;
#pragma unroll
    for (int pt = 0; pt < 2; ++pt) { const int pp = 32 * pt + r32; p.ybuf[t * 512 + hd * 64 + pp] = acc[pt][e] + ea * acc2[pt][e] + dsk * bf2f(xb[(long)lr * 1024 + hd * 64 + pp]); } }
}
__device__ __forceinline__ void unit_bnorm(const Params& p, int layer, int u, int lane) {
  const int g = u & 1; const long t = u >> 1; const float4 yv = *(const float4*)(p.ybuf + t * 512 + g * 256 + lane * 4);
  SB* mp = p.mix + t * NMIX + MX_B + g * 256 + lane * 4; const ushort4 zv = *(const ushort4*)mp;
  const float v0 = yv.x * bf2f(zv.x), v1 = yv.y * bf2f(zv.y), v2 = yv.z * bf2f(zv.z), v3 = yv.w * bf2f(zv.w);
  const float ss = wave_sum_f(v0 * v0 + v1 * v1 + v2 * v2 + v3 * v3); const float r = 1.f / sqrtf(ss * (1.f / 256.f) + 1e-6f);
  const float4 w = *(const float4*)(p.b_norm + layer * 512 + g * 256 + lane * 4);
  ushort4 o; o.x = f2bf(v0 * r * w.x); o.y = f2bf(v1 * r * w.y); o.z = f2bf(v2 * r * w.z); o.w = f2bf(v3 * r * w.w); *(ushort4*)mp = o;
}
__device__ __forceinline__ void unit_bdt(const Params& p, int layer, int u, int lane) {
  const int hd = u & 7, c = u >> 3; const float a = -expf(p.a_log[layer * 8 + hd]), bias = p.dt_bias[layer * 8 + hd]; const long t0 = (long)c * 128 + 2 * lane;
  const float d0 = softplus_f(p.small[t0 * NSMALL + 24 + hd] + bias), d1 = softplus_f(p.small[(t0 + 1) * NSMALL + 24 + hd] + bias);
  float run = (d0 + d1) * a;
#pragma unroll
  for (int o = 1; o < 64; o <<= 1) { const float v = __shfl_up(run, o); if (lane >= o) run += v; }
  const float tot = __shfl(run, 63); const float c1 = run, c0 = run - d1 * a;
  p.dt[t0 * 8 + hd] = d0; p.dt[(t0 + 1) * 8 + hd] = d1; p.acs[t0 * 8 + hd] = c0; p.acs[(t0 + 1) * 8 + hd] = c1;
  p.wst[t0 * 8 + hd] = d0 * expf(tot - c0); p.wst[(t0 + 1) * 8 + hd] = d1 * expf(tot - c1);
}
__device__ __forceinline__ void item_bconv(const Params& p, int layer, long gid) {
  const int cg = (int)(gid & 127) * 8; const long t = gid >> 7; const float* w = p.conv_w + (long)layer * 4 * 1024 + cg; const float* bb = p.conv_b + layer * 1024 + cg;
  float acc[8];
#pragma unroll
  for (int k = 0; k < 8; ++k) acc[k] = bb[k];
#pragma unroll
  for (int i = 0; i < 4; ++i) { const long tt = t - 3 + i; if (tt >= 0) { const uint4 vv = *(const uint4*)(p.proj + tt * NPROJ + PB_X + cg); const unsigned wd[4] = {vv.x, vv.y, vv.z, vv.w};
#pragma unroll
      for (int k = 0; k < 4; ++k) { acc[2 * k] += w[i * 1024 + 2 * k] * __uint_as_float(wd[k] << 16); acc[2 * k + 1] += w[i * 1024 + 2 * k + 1] * __uint_as_float(wd[k] & 0xffff0000u); } } }
  uint4 o; o.x = pk2(silu_f(acc[0]), silu_f(acc[1])); o.y = pk2(silu_f(acc[2]), silu_f(acc[3])); o.z = pk2(silu_f(acc[4]), silu_f(acc[5])); o.w = pk2(silu_f(acc[6]), silu_f(acc[7]));
  *(uint4*)(p.xconv + t * 1024 + cg) = o;
}
__device__ __forceinline__ void unit_cmp(const Params& p, int layer, int u, int lane) {
  const int ncmp = p.S / 16, ntile = ncmp * 2 / 32; const int kv = u / ntile, rt = u % ntile, r32 = lane & 31, hi = lane >> 5;
  const int r = 32 * rt + r32, j = r >> 1, hk = r & 1;
  const unsigned short* w1t = p.w1t + (long)kv * 128 * 2048; const unsigned short* w2t = p.w2t + kv * 64 * 128; const float* pe = p.cmp_pos + (long)(layer * 2 + kv) * 32 * 64;
  const SB* src = p.proj + PA_KV + kv * 128 + hk * 64;
  f32x16 acc[4] = {zero16(), zero16(), zero16(), zero16()};
#pragma unroll 4
  for (int ks = 0; ks < 128; ++ks) { const int t = ks >> 2, d = (ks & 3) * 16 + 8 * hi; const long tok = 16 * j + t;
    const float4 p0 = *(const float4*)(pe + t * 64 + d), p1 = *(const float4*)(pe + t * 64 + d + 4); float v[8] = {p0.x, p0.y, p0.z, p0.w, p1.x, p1.y, p1.z, p1.w};
    if (tok < p.S) { const uint4 vv = *(const uint4*)(src + tok * NPROJ + d); const unsigned wd[4] = {vv.x, vv.y, vv.z, vv.w};
#pragma unroll
      for (int k = 0; k < 4; ++k) { v[2 * k] += __uint_as_float(wd[k] << 16); v[2 * k + 1] += __uint_as_float(wd[k] & 0xffff0000u); } }
    u32x4 bw; bw[0] = pk2(v[0], v[1]); bw[1] = pk2(v[2], v[3]); bw[2] = pk2(v[4], v[5]); bw[3] = pk2(v[6], v[7]); const bf16x8 bfr = __builtin_bit_cast(bf16x8, bw);
#pragma unroll
    for (int ut = 0; ut < 4; ++ut) { const bf16x8 af = *(const bf16x8*)(w1t + (long)(32 * ut + r32) * 2048 + 16 * ks + 8 * hi); acc[ut] = MFMA32(af, bfr, acc[ut]); } }
  f32x16 o2[2] = {zero16(), zero16()};
#pragma unroll
  for (int ut = 0; ut < 4; ++ut) {
#pragma unroll
    for (int e = 0; e < 16; ++e) acc[ut][e] = gelu_f(acc[ut][e]);
#pragma unroll
    for (int s2 = 0; s2 < 2; ++s2) { const bf16x8 hb = pack8(acc[ut], 8 * s2);
#pragma unroll
      for (int dt = 0; dt < 2; ++dt) { const unsigned short* wr = w2t + (32 * dt + r32) * 128 + 32 * ut + 16 * s2 + 4 * hi; const uint2 x0 = *(const uint2*)wr, x1 = *(const uint2*)(wr + 8);
        u32x4 aw; aw[0] = x0.x; aw[1] = x0.y; aw[2] = x1.x; aw[3] = x1.y; o2[dt] = MFMA32(__builtin_bit_cast(bf16x8, aw), hb, o2[dt]); } } }
  SB* dst = p.kvc + ((long)kv * ncmp * 2 + r) * 64;
#pragma unroll
  for (int dt = 0; dt < 2; ++dt)
#pragma unroll
    for (int e = 0; e < 16; ++e) dst[32 * dt + crow(e, hi)] = f2bf(o2[dt][e]);
}

struct AselLds { unsigned short k[2][4096]; unsigned short v[2][4096]; unsigned sel[64][8]; unsigned anyb[8]; int nlist; int pad[7]; unsigned char blist[256]; float xch[4][32]; };
__device__ __forceinline__ void asel_issue(uint4 (&r)[4], const SB* kvb, int b, int tid) {
#pragma unroll
  for (int i = 0; i < 2; ++i) { const int idx = tid + 256 * i, row = idx >> 3, ch = idx & 7; const SB* src = kvb + (long)(b * 64 + row) * NPROJ + ch * 8; r[i] = *(const uint4*)src; r[2 + i] = *(const uint4*)(src + 128); }
}
__device__ __forceinline__ void asel_commit(const uint4 (&r)[4], AselLds* A, int stage, int tid) {
#pragma unroll
  for (int i = 0; i < 2; ++i) { const int idx = tid + 256 * i, row = idx >> 3, ch = idx & 7;
    *(uint4*)&A->k[stage][row * 64 + ((ch ^ (row & 7)) * 8)] = r[i];
    *(uint4*)&A->v[stage][(ch >> 2) * 2048 + row * 32 + (ch & 3) * 8] = r[2 + i]; }
}
__device__ __forceinline__ void asel_coltile(const Params& p, FlashState& S_, const bf16x8 (&qf)[4], AselLds* A, float* xch, int stage, int b, int cur, int q0, int qbase, int h, float c31, int lane) {
  const int r32 = lane & 31, hi = lane >> 5; const int ql = qbase + (r32 >> 2); const int q = q0 + ql;
  const bool selq = (A->sel[ql][b >> 5] >> (b & 31)) & 1u;
  if (!__any(selq)) return;
  const bool far = (q0 - (b * 64 + 63)) >= 1513; const bool edge = (b == cur);
  bf16x8 kf0[4], kf1[4];
#pragma unroll
  for (int d0 = 0; d0 < 4; ++d0) { const int row0 = r32, row1 = 32 + r32;
    kf0[d0] = *(const bf16x8*)&A->k[stage][row0 * 64 + (((2 * d0 + hi) ^ ((row0 >> 1) & 7)) * 8)];
    kf1[d0] = *(const bf16x8*)&A->k[stage][row1 * 64 + (((2 * d0 + hi) ^ ((row1 >> 1) & 7)) * 8)]; }
  f32x16 s0 = zero16(), s1 = zero16();
#pragma unroll
  for (int d0 = 0; d0 < 4; ++d0) { s0 = MFMA32(kf0[d0], qf[d0], s0); s1 = MFMA32(kf1[d0], qf[d0], s1); }
#pragma unroll
  for (int e = 0; e < 16; ++e) { const int tk = b * 64 + (e & 3) + 8 * (e >> 2) + 4 * hi; const int dist = q - tk; float b0, b1;
    if (far) { b0 = c31; b1 = c31; } else { const int d0c = dist < 0 ? 0 : (dist > 2047 ? 2047 : dist); const int d1 = dist - 32; const int d1c = d1 < 0 ? 0 : (d1 > 2047 ? 2047 : d1);
      b0 = p.tabA[h * TABA_N + d0c] * L2E; b1 = p.tabA[h * TABA_N + d1c] * L2E; }
    float v0 = s0[e] * QSC + b0, v1 = s1[e] * QSC + b1; if (!selq || (edge && dist < 0)) v0 = NINF; if (!selq || (edge && dist < 32)) v1 = NINF; s0[e] = v0; s1[e] = v1; }
  flash_core2(S_, s0, s1, A->v[stage], xch, lane);
}
__device__ __forceinline__ void asel_store(const Params& p, FlashState& S_, float* xch, int q0, int qbase, int g, int lane) {
  const int r32 = lane & 31, hi = lane >> 5;
  const float lt = S_.l + __shfl_xor(S_.l, 32); const float inv = lt > 0.f ? 1.f / lt : 0.f; xch[r32] = inv;
#pragma unroll
  for (int e = 0; e < 16; ++e) { const int j = crow(e, hi); const float a = xch[j]; const int q = q0 + qbase + (j >> 2), he = g * 4 + (j & 3);
    const float* gl = p.small + (long)q * NSMALL + he * 3; const float g0 = sigmoid_f(gl[0]), g1 = sigmoid_f(gl[1]), g2 = sigmoid_f(gl[2]);
#pragma unroll
    for (int db = 0; db < 2; ++db) { const long c = (long)q * 512 + he * 64 + db * 32 + r32; const float os = (db ? S_.o1[e] : S_.o0[e]) * a;
      const float av = g0 * bf2f(p.oc[c]) + g1 * os + g2 * bf2f(p.ow[c]); SB* mp = p.mix + (long)q * NMIX + MX_A + he * 64 + db * 32 + r32; *mp = f2bf(av * bf2f(*mp)); } }
}
__device__ __forceinline__ void unit_asel_blk(const Params& p, int u, AselLds* A) {
  int tid = threadIdx.x; asm volatile("" : "+v"(tid));
  const int lane = tid & 63, w = __builtin_amdgcn_readfirstlane(tid >> 6), r32 = lane & 31, hi = lane >> 5;
  const int g = u & 1, qt = (p.S / 32 - 1) - (u >> 1), q0 = qt * 32, cur = q0 >> 6;
  const SB* kvb = p.proj + PA_KV + 2 * 128 + g * 64;
  __syncthreads();
  for (int i = tid; i < 64 * 8 + 8; i += 256) ((unsigned*)A->sel)[i] = 0u;
  __syncthreads();
#pragma unroll
  for (int i = 0; i < 2; ++i) { const int e = tid + 256 * i, ql = e >> 4, kk = e & 15; const int b = p.idx[((long)(q0 + ql) * 2 + g) * 16 + kk];
    if (b >= 0) { atomicOr(&A->sel[ql][b >> 5], 1u << (b & 31)); atomicOr(&A->anyb[b >> 5], 1u << (b & 31)); } }
  __syncthreads();
  if (tid < 64) {
    const unsigned wbits = A->anyb[lane >> 3]; const unsigned nib = (wbits >> ((lane & 7) * 4)) & 15u; const int cnt = __popc(nib);
    int pre = cnt;
#pragma unroll
    for (int o = 1; o < 64; o <<= 1) { const int v = __shfl_up(pre, o); if (lane >= o) pre += v; }
    int pos = pre - cnt;
#pragma unroll
    for (int k = 0; k < 4; ++k) if ((nib >> k) & 1u) A->blist[pos++] = (unsigned char)(lane * 4 + k);
    if (lane == 63) A->nlist = pre;
  }
  __syncthreads();
  const int nlist = A->nlist;
  const int hh = r32 & 3, h = g * 4 + hh; const float c31 = p.tabA[h * TABA_N + 2047] * L2E;
  bf16x8 qf0[4]; FlashState st0;
  load_q(qf0, p.proj + (long)(q0 + 8 * w + (r32 >> 2)) * NPROJ + PA_Q + h * 64, hi);
  st0.o0 = zero16(); st0.o1 = zero16(); st0.m = -1e30f; st0.l = 0.f;
  float* xch = A->xch[w];
#define ASEL_DMA(bb, stg) { const int b_ = (bb); _Pragma("unroll") for (int i_ = 0; i_ < 2; ++i_) { const int pk_ = 2 * w + i_; \
      { const int row_ = pk_ * 8 + (lane >> 3), pc_ = lane & 7; __builtin_amdgcn_global_load_lds((gptr_t)(kvb + (long)(b_ * 64 + row_) * NPROJ + ((pc_ ^ ((row_ >> 1) & 7)) * 8)), (lptr_t)&A->k[stg][pk_ * 512], 16, 0, 0); } \
      { const int db_ = pk_ >> 2, row_ = (pk_ & 3) * 16 + (lane >> 2), wi_ = lane & 3; __builtin_amdgcn_global_load_lds((gptr_t)(kvb + 128 + (long)(b_ * 64 + row_) * NPROJ + db_ * 32 + wi_ * 8), (lptr_t)&A->v[stg][db_ * 2048 + (pk_ & 3) * 512], 16, 0, 0); } } }
  if (nlist > 0) ASEL_DMA(A->blist[0], 0);
  for (int it = 0; it < nlist; ++it) {
    const int stage = it & 1; const int b = A->blist[it];
    __syncthreads();
    if (it + 1 < nlist) ASEL_DMA(A->blist[it + 1], stage ^ 1);
    asel_coltile(p, st0, qf0, A, xch, stage, b, cur, q0, 8 * w, h, c31, lane);
  }
  asel_store(p, st0, xch, q0, 8 * w, g, lane);
#undef ASEL_DMA
}
__device__ __forceinline__ void unit_topk4(const Params& p, int u, int lane) {
  float v[4][4]; int cur[4], mine[4];
#pragma unroll
  for (int r = 0; r < 4; ++r) { const int row = u * 4 + r; const int q = row >> 1; cur[r] = q >> 6; const float* imp = p.imp + (long)row * 256; mine[r] = -1;
#pragma unroll
    for (int k = 0; k < 4; ++k) { const int b = lane + 64 * k; float x = (b <= cur[r]) ? imp[b] : -1.f; if (b == 0 || b == cur[r]) x = 1e4f; v[r][k] = x; } }
  for (int k = 0; k < 16; ++k) {
    float m[4]; int cand[4];
#pragma unroll
    for (int r = 0; r < 4; ++r) m[r] = fmaxf(fmaxf(v[r][0], v[r][1]), fmaxf(v[r][2], v[r][3]));
#pragma unroll
    for (int o = 32; o > 0; o >>= 1) {
#pragma unroll
      for (int r = 0; r < 4; ++r) m[r] = fmaxf(m[r], __shfl_xor(m[r], o)); }
#pragma unroll
    for (int r = 0; r < 4; ++r) { cand[r] = 0x7fffffff;
#pragma unroll
      for (int kk = 3; kk >= 0; --kk) if (v[r][kk] == m[r]) cand[r] = lane + 64 * kk; }
#pragma unroll
    for (int o = 32; o > 0; o >>= 1) {
#pragma unroll
      for (int r = 0; r < 4; ++r) { const int w = __shfl_xor(cand[r], o); cand[r] = w < cand[r] ? w : cand[r]; } }
#pragma unroll
    for (int r = 0; r < 4; ++r) {
#pragma unroll
      for (int kk = 0; kk < 4; ++kk) if (lane + 64 * kk == cand[r]) v[r][kk] = -2.f;
      if (lane == k) mine[r] = (m[r] >= 0.f) ? cand[r] : -1; }
  }
#pragma unroll
  for (int r = 0; r < 4; ++r) if (lane < 16) p.idx[(long)(u * 4 + r) * 16 + lane] = mine[r];
}
__device__ __forceinline__ void unit_bout_blk(const Params& p, int layer, int ub, char* smem) {
  int tid = threadIdx.x; asm volatile("" : "+v"(tid));
  const int lane = tid & 63, w = __builtin_amdgcn_readfirstlane(tid >> 6), r32 = lane & 31, hi = lane >> 5;
  const int lt = ub & 3, g = (ub >> 2) & 1, c = ub >> 3, hd = g * 4 + w;
  WaveLds2* L = ((WaveLds2*)smem) + w;
  __syncthreads();
  for (int x = lane; x < 128; x += 64) { L->acs[x] = p.acs[((long)c * 128 + x) * 8 + hd]; L->dtv[x] = p.dt[((long)c * 128 + x) * 8 + hd]; }
  f32x16 acc[2] = {zero16(), zero16()}, acc2[2] = {zero16(), zero16()};
  const SB* xb = p.xconv + (long)c * 128 * 1024; const int l = 32 * lt + r32; const float al = p.acs[((long)c * 128 + l) * 8 + hd];
  const float* cbr = p.cb + ((long)c * 2 + g) * 16384 + (long)l * 128;
  for (int sc = 0; sc <= lt; ++sc) {
    stage_slab<false>(L->x, xb + (long)(32 * sc) * 1024 + hd * 64, 1024, [&](int) { return 1.f; }, lane);
#pragma unroll
    for (int s2 = 0; s2 < 2; ++s2) { float mv[8];
#pragma unroll
      for (int jj = 0; jj < 2; ++jj) { const int s0 = 32 * sc + 16 * s2 + 8 * jj + 4 * hi; const float4 cv = *(const float4*)(cbr + s0); const float4 av = *(const float4*)(&L->acs[s0]); const float4 dv = *(const float4*)(&L->dtv[s0]);
        mv[4 * jj + 0] = (s0 + 0 <= l) ? cv.x * __expf(al - av.x) * dv.x : 0.f; mv[4 * jj + 1] = (s0 + 1 <= l) ? cv.y * __expf(al - av.y) * dv.y : 0.f;
        mv[4 * jj + 2] = (s0 + 2 <= l) ? cv.z * __expf(al - av.z) * dv.z : 0.f; mv[4 * jj + 3] = (s0 + 3 <= l) ? cv.w * __expf(al - av.w) * dv.w : 0.f; }
      u32x4 aw; aw[0] = pk2(mv[0], mv[1]); aw[1] = pk2(mv[2], mv[3]); aw[2] = pk2(mv[4], mv[5]); aw[3] = pk2(mv[6], mv[7]); const bf16x8 af = __builtin_bit_cast(bf16x8, aw);
#pragma unroll
      for (int pt = 0; pt < 2; ++pt) acc[pt] = MFMA32(af, slab_frag(L->x, pt, s2, lane), acc[pt]); } }
  const SB* cmr = xb + (long)l * 1024 + 768 + g * 128; const float* prv = p.states + ((long)c * 8 + hd) * 8192;
#pragma unroll 2
  for (int ks = 0; ks < 8; ++ks) { const bf16x8 af = *(const bf16x8*)(cmr + 16 * ks + 8 * hi);
#pragma unroll
    for (int pt = 0; pt < 2; ++pt) { const float* pr = prv + (long)(32 * pt + r32) * 128 + 16 * ks + 8 * hi; const float4 a0 = *(const float4*)pr, a1 = *(const float4*)(pr + 4);
      u32x4 bw; bw[0] = pk2(a0.x, a0.y); bw[1] = pk2(a0.z, a0.w); bw[2] = pk2(a1.x, a1.y); bw[3] = pk2(a1.z, a1.w);
      acc2[pt] = MFMA32(af, __builtin_bit_cast(bf16x8, bw), acc2[pt]); } }
  const float dsk = p.b_d[layer * 8 + hd];
  float* yl = (float*)L;
#pragma unroll
  for (int e = 0; e < 16; ++e) { const int lr = crow(e, hi); const float ea = __expf(L->acs[32 * lt + lr]);
#pragma unroll
    for (int pt = 0; pt < 2; ++pt) { const int pp = 32 * pt + r32; yl[lr * 64 + pp] = acc[pt][e] + ea * acc2[pt][e] + dsk * bf2f(xb[(long)(32 * lt + lr) * 1024 + hd * 64 + pp]); } }
  __syncthreads();
  { const int row = tid >> 3, sub = tid & 7; const long t = (long)c * 128 + 32 * lt + row; SB* mp = p.mix + t * NMIX + MX_B + g * 256 + sub * 32;
    const float* ysrc = (const float*)(((WaveLds2*)smem) + (sub >> 1)) + row * 64 + (sub & 1) * 32;
    float vv[32]; float ss = 0.f;
#pragma unroll
    for (int i = 0; i < 4; ++i) { const uint4 zz = *(const uint4*)(mp + 8 * i); const unsigned zw[4] = {zz.x, zz.y, zz.z, zz.w};
#pragma unroll
      for (int k = 0; k < 4; ++k) { const float y0 = ysrc[8 * i + 2 * k] * __uint_as_float(zw[k] << 16), y1 = ysrc[8 * i + 2 * k + 1] * __uint_as_float(zw[k] & 0xffff0000u); vv[8 * i + 2 * k] = y0; vv[8 * i + 2 * k + 1] = y1; ss += y0 * y0 + y1 * y1; } }
    ss += __shfl_xor(ss, 1); ss += __shfl_xor(ss, 2); ss += __shfl_xor(ss, 4);
    const float r = 1.f / sqrtf(ss * (1.f / 256.f) + 1e-6f); const float* wn = p.b_norm + layer * 512 + g * 256 + sub * 32;
#pragma unroll
    for (int i = 0; i < 4; ++i) { uint4 o; o.x = pk2(vv[8 * i] * r * wn[8 * i], vv[8 * i + 1] * r * wn[8 * i + 1]); o.y = pk2(vv[8 * i + 2] * r * wn[8 * i + 2], vv[8 * i + 3] * r * wn[8 * i + 3]);
      o.z = pk2(vv[8 * i + 4] * r * wn[8 * i + 4], vv[8 * i + 5] * r * wn[8 * i + 5]); o.w = pk2(vv[8 * i + 6] * r * wn[8 * i + 6], vv[8 * i + 7] * r * wn[8 * i + 7]); *(uint4*)(mp + 8 * i) = o; } }
}

__device__ __forceinline__ void unit_memkv(const Params& p, int u, int lane) {
  const int l = u >> 8, m = u & 255; const float* row = p.mem + (long)m * DM; const float* nw = p.m_norm + l * DM; const float* w = p.m_wkv + (long)l * DM * 512 + lane * 8;
  float ss = 0.f;
#pragma unroll
  for (int i = 0; i < 4; ++i) { const float4 v = *(const float4*)(row + i * 256 + lane * 4); ss += v.x * v.x + v.y * v.y + v.z * v.z + v.w * v.w; }
  ss = wave_sum_f(ss); const float r = 1.f / sqrtf(ss * (1.f / DM) + 1e-6f);
  float acc[8] = {0.f, 0.f, 0.f, 0.f, 0.f, 0.f, 0.f, 0.f};
#pragma unroll 8
  for (int d = 0; d < DM; ++d) { const float a = row[d] * r * nw[d]; const float4 w0 = *(const float4*)(w + (long)d * 512), w1 = *(const float4*)(w + (long)d * 512 + 4);
    acc[0] += a * w0.x; acc[1] += a * w0.y; acc[2] += a * w0.z; acc[3] += a * w0.w; acc[4] += a * w1.x; acc[5] += a * w1.y; acc[6] += a * w1.z; acc[7] += a * w1.w; }
  uint4 o; o.x = pk2(acc[0], acc[1]); o.y = pk2(acc[2], acc[3]); o.z = pk2(acc[4], acc[5]); o.w = pk2(acc[6], acc[7]);
  *(uint4*)(p.memkv + (long)u * 512 + lane * 8) = o;
}

#define SEQ 16384
#define DEPTH 4

__device__ __forceinline__ int n2o(int n) {
  if (n < 1280) return n;
  if (n < 2304) return n - 1280 + 1816;
  if (n < 2816) return n - 2304 + 3360;
  if (n < 3072) return n - 2816 + 3872;
  if (n < 4608) return n - 3072 + 4640;
  if (n < 5632) return n - 4608 + 6176;
  if (n < 5888) return n - 5632 + 7712;
  n -= 5888;
  if (n < 512) return 1304 + n;
  if (n < 1024) return 2848 + n - 512;
  if (n < 1536) return 4128 + n - 1024;
  if (n < 2048) return 7200 + n - 1536;
  if (n < 2304) return 7968 + n - 2048;
  n -= 2304;
  if (n < 24) return 1280 + n;
  if (n < 32) return 2840 + n - 24;
  return -1;
}

template <bool MAP>
__device__ __forceinline__ void cvt_tile(const float* __restrict__ src, int lds_, unsigned short* __restrict__ dst, int ldd, int k0, int n0, float* tile  ) {
  int tid = threadIdx.x; asm volatile("" : "+v"(tid));
  __syncthreads();
#pragma unroll
  for (int e = 0; e < 16; ++e) { int idx = tid + 256 * e, kk = idx >> 6, nn = idx & 63; int oc = MAP ? n2o(n0 + nn) : (n0 + nn);
    tile[kk * 65 + nn] = (oc >= 0) ? src[(long)(k0 + kk) * lds_ + oc] : 0.f; }
  __syncthreads();
#pragma unroll
  for (int e = 0; e < 16; ++e) { int idx = tid + 256 * e, nn = idx >> 6, kk = idx & 63; dst[(long)(n0 + nn) * ldd + k0 + kk] = f2bf(tile[kk * 65 + nn]); }
}

__device__ __forceinline__ float wave_sum(float v) {
#pragma unroll
  for (int o = 32; o > 0; o >>= 1) v += __shfl_xor(v, o);
  return v;
}

__device__ __forceinline__ void norm_row_wave(const Params& p, int layer, int t, bool do_h, int lane) {
  const float* xin = (layer == 0) ? p.x + (long)t * DM : p.out + (long)t * DM;
  float4 xv[4], yv[4];
#pragma unroll
  for (int i = 0; i < 4; ++i) xv[i] = *(const float4*)(xin + i * 256 + lane * 4);
  if (layer > 0) {
    float ss = 0.f;
#pragma unroll
    for (int i = 0; i < 4; ++i) { yv[i] = *(const float4*)(p.y + (long)t * DM + i * 256 + lane * 4); ss += yv[i].x * yv[i].x + yv[i].y * yv[i].y + yv[i].z * yv[i].z + yv[i].w * yv[i].w; }
    ss = wave_sum(ss); float r1 = 1.f / sqrtf(ss / DM + 1e-6f);
#pragma unroll
    for (int i = 0; i < 4; ++i) { float4 w = *(const float4*)(p.post_norm + (layer - 1) * DM + i * 256 + lane * 4);
      xv[i].x += yv[i].x * r1 * w.x; xv[i].y += yv[i].y * r1 * w.y; xv[i].z += yv[i].z * r1 * w.z; xv[i].w += yv[i].w * r1 * w.w; }
  }
  float ss2 = 0.f;
#pragma unroll
  for (int i = 0; i < 4; ++i) { *(float4*)(p.out + (long)t * DM + i * 256 + lane * 4) = xv[i]; ss2 += xv[i].x * xv[i].x + xv[i].y * xv[i].y + xv[i].z * xv[i].z + xv[i].w * xv[i].w; }
  if (!do_h) return;
  ss2 = wave_sum(ss2); float r2 = 1.f / sqrtf(ss2 / DM + 1e-6f);
#pragma unroll
  for (int i = 0; i < 4; ++i) { float4 w = *(const float4*)(p.pre_norm + layer * DM + i * 256 + lane * 4);
    ushort4 o; o.x = f2bf(xv[i].x * r2 * w.x); o.y = f2bf(xv[i].y * r2 * w.y); o.z = f2bf(xv[i].z * r2 * w.z); o.w = f2bf(xv[i].w * r2 * w.w);
    *(ushort4*)(p.h + (long)t * DM + i * 256 + lane * 4) = o; }
}

struct GemmSmem { unsigned short a[2][128 * 64]; unsigned short b[2][128 * 64]; };
__device__ __forceinline__ void glds16(const void* g, void* lds_wave_base) {
  __builtin_amdgcn_global_load_lds((gptr_t)g, (lptr_t)lds_wave_base, 16, 0, 0);
}
template <int EPI>
__device__ __forceinline__ void gemm_tile(const Params& p, const unsigned short* __restrict__ A, int lda, const unsigned short* __restrict__ Bt, int ldb, int K, int m0, int n0, GemmSmem& sm, float* outp = nullptr) {
  int tid = threadIdx.x; asm volatile("" : "+v"(tid));
  const int lane = tid & 63, wid = __builtin_amdgcn_readfirstlane(tid >> 6), wr = wid >> 1, wc = wid & 1, r = lane & 31, h = lane >> 5;
  f32x16 acc[2][2];
#pragma unroll
  for (int i = 0; i < 2; ++i)
#pragma unroll
    for (int j = 0; j < 2; ++j) acc[i][j] = zero16();
  const int prow = lane >> 3, pc = lane & 7;
  const unsigned short* ga[4]; const unsigned short* gb[4];
#pragma unroll
  for (int i = 0; i < 4; ++i) { const int row = (wid * 4 + i) * 8 + prow; const int lc = (pc ^ ((row >> 1) & 7)) * 8;
    ga[i] = A + (long)(m0 + row) * lda + lc; gb[i] = Bt + (long)(n0 + row) * ldb + lc; }
  __syncthreads();
#pragma unroll
  for (int i = 0; i < 4; ++i) { glds16(ga[i], &sm.a[0][(wid * 4 + i) * 512]); glds16(gb[i], &sm.b[0][(wid * 4 + i) * 512]); }
  __syncthreads();
  const int nk = K / 64;
  for (int kt = 0; kt < nk; ++kt) {
    const int cur = kt & 1;
    if (kt + 1 < nk) { const int ko = (kt + 1) * 64;
#pragma unroll
      for (int i = 0; i < 4; ++i) { glds16(ga[i] + ko, &sm.a[cur ^ 1][(wid * 4 + i) * 512]); glds16(gb[i] + ko, &sm.b[cur ^ 1][(wid * 4 + i) * 512]); } }
#pragma unroll
    for (int ks = 0; ks < 4; ++ks) {
      bf16x8 af[2], bfr[2];
#pragma unroll
      for (int i = 0; i < 2; ++i) { const int row = wr * 64 + i * 32 + r; af[i] = *(const bf16x8*)&sm.a[cur][row * 64 + (((2 * ks + h) ^ ((row >> 1) & 7)) * 8)]; }
#pragma unroll
      for (int j = 0; j < 2; ++j) { const int row = wc * 64 + j * 32 + r; bfr[j] = *(const bf16x8*)&sm.b[cur][row * 64 + (((2 * ks + h) ^ ((row >> 1) & 7)) * 8)]; }
#pragma unroll
      for (int i = 0; i < 2; ++i)
#pragma unroll
        for (int j = 0; j < 2; ++j) acc[i][j] = __builtin_amdgcn_mfma_f32_32x32x16_bf16(af[i], bfr[j], acc[i][j], 0, 0, 0);
    }
    __syncthreads();
  }
  const int ncol0 = n0 + wc * 64;
  if (EPI == 2) {
#pragma unroll
    for (int i = 0; i < 2; ++i)
#pragma unroll
      for (int j = 0; j < 2; ++j)
#pragma unroll
        for (int e = 0; e < 16; ++e) { int row = m0 + wr * 64 + i * 32 + (e & 3) + 8 * (e >> 2) + 4 * h; outp[row * 128 + ncol0 + j * 32 + r] = acc[i][j][e]; }
  } else if (EPI == 1) {
#pragma unroll
    for (int i = 0; i < 2; ++i)
#pragma unroll
      for (int j = 0; j < 2; ++j)
#pragma unroll
        for (int e = 0; e < 16; ++e) { int row = m0 + wr * 64 + i * 32 + (e & 3) + 8 * (e >> 2) + 4 * h; p.y[(long)row * DM + ncol0 + j * 32 + r] = acc[i][j][e]; }
  } else {
    if (ncol0 < NPROJ) {
      const bool rope = (ncol0 >= PC_Q && ncol0 < PC_KV + 128);
#pragma unroll
      for (int i = 0; i < 2; ++i)
#pragma unroll
        for (int e = 0; e < 16; ++e) { int row = m0 + wr * 64 + i * 32 + (e & 3) + 8 * (e >> 2) + 4 * h; float v0 = acc[i][0][e], v1 = acc[i][1][e];
          if (rope) { float c = p.rope_cs[row * 32 + r], s = p.rope_sn[row * 32 + r]; float t1 = v0, t2 = v1; v0 = t1 * c - t2 * s; v1 = t2 * c + t1 * s; }
          p.proj[(long)row * NPROJ + ncol0 + r] = f2bf(v0); p.proj[(long)row * NPROJ + ncol0 + 32 + r] = f2bf(v1); }
    } else if (ncol0 < 8192) {
#pragma unroll
      for (int i = 0; i < 2; ++i)
#pragma unroll
        for (int j = 0; j < 2; ++j)
#pragma unroll
          for (int e = 0; e < 16; ++e) { int row = m0 + wr * 64 + i * 32 + (e & 3) + 8 * (e >> 2) + 4 * h; p.mix[(long)row * NMIX + (ncol0 - NPROJ) + j * 32 + r] = f2bf(silu_f(acc[i][j][e])); }
    } else if (ncol0 == 8192) {
#pragma unroll
      for (int i = 0; i < 2; ++i)
#pragma unroll
        for (int e = 0; e < 16; ++e) { int row = m0 + wr * 64 + i * 32 + (e & 3) + 8 * (e >> 2) + 4 * h; p.small[(long)row * NSMALL + r] = acc[i][0][e]; }
    }
  }
}

__device__ __forceinline__ int gw0(int g) { asm volatile("" : "+v"(g)); return g; }
__device__ __forceinline__ int bid0() { int b = blockIdx.x; asm volatile("" : "+s"(b)); return b; }

#define XB_TMO      128
#define XB_XCNT(j)  (256  + 64 * (j))
#define XB_XSUB(j)  (1280 + 64 * (j))
#define XB_XGEN(j)  (2304 + 64 * (j))
#define XB_TOP      3328
#define XB_TOPGEN   3392
#define XCD_BAR_WORDS 3456
#define XB_SPIN_CAP (1u << 28)
__device__ __forceinline__ unsigned xb_ld(unsigned* p) { return __hip_atomic_load(p, __ATOMIC_RELAXED, __HIP_MEMORY_SCOPE_AGENT); }
__device__ __forceinline__ unsigned xb_add(unsigned* p, unsigned v) { return __hip_atomic_fetch_add(p, v, __ATOMIC_RELAXED, __HIP_MEMORY_SCOPE_AGENT); }
__device__ __forceinline__ unsigned xb_xcc_id() { return (unsigned)__builtin_amdgcn_s_getreg((3 << 11) | 20) & 0xFu; }
#define XB_SPIN(cond, bar) do { unsigned _sp = 0; while (cond) { __builtin_amdgcn_s_sleep(1); \
    if ((++_sp & 255u) == 0u) { if (xb_ld(&(bar)[XB_TMO])) break; if (_sp > XB_SPIN_CAP) { atomicAdd(&(bar)[XB_TMO], 1u); break; } } } } while (0)
struct XcdBarrier { unsigned* bar; unsigned x; volatile LDS3 unsigned* st; };
__device__ __forceinline__ XcdBarrier xcd_barrier_post(unsigned* bar, volatile LDS3 unsigned* st) {
  XcdBarrier b; b.bar = bar; b.x = xb_xcc_id(); b.st = st;
  if (threadIdx.x == 0) (void)xb_add(&bar[XB_XCNT(b.x)], 1u);
  return b;
}
__device__ __forceinline__ void xcd_barrier_complete(unsigned* bar, unsigned x, unsigned& nloc, unsigned& nx) {
  const unsigned G = gridDim.x; unsigned sum, cnt, mine, sp = 0u;
  for (;;) { sum = 0u; cnt = 0u; mine = 0u;
#pragma unroll
    for (unsigned j = 0; j < 16; ++j) { const unsigned c = xb_ld(&bar[XB_XCNT(j)]); sum += c; cnt += (c > 0u) ? 1u : 0u; mine = (j == x) ? c : mine; }
    if (sum == G) break;
    __builtin_amdgcn_s_sleep(1);
    if ((++sp & 255u) == 0u) { if (xb_ld(&bar[XB_TMO])) break; if (sp > XB_SPIN_CAP) { atomicAdd(&bar[XB_TMO], 1u); break; } } }
  nloc = mine > 0u ? mine : 1u; nx = cnt > 0u ? cnt : 1u;
}
__device__ __forceinline__ void xcd_barrier(const XcdBarrier& b) {
  asm volatile("s_waitcnt vmcnt(0)" ::: "memory");
  __syncthreads();
  if (threadIdx.x == 0) {
    unsigned* bar = b.bar;
    __builtin_amdgcn_s_waitcnt(0);
    unsigned nloc = b.st[0], nx = b.st[1];
    if (nloc == 0u) { xcd_barrier_complete(bar, b.x, nloc, nx); b.st[0] = nloc; b.st[1] = nx; }
    const unsigned old = xb_add(&bar[XB_XSUB(b.x)], 1u);
    const unsigned gen = old / nloc;
    if (old + 1u == (gen + 1u) * nloc) {
      __builtin_amdgcn_fence(__ATOMIC_RELEASE, "agent");
      asm volatile("s_waitcnt vmcnt(0)" ::: "memory");
      const unsigned og = xb_add(&bar[XB_TOP], 1u);
      const unsigned tg = og / nx;
      if (og + 1u == (tg + 1u) * nx) xb_add(&bar[XB_TOPGEN], 1u);
      else XB_SPIN(xb_ld(&bar[XB_TOPGEN]) == tg, bar);
      __builtin_amdgcn_fence(__ATOMIC_ACQUIRE, "agent");
      xb_add(&bar[XB_XGEN(b.x)], 1u);
      asm volatile("s_waitcnt vmcnt(0)" ::: "memory");
    } else {
      XB_SPIN(xb_ld(&bar[XB_XGEN(b.x)]) == gen, bar);
      __builtin_amdgcn_fence(__ATOMIC_ACQUIRE, "agent");
      asm volatile("s_waitcnt vmcnt(0)" ::: "memory");
    }
  }
  __syncthreads();
}

struct KArgs { const void* in[20]; float* out; char* ws; };
#ifdef SELFCHK
#define RUN_S 4096
#else
#define RUN_S SEQ
#endif
__host__ __device__ __forceinline__ size_t fill_ws(Params& p, Params& p2, char* w) {
  size_t off = 0;
#define TAKE(bytes) (w + ((off += (((size_t)(bytes)) + 255) & ~(size_t)255) - ((((size_t)(bytes)) + 255) & ~(size_t)255)))
  const size_t S = RUN_S, ncmp = S / 16, nc = S / 128;
  p.S = RUN_S;
  p.wt_in = (unsigned short*)TAKE(8320 * 1024 * 2); p.wt_out = (unsigned short*)TAKE(1024 * 2304 * 2); p.w1t = (unsigned short*)TAKE(2 * 128 * 2048 * 2); p.w2t = (unsigned short*)TAKE(2 * 64 * 128 * 2);
  p.h = (SB*)TAKE(S * 1024 * 2); p.ybuf = (float*)p.h;
  p.proj = (SB*)TAKE(S * NPROJ * 2); p.y = (float*)p.proj;
  p.small = (float*)TAKE(S * 32 * 4); p.mix = (SB*)TAKE(S * NMIX * 2);
  p.rope_cs = (float*)TAKE(S * 32 * 4); p.rope_sn = (float*)TAKE(S * 32 * 4); p.tabA = (float*)TAKE(8 * TABA_N * 4); p.tabD = (float*)TAKE(24 * TABD_N * 4);
  p.memkv = (SB*)TAKE(4 * 256 * 512 * 2); p.hid = (float*)TAKE(2 * ncmp * 256 * 4); p.kvc = (SB*)TAKE(2 * ncmp * 128 * 2);
  p.cml = (float*)TAKE(S * 16 * 4); p.idx = (int*)TAKE(S * 32 * 4); p.oc = (SB*)TAKE(S * 512 * 2); p.ow = (SB*)TAKE(S * 512 * 2);
  p.dop = (SB*)TAKE(3 * S * 512 * 2); p.dlse = (float*)TAKE(3 * S * 8 * 4); p.xconv = (SB*)TAKE(S * 1024 * 2);
  p.dt = (float*)TAKE(S * 8 * 4); p.acs = (float*)TAKE(S * 8 * 4); p.wst = (float*)TAKE(S * 8 * 4); p.cb = (float*)TAKE(nc * 2 * 128 * 128 * 4); p.states = (float*)TAKE(nc * 65536 * 4);
  p.bar = (unsigned*)TAKE(16384);
  p2 = p;
#ifdef SELFCHK
  p.imp = (float*)TAKE(S * 512 * 4);
  p2.mix = (SB*)TAKE(S * NMIX * 2); p2.ow = (SB*)TAKE(S * 512 * 2); p2.oc = (SB*)TAKE(S * 512 * 2); p2.dop = (SB*)TAKE(3 * S * 512 * 2); p2.dlse = (float*)TAKE(3 * S * 8 * 4);
  p2.cml = (float*)TAKE(S * 16 * 4); p2.imp = (float*)TAKE(S * 512 * 4); p2.idx = (int*)TAKE(S * 32 * 4); p2.cb = (float*)TAKE(nc * 2 * 128 * 128 * 4);
  p2.kvc = (SB*)TAKE(2 * ncmp * 128 * 2); p2.xconv = (SB*)TAKE(S * 1024 * 2); p2.dt = (float*)TAKE(S * 8 * 4); p2.acs = (float*)TAKE(S * 8 * 4); p2.wst = (float*)TAKE(S * 8 * 4);
  p2.states = (float*)TAKE(nc * 65536 * 4); p2.ybuf = (float*)TAKE(S * 512 * 4); p.ybuf = (float*)TAKE(S * 512 * 4);
#else
  p.imp = (float*)p.dop; p2 = p;
#endif
  return off;
}
__host__ __device__ __forceinline__ void fill_inputs(Params& p, const KArgs& a) {
  p.x = (const float*)a.in[0]; p.mem = (const float*)a.in[1]; p.pos = (const int*)a.in[2]; p.pre_norm = (const float*)a.in[3]; p.post_norm = (const float*)a.in[4];
  p.w_in = (const float*)a.in[5]; p.w_out = (const float*)a.in[6]; p.rel_bias = (const float*)a.in[7]; p.cmp_pos = (const float*)a.in[8]; p.cmp_w1 = (const float*)a.in[9];
  p.cmp_w2 = (const float*)a.in[10]; p.conv_w = (const float*)a.in[11]; p.conv_b = (const float*)a.in[12]; p.dt_bias = (const float*)a.in[13]; p.a_log = (const float*)a.in[14];
  p.b_d = (const float*)a.in[15]; p.b_norm = (const float*)a.in[16]; p.sinks = (const float*)a.in[17]; p.m_norm = (const float*)a.in[18]; p.m_wkv = (const float*)a.in[19];
  p.out = a.out;
}
#define GS(N, ...) { long g0_ = gtid; asm volatile("" : "+v"(g0_)); for (long gid = g0_; gid < (long)(N); gid += gsz) { __VA_ARGS__; } }
#define WU(N, ...) { for (int u_ = gw0(gwave); u_ < (int)(N); u_ += nwave) { const int u = __builtin_amdgcn_readfirstlane(u_); int lane = threadIdx.x & 63; asm volatile("" : "+v"(lane)); \
    WaveLds* WL = ((WaveLds*)smem_raw) + __builtin_amdgcn_readfirstlane((int)(threadIdx.x >> 6)); __VA_ARGS__; } }
#define GSYNC() xcd_barrier(xb)
#define KERNEL_PROLOGUE \
  Params p, p2; p.pad0 = 0; fill_inputs(p, ka); fill_ws(p, p2, ka.ws); \
  cg::grid_group grid = cg::this_grid(); \
  __shared__ __attribute__((aligned(16))) char smem_raw[sizeof(GemmSmem) + 16]; \
  volatile LDS3 unsigned* xbst = (volatile LDS3 unsigned*)(smem_raw + sizeof(GemmSmem)); \
  if (threadIdx.x < 4) xbst[threadIdx.x] = 0u; \
  __syncthreads(); \
  XcdBarrier xb = xcd_barrier_post(p.bar, xbst); \
  GemmSmem& gsm = *(GemmSmem*)smem_raw; float* ftile = (float*)smem_raw; \
  const long gtid = (long)blockIdx.x * 256 + threadIdx.x, gsz = (long)gridDim.x * 256; \
  const int gwave = (int)(gtid >> 6), nwave = (int)(gsz >> 6); \
  const int S = p.S, ncmp = S / 16, nc = S / 128, nqt = S / 32; (void)ncmp; (void)nc; (void)nqt; (void)ftile; (void)gsm; \
  GS((long)S * 32, ph_rope(p, gid)); \
  GS(8 * TABA_N + 24 * TABD_N, ph_tabs(p, gid)); \
  WU(DEPTH * 256, unit_memkv(p, u, lane));
#define PHASE_P1(layer) \
    for (int t = gw0(gwave); t < S; t += nwave) { int lane = threadIdx.x & 63; asm volatile("" : "+v"(lane)); norm_row_wave(p, layer, t, true, lane); } \
    { const float* wi = p.w_in + (long)(layer) * 1024 * 8224; \
      for (int tl = bid0(); tl < 16 * 130; tl += gridDim.x) cvt_tile<true>(wi, 8224, p.wt_in, 1024, (tl & 15) * 64, (tl >> 4) * 64, ftile); \
      const float* wo = p.w_out + (long)(layer) * 2304 * 1024; \
      for (int tl = bid0(); tl < 36 * 16; tl += gridDim.x) cvt_tile<false>(wo, 1024, p.wt_out, 2304, (tl % 36) * 64, (tl / 36) * 64, ftile); \
      for (int tl = bid0(); tl < 2 * 64; tl += gridDim.x) { const int kv = tl >> 6, t6 = tl & 63; cvt_tile<false>(p.cmp_w1 + (long)((layer) * 2 + kv) * 2048 * 128, 128, p.w1t + (long)kv * 128 * 2048, 2048, (t6 >> 1) * 64, (t6 & 1) * 64, ftile); } \
      for (int tl = bid0(); tl < 2 * 2; tl += gridDim.x) { const int kv = tl >> 1; cvt_tile<false>(p.cmp_w2 + (long)((layer) * 2 + kv) * 128 * 64, 64, p.w2t + (long)kv * 64 * 128, 128, (tl & 1) * 64, 0, ftile); } }
#define PHASE_P2() \
    {   \
      const int x_ = bid0() & 7, li_ = bid0() >> 3, nl_ = (gridDim.x + 7) >> 3, mper_ = (S / 128) / 8; \
      if (mper_ != 16) { for (int tl = bid0(); tl < (S / 128) * 65; tl += gridDim.x) { int mt = tl % (S / 128), nt = tl / (S / 128); gemm_tile<0>(p, p.h, DM, p.wt_in, DM, DM, mt * 128, nt * 128, gsm); } } \
      else for (int t_ = li_; t_ < mper_ * 65; t_ += nl_) { const int half_ = t_ / 520, r_ = t_ % 520; int ml_, nt_; \
        if (r_ < 512) { ml_ = r_ & 7; nt_ = (r_ >> 6) * 8 + ((r_ & 63) >> 3); } else { ml_ = r_ - 512; nt_ = 64; } \
        const int mt_ = x_ * mper_ + half_ * 8 + ml_; gemm_tile<0>(p, p.h, DM, p.wt_in, DM, DM, mt_ * 128, nt_ * 128, gsm); } }
#define PHASE_FLASH3(layer) \
    { const int nA = nqt * 8, nM = nqt * 4, nD = 3 * nqt * 8, nC = nqt * 8; \
      WU(nA + nM + nD + nC, { if (u < nA) unit_awin(p, u, WL, lane); else if (u < nA + nM) unit_m(p, layer, u - nA, WL, lane); \
                              else if (u < nA + nM + nD) unit_d(p, u - nA - nM, WL, lane); else unit_c(p, layer, u - nA - nM - nD, WL, lane); }); }
#define WU2(N, ...) { for (int u_ = gw0(gwave); u_ < (int)(N); u_ += nwave) { const int u = __builtin_amdgcn_readfirstlane(u_); int lane = threadIdx.x & 63; asm volatile("" : "+v"(lane)); \
    WaveLds2* WL2 = ((WaveLds2*)smem_raw) + __builtin_amdgcn_readfirstlane((int)(threadIdx.x >> 6)); __VA_ARGS__; } }
#define PHASE_CB() \
    for (int tl = bid0(); tl < nc * 2; tl += gridDim.x) { const SB* xb_ = p.xconv + (long)(tl >> 1) * 128 * 1024 + (tl & 1) * 128; gemm_tile<2>(p, xb_ + 768, 1024, xb_ + 512, 1024, 128, 0, 0, gsm, p.cb + (long)tl * 16384); }

#ifndef SELFCHK
__global__ void __launch_bounds__(256, LB2) mega(KArgs ka) {
  KERNEL_PROLOGUE
#ifdef REP_PRO
  GS((long)S * 32, ph_rope(p, gid)); GS(8 * TABA_N + 24 * TABD_N, ph_tabs(p, gid)); WU(DEPTH * 256, unit_memkv(p, u, lane));
#endif
#ifdef TSEL
  unsigned long long tlast = __builtin_amdgcn_s_memrealtime();
#define TMARK(id) { if (gtid == 0) { const unsigned long long tn = __builtin_amdgcn_s_memrealtime(); ((unsigned long long*)p.bar)[id] += tn - tlast; tlast = tn; } }
#else
#define TMARK(id)
#endif
  for (int layer = 0; layer < DEPTH; ++layer) {
    PHASE_P1(layer)
#ifdef REP_P1
    PHASE_P1(layer)
#endif
    if (layer == 0) grid.sync(); else GSYNC();
    TMARK(1)
    PHASE_P2()
#ifdef REP_G
    PHASE_P2()
#endif
    GSYNC();
    TMARK(2)
    WU(2 * (ncmp * 2 / 32), unit_cmp(p, layer, u, lane));
#ifdef REP_F3
    { const int nA = nqt * 8, nD = 3 * nqt * 8; WU(nA + nD, { if (u < nA) unit_awin(p, u, WL, lane); else unit_d(p, u - nA, WL, lane); }); }
#endif
    PHASE_FLASH3(layer)
    GS((long)S * 128, item_bconv(p, layer, gid));
    WU(nc * 8, unit_bdt(p, layer, u, lane));
#ifdef REP_P3B
    WU(2 * (ncmp * 2 / 32), unit_cmp(p, layer, u, lane));
    GS((long)S * 128, item_bconv(p, layer, gid));
    WU(nc * 8, unit_bdt(p, layer, u, lane));
#endif
    GSYNC();
    TMARK(3)
    WU(nqt * 8, unit_acmp1(p, u, WL, lane));
    __syncthreads();
    PHASE_CB()
    __syncthreads();
    WU2(nc * 16, unit_bstates(p, u, WL2, lane));
#ifdef REP_P4
    __syncthreads();
    WU(nqt * 8, unit_acmp1(p, u, WL, lane));
    __syncthreads();
    PHASE_CB()
    __syncthreads();
    WU2(nc * 16, unit_bstates(p, u, WL2, lane));
#endif
    GS((long)S * 8, ph_d_merge(p, gid));
    GSYNC();
    TMARK(4)
    WU(nqt * 8, unit_acmp2(p, u, lane));
#ifdef REP_P5A
    WU(nqt * 8, unit_acmp2(p, u, lane));
#endif
    GS(65536, ph_b_scan(p, gid));
    GSYNC();
    TMARK(5)
    WU(S * 2 / 4, unit_topk4(p, u, lane));
    GSYNC();
    TMARK(6)
    { const int nu_ = (S / 32) * 2, G_ = gridDim.x; int k_ = 0;
      for (int base_ = 0; base_ < nu_; base_ += G_, ++k_) { const int ub = base_ + ((k_ & 1) ? (G_ - 1 - bid0()) : bid0()); if (ub < nu_) unit_asel_blk(p, ub, (AselLds*)smem_raw); } }
    for (;;) { __syncthreads(); if (threadIdx.x == 0) xbst[2] = atomicAdd(&p.bar[40 + layer], 1u); __syncthreads(); const int ub = (int)xbst[2]; if (ub >= nc * 8) break; unit_bout_blk(p, layer, ub, smem_raw); }
    GSYNC();
    TMARK(8)
    for (int tl = bid0(); tl < (S / 128) * 8; tl += gridDim.x) { int mt = tl % (S / 128), nt = tl / (S / 128); gemm_tile<1>(p, p.mix, NMIX, p.wt_out, NMIX, NMIX, mt * 128, nt * 128, gsm); }
#ifdef REP_P8
    for (int tl = bid0(); tl < (S / 128) * 8; tl += gridDim.x) { int mt = tl % (S / 128), nt = tl / (S / 128); gemm_tile<1>(p, p.mix, NMIX, p.wt_out, NMIX, NMIX, mt * 128, nt * 128, gsm); }
#endif
    GSYNC();
    TMARK(9)
  }
  for (int t = gw0(gwave); t < S; t += nwave) { int lane = threadIdx.x & 63; asm volatile("" : "+v"(lane)); norm_row_wave(p, DEPTH, t, false, lane); }
#ifdef TSEL
  GSYNC();
  { float us = 0.f; for (int k = 1; k < 10; ++k) if ((TSEL >> k) & 1) us += (float)((unsigned long long*)p.bar)[k] * 0.01f;
    const float kk = 2.f * log2f(us + 1.f);
    GS((long)S * 1024, p.out[gid] = kk); }
#endif
}
#else
__device__ __forceinline__ void chk_update(unsigned* slot, float diff, float ref) {
  atomicMax(&slot[0], __float_as_uint(fabsf(diff))); atomicMax(&slot[1], __float_as_uint(fabsf(ref)));
}
#define CMPB(slot, a, b_) chk_update(sl + (slot), bf2f(a) - bf2f(b_), bf2f(b_))
#define CMPF(slot, a, b_) chk_update(sl + (slot), (a) - (b_), (b_))
__global__ void __launch_bounds__(256, 1) mega(KArgs ka) {
  KERNEL_PROLOGUE
  if (gtid < 64) p.bar[gtid] = 0u;
  unsigned* sl = p.bar;
  const int layer = 0;
  PHASE_P1(layer)
  grid.sync();
  PHASE_P2()
  GSYNC();
  GS((long)S * NMIX, p2.mix[gid] = p.mix[gid]);
  GSYNC();
  PHASE_FLASH3(layer)
  WU(2 * (ncmp * 2 / 32), unit_cmp(p, layer, u, lane));
  GS((long)S * 128, item_bconv(p, layer, gid));
  WU(nc * 8, unit_bdt(p, layer, u, lane));
  GS((long)2 * ncmp * 256, ph_cmp_hid(p2, layer, gid));
  GS((long)S * 8, ph_a_win(p2, gid));
  GS((long)S * 8, ph_c(p2, layer, gid));
  GS((long)3 * S * 8, ph_d(p2, gid));
  GS((long)S * 4, ph_m(p2, layer, gid));
  GS((long)S * 1024, ph_b_conv(p2, layer, gid));
  GS((long)nc * 8, ph_b_dt2(p2, layer, gid));
  GSYNC();
  GS((long)2 * ncmp * 128, ph_cmp_out(p2, layer, gid));
  GSYNC();
  GS((long)2 * ncmp * 128, CMPB(20, p.kvc[gid], p2.kvc[gid]));
  GS((long)S * 1024, CMPB(22, p.xconv[gid], p2.xconv[gid]));
  GS((long)S * 8, { CMPF(24, p.dt[gid], p2.dt[gid]); CMPF(24, p.acs[gid], p2.acs[gid]); CMPF(24, p.wst[gid], p2.wst[gid]); });
  GSYNC();
  GS((long)2 * ncmp * 128, p2.kvc[gid] = p.kvc[gid]);
  GS((long)S * 1024, p2.xconv[gid] = p.xconv[gid]);
  GS((long)S * 8, { p2.dt[gid] = p.dt[gid]; p2.acs[gid] = p.acs[gid]; p2.wst[gid] = p.wst[gid]; });
  GSYNC();
  WU(nqt * 8, unit_acmp1(p, u, WL, lane));
  __syncthreads();
  PHASE_CB()
  __syncthreads();
  WU2(nc * 16, unit_bstates(p, u, WL2, lane));
  GS((long)S * 8, ph_a_cmp1(p2, gid));
  GS((long)nc * 2 * 128 * 128, ph_b_cb(p2, gid));
  GS((long)nc * 65536, ph_b_states(p2, gid));
  GSYNC();
  WU(nqt * 8, unit_acmp2(p, u, lane));
  GS((long)S * 2, ph_a_cmp2(p2, gid));
  GS((long)nc * 65536, CMPF(26, p.states[gid], p2.states[gid]));
  GS((long)nc * 2 * 128 * 128, { int s_ = (int)(gid & 127), l_ = (int)((gid >> 7) & 127); if (s_ <= l_) CMPF(18, p.cb[gid], p2.cb[gid]); });
  GSYNC();
  GS(65536, ph_b_scan(p, gid));
  GS(65536, ph_b_scan(p2, gid));
  GS((long)S * 512, { CMPB(0, p.ow[gid], p2.ow[gid]); CMPB(2, p.oc[gid], p2.oc[gid]); long t = gid >> 9, c = gid & 511; CMPB(4, p.mix[t * NMIX + MX_C + c], p2.mix[t * NMIX + MX_C + c]);
                      if (c < 256) CMPB(6, p.mix[t * NMIX + MX_M + c], p2.mix[t * NMIX + MX_M + c]); });
  GS((long)3 * S * 512, CMPB(8, p.dop[gid], p2.dop[gid]));
  GS((long)3 * S * 8, chk_update(sl + 10, p.dlse[gid] - p2.dlse[gid], 1.f));
  GS((long)S * 2 * 256, { long qg = gid >> 8; int bb = (int)(gid & 255); int q = (int)(qg >> 1); if (bb <= (q >> 6)) CMPF(12, p.imp[gid], p2.imp[gid]); });
  GSYNC();
  GS((long)S * 512, p2.imp[gid] = p.imp[gid]);
  GSYNC();
  WU(S * 2 / 4, unit_topk4(p, u, lane));
  WU2(nc * 32, unit_bout(p, layer, u, WL2, lane));
  GS((long)S * 2, ph_a_topk(p2, gid));
  GS((long)S * 512, ph_b_out(p2, layer, gid));
  GSYNC();
  GS((long)S * 2, { int q = (int)(gid >> 1); int nv = (q >> 6) + 1; nv = nv > 16 ? 16 : nv; int bad = 0;
    for (int k = 0; k < 16; ++k) { int mine = p.idx[gid * 16 + k]; bool found = false; for (int k2 = 0; k2 < 16; ++k2) found |= (p2.idx[gid * 16 + k2] == mine); if (k < nv) bad += !found || mine < 0; else bad += (mine >= 0); }
    chk_update(sl + 14, (float)bad, 1.f); });
  GS((long)S * 512, CMPF(28, p.ybuf[gid], p2.ybuf[gid]));
  GSYNC();
  GS((long)S * 32, p2.idx[gid] = p.idx[gid]);
  GS((long)S * 512, p2.ybuf[gid] = p.ybuf[gid]);
  GSYNC();
  for (int ub = bid0(); ub < (S / 32) * 2; ub += gridDim.x) unit_asel_blk(p, ub, (AselLds*)smem_raw);
  for (;;) { __syncthreads(); if (threadIdx.x == 0) xbst[2] = atomicAdd(&p.bar[40 + layer], 1u); __syncthreads(); const int ub = (int)xbst[2]; if (ub >= nc * 8) break; unit_bout_blk(p, layer, ub, smem_raw); }
  GS((long)S * 8, ph_a_sel(p2, gid));
  GS((long)S * 2, ph_b_norm(p2, layer, gid));
  GSYNC();
  GS((long)S * 512, { long t = gid >> 9, c = gid & 511; CMPB(16, p.mix[t * NMIX + MX_A + c], p2.mix[t * NMIX + MX_A + c]); CMPB(30, p.mix[t * NMIX + MX_B + c], p2.mix[t * NMIX + MX_B + c]); });
  GSYNC();
  { float R = 0.f;
    for (int k = 0; k < 16; ++k) { float d = __uint_as_float(p.bar[2 * k]), r = __uint_as_float(p.bar[2 * k + 1]); float q = d / (r + 1e-20f); if (CHKSEL < 0 || CHKSEL == k) R = fmaxf(R, q); }
    GS((long)SEQ * 1024, p.out[gid] = 1e4f * R); }
}
#endif

__global__ void zz_tail_pad(float* o) { asm volatile(".rept 512\n\ts_nop 0\n\t.endr" ::: "memory"); if (o) o[0] = 0.f; }
__global__ void fill_code(float* o, float v, long n) { long i = blockIdx.x * 256L + threadIdx.x; if (i < n) o[i] = v; }
extern "C" void kernel_launch(void* const* d_in, const int* in_sizes, int n_in, void* d_out, int out_size, void* d_ws, size_t ws_size, hipStream_t stream) {
  KArgs ka; memset(&ka, 0, sizeof(ka));
  for (int i = 0; i < 20; ++i) ka.in[i] = d_in[i];
  ka.out = (float*)d_out; ka.ws = (char*)d_ws;
  Params hp, hp2; memset(&hp, 0, sizeof(hp)); const size_t need = fill_ws(hp, hp2, (char*)d_ws);
  if (need > ws_size) { fprintf(stderr, "workspace too small: need %zu have %zu\n", need, ws_size); return; }
  static int grid_blocks = 0;
  if (!grid_blocks) { int dev = 0, cus = 0, per_cu = 0; (void)hipGetDevice(&dev); (void)hipDeviceGetAttribute(&cus, hipDeviceAttributeMultiprocessorCount, dev);
    (void)hipOccupancyMaxActiveBlocksPerMultiprocessor(&per_cu, mega, 256, 0); if (per_cu > LB2) per_cu = LB2; if (per_cu < 1) per_cu = 1; grid_blocks = cus * per_cu; }
  (void)hipMemsetAsync(hp.bar, 0, 16384, stream);
  void* args[] = {&ka};
  hipError_t e = hipLaunchCooperativeKernel((void*)mega, dim3(grid_blocks), dim3(256), args, 0, stream);
  if (e != hipSuccess) { (void)hipGetLastError(); fill_code<<<(unsigned)(((long)SEQ * 1024 + 255) / 256), 256, 0, stream>>>((float*)d_out, 1000.f * (float)(int)e + (float)grid_blocks, (long)SEQ * 1024); }
}
```

```cpp
#include <hip/hip_runtime.h>
#include <hip/hip_cooperative_groups.h>
#include <cstdio>
#include <cstdint>
#include <cstring>
namespace cg = cooperative_groups;
#define HD_ __device__ __forceinline__
#ifndef CHKSEL
#define CHKSEL -1
#endif
#ifndef LB2
#define LB2 2
#endif
#ifndef HD_
#define HD_ inline
#endif
#ifdef SB_IS_FLOAT
typedef float SB;
HD_ float ldf(const SB* p) { return *p; }
HD_ void stf(SB* p, float v) { *p = v; }
#else
typedef unsigned short SB;
HD_ float bf2f(unsigned short b) { unsigned u = ((unsigned)b) << 16; float f; __builtin_memcpy(&f, &u, 4); return f; }
HD_ unsigned short f2bf(float f) { unsigned u; __builtin_memcpy(&u, &f, 4); u += 0x7fffu + ((u >> 16) & 1u); return (unsigned short)(u >> 16); }
HD_ float ldf(const SB* p) { return bf2f(*p); }
HD_ void stf(SB* p, float v) { *p = f2bf(v); }
#endif

#define DM 1024
#define NPROJ 5888
#define NMIX 2304
#define NSMALL 32
#define PA_Q 0
#define PA_KV 512
#define PB_X 1280
#define PC_Q 2304
#define PC_KV 2816
#define PD_Q 3072
#define PD_KV 4608
#define PM_Q 5632
#define MX_A 0
#define MX_B 512
#define MX_C 1024
#define MX_D 1536
#define MX_M 2048
#define TABA_N 2048
#define TABD_N 132

struct Params {
  int S; int pad0;
  const float *x, *mem; const int* pos;
  const float *pre_norm, *post_norm, *w_in, *w_out, *rel_bias, *cmp_pos, *cmp_w1, *cmp_w2, *conv_w, *conv_b, *dt_bias, *a_log, *b_d,
      *b_norm, *sinks, *m_norm, *m_wkv;
  float* out;
  unsigned short* wt_in;
  unsigned short* wt_out;
  unsigned short *w1t, *w2t;
  SB* h;
  SB* proj;
  float* small;
  SB* mix;
  float* y;
  float *rope_cs, *rope_sn;
  float *tabA, *tabD;
  SB* memkv;
  float* hid;
  SB* kvc;
  float* imp;
  float* cml;
  int* idx;
  SB *oc, *ow;
  SB* dop;
  float* dlse;
  SB* xconv;
  float *dt, *acs;
  float* wst;
  float* cb;
  float* states;
  float* ybuf;
  unsigned* bar;
};

HD_ float silu_f(float x) { return x / (1.f + expf(-x)); }
HD_ float sigmoid_f(float x) { return 1.f / (1.f + expf(-x)); }
HD_ float gelu_f(float x) { return 0.5f * x * (1.f + tanhf(0.7978845608028654f * (x + 0.044715f * x * x * x))); }
HD_ float softplus_f(float x) { return fmaxf(x, 0.f) + log1pf(expf(-fabsf(x))); }

HD_ int t5_bucket(int d) {
  if (d < 16) return d < 0 ? 0 : d;
  const int thr[15] = {22, 30, 40, 54, 73, 99, 134, 182, 246, 332, 450, 609, 825, 1117, 1513};
  int b = 16;
  for (int k = 0; k < 15; ++k) b += (d >= thr[k]) ? 1 : 0;
  return b;
}

HD_ void ph_rope(const Params& p, long gid) {
  int s = (int)(gid >> 5), i = (int)(gid & 31);
  float inv = powf(150000.f, -(float)i / 32.f);
  float ang = (float)p.pos[s] * inv;
  p.rope_cs[gid] = cosf(ang); p.rope_sn[gid] = sinf(ang);
}
HD_ void ph_tabs(const Params& p, long gid) {
  if (gid < 8 * TABA_N) { int h = (int)(gid / TABA_N), d = (int)(gid % TABA_N); p.tabA[gid] = p.rel_bias[t5_bucket(d) * 32 + h]; }
  else { long g2 = gid - 8 * TABA_N; int hh = (int)(g2 / TABD_N), d = (int)(g2 % TABD_N); int gi = hh >> 3;
    int dil = gi == 0 ? 1 : (gi == 1 ? 4 : 16); p.tabD[g2] = p.rel_bias[t5_bucket(d * dil) * 32 + 8 + hh]; }
}
HD_ void ph_memkv(const Params& p, long gid) {
  int e = (int)(gid & 511), m = (int)((gid >> 9) & 255), l = (int)(gid >> 17);
  const float* row = p.mem + (long)m * DM;
  float ss = 0.f; _Pragma("unroll 16") for (int d = 0; d < DM; ++d) ss += row[d] * row[d];
  float r = 1.f / sqrtf(ss / DM + 1e-6f);
  float acc = 0.f;
  _Pragma("unroll 16") for (int d = 0; d < DM; ++d) acc += row[d] * r * p.m_norm[l * DM + d] * p.m_wkv[((long)l * DM + d) * 512 + e];
  stf(&p.memkv[gid], acc);
}
HD_ void ph_norm_row(const Params& p, int layer, int t, bool do_h) {
  const float* xin = (layer == 0) ? p.x + (long)t * DM : p.out + (long)t * DM;
  float* xo = p.out + (long)t * DM;
  float r1 = 0.f;
  if (layer > 0) { const float* y = p.y + (long)t * DM; float ss = 0.f; for (int d = 0; d < DM; ++d) ss += y[d] * y[d]; r1 = 1.f / sqrtf(ss / DM + 1e-6f); }
  float ss2 = 0.f;
  for (int d = 0; d < DM; ++d) { float v = xin[d]; if (layer > 0) v += p.y[(long)t * DM + d] * r1 * p.post_norm[(layer - 1) * DM + d]; xo[d] = v; ss2 += v * v; }
  if (!do_h) return;
  float r2 = 1.f / sqrtf(ss2 / DM + 1e-6f);
  for (int d = 0; d < DM; ++d) stf(&p.h[(long)t * DM + d], xo[d] * r2 * p.pre_norm[layer * DM + d]);
}

HD_ void ph_cmp_hid(const Params& p, int layer, long gid) {
  int u = (int)(gid & 127), hk = (int)((gid >> 7) & 1); long r = gid >> 8; int ncmp = p.S / 16; int j = (int)(r % ncmp), kv = (int)(r / ncmp);
  const float* w1 = p.cmp_w1 + ((long)(layer * 2 + kv) * 2048) * 128;
  const float* pe = p.cmp_pos + (long)(layer * 2 + kv) * 32 * 64;
  float acc = 0.f;
  for (int t = 0; t < 32; ++t) { int tok = 16 * j + t;
    _Pragma("unroll 16") for (int d = 0; d < 64; ++d) { float v = pe[t * 64 + d]; if (tok < p.S) v += ldf(&p.proj[(long)tok * NPROJ + PA_KV + kv * 128 + hk * 64 + d]);
      acc += v * w1[(long)(t * 64 + d) * 128 + u]; } }
  p.hid[gid] = gelu_f(acc);
}
HD_ void ph_cmp_out(const Params& p, int layer, long gid) {
  int d = (int)(gid & 63), hk = (int)((gid >> 6) & 1); long r = gid >> 7; int ncmp = p.S / 16; int j = (int)(r % ncmp), kv = (int)(r / ncmp);
  const float* w2 = p.cmp_w2 + (long)(layer * 2 + kv) * 128 * 64;
  const float* hd = p.hid + (((long)kv * ncmp + j) * 2 + hk) * 128;
  float acc = 0.f; for (int u = 0; u < 128; ++u) acc += hd[u] * w2[u * 64 + d];
  stf(&p.kvc[gid], acc);
}
HD_ void ph_a_cmp1(const Params& p, long gid) {
  int h = (int)(gid & 7), q = (int)(gid >> 3), g = h >> 2; int ncmp = p.S / 16;
  int jn = (q >= 31) ? ((q - 31) / 16 + 1) : 0;
  const SB* kc = p.kvc; const SB* vc = p.kvc + (long)ncmp * 128;
  float qv[64], o[64]; for (int d = 0; d < 64; ++d) { qv[d] = ldf(&p.proj[(long)q * NPROJ + PA_Q + h * 64 + d]); o[d] = 0.f; }
  float m = -1e30f, l = 0.f;
  for (int j = 0; j < jn; ++j) { const SB* kr = &kc[((long)j * 2 + g) * 64]; const SB* vr = &vc[((long)j * 2 + g) * 64];
    float s = 0.f; for (int d = 0; d < 64; ++d) s += qv[d] * ldf(&kr[d]);
    int dist = q - (16 * j + 31); s = s * 0.125f + p.tabA[h * TABA_N + (dist < TABA_N ? dist : TABA_N - 1)];
    float mn = fmaxf(m, s), a = expf(m - mn), pr = expf(s - mn); l = l * a + pr; for (int d = 0; d < 64; ++d) o[d] = o[d] * a + pr * ldf(&vr[d]); m = mn; }
  float il = jn > 0 ? 1.f / l : 0.f; for (int d = 0; d < 64; ++d) stf(&p.oc[(long)q * 512 + h * 64 + d], o[d] * il);
  p.cml[gid * 2] = m; p.cml[gid * 2 + 1] = il;
}
HD_ void ph_a_cmp2(const Params& p, long gid) {
  int g = (int)(gid & 1), q = (int)(gid >> 1); int ncmp = p.S / 16;
  float* imp = p.imp + gid * 256; for (int b = 0; b < 256; ++b) imp[b] = 0.f;
  int jn = (q >= 31) ? ((q - 31) / 16 + 1) : 0; const SB* kc = p.kvc;
  for (int hh = 0; hh < 4; ++hh) { int h = g * 4 + hh; float qv[64]; for (int d = 0; d < 64; ++d) qv[d] = ldf(&p.proj[(long)q * NPROJ + PA_Q + h * 64 + d]);
    float m = p.cml[((long)q * 8 + h) * 2], il = p.cml[((long)q * 8 + h) * 2 + 1];
    for (int j = 0; j < jn; ++j) { const SB* kr = &kc[((long)j * 2 + g) * 64]; float s = 0.f; for (int d = 0; d < 64; ++d) s += qv[d] * ldf(&kr[d]);
      int dist = q - (16 * j + 31); s = s * 0.125f + p.tabA[h * TABA_N + (dist < TABA_N ? dist : TABA_N - 1)]; float pr = expf(s - m) * il;
      imp[j >> 2] += pr; if (j + 1 < ncmp) imp[(j + 1) >> 2] += pr; } }
}
HD_ void ph_a_topk(const Params& p, long gid) {
  int q = (int)(gid >> 1); float* imp = p.imp + gid * 256; int* idx = p.idx + gid * 16; int cur = q >> 6;
  imp[0] = 1e4f; imp[cur] = 1e4f;
  for (int k = 0; k < 16; ++k) { int best = -1; float bv = -1.f;
    for (int b = 0; b <= cur; ++b) { float v = imp[b]; if (v > bv) { bv = v; best = b; } }
    idx[k] = best; if (best >= 0) imp[best] = -2.f; }
}
HD_ void ph_a_win(const Params& p, long gid) {
  int h = (int)(gid & 7), q = (int)(gid >> 3), hk = h >> 2;
  float qv[64], o[64]; for (int d = 0; d < 64; ++d) { qv[d] = ldf(&p.proj[(long)q * NPROJ + PA_Q + h * 64 + d]); o[d] = 0.f; }
  float m = -1e30f, l = 0.f; int lo = q - 511 < 0 ? 0 : q - 511;
  for (int t = lo; t <= q; ++t) { const SB* kr = &p.proj[(long)t * NPROJ + PA_KV + 4 * 128 + hk * 64]; const SB* vr = kr + 128;
    float s = 0.f; for (int d = 0; d < 64; ++d) s += qv[d] * ldf(&kr[d]); s = s * 0.125f + p.tabA[h * TABA_N + (q - t)];
    float mn = fmaxf(m, s), a = expf(m - mn), pr = expf(s - mn); l = l * a + pr; for (int d = 0; d < 64; ++d) o[d] = o[d] * a + pr * ldf(&vr[d]); m = mn; }
  float il = 1.f / l; for (int d = 0; d < 64; ++d) stf(&p.ow[(long)q * 512 + h * 64 + d], o[d] * il);
}
HD_ void ph_a_sel(const Params& p, long gid) {
  int h = (int)(gid & 7), q = (int)(gid >> 3), hk = h >> 2; const int* idx = p.idx + ((long)q * 2 + hk) * 16;
  float qv[64], o[64]; for (int d = 0; d < 64; ++d) { qv[d] = ldf(&p.proj[(long)q * NPROJ + PA_Q + h * 64 + d]); o[d] = 0.f; }
  float m = -1e30f, l = 0.f;
  for (int k = 0; k < 16; ++k) { int b = idx[k]; if (b < 0) continue;
    for (int i = 0; i < 64; ++i) { int t = b * 64 + i; if (t > q) break;
      const SB* kr = &p.proj[(long)t * NPROJ + PA_KV + 2 * 128 + hk * 64]; const SB* vr = kr + 128;
      float s = 0.f; for (int d = 0; d < 64; ++d) s += qv[d] * ldf(&kr[d]); int dist = q - t; s = s * 0.125f + p.tabA[h * TABA_N + (dist < TABA_N ? dist : TABA_N - 1)];
      float mn = fmaxf(m, s), a = expf(m - mn), pr = expf(s - mn); l = l * a + pr; for (int d = 0; d < 64; ++d) o[d] = o[d] * a + pr * ldf(&vr[d]); m = mn; } }
  float il = 1.f / l; const float* gl = p.small + (long)q * NSMALL + h * 3;
  float g0 = sigmoid_f(gl[0]), g1 = sigmoid_f(gl[1]), g2 = sigmoid_f(gl[2]);
  for (int d = 0; d < 64; ++d) { long c = (long)q * 512 + h * 64 + d; float a = g0 * ldf(&p.oc[c]) + g1 * o[d] * il + g2 * ldf(&p.ow[c]);
    SB* mp = &p.mix[(long)q * NMIX + MX_A + h * 64 + d]; stf(mp, a * ldf(mp)); }
}
HD_ void ph_c(const Params& p, int layer, long gid) {
  int h = (int)(gid & 7), q = (int)(gid >> 3), hk = h >> 2;
  float qv[64], o[64]; for (int d = 0; d < 64; ++d) { qv[d] = ldf(&p.proj[(long)q * NPROJ + PC_Q + h * 64 + d]); o[d] = 0.f; }
  float m = p.sinks[layer * 8 + h], l = 1.f; int lo = q - 127 < 0 ? 0 : q - 127;
  for (int t = lo; t <= q; ++t) { const SB* kr = &p.proj[(long)t * NPROJ + PC_KV + hk * 64]; const SB* vr = kr + 128;
    float s = 0.f; for (int d = 0; d < 64; ++d) s += qv[d] * ldf(&kr[d]); s *= 0.125f;
    float mn = fmaxf(m, s), a = expf(m - mn), pr = expf(s - mn); l = l * a + pr; for (int d = 0; d < 64; ++d) o[d] = o[d] * a + pr * ldf(&vr[d]); m = mn; }
  float il = 1.f / l; for (int d = 0; d < 64; ++d) { SB* mp = &p.mix[(long)q * NMIX + MX_C + h * 64 + d]; stf(mp, o[d] * il * ldf(mp)); }
}
HD_ void ph_d(const Params& p, long gid) {
  int h = (int)(gid & 7); long r = gid >> 3; int q = (int)(r % p.S), gi = (int)(r / p.S); int dil = gi == 0 ? 1 : (gi == 1 ? 4 : 16);
  float qv[64], o[64]; for (int d = 0; d < 64; ++d) { qv[d] = ldf(&p.proj[(long)q * NPROJ + PD_Q + gi * 512 + h * 64 + d]); o[d] = 0.f; }
  float m = -1e30f, l = 0.f;
  for (int dd = 0; dd <= 128; ++dd) { int t = q - dil * dd; if (t < 0) break;
    const SB* kr = &p.proj[(long)t * NPROJ + PD_KV + h * 64]; const SB* vr = kr + 512;
    float s = 0.f; for (int d = 0; d < 64; ++d) s += qv[d] * ldf(&kr[d]); s = s * 0.125f + p.tabD[(gi * 8 + h) * TABD_N + dd];
    float mn = fmaxf(m, s), a = expf(m - mn), pr = expf(s - mn); l = l * a + pr; for (int d = 0; d < 64; ++d) o[d] = o[d] * a + pr * ldf(&vr[d]); m = mn; }
  float il = 1.f / l; for (int d = 0; d < 64; ++d) stf(&p.dop[((long)gi * p.S + q) * 512 + h * 64 + d], o[d] * il);
  p.dlse[((long)gi * p.S + q) * 8 + h] = m + logf(l);
}
HD_ void ph_d_merge(const Params& p, long gid) {
  int h = (int)(gid & 7), q = (int)(gid >> 3);
  float l0 = p.dlse[((long)0 * p.S + q) * 8 + h], l1 = p.dlse[((long)1 * p.S + q) * 8 + h], l2 = p.dlse[((long)2 * p.S + q) * 8 + h];
  float mm = fmaxf(l0, fmaxf(l1, l2)); float e0 = expf(l0 - mm), e1 = expf(l1 - mm), e2 = expf(l2 - mm), is = 1.f / (e0 + e1 + e2);
  for (int d = 0; d < 64; ++d) { long c = (long)q * 512 + h * 64 + d;
    float v = (e0 * ldf(&p.dop[c]) + e1 * ldf(&p.dop[(long)p.S * 512 + c]) + e2 * ldf(&p.dop[(long)2 * p.S * 512 + c])) * is;
    SB* mp = &p.mix[(long)q * NMIX + MX_D + h * 64 + d]; stf(mp, v * ldf(mp)); }
}
HD_ void ph_m(const Params& p, int layer, long gid) {
  int h = (int)(gid & 3), q = (int)(gid >> 2);
  float qv[64], o[64]; for (int d = 0; d < 64; ++d) { qv[d] = ldf(&p.proj[(long)q * NPROJ + PM_Q + h * 64 + d]); o[d] = 0.f; }
  float m = -1e30f, l = 0.f; const SB* kvb = p.memkv + (long)layer * 256 * 512;
  for (int t = 0; t < 256; ++t) { const SB* kr = kvb + (long)t * 512 + h * 64; const SB* vr = kr + 256;
    float s = 0.f; for (int d = 0; d < 64; ++d) s += qv[d] * ldf(&kr[d]); s *= 0.125f;
    float mn = fmaxf(m, s), a = expf(m - mn), pr = expf(s - mn); l = l * a + pr; for (int d = 0; d < 64; ++d) o[d] = o[d] * a + pr * ldf(&vr[d]); m = mn; }
  float il = 1.f / l; for (int d = 0; d < 64; ++d) { SB* mp = &p.mix[(long)q * NMIX + MX_M + h * 64 + d]; stf(mp, o[d] * il * ldf(mp)); }
}
HD_ void ph_b_conv(const Params& p, int layer, long gid) {
  int c = (int)(gid & 1023), t = (int)(gid >> 10); const float* w = p.conv_w + (long)layer * 4 * 1024;
  float acc = p.conv_b[layer * 1024 + c];
  for (int i = 0; i < 4; ++i) { int tt = t - 3 + i; if (tt >= 0) acc += w[i * 1024 + c] * ldf(&p.proj[(long)tt * NPROJ + PB_X + c]); }
  stf(&p.xconv[gid], silu_f(acc));
}
HD_ void ph_b_dt(const Params& p, int layer, long gid) {
  int hd = (int)(gid & 7), c = (int)(gid >> 3); float a = -expf(p.a_log[layer * 8 + hd]); float cs = 0.f;
  for (int l = 0; l < 128; ++l) { int t = c * 128 + l; float dt = softplus_f(p.small[(long)t * NSMALL + 24 + hd] + p.dt_bias[layer * 8 + hd]);
    cs += dt * a; p.dt[(long)t * 8 + hd] = dt; p.acs[(long)t * 8 + hd] = cs; }
}
HD_ void ph_b_cb(const Params& p, long gid) {
  int s = (int)(gid & 127), l = (int)((gid >> 7) & 127), g = (int)((gid >> 14) & 1), c = (int)(gid >> 15);
  if (s > l) { p.cb[gid] = 0.f; return; }
  const SB* cm = &p.xconv[(long)(c * 128 + l) * 1024 + 768 + g * 128]; const SB* bm = &p.xconv[(long)(c * 128 + s) * 1024 + 512 + g * 128];
  float acc = 0.f; for (int n = 0; n < 128; ++n) acc += ldf(&cm[n]) * ldf(&bm[n]);
  p.cb[gid] = acc;
}
HD_ void ph_b_states(const Params& p, long gid) {
  int n = (int)(gid & 127), pp = (int)((gid >> 7) & 63), hd = (int)((gid >> 13) & 7), c = (int)(gid >> 16), g = hd >> 2;
  float last = p.acs[(long)(c * 128 + 127) * 8 + hd]; float acc = 0.f;
  for (int l = 0; l < 128; ++l) { long t = c * 128 + l;
    acc += ldf(&p.xconv[t * 1024 + 512 + g * 128 + n]) * expf(last - p.acs[t * 8 + hd]) * ldf(&p.xconv[t * 1024 + hd * 64 + pp]) * p.dt[t * 8 + hd]; }
  p.states[gid] = acc;
}
HD_ void ph_b_scan(const Params& p, long gid) {
  int hd = (int)(gid >> 13); int nc = p.S / 128; float h = 0.f;
  for (int c0 = 0; c0 < nc; c0 += 8) { float st[8], dc[8];
    for (int i = 0; i < 8; ++i) { st[i] = p.states[(long)(c0 + i) * 65536 + gid]; dc[i] = p.acs[(long)((c0 + i) * 128 + 127) * 8 + hd]; }
    for (int i = 0; i < 8; ++i) { p.states[(long)(c0 + i) * 65536 + gid] = h; h = h * expf(dc[i]) + st[i]; } }
}
HD_ void ph_b_out(const Params& p, int layer, long gid) {
  int pp = (int)(gid & 63), hd = (int)((gid >> 6) & 7), t = (int)(gid >> 9), g = hd >> 2, c = t >> 7, l = t & 127;
  float al = p.acs[(long)t * 8 + hd]; float acc = 0.f;
  const float* cbr = &p.cb[(((long)c * 2 + g) * 128 + l) * 128];
  for (int s = 0; s <= l; ++s) { long ts = c * 128 + s; acc += cbr[s] * expf(al - p.acs[ts * 8 + hd]) * ldf(&p.xconv[ts * 1024 + hd * 64 + pp]) * p.dt[ts * 8 + hd]; }
  float acc2 = 0.f; const float* pr = &p.states[(long)c * 65536 + ((long)hd * 64 + pp) * 128]; const SB* cm = &p.xconv[(long)t * 1024 + 768 + g * 128];
  for (int n = 0; n < 128; ++n) acc2 += ldf(&cm[n]) * pr[n];
  p.ybuf[gid] = acc + expf(al) * acc2 + ldf(&p.xconv[(long)t * 1024 + hd * 64 + pp]) * p.b_d[layer * 8 + hd];
}
HD_ void ph_b_norm(const Params& p, int layer, long gid) {
  int g = (int)(gid & 1), t = (int)(gid >> 1); float ss = 0.f;
  for (int i = 0; i < 256; ++i) { float v = p.ybuf[(long)t * 512 + g * 256 + i] * ldf(&p.mix[(long)t * NMIX + MX_B + g * 256 + i]); ss += v * v; }
  float r = 1.f / sqrtf(ss / 256.f + 1e-6f);
  for (int i = 0; i < 256; ++i) { SB* mp = &p.mix[(long)t * NMIX + MX_B + g * 256 + i]; float v = p.ybuf[(long)t * 512 + g * 256 + i] * ldf(mp);
    stf(mp, v * r * p.b_norm[layer * 512 + g * 256 + i]); }
}

HD_ void ph_b_dt2(const Params& p, int layer, long gid) {
  int hd = (int)(gid & 7), c = (int)(gid >> 3); float a = -expf(p.a_log[layer * 8 + hd]); float cs = 0.f;
  for (int l = 0; l < 128; ++l) { int t = c * 128 + l; float dt = softplus_f(p.small[(long)t * NSMALL + 24 + hd] + p.dt_bias[layer * 8 + hd]);
    cs += dt * a; p.dt[(long)t * 8 + hd] = dt; p.acs[(long)t * 8 + hd] = cs; }
  for (int l = 0; l < 128; ++l) { long t = c * 128 + l; p.wst[t * 8 + hd] = p.dt[t * 8 + hd] * expf(cs - p.acs[t * 8 + hd]); }
}
HD_ void ph_b_states2(const Params& p, long gid) {
  int pp = (int)(gid & 63), n = (int)((gid >> 6) & 127), hd = (int)((gid >> 13) & 7), c = (int)(gid >> 16), g = hd >> 2;
  float acc = 0.f;
  _Pragma("unroll 16") for (int l = 0; l < 128; ++l) { long t = c * 128 + l; acc += ldf(&p.xconv[t * 1024 + 512 + g * 128 + n]) * p.wst[t * 8 + hd] * ldf(&p.xconv[t * 1024 + hd * 64 + pp]); }
  p.states[gid] = acc;
}
HD_ void ph_b_out2(const Params& p, int layer, long gid) {
  int pp = (int)(gid & 63), hd = (int)((gid >> 6) & 7), t = (int)(gid >> 9), g = hd >> 2, c = t >> 7, l = t & 127;
  float al = p.acs[(long)t * 8 + hd]; float acc = 0.f;
  const float* cbr = &p.cb[(((long)c * 2 + g) * 128 + l) * 128];
  _Pragma("unroll 8") for (int s = 0; s <= l; ++s) { long ts = c * 128 + s; acc += cbr[s] * expf(al - p.acs[ts * 8 + hd]) * p.dt[ts * 8 + hd] * ldf(&p.xconv[ts * 1024 + hd * 64 + pp]); }
  float acc2 = 0.f; const float* pr = &p.states[(long)c * 65536 + (long)hd * 8192 + pp]; const SB* cm = &p.xconv[(long)t * 1024 + 768 + g * 128];
  _Pragma("unroll 16") for (int n = 0; n < 128; ++n) acc2 += ldf(&cm[n]) * pr[n * 64];
  p.ybuf[gid] = acc + expf(al) * acc2 + ldf(&p.xconv[(long)t * 1024 + hd * 64 + pp]) * p.b_d[layer * 8 + hd];
}

typedef __attribute__((ext_vector_type(8))) short bf16x8;
typedef __attribute__((ext_vector_type(16))) float f32x16;
typedef short v4i16_t __attribute__((ext_vector_type(4)));
typedef __bf16 bf2_t __attribute__((ext_vector_type(2)));
typedef float f2_t __attribute__((ext_vector_type(2)));
typedef unsigned u32x4 __attribute__((ext_vector_type(4)));
#define LDS3 __attribute__((address_space(3)))
typedef __attribute__((address_space(1))) const void* gptr_t;
typedef __attribute__((address_space(3))) void* lptr_t;
#define L2E 1.4426950408889634f
#define LN2 0.6931471805599453f
#define QSC (0.125f * L2E)
#ifndef FTHR
#define FTHR 8.0f
#endif
#define NINF (-__builtin_huge_valf())

struct WaveLds { unsigned short v[4096]; float tab[640]; float xch[32]; float pad[32]; };

__device__ __forceinline__ unsigned pk2(float a, float b) { f2_t v = {a, b}; bf2_t r = __builtin_convertvector(v, bf2_t); return __builtin_bit_cast(unsigned, r); }
__device__ __forceinline__ int crow(int e, int hi) { return (e & 3) + 8 * (e >> 2) + 4 * hi; }
__device__ __forceinline__ bf16x8 pack8(const f32x16& s, int o) {
  u32x4 r; r[0] = pk2(s[o], s[o + 1]); r[1] = pk2(s[o + 2], s[o + 3]); r[2] = pk2(s[o + 4], s[o + 5]); r[3] = pk2(s[o + 6], s[o + 7]); return __builtin_bit_cast(bf16x8, r); }
__device__ __forceinline__ f32x16 zero16() { f32x16 z;
#pragma unroll
  for (int e = 0; e < 16; ++e) z[e] = 0.f; return z; }
#define MFMA32(a, b, c) __builtin_amdgcn_mfma_f32_32x32x16_bf16((a), (b), (c), 0, 0, 0)

struct FlashState { f32x16 o0, o1; float m, l; };
__device__ __forceinline__ float wave_sum_f(float v) {
#pragma unroll
  for (int o = 32; o > 0; o >>= 1) v += __shfl_xor(v, o);
  return v; }

__device__ __forceinline__ void flash_core1(FlashState& st, f32x16& s, const unsigned short* vimg, float* xch, int lane) {
  const int r32 = lane & 31, hi = lane >> 5;
  float mx = s[0];
#pragma unroll
  for (int e = 1; e < 16; ++e) mx = fmaxf(mx, s[e]);
  mx = fmaxf(mx, __shfl_xor(mx, 32));
  if (__any(mx > st.m + FTHR)) {
    const float mn = fmaxf(st.m, mx); const float al = __builtin_amdgcn_exp2f(st.m - mn); st.m = mn; st.l *= al; xch[r32] = al;
#pragma unroll
    for (int e = 0; e < 16; ++e) { const float a = xch[crow(e, hi)]; st.o0[e] *= a; st.o1[e] *= a; }
  }
  float ps = 0.f;
#pragma unroll
  for (int e = 0; e < 16; ++e) { s[e] = __builtin_amdgcn_exp2f(s[e] - st.m); ps += s[e]; }
  st.l += ps;
  const bf16x8 pa0 = pack8(s, 0), pa1 = pack8(s, 8);
  const unsigned short* vb = vimg + (4 * hi + ((lane & 15) >> 2)) * 32 + ((lane >> 4) & 1) * 16 + (lane & 3) * 4;
#pragma unroll
  for (int s2 = 0; s2 < 2; ++s2) {
#pragma unroll
    for (int db = 0; db < 2; ++db) {
      const v4i16_t lo = __builtin_amdgcn_ds_read_tr16_b64_v4i16((LDS3 v4i16_t*)(vb + db * 2048 + s2 * 512));
      const v4i16_t hh = __builtin_amdgcn_ds_read_tr16_b64_v4i16((LDS3 v4i16_t*)(vb + db * 2048 + s2 * 512 + 256));
      const bf16x8 vf = {lo[0], lo[1], lo[2], lo[3], hh[0], hh[1], hh[2], hh[3]};
      if (db == 0) st.o0 = MFMA32(s2 ? pa1 : pa0, vf, st.o0); else st.o1 = MFMA32(s2 ? pa1 : pa0, vf, st.o1);
    }
  }
}
template <class VRow, class Fix>
__device__ __forceinline__ void flash_tile(FlashState& st, const bf16x8 (&qf)[4], const SB* kp, VRow vrow, Fix fix, WaveLds* L, int lane) {
  const int r32 = lane & 31, hi = lane >> 5;
  bf16x8 kf[4];
#pragma unroll
  for (int d0 = 0; d0 < 4; ++d0) kf[d0] = *(const bf16x8*)(kp + d0 * 16 + hi * 8);
#pragma unroll
  for (int i = 0; i < 4; ++i) { const int c = lane + 64 * i, key = c >> 3, ch = c & 7; const SB* vp = vrow(key); const uint4 vv = *(const uint4*)(vp + ch * 8);
    *(uint4*)&L->v[(ch >> 2) * 2048 + key * 32 + (ch & 3) * 8] = vv; }
  f32x16 s = zero16();
#pragma unroll
  for (int d0 = 0; d0 < 4; ++d0) s = MFMA32(kf[d0], qf[d0], s);
  fix(s);
  flash_core1(st, s, L->v, L->xch, lane);
}
__device__ __forceinline__ void flash_core2(FlashState& st, f32x16& s0, f32x16& s1, const unsigned short* vimg, float* xch, int lane) {
  const int r32 = lane & 31, hi = lane >> 5;
  float mx = fmaxf(s0[0], s1[0]);
#pragma unroll
  for (int e = 1; e < 16; ++e) mx = fmaxf(mx, fmaxf(s0[e], s1[e]));
  mx = fmaxf(mx, __shfl_xor(mx, 32));
  if (__any(mx > st.m + FTHR)) {
    const float mn = fmaxf(st.m, mx); const float al = __builtin_amdgcn_exp2f(st.m - mn); st.m = mn; st.l *= al; xch[r32] = al;
#pragma unroll
    for (int e = 0; e < 16; ++e) { const float a = xch[crow(e, hi)]; st.o0[e] *= a; st.o1[e] *= a; }
  }
  float ps = 0.f;
#pragma unroll
  for (int e = 0; e < 16; ++e) { s0[e] = __builtin_amdgcn_exp2f(s0[e] - st.m); s1[e] = __builtin_amdgcn_exp2f(s1[e] - st.m); ps += s0[e] + s1[e]; }
  st.l += ps;
  bf16x8 pa[4]; pa[0] = pack8(s0, 0); pa[1] = pack8(s0, 8); pa[2] = pack8(s1, 0); pa[3] = pack8(s1, 8);
  const unsigned short* vb = vimg + (4 * hi + ((lane & 15) >> 2)) * 32 + ((lane >> 4) & 1) * 16 + (lane & 3) * 4;
#pragma unroll
  for (int kk = 0; kk < 4; ++kk) {
#pragma unroll
    for (int db = 0; db < 2; ++db) {
      const v4i16_t lo = __builtin_amdgcn_ds_read_tr16_b64_v4i16((LDS3 v4i16_t*)(vb + db * 2048 + kk * 512));
      const v4i16_t hh = __builtin_amdgcn_ds_read_tr16_b64_v4i16((LDS3 v4i16_t*)(vb + db * 2048 + kk * 512 + 256));
      const bf16x8 vf = {lo[0], lo[1], lo[2], lo[3], hh[0], hh[1], hh[2], hh[3]};
      if (db == 0) st.o0 = MFMA32(pa[kk], vf, st.o0); else st.o1 = MFMA32(pa[kk], vf, st.o1);
    }
  }
}
#ifndef FT2
#define FT2 1
#endif
template <class VRow, class Fix0, class Fix1>
__device__ __forceinline__ void flash_tile2(FlashState& st, const bf16x8 (&qf)[4], const SB* kp0, const SB* kp1, VRow vrow, Fix0 fix0, Fix1 fix1, WaveLds* L, int lane) {
  if (!FT2) { flash_tile(st, qf, kp0, [&](int key) { return vrow(key); }, fix0, L, lane); flash_tile(st, qf, kp1, [&](int key) { return vrow(key + 32); }, fix1, L, lane); return; }
  const int hi = lane >> 5;
  bf16x8 kf0[4], kf1[4];
#pragma unroll
  for (int d0 = 0; d0 < 4; ++d0) { kf0[d0] = *(const bf16x8*)(kp0 + d0 * 16 + hi * 8); kf1[d0] = *(const bf16x8*)(kp1 + d0 * 16 + hi * 8); }
#pragma unroll
  for (int i = 0; i < 8; ++i) { const int c = lane + 64 * i, key = c >> 3, ch = c & 7; const SB* vp = vrow(key); const uint4 vv = *(const uint4*)(vp + ch * 8);
    *(uint4*)&L->v[(ch >> 2) * 2048 + key * 32 + (ch & 3) * 8] = vv; }
  f32x16 s0 = zero16(), s1 = zero16();
#pragma unroll
  for (int d0 = 0; d0 < 4; ++d0) { s0 = MFMA32(kf0[d0], qf[d0], s0); s1 = MFMA32(kf1[d0], qf[d0], s1); }
  fix0(s0); fix1(s1);
  flash_core2(st, s0, s1, L->v, L->xch, lane);
}
__device__ __forceinline__ float flash_finish(FlashState& st, WaveLds* L, int lane) {
  const int r32 = lane & 31, hi = lane >> 5;
  const float lt = st.l + __shfl_xor(st.l, 32); const float inv = lt > 0.f ? 1.f / lt : 0.f;
  L->xch[r32] = inv;
#pragma unroll
  for (int e = 0; e < 16; ++e) { const float a = L->xch[crow(e, hi)]; st.o0[e] *= a; st.o1[e] *= a; }
  return (st.m + __builtin_amdgcn_logf(lt)) * LN2;
}
__device__ __forceinline__ void load_q(bf16x8 (&qf)[4], const SB* qp, int hi) {
#pragma unroll
  for (int d0 = 0; d0 < 4; ++d0) qf[d0] = *(const bf16x8*)(qp + d0 * 16 + hi * 8);
}
__device__ __forceinline__ void fix_tab(f32x16& s, const WaveLds* L, int base, int lane, bool chk, int kb) {
  const int r32 = lane & 31, hi = lane >> 5; const float* tp = L->tab + base + r32 + 32 - 4 * hi;
#pragma unroll
  for (int e = 0; e < 16; ++e) { const int kk = (e & 3) + 8 * (e >> 2); float v = s[e] * QSC + tp[-kk]; if (chk && (kb + kk + 4 * hi < 0)) v = NINF; s[e] = v; }
}

__device__ __forceinline__ void unit_c(const Params& p, int layer, int u, WaveLds* L, int lane) {
  const int h = u & 7, qt = u >> 3, q0 = qt * 32, hk = h >> 2, r32 = lane & 31, hi = lane >> 5;
  for (int x = lane; x < 192; x += 64) { const int dist = x - 32; L->tab[x] = (dist >= 0 && dist <= 127) ? 0.f : NINF; }
  bf16x8 qf[4]; load_q(qf, p.proj + (long)(q0 + r32) * NPROJ + PC_Q + h * 64, hi);
  FlashState st; st.o0 = zero16(); st.o1 = zero16(); st.m = p.sinks[layer * 8 + h] * L2E; st.l = hi ? 0.f : 1.f;
  const SB* kvb = p.proj + PC_KV + hk * 64; const bool chk = q0 < 128;
  for (int t = 0; t < 4; t += 2) { const int kb = q0 - 128 + 32 * t; int tok0 = kb + r32, tok1 = kb + 32 + r32; tok0 = tok0 < 0 ? 0 : tok0; tok1 = tok1 < 0 ? 0 : tok1;
    flash_tile2(st, qf, kvb + (long)tok0 * NPROJ, kvb + (long)tok1 * NPROJ, [&](int key) { int tk = kb + key; tk = tk < 0 ? 0 : tk; return kvb + 128 + (long)tk * NPROJ; },
                [&](f32x16& s) { fix_tab(s, L, 128 - 32 * t, lane, chk, kb); }, [&](f32x16& s) { fix_tab(s, L, 96 - 32 * t, lane, chk, kb + 32); }, L, lane); }
  { const int t = 4; const int kb = q0 - 128 + 32 * t; int tok = kb + r32; tok = tok < 0 ? 0 : tok;
    flash_tile(st, qf, kvb + (long)tok * NPROJ, [&](int key) { int tk = kb + key; tk = tk < 0 ? 0 : tk; return kvb + 128 + (long)tk * NPROJ; },
               [&](f32x16& s) { fix_tab(s, L, 128 - 32 * t, lane, chk, kb); }, L, lane); }
  flash_finish(st, L, lane);
#pragma unroll
  for (int e = 0; e < 16; ++e) { SB* mp = p.mix + (long)(q0 + crow(e, hi)) * NMIX + MX_C + h * 64 + r32; mp[0] = f2bf(st.o0[e] * bf2f(mp[0])); mp[32] = f2bf(st.o1[e] * bf2f(mp[32])); }
}
__device__ __forceinline__ void unit_m(const Params& p, int layer, int u, WaveLds* L, int lane) {
  const int h = u & 3, qt = u >> 2, q0 = qt * 32, r32 = lane & 31, hi = lane >> 5;
  bf16x8 qf[4]; load_q(qf, p.proj + (long)(q0 + r32) * NPROJ + PM_Q + h * 64, hi);
  FlashState st; st.o0 = zero16(); st.o1 = zero16(); st.m = -1e30f; st.l = 0.f;
  const SB* kb = p.memkv + (long)layer * 256 * 512 + h * 64;
  for (int t = 0; t < 8; t += 2) { auto fx = [&](f32x16& s) {
#pragma unroll
      for (int e = 0; e < 16; ++e) s[e] *= QSC; };
    flash_tile2(st, qf, kb + (long)(32 * t + r32) * 512, kb + (long)(32 * t + 32 + r32) * 512, [&](int key) { return kb + 256 + (long)(32 * t + key) * 512; }, fx, fx, L, lane); }
  flash_finish(st, L, lane);
#pragma unroll
  for (int e = 0; e < 16; ++e) { SB* mp = p.mix + (long)(q0 + crow(e, hi)) * NMIX + MX_M + h * 64 + r32; mp[0] = f2bf(st.o0[e] * bf2f(mp[0])); mp[32] = f2bf(st.o1[e] * bf2f(mp[32])); }
}
__device__ __forceinline__ void unit_awin(const Params& p, int u, WaveLds* L, int lane) {
  const int h = u & 7, qt = u >> 3, q0 = qt * 32, hk = h >> 2, r32 = lane & 31, hi = lane >> 5;
  for (int x = lane; x < 608; x += 64) { const int dist = x - 32; L->tab[x] = (dist >= 0 && dist <= 511) ? p.tabA[h * TABA_N + dist] * L2E : NINF; }
  bf16x8 qf[4]; load_q(qf, p.proj + (long)(q0 + r32) * NPROJ + PA_Q + h * 64, hi);
  FlashState st; st.o0 = zero16(); st.o1 = zero16(); st.m = -1e30f; st.l = 0.f;
  const SB* kvb = p.proj + PA_KV + 4 * 128 + hk * 64; const bool chk = q0 < 512;
  { const int t = 0; const int kb = q0 - 512; if (kb + 31 >= 0) { int tok = kb + r32; tok = tok < 0 ? 0 : tok;
    flash_tile(st, qf, kvb + (long)tok * NPROJ, [&](int key) { int tk = kb + key; tk = tk < 0 ? 0 : tk; return kvb + 128 + (long)tk * NPROJ; },
               [&](f32x16& s) { fix_tab(s, L, 512 - 32 * t, lane, chk, kb); }, L, lane); } }
  for (int t = 1; t < 17; t += 2) { const int kb = q0 - 512 + 32 * t; if (kb + 63 < 0) continue; int tok0 = kb + r32, tok1 = kb + 32 + r32; tok0 = tok0 < 0 ? 0 : tok0; tok1 = tok1 < 0 ? 0 : tok1;
    flash_tile2(st, qf, kvb + (long)tok0 * NPROJ, kvb + (long)tok1 * NPROJ, [&](int key) { int tk = kb + key; tk = tk < 0 ? 0 : tk; return kvb + 128 + (long)tk * NPROJ; },
                [&](f32x16& s) { fix_tab(s, L, 512 - 32 * t, lane, chk, kb); }, [&](f32x16& s) { fix_tab(s, L, 480 - 32 * t, lane, chk, kb + 32); }, L, lane); }
  flash_finish(st, L, lane);
#pragma unroll
  for (int e = 0; e < 16; ++e) { SB* op = p.ow + (long)(q0 + crow(e, hi)) * 512 + h * 64 + r32; op[0] = f2bf(st.o0[e]); op[32] = f2bf(st.o1[e]); }
}
__device__ __forceinline__ void unit_d(const Params& p, int u, WaveLds* L, int lane) {
  const int S = p.S, per = (S / 32) * 8; const int gi = u / per, u2 = u % per; const int h = u2 & 7, v = u2 >> 3;
  const int dil = gi == 0 ? 1 : (gi == 1 ? 4 : 16); const int tiles_per_res = (S / dil) / 32; const int r = v / tiles_per_res, it = v % tiles_per_res, i0 = it * 32;
  const int r32 = lane & 31, hi = lane >> 5;
  for (int x = lane; x < 192; x += 64) { const int dd = x - 32; L->tab[x] = (dd >= 0 && dd <= 128) ? p.tabD[(gi * 8 + h) * TABD_N + dd] * L2E : NINF; }
  bf16x8 qf[4]; load_q(qf, p.proj + (long)(r + dil * (i0 + r32)) * NPROJ + PD_Q + gi * 512 + h * 64, hi);
  FlashState st; st.o0 = zero16(); st.o1 = zero16(); st.m = -1e30f; st.l = 0.f;
  const SB* kvb = p.proj + PD_KV + h * 64; const bool chk = i0 < 128;
  for (int t = 0; t < 4; t += 2) { const int jb = i0 - 128 + 32 * t; if (jb + 63 < 0) continue; int j0 = jb + r32, j1 = jb + 32 + r32; j0 = j0 < 0 ? 0 : j0; j1 = j1 < 0 ? 0 : j1;
    flash_tile2(st, qf, kvb + (long)(r + dil * j0) * NPROJ, kvb + (long)(r + dil * j1) * NPROJ, [&](int key) { int jj = jb + key; jj = jj < 0 ? 0 : jj; return kvb + 512 + (long)(r + dil * jj) * NPROJ; },
                [&](f32x16& s) { fix_tab(s, L, 128 - 32 * t, lane, chk, jb); }, [&](f32x16& s) { fix_tab(s, L, 96 - 32 * t, lane, chk, jb + 32); }, L, lane); }
  { const int t = 4; const int jb = i0 - 128 + 32 * t; int j = jb + r32; j = j < 0 ? 0 : j;
    flash_tile(st, qf, kvb + (long)(r + dil * j) * NPROJ, [&](int key) { int jj = jb + key; jj = jj < 0 ? 0 : jj; return kvb + 512 + (long)(r + dil * jj) * NPROJ; },
               [&](f32x16& s) { fix_tab(s, L, 128 - 32 * t, lane, chk, jb); }, L, lane); }
  const float lse = flash_finish(st, L, lane);
#pragma unroll
  for (int e = 0; e < 16; ++e) { const long tok = r + dil * (i0 + crow(e, hi)); SB* op = p.dop + ((long)gi * S + tok) * 512 + h * 64 + r32; op[0] = f2bf(st.o0[e]); op[32] = f2bf(st.o1[e]); }
  if (hi == 0) p.dlse[((long)gi * S + r + dil * (i0 + r32)) * 8 + h] = lse;
}
__device__ __forceinline__ void fix_cmp(f32x16& s, const Params& p, int h, int q0, int t, int lane) {
  const int r32 = lane & 31, hi = lane >> 5; const int dq = q0 + r32 - 31 - 16 * (32 * t + 4 * hi);
  const bool far = (q0 - 16 * (32 * t + 31) - 31) >= 1513; const float c31 = p.tabA[h * TABA_N + 2047] * L2E;
#pragma unroll
  for (int e = 0; e < 16; ++e) { const int kk = (e & 3) + 8 * (e >> 2); const int dist = dq - 16 * kk; float b;
    if (far) b = c31; else { const int dc = dist < 0 ? 0 : (dist > 2047 ? 2047 : dist); b = p.tabA[h * TABA_N + dc] * L2E; }
    s[e] = dist < 0 ? NINF : s[e] * QSC + b; }
}
__device__ __forceinline__ void unit_acmp1(const Params& p, int u, WaveLds* L, int lane) {
  const int h = u & 7, qt = (p.S / 32 - 1) - (u >> 3), q0 = qt * 32, g = h >> 2, r32 = lane & 31, hi = lane >> 5; const int ncmp = p.S / 16;
  bf16x8 qf[4]; load_q(qf, p.proj + (long)(q0 + r32) * NPROJ + PA_Q + h * 64, hi);
  FlashState st; st.o0 = zero16(); st.o1 = zero16(); st.m = -1e30f; st.l = 0.f;
  const int jn = q0 / 16 + 1, nt = (jn + 31) / 32; const SB* kc = p.kvc + g * 64; const SB* vc = p.kvc + (long)ncmp * 128 + g * 64;
  int t = 0;
  for (; t + 1 < nt; t += 2) { int j0 = 32 * t + r32, j1 = j0 + 32; j0 = j0 >= ncmp ? ncmp - 1 : j0; j1 = j1 >= ncmp ? ncmp - 1 : j1;
    flash_tile2(st, qf, kc + (long)j0 * 128, kc + (long)j1 * 128, [&](int key) { int jj = 32 * t + key; jj = jj >= ncmp ? ncmp - 1 : jj; return vc + (long)jj * 128; },
                [&](f32x16& s) { fix_cmp(s, p, h, q0, t, lane); }, [&](f32x16& s) { fix_cmp(s, p, h, q0, t + 1, lane); }, L, lane); }
  if (t < nt) { int j = 32 * t + r32; j = j >= ncmp ? ncmp - 1 : j;
    flash_tile(st, qf, kc + (long)j * 128, [&](int key) { int jj = 32 * t + key; jj = jj >= ncmp ? ncmp - 1 : jj; return vc + (long)jj * 128; },
               [&](f32x16& s) { fix_cmp(s, p, h, q0, t, lane); }, L, lane); }
  const float lt = st.l + __shfl_xor(st.l, 32); const float inv = lt > 0.f ? 1.f / lt : 0.f;
  flash_finish(st, L, lane);
#pragma unroll
  for (int e = 0; e < 16; ++e) { SB* op = p.oc + (long)(q0 + crow(e, hi)) * 512 + h * 64 + r32; op[0] = f2bf(st.o0[e]); op[32] = f2bf(st.o1[e]); }
  if (hi == 0) { p.cml[((long)(q0 + r32) * 8 + h) * 2] = st.m; p.cml[((long)(q0 + r32) * 8 + h) * 2 + 1] = inv; }
}
__device__ __forceinline__ void unit_acmp2(const Params& p, int u, int lane) {
  const int part = u & 3, g = (u >> 2) & 1, qt = (p.S / 32 - 1) - (u >> 3), q0 = qt * 32, r32 = lane & 31, hi = lane >> 5; const int ncmp = p.S / 16;
  const int jn = q0 / 16 + 1, nt = (jn + 31) / 32; const SB* kc = p.kvc + g * 64; float carry = 0.f;
  const int tper = (nt + 3) >> 2, tbeg = part * tper, tend = (tbeg + tper < nt) ? tbeg + tper : nt; if (tbeg >= nt) return;
  float* impq = p.imp + ((long)(q0 + r32) * 2 + g) * 256;
  const SB* qbase = p.proj + (long)(q0 + r32) * NPROJ + PA_Q + g * 256; const float* cmlq = p.cml + ((long)(q0 + r32) * 8 + g * 4) * 2;
  for (int t = (tbeg > 0 ? tbeg - 1 : 0); t < tend; ++t) { int j = 32 * t + r32; j = j >= ncmp ? ncmp - 1 : j; const SB* kp = kc + (long)j * 128;
    bf16x8 kf[4];
#pragma unroll
    for (int d0 = 0; d0 < 4; ++d0) kf[d0] = *(const bf16x8*)(kp + d0 * 16 + hi * 8);
    float accA[4] = {0.f, 0.f, 0.f, 0.f}, accL[4] = {0.f, 0.f, 0.f, 0.f};
#pragma unroll 1
    for (int hh = 0; hh < 4; ++hh) { bf16x8 qf[4]; load_q(qf, qbase + hh * 64, hi); const float m = cmlq[hh * 2], il = cmlq[hh * 2 + 1];
      f32x16 s = zero16();
#pragma unroll
      for (int d0 = 0; d0 < 4; ++d0) s = MFMA32(kf[d0], qf[d0], s);
      fix_cmp(s, p, g * 4 + hh, q0, t, lane);
#pragma unroll
      for (int e = 0; e < 16; ++e) { const float pr = __builtin_amdgcn_exp2f(s[e] - m) * il; accA[e >> 2] += pr; if ((e & 3) == 3) accL[e >> 2] += pr; } }
    float oth[4];
#pragma unroll
    for (int eg = 0; eg < 4; ++eg) oth[eg] = __shfl_xor(accL[eg], 32);
#pragma unroll
    for (int eg = 0; eg < 4; ++eg) { const float prev = hi ? oth[eg] : (eg > 0 ? oth[eg > 0 ? eg - 1 : 0] : carry); if (t >= tbeg) impq[8 * t + 2 * eg + hi] = 2.f * accA[eg] - accL[eg] + prev; }
    carry = oth[3]; }
}
__device__ __forceinline__ float wave_max_f(float v) {
#pragma unroll
  for (int o = 32; o > 0; o >>= 1) v = fmaxf(v, __shfl_xor(v, o));
  return v; }
__device__ __forceinline__ int wave_min_i(int v) {
#pragma unroll
  for (int o = 32; o > 0; o >>= 1) { const int w = __shfl_xor(v, o); v = w < v ? w : v; }
  return v; }
__device__ __forceinline__ void unit_topk(const Params& p, int u, int lane) {
  const int q = u >> 1, cur = q >> 6; const float* imp = p.imp + (long)u * 256; int* idx = p.idx + (long)u * 16;
  float v[4];
#pragma unroll
  for (int k = 0; k < 4; ++k) { const int b = lane + 64 * k; float x = (b <= cur) ? imp[b] : -1.f; if (b == 0 || b == cur) x = 1e4f; v[k] = x; }
  int mine = -1;
  for (int k = 0; k < 16; ++k) {
    float lm = fmaxf(fmaxf(v[0], v[1]), fmaxf(v[2], v[3])); const float m = wave_max_f(lm);
    int cand = 0x7fffffff;
#pragma unroll
    for (int kk = 3; kk >= 0; --kk) if (v[kk] == m) cand = lane + 64 * kk;
    const int bsel = wave_min_i(cand);
#pragma unroll
    for (int kk = 0; kk < 4; ++kk) if (lane + 64 * kk == bsel) v[kk] = -2.f;
    if (lane == k) mine = (m >= 0.f) ? bsel : -1;
  }
  if (lane < 16) idx[lane] = mine;
}
template <bool STORE = true>
__device__ __forceinline__ void unit_asel(const Params& p, int u, WaveLds* L, int lane) {
  const int g = u & 1, q = u >> 1, r32 = lane & 31, hi = lane >> 5, hh = r32 & 3, h = g * 4 + hh;
  bf16x8 qf[4]; load_q(qf, p.proj + (long)q * NPROJ + PA_Q + h * 64, hi);
  FlashState st; st.o0 = zero16(); st.o1 = zero16(); st.m = -1e30f; st.l = 0.f;
  const int* idx = p.idx + (long)u * 16; const SB* kvb = p.proj + PA_KV + 2 * 128 + g * 64; const float c31 = p.tabA[h * TABA_N + 2047] * L2E;
  for (int k = 0; k < 16; ++k) { const int b = __builtin_amdgcn_readfirstlane(idx[k]); if (b < 0) continue;
    for (int kt = 0; kt < 2; ++kt) { const int t0 = b * 64 + kt * 32; if (t0 > q) continue;
      const bool far = (q - (t0 + 31)) >= 1513; const bool edge = (t0 + 31 > q);
      flash_tile(st, qf, kvb + (long)(t0 + r32) * NPROJ, [&](int key) { return kvb + 128 + (long)(t0 + key) * NPROJ; },
                 [&](f32x16& s) {
#pragma unroll
                   for (int e = 0; e < 16; ++e) { const int tk = t0 + (e & 3) + 8 * (e >> 2) + 4 * hi; const int dist = q - tk; float bsv;
                     if (far) bsv = c31; else { const int dc = dist < 0 ? 0 : (dist > 2047 ? 2047 : dist); bsv = p.tabA[h * TABA_N + dc] * L2E; }
                     float vv = s[e] * QSC + bsv; if (edge && dist < 0) vv = NINF; s[e] = vv; } }, L, lane); } }
  flash_finish(st, L, lane);
  if (!STORE) { asm volatile("" :: "v"(st.o0[0]), "v"(st.o1[3])); return; }
  if (hi == 0) {
#pragma unroll
    for (int e = 0; e < 4; ++e) { const int he = g * 4 + e; const float* gl = p.small + (long)q * NSMALL + he * 3;
      const float g0 = sigmoid_f(gl[0]), g1 = sigmoid_f(gl[1]), g2 = sigmoid_f(gl[2]);
#pragma unroll
      for (int db = 0; db < 2; ++db) { const long c = (long)q * 512 + he * 64 + db * 32 + r32; const float os = db ? st.o1[e] : st.o0[e];
        const float a = g0 * bf2f(p.oc[c]) + g1 * os + g2 * bf2f(p.ow[c]); SB* mp = p.mix + (long)q * NMIX + MX_A + he * 64 + db * 32 + r32; *mp = f2bf(a * bf2f(*mp)); } }
  }
}

struct WaveLds2 { unsigned short x[2048]; unsigned short b[2048]; float acs[128]; float dtv[128]; float xch[64]; };
template <bool SCALE, class RowScale>
__device__ __forceinline__ void stage_slab(unsigned short* dst, const SB* src, long ld, RowScale rs, int lane) {
#pragma unroll
  for (int i = 0; i < 4; ++i) { const int c = lane + 64 * i, row = c >> 3, ch = c & 7; uint4 vv = *(const uint4*)(src + (long)row * ld + ch * 8);
    if (SCALE) { const float sc = rs(row); unsigned w[4] = {vv.x, vv.y, vv.z, vv.w};
#pragma unroll
      for (int k = 0; k < 4; ++k) { const float lo = __uint_as_float(w[k] << 16) * sc, hi2 = __uint_as_float(w[k] & 0xffff0000u) * sc; w[k] = pk2(lo, hi2); }
      vv.x = w[0]; vv.y = w[1]; vv.z = w[2]; vv.w = w[3]; }
    *(uint4*)&dst[(ch >> 2) * 1024 + row * 32 + (ch & 3) * 8] = vv; }
}
__device__ __forceinline__ bf16x8 slab_frag(const unsigned short* img, int cb, int s2, int lane) {
  const int hi = lane >> 5; const unsigned short* vb = img + (4 * hi + ((lane & 15) >> 2)) * 32 + ((lane >> 4) & 1) * 16 + (lane & 3) * 4 + cb * 1024 + s2 * 512;
  const v4i16_t lo = __builtin_amdgcn_ds_read_tr16_b64_v4i16((LDS3 v4i16_t*)vb);
  const v4i16_t hh = __builtin_amdgcn_ds_read_tr16_b64_v4i16((LDS3 v4i16_t*)(vb + 256));
  return (bf16x8){lo[0], lo[1], lo[2], lo[3], hh[0], hh[1], hh[2], hh[3]};
}
__device__ __forceinline__ void unit_bstates(const Params& p, int u, WaveLds2* L, int lane) {
  const int nh = u & 1, hd = (u >> 1) & 7, c = u >> 4, g = hd >> 2, r32 = lane & 31, hi = lane >> 5;
  f32x16 acc[2][2];
#pragma unroll
  for (int i = 0; i < 2; ++i)
#pragma unroll
    for (int j = 0; j < 2; ++j) acc[i][j] = zero16();
  const SB* xb = p.xconv + (long)c * 128 * 1024; const float* wst = p.wst + (long)c * 128 * 8 + hd;
  for (int q4 = 0; q4 < 4; ++q4) {
    stage_slab<true>(L->x, xb + (long)(32 * q4) * 1024 + hd * 64, 1024, [&](int row) { return wst[(32 * q4 + row) * 8]; }, lane);
    stage_slab<false>(L->b, xb + (long)(32 * q4) * 1024 + 512 + g * 128 + nh * 64, 1024, [&](int) { return 1.f; }, lane);
#pragma unroll
    for (int s2 = 0; s2 < 2; ++s2) { bf16x8 af[2], bfr[2];
#pragma unroll
      for (int i = 0; i < 2; ++i) { af[i] = slab_frag(L->x, i, s2, lane); bfr[i] = slab_frag(L->b, i, s2, lane); }
#pragma unroll
      for (int i = 0; i < 2; ++i)
#pragma unroll
        for (int j = 0; j < 2; ++j) acc[i][j] = MFMA32(af[i], bfr[j], acc[i][j]); } }
  float* so = p.states + ((long)c * 8 + hd) * 8192 + nh * 64 + r32;
#pragma unroll
  for (int i = 0; i < 2; ++i)
#pragma unroll
    for (int j = 0; j < 2; ++j)
#pragma unroll
      for (int e = 0; e < 16; ++e) so[(long)(32 * i + crow(e, hi)) * 128 + 32 * j] = acc[i][j][e];
}
__device__ __forceinline__ void unit_bout(const Params& p, int layer, int u, WaveLds2* L, int lane) {
  const int lt = u & 3, hd = (u >> 2) & 7, c = u >> 5, g = hd >> 2, r32 = lane & 31, hi = lane >> 5;
  for (int x = lane; x < 128; x += 64) { L->acs[x] = p.acs[((long)c * 128 + x) * 8 + hd]; L->dtv[x] = p.dt[((long)c * 128 + x) * 8 + hd]; }
  f32x16 acc[2] = {zero16(), zero16()}, acc2[2] = {zero16(), zero16()};
  const SB* xb = p.xconv + (long)c * 128 * 1024; const int l = 32 * lt + r32; const float al = p.acs[((long)c * 128 + l) * 8 + hd];
  const float* cbr = p.cb + ((long)c * 2 + g) * 16384 + (long)l * 128;
  for (int sc = 0; sc <= lt; ++sc) {
    stage_slab<false>(L->x, xb + (long)(32 * sc) * 1024 + hd * 64, 1024, [&](int) { return 1.f; }, lane);
#pragma unroll
    for (int s2 = 0; s2 < 2; ++s2) { float mv[8];
#pragma unroll
      for (int jj = 0; jj < 2; ++jj) { const int s0 = 32 * sc + 16 * s2 + 8 * jj + 4 * hi; const float4 cv = *(const float4*)(cbr + s0); const float4 av = *(const float4*)(&L->acs[s0]); const float4 dv = *(const float4*)(&L->dtv[s0]);
        mv[4 * jj + 0] = (s0 + 0 <= l) ? cv.x * __expf(al - av.x) * dv.x : 0.f; mv[4 * jj + 1] = (s0 + 1 <= l) ? cv.y * __expf(al - av.y) * dv.y : 0.f;
        mv[4 * jj + 2] = (s0 + 2 <= l) ? cv.z * __expf(al - av.z) * dv.z : 0.f; mv[4 * jj + 3] = (s0 + 3 <= l) ? cv.w * __expf(al - av.w) * dv.w : 0.f; }
      u32x4 aw; aw[0] = pk2(mv[0], mv[1]); aw[1] = pk2(mv[2], mv[3]); aw[2] = pk2(mv[4], mv[5]); aw[3] = pk2(mv[6], mv[7]); const bf16x8 af = __builtin_bit_cast(bf16x8, aw);
#pragma unroll
      for (int pt = 0; pt < 2; ++pt) acc[pt] = MFMA32(af, slab_frag(L->x, pt, s2, lane), acc[pt]); } }
  const SB* cmr = xb + (long)l * 1024 + 768 + g * 128; const float* prv = p.states + ((long)c * 8 + hd) * 8192;
#pragma unroll 2
  for (int ks = 0; ks < 8; ++ks) { const bf16x8 af = *(const bf16x8*)(cmr + 16 * ks + 8 * hi);
#pragma unroll
    for (int pt = 0; pt < 2; ++pt) { const float* pr = prv + (long)(32 * pt + r32) * 128 + 16 * ks + 8 * hi; const float4 a0 = *(const float4*)pr, a1 = *(const float4*)(pr + 4);
      u32x4 bw; bw[0] = pk2(a0.x, a0.y); bw[1] = pk2(a0.z, a0.w); bw[2] = pk2(a1.x, a1.y); bw[3] = pk2(a1.z, a1.w);
      acc2[pt] = MFMA32(af, __builtin_bit_cast(bf16x8, bw), acc2[pt]); } }
  const float dsk = p.b_d[layer * 8 + hd];
#pragma unroll
  for (int e = 0; e < 16; ++e) { const int lr = 32 * lt + crow(e, hi); const float ea = __expf(L->acs[lr]); const long t = (long)c * 128 + lr;
#pragma unroll
    for (int pt = 0; pt < 2; ++pt) { const int pp = 32 * pt + r32; p.ybuf[t * 512 + hd * 64 + pp] = acc[pt][e] + ea * acc2[pt][e] + dsk * bf2f(xb[(long)lr * 1024 + hd * 64 + pp]); } }
}
__device__ __forceinline__ void unit_bnorm(const Params& p, int layer, int u, int lane) {
  const int g = u & 1; const long t = u >> 1; const float4 yv = *(const float4*)(p.ybuf + t * 512 + g * 256 + lane * 4);
  SB* mp = p.mix + t * NMIX + MX_B + g * 256 + lane * 4; const ushort4 zv = *(const ushort4*)mp;
  const float v0 = yv.x * bf2f(zv.x), v1 = yv.y * bf2f(zv.y), v2 = yv.z * bf2f(zv.z), v3 = yv.w * bf2f(zv.w);
  const float ss = wave_sum_f(v0 * v0 + v1 * v1 + v2 * v2 + v3 * v3); const float r = 1.f / sqrtf(ss * (1.f / 256.f) + 1e-6f);
  const float4 w = *(const float4*)(p.b_norm + layer * 512 + g * 256 + lane * 4);
  ushort4 o; o.x = f2bf(v0 * r * w.x); o.y = f2bf(v1 * r * w.y); o.z = f2bf(v2 * r * w.z); o.w = f2bf(v3 * r * w.w); *(ushort4*)mp = o;
}
__device__ __forceinline__ void unit_bdt(const Params& p, int layer, int u, int lane) {
  const int hd = u & 7, c = u >> 3; const float a = -expf(p.a_log[layer * 8 + hd]), bias = p.dt_bias[layer * 8 + hd]; const long t0 = (long)c * 128 + 2 * lane;
  const float d0 = softplus_f(p.small[t0 * NSMALL + 24 + hd] + bias), d1 = softplus_f(p.small[(t0 + 1) * NSMALL + 24 + hd] + bias);
  float run = (d0 + d1) * a;
#pragma unroll
  for (int o = 1; o < 64; o <<= 1) { const float v = __shfl_up(run, o); if (lane >= o) run += v; }
  const float tot = __shfl(run, 63); const float c1 = run, c0 = run - d1 * a;
  p.dt[t0 * 8 + hd] = d0; p.dt[(t0 + 1) * 8 + hd] = d1; p.acs[t0 * 8 + hd] = c0; p.acs[(t0 + 1) * 8 + hd] = c1;
  p.wst[t0 * 8 + hd] = d0 * expf(tot - c0); p.wst[(t0 + 1) * 8 + hd] = d1 * expf(tot - c1);
}
__device__ __forceinline__ void item_bconv(const Params& p, int layer, long gid) {
  const int cg = (int)(gid & 127) * 8; const long t = gid >> 7; const float* w = p.conv_w + (long)layer * 4 * 1024 + cg; const float* bb = p.conv_b + layer * 1024 + cg;
  float acc[8];
#pragma unroll
  for (int k = 0; k < 8; ++k) acc[k] = bb[k];
#pragma unroll
  for (int i = 0; i < 4; ++i) { const long tt = t - 3 + i; if (tt >= 0) { const uint4 vv = *(const uint4*)(p.proj + tt * NPROJ + PB_X + cg); const unsigned wd[4] = {vv.x, vv.y, vv.z, vv.w};
#pragma unroll
      for (int k = 0; k < 4; ++k) { acc[2 * k] += w[i * 1024 + 2 * k] * __uint_as_float(wd[k] << 16); acc[2 * k + 1] += w[i * 1024 + 2 * k + 1] * __uint_as_float(wd[k] & 0xffff0000u); } } }
  uint4 o; o.x = pk2(silu_f(acc[0]), silu_f(acc[1])); o.y = pk2(silu_f(acc[2]), silu_f(acc[3])); o.z = pk2(silu_f(acc[4]), silu_f(acc[5])); o.w = pk2(silu_f(acc[6]), silu_f(acc[7]));
  *(uint4*)(p.xconv + t * 1024 + cg) = o;
}
__device__ __forceinline__ void unit_cmp(const Params& p, int layer, int u, int lane) {
  const int ncmp = p.S / 16, ntile = ncmp * 2 / 32; const int kv = u / ntile, rt = u % ntile, r32 = lane & 31, hi = lane >> 5;
  const int r = 32 * rt + r32, j = r >> 1, hk = r & 1;
  const unsigned short* w1t = p.w1t + (long)kv * 128 * 2048; const unsigned short* w2t = p.w2t + kv * 64 * 128; const float* pe = p.cmp_pos + (long)(layer * 2 + kv) * 32 * 64;
  const SB* src = p.proj + PA_KV + kv * 128 + hk * 64;
  f32x16 acc[4] = {zero16(), zero16(), zero16(), zero16()};
#pragma unroll 4
  for (int ks = 0; ks < 128; ++ks) { const int t = ks >> 2, d = (ks & 3) * 16 + 8 * hi; const long tok = 16 * j + t;
    const float4 p0 = *(const float4*)(pe + t * 64 + d), p1 = *(const float4*)(pe + t * 64 + d + 4); float v[8] = {p0.x, p0.y, p0.z, p0.w, p1.x, p1.y, p1.z, p1.w};
    { const long tokc = tok < p.S ? tok : (long)p.S - 1; const float vm = tok < p.S ? 1.f : 0.f;
      const uint4 vv = *(const uint4*)(src + tokc * NPROJ + d); const unsigned wd[4] = {vv.x, vv.y, vv.z, vv.w};
#pragma unroll
      for (int k = 0; k < 4; ++k) { v[2 * k] += vm * __uint_as_float(wd[k] << 16); v[2 * k + 1] += vm * __uint_as_float(wd[k] & 0xffff0000u); } }
    u32x4 bw; bw[0] = pk2(v[0], v[1]); bw[1] = pk2(v[2], v[3]); bw[2] = pk2(v[4], v[5]); bw[3] = pk2(v[6], v[7]); const bf16x8 bfr = __builtin_bit_cast(bf16x8, bw);
#pragma unroll
    for (int ut = 0; ut < 4; ++ut) { const bf16x8 af = *(const bf16x8*)(w1t + (long)(32 * ut + r32) * 2048 + 16 * ks + 8 * hi); acc[ut] = MFMA32(af, bfr, acc[ut]); } }
  f32x16 o2[2] = {zero16(), zero16()};
#pragma unroll
  for (int ut = 0; ut < 4; ++ut) {
#pragma unroll
    for (int e = 0; e < 16; ++e) acc[ut][e] = gelu_f(acc[ut][e]);
#pragma unroll
    for (int s2 = 0; s2 < 2; ++s2) { const bf16x8 hb = pack8(acc[ut], 8 * s2);
#pragma unroll
      for (int dt = 0; dt < 2; ++dt) { const unsigned short* wr = w2t + (32 * dt + r32) * 128 + 32 * ut + 16 * s2 + 4 * hi; const uint2 x0 = *(const uint2*)wr, x1 = *(const uint2*)(wr + 8);
        u32x4 aw; aw[0] = x0.x; aw[1] = x0.y; aw[2] = x1.x; aw[3] = x1.y; o2[dt] = MFMA32(__builtin_bit_cast(bf16x8, aw), hb, o2[dt]); } } }
  SB* dst = p.kvc + ((long)kv * ncmp * 2 + r) * 64;
#pragma unroll
  for (int dt = 0; dt < 2; ++dt)
#pragma unroll
    for (int e = 0; e < 16; ++e) dst[32 * dt + crow(e, hi)] = f2bf(o2[dt][e]);
}

template <class RowFn>
__device__ __forceinline__ void topk4_rows(const Params& p, RowFn rowfn, int lane) {
  float v[4][4]; int cur[4], mine[4];
#pragma unroll
  for (int r = 0; r < 4; ++r) { const int row = rowfn(r); const int q = row >> 1; cur[r] = q >> 6; const float* imp = p.imp + (long)row * 256; mine[r] = -1;
#pragma unroll
    for (int k = 0; k < 4; ++k) { const int b = lane + 64 * k; float x = (b <= cur[r]) ? imp[b] : -1.f; if (b == 0 || b == cur[r]) x = 1e4f; v[r][k] = x; } }
  for (int k = 0; k < 16; ++k) {
    float m[4]; int cand[4];
#pragma unroll
    for (int r = 0; r < 4; ++r) m[r] = fmaxf(fmaxf(v[r][0], v[r][1]), fmaxf(v[r][2], v[r][3]));
#pragma unroll
    for (int o = 32; o > 0; o >>= 1) {
#pragma unroll
      for (int r = 0; r < 4; ++r) m[r] = fmaxf(m[r], __shfl_xor(m[r], o)); }
#pragma unroll
    for (int r = 0; r < 4; ++r) { cand[r] = 0x7fffffff;
#pragma unroll
      for (int kk = 3; kk >= 0; --kk) if (v[r][kk] == m[r]) cand[r] = lane + 64 * kk; }
#pragma unroll
    for (int o = 32; o > 0; o >>= 1) {
#pragma unroll
      for (int r = 0; r < 4; ++r) { const int w = __shfl_xor(cand[r], o); cand[r] = w < cand[r] ? w : cand[r]; } }
#pragma unroll
    for (int r = 0; r < 4; ++r) {
#pragma unroll
      for (int kk = 0; kk < 4; ++kk) if (lane + 64 * kk == cand[r]) v[r][kk] = -2.f;
      if (lane == k) mine[r] = (m[r] >= 0.f) ? cand[r] : -1; }
  }
#pragma unroll
  for (int r = 0; r < 4; ++r) if (lane < 16) p.idx[(long)rowfn(r) * 16 + lane] = mine[r];
}
__device__ __forceinline__ void unit_topk4(const Params& p, int u, int lane) { topk4_rows(p, [&](int r) { return u * 4 + r; }, lane); }
struct AselLds { unsigned short k[3][4096]; unsigned short v[3][4096]; unsigned sel[64][8]; unsigned anyb[8]; int nlist; int pad[7]; unsigned char blist[256]; float xch[4][32]; };
__device__ __forceinline__ void asel_issue(uint4 (&r)[4], const SB* kvb, int b, int tid) {
#pragma unroll
  for (int i = 0; i < 2; ++i) { const int idx = tid + 256 * i, row = idx >> 3, ch = idx & 7; const SB* src = kvb + (long)(b * 64 + row) * NPROJ + ch * 8; r[i] = *(const uint4*)src; r[2 + i] = *(const uint4*)(src + 128); }
}
__device__ __forceinline__ void asel_commit(const uint4 (&r)[4], AselLds* A, int stage, int tid) {
#pragma unroll
  for (int i = 0; i < 2; ++i) { const int idx = tid + 256 * i, row = idx >> 3, ch = idx & 7;
    *(uint4*)&A->k[stage][row * 64 + ((ch ^ (row & 7)) * 8)] = r[i];
    *(uint4*)&A->v[stage][(ch >> 2) * 2048 + row * 32 + (ch & 3) * 8] = r[2 + i]; }
}
__device__ __forceinline__ void asel_coltile(const Params& p, FlashState& S_, const bf16x8 (&qf)[4], AselLds* A, float* xch, int stage, int b, int cur, int q0, int qbase, int h, float c31, int lane) {
  const int r32 = lane & 31, hi = lane >> 5; const int ql = qbase + (r32 >> 2); const int q = q0 + ql;
  const bool selq = (A->sel[ql][b >> 5] >> (b & 31)) & 1u;
  if (!__any(selq)) return;
  const bool far = (q0 - (b * 64 + 63)) >= 1513; const bool edge = (b == cur);
#if FT2
  bf16x8 kf0[4], kf1[4];
#pragma unroll
  for (int d0 = 0; d0 < 4; ++d0) { const int row0 = r32, row1 = 32 + r32;
    kf0[d0] = *(const bf16x8*)&A->k[stage][row0 * 64 + (((2 * d0 + hi) ^ ((row0 >> 1) & 7)) * 8)];
    kf1[d0] = *(const bf16x8*)&A->k[stage][row1 * 64 + (((2 * d0 + hi) ^ ((row1 >> 1) & 7)) * 8)]; }
  f32x16 s0 = zero16(), s1 = zero16();
#pragma unroll
  for (int d0 = 0; d0 < 4; ++d0) { s0 = MFMA32(kf0[d0], qf[d0], s0); s1 = MFMA32(kf1[d0], qf[d0], s1); }
#pragma unroll
  for (int e = 0; e < 16; ++e) { const int tk = b * 64 + (e & 3) + 8 * (e >> 2) + 4 * hi; const int dist = q - tk; float b0, b1;
    if (far) { b0 = c31; b1 = c31; } else { const int d0c = dist < 0 ? 0 : (dist > 2047 ? 2047 : dist); const int d1 = dist - 32; const int d1c = d1 < 0 ? 0 : (d1 > 2047 ? 2047 : d1);
      b0 = p.tabA[h * TABA_N + d0c] * L2E; b1 = p.tabA[h * TABA_N + d1c] * L2E; }
    float v0 = s0[e] * QSC + b0, v1 = s1[e] * QSC + b1; if (!selq || (edge && dist < 0)) v0 = NINF; if (!selq || (edge && dist < 32)) v1 = NINF; s0[e] = v0; s1[e] = v1; }
  flash_core2(S_, s0, s1, A->v[stage], xch, lane);
}
#else
#pragma unroll 1
  for (int kt = 0; kt < 2; ++kt) { const int t0 = b * 64 + 32 * kt; if (edge && t0 > q0 + qbase + 7) continue;
    bf16x8 kf[4]; { const int row = 32 * kt + r32;
#pragma unroll
      for (int d0 = 0; d0 < 4; ++d0) kf[d0] = *(const bf16x8*)&A->k[stage][row * 64 + (((2 * d0 + hi) ^ ((row >> 1) & 7)) * 8)]; }
    f32x16 s = zero16();
#pragma unroll
    for (int d0 = 0; d0 < 4; ++d0) s = MFMA32(kf[d0], qf[d0], s);
#pragma unroll
    for (int e = 0; e < 16; ++e) { const int tk = t0 + (e & 3) + 8 * (e >> 2) + 4 * hi; const int dist = q - tk; float bsv;
      if (far) bsv = c31; else { const int dc = dist < 0 ? 0 : (dist > 2047 ? 2047 : dist); bsv = p.tabA[h * TABA_N + dc] * L2E; }
      float vv = s[e] * QSC + bsv; if (!selq || (edge && dist < 0)) vv = NINF; s[e] = vv; }
    flash_core1(S_, s, A->v[stage] + kt * 1024, xch, lane);
  }
}
#endif
__device__ __forceinline__ void asel_store(const Params& p, FlashState& S_, float* xch, int q0, int qbase, int g, int lane) {
  const int r32 = lane & 31, hi = lane >> 5;
  const float lt = S_.l + __shfl_xor(S_.l, 32); const float inv = lt > 0.f ? 1.f / lt : 0.f; xch[r32] = inv;
#pragma unroll
  for (int e = 0; e < 16; ++e) { const int j = crow(e, hi); const float a = xch[j]; const int q = q0 + qbase + (j >> 2), he = g * 4 + (j & 3);
    const float* gl = p.small + (long)q * NSMALL + he * 3; const float g0 = sigmoid_f(gl[0]), g1 = sigmoid_f(gl[1]), g2 = sigmoid_f(gl[2]);
#pragma unroll
    for (int db = 0; db < 2; ++db) { const long c = (long)q * 512 + he * 64 + db * 32 + r32; const float os = (db ? S_.o1[e] : S_.o0[e]) * a;
      const float av = g0 * bf2f(p.oc[c]) + g1 * os + g2 * bf2f(p.ow[c]); SB* mp = p.mix + (long)q * NMIX + MX_A + he * 64 + db * 32 + r32; *mp = f2bf(av * bf2f(*mp)); } }
}
__device__ __forceinline__ void unit_asel_blk(const Params& p, int u, AselLds* A) {
  int tid = threadIdx.x; asm volatile("" : "+v"(tid));
  const int lane = tid & 63, w = __builtin_amdgcn_readfirstlane(tid >> 6), r32 = lane & 31, hi = lane >> 5;
  const int g = u & 1, qt = (p.S / 32 - 1) - (u >> 1), q0 = qt * 32, cur = q0 >> 6;
  const SB* kvb = p.proj + PA_KV + 2 * 128 + g * 64;
  __syncthreads();
  for (int i = tid; i < 64 * 8 + 8; i += 256) ((unsigned*)A->sel)[i] = 0u;
#ifndef ASEL_NO_TOPK
  topk4_rows(p, [&](int r) { return (q0 + 8 * w + r) * 2 + g; }, lane); topk4_rows(p, [&](int r) { return (q0 + 8 * w + 4 + r) * 2 + g; }, lane);
  asm volatile("s_waitcnt vmcnt(0)" ::: "memory");
#endif
  __syncthreads();
#pragma unroll
  for (int i = 0; i < 2; ++i) { const int e = tid + 256 * i, ql = e >> 4, kk = e & 15; const int b = __hip_atomic_load(&p.idx[((long)(q0 + ql) * 2 + g) * 16 + kk], __ATOMIC_RELAXED, __HIP_MEMORY_SCOPE_AGENT);
    if (b >= 0) { atomicOr(&A->sel[ql][b >> 5], 1u << (b & 31)); atomicOr(&A->anyb[b >> 5], 1u << (b & 31)); } }
  __syncthreads();
  if (tid < 64) {
    const unsigned wbits = A->anyb[lane >> 3]; const unsigned nib = (wbits >> ((lane & 7) * 4)) & 15u; const int cnt = __popc(nib);
    int pre = cnt;
#pragma unroll
    for (int o = 1; o < 64; o <<= 1) { const int v = __shfl_up(pre, o); if (lane >= o) pre += v; }
    int pos = pre - cnt;
#pragma unroll
    for (int k = 0; k < 4; ++k) if ((nib >> k) & 1u) A->blist[pos++] = (unsigned char)(lane * 4 + k);
    if (lane == 63) A->nlist = pre;
  }
  __syncthreads();
  const int nlist = A->nlist;
  const int hh = r32 & 3, h = g * 4 + hh; const float c31 = p.tabA[h * TABA_N + 2047] * L2E;
  bf16x8 qf0[4]; FlashState st0;
  load_q(qf0, p.proj + (long)(q0 + 8 * w + (r32 >> 2)) * NPROJ + PA_Q + h * 64, hi);
  st0.o0 = zero16(); st0.o1 = zero16(); st0.m = -1e30f; st0.l = 0.f;
  float* xch = A->xch[w];
#define ASEL_DMA(bb, stg) { const int b_ = (bb); _Pragma("unroll") for (int i_ = 0; i_ < 2; ++i_) { const int pk_ = 2 * w + i_; \
      { const int row_ = pk_ * 8 + (lane >> 3), pc_ = lane & 7; __builtin_amdgcn_global_load_lds((gptr_t)(kvb + (long)(b_ * 64 + row_) * NPROJ + ((pc_ ^ ((row_ >> 1) & 7)) * 8)), (lptr_t)&A->k[stg][pk_ * 512], 16, 0, 0); } \
      { const int db_ = pk_ >> 2, row_ = (pk_ & 3) * 16 + (lane >> 2), wi_ = lane & 3; __builtin_amdgcn_global_load_lds((gptr_t)(kvb + 128 + (long)(b_ * 64 + row_) * NPROJ + db_ * 32 + wi_ * 8), (lptr_t)&A->v[stg][db_ * 2048 + (pk_ & 3) * 512], 16, 0, 0); } } }
  if (nlist > 0) ASEL_DMA(A->blist[0], 0);
  if (nlist > 1) ASEL_DMA(A->blist[1], 1);
  int stage = 0;
  for (int it = 0; it < nlist; ++it) {
    const int b = A->blist[it];
    if (it + 1 < nlist) asm volatile("s_waitcnt vmcnt(4) lgkmcnt(0)\n\ts_barrier" ::: "memory"); else asm volatile("s_waitcnt vmcnt(0) lgkmcnt(0)\n\ts_barrier" ::: "memory");
    if (it + 2 < nlist) { const int s2_ = (stage == 0) ? 2 : stage - 1; ASEL_DMA(A->blist[it + 2], s2_); }
    asel_coltile(p, st0, qf0, A, xch, stage, b, cur, q0, 8 * w, h, c31, lane);
    stage = (stage == 2) ? 0 : stage + 1;
  }
  asel_store(p, st0, xch, q0, 8 * w, g, lane);
#undef ASEL_DMA
}
__device__ __forceinline__ void unit_bout_blk(const Params& p, int layer, int ub, char* smem) {
  int tid = threadIdx.x; asm volatile("" : "+v"(tid));
  const int lane = tid & 63, w = __builtin_amdgcn_readfirstlane(tid >> 6), r32 = lane & 31, hi = lane >> 5;
  const int lt = ub & 3, g = (ub >> 2) & 1, c = ub >> 3, hd = g * 4 + w;
  WaveLds2* L = ((WaveLds2*)smem) + w;
  __syncthreads();
  for (int x = lane; x < 128; x += 64) { L->acs[x] = p.acs[((long)c * 128 + x) * 8 + hd]; L->dtv[x] = p.dt[((long)c * 128 + x) * 8 + hd]; }
  f32x16 acc[2] = {zero16(), zero16()}, acc2[2] = {zero16(), zero16()};
  const SB* xb = p.xconv + (long)c * 128 * 1024; const int l = 32 * lt + r32; const float al = p.acs[((long)c * 128 + l) * 8 + hd];
  const float* cbr = p.cb + ((long)c * 2 + g) * 16384 + (long)l * 128;
  for (int sc = 0; sc <= lt; ++sc) {
    stage_slab<false>(L->x, xb + (long)(32 * sc) * 1024 + hd * 64, 1024, [&](int) { return 1.f; }, lane);
#pragma unroll
    for (int s2 = 0; s2 < 2; ++s2) { float mv[8];
#pragma unroll
      for (int jj = 0; jj < 2; ++jj) { const int s0 = 32 * sc + 16 * s2 + 8 * jj + 4 * hi; const float4 cv = *(const float4*)(cbr + s0); const float4 av = *(const float4*)(&L->acs[s0]); const float4 dv = *(const float4*)(&L->dtv[s0]);
        mv[4 * jj + 0] = (s0 + 0 <= l) ? cv.x * __expf(al - av.x) * dv.x : 0.f; mv[4 * jj + 1] = (s0 + 1 <= l) ? cv.y * __expf(al - av.y) * dv.y : 0.f;
        mv[4 * jj + 2] = (s0 + 2 <= l) ? cv.z * __expf(al - av.z) * dv.z : 0.f; mv[4 * jj + 3] = (s0 + 3 <= l) ? cv.w * __expf(al - av.w) * dv.w : 0.f; }
      u32x4 aw; aw[0] = pk2(mv[0], mv[1]); aw[1] = pk2(mv[2], mv[3]); aw[2] = pk2(mv[4], mv[5]); aw[3] = pk2(mv[6], mv[7]); const bf16x8 af = __builtin_bit_cast(bf16x8, aw);
#pragma unroll
      for (int pt = 0; pt < 2; ++pt) acc[pt] = MFMA32(af, slab_frag(L->x, pt, s2, lane), acc[pt]); } }
  const SB* cmr = xb + (long)l * 1024 + 768 + g * 128; const float* prv = p.states + ((long)c * 8 + hd) * 8192;
#pragma unroll 2
  for (int ks = 0; ks < 8; ++ks) { const bf16x8 af = *(const bf16x8*)(cmr + 16 * ks + 8 * hi);
#pragma unroll
    for (int pt = 0; pt < 2; ++pt) { const float* pr = prv + (long)(32 * pt + r32) * 128 + 16 * ks + 8 * hi; const float4 a0 = *(const float4*)pr, a1 = *(const float4*)(pr + 4);
      u32x4 bw; bw[0] = pk2(a0.x, a0.y); bw[1] = pk2(a0.z, a0.w); bw[2] = pk2(a1.x, a1.y); bw[3] = pk2(a1.z, a1.w);
      acc2[pt] = MFMA32(af, __builtin_bit_cast(bf16x8, bw), acc2[pt]); } }
  const float dsk = p.b_d[layer * 8 + hd];
  float* yl = (float*)L;
#pragma unroll
  for (int e = 0; e < 16; ++e) { const int lr = crow(e, hi); const float ea = __expf(L->acs[32 * lt + lr]);
#pragma unroll
    for (int pt = 0; pt < 2; ++pt) { const int pp = 32 * pt + r32; yl[lr * 64 + pp] = acc[pt][e] + ea * acc2[pt][e] + dsk * bf2f(xb[(long)(32 * lt + lr) * 1024 + hd * 64 + pp]); } }
  __syncthreads();
  { const int row = tid >> 3, sub = tid & 7; const long t = (long)c * 128 + 32 * lt + row; SB* mp = p.mix + t * NMIX + MX_B + g * 256 + sub * 32;
    const float* ysrc = (const float*)(((WaveLds2*)smem) + (sub >> 1)) + row * 64 + (sub & 1) * 32;
    float vv[32]; float ss = 0.f;
#pragma unroll
    for (int i = 0; i < 4; ++i) { const uint4 zz = *(const uint4*)(mp + 8 * i); const unsigned zw[4] = {zz.x, zz.y, zz.z, zz.w};
#pragma unroll
      for (int k = 0; k < 4; ++k) { const float y0 = ysrc[8 * i + 2 * k] * __uint_as_float(zw[k] << 16), y1 = ysrc[8 * i + 2 * k + 1] * __uint_as_float(zw[k] & 0xffff0000u); vv[8 * i + 2 * k] = y0; vv[8 * i + 2 * k + 1] = y1; ss += y0 * y0 + y1 * y1; } }
    ss += __shfl_xor(ss, 1); ss += __shfl_xor(ss, 2); ss += __shfl_xor(ss, 4);
    const float r = 1.f / sqrtf(ss * (1.f / 256.f) + 1e-6f); const float* wn = p.b_norm + layer * 512 + g * 256 + sub * 32;
#pragma unroll
    for (int i = 0; i < 4; ++i) { uint4 o; o.x = pk2(vv[8 * i] * r * wn[8 * i], vv[8 * i + 1] * r * wn[8 * i + 1]); o.y = pk2(vv[8 * i + 2] * r * wn[8 * i + 2], vv[8 * i + 3] * r * wn[8 * i + 3]);
      o.z = pk2(vv[8 * i + 4] * r * wn[8 * i + 4], vv[8 * i + 5] * r * wn[8 * i + 5]); o.w = pk2(vv[8 * i + 6] * r * wn[8 * i + 6], vv[8 * i + 7] * r * wn[8 * i + 7]); *(uint4*)(mp + 8 * i) = o; } }
}

__device__ __forceinline__ void unit_memkv(const Params& p, int u, int lane) {
  const int l = u >> 8, m = u & 255; const float* row = p.mem + (long)m * DM; const float* nw = p.m_norm + l * DM; const float* w = p.m_wkv + (long)l * DM * 512 + lane * 8;
  float ss = 0.f;
#pragma unroll
  for (int i = 0; i < 4; ++i) { const float4 v = *(const float4*)(row + i * 256 + lane * 4); ss += v.x * v.x + v.y * v.y + v.z * v.z + v.w * v.w; }
  ss = wave_sum_f(ss); const float r = 1.f / sqrtf(ss * (1.f / DM) + 1e-6f);
  float acc[8] = {0.f, 0.f, 0.f, 0.f, 0.f, 0.f, 0.f, 0.f};
#pragma unroll 8
  for (int d = 0; d < DM; ++d) { const float a = row[d] * r * nw[d]; const float4 w0 = *(const float4*)(w + (long)d * 512), w1 = *(const float4*)(w + (long)d * 512 + 4);
    acc[0] += a * w0.x; acc[1] += a * w0.y; acc[2] += a * w0.z; acc[3] += a * w0.w; acc[4] += a * w1.x; acc[5] += a * w1.y; acc[6] += a * w1.z; acc[7] += a * w1.w; }
  uint4 o; o.x = pk2(acc[0], acc[1]); o.y = pk2(acc[2], acc[3]); o.z = pk2(acc[4], acc[5]); o.w = pk2(acc[6], acc[7]);
  *(uint4*)(p.memkv + (long)u * 512 + lane * 8) = o;
}

#define SEQ 16384
#define DEPTH 4

__device__ __forceinline__ int n2o(int n) {
  if (n < 1280) return n;
  if (n < 2304) return n - 1280 + 1816;
  if (n < 2816) return n - 2304 + 3360;
  if (n < 3072) return n - 2816 + 3872;
  if (n < 4608) return n - 3072 + 4640;
  if (n < 5632) return n - 4608 + 6176;
  if (n < 5888) return n - 5632 + 7712;
  n -= 5888;
  if (n < 512) return 1304 + n;
  if (n < 1024) return 2848 + n - 512;
  if (n < 1536) return 4128 + n - 1024;
  if (n < 2048) return 7200 + n - 1536;
  if (n < 2304) return 7968 + n - 2048;
  n -= 2304;
  if (n < 24) return 1280 + n;
  if (n < 32) return 2840 + n - 24;
  return -1;
}

template <bool MAP>
__device__ __forceinline__ void cvt_tile(const float* __restrict__ src, int lds_, unsigned short* __restrict__ dst, int ldd, int k0, int n0, float* tile  ) {
  int tid = threadIdx.x; asm volatile("" : "+v"(tid));
  __syncthreads();
#pragma unroll
  for (int e = 0; e < 16; ++e) { int idx = tid + 256 * e, kk = idx >> 6, nn = idx & 63; int oc = MAP ? n2o(n0 + nn) : (n0 + nn);
    tile[kk * 65 + nn] = (oc >= 0) ? src[(long)(k0 + kk) * lds_ + oc] : 0.f; }
  __syncthreads();
#pragma unroll
  for (int e = 0; e < 16; ++e) { int idx = tid + 256 * e, nn = idx >> 6, kk = idx & 63; dst[(long)(n0 + nn) * ldd + k0 + kk] = f2bf(tile[kk * 65 + nn]); }
}

__device__ __forceinline__ float wave_sum(float v) {
#pragma unroll
  for (int o = 32; o > 0; o >>= 1) v += __shfl_xor(v, o);
  return v;
}

__device__ __forceinline__ void norm_row_wave(const Params& p, int layer, int t, bool do_h, int lane) {
  const float* xin = (layer == 0) ? p.x + (long)t * DM : p.out + (long)t * DM;
  float4 xv[4], yv[4];
#pragma unroll
  for (int i = 0; i < 4; ++i) xv[i] = *(const float4*)(xin + i * 256 + lane * 4);
  if (layer > 0) {
    float ss = 0.f;
#pragma unroll
    for (int i = 0; i < 4; ++i) { yv[i] = *(const float4*)(p.y + (long)t * DM + i * 256 + lane * 4); ss += yv[i].x * yv[i].x + yv[i].y * yv[i].y + yv[i].z * yv[i].z + yv[i].w * yv[i].w; }
    ss = wave_sum(ss); float r1 = 1.f / sqrtf(ss / DM + 1e-6f);
#pragma unroll
    for (int i = 0; i < 4; ++i) { float4 w = *(const float4*)(p.post_norm + (layer - 1) * DM + i * 256 + lane * 4);
      xv[i].x += yv[i].x * r1 * w.x; xv[i].y += yv[i].y * r1 * w.y; xv[i].z += yv[i].z * r1 * w.z; xv[i].w += yv[i].w * r1 * w.w; }
  }
  float ss2 = 0.f;
#pragma unroll
  for (int i = 0; i < 4; ++i) { *(float4*)(p.out + (long)t * DM + i * 256 + lane * 4) = xv[i]; ss2 += xv[i].x * xv[i].x + xv[i].y * xv[i].y + xv[i].z * xv[i].z + xv[i].w * xv[i].w; }
  if (!do_h) return;
  ss2 = wave_sum(ss2); float r2 = 1.f / sqrtf(ss2 / DM + 1e-6f);
#pragma unroll
  for (int i = 0; i < 4; ++i) { float4 w = *(const float4*)(p.pre_norm + layer * DM + i * 256 + lane * 4);
    ushort4 o; o.x = f2bf(xv[i].x * r2 * w.x); o.y = f2bf(xv[i].y * r2 * w.y); o.z = f2bf(xv[i].z * r2 * w.z); o.w = f2bf(xv[i].w * r2 * w.w);
    *(ushort4*)(p.h + (long)t * DM + i * 256 + lane * 4) = o; }
}

#ifndef GMI
#define GMI 4
#endif
struct GemmSmem { unsigned short a[2][64 * GMI * 32]; unsigned short b[2][128 * 32]; };
__device__ __forceinline__ void glds16(const void* g, void* lds_wave_base) { __builtin_amdgcn_global_load_lds((gptr_t)g, (lptr_t)lds_wave_base, 16, 0, 0); }
template <int EPI, int MI, bool DRY = false>
__device__ __forceinline__ void gemm_tile(const Params& p, const unsigned short* __restrict__ A, int lda, const unsigned short* __restrict__ Bt, int ldb, int K, int m0, int n0, GemmSmem& sm, float* outp = nullptr) {
  int tid = threadIdx.x; asm volatile("" : "+v"(tid));
  const int lane = tid & 63, wid = __builtin_amdgcn_readfirstlane(tid >> 6), wr = wid >> 1, wc = wid & 1, r = lane & 31, h = lane >> 5;
  f32x16 acc[MI][2];
#pragma unroll
  for (int i = 0; i < MI; ++i)
#pragma unroll
    for (int j = 0; j < 2; ++j) acc[i][j] = zero16();
  const int prow = lane >> 2, pc = lane & 3;
  const unsigned short* ga[MI]; const unsigned short* gb[2];
#pragma unroll
  for (int i = 0; i < MI; ++i) { const int row = (wid * MI + i) * 16 + prow; ga[i] = A + (long)(m0 + row) * lda + ((pc ^ ((row >> 2) & 3)) * 8); }
#pragma unroll
  for (int i = 0; i < 2; ++i) { const int row = (wid * 2 + i) * 16 + prow; gb[i] = Bt + (long)(n0 + row) * ldb + ((pc ^ ((row >> 2) & 3)) * 8); }
  __syncthreads();
#pragma unroll
  for (int i = 0; i < MI; ++i) glds16(ga[i], &sm.a[0][(wid * MI + i) * 512]);
#pragma unroll
  for (int i = 0; i < 2; ++i) glds16(gb[i], &sm.b[0][(wid * 2 + i) * 512]);
  __syncthreads();
  const int nk = K / 32;
  for (int kt = 0; kt < nk; ++kt) {
    const int cur = kt & 1;
    if (kt + 1 < nk) { const int ko = (kt + 1) * 32;
#pragma unroll
      for (int i = 0; i < MI; ++i) glds16(ga[i] + ko, &sm.a[cur ^ 1][(wid * MI + i) * 512]);
#pragma unroll
      for (int i = 0; i < 2; ++i) glds16(gb[i] + ko, &sm.b[cur ^ 1][(wid * 2 + i) * 512]); }
#pragma unroll
    for (int ks = 0; ks < 2; ++ks) {
      bf16x8 af[MI], bfr[2];
#pragma unroll
      for (int i = 0; i < MI; ++i) { const int row = wr * (32 * MI) + i * 32 + r; af[i] = *(const bf16x8*)&sm.a[cur][row * 32 + (((2 * ks + h) ^ ((row >> 2) & 3)) * 8)]; }
#pragma unroll
      for (int j = 0; j < 2; ++j) { const int row = wc * 64 + j * 32 + r; bfr[j] = *(const bf16x8*)&sm.b[cur][row * 32 + (((2 * ks + h) ^ ((row >> 2) & 3)) * 8)]; }
#pragma unroll
      for (int i = 0; i < MI; ++i)
#pragma unroll
        for (int j = 0; j < 2; ++j) acc[i][j] = __builtin_amdgcn_mfma_f32_32x32x16_bf16(af[i], bfr[j], acc[i][j], 0, 0, 0);
    }
    __syncthreads();
  }
  if (DRY) {
#pragma unroll
    for (int i = 0; i < MI; ++i) asm volatile("" :: "v"(acc[i][0]), "v"(acc[i][1]));
    return; }
  const int ncol0 = n0 + wc * 64;
  const int mrow0 = m0 + wr * (32 * MI);
  if (EPI == 2) {
#pragma unroll
    for (int i = 0; i < MI; ++i)
#pragma unroll
      for (int j = 0; j < 2; ++j)
#pragma unroll
        for (int e = 0; e < 16; ++e) { int row = mrow0 + i * 32 + (e & 3) + 8 * (e >> 2) + 4 * h; outp[row * 128 + ncol0 + j * 32 + r] = acc[i][j][e]; }
  } else if (EPI == 1) {
#pragma unroll
    for (int i = 0; i < MI; ++i)
#pragma unroll
      for (int j = 0; j < 2; ++j)
#pragma unroll
        for (int e = 0; e < 16; ++e) { int row = mrow0 + i * 32 + (e & 3) + 8 * (e >> 2) + 4 * h; p.y[(long)row * DM + ncol0 + j * 32 + r] = acc[i][j][e]; }
  } else {
    if (ncol0 < NPROJ) {
      const bool rope = (ncol0 >= PC_Q && ncol0 < PC_KV + 128);
#pragma unroll
      for (int i = 0; i < MI; ++i)
#pragma unroll
        for (int e = 0; e < 16; ++e) { int row = mrow0 + i * 32 + (e & 3) + 8 * (e >> 2) + 4 * h; float v0 = acc[i][0][e], v1 = acc[i][1][e];
          if (rope) { float c = p.rope_cs[row * 32 + r], s = p.rope_sn[row * 32 + r]; float t1 = v0, t2 = v1; v0 = t1 * c - t2 * s; v1 = t2 * c + t1 * s; }
          p.proj[(long)row * NPROJ + ncol0 + r] = f2bf(v0); p.proj[(long)row * NPROJ + ncol0 + 32 + r] = f2bf(v1); }
    } else if (ncol0 < 8192) {
#pragma unroll
      for (int i = 0; i < MI; ++i)
#pragma unroll
        for (int j = 0; j < 2; ++j)
#pragma unroll
          for (int e = 0; e < 16; ++e) { int row = mrow0 + i * 32 + (e & 3) + 8 * (e >> 2) + 4 * h; p.mix[(long)row * NMIX + (ncol0 - NPROJ) + j * 32 + r] = f2bf(silu_f(acc[i][j][e])); }
    } else if (ncol0 == 8192) {
#pragma unroll
      for (int i = 0; i < MI; ++i)
#pragma unroll
        for (int e = 0; e < 16; ++e) { int row = mrow0 + i * 32 + (e & 3) + 8 * (e >> 2) + 4 * h; p.small[(long)row * NSMALL + r] = acc[i][0][e]; }
    }
  }
}

__device__ __forceinline__ int gw0(int g) { asm volatile("" : "+v"(g)); return g; }
__device__ __forceinline__ int bid0() { int b = blockIdx.x; asm volatile("" : "+s"(b)); return b; }

#define XB_TMO      128
#define XB_XCNT(j)  (256  + 64 * (j))
#define XB_XSUB(j)  (1280 + 64 * (j))
#define XB_XGEN(j)  (2304 + 64 * (j))
#define XB_TOP      3328
#define XB_TOPGEN   3392
#define XCD_BAR_WORDS 3456
#define XB_SPIN_CAP (1u << 28)
__device__ __forceinline__ unsigned xb_ld(unsigned* p) { return __hip_atomic_load(p, __ATOMIC_RELAXED, __HIP_MEMORY_SCOPE_AGENT); }
__device__ __forceinline__ unsigned xb_add(unsigned* p, unsigned v) { return __hip_atomic_fetch_add(p, v, __ATOMIC_RELAXED, __HIP_MEMORY_SCOPE_AGENT); }
__device__ __forceinline__ unsigned xb_xcc_id() { return (unsigned)__builtin_amdgcn_s_getreg((3 << 11) | 20) & 0xFu; }
#define XB_SPIN(cond, bar) do { unsigned _sp = 0; while (cond) { __builtin_amdgcn_s_sleep(1); \
    if ((++_sp & 255u) == 0u) { if (xb_ld(&(bar)[XB_TMO])) break; if (_sp > XB_SPIN_CAP) { atomicAdd(&(bar)[XB_TMO], 1u); break; } } } } while (0)
struct XcdBarrier { unsigned* bar; unsigned x; volatile LDS3 unsigned* st; };
__device__ __forceinline__ XcdBarrier xcd_barrier_post(unsigned* bar, volatile LDS3 unsigned* st) {
  XcdBarrier b; b.bar = bar; b.x = xb_xcc_id(); b.st = st;
  if (threadIdx.x == 0) (void)xb_add(&bar[XB_XCNT(b.x)], 1u);
  return b;
}
__device__ __forceinline__ void xcd_barrier_complete(unsigned* bar, unsigned x, unsigned& nloc, unsigned& nx) {
  const unsigned G = gridDim.x; unsigned sum, cnt, mine, sp = 0u;
  for (;;) { sum = 0u; cnt = 0u; mine = 0u;
#pragma unroll
    for (unsigned j = 0; j < 16; ++j) { const unsigned c = xb_ld(&bar[XB_XCNT(j)]); sum += c; cnt += (c > 0u) ? 1u : 0u; mine = (j == x) ? c : mine; }
    if (sum == G) break;
    __builtin_amdgcn_s_sleep(1);
    if ((++sp & 255u) == 0u) { if (xb_ld(&bar[XB_TMO])) break; if (sp > XB_SPIN_CAP) { atomicAdd(&bar[XB_TMO], 1u); break; } } }
  nloc = mine > 0u ? mine : 1u; nx = cnt > 0u ? cnt : 1u;
}
__device__ __forceinline__ void xcd_barrier(const XcdBarrier& b) {
  asm volatile("s_waitcnt vmcnt(0)" ::: "memory");
  __syncthreads();
  if (threadIdx.x == 0) {
    unsigned* bar = b.bar;
    __builtin_amdgcn_s_waitcnt(0);
    unsigned nloc = b.st[0], nx = b.st[1];
    if (nloc == 0u) { xcd_barrier_complete(bar, b.x, nloc, nx); b.st[0] = nloc; b.st[1] = nx; }
    const unsigned old = xb_add(&bar[XB_XSUB(b.x)], 1u);
    const unsigned gen = old / nloc;
    if (old + 1u == (gen + 1u) * nloc) {
      __builtin_amdgcn_fence(__ATOMIC_RELEASE, "agent");
      asm volatile("s_waitcnt vmcnt(0)" ::: "memory");
      const unsigned og = xb_add(&bar[XB_TOP], 1u);
      const unsigned tg = og / nx;
      if (og + 1u == (tg + 1u) * nx) xb_add(&bar[XB_TOPGEN], 1u);
      else XB_SPIN(xb_ld(&bar[XB_TOPGEN]) == tg, bar);
      __builtin_amdgcn_fence(__ATOMIC_ACQUIRE, "agent");
      xb_add(&bar[XB_XGEN(b.x)], 1u);
      asm volatile("s_waitcnt vmcnt(0)" ::: "memory");
    } else {
      XB_SPIN(xb_ld(&bar[XB_XGEN(b.x)]) == gen, bar);
      __builtin_amdgcn_fence(__ATOMIC_ACQUIRE, "agent");
      asm volatile("s_waitcnt vmcnt(0)" ::: "memory");
    }
  }
  __syncthreads();
}

struct KArgs { const void* in[20]; float* out; char* ws; };
#ifdef SELFCHK
#define RUN_S 4096
#else
#define RUN_S SEQ
#endif
__host__ __device__ __forceinline__ size_t fill_ws(Params& p, Params& p2, char* w) {
  size_t off = 0;
#define TAKE(bytes) (w + ((off += (((size_t)(bytes)) + 255) & ~(size_t)255) - ((((size_t)(bytes)) + 255) & ~(size_t)255)))
  const size_t S = RUN_S, ncmp = S / 16, nc = S / 128;
  p.S = RUN_S;
  p.wt_in = (unsigned short*)TAKE(8320 * 1024 * 2); p.wt_out = (unsigned short*)TAKE(1024 * 2304 * 2); p.w1t = (unsigned short*)TAKE(2 * 128 * 2048 * 2); p.w2t = (unsigned short*)TAKE(2 * 64 * 128 * 2);
  p.h = (SB*)TAKE(S * 1024 * 2); p.ybuf = (float*)p.h;
  p.proj = (SB*)TAKE(S * NPROJ * 2); p.y = (float*)p.proj;
  p.small = (float*)TAKE(S * 32 * 4); p.mix = (SB*)TAKE(S * NMIX * 2);
  p.rope_cs = (float*)TAKE(S * 32 * 4); p.rope_sn = (float*)TAKE(S * 32 * 4); p.tabA = (float*)TAKE(8 * TABA_N * 4); p.tabD = (float*)TAKE(24 * TABD_N * 4);
  p.memkv = (SB*)TAKE(4 * 256 * 512 * 2); p.hid = (float*)TAKE(2 * ncmp * 256 * 4); p.kvc = (SB*)TAKE(2 * ncmp * 128 * 2);
  p.cml = (float*)TAKE(S * 16 * 4); p.idx = (int*)TAKE(S * 32 * 4); p.oc = (SB*)TAKE(S * 512 * 2); p.ow = (SB*)TAKE(S * 512 * 2);
  p.dop = (SB*)TAKE(3 * S * 512 * 2); p.dlse = (float*)TAKE(3 * S * 8 * 4); p.xconv = (SB*)TAKE(S * 1024 * 2);
  p.dt = (float*)TAKE(S * 8 * 4); p.acs = (float*)TAKE(S * 8 * 4); p.wst = (float*)TAKE(S * 8 * 4); p.cb = (float*)TAKE(nc * 2 * 128 * 128 * 4); p.states = (float*)TAKE(nc * 65536 * 4);
  p.bar = (unsigned*)TAKE(131072);
  p2 = p;
#ifdef SELFCHK
  p.imp = (float*)TAKE(S * 512 * 4);
  p2.mix = (SB*)TAKE(S * NMIX * 2); p2.ow = (SB*)TAKE(S * 512 * 2); p2.oc = (SB*)TAKE(S * 512 * 2); p2.dop = (SB*)TAKE(3 * S * 512 * 2); p2.dlse = (float*)TAKE(3 * S * 8 * 4);
  p2.cml = (float*)TAKE(S * 16 * 4); p2.imp = (float*)TAKE(S * 512 * 4); p2.idx = (int*)TAKE(S * 32 * 4); p2.cb = (float*)TAKE(nc * 2 * 128 * 128 * 4);
  p2.kvc = (SB*)TAKE(2 * ncmp * 128 * 2); p2.xconv = (SB*)TAKE(S * 1024 * 2); p2.dt = (float*)TAKE(S * 8 * 4); p2.acs = (float*)TAKE(S * 8 * 4); p2.wst = (float*)TAKE(S * 8 * 4);
  p2.states = (float*)TAKE(nc * 65536 * 4); p2.ybuf = (float*)TAKE(S * 512 * 4); p.ybuf = (float*)TAKE(S * 512 * 4);
#else
  p.imp = (float*)p.dop; p2 = p;
#endif
  return off;
}
__host__ __device__ __forceinline__ void fill_inputs(Params& p, const KArgs& a) {
  p.x = (const float*)a.in[0]; p.mem = (const float*)a.in[1]; p.pos = (const int*)a.in[2]; p.pre_norm = (const float*)a.in[3]; p.post_norm = (const float*)a.in[4];
  p.w_in = (const float*)a.in[5]; p.w_out = (const float*)a.in[6]; p.rel_bias = (const float*)a.in[7]; p.cmp_pos = (const float*)a.in[8]; p.cmp_w1 = (const float*)a.in[9];
  p.cmp_w2 = (const float*)a.in[10]; p.conv_w = (const float*)a.in[11]; p.conv_b = (const float*)a.in[12]; p.dt_bias = (const float*)a.in[13]; p.a_log = (const float*)a.in[14];
  p.b_d = (const float*)a.in[15]; p.b_norm = (const float*)a.in[16]; p.sinks = (const float*)a.in[17]; p.m_norm = (const float*)a.in[18]; p.m_wkv = (const float*)a.in[19];
  p.out = a.out;
}
#define GS(N, ...) { long g0_ = gtid; asm volatile("" : "+v"(g0_)); for (long gid = g0_; gid < (long)(N); gid += gsz) { __VA_ARGS__; } }
#define WU(N, ...) { for (int u_ = gw0(gwave); u_ < (int)(N); u_ += nwave) { const int u = __builtin_amdgcn_readfirstlane(u_); int lane = threadIdx.x & 63; asm volatile("" : "+v"(lane)); \
    WaveLds* WL = ((WaveLds*)smem_raw) + __builtin_amdgcn_readfirstlane((int)(threadIdx.x >> 6)); __VA_ARGS__; } }
#define GSYNC() xcd_barrier(xb)
#ifndef CMP_SKIP
#define CMP_SKIP 7
#endif
#define WUQ(slot, N, ...) { unsigned* cq_ = &p.bar[4096 + (layer * 8 + (slot)) * 64 * 8 + (blockIdx.x & 7) * 64]; for (;;) { unsigned t_ = 0u; if ((threadIdx.x & 63) == 0) t_ = atomicAdd(cq_, 1u); \
    const int u = __builtin_amdgcn_readfirstlane((int)t_) * 8 + (int)(blockIdx.x & 7); if (u >= (int)(N)) break; int lane = threadIdx.x & 63; asm volatile("" : "+v"(lane)); \
    WaveLds* WL = ((WaveLds*)smem_raw) + __builtin_amdgcn_readfirstlane((int)(threadIdx.x >> 6)); WaveLds2* WL2 = (WaveLds2*)WL; (void)WL2; __VA_ARGS__; } }
#define SMEM_BYTES (sizeof(AselLds) > sizeof(GemmSmem) ? ((sizeof(AselLds) + 15) & ~(size_t)15) : sizeof(GemmSmem))
#define KERNEL_PROLOGUE \
  Params p, p2; p.pad0 = 0; fill_inputs(p, ka); fill_ws(p, p2, ka.ws); \
  cg::grid_group grid = cg::this_grid(); \
  __shared__ __attribute__((aligned(16))) char smem_raw[SMEM_BYTES + 16]; \
  volatile LDS3 unsigned* xbst = (volatile LDS3 unsigned*)(smem_raw + SMEM_BYTES); \
  if (threadIdx.x < 4) xbst[threadIdx.x] = 0u; \
  __syncthreads(); \
  XcdBarrier xb = xcd_barrier_post(p.bar, xbst); \
  GemmSmem& gsm = *(GemmSmem*)smem_raw; float* ftile = (float*)smem_raw; \
  const long gtid = (long)blockIdx.x * 256 + threadIdx.x, gsz = (long)gridDim.x * 256; \
  const int gwave = (int)(gtid >> 6), nwave = (int)(gsz >> 6); \
  const int S = p.S, ncmp = S / 16, nc = S / 128, nqt = S / 32; (void)ncmp; (void)nc; (void)nqt; (void)ftile; (void)gsm; \
  GS((long)S * 32, ph_rope(p, gid)); \
  GS(8 * TABA_N + 24 * TABD_N, ph_tabs(p, gid)); \
  WU(DEPTH * 256, unit_memkv(p, u, lane));
#define PHASE_P1(layer) \
    for (int t = gw0(gwave); t < S; t += nwave) { int lane = threadIdx.x & 63; asm volatile("" : "+v"(lane)); norm_row_wave(p, layer, t, true, lane); } \
    { const float* wi = p.w_in + (long)(layer) * 1024 * 8224; \
      for (int tl = bid0(); tl < 16 * 130; tl += gridDim.x) cvt_tile<true>(wi, 8224, p.wt_in, 1024, (tl & 15) * 64, (tl >> 4) * 64, ftile); \
      const float* wo = p.w_out + (long)(layer) * 2304 * 1024; \
      for (int tl = bid0(); tl < 36 * 16; tl += gridDim.x) cvt_tile<false>(wo, 1024, p.wt_out, 2304, (tl % 36) * 64, (tl / 36) * 64, ftile); \
      for (int tl = bid0(); tl < 2 * 64; tl += gridDim.x) { const int kv = tl >> 6, t6 = tl & 63; cvt_tile<false>(p.cmp_w1 + (long)((layer) * 2 + kv) * 2048 * 128, 128, p.w1t + (long)kv * 128 * 2048, 2048, (t6 >> 1) * 64, (t6 & 1) * 64, ftile); } \
      for (int tl = bid0(); tl < 2 * 2; tl += gridDim.x) { const int kv = tl >> 1; cvt_tile<false>(p.cmp_w2 + (long)((layer) * 2 + kv) * 128 * 64, 64, p.w2t + (long)kv * 64 * 128, 128, (tl & 1) * 64, 0, ftile); } }
#define PHASE_P2() \
    {   \
      const int x_ = bid0() & 7, li_ = bid0() >> 3, nl_ = (gridDim.x + 7) >> 3, mtiles_ = S / (64 * GMI), mper_ = mtiles_ / 8; \
      if ((mper_ & 7) != 0 || (gridDim.x & 7) != 0) { for (int tl = bid0(); tl < mtiles_ * 65; tl += gridDim.x) { int mt = tl % mtiles_, nt = tl / mtiles_; gemm_tile<0, GMI>(p, p.h, DM, p.wt_in, DM, DM, mt * 64 * GMI, nt * 128, gsm); } } \
      else for (int t_ = li_; t_ < mper_ * 65; t_ += nl_) { const int half_ = t_ / 520, r_ = t_ % 520; int ml_, nt_; \
        if (r_ < 512) { ml_ = r_ & 7; nt_ = (r_ >> 6) * 8 + ((r_ & 63) >> 3); } else { ml_ = r_ - 512; nt_ = 64; } \
        gemm_tile<0, GMI>(p, p.h, DM, p.wt_in, DM, DM, (x_ * mper_ + half_ * 8 + ml_) * 64 * GMI, nt_ * 128, gsm); } }
#define PHASE_FLASH3(layer) \
    { const int nA = nqt * 8, nM = nqt * 4, nD = 3 * nqt * 8, nC = nqt * 8; \
      WU(nA + nM + nD + nC, { if (u < nA) unit_awin(p, u, WL, lane); else if (u < nA + nM) unit_m(p, layer, u - nA, WL, lane); \
                              else if (u < nA + nM + nD) unit_d(p, u - nA - nM, WL, lane); else unit_c(p, layer, u - nA - nM - nD, WL, lane); }); }
#define WU2(N, ...) { for (int u_ = gw0(gwave); u_ < (int)(N); u_ += nwave) { const int u = __builtin_amdgcn_readfirstlane(u_); int lane = threadIdx.x & 63; asm volatile("" : "+v"(lane)); \
    WaveLds2* WL2 = ((WaveLds2*)smem_raw) + __builtin_amdgcn_readfirstlane((int)(threadIdx.x >> 6)); __VA_ARGS__; } }
#define PHASE_CB() \
    for (int tl = bid0(); tl < nc * 2; tl += gridDim.x) { const SB* xb_ = p.xconv + (long)(tl >> 1) * 128 * 1024 + (tl & 1) * 128; gemm_tile<2, 2>(p, xb_ + 768, 1024, xb_ + 512, 1024, 128, 0, 0, gsm, p.cb + (long)tl * 16384); }

#ifndef SELFCHK
#define PH_BEGIN { char* wsb_ = ka.ws; asm volatile("" : "+s"(wsb_)); Params p, p2_; p.pad0 = 0; fill_inputs(p, ka); fill_ws(p, p2_, wsb_); (void)p2_;
#define PH_END }
__global__ void __launch_bounds__(256, LB2) mega(KArgs ka) {
  KERNEL_PROLOGUE
#ifdef REP_PRO
  GS((long)S * 32, ph_rope(p, gid)); GS(8 * TABA_N + 24 * TABD_N, ph_tabs(p, gid)); WU(DEPTH * 256, unit_memkv(p, u, lane));
#endif
#ifdef TSEL
  unsigned long long tlast = __builtin_amdgcn_s_memrealtime();
#define TMARK(id) { if (gtid == 0) { const unsigned long long tn = __builtin_amdgcn_s_memrealtime(); ((unsigned long long*)p.bar)[id] += tn - tlast; tlast = tn; } }
#else
#define TMARK(id)
#endif
  for (int layer = 0; layer < DEPTH; ++layer) {
    PH_BEGIN
    PHASE_P1(layer)
#ifdef REP_P1
    PHASE_P1(layer)
#endif
    PH_END
    if (layer == 0) grid.sync(); else GSYNC();
    PH_BEGIN
    TMARK(1)
    PHASE_P2()
#ifdef REP_G
    PHASE_P2()
#endif
#ifdef REP_G2
    { const int x_ = bid0() & 7, li_ = bid0() >> 3, nl_ = (gridDim.x + 7) >> 3; for (int t_ = li_; t_ < 520; t_ += nl_) { int ml_, nt_; if (t_ < 512) { ml_ = t_ & 7; nt_ = (t_ >> 6) * 8 + ((t_ & 63) >> 3); } else { ml_ = t_ - 512; nt_ = 64; }
        gemm_tile<0, GMI, true>(p, p.h, DM, p.wt_in, DM, DM, (x_ * 8 + ml_) * 64 * GMI, nt_ * 128, gsm); } }
#endif
    PH_END
    GSYNC();
    PH_BEGIN
    TMARK(2)
    { const int nCmp = 2 * (ncmp * 2 / 32), nA = nqt * 8, nM = nqt * 4, nD = 3 * nqt * 8, nC = nqt * 8, nF = nA + nM + nD + nC;
      const int cw0 = nwave - nCmp; const bool cmpw = (gwave >= cw0) && (cw0 > 0);
#define FLASH_UNIT(uu) { const int u = __builtin_amdgcn_readfirstlane(uu); int lane = threadIdx.x & 63; asm volatile("" : "+v"(lane)); WaveLds* WL = ((WaveLds*)smem_raw) + __builtin_amdgcn_readfirstlane((int)(threadIdx.x >> 6)); \
        if (u < nA) unit_awin(p, u, WL, lane); else if (u < nA + nM) unit_m(p, layer, u - nA, WL, lane); else if (u < nA + nM + nD) unit_d(p, u - nA - nM, WL, lane); else unit_c(p, layer, u - nA - nM - nD, WL, lane); }
      if (cw0 <= 0) { WU(nCmp, unit_cmp(p, layer, u, lane)); }
      else if (cmpw) { const int u = __builtin_amdgcn_readfirstlane(gwave - cw0); int lane = threadIdx.x & 63; asm volatile("" : "+v"(lane)); unit_cmp(p, layer, u, lane); }
      for (int r_ = (cmpw ? CMP_SKIP : 0), u_ = gw0(gwave) + r_ * nwave; u_ < nF; u_ += nwave) FLASH_UNIT(u_)
      if (cw0 > 0 && gwave < CMP_SKIP * nCmp) { const int u_ = (gwave / nCmp) * nwave + cw0 + (gwave % nCmp); if (u_ < nF) FLASH_UNIT(u_) }
#undef FLASH_UNIT
    }
    GS((long)S * 128, item_bconv(p, layer, gid));
    WU(nc * 8, unit_bdt(p, layer, u, lane));
    PH_END
    GSYNC();
    PH_BEGIN
    TMARK(3)
    WU(nqt * 8, unit_acmp1(p, u, WL, lane));
    __syncthreads();
    PHASE_CB()
    __syncthreads();
    WU2(nc * 16, unit_bstates(p, u, WL2, lane));
#ifdef REP_P4
    __syncthreads();
    WU(nqt * 8, unit_acmp1(p, u, WL, lane));
    __syncthreads();
    PHASE_CB()
    __syncthreads();
    WU2(nc * 16, unit_bstates(p, u, WL2, lane));
#endif
    GS((long)S * 8, ph_d_merge(p, gid));
    PH_END
    GSYNC();
    PH_BEGIN
    TMARK(4)
    WU(nqt * 8, unit_acmp2(p, u, lane));
#ifdef REP_P5A
    WU(nqt * 8, unit_acmp2(p, u, lane));
#endif
    GS(65536, ph_b_scan(p, gid));
    PH_END
    GSYNC();
    PH_BEGIN
    TMARK(5)
    { const int nu_ = (S / 32) * 2, G_ = gridDim.x; int k_ = 0;
      for (int base_ = 0; base_ < nu_; base_ += G_, ++k_) { const int ub = base_ + ((k_ & 1) ? (G_ - 1 - bid0()) : bid0()); if (ub < nu_) unit_asel_blk(p, ub, (AselLds*)smem_raw); } }
    TMARK(7)
    for (;;) { __syncthreads(); if (threadIdx.x == 0) xbst[2] = atomicAdd(&p.bar[48 + layer * 8 + 5], 1u); __syncthreads(); const int ub = (int)xbst[2]; if (ub >= nc * 8) break; unit_bout_blk(p, layer, ub, smem_raw); }
    PH_END
    GSYNC();
    PH_BEGIN
    TMARK(8)
    for (int tl = bid0(); tl < (S / (64 * GMI)) * 8; tl += gridDim.x) { int mt = tl >> 3, nt = tl & 7; gemm_tile<1, GMI>(p, p.mix, NMIX, p.wt_out, NMIX, NMIX, mt * 64 * GMI, nt * 128, gsm); }
#ifdef REP_P8
    for (int tl = bid0(); tl < (S / (64 * GMI)) * 8; tl += gridDim.x) { int mt = tl >> 3, nt = tl & 7; gemm_tile<1, GMI>(p, p.mix, NMIX, p.wt_out, NMIX, NMIX, mt * 64 * GMI, nt * 128, gsm); }
#endif
    PH_END
    GSYNC();
    PH_BEGIN
    TMARK(9)
    PH_END
  }
  for (int t = gw0(gwave); t < S; t += nwave) { int lane = threadIdx.x & 63; asm volatile("" : "+v"(lane)); norm_row_wave(p, DEPTH, t, false, lane); }
#ifdef TSEL
  GSYNC();
  { float best = -1.f; int bi = 0; for (int k = 1; k < 10; ++k) if (!((TSEL >> k) & 1)) { const float us = (float)((unsigned long long*)p.bar)[k] * 0.01f; if (us > best) { best = us; bi = k; } }
    const float kk = 10.f * (float)bi + floorf(log2f(best + 1.f));
    GS((long)S * 1024, p.out[gid] = kk); }
#endif
}
#else
__device__ __forceinline__ void chk_update(unsigned* slot, float diff, float ref) {
  atomicMax(&slot[0], __float_as_uint(fabsf(diff))); atomicMax(&slot[1], __float_as_uint(fabsf(ref)));
}
#define CMPB(slot, a, b_) chk_update(sl + (slot), bf2f(a) - bf2f(b_), bf2f(b_))
#define CMPF(slot, a, b_) chk_update(sl + (slot), (a) - (b_), (b_))
__global__ void __launch_bounds__(256, 1) mega(KArgs ka) {
  KERNEL_PROLOGUE
  if (gtid < 64) p.bar[gtid] = 0u;
  unsigned* sl = p.bar;
  const int layer = 0;
  PHASE_P1(layer)
  grid.sync();
  PHASE_P2()
  GSYNC();
  GS((long)S * NMIX, p2.mix[gid] = p.mix[gid]);
  GSYNC();
  PHASE_FLASH3(layer)
  WU(2 * (ncmp * 2 / 32), unit_cmp(p, layer, u, lane));
  GS((long)S * 128, item_bconv(p, layer, gid));
  WU(nc * 8, unit_bdt(p, layer, u, lane));
  GS((long)2 * ncmp * 256, ph_cmp_hid(p2, layer, gid));
  GS((long)S * 8, ph_a_win(p2, gid));
  GS((long)S * 8, ph_c(p2, layer, gid));
  GS((long)3 * S * 8, ph_d(p2, gid));
  GS((long)S * 4, ph_m(p2, layer, gid));
  GS((long)S * 1024, ph_b_conv(p2, layer, gid));
  GS((long)nc * 8, ph_b_dt2(p2, layer, gid));
  GSYNC();
  GS((long)2 * ncmp * 128, ph_cmp_out(p2, layer, gid));
  GSYNC();
  GS((long)2 * ncmp * 128, CMPB(20, p.kvc[gid], p2.kvc[gid]));
  GS((long)S * 1024, CMPB(22, p.xconv[gid], p2.xconv[gid]));
  GS((long)S * 8, { CMPF(24, p.dt[gid], p2.dt[gid]); CMPF(24, p.acs[gid], p2.acs[gid]); CMPF(24, p.wst[gid], p2.wst[gid]); });
  GSYNC();
  GS((long)2 * ncmp * 128, p2.kvc[gid] = p.kvc[gid]);
  GS((long)S * 1024, p2.xconv[gid] = p.xconv[gid]);
  GS((long)S * 8, { p2.dt[gid] = p.dt[gid]; p2.acs[gid] = p.acs[gid]; p2.wst[gid] = p.wst[gid]; });
  GSYNC();
  WU(nqt * 8, unit_acmp1(p, u, WL, lane));
  __syncthreads();
  PHASE_CB()
  __syncthreads();
  WU2(nc * 16, unit_bstates(p, u, WL2, lane));
  GS((long)S * 8, ph_a_cmp1(p2, gid));
  GS((long)nc * 2 * 128 * 128, ph_b_cb(p2, gid));
  GS((long)nc * 65536, ph_b_states(p2, gid));
  GSYNC();
  WU(nqt * 8, unit_acmp2(p, u, lane));
  GS((long)S * 2, ph_a_cmp2(p2, gid));
  GS((long)nc * 65536, CMPF(26, p.states[gid], p2.states[gid]));
  GS((long)nc * 2 * 128 * 128, { int s_ = (int)(gid & 127), l_ = (int)((gid >> 7) & 127); if (s_ <= l_) CMPF(18, p.cb[gid], p2.cb[gid]); });
  GSYNC();
  GS(65536, ph_b_scan(p, gid));
  GS(65536, ph_b_scan(p2, gid));
  GS((long)S * 512, { CMPB(0, p.ow[gid], p2.ow[gid]); CMPB(2, p.oc[gid], p2.oc[gid]); long t = gid >> 9, c = gid & 511; CMPB(4, p.mix[t * NMIX + MX_C + c], p2.mix[t * NMIX + MX_C + c]);
                      if (c < 256) CMPB(6, p.mix[t * NMIX + MX_M + c], p2.mix[t * NMIX + MX_M + c]); });
  GS((long)3 * S * 512, CMPB(8, p.dop[gid], p2.dop[gid]));
  GS((long)3 * S * 8, chk_update(sl + 10, p.dlse[gid] - p2.dlse[gid], 1.f));
  GS((long)S * 2 * 256, { long qg = gid >> 8; int bb = (int)(gid & 255); int q = (int)(qg >> 1); if (bb <= (q >> 6)) CMPF(12, p.imp[gid], p2.imp[gid]); });
  GSYNC();
  GS((long)S * 512, p2.imp[gid] = p.imp[gid]);
  GSYNC();
  WU(S * 2 / 4, unit_topk4(p, u, lane));
  WU2(nc * 32, unit_bout(p, layer, u, WL2, lane));
  GS((long)S * 2, ph_a_topk(p2, gid));
  GS((long)S * 512, ph_b_out(p2, layer, gid));
  GSYNC();
  GS((long)S * 2, { int q = (int)(gid >> 1); int nv = (q >> 6) + 1; nv = nv > 16 ? 16 : nv; int bad = 0;
    for (int k = 0; k < 16; ++k) { int mine = p.idx[gid * 16 + k]; bool found = false; for (int k2 = 0; k2 < 16; ++k2) found |= (p2.idx[gid * 16 + k2] == mine); if (k < nv) bad += !found || mine < 0; else bad += (mine >= 0); }
    chk_update(sl + 14, (float)bad, 1.f); });
  GS((long)S * 512, CMPF(28, p.ybuf[gid], p2.ybuf[gid]));
  GSYNC();
  GS((long)S * 32, p2.idx[gid] = p.idx[gid]);
  GS((long)S * 512, p2.ybuf[gid] = p.ybuf[gid]);
  GSYNC();
  for (int ub = bid0(); ub < (S / 32) * 2; ub += gridDim.x) unit_asel_blk(p, ub, (AselLds*)smem_raw);
  for (;;) { __syncthreads(); if (threadIdx.x == 0) xbst[2] = atomicAdd(&p.bar[40 + layer], 1u); __syncthreads(); const int ub = (int)xbst[2]; if (ub >= nc * 8) break; unit_bout_blk(p, layer, ub, smem_raw); }
  GS((long)S * 8, ph_a_sel(p2, gid));
  GS((long)S * 2, ph_b_norm(p2, layer, gid));
  GSYNC();
  GS((long)S * 512, { long t = gid >> 9, c = gid & 511; CMPB(16, p.mix[t * NMIX + MX_A + c], p2.mix[t * NMIX + MX_A + c]); CMPB(30, p.mix[t * NMIX + MX_B + c], p2.mix[t * NMIX + MX_B + c]); });
  GSYNC();
  { float R = 0.f;
    for (int k = 0; k < 16; ++k) { float d = __uint_as_float(p.bar[2 * k]), r = __uint_as_float(p.bar[2 * k + 1]); float q = d / (r + 1e-20f); if (CHKSEL < 0 || CHKSEL == k) R = fmaxf(R, q); }
    GS((long)SEQ * 1024, p.out[gid] = 1e4f * R); }
}
#endif

__global__ void zz_tail_pad(float* o) { asm volatile(".rept 512\n\ts_nop 0\n\t.endr" ::: "memory"); if (o) o[0] = 0.f; }
__global__ void fill_code(float* o, float v, long n) { long i = blockIdx.x * 256L + threadIdx.x; if (i < n) o[i] = v; }
extern "C" void kernel_launch(void* const* d_in, const int* in_sizes, int n_in, void* d_out, int out_size, void* d_ws, size_t ws_size, hipStream_t stream) {
  KArgs ka; memset(&ka, 0, sizeof(ka));
  for (int i = 0; i < 20; ++i) ka.in[i] = d_in[i];
  ka.out = (float*)d_out; ka.ws = (char*)d_ws;
  Params hp, hp2; memset(&hp, 0, sizeof(hp)); const size_t need = fill_ws(hp, hp2, (char*)d_ws);
  if (need > ws_size) { fprintf(stderr, "workspace too small: need %zu have %zu\n", need, ws_size); return; }
  static int grid_blocks = 0;
  if (!grid_blocks) { int dev = 0, cus = 0, per_cu = 0; (void)hipGetDevice(&dev); (void)hipDeviceGetAttribute(&cus, hipDeviceAttributeMultiprocessorCount, dev);
    (void)hipOccupancyMaxActiveBlocksPerMultiprocessor(&per_cu, mega, 256, 0); if (per_cu > LB2) per_cu = LB2; if (per_cu < 1) per_cu = 1; grid_blocks = cus * per_cu; }
  (void)hipMemsetAsync(hp.bar, 0, 131072, stream);
  void* args[] = {&ka};
  hipError_t e = hipLaunchCooperativeKernel((void*)mega, dim3(grid_blocks), dim3(256), args, 0, stream);
  if (e != hipSuccess) { (void)hipGetLastError(); fill_code<<<(unsigned)(((long)SEQ * 1024 + 255) / 256), 256, 0, stream>>>((float*)d_out, 1000.f * (float)(int)e + (float)grid_blocks, (long)SEQ * 1024); }
}
```

```cpp
#include <hip/hip_runtime.h>
#include <hip/hip_cooperative_groups.h>
#include <cstdio>
#include <cstdint>
#include <cstring>
namespace cg = cooperative_groups;
#define HD_ __device__ __forceinline__
#ifndef CHKSEL
#define CHKSEL -1
#endif
#ifndef LB2
#define LB2 2
#endif
#ifndef HD_
#define HD_ inline
#endif
#ifdef SB_IS_FLOAT
typedef float SB;
HD_ float ldf(const SB* p) { return *p; }
HD_ void stf(SB* p, float v) { *p = v; }
#else
typedef unsigned short SB;
HD_ float bf2f(unsigned short b) { unsigned u = ((unsigned)b) << 16; float f; __builtin_memcpy(&f, &u, 4); return f; }
HD_ unsigned short f2bf(float f) { unsigned u; __builtin_memcpy(&u, &f, 4); u += 0x7fffu + ((u >> 16) & 1u); return (unsigned short)(u >> 16); }
HD_ float ldf(const SB* p) { return bf2f(*p); }
HD_ void stf(SB* p, float v) { *p = f2bf(v); }
#endif

#define DM 1024
#define NPROJ 5888
#define NMIX 2304
#define NSMALL 32
#define PA_Q 0
#define PA_KV 512
#define PB_X 1280
#define PC_Q 2304
#define PC_KV 2816
#define PD_Q 3072
#define PD_KV 4608
#define PM_Q 5632
#define MX_A 0
#define MX_B 512
#define MX_C 1024
#define MX_D 1536
#define MX_M 2048
#define TABA_N 2048
#define TABD_N 132

struct Params {
  int S; int pad0;
  const float *x, *mem; const int* pos;
  const float *pre_norm, *post_norm, *w_in, *w_out, *rel_bias, *cmp_pos, *cmp_w1, *cmp_w2, *conv_w, *conv_b, *dt_bias, *a_log, *b_d,
      *b_norm, *sinks, *m_norm, *m_wkv;
  float* out;
  unsigned short* wt_in;
  unsigned short* wt_out;
  unsigned short *w1t, *w2t;
  SB* h;
  SB* proj;
  float* small;
  SB* mix;
  float* y;
  float *rope_cs, *rope_sn;
  float *tabA, *tabD;
  SB* memkv;
  float* hid;
  SB* kvc;
  float* imp;
  float* cml;
  int* idx;
  SB *oc, *ow;
  SB* dop;
  float* dlse;
  SB* xconv;
  float *dt, *acs;
  float* wst;
  float* cb;
  float* states;
  float* ybuf;
  unsigned* bar;
};

HD_ float silu_f(float x) { return x / (1.f + expf(-x)); }
HD_ float sigmoid_f(float x) { return 1.f / (1.f + expf(-x)); }
HD_ float gelu_f(float x) { return 0.5f * x * (1.f + tanhf(0.7978845608028654f * (x + 0.044715f * x * x * x))); }
HD_ float softplus_f(float x) { return fmaxf(x, 0.f) + log1pf(expf(-fabsf(x))); }

HD_ int t5_bucket(int d) {
  if (d < 16) return d < 0 ? 0 : d;
  const int thr[15] = {22, 30, 40, 54, 73, 99, 134, 182, 246, 332, 450, 609, 825, 1117, 1513};
  int b = 16;
  for (int k = 0; k < 15; ++k) b += (d >= thr[k]) ? 1 : 0;
  return b;
}

HD_ void ph_rope(const Params& p, long gid) {
  int s = (int)(gid >> 5), i = (int)(gid & 31);
  float inv = powf(150000.f, -(float)i / 32.f);
  float ang = (float)p.pos[s] * inv;
  p.rope_cs[gid] = cosf(ang); p.rope_sn[gid] = sinf(ang);
}
HD_ void ph_tabs(const Params& p, long gid) {
  if (gid < 8 * TABA_N) { int h = (int)(gid / TABA_N), d = (int)(gid % TABA_N); p.tabA[gid] = p.rel_bias[t5_bucket(d) * 32 + h]; }
  else { long g2 = gid - 8 * TABA_N; int hh = (int)(g2 / TABD_N), d = (int)(g2 % TABD_N); int gi = hh >> 3;
    int dil = gi == 0 ? 1 : (gi == 1 ? 4 : 16); p.tabD[g2] = p.rel_bias[t5_bucket(d * dil) * 32 + 8 + hh]; }
}
HD_ void ph_memkv(const Params& p, long gid) {
  int e = (int)(gid & 511), m = (int)((gid >> 9) & 255), l = (int)(gid >> 17);
  const float* row = p.mem + (long)m * DM;
  float ss = 0.f; _Pragma("unroll 16") for (int d = 0; d < DM; ++d) ss += row[d] * row[d];
  float r = 1.f / sqrtf(ss / DM + 1e-6f);
  float acc = 0.f;
  _Pragma("unroll 16") for (int d = 0; d < DM; ++d) acc += row[d] * r * p.m_norm[l * DM + d] * p.m_wkv[((long)l * DM + d) * 512 + e];
  stf(&p.memkv[gid], acc);
}
HD_ void ph_norm_row(const Params& p, int layer, int t, bool do_h) {
  const float* xin = (layer == 0) ? p.x + (long)t * DM : p.out + (long)t * DM;
  float* xo = p.out + (long)t * DM;
  float r1 = 0.f;
  if (layer > 0) { const float* y = p.y + (long)t * DM; float ss = 0.f; for (int d = 0; d < DM; ++d) ss += y[d] * y[d]; r1 = 1.f / sqrtf(ss / DM + 1e-6f); }
  float ss2 = 0.f;
  for (int d = 0; d < DM; ++d) { float v = xin[d]; if (layer > 0) v += p.y[(long)t * DM + d] * r1 * p.post_norm[(layer - 1) * DM + d]; xo[d] = v; ss2 += v * v; }
  if (!do_h) return;
  float r2 = 1.f / sqrtf(ss2 / DM + 1e-6f);
  for (int d = 0; d < DM; ++d) stf(&p.h[(long)t * DM + d], xo[d] * r2 * p.pre_norm[layer * DM + d]);
}

HD_ void ph_cmp_hid(const Params& p, int layer, long gid) {
  int u = (int)(gid & 127), hk = (int)((gid >> 7) & 1); long r = gid >> 8; int ncmp = p.S / 16; int j = (int)(r % ncmp), kv = (int)(r / ncmp);
  const float* w1 = p.cmp_w1 + ((long)(layer * 2 + kv) * 2048) * 128;
  const float* pe = p.cmp_pos + (long)(layer * 2 + kv) * 32 * 64;
  float acc = 0.f;
  for (int t = 0; t < 32; ++t) { int tok = 16 * j + t;
    _Pragma("unroll 16") for (int d = 0; d < 64; ++d) { float v = pe[t * 64 + d]; if (tok < p.S) v += ldf(&p.proj[(long)tok * NPROJ + PA_KV + kv * 128 + hk * 64 + d]);
      acc += v * w1[(long)(t * 64 + d) * 128 + u]; } }
  p.hid[gid] = gelu_f(acc);
}
HD_ void ph_cmp_out(const Params& p, int layer, long gid) {
  int d = (int)(gid & 63), hk = (int)((gid >> 6) & 1); long r = gid >> 7; int ncmp = p.S / 16; int j = (int)(r % ncmp), kv = (int)(r / ncmp);
  const float* w2 = p.cmp_w2 + (long)(layer * 2 + kv) * 128 * 64;
  const float* hd = p.hid + (((long)kv * ncmp + j) * 2 + hk) * 128;
  float acc = 0.f; for (int u = 0; u < 128; ++u) acc += hd[u] * w2[u * 64 + d];
  stf(&p.kvc[gid], acc);
}
HD_ void ph_a_cmp1(const Params& p, long gid) {
  int h = (int)(gid & 7), q = (int)(gid >> 3), g = h >> 2; int ncmp = p.S / 16;
  int jn = (q >= 31) ? ((q - 31) / 16 + 1) : 0;
  const SB* kc = p.kvc; const SB* vc = p.kvc + (long)ncmp * 128;
  float qv[64], o[64]; for (int d = 0; d < 64; ++d) { qv[d] = ldf(&p.proj[(long)q * NPROJ + PA_Q + h * 64 + d]); o[d] = 0.f; }
  float m = -1e30f, l = 0.f;
  for (int j = 0; j < jn; ++j) { const SB* kr = &kc[((long)j * 2 + g) * 64]; const SB* vr = &vc[((long)j * 2 + g) * 64];
    float s = 0.f; for (int d = 0; d < 64; ++d) s += qv[d] * ldf(&kr[d]);
    int dist = q - (16 * j + 31); s = s * 0.125f + p.tabA[h * TABA_N + (dist < TABA_N ? dist : TABA_N - 1)];
    float mn = fmaxf(m, s), a = expf(m - mn), pr = expf(s - mn); l = l * a + pr; for (int d = 0; d < 64; ++d) o[d] = o[d] * a + pr * ldf(&vr[d]); m = mn; }
  float il = jn > 0 ? 1.f / l : 0.f; for (int d = 0; d < 64; ++d) stf(&p.oc[(long)q * 512 + h * 64 + d], o[d] * il);
  p.cml[gid * 2] = m; p.cml[gid * 2 + 1] = il;
}
HD_ void ph_a_cmp2(const Params& p, long gid) {
  int g = (int)(gid & 1), q = (int)(gid >> 1); int ncmp = p.S / 16;
  float* imp = p.imp + gid * 256; for (int b = 0; b < 256; ++b) imp[b] = 0.f;
  int jn = (q >= 31) ? ((q - 31) / 16 + 1) : 0; const SB* kc = p.kvc;
  for (int hh = 0; hh < 4; ++hh) { int h = g * 4 + hh; float qv[64]; for (int d = 0; d < 64; ++d) qv[d] = ldf(&p.proj[(long)q * NPROJ + PA_Q + h * 64 + d]);
    float m = p.cml[((long)q * 8 + h) * 2], il = p.cml[((long)q * 8 + h) * 2 + 1];
    for (int j = 0; j < jn; ++j) { const SB* kr = &kc[((long)j * 2 + g) * 64]; float s = 0.f; for (int d = 0; d < 64; ++d) s += qv[d] * ldf(&kr[d]);
      int dist = q - (16 * j + 31); s = s * 0.125f + p.tabA[h * TABA_N + (dist < TABA_N ? dist : TABA_N - 1)]; float pr = expf(s - m) * il;
      imp[j >> 2] += pr; if (j + 1 < ncmp) imp[(j + 1) >> 2] += pr; } }
}
HD_ void ph_a_topk(const Params& p, long gid) {
  int q = (int)(gid >> 1); float* imp = p.imp + gid * 256; int* idx = p.idx + gid * 16; int cur = q >> 6;
  imp[0] = 1e4f; imp[cur] = 1e4f;
  for (int k = 0; k < 16; ++k) { int best = -1; float bv = -1.f;
    for (int b = 0; b <= cur; ++b) { float v = imp[b]; if (v > bv) { bv = v; best = b; } }
    idx[k] = best; if (best >= 0) imp[best] = -2.f; }
}
HD_ void ph_a_win(const Params& p, long gid) {
  int h = (int)(gid & 7), q = (int)(gid >> 3), hk = h >> 2;
  float qv[64], o[64]; for (int d = 0; d < 64; ++d) { qv[d] = ldf(&p.proj[(long)q * NPROJ + PA_Q + h * 64 + d]); o[d] = 0.f; }
  float m = -1e30f, l = 0.f; int lo = q - 511 < 0 ? 0 : q - 511;
  for (int t = lo; t <= q; ++t) { const SB* kr = &p.proj[(long)t * NPROJ + PA_KV + 4 * 128 + hk * 64]; const SB* vr = kr + 128;
    float s = 0.f; for (int d = 0; d < 64; ++d) s += qv[d] * ldf(&kr[d]); s = s * 0.125f + p.tabA[h * TABA_N + (q - t)];
    float mn = fmaxf(m, s), a = expf(m - mn), pr = expf(s - mn); l = l * a + pr; for (int d = 0; d < 64; ++d) o[d] = o[d] * a + pr * ldf(&vr[d]); m = mn; }
  float il = 1.f / l; for (int d = 0; d < 64; ++d) stf(&p.ow[(long)q * 512 + h * 64 + d], o[d] * il);
}
HD_ void ph_a_sel(const Params& p, long gid) {
  int h = (int)(gid & 7), q = (int)(gid >> 3), hk = h >> 2; const int* idx = p.idx + ((long)q * 2 + hk) * 16;
  float qv[64], o[64]; for (int d = 0; d < 64; ++d) { qv[d] = ldf(&p.proj[(long)q * NPROJ + PA_Q + h * 64 + d]); o[d] = 0.f; }
  float m = -1e30f, l = 0.f;
  for (int k = 0; k < 16; ++k) { int b = idx[k]; if (b < 0) continue;
    for (int i = 0; i < 64; ++i) { int t = b * 64 + i; if (t > q) break;
      const SB* kr = &p.proj[(long)t * NPROJ + PA_KV + 2 * 128 + hk * 64]; const SB* vr = kr + 128;
      float s = 0.f; for (int d = 0; d < 64; ++d) s += qv[d] * ldf(&kr[d]); int dist = q - t; s = s * 0.125f + p.tabA[h * TABA_N + (dist < TABA_N ? dist : TABA_N - 1)];
      float mn = fmaxf(m, s), a = expf(m - mn), pr = expf(s - mn); l = l * a + pr; for (int d = 0; d < 64; ++d) o[d] = o[d] * a + pr * ldf(&vr[d]); m = mn; } }
  float il = 1.f / l; const float* gl = p.small + (long)q * NSMALL + h * 3;
  float g0 = sigmoid_f(gl[0]), g1 = sigmoid_f(gl[1]), g2 = sigmoid_f(gl[2]);
  for (int d = 0; d < 64; ++d) { long c = (long)q * 512 + h * 64 + d; float a = g0 * ldf(&p.oc[c]) + g1 * o[d] * il + g2 * ldf(&p.ow[c]);
    SB* mp = &p.mix[(long)q * NMIX + MX_A + h * 64 + d]; stf(mp, a * ldf(mp)); }
}
HD_ void ph_c(const Params& p, int layer, long gid) {
  int h = (int)(gid & 7), q = (int)(gid >> 3), hk = h >> 2;
  float qv[64], o[64]; for (int d = 0; d < 64; ++d) { qv[d] = ldf(&p.proj[(long)q * NPROJ + PC_Q + h * 64 + d]); o[d] = 0.f; }
  float m = p.sinks[layer * 8 + h], l = 1.f; int lo = q - 127 < 0 ? 0 : q - 127;
  for (int t = lo; t <= q; ++t) { const SB* kr = &p.proj[(long)t * NPROJ + PC_KV + hk * 64]; const SB* vr = kr + 128;
    float s = 0.f; for (int d = 0; d < 64; ++d) s += qv[d] * ldf(&kr[d]); s *= 0.125f;
    float mn = fmaxf(m, s), a = expf(m - mn), pr = expf(s - mn); l = l * a + pr; for (int d = 0; d < 64; ++d) o[d] = o[d] * a + pr * ldf(&vr[d]); m = mn; }
  float il = 1.f / l; for (int d = 0; d < 64; ++d) { SB* mp = &p.mix[(long)q * NMIX + MX_C + h * 64 + d]; stf(mp, o[d] * il * ldf(mp)); }
}
HD_ void ph_d(const Params& p, long gid) {
  int h = (int)(gid & 7); long r = gid >> 3; int q = (int)(r % p.S), gi = (int)(r / p.S); int dil = gi == 0 ? 1 : (gi == 1 ? 4 : 16);
  float qv[64], o[64]; for (int d = 0; d < 64; ++d) { qv[d] = ldf(&p.proj[(long)q * NPROJ + PD_Q + gi * 512 + h * 64 + d]); o[d] = 0.f; }
  float m = -1e30f, l = 0.f;
  for (int dd = 0; dd <= 128; ++dd) { int t = q - dil * dd; if (t < 0) break;
    const SB* kr = &p.proj[(long)t * NPROJ + PD_KV + h * 64]; const SB* vr = kr + 512;
    float s = 0.f; for (int d = 0; d < 64; ++d) s += qv[d] * ldf(&kr[d]); s = s * 0.125f + p.tabD[(gi * 8 + h) * TABD_N + dd];
    float mn = fmaxf(m, s), a = expf(m - mn), pr = expf(s - mn); l = l * a + pr; for (int d = 0; d < 64; ++d) o[d] = o[d] * a + pr * ldf(&vr[d]); m = mn; }
  float il = 1.f / l; for (int d = 0; d < 64; ++d) stf(&p.dop[((long)gi * p.S + q) * 512 + h * 64 + d], o[d] * il);
  p.dlse[((long)gi * p.S + q) * 8 + h] = m + logf(l);
}
HD_ void ph_d_merge(const Params& p, long gid) {
  int h = (int)(gid & 7), q = (int)(gid >> 3);
  float l0 = p.dlse[((long)0 * p.S + q) * 8 + h], l1 = p.dlse[((long)1 * p.S + q) * 8 + h], l2 = p.dlse[((long)2 * p.S + q) * 8 + h];
  float mm = fmaxf(l0, fmaxf(l1, l2)); float e0 = expf(l0 - mm), e1 = expf(l1 - mm), e2 = expf(l2 - mm), is = 1.f / (e0 + e1 + e2);
  for (int d = 0; d < 64; ++d) { long c = (long)q * 512 + h * 64 + d;
    float v = (e0 * ldf(&p.dop[c]) + e1 * ldf(&p.dop[(long)p.S * 512 + c]) + e2 * ldf(&p.dop[(long)2 * p.S * 512 + c])) * is;
    SB* mp = &p.mix[(long)q * NMIX + MX_D + h * 64 + d]; stf(mp, v * ldf(mp)); }
}
HD_ void ph_m(const Params& p, int layer, long gid) {
  int h = (int)(gid & 3), q = (int)(gid >> 2);
  float qv[64], o[64]; for (int d = 0; d < 64; ++d) { qv[d] = ldf(&p.proj[(long)q * NPROJ + PM_Q + h * 64 + d]); o[d] = 0.f; }
  float m = -1e30f, l = 0.f; const SB* kvb = p.memkv + (long)layer * 256 * 512;
  for (int t = 0; t < 256; ++t) { const SB* kr = kvb + (long)t * 512 + h * 64; const SB* vr = kr + 256;
    float s = 0.f; for (int d = 0; d < 64; ++d) s += qv[d] * ldf(&kr[d]); s *= 0.125f;
    float mn = fmaxf(m, s), a = expf(m - mn), pr = expf(s - mn); l = l * a + pr; for (int d = 0; d < 64; ++d) o[d] = o[d] * a + pr * ldf(&vr[d]); m = mn; }
  float il = 1.f / l; for (int d = 0; d < 64; ++d) { SB* mp = &p.mix[(long)q * NMIX + MX_M + h * 64 + d]; stf(mp, o[d] * il * ldf(mp)); }
}
HD_ void ph_b_conv(const Params& p, int layer, long gid) {
  int c = (int)(gid & 1023), t = (int)(gid >> 10); const float* w = p.conv_w + (long)layer * 4 * 1024;
  float acc = p.conv_b[layer * 1024 + c];
  for (int i = 0; i < 4; ++i) { int tt = t - 3 + i; if (tt >= 0) acc += w[i * 1024 + c] * ldf(&p.proj[(long)tt * NPROJ + PB_X + c]); }
  stf(&p.xconv[gid], silu_f(acc));
}
HD_ void ph_b_dt(const Params& p, int layer, long gid) {
  int hd = (int)(gid & 7), c = (int)(gid >> 3); float a = -expf(p.a_log[layer * 8 + hd]); float cs = 0.f;
  for (int l = 0; l < 128; ++l) { int t = c * 128 + l; float dt = softplus_f(p.small[(long)t * NSMALL + 24 + hd] + p.dt_bias[layer * 8 + hd]);
    cs += dt * a; p.dt[(long)t * 8 + hd] = dt; p.acs[(long)t * 8 + hd] = cs; }
}
HD_ void ph_b_cb(const Params& p, long gid) {
  int s = (int)(gid & 127), l = (int)((gid >> 7) & 127), g = (int)((gid >> 14) & 1), c = (int)(gid >> 15);
  if (s > l) { p.cb[gid] = 0.f; return; }
  const SB* cm = &p.xconv[(long)(c * 128 + l) * 1024 + 768 + g * 128]; const SB* bm = &p.xconv[(long)(c * 128 + s) * 1024 + 512 + g * 128];
  float acc = 0.f; for (int n = 0; n < 128; ++n) acc += ldf(&cm[n]) * ldf(&bm[n]);
  p.cb[gid] = acc;
}
HD_ void ph_b_states(const Params& p, long gid) {
  int n = (int)(gid & 127), pp = (int)((gid >> 7) & 63), hd = (int)((gid >> 13) & 7), c = (int)(gid >> 16), g = hd >> 2;
  float last = p.acs[(long)(c * 128 + 127) * 8 + hd]; float acc = 0.f;
  for (int l = 0; l < 128; ++l) { long t = c * 128 + l;
    acc += ldf(&p.xconv[t * 1024 + 512 + g * 128 + n]) * expf(last - p.acs[t * 8 + hd]) * ldf(&p.xconv[t * 1024 + hd * 64 + pp]) * p.dt[t * 8 + hd]; }
  p.states[gid] = acc;
}
HD_ void ph_b_scan(const Params& p, long gid) {
  int hd = (int)(gid >> 13); int nc = p.S / 128; float h = 0.f;
  for (int c0 = 0; c0 < nc; c0 += 8) { float st[8], dc[8];
    for (int i = 0; i < 8; ++i) { st[i] = p.states[(long)(c0 + i) * 65536 + gid]; dc[i] = p.acs[(long)((c0 + i) * 128 + 127) * 8 + hd]; }
    for (int i = 0; i < 8; ++i) { p.states[(long)(c0 + i) * 65536 + gid] = h; h = h * expf(dc[i]) + st[i]; } }
}
HD_ void ph_b_out(const Params& p, int layer, long gid) {
  int pp = (int)(gid & 63), hd = (int)((gid >> 6) & 7), t = (int)(gid >> 9), g = hd >> 2, c = t >> 7, l = t & 127;
  float al = p.acs[(long)t * 8 + hd]; float acc = 0.f;
  const float* cbr = &p.cb[(((long)c * 2 + g) * 128 + l) * 128];
  for (int s = 0; s <= l; ++s) { long ts = c * 128 + s; acc += cbr[s] * expf(al - p.acs[ts * 8 + hd]) * ldf(&p.xconv[ts * 1024 + hd * 64 + pp]) * p.dt[ts * 8 + hd]; }
  float acc2 = 0.f; const float* pr = &p.states[(long)c * 65536 + ((long)hd * 64 + pp) * 128]; const SB* cm = &p.xconv[(long)t * 1024 + 768 + g * 128];
  for (int n = 0; n < 128; ++n) acc2 += ldf(&cm[n]) * pr[n];
  p.ybuf[gid] = acc + expf(al) * acc2 + ldf(&p.xconv[(long)t * 1024 + hd * 64 + pp]) * p.b_d[layer * 8 + hd];
}
HD_ void ph_b_norm(const Params& p, int layer, long gid) {
  int g = (int)(gid & 1), t = (int)(gid >> 1); float ss = 0.f;
  for (int i = 0; i < 256; ++i) { float v = p.ybuf[(long)t * 512 + g * 256 + i] * ldf(&p.mix[(long)t * NMIX + MX_B + g * 256 + i]); ss += v * v; }
  float r = 1.f / sqrtf(ss / 256.f + 1e-6f);
  for (int i = 0; i < 256; ++i) { SB* mp = &p.mix[(long)t * NMIX + MX_B + g * 256 + i]; float v = p.ybuf[(long)t * 512 + g * 256 + i] * ldf(mp);
    stf(mp, v * r * p.b_norm[layer * 512 + g * 256 + i]); }
}

HD_ void ph_b_dt2(const Params& p, int layer, long gid) {
  int hd = (int)(gid & 7), c = (int)(gid >> 3); float a = -expf(p.a_log[layer * 8 + hd]); float cs = 0.f;
  for (int l = 0; l < 128; ++l) { int t = c * 128 + l; float dt = softplus_f(p.small[(long)t * NSMALL + 24 + hd] + p.dt_bias[layer * 8 + hd]);
    cs += dt * a; p.dt[(long)t * 8 + hd] = dt; p.acs[(long)t * 8 + hd] = cs; }
  for (int l = 0; l < 128; ++l) { long t = c * 128 + l; p.wst[t * 8 + hd] = p.dt[t * 8 + hd] * expf(cs - p.acs[t * 8 + hd]); }
}
HD_ void ph_b_states2(const Params& p, long gid) {
  int pp = (int)(gid & 63), n = (int)((gid >> 6) & 127), hd = (int)((gid >> 13) & 7), c = (int)(gid >> 16), g = hd >> 2;
  float acc = 0.f;
  _Pragma("unroll 16") for (int l = 0; l < 128; ++l) { long t = c * 128 + l; acc += ldf(&p.xconv[t * 1024 + 512 + g * 128 + n]) * p.wst[t * 8 + hd] * ldf(&p.xconv[t * 1024 + hd * 64 + pp]); }
  p.states[gid] = acc;
}
HD_ void ph_b_out2(const Params& p, int layer, long gid) {
  int pp = (int)(gid & 63), hd = (int)((gid >> 6) & 7), t = (int)(gid >> 9), g = hd >> 2, c = t >> 7, l = t & 127;
  float al = p.acs[(long)t * 8 + hd]; float acc = 0.f;
  const float* cbr = &p.cb[(((long)c * 2 + g) * 128 + l) * 128];
  _Pragma("unroll 8") for (int s = 0; s <= l; ++s) { long ts = c * 128 + s; acc += cbr[s] * expf(al - p.acs[ts * 8 + hd]) * p.dt[ts * 8 + hd] * ldf(&p.xconv[ts * 1024 + hd * 64 + pp]); }
  float acc2 = 0.f; const float* pr = &p.states[(long)c * 65536 + (long)hd * 8192 + pp]; const SB* cm = &p.xconv[(long)t * 1024 + 768 + g * 128];
  _Pragma("unroll 16") for (int n = 0; n < 128; ++n) acc2 += ldf(&cm[n]) * pr[n * 64];
  p.ybuf[gid] = acc + expf(al) * acc2 + ldf(&p.xconv[(long)t * 1024 + hd * 64 + pp]) * p.b_d[layer * 8 + hd];
}

typedef __attribute__((ext_vector_type(8))) short bf16x8;
typedef __attribute__((ext_vector_type(16))) float f32x16;
typedef short v4i16_t __attribute__((ext_vector_type(4)));
typedef __bf16 bf2_t __attribute__((ext_vector_type(2)));
typedef float f2_t __attribute__((ext_vector_type(2)));
typedef unsigned u32x4 __attribute__((ext_vector_type(4)));
#define LDS3 __attribute__((address_space(3)))
typedef __attribute__((address_space(1))) const void* gptr_t;
typedef __attribute__((address_space(3))) void* lptr_t;
#define L2E 1.4426950408889634f
#define LN2 0.6931471805599453f
#define QSC (0.125f * L2E)
#ifndef FTHR
#define FTHR 8.0f
#endif
#define NINF (-__builtin_huge_valf())

struct WaveLds { unsigned short v[4096]; float tab[640]; float xch[32]; float pad[32]; };

__device__ __forceinline__ unsigned pk2(float a, float b) { f2_t v = {a, b}; bf2_t r = __builtin_convertvector(v, bf2_t); return __builtin_bit_cast(unsigned, r); }
__device__ __forceinline__ int crow(int e, int hi) { return (e & 3) + 8 * (e >> 2) + 4 * hi; }
__device__ __forceinline__ bf16x8 pack8(const f32x16& s, int o) {
  u32x4 r; r[0] = pk2(s[o], s[o + 1]); r[1] = pk2(s[o + 2], s[o + 3]); r[2] = pk2(s[o + 4], s[o + 5]); r[3] = pk2(s[o + 6], s[o + 7]); return __builtin_bit_cast(bf16x8, r); }
__device__ __forceinline__ f32x16 zero16() { f32x16 z;
#pragma unroll
  for (int e = 0; e < 16; ++e) z[e] = 0.f; return z; }
#define MFMA32(a, b, c) __builtin_amdgcn_mfma_f32_32x32x16_bf16((a), (b), (c), 0, 0, 0)

struct FlashState { f32x16 o0, o1; float m, l; };
__device__ __forceinline__ float wave_sum_f(float v) {
#pragma unroll
  for (int o = 32; o > 0; o >>= 1) v += __shfl_xor(v, o);
  return v; }

__device__ __forceinline__ void flash_core1(FlashState& st, f32x16& s, const unsigned short* vimg, float* xch, int lane) {
  const int r32 = lane & 31, hi = lane >> 5;
  float mx = s[0];
#pragma unroll
  for (int e = 1; e < 16; ++e) mx = fmaxf(mx, s[e]);
  mx = fmaxf(mx, __shfl_xor(mx, 32));
  if (__any(mx > st.m + FTHR)) {
    const float mn = fmaxf(st.m, mx); const float al = __builtin_amdgcn_exp2f(st.m - mn); st.m = mn; st.l *= al; xch[r32] = al;
#pragma unroll
    for (int e = 0; e < 16; ++e) { const float a = xch[crow(e, hi)]; st.o0[e] *= a; st.o1[e] *= a; }
  }
  float ps = 0.f;
#pragma unroll
  for (int e = 0; e < 16; ++e) { s[e] = __builtin_amdgcn_exp2f(s[e] - st.m); ps += s[e]; }
  st.l += ps;
  const bf16x8 pa0 = pack8(s, 0), pa1 = pack8(s, 8);
  const unsigned short* vb = vimg + (4 * hi + ((lane & 15) >> 2)) * 32 + ((lane >> 4) & 1) * 16 + (lane & 3) * 4;
#pragma unroll
  for (int s2 = 0; s2 < 2; ++s2) {
#pragma unroll
    for (int db = 0; db < 2; ++db) {
      const v4i16_t lo = __builtin_amdgcn_ds_read_tr16_b64_v4i16((LDS3 v4i16_t*)(vb + db * 2048 + s2 * 512));
      const v4i16_t hh = __builtin_amdgcn_ds_read_tr16_b64_v4i16((LDS3 v4i16_t*)(vb + db * 2048 + s2 * 512 + 256));
      const bf16x8 vf = {lo[0], lo[1], lo[2], lo[3], hh[0], hh[1], hh[2], hh[3]};
      if (db == 0) st.o0 = MFMA32(s2 ? pa1 : pa0, vf, st.o0); else st.o1 = MFMA32(s2 ? pa1 : pa0, vf, st.o1);
    }
  }
}
__device__ __forceinline__ void flash_core1_lin(FlashState& st, f32x16& s, float qs, float bb, const unsigned short* vimg, float* xch, int lane) {
  const int r32 = lane & 31, hi = lane >> 5;
  float mr = s[0];
#pragma unroll
  for (int e = 1; e < 16; ++e) mr = fmaxf(mr, s[e]);
  float mx = __builtin_fmaf(mr, qs, bb);
  mx = fmaxf(mx, __shfl_xor(mx, 32));
  if (__any(mx > st.m + FTHR)) {
    const float mn = fmaxf(st.m, mx); const float al = __builtin_amdgcn_exp2f(st.m - mn); st.m = mn; st.l *= al; xch[r32] = al;
#pragma unroll
    for (int e = 0; e < 16; ++e) { const float a = xch[crow(e, hi)]; st.o0[e] *= a; st.o1[e] *= a; }
  }
  const float bm = bb - st.m; float ps = 0.f;
#pragma unroll
  for (int e = 0; e < 16; ++e) { s[e] = __builtin_amdgcn_exp2f(__builtin_fmaf(s[e], qs, bm)); ps += s[e]; }
  st.l += ps;
  const bf16x8 pa0 = pack8(s, 0), pa1 = pack8(s, 8);
  const unsigned short* vb = vimg + (4 * hi + ((lane & 15) >> 2)) * 32 + ((lane >> 4) & 1) * 16 + (lane & 3) * 4;
#pragma unroll
  for (int s2 = 0; s2 < 2; ++s2) {
#pragma unroll
    for (int db = 0; db < 2; ++db) {
      const v4i16_t lo = __builtin_amdgcn_ds_read_tr16_b64_v4i16((LDS3 v4i16_t*)(vb + db * 2048 + s2 * 512));
      const v4i16_t hh = __builtin_amdgcn_ds_read_tr16_b64_v4i16((LDS3 v4i16_t*)(vb + db * 2048 + s2 * 512 + 256));
      const bf16x8 vf = {lo[0], lo[1], lo[2], lo[3], hh[0], hh[1], hh[2], hh[3]};
      if (db == 0) st.o0 = MFMA32(s2 ? pa1 : pa0, vf, st.o0); else st.o1 = MFMA32(s2 ? pa1 : pa0, vf, st.o1);
    }
  }
}
template <class VRow, class Fix>
__device__ __forceinline__ void flash_tile(FlashState& st, const bf16x8 (&qf)[4], const SB* kp, VRow vrow, Fix fix, WaveLds* L, int lane) {
  const int r32 = lane & 31, hi = lane >> 5;
  bf16x8 kf[4];
#pragma unroll
  for (int d0 = 0; d0 < 4; ++d0) kf[d0] = *(const bf16x8*)(kp + d0 * 16 + hi * 8);
#pragma unroll
  for (int i = 0; i < 4; ++i) { const int c = lane + 64 * i, key = c >> 3, ch = c & 7; const SB* vp = vrow(key); const uint4 vv = *(const uint4*)(vp + ch * 8);
    *(uint4*)&L->v[(ch >> 2) * 2048 + key * 32 + (ch & 3) * 8] = vv; }
  f32x16 s = zero16();
#pragma unroll
  for (int d0 = 0; d0 < 4; ++d0) s = MFMA32(kf[d0], qf[d0], s);
  fix(s);
  flash_core1(st, s, L->v, L->xch, lane);
}
__device__ __forceinline__ void flash_core2(FlashState& st, f32x16& s0, f32x16& s1, const unsigned short* vimg, float* xch, int lane) {
  const int r32 = lane & 31, hi = lane >> 5;
  float mx = fmaxf(s0[0], s1[0]);
#pragma unroll
  for (int e = 1; e < 16; ++e) mx = fmaxf(mx, fmaxf(s0[e], s1[e]));
  mx = fmaxf(mx, __shfl_xor(mx, 32));
  if (__any(mx > st.m + FTHR)) {
    const float mn = fmaxf(st.m, mx); const float al = __builtin_amdgcn_exp2f(st.m - mn); st.m = mn; st.l *= al; xch[r32] = al;
#pragma unroll
    for (int e = 0; e < 16; ++e) { const float a = xch[crow(e, hi)]; st.o0[e] *= a; st.o1[e] *= a; }
  }
  float ps = 0.f;
#pragma unroll
  for (int e = 0; e < 16; ++e) { s0[e] = __builtin_amdgcn_exp2f(s0[e] - st.m); s1[e] = __builtin_amdgcn_exp2f(s1[e] - st.m); ps += s0[e] + s1[e]; }
  st.l += ps;
  bf16x8 pa[4]; pa[0] = pack8(s0, 0); pa[1] = pack8(s0, 8); pa[2] = pack8(s1, 0); pa[3] = pack8(s1, 8);
  const unsigned short* vb = vimg + (4 * hi + ((lane & 15) >> 2)) * 32 + ((lane >> 4) & 1) * 16 + (lane & 3) * 4;
#pragma unroll
  for (int kk = 0; kk < 4; ++kk) {
#pragma unroll
    for (int db = 0; db < 2; ++db) {
      const v4i16_t lo = __builtin_amdgcn_ds_read_tr16_b64_v4i16((LDS3 v4i16_t*)(vb + db * 2048 + kk * 512));
      const v4i16_t hh = __builtin_amdgcn_ds_read_tr16_b64_v4i16((LDS3 v4i16_t*)(vb + db * 2048 + kk * 512 + 256));
      const bf16x8 vf = {lo[0], lo[1], lo[2], lo[3], hh[0], hh[1], hh[2], hh[3]};
      if (db == 0) st.o0 = MFMA32(pa[kk], vf, st.o0); else st.o1 = MFMA32(pa[kk], vf, st.o1);
    }
  }
}
__device__ __forceinline__ void flash_core2_lin(FlashState& st, f32x16& s0, f32x16& s1, float qs, float bb, const unsigned short* vimg, float* xch, int lane) {
  const int r32 = lane & 31, hi = lane >> 5;
  float mr = fmaxf(s0[0], s1[0]);
#pragma unroll
  for (int e = 1; e < 16; ++e) mr = fmaxf(mr, fmaxf(s0[e], s1[e]));
  float mx = __builtin_fmaf(mr, qs, bb);
  mx = fmaxf(mx, __shfl_xor(mx, 32));
  if (__any(mx > st.m + FTHR)) {
    const float mn = fmaxf(st.m, mx); const float al = __builtin_amdgcn_exp2f(st.m - mn); st.m = mn; st.l *= al; xch[r32] = al;
#pragma unroll
    for (int e = 0; e < 16; ++e) { const float a = xch[crow(e, hi)]; st.o0[e] *= a; st.o1[e] *= a; }
  }
  const float bm = bb - st.m; float ps = 0.f;
#pragma unroll
  for (int e = 0; e < 16; ++e) { s0[e] = __builtin_amdgcn_exp2f(__builtin_fmaf(s0[e], qs, bm)); s1[e] = __builtin_amdgcn_exp2f(__builtin_fmaf(s1[e], qs, bm)); ps += s0[e] + s1[e]; }
  st.l += ps;
  bf16x8 pa[4]; pa[0] = pack8(s0, 0); pa[1] = pack8(s0, 8); pa[2] = pack8(s1, 0); pa[3] = pack8(s1, 8);
  const unsigned short* vb = vimg + (4 * hi + ((lane & 15) >> 2)) * 32 + ((lane >> 4) & 1) * 16 + (lane & 3) * 4;
#pragma unroll
  for (int kk = 0; kk < 4; ++kk) {
#pragma unroll
    for (int db = 0; db < 2; ++db) {
      const v4i16_t lo = __builtin_amdgcn_ds_read_tr16_b64_v4i16((LDS3 v4i16_t*)(vb + db * 2048 + kk * 512));
      const v4i16_t hh = __builtin_amdgcn_ds_read_tr16_b64_v4i16((LDS3 v4i16_t*)(vb + db * 2048 + kk * 512 + 256));
      const bf16x8 vf = {lo[0], lo[1], lo[2], lo[3], hh[0], hh[1], hh[2], hh[3]};
      if (db == 0) st.o0 = MFMA32(pa[kk], vf, st.o0); else st.o1 = MFMA32(pa[kk], vf, st.o1);
    }
  }
}
#ifndef FT2
#define FT2 1
#endif
template <class VRow, class Fix0, class Fix1>
__device__ __forceinline__ void flash_tile2(FlashState& st, const bf16x8 (&qf)[4], const SB* kp0, const SB* kp1, VRow vrow, Fix0 fix0, Fix1 fix1, WaveLds* L, int lane) {
  if (!FT2) { flash_tile(st, qf, kp0, [&](int key) { return vrow(key); }, fix0, L, lane); flash_tile(st, qf, kp1, [&](int key) { return vrow(key + 32); }, fix1, L, lane); return; }
  const int hi = lane >> 5;
  bf16x8 kf0[4], kf1[4];
#pragma unroll
  for (int d0 = 0; d0 < 4; ++d0) { kf0[d0] = *(const bf16x8*)(kp0 + d0 * 16 + hi * 8); kf1[d0] = *(const bf16x8*)(kp1 + d0 * 16 + hi * 8); }
#pragma unroll
  for (int i = 0; i < 8; ++i) { const int c = lane + 64 * i, key = c >> 3, ch = c & 7; const SB* vp = vrow(key); const uint4 vv = *(const uint4*)(vp + ch * 8);
    *(uint4*)&L->v[(ch >> 2) * 2048 + key * 32 + (ch & 3) * 8] = vv; }
  f32x16 s0 = zero16(), s1 = zero16();
#pragma unroll
  for (int d0 = 0; d0 < 4; ++d0) { s0 = MFMA32(kf0[d0], qf[d0], s0); s1 = MFMA32(kf1[d0], qf[d0], s1); }
  fix0(s0); fix1(s1);
  flash_core2(st, s0, s1, L->v, L->xch, lane);
}
template <class KPtr, class VRow, class Fix>
__device__ __forceinline__ void flash_run(FlashState& st, const bf16x8 (&qf)[4], int t0, int t1, KPtr kptr, VRow vrow, Fix fix, WaveLds* L, int lane) {
  if (t0 >= t1) return;
  const int hi = lane >> 5; bf16x8 kfn[4];
#define FR_ISSUE(tt) { const int t_ = (tt); _Pragma("unroll") for (int i_ = 0; i_ < 4; ++i_) { const int db_ = i_ >> 1, key_ = (i_ & 1) * 16 + (lane >> 2), wi_ = lane & 3; \
      __builtin_amdgcn_global_load_lds((gptr_t)(vrow(t_, key_) + db_ * 32 + wi_ * 8), (lptr_t)&L->v[db_ * 2048 + (t_ & 1) * 1024 + (i_ & 1) * 512], 16, 0, 0); } \
    const SB* kp_ = kptr(t_); _Pragma("unroll") for (int d0_ = 0; d0_ < 4; ++d0_) kfn[d0_] = *(const bf16x8*)(kp_ + d0_ * 16 + hi * 8); }
  FR_ISSUE(t0)
  for (int t = t0; t < t1; ++t) {
    asm volatile("s_waitcnt vmcnt(0)" ::: "memory");
    bf16x8 kf[4];
#pragma unroll
    for (int d0 = 0; d0 < 4; ++d0) kf[d0] = kfn[d0];
    if (t + 1 < t1) FR_ISSUE(t + 1)
    f32x16 s = zero16();
#pragma unroll
    for (int d0 = 0; d0 < 4; ++d0) s = MFMA32(kf[d0], qf[d0], s);
    fix(t, s);
    flash_core1(st, s, L->v + (t & 1) * 1024, L->xch, lane);
  }
#undef FR_ISSUE
}
__device__ __forceinline__ float flash_finish(FlashState& st, WaveLds* L, int lane) {
  const int r32 = lane & 31, hi = lane >> 5;
  const float lt = st.l + __shfl_xor(st.l, 32); const float inv = lt > 0.f ? 1.f / lt : 0.f;
  L->xch[r32] = inv;
#pragma unroll
  for (int e = 0; e < 16; ++e) { const float a = L->xch[crow(e, hi)]; st.o0[e] *= a; st.o1[e] *= a; }
  return (st.m + __builtin_amdgcn_logf(lt)) * LN2;
}
__device__ __forceinline__ void load_q(bf16x8 (&qf)[4], const SB* qp, int hi) {
#pragma unroll
  for (int d0 = 0; d0 < 4; ++d0) qf[d0] = *(const bf16x8*)(qp + d0 * 16 + hi * 8);
}
__device__ __forceinline__ void fix_tab(f32x16& s, const WaveLds* L, int base, int lane, bool chk, int kb) {
  const int r32 = lane & 31, hi = lane >> 5; const float* tp = L->tab + base + r32 + 32 - 4 * hi;
#pragma unroll
  for (int e = 0; e < 16; ++e) { const int kk = (e & 3) + 8 * (e >> 2); float v = s[e] * QSC + tp[-kk]; if (chk && (kb + kk + 4 * hi < 0)) v = NINF; s[e] = v; }
}

__device__ __forceinline__ void unit_c(const Params& p, int layer, int u, WaveLds* L, int lane) {
  const int h = u & 7, qt = u >> 3, q0 = qt * 32, hk = h >> 2, r32 = lane & 31, hi = lane >> 5;
  for (int x = lane; x < 192; x += 64) { const int dist = x - 32; L->tab[x] = (dist >= 0 && dist <= 127) ? 0.f : NINF; }
  bf16x8 qf[4]; load_q(qf, p.proj + (long)(q0 + r32) * NPROJ + PC_Q + h * 64, hi);
  FlashState st; st.o0 = zero16(); st.o1 = zero16(); st.m = p.sinks[layer * 8 + h] * L2E; st.l = hi ? 0.f : 1.f;
  const SB* kvb = p.proj + PC_KV + hk * 64; const bool chk = q0 < 128;
  flash_run(st, qf, 0, 5, [&](int t) { int tok = q0 - 128 + 32 * t + r32; tok = tok < 0 ? 0 : tok; return kvb + (long)tok * NPROJ; },
            [&](int t, int key) { int tk = q0 - 128 + 32 * t + key; tk = tk < 0 ? 0 : tk; return kvb + 128 + (long)tk * NPROJ; },
            [&](int t, f32x16& s) { fix_tab(s, L, 128 - 32 * t, lane, chk, q0 - 128 + 32 * t); }, L, lane);
  flash_finish(st, L, lane);
#pragma unroll
  for (int e = 0; e < 16; ++e) { SB* mp = p.mix + (long)(q0 + crow(e, hi)) * NMIX + MX_C + h * 64 + r32; mp[0] = f2bf(st.o0[e] * bf2f(mp[0])); mp[32] = f2bf(st.o1[e] * bf2f(mp[32])); }
}
__device__ __forceinline__ void unit_m(const Params& p, int layer, int u, WaveLds* L, int lane) {
  const int h = u & 3, qt = u >> 2, q0 = qt * 32, r32 = lane & 31, hi = lane >> 5;
  bf16x8 qf[4]; load_q(qf, p.proj + (long)(q0 + r32) * NPROJ + PM_Q + h * 64, hi);
  FlashState st; st.o0 = zero16(); st.o1 = zero16(); st.m = -1e30f; st.l = 0.f;
  const SB* kb = p.memkv + (long)layer * 256 * 512 + h * 64;
  flash_run(st, qf, 0, 8, [&](int t) { return kb + (long)(32 * t + r32) * 512; }, [&](int t, int key) { return kb + 256 + (long)(32 * t + key) * 512; },
            [&](int, f32x16& s) {
#pragma unroll
              for (int e = 0; e < 16; ++e) s[e] *= QSC; }, L, lane);
  flash_finish(st, L, lane);
#pragma unroll
  for (int e = 0; e < 16; ++e) { SB* mp = p.mix + (long)(q0 + crow(e, hi)) * NMIX + MX_M + h * 64 + r32; mp[0] = f2bf(st.o0[e] * bf2f(mp[0])); mp[32] = f2bf(st.o1[e] * bf2f(mp[32])); }
}
__device__ __forceinline__ void unit_awin(const Params& p, int u, WaveLds* L, int lane) {
  const int h = u & 7, qt = u >> 3, q0 = qt * 32, hk = h >> 2, r32 = lane & 31, hi = lane >> 5;
  for (int x = lane; x < 608; x += 64) { const int dist = x - 32; L->tab[x] = (dist >= 0 && dist <= 511) ? p.tabA[h * TABA_N + dist] * L2E : NINF; }
  bf16x8 qf[4]; load_q(qf, p.proj + (long)(q0 + r32) * NPROJ + PA_Q + h * 64, hi);
  FlashState st; st.o0 = zero16(); st.o1 = zero16(); st.m = -1e30f; st.l = 0.f;
  const SB* kvb = p.proj + PA_KV + 4 * 128 + hk * 64; const bool chk = q0 < 512;
  { int tfirst = 0; if (q0 < 512) tfirst = (512 - q0) / 32 - 0; if (tfirst > 16) tfirst = 16; if (q0 < 512 && (q0 - 512 + 32 * tfirst + 31) < 0) ++tfirst;
    flash_run(st, qf, tfirst, 17, [&](int t) { int tok = q0 - 512 + 32 * t + r32; tok = tok < 0 ? 0 : tok; return kvb + (long)tok * NPROJ; },
              [&](int t, int key) { int tk = q0 - 512 + 32 * t + key; tk = tk < 0 ? 0 : tk; return kvb + 128 + (long)tk * NPROJ; },
              [&](int t, f32x16& s) { fix_tab(s, L, 512 - 32 * t, lane, chk, q0 - 512 + 32 * t); }, L, lane); }
  flash_finish(st, L, lane);
#pragma unroll
  for (int e = 0; e < 16; ++e) { SB* op = p.ow + (long)(q0 + crow(e, hi)) * 512 + h * 64 + r32; op[0] = f2bf(st.o0[e]); op[32] = f2bf(st.o1[e]); }
}
__device__ __forceinline__ void unit_d(const Params& p, int u, WaveLds* L, int lane) {
  const int S = p.S, per = (S / 32) * 8; const int gi = u / per, u2 = u % per; const int h = u2 & 7, v = u2 >> 3;
  const int dil = gi == 0 ? 1 : (gi == 1 ? 4 : 16); const int it = v / dil, r = v % dil, i0 = it * 32;
  const int r32 = lane & 31, hi = lane >> 5;
  for (int x = lane; x < 192; x += 64) { const int dd = x - 32; L->tab[x] = (dd >= 0 && dd <= 128) ? p.tabD[(gi * 8 + h) * TABD_N + dd] * L2E : NINF; }
  bf16x8 qf[4]; load_q(qf, p.proj + (long)(r + dil * (i0 + r32)) * NPROJ + PD_Q + gi * 512 + h * 64, hi);
  FlashState st; st.o0 = zero16(); st.o1 = zero16(); st.m = -1e30f; st.l = 0.f;
  const SB* kvb = p.proj + PD_KV + h * 64; const bool chk = i0 < 128;
  flash_run(st, qf, 0, 5, [&](int t) { int j = i0 - 128 + 32 * t + r32; j = j < 0 ? 0 : j; return kvb + (long)(r + dil * j) * NPROJ; },
            [&](int t, int key) { int jj = i0 - 128 + 32 * t + key; jj = jj < 0 ? 0 : jj; return kvb + 512 + (long)(r + dil * jj) * NPROJ; },
            [&](int t, f32x16& s) { fix_tab(s, L, 128 - 32 * t, lane, chk, i0 - 128 + 32 * t); }, L, lane);
  const float lse = flash_finish(st, L, lane);
#pragma unroll
  for (int e = 0; e < 16; ++e) { const long tok = r + dil * (i0 + crow(e, hi)); SB* op = p.dop + ((long)gi * S + tok) * 512 + h * 64 + r32; op[0] = f2bf(st.o0[e]); op[32] = f2bf(st.o1[e]); }
  if (hi == 0) p.dlse[((long)gi * S + r + dil * (i0 + r32)) * 8 + h] = lse;
}
__device__ __forceinline__ void fix_cmp(f32x16& s, const Params& p, int h, int q0, int t, int lane) {
  const int r32 = lane & 31, hi = lane >> 5; const int dq = q0 + r32 - 31 - 16 * (32 * t + 4 * hi);
  const bool far = (q0 - 16 * (32 * t + 31) - 31) >= 1513; const float c31 = p.tabA[h * TABA_N + 2047] * L2E;
#pragma unroll
  for (int e = 0; e < 16; ++e) { const int kk = (e & 3) + 8 * (e >> 2); const int dist = dq - 16 * kk; float b;
    if (far) b = c31; else { const int dc = dist < 0 ? 0 : (dist > 2047 ? 2047 : dist); b = p.tabA[h * TABA_N + dc] * L2E; }
    s[e] = dist < 0 ? NINF : s[e] * QSC + b; }
}
__device__ __forceinline__ void unit_acmp1(const Params& p, int u, WaveLds* L, int lane) {
  const int h = u & 7, qt = (p.S / 32 - 1) - (u >> 3), q0 = qt * 32, g = h >> 2, r32 = lane & 31, hi = lane >> 5; const int ncmp = p.S / 16;
  bf16x8 qf[4]; load_q(qf, p.proj + (long)(q0 + r32) * NPROJ + PA_Q + h * 64, hi);
  FlashState st; st.o0 = zero16(); st.o1 = zero16(); st.m = -1e30f; st.l = 0.f;
  const int jn = q0 / 16 + 1, nt = (jn + 31) / 32; const SB* kc = p.kvc + g * 64; const SB* vc = p.kvc + (long)ncmp * 128 + g * 64;
  flash_run(st, qf, 0, nt, [&](int t) { int j = 32 * t + r32; j = j >= ncmp ? ncmp - 1 : j; return kc + (long)j * 128; },
            [&](int t, int key) { int jj = 32 * t + key; jj = jj >= ncmp ? ncmp - 1 : jj; return vc + (long)jj * 128; },
            [&](int t, f32x16& s) { fix_cmp(s, p, h, q0, t, lane); }, L, lane);
  const float lt = st.l + __shfl_xor(st.l, 32); const float inv = lt > 0.f ? 1.f / lt : 0.f;
  flash_finish(st, L, lane);
#pragma unroll
  for (int e = 0; e < 16; ++e) { SB* op = p.oc + (long)(q0 + crow(e, hi)) * 512 + h * 64 + r32; op[0] = f2bf(st.o0[e]); op[32] = f2bf(st.o1[e]); }
  if (hi == 0) { p.cml[((long)(q0 + r32) * 8 + h) * 2] = st.m; p.cml[((long)(q0 + r32) * 8 + h) * 2 + 1] = inv; }
}
__device__ __forceinline__ void unit_acmp2(const Params& p, int u, int lane) {
  const int part = u & 3, g = (u >> 2) & 1, qt = (p.S / 32 - 1) - (u >> 3), q0 = qt * 32, r32 = lane & 31, hi = lane >> 5; const int ncmp = p.S / 16;
  const int jn = q0 / 16 + 1, nt = (jn + 31) / 32; const SB* kc = p.kvc + g * 64; float carry = 0.f;
  const int tper = (nt + 3) >> 2, tbeg = part * tper, tend = (tbeg + tper < nt) ? tbeg + tper : nt; if (tbeg >= nt) return;
  float* impq = p.imp + ((long)(q0 + r32) * 2 + g) * 256;
  const SB* qbase = p.proj + (long)(q0 + r32) * NPROJ + PA_Q + g * 256; const float* cmlq = p.cml + ((long)(q0 + r32) * 8 + g * 4) * 2;
  for (int t = (tbeg > 0 ? tbeg - 1 : 0); t < tend; ++t) { int j = 32 * t + r32; j = j >= ncmp ? ncmp - 1 : j; const SB* kp = kc + (long)j * 128;
    bf16x8 kf[4];
#pragma unroll
    for (int d0 = 0; d0 < 4; ++d0) kf[d0] = *(const bf16x8*)(kp + d0 * 16 + hi * 8);
    float accA[4] = {0.f, 0.f, 0.f, 0.f}, accL[4] = {0.f, 0.f, 0.f, 0.f};
#pragma unroll 1
    for (int hh = 0; hh < 4; ++hh) { bf16x8 qf[4]; load_q(qf, qbase + hh * 64, hi); const float m = cmlq[hh * 2], il = cmlq[hh * 2 + 1];
      f32x16 s = zero16();
#pragma unroll
      for (int d0 = 0; d0 < 4; ++d0) s = MFMA32(kf[d0], qf[d0], s);
      fix_cmp(s, p, g * 4 + hh, q0, t, lane);
#pragma unroll
      for (int e = 0; e < 16; ++e) { const float pr = __builtin_amdgcn_exp2f(s[e] - m) * il; accA[e >> 2] += pr; if ((e & 3) == 3) accL[e >> 2] += pr; } }
    float oth[4];
#pragma unroll
    for (int eg = 0; eg < 4; ++eg) oth[eg] = __shfl_xor(accL[eg], 32);
#pragma unroll
    for (int eg = 0; eg < 4; ++eg) { const float prev = hi ? oth[eg] : (eg > 0 ? oth[eg > 0 ? eg - 1 : 0] : carry); if (t >= tbeg) impq[8 * t + 2 * eg + hi] = 2.f * accA[eg] - accL[eg] + prev; }
    carry = oth[3]; }
}
__device__ __forceinline__ float wave_max_f(float v) {
#pragma unroll
  for (int o = 32; o > 0; o >>= 1) v = fmaxf(v, __shfl_xor(v, o));
  return v; }
__device__ __forceinline__ int wave_min_i(int v) {
#pragma unroll
  for (int o = 32; o > 0; o >>= 1) { const int w = __shfl_xor(v, o); v = w < v ? w : v; }
  return v; }
__device__ __forceinline__ void unit_topk(const Params& p, int u, int lane) {
  const int q = u >> 1, cur = q >> 6; const float* imp = p.imp + (long)u * 256; int* idx = p.idx + (long)u * 16;
  float v[4];
#pragma unroll
  for (int k = 0; k < 4; ++k) { const int b = lane + 64 * k; float x = (b <= cur) ? imp[b] : -1.f; if (b == 0 || b == cur) x = 1e4f; v[k] = x; }
  int mine = -1;
  for (int k = 0; k < 16; ++k) {
    float lm = fmaxf(fmaxf(v[0], v[1]), fmaxf(v[2], v[3])); const float m = wave_max_f(lm);
    int cand = 0x7fffffff;
#pragma unroll
    for (int kk = 3; kk >= 0; --kk) if (v[kk] == m) cand = lane + 64 * kk;
    const int bsel = wave_min_i(cand);
#pragma unroll
    for (int kk = 0; kk < 4; ++kk) if (lane + 64 * kk == bsel) v[kk] = -2.f;
    if (lane == k) mine = (m >= 0.f) ? bsel : -1;
  }
  if (lane < 16) idx[lane] = mine;
}
template <bool STORE = true>
__device__ __forceinline__ void unit_asel(const Params& p, int u, WaveLds* L, int lane) {
  const int g = u & 1, q = u >> 1, r32 = lane & 31, hi = lane >> 5, hh = r32 & 3, h = g * 4 + hh;
  bf16x8 qf[4]; load_q(qf, p.proj + (long)q * NPROJ + PA_Q + h * 64, hi);
  FlashState st; st.o0 = zero16(); st.o1 = zero16(); st.m = -1e30f; st.l = 0.f;
  const int* idx = p.idx + (long)u * 16; const SB* kvb = p.proj + PA_KV + 2 * 128 + g * 64; const float c31 = p.tabA[h * TABA_N + 2047] * L2E;
  for (int k = 0; k < 16; ++k) { const int b = __builtin_amdgcn_readfirstlane(idx[k]); if (b < 0) continue;
    for (int kt = 0; kt < 2; ++kt) { const int t0 = b * 64 + kt * 32; if (t0 > q) continue;
      const bool far = (q - (t0 + 31)) >= 1513; const bool edge = (t0 + 31 > q);
      flash_tile(st, qf, kvb + (long)(t0 + r32) * NPROJ, [&](int key) { return kvb + 128 + (long)(t0 + key) * NPROJ; },
                 [&](f32x16& s) {
#pragma unroll
                   for (int e = 0; e < 16; ++e) { const int tk = t0 + (e & 3) + 8 * (e >> 2) + 4 * hi; const int dist = q - tk; float bsv;
                     if (far) bsv = c31; else { const int dc = dist < 0 ? 0 : (dist > 2047 ? 2047 : dist); bsv = p.tabA[h * TABA_N + dc] * L2E; }
                     float vv = s[e] * QSC + bsv; if (edge && dist < 0) vv = NINF; s[e] = vv; } }, L, lane); } }
  flash_finish(st, L, lane);
  if (!STORE) { asm volatile("" :: "v"(st.o0[0]), "v"(st.o1[3])); return; }
  if (hi == 0) {
#pragma unroll
    for (int e = 0; e < 4; ++e) { const int he = g * 4 + e; const float* gl = p.small + (long)q * NSMALL + he * 3;
      const float g0 = sigmoid_f(gl[0]), g1 = sigmoid_f(gl[1]), g2 = sigmoid_f(gl[2]);
#pragma unroll
      for (int db = 0; db < 2; ++db) { const long c = (long)q * 512 + he * 64 + db * 32 + r32; const float os = db ? st.o1[e] : st.o0[e];
        const float a = g0 * bf2f(p.oc[c]) + g1 * os + g2 * bf2f(p.ow[c]); SB* mp = p.mix + (long)q * NMIX + MX_A + he * 64 + db * 32 + r32; *mp = f2bf(a * bf2f(*mp)); } }
  }
}

struct WaveLds2 { unsigned short x[2048]; unsigned short b[2048]; float acs[128]; float dtv[128]; float xch[64]; };
template <bool SCALE, class RowScale>
__device__ __forceinline__ void stage_slab(unsigned short* dst, const SB* src, long ld, RowScale rs, int lane) {
#pragma unroll
  for (int i = 0; i < 4; ++i) { const int c = lane + 64 * i, row = c >> 3, ch = c & 7; uint4 vv = *(const uint4*)(src + (long)row * ld + ch * 8);
    if (SCALE) { const float sc = rs(row); unsigned w[4] = {vv.x, vv.y, vv.z, vv.w};
#pragma unroll
      for (int k = 0; k < 4; ++k) { const float lo = __uint_as_float(w[k] << 16) * sc, hi2 = __uint_as_float(w[k] & 0xffff0000u) * sc; w[k] = pk2(lo, hi2); }
      vv.x = w[0]; vv.y = w[1]; vv.z = w[2]; vv.w = w[3]; }
    *(uint4*)&dst[(ch >> 2) * 1024 + row * 32 + (ch & 3) * 8] = vv; }
}
__device__ __forceinline__ bf16x8 slab_frag(const unsigned short* img, int cb, int s2, int lane) {
  const int hi = lane >> 5; const unsigned short* vb = img + (4 * hi + ((lane & 15) >> 2)) * 32 + ((lane >> 4) & 1) * 16 + (lane & 3) * 4 + cb * 1024 + s2 * 512;
  const v4i16_t lo = __builtin_amdgcn_ds_read_tr16_b64_v4i16((LDS3 v4i16_t*)vb);
  const v4i16_t hh = __builtin_amdgcn_ds_read_tr16_b64_v4i16((LDS3 v4i16_t*)(vb + 256));
  return (bf16x8){lo[0], lo[1], lo[2], lo[3], hh[0], hh[1], hh[2], hh[3]};
}
__device__ __forceinline__ void unit_bstates(const Params& p, int u, WaveLds2* L, int lane) {
  const int nh = u & 1, hd = (u >> 1) & 7, c = u >> 4, g = hd >> 2, r32 = lane & 31, hi = lane >> 5;
  f32x16 acc[2][2];
#pragma unroll
  for (int i = 0; i < 2; ++i)
#pragma unroll
    for (int j = 0; j < 2; ++j) acc[i][j] = zero16();
  const SB* xb = p.xconv + (long)c * 128 * 1024; const float* wst = p.wst + (long)c * 128 * 8 + hd;
  for (int q4 = 0; q4 < 4; ++q4) {
    stage_slab<true>(L->x, xb + (long)(32 * q4) * 1024 + hd * 64, 1024, [&](int row) { return wst[(32 * q4 + row) * 8]; }, lane);
    stage_slab<false>(L->b, xb + (long)(32 * q4) * 1024 + 512 + g * 128 + nh * 64, 1024, [&](int) { return 1.f; }, lane);
#pragma unroll
    for (int s2 = 0; s2 < 2; ++s2) { bf16x8 af[2], bfr[2];
#pragma unroll
      for (int i = 0; i < 2; ++i) { af[i] = slab_frag(L->x, i, s2, lane); bfr[i] = slab_frag(L->b, i, s2, lane); }
#pragma unroll
      for (int i = 0; i < 2; ++i)
#pragma unroll
        for (int j = 0; j < 2; ++j) acc[i][j] = MFMA32(af[i], bfr[j], acc[i][j]); } }
  float* so = p.states + ((long)c * 8 + hd) * 8192 + nh * 64 + r32;
#pragma unroll
  for (int i = 0; i < 2; ++i)
#pragma unroll
    for (int j = 0; j < 2; ++j)
#pragma unroll
      for (int e = 0; e < 16; ++e) so[(long)(32 * i + crow(e, hi)) * 128 + 32 * j] = acc[i][j][e];
}
__device__ __forceinline__ void unit_bout(const Params& p, int layer, int u, WaveLds2* L, int lane) {
  const int lt = u & 3, hd = (u >> 2) & 7, c = u >> 5, g = hd >> 2, r32 = lane & 31, hi = lane >> 5;
  for (int x = lane; x < 128; x += 64) { L->acs[x] = p.acs[((long)c * 128 + x) * 8 + hd]; L->dtv[x] = p.dt[((long)c * 128 + x) * 8 + hd]; }
  f32x16 acc[2] = {zero16(), zero16()}, acc2[2] = {zero16(), zero16()};
  const SB* xb = p.xconv + (long)c * 128 * 1024; const int l = 32 * lt + r32; const float al = p.acs[((long)c * 128 + l) * 8 + hd];
  const float* cbr = p.cb + ((long)c * 2 + g) * 16384 + (long)l * 128;
  for (int sc = 0; sc <= lt; ++sc) {
    stage_slab<false>(L->x, xb + (long)(32 * sc) * 1024 + hd * 64, 1024, [&](int) { return 1.f; }, lane);
#pragma unroll
    for (int s2 = 0; s2 < 2; ++s2) { float mv[8];
#pragma unroll
      for (int jj = 0; jj < 2; ++jj) { const int s0 = 32 * sc + 16 * s2 + 8 * jj + 4 * hi; const float4 cv = *(const float4*)(cbr + s0); const float4 av = *(const float4*)(&L->acs[s0]); const float4 dv = *(const float4*)(&L->dtv[s0]);
        mv[4 * jj + 0] = (s0 + 0 <= l) ? cv.x * __expf(al - av.x) * dv.x : 0.f; mv[4 * jj + 1] = (s0 + 1 <= l) ? cv.y * __expf(al - av.y) * dv.y : 0.f;
        mv[4 * jj + 2] = (s0 + 2 <= l) ? cv.z * __expf(al - av.z) * dv.z : 0.f; mv[4 * jj + 3] = (s0 + 3 <= l) ? cv.w * __expf(al - av.w) * dv.w : 0.f; }
      u32x4 aw; aw[0] = pk2(mv[0], mv[1]); aw[1] = pk2(mv[2], mv[3]); aw[2] = pk2(mv[4], mv[5]); aw[3] = pk2(mv[6], mv[7]); const bf16x8 af = __builtin_bit_cast(bf16x8, aw);
#pragma unroll
      for (int pt = 0; pt < 2; ++pt) acc[pt] = MFMA32(af, slab_frag(L->x, pt, s2, lane), acc[pt]); } }
  const SB* cmr = xb + (long)l * 1024 + 768 + g * 128; const float* prv = p.states + ((long)c * 8 + hd) * 8192;
#pragma unroll 2
  for (int ks = 0; ks < 8; ++ks) { const bf16x8 af = *(const bf16x8*)(cmr + 16 * ks + 8 * hi);
#pragma unroll
    for (int pt = 0; pt < 2; ++pt) { const float* pr = prv + (long)(32 * pt + r32) * 128 + 16 * ks + 8 * hi; const float4 a0 = *(const float4*)pr, a1 = *(const float4*)(pr + 4);
      u32x4 bw; bw[0] = pk2(a0.x, a0.y); bw[1] = pk2(a0.z, a0.w); bw[2] = pk2(a1.x, a1.y); bw[3] = pk2(a1.z, a1.w);
      acc2[pt] = MFMA32(af, __builtin_bit_cast(bf16x8, bw), acc2[pt]); } }
  const float dsk = p.b_d[layer * 8 + hd];
#pragma unroll
  for (int e = 0; e < 16; ++e) { const int lr = 32 * lt + crow(e, hi); const float ea = __expf(L->acs[lr]); const long t = (long)c * 128 + lr;
#pragma unroll
    for (int pt = 0; pt < 2; ++pt) { const int pp = 32 * pt + r32; p.ybuf[t * 512 + hd * 64 + pp] = acc[pt][e] + ea * acc2[pt][e] + dsk * bf2f(xb[(long)lr * 1024 + hd * 64 + pp]); } }
}
__device__ __forceinline__ void unit_bnorm(const Params& p, int layer, int u, int lane) {
  const int g = u & 1; const long t = u >> 1; const float4 yv = *(const float4*)(p.ybuf + t * 512 + g * 256 + lane * 4);
  SB* mp = p.mix + t * NMIX + MX_B + g * 256 + lane * 4; const ushort4 zv = *(const ushort4*)mp;
  const float v0 = yv.x * bf2f(zv.x), v1 = yv.y * bf2f(zv.y), v2 = yv.z * bf2f(zv.z), v3 = yv.w * bf2f(zv.w);
  const float ss = wave_sum_f(v0 * v0 + v1 * v1 + v2 * v2 + v3 * v3); const float r = 1.f / sqrtf(ss * (1.f / 256.f) + 1e-6f);
  const float4 w = *(const float4*)(p.b_norm + layer * 512 + g * 256 + lane * 4);
  ushort4 o; o.x = f2bf(v0 * r * w.x); o.y = f2bf(v1 * r * w.y); o.z = f2bf(v2 * r * w.z); o.w = f2bf(v3 * r * w.w); *(ushort4*)mp = o;
}
__device__ __forceinline__ void unit_bdt(const Params& p, int layer, int u, int lane) {
  const int hd = u & 7, c = u >> 3; const float a = -expf(p.a_log[layer * 8 + hd]), bias = p.dt_bias[layer * 8 + hd]; const long t0 = (long)c * 128 + 2 * lane;
  const float d0 = softplus_f(p.small[t0 * NSMALL + 24 + hd] + bias), d1 = softplus_f(p.small[(t0 + 1) * NSMALL + 24 + hd] + bias);
  float run = (d0 + d1) * a;
#pragma unroll
  for (int o = 1; o < 64; o <<= 1) { const float v = __shfl_up(run, o); if (lane >= o) run += v; }
  const float tot = __shfl(run, 63); const float c1 = run, c0 = run - d1 * a;
  p.dt[t0 * 8 + hd] = d0; p.dt[(t0 + 1) * 8 + hd] = d1; p.acs[t0 * 8 + hd] = c0; p.acs[(t0 + 1) * 8 + hd] = c1;
  p.wst[t0 * 8 + hd] = d0 * expf(tot - c0); p.wst[(t0 + 1) * 8 + hd] = d1 * expf(tot - c1);
}
__device__ __forceinline__ void item_bconv(const Params& p, int layer, long gid) {
  const int cg = (int)(gid & 127) * 8; const long t = gid >> 7; const float* w = p.conv_w + (long)layer * 4 * 1024 + cg; const float* bb = p.conv_b + layer * 1024 + cg;
  float acc[8];
#pragma unroll
  for (int k = 0; k < 8; ++k) acc[k] = bb[k];
#pragma unroll
  for (int i = 0; i < 4; ++i) { const long tt = t - 3 + i; if (tt >= 0) { const uint4 vv = *(const uint4*)(p.proj + tt * NPROJ + PB_X + cg); const unsigned wd[4] = {vv.x, vv.y, vv.z, vv.w};
#pragma unroll
      for (int k = 0; k < 4; ++k) { acc[2 * k] += w[i * 1024 + 2 * k] * __uint_as_float(wd[k] << 16); acc[2 * k + 1] += w[i * 1024 + 2 * k + 1] * __uint_as_float(wd[k] & 0xffff0000u); } } }
  uint4 o; o.x = pk2(silu_f(acc[0]), silu_f(acc[1])); o.y = pk2(silu_f(acc[2]), silu_f(acc[3])); o.z = pk2(silu_f(acc[4]), silu_f(acc[5])); o.w = pk2(silu_f(acc[6]), silu_f(acc[7]));
  *(uint4*)(p.xconv + t * 1024 + cg) = o;
}
__device__ __forceinline__ void unit_cmp(const Params& p, int layer, int u, int lane) {
  const int ncmp = p.S / 16, ntile = ncmp * 2 / 32; const int kv = u / ntile, rt = u % ntile, r32 = lane & 31, hi = lane >> 5;
  const int r = 32 * rt + r32, j = r >> 1, hk = r & 1;
  const unsigned short* w1t = p.w1t + (long)kv * 128 * 2048; const unsigned short* w2t = p.w2t + kv * 64 * 128; const float* pe = p.cmp_pos + (long)(layer * 2 + kv) * 32 * 64;
  const SB* src = p.proj + PA_KV + kv * 128 + hk * 64;
  f32x16 acc[4] = {zero16(), zero16(), zero16(), zero16()};
#pragma unroll 4
  for (int ks = 0; ks < 128; ++ks) { const int t = ks >> 2, d = (ks & 3) * 16 + 8 * hi; const long tok = 16 * j + t;
    const float4 p0 = *(const float4*)(pe + t * 64 + d), p1 = *(const float4*)(pe + t * 64 + d + 4); float v[8] = {p0.x, p0.y, p0.z, p0.w, p1.x, p1.y, p1.z, p1.w};
    { const long tokc = tok < p.S ? tok : (long)p.S - 1; const float vm = tok < p.S ? 1.f : 0.f;
      const uint4 vv = *(const uint4*)(src + tokc * NPROJ + d); const unsigned wd[4] = {vv.x, vv.y, vv.z, vv.w};
#pragma unroll
      for (int k = 0; k < 4; ++k) { v[2 * k] += vm * __uint_as_float(wd[k] << 16); v[2 * k + 1] += vm * __uint_as_float(wd[k] & 0xffff0000u); } }
    u32x4 bw; bw[0] = pk2(v[0], v[1]); bw[1] = pk2(v[2], v[3]); bw[2] = pk2(v[4], v[5]); bw[3] = pk2(v[6], v[7]); const bf16x8 bfr = __builtin_bit_cast(bf16x8, bw);
#pragma unroll
    for (int ut = 0; ut < 4; ++ut) { const bf16x8 af = *(const bf16x8*)(w1t + (long)(32 * ut + r32) * 2048 + 16 * ks + 8 * hi); acc[ut] = MFMA32(af, bfr, acc[ut]); } }
  f32x16 o2[2] = {zero16(), zero16()};
#pragma unroll
  for (int ut = 0; ut < 4; ++ut) {
#pragma unroll
    for (int e = 0; e < 16; ++e) acc[ut][e] = gelu_f(acc[ut][e]);
#pragma unroll
    for (int s2 = 0; s2 < 2; ++s2) { const bf16x8 hb = pack8(acc[ut], 8 * s2);
#pragma unroll
      for (int dt = 0; dt < 2; ++dt) { const unsigned short* wr = w2t + (32 * dt + r32) * 128 + 32 * ut + 16 * s2 + 4 * hi; const uint2 x0 = *(const uint2*)wr, x1 = *(const uint2*)(wr + 8);
        u32x4 aw; aw[0] = x0.x; aw[1] = x0.y; aw[2] = x1.x; aw[3] = x1.y; o2[dt] = MFMA32(__builtin_bit_cast(bf16x8, aw), hb, o2[dt]); } } }
  SB* dst = p.kvc + ((long)kv * ncmp * 2 + r) * 64;
#pragma unroll
  for (int dt = 0; dt < 2; ++dt)
#pragma unroll
    for (int e = 0; e < 16; ++e) dst[32 * dt + crow(e, hi)] = f2bf(o2[dt][e]);
}

template <class RowFn>
__device__ __forceinline__ void topk4_rows(const Params& p, RowFn rowfn, int lane) {
  float v[4][4]; int cur[4], mine[4];
#pragma unroll
  for (int r = 0; r < 4; ++r) { const int row = rowfn(r); const int q = row >> 1; cur[r] = q >> 6; const float* imp = p.imp + (long)row * 256; mine[r] = -1;
#pragma unroll
    for (int k = 0; k < 4; ++k) { const int b = lane + 64 * k; float x = (b <= cur[r]) ? imp[b] : -1.f; if (b == 0 || b == cur[r]) x = 1e4f; v[r][k] = x; } }
  for (int k = 0; k < 16; ++k) {
    float m[4]; int cand[4];
#pragma unroll
    for (int r = 0; r < 4; ++r) m[r] = fmaxf(fmaxf(v[r][0], v[r][1]), fmaxf(v[r][2], v[r][3]));
#pragma unroll
    for (int o = 32; o > 0; o >>= 1) {
#pragma unroll
      for (int r = 0; r < 4; ++r) m[r] = fmaxf(m[r], __shfl_xor(m[r], o)); }
#pragma unroll
    for (int r = 0; r < 4; ++r) { cand[r] = 0x7fffffff;
#pragma unroll
      for (int kk = 3; kk >= 0; --kk) if (v[r][kk] == m[r]) cand[r] = lane + 64 * kk; }
#pragma unroll
    for (int o = 32; o > 0; o >>= 1) {
#pragma unroll
      for (int r = 0; r < 4; ++r) { const int w = __shfl_xor(cand[r], o); cand[r] = w < cand[r] ? w : cand[r]; } }
#pragma unroll
    for (int r = 0; r < 4; ++r) {
#pragma unroll
      for (int kk = 0; kk < 4; ++kk) if (lane + 64 * kk == cand[r]) v[r][kk] = -2.f;
      if (lane == k) mine[r] = (m[r] >= 0.f) ? cand[r] : -1; }
  }
#pragma unroll
  for (int r = 0; r < 4; ++r) if (lane < 16) p.idx[(long)rowfn(r) * 16 + lane] = mine[r];
}
__device__ __forceinline__ void unit_topk4(const Params& p, int u, int lane) { topk4_rows(p, [&](int r) { return u * 4 + r; }, lane); }
struct AselLds { unsigned short k[2][4096]; unsigned short v[2][4096]; unsigned short q[4][2048]; unsigned sel[64][8]; unsigned anyb[8]; int nlist; int pad[7]; unsigned char blist[256]; float xch[4][32]; };
__device__ __forceinline__ void asel_issue(uint4 (&r)[4], const SB* kvb, int b, int tid) {
#pragma unroll
  for (int i = 0; i < 2; ++i) { const int idx = tid + 256 * i, row = idx >> 3, ch = idx & 7; const SB* src = kvb + (long)(b * 64 + row) * NPROJ + ch * 8; r[i] = *(const uint4*)src; r[2 + i] = *(const uint4*)(src + 128); }
}
__device__ __forceinline__ void asel_commit(const uint4 (&r)[4], AselLds* A, int stage, int tid) {
#pragma unroll
  for (int i = 0; i < 2; ++i) { const int idx = tid + 256 * i, row = idx >> 3, ch = idx & 7;
    *(uint4*)&A->k[stage][row * 64 + ((ch ^ (row & 7)) * 8)] = r[i];
    *(uint4*)&A->v[stage][(ch >> 2) * 2048 + row * 32 + (ch & 3) * 8] = r[2 + i]; }
}
__device__ __forceinline__ void asel_coltile(const Params& p, FlashState& S_, const unsigned short* qlds, AselLds* A, float* xch, int stage, int b, int cur, int q0, int qbase, int h, float c31, int lane) {
  const int r32 = lane & 31, hi = lane >> 5; const int ql = qbase + (r32 >> 2); const int q = q0 + ql;
  const bool selq = (A->sel[ql][b >> 5] >> (b & 31)) & 1u;
  if (!__any(selq)) return;
  bf16x8 qf[4];
#pragma unroll
  for (int d0 = 0; d0 < 4; ++d0) qf[d0] = *(const bf16x8*)&qlds[r32 * 64 + d0 * 16 + hi * 8];
  const bool far = (q0 - (b * 64 + 63)) >= 1513; const bool edge = (b == cur);
#ifndef ASEL2
#define ASEL2 1
#endif
#if ASEL2
  bf16x8 kf0[4], kf1[4];
#pragma unroll
  for (int d0 = 0; d0 < 4; ++d0) { const int row0 = r32, row1 = 32 + r32;
    kf0[d0] = *(const bf16x8*)&A->k[stage][row0 * 64 + (((2 * d0 + hi) ^ ((row0 >> 1) & 7)) * 8)];
    kf1[d0] = *(const bf16x8*)&A->k[stage][row1 * 64 + (((2 * d0 + hi) ^ ((row1 >> 1) & 7)) * 8)]; }
  f32x16 s0 = zero16(), s1 = zero16();
#pragma unroll
  for (int d0 = 0; d0 < 4; ++d0) { s0 = MFMA32(kf0[d0], qf[d0], s0); s1 = MFMA32(kf1[d0], qf[d0], s1); }
  if (far) { flash_core2_lin(S_, s0, s1, selq ? QSC : 0.f, selq ? c31 : NINF, A->v[stage], xch, lane); return; }
#pragma unroll
  for (int e = 0; e < 16; ++e) { const int tk = b * 64 + (e & 3) + 8 * (e >> 2) + 4 * hi; const int dist = q - tk; float b0, b1;
    if (far) { b0 = c31; b1 = c31; } else { const int d0c = dist < 0 ? 0 : (dist > 2047 ? 2047 : dist); const int d1 = dist - 32; const int d1c = d1 < 0 ? 0 : (d1 > 2047 ? 2047 : d1);
      b0 = p.tabA[h * TABA_N + d0c] * L2E; b1 = p.tabA[h * TABA_N + d1c] * L2E; }
    float v0 = s0[e] * QSC + b0, v1 = s1[e] * QSC + b1; if (!selq || (edge && dist < 0)) v0 = NINF; if (!selq || (edge && dist < 32)) v1 = NINF; s0[e] = v0; s1[e] = v1; }
  flash_core2(S_, s0, s1, A->v[stage], xch, lane);
}
#else
#pragma unroll 1
  for (int kt = 0; kt < 2; ++kt) { const int t0 = b * 64 + 32 * kt; if (edge && t0 > q0 + qbase + 7) continue;
    bf16x8 kf[4]; { const int row = 32 * kt + r32;
#pragma unroll
      for (int d0 = 0; d0 < 4; ++d0) kf[d0] = *(const bf16x8*)&A->k[stage][row * 64 + (((2 * d0 + hi) ^ ((row >> 1) & 7)) * 8)]; }
    f32x16 s = zero16();
#pragma unroll
    for (int d0 = 0; d0 < 4; ++d0) s = MFMA32(kf[d0], qf[d0], s);
    if (far) { flash_core1_lin(S_, s, selq ? QSC : 0.f, selq ? c31 : NINF, A->v[stage] + kt * 1024, xch, lane); continue; }
#pragma unroll
    for (int e = 0; e < 16; ++e) { const int tk = t0 + (e & 3) + 8 * (e >> 2) + 4 * hi; const int dist = q - tk;
      const int dc = dist < 0 ? 0 : (dist > 2047 ? 2047 : dist); const float bsv = p.tabA[h * TABA_N + dc] * L2E;
      float vv = s[e] * QSC + bsv; if (!selq || (edge && dist < 0)) vv = NINF; s[e] = vv; }
    flash_core1(S_, s, A->v[stage] + kt * 1024, xch, lane);
  }
}
#endif
__device__ __forceinline__ void asel_store(const Params& p, FlashState& S_, float* xch, int q0, int qbase, int g, int lane) {
  const int r32 = lane & 31, hi = lane >> 5;
  const float lt = S_.l + __shfl_xor(S_.l, 32); const float inv = lt > 0.f ? 1.f / lt : 0.f; xch[r32] = inv;
#pragma unroll
  for (int e = 0; e < 16; ++e) { const int j = crow(e, hi); const float a = xch[j]; const int q = q0 + qbase + (j >> 2), he = g * 4 + (j & 3);
    const float* gl = p.small + (long)q * NSMALL + he * 3; const float g0 = sigmoid_f(gl[0]), g1 = sigmoid_f(gl[1]), g2 = sigmoid_f(gl[2]);
#pragma unroll
    for (int db = 0; db < 2; ++db) { const long c = (long)q * 512 + he * 64 + db * 32 + r32; const float os = (db ? S_.o1[e] : S_.o0[e]) * a;
      const float av = g0 * bf2f(p.oc[c]) + g1 * os + g2 * bf2f(p.ow[c]); SB* mp = p.mix + (long)q * NMIX + MX_A + he * 64 + db * 32 + r32; *mp = f2bf(av * bf2f(*mp)); } }
}
__device__ __forceinline__ void unit_asel_blk(const Params& p, int u, AselLds* A) {
  int tid = threadIdx.x; asm volatile("" : "+v"(tid));
  const int lane = tid & 63, w = __builtin_amdgcn_readfirstlane(tid >> 6), r32 = lane & 31, hi = lane >> 5;
  const int g = u & 1, qt = (p.S / 32 - 1) - (u >> 1), q0 = qt * 32, cur = q0 >> 6;
  const SB* kvb = p.proj + PA_KV + 2 * 128 + g * 64;
  __syncthreads();
  for (int i = tid; i < 64 * 8 + 8; i += 256) ((unsigned*)A->sel)[i] = 0u;
#ifndef ASEL_NO_TOPK
  topk4_rows(p, [&](int r) { return (q0 + 8 * w + r) * 2 + g; }, lane); topk4_rows(p, [&](int r) { return (q0 + 8 * w + 4 + r) * 2 + g; }, lane);
  asm volatile("s_waitcnt vmcnt(0)" ::: "memory");
#endif
  __syncthreads();
#pragma unroll
  for (int i = 0; i < 2; ++i) { const int e = tid + 256 * i, ql = e >> 4, kk = e & 15; const int b = __hip_atomic_load(&p.idx[((long)(q0 + ql) * 2 + g) * 16 + kk], __ATOMIC_RELAXED, __HIP_MEMORY_SCOPE_AGENT);
    if (b >= 0) { atomicOr(&A->sel[ql][b >> 5], 1u << (b & 31)); atomicOr(&A->anyb[b >> 5], 1u << (b & 31)); } }
  __syncthreads();
  if (tid < 64) {
    const unsigned wbits = A->anyb[lane >> 3]; const unsigned nib = (wbits >> ((lane & 7) * 4)) & 15u; const int cnt = __popc(nib);
    int pre = cnt;
#pragma unroll
    for (int o = 1; o < 64; o <<= 1) { const int v = __shfl_up(pre, o); if (lane >= o) pre += v; }
    int pos = pre - cnt;
#pragma unroll
    for (int k = 0; k < 4; ++k) if ((nib >> k) & 1u) A->blist[pos++] = (unsigned char)(lane * 4 + k);
    if (lane == 63) A->nlist = pre;
  }
  __syncthreads();
  const int nlist = A->nlist;
  const int hh = r32 & 3, h = g * 4 + hh; const float c31 = p.tabA[h * TABA_N + 2047] * L2E;
  FlashState st0;
  { bf16x8 qf0[4]; load_q(qf0, p.proj + (long)(q0 + 8 * w + (r32 >> 2)) * NPROJ + PA_Q + h * 64, hi);
#pragma unroll
    for (int d0 = 0; d0 < 4; ++d0) *(bf16x8*)&A->q[w][r32 * 64 + d0 * 16 + hi * 8] = qf0[d0]; }
  st0.o0 = zero16(); st0.o1 = zero16(); st0.m = -1e30f; st0.l = 0.f;
  float* xch = A->xch[w];
#define ASEL_DMA(bb, stg) { const int b_ = (bb); _Pragma("unroll") for (int i_ = 0; i_ < 2; ++i_) { const int pk_ = 2 * w + i_; \
      { const int row_ = pk_ * 8 + (lane >> 3), pc_ = lane & 7; __builtin_amdgcn_global_load_lds((gptr_t)(kvb + (long)(b_ * 64 + row_) * NPROJ + ((pc_ ^ ((row_ >> 1) & 7)) * 8)), (lptr_t)&A->k[stg][pk_ * 512], 16, 0, 0); } \
      { const int db_ = pk_ >> 2, row_ = (pk_ & 3) * 16 + (lane >> 2), wi_ = lane & 3; __builtin_amdgcn_global_load_lds((gptr_t)(kvb + 128 + (long)(b_ * 64 + row_) * NPROJ + db_ * 32 + wi_ * 8), (lptr_t)&A->v[stg][db_ * 2048 + (pk_ & 3) * 512], 16, 0, 0); } } }
  if (nlist > 0) ASEL_DMA(A->blist[0], 0);
  for (int it = 0; it < nlist; ++it) {
    const int stage = it & 1; const int b = A->blist[it];
    __syncthreads();
    if (it + 1 < nlist) ASEL_DMA(A->blist[it + 1], stage ^ 1);
    asel_coltile(p, st0, A->q[w], A, xch, stage, b, cur, q0, 8 * w, h, c31, lane);
  }
  asel_store(p, st0, xch, q0, 8 * w, g, lane);
#undef ASEL_DMA
}
__device__ __forceinline__ void unit_bout_blk(const Params& p, int layer, int ub, char* smem) {
  int tid = threadIdx.x; asm volatile("" : "+v"(tid));
  const int lane = tid & 63, w = __builtin_amdgcn_readfirstlane(tid >> 6), r32 = lane & 31, hi = lane >> 5;
  const int lt = ub & 3, g = (ub >> 2) & 1, c = ub >> 3, hd = g * 4 + w;
  WaveLds2* L = ((WaveLds2*)smem) + w;
  __syncthreads();
  for (int x = lane; x < 128; x += 64) { L->acs[x] = p.acs[((long)c * 128 + x) * 8 + hd]; L->dtv[x] = p.dt[((long)c * 128 + x) * 8 + hd]; }
  f32x16 acc[2] = {zero16(), zero16()}, acc2[2] = {zero16(), zero16()};
  const SB* xb = p.xconv + (long)c * 128 * 1024; const int l = 32 * lt + r32; const float al = p.acs[((long)c * 128 + l) * 8 + hd];
  const float* cbr = p.cb + ((long)c * 2 + g) * 16384 + (long)l * 128;
  for (int sc = 0; sc <= lt; ++sc) {
    stage_slab<false>(L->x, xb + (long)(32 * sc) * 1024 + hd * 64, 1024, [&](int) { return 1.f; }, lane);
#pragma unroll
    for (int s2 = 0; s2 < 2; ++s2) { float mv[8];
#pragma unroll
      for (int jj = 0; jj < 2; ++jj) { const int s0 = 32 * sc + 16 * s2 + 8 * jj + 4 * hi; const float4 cv = *(const float4*)(cbr + s0); const float4 av = *(const float4*)(&L->acs[s0]); const float4 dv = *(const float4*)(&L->dtv[s0]);
        mv[4 * jj + 0] = (s0 + 0 <= l) ? cv.x * __expf(al - av.x) * dv.x : 0.f; mv[4 * jj + 1] = (s0 + 1 <= l) ? cv.y * __expf(al - av.y) * dv.y : 0.f;
        mv[4 * jj + 2] = (s0 + 2 <= l) ? cv.z * __expf(al - av.z) * dv.z : 0.f; mv[4 * jj + 3] = (s0 + 3 <= l) ? cv.w * __expf(al - av.w) * dv.w : 0.f; }
      u32x4 aw; aw[0] = pk2(mv[0], mv[1]); aw[1] = pk2(mv[2], mv[3]); aw[2] = pk2(mv[4], mv[5]); aw[3] = pk2(mv[6], mv[7]); const bf16x8 af = __builtin_bit_cast(bf16x8, aw);
#pragma unroll
      for (int pt = 0; pt < 2; ++pt) acc[pt] = MFMA32(af, slab_frag(L->x, pt, s2, lane), acc[pt]); } }
  const SB* cmr = xb + (long)l * 1024 + 768 + g * 128; const float* prv = p.states + ((long)c * 8 + hd) * 8192;
#pragma unroll 2
  for (int ks = 0; ks < 8; ++ks) { const bf16x8 af = *(const bf16x8*)(cmr + 16 * ks + 8 * hi);
#pragma unroll
    for (int pt = 0; pt < 2; ++pt) { const float* pr = prv + (long)(32 * pt + r32) * 128 + 16 * ks + 8 * hi; const float4 a0 = *(const float4*)pr, a1 = *(const float4*)(pr + 4);
      u32x4 bw; bw[0] = pk2(a0.x, a0.y); bw[1] = pk2(a0.z, a0.w); bw[2] = pk2(a1.x, a1.y); bw[3] = pk2(a1.z, a1.w);
      acc2[pt] = MFMA32(af, __builtin_bit_cast(bf16x8, bw), acc2[pt]); } }
  const float dsk = p.b_d[layer * 8 + hd];
  float* yl = (float*)L;
#pragma unroll
  for (int e = 0; e < 16; ++e) { const int lr = crow(e, hi); const float ea = __expf(L->acs[32 * lt + lr]);
#pragma unroll
    for (int pt = 0; pt < 2; ++pt) { const int pp = 32 * pt + r32; yl[lr * 64 + pp] = acc[pt][e] + ea * acc2[pt][e] + dsk * bf2f(xb[(long)(32 * lt + lr) * 1024 + hd * 64 + pp]); } }
  __syncthreads();
  { const int row = tid >> 3, sub = tid & 7; const long t = (long)c * 128 + 32 * lt + row; SB* mp = p.mix + t * NMIX + MX_B + g * 256 + sub * 32;
    const float* ysrc = (const float*)(((WaveLds2*)smem) + (sub >> 1)) + row * 64 + (sub & 1) * 32;
    float vv[32]; float ss = 0.f;
#pragma unroll
    for (int i = 0; i < 4; ++i) { const uint4 zz = *(const uint4*)(mp + 8 * i); const unsigned zw[4] = {zz.x, zz.y, zz.z, zz.w};
#pragma unroll
      for (int k = 0; k < 4; ++k) { const float y0 = ysrc[8 * i + 2 * k] * __uint_as_float(zw[k] << 16), y1 = ysrc[8 * i + 2 * k + 1] * __uint_as_float(zw[k] & 0xffff0000u); vv[8 * i + 2 * k] = y0; vv[8 * i + 2 * k + 1] = y1; ss += y0 * y0 + y1 * y1; } }
    ss += __shfl_xor(ss, 1); ss += __shfl_xor(ss, 2); ss += __shfl_xor(ss, 4);
    const float r = 1.f / sqrtf(ss * (1.f / 256.f) + 1e-6f); const float* wn = p.b_norm + layer * 512 + g * 256 + sub * 32;
#pragma unroll
    for (int i = 0; i < 4; ++i) { uint4 o; o.x = pk2(vv[8 * i] * r * wn[8 * i], vv[8 * i + 1] * r * wn[8 * i + 1]); o.y = pk2(vv[8 * i + 2] * r * wn[8 * i + 2], vv[8 * i + 3] * r * wn[8 * i + 3]);
      o.z = pk2(vv[8 * i + 4] * r * wn[8 * i + 4], vv[8 * i + 5] * r * wn[8 * i + 5]); o.w = pk2(vv[8 * i + 6] * r * wn[8 * i + 6], vv[8 * i + 7] * r * wn[8 * i + 7]); *(uint4*)(mp + 8 * i) = o; } }
}

__device__ __forceinline__ void unit_memkv(const Params& p, int u, int lane) {
  const int l = u >> 8, m = u & 255; const float* row = p.mem + (long)m * DM; const float* nw = p.m_norm + l * DM; const float* w = p.m_wkv + (long)l * DM * 512 + lane * 8;
  float ss = 0.f;
#pragma unroll
  for (int i = 0; i < 4; ++i) { const float4 v = *(const float4*)(row + i * 256 + lane * 4); ss += v.x * v.x + v.y * v.y + v.z * v.z + v.w * v.w; }
  ss = wave_sum_f(ss); const float r = 1.f / sqrtf(ss * (1.f / DM) + 1e-6f);
  float acc[8] = {0.f, 0.f, 0.f, 0.f, 0.f, 0.f, 0.f, 0.f};
#pragma unroll 8
  for (int d = 0; d < DM; ++d) { const float a = row[d] * r * nw[d]; const float4 w0 = *(const float4*)(w + (long)d * 512), w1 = *(const float4*)(w + (long)d * 512 + 4);
    acc[0] += a * w0.x; acc[1] += a * w0.y; acc[2] += a * w0.z; acc[3] += a * w0.w; acc[4] += a * w1.x; acc[5] += a * w1.y; acc[6] += a * w1.z; acc[7] += a * w1.w; }
  uint4 o; o.x = pk2(acc[0], acc[1]); o.y = pk2(acc[2], acc[3]); o.z = pk2(acc[4], acc[5]); o.w = pk2(acc[6], acc[7]);
  *(uint4*)(p.memkv + (long)u * 512 + lane * 8) = o;
}

__device__ __forceinline__ void item_dmerge(const Params& p, long gid) {
  const int c8 = (int)(gid & 63), h = c8 >> 3; const long q = gid >> 6; const long S = p.S;
  const float l0 = p.dlse[(0 * S + q) * 8 + h], l1 = p.dlse[(1 * S + q) * 8 + h], l2 = p.dlse[(2 * S + q) * 8 + h];
  const float mm = fmaxf(l0, fmaxf(l1, l2)); float e0 = __expf(l0 - mm), e1 = __expf(l1 - mm), e2 = __expf(l2 - mm); const float is = 1.f / (e0 + e1 + e2); e0 *= is; e1 *= is; e2 *= is;
  const long c = q * 512 + c8 * 8; const uint4 a = *(const uint4*)(p.dop + c), b = *(const uint4*)(p.dop + S * 512 + c), d = *(const uint4*)(p.dop + 2 * S * 512 + c);
  SB* mp = p.mix + q * NMIX + MX_D + c8 * 8; const uint4 z = *(const uint4*)mp;
  const unsigned aw[4] = {a.x, a.y, a.z, a.w}, bw[4] = {b.x, b.y, b.z, b.w}, dw[4] = {d.x, d.y, d.z, d.w}, zw[4] = {z.x, z.y, z.z, z.w}; unsigned ow[4];
#pragma unroll
  for (int k = 0; k < 4; ++k) {
    const float lo = (e0 * __uint_as_float(aw[k] << 16) + e1 * __uint_as_float(bw[k] << 16) + e2 * __uint_as_float(dw[k] << 16)) * __uint_as_float(zw[k] << 16);
    const float hi = (e0 * __uint_as_float(aw[k] & 0xffff0000u) + e1 * __uint_as_float(bw[k] & 0xffff0000u) + e2 * __uint_as_float(dw[k] & 0xffff0000u)) * __uint_as_float(zw[k] & 0xffff0000u);
    ow[k] = pk2(lo, hi); }
  uint4 o; o.x = ow[0]; o.y = ow[1]; o.z = ow[2]; o.w = ow[3]; *(uint4*)mp = o;
}

#define SEQ 16384
#define DEPTH 4

__device__ __forceinline__ int n2o(int n) {
  if (n < 1280) return n;
  if (n < 2304) return n - 1280 + 1816;
  if (n < 2816) return n - 2304 + 3360;
  if (n < 3072) return n - 2816 + 3872;
  if (n < 4608) return n - 3072 + 4640;
  if (n < 5632) return n - 4608 + 6176;
  if (n < 5888) return n - 5632 + 7712;
  n -= 5888;
  if (n < 512) return 1304 + n;
  if (n < 1024) return 2848 + n - 512;
  if (n < 1536) return 4128 + n - 1024;
  if (n < 2048) return 7200 + n - 1536;
  if (n < 2304) return 7968 + n - 2048;
  n -= 2304;
  if (n < 24) return 1280 + n;
  if (n < 32) return 2840 + n - 24;
  return -1;
}

template <bool MAP>
__device__ __forceinline__ void cvt_tile(const float* __restrict__ src, int lds_, unsigned short* __restrict__ dst, int ldd, int k0, int n0, float* tile  ) {
  int tid = threadIdx.x; asm volatile("" : "+v"(tid));
  __syncthreads();
#pragma unroll
  for (int e = 0; e < 16; ++e) { int idx = tid + 256 * e, kk = idx >> 6, nn = idx & 63; int oc = MAP ? n2o(n0 + nn) : (n0 + nn);
    tile[kk * 65 + nn] = (oc >= 0) ? src[(long)(k0 + kk) * lds_ + oc] : 0.f; }
  __syncthreads();
#pragma unroll
  for (int e = 0; e < 16; ++e) { int idx = tid + 256 * e, nn = idx >> 6, kk = idx & 63; dst[(long)(n0 + nn) * ldd + k0 + kk] = f2bf(tile[kk * 65 + nn]); }
}

__device__ __forceinline__ float wave_sum(float v) {
#pragma unroll
  for (int o = 32; o > 0; o >>= 1) v += __shfl_xor(v, o);
  return v;
}

__device__ __forceinline__ void norm_row_wave(const Params& p, int layer, int t, bool do_h, int lane) {
  const float* xin = (layer == 0) ? p.x + (long)t * DM : p.out + (long)t * DM;
  float4 xv[4], yv[4];
#pragma unroll
  for (int i = 0; i < 4; ++i) xv[i] = *(const float4*)(xin + i * 256 + lane * 4);
  if (layer > 0) {
    float ss = 0.f;
#pragma unroll
    for (int i = 0; i < 4; ++i) { yv[i] = *(const float4*)(p.y + (long)t * DM + i * 256 + lane * 4); ss += yv[i].x * yv[i].x + yv[i].y * yv[i].y + yv[i].z * yv[i].z + yv[i].w * yv[i].w; }
    ss = wave_sum(ss); float r1 = 1.f / sqrtf(ss / DM + 1e-6f);
#pragma unroll
    for (int i = 0; i < 4; ++i) { float4 w = *(const float4*)(p.post_norm + (layer - 1) * DM + i * 256 + lane * 4);
      xv[i].x += yv[i].x * r1 * w.x; xv[i].y += yv[i].y * r1 * w.y; xv[i].z += yv[i].z * r1 * w.z; xv[i].w += yv[i].w * r1 * w.w; }
  }
  float ss2 = 0.f;
#pragma unroll
  for (int i = 0; i < 4; ++i) { *(float4*)(p.out + (long)t * DM + i * 256 + lane * 4) = xv[i]; ss2 += xv[i].x * xv[i].x + xv[i].y * xv[i].y + xv[i].z * xv[i].z + xv[i].w * xv[i].w; }
  if (!do_h) return;
  ss2 = wave_sum(ss2); float r2 = 1.f / sqrtf(ss2 / DM + 1e-6f);
#pragma unroll
  for (int i = 0; i < 4; ++i) { float4 w = *(const float4*)(p.pre_norm + layer * DM + i * 256 + lane * 4);
    ushort4 o; o.x = f2bf(xv[i].x * r2 * w.x); o.y = f2bf(xv[i].y * r2 * w.y); o.z = f2bf(xv[i].z * r2 * w.z); o.w = f2bf(xv[i].w * r2 * w.w);
    *(ushort4*)(p.h + (long)t * DM + i * 256 + lane * 4) = o; }
}

#ifndef GMI
#define GMI 4
#endif
struct GemmSmem { unsigned short a[3][64 * GMI * 32]; unsigned short b[3][128 * 32]; };
__device__ __forceinline__ void glds16(const void* g, void* lds_wave_base) { __builtin_amdgcn_global_load_lds((gptr_t)g, (lptr_t)lds_wave_base, 16, 0, 0); }
template <int EPI, int MI, bool DRY = false>
__device__ __forceinline__ void gemm_tile(const Params& p, const unsigned short* __restrict__ A, int lda, const unsigned short* __restrict__ Bt, int ldb, int K, int m0, int n0, GemmSmem& sm, float* outp = nullptr) {
  int tid = threadIdx.x; asm volatile("" : "+v"(tid));
  const int lane = tid & 63, wid = __builtin_amdgcn_readfirstlane(tid >> 6), wr = wid >> 1, wc = wid & 1, r = lane & 31, h = lane >> 5;
  f32x16 acc[MI][2];
#pragma unroll
  for (int i = 0; i < MI; ++i)
#pragma unroll
    for (int j = 0; j < 2; ++j) acc[i][j] = zero16();
  const int prow = lane >> 2, pc = lane & 3;
  const unsigned short* ga[MI]; const unsigned short* gb[2];
#pragma unroll
  for (int i = 0; i < MI; ++i) { const int row = (wid * MI + i) * 16 + prow; ga[i] = A + (long)(m0 + row) * lda + ((pc ^ ((row >> 2) & 3)) * 8); }
#pragma unroll
  for (int i = 0; i < 2; ++i) { const int row = (wid * 2 + i) * 16 + prow; gb[i] = Bt + (long)(n0 + row) * ldb + ((pc ^ ((row >> 2) & 3)) * 8); }
#define GEMM_DMA(stg, ko) { _Pragma("unroll") for (int i_ = 0; i_ < MI; ++i_) glds16(ga[i_] + (ko), &sm.a[stg][(wid * MI + i_) * 512]); _Pragma("unroll") for (int i_ = 0; i_ < 2; ++i_) glds16(gb[i_] + (ko), &sm.b[stg][(wid * 2 + i_) * 512]); }
  __syncthreads();
  const int nk = K / 32;
  GEMM_DMA(0, 0)
  if (nk > 1) GEMM_DMA(1, 32)
  int cur = 0;
  for (int kt = 0; kt < nk; ++kt) {
    if (kt + 1 < nk) { if (MI == 4) asm volatile("s_waitcnt vmcnt(6) lgkmcnt(0)\n\ts_barrier" ::: "memory"); else asm volatile("s_waitcnt vmcnt(4) lgkmcnt(0)\n\ts_barrier" ::: "memory"); }
    else asm volatile("s_waitcnt vmcnt(0) lgkmcnt(0)\n\ts_barrier" ::: "memory");
    if (kt + 2 < nk) { const int s2_ = (cur == 0) ? 2 : cur - 1; GEMM_DMA(s2_, (kt + 2) * 32) }
#pragma unroll
    for (int ks = 0; ks < 2; ++ks) {
      bf16x8 af[MI], bfr[2];
#pragma unroll
      for (int i = 0; i < MI; ++i) { const int row = wr * (32 * MI) + i * 32 + r; af[i] = *(const bf16x8*)&sm.a[cur][row * 32 + (((2 * ks + h) ^ ((row >> 2) & 3)) * 8)]; }
#pragma unroll
      for (int j = 0; j < 2; ++j) { const int row = wc * 64 + j * 32 + r; bfr[j] = *(const bf16x8*)&sm.b[cur][row * 32 + (((2 * ks + h) ^ ((row >> 2) & 3)) * 8)]; }
#pragma unroll
      for (int i = 0; i < MI; ++i)
#pragma unroll
        for (int j = 0; j < 2; ++j) acc[i][j] = __builtin_amdgcn_mfma_f32_32x32x16_bf16(af[i], bfr[j], acc[i][j], 0, 0, 0);
    }
    cur = (cur == 2) ? 0 : cur + 1;
  }
#undef GEMM_DMA
  __syncthreads();
  if (DRY) {
#pragma unroll
    for (int i = 0; i < MI; ++i) asm volatile("" :: "v"(acc[i][0]), "v"(acc[i][1]));
    return; }
  const int ncol0 = n0 + wc * 64;
  const int mrow0 = m0 + wr * (32 * MI);
  if (EPI == 2) {
#pragma unroll
    for (int i = 0; i < MI; ++i)
#pragma unroll
      for (int j = 0; j < 2; ++j)
#pragma unroll
        for (int e = 0; e < 16; ++e) { int row = mrow0 + i * 32 + (e & 3) + 8 * (e >> 2) + 4 * h; outp[row * 128 + ncol0 + j * 32 + r] = acc[i][j][e]; }
  } else if (EPI == 1) {
#pragma unroll
    for (int i = 0; i < MI; ++i)
#pragma unroll
      for (int j = 0; j < 2; ++j)
#pragma unroll
        for (int e = 0; e < 16; ++e) { int row = mrow0 + i * 32 + (e & 3) + 8 * (e >> 2) + 4 * h; p.y[(long)row * DM + ncol0 + j * 32 + r] = acc[i][j][e]; }
  } else {
    if (ncol0 < 8192) {
      const bool toproj = ncol0 < NPROJ; const bool rope = toproj && (ncol0 >= PC_Q && ncol0 < PC_KV + 128);
      unsigned short* stg = ((unsigned short*)&sm) + wid * (64 * 72);
      SB* gdst = toproj ? (p.proj + ncol0) : (p.mix + (ncol0 - NPROJ)); const long gld = toproj ? NPROJ : NMIX;
#pragma unroll
      for (int hf = 0; hf < MI / 2; ++hf) {
#pragma unroll
        for (int i2 = 0; i2 < 2; ++i2) { const int i = hf * 2 + i2;
#pragma unroll
          for (int e = 0; e < 16; ++e) { const int rl = i2 * 32 + (e & 3) + 8 * (e >> 2) + 4 * h; float v0 = acc[i][0][e], v1 = acc[i][1][e];
            if (rope) { const int row = mrow0 + hf * 64 + rl; const float c = p.rope_cs[row * 32 + r], s = p.rope_sn[row * 32 + r]; const float t1 = v0, t2 = v1; v0 = t1 * c - t2 * s; v1 = t2 * c + t1 * s; }
            if (!toproj) { v0 = silu_f(v0); v1 = silu_f(v1); }
            stg[rl * 72 + r] = f2bf(v0); stg[rl * 72 + 32 + r] = f2bf(v1); } }
#pragma unroll
        for (int c8 = 0; c8 < 8; ++c8) { const int idx = lane + 64 * c8, rl = idx >> 3, ch = idx & 7; const uint4 vv = *(const uint4*)&stg[rl * 72 + ch * 8];
          *(uint4*)(gdst + (long)(mrow0 + hf * 64 + rl) * gld + ch * 8) = vv; }
      }
    } else if (ncol0 == 8192) {
#pragma unroll
      for (int i = 0; i < MI; ++i)
#pragma unroll
        for (int e = 0; e < 16; ++e) { int row = mrow0 + i * 32 + (e & 3) + 8 * (e >> 2) + 4 * h; p.small[(long)row * NSMALL + r] = acc[i][0][e]; }
    }
  }
}

__device__ __forceinline__ unsigned tx_() { unsigned t = threadIdx.x; asm volatile("" : "+v"(t)); return t; }
__device__ __forceinline__ int gw0(int) { return (int)((blockIdx.x * 256u + tx_()) >> 6); }
__device__ __forceinline__ int bid0() { int b = blockIdx.x; asm volatile("" : "+s"(b)); return b; }

#define XB_TMO      128
#define XB_XCNT(j)  (256  + 64 * (j))
#define XB_XSUB(j)  (1280 + 64 * (j))
#define XB_XGEN(j)  (2304 + 64 * (j))
#define XB_TOP      3328
#define XB_TOPGEN   3392
#define XCD_BAR_WORDS 3456
#define XB_SPIN_CAP (1u << 28)
__device__ __forceinline__ unsigned xb_ld(unsigned* p) { return __hip_atomic_load(p, __ATOMIC_RELAXED, __HIP_MEMORY_SCOPE_AGENT); }
__device__ __forceinline__ unsigned xb_add(unsigned* p, unsigned v) { return __hip_atomic_fetch_add(p, v, __ATOMIC_RELAXED, __HIP_MEMORY_SCOPE_AGENT); }
__device__ __forceinline__ unsigned xb_xcc_id() { return (unsigned)__builtin_amdgcn_s_getreg((3 << 11) | 20) & 0xFu; }
#define XB_SPIN(cond, bar) do { unsigned _sp = 0; while (cond) { __builtin_amdgcn_s_sleep(1); \
    if ((++_sp & 255u) == 0u) { if (xb_ld(&(bar)[XB_TMO])) break; if (_sp > XB_SPIN_CAP) { atomicAdd(&(bar)[XB_TMO], 1u); break; } } } } while (0)
struct XcdBarrier { unsigned* bar; unsigned x; volatile LDS3 unsigned* st; };
__device__ __forceinline__ XcdBarrier xcd_barrier_post(unsigned* bar, volatile LDS3 unsigned* st) {
  XcdBarrier b; b.bar = bar; b.x = xb_xcc_id(); b.st = st;
  if (threadIdx.x == 0) (void)xb_add(&bar[XB_XCNT(b.x)], 1u);
  return b;
}
__device__ __forceinline__ void xcd_barrier_complete(unsigned* bar, unsigned x, unsigned& nloc, unsigned& nx) {
  const unsigned G = gridDim.x; unsigned sum, cnt, mine, sp = 0u;
  for (;;) { sum = 0u; cnt = 0u; mine = 0u;
#pragma unroll
    for (unsigned j = 0; j < 16; ++j) { const unsigned c = xb_ld(&bar[XB_XCNT(j)]); sum += c; cnt += (c > 0u) ? 1u : 0u; mine = (j == x) ? c : mine; }
    if (sum == G) break;
    __builtin_amdgcn_s_sleep(1);
    if ((++sp & 255u) == 0u) { if (xb_ld(&bar[XB_TMO])) break; if (sp > XB_SPIN_CAP) { atomicAdd(&bar[XB_TMO], 1u); break; } } }
  nloc = mine > 0u ? mine : 1u; nx = cnt > 0u ? cnt : 1u;
}
__device__ __forceinline__ void xcd_barrier(const XcdBarrier& b) {
  asm volatile("s_waitcnt vmcnt(0)" ::: "memory");
  __syncthreads();
  if (threadIdx.x == 0) {
    unsigned* bar = b.bar;
    __builtin_amdgcn_s_waitcnt(0);
    unsigned nloc = b.st[0], nx = b.st[1];
    if (nloc == 0u) { xcd_barrier_complete(bar, b.x, nloc, nx); b.st[0] = nloc; b.st[1] = nx; }
    const unsigned old = xb_add(&bar[XB_XSUB(b.x)], 1u);
    const unsigned gen = old / nloc;
    if (old + 1u == (gen + 1u) * nloc) {
      __builtin_amdgcn_fence(__ATOMIC_RELEASE, "agent");
      asm volatile("s_waitcnt vmcnt(0)" ::: "memory");
      const unsigned og = xb_add(&bar[XB_TOP], 1u);
      const unsigned tg = og / nx;
      if (og + 1u == (tg + 1u) * nx) xb_add(&bar[XB_TOPGEN], 1u);
      else XB_SPIN(xb_ld(&bar[XB_TOPGEN]) == tg, bar);
      __builtin_amdgcn_fence(__ATOMIC_ACQUIRE, "agent");
      xb_add(&bar[XB_XGEN(b.x)], 1u);
      asm volatile("s_waitcnt vmcnt(0)" ::: "memory");
    } else {
      XB_SPIN(xb_ld(&bar[XB_XGEN(b.x)]) == gen, bar);
      __builtin_amdgcn_fence(__ATOMIC_ACQUIRE, "agent");
      asm volatile("s_waitcnt vmcnt(0)" ::: "memory");
    }
  }
  __syncthreads();
}

struct KArgs { const void* in[20]; float* out; char* ws; };
#ifdef SELFCHK
#define RUN_S 4096
#else
#define RUN_S SEQ
#endif
__host__ __device__ __forceinline__ size_t fill_ws(Params& p, Params& p2, char* w) {
  size_t off = 0;
#define TAKE(bytes) (w + ((off += (((size_t)(bytes)) + 255) & ~(size_t)255) - ((((size_t)(bytes)) + 255) & ~(size_t)255)))
  const size_t S = RUN_S, ncmp = S / 16, nc = S / 128;
  p.S = RUN_S;
  p.wt_in = (unsigned short*)TAKE(8320 * 1024 * 2); p.wt_out = (unsigned short*)TAKE(1024 * 2304 * 2); p.w1t = (unsigned short*)TAKE(2 * 128 * 2048 * 2); p.w2t = (unsigned short*)TAKE(2 * 64 * 128 * 2);
  p.h = (SB*)TAKE(S * 1024 * 2); p.ybuf = (float*)p.h;
  p.proj = (SB*)TAKE(S * NPROJ * 2); p.y = (float*)p.proj;
  p.small = (float*)TAKE(S * 32 * 4); p.mix = (SB*)TAKE(S * NMIX * 2);
  p.rope_cs = (float*)TAKE(S * 32 * 4); p.rope_sn = (float*)TAKE(S * 32 * 4); p.tabA = (float*)TAKE(8 * TABA_N * 4); p.tabD = (float*)TAKE(24 * TABD_N * 4);
  p.memkv = (SB*)TAKE(4 * 256 * 512 * 2); p.hid = (float*)TAKE(2 * ncmp * 256 * 4); p.kvc = (SB*)TAKE(2 * ncmp * 128 * 2);
  p.cml = (float*)TAKE(S * 16 * 4); p.idx = (int*)TAKE(S * 32 * 4); p.oc = (SB*)TAKE(S * 512 * 2); p.ow = (SB*)TAKE(S * 512 * 2);
  p.dop = (SB*)TAKE(3 * S * 512 * 2); p.dlse = (float*)TAKE(3 * S * 8 * 4); p.xconv = (SB*)TAKE(S * 1024 * 2);
  p.dt = (float*)TAKE(S * 8 * 4); p.acs = (float*)TAKE(S * 8 * 4); p.wst = (float*)TAKE(S * 8 * 4); p.cb = (float*)TAKE(nc * 2 * 128 * 128 * 4); p.states = (float*)TAKE(nc * 65536 * 4);
  p.bar = (unsigned*)TAKE(131072);
  p2 = p;
#ifdef SELFCHK
  p.imp = (float*)TAKE(S * 512 * 4);
  p2.mix = (SB*)TAKE(S * NMIX * 2); p2.ow = (SB*)TAKE(S * 512 * 2); p2.oc = (SB*)TAKE(S * 512 * 2); p2.dop = (SB*)TAKE(3 * S * 512 * 2); p2.dlse = (float*)TAKE(3 * S * 8 * 4);
  p2.cml = (float*)TAKE(S * 16 * 4); p2.imp = (float*)TAKE(S * 512 * 4); p2.idx = (int*)TAKE(S * 32 * 4); p2.cb = (float*)TAKE(nc * 2 * 128 * 128 * 4);
  p2.kvc = (SB*)TAKE(2 * ncmp * 128 * 2); p2.xconv = (SB*)TAKE(S * 1024 * 2); p2.dt = (float*)TAKE(S * 8 * 4); p2.acs = (float*)TAKE(S * 8 * 4); p2.wst = (float*)TAKE(S * 8 * 4);
  p2.states = (float*)TAKE(nc * 65536 * 4); p2.ybuf = (float*)TAKE(S * 512 * 4); p.ybuf = (float*)TAKE(S * 512 * 4);
#else
  p.imp = (float*)p.dop; p2 = p;
#endif
  return off;
}
__host__ __device__ __forceinline__ void fill_inputs(Params& p, const KArgs& a) {
  p.x = (const float*)a.in[0]; p.mem = (const float*)a.in[1]; p.pos = (const int*)a.in[2]; p.pre_norm = (const float*)a.in[3]; p.post_norm = (const float*)a.in[4];
  p.w_in = (const float*)a.in[5]; p.w_out = (const float*)a.in[6]; p.rel_bias = (const float*)a.in[7]; p.cmp_pos = (const float*)a.in[8]; p.cmp_w1 = (const float*)a.in[9];
  p.cmp_w2 = (const float*)a.in[10]; p.conv_w = (const float*)a.in[11]; p.conv_b = (const float*)a.in[12]; p.dt_bias = (const float*)a.in[13]; p.a_log = (const float*)a.in[14];
  p.b_d = (const float*)a.in[15]; p.b_norm = (const float*)a.in[16]; p.sinks = (const float*)a.in[17]; p.m_norm = (const float*)a.in[18]; p.m_wkv = (const float*)a.in[19];
  p.out = a.out;
}
#define GS(N, ...) { long g0_ = (long)blockIdx.x * 256 + tx_(); for (long gid = g0_; gid < (long)(N); gid += gsz) { __VA_ARGS__; } }
#define WU(N, ...) { for (int u_ = gw0(gwave); u_ < (int)(N); u_ += nwave) { const int u = __builtin_amdgcn_readfirstlane(u_); const unsigned tq_ = tx_(); int lane = tq_ & 63; \
    WaveLds* WL = ((WaveLds*)smem_raw) + __builtin_amdgcn_readfirstlane((int)(tq_ >> 6)); __VA_ARGS__; } }
#define GSYNC() xcd_barrier(xb)
#ifndef CMP_SKIP
#define CMP_SKIP 10
#endif
#define WUQ(slot, N, ...) { unsigned* cq_ = &p.bar[4096 + (layer * 8 + (slot)) * 64 * 8 + (blockIdx.x & 7) * 64]; for (;;) { unsigned t_ = 0u; if ((threadIdx.x & 63) == 0) t_ = atomicAdd(cq_, 1u); \
    const int u = __builtin_amdgcn_readfirstlane((int)t_) * 8 + (int)(blockIdx.x & 7); if (u >= (int)(N)) break; int lane = threadIdx.x & 63; asm volatile("" : "+v"(lane)); \
    WaveLds* WL = ((WaveLds*)smem_raw) + __builtin_amdgcn_readfirstlane((int)(threadIdx.x >> 6)); WaveLds2* WL2 = (WaveLds2*)WL; (void)WL2; __VA_ARGS__; } }
#define SMEM_BYTES (sizeof(AselLds) > sizeof(GemmSmem) ? ((sizeof(AselLds) + 15) & ~(size_t)15) : sizeof(GemmSmem))
#define gtid ((long)blockIdx.x * 256 + tx_())
#define gwave ((int)((blockIdx.x * 256u + tx_()) >> 6))
#define KERNEL_PROLOGUE \
  Params p, p2; p.pad0 = 0; fill_inputs(p, ka); fill_ws(p, p2, ka.ws); \
  cg::grid_group grid = cg::this_grid(); \
  __shared__ __attribute__((aligned(16))) char smem_raw[SMEM_BYTES + 16]; \
  volatile LDS3 unsigned* xbst = (volatile LDS3 unsigned*)(smem_raw + SMEM_BYTES); \
  if (threadIdx.x < 4) xbst[threadIdx.x] = 0u; \
  __syncthreads(); \
  XcdBarrier xb = xcd_barrier_post(p.bar, xbst); \
  GemmSmem& gsm = *(GemmSmem*)smem_raw; float* ftile = (float*)smem_raw; \
  const long gsz = (long)gridDim.x * 256; const int nwave = (int)(gsz >> 6); \
  const int S = p.S, ncmp = S / 16, nc = S / 128, nqt = S / 32; (void)ncmp; (void)nc; (void)nqt; (void)ftile; (void)gsm; \
  GS((long)S * 32, ph_rope(p, gid)); \
  GS(8 * TABA_N + 24 * TABD_N, ph_tabs(p, gid)); \
  WU(DEPTH * 256, unit_memkv(p, u, lane));
#define PHASE_P1(layer) \
    for (int t = gw0(gwave); t < S; t += nwave) { int lane = tx_() & 63; norm_row_wave(p, layer, t, true, lane); } \
    { const float* wi = p.w_in + (long)(layer) * 1024 * 8224; \
      for (int tl = bid0(); tl < 16 * 130; tl += gridDim.x) cvt_tile<true>(wi, 8224, p.wt_in, 1024, (tl & 15) * 64, (tl >> 4) * 64, ftile); \
      const float* wo = p.w_out + (long)(layer) * 2304 * 1024; \
      for (int tl = bid0(); tl < 36 * 16; tl += gridDim.x) cvt_tile<false>(wo, 1024, p.wt_out, 2304, (tl % 36) * 64, (tl / 36) * 64, ftile); \
      for (int tl = bid0(); tl < 2 * 64; tl += gridDim.x) { const int kv = tl >> 6, t6 = tl & 63; cvt_tile<false>(p.cmp_w1 + (long)((layer) * 2 + kv) * 2048 * 128, 128, p.w1t + (long)kv * 128 * 2048, 2048, (t6 >> 1) * 64, (t6 & 1) * 64, ftile); } \
      for (int tl = bid0(); tl < 2 * 2; tl += gridDim.x) { const int kv = tl >> 1; cvt_tile<false>(p.cmp_w2 + (long)((layer) * 2 + kv) * 128 * 64, 64, p.w2t + (long)kv * 64 * 128, 128, (tl & 1) * 64, 0, ftile); } }
#define PHASE_P2() \
    {   \
      const int x_ = bid0() & 7, li_ = bid0() >> 3, nl_ = (gridDim.x + 7) >> 3, mtiles_ = S / (64 * GMI), mper_ = mtiles_ / 8; \
      if ((mper_ & 7) != 0 || (gridDim.x & 7) != 0) { for (int tl = bid0(); tl < mtiles_ * 65; tl += gridDim.x) { int mt = tl % mtiles_, nt = tl / mtiles_; gemm_tile<0, GMI>(p, p.h, DM, p.wt_in, DM, DM, mt * 64 * GMI, nt * 128, gsm); } } \
      else for (int t_ = li_; t_ < mper_ * 65; t_ += nl_) { const int half_ = t_ / 520, r_ = t_ % 520; int ml_, nt_; \
        if (r_ < 512) { ml_ = r_ & 7; nt_ = (r_ >> 6) * 8 + ((r_ & 63) >> 3); } else { ml_ = r_ - 512; nt_ = 64; } \
        gemm_tile<0, GMI>(p, p.h, DM, p.wt_in, DM, DM, (x_ * mper_ + half_ * 8 + ml_) * 64 * GMI, nt_ * 128, gsm); } }
#define PHASE_FLASH3(layer) \
    { const int nA = nqt * 8, nM = nqt * 4, nD = 3 * nqt * 8, nC = nqt * 8; \
      WU(nA + nM + nD + nC, { if (u < nA) unit_awin(p, u, WL, lane); else if (u < nA + nM) unit_m(p, layer, u - nA, WL, lane); \
                              else if (u < nA + nM + nD) unit_d(p, u - nA - nM, WL, lane); else unit_c(p, layer, u - nA - nM - nD, WL, lane); }); }
#define WU2(N, ...) { for (int u_ = gw0(gwave); u_ < (int)(N); u_ += nwave) { const int u = __builtin_amdgcn_readfirstlane(u_); const unsigned tq_ = tx_(); int lane = tq_ & 63; \
    WaveLds2* WL2 = ((WaveLds2*)smem_raw) + __builtin_amdgcn_readfirstlane((int)(tq_ >> 6)); __VA_ARGS__; } }
#define PHASE_CB() \
    for (int tl = bid0(); tl < nc * 2; tl += gridDim.x) { const SB* xb_ = p.xconv + (long)(tl >> 1) * 128 * 1024 + (tl & 1) * 128; gemm_tile<2, 2>(p, xb_ + 768, 1024, xb_ + 512, 1024, 128, 0, 0, gsm, p.cb + (long)tl * 16384); }

#ifndef SELFCHK
#define PH_BEGIN { char* wsb_ = ka.ws; asm volatile("" : "+s"(wsb_)); Params p, p2_; p.pad0 = 0; fill_inputs(p, ka); fill_ws(p, p2_, wsb_); (void)p2_;
#define PH_END }
__global__ void __launch_bounds__(256, LB2) mega(KArgs ka) {
  KERNEL_PROLOGUE
#ifdef REP_PRO
  GS((long)S * 32, ph_rope(p, gid)); GS(8 * TABA_N + 24 * TABD_N, ph_tabs(p, gid)); WU(DEPTH * 256, unit_memkv(p, u, lane));
#endif
#ifdef TSEL
  unsigned long long tlast = __builtin_amdgcn_s_memrealtime();
#define TMARK(id) { if (gtid == 0) { const unsigned long long tn = __builtin_amdgcn_s_memrealtime(); ((unsigned long long*)p.bar)[id] += tn - tlast; tlast = tn; } }
#else
#define TMARK(id)
#endif
  for (int layer = 0; layer < DEPTH; ++layer) {
    PH_BEGIN
    PHASE_P1(layer)
#ifdef REP_P1
    PHASE_P1(layer)
#endif
    PH_END
    if (layer == 0) grid.sync(); else GSYNC();
    PH_BEGIN
    TMARK(1)
    PHASE_P2()
#ifdef REP_G
    PHASE_P2()
#endif
#ifdef REP_G2
    { const int x_ = bid0() & 7, li_ = bid0() >> 3, nl_ = (gridDim.x + 7) >> 3; for (int t_ = li_; t_ < 520; t_ += nl_) { int ml_, nt_; if (t_ < 512) { ml_ = t_ & 7; nt_ = (t_ >> 6) * 8 + ((t_ & 63) >> 3); } else { ml_ = t_ - 512; nt_ = 64; }
        gemm_tile<0, GMI, true>(p, p.h, DM, p.wt_in, DM, DM, (x_ * 8 + ml_) * 64 * GMI, nt_ * 128, gsm); } }
#endif
    PH_END
    GSYNC();
    PH_BEGIN
    TMARK(2)
    { const int nCmp = 2 * (ncmp * 2 / 32), nA = nqt * 8, nM = nqt * 4, nD = 3 * nqt * 8, nC = nqt * 8, nF = nA + nM + nD + nC;
      const int cw0 = nwave - nCmp; const bool cmpw = (gwave >= cw0) && (cw0 > 0);
#define FLASH_UNIT(uu) {   \
        const int v_ = __builtin_amdgcn_readfirstlane(uu); const int gw_ = v_ % nwave, rr_ = v_ / nwave; const int x_ = (gw_ >> 2) & 7, lw_ = ((gw_ >> 5) << 2) | (gw_ & 3); int j_ = rr_ * (nwave >> 3) + lw_; \
        const unsigned tq_ = tx_(); int lane = tq_ & 63; WaveLds* WL = ((WaveLds*)smem_raw) + __builtin_amdgcn_readfirstlane((int)(tq_ >> 6)); \
        if ((nwave & 31) != 0) { const int u = v_; if (u < nA) unit_awin(p, u, WL, lane); else if (u < nA + nM) unit_m(p, layer, u - nA, WL, lane); else if (u < nA + nM + nD) unit_d(p, u - nA - nM, WL, lane); else unit_c(p, layer, u - nA - nM - nD, WL, lane); } \
        else if (j_ < nA / 8) unit_awin(p, x_ * (nA / 8) + j_, WL, lane); \
        else if ((j_ -= nA / 8) < nM / 8) unit_m(p, layer, x_ * (nM / 8) + j_, WL, lane); \
        else if ((j_ -= nM / 8) < nD / 24) unit_d(p, x_ * (nD / 24) + j_, WL, lane); \
        else if ((j_ -= nD / 24) < nD / 24) unit_d(p, nD / 3 + x_ * (nD / 24) + j_, WL, lane); \
        else if ((j_ -= nD / 24) < nD / 24) unit_d(p, 2 * (nD / 3) + x_ * (nD / 24) + j_, WL, lane); \
        else if ((j_ -= nD / 24) < nC / 8) unit_c(p, layer, x_ * (nC / 8) + j_, WL, lane); }
      if (cw0 <= 0) { WU(nCmp, unit_cmp(p, layer, u, lane)); }
      else if (cmpw) { const int u = __builtin_amdgcn_readfirstlane(gwave - cw0); int lane = tx_() & 63; unit_cmp(p, layer, u, lane); }
      for (int r_ = (cmpw ? CMP_SKIP : 0), u_ = gw0(gwave) + r_ * nwave; u_ < nF; u_ += nwave) FLASH_UNIT(u_)
      if (cw0 > 0 && gwave < CMP_SKIP * nCmp) { const int u_ = (gwave / nCmp) * nwave + cw0 + (gwave % nCmp); if (u_ < nF) FLASH_UNIT(u_) }
#undef FLASH_UNIT
    }
    GS((long)S * 128, item_bconv(p, layer, gid));
    WU(nc * 8, unit_bdt(p, layer, u, lane));
    PH_END
    GSYNC();
    PH_BEGIN
    TMARK(3)
    WU(nqt * 8, unit_acmp1(p, u, WL, lane));
    __syncthreads();
    PHASE_CB()
    __syncthreads();
    WU2(nc * 16, unit_bstates(p, u, WL2, lane));
#ifdef REP_P4
    __syncthreads();
    WU(nqt * 8, unit_acmp1(p, u, WL, lane));
    __syncthreads();
    PHASE_CB()
    __syncthreads();
    WU2(nc * 16, unit_bstates(p, u, WL2, lane));
#endif
    GS((long)S * 64, item_dmerge(p, gid));
    PH_END
    GSYNC();
    PH_BEGIN
    TMARK(4)
    WU(nqt * 8, unit_acmp2(p, u, lane));
#ifdef REP_P5A
    WU(nqt * 8, unit_acmp2(p, u, lane));
#endif
    GS(65536, ph_b_scan(p, gid));
    PH_END
    GSYNC();
    PH_BEGIN
    TMARK(5)
    { const int nu_ = (S / 32) * 2, G_ = gridDim.x; int k_ = 0;
      for (int base_ = 0; base_ < nu_; base_ += G_, ++k_) { const int ub = base_ + ((k_ & 1) ? (G_ - 1 - bid0()) : bid0()); if (ub < nu_) unit_asel_blk(p, ub, (AselLds*)smem_raw); } }
    TMARK(7)
    for (;;) { __syncthreads(); if (threadIdx.x == 0) xbst[2] = atomicAdd(&p.bar[48 + layer * 8 + 5], 1u); __syncthreads(); const int ub = (int)xbst[2]; if (ub >= nc * 8) break; unit_bout_blk(p, layer, ub, smem_raw); }
    PH_END
    GSYNC();
    PH_BEGIN
    TMARK(8)
    for (int tl = bid0(); tl < (S / (64 * GMI)) * 8; tl += gridDim.x) { int mt = tl >> 3, nt = tl & 7; gemm_tile<1, GMI>(p, p.mix, NMIX, p.wt_out, NMIX, NMIX, mt * 64 * GMI, nt * 128, gsm); }
#ifdef REP_P8
    for (int tl = bid0(); tl < (S / (64 * GMI)) * 8; tl += gridDim.x) { int mt = tl >> 3, nt = tl & 7; gemm_tile<1, GMI>(p, p.mix, NMIX, p.wt_out, NMIX, NMIX, mt * 64 * GMI, nt * 128, gsm); }
#endif
    PH_END
    GSYNC();
    PH_BEGIN
    TMARK(9)
    PH_END
  }
  for (int t = gw0(gwave); t < S; t += nwave) { int lane = tx_() & 63; norm_row_wave(p, DEPTH, t, false, lane); }
#ifdef TSEL
  GSYNC();
  { float best = -1.f; int bi = 0; for (int k = 1; k < 10; ++k) if (!((TSEL >> k) & 1)) { const float us = (float)((unsigned long long*)p.bar)[k] * 0.01f; if (us > best) { best = us; bi = k; } }
    const float kk = 10.f * (float)bi + floorf(log2f(best + 1.f));
    GS((long)S * 1024, p.out[gid] = kk); }
#endif
}
#else
__device__ __forceinline__ void chk_update(unsigned* slot, float diff, float ref) {
  atomicMax(&slot[0], __float_as_uint(fabsf(diff))); atomicMax(&slot[1], __float_as_uint(fabsf(ref)));
}
#define CMPB(slot, a, b_) chk_update(sl + (slot), bf2f(a) - bf2f(b_), bf2f(b_))
#define CMPF(slot, a, b_) chk_update(sl + (slot), (a) - (b_), (b_))
__global__ void __launch_bounds__(256, 1) mega(KArgs ka) {
  KERNEL_PROLOGUE
  if (gtid < 64) p.bar[gtid] = 0u;
  unsigned* sl = p.bar;
  const int layer = 0;
  PHASE_P1(layer)
  grid.sync();
  PHASE_P2()
  GSYNC();
  GS((long)S * NMIX, p2.mix[gid] = p.mix[gid]);
  GSYNC();
  PHASE_FLASH3(layer)
  WU(2 * (ncmp * 2 / 32), unit_cmp(p, layer, u, lane));
  GS((long)S * 128, item_bconv(p, layer, gid));
  WU(nc * 8, unit_bdt(p, layer, u, lane));
  GS((long)2 * ncmp * 256, ph_cmp_hid(p2, layer, gid));
  GS((long)S * 8, ph_a_win(p2, gid));
  GS((long)S * 8, ph_c(p2, layer, gid));
  GS((long)3 * S * 8, ph_d(p2, gid));
  GS((long)S * 4, ph_m(p2, layer, gid));
  GS((long)S * 1024, ph_b_conv(p2, layer, gid));
  GS((long)nc * 8, ph_b_dt2(p2, layer, gid));
  GSYNC();
  GS((long)2 * ncmp * 128, ph_cmp_out(p2, layer, gid));
  GSYNC();
  GS((long)2 * ncmp * 128, CMPB(20, p.kvc[gid], p2.kvc[gid]));
  GS((long)S * 1024, CMPB(22, p.xconv[gid], p2.xconv[gid]));
  GS((long)S * 8, { CMPF(24, p.dt[gid], p2.dt[gid]); CMPF(24, p.acs[gid], p2.acs[gid]); CMPF(24, p.wst[gid], p2.wst[gid]); });
  GSYNC();
  GS((long)2 * ncmp * 128, p2.kvc[gid] = p.kvc[gid]);
  GS((long)S * 1024, p2.xconv[gid] = p.xconv[gid]);
  GS((long)S * 8, { p2.dt[gid] = p.dt[gid]; p2.acs[gid] = p.acs[gid]; p2.wst[gid] = p.wst[gid]; });
  GSYNC();
  WU(nqt * 8, unit_acmp1(p, u, WL, lane));
  __syncthreads();
  PHASE_CB()
  __syncthreads();
  WU2(nc * 16, unit_bstates(p, u, WL2, lane));
  GS((long)S * 8, ph_a_cmp1(p2, gid));
  GS((long)nc * 2 * 128 * 128, ph_b_cb(p2, gid));
  GS((long)nc * 65536, ph_b_states(p2, gid));
  GSYNC();
  WU(nqt * 8, unit_acmp2(p, u, lane));
  GS((long)S * 2, ph_a_cmp2(p2, gid));
  GS((long)nc * 65536, CMPF(26, p.states[gid], p2.states[gid]));
  GS((long)nc * 2 * 128 * 128, { int s_ = (int)(gid & 127), l_ = (int)((gid >> 7) & 127); if (s_ <= l_) CMPF(18, p.cb[gid], p2.cb[gid]); });
  GSYNC();
  GS(65536, ph_b_scan(p, gid));
  GS(65536, ph_b_scan(p2, gid));
  GS((long)S * 512, { CMPB(0, p.ow[gid], p2.ow[gid]); CMPB(2, p.oc[gid], p2.oc[gid]); long t = gid >> 9, c = gid & 511; CMPB(4, p.mix[t * NMIX + MX_C + c], p2.mix[t * NMIX + MX_C + c]);
                      if (c < 256) CMPB(6, p.mix[t * NMIX + MX_M + c], p2.mix[t * NMIX + MX_M + c]); });
  GS((long)3 * S * 512, CMPB(8, p.dop[gid], p2.dop[gid]));
  GS((long)3 * S * 8, chk_update(sl + 10, p.dlse[gid] - p2.dlse[gid], 1.f));
  GS((long)S * 2 * 256, { long qg = gid >> 8; int bb = (int)(gid & 255); int q = (int)(qg >> 1); if (bb <= (q >> 6)) CMPF(12, p.imp[gid], p2.imp[gid]); });
  GSYNC();
  GS((long)S * 512, p2.imp[gid] = p.imp[gid]);
  GSYNC();
  WU(S * 2 / 4, unit_topk4(p, u, lane));
  WU2(nc * 32, unit_bout(p, layer, u, WL2, lane));
  GS((long)S * 2, ph_a_topk(p2, gid));
  GS((long)S * 512, ph_b_out(p2, layer, gid));
  GSYNC();
  GS((long)S * 2, { int q = (int)(gid >> 1); int nv = (q >> 6) + 1; nv = nv > 16 ? 16 : nv; int bad = 0;
    for (int k = 0; k < 16; ++k) { int mine = p.idx[gid * 16 + k]; bool found = false; for (int k2 = 0; k2 < 16; ++k2) found |= (p2.idx[gid * 16 + k2] == mine); if (k < nv) bad += !found || mine < 0; else bad += (mine >= 0); }
    chk_update(sl + 14, (float)bad, 1.f); });
  GS((long)S * 512, CMPF(28, p.ybuf[gid], p2.ybuf[gid]));
  GSYNC();
  GS((long)S * 32, p2.idx[gid] = p.idx[gid]);
  GS((long)S * 512, p2.ybuf[gid] = p.ybuf[gid]);
  GSYNC();
  for (int ub = bid0(); ub < (S / 32) * 2; ub += gridDim.x) unit_asel_blk(p, ub, (AselLds*)smem_raw);
  for (;;) { __syncthreads(); if (threadIdx.x == 0) xbst[2] = atomicAdd(&p.bar[40 + layer], 1u); __syncthreads(); const int ub = (int)xbst[2]; if (ub >= nc * 8) break; unit_bout_blk(p, layer, ub, smem_raw); }
  GS((long)S * 8, ph_a_sel(p2, gid));
  GS((long)S * 2, ph_b_norm(p2, layer, gid));
  GSYNC();
  GS((long)S * 512, { long t = gid >> 9, c = gid & 511; CMPB(16, p.mix[t * NMIX + MX_A + c], p2.mix[t * NMIX + MX_A + c]); CMPB(30, p.mix[t * NMIX + MX_B + c], p2.mix[t * NMIX + MX_B + c]); });
  GSYNC();
  { float R = 0.f;
    for (int k = 0; k < 16; ++k) { float d = __uint_as_float(p.bar[2 * k]), r = __uint_as_float(p.bar[2 * k + 1]); float q = d / (r + 1e-20f); if (CHKSEL < 0 || CHKSEL == k) R = fmaxf(R, q); }
    GS((long)SEQ * 1024, p.out[gid] = 1e4f * R); }
}
#endif

__global__ void zz_tail_pad(float* o) { asm volatile(".rept 512\n\ts_nop 0\n\t.endr" ::: "memory"); if (o) o[0] = 0.f; }
__global__ void fill_code(float* o, float v, long n) { long i = blockIdx.x * 256L + threadIdx.x; if (i < n) o[i] = v; }
extern "C" void kernel_launch(void* const* d_in, const int* in_sizes, int n_in, void* d_out, int out_size, void* d_ws, size_t ws_size, hipStream_t stream) {
  KArgs ka; memset(&ka, 0, sizeof(ka));
  for (int i = 0; i < 20; ++i) ka.in[i] = d_in[i];
  ka.out = (float*)d_out; ka.ws = (char*)d_ws;
  Params hp, hp2; memset(&hp, 0, sizeof(hp)); const size_t need = fill_ws(hp, hp2, (char*)d_ws);
  if (need > ws_size) { fprintf(stderr, "workspace too small: need %zu have %zu\n", need, ws_size); return; }
  static int grid_blocks = 0;
  if (!grid_blocks) { int dev = 0, cus = 0, per_cu = 0; (void)hipGetDevice(&dev); (void)hipDeviceGetAttribute(&cus, hipDeviceAttributeMultiprocessorCount, dev);
    (void)hipOccupancyMaxActiveBlocksPerMultiprocessor(&per_cu, mega, 256, 0); if (per_cu > LB2) per_cu = LB2; if (per_cu < 1) per_cu = 1; grid_blocks = cus * per_cu; }
  (void)hipMemsetAsync(hp.bar, 0, 131072, stream);
  void* args[] = {&ka};
  hipError_t e = hipLaunchCooperativeKernel((void*)mega, dim3(grid_blocks), dim3(256), args, 0, stream);
  if (e != hipSuccess) { (void)hipGetLastError(); fill_code<<<(unsigned)(((long)SEQ * 1024 + 255) / 256), 256, 0, stream>>>((float*)d_out, 1000.f * (float)(int)e + (float)grid_blocks, (long)SEQ * 1024); }
}
```

```cpp
#include <hip/hip_runtime.h>
#include <hip/hip_cooperative_groups.h>
#include <cstdio>
#include <cstdint>
#include <cstring>
namespace cg = cooperative_groups;
#define HD_ __device__ __forceinline__
#ifndef CHKSEL
#define CHKSEL -1
#endif
#ifndef LB2
#define LB2 2
#endif
#ifndef HD_
#define HD_ inline
#endif
#ifdef SB_IS_FLOAT
typedef float SB;
HD_ float ldf(const SB* p) { return *p; }
HD_ void stf(SB* p, float v) { *p = v; }
#else
typedef unsigned short SB;
HD_ float bf2f(unsigned short b) { unsigned u = ((unsigned)b) << 16; float f; __builtin_memcpy(&f, &u, 4); return f; }
HD_ unsigned short f2bf(float f) { unsigned u; __builtin_memcpy(&u, &f, 4); u += 0x7fffu + ((u >> 16) & 1u); return (unsigned short)(u >> 16); }
HD_ float ldf(const SB* p) { return bf2f(*p); }
HD_ void stf(SB* p, float v) { *p = f2bf(v); }
#endif

#define DM 1024
#define NPROJ 5888
#define NMIX 2304
#define NSMALL 32
#define PA_Q 0
#define PA_KV 512
#define PB_X 1280
#define PC_Q 2304
#define PC_KV 2816
#define PD_Q 3072
#define PD_KV 4608
#define PM_Q 5632
#define MX_A 0
#define MX_B 512
#define MX_C 1024
#define MX_D 1536
#define MX_M 2048
#define TABA_N 2048
#define TABD_N 132

struct Params {
  int S; int pad0;
  const float *x, *mem; const int* pos;
  const float *pre_norm, *post_norm, *w_in, *w_out, *rel_bias, *cmp_pos, *cmp_w1, *cmp_w2, *conv_w, *conv_b, *dt_bias, *a_log, *b_d,
      *b_norm, *sinks, *m_norm, *m_wkv;
  float* out;
  unsigned short* wt_in;
  unsigned short* wt_out;
  unsigned short *w1t, *w2t;
  SB* h;
  SB* proj;
  float* small;
  SB* mix;
  float* y;
  float *rope_cs, *rope_sn;
  float *tabA, *tabD;
  SB* memkv;
  float* hid;
  SB* kvc;
  float* imp;
  float* cml;
  int* idx;
  SB *oc, *ow;
  SB* dop;
  float* dlse;
  SB* xconv;
  float *dt, *acs;
  float* wst;
  float* cb;
  float* states;
  float* ybuf;
  unsigned* bar;
};

HD_ float silu_f(float x) { return x / (1.f + expf(-x)); }
HD_ float sigmoid_f(float x) { return 1.f / (1.f + expf(-x)); }
HD_ float gelu_f(float x) { return 0.5f * x * (1.f + tanhf(0.7978845608028654f * (x + 0.044715f * x * x * x))); }
HD_ float softplus_f(float x) { return fmaxf(x, 0.f) + log1pf(expf(-fabsf(x))); }

HD_ int t5_bucket(int d) {
  if (d < 16) return d < 0 ? 0 : d;
  const int thr[15] = {22, 30, 40, 54, 73, 99, 134, 182, 246, 332, 450, 609, 825, 1117, 1513};
  int b = 16;
  for (int k = 0; k < 15; ++k) b += (d >= thr[k]) ? 1 : 0;
  return b;
}

HD_ void ph_rope(const Params& p, long gid) {
  int s = (int)(gid >> 5), i = (int)(gid & 31);
  float inv = powf(150000.f, -(float)i / 32.f);
  float ang = (float)p.pos[s] * inv;
  p.rope_cs[gid] = cosf(ang); p.rope_sn[gid] = sinf(ang);
}
HD_ void ph_tabs(const Params& p, long gid) {
  if (gid < 8 * TABA_N) { int h = (int)(gid / TABA_N), d = (int)(gid % TABA_N); p.tabA[gid] = p.rel_bias[t5_bucket(d) * 32 + h]; }
  else { long g2 = gid - 8 * TABA_N; int hh = (int)(g2 / TABD_N), d = (int)(g2 % TABD_N); int gi = hh >> 3;
    int dil = gi == 0 ? 1 : (gi == 1 ? 4 : 16); p.tabD[g2] = p.rel_bias[t5_bucket(d * dil) * 32 + 8 + hh]; }
}
HD_ void ph_memkv(const Params& p, long gid) {
  int e = (int)(gid & 511), m = (int)((gid >> 9) & 255), l = (int)(gid >> 17);
  const float* row = p.mem + (long)m * DM;
  float ss = 0.f; _Pragma("unroll 16") for (int d = 0; d < DM; ++d) ss += row[d] * row[d];
  float r = 1.f / sqrtf(ss / DM + 1e-6f);
  float acc = 0.f;
  _Pragma("unroll 16") for (int d = 0; d < DM; ++d) acc += row[d] * r * p.m_norm[l * DM + d] * p.m_wkv[((long)l * DM + d) * 512 + e];
  stf(&p.memkv[gid], acc);
}
HD_ void ph_norm_row(const Params& p, int layer, int t, bool do_h) {
  const float* xin = (layer == 0) ? p.x + (long)t * DM : p.out + (long)t * DM;
  float* xo = p.out + (long)t * DM;
  float r1 = 0.f;
  if (layer > 0) { const float* y = p.y + (long)t * DM; float ss = 0.f; for (int d = 0; d < DM; ++d) ss += y[d] * y[d]; r1 = 1.f / sqrtf(ss / DM + 1e-6f); }
  float ss2 = 0.f;
  for (int d = 0; d < DM; ++d) { float v = xin[d]; if (layer > 0) v += p.y[(long)t * DM + d] * r1 * p.post_norm[(layer - 1) * DM + d]; xo[d] = v; ss2 += v * v; }
  if (!do_h) return;
  float r2 = 1.f / sqrtf(ss2 / DM + 1e-6f);
  for (int d = 0; d < DM; ++d) stf(&p.h[(long)t * DM + d], xo[d] * r2 * p.pre_norm[layer * DM + d]);
}

HD_ void ph_cmp_hid(const Params& p, int layer, long gid) {
  int u = (int)(gid & 127), hk = (int)((gid >> 7) & 1); long r = gid >> 8; int ncmp = p.S / 16; int j = (int)(r % ncmp), kv = (int)(r / ncmp);
  const float* w1 = p.cmp_w1 + ((long)(layer * 2 + kv) * 2048) * 128;
  const float* pe = p.cmp_pos + (long)(layer * 2 + kv) * 32 * 64;
  float acc = 0.f;
  for (int t = 0; t < 32; ++t) { int tok = 16 * j + t;
    _Pragma("unroll 16") for (int d = 0; d < 64; ++d) { float v = pe[t * 64 + d]; if (tok < p.S) v += ldf(&p.proj[(long)tok * NPROJ + PA_KV + kv * 128 + hk * 64 + d]);
      acc += v * w1[(long)(t * 64 + d) * 128 + u]; } }
  p.hid[gid] = gelu_f(acc);
}
HD_ void ph_cmp_out(const Params& p, int layer, long gid) {
  int d = (int)(gid & 63), hk = (int)((gid >> 6) & 1); long r = gid >> 7; int ncmp = p.S / 16; int j = (int)(r % ncmp), kv = (int)(r / ncmp);
  const float* w2 = p.cmp_w2 + (long)(layer * 2 + kv) * 128 * 64;
  const float* hd = p.hid + (((long)kv * ncmp + j) * 2 + hk) * 128;
  float acc = 0.f; for (int u = 0; u < 128; ++u) acc += hd[u] * w2[u * 64 + d];
  stf(&p.kvc[gid], acc);
}
HD_ void ph_a_cmp1(const Params& p, long gid) {
  int h = (int)(gid & 7), q = (int)(gid >> 3), g = h >> 2; int ncmp = p.S / 16;
  int jn = (q >= 31) ? ((q - 31) / 16 + 1) : 0;
  const SB* kc = p.kvc; const SB* vc = p.kvc + (long)ncmp * 128;
  float qv[64], o[64]; for (int d = 0; d < 64; ++d) { qv[d] = ldf(&p.proj[(long)q * NPROJ + PA_Q + h * 64 + d]); o[d] = 0.f; }
  float m = -1e30f, l = 0.f;
  for (int j = 0; j < jn; ++j) { const SB* kr = &kc[((long)j * 2 + g) * 64]; const SB* vr = &vc[((long)j * 2 + g) * 64];
    float s = 0.f; for (int d = 0; d < 64; ++d) s += qv[d] * ldf(&kr[d]);
    int dist = q - (16 * j + 31); s = s * 0.125f + p.tabA[h * TABA_N + (dist < TABA_N ? dist : TABA_N - 1)];
    float mn = fmaxf(m, s), a = expf(m - mn), pr = expf(s - mn); l = l * a + pr; for (int d = 0; d < 64; ++d) o[d] = o[d] * a + pr * ldf(&vr[d]); m = mn; }
  float il = jn > 0 ? 1.f / l : 0.f; for (int d = 0; d < 64; ++d) stf(&p.oc[(long)q * 512 + h * 64 + d], o[d] * il);
  p.cml[gid * 2] = m; p.cml[gid * 2 + 1] = il;
}
HD_ void ph_a_cmp2(const Params& p, long gid) {
  int g = (int)(gid & 1), q = (int)(gid >> 1); int ncmp = p.S / 16;
  float* imp = p.imp + gid * 256; for (int b = 0; b < 256; ++b) imp[b] = 0.f;
  int jn = (q >= 31) ? ((q - 31) / 16 + 1) : 0; const SB* kc = p.kvc;
  for (int hh = 0; hh < 4; ++hh) { int h = g * 4 + hh; float qv[64]; for (int d = 0; d < 64; ++d) qv[d] = ldf(&p.proj[(long)q * NPROJ + PA_Q + h * 64 + d]);
    float m = p.cml[((long)q * 8 + h) * 2], il = p.cml[((long)q * 8 + h) * 2 + 1];
    for (int j = 0; j < jn; ++j) { const SB* kr = &kc[((long)j * 2 + g) * 64]; float s = 0.f; for (int d = 0; d < 64; ++d) s += qv[d] * ldf(&kr[d]);
      int dist = q - (16 * j + 31); s = s * 0.125f + p.tabA[h * TABA_N + (dist < TABA_N ? dist : TABA_N - 1)]; float pr = expf(s - m) * il;
      imp[j >> 2] += pr; if (j + 1 < ncmp) imp[(j + 1) >> 2] += pr; } }
}
HD_ void ph_a_topk(const Params& p, long gid) {
  int q = (int)(gid >> 1); float* imp = p.imp + gid * 256; int* idx = p.idx + gid * 16; int cur = q >> 6;
  imp[0] = 1e4f; imp[cur] = 1e4f;
  for (int k = 0; k < 16; ++k) { int best = -1; float bv = -1.f;
    for (int b = 0; b <= cur; ++b) { float v = imp[b]; if (v > bv) { bv = v; best = b; } }
    idx[k] = best; if (best >= 0) imp[best] = -2.f; }
}
HD_ void ph_a_win(const Params& p, long gid) {
  int h = (int)(gid & 7), q = (int)(gid >> 3), hk = h >> 2;
  float qv[64], o[64]; for (int d = 0; d < 64; ++d) { qv[d] = ldf(&p.proj[(long)q * NPROJ + PA_Q + h * 64 + d]); o[d] = 0.f; }
  float m = -1e30f, l = 0.f; int lo = q - 511 < 0 ? 0 : q - 511;
  for (int t = lo; t <= q; ++t) { const SB* kr = &p.proj[(long)t * NPROJ + PA_KV + 4 * 128 + hk * 64]; const SB* vr = kr + 128;
    float s = 0.f; for (int d = 0; d < 64; ++d) s += qv[d] * ldf(&kr[d]); s = s * 0.125f + p.tabA[h * TABA_N + (q - t)];
    float mn = fmaxf(m, s), a = expf(m - mn), pr = expf(s - mn); l = l * a + pr; for (int d = 0; d < 64; ++d) o[d] = o[d] * a + pr * ldf(&vr[d]); m = mn; }
  float il = 1.f / l; for (int d = 0; d < 64; ++d) stf(&p.ow[(long)q * 512 + h * 64 + d], o[d] * il);
}
HD_ void ph_a_sel(const Params& p, long gid) {
  int h = (int)(gid & 7), q = (int)(gid >> 3), hk = h >> 2; const int* idx = p.idx + ((long)q * 2 + hk) * 16;
  float qv[64], o[64]; for (int d = 0; d < 64; ++d) { qv[d] = ldf(&p.proj[(long)q * NPROJ + PA_Q + h * 64 + d]); o[d] = 0.f; }
  float m = -1e30f, l = 0.f;
  for (int k = 0; k < 16; ++k) { int b = idx[k]; if (b < 0) continue;
    for (int i = 0; i < 64; ++i) { int t = b * 64 + i; if (t > q) break;
      const SB* kr = &p.proj[(long)t * NPROJ + PA_KV + 2 * 128 + hk * 64]; const SB* vr = kr + 128;
      float s = 0.f; for (int d = 0; d < 64; ++d) s += qv[d] * ldf(&kr[d]); int dist = q - t; s = s * 0.125f + p.tabA[h * TABA_N + (dist < TABA_N ? dist : TABA_N - 1)];
      float mn = fmaxf(m, s), a = expf(m - mn), pr = expf(s - mn); l = l * a + pr; for (int d = 0; d < 64; ++d) o[d] = o[d] * a + pr * ldf(&vr[d]); m = mn; } }
  float il = 1.f / l; const float* gl = p.small + (long)q * NSMALL + h * 3;
  float g0 = sigmoid_f(gl[0]), g1 = sigmoid_f(gl[1]), g2 = sigmoid_f(gl[2]);
  for (int d = 0; d < 64; ++d) { long c = (long)q * 512 + h * 64 + d; float a = g0 * ldf(&p.oc[c]) + g1 * o[d] * il + g2 * ldf(&p.ow[c]);
    SB* mp = &p.mix[(long)q * NMIX + MX_A + h * 64 + d]; stf(mp, a * ldf(mp)); }
}
HD_ void ph_c(const Params& p, int layer, long gid) {
  int h = (int)(gid & 7), q = (int)(gid >> 3), hk = h >> 2;
  float qv[64], o[64]; for (int d = 0; d < 64; ++d) { qv[d] = ldf(&p.proj[(long)q * NPROJ + PC_Q + h * 64 + d]); o[d] = 0.f; }
  float m = p.sinks[layer * 8 + h], l = 1.f; int lo = q - 127 < 0 ? 0 : q - 127;
  for (int t = lo; t <= q; ++t) { const SB* kr = &p.proj[(long)t * NPROJ + PC_KV + hk * 64]; const SB* vr = kr + 128;
    float s = 0.f; for (int d = 0; d < 64; ++d) s += qv[d] * ldf(&kr[d]); s *= 0.125f;
    float mn = fmaxf(m, s), a = expf(m - mn), pr = expf(s - mn); l = l * a + pr; for (int d = 0; d < 64; ++d) o[d] = o[d] * a + pr * ldf(&vr[d]); m = mn; }
  float il = 1.f / l; for (int d = 0; d < 64; ++d) { SB* mp = &p.mix[(long)q * NMIX + MX_C + h * 64 + d]; stf(mp, o[d] * il * ldf(mp)); }
}
HD_ void ph_d(const Params& p, long gid) {
  int h = (int)(gid & 7); long r = gid >> 3; int q = (int)(r % p.S), gi = (int)(r / p.S); int dil = gi == 0 ? 1 : (gi == 1 ? 4 : 16);
  float qv[64], o[64]; for (int d = 0; d < 64; ++d) { qv[d] = ldf(&p.proj[(long)q * NPROJ + PD_Q + gi * 512 + h * 64 + d]); o[d] = 0.f; }
  float m = -1e30f, l = 0.f;
  for (int dd = 0; dd <= 128; ++dd) { int t = q - dil * dd; if (t < 0) break;
    const SB* kr = &p.proj[(long)t * NPROJ + PD_KV + h * 64]; const SB* vr = kr + 512;
    float s = 0.f; for (int d = 0; d < 64; ++d) s += qv[d] * ldf(&kr[d]); s = s * 0.125f + p.tabD[(gi * 8 + h) * TABD_N + dd];
    float mn = fmaxf(m, s), a = expf(m - mn), pr = expf(s - mn); l = l * a + pr; for (int d = 0; d < 64; ++d) o[d] = o[d] * a + pr * ldf(&vr[d]); m = mn; }
  float il = 1.f / l; for (int d = 0; d < 64; ++d) stf(&p.dop[((long)gi * p.S + q) * 512 + h * 64 + d], o[d] * il);
  p.dlse[((long)gi * p.S + q) * 8 + h] = m + logf(l);
}
HD_ void ph_d_merge(const Params& p, long gid) {
  int h = (int)(gid & 7), q = (int)(gid >> 3);
  float l0 = p.dlse[((long)0 * p.S + q) * 8 + h], l1 = p.dlse[((long)1 * p.S + q) * 8 + h], l2 = p.dlse[((long)2 * p.S + q) * 8 + h];
  float mm = fmaxf(l0, fmaxf(l1, l2)); float e0 = expf(l0 - mm), e1 = expf(l1 - mm), e2 = expf(l2 - mm), is = 1.f / (e0 + e1 + e2);
  for (int d = 0; d < 64; ++d) { long c = (long)q * 512 + h * 64 + d;
    float v = (e0 * ldf(&p.dop[c]) + e1 * ldf(&p.dop[(long)p.S * 512 + c]) + e2 * ldf(&p.dop[(long)2 * p.S * 512 + c])) * is;
    SB* mp = &p.mix[(long)q * NMIX + MX_D + h * 64 + d]; stf(mp, v * ldf(mp)); }
}
HD_ void ph_m(const Params& p, int layer, long gid) {
  int h = (int)(gid & 3), q = (int)(gid >> 2);
  float qv[64], o[64]; for (int d = 0; d < 64; ++d) { qv[d] = ldf(&p.proj[(long)q * NPROJ + PM_Q + h * 64 + d]); o[d] = 0.f; }
  float m = -1e30f, l = 0.f; const SB* kvb = p.memkv + (long)layer * 256 * 512;
  for (int t = 0; t < 256; ++t) { const SB* kr = kvb + (long)t * 512 + h * 64; const SB* vr = kr + 256;
    float s = 0.f; for (int d = 0; d < 64; ++d) s += qv[d] * ldf(&kr[d]); s *= 0.125f;
    float mn = fmaxf(m, s), a = expf(m - mn), pr = expf(s - mn); l = l * a + pr; for (int d = 0; d < 64; ++d) o[d] = o[d] * a + pr * ldf(&vr[d]); m = mn; }
  float il = 1.f / l; for (int d = 0; d < 64; ++d) { SB* mp = &p.mix[(long)q * NMIX + MX_M + h * 64 + d]; stf(mp, o[d] * il * ldf(mp)); }
}
HD_ void ph_b_conv(const Params& p, int layer, long gid) {
  int c = (int)(gid & 1023), t = (int)(gid >> 10); const float* w = p.conv_w + (long)layer * 4 * 1024;
  float acc = p.conv_b[layer * 1024 + c];
  for (int i = 0; i < 4; ++i) { int tt = t - 3 + i; if (tt >= 0) acc += w[i * 1024 + c] * ldf(&p.proj[(long)tt * NPROJ + PB_X + c]); }
  stf(&p.xconv[gid], silu_f(acc));
}
HD_ void ph_b_dt(const Params& p, int layer, long gid) {
  int hd = (int)(gid & 7), c = (int)(gid >> 3); float a = -expf(p.a_log[layer * 8 + hd]); float cs = 0.f;
  for (int l = 0; l < 128; ++l) { int t = c * 128 + l; float dt = softplus_f(p.small[(long)t * NSMALL + 24 + hd] + p.dt_bias[layer * 8 + hd]);
    cs += dt * a; p.dt[(long)t * 8 + hd] = dt; p.acs[(long)t * 8 + hd] = cs; }
}
HD_ void ph_b_cb(const Params& p, long gid) {
  int s = (int)(gid & 127), l = (int)((gid >> 7) & 127), g = (int)((gid >> 14) & 1), c = (int)(gid >> 15);
  if (s > l) { p.cb[gid] = 0.f; return; }
  const SB* cm = &p.xconv[(long)(c * 128 + l) * 1024 + 768 + g * 128]; const SB* bm = &p.xconv[(long)(c * 128 + s) * 1024 + 512 + g * 128];
  float acc = 0.f; for (int n = 0; n < 128; ++n) acc += ldf(&cm[n]) * ldf(&bm[n]);
  p.cb[gid] = acc;
}
HD_ void ph_b_states(const Params& p, long gid) {
  int n = (int)(gid & 127), pp = (int)((gid >> 7) & 63), hd = (int)((gid >> 13) & 7), c = (int)(gid >> 16), g = hd >> 2;
  float last = p.acs[(long)(c * 128 + 127) * 8 + hd]; float acc = 0.f;
  for (int l = 0; l < 128; ++l) { long t = c * 128 + l;
    acc += ldf(&p.xconv[t * 1024 + 512 + g * 128 + n]) * expf(last - p.acs[t * 8 + hd]) * ldf(&p.xconv[t * 1024 + hd * 64 + pp]) * p.dt[t * 8 + hd]; }
  p.states[gid] = acc;
}
HD_ void ph_b_scan(const Params& p, long gid) {
  int hd = (int)(gid >> 13); int nc = p.S / 128; float h = 0.f;
  for (int c0 = 0; c0 < nc; c0 += 8) { float st[8], dc[8];
    for (int i = 0; i < 8; ++i) { st[i] = p.states[(long)(c0 + i) * 65536 + gid]; dc[i] = p.acs[(long)((c0 + i) * 128 + 127) * 8 + hd]; }
    for (int i = 0; i < 8; ++i) { p.states[(long)(c0 + i) * 65536 + gid] = h; h = h * expf(dc[i]) + st[i]; } }
}
HD_ void ph_b_out(const Params& p, int layer, long gid) {
  int pp = (int)(gid & 63), hd = (int)((gid >> 6) & 7), t = (int)(gid >> 9), g = hd >> 2, c = t >> 7, l = t & 127;
  float al = p.acs[(long)t * 8 + hd]; float acc = 0.f;
  const float* cbr = &p.cb[(((long)c * 2 + g) * 128 + l) * 128];
  for (int s = 0; s <= l; ++s) { long ts = c * 128 + s; acc += cbr[s] * expf(al - p.acs[ts * 8 + hd]) * ldf(&p.xconv[ts * 1024 + hd * 64 + pp]) * p.dt[ts * 8 + hd]; }
  float acc2 = 0.f; const float* pr = &p.states[(long)c * 65536 + ((long)hd * 64 + pp) * 128]; const SB* cm = &p.xconv[(long)t * 1024 + 768 + g * 128];
  for (int n = 0; n < 128; ++n) acc2 += ldf(&cm[n]) * pr[n];
  p.ybuf[gid] = acc + expf(al) * acc2 + ldf(&p.xconv[(long)t * 1024 + hd * 64 + pp]) * p.b_d[layer * 8 + hd];
}
HD_ void ph_b_norm(const Params& p, int layer, long gid) {
  int g = (int)(gid & 1), t = (int)(gid >> 1); float ss = 0.f;
  for (int i = 0; i < 256; ++i) { float v = p.ybuf[(long)t * 512 + g * 256 + i] * ldf(&p.mix[(long)t * NMIX + MX_B + g * 256 + i]); ss += v * v; }
  float r = 1.f / sqrtf(ss / 256.f + 1e-6f);
  for (int i = 0; i < 256; ++i) { SB* mp = &p.mix[(long)t * NMIX + MX_B + g * 256 + i]; float v = p.ybuf[(long)t * 512 + g * 256 + i] * ldf(mp);
    stf(mp, v * r * p.b_norm[layer * 512 + g * 256 + i]); }
}

HD_ void ph_b_dt2(const Params& p, int layer, long gid) {
  int hd = (int)(gid & 7), c = (int)(gid >> 3); float a = -expf(p.a_log[layer * 8 + hd]); float cs = 0.f;
  for (int l = 0; l < 128; ++l) { int t = c * 128 + l; float dt = softplus_f(p.small[(long)t * NSMALL + 24 + hd] + p.dt_bias[layer * 8 + hd]);
    cs += dt * a; p.dt[(long)t * 8 + hd] = dt; p.acs[(long)t * 8 + hd] = cs; }
  for (int l = 0; l < 128; ++l) { long t = c * 128 + l; p.wst[t * 8 + hd] = p.dt[t * 8 + hd] * expf(cs - p.acs[t * 8 + hd]); }
}
HD_ void ph_b_states2(const Params& p, long gid) {
  int pp = (int)(gid & 63), n = (int)((gid >> 6) & 127), hd = (int)((gid >> 13) & 7), c = (int)(gid >> 16), g = hd >> 2;
  float acc = 0.f;
  _Pragma("unroll 16") for (int l = 0; l < 128; ++l) { long t = c * 128 + l; acc += ldf(&p.xconv[t * 1024 + 512 + g * 128 + n]) * p.wst[t * 8 + hd] * ldf(&p.xconv[t * 1024 + hd * 64 + pp]); }
  p.states[gid] = acc;
}
HD_ void ph_b_out2(const Params& p, int layer, long gid) {
  int pp = (int)(gid & 63), hd = (int)((gid >> 6) & 7), t = (int)(gid >> 9), g = hd >> 2, c = t >> 7, l = t & 127;
  float al = p.acs[(long)t * 8 + hd]; float acc = 0.f;
  const float* cbr = &p.cb[(((long)c * 2 + g) * 128 + l) * 128];
  _Pragma("unroll 8") for (int s = 0; s <= l; ++s) { long ts = c * 128 + s; acc += cbr[s] * expf(al - p.acs[ts * 8 + hd]) * p.dt[ts * 8 + hd] * ldf(&p.xconv[ts * 1024 + hd * 64 + pp]); }
  float acc2 = 0.f; const float* pr = &p.states[(long)c * 65536 + (long)hd * 8192 + pp]; const SB* cm = &p.xconv[(long)t * 1024 + 768 + g * 128];
  _Pragma("unroll 16") for (int n = 0; n < 128; ++n) acc2 += ldf(&cm[n]) * pr[n * 64];
  p.ybuf[gid] = acc + expf(al) * acc2 + ldf(&p.xconv[(long)t * 1024 + hd * 64 + pp]) * p.b_d[layer * 8 + hd];
}

typedef __attribute__((ext_vector_type(8))) short bf16x8;
typedef __attribute__((ext_vector_type(16))) float f32x16;
typedef short v4i16_t __attribute__((ext_vector_type(4)));
typedef __bf16 bf2_t __attribute__((ext_vector_type(2)));
typedef float f2_t __attribute__((ext_vector_type(2)));
typedef unsigned u32x4 __attribute__((ext_vector_type(4)));
#define LDS3 __attribute__((address_space(3)))
typedef __attribute__((address_space(1))) const void* gptr_t;
typedef __attribute__((address_space(3))) void* lptr_t;
#define L2E 1.4426950408889634f
#define LN2 0.6931471805599453f
#define QSC (0.125f * L2E)
#ifndef FTHR
#define FTHR 8.0f
#endif
#define NINF (-__builtin_huge_valf())

struct WaveLds { unsigned short v[4096]; float tab[640]; float xch[32]; float pad[32]; };

__device__ __forceinline__ unsigned pk2(float a, float b) { f2_t v = {a, b}; bf2_t r = __builtin_convertvector(v, bf2_t); return __builtin_bit_cast(unsigned, r); }
__device__ __forceinline__ int crow(int e, int hi) { return (e & 3) + 8 * (e >> 2) + 4 * hi; }
__device__ __forceinline__ bf16x8 pack8(const f32x16& s, int o) {
  u32x4 r; r[0] = pk2(s[o], s[o + 1]); r[1] = pk2(s[o + 2], s[o + 3]); r[2] = pk2(s[o + 4], s[o + 5]); r[3] = pk2(s[o + 6], s[o + 7]); return __builtin_bit_cast(bf16x8, r); }
__device__ __forceinline__ f32x16 zero16() { f32x16 z;
#pragma unroll
  for (int e = 0; e < 16; ++e) z[e] = 0.f; return z; }
#define MFMA32(a, b, c) __builtin_amdgcn_mfma_f32_32x32x16_bf16((a), (b), (c), 0, 0, 0)

struct FlashState { f32x16 o0, o1; float m, l; };
__device__ __forceinline__ float wave_sum_f(float v) {
#pragma unroll
  for (int o = 32; o > 0; o >>= 1) v += __shfl_xor(v, o);
  return v; }

__device__ __forceinline__ void flash_core1(FlashState& st, f32x16& s, const unsigned short* vimg, float* xch, int lane) {
  const int r32 = lane & 31, hi = lane >> 5;
  float mx = s[0];
#pragma unroll
  for (int e = 1; e < 16; ++e) mx = fmaxf(mx, s[e]);
  mx = fmaxf(mx, __shfl_xor(mx, 32));
  if (__any(mx > st.m + FTHR)) {
    const float mn = fmaxf(st.m, mx); const float al = __builtin_amdgcn_exp2f(st.m - mn); st.m = mn; st.l *= al; xch[r32] = al;
#pragma unroll
    for (int e = 0; e < 16; ++e) { const float a = xch[crow(e, hi)]; st.o0[e] *= a; st.o1[e] *= a; }
  }
  float ps = 0.f;
#pragma unroll
  for (int e = 0; e < 16; ++e) { s[e] = __builtin_amdgcn_exp2f(s[e] - st.m); ps += s[e]; }
  st.l += ps;
  const bf16x8 pa0 = pack8(s, 0), pa1 = pack8(s, 8);
  const unsigned short* vb = vimg + (4 * hi + ((lane & 15) >> 2)) * 32 + ((lane >> 4) & 1) * 16 + (lane & 3) * 4;
#pragma unroll
  for (int s2 = 0; s2 < 2; ++s2) {
#pragma unroll
    for (int db = 0; db < 2; ++db) {
      const v4i16_t lo = __builtin_amdgcn_ds_read_tr16_b64_v4i16((LDS3 v4i16_t*)(vb + db * 2048 + s2 * 512));
      const v4i16_t hh = __builtin_amdgcn_ds_read_tr16_b64_v4i16((LDS3 v4i16_t*)(vb + db * 2048 + s2 * 512 + 256));
      const bf16x8 vf = {lo[0], lo[1], lo[2], lo[3], hh[0], hh[1], hh[2], hh[3]};
      if (db == 0) st.o0 = MFMA32(s2 ? pa1 : pa0, vf, st.o0); else st.o1 = MFMA32(s2 ? pa1 : pa0, vf, st.o1);
    }
  }
}
__device__ __forceinline__ void flash_core1_lin(FlashState& st, f32x16& s, float qs, float bb, const unsigned short* vimg, float* xch, int lane) {
  const int r32 = lane & 31, hi = lane >> 5;
  float mr = s[0];
#pragma unroll
  for (int e = 1; e < 16; ++e) mr = fmaxf(mr, s[e]);
  float mx = __builtin_fmaf(mr, qs, bb);
  mx = fmaxf(mx, __shfl_xor(mx, 32));
  if (__any(mx > st.m + FTHR)) {
    const float mn = fmaxf(st.m, mx); const float al = __builtin_amdgcn_exp2f(st.m - mn); st.m = mn; st.l *= al; xch[r32] = al;
#pragma unroll
    for (int e = 0; e < 16; ++e) { const float a = xch[crow(e, hi)]; st.o0[e] *= a; st.o1[e] *= a; }
  }
  const float bm = bb - st.m; float ps = 0.f;
#pragma unroll
  for (int e = 0; e < 16; ++e) { s[e] = __builtin_amdgcn_exp2f(__builtin_fmaf(s[e], qs, bm)); ps += s[e]; }
  st.l += ps;
  const bf16x8 pa0 = pack8(s, 0), pa1 = pack8(s, 8);
  const unsigned short* vb = vimg + (4 * hi + ((lane & 15) >> 2)) * 32 + ((lane >> 4) & 1) * 16 + (lane & 3) * 4;
#pragma unroll
  for (int s2 = 0; s2 < 2; ++s2) {
#pragma unroll
    for (int db = 0; db < 2; ++db) {
      const v4i16_t lo = __builtin_amdgcn_ds_read_tr16_b64_v4i16((LDS3 v4i16_t*)(vb + db * 2048 + s2 * 512));
      const v4i16_t hh = __builtin_amdgcn_ds_read_tr16_b64_v4i16((LDS3 v4i16_t*)(vb + db * 2048 + s2 * 512 + 256));
      const bf16x8 vf = {lo[0], lo[1], lo[2], lo[3], hh[0], hh[1], hh[2], hh[3]};
      if (db == 0) st.o0 = MFMA32(s2 ? pa1 : pa0, vf, st.o0); else st.o1 = MFMA32(s2 ? pa1 : pa0, vf, st.o1);
    }
  }
}
template <class VRow, class Fix>
__device__ __forceinline__ void flash_tile(FlashState& st, const bf16x8 (&qf)[4], const SB* kp, VRow vrow, Fix fix, WaveLds* L, int lane) {
  const int r32 = lane & 31, hi = lane >> 5;
  bf16x8 kf[4];
#pragma unroll
  for (int d0 = 0; d0 < 4; ++d0) kf[d0] = *(const bf16x8*)(kp + d0 * 16 + hi * 8);
#pragma unroll
  for (int i = 0; i < 4; ++i) { const int c = lane + 64 * i, key = c >> 3, ch = c & 7; const SB* vp = vrow(key); const uint4 vv = *(const uint4*)(vp + ch * 8);
    *(uint4*)&L->v[(ch >> 2) * 2048 + key * 32 + (ch & 3) * 8] = vv; }
  f32x16 s = zero16();
#pragma unroll
  for (int d0 = 0; d0 < 4; ++d0) s = MFMA32(kf[d0], qf[d0], s);
  fix(s);
  flash_core1(st, s, L->v, L->xch, lane);
}
__device__ __forceinline__ void flash_core2(FlashState& st, f32x16& s0, f32x16& s1, const unsigned short* vimg, float* xch, int lane) {
  const int r32 = lane & 31, hi = lane >> 5;
  float mx = fmaxf(s0[0], s1[0]);
#pragma unroll
  for (int e = 1; e < 16; ++e) mx = fmaxf(mx, fmaxf(s0[e], s1[e]));
  mx = fmaxf(mx, __shfl_xor(mx, 32));
  if (__any(mx > st.m + FTHR)) {
    const float mn = fmaxf(st.m, mx); const float al = __builtin_amdgcn_exp2f(st.m - mn); st.m = mn; st.l *= al; xch[r32] = al;
#pragma unroll
    for (int e = 0; e < 16; ++e) { const float a = xch[crow(e, hi)]; st.o0[e] *= a; st.o1[e] *= a; }
  }
  float ps = 0.f;
#pragma unroll
  for (int e = 0; e < 16; ++e) { s0[e] = __builtin_amdgcn_exp2f(s0[e] - st.m); s1[e] = __builtin_amdgcn_exp2f(s1[e] - st.m); ps += s0[e] + s1[e]; }
  st.l += ps;
  bf16x8 pa[4]; pa[0] = pack8(s0, 0); pa[1] = pack8(s0, 8); pa[2] = pack8(s1, 0); pa[3] = pack8(s1, 8);
  const unsigned short* vb = vimg + (4 * hi + ((lane & 15) >> 2)) * 32 + ((lane >> 4) & 1) * 16 + (lane & 3) * 4;
#pragma unroll
  for (int kk = 0; kk < 4; ++kk) {
#pragma unroll
    for (int db = 0; db < 2; ++db) {
      const v4i16_t lo = __builtin_amdgcn_ds_read_tr16_b64_v4i16((LDS3 v4i16_t*)(vb + db * 2048 + kk * 512));
      const v4i16_t hh = __builtin_amdgcn_ds_read_tr16_b64_v4i16((LDS3 v4i16_t*)(vb + db * 2048 + kk * 512 + 256));
      const bf16x8 vf = {lo[0], lo[1], lo[2], lo[3], hh[0], hh[1], hh[2], hh[3]};
      if (db == 0) st.o0 = MFMA32(pa[kk], vf, st.o0); else st.o1 = MFMA32(pa[kk], vf, st.o1);
    }
  }
}
__device__ __forceinline__ void flash_core2_lin(FlashState& st, f32x16& s0, f32x16& s1, float qs, float bb, const unsigned short* vimg, float* xch, int lane) {
  const int r32 = lane & 31, hi = lane >> 5;
  float mr = fmaxf(s0[0], s1[0]);
#pragma unroll
  for (int e = 1; e < 16; ++e) mr = fmaxf(mr, fmaxf(s0[e], s1[e]));
  float mx = __builtin_fmaf(mr, qs, bb);
  mx = fmaxf(mx, __shfl_xor(mx, 32));
  if (__any(mx > st.m + FTHR)) {
    const float mn = fmaxf(st.m, mx); const float al = __builtin_amdgcn_exp2f(st.m - mn); st.m = mn; st.l *= al; xch[r32] = al;
#pragma unroll
    for (int e = 0; e < 16; ++e) { const float a = xch[crow(e, hi)]; st.o0[e] *= a; st.o1[e] *= a; }
  }
  const float bm = bb - st.m; float ps = 0.f;
#pragma unroll
  for (int e = 0; e < 16; ++e) { s0[e] = __builtin_amdgcn_exp2f(__builtin_fmaf(s0[e], qs, bm)); s1[e] = __builtin_amdgcn_exp2f(__builtin_fmaf(s1[e], qs, bm)); ps += s0[e] + s1[e]; }
  st.l += ps;
  bf16x8 pa[4]; pa[0] = pack8(s0, 0); pa[1] = pack8(s0, 8); pa[2] = pack8(s1, 0); pa[3] = pack8(s1, 8);
  const unsigned short* vb = vimg + (4 * hi + ((lane & 15) >> 2)) * 32 + ((lane >> 4) & 1) * 16 + (lane & 3) * 4;
#pragma unroll
  for (int kk = 0; kk < 4; ++kk) {
#pragma unroll
    for (int db = 0; db < 2; ++db) {
      const v4i16_t lo = __builtin_amdgcn_ds_read_tr16_b64_v4i16((LDS3 v4i16_t*)(vb + db * 2048 + kk * 512));
      const v4i16_t hh = __builtin_amdgcn_ds_read_tr16_b64_v4i16((LDS3 v4i16_t*)(vb + db * 2048 + kk * 512 + 256));
      const bf16x8 vf = {lo[0], lo[1], lo[2], lo[3], hh[0], hh[1], hh[2], hh[3]};
      if (db == 0) st.o0 = MFMA32(pa[kk], vf, st.o0); else st.o1 = MFMA32(pa[kk], vf, st.o1);
    }
  }
}
#ifndef FT2
#define FT2 1
#endif
template <class VRow, class Fix0, class Fix1>
__device__ __forceinline__ void flash_tile2(FlashState& st, const bf16x8 (&qf)[4], const SB* kp0, const SB* kp1, VRow vrow, Fix0 fix0, Fix1 fix1, WaveLds* L, int lane) {
  if (!FT2) { flash_tile(st, qf, kp0, [&](int key) { return vrow(key); }, fix0, L, lane); flash_tile(st, qf, kp1, [&](int key) { return vrow(key + 32); }, fix1, L, lane); return; }
  const int hi = lane >> 5;
  bf16x8 kf0[4], kf1[4];
#pragma unroll
  for (int d0 = 0; d0 < 4; ++d0) { kf0[d0] = *(const bf16x8*)(kp0 + d0 * 16 + hi * 8); kf1[d0] = *(const bf16x8*)(kp1 + d0 * 16 + hi * 8); }
#pragma unroll
  for (int i = 0; i < 8; ++i) { const int c = lane + 64 * i, key = c >> 3, ch = c & 7; const SB* vp = vrow(key); const uint4 vv = *(const uint4*)(vp + ch * 8);
    *(uint4*)&L->v[(ch >> 2) * 2048 + key * 32 + (ch & 3) * 8] = vv; }
  f32x16 s0 = zero16(), s1 = zero16();
#pragma unroll
  for (int d0 = 0; d0 < 4; ++d0) { s0 = MFMA32(kf0[d0], qf[d0], s0); s1 = MFMA32(kf1[d0], qf[d0], s1); }
  fix0(s0); fix1(s1);
  flash_core2(st, s0, s1, L->v, L->xch, lane);
}
template <class KPtr, class VRow, class Fix>
__device__ __forceinline__ void flash_run(FlashState& st, const bf16x8 (&qf)[4], int t0, int t1, KPtr kptr, VRow vrow, Fix fix, WaveLds* L, int lane) {
  if (t0 >= t1) return;
  const int hi = lane >> 5; bf16x8 kfn[4];
#define FR_ISSUE(tt) { const int t_ = (tt); _Pragma("unroll") for (int i_ = 0; i_ < 4; ++i_) { const int db_ = i_ >> 1, key_ = (i_ & 1) * 16 + (lane >> 2), wi_ = lane & 3; \
      __builtin_amdgcn_global_load_lds((gptr_t)(vrow(t_, key_) + db_ * 32 + wi_ * 8), (lptr_t)&L->v[db_ * 2048 + (t_ & 1) * 1024 + (i_ & 1) * 512], 16, 0, 0); } \
    const SB* kp_ = kptr(t_); _Pragma("unroll") for (int d0_ = 0; d0_ < 4; ++d0_) kfn[d0_] = *(const bf16x8*)(kp_ + d0_ * 16 + hi * 8); }
  FR_ISSUE(t0)
  for (int t = t0; t < t1; ++t) {
    asm volatile("s_waitcnt vmcnt(0)" ::: "memory");
    bf16x8 kf[4];
#pragma unroll
    for (int d0 = 0; d0 < 4; ++d0) kf[d0] = kfn[d0];
    if (t + 1 < t1) FR_ISSUE(t + 1)
    f32x16 s = zero16();
#pragma unroll
    for (int d0 = 0; d0 < 4; ++d0) s = MFMA32(kf[d0], qf[d0], s);
    fix(t, s);
    flash_core1(st, s, L->v + (t & 1) * 1024, L->xch, lane);
  }
#undef FR_ISSUE
}
__device__ __forceinline__ float flash_finish(FlashState& st, WaveLds* L, int lane) {
  const int r32 = lane & 31, hi = lane >> 5;
  const float lt = st.l + __shfl_xor(st.l, 32); const float inv = lt > 0.f ? 1.f / lt : 0.f;
  L->xch[r32] = inv;
#pragma unroll
  for (int e = 0; e < 16; ++e) { const float a = L->xch[crow(e, hi)]; st.o0[e] *= a; st.o1[e] *= a; }
  return (st.m + __builtin_amdgcn_logf(lt)) * LN2;
}
__device__ __forceinline__ void load_q(bf16x8 (&qf)[4], const SB* qp, int hi) {
#pragma unroll
  for (int d0 = 0; d0 < 4; ++d0) qf[d0] = *(const bf16x8*)(qp + d0 * 16 + hi * 8);
}
__device__ __forceinline__ void fix_tab(f32x16& s, const WaveLds* L, int base, int lane, bool chk, int kb) {
  const int r32 = lane & 31, hi = lane >> 5; const float* tp = L->tab + base + r32 + 32 - 4 * hi;
#pragma unroll
  for (int e = 0; e < 16; ++e) { const int kk = (e & 3) + 8 * (e >> 2); float v = s[e] * QSC + tp[-kk]; if (chk && (kb + kk + 4 * hi < 0)) v = NINF; s[e] = v; }
}

__device__ __forceinline__ void unit_c(const Params& p, int layer, int u, WaveLds* L, int lane) {
  const int h = u & 7, qt = u >> 3, q0 = qt * 32, hk = h >> 2, r32 = lane & 31, hi = lane >> 5;
  for (int x = lane; x < 192; x += 64) { const int dist = x - 32; L->tab[x] = (dist >= 0 && dist <= 127) ? 0.f : NINF; }
  bf16x8 qf[4]; load_q(qf, p.proj + (long)(q0 + r32) * NPROJ + PC_Q + h * 64, hi);
  FlashState st; st.o0 = zero16(); st.o1 = zero16(); st.m = p.sinks[layer * 8 + h] * L2E; st.l = hi ? 0.f : 1.f;
  const SB* kvb = p.proj + PC_KV + hk * 64; const bool chk = q0 < 128;
  flash_run(st, qf, 0, 5, [&](int t) { int tok = q0 - 128 + 32 * t + r32; tok = tok < 0 ? 0 : tok; return kvb + (long)tok * NPROJ; },
            [&](int t, int key) { int tk = q0 - 128 + 32 * t + key; tk = tk < 0 ? 0 : tk; return kvb + 128 + (long)tk * NPROJ; },
            [&](int t, f32x16& s) { fix_tab(s, L, 128 - 32 * t, lane, chk, q0 - 128 + 32 * t); }, L, lane);
  flash_finish(st, L, lane);
#pragma unroll
  for (int e = 0; e < 16; ++e) { SB* mp = p.mix + (long)(q0 + crow(e, hi)) * NMIX + MX_C + h * 64 + r32; mp[0] = f2bf(st.o0[e] * bf2f(mp[0])); mp[32] = f2bf(st.o1[e] * bf2f(mp[32])); }
}
__device__ __forceinline__ void unit_m(const Params& p, int layer, int u, WaveLds* L, int lane) {
  const int h = u & 3, qt = u >> 2, q0 = qt * 32, r32 = lane & 31, hi = lane >> 5;
  bf16x8 qf[4]; load_q(qf, p.proj + (long)(q0 + r32) * NPROJ + PM_Q + h * 64, hi);
  FlashState st; st.o0 = zero16(); st.o1 = zero16(); st.m = -1e30f; st.l = 0.f;
  const SB* kb = p.memkv + (long)layer * 256 * 512 + h * 64;
  flash_run(st, qf, 0, 8, [&](int t) { return kb + (long)(32 * t + r32) * 512; }, [&](int t, int key) { return kb + 256 + (long)(32 * t + key) * 512; },
            [&](int, f32x16& s) {
#pragma unroll
              for (int e = 0; e < 16; ++e) s[e] *= QSC; }, L, lane);
  flash_finish(st, L, lane);
#pragma unroll
  for (int e = 0; e < 16; ++e) { SB* mp = p.mix + (long)(q0 + crow(e, hi)) * NMIX + MX_M + h * 64 + r32; mp[0] = f2bf(st.o0[e] * bf2f(mp[0])); mp[32] = f2bf(st.o1[e] * bf2f(mp[32])); }
}
__device__ __forceinline__ void unit_awin(const Params& p, int u, WaveLds* L, int lane) {
  const int h = u & 7, qt = u >> 3, q0 = qt * 32, hk = h >> 2, r32 = lane & 31, hi = lane >> 5;
  for (int x = lane; x < 608; x += 64) { const int dist = x - 32; L->tab[x] = (dist >= 0 && dist <= 511) ? p.tabA[h * TABA_N + dist] * L2E : NINF; }
  bf16x8 qf[4]; load_q(qf, p.proj + (long)(q0 + r32) * NPROJ + PA_Q + h * 64, hi);
  FlashState st; st.o0 = zero16(); st.o1 = zero16(); st.m = -1e30f; st.l = 0.f;
  const SB* kvb = p.proj + PA_KV + 4 * 128 + hk * 64; const bool chk = q0 < 512;
  { int tfirst = 0; if (q0 < 512) tfirst = (512 - q0) / 32 - 0; if (tfirst > 16) tfirst = 16; if (q0 < 512 && (q0 - 512 + 32 * tfirst + 31) < 0) ++tfirst;
    flash_run(st, qf, tfirst, 17, [&](int t) { int tok = q0 - 512 + 32 * t + r32; tok = tok < 0 ? 0 : tok; return kvb + (long)tok * NPROJ; },
              [&](int t, int key) { int tk = q0 - 512 + 32 * t + key; tk = tk < 0 ? 0 : tk; return kvb + 128 + (long)tk * NPROJ; },
              [&](int t, f32x16& s) { fix_tab(s, L, 512 - 32 * t, lane, chk, q0 - 512 + 32 * t); }, L, lane); }
  flash_finish(st, L, lane);
#pragma unroll
  for (int e = 0; e < 16; ++e) { SB* op = p.ow + (long)(q0 + crow(e, hi)) * 512 + h * 64 + r32; op[0] = f2bf(st.o0[e]); op[32] = f2bf(st.o1[e]); }
}
__device__ __forceinline__ void unit_d(const Params& p, int u, WaveLds* L, int lane) {
  const int S = p.S, per = (S / 32) * 8; const int gi = u / per, u2 = u % per; const int h = u2 & 7, v = u2 >> 3;
  const int dil = gi == 0 ? 1 : (gi == 1 ? 4 : 16); const int it = v / dil, r = v % dil, i0 = it * 32;
  const int r32 = lane & 31, hi = lane >> 5;
  for (int x = lane; x < 192; x += 64) { const int dd = x - 32; L->tab[x] = (dd >= 0 && dd <= 128) ? p.tabD[(gi * 8 + h) * TABD_N + dd] * L2E : NINF; }
  bf16x8 qf[4]; load_q(qf, p.proj + (long)(r + dil * (i0 + r32)) * NPROJ + PD_Q + gi * 512 + h * 64, hi);
  FlashState st; st.o0 = zero16(); st.o1 = zero16(); st.m = -1e30f; st.l = 0.f;
  const SB* kvb = p.proj + PD_KV + h * 64; const bool chk = i0 < 128;
  flash_run(st, qf, 0, 5, [&](int t) { int j = i0 - 128 + 32 * t + r32; j = j < 0 ? 0 : j; return kvb + (long)(r + dil * j) * NPROJ; },
            [&](int t, int key) { int jj = i0 - 128 + 32 * t + key; jj = jj < 0 ? 0 : jj; return kvb + 512 + (long)(r + dil * jj) * NPROJ; },
            [&](int t, f32x16& s) { fix_tab(s, L, 128 - 32 * t, lane, chk, i0 - 128 + 32 * t); }, L, lane);
  const float lse = flash_finish(st, L, lane);
#pragma unroll
  for (int e = 0; e < 16; ++e) { const long tok = r + dil * (i0 + crow(e, hi)); SB* op = p.dop + ((long)gi * S + tok) * 512 + h * 64 + r32; op[0] = f2bf(st.o0[e]); op[32] = f2bf(st.o1[e]); }
  if (hi == 0) p.dlse[((long)gi * S + r + dil * (i0 + r32)) * 8 + h] = lse;
}
__device__ __forceinline__ void fix_cmp(f32x16& s, const Params& p, int h, int q0, int t, int lane) {
  const int r32 = lane & 31, hi = lane >> 5; const int dq = q0 + r32 - 31 - 16 * (32 * t + 4 * hi);
  const bool far = (q0 - 16 * (32 * t + 31) - 31) >= 1513; const float c31 = p.tabA[h * TABA_N + 2047] * L2E;
#pragma unroll
  for (int e = 0; e < 16; ++e) { const int kk = (e & 3) + 8 * (e >> 2); const int dist = dq - 16 * kk; float b;
    if (far) b = c31; else { const int dc = dist < 0 ? 0 : (dist > 2047 ? 2047 : dist); b = p.tabA[h * TABA_N + dc] * L2E; }
    s[e] = dist < 0 ? NINF : s[e] * QSC + b; }
}
__device__ __forceinline__ void unit_acmp1(const Params& p, int u, WaveLds* L, int lane) {
  const int h = u & 7, qt = (p.S / 32 - 1) - (u >> 3), q0 = qt * 32, g = h >> 2, r32 = lane & 31, hi = lane >> 5; const int ncmp = p.S / 16;
  bf16x8 qf[4]; load_q(qf, p.proj + (long)(q0 + r32) * NPROJ + PA_Q + h * 64, hi);
  FlashState st; st.o0 = zero16(); st.o1 = zero16(); st.m = -1e30f; st.l = 0.f;
  const int jn = q0 / 16 + 1, nt = (jn + 31) / 32; const SB* kc = p.kvc + g * 64; const SB* vc = p.kvc + (long)ncmp * 128 + g * 64;
  flash_run(st, qf, 0, nt, [&](int t) { int j = 32 * t + r32; j = j >= ncmp ? ncmp - 1 : j; return kc + (long)j * 128; },
            [&](int t, int key) { int jj = 32 * t + key; jj = jj >= ncmp ? ncmp - 1 : jj; return vc + (long)jj * 128; },
            [&](int t, f32x16& s) { fix_cmp(s, p, h, q0, t, lane); }, L, lane);
  const float lt = st.l + __shfl_xor(st.l, 32); const float inv = lt > 0.f ? 1.f / lt : 0.f;
  flash_finish(st, L, lane);
#pragma unroll
  for (int e = 0; e < 16; ++e) { SB* op = p.oc + (long)(q0 + crow(e, hi)) * 512 + h * 64 + r32; op[0] = f2bf(st.o0[e]); op[32] = f2bf(st.o1[e]); }
  if (hi == 0) { p.cml[((long)(q0 + r32) * 8 + h) * 2] = st.m; p.cml[((long)(q0 + r32) * 8 + h) * 2 + 1] = inv; }
}
__device__ __forceinline__ void unit_acmp2(const Params& p, int u, int lane) {
  const int part = u & 3, g = (u >> 2) & 1, qt = (p.S / 32 - 1) - (u >> 3), q0 = qt * 32, r32 = lane & 31, hi = lane >> 5; const int ncmp = p.S / 16;
  const int jn = q0 / 16 + 1, nt = (jn + 31) / 32; const SB* kc = p.kvc + g * 64; float carry = 0.f;
  const int tper = (nt + 3) >> 2, tbeg = part * tper, tend = (tbeg + tper < nt) ? tbeg + tper : nt; if (tbeg >= nt) return;
  float* impq = p.imp + ((long)(q0 + r32) * 2 + g) * 256;
  const SB* qbase = p.proj + (long)(q0 + r32) * NPROJ + PA_Q + g * 256; const float* cmlq = p.cml + ((long)(q0 + r32) * 8 + g * 4) * 2;
  bf16x8 kfn[4]; { const int t = (tbeg > 0 ? tbeg - 1 : 0); int j = 32 * t + r32; j = j >= ncmp ? ncmp - 1 : j; const SB* kp = kc + (long)j * 128;
#pragma unroll
    for (int d0 = 0; d0 < 4; ++d0) kfn[d0] = *(const bf16x8*)(kp + d0 * 16 + hi * 8); }
  for (int t = (tbeg > 0 ? tbeg - 1 : 0); t < tend; ++t) {
    bf16x8 kf[4];
#pragma unroll
    for (int d0 = 0; d0 < 4; ++d0) kf[d0] = kfn[d0];
    if (t + 1 < tend) { int j = 32 * (t + 1) + r32; j = j >= ncmp ? ncmp - 1 : j; const SB* kp = kc + (long)j * 128;
#pragma unroll
      for (int d0 = 0; d0 < 4; ++d0) kfn[d0] = *(const bf16x8*)(kp + d0 * 16 + hi * 8); }
    float accA[4] = {0.f, 0.f, 0.f, 0.f}, accL[4] = {0.f, 0.f, 0.f, 0.f};
#pragma unroll 1
    for (int hh = 0; hh < 4; ++hh) { bf16x8 qf[4]; load_q(qf, qbase + hh * 64, hi); const float m = cmlq[hh * 2], il = cmlq[hh * 2 + 1];
      f32x16 s = zero16();
#pragma unroll
      for (int d0 = 0; d0 < 4; ++d0) s = MFMA32(kf[d0], qf[d0], s);
      fix_cmp(s, p, g * 4 + hh, q0, t, lane);
#pragma unroll
      for (int e = 0; e < 16; ++e) { const float pr = __builtin_amdgcn_exp2f(s[e] - m) * il; accA[e >> 2] += pr; if ((e & 3) == 3) accL[e >> 2] += pr; } }
    float oth[4];
#pragma unroll
    for (int eg = 0; eg < 4; ++eg) oth[eg] = __shfl_xor(accL[eg], 32);
#pragma unroll
    for (int eg = 0; eg < 4; ++eg) { const float prev = hi ? oth[eg] : (eg > 0 ? oth[eg > 0 ? eg - 1 : 0] : carry); if (t >= tbeg) impq[8 * t + 2 * eg + hi] = 2.f * accA[eg] - accL[eg] + prev; }
    carry = oth[3]; }
}
__device__ __forceinline__ float wave_max_f(float v) {
#pragma unroll
  for (int o = 32; o > 0; o >>= 1) v = fmaxf(v, __shfl_xor(v, o));
  return v; }
__device__ __forceinline__ int wave_min_i(int v) {
#pragma unroll
  for (int o = 32; o > 0; o >>= 1) { const int w = __shfl_xor(v, o); v = w < v ? w : v; }
  return v; }
__device__ __forceinline__ void unit_topk(const Params& p, int u, int lane) {
  const int q = u >> 1, cur = q >> 6; const float* imp = p.imp + (long)u * 256; int* idx = p.idx + (long)u * 16;
  float v[4];
#pragma unroll
  for (int k = 0; k < 4; ++k) { const int b = lane + 64 * k; float x = (b <= cur) ? imp[b] : -1.f; if (b == 0 || b == cur) x = 1e4f; v[k] = x; }
  int mine = -1;
  for (int k = 0; k < 16; ++k) {
    float lm = fmaxf(fmaxf(v[0], v[1]), fmaxf(v[2], v[3])); const float m = wave_max_f(lm);
    int cand = 0x7fffffff;
#pragma unroll
    for (int kk = 3; kk >= 0; --kk) if (v[kk] == m) cand = lane + 64 * kk;
    const int bsel = wave_min_i(cand);
#pragma unroll
    for (int kk = 0; kk < 4; ++kk) if (lane + 64 * kk == bsel) v[kk] = -2.f;
    if (lane == k) mine = (m >= 0.f) ? bsel : -1;
  }
  if (lane < 16) idx[lane] = mine;
}
template <bool STORE = true>
__device__ __forceinline__ void unit_asel(const Params& p, int u, WaveLds* L, int lane) {
  const int g = u & 1, q = u >> 1, r32 = lane & 31, hi = lane >> 5, hh = r32 & 3, h = g * 4 + hh;
  bf16x8 qf[4]; load_q(qf, p.proj + (long)q * NPROJ + PA_Q + h * 64, hi);
  FlashState st; st.o0 = zero16(); st.o1 = zero16(); st.m = -1e30f; st.l = 0.f;
  const int* idx = p.idx + (long)u * 16; const SB* kvb = p.proj + PA_KV + 2 * 128 + g * 64; const float c31 = p.tabA[h * TABA_N + 2047] * L2E;
  for (int k = 0; k < 16; ++k) { const int b = __builtin_amdgcn_readfirstlane(idx[k]); if (b < 0) continue;
    for (int kt = 0; kt < 2; ++kt) { const int t0 = b * 64 + kt * 32; if (t0 > q) continue;
      const bool far = (q - (t0 + 31)) >= 1513; const bool edge = (t0 + 31 > q);
      flash_tile(st, qf, kvb + (long)(t0 + r32) * NPROJ, [&](int key) { return kvb + 128 + (long)(t0 + key) * NPROJ; },
                 [&](f32x16& s) {
#pragma unroll
                   for (int e = 0; e < 16; ++e) { const int tk = t0 + (e & 3) + 8 * (e >> 2) + 4 * hi; const int dist = q - tk; float bsv;
                     if (far) bsv = c31; else { const int dc = dist < 0 ? 0 : (dist > 2047 ? 2047 : dist); bsv = p.tabA[h * TABA_N + dc] * L2E; }
                     float vv = s[e] * QSC + bsv; if (edge && dist < 0) vv = NINF; s[e] = vv; } }, L, lane); } }
  flash_finish(st, L, lane);
  if (!STORE) { asm volatile("" :: "v"(st.o0[0]), "v"(st.o1[3])); return; }
  if (hi == 0) {
#pragma unroll
    for (int e = 0; e < 4; ++e) { const int he = g * 4 + e; const float* gl = p.small + (long)q * NSMALL + he * 3;
      const float g0 = sigmoid_f(gl[0]), g1 = sigmoid_f(gl[1]), g2 = sigmoid_f(gl[2]);
#pragma unroll
      for (int db = 0; db < 2; ++db) { const long c = (long)q * 512 + he * 64 + db * 32 + r32; const float os = db ? st.o1[e] : st.o0[e];
        const float a = g0 * bf2f(p.oc[c]) + g1 * os + g2 * bf2f(p.ow[c]); SB* mp = p.mix + (long)q * NMIX + MX_A + he * 64 + db * 32 + r32; *mp = f2bf(a * bf2f(*mp)); } }
  }
}

struct WaveLds2 { unsigned short x[2048]; unsigned short b[2048]; float acs[128]; float dtv[128]; float xch[64]; };
template <bool SCALE, class RowScale>
__device__ __forceinline__ void stage_slab(unsigned short* dst, const SB* src, long ld, RowScale rs, int lane) {
#pragma unroll
  for (int i = 0; i < 4; ++i) { const int c = lane + 64 * i, row = c >> 3, ch = c & 7; uint4 vv = *(const uint4*)(src + (long)row * ld + ch * 8);
    if (SCALE) { const float sc = rs(row); unsigned w[4] = {vv.x, vv.y, vv.z, vv.w};
#pragma unroll
      for (int k = 0; k < 4; ++k) { const float lo = __uint_as_float(w[k] << 16) * sc, hi2 = __uint_as_float(w[k] & 0xffff0000u) * sc; w[k] = pk2(lo, hi2); }
      vv.x = w[0]; vv.y = w[1]; vv.z = w[2]; vv.w = w[3]; }
    *(uint4*)&dst[(ch >> 2) * 1024 + row * 32 + (ch & 3) * 8] = vv; }
}
__device__ __forceinline__ bf16x8 slab_frag(const unsigned short* img, int cb, int s2, int lane) {
  const int hi = lane >> 5; const unsigned short* vb = img + (4 * hi + ((lane & 15) >> 2)) * 32 + ((lane >> 4) & 1) * 16 + (lane & 3) * 4 + cb * 1024 + s2 * 512;
  const v4i16_t lo = __builtin_amdgcn_ds_read_tr16_b64_v4i16((LDS3 v4i16_t*)vb);
  const v4i16_t hh = __builtin_amdgcn_ds_read_tr16_b64_v4i16((LDS3 v4i16_t*)(vb + 256));
  return (bf16x8){lo[0], lo[1], lo[2], lo[3], hh[0], hh[1], hh[2], hh[3]};
}
__device__ __forceinline__ void unit_bstates(const Params& p, int u, WaveLds2* L, int lane) {
  const int nh = u & 1, hd = (u >> 1) & 7, c = u >> 4, g = hd >> 2, r32 = lane & 31, hi = lane >> 5;
  f32x16 acc[2][2];
#pragma unroll
  for (int i = 0; i < 2; ++i)
#pragma unroll
    for (int j = 0; j < 2; ++j) acc[i][j] = zero16();
  const SB* xb = p.xconv + (long)c * 128 * 1024; const float* wst = p.wst + (long)c * 128 * 8 + hd;
  for (int q4 = 0; q4 < 4; ++q4) {
    stage_slab<true>(L->x, xb + (long)(32 * q4) * 1024 + hd * 64, 1024, [&](int row) { return wst[(32 * q4 + row) * 8]; }, lane);
    stage_slab<false>(L->b, xb + (long)(32 * q4) * 1024 + 512 + g * 128 + nh * 64, 1024, [&](int) { return 1.f; }, lane);
#pragma unroll
    for (int s2 = 0; s2 < 2; ++s2) { bf16x8 af[2], bfr[2];
#pragma unroll
      for (int i = 0; i < 2; ++i) { af[i] = slab_frag(L->x, i, s2, lane); bfr[i] = slab_frag(L->b, i, s2, lane); }
#pragma unroll
      for (int i = 0; i < 2; ++i)
#pragma unroll
        for (int j = 0; j < 2; ++j) acc[i][j] = MFMA32(af[i], bfr[j], acc[i][j]); } }
  float* so = p.states + ((long)c * 8 + hd) * 8192 + nh * 64 + r32;
#pragma unroll
  for (int i = 0; i < 2; ++i)
#pragma unroll
    for (int j = 0; j < 2; ++j)
#pragma unroll
      for (int e = 0; e < 16; ++e) so[(long)(32 * i + crow(e, hi)) * 128 + 32 * j] = acc[i][j][e];
}
__device__ __forceinline__ void unit_bout(const Params& p, int layer, int u, WaveLds2* L, int lane) {
  const int lt = u & 3, hd = (u >> 2) & 7, c = u >> 5, g = hd >> 2, r32 = lane & 31, hi = lane >> 5;
  for (int x = lane; x < 128; x += 64) { L->acs[x] = p.acs[((long)c * 128 + x) * 8 + hd]; L->dtv[x] = p.dt[((long)c * 128 + x) * 8 + hd]; }
  f32x16 acc[2] = {zero16(), zero16()}, acc2[2] = {zero16(), zero16()};
  const SB* xb = p.xconv + (long)c * 128 * 1024; const int l = 32 * lt + r32; const float al = p.acs[((long)c * 128 + l) * 8 + hd];
  const float* cbr = p.cb + ((long)c * 2 + g) * 16384 + (long)l * 128;
  for (int sc = 0; sc <= lt; ++sc) {
    stage_slab<false>(L->x, xb + (long)(32 * sc) * 1024 + hd * 64, 1024, [&](int) { return 1.f; }, lane);
#pragma unroll
    for (int s2 = 0; s2 < 2; ++s2) { float mv[8];
#pragma unroll
      for (int jj = 0; jj < 2; ++jj) { const int s0 = 32 * sc + 16 * s2 + 8 * jj + 4 * hi; const float4 cv = *(const float4*)(cbr + s0); const float4 av = *(const float4*)(&L->acs[s0]); const float4 dv = *(const float4*)(&L->dtv[s0]);
        mv[4 * jj + 0] = (s0 + 0 <= l) ? cv.x * __expf(al - av.x) * dv.x : 0.f; mv[4 * jj + 1] = (s0 + 1 <= l) ? cv.y * __expf(al - av.y) * dv.y : 0.f;
        mv[4 * jj + 2] = (s0 + 2 <= l) ? cv.z * __expf(al - av.z) * dv.z : 0.f; mv[4 * jj + 3] = (s0 + 3 <= l) ? cv.w * __expf(al - av.w) * dv.w : 0.f; }
      u32x4 aw; aw[0] = pk2(mv[0], mv[1]); aw[1] = pk2(mv[2], mv[3]); aw[2] = pk2(mv[4], mv[5]); aw[3] = pk2(mv[6], mv[7]); const bf16x8 af = __builtin_bit_cast(bf16x8, aw);
#pragma unroll
      for (int pt = 0; pt < 2; ++pt) acc[pt] = MFMA32(af, slab_frag(L->x, pt, s2, lane), acc[pt]); } }
  const SB* cmr = xb + (long)l * 1024 + 768 + g * 128; const float* prv = p.states + ((long)c * 8 + hd) * 8192;
#pragma unroll 2
  for (int ks = 0; ks < 8; ++ks) { const bf16x8 af = *(const bf16x8*)(cmr + 16 * ks + 8 * hi);
#pragma unroll
    for (int pt = 0; pt < 2; ++pt) { const float* pr = prv + (long)(32 * pt + r32) * 128 + 16 * ks + 8 * hi; const float4 a0 = *(const float4*)pr, a1 = *(const float4*)(pr + 4);
      u32x4 bw; bw[0] = pk2(a0.x, a0.y); bw[1] = pk2(a0.z, a0.w); bw[2] = pk2(a1.x, a1.y); bw[3] = pk2(a1.z, a1.w);
      acc2[pt] = MFMA32(af, __builtin_bit_cast(bf16x8, bw), acc2[pt]); } }
  const float dsk = p.b_d[layer * 8 + hd];
#pragma unroll
  for (int e = 0; e < 16; ++e) { const int lr = 32 * lt + crow(e, hi); const float ea = __expf(L->acs[lr]); const long t = (long)c * 128 + lr;
#pragma unroll
    for (int pt = 0; pt < 2; ++pt) { const int pp = 32 * pt + r32; p.ybuf[t * 512 + hd * 64 + pp] = acc[pt][e] + ea * acc2[pt][e] + dsk * bf2f(xb[(long)lr * 1024 + hd * 64 + pp]); } }
}
__device__ __forceinline__ void unit_bnorm(const Params& p, int layer, int u, int lane) {
  const int g = u & 1; const long t = u >> 1; const float4 yv = *(const float4*)(p.ybuf + t * 512 + g * 256 + lane * 4);
  SB* mp = p.mix + t * NMIX + MX_B + g * 256 + lane * 4; const ushort4 zv = *(const ushort4*)mp;
  const float v0 = yv.x * bf2f(zv.x), v1 = yv.y * bf2f(zv.y), v2 = yv.z * bf2f(zv.z), v3 = yv.w * bf2f(zv.w);
  const float ss = wave_sum_f(v0 * v0 + v1 * v1 + v2 * v2 + v3 * v3); const float r = 1.f / sqrtf(ss * (1.f / 256.f) + 1e-6f);
  const float4 w = *(const float4*)(p.b_norm + layer * 512 + g * 256 + lane * 4);
  ushort4 o; o.x = f2bf(v0 * r * w.x); o.y = f2bf(v1 * r * w.y); o.z = f2bf(v2 * r * w.z); o.w = f2bf(v3 * r * w.w); *(ushort4*)mp = o;
}
__device__ __forceinline__ void unit_bdt(const Params& p, int layer, int u, int lane) {
  const int hd = u & 7, c = u >> 3; const float a = -expf(p.a_log[layer * 8 + hd]), bias = p.dt_bias[layer * 8 + hd]; const long t0 = (long)c * 128 + 2 * lane;
  const float d0 = softplus_f(p.small[t0 * NSMALL + 24 + hd] + bias), d1 = softplus_f(p.small[(t0 + 1) * NSMALL + 24 + hd] + bias);
  float run = (d0 + d1) * a;
#pragma unroll
  for (int o = 1; o < 64; o <<= 1) { const float v = __shfl_up(run, o); if (lane >= o) run += v; }
  const float tot = __shfl(run, 63); const float c1 = run, c0 = run - d1 * a;
  p.dt[t0 * 8 + hd] = d0; p.dt[(t0 + 1) * 8 + hd] = d1; p.acs[t0 * 8 + hd] = c0; p.acs[(t0 + 1) * 8 + hd] = c1;
  p.wst[t0 * 8 + hd] = d0 * expf(tot - c0); p.wst[(t0 + 1) * 8 + hd] = d1 * expf(tot - c1);
}
__device__ __forceinline__ void item_bconv(const Params& p, int layer, long gid) {
  const int cg = (int)(gid & 127) * 8; const long t = gid >> 7; const float* w = p.conv_w + (long)layer * 4 * 1024 + cg; const float* bb = p.conv_b + layer * 1024 + cg;
  const float4 b0 = *(const float4*)bb, b1 = *(const float4*)(bb + 4);
  float acc[8] = {b0.x, b0.y, b0.z, b0.w, b1.x, b1.y, b1.z, b1.w};
#pragma unroll
  for (int i = 0; i < 4; ++i) { const long tt = t - 3 + i; const long tc = tt < 0 ? 0 : tt; const float vm = tt < 0 ? 0.f : 1.f;
    const uint4 vv = *(const uint4*)(p.proj + tc * NPROJ + PB_X + cg); const unsigned wd[4] = {vv.x, vv.y, vv.z, vv.w};
    const float4 w0 = *(const float4*)(w + i * 1024), w1 = *(const float4*)(w + i * 1024 + 4); const float wv[8] = {w0.x, w0.y, w0.z, w0.w, w1.x, w1.y, w1.z, w1.w};
#pragma unroll
    for (int k = 0; k < 4; ++k) { acc[2 * k] += vm * wv[2 * k] * __uint_as_float(wd[k] << 16); acc[2 * k + 1] += vm * wv[2 * k + 1] * __uint_as_float(wd[k] & 0xffff0000u); } }
  uint4 o; o.x = pk2(silu_f(acc[0]), silu_f(acc[1])); o.y = pk2(silu_f(acc[2]), silu_f(acc[3])); o.z = pk2(silu_f(acc[4]), silu_f(acc[5])); o.w = pk2(silu_f(acc[6]), silu_f(acc[7]));
  *(uint4*)(p.xconv + t * 1024 + cg) = o;
}
__device__ __forceinline__ void unit_cmp(const Params& p, int layer, int u, int lane) {
  const int ncmp = p.S / 16, ntile = ncmp * 2 / 32; const int kv = u / ntile, rt = u % ntile, r32 = lane & 31, hi = lane >> 5;
  const int r = 32 * rt + r32, j = r >> 1, hk = r & 1;
  const unsigned short* w1t = p.w1t + (long)kv * 128 * 2048; const unsigned short* w2t = p.w2t + kv * 64 * 128; const float* pe = p.cmp_pos + (long)(layer * 2 + kv) * 32 * 64;
  const SB* src = p.proj + PA_KV + kv * 128 + hk * 64;
  f32x16 acc[4] = {zero16(), zero16(), zero16(), zero16()};
#pragma unroll 4
  for (int ks = 0; ks < 128; ++ks) { const int t = ks >> 2, d = (ks & 3) * 16 + 8 * hi; const long tok = 16 * j + t;
    const float4 p0 = *(const float4*)(pe + t * 64 + d), p1 = *(const float4*)(pe + t * 64 + d + 4); float v[8] = {p0.x, p0.y, p0.z, p0.w, p1.x, p1.y, p1.z, p1.w};
    { const long tokc = tok < p.S ? tok : (long)p.S - 1; const float vm = tok < p.S ? 1.f : 0.f;
      const uint4 vv = *(const uint4*)(src + tokc * NPROJ + d); const unsigned wd[4] = {vv.x, vv.y, vv.z, vv.w};
#pragma unroll
      for (int k = 0; k < 4; ++k) { v[2 * k] += vm * __uint_as_float(wd[k] << 16); v[2 * k + 1] += vm * __uint_as_float(wd[k] & 0xffff0000u); } }
    u32x4 bw; bw[0] = pk2(v[0], v[1]); bw[1] = pk2(v[2], v[3]); bw[2] = pk2(v[4], v[5]); bw[3] = pk2(v[6], v[7]); const bf16x8 bfr = __builtin_bit_cast(bf16x8, bw);
#pragma unroll
    for (int ut = 0; ut < 4; ++ut) { const bf16x8 af = *(const bf16x8*)(w1t + (long)(32 * ut + r32) * 2048 + 16 * ks + 8 * hi); acc[ut] = MFMA32(af, bfr, acc[ut]); } }
  f32x16 o2[2] = {zero16(), zero16()};
#pragma unroll
  for (int ut = 0; ut < 4; ++ut) {
#pragma unroll
    for (int e = 0; e < 16; ++e) acc[ut][e] = gelu_f(acc[ut][e]);
#pragma unroll
    for (int s2 = 0; s2 < 2; ++s2) { const bf16x8 hb = pack8(acc[ut], 8 * s2);
#pragma unroll
      for (int dt = 0; dt < 2; ++dt) { const unsigned short* wr = w2t + (32 * dt + r32) * 128 + 32 * ut + 16 * s2 + 4 * hi; const uint2 x0 = *(const uint2*)wr, x1 = *(const uint2*)(wr + 8);
        u32x4 aw; aw[0] = x0.x; aw[1] = x0.y; aw[2] = x1.x; aw[3] = x1.y; o2[dt] = MFMA32(__builtin_bit_cast(bf16x8, aw), hb, o2[dt]); } } }
  SB* dst = p.kvc + ((long)kv * ncmp * 2 + r) * 64;
#pragma unroll
  for (int dt = 0; dt < 2; ++dt)
#pragma unroll
    for (int e = 0; e < 16; ++e) dst[32 * dt + crow(e, hi)] = f2bf(o2[dt][e]);
}

template <class RowFn>
__device__ __forceinline__ void topk4_rows(const Params& p, RowFn rowfn, int lane) {
  float v[4][4]; int cur[4], mine[4];
#pragma unroll
  for (int r = 0; r < 4; ++r) { const int row = rowfn(r); const int q = row >> 1; cur[r] = q >> 6; const float* imp = p.imp + (long)row * 256; mine[r] = -1;
#pragma unroll
    for (int k = 0; k < 4; ++k) { const int b = lane + 64 * k; float x = (b <= cur[r]) ? imp[b] : -1.f; if (b == 0 || b == cur[r]) x = 1e4f; v[r][k] = x; } }
  for (int k = 0; k < 16; ++k) {
    float m[4]; int cand[4];
#pragma unroll
    for (int r = 0; r < 4; ++r) m[r] = fmaxf(fmaxf(v[r][0], v[r][1]), fmaxf(v[r][2], v[r][3]));
#pragma unroll
    for (int o = 32; o > 0; o >>= 1) {
#pragma unroll
      for (int r = 0; r < 4; ++r) m[r] = fmaxf(m[r], __shfl_xor(m[r], o)); }
#pragma unroll
    for (int r = 0; r < 4; ++r) { cand[r] = 0x7fffffff;
#pragma unroll
      for (int kk = 3; kk >= 0; --kk) if (v[r][kk] == m[r]) cand[r] = lane + 64 * kk; }
#pragma unroll
    for (int o = 32; o > 0; o >>= 1) {
#pragma unroll
      for (int r = 0; r < 4; ++r) { const int w = __shfl_xor(cand[r], o); cand[r] = w < cand[r] ? w : cand[r]; } }
#pragma unroll
    for (int r = 0; r < 4; ++r) {
#pragma unroll
      for (int kk = 0; kk < 4; ++kk) if (lane + 64 * kk == cand[r]) v[r][kk] = -2.f;
      if (lane == k) mine[r] = (m[r] >= 0.f) ? cand[r] : -1; }
  }
#pragma unroll
  for (int r = 0; r < 4; ++r) if (lane < 16) p.idx[(long)rowfn(r) * 16 + lane] = mine[r];
}
__device__ __forceinline__ void unit_topk4(const Params& p, int u, int lane) { topk4_rows(p, [&](int r) { return u * 4 + r; }, lane); }
struct AselLds { unsigned short k[2][4096]; unsigned short v[2][4096]; unsigned short q[4][2048]; unsigned sel[64][8]; unsigned anyb[8]; int nlist; int pad[7]; unsigned char blist[256]; float xch[4][32]; };
__device__ __forceinline__ void asel_issue(uint4 (&r)[4], const SB* kvb, int b, int tid) {
#pragma unroll
  for (int i = 0; i < 2; ++i) { const int idx = tid + 256 * i, row = idx >> 3, ch = idx & 7; const SB* src = kvb + (long)(b * 64 + row) * NPROJ + ch * 8; r[i] = *(const uint4*)src; r[2 + i] = *(const uint4*)(src + 128); }
}
__device__ __forceinline__ void asel_commit(const uint4 (&r)[4], AselLds* A, int stage, int tid) {
#pragma unroll
  for (int i = 0; i < 2; ++i) { const int idx = tid + 256 * i, row = idx >> 3, ch = idx & 7;
    *(uint4*)&A->k[stage][row * 64 + ((ch ^ (row & 7)) * 8)] = r[i];
    *(uint4*)&A->v[stage][(ch >> 2) * 2048 + row * 32 + (ch & 3) * 8] = r[2 + i]; }
}
__device__ __forceinline__ void asel_coltile(const Params& p, FlashState& S_, const unsigned short* qlds, AselLds* A, float* xch, int stage, int b, int cur, int q0, int qbase, int h, float c31, int lane) {
  const int r32 = lane & 31, hi = lane >> 5; const int ql = qbase + (r32 >> 2); const int q = q0 + ql;
  const bool selq = (A->sel[ql][b >> 5] >> (b & 31)) & 1u;
  if (!__any(selq)) return;
  bf16x8 qf[4];
#pragma unroll
  for (int d0 = 0; d0 < 4; ++d0) qf[d0] = *(const bf16x8*)&qlds[r32 * 64 + (((2 * d0 + hi) ^ ((r32 >> 1) & 7)) * 8)];
  const bool far = (q0 - (b * 64 + 63)) >= 1513; const bool edge = (b == cur);
#ifndef ASEL2
#define ASEL2 1
#endif
#if ASEL2
  bf16x8 kf0[4], kf1[4];
#pragma unroll
  for (int d0 = 0; d0 < 4; ++d0) { const int row0 = r32, row1 = 32 + r32;
    kf0[d0] = *(const bf16x8*)&A->k[stage][row0 * 64 + (((2 * d0 + hi) ^ ((row0 >> 1) & 7)) * 8)];
    kf1[d0] = *(const bf16x8*)&A->k[stage][row1 * 64 + (((2 * d0 + hi) ^ ((row1 >> 1) & 7)) * 8)]; }
  f32x16 s0 = zero16(), s1 = zero16();
#pragma unroll
  for (int d0 = 0; d0 < 4; ++d0) { s0 = MFMA32(kf0[d0], qf[d0], s0); s1 = MFMA32(kf1[d0], qf[d0], s1); }
  if (far) { flash_core2_lin(S_, s0, s1, selq ? QSC : 0.f, selq ? c31 : NINF, A->v[stage], xch, lane); return; }
#pragma unroll
  for (int e = 0; e < 16; ++e) { const int tk = b * 64 + (e & 3) + 8 * (e >> 2) + 4 * hi; const int dist = q - tk; float b0, b1;
    if (far) { b0 = c31; b1 = c31; } else { const int d0c = dist < 0 ? 0 : (dist > 2047 ? 2047 : dist); const int d1 = dist - 32; const int d1c = d1 < 0 ? 0 : (d1 > 2047 ? 2047 : d1);
      b0 = p.tabA[h * TABA_N + d0c] * L2E; b1 = p.tabA[h * TABA_N + d1c] * L2E; }
    float v0 = s0[e] * QSC + b0, v1 = s1[e] * QSC + b1; if (!selq || (edge && dist < 0)) v0 = NINF; if (!selq || (edge && dist < 32)) v1 = NINF; s0[e] = v0; s1[e] = v1; }
  flash_core2(S_, s0, s1, A->v[stage], xch, lane);
}
#else
#pragma unroll 1
  for (int kt = 0; kt < 2; ++kt) { const int t0 = b * 64 + 32 * kt; if (edge && t0 > q0 + qbase + 7) continue;
    bf16x8 kf[4]; { const int row = 32 * kt + r32;
#pragma unroll
      for (int d0 = 0; d0 < 4; ++d0) kf[d0] = *(const bf16x8*)&A->k[stage][row * 64 + (((2 * d0 + hi) ^ ((row >> 1) & 7)) * 8)]; }
    f32x16 s = zero16();
#pragma unroll
    for (int d0 = 0; d0 < 4; ++d0) s = MFMA32(kf[d0], qf[d0], s);
    if (far) { flash_core1_lin(S_, s, selq ? QSC : 0.f, selq ? c31 : NINF, A->v[stage] + kt * 1024, xch, lane); continue; }
#pragma unroll
    for (int e = 0; e < 16; ++e) { const int tk = t0 + (e & 3) + 8 * (e >> 2) + 4 * hi; const int dist = q - tk;
      const int dc = dist < 0 ? 0 : (dist > 2047 ? 2047 : dist); const float bsv = p.tabA[h * TABA_N + dc] * L2E;
      float vv = s[e] * QSC + bsv; if (!selq || (edge && dist < 0)) vv = NINF; s[e] = vv; }
    flash_core1(S_, s, A->v[stage] + kt * 1024, xch, lane);
  }
}
#endif
__device__ __forceinline__ void asel_store(const Params& p, FlashState& S_, float* xch, int q0, int qbase, int g, int lane) {
  const int r32 = lane & 31, hi = lane >> 5;
  const float lt = S_.l + __shfl_xor(S_.l, 32); const float inv = lt > 0.f ? 1.f / lt : 0.f; xch[r32] = inv;
#pragma unroll
  for (int e = 0; e < 16; ++e) { const int j = crow(e, hi); const float a = xch[j]; const int q = q0 + qbase + (j >> 2), he = g * 4 + (j & 3);
    const float* gl = p.small + (long)q * NSMALL + he * 3; const float g0 = sigmoid_f(gl[0]), g1 = sigmoid_f(gl[1]), g2 = sigmoid_f(gl[2]);
#pragma unroll
    for (int db = 0; db < 2; ++db) { const long c = (long)q * 512 + he * 64 + db * 32 + r32; const float os = (db ? S_.o1[e] : S_.o0[e]) * a;
      const float av = g0 * bf2f(p.oc[c]) + g1 * os + g2 * bf2f(p.ow[c]); SB* mp = p.mix + (long)q * NMIX + MX_A + he * 64 + db * 32 + r32; *mp = f2bf(av * bf2f(*mp)); } }
}
__device__ __forceinline__ void unit_asel_blk(const Params& p, int u, AselLds* A) {
  int tid = threadIdx.x; asm volatile("" : "+v"(tid));
  const int lane = tid & 63, w = __builtin_amdgcn_readfirstlane(tid >> 6), r32 = lane & 31, hi = lane >> 5;
  const int g = u & 1, qt = (p.S / 32 - 1) - (u >> 1), q0 = qt * 32, cur = q0 >> 6;
  const SB* kvb = p.proj + PA_KV + 2 * 128 + g * 64;
  __syncthreads();
  for (int i = tid; i < 64 * 8 + 8; i += 256) ((unsigned*)A->sel)[i] = 0u;
#ifndef ASEL_NO_TOPK
  topk4_rows(p, [&](int r) { return (q0 + 8 * w + r) * 2 + g; }, lane); topk4_rows(p, [&](int r) { return (q0 + 8 * w + 4 + r) * 2 + g; }, lane);
  asm volatile("s_waitcnt vmcnt(0)" ::: "memory");
#endif
  __syncthreads();
#pragma unroll
  for (int i = 0; i < 2; ++i) { const int e = tid + 256 * i, ql = e >> 4, kk = e & 15; const int b = __hip_atomic_load(&p.idx[((long)(q0 + ql) * 2 + g) * 16 + kk], __ATOMIC_RELAXED, __HIP_MEMORY_SCOPE_AGENT);
    if (b >= 0) { atomicOr(&A->sel[ql][b >> 5], 1u << (b & 31)); atomicOr(&A->anyb[b >> 5], 1u << (b & 31)); } }
  __syncthreads();
  if (tid < 64) {
    const unsigned wbits = A->anyb[lane >> 3]; const unsigned nib = (wbits >> ((lane & 7) * 4)) & 15u; const int cnt = __popc(nib);
    int pre = cnt;
#pragma unroll
    for (int o = 1; o < 64; o <<= 1) { const int v = __shfl_up(pre, o); if (lane >= o) pre += v; }
    int pos = pre - cnt;
#pragma unroll
    for (int k = 0; k < 4; ++k) if ((nib >> k) & 1u) A->blist[pos++] = (unsigned char)(lane * 4 + k);
    if (lane == 63) A->nlist = pre;
  }
  __syncthreads();
  const int nlist = A->nlist;
  const int hh = r32 & 3, h = g * 4 + hh; const float c31 = p.tabA[h * TABA_N + 2047] * L2E;
  FlashState st0;
  { bf16x8 qf0[4]; load_q(qf0, p.proj + (long)(q0 + 8 * w + (r32 >> 2)) * NPROJ + PA_Q + h * 64, hi);
#pragma unroll
    for (int d0 = 0; d0 < 4; ++d0) *(bf16x8*)&A->q[w][r32 * 64 + (((2 * d0 + hi) ^ ((r32 >> 1) & 7)) * 8)] = qf0[d0]; }
  st0.o0 = zero16(); st0.o1 = zero16(); st0.m = -1e30f; st0.l = 0.f;
  float* xch = A->xch[w];
#define ASEL_DMA(bb, stg) { const int b_ = (bb); _Pragma("unroll") for (int i_ = 0; i_ < 2; ++i_) { const int pk_ = 2 * w + i_; \
      { const int row_ = pk_ * 8 + (lane >> 3), pc_ = lane & 7; __builtin_amdgcn_global_load_lds((gptr_t)(kvb + (long)(b_ * 64 + row_) * NPROJ + ((pc_ ^ ((row_ >> 1) & 7)) * 8)), (lptr_t)&A->k[stg][pk_ * 512], 16, 0, 0); } \
      { const int db_ = pk_ >> 2, row_ = (pk_ & 3) * 16 + (lane >> 2), wi_ = lane & 3; __builtin_amdgcn_global_load_lds((gptr_t)(kvb + 128 + (long)(b_ * 64 + row_) * NPROJ + db_ * 32 + wi_ * 8), (lptr_t)&A->v[stg][db_ * 2048 + (pk_ & 3) * 512], 16, 0, 0); } } }
  if (nlist > 0) ASEL_DMA(A->blist[0], 0);
  for (int it = 0; it < nlist; ++it) {
    const int stage = it & 1; const int b = A->blist[it];
    __syncthreads();
    if (it + 1 < nlist) ASEL_DMA(A->blist[it + 1], stage ^ 1);
    asel_coltile(p, st0, A->q[w], A, xch, stage, b, cur, q0, 8 * w, h, c31, lane);
  }
  asel_store(p, st0, xch, q0, 8 * w, g, lane);
#undef ASEL_DMA
}
__device__ __forceinline__ void unit_bout_blk(const Params& p, int layer, int ub, char* smem) {
  int tid = threadIdx.x; asm volatile("" : "+v"(tid));
  const int lane = tid & 63, w = __builtin_amdgcn_readfirstlane(tid >> 6), r32 = lane & 31, hi = lane >> 5;
  const int lt = ub & 3, g = (ub >> 2) & 1, c = ub >> 3, hd = g * 4 + w;
  WaveLds2* L = ((WaveLds2*)smem) + w;
  __syncthreads();
  for (int x = lane; x < 128; x += 64) { L->acs[x] = p.acs[((long)c * 128 + x) * 8 + hd]; L->dtv[x] = p.dt[((long)c * 128 + x) * 8 + hd]; }
  f32x16 acc[2] = {zero16(), zero16()}, acc2[2] = {zero16(), zero16()};
  const SB* xb = p.xconv + (long)c * 128 * 1024; const int l = 32 * lt + r32; const float al = p.acs[((long)c * 128 + l) * 8 + hd];
  const float* cbr = p.cb + ((long)c * 2 + g) * 16384 + (long)l * 128;
  for (int sc = 0; sc <= lt; ++sc) {
    stage_slab<false>(L->x, xb + (long)(32 * sc) * 1024 + hd * 64, 1024, [&](int) { return 1.f; }, lane);
#pragma unroll
    for (int s2 = 0; s2 < 2; ++s2) { float mv[8];
#pragma unroll
      for (int jj = 0; jj < 2; ++jj) { const int s0 = 32 * sc + 16 * s2 + 8 * jj + 4 * hi; const float4 cv = *(const float4*)(cbr + s0); const float4 av = *(const float4*)(&L->acs[s0]); const float4 dv = *(const float4*)(&L->dtv[s0]);
        mv[4 * jj + 0] = (s0 + 0 <= l) ? cv.x * __expf(al - av.x) * dv.x : 0.f; mv[4 * jj + 1] = (s0 + 1 <= l) ? cv.y * __expf(al - av.y) * dv.y : 0.f;
        mv[4 * jj + 2] = (s0 + 2 <= l) ? cv.z * __expf(al - av.z) * dv.z : 0.f; mv[4 * jj + 3] = (s0 + 3 <= l) ? cv.w * __expf(al - av.w) * dv.w : 0.f; }
      u32x4 aw; aw[0] = pk2(mv[0], mv[1]); aw[1] = pk2(mv[2], mv[3]); aw[2] = pk2(mv[4], mv[5]); aw[3] = pk2(mv[6], mv[7]); const bf16x8 af = __builtin_bit_cast(bf16x8, aw);
#pragma unroll
      for (int pt = 0; pt < 2; ++pt) acc[pt] = MFMA32(af, slab_frag(L->x, pt, s2, lane), acc[pt]); } }
  const SB* cmr = xb + (long)l * 1024 + 768 + g * 128; const float* prv = p.states + ((long)c * 8 + hd) * 8192;
#pragma unroll 2
  for (int ks = 0; ks < 8; ++ks) { const bf16x8 af = *(const bf16x8*)(cmr + 16 * ks + 8 * hi);
#pragma unroll
    for (int pt = 0; pt < 2; ++pt) { const float* pr = prv + (long)(32 * pt + r32) * 128 + 16 * ks + 8 * hi; const float4 a0 = *(const float4*)pr, a1 = *(const float4*)(pr + 4);
      u32x4 bw; bw[0] = pk2(a0.x, a0.y); bw[1] = pk2(a0.z, a0.w); bw[2] = pk2(a1.x, a1.y); bw[3] = pk2(a1.z, a1.w);
      acc2[pt] = MFMA32(af, __builtin_bit_cast(bf16x8, bw), acc2[pt]); } }
  const float dsk = p.b_d[layer * 8 + hd];
  float* yl = (float*)L;
#pragma unroll
  for (int e = 0; e < 16; ++e) { const int lr = crow(e, hi); const float ea = __expf(L->acs[32 * lt + lr]);
#pragma unroll
    for (int pt = 0; pt < 2; ++pt) { const int pp = 32 * pt + r32; yl[lr * 64 + pp] = acc[pt][e] + ea * acc2[pt][e] + dsk * bf2f(xb[(long)(32 * lt + lr) * 1024 + hd * 64 + pp]); } }
  __syncthreads();
  { const int row = tid >> 3, sub = tid & 7; const long t = (long)c * 128 + 32 * lt + row; SB* mp = p.mix + t * NMIX + MX_B + g * 256 + sub * 32;
    const float* ysrc = (const float*)(((WaveLds2*)smem) + (sub >> 1)) + row * 64 + (sub & 1) * 32;
    float vv[32]; float ss = 0.f;
#pragma unroll
    for (int i = 0; i < 4; ++i) { const uint4 zz = *(const uint4*)(mp + 8 * i); const unsigned zw[4] = {zz.x, zz.y, zz.z, zz.w};
#pragma unroll
      for (int k = 0; k < 4; ++k) { const float y0 = ysrc[8 * i + 2 * k] * __uint_as_float(zw[k] << 16), y1 = ysrc[8 * i + 2 * k + 1] * __uint_as_float(zw[k] & 0xffff0000u); vv[8 * i + 2 * k] = y0; vv[8 * i + 2 * k + 1] = y1; ss += y0 * y0 + y1 * y1; } }
    ss += __shfl_xor(ss, 1); ss += __shfl_xor(ss, 2); ss += __shfl_xor(ss, 4);
    const float r = 1.f / sqrtf(ss * (1.f / 256.f) + 1e-6f); const float* wn = p.b_norm + layer * 512 + g * 256 + sub * 32;
#pragma unroll
    for (int i = 0; i < 4; ++i) { uint4 o; o.x = pk2(vv[8 * i] * r * wn[8 * i], vv[8 * i + 1] * r * wn[8 * i + 1]); o.y = pk2(vv[8 * i + 2] * r * wn[8 * i + 2], vv[8 * i + 3] * r * wn[8 * i + 3]);
      o.z = pk2(vv[8 * i + 4] * r * wn[8 * i + 4], vv[8 * i + 5] * r * wn[8 * i + 5]); o.w = pk2(vv[8 * i + 6] * r * wn[8 * i + 6], vv[8 * i + 7] * r * wn[8 * i + 7]); *(uint4*)(mp + 8 * i) = o; } }
}

__device__ __forceinline__ void unit_memkv(const Params& p, int u, int lane) {
  const int l = u >> 8, m = u & 255; const float* row = p.mem + (long)m * DM; const float* nw = p.m_norm + l * DM; const float* w = p.m_wkv + (long)l * DM * 512 + lane * 8;
  float ss = 0.f;
#pragma unroll
  for (int i = 0; i < 4; ++i) { const float4 v = *(const float4*)(row + i * 256 + lane * 4); ss += v.x * v.x + v.y * v.y + v.z * v.z + v.w * v.w; }
  ss = wave_sum_f(ss); const float r = 1.f / sqrtf(ss * (1.f / DM) + 1e-6f);
  float acc[8] = {0.f, 0.f, 0.f, 0.f, 0.f, 0.f, 0.f, 0.f};
#pragma unroll 8
  for (int d = 0; d < DM; ++d) { const float a = row[d] * r * nw[d]; const float4 w0 = *(const float4*)(w + (long)d * 512), w1 = *(const float4*)(w + (long)d * 512 + 4);
    acc[0] += a * w0.x; acc[1] += a * w0.y; acc[2] += a * w0.z; acc[3] += a * w0.w; acc[4] += a * w1.x; acc[5] += a * w1.y; acc[6] += a * w1.z; acc[7] += a * w1.w; }
  uint4 o; o.x = pk2(acc[0], acc[1]); o.y = pk2(acc[2], acc[3]); o.z = pk2(acc[4], acc[5]); o.w = pk2(acc[6], acc[7]);
  *(uint4*)(p.memkv + (long)u * 512 + lane * 8) = o;
}

__device__ __forceinline__ void item_dmerge(const Params& p, long gid) {
  const int c8 = (int)(gid & 63), h = c8 >> 3; const long q = gid >> 6; const long S = p.S;
  const float l0 = p.dlse[(0 * S + q) * 8 + h], l1 = p.dlse[(1 * S + q) * 8 + h], l2 = p.dlse[(2 * S + q) * 8 + h];
  const float mm = fmaxf(l0, fmaxf(l1, l2)); float e0 = __expf(l0 - mm), e1 = __expf(l1 - mm), e2 = __expf(l2 - mm); const float is = 1.f / (e0 + e1 + e2); e0 *= is; e1 *= is; e2 *= is;
  const long c = q * 512 + c8 * 8; const uint4 a = *(const uint4*)(p.dop + c), b = *(const uint4*)(p.dop + S * 512 + c), d = *(const uint4*)(p.dop + 2 * S * 512 + c);
  SB* mp = p.mix + q * NMIX + MX_D + c8 * 8; const uint4 z = *(const uint4*)mp;
  const unsigned aw[4] = {a.x, a.y, a.z, a.w}, bw[4] = {b.x, b.y, b.z, b.w}, dw[4] = {d.x, d.y, d.z, d.w}, zw[4] = {z.x, z.y, z.z, z.w}; unsigned ow[4];
#pragma unroll
  for (int k = 0; k < 4; ++k) {
    const float lo = (e0 * __uint_as_float(aw[k] << 16) + e1 * __uint_as_float(bw[k] << 16) + e2 * __uint_as_float(dw[k] << 16)) * __uint_as_float(zw[k] << 16);
    const float hi = (e0 * __uint_as_float(aw[k] & 0xffff0000u) + e1 * __uint_as_float(bw[k] & 0xffff0000u) + e2 * __uint_as_float(dw[k] & 0xffff0000u)) * __uint_as_float(zw[k] & 0xffff0000u);
    ow[k] = pk2(lo, hi); }
  uint4 o; o.x = ow[0]; o.y = ow[1]; o.z = ow[2]; o.w = ow[3]; *(uint4*)mp = o;
}

__device__ __forceinline__ void unit_cmp_blk(const Params& p, int layer, int u, float* red  ) {
  int tid = threadIdx.x; asm volatile("" : "+v"(tid));
  const int lane = tid & 63, w = __builtin_amdgcn_readfirstlane(tid >> 6), r32 = lane & 31, hi = lane >> 5;
  const int ncmp = p.S / 16, ntile = ncmp * 2 / 32; const int kv = u / ntile, rt = u % ntile;
  const int r = 32 * rt + r32, j = r >> 1, hk = r & 1;
  const unsigned short* w1t = p.w1t + (long)kv * 128 * 2048; const unsigned short* w2t = p.w2t + kv * 64 * 128; const float* pe = p.cmp_pos + (long)(layer * 2 + kv) * 32 * 64;
  const SB* src = p.proj + PA_KV + kv * 128 + hk * 64;
  f32x16 acc[4] = {zero16(), zero16(), zero16(), zero16()};
#pragma unroll 4
  for (int ks = 32 * w; ks < 32 * w + 32; ++ks) { const int t = ks >> 2, d = (ks & 3) * 16 + 8 * hi; const long tok = 16 * j + t;
    const float4 p0 = *(const float4*)(pe + t * 64 + d), p1 = *(const float4*)(pe + t * 64 + d + 4); float v[8] = {p0.x, p0.y, p0.z, p0.w, p1.x, p1.y, p1.z, p1.w};
    { const long tokc = tok < p.S ? tok : (long)p.S - 1; const float vm = tok < p.S ? 1.f : 0.f;
      const uint4 vv = *(const uint4*)(src + tokc * NPROJ + d); const unsigned wd[4] = {vv.x, vv.y, vv.z, vv.w};
#pragma unroll
      for (int k = 0; k < 4; ++k) { v[2 * k] += vm * __uint_as_float(wd[k] << 16); v[2 * k + 1] += vm * __uint_as_float(wd[k] & 0xffff0000u); } }
    u32x4 bw; bw[0] = pk2(v[0], v[1]); bw[1] = pk2(v[2], v[3]); bw[2] = pk2(v[4], v[5]); bw[3] = pk2(v[6], v[7]); const bf16x8 bfr = __builtin_bit_cast(bf16x8, bw);
#pragma unroll
    for (int ut = 0; ut < 4; ++ut) { const bf16x8 af = *(const bf16x8*)(w1t + (long)(32 * ut + r32) * 2048 + 16 * ks + 8 * hi); acc[ut] = MFMA32(af, bfr, acc[ut]); } }
  __syncthreads();
#pragma unroll
  for (int ut = 0; ut < 4; ++ut)
#pragma unroll
    for (int q4 = 0; q4 < 4; ++q4) *(float4*)&red[(((w * 4 + ut) * 4 + q4) * 64 + lane) * 4] = make_float4(acc[ut][4 * q4], acc[ut][4 * q4 + 1], acc[ut][4 * q4 + 2], acc[ut][4 * q4 + 3]);
  __syncthreads();
  f32x16 hsum = zero16();
#pragma unroll
  for (int w2 = 0; w2 < 4; ++w2)
#pragma unroll
    for (int q4 = 0; q4 < 4; ++q4) { const float4 t4 = *(const float4*)&red[(((w2 * 4 + w) * 4 + q4) * 64 + lane) * 4]; hsum[4 * q4] += t4.x; hsum[4 * q4 + 1] += t4.y; hsum[4 * q4 + 2] += t4.z; hsum[4 * q4 + 3] += t4.w; }
#pragma unroll
  for (int e = 0; e < 16; ++e) hsum[e] = gelu_f(hsum[e]);
  f32x16 o2[2] = {zero16(), zero16()};
#pragma unroll
  for (int s2 = 0; s2 < 2; ++s2) { const bf16x8 hb = pack8(hsum, 8 * s2);
#pragma unroll
    for (int dt = 0; dt < 2; ++dt) { const unsigned short* wr = w2t + (32 * dt + r32) * 128 + 32 * w + 16 * s2 + 4 * hi; const uint2 x0 = *(const uint2*)wr, x1 = *(const uint2*)(wr + 8);
      u32x4 aw; aw[0] = x0.x; aw[1] = x0.y; aw[2] = x1.x; aw[3] = x1.y; o2[dt] = MFMA32(__builtin_bit_cast(bf16x8, aw), hb, o2[dt]); } }
  __syncthreads();
#pragma unroll
  for (int dt = 0; dt < 2; ++dt)
#pragma unroll
    for (int q4 = 0; q4 < 4; ++q4) *(float4*)&red[(((w * 2 + dt) * 4 + q4) * 64 + lane) * 4] = make_float4(o2[dt][4 * q4], o2[dt][4 * q4 + 1], o2[dt][4 * q4 + 2], o2[dt][4 * q4 + 3]);
  __syncthreads();
  if (w < 2) {
    const int dt = w; SB* dst = p.kvc + ((long)kv * ncmp * 2 + r) * 64;
#pragma unroll
    for (int q4 = 0; q4 < 4; ++q4) { float4 s4 = make_float4(0.f, 0.f, 0.f, 0.f);
#pragma unroll
      for (int w2 = 0; w2 < 4; ++w2) { const float4 t4 = *(const float4*)&red[(((w2 * 2 + dt) * 4 + q4) * 64 + lane) * 4]; s4.x += t4.x; s4.y += t4.y; s4.z += t4.z; s4.w += t4.w; }
      dst[32 * dt + crow(4 * q4 + 0, hi)] = f2bf(s4.x); dst[32 * dt + crow(4 * q4 + 1, hi)] = f2bf(s4.y); dst[32 * dt + crow(4 * q4 + 2, hi)] = f2bf(s4.z); dst[32 * dt + crow(4 * q4 + 3, hi)] = f2bf(s4.w); } }
}

#define SEQ 16384
#define DEPTH 4

__device__ __forceinline__ int n2o(int n) {
  if (n < 1280) return n;
  if (n < 2304) return n - 1280 + 1816;
  if (n < 2816) return n - 2304 + 3360;
  if (n < 3072) return n - 2816 + 3872;
  if (n < 4608) return n - 3072 + 4640;
  if (n < 5632) return n - 4608 + 6176;
  if (n < 5888) return n - 5632 + 7712;
  n -= 5888;
  if (n < 512) return 1304 + n;
  if (n < 1024) return 2848 + n - 512;
  if (n < 1536) return 4128 + n - 1024;
  if (n < 2048) return 7200 + n - 1536;
  if (n < 2304) return 7968 + n - 2048;
  n -= 2304;
  if (n < 24) return 1280 + n;
  if (n < 32) return 2840 + n - 24;
  return -1;
}

template <bool MAP>
__device__ __forceinline__ void cvt_tile(const float* __restrict__ src, int lds_, unsigned short* __restrict__ dst, int ldd, int k0, int n0, float* tile  ) {
  int tid = threadIdx.x; asm volatile("" : "+v"(tid));
  __syncthreads();
#pragma unroll
  for (int e = 0; e < 16; ++e) { int idx = tid + 256 * e, kk = idx >> 6, nn = idx & 63; int oc = MAP ? n2o(n0 + nn) : (n0 + nn);
    tile[kk * 65 + nn] = (oc >= 0) ? src[(long)(k0 + kk) * lds_ + oc] : 0.f; }
  __syncthreads();
#pragma unroll
  for (int e = 0; e < 16; ++e) { int idx = tid + 256 * e, nn = idx >> 6, kk = idx & 63; dst[(long)(n0 + nn) * ldd + k0 + kk] = f2bf(tile[kk * 65 + nn]); }
}

__device__ __forceinline__ float wave_sum(float v) {
#pragma unroll
  for (int o = 32; o > 0; o >>= 1) v += __shfl_xor(v, o);
  return v;
}

__device__ __forceinline__ void norm_row_wave(const Params& p, int layer, int t, bool do_h, int lane) {
  const float* xin = (layer == 0) ? p.x + (long)t * DM : p.out + (long)t * DM;
  float4 xv[4], yv[4];
#pragma unroll
  for (int i = 0; i < 4; ++i) xv[i] = *(const float4*)(xin + i * 256 + lane * 4);
  if (layer > 0) {
    float ss = 0.f;
#pragma unroll
    for (int i = 0; i < 4; ++i) { yv[i] = *(const float4*)(p.y + (long)t * DM + i * 256 + lane * 4); ss += yv[i].x * yv[i].x + yv[i].y * yv[i].y + yv[i].z * yv[i].z + yv[i].w * yv[i].w; }
    ss = wave_sum(ss); float r1 = 1.f / sqrtf(ss / DM + 1e-6f);
#pragma unroll
    for (int i = 0; i < 4; ++i) { float4 w = *(const float4*)(p.post_norm + (layer - 1) * DM + i * 256 + lane * 4);
      xv[i].x += yv[i].x * r1 * w.x; xv[i].y += yv[i].y * r1 * w.y; xv[i].z += yv[i].z * r1 * w.z; xv[i].w += yv[i].w * r1 * w.w; }
  }
  float ss2 = 0.f;
#pragma unroll
  for (int i = 0; i < 4; ++i) { *(float4*)(p.out + (long)t * DM + i * 256 + lane * 4) = xv[i]; ss2 += xv[i].x * xv[i].x + xv[i].y * xv[i].y + xv[i].z * xv[i].z + xv[i].w * xv[i].w; }
  if (!do_h) return;
  ss2 = wave_sum(ss2); float r2 = 1.f / sqrtf(ss2 / DM + 1e-6f);
#pragma unroll
  for (int i = 0; i < 4; ++i) { float4 w = *(const float4*)(p.pre_norm + layer * DM + i * 256 + lane * 4);
    ushort4 o; o.x = f2bf(xv[i].x * r2 * w.x); o.y = f2bf(xv[i].y * r2 * w.y); o.z = f2bf(xv[i].z * r2 * w.z); o.w = f2bf(xv[i].w * r2 * w.w);
    *(ushort4*)(p.h + (long)t * DM + i * 256 + lane * 4) = o; }
}

#ifndef GMI
#define GMI 4
#endif
struct GemmSmem { unsigned short a[3][64 * GMI * 32]; unsigned short b[3][128 * 32]; };
__device__ __forceinline__ void glds16(const void* g, void* lds_wave_base) { __builtin_amdgcn_global_load_lds((gptr_t)g, (lptr_t)lds_wave_base, 16, 0, 0); }
template <int EPI, int MI, bool DRY = false>
__device__ __forceinline__ void gemm_tile(const Params& p, const unsigned short* __restrict__ A, int lda, const unsigned short* __restrict__ Bt, int ldb, int K, int m0, int n0, GemmSmem& sm, float* outp = nullptr) {
  int tid = threadIdx.x; asm volatile("" : "+v"(tid));
  const int lane = tid & 63, wid = __builtin_amdgcn_readfirstlane(tid >> 6), wr = wid >> 1, wc = wid & 1, r = lane & 31, h = lane >> 5;
  f32x16 acc[MI][2];
#pragma unroll
  for (int i = 0; i < MI; ++i)
#pragma unroll
    for (int j = 0; j < 2; ++j) acc[i][j] = zero16();
  const int prow = lane >> 2, pc = lane & 3;
  const unsigned short* ga[MI]; const unsigned short* gb[2];
#pragma unroll
  for (int i = 0; i < MI; ++i) { const int row = (wid * MI + i) * 16 + prow; ga[i] = A + (long)(m0 + row) * lda + ((pc ^ ((row >> 2) & 3)) * 8); }
#pragma unroll
  for (int i = 0; i < 2; ++i) { const int row = (wid * 2 + i) * 16 + prow; gb[i] = Bt + (long)(n0 + row) * ldb + ((pc ^ ((row >> 2) & 3)) * 8); }
#define GEMM_DMA(stg, ko) { _Pragma("unroll") for (int i_ = 0; i_ < MI; ++i_) glds16(ga[i_] + (ko), &sm.a[stg][(wid * MI + i_) * 512]); _Pragma("unroll") for (int i_ = 0; i_ < 2; ++i_) glds16(gb[i_] + (ko), &sm.b[stg][(wid * 2 + i_) * 512]); }
  __syncthreads();
  const int nk = K / 32;
  GEMM_DMA(0, 0)
  if (nk > 1) GEMM_DMA(1, 32)
  int cur = 0;
  for (int kt = 0; kt < nk; ++kt) {
    if (kt + 1 < nk) { if (MI == 4) asm volatile("s_waitcnt vmcnt(6) lgkmcnt(0)\n\ts_barrier" ::: "memory"); else asm volatile("s_waitcnt vmcnt(4) lgkmcnt(0)\n\ts_barrier" ::: "memory"); }
    else asm volatile("s_waitcnt vmcnt(0) lgkmcnt(0)\n\ts_barrier" ::: "memory");
    if (kt + 2 < nk) { const int s2_ = (cur == 0) ? 2 : cur - 1; GEMM_DMA(s2_, (kt + 2) * 32) }
#pragma unroll
    for (int ks = 0; ks < 2; ++ks) {
      bf16x8 af[MI], bfr[2];
#pragma unroll
      for (int i = 0; i < MI; ++i) { const int row = wr * (32 * MI) + i * 32 + r; af[i] = *(const bf16x8*)&sm.a[cur][row * 32 + (((2 * ks + h) ^ ((row >> 2) & 3)) * 8)]; }
#pragma unroll
      for (int j = 0; j < 2; ++j) { const int row = wc * 64 + j * 32 + r; bfr[j] = *(const bf16x8*)&sm.b[cur][row * 32 + (((2 * ks + h) ^ ((row >> 2) & 3)) * 8)]; }
#pragma unroll
      for (int i = 0; i < MI; ++i)
#pragma unroll
        for (int j = 0; j < 2; ++j) acc[i][j] = __builtin_amdgcn_mfma_f32_32x32x16_bf16(af[i], bfr[j], acc[i][j], 0, 0, 0);
    }
    cur = (cur == 2) ? 0 : cur + 1;
  }
#undef GEMM_DMA
  __syncthreads();
  if (DRY) {
#pragma unroll
    for (int i = 0; i < MI; ++i) asm volatile("" :: "v"(acc[i][0]), "v"(acc[i][1]));
    return; }
  const int ncol0 = n0 + wc * 64;
  const int mrow0 = m0 + wr * (32 * MI);
  if (EPI == 2) {
#pragma unroll
    for (int i = 0; i < MI; ++i)
#pragma unroll
      for (int j = 0; j < 2; ++j)
#pragma unroll
        for (int e = 0; e < 16; ++e) { int row = mrow0 + i * 32 + (e & 3) + 8 * (e >> 2) + 4 * h; outp[row * 128 + ncol0 + j * 32 + r] = acc[i][j][e]; }
  } else if (EPI == 1) {
#pragma unroll
    for (int i = 0; i < MI; ++i)
#pragma unroll
      for (int j = 0; j < 2; ++j)
#pragma unroll
        for (int e = 0; e < 16; ++e) { int row = mrow0 + i * 32 + (e & 3) + 8 * (e >> 2) + 4 * h; p.y[(long)row * DM + ncol0 + j * 32 + r] = acc[i][j][e]; }
  } else {
    if (ncol0 < 8192) {
      const bool toproj = ncol0 < NPROJ; const bool rope = toproj && (ncol0 >= PC_Q && ncol0 < PC_KV + 128);
      unsigned short* stg = ((unsigned short*)&sm) + wid * (64 * 72);
      SB* gdst = toproj ? (p.proj + ncol0) : (p.mix + (ncol0 - NPROJ)); const long gld = toproj ? NPROJ : NMIX;
#pragma unroll
      for (int hf = 0; hf < MI / 2; ++hf) {
#pragma unroll
        for (int i2 = 0; i2 < 2; ++i2) { const int i = hf * 2 + i2;
#pragma unroll
          for (int e = 0; e < 16; ++e) { const int rl = i2 * 32 + (e & 3) + 8 * (e >> 2) + 4 * h; float v0 = acc[i][0][e], v1 = acc[i][1][e];
            if (rope) { const int row = mrow0 + hf * 64 + rl; const float c = p.rope_cs[row * 32 + r], s = p.rope_sn[row * 32 + r]; const float t1 = v0, t2 = v1; v0 = t1 * c - t2 * s; v1 = t2 * c + t1 * s; }
            if (!toproj) { v0 = silu_f(v0); v1 = silu_f(v1); }
            stg[rl * 72 + r] = f2bf(v0); stg[rl * 72 + 32 + r] = f2bf(v1); } }
#pragma unroll
        for (int c8 = 0; c8 < 8; ++c8) { const int idx = lane + 64 * c8, rl = idx >> 3, ch = idx & 7; const uint4 vv = *(const uint4*)&stg[rl * 72 + ch * 8];
          *(uint4*)(gdst + (long)(mrow0 + hf * 64 + rl) * gld + ch * 8) = vv; }
      }
    } else if (ncol0 == 8192) {
#pragma unroll
      for (int i = 0; i < MI; ++i)
#pragma unroll
        for (int e = 0; e < 16; ++e) { int row = mrow0 + i * 32 + (e & 3) + 8 * (e >> 2) + 4 * h; p.small[(long)row * NSMALL + r] = acc[i][0][e]; }
    }
  }
}

__device__ __forceinline__ unsigned tx_() { unsigned t = threadIdx.x; asm volatile("" : "+v"(t)); return t; }
__device__ __forceinline__ int gw0(int) { return (int)((blockIdx.x * 256u + tx_()) >> 6); }
__device__ __forceinline__ int bid0() { int b = blockIdx.x; asm volatile("" : "+s"(b)); return b; }

#define XB_TMO      128
#define XB_XCNT(j)  (256  + 64 * (j))
#define XB_XSUB(j)  (1280 + 64 * (j))
#define XB_XGEN(j)  (2304 + 64 * (j))
#define XB_TOP      3328
#define XB_TOPGEN   3392
#define XCD_BAR_WORDS 3456
#define XB_SPIN_CAP (1u << 28)
__device__ __forceinline__ unsigned xb_ld(unsigned* p) { return __hip_atomic_load(p, __ATOMIC_RELAXED, __HIP_MEMORY_SCOPE_AGENT); }
__device__ __forceinline__ unsigned xb_add(unsigned* p, unsigned v) { return __hip_atomic_fetch_add(p, v, __ATOMIC_RELAXED, __HIP_MEMORY_SCOPE_AGENT); }
__device__ __forceinline__ unsigned xb_xcc_id() { return (unsigned)__builtin_amdgcn_s_getreg((3 << 11) | 20) & 0xFu; }
#define XB_SPIN(cond, bar) do { unsigned _sp = 0; while (cond) { __builtin_amdgcn_s_sleep(1); \
    if ((++_sp & 255u) == 0u) { if (xb_ld(&(bar)[XB_TMO])) break; if (_sp > XB_SPIN_CAP) { atomicAdd(&(bar)[XB_TMO], 1u); break; } } } } while (0)
struct XcdBarrier { unsigned* bar; unsigned x; volatile LDS3 unsigned* st; };
__device__ __forceinline__ XcdBarrier xcd_barrier_post(unsigned* bar, volatile LDS3 unsigned* st) {
  XcdBarrier b; b.bar = bar; b.x = xb_xcc_id(); b.st = st;
  if (threadIdx.x == 0) (void)xb_add(&bar[XB_XCNT(b.x)], 1u);
  return b;
}
__device__ __forceinline__ void xcd_barrier_complete(unsigned* bar, unsigned x, unsigned& nloc, unsigned& nx) {
  const unsigned G = gridDim.x; unsigned sum, cnt, mine, sp = 0u;
  for (;;) { sum = 0u; cnt = 0u; mine = 0u;
#pragma unroll
    for (unsigned j = 0; j < 16; ++j) { const unsigned c = xb_ld(&bar[XB_XCNT(j)]); sum += c; cnt += (c > 0u) ? 1u : 0u; mine = (j == x) ? c : mine; }
    if (sum == G) break;
    __builtin_amdgcn_s_sleep(1);
    if ((++sp & 255u) == 0u) { if (xb_ld(&bar[XB_TMO])) break; if (sp > XB_SPIN_CAP) { atomicAdd(&bar[XB_TMO], 1u); break; } } }
  nloc = mine > 0u ? mine : 1u; nx = cnt > 0u ? cnt : 1u;
}
__device__ __forceinline__ void xcd_barrier(const XcdBarrier& b) {
  asm volatile("s_waitcnt vmcnt(0)" ::: "memory");
  __syncthreads();
  if (threadIdx.x == 0) {
    unsigned* bar = b.bar;
    __builtin_amdgcn_s_waitcnt(0);
    unsigned nloc = b.st[0], nx = b.st[1];
    if (nloc == 0u) { xcd_barrier_complete(bar, b.x, nloc, nx); b.st[0] = nloc; b.st[1] = nx; }
    const unsigned old = xb_add(&bar[XB_XSUB(b.x)], 1u);
    const unsigned gen = old / nloc;
    if (old + 1u == (gen + 1u) * nloc) {
      __builtin_amdgcn_fence(__ATOMIC_RELEASE, "agent");
      asm volatile("s_waitcnt vmcnt(0)" ::: "memory");
      const unsigned og = xb_add(&bar[XB_TOP], 1u);
      const unsigned tg = og / nx;
      if (og + 1u == (tg + 1u) * nx) xb_add(&bar[XB_TOPGEN], 1u);
      else XB_SPIN(xb_ld(&bar[XB_TOPGEN]) == tg, bar);
      __builtin_amdgcn_fence(__ATOMIC_ACQUIRE, "agent");
      xb_add(&bar[XB_XGEN(b.x)], 1u);
      asm volatile("s_waitcnt vmcnt(0)" ::: "memory");
    } else {
      XB_SPIN(xb_ld(&bar[XB_XGEN(b.x)]) == gen, bar);
      __builtin_amdgcn_fence(__ATOMIC_ACQUIRE, "agent");
      asm volatile("s_waitcnt vmcnt(0)" ::: "memory");
    }
  }
  __syncthreads();
}

struct KArgs { const void* in[20]; float* out; char* ws; };
#ifdef SELFCHK
#define RUN_S 4096
#else
#define RUN_S SEQ
#endif
__host__ __device__ __forceinline__ size_t fill_ws(Params& p, Params& p2, char* w) {
  size_t off = 0;
#define TAKE(bytes) (w + ((off += (((size_t)(bytes)) + 255) & ~(size_t)255) - ((((size_t)(bytes)) + 255) & ~(size_t)255)))
  const size_t S = RUN_S, ncmp = S / 16, nc = S / 128;
  p.S = RUN_S;
  p.wt_in = (unsigned short*)TAKE(8320 * 1024 * 2); p.wt_out = (unsigned short*)TAKE(2 * 1024 * 2304 * 2); p.w1t = (unsigned short*)TAKE(2 * 128 * 2048 * 2); p.w2t = (unsigned short*)TAKE(2 * 64 * 128 * 2);
  p.h = (SB*)TAKE(S * 1024 * 2); p.ybuf = (float*)p.h;
  p.proj = (SB*)TAKE(S * NPROJ * 2); p.y = (float*)p.proj;
  p.small = (float*)TAKE(S * 32 * 4); p.mix = (SB*)TAKE(S * NMIX * 2);
  p.rope_cs = (float*)TAKE(S * 32 * 4); p.rope_sn = (float*)TAKE(S * 32 * 4); p.tabA = (float*)TAKE(8 * TABA_N * 4); p.tabD = (float*)TAKE(24 * TABD_N * 4);
  p.memkv = (SB*)TAKE(4 * 256 * 512 * 2); p.hid = (float*)TAKE(2 * ncmp * 256 * 4); p.kvc = (SB*)TAKE(2 * ncmp * 128 * 2);
  p.cml = (float*)TAKE(S * 16 * 4); p.idx = (int*)TAKE(S * 32 * 4); p.oc = (SB*)TAKE(S * 512 * 2); p.ow = (SB*)TAKE(S * 512 * 2);
  p.dop = (SB*)TAKE(3 * S * 512 * 2); p.dlse = (float*)TAKE(3 * S * 8 * 4); p.xconv = (SB*)TAKE(S * 1024 * 2);
  p.dt = (float*)TAKE(S * 8 * 4); p.acs = (float*)TAKE(S * 8 * 4); p.wst = (float*)TAKE(S * 8 * 4); p.cb = (float*)TAKE(nc * 2 * 128 * 128 * 4); p.states = (float*)TAKE(nc * 65536 * 4);
  p.bar = (unsigned*)TAKE(131072);
  p2 = p;
#ifdef SELFCHK
  p.imp = (float*)TAKE(S * 512 * 4);
  p2.mix = (SB*)TAKE(S * NMIX * 2); p2.ow = (SB*)TAKE(S * 512 * 2); p2.oc = (SB*)TAKE(S * 512 * 2); p2.dop = (SB*)TAKE(3 * S * 512 * 2); p2.dlse = (float*)TAKE(3 * S * 8 * 4);
  p2.cml = (float*)TAKE(S * 16 * 4); p2.imp = (float*)TAKE(S * 512 * 4); p2.idx = (int*)TAKE(S * 32 * 4); p2.cb = (float*)TAKE(nc * 2 * 128 * 128 * 4);
  p2.kvc = (SB*)TAKE(2 * ncmp * 128 * 2); p2.xconv = (SB*)TAKE(S * 1024 * 2); p2.dt = (float*)TAKE(S * 8 * 4); p2.acs = (float*)TAKE(S * 8 * 4); p2.wst = (float*)TAKE(S * 8 * 4);
  p2.states = (float*)TAKE(nc * 65536 * 4); p2.ybuf = (float*)TAKE(S * 512 * 4); p.ybuf = (float*)TAKE(S * 512 * 4);
#else
  p.imp = (float*)p.dop; p2 = p;
#endif
  return off;
}
__host__ __device__ __forceinline__ void fill_inputs(Params& p, const KArgs& a) {
  p.x = (const float*)a.in[0]; p.mem = (const float*)a.in[1]; p.pos = (const int*)a.in[2]; p.pre_norm = (const float*)a.in[3]; p.post_norm = (const float*)a.in[4];
  p.w_in = (const float*)a.in[5]; p.w_out = (const float*)a.in[6]; p.rel_bias = (const float*)a.in[7]; p.cmp_pos = (const float*)a.in[8]; p.cmp_w1 = (const float*)a.in[9];
  p.cmp_w2 = (const float*)a.in[10]; p.conv_w = (const float*)a.in[11]; p.conv_b = (const float*)a.in[12]; p.dt_bias = (const float*)a.in[13]; p.a_log = (const float*)a.in[14];
  p.b_d = (const float*)a.in[15]; p.b_norm = (const float*)a.in[16]; p.sinks = (const float*)a.in[17]; p.m_norm = (const float*)a.in[18]; p.m_wkv = (const float*)a.in[19];
  p.out = a.out;
}
#define GS(N, ...) { long g0_ = (long)blockIdx.x * 256 + tx_(); for (long gid = g0_; gid < (long)(N); gid += gsz) { __VA_ARGS__; } }
#define WU(N, ...) { for (int u_ = gw0(gwave); u_ < (int)(N); u_ += nwave) { const int u = __builtin_amdgcn_readfirstlane(u_); const unsigned tq_ = tx_(); int lane = tq_ & 63; \
    WaveLds* WL = ((WaveLds*)smem_raw) + __builtin_amdgcn_readfirstlane((int)(tq_ >> 6)); __VA_ARGS__; } }
#define GSYNC() xcd_barrier(xb)
#ifndef CMP_SKIP
#define CMP_SKIP 3
#endif
#define WUQ(slot, N, ...) { unsigned* cq_ = &p.bar[4096 + (layer * 8 + (slot)) * 64 * 8 + (blockIdx.x & 7) * 64]; for (;;) { unsigned t_ = 0u; if ((threadIdx.x & 63) == 0) t_ = atomicAdd(cq_, 1u); \
    const int u = __builtin_amdgcn_readfirstlane((int)t_) * 8 + (int)(blockIdx.x & 7); if (u >= (int)(N)) break; int lane = threadIdx.x & 63; asm volatile("" : "+v"(lane)); \
    WaveLds* WL = ((WaveLds*)smem_raw) + __builtin_amdgcn_readfirstlane((int)(threadIdx.x >> 6)); WaveLds2* WL2 = (WaveLds2*)WL; (void)WL2; __VA_ARGS__; } }
#define SMEM_BYTES (sizeof(AselLds) > sizeof(GemmSmem) ? ((sizeof(AselLds) + 15) & ~(size_t)15) : sizeof(GemmSmem))
#define gtid ((long)blockIdx.x * 256 + tx_())
#define gwave ((int)((blockIdx.x * 256u + tx_()) >> 6))
#define KERNEL_PROLOGUE \
  Params p, p2; p.pad0 = 0; fill_inputs(p, ka); fill_ws(p, p2, ka.ws); \
  cg::grid_group grid = cg::this_grid(); \
  __shared__ __attribute__((aligned(16))) char smem_raw[SMEM_BYTES + 16]; \
  volatile LDS3 unsigned* xbst = (volatile LDS3 unsigned*)(smem_raw + SMEM_BYTES); \
  if (threadIdx.x < 4) xbst[threadIdx.x] = 0u; \
  __syncthreads(); \
  XcdBarrier xb = xcd_barrier_post(p.bar, xbst); \
  GemmSmem& gsm = *(GemmSmem*)smem_raw; float* ftile = (float*)smem_raw; \
  const long gsz = (long)gridDim.x * 256; const int nwave = (int)(gsz >> 6); \
  const int S = p.S, ncmp = S / 16, nc = S / 128, nqt = S / 32; (void)ncmp; (void)nc; (void)nqt; (void)ftile; (void)gsm; \
  GS((long)S * 32, ph_rope(p, gid)); \
  GS(8 * TABA_N + 24 * TABD_N, ph_tabs(p, gid)); \
  WU(DEPTH * 256, unit_memkv(p, u, lane));
#define PHASE_NORM(layer) \
    for (int t = gw0(gwave); t < S; t += nwave) { int lane = tx_() & 63; norm_row_wave(p, layer, t, true, lane); }
#define PHASE_CVT(layer) \
    { const float* wi = p.w_in + (long)(layer) * 1024 * 8224; unsigned short* wob_ = p.wt_out + (long)((layer) & 1) * 1024 * 2304; \
      for (int tl = bid0(); tl < 16 * 130; tl += gridDim.x) cvt_tile<true>(wi, 8224, p.wt_in, 1024, (tl & 15) * 64, (tl >> 4) * 64, ftile); \
      const float* wo = p.w_out + (long)(layer) * 2304 * 1024; \
      for (int tl = bid0(); tl < 36 * 16; tl += gridDim.x) cvt_tile<false>(wo, 1024, wob_, 2304, (tl % 36) * 64, (tl / 36) * 64, ftile); \
      for (int tl = bid0(); tl < 2 * 64; tl += gridDim.x) { const int kv = tl >> 6, t6 = tl & 63; cvt_tile<false>(p.cmp_w1 + (long)((layer) * 2 + kv) * 2048 * 128, 128, p.w1t + (long)kv * 128 * 2048, 2048, (t6 >> 1) * 64, (t6 & 1) * 64, ftile); } \
      for (int tl = bid0(); tl < 2 * 2; tl += gridDim.x) { const int kv = tl >> 1; cvt_tile<false>(p.cmp_w2 + (long)((layer) * 2 + kv) * 128 * 64, 64, p.w2t + (long)kv * 64 * 128, 128, (tl & 1) * 64, 0, ftile); } }
#define PHASE_P1(layer) PHASE_NORM(layer) PHASE_CVT(layer)
#define PHASE_P2() \
    {   \
      const int x_ = bid0() & 7, li_ = bid0() >> 3, nl_ = (gridDim.x + 7) >> 3, mtiles_ = S / (64 * GMI), mper_ = mtiles_ / 8; \
      if ((mper_ & 7) != 0 || (gridDim.x & 7) != 0) { for (int tl = bid0(); tl < mtiles_ * 65; tl += gridDim.x) { int mt = tl % mtiles_, nt = tl / mtiles_; gemm_tile<0, GMI>(p, p.h, DM, p.wt_in, DM, DM, mt * 64 * GMI, nt * 128, gsm); } } \
      else for (int t_ = li_; t_ < mper_ * 65; t_ += nl_) { const int half_ = t_ / 520, r_ = t_ % 520; int ml_, nt_; \
        if (r_ < 512) { ml_ = r_ & 7; nt_ = (r_ >> 6) * 8 + ((r_ & 63) >> 3); } else { ml_ = r_ - 512; nt_ = 64; } \
        gemm_tile<0, GMI>(p, p.h, DM, p.wt_in, DM, DM, (x_ * mper_ + half_ * 8 + ml_) * 64 * GMI, nt_ * 128, gsm); } }
#define PHASE_FLASH3(layer) \
    { const int nA = nqt * 8, nM = nqt * 4, nD = 3 * nqt * 8, nC = nqt * 8; \
      WU(nA + nM + nD + nC, { if (u < nA) unit_awin(p, u, WL, lane); else if (u < nA + nM) unit_m(p, layer, u - nA, WL, lane); \
                              else if (u < nA + nM + nD) unit_d(p, u - nA - nM, WL, lane); else unit_c(p, layer, u - nA - nM - nD, WL, lane); }); }
#define WU2(N, ...) { for (int u_ = gw0(gwave); u_ < (int)(N); u_ += nwave) { const int u = __builtin_amdgcn_readfirstlane(u_); const unsigned tq_ = tx_(); int lane = tq_ & 63; \
    WaveLds2* WL2 = ((WaveLds2*)smem_raw) + __builtin_amdgcn_readfirstlane((int)(tq_ >> 6)); __VA_ARGS__; } }
#define PHASE_CB() \
    for (int tl = bid0(); tl < nc * 2; tl += gridDim.x) { const SB* xb_ = p.xconv + (long)(tl >> 1) * 128 * 1024 + (tl & 1) * 128; gemm_tile<2, 2>(p, xb_ + 768, 1024, xb_ + 512, 1024, 128, 0, 0, gsm, p.cb + (long)tl * 16384); }

#ifndef SELFCHK
#define PH_BEGIN { char* wsb_ = ka.ws; asm volatile("" : "+s"(wsb_)); Params p, p2_; p.pad0 = 0; fill_inputs(p, ka); fill_ws(p, p2_, wsb_); (void)p2_;
#define PH_END }
__global__ void __launch_bounds__(256, LB2) mega(KArgs ka) {
  KERNEL_PROLOGUE
#ifdef REP_PRO
  GS((long)S * 32, ph_rope(p, gid)); GS(8 * TABA_N + 24 * TABD_N, ph_tabs(p, gid)); WU(DEPTH * 256, unit_memkv(p, u, lane));
#endif
#ifdef TSEL
  unsigned long long tlast = __builtin_amdgcn_s_memrealtime();
#define TMARK(id) { if (gtid == 0) { const unsigned long long tn = __builtin_amdgcn_s_memrealtime(); ((unsigned long long*)p.bar)[id] += tn - tlast; tlast = tn; } }
#else
#define TMARK(id)
#endif
  for (int layer = 0; layer < DEPTH; ++layer) {
    PH_BEGIN
    PHASE_P1(layer)
#ifdef REP_P1
    PHASE_P1(layer)
#endif
    PH_END
    if (layer == 0) grid.sync(); else GSYNC();
    PH_BEGIN
    TMARK(1)
    PHASE_P2()
#ifdef REP_G
    PHASE_P2()
#endif
#ifdef REP_G2
    { const int x_ = bid0() & 7, li_ = bid0() >> 3, nl_ = (gridDim.x + 7) >> 3; for (int t_ = li_; t_ < 520; t_ += nl_) { int ml_, nt_; if (t_ < 512) { ml_ = t_ & 7; nt_ = (t_ >> 6) * 8 + ((t_ & 63) >> 3); } else { ml_ = t_ - 512; nt_ = 64; }
        gemm_tile<0, GMI, true>(p, p.h, DM, p.wt_in, DM, DM, (x_ * 8 + ml_) * 64 * GMI, nt_ * 128, gsm); } }
#endif
    PH_END
    GSYNC();
    PH_BEGIN
    TMARK(2)
    { const int nCmp = 2 * (ncmp * 2 / 32), nA = nqt * 8, nM = nqt * 4, nD = 3 * nqt * 8, nC = nqt * 8, nF = nA + nM + nD + nC;
      const int cb0 = (int)gridDim.x - nCmp; const bool cmpw = ((int)blockIdx.x >= cb0) && (cb0 > 0); const int cw0 = cb0 * 4;
#define FLASH_UNIT(uu) {   \
        const int v_ = __builtin_amdgcn_readfirstlane(uu); const int gw_ = v_ % nwave, rr_ = v_ / nwave; const int x_ = (gw_ >> 2) & 7, lw_ = ((gw_ >> 5) << 2) | (gw_ & 3); int j_ = rr_ * (nwave >> 3) + lw_; \
        const unsigned tq_ = tx_(); int lane = tq_ & 63; WaveLds* WL = ((WaveLds*)smem_raw) + __builtin_amdgcn_readfirstlane((int)(tq_ >> 6)); \
        if ((nwave & 31) != 0) { const int u = v_; if (u < nA) unit_awin(p, u, WL, lane); else if (u < nA + nM) unit_m(p, layer, u - nA, WL, lane); else if (u < nA + nM + nD) unit_d(p, u - nA - nM, WL, lane); else unit_c(p, layer, u - nA - nM - nD, WL, lane); } \
        else if (j_ < nA / 8) unit_awin(p, x_ * (nA / 8) + j_, WL, lane); \
        else if ((j_ -= nA / 8) < nM / 8) unit_m(p, layer, x_ * (nM / 8) + j_, WL, lane); \
        else if ((j_ -= nM / 8) < nD / 24) unit_d(p, x_ * (nD / 24) + j_, WL, lane); \
        else if ((j_ -= nD / 24) < nD / 24) unit_d(p, nD / 3 + x_ * (nD / 24) + j_, WL, lane); \
        else if ((j_ -= nD / 24) < nD / 24) unit_d(p, 2 * (nD / 3) + x_ * (nD / 24) + j_, WL, lane); \
        else if ((j_ -= nD / 24) < nC / 8) unit_c(p, layer, x_ * (nC / 8) + j_, WL, lane); }
      if (cb0 <= 0) { for (int ub = bid0(); ub < nCmp; ub += gridDim.x) unit_cmp_blk(p, layer, ub, (float*)smem_raw); __syncthreads(); }
      else if (cmpw) { unit_cmp_blk(p, layer, (int)blockIdx.x - cb0, (float*)smem_raw); __syncthreads(); }
      for (int r_ = (cmpw ? CMP_SKIP : 0), u_ = gw0(gwave) + r_ * nwave; u_ < nF; u_ += nwave) FLASH_UNIT(u_)
      if (cb0 > 0 && gwave < CMP_SKIP * nCmp * 4) { const int u_ = (gwave / (nCmp * 4)) * nwave + cw0 + (gwave % (nCmp * 4)); if (u_ < nF) FLASH_UNIT(u_) }
#undef FLASH_UNIT
    }
    GS((long)S * 128, item_bconv(p, layer, gid));
    WU(nc * 8, unit_bdt(p, layer, u, lane));
    PH_END
    GSYNC();
    PH_BEGIN
    TMARK(3)
    WU(nqt * 8, unit_acmp1(p, u, WL, lane));
    __syncthreads();
    PHASE_CB()
    __syncthreads();
    WU2(nc * 16, unit_bstates(p, u, WL2, lane));
#ifdef REP_P4
    __syncthreads();
    WU(nqt * 8, unit_acmp1(p, u, WL, lane));
    __syncthreads();
    PHASE_CB()
    __syncthreads();
    WU2(nc * 16, unit_bstates(p, u, WL2, lane));
#endif
    GS((long)S * 64, item_dmerge(p, gid));
    PH_END
    GSYNC();
    PH_BEGIN
    TMARK(4)
    WU(nqt * 8, unit_acmp2(p, u, lane));
#ifdef REP_P5A
    WU(nqt * 8, unit_acmp2(p, u, lane));
#endif
    GS(65536, ph_b_scan(p, gid));
    PH_END
    GSYNC();
    PH_BEGIN
    TMARK(5)
    for (int ub = bid0(); ub < nc * 8; ub += gridDim.x) unit_bout_blk(p, layer, ub, smem_raw);
    TMARK(7)
    for (;;) { __syncthreads(); if (threadIdx.x == 0) xbst[2] = atomicAdd(&p.bar[48 + layer * 8 + 6], 1u); __syncthreads(); const int ub = (int)xbst[2]; if (ub >= (S / 32) * 2) break; unit_asel_blk(p, ub, (AselLds*)smem_raw); }
    PH_END
    GSYNC();
    PH_BEGIN
    TMARK(8)
    for (int tl = bid0(); tl < (S / (64 * GMI)) * 8; tl += gridDim.x) { int mt = tl >> 3, nt = tl & 7; gemm_tile<1, GMI>(p, p.mix, NMIX, p.wt_out + (long)(layer & 1) * 1024 * 2304, NMIX, NMIX, mt * 64 * GMI, nt * 128, gsm); }
#ifdef REP_P8
    for (int tl = bid0(); tl < (S / (64 * GMI)) * 8; tl += gridDim.x) { int mt = tl >> 3, nt = tl & 7; gemm_tile<1, GMI>(p, p.mix, NMIX, p.wt_out + (long)(layer & 1) * 1024 * 2304, NMIX, NMIX, mt * 64 * GMI, nt * 128, gsm); }
#endif
    PH_END
    GSYNC();
    PH_BEGIN
    TMARK(9)
    PH_END
  }
  for (int t = gw0(gwave); t < S; t += nwave) { int lane = tx_() & 63; norm_row_wave(p, DEPTH, t, false, lane); }
#ifdef TSEL
  GSYNC();
  { float best = -1.f; int bi = 0; for (int k = 1; k < 10; ++k) if (!((TSEL >> k) & 1)) { const float us = (float)((unsigned long long*)p.bar)[k] * 0.01f; if (us > best) { best = us; bi = k; } }
    const float kk = 10.f * (float)bi + floorf(log2f(best + 1.f));
    GS((long)S * 1024, p.out[gid] = kk); }
#endif
}
#else
__device__ __forceinline__ void chk_update(unsigned* slot, float diff, float ref) {
  atomicMax(&slot[0], __float_as_uint(fabsf(diff))); atomicMax(&slot[1], __float_as_uint(fabsf(ref)));
}
#define CMPB(slot, a, b_) chk_update(sl + (slot), bf2f(a) - bf2f(b_), bf2f(b_))
#define CMPF(slot, a, b_) chk_update(sl + (slot), (a) - (b_), (b_))
__global__ void __launch_bounds__(256, 1) mega(KArgs ka) {
  KERNEL_PROLOGUE
  if (gtid < 64) p.bar[gtid] = 0u;
  unsigned* sl = p.bar;
  const int layer = 0;
  PHASE_P1(layer)
  grid.sync();
  PHASE_P2()
  GSYNC();
  GS((long)S * NMIX, p2.mix[gid] = p.mix[gid]);
  GSYNC();
  PHASE_FLASH3(layer)
  __syncthreads();
  for (int ub = bid0(); ub < 2 * (ncmp * 2 / 32); ub += gridDim.x) unit_cmp_blk(p, layer, ub, (float*)smem_raw);
  __syncthreads();
  GS((long)S * 128, item_bconv(p, layer, gid));
  WU(nc * 8, unit_bdt(p, layer, u, lane));
  GS((long)2 * ncmp * 256, ph_cmp_hid(p2, layer, gid));
  GS((long)S * 8, ph_a_win(p2, gid));
  GS((long)S * 8, ph_c(p2, layer, gid));
  GS((long)3 * S * 8, ph_d(p2, gid));
  GS((long)S * 4, ph_m(p2, layer, gid));
  GS((long)S * 1024, ph_b_conv(p2, layer, gid));
  GS((long)nc * 8, ph_b_dt2(p2, layer, gid));
  GSYNC();
  GS((long)2 * ncmp * 128, ph_cmp_out(p2, layer, gid));
  GSYNC();
  GS((long)2 * ncmp * 128, CMPB(20, p.kvc[gid], p2.kvc[gid]));
  GS((long)S * 1024, CMPB(22, p.xconv[gid], p2.xconv[gid]));
  GS((long)S * 8, { CMPF(24, p.dt[gid], p2.dt[gid]); CMPF(24, p.acs[gid], p2.acs[gid]); CMPF(24, p.wst[gid], p2.wst[gid]); });
  GSYNC();
  GS((long)2 * ncmp * 128, p2.kvc[gid] = p.kvc[gid]);
  GS((long)S * 1024, p2.xconv[gid] = p.xconv[gid]);
  GS((long)S * 8, { p2.dt[gid] = p.dt[gid]; p2.acs[gid] = p.acs[gid]; p2.wst[gid] = p.wst[gid]; });
  GSYNC();
  WU(nqt * 8, unit_acmp1(p, u, WL, lane));
  __syncthreads();
  PHASE_CB()
  __syncthreads();
  WU2(nc * 16, unit_bstates(p, u, WL2, lane));
  GS((long)S * 8, ph_a_cmp1(p2, gid));
  GS((long)nc * 2 * 128 * 128, ph_b_cb(p2, gid));
  GS((long)nc * 65536, ph_b_states(p2, gid));
  GSYNC();
  WU(nqt * 8, unit_acmp2(p, u, lane));
  GS((long)S * 2, ph_a_cmp2(p2, gid));
  GS((long)nc * 65536, CMPF(26, p.states[gid], p2.states[gid]));
  GS((long)nc * 2 * 128 * 128, { int s_ = (int)(gid & 127), l_ = (int)((gid >> 7) & 127); if (s_ <= l_) CMPF(18, p.cb[gid], p2.cb[gid]); });
  GSYNC();
  GS(65536, ph_b_scan(p, gid));
  GS(65536, ph_b_scan(p2, gid));
  GS((long)S * 512, { CMPB(0, p.ow[gid], p2.ow[gid]); CMPB(2, p.oc[gid], p2.oc[gid]); long t = gid >> 9, c = gid & 511; CMPB(4, p.mix[t * NMIX + MX_C + c], p2.mix[t * NMIX + MX_C + c]);
                      if (c < 256) CMPB(6, p.mix[t * NMIX + MX_M + c], p2.mix[t * NMIX + MX_M + c]); });
  GS((long)3 * S * 512, CMPB(8, p.dop[gid], p2.dop[gid]));
  GS((long)3 * S * 8, chk_update(sl + 10, p.dlse[gid] - p2.dlse[gid], 1.f));
  GS((long)S * 2 * 256, { long qg = gid >> 8; int bb = (int)(gid & 255); int q = (int)(qg >> 1); if (bb <= (q >> 6)) CMPF(12, p.imp[gid], p2.imp[gid]); });
  GSYNC();
  GS((long)S * 512, p2.imp[gid] = p.imp[gid]);
  GSYNC();
  WU(S * 2 / 4, unit_topk4(p, u, lane));
  WU2(nc * 32, unit_bout(p, layer, u, WL2, lane));
  GS((long)S * 2, ph_a_topk(p2, gid));
  GS((long)S * 512, ph_b_out(p2, layer, gid));
  GSYNC();
  GS((long)S * 2, { int q = (int)(gid >> 1); int nv = (q >> 6) + 1; nv = nv > 16 ? 16 : nv; int bad = 0;
    for (int k = 0; k < 16; ++k) { int mine = p.idx[gid * 16 + k]; bool found = false; for (int k2 = 0; k2 < 16; ++k2) found |= (p2.idx[gid * 16 + k2] == mine); if (k < nv) bad += !found || mine < 0; else bad += (mine >= 0); }
    chk_update(sl + 14, (float)bad, 1.f); });
  GS((long)S * 512, CMPF(28, p.ybuf[gid], p2.ybuf[gid]));
  GSYNC();
  GS((long)S * 32, p2.idx[gid] = p.idx[gid]);
  GS((long)S * 512, p2.ybuf[gid] = p.ybuf[gid]);
  GSYNC();
  for (int ub = bid0(); ub < (S / 32) * 2; ub += gridDim.x) unit_asel_blk(p, ub, (AselLds*)smem_raw);
  for (;;) { __syncthreads(); if (threadIdx.x == 0) xbst[2] = atomicAdd(&p.bar[40 + layer], 1u); __syncthreads(); const int ub = (int)xbst[2]; if (ub >= nc * 8) break; unit_bout_blk(p, layer, ub, smem_raw); }
  GS((long)S * 8, ph_a_sel(p2, gid));
  GS((long)S * 2, ph_b_norm(p2, layer, gid));
  GSYNC();
  GS((long)S * 512, { long t = gid >> 9, c = gid & 511; CMPB(16, p.mix[t * NMIX + MX_A + c], p2.mix[t * NMIX + MX_A + c]); CMPB(30, p.mix[t * NMIX + MX_B + c], p2.mix[t * NMIX + MX_B + c]); });
  GSYNC();
  { float R = 0.f;
    for (int k = 0; k < 16; ++k) { float d = __uint_as_float(p.bar[2 * k]), r = __uint_as_float(p.bar[2 * k + 1]); float q = d / (r + 1e-20f); if (CHKSEL < 0 || CHKSEL == k) R = fmaxf(R, q); }
    GS((long)SEQ * 1024, p.out[gid] = 1e4f * R); }
}
#endif

__global__ void zz_tail_pad(float* o) { asm volatile(".rept 512\n\ts_nop 0\n\t.endr" ::: "memory"); if (o) o[0] = 0.f; }
__global__ void fill_code(float* o, float v, long n) { long i = blockIdx.x * 256L + threadIdx.x; if (i < n) o[i] = v; }
extern "C" void kernel_launch(void* const* d_in, const int* in_sizes, int n_in, void* d_out, int out_size, void* d_ws, size_t ws_size, hipStream_t stream) {
  KArgs ka; memset(&ka, 0, sizeof(ka));
  for (int i = 0; i < 20; ++i) ka.in[i] = d_in[i];
  ka.out = (float*)d_out; ka.ws = (char*)d_ws;
  Params hp, hp2; memset(&hp, 0, sizeof(hp)); const size_t need = fill_ws(hp, hp2, (char*)d_ws);
  if (need > ws_size) { fprintf(stderr, "workspace too small: need %zu have %zu\n", need, ws_size); return; }
  static int grid_blocks = 0;
  if (!grid_blocks) { int dev = 0, cus = 0, per_cu = 0; (void)hipGetDevice(&dev); (void)hipDeviceGetAttribute(&cus, hipDeviceAttributeMultiprocessorCount, dev);
    (void)hipOccupancyMaxActiveBlocksPerMultiprocessor(&per_cu, mega, 256, 0); if (per_cu > LB2) per_cu = LB2; if (per_cu < 1) per_cu = 1; grid_blocks = cus * per_cu; }
  (void)hipMemsetAsync(hp.bar, 0, 131072, stream);
  void* args[] = {&ka};
  hipError_t e = hipLaunchCooperativeKernel((void*)mega, dim3(grid_blocks), dim3(256), args, 0, stream);
  if (e != hipSuccess) { (void)hipGetLastError(); fill_code<<<(unsigned)(((long)SEQ * 1024 + 255) / 256), 256, 0, stream>>>((float*)d_out, 1000.f * (float)(int)e + (float)grid_blocks, (long)SEQ * 1024); }
}
```

```cpp
#include <hip/hip_runtime.h>
#include <hip/hip_cooperative_groups.h>
#include <cstdio>
#include <cstdint>
#include <cstring>
namespace cg = cooperative_groups;
#define HD_ __device__ __forceinline__
#ifndef CHKSEL
#define CHKSEL -1
#endif
#ifndef LB2
#define LB2 2
#endif
#ifndef HD_
#define HD_ inline
#endif
#ifdef SB_IS_FLOAT
typedef float SB;
HD_ float ldf(const SB* p) { return *p; }
HD_ void stf(SB* p, float v) { *p = v; }
#else
typedef unsigned short SB;
HD_ float bf2f(unsigned short b) { unsigned u = ((unsigned)b) << 16; float f; __builtin_memcpy(&f, &u, 4); return f; }
HD_ unsigned short f2bf(float f) { unsigned u; __builtin_memcpy(&u, &f, 4); u += 0x7fffu + ((u >> 16) & 1u); return (unsigned short)(u >> 16); }
HD_ float ldf(const SB* p) { return bf2f(*p); }
HD_ void stf(SB* p, float v) { *p = f2bf(v); }
#endif

#define DM 1024
#define NPROJ 5888
#define NMIX 2304
#define NSMALL 32
#define PA_Q 0
#define PA_KV 512
#define PB_X 1280
#define PC_Q 2304
#define PC_KV 2816
#define PD_Q 3072
#define PD_KV 4608
#define PM_Q 5632
#define MX_A 0
#define MX_B 512
#define MX_C 1024
#define MX_D 1536
#define MX_M 2048
#define TABA_N 2048
#define TABD_N 132

struct Params {
  int S; int pad0;
  const float *x, *mem; const int* pos;
  const float *pre_norm, *post_norm, *w_in, *w_out, *rel_bias, *cmp_pos, *cmp_w1, *cmp_w2, *conv_w, *conv_b, *dt_bias, *a_log, *b_d,
      *b_norm, *sinks, *m_norm, *m_wkv;
  float* out;
  unsigned short* wt_in;
  unsigned short* wt_out;
  unsigned short *w1t, *w2t;
  SB* h;
  SB* proj;
  float* small;
  SB* mix;
  float* y;
  float *rope_cs, *rope_sn;
  float *tabA, *tabD;
  SB* memkv;
  float* hid;
  SB* kvc;
  float* imp;
  float* cml;
  int* idx;
  SB *oc, *ow;
  SB* dop;
  float* dlse;
  SB* xconv;
  float *dt, *acs;
  float* wst;
  float* cb;
  float* states;
  float* ybuf;
  unsigned* bar;
};

HD_ float silu_f(float x) { return x / (1.f + expf(-x)); }
HD_ float sigmoid_f(float x) { return 1.f / (1.f + expf(-x)); }
HD_ float gelu_f(float x) { return 0.5f * x * (1.f + tanhf(0.7978845608028654f * (x + 0.044715f * x * x * x))); }
HD_ float softplus_f(float x) { return fmaxf(x, 0.f) + log1pf(expf(-fabsf(x))); }

HD_ int t5_bucket(int d) {
  if (d < 16) return d < 0 ? 0 : d;
  const int thr[15] = {22, 30, 40, 54, 73, 99, 134, 182, 246, 332, 450, 609, 825, 1117, 1513};
  int b = 16;
  for (int k = 0; k < 15; ++k) b += (d >= thr[k]) ? 1 : 0;
  return b;
}

HD_ void ph_rope(const Params& p, long gid) {
  int s = (int)(gid >> 5), i = (int)(gid & 31);
  float inv = powf(150000.f, -(float)i / 32.f);
  float ang = (float)p.pos[s] * inv;
  p.rope_cs[gid] = cosf(ang); p.rope_sn[gid] = sinf(ang);
}
HD_ void ph_tabs(const Params& p, long gid) {
  if (gid < 8 * TABA_N) { int h = (int)(gid / TABA_N), d = (int)(gid % TABA_N); p.tabA[gid] = p.rel_bias[t5_bucket(d) * 32 + h]; }
  else { long g2 = gid - 8 * TABA_N; int hh = (int)(g2 / TABD_N), d = (int)(g2 % TABD_N); int gi = hh >> 3;
    int dil = gi == 0 ? 1 : (gi == 1 ? 4 : 16); p.tabD[g2] = p.rel_bias[t5_bucket(d * dil) * 32 + 8 + hh]; }
}
HD_ void ph_memkv(const Params& p, long gid) {
  int e = (int)(gid & 511), m = (int)((gid >> 9) & 255), l = (int)(gid >> 17);
  const float* row = p.mem + (long)m * DM;
  float ss = 0.f; _Pragma("unroll 16") for (int d = 0; d < DM; ++d) ss += row[d] * row[d];
  float r = 1.f / sqrtf(ss / DM + 1e-6f);
  float acc = 0.f;
  _Pragma("unroll 16") for (int d = 0; d < DM; ++d) acc += row[d] * r * p.m_norm[l * DM + d] * p.m_wkv[((long)l * DM + d) * 512 + e];
  stf(&p.memkv[gid], acc);
}
HD_ void ph_norm_row(const Params& p, int layer, int t, bool do_h) {
  const float* xin = (layer == 0) ? p.x + (long)t * DM : p.out + (long)t * DM;
  float* xo = p.out + (long)t * DM;
  float r1 = 0.f;
  if (layer > 0) { const float* y = p.y + (long)t * DM; float ss = 0.f; for (int d = 0; d < DM; ++d) ss += y[d] * y[d]; r1 = 1.f / sqrtf(ss / DM + 1e-6f); }
  float ss2 = 0.f;
  for (int d = 0; d < DM; ++d) { float v = xin[d]; if (layer > 0) v += p.y[(long)t * DM + d] * r1 * p.post_norm[(layer - 1) * DM + d]; xo[d] = v; ss2 += v * v; }
  if (!do_h) return;
  float r2 = 1.f / sqrtf(ss2 / DM + 1e-6f);
  for (int d = 0; d < DM; ++d) stf(&p.h[(long)t * DM + d], xo[d] * r2 * p.pre_norm[layer * DM + d]);
}

HD_ void ph_cmp_hid(const Params& p, int layer, long gid) {
  int u = (int)(gid & 127), hk = (int)((gid >> 7) & 1); long r = gid >> 8; int ncmp = p.S / 16; int j = (int)(r % ncmp), kv = (int)(r / ncmp);
  const float* w1 = p.cmp_w1 + ((long)(layer * 2 + kv) * 2048) * 128;
  const float* pe = p.cmp_pos + (long)(layer * 2 + kv) * 32 * 64;
  float acc = 0.f;
  for (int t = 0; t < 32; ++t) { int tok = 16 * j + t;
    _Pragma("unroll 16") for (int d = 0; d < 64; ++d) { float v = pe[t * 64 + d]; if (tok < p.S) v += ldf(&p.proj[(long)tok * NPROJ + PA_KV + kv * 128 + hk * 64 + d]);
      acc += v * w1[(long)(t * 64 + d) * 128 + u]; } }
  p.hid[gid] = gelu_f(acc);
}
HD_ void ph_cmp_out(const Params& p, int layer, long gid) {
  int d = (int)(gid & 63), hk = (int)((gid >> 6) & 1); long r = gid >> 7; int ncmp = p.S / 16; int j = (int)(r % ncmp), kv = (int)(r / ncmp);
  const float* w2 = p.cmp_w2 + (long)(layer * 2 + kv) * 128 * 64;
  const float* hd = p.hid + (((long)kv * ncmp + j) * 2 + hk) * 128;
  float acc = 0.f; for (int u = 0; u < 128; ++u) acc += hd[u] * w2[u * 64 + d];
  stf(&p.kvc[gid], acc);
}
HD_ void ph_a_cmp1(const Params& p, long gid) {
  int h = (int)(gid & 7), q = (int)(gid >> 3), g = h >> 2; int ncmp = p.S / 16;
  int jn = (q >= 31) ? ((q - 31) / 16 + 1) : 0;
  const SB* kc = p.kvc; const SB* vc = p.kvc + (long)ncmp * 128;
  float qv[64], o[64]; for (int d = 0; d < 64; ++d) { qv[d] = ldf(&p.proj[(long)q * NPROJ + PA_Q + h * 64 + d]); o[d] = 0.f; }
  float m = -1e30f, l = 0.f;
  for (int j = 0; j < jn; ++j) { const SB* kr = &kc[((long)j * 2 + g) * 64]; const SB* vr = &vc[((long)j * 2 + g) * 64];
    float s = 0.f; for (int d = 0; d < 64; ++d) s += qv[d] * ldf(&kr[d]);
    int dist = q - (16 * j + 31); s = s * 0.125f + p.tabA[h * TABA_N + (dist < TABA_N ? dist : TABA_N - 1)];
    float mn = fmaxf(m, s), a = expf(m - mn), pr = expf(s - mn); l = l * a + pr; for (int d = 0; d < 64; ++d) o[d] = o[d] * a + pr * ldf(&vr[d]); m = mn; }
  float il = jn > 0 ? 1.f / l : 0.f; for (int d = 0; d < 64; ++d) stf(&p.oc[(long)q * 512 + h * 64 + d], o[d] * il);
  p.cml[gid * 2] = m; p.cml[gid * 2 + 1] = il;
}
HD_ void ph_a_cmp2(const Params& p, long gid) {
  int g = (int)(gid & 1), q = (int)(gid >> 1); int ncmp = p.S / 16;
  float* imp = p.imp + gid * 256; for (int b = 0; b < 256; ++b) imp[b] = 0.f;
  int jn = (q >= 31) ? ((q - 31) / 16 + 1) : 0; const SB* kc = p.kvc;
  for (int hh = 0; hh < 4; ++hh) { int h = g * 4 + hh; float qv[64]; for (int d = 0; d < 64; ++d) qv[d] = ldf(&p.proj[(long)q * NPROJ + PA_Q + h * 64 + d]);
    float m = p.cml[((long)q * 8 + h) * 2], il = p.cml[((long)q * 8 + h) * 2 + 1];
    for (int j = 0; j < jn; ++j) { const SB* kr = &kc[((long)j * 2 + g) * 64]; float s = 0.f; for (int d = 0; d < 64; ++d) s += qv[d] * ldf(&kr[d]);
      int dist = q - (16 * j + 31); s = s * 0.125f + p.tabA[h * TABA_N + (dist < TABA_N ? dist : TABA_N - 1)]; float pr = expf(s - m) * il;
      imp[j >> 2] += pr; if (j + 1 < ncmp) imp[(j + 1) >> 2] += pr; } }
}
HD_ void ph_a_topk(const Params& p, long gid) {
  int q = (int)(gid >> 1); float* imp = p.imp + gid * 256; int* idx = p.idx + gid * 16; int cur = q >> 6;
  imp[0] = 1e4f; imp[cur] = 1e4f;
  for (int k = 0; k < 16; ++k) { int best = -1; float bv = -1.f;
    for (int b = 0; b <= cur; ++b) { float v = imp[b]; if (v > bv) { bv = v; best = b; } }
    idx[k] = best; if (best >= 0) imp[best] = -2.f; }
}
HD_ void ph_a_win(const Params& p, long gid) {
  int h = (int)(gid & 7), q = (int)(gid >> 3), hk = h >> 2;
  float qv[64], o[64]; for (int d = 0; d < 64; ++d) { qv[d] = ldf(&p.proj[(long)q * NPROJ + PA_Q + h * 64 + d]); o[d] = 0.f; }
  float m = -1e30f, l = 0.f; int lo = q - 511 < 0 ? 0 : q - 511;
  for (int t = lo; t <= q; ++t) { const SB* kr = &p.proj[(long)t * NPROJ + PA_KV + 4 * 128 + hk * 64]; const SB* vr = kr + 128;
    float s = 0.f; for (int d = 0; d < 64; ++d) s += qv[d] * ldf(&kr[d]); s = s * 0.125f + p.tabA[h * TABA_N + (q - t)];
    float mn = fmaxf(m, s), a = expf(m - mn), pr = expf(s - mn); l = l * a + pr; for (int d = 0; d < 64; ++d) o[d] = o[d] * a + pr * ldf(&vr[d]); m = mn; }
  float il = 1.f / l; for (int d = 0; d < 64; ++d) stf(&p.ow[(long)q * 512 + h * 64 + d], o[d] * il);
}
HD_ void ph_a_sel(const Params& p, long gid) {
  int h = (int)(gid & 7), q = (int)(gid >> 3), hk = h >> 2; const int* idx = p.idx + ((long)q * 2 + hk) * 16;
  float qv[64], o[64]; for (int d = 0; d < 64; ++d) { qv[d] = ldf(&p.proj[(long)q * NPROJ + PA_Q + h * 64 + d]); o[d] = 0.f; }
  float m = -1e30f, l = 0.f;
  for (int k = 0; k < 16; ++k) { int b = idx[k]; if (b < 0) continue;
    for (int i = 0; i < 64; ++i) { int t = b * 64 + i; if (t > q) break;
      const SB* kr = &p.proj[(long)t * NPROJ + PA_KV + 2 * 128 + hk * 64]; const SB* vr = kr + 128;
      float s = 0.f; for (int d = 0; d < 64; ++d) s += qv[d] * ldf(&kr[d]); int dist = q - t; s = s * 0.125f + p.tabA[h * TABA_N + (dist < TABA_N ? dist : TABA_N - 1)];
      float mn = fmaxf(m, s), a = expf(m - mn), pr = expf(s - mn); l = l * a + pr; for (int d = 0; d < 64; ++d) o[d] = o[d] * a + pr * ldf(&vr[d]); m = mn; } }
  float il = 1.f / l; const float* gl = p.small + (long)q * NSMALL + h * 3;
  float g0 = sigmoid_f(gl[0]), g1 = sigmoid_f(gl[1]), g2 = sigmoid_f(gl[2]);
  for (int d = 0; d < 64; ++d) { long c = (long)q * 512 + h * 64 + d; float a = g0 * ldf(&p.oc[c]) + g1 * o[d] * il + g2 * ldf(&p.ow[c]);
    SB* mp = &p.mix[(long)q * NMIX + MX_A + h * 64 + d]; stf(mp, a * ldf(mp)); }
}
HD_ void ph_c(const Params& p, int layer, long gid) {
  int h = (int)(gid & 7), q = (int)(gid >> 3), hk = h >> 2;
  float qv[64], o[64]; for (int d = 0; d < 64; ++d) { qv[d] = ldf(&p.proj[(long)q * NPROJ + PC_Q + h * 64 + d]); o[d] = 0.f; }
  float m = p.sinks[layer * 8 + h], l = 1.f; int lo = q - 127 < 0 ? 0 : q - 127;
  for (int t = lo; t <= q; ++t) { const SB* kr = &p.proj[(long)t * NPROJ + PC_KV + hk * 64]; const SB* vr = kr + 128;
    float s = 0.f; for (int d = 0; d < 64; ++d) s += qv[d] * ldf(&kr[d]); s *= 0.125f;
    float mn = fmaxf(m, s), a = expf(m - mn), pr = expf(s - mn); l = l * a + pr; for (int d = 0; d < 64; ++d) o[d] = o[d] * a + pr * ldf(&vr[d]); m = mn; }
  float il = 1.f / l; for (int d = 0; d < 64; ++d) { SB* mp = &p.mix[(long)q * NMIX + MX_C + h * 64 + d]; stf(mp, o[d] * il * ldf(mp)); }
}
HD_ void ph_d(const Params& p, long gid) {
  int h = (int)(gid & 7); long r = gid >> 3; int q = (int)(r % p.S), gi = (int)(r / p.S); int dil = gi == 0 ? 1 : (gi == 1 ? 4 : 16);
  float qv[64], o[64]; for (int d = 0; d < 64; ++d) { qv[d] = ldf(&p.proj[(long)q * NPROJ + PD_Q + gi * 512 + h * 64 + d]); o[d] = 0.f; }
  float m = -1e30f, l = 0.f;
  for (int dd = 0; dd <= 128; ++dd) { int t = q - dil * dd; if (t < 0) break;
    const SB* kr = &p.proj[(long)t * NPROJ + PD_KV + h * 64]; const SB* vr = kr + 512;
    float s = 0.f; for (int d = 0; d < 64; ++d) s += qv[d] * ldf(&kr[d]); s = s * 0.125f + p.tabD[(gi * 8 + h) * TABD_N + dd];
    float mn = fmaxf(m, s), a = expf(m - mn), pr = expf(s - mn); l = l * a + pr; for (int d = 0; d < 64; ++d) o[d] = o[d] * a + pr * ldf(&vr[d]); m = mn; }
  float il = 1.f / l; for (int d = 0; d < 64; ++d) stf(&p.dop[((long)gi * p.S + q) * 512 + h * 64 + d], o[d] * il);
  p.dlse[((long)gi * p.S + q) * 8 + h] = m + logf(l);
}
HD_ void ph_d_merge(const Params& p, long gid) {
  int h = (int)(gid & 7), q = (int)(gid >> 3);
  float l0 = p.dlse[((long)0 * p.S + q) * 8 + h], l1 = p.dlse[((long)1 * p.S + q) * 8 + h], l2 = p.dlse[((long)2 * p.S + q) * 8 + h];
  float mm = fmaxf(l0, fmaxf(l1, l2)); float e0 = expf(l0 - mm), e1 = expf(l1 - mm), e2 = expf(l2 - mm), is = 1.f / (e0 + e1 + e2);
  for (int d = 0; d < 64; ++d) { long c = (long)q * 512 + h * 64 + d;
    float v = (e0 * ldf(&p.dop[c]) + e1 * ldf(&p.dop[(long)p.S * 512 + c]) + e2 * ldf(&p.dop[(long)2 * p.S * 512 + c])) * is;
    SB* mp = &p.mix[(long)q * NMIX + MX_D + h * 64 + d]; stf(mp, v * ldf(mp)); }
}
HD_ void ph_m(const Params& p, int layer, long gid) {
  int h = (int)(gid & 3), q = (int)(gid >> 2);
  float qv[64], o[64]; for (int d = 0; d < 64; ++d) { qv[d] = ldf(&p.proj[(long)q * NPROJ + PM_Q + h * 64 + d]); o[d] = 0.f; }
  float m = -1e30f, l = 0.f; const SB* kvb = p.memkv + (long)layer * 256 * 512;
  for (int t = 0; t < 256; ++t) { const SB* kr = kvb + (long)t * 512 + h * 64; const SB* vr = kr + 256;
    float s = 0.f; for (int d = 0; d < 64; ++d) s += qv[d] * ldf(&kr[d]); s *= 0.125f;
    float mn = fmaxf(m, s), a = expf(m - mn), pr = expf(s - mn); l = l * a + pr; for (int d = 0; d < 64; ++d) o[d] = o[d] * a + pr * ldf(&vr[d]); m = mn; }
  float il = 1.f / l; for (int d = 0; d < 64; ++d) { SB* mp = &p.mix[(long)q * NMIX + MX_M + h * 64 + d]; stf(mp, o[d] * il * ldf(mp)); }
}
HD_ void ph_b_conv(const Params& p, int layer, long gid) {
  int c = (int)(gid & 1023), t = (int)(gid >> 10); const float* w = p.conv_w + (long)layer * 4 * 1024;
  float acc = p.conv_b[layer * 1024 + c];
  for (int i = 0; i < 4; ++i) { int tt = t - 3 + i; if (tt >= 0) acc += w[i * 1024 + c] * ldf(&p.proj[(long)tt * NPROJ + PB_X + c]); }
  stf(&p.xconv[gid], silu_f(acc));
}
HD_ void ph_b_dt(const Params& p, int layer, long gid) {
  int hd = (int)(gid & 7), c = (int)(gid >> 3); float a = -expf(p.a_log[layer * 8 + hd]); float cs = 0.f;
  for (int l = 0; l < 128; ++l) { int t = c * 128 + l; float dt = softplus_f(p.small[(long)t * NSMALL + 24 + hd] + p.dt_bias[layer * 8 + hd]);
    cs += dt * a; p.dt[(long)t * 8 + hd] = dt; p.acs[(long)t * 8 + hd] = cs; }
}
HD_ void ph_b_cb(const Params& p, long gid) {
  int s = (int)(gid & 127), l = (int)((gid >> 7) & 127), g = (int)((gid >> 14) & 1), c = (int)(gid >> 15);
  if (s > l) { p.cb[gid] = 0.f; return; }
  const SB* cm = &p.xconv[(long)(c * 128 + l) * 1024 + 768 + g * 128]; const SB* bm = &p.xconv[(long)(c * 128 + s) * 1024 + 512 + g * 128];
  float acc = 0.f; for (int n = 0; n < 128; ++n) acc += ldf(&cm[n]) * ldf(&bm[n]);
  p.cb[gid] = acc;
}
HD_ void ph_b_states(const Params& p, long gid) {
  int n = (int)(gid & 127), pp = (int)((gid >> 7) & 63), hd = (int)((gid >> 13) & 7), c = (int)(gid >> 16), g = hd >> 2;
  float last = p.acs[(long)(c * 128 + 127) * 8 + hd]; float acc = 0.f;
  for (int l = 0; l < 128; ++l) { long t = c * 128 + l;
    acc += ldf(&p.xconv[t * 1024 + 512 + g * 128 + n]) * expf(last - p.acs[t * 8 + hd]) * ldf(&p.xconv[t * 1024 + hd * 64 + pp]) * p.dt[t * 8 + hd]; }
  p.states[gid] = acc;
}
HD_ void ph_b_scan(const Params& p, long gid) {
  int hd = (int)(gid >> 13); int nc = p.S / 128; float h = 0.f;
  for (int c0 = 0; c0 < nc; c0 += 8) { float st[8], dc[8];
    for (int i = 0; i < 8; ++i) { st[i] = p.states[(long)(c0 + i) * 65536 + gid]; dc[i] = p.acs[(long)((c0 + i) * 128 + 127) * 8 + hd]; }
    for (int i = 0; i < 8; ++i) { p.states[(long)(c0 + i) * 65536 + gid] = h; h = h * expf(dc[i]) + st[i]; } }
}
HD_ void ph_b_out(const Params& p, int layer, long gid) {
  int pp = (int)(gid & 63), hd = (int)((gid >> 6) & 7), t = (int)(gid >> 9), g = hd >> 2, c = t >> 7, l = t & 127;
  float al = p.acs[(long)t * 8 + hd]; float acc = 0.f;
  const float* cbr = &p.cb[(((long)c * 2 + g) * 128 + l) * 128];
  for (int s = 0; s <= l; ++s) { long ts = c * 128 + s; acc += cbr[s] * expf(al - p.acs[ts * 8 + hd]) * ldf(&p.xconv[ts * 1024 + hd * 64 + pp]) * p.dt[ts * 8 + hd]; }
  float acc2 = 0.f; const float* pr = &p.states[(long)c * 65536 + ((long)hd * 64 + pp) * 128]; const SB* cm = &p.xconv[(long)t * 1024 + 768 + g * 128];
  for (int n = 0; n < 128; ++n) acc2 += ldf(&cm[n]) * pr[n];
  p.ybuf[gid] = acc + expf(al) * acc2 + ldf(&p.xconv[(long)t * 1024 + hd * 64 + pp]) * p.b_d[layer * 8 + hd];
}
HD_ void ph_b_norm(const Params& p, int layer, long gid) {
  int g = (int)(gid & 1), t = (int)(gid >> 1); float ss = 0.f;
  for (int i = 0; i < 256; ++i) { float v = p.ybuf[(long)t * 512 + g * 256 + i] * ldf(&p.mix[(long)t * NMIX + MX_B + g * 256 + i]); ss += v * v; }
  float r = 1.f / sqrtf(ss / 256.f + 1e-6f);
  for (int i = 0; i < 256; ++i) { SB* mp = &p.mix[(long)t * NMIX + MX_B + g * 256 + i]; float v = p.ybuf[(long)t * 512 + g * 256 + i] * ldf(mp);
    stf(mp, v * r * p.b_norm[layer * 512 + g * 256 + i]); }
}

HD_ void ph_b_dt2(const Params& p, int layer, long gid) {
  int hd = (int)(gid & 7), c = (int)(gid >> 3); float a = -expf(p.a_log[layer * 8 + hd]); float cs = 0.f;
  for (int l = 0; l < 128; ++l) { int t = c * 128 + l; float dt = softplus_f(p.small[(long)t * NSMALL + 24 + hd] + p.dt_bias[layer * 8 + hd]);
    cs += dt * a; p.dt[(long)t * 8 + hd] = dt; p.acs[(long)t * 8 + hd] = cs; }
  for (int l = 0; l < 128; ++l) { long t = c * 128 + l; p.wst[t * 8 + hd] = p.dt[t * 8 + hd] * expf(cs - p.acs[t * 8 + hd]); }
}
HD_ void ph_b_states2(const Params& p, long gid) {
  int pp = (int)(gid & 63), n = (int)((gid >> 6) & 127), hd = (int)((gid >> 13) & 7), c = (int)(gid >> 16), g = hd >> 2;
  float acc = 0.f;
  _Pragma("unroll 16") for (int l = 0; l < 128; ++l) { long t = c * 128 + l; acc += ldf(&p.xconv[t * 1024 + 512 + g * 128 + n]) * p.wst[t * 8 + hd] * ldf(&p.xconv[t * 1024 + hd * 64 + pp]); }
  p.states[gid] = acc;
}
HD_ void ph_b_out2(const Params& p, int layer, long gid) {
  int pp = (int)(gid & 63), hd = (int)((gid >> 6) & 7), t = (int)(gid >> 9), g = hd >> 2, c = t >> 7, l = t & 127;
  float al = p.acs[(long)t * 8 + hd]; float acc = 0.f;
  const float* cbr = &p.cb[(((long)c * 2 + g) * 128 + l) * 128];
  _Pragma("unroll 8") for (int s = 0; s <= l; ++s) { long ts = c * 128 + s; acc += cbr[s] * expf(al - p.acs[ts * 8 + hd]) * p.dt[ts * 8 + hd] * ldf(&p.xconv[ts * 1024 + hd * 64 + pp]); }
  float acc2 = 0.f; const float* pr = &p.states[(long)c * 65536 + (long)hd * 8192 + pp]; const SB* cm = &p.xconv[(long)t * 1024 + 768 + g * 128];
  _Pragma("unroll 16") for (int n = 0; n < 128; ++n) acc2 += ldf(&cm[n]) * pr[n * 64];
  p.ybuf[gid] = acc + expf(al) * acc2 + ldf(&p.xconv[(long)t * 1024 + hd * 64 + pp]) * p.b_d[layer * 8 + hd];
}

typedef __attribute__((ext_vector_type(8))) short bf16x8;
typedef __attribute__((ext_vector_type(16))) float f32x16;
typedef short v4i16_t __attribute__((ext_vector_type(4)));
typedef __bf16 bf2_t __attribute__((ext_vector_type(2)));
typedef float f2_t __attribute__((ext_vector_type(2)));
typedef unsigned u32x4 __attribute__((ext_vector_type(4)));
#define LDS3 __attribute__((address_space(3)))
typedef __attribute__((address_space(1))) const void* gptr_t;
typedef __attribute__((address_space(3))) void* lptr_t;
#define L2E 1.4426950408889634f
#define LN2 0.6931471805599453f
#define QSC (0.125f * L2E)
#ifndef FTHR
#define FTHR 8.0f
#endif
#define NINF (-__builtin_huge_valf())

struct WaveLds { unsigned short v[4096]; float tab[640]; float xch[32]; float pad[32]; };

__device__ __forceinline__ unsigned pk2(float a, float b) { f2_t v = {a, b}; bf2_t r = __builtin_convertvector(v, bf2_t); return __builtin_bit_cast(unsigned, r); }
__device__ __forceinline__ int crow(int e, int hi) { return (e & 3) + 8 * (e >> 2) + 4 * hi; }
__device__ __forceinline__ bf16x8 pack8(const f32x16& s, int o) {
  u32x4 r; r[0] = pk2(s[o], s[o + 1]); r[1] = pk2(s[o + 2], s[o + 3]); r[2] = pk2(s[o + 4], s[o + 5]); r[3] = pk2(s[o + 6], s[o + 7]); return __builtin_bit_cast(bf16x8, r); }
__device__ __forceinline__ f32x16 zero16() { f32x16 z;
#pragma unroll
  for (int e = 0; e < 16; ++e) z[e] = 0.f; return z; }
#define MFMA32(a, b, c) __builtin_amdgcn_mfma_f32_32x32x16_bf16((a), (b), (c), 0, 0, 0)

__device__ __forceinline__ float xor32_f(float v) { const auto rr = __builtin_amdgcn_permlane32_swap(__float_as_uint(v), __float_as_uint(v), false, false); const int hi_ = (int)(threadIdx.x & 32u); return __uint_as_float(hi_ ? rr[0] : rr[1]); }
struct FlashState { f32x16 o0, o1; float m, l; };
__device__ __forceinline__ float wave_sum_f(float v) {
#pragma unroll
  for (int o = 32; o > 0; o >>= 1) v += __shfl_xor(v, o);
  return v; }

__device__ __forceinline__ void flash_core1(FlashState& st, f32x16& s, const unsigned short* vimg, float* xch, int lane) {
  const int r32 = lane & 31, hi = lane >> 5;
  float mx = s[0];
#pragma unroll
  for (int e = 1; e < 16; ++e) mx = fmaxf(mx, s[e]);
  mx = fmaxf(mx, xor32_f(mx));
  if (__any(mx > st.m + FTHR)) {
    const float mn = fmaxf(st.m, mx); const float al = __builtin_amdgcn_exp2f(st.m - mn); st.m = mn; st.l *= al; xch[r32] = al;
#pragma unroll
    for (int e = 0; e < 16; ++e) { const float a = xch[crow(e, hi)]; st.o0[e] *= a; st.o1[e] *= a; }
  }
  float ps = 0.f;
#pragma unroll
  for (int e = 0; e < 16; ++e) { s[e] = __builtin_amdgcn_exp2f(s[e] - st.m); ps += s[e]; }
  st.l += ps;
  const bf16x8 pa0 = pack8(s, 0), pa1 = pack8(s, 8);
  const unsigned short* vb = vimg + (4 * hi + ((lane & 15) >> 2)) * 32 + ((lane >> 4) & 1) * 16 + (lane & 3) * 4;
#pragma unroll
  for (int s2 = 0; s2 < 2; ++s2) {
#pragma unroll
    for (int db = 0; db < 2; ++db) {
      const v4i16_t lo = __builtin_amdgcn_ds_read_tr16_b64_v4i16((LDS3 v4i16_t*)(vb + db * 2048 + s2 * 512));
      const v4i16_t hh = __builtin_amdgcn_ds_read_tr16_b64_v4i16((LDS3 v4i16_t*)(vb + db * 2048 + s2 * 512 + 256));
      const bf16x8 vf = {lo[0], lo[1], lo[2], lo[3], hh[0], hh[1], hh[2], hh[3]};
      if (db == 0) st.o0 = MFMA32(s2 ? pa1 : pa0, vf, st.o0); else st.o1 = MFMA32(s2 ? pa1 : pa0, vf, st.o1);
    }
  }
}
__device__ __forceinline__ void flash_core1_lin(FlashState& st, f32x16& s, float qs, float bb, const unsigned short* vimg, float* xch, int lane) {
  const int r32 = lane & 31, hi = lane >> 5;
  float mr = s[0];
#pragma unroll
  for (int e = 1; e < 16; ++e) mr = fmaxf(mr, s[e]);
  float mx = __builtin_fmaf(mr, qs, bb);
  mx = fmaxf(mx, xor32_f(mx));
  if (__any(mx > st.m + FTHR)) {
    const float mn = fmaxf(st.m, mx); const float al = __builtin_amdgcn_exp2f(st.m - mn); st.m = mn; st.l *= al; xch[r32] = al;
#pragma unroll
    for (int e = 0; e < 16; ++e) { const float a = xch[crow(e, hi)]; st.o0[e] *= a; st.o1[e] *= a; }
  }
  const float bm = bb - st.m; float ps = 0.f;
#pragma unroll
  for (int e = 0; e < 16; ++e) { s[e] = __builtin_amdgcn_exp2f(__builtin_fmaf(s[e], qs, bm)); ps += s[e]; }
  st.l += ps;
  const bf16x8 pa0 = pack8(s, 0), pa1 = pack8(s, 8);
  const unsigned short* vb = vimg + (4 * hi + ((lane & 15) >> 2)) * 32 + ((lane >> 4) & 1) * 16 + (lane & 3) * 4;
#pragma unroll
  for (int s2 = 0; s2 < 2; ++s2) {
#pragma unroll
    for (int db = 0; db < 2; ++db) {
      const v4i16_t lo = __builtin_amdgcn_ds_read_tr16_b64_v4i16((LDS3 v4i16_t*)(vb + db * 2048 + s2 * 512));
      const v4i16_t hh = __builtin_amdgcn_ds_read_tr16_b64_v4i16((LDS3 v4i16_t*)(vb + db * 2048 + s2 * 512 + 256));
      const bf16x8 vf = {lo[0], lo[1], lo[2], lo[3], hh[0], hh[1], hh[2], hh[3]};
      if (db == 0) st.o0 = MFMA32(s2 ? pa1 : pa0, vf, st.o0); else st.o1 = MFMA32(s2 ? pa1 : pa0, vf, st.o1);
    }
  }
}
template <class VRow, class Fix>
__device__ __forceinline__ void flash_tile(FlashState& st, const bf16x8 (&qf)[4], const SB* kp, VRow vrow, Fix fix, WaveLds* L, int lane) {
  const int r32 = lane & 31, hi = lane >> 5;
  bf16x8 kf[4];
#pragma unroll
  for (int d0 = 0; d0 < 4; ++d0) kf[d0] = *(const bf16x8*)(kp + d0 * 16 + hi * 8);
#pragma unroll
  for (int i = 0; i < 4; ++i) { const int c = lane + 64 * i, key = c >> 3, ch = c & 7; const SB* vp = vrow(key); const uint4 vv = *(const uint4*)(vp + ch * 8);
    *(uint4*)&L->v[(ch >> 2) * 2048 + key * 32 + (ch & 3) * 8] = vv; }
  f32x16 s = zero16();
#pragma unroll
  for (int d0 = 0; d0 < 4; ++d0) s = MFMA32(kf[d0], qf[d0], s);
  fix(s);
  flash_core1(st, s, L->v, L->xch, lane);
}
__device__ __forceinline__ void flash_core2(FlashState& st, f32x16& s0, f32x16& s1, const unsigned short* vimg, float* xch, int lane) {
  const int r32 = lane & 31, hi = lane >> 5;
  float mx = fmaxf(s0[0], s1[0]);
#pragma unroll
  for (int e = 1; e < 16; ++e) mx = fmaxf(mx, fmaxf(s0[e], s1[e]));
  mx = fmaxf(mx, xor32_f(mx));
  if (__any(mx > st.m + FTHR)) {
    const float mn = fmaxf(st.m, mx); const float al = __builtin_amdgcn_exp2f(st.m - mn); st.m = mn; st.l *= al; xch[r32] = al;
#pragma unroll
    for (int e = 0; e < 16; ++e) { const float a = xch[crow(e, hi)]; st.o0[e] *= a; st.o1[e] *= a; }
  }
  float ps = 0.f;
#pragma unroll
  for (int e = 0; e < 16; ++e) { s0[e] = __builtin_amdgcn_exp2f(s0[e] - st.m); s1[e] = __builtin_amdgcn_exp2f(s1[e] - st.m); ps += s0[e] + s1[e]; }
  st.l += ps;
  bf16x8 pa[4]; pa[0] = pack8(s0, 0); pa[1] = pack8(s0, 8); pa[2] = pack8(s1, 0); pa[3] = pack8(s1, 8);
  const unsigned short* vb = vimg + (4 * hi + ((lane & 15) >> 2)) * 32 + ((lane >> 4) & 1) * 16 + (lane & 3) * 4;
#pragma unroll
  for (int kk = 0; kk < 4; ++kk) {
#pragma unroll
    for (int db = 0; db < 2; ++db) {
      const v4i16_t lo = __builtin_amdgcn_ds_read_tr16_b64_v4i16((LDS3 v4i16_t*)(vb + db * 2048 + kk * 512));
      const v4i16_t hh = __builtin_amdgcn_ds_read_tr16_b64_v4i16((LDS3 v4i16_t*)(vb + db * 2048 + kk * 512 + 256));
      const bf16x8 vf = {lo[0], lo[1], lo[2], lo[3], hh[0], hh[1], hh[2], hh[3]};
      if (db == 0) st.o0 = MFMA32(pa[kk], vf, st.o0); else st.o1 = MFMA32(pa[kk], vf, st.o1);
    }
  }
}
__device__ __forceinline__ void flash_core2_lin(FlashState& st, f32x16& s0, f32x16& s1, float qs, float bb, const unsigned short* vimg, float* xch, int lane) {
  const int r32 = lane & 31, hi = lane >> 5;
  float mr = fmaxf(s0[0], s1[0]);
#pragma unroll
  for (int e = 1; e < 16; ++e) mr = fmaxf(mr, fmaxf(s0[e], s1[e]));
  float mx = __builtin_fmaf(mr, qs, bb);
  mx = fmaxf(mx, xor32_f(mx));
  if (__any(mx > st.m + FTHR)) {
    const float mn = fmaxf(st.m, mx); const float al = __builtin_amdgcn_exp2f(st.m - mn); st.m = mn; st.l *= al; xch[r32] = al;
#pragma unroll
    for (int e = 0; e < 16; ++e) { const float a = xch[crow(e, hi)]; st.o0[e] *= a; st.o1[e] *= a; }
  }
  const float bm = bb - st.m; float ps = 0.f;
#pragma unroll
  for (int e = 0; e < 16; ++e) { s0[e] = __builtin_amdgcn_exp2f(__builtin_fmaf(s0[e], qs, bm)); s1[e] = __builtin_amdgcn_exp2f(__builtin_fmaf(s1[e], qs, bm)); ps += s0[e] + s1[e]; }
  st.l += ps;
  bf16x8 pa[4]; pa[0] = pack8(s0, 0); pa[1] = pack8(s0, 8); pa[2] = pack8(s1, 0); pa[3] = pack8(s1, 8);
  const unsigned short* vb = vimg + (4 * hi + ((lane & 15) >> 2)) * 32 + ((lane >> 4) & 1) * 16 + (lane & 3) * 4;
#pragma unroll
  for (int kk = 0; kk < 4; ++kk) {
#pragma unroll
    for (int db = 0; db < 2; ++db) {
      const v4i16_t lo = __builtin_amdgcn_ds_read_tr16_b64_v4i16((LDS3 v4i16_t*)(vb + db * 2048 + kk * 512));
      const v4i16_t hh = __builtin_amdgcn_ds_read_tr16_b64_v4i16((LDS3 v4i16_t*)(vb + db * 2048 + kk * 512 + 256));
      const bf16x8 vf = {lo[0], lo[1], lo[2], lo[3], hh[0], hh[1], hh[2], hh[3]};
      if (db == 0) st.o0 = MFMA32(pa[kk], vf, st.o0); else st.o1 = MFMA32(pa[kk], vf, st.o1);
    }
  }
}
#ifndef FT2
#define FT2 1
#endif
template <class VRow, class Fix0, class Fix1>
__device__ __forceinline__ void flash_tile2(FlashState& st, const bf16x8 (&qf)[4], const SB* kp0, const SB* kp1, VRow vrow, Fix0 fix0, Fix1 fix1, WaveLds* L, int lane) {
  if (!FT2) { flash_tile(st, qf, kp0, [&](int key) { return vrow(key); }, fix0, L, lane); flash_tile(st, qf, kp1, [&](int key) { return vrow(key + 32); }, fix1, L, lane); return; }
  const int hi = lane >> 5;
  bf16x8 kf0[4], kf1[4];
#pragma unroll
  for (int d0 = 0; d0 < 4; ++d0) { kf0[d0] = *(const bf16x8*)(kp0 + d0 * 16 + hi * 8); kf1[d0] = *(const bf16x8*)(kp1 + d0 * 16 + hi * 8); }
#pragma unroll
  for (int i = 0; i < 8; ++i) { const int c = lane + 64 * i, key = c >> 3, ch = c & 7; const SB* vp = vrow(key); const uint4 vv = *(const uint4*)(vp + ch * 8);
    *(uint4*)&L->v[(ch >> 2) * 2048 + key * 32 + (ch & 3) * 8] = vv; }
  f32x16 s0 = zero16(), s1 = zero16();
#pragma unroll
  for (int d0 = 0; d0 < 4; ++d0) { s0 = MFMA32(kf0[d0], qf[d0], s0); s1 = MFMA32(kf1[d0], qf[d0], s1); }
  fix0(s0); fix1(s1);
  flash_core2(st, s0, s1, L->v, L->xch, lane);
}
template <class KPtr, class VRow, class Fix>
__device__ __forceinline__ void flash_run(FlashState& st, const bf16x8 (&qf)[4], int t0, int t1, KPtr kptr, VRow vrow, Fix fix, WaveLds* L, int lane) {
  if (t0 >= t1) return;
  const int hi = lane >> 5; bf16x8 kfn[4];
#define FR_ISSUE(tt) { const int t_ = (tt); _Pragma("unroll") for (int i_ = 0; i_ < 4; ++i_) { const int db_ = i_ >> 1, key_ = (i_ & 1) * 16 + (lane >> 2), wi_ = lane & 3; \
      __builtin_amdgcn_global_load_lds((gptr_t)(vrow(t_, key_) + db_ * 32 + wi_ * 8), (lptr_t)&L->v[db_ * 2048 + (t_ & 1) * 1024 + (i_ & 1) * 512], 16, 0, 0); } \
    const SB* kp_ = kptr(t_); _Pragma("unroll") for (int d0_ = 0; d0_ < 4; ++d0_) kfn[d0_] = *(const bf16x8*)(kp_ + d0_ * 16 + hi * 8); }
  FR_ISSUE(t0)
  for (int t = t0; t < t1; ++t) {
    asm volatile("s_waitcnt vmcnt(0)" ::: "memory");
    bf16x8 kf[4];
#pragma unroll
    for (int d0 = 0; d0 < 4; ++d0) kf[d0] = kfn[d0];
    if (t + 1 < t1) FR_ISSUE(t + 1)
    f32x16 s = zero16();
#pragma unroll
    for (int d0 = 0; d0 < 4; ++d0) s = MFMA32(kf[d0], qf[d0], s);
    fix(t, s);
    flash_core1(st, s, L->v + (t & 1) * 1024, L->xch, lane);
  }
#undef FR_ISSUE
}
__device__ __forceinline__ float flash_finish(FlashState& st, WaveLds* L, int lane) {
  const int r32 = lane & 31, hi = lane >> 5;
  const float lt = st.l + xor32_f(st.l); const float inv = lt > 0.f ? 1.f / lt : 0.f;
  L->xch[r32] = inv;
#pragma unroll
  for (int e = 0; e < 16; ++e) { const float a = L->xch[crow(e, hi)]; st.o0[e] *= a; st.o1[e] *= a; }
  return (st.m + __builtin_amdgcn_logf(lt)) * LN2;
}
__device__ __forceinline__ void load_q(bf16x8 (&qf)[4], const SB* qp, int hi) {
#pragma unroll
  for (int d0 = 0; d0 < 4; ++d0) qf[d0] = *(const bf16x8*)(qp + d0 * 16 + hi * 8);
}
__device__ __forceinline__ void fix_tab(f32x16& s, const WaveLds* L, int base, int lane, bool chk, int kb) {
  const int r32 = lane & 31, hi = lane >> 5; const float* tp = L->tab + base + r32 + 32 - 4 * hi;
#pragma unroll
  for (int e = 0; e < 16; ++e) { const int kk = (e & 3) + 8 * (e >> 2); float v = s[e] * QSC + tp[-kk]; if (chk && (kb + kk + 4 * hi < 0)) v = NINF; s[e] = v; }
}

__device__ __forceinline__ void unit_c(const Params& p, int layer, int u, WaveLds* L, int lane) {
  const int h = u & 7, qt = u >> 3, q0 = qt * 32, hk = h >> 2, r32 = lane & 31, hi = lane >> 5;
  for (int x = lane; x < 192; x += 64) { const int dist = x - 32; L->tab[x] = (dist >= 0 && dist <= 127) ? 0.f : NINF; }
  bf16x8 qf[4]; load_q(qf, p.proj + (long)(q0 + r32) * NPROJ + PC_Q + h * 64, hi);
  FlashState st; st.o0 = zero16(); st.o1 = zero16(); st.m = p.sinks[layer * 8 + h] * L2E; st.l = hi ? 0.f : 1.f;
  const SB* kvb = p.proj + PC_KV + hk * 64; const bool chk = q0 < 128;
  flash_run(st, qf, 0, 5, [&](int t) { int tok = q0 - 128 + 32 * t + r32; tok = tok < 0 ? 0 : tok; return kvb + (long)tok * NPROJ; },
            [&](int t, int key) { int tk = q0 - 128 + 32 * t + key; tk = tk < 0 ? 0 : tk; return kvb + 128 + (long)tk * NPROJ; },
            [&](int t, f32x16& s) { fix_tab(s, L, 128 - 32 * t, lane, chk, q0 - 128 + 32 * t); }, L, lane);
  flash_finish(st, L, lane);
#pragma unroll
  for (int e = 0; e < 16; ++e) { SB* mp = p.mix + (long)(q0 + crow(e, hi)) * NMIX + MX_C + h * 64 + r32; mp[0] = f2bf(st.o0[e] * bf2f(mp[0])); mp[32] = f2bf(st.o1[e] * bf2f(mp[32])); }
}
__device__ __forceinline__ void unit_m(const Params& p, int layer, int u, WaveLds* L, int lane) {
  const int h = u & 3, qt = u >> 2, q0 = qt * 32, r32 = lane & 31, hi = lane >> 5;
  bf16x8 qf[4]; load_q(qf, p.proj + (long)(q0 + r32) * NPROJ + PM_Q + h * 64, hi);
  FlashState st; st.o0 = zero16(); st.o1 = zero16(); st.m = -1e30f; st.l = 0.f;
  const SB* kb = p.memkv + (long)layer * 256 * 512 + h * 64;
  flash_run(st, qf, 0, 8, [&](int t) { return kb + (long)(32 * t + r32) * 512; }, [&](int t, int key) { return kb + 256 + (long)(32 * t + key) * 512; },
            [&](int, f32x16& s) {
#pragma unroll
              for (int e = 0; e < 16; ++e) s[e] *= QSC; }, L, lane);
  flash_finish(st, L, lane);
#pragma unroll
  for (int e = 0; e < 16; ++e) { SB* mp = p.mix + (long)(q0 + crow(e, hi)) * NMIX + MX_M + h * 64 + r32; mp[0] = f2bf(st.o0[e] * bf2f(mp[0])); mp[32] = f2bf(st.o1[e] * bf2f(mp[32])); }
}
__device__ __forceinline__ void unit_awin(const Params& p, int u, WaveLds* L, int lane) {
  const int h = u & 7, qt = u >> 3, q0 = qt * 32, hk = h >> 2, r32 = lane & 31, hi = lane >> 5;
  for (int x = lane; x < 608; x += 64) { const int dist = x - 32; L->tab[x] = (dist >= 0 && dist <= 511) ? p.tabA[h * TABA_N + dist] * L2E : NINF; }
  bf16x8 qf[4]; load_q(qf, p.proj + (long)(q0 + r32) * NPROJ + PA_Q + h * 64, hi);
  FlashState st; st.o0 = zero16(); st.o1 = zero16(); st.m = -1e30f; st.l = 0.f;
  const SB* kvb = p.proj + PA_KV + 4 * 128 + hk * 64; const bool chk = q0 < 512;
  { int tfirst = 0; if (q0 < 512) tfirst = (512 - q0) / 32 - 0; if (tfirst > 16) tfirst = 16; if (q0 < 512 && (q0 - 512 + 32 * tfirst + 31) < 0) ++tfirst;
    flash_run(st, qf, tfirst, 17, [&](int t) { int tok = q0 - 512 + 32 * t + r32; tok = tok < 0 ? 0 : tok; return kvb + (long)tok * NPROJ; },
              [&](int t, int key) { int tk = q0 - 512 + 32 * t + key; tk = tk < 0 ? 0 : tk; return kvb + 128 + (long)tk * NPROJ; },
              [&](int t, f32x16& s) { fix_tab(s, L, 512 - 32 * t, lane, chk, q0 - 512 + 32 * t); }, L, lane); }
  flash_finish(st, L, lane);
#pragma unroll
  for (int e = 0; e < 16; ++e) { SB* op = p.ow + (long)(q0 + crow(e, hi)) * 512 + h * 64 + r32; op[0] = f2bf(st.o0[e]); op[32] = f2bf(st.o1[e]); }
}
__device__ __forceinline__ void unit_d(const Params& p, int u, WaveLds* L, int lane) {
  const int S = p.S, per = (S / 32) * 8; const int gi = u / per, u2 = u % per; const int h = u2 & 7, v = u2 >> 3;
  const int dil = gi == 0 ? 1 : (gi == 1 ? 4 : 16); const int it = v / dil, r = v % dil, i0 = it * 32;
  const int r32 = lane & 31, hi = lane >> 5;
  for (int x = lane; x < 192; x += 64) { const int dd = x - 32; L->tab[x] = (dd >= 0 && dd <= 128) ? p.tabD[(gi * 8 + h) * TABD_N + dd] * L2E : NINF; }
  bf16x8 qf[4]; load_q(qf, p.proj + (long)(r + dil * (i0 + r32)) * NPROJ + PD_Q + gi * 512 + h * 64, hi);
  FlashState st; st.o0 = zero16(); st.o1 = zero16(); st.m = -1e30f; st.l = 0.f;
  const SB* kvb = p.proj + PD_KV + h * 64; const bool chk = i0 < 128;
  flash_run(st, qf, 0, 5, [&](int t) { int j = i0 - 128 + 32 * t + r32; j = j < 0 ? 0 : j; return kvb + (long)(r + dil * j) * NPROJ; },
            [&](int t, int key) { int jj = i0 - 128 + 32 * t + key; jj = jj < 0 ? 0 : jj; return kvb + 512 + (long)(r + dil * jj) * NPROJ; },
            [&](int t, f32x16& s) { fix_tab(s, L, 128 - 32 * t, lane, chk, i0 - 128 + 32 * t); }, L, lane);
  const float lse = flash_finish(st, L, lane);
#pragma unroll
  for (int e = 0; e < 16; ++e) { const long tok = r + dil * (i0 + crow(e, hi)); SB* op = p.dop + ((long)gi * S + tok) * 512 + h * 64 + r32; op[0] = f2bf(st.o0[e]); op[32] = f2bf(st.o1[e]); }
  if (hi == 0) p.dlse[((long)gi * S + r + dil * (i0 + r32)) * 8 + h] = lse;
}
__device__ __forceinline__ void fix_cmp(f32x16& s, const Params& p, int h, int q0, int t, int lane) {
  const int r32 = lane & 31, hi = lane >> 5; const int dq = q0 + r32 - 31 - 16 * (32 * t + 4 * hi);
  const bool far = (q0 - 16 * (32 * t + 31) - 31) >= 1513; const float c31 = p.tabA[h * TABA_N + 2047] * L2E;
#pragma unroll
  for (int e = 0; e < 16; ++e) { const int kk = (e & 3) + 8 * (e >> 2); const int dist = dq - 16 * kk; float b;
    if (far) b = c31; else { const int dc = dist < 0 ? 0 : (dist > 2047 ? 2047 : dist); b = p.tabA[h * TABA_N + dc] * L2E; }
    s[e] = dist < 0 ? NINF : s[e] * QSC + b; }
}
__device__ __forceinline__ void unit_acmp1(const Params& p, int u, WaveLds* L, int lane) {
  const int h = u & 7, qt = (p.S / 32 - 1) - (u >> 3), q0 = qt * 32, g = h >> 2, r32 = lane & 31, hi = lane >> 5; const int ncmp = p.S / 16;
  bf16x8 qf[4]; load_q(qf, p.proj + (long)(q0 + r32) * NPROJ + PA_Q + h * 64, hi);
  FlashState st; st.o0 = zero16(); st.o1 = zero16(); st.m = -1e30f; st.l = 0.f;
  const int jn = q0 / 16 + 1, nt = (jn + 31) / 32; const SB* kc = p.kvc + g * 64; const SB* vc = p.kvc + (long)ncmp * 128 + g * 64;
  flash_run(st, qf, 0, nt, [&](int t) { int j = 32 * t + r32; j = j >= ncmp ? ncmp - 1 : j; return kc + (long)j * 128; },
            [&](int t, int key) { int jj = 32 * t + key; jj = jj >= ncmp ? ncmp - 1 : jj; return vc + (long)jj * 128; },
            [&](int t, f32x16& s) { fix_cmp(s, p, h, q0, t, lane); }, L, lane);
  const float lt = st.l + xor32_f(st.l); const float inv = lt > 0.f ? 1.f / lt : 0.f;
  flash_finish(st, L, lane);
#pragma unroll
  for (int e = 0; e < 16; ++e) { SB* op = p.oc + (long)(q0 + crow(e, hi)) * 512 + h * 64 + r32; op[0] = f2bf(st.o0[e]); op[32] = f2bf(st.o1[e]); }
  if (hi == 0) { p.cml[((long)(q0 + r32) * 8 + h) * 2] = st.m; p.cml[((long)(q0 + r32) * 8 + h) * 2 + 1] = inv; }
}
__device__ __forceinline__ void unit_acmp2(const Params& p, int u, int lane) {
  const int part = u & 3, g = (u >> 2) & 1, qt = (p.S / 32 - 1) - (u >> 3), q0 = qt * 32, r32 = lane & 31, hi = lane >> 5; const int ncmp = p.S / 16;
  const int jn = q0 / 16 + 1, nt = (jn + 31) / 32; const SB* kc = p.kvc + g * 64; float carry = 0.f;
  const int tper = (nt + 3) >> 2, tbeg = part * tper, tend = (tbeg + tper < nt) ? tbeg + tper : nt; if (tbeg >= nt) return;
  float* impq = p.imp + ((long)qt * 2 + g) * 256 * 32 + r32;
  const SB* qbase = p.proj + (long)(q0 + r32) * NPROJ + PA_Q + g * 256; const float* cmlq = p.cml + ((long)(q0 + r32) * 8 + g * 4) * 2;
  bf16x8 kfn[4]; { const int t = (tbeg > 0 ? tbeg - 1 : 0); int j = 32 * t + r32; j = j >= ncmp ? ncmp - 1 : j; const SB* kp = kc + (long)j * 128;
#pragma unroll
    for (int d0 = 0; d0 < 4; ++d0) kfn[d0] = *(const bf16x8*)(kp + d0 * 16 + hi * 8); }
  for (int t = (tbeg > 0 ? tbeg - 1 : 0); t < tend; ++t) {
    bf16x8 kf[4];
#pragma unroll
    for (int d0 = 0; d0 < 4; ++d0) kf[d0] = kfn[d0];
    if (t + 1 < tend) { int j = 32 * (t + 1) + r32; j = j >= ncmp ? ncmp - 1 : j; const SB* kp = kc + (long)j * 128;
#pragma unroll
      for (int d0 = 0; d0 < 4; ++d0) kfn[d0] = *(const bf16x8*)(kp + d0 * 16 + hi * 8); }
    float accA[4] = {0.f, 0.f, 0.f, 0.f}, accL[4] = {0.f, 0.f, 0.f, 0.f};
#pragma unroll 1
    for (int hh = 0; hh < 4; ++hh) { bf16x8 qf[4]; load_q(qf, qbase + hh * 64, hi); const float m = cmlq[hh * 2], il = cmlq[hh * 2 + 1];
      f32x16 s = zero16();
#pragma unroll
      for (int d0 = 0; d0 < 4; ++d0) s = MFMA32(kf[d0], qf[d0], s);
      fix_cmp(s, p, g * 4 + hh, q0, t, lane);
#pragma unroll
      for (int e = 0; e < 16; ++e) { const float pr = __builtin_amdgcn_exp2f(s[e] - m) * il; accA[e >> 2] += pr; if ((e & 3) == 3) accL[e >> 2] += pr; } }
    float oth[4];
#pragma unroll
    for (int eg = 0; eg < 4; ++eg) oth[eg] = xor32_f(accL[eg]);
#pragma unroll
    for (int eg = 0; eg < 4; ++eg) { const float prev = hi ? oth[eg] : (eg > 0 ? oth[eg > 0 ? eg - 1 : 0] : carry); if (t >= tbeg) impq[(8 * t + 2 * eg + hi) * 32] = 2.f * accA[eg] - accL[eg] + prev; }
    carry = oth[3]; }
}
#define DPP_F(v, ctrl, rm) __builtin_bit_cast(float, __builtin_amdgcn_update_dpp(__builtin_bit_cast(int, v), __builtin_bit_cast(int, v), ctrl, rm, 0xf, false))
#define DPP_I(v, ctrl, rm) __builtin_amdgcn_update_dpp(v, v, ctrl, rm, 0xf, false)
__device__ __forceinline__ float wave_max_f(float v) {
  v = fmaxf(v, DPP_F(v, 0xB1, 0xf)); v = fmaxf(v, DPP_F(v, 0x4E, 0xf)); v = fmaxf(v, DPP_F(v, 0x141, 0xf)); v = fmaxf(v, DPP_F(v, 0x140, 0xf));
  v = fmaxf(v, DPP_F(v, 0x142, 0xa)); v = fmaxf(v, DPP_F(v, 0x143, 0xc));
  return __builtin_bit_cast(float, __builtin_amdgcn_readlane(__builtin_bit_cast(int, v), 63)); }
__device__ __forceinline__ int imin_(int a, int b) { return a < b ? a : b; }
__device__ __forceinline__ int wave_min_i(int v) {
  v = imin_(v, DPP_I(v, 0xB1, 0xf)); v = imin_(v, DPP_I(v, 0x4E, 0xf)); v = imin_(v, DPP_I(v, 0x141, 0xf)); v = imin_(v, DPP_I(v, 0x140, 0xf));
  v = imin_(v, DPP_I(v, 0x142, 0xa)); v = imin_(v, DPP_I(v, 0x143, 0xc));
  return __builtin_amdgcn_readlane(v, 63); }
__device__ __forceinline__ void unit_topk(const Params& p, int u, int lane) {
  const int q = u >> 1, cur = q >> 6; const float* imp = p.imp + ((long)(q >> 5) * 2 + (u & 1)) * 256 * 32 + (q & 31); int* idx = p.idx + (long)u * 16;
  float v[4];
#pragma unroll
  for (int k = 0; k < 4; ++k) { const int b = lane + 64 * k; float x = (b <= cur) ? imp[b * 32] : -1.f; if (b == 0 || b == cur) x = 1e4f; v[k] = x; }
  int mine = -1;
  for (int k = 0; k < 16; ++k) {
    float lm = fmaxf(fmaxf(v[0], v[1]), fmaxf(v[2], v[3])); const float m = wave_max_f(lm);
    int cand = 0x7fffffff;
#pragma unroll
    for (int kk = 3; kk >= 0; --kk) if (v[kk] == m) cand = lane + 64 * kk;
    const int bsel = wave_min_i(cand);
#pragma unroll
    for (int kk = 0; kk < 4; ++kk) if (lane + 64 * kk == bsel) v[kk] = -2.f;
    if (lane == k) mine = (m >= 0.f) ? bsel : -1;
  }
  if (lane < 16) idx[lane] = mine;
}
template <bool STORE = true>
__device__ __forceinline__ void unit_asel(const Params& p, int u, WaveLds* L, int lane) {
  const int g = u & 1, q = u >> 1, r32 = lane & 31, hi = lane >> 5, hh = r32 & 3, h = g * 4 + hh;
  bf16x8 qf[4]; load_q(qf, p.proj + (long)q * NPROJ + PA_Q + h * 64, hi);
  FlashState st; st.o0 = zero16(); st.o1 = zero16(); st.m = -1e30f; st.l = 0.f;
  const int* idx = p.idx + (long)u * 16; const SB* kvb = p.proj + PA_KV + 2 * 128 + g * 64; const float c31 = p.tabA[h * TABA_N + 2047] * L2E;
  for (int k = 0; k < 16; ++k) { const int b = __builtin_amdgcn_readfirstlane(idx[k]); if (b < 0) continue;
    for (int kt = 0; kt < 2; ++kt) { const int t0 = b * 64 + kt * 32; if (t0 > q) continue;
      const bool far = (q - (t0 + 31)) >= 1513; const bool edge = (t0 + 31 > q);
      flash_tile(st, qf, kvb + (long)(t0 + r32) * NPROJ, [&](int key) { return kvb + 128 + (long)(t0 + key) * NPROJ; },
                 [&](f32x16& s) {
#pragma unroll
                   for (int e = 0; e < 16; ++e) { const int tk = t0 + (e & 3) + 8 * (e >> 2) + 4 * hi; const int dist = q - tk; float bsv;
                     if (far) bsv = c31; else { const int dc = dist < 0 ? 0 : (dist > 2047 ? 2047 : dist); bsv = p.tabA[h * TABA_N + dc] * L2E; }
                     float vv = s[e] * QSC + bsv; if (edge && dist < 0) vv = NINF; s[e] = vv; } }, L, lane); } }
  flash_finish(st, L, lane);
  if (!STORE) { asm volatile("" :: "v"(st.o0[0]), "v"(st.o1[3])); return; }
  if (hi == 0) {
#pragma unroll
    for (int e = 0; e < 4; ++e) { const int he = g * 4 + e; const float* gl = p.small + (long)q * NSMALL + he * 3;
      const float g0 = sigmoid_f(gl[0]), g1 = sigmoid_f(gl[1]), g2 = sigmoid_f(gl[2]);
#pragma unroll
      for (int db = 0; db < 2; ++db) { const long c = (long)q * 512 + he * 64 + db * 32 + r32; const float os = db ? st.o1[e] : st.o0[e];
        const float a = g0 * bf2f(p.oc[c]) + g1 * os + g2 * bf2f(p.ow[c]); SB* mp = p.mix + (long)q * NMIX + MX_A + he * 64 + db * 32 + r32; *mp = f2bf(a * bf2f(*mp)); } }
  }
}

struct WaveLds2 { unsigned short x[2048]; unsigned short b[2048]; float acs[128]; float dtv[128]; float xch[64]; };
template <bool SCALE, class RowScale>
__device__ __forceinline__ void stage_slab(unsigned short* dst, const SB* src, long ld, RowScale rs, int lane) {
#pragma unroll
  for (int i = 0; i < 4; ++i) { const int c = lane + 64 * i, row = c >> 3, ch = c & 7; uint4 vv = *(const uint4*)(src + (long)row * ld + ch * 8);
    if (SCALE) { const float sc = rs(row); unsigned w[4] = {vv.x, vv.y, vv.z, vv.w};
#pragma unroll
      for (int k = 0; k < 4; ++k) { const float lo = __uint_as_float(w[k] << 16) * sc, hi2 = __uint_as_float(w[k] & 0xffff0000u) * sc; w[k] = pk2(lo, hi2); }
      vv.x = w[0]; vv.y = w[1]; vv.z = w[2]; vv.w = w[3]; }
    *(uint4*)&dst[(ch >> 2) * 1024 + row * 32 + (ch & 3) * 8] = vv; }
}
__device__ __forceinline__ bf16x8 slab_frag(const unsigned short* img, int cb, int s2, int lane) {
  const int hi = lane >> 5; const unsigned short* vb = img + (4 * hi + ((lane & 15) >> 2)) * 32 + ((lane >> 4) & 1) * 16 + (lane & 3) * 4 + cb * 1024 + s2 * 512;
  const v4i16_t lo = __builtin_amdgcn_ds_read_tr16_b64_v4i16((LDS3 v4i16_t*)vb);
  const v4i16_t hh = __builtin_amdgcn_ds_read_tr16_b64_v4i16((LDS3 v4i16_t*)(vb + 256));
  return (bf16x8){lo[0], lo[1], lo[2], lo[3], hh[0], hh[1], hh[2], hh[3]};
}
__device__ __forceinline__ void unit_bstates(const Params& p, int u, WaveLds2* L, int lane) {
  const int nh = u & 1, hd = (u >> 1) & 7, c = u >> 4, g = hd >> 2, r32 = lane & 31, hi = lane >> 5;
  f32x16 acc[2][2];
#pragma unroll
  for (int i = 0; i < 2; ++i)
#pragma unroll
    for (int j = 0; j < 2; ++j) acc[i][j] = zero16();
  const SB* xb = p.xconv + (long)c * 128 * 1024; const float* wst = p.wst + (long)c * 128 * 8 + hd;
  for (int q4 = 0; q4 < 4; ++q4) {
    stage_slab<true>(L->x, xb + (long)(32 * q4) * 1024 + hd * 64, 1024, [&](int row) { return wst[(32 * q4 + row) * 8]; }, lane);
    stage_slab<false>(L->b, xb + (long)(32 * q4) * 1024 + 512 + g * 128 + nh * 64, 1024, [&](int) { return 1.f; }, lane);
#pragma unroll
    for (int s2 = 0; s2 < 2; ++s2) { bf16x8 af[2], bfr[2];
#pragma unroll
      for (int i = 0; i < 2; ++i) { af[i] = slab_frag(L->x, i, s2, lane); bfr[i] = slab_frag(L->b, i, s2, lane); }
#pragma unroll
      for (int i = 0; i < 2; ++i)
#pragma unroll
        for (int j = 0; j < 2; ++j) acc[i][j] = MFMA32(af[i], bfr[j], acc[i][j]); } }
  float* so = p.states + ((long)c * 8 + hd) * 8192 + nh * 64 + r32;
#pragma unroll
  for (int i = 0; i < 2; ++i)
#pragma unroll
    for (int j = 0; j < 2; ++j)
#pragma unroll
      for (int e = 0; e < 16; ++e) so[(long)(32 * i + crow(e, hi)) * 128 + 32 * j] = acc[i][j][e];
}
__device__ __forceinline__ void unit_bout(const Params& p, int layer, int u, WaveLds2* L, int lane) {
  const int lt = u & 3, hd = (u >> 2) & 7, c = u >> 5, g = hd >> 2, r32 = lane & 31, hi = lane >> 5;
  for (int x = lane; x < 128; x += 64) { L->acs[x] = p.acs[((long)c * 128 + x) * 8 + hd]; L->dtv[x] = p.dt[((long)c * 128 + x) * 8 + hd]; }
  f32x16 acc[2] = {zero16(), zero16()}, acc2[2] = {zero16(), zero16()};
  const SB* xb = p.xconv + (long)c * 128 * 1024; const int l = 32 * lt + r32; const float al = p.acs[((long)c * 128 + l) * 8 + hd];
  const float* cbr = p.cb + ((long)c * 2 + g) * 16384 + (long)l * 128;
  for (int sc = 0; sc <= lt; ++sc) {
    stage_slab<false>(L->x, xb + (long)(32 * sc) * 1024 + hd * 64, 1024, [&](int) { return 1.f; }, lane);
#pragma unroll
    for (int s2 = 0; s2 < 2; ++s2) { float mv[8];
#pragma unroll
      for (int jj = 0; jj < 2; ++jj) { const int s0 = 32 * sc + 16 * s2 + 8 * jj + 4 * hi; const float4 cv = *(const float4*)(cbr + s0); const float4 av = *(const float4*)(&L->acs[s0]); const float4 dv = *(const float4*)(&L->dtv[s0]);
        mv[4 * jj + 0] = (s0 + 0 <= l) ? cv.x * __expf(al - av.x) * dv.x : 0.f; mv[4 * jj + 1] = (s0 + 1 <= l) ? cv.y * __expf(al - av.y) * dv.y : 0.f;
        mv[4 * jj + 2] = (s0 + 2 <= l) ? cv.z * __expf(al - av.z) * dv.z : 0.f; mv[4 * jj + 3] = (s0 + 3 <= l) ? cv.w * __expf(al - av.w) * dv.w : 0.f; }
      u32x4 aw; aw[0] = pk2(mv[0], mv[1]); aw[1] = pk2(mv[2], mv[3]); aw[2] = pk2(mv[4], mv[5]); aw[3] = pk2(mv[6], mv[7]); const bf16x8 af = __builtin_bit_cast(bf16x8, aw);
#pragma unroll
      for (int pt = 0; pt < 2; ++pt) acc[pt] = MFMA32(af, slab_frag(L->x, pt, s2, lane), acc[pt]); } }
  const SB* cmr = xb + (long)l * 1024 + 768 + g * 128; const float* prv = p.states + ((long)c * 8 + hd) * 8192;
#pragma unroll 2
  for (int ks = 0; ks < 8; ++ks) { const bf16x8 af = *(const bf16x8*)(cmr + 16 * ks + 8 * hi);
#pragma unroll
    for (int pt = 0; pt < 2; ++pt) { const float* pr = prv + (long)(32 * pt + r32) * 128 + 16 * ks + 8 * hi; const float4 a0 = *(const float4*)pr, a1 = *(const float4*)(pr + 4);
      u32x4 bw; bw[0] = pk2(a0.x, a0.y); bw[1] = pk2(a0.z, a0.w); bw[2] = pk2(a1.x, a1.y); bw[3] = pk2(a1.z, a1.w);
      acc2[pt] = MFMA32(af, __builtin_bit_cast(bf16x8, bw), acc2[pt]); } }
  const float dsk = p.b_d[layer * 8 + hd];
#pragma unroll
  for (int e = 0; e < 16; ++e) { const int lr = 32 * lt + crow(e, hi); const float ea = __expf(L->acs[lr]); const long t = (long)c * 128 + lr;
#pragma unroll
    for (int pt = 0; pt < 2; ++pt) { const int pp = 32 * pt + r32; p.ybuf[t * 512 + hd * 64 + pp] = acc[pt][e] + ea * acc2[pt][e] + dsk * bf2f(xb[(long)lr * 1024 + hd * 64 + pp]); } }
}
__device__ __forceinline__ void unit_bnorm(const Params& p, int layer, int u, int lane) {
  const int g = u & 1; const long t = u >> 1; const float4 yv = *(const float4*)(p.ybuf + t * 512 + g * 256 + lane * 4);
  SB* mp = p.mix + t * NMIX + MX_B + g * 256 + lane * 4; const ushort4 zv = *(const ushort4*)mp;
  const float v0 = yv.x * bf2f(zv.x), v1 = yv.y * bf2f(zv.y), v2 = yv.z * bf2f(zv.z), v3 = yv.w * bf2f(zv.w);
  const float ss = wave_sum_f(v0 * v0 + v1 * v1 + v2 * v2 + v3 * v3); const float r = 1.f / sqrtf(ss * (1.f / 256.f) + 1e-6f);
  const float4 w = *(const float4*)(p.b_norm + layer * 512 + g * 256 + lane * 4);
  ushort4 o; o.x = f2bf(v0 * r * w.x); o.y = f2bf(v1 * r * w.y); o.z = f2bf(v2 * r * w.z); o.w = f2bf(v3 * r * w.w); *(ushort4*)mp = o;
}
__device__ __forceinline__ void unit_bdt(const Params& p, int layer, int u, int lane) {
  const int hd = u & 7, c = u >> 3; const float a = -expf(p.a_log[layer * 8 + hd]), bias = p.dt_bias[layer * 8 + hd]; const long t0 = (long)c * 128 + 2 * lane;
  const float d0 = softplus_f(p.small[t0 * NSMALL + 24 + hd] + bias), d1 = softplus_f(p.small[(t0 + 1) * NSMALL + 24 + hd] + bias);
  float run = (d0 + d1) * a;
#pragma unroll
  for (int o = 1; o < 64; o <<= 1) { const float v = __shfl_up(run, o); if (lane >= o) run += v; }
  const float tot = __shfl(run, 63); const float c1 = run, c0 = run - d1 * a;
  p.dt[t0 * 8 + hd] = d0; p.dt[(t0 + 1) * 8 + hd] = d1; p.acs[t0 * 8 + hd] = c0; p.acs[(t0 + 1) * 8 + hd] = c1;
  p.wst[t0 * 8 + hd] = d0 * expf(tot - c0); p.wst[(t0 + 1) * 8 + hd] = d1 * expf(tot - c1);
}
__device__ __forceinline__ void item_bconv(const Params& p, int layer, long gid) {
  const int cg = (int)(gid & 127) * 8; const long t = gid >> 7; const float* w = p.conv_w + (long)layer * 4 * 1024 + cg; const float* bb = p.conv_b + layer * 1024 + cg;
  const float4 b0 = *(const float4*)bb, b1 = *(const float4*)(bb + 4);
  float acc[8] = {b0.x, b0.y, b0.z, b0.w, b1.x, b1.y, b1.z, b1.w};
#pragma unroll
  for (int i = 0; i < 4; ++i) { const long tt = t - 3 + i; const long tc = tt < 0 ? 0 : tt; const float vm = tt < 0 ? 0.f : 1.f;
    const uint4 vv = *(const uint4*)(p.proj + tc * NPROJ + PB_X + cg); const unsigned wd[4] = {vv.x, vv.y, vv.z, vv.w};
    const float4 w0 = *(const float4*)(w + i * 1024), w1 = *(const float4*)(w + i * 1024 + 4); const float wv[8] = {w0.x, w0.y, w0.z, w0.w, w1.x, w1.y, w1.z, w1.w};
#pragma unroll
    for (int k = 0; k < 4; ++k) { acc[2 * k] += vm * wv[2 * k] * __uint_as_float(wd[k] << 16); acc[2 * k + 1] += vm * wv[2 * k + 1] * __uint_as_float(wd[k] & 0xffff0000u); } }
  uint4 o; o.x = pk2(silu_f(acc[0]), silu_f(acc[1])); o.y = pk2(silu_f(acc[2]), silu_f(acc[3])); o.z = pk2(silu_f(acc[4]), silu_f(acc[5])); o.w = pk2(silu_f(acc[6]), silu_f(acc[7]));
  *(uint4*)(p.xconv + t * 1024 + cg) = o;
}
__device__ __forceinline__ void unit_cmp(const Params& p, int layer, int u, int lane) {
  const int ncmp = p.S / 16, ntile = ncmp * 2 / 32; const int kv = u / ntile, rt = u % ntile, r32 = lane & 31, hi = lane >> 5;
  const int r = 32 * rt + r32, j = r >> 1, hk = r & 1;
  const unsigned short* w1t = p.w1t + (long)kv * 128 * 2048; const unsigned short* w2t = p.w2t + kv * 64 * 128; const float* pe = p.cmp_pos + (long)(layer * 2 + kv) * 32 * 64;
  const SB* src = p.proj + PA_KV + kv * 128 + hk * 64;
  f32x16 acc[4] = {zero16(), zero16(), zero16(), zero16()};
#pragma unroll 4
  for (int ks = 0; ks < 128; ++ks) { const int t = ks >> 2, d = (ks & 3) * 16 + 8 * hi; const long tok = 16 * j + t;
    const float4 p0 = *(const float4*)(pe + t * 64 + d), p1 = *(const float4*)(pe + t * 64 + d + 4); float v[8] = {p0.x, p0.y, p0.z, p0.w, p1.x, p1.y, p1.z, p1.w};
    { const long tokc = tok < p.S ? tok : (long)p.S - 1; const float vm = tok < p.S ? 1.f : 0.f;
      const uint4 vv = *(const uint4*)(src + tokc * NPROJ + d); const unsigned wd[4] = {vv.x, vv.y, vv.z, vv.w};
#pragma unroll
      for (int k = 0; k < 4; ++k) { v[2 * k] += vm * __uint_as_float(wd[k] << 16); v[2 * k + 1] += vm * __uint_as_float(wd[k] & 0xffff0000u); } }
    u32x4 bw; bw[0] = pk2(v[0], v[1]); bw[1] = pk2(v[2], v[3]); bw[2] = pk2(v[4], v[5]); bw[3] = pk2(v[6], v[7]); const bf16x8 bfr = __builtin_bit_cast(bf16x8, bw);
#pragma unroll
    for (int ut = 0; ut < 4; ++ut) { const bf16x8 af = *(const bf16x8*)(w1t + (long)(32 * ut + r32) * 2048 + 16 * ks + 8 * hi); acc[ut] = MFMA32(af, bfr, acc[ut]); } }
  f32x16 o2[2] = {zero16(), zero16()};
#pragma unroll
  for (int ut = 0; ut < 4; ++ut) {
#pragma unroll
    for (int e = 0; e < 16; ++e) acc[ut][e] = gelu_f(acc[ut][e]);
#pragma unroll
    for (int s2 = 0; s2 < 2; ++s2) { const bf16x8 hb = pack8(acc[ut], 8 * s2);
#pragma unroll
      for (int dt = 0; dt < 2; ++dt) { const unsigned short* wr = w2t + (32 * dt + r32) * 128 + 32 * ut + 16 * s2 + 4 * hi; const uint2 x0 = *(const uint2*)wr, x1 = *(const uint2*)(wr + 8);
        u32x4 aw; aw[0] = x0.x; aw[1] = x0.y; aw[2] = x1.x; aw[3] = x1.y; o2[dt] = MFMA32(__builtin_bit_cast(bf16x8, aw), hb, o2[dt]); } } }
  SB* dst = p.kvc + ((long)kv * ncmp * 2 + r) * 64;
#pragma unroll
  for (int dt = 0; dt < 2; ++dt)
#pragma unroll
    for (int e = 0; e < 16; ++e) dst[32 * dt + crow(e, hi)] = f2bf(o2[dt][e]);
}

template <class RowFn>
__device__ __forceinline__ void topk4_rows(const Params& p, RowFn rowfn, int lane) {
  float v[4][4]; int cur[4], mine[4];
#pragma unroll
  for (int r = 0; r < 4; ++r) { const int row = rowfn(r); const int q = row >> 1; cur[r] = q >> 6; const float* imp = p.imp + ((long)(q >> 5) * 2 + (row & 1)) * 256 * 32 + (q & 31); mine[r] = -1;
#pragma unroll
    for (int k = 0; k < 4; ++k) { const int b = lane + 64 * k; float x = (b <= cur[r]) ? imp[b * 32] : -1.f; if (b == 0 || b == cur[r]) x = 1e4f; v[r][k] = x; } }
  for (int k = 0; k < 16; ++k) {
    float m[4]; int cand[4];
#pragma unroll
    for (int r = 0; r < 4; ++r) m[r] = wave_max_f(fmaxf(fmaxf(v[r][0], v[r][1]), fmaxf(v[r][2], v[r][3])));
#pragma unroll
    for (int r = 0; r < 4; ++r) { int c = 0x7fffffff;
#pragma unroll
      for (int kk = 3; kk >= 0; --kk) if (v[r][kk] == m[r]) c = lane + 64 * kk;
      cand[r] = wave_min_i(c); }
#pragma unroll
    for (int r = 0; r < 4; ++r) {
#pragma unroll
      for (int kk = 0; kk < 4; ++kk) if (lane + 64 * kk == cand[r]) v[r][kk] = -2.f;
      if (lane == k) mine[r] = (m[r] >= 0.f) ? cand[r] : -1; }
  }
#pragma unroll
  for (int r = 0; r < 4; ++r) if (lane < 16) p.idx[(long)rowfn(r) * 16 + lane] = mine[r];
}
__device__ __forceinline__ void unit_topk4(const Params& p, int u, int lane) { topk4_rows(p, [&](int r) { return u * 4 + r; }, lane); }
__device__ __forceinline__ void glds16_asm(const void* gsrc, unsigned lds_dst) {
  unsigned keep; asm volatile("s_mov_b32 %0, m0\n\ts_mov_b32 m0, %2\n\ts_nop 0\n\tglobal_load_lds_dwordx4 %1, off\n\ts_mov_b32 m0, %0" : "=&s"(keep) : "v"(gsrc), "s"(lds_dst) : "memory");
}
__device__ __forceinline__ unsigned lds_addr(const void* p) { return (unsigned)(size_t)(LDS3 const void*)p; }
struct AselLds { unsigned short k[3][4096]; unsigned short v[3][4096]; unsigned short q[4][2048]; unsigned sel[64][8]; unsigned anyb[8]; int nlist; int pad[7]; unsigned char blist[256]; float xch[4][32]; unsigned char bkt[1664]; float relS[128]; };
__device__ __forceinline__ void asel_issue(uint4 (&r)[4], const SB* kvb, int b, int tid) {
#pragma unroll
  for (int i = 0; i < 2; ++i) { const int idx = tid + 256 * i, row = idx >> 3, ch = idx & 7; const SB* src = kvb + (long)(b * 64 + row) * NPROJ + ch * 8; r[i] = *(const uint4*)src; r[2 + i] = *(const uint4*)(src + 128); }
}
__device__ __forceinline__ void asel_commit(const uint4 (&r)[4], AselLds* A, int stage, int tid) {
#pragma unroll
  for (int i = 0; i < 2; ++i) { const int idx = tid + 256 * i, row = idx >> 3, ch = idx & 7;
    *(uint4*)&A->k[stage][row * 64 + ((ch ^ (row & 7)) * 8)] = r[i];
    *(uint4*)&A->v[stage][(ch >> 2) * 2048 + row * 32 + (ch & 3) * 8] = r[2 + i]; }
}
__device__ __forceinline__ void asel_coltile(const Params& p, FlashState& S_, const unsigned short* qlds, AselLds* A, float* xch, int stage, int b, int cur, int q0, int qbase, int h, float c31, int lane) {
  const int r32 = lane & 31, hi = lane >> 5; const int ql = qbase + (r32 >> 2); const int q = q0 + ql;
  const bool selq = (A->sel[ql][b >> 5] >> (b & 31)) & 1u;
  if (!__any(selq)) return;
  bf16x8 qf[4];
#pragma unroll
  for (int d0 = 0; d0 < 4; ++d0) qf[d0] = *(const bf16x8*)&qlds[r32 * 64 + (((2 * d0 + hi) ^ ((r32 >> 1) & 7)) * 8)];
  const bool far = (q0 - (b * 64 + 63)) >= 1513; const bool edge = (b == cur);
#ifndef ASEL2
#define ASEL2 1
#endif
#if ASEL2
  bf16x8 kf0[4], kf1[4];
#pragma unroll
  for (int d0 = 0; d0 < 4; ++d0) { const int row0 = r32, row1 = 32 + r32;
    kf0[d0] = *(const bf16x8*)&A->k[stage][row0 * 64 + (((2 * d0 + hi) ^ ((row0 >> 1) & 7)) * 8)];
    kf1[d0] = *(const bf16x8*)&A->k[stage][row1 * 64 + (((2 * d0 + hi) ^ ((row1 >> 1) & 7)) * 8)]; }
  f32x16 s0 = zero16(), s1 = zero16();
#pragma unroll
  for (int d0 = 0; d0 < 4; ++d0) { s0 = MFMA32(kf0[d0], qf[d0], s0); s1 = MFMA32(kf1[d0], qf[d0], s1); }
  if (far) { flash_core2_lin(S_, s0, s1, selq ? QSC : 0.f, selq ? c31 : NINF, A->v[stage], xch, lane); return; }
#pragma unroll
  for (int e = 0; e < 16; ++e) { const int tk = b * 64 + (e & 3) + 8 * (e >> 2) + 4 * hi; const int dist = q - tk; float b0, b1;
    { const int d0c = dist < 0 ? 0 : (dist > 1663 ? 1663 : dist); const int d1 = dist - 32; const int d1c = d1 < 0 ? 0 : (d1 > 1663 ? 1663 : d1);
      b0 = A->relS[A->bkt[d0c] * 4 + (h & 3)]; b1 = A->relS[A->bkt[d1c] * 4 + (h & 3)]; }
    float v0 = s0[e] * QSC + b0, v1 = s1[e] * QSC + b1; if (!selq || (edge && dist < 0)) v0 = NINF; if (!selq || (edge && dist < 32)) v1 = NINF; s0[e] = v0; s1[e] = v1; }
  flash_core2(S_, s0, s1, A->v[stage], xch, lane);
}
#else
#pragma unroll 1
  for (int kt = 0; kt < 2; ++kt) { const int t0 = b * 64 + 32 * kt; if (edge && t0 > q0 + qbase + 7) continue;
    bf16x8 kf[4]; { const int row = 32 * kt + r32;
#pragma unroll
      for (int d0 = 0; d0 < 4; ++d0) kf[d0] = *(const bf16x8*)&A->k[stage][row * 64 + (((2 * d0 + hi) ^ ((row >> 1) & 7)) * 8)]; }
    f32x16 s = zero16();
#pragma unroll
    for (int d0 = 0; d0 < 4; ++d0) s = MFMA32(kf[d0], qf[d0], s);
    if (far) { flash_core1_lin(S_, s, selq ? QSC : 0.f, selq ? c31 : NINF, A->v[stage] + kt * 1024, xch, lane); continue; }
#pragma unroll
    for (int e = 0; e < 16; ++e) { const int tk = t0 + (e & 3) + 8 * (e >> 2) + 4 * hi; const int dist = q - tk;
      const int dc = dist < 0 ? 0 : (dist > 2047 ? 2047 : dist); const float bsv = p.tabA[h * TABA_N + dc] * L2E;
      float vv = s[e] * QSC + bsv; if (!selq || (edge && dist < 0)) vv = NINF; s[e] = vv; }
    flash_core1(S_, s, A->v[stage] + kt * 1024, xch, lane);
  }
}
#endif
__device__ __forceinline__ void asel_store(const Params& p, FlashState& S_, float* xch, int q0, int qbase, int g, int lane) {
  const int r32 = lane & 31, hi = lane >> 5;
  const float lt = S_.l + xor32_f(S_.l); const float inv = lt > 0.f ? 1.f / lt : 0.f; xch[r32] = inv;
#pragma unroll
  for (int e = 0; e < 16; ++e) { const int j = crow(e, hi); const float a = xch[j]; const int q = q0 + qbase + (j >> 2), he = g * 4 + (j & 3);
    const float* gl = p.small + (long)q * NSMALL + he * 3; const float g0 = sigmoid_f(gl[0]), g1 = sigmoid_f(gl[1]), g2 = sigmoid_f(gl[2]);
#pragma unroll
    for (int db = 0; db < 2; ++db) { const long c = (long)q * 512 + he * 64 + db * 32 + r32; const float os = (db ? S_.o1[e] : S_.o0[e]) * a;
      const float av = g0 * bf2f(p.oc[c]) + g1 * os + g2 * bf2f(p.ow[c]); SB* mp = p.mix + (long)q * NMIX + MX_A + he * 64 + db * 32 + r32; *mp = f2bf(av * bf2f(*mp)); } }
}
template <bool STORE = true, bool NOSTEPS = false>
__device__ __forceinline__ void unit_asel_blk(const Params& p, int u, AselLds* A) {
  int tid = threadIdx.x; asm volatile("" : "+v"(tid));
  const int lane = tid & 63, w = __builtin_amdgcn_readfirstlane(tid >> 6), r32 = lane & 31, hi = lane >> 5;
  const int g = u & 1, qt = (p.S / 32 - 1) - (u >> 1), q0 = qt * 32, cur = q0 >> 6;
  const SB* kvb = p.proj + PA_KV + 2 * 128 + g * 64;
  __syncthreads();
  for (int i = tid; i < 64 * 8 + 8; i += 256) ((unsigned*)A->sel)[i] = 0u;
  for (int i = tid; i < 1664; i += 256) A->bkt[i] = (unsigned char)t5_bucket(i);
  if (tid < 128) A->relS[tid] = p.rel_bias[(tid >> 2) * 32 + g * 4 + (tid & 3)] * L2E;
#ifndef ASEL_NO_TOPK
  topk4_rows(p, [&](int r) { return (q0 + 8 * w + r) * 2 + g; }, lane); topk4_rows(p, [&](int r) { return (q0 + 8 * w + 4 + r) * 2 + g; }, lane);
  asm volatile("s_waitcnt vmcnt(0)" ::: "memory");
#endif
  __syncthreads();
#pragma unroll
  for (int i = 0; i < 2; ++i) { const int e = tid + 256 * i, ql = e >> 4, kk = e & 15; const int b = __hip_atomic_load(&p.idx[((long)(q0 + ql) * 2 + g) * 16 + kk], __ATOMIC_RELAXED, __HIP_MEMORY_SCOPE_AGENT);
    if (b >= 0) { atomicOr(&A->sel[ql][b >> 5], 1u << (b & 31)); atomicOr(&A->anyb[b >> 5], 1u << (b & 31)); } }
  __syncthreads();
  if (tid < 64) {
    const unsigned wbits = A->anyb[lane >> 3]; const unsigned nib = (wbits >> ((lane & 7) * 4)) & 15u; const int cnt = __popc(nib);
    int pre = cnt;
#pragma unroll
    for (int o = 1; o < 64; o <<= 1) { const int v = __shfl_up(pre, o); if (lane >= o) pre += v; }
    int pos = pre - cnt;
#pragma unroll
    for (int k = 0; k < 4; ++k) if ((nib >> k) & 1u) A->blist[pos++] = (unsigned char)(lane * 4 + k);
    if (lane == 63) A->nlist = pre;
  }
  __syncthreads();
  const int nlist = NOSTEPS ? 0 : A->nlist;
  const int hh = r32 & 3, h = g * 4 + hh; const float c31 = p.tabA[h * TABA_N + 2047] * L2E;
  FlashState st0;
  { bf16x8 qf0[4]; load_q(qf0, p.proj + (long)(q0 + 8 * w + (r32 >> 2)) * NPROJ + PA_Q + h * 64, hi);
#pragma unroll
    for (int d0 = 0; d0 < 4; ++d0) *(bf16x8*)&A->q[w][r32 * 64 + (((2 * d0 + hi) ^ ((r32 >> 1) & 7)) * 8)] = qf0[d0]; }
  st0.o0 = zero16(); st0.o1 = zero16(); st0.m = -1e30f; st0.l = 0.f;
  float* xch = A->xch[w];
#define ASEL_DMA(bb, stg) { const int b_ = (bb); _Pragma("unroll") for (int i_ = 0; i_ < 2; ++i_) { const int pk_ = 2 * w + i_; \
      { const int row_ = pk_ * 8 + (lane >> 3), pc_ = lane & 7; glds16_asm(kvb + (long)(b_ * 64 + row_) * NPROJ + ((pc_ ^ ((row_ >> 1) & 7)) * 8), (unsigned)__builtin_amdgcn_readfirstlane((int)lds_addr(&A->k[stg][pk_ * 512]))); } \
      { const int db_ = pk_ >> 2, row_ = (pk_ & 3) * 16 + (lane >> 2), wi_ = lane & 3; glds16_asm(kvb + 128 + (long)(b_ * 64 + row_) * NPROJ + db_ * 32 + wi_ * 8, (unsigned)__builtin_amdgcn_readfirstlane((int)lds_addr(&A->v[stg][db_ * 2048 + (pk_ & 3) * 512]))); } } }
  asm volatile("s_waitcnt vmcnt(0)" ::: "memory");
  if (nlist > 0) ASEL_DMA(A->blist[0], 0);
  if (nlist > 1) ASEL_DMA(A->blist[1], 1);
  int stage = 0;
  for (int it = 0; it < nlist; ++it) {
    const int b = A->blist[it];
    if (it + 1 < nlist) asm volatile("s_waitcnt vmcnt(4) lgkmcnt(0)\n\ts_barrier" ::: "memory"); else asm volatile("s_waitcnt vmcnt(0) lgkmcnt(0)\n\ts_barrier" ::: "memory");
    if (it + 2 < nlist) { const int s2_ = (stage == 0) ? 2 : stage - 1; ASEL_DMA(A->blist[it + 2], s2_); }
    asel_coltile(p, st0, A->q[w], A, xch, stage, b, cur, q0, 8 * w, h, c31, lane);
    stage = (stage == 2) ? 0 : stage + 1;
  }
  asm volatile("s_waitcnt vmcnt(0)" ::: "memory");
  if (STORE) asel_store(p, st0, xch, q0, 8 * w, g, lane); else asm volatile("" :: "v"(st0.o0[0]), "v"(st0.o1[5]), "v"(st0.l));
#undef ASEL_DMA
}
template <bool STORE = true>
__device__ __forceinline__ void unit_bout_blk(const Params& p, int layer, int ub, char* smem) {
  int tid = threadIdx.x; asm volatile("" : "+v"(tid));
  const int lane = tid & 63, w = __builtin_amdgcn_readfirstlane(tid >> 6), r32 = lane & 31, hi = lane >> 5;
  const int lt = ub & 3, g = (ub >> 2) & 1, c = ub >> 3, hd = g * 4 + w;
  WaveLds2* L = ((WaveLds2*)smem) + w;
  __syncthreads();
  for (int x = lane; x < 128; x += 64) { L->acs[x] = p.acs[((long)c * 128 + x) * 8 + hd]; L->dtv[x] = p.dt[((long)c * 128 + x) * 8 + hd]; }
  f32x16 acc[2] = {zero16(), zero16()}, acc2[2] = {zero16(), zero16()};
  const SB* xb = p.xconv + (long)c * 128 * 1024; const int l = 32 * lt + r32; const float al = p.acs[((long)c * 128 + l) * 8 + hd];
  const float* cbr = p.cb + ((long)c * 2 + g) * 16384 + (long)l * 128;
  for (int sc = 0; sc <= lt; ++sc) {
    stage_slab<false>(L->x, xb + (long)(32 * sc) * 1024 + hd * 64, 1024, [&](int) { return 1.f; }, lane);
#pragma unroll
    for (int s2 = 0; s2 < 2; ++s2) { float mv[8];
#pragma unroll
      for (int jj = 0; jj < 2; ++jj) { const int s0 = 32 * sc + 16 * s2 + 8 * jj + 4 * hi; const float4 cv = *(const float4*)(cbr + s0); const float4 av = *(const float4*)(&L->acs[s0]); const float4 dv = *(const float4*)(&L->dtv[s0]);
        mv[4 * jj + 0] = (s0 + 0 <= l) ? cv.x * __expf(al - av.x) * dv.x : 0.f; mv[4 * jj + 1] = (s0 + 1 <= l) ? cv.y * __expf(al - av.y) * dv.y : 0.f;
        mv[4 * jj + 2] = (s0 + 2 <= l) ? cv.z * __expf(al - av.z) * dv.z : 0.f; mv[4 * jj + 3] = (s0 + 3 <= l) ? cv.w * __expf(al - av.w) * dv.w : 0.f; }
      u32x4 aw; aw[0] = pk2(mv[0], mv[1]); aw[1] = pk2(mv[2], mv[3]); aw[2] = pk2(mv[4], mv[5]); aw[3] = pk2(mv[6], mv[7]); const bf16x8 af = __builtin_bit_cast(bf16x8, aw);
#pragma unroll
      for (int pt = 0; pt < 2; ++pt) acc[pt] = MFMA32(af, slab_frag(L->x, pt, s2, lane), acc[pt]); } }
  const SB* cmr = xb + (long)l * 1024 + 768 + g * 128; const float* prv = p.states + ((long)c * 8 + hd) * 8192;
#pragma unroll 2
  for (int ks = 0; ks < 8; ++ks) { const bf16x8 af = *(const bf16x8*)(cmr + 16 * ks + 8 * hi);
#pragma unroll
    for (int pt = 0; pt < 2; ++pt) { const float* pr = prv + (long)(32 * pt + r32) * 128 + 16 * ks + 8 * hi; const float4 a0 = *(const float4*)pr, a1 = *(const float4*)(pr + 4);
      u32x4 bw; bw[0] = pk2(a0.x, a0.y); bw[1] = pk2(a0.z, a0.w); bw[2] = pk2(a1.x, a1.y); bw[3] = pk2(a1.z, a1.w);
      acc2[pt] = MFMA32(af, __builtin_bit_cast(bf16x8, bw), acc2[pt]); } }
  const float dsk = p.b_d[layer * 8 + hd];
  float* yl = (float*)L;
#pragma unroll
  for (int e = 0; e < 16; ++e) { const int lr = crow(e, hi); const float ea = __expf(L->acs[32 * lt + lr]);
#pragma unroll
    for (int pt = 0; pt < 2; ++pt) { const int pp = 32 * pt + r32; yl[lr * 64 + pp] = acc[pt][e] + ea * acc2[pt][e] + dsk * bf2f(xb[(long)(32 * lt + lr) * 1024 + hd * 64 + pp]); } }
  __syncthreads();
  { const int row = tid >> 3, sub = tid & 7; const long t = (long)c * 128 + 32 * lt + row; SB* mp = p.mix + t * NMIX + MX_B + g * 256 + sub * 32;
    const float* ysrc = (const float*)(((WaveLds2*)smem) + (sub >> 1)) + row * 64 + (sub & 1) * 32;
    float vv[32]; float ss = 0.f;
#pragma unroll
    for (int i = 0; i < 4; ++i) { const uint4 zz = *(const uint4*)(mp + 8 * i); const unsigned zw[4] = {zz.x, zz.y, zz.z, zz.w};
#pragma unroll
      for (int k = 0; k < 4; ++k) { const float y0 = ysrc[8 * i + 2 * k] * __uint_as_float(zw[k] << 16), y1 = ysrc[8 * i + 2 * k + 1] * __uint_as_float(zw[k] & 0xffff0000u); vv[8 * i + 2 * k] = y0; vv[8 * i + 2 * k + 1] = y1; ss += y0 * y0 + y1 * y1; } }
    ss += __shfl_xor(ss, 1); ss += __shfl_xor(ss, 2); ss += __shfl_xor(ss, 4);
    const float r = 1.f / sqrtf(ss * (1.f / 256.f) + 1e-6f); const float* wn = p.b_norm + layer * 512 + g * 256 + sub * 32;
#pragma unroll
    for (int i = 0; i < 4; ++i) { uint4 o; o.x = pk2(vv[8 * i] * r * wn[8 * i], vv[8 * i + 1] * r * wn[8 * i + 1]); o.y = pk2(vv[8 * i + 2] * r * wn[8 * i + 2], vv[8 * i + 3] * r * wn[8 * i + 3]);
      o.z = pk2(vv[8 * i + 4] * r * wn[8 * i + 4], vv[8 * i + 5] * r * wn[8 * i + 5]); o.w = pk2(vv[8 * i + 6] * r * wn[8 * i + 6], vv[8 * i + 7] * r * wn[8 * i + 7]); if (STORE) *(uint4*)(mp + 8 * i) = o; else asm volatile("" :: "v"(o.x), "v"(o.w)); } }
}

__device__ __forceinline__ void unit_memkv(const Params& p, int u, int lane) {
  const int l = u >> 8, m = u & 255; const float* row = p.mem + (long)m * DM; const float* nw = p.m_norm + l * DM; const float* w = p.m_wkv + (long)l * DM * 512 + lane * 8;
  float ss = 0.f;
#pragma unroll
  for (int i = 0; i < 4; ++i) { const float4 v = *(const float4*)(row + i * 256 + lane * 4); ss += v.x * v.x + v.y * v.y + v.z * v.z + v.w * v.w; }
  ss = wave_sum_f(ss); const float r = 1.f / sqrtf(ss * (1.f / DM) + 1e-6f);
  float acc[8] = {0.f, 0.f, 0.f, 0.f, 0.f, 0.f, 0.f, 0.f};
#pragma unroll 8
  for (int d = 0; d < DM; ++d) { const float a = row[d] * r * nw[d]; const float4 w0 = *(const float4*)(w + (long)d * 512), w1 = *(const float4*)(w + (long)d * 512 + 4);
    acc[0] += a * w0.x; acc[1] += a * w0.y; acc[2] += a * w0.z; acc[3] += a * w0.w; acc[4] += a * w1.x; acc[5] += a * w1.y; acc[6] += a * w1.z; acc[7] += a * w1.w; }
  uint4 o; o.x = pk2(acc[0], acc[1]); o.y = pk2(acc[2], acc[3]); o.z = pk2(acc[4], acc[5]); o.w = pk2(acc[6], acc[7]);
  *(uint4*)(p.memkv + (long)u * 512 + lane * 8) = o;
}

__device__ __forceinline__ void item_dmerge(const Params& p, long gid) {
  const int c8 = (int)(gid & 63), h = c8 >> 3; const long q = gid >> 6; const long S = p.S;
  const float l0 = p.dlse[(0 * S + q) * 8 + h], l1 = p.dlse[(1 * S + q) * 8 + h], l2 = p.dlse[(2 * S + q) * 8 + h];
  const float mm = fmaxf(l0, fmaxf(l1, l2)); float e0 = __expf(l0 - mm), e1 = __expf(l1 - mm), e2 = __expf(l2 - mm); const float is = 1.f / (e0 + e1 + e2); e0 *= is; e1 *= is; e2 *= is;
  const long c = q * 512 + c8 * 8; const uint4 a = *(const uint4*)(p.dop + c), b = *(const uint4*)(p.dop + S * 512 + c), d = *(const uint4*)(p.dop + 2 * S * 512 + c);
  SB* mp = p.mix + q * NMIX + MX_D + c8 * 8; const uint4 z = *(const uint4*)mp;
  const unsigned aw[4] = {a.x, a.y, a.z, a.w}, bw[4] = {b.x, b.y, b.z, b.w}, dw[4] = {d.x, d.y, d.z, d.w}, zw[4] = {z.x, z.y, z.z, z.w}; unsigned ow[4];
#pragma unroll
  for (int k = 0; k < 4; ++k) {
    const float lo = (e0 * __uint_as_float(aw[k] << 16) + e1 * __uint_as_float(bw[k] << 16) + e2 * __uint_as_float(dw[k] << 16)) * __uint_as_float(zw[k] << 16);
    const float hi = (e0 * __uint_as_float(aw[k] & 0xffff0000u) + e1 * __uint_as_float(bw[k] & 0xffff0000u) + e2 * __uint_as_float(dw[k] & 0xffff0000u)) * __uint_as_float(zw[k] & 0xffff0000u);
    ow[k] = pk2(lo, hi); }
  uint4 o; o.x = ow[0]; o.y = ow[1]; o.z = ow[2]; o.w = ow[3]; *(uint4*)mp = o;
}

__device__ __forceinline__ void unit_cmp_blk(const Params& p, int layer, int u, float* red  ) {
  int tid = threadIdx.x; asm volatile("" : "+v"(tid));
  const int lane = tid & 63, w = __builtin_amdgcn_readfirstlane(tid >> 6), r32 = lane & 31, hi = lane >> 5;
  const int ncmp = p.S / 16, ntile = ncmp * 2 / 32; const int kv = u / ntile, rt = u % ntile;
  const int r = 32 * rt + r32, j = r >> 1, hk = r & 1;
  const unsigned short* w1t = p.w1t + (long)kv * 128 * 2048; const unsigned short* w2t = p.w2t + kv * 64 * 128; const float* pe = p.cmp_pos + (long)(layer * 2 + kv) * 32 * 64;
  const SB* src = p.proj + PA_KV + kv * 128 + hk * 64;
  f32x16 acc[4] = {zero16(), zero16(), zero16(), zero16()};
#pragma unroll 4
  for (int ks = 32 * w; ks < 32 * w + 32; ++ks) { const int t = ks >> 2, d = (ks & 3) * 16 + 8 * hi; const long tok = 16 * j + t;
    const float4 p0 = *(const float4*)(pe + t * 64 + d), p1 = *(const float4*)(pe + t * 64 + d + 4); float v[8] = {p0.x, p0.y, p0.z, p0.w, p1.x, p1.y, p1.z, p1.w};
    { const long tokc = tok < p.S ? tok : (long)p.S - 1; const float vm = tok < p.S ? 1.f : 0.f;
      const uint4 vv = *(const uint4*)(src + tokc * NPROJ + d); const unsigned wd[4] = {vv.x, vv.y, vv.z, vv.w};
#pragma unroll
      for (int k = 0; k < 4; ++k) { v[2 * k] += vm * __uint_as_float(wd[k] << 16); v[2 * k + 1] += vm * __uint_as_float(wd[k] & 0xffff0000u); } }
    u32x4 bw; bw[0] = pk2(v[0], v[1]); bw[1] = pk2(v[2], v[3]); bw[2] = pk2(v[4], v[5]); bw[3] = pk2(v[6], v[7]); const bf16x8 bfr = __builtin_bit_cast(bf16x8, bw);
#pragma unroll
    for (int ut = 0; ut < 4; ++ut) { const bf16x8 af = *(const bf16x8*)(w1t + (long)(32 * ut + r32) * 2048 + 16 * ks + 8 * hi); acc[ut] = MFMA32(af, bfr, acc[ut]); } }
  __syncthreads();
#pragma unroll
  for (int ut = 0; ut < 4; ++ut)
#pragma unroll
    for (int q4 = 0; q4 < 4; ++q4) *(float4*)&red[(((w * 4 + ut) * 4 + q4) * 64 + lane) * 4] = make_float4(acc[ut][4 * q4], acc[ut][4 * q4 + 1], acc[ut][4 * q4 + 2], acc[ut][4 * q4 + 3]);
  __syncthreads();
  f32x16 hsum = zero16();
#pragma unroll
  for (int w2 = 0; w2 < 4; ++w2)
#pragma unroll
    for (int q4 = 0; q4 < 4; ++q4) { const float4 t4 = *(const float4*)&red[(((w2 * 4 + w) * 4 + q4) * 64 + lane) * 4]; hsum[4 * q4] += t4.x; hsum[4 * q4 + 1] += t4.y; hsum[4 * q4 + 2] += t4.z; hsum[4 * q4 + 3] += t4.w; }
#pragma unroll
  for (int e = 0; e < 16; ++e) hsum[e] = gelu_f(hsum[e]);
  f32x16 o2[2] = {zero16(), zero16()};
#pragma unroll
  for (int s2 = 0; s2 < 2; ++s2) { const bf16x8 hb = pack8(hsum, 8 * s2);
#pragma unroll
    for (int dt = 0; dt < 2; ++dt) { const unsigned short* wr = w2t + (32 * dt + r32) * 128 + 32 * w + 16 * s2 + 4 * hi; const uint2 x0 = *(const uint2*)wr, x1 = *(const uint2*)(wr + 8);
      u32x4 aw; aw[0] = x0.x; aw[1] = x0.y; aw[2] = x1.x; aw[3] = x1.y; o2[dt] = MFMA32(__builtin_bit_cast(bf16x8, aw), hb, o2[dt]); } }
  __syncthreads();
#pragma unroll
  for (int dt = 0; dt < 2; ++dt)
#pragma unroll
    for (int q4 = 0; q4 < 4; ++q4) *(float4*)&red[(((w * 2 + dt) * 4 + q4) * 64 + lane) * 4] = make_float4(o2[dt][4 * q4], o2[dt][4 * q4 + 1], o2[dt][4 * q4 + 2], o2[dt][4 * q4 + 3]);
  __syncthreads();
  if (w < 2) {
    const int dt = w; SB* dst = p.kvc + ((long)kv * ncmp * 2 + r) * 64;
#pragma unroll
    for (int q4 = 0; q4 < 4; ++q4) { float4 s4 = make_float4(0.f, 0.f, 0.f, 0.f);
#pragma unroll
      for (int w2 = 0; w2 < 4; ++w2) { const float4 t4 = *(const float4*)&red[(((w2 * 2 + dt) * 4 + q4) * 64 + lane) * 4]; s4.x += t4.x; s4.y += t4.y; s4.z += t4.z; s4.w += t4.w; }
      dst[32 * dt + crow(4 * q4 + 0, hi)] = f2bf(s4.x); dst[32 * dt + crow(4 * q4 + 1, hi)] = f2bf(s4.y); dst[32 * dt + crow(4 * q4 + 2, hi)] = f2bf(s4.z); dst[32 * dt + crow(4 * q4 + 3, hi)] = f2bf(s4.w); } }
}

#define SEQ 16384
#define DEPTH 4

__device__ __forceinline__ int n2o(int n) {
  if (n < 1280) return n;
  if (n < 2304) return n - 1280 + 1816;
  if (n < 2816) return n - 2304 + 3360;
  if (n < 3072) return n - 2816 + 3872;
  if (n < 4608) return n - 3072 + 4640;
  if (n < 5632) return n - 4608 + 6176;
  if (n < 5888) return n - 5632 + 7712;
  n -= 5888;
  if (n < 512) return 1304 + n;
  if (n < 1024) return 2848 + n - 512;
  if (n < 1536) return 4128 + n - 1024;
  if (n < 2048) return 7200 + n - 1536;
  if (n < 2304) return 7968 + n - 2048;
  n -= 2304;
  if (n < 24) return 1280 + n;
  if (n < 32) return 2840 + n - 24;
  return -1;
}

template <bool MAP>
__device__ __forceinline__ void cvt_tile(const float* __restrict__ src, int lds_, unsigned short* __restrict__ dst, int ldd, int k0, int n0, float* tile  ) {
  int tid = threadIdx.x; asm volatile("" : "+v"(tid));
  __syncthreads();
#pragma unroll
  for (int e = 0; e < 16; ++e) { int idx = tid + 256 * e, kk = idx >> 6, nn = idx & 63; int oc = MAP ? n2o(n0 + nn) : (n0 + nn);
    tile[kk * 65 + nn] = (oc >= 0) ? src[(long)(k0 + kk) * lds_ + oc] : 0.f; }
  __syncthreads();
#pragma unroll
  for (int e = 0; e < 16; ++e) { int idx = tid + 256 * e, nn = idx >> 6, kk = idx & 63; dst[(long)(n0 + nn) * ldd + k0 + kk] = f2bf(tile[kk * 65 + nn]); }
}

__device__ __forceinline__ float wave_sum(float v) {
#pragma unroll
  for (int o = 32; o > 0; o >>= 1) v += __shfl_xor(v, o);
  return v;
}

__device__ __forceinline__ void norm_row_wave(const Params& p, int layer, int t, bool do_h, int lane) {
  const float* xin = (layer == 0) ? p.x + (long)t * DM : p.out + (long)t * DM;
  float4 xv[4], yv[4];
#pragma unroll
  for (int i = 0; i < 4; ++i) xv[i] = *(const float4*)(xin + i * 256 + lane * 4);
  if (layer > 0) {
    float ss = 0.f;
#pragma unroll
    for (int i = 0; i < 4; ++i) { yv[i] = *(const float4*)(p.y + (long)t * DM + i * 256 + lane * 4); ss += yv[i].x * yv[i].x + yv[i].y * yv[i].y + yv[i].z * yv[i].z + yv[i].w * yv[i].w; }
    ss = wave_sum(ss); float r1 = 1.f / sqrtf(ss / DM + 1e-6f);
#pragma unroll
    for (int i = 0; i < 4; ++i) { float4 w = *(const float4*)(p.post_norm + (layer - 1) * DM + i * 256 + lane * 4);
      xv[i].x += yv[i].x * r1 * w.x; xv[i].y += yv[i].y * r1 * w.y; xv[i].z += yv[i].z * r1 * w.z; xv[i].w += yv[i].w * r1 * w.w; }
  }
  float ss2 = 0.f;
#pragma unroll
  for (int i = 0; i < 4; ++i) { *(float4*)(p.out + (long)t * DM + i * 256 + lane * 4) = xv[i]; ss2 += xv[i].x * xv[i].x + xv[i].y * xv[i].y + xv[i].z * xv[i].z + xv[i].w * xv[i].w; }
  if (!do_h) return;
  ss2 = wave_sum(ss2); float r2 = 1.f / sqrtf(ss2 / DM + 1e-6f);
#pragma unroll
  for (int i = 0; i < 4; ++i) { float4 w = *(const float4*)(p.pre_norm + layer * DM + i * 256 + lane * 4);
    ushort4 o; o.x = f2bf(xv[i].x * r2 * w.x); o.y = f2bf(xv[i].y * r2 * w.y); o.z = f2bf(xv[i].z * r2 * w.z); o.w = f2bf(xv[i].w * r2 * w.w);
    *(ushort4*)(p.h + (long)t * DM + i * 256 + lane * 4) = o; }
}

#ifndef GMI
#define GMI 4
#endif
struct GemmSmem { unsigned short a[3][64 * GMI * 32]; unsigned short b[3][128 * 32]; };
__device__ __forceinline__ void glds16(const void* g, void* lds_wave_base) { __builtin_amdgcn_global_load_lds((gptr_t)g, (lptr_t)lds_wave_base, 16, 0, 0); }
template <int EPI, int MI, bool DRY = false>
__device__ __forceinline__ void gemm_tile(const Params& p, const unsigned short* __restrict__ A, int lda, const unsigned short* __restrict__ Bt, int ldb, int K, int m0, int n0, GemmSmem& sm, float* outp = nullptr) {
  int tid = threadIdx.x; asm volatile("" : "+v"(tid));
  const int lane = tid & 63, wid = __builtin_amdgcn_readfirstlane(tid >> 6), wr = wid >> 1, wc = wid & 1, r = lane & 31, h = lane >> 5;
  f32x16 acc[MI][2];
#pragma unroll
  for (int i = 0; i < MI; ++i)
#pragma unroll
    for (int j = 0; j < 2; ++j) acc[i][j] = zero16();
  const int prow = lane >> 2, pc = lane & 3;
  const unsigned short* ga[MI]; const unsigned short* gb[2];
#pragma unroll
  for (int i = 0; i < MI; ++i) { const int row = (wid * MI + i) * 16 + prow; ga[i] = A + (long)(m0 + row) * lda + ((pc ^ ((row >> 2) & 3)) * 8); }
#pragma unroll
  for (int i = 0; i < 2; ++i) { const int row = (wid * 2 + i) * 16 + prow; gb[i] = Bt + (long)(n0 + row) * ldb + ((pc ^ ((row >> 2) & 3)) * 8); }
#define GEMM_DMA(stg, ko) { _Pragma("unroll") for (int i_ = 0; i_ < MI; ++i_) glds16(ga[i_] + (ko), &sm.a[stg][(wid * MI + i_) * 512]); _Pragma("unroll") for (int i_ = 0; i_ < 2; ++i_) glds16(gb[i_] + (ko), &sm.b[stg][(wid * 2 + i_) * 512]); }
  __syncthreads();
  const int nk = K / 32;
  GEMM_DMA(0, 0)
  if (nk > 1) GEMM_DMA(1, 32)
  int cur = 0;
  for (int kt = 0; kt < nk; ++kt) {
    if (kt + 1 < nk) { if (MI == 4) asm volatile("s_waitcnt vmcnt(6) lgkmcnt(0)\n\ts_barrier" ::: "memory"); else asm volatile("s_waitcnt vmcnt(4) lgkmcnt(0)\n\ts_barrier" ::: "memory"); }
    else asm volatile("s_waitcnt vmcnt(0) lgkmcnt(0)\n\ts_barrier" ::: "memory");
    if (kt + 2 < nk) { const int s2_ = (cur == 0) ? 2 : cur - 1; GEMM_DMA(s2_, (kt + 2) * 32) }
#pragma unroll
    for (int ks = 0; ks < 2; ++ks) {
      bf16x8 af[MI], bfr[2];
#pragma unroll
      for (int i = 0; i < MI; ++i) { const int row = wr * (32 * MI) + i * 32 + r; af[i] = *(const bf16x8*)&sm.a[cur][row * 32 + (((2 * ks + h) ^ ((row >> 2) & 3)) * 8)]; }
#pragma unroll
      for (int j = 0; j < 2; ++j) { const int row = wc * 64 + j * 32 + r; bfr[j] = *(const bf16x8*)&sm.b[cur][row * 32 + (((2 * ks + h) ^ ((row >> 2) & 3)) * 8)]; }
#pragma unroll
      for (int i = 0; i < MI; ++i)
#pragma unroll
        for (int j = 0; j < 2; ++j) acc[i][j] = __builtin_amdgcn_mfma_f32_32x32x16_bf16(af[i], bfr[j], acc[i][j], 0, 0, 0);
    }
    cur = (cur == 2) ? 0 : cur + 1;
  }
#undef GEMM_DMA
  __syncthreads();
  if (DRY) {
#pragma unroll
    for (int i = 0; i < MI; ++i) asm volatile("" :: "v"(acc[i][0]), "v"(acc[i][1]));
    return; }
  const int ncol0 = n0 + wc * 64;
  const int mrow0 = m0 + wr * (32 * MI);
  if (EPI == 2) {
#pragma unroll
    for (int i = 0; i < MI; ++i)
#pragma unroll
      for (int j = 0; j < 2; ++j)
#pragma unroll
        for (int e = 0; e < 16; ++e) { int row = mrow0 + i * 32 + (e & 3) + 8 * (e >> 2) + 4 * h; outp[row * 128 + ncol0 + j * 32 + r] = acc[i][j][e]; }
  } else if (EPI == 1) {
#pragma unroll
    for (int i = 0; i < MI; ++i)
#pragma unroll
      for (int j = 0; j < 2; ++j)
#pragma unroll
        for (int e = 0; e < 16; ++e) { int row = mrow0 + i * 32 + (e & 3) + 8 * (e >> 2) + 4 * h; p.y[(long)row * DM + ncol0 + j * 32 + r] = acc[i][j][e]; }
  } else {
    if (ncol0 < 8192) {
      const bool toproj = ncol0 < NPROJ; const bool rope = toproj && (ncol0 >= PC_Q && ncol0 < PC_KV + 128);
      unsigned short* stg = ((unsigned short*)&sm) + wid * (64 * 72);
      SB* gdst = toproj ? (p.proj + ncol0) : (p.mix + (ncol0 - NPROJ)); const long gld = toproj ? NPROJ : NMIX;
#pragma unroll
      for (int hf = 0; hf < MI / 2; ++hf) {
#pragma unroll
        for (int i2 = 0; i2 < 2; ++i2) { const int i = hf * 2 + i2;
#pragma unroll
          for (int e = 0; e < 16; ++e) { const int rl = i2 * 32 + (e & 3) + 8 * (e >> 2) + 4 * h; float v0 = acc[i][0][e], v1 = acc[i][1][e];
            if (rope) { const int row = mrow0 + hf * 64 + rl; const float c = p.rope_cs[row * 32 + r], s = p.rope_sn[row * 32 + r]; const float t1 = v0, t2 = v1; v0 = t1 * c - t2 * s; v1 = t2 * c + t1 * s; }
            if (!toproj) { v0 = silu_f(v0); v1 = silu_f(v1); }
            stg[rl * 72 + r] = f2bf(v0); stg[rl * 72 + 32 + r] = f2bf(v1); } }
#pragma unroll
        for (int c8 = 0; c8 < 8; ++c8) { const int idx = lane + 64 * c8, rl = idx >> 3, ch = idx & 7; const uint4 vv = *(const uint4*)&stg[rl * 72 + ch * 8];
          *(uint4*)(gdst + (long)(mrow0 + hf * 64 + rl) * gld + ch * 8) = vv; }
      }
    } else if (ncol0 == 8192) {
#pragma unroll
      for (int i = 0; i < MI; ++i)
#pragma unroll
        for (int e = 0; e < 16; ++e) { int row = mrow0 + i * 32 + (e & 3) + 8 * (e >> 2) + 4 * h; p.small[(long)row * NSMALL + r] = acc[i][0][e]; }
    }
  }
}

__device__ __forceinline__ unsigned tx_() { unsigned t = threadIdx.x; asm volatile("" : "+v"(t)); return t; }
__device__ __forceinline__ int gw0(int) { return (int)((blockIdx.x * 256u + tx_()) >> 6); }
__device__ __forceinline__ int bid0() { int b = blockIdx.x; asm volatile("" : "+s"(b)); return b; }

#define XB_TMO      128
#define XB_XCNT(j)  (256  + 64 * (j))
#define XB_XSUB(j)  (1280 + 64 * (j))
#define XB_XGEN(j)  (2304 + 64 * (j))
#define XB_TOP      3328
#define XB_TOPGEN   3392
#define XCD_BAR_WORDS 3456
#define XB_SPIN_CAP (1u << 28)
__device__ __forceinline__ unsigned xb_ld(unsigned* p) { return __hip_atomic_load(p, __ATOMIC_RELAXED, __HIP_MEMORY_SCOPE_AGENT); }
__device__ __forceinline__ unsigned xb_add(unsigned* p, unsigned v) { return __hip_atomic_fetch_add(p, v, __ATOMIC_RELAXED, __HIP_MEMORY_SCOPE_AGENT); }
__device__ __forceinline__ unsigned xb_xcc_id() { return (unsigned)__builtin_amdgcn_s_getreg((3 << 11) | 20) & 0xFu; }
#define XB_SPIN(cond, bar) do { unsigned _sp = 0; while (cond) { __builtin_amdgcn_s_sleep(1); \
    if ((++_sp & 255u) == 0u) { if (xb_ld(&(bar)[XB_TMO])) break; if (_sp > XB_SPIN_CAP) { atomicAdd(&(bar)[XB_TMO], 1u); break; } } } } while (0)
struct XcdBarrier { unsigned* bar; unsigned x; volatile LDS3 unsigned* st; };
__device__ __forceinline__ XcdBarrier xcd_barrier_post(unsigned* bar, volatile LDS3 unsigned* st) {
  XcdBarrier b; b.bar = bar; b.x = xb_xcc_id(); b.st = st;
  if (threadIdx.x == 0) (void)xb_add(&bar[XB_XCNT(b.x)], 1u);
  return b;
}
__device__ __forceinline__ void xcd_barrier_complete(unsigned* bar, unsigned x, unsigned& nloc, unsigned& nx) {
  const unsigned G = gridDim.x; unsigned sum, cnt, mine, sp = 0u;
  for (;;) { sum = 0u; cnt = 0u; mine = 0u;
#pragma unroll
    for (unsigned j = 0; j < 16; ++j) { const unsigned c = xb_ld(&bar[XB_XCNT(j)]); sum += c; cnt += (c > 0u) ? 1u : 0u; mine = (j == x) ? c : mine; }
    if (sum == G) break;
    __builtin_amdgcn_s_sleep(1);
    if ((++sp & 255u) == 0u) { if (xb_ld(&bar[XB_TMO])) break; if (sp > XB_SPIN_CAP) { atomicAdd(&bar[XB_TMO], 1u); break; } } }
  nloc = mine > 0u ? mine : 1u; nx = cnt > 0u ? cnt : 1u;
}
__device__ __forceinline__ void xcd_barrier(const XcdBarrier& b) {
  asm volatile("s_waitcnt vmcnt(0)" ::: "memory");
  __syncthreads();
  if (threadIdx.x == 0) {
    unsigned* bar = b.bar;
    __builtin_amdgcn_s_waitcnt(0);
    unsigned nloc = b.st[0], nx = b.st[1];
    if (nloc == 0u) { xcd_barrier_complete(bar, b.x, nloc, nx); b.st[0] = nloc; b.st[1] = nx; }
    const unsigned old = xb_add(&bar[XB_XSUB(b.x)], 1u);
    const unsigned gen = old / nloc;
    if (old + 1u == (gen + 1u) * nloc) {
      __builtin_amdgcn_fence(__ATOMIC_RELEASE, "agent");
      asm volatile("s_waitcnt vmcnt(0)" ::: "memory");
      const unsigned og = xb_add(&bar[XB_TOP], 1u);
      const unsigned tg = og / nx;
      if (og + 1u == (tg + 1u) * nx) xb_add(&bar[XB_TOPGEN], 1u);
      else XB_SPIN(xb_ld(&bar[XB_TOPGEN]) == tg, bar);
      __builtin_amdgcn_fence(__ATOMIC_ACQUIRE, "agent");
      xb_add(&bar[XB_XGEN(b.x)], 1u);
      asm volatile("s_waitcnt vmcnt(0)" ::: "memory");
    } else {
      XB_SPIN(xb_ld(&bar[XB_XGEN(b.x)]) == gen, bar);
      __builtin_amdgcn_fence(__ATOMIC_ACQUIRE, "agent");
      asm volatile("s_waitcnt vmcnt(0)" ::: "memory");
    }
  }
  __syncthreads();
}

struct KArgs { const void* in[20]; float* out; char* ws; };
#ifdef SELFCHK
#define RUN_S 4096
#else
#define RUN_S SEQ
#endif
__host__ __device__ __forceinline__ size_t fill_ws(Params& p, Params& p2, char* w) {
  size_t off = 0;
#define TAKE(bytes) (w + ((off += (((size_t)(bytes)) + 255) & ~(size_t)255) - ((((size_t)(bytes)) + 255) & ~(size_t)255)))
  const size_t S = RUN_S, ncmp = S / 16, nc = S / 128;
  p.S = RUN_S;
  p.wt_in = (unsigned short*)TAKE(8320 * 1024 * 2); p.wt_out = (unsigned short*)TAKE(2 * 1024 * 2304 * 2); p.w1t = (unsigned short*)TAKE(2 * 128 * 2048 * 2); p.w2t = (unsigned short*)TAKE(2 * 64 * 128 * 2);
  p.h = (SB*)TAKE(S * 1024 * 2); p.ybuf = (float*)p.h;
  p.proj = (SB*)TAKE(S * NPROJ * 2); p.y = (float*)p.proj;
  p.small = (float*)TAKE(S * 32 * 4); p.mix = (SB*)TAKE(S * NMIX * 2);
  p.rope_cs = (float*)TAKE(S * 32 * 4); p.rope_sn = (float*)TAKE(S * 32 * 4); p.tabA = (float*)TAKE(8 * TABA_N * 4); p.tabD = (float*)TAKE(24 * TABD_N * 4);
  p.memkv = (SB*)TAKE(4 * 256 * 512 * 2); p.hid = (float*)TAKE(2 * ncmp * 256 * 4); p.kvc = (SB*)TAKE(2 * ncmp * 128 * 2);
  p.cml = (float*)TAKE(S * 16 * 4); p.idx = (int*)TAKE(S * 32 * 4); p.oc = (SB*)TAKE(S * 512 * 2); p.ow = (SB*)TAKE(S * 512 * 2);
  p.dop = (SB*)TAKE(3 * S * 512 * 2); p.dlse = (float*)TAKE(3 * S * 8 * 4); p.xconv = (SB*)TAKE(S * 1024 * 2);
  p.dt = (float*)TAKE(S * 8 * 4); p.acs = (float*)TAKE(S * 8 * 4); p.wst = (float*)TAKE(S * 8 * 4); p.cb = (float*)TAKE(nc * 2 * 128 * 128 * 4); p.states = (float*)TAKE(nc * 65536 * 4);
  p.bar = (unsigned*)TAKE(131072);
  p2 = p;
#ifdef SELFCHK
  p.imp = (float*)TAKE(S * 512 * 4);
  p2.mix = (SB*)TAKE(S * NMIX * 2); p2.ow = (SB*)TAKE(S * 512 * 2); p2.oc = (SB*)TAKE(S * 512 * 2); p2.dop = (SB*)TAKE(3 * S * 512 * 2); p2.dlse = (float*)TAKE(3 * S * 8 * 4);
  p2.cml = (float*)TAKE(S * 16 * 4); p2.imp = (float*)TAKE(S * 512 * 4); p2.idx = (int*)TAKE(S * 32 * 4); p2.cb = (float*)TAKE(nc * 2 * 128 * 128 * 4);
  p2.kvc = (SB*)TAKE(2 * ncmp * 128 * 2); p2.xconv = (SB*)TAKE(S * 1024 * 2); p2.dt = (float*)TAKE(S * 8 * 4); p2.acs = (float*)TAKE(S * 8 * 4); p2.wst = (float*)TAKE(S * 8 * 4);
  p2.states = (float*)TAKE(nc * 65536 * 4); p2.ybuf = (float*)TAKE(S * 512 * 4); p.ybuf = (float*)TAKE(S * 512 * 4);
#else
  p.imp = (float*)p.dop; p2 = p;
#endif
  return off;
}
__host__ __device__ __forceinline__ void fill_inputs(Params& p, const KArgs& a) {
  p.x = (const float*)a.in[0]; p.mem = (const float*)a.in[1]; p.pos = (const int*)a.in[2]; p.pre_norm = (const float*)a.in[3]; p.post_norm = (const float*)a.in[4];
  p.w_in = (const float*)a.in[5]; p.w_out = (const float*)a.in[6]; p.rel_bias = (const float*)a.in[7]; p.cmp_pos = (const float*)a.in[8]; p.cmp_w1 = (const float*)a.in[9];
  p.cmp_w2 = (const float*)a.in[10]; p.conv_w = (const float*)a.in[11]; p.conv_b = (const float*)a.in[12]; p.dt_bias = (const float*)a.in[13]; p.a_log = (const float*)a.in[14];
  p.b_d = (const float*)a.in[15]; p.b_norm = (const float*)a.in[16]; p.sinks = (const float*)a.in[17]; p.m_norm = (const float*)a.in[18]; p.m_wkv = (const float*)a.in[19];
  p.out = a.out;
}
#define GS(N, ...) { long g0_ = (long)blockIdx.x * 256 + tx_(); for (long gid = g0_; gid < (long)(N); gid += gsz) { __VA_ARGS__; } }
#define WU(N, ...) { for (int u_ = gw0(gwave); u_ < (int)(N); u_ += nwave) { const int u = __builtin_amdgcn_readfirstlane(u_); const unsigned tq_ = tx_(); int lane = tq_ & 63; \
    WaveLds* WL = ((WaveLds*)smem_raw) + __builtin_amdgcn_readfirstlane((int)(tq_ >> 6)); __VA_ARGS__; } }
#define GSYNC() xcd_barrier(xb)
#ifndef CMP_SKIP
#define CMP_SKIP 3
#endif
#define WUQ(slot, CH, N, ...) { unsigned* cq_ = &p.bar[4096 + (layer * 8 + (slot)) * 64 * 8 + (blockIdx.x & 7) * 64]; for (;;) { unsigned t_ = 0u; if ((tx_() & 63) == 0) t_ = atomicAdd(cq_, 1u); \
    const int c0_ = __builtin_amdgcn_readfirstlane((int)t_) * (CH); if ((c0_ * 8 + (int)(blockIdx.x & 7)) >= (int)(N)) break; \
    for (int ci_ = 0; ci_ < (CH); ++ci_) { const int u = (c0_ + ci_) * 8 + (int)(blockIdx.x & 7); if (u >= (int)(N)) break; const unsigned tq_ = tx_(); int lane = tq_ & 63; \
      WaveLds* WL = ((WaveLds*)smem_raw) + __builtin_amdgcn_readfirstlane((int)(tq_ >> 6)); (void)WL; __VA_ARGS__; } } }
#define SMEM_BYTES (sizeof(AselLds) > sizeof(GemmSmem) ? ((sizeof(AselLds) + 15) & ~(size_t)15) : sizeof(GemmSmem))
#define gtid ((long)blockIdx.x * 256 + tx_())
#define gwave ((int)((blockIdx.x * 256u + tx_()) >> 6))
#define KERNEL_PROLOGUE \
  Params p, p2; p.pad0 = 0; fill_inputs(p, ka); fill_ws(p, p2, ka.ws); \
  cg::grid_group grid = cg::this_grid(); \
  __shared__ __attribute__((aligned(16))) char smem_raw[SMEM_BYTES + 16]; \
  volatile LDS3 unsigned* xbst = (volatile LDS3 unsigned*)(smem_raw + SMEM_BYTES); \
  if (threadIdx.x < 4) xbst[threadIdx.x] = 0u; \
  __syncthreads(); \
  XcdBarrier xb = xcd_barrier_post(p.bar, xbst); \
  GemmSmem& gsm = *(GemmSmem*)smem_raw; float* ftile = (float*)smem_raw; \
  const long gsz = (long)gridDim.x * 256; const int nwave = (int)(gsz >> 6); \
  const int S = p.S, ncmp = S / 16, nc = S / 128, nqt = S / 32; (void)ncmp; (void)nc; (void)nqt; (void)ftile; (void)gsm; \
  GS((long)S * 32, ph_rope(p, gid)); \
  GS(8 * TABA_N + 24 * TABD_N, ph_tabs(p, gid)); \
  WU(DEPTH * 256, unit_memkv(p, u, lane));
#define PHASE_NORM(layer) \
    for (int t = gw0(gwave); t < S; t += nwave) { int lane = tx_() & 63; norm_row_wave(p, layer, t, true, lane); }
#define PHASE_CVT(layer) \
    { const float* wi = p.w_in + (long)(layer) * 1024 * 8224; unsigned short* wob_ = p.wt_out + (long)((layer) & 1) * 1024 * 2304; \
      for (int tl = bid0(); tl < 16 * 130; tl += gridDim.x) cvt_tile<true>(wi, 8224, p.wt_in, 1024, (tl & 15) * 64, (tl >> 4) * 64, ftile); \
      const float* wo = p.w_out + (long)(layer) * 2304 * 1024; \
      for (int tl = bid0(); tl < 36 * 16; tl += gridDim.x) cvt_tile<false>(wo, 1024, wob_, 2304, (tl % 36) * 64, (tl / 36) * 64, ftile); \
      for (int tl = bid0(); tl < 2 * 64; tl += gridDim.x) { const int kv = tl >> 6, t6 = tl & 63; cvt_tile<false>(p.cmp_w1 + (long)((layer) * 2 + kv) * 2048 * 128, 128, p.w1t + (long)kv * 128 * 2048, 2048, (t6 >> 1) * 64, (t6 & 1) * 64, ftile); } \
      for (int tl = bid0(); tl < 2 * 2; tl += gridDim.x) { const int kv = tl >> 1; cvt_tile<false>(p.cmp_w2 + (long)((layer) * 2 + kv) * 128 * 64, 64, p.w2t + (long)kv * 64 * 128, 128, (tl & 1) * 64, 0, ftile); } }
#define PHASE_P1(layer) PHASE_NORM(layer) PHASE_CVT(layer)
#define PHASE_P2() \
    {   \
      const int x_ = bid0() & 7, li_ = bid0() >> 3, nl_ = (gridDim.x + 7) >> 3, mtiles_ = S / (64 * GMI), mper_ = mtiles_ / 8; \
      if ((mper_ & 7) != 0 || (gridDim.x & 7) != 0) { for (int tl = bid0(); tl < mtiles_ * 65; tl += gridDim.x) { int mt = tl % mtiles_, nt = tl / mtiles_; gemm_tile<0, GMI>(p, p.h, DM, p.wt_in, DM, DM, mt * 64 * GMI, nt * 128, gsm); } } \
      else for (int t_ = li_; t_ < mper_ * 65; t_ += nl_) { const int half_ = t_ / 520, r_ = t_ % 520; int ml_, nt_; \
        if (r_ < 512) { ml_ = r_ & 7; nt_ = (r_ >> 6) * 8 + ((r_ & 63) >> 3); } else { ml_ = r_ - 512; nt_ = 64; } \
        gemm_tile<0, GMI>(p, p.h, DM, p.wt_in, DM, DM, (x_ * mper_ + half_ * 8 + ml_) * 64 * GMI, nt_ * 128, gsm); } }
#define PHASE_FLASH3(layer) \
    { const int nA = nqt * 8, nM = nqt * 4, nD = 3 * nqt * 8, nC = nqt * 8; \
      WU(nA + nM + nD + nC, { if (u < nA) unit_awin(p, u, WL, lane); else if (u < nA + nM) unit_m(p, layer, u - nA, WL, lane); \
                              else if (u < nA + nM + nD) unit_d(p, u - nA - nM, WL, lane); else unit_c(p, layer, u - nA - nM - nD, WL, lane); }); }
#define WU2(N, ...) { for (int u_ = gw0(gwave); u_ < (int)(N); u_ += nwave) { const int u = __builtin_amdgcn_readfirstlane(u_); const unsigned tq_ = tx_(); int lane = tq_ & 63; \
    WaveLds2* WL2 = ((WaveLds2*)smem_raw) + __builtin_amdgcn_readfirstlane((int)(tq_ >> 6)); __VA_ARGS__; } }
#define PHASE_CB() \
    for (int tl = bid0(); tl < nc * 2; tl += gridDim.x) { const SB* xb_ = p.xconv + (long)(tl >> 1) * 128 * 1024 + (tl & 1) * 128; gemm_tile<2, 2>(p, xb_ + 768, 1024, xb_ + 512, 1024, 128, 0, 0, gsm, p.cb + (long)tl * 16384); }

#ifndef SELFCHK
#define PH_BEGIN { char* wsb_ = ka.ws; asm volatile("" : "+s"(wsb_)); Params p, p2_; p.pad0 = 0; fill_inputs(p, ka); fill_ws(p, p2_, wsb_); (void)p2_;
#define PH_END }
__global__ void __launch_bounds__(256, LB2) mega(KArgs ka) {
  KERNEL_PROLOGUE
#ifdef REP_PRO
  GS((long)S * 32, ph_rope(p, gid)); GS(8 * TABA_N + 24 * TABD_N, ph_tabs(p, gid)); WU(DEPTH * 256, unit_memkv(p, u, lane));
#endif
#ifdef TSEL
  unsigned long long tlast = __builtin_amdgcn_s_memrealtime();
#define TMARK(id) { if (gtid == 0) { const unsigned long long tn = __builtin_amdgcn_s_memrealtime(); ((unsigned long long*)p.bar)[id] += tn - tlast; tlast = tn; } }
#else
#define TMARK(id)
#endif
  for (int layer = 0; layer < DEPTH; ++layer) {
    PH_BEGIN
    PHASE_P1(layer)
#ifdef REP_P1
    PHASE_P1(layer)
#endif
    PH_END
    if (layer == 0) grid.sync(); else GSYNC();
    PH_BEGIN
    TMARK(1)
    PHASE_P2()
#ifdef REP_G
    PHASE_P2()
#endif
#ifdef REP_G2
    { const int x_ = bid0() & 7, li_ = bid0() >> 3, nl_ = (gridDim.x + 7) >> 3; for (int t_ = li_; t_ < 520; t_ += nl_) { int ml_, nt_; if (t_ < 512) { ml_ = t_ & 7; nt_ = (t_ >> 6) * 8 + ((t_ & 63) >> 3); } else { ml_ = t_ - 512; nt_ = 64; }
        gemm_tile<0, GMI, true>(p, p.h, DM, p.wt_in, DM, DM, (x_ * 8 + ml_) * 64 * GMI, nt_ * 128, gsm); } }
#endif
    PH_END
    GSYNC();
    PH_BEGIN
    TMARK(2)
    { const int nCmp = 2 * (ncmp * 2 / 32), nA = nqt * 8, nM = nqt * 4, nD = 3 * nqt * 8, nC = nqt * 8, nF = nA + nM + nD + nC;
      const int cb0 = (int)gridDim.x - nCmp; const bool cmpw = ((int)blockIdx.x >= cb0) && (cb0 > 0); const int cw0 = cb0 * 4;
#define FLASH_UNIT(uu) {   \
        const int v_ = __builtin_amdgcn_readfirstlane(uu); const int gw_ = v_ % nwave, rr_ = v_ / nwave; const int x_ = (gw_ >> 2) & 7, lw_ = ((gw_ >> 5) << 2) | (gw_ & 3); int j_ = rr_ * (nwave >> 3) + lw_; \
        const unsigned tq_ = tx_(); int lane = tq_ & 63; WaveLds* WL = ((WaveLds*)smem_raw) + __builtin_amdgcn_readfirstlane((int)(tq_ >> 6)); \
        if ((nwave & 31) != 0) { const int u = v_; if (u < nA) unit_awin(p, u, WL, lane); else if (u < nA + nM) unit_m(p, layer, u - nA, WL, lane); else if (u < nA + nM + nD) unit_d(p, u - nA - nM, WL, lane); else unit_c(p, layer, u - nA - nM - nD, WL, lane); } \
        else if (j_ < nA / 8) unit_awin(p, x_ * (nA / 8) + j_, WL, lane); \
        else if ((j_ -= nA / 8) < nM / 8) unit_m(p, layer, x_ * (nM / 8) + j_, WL, lane); \
        else if ((j_ -= nM / 8) < nD / 24) unit_d(p, x_ * (nD / 24) + j_, WL, lane); \
        else if ((j_ -= nD / 24) < nD / 24) unit_d(p, nD / 3 + x_ * (nD / 24) + j_, WL, lane); \
        else if ((j_ -= nD / 24) < nD / 24) unit_d(p, 2 * (nD / 3) + x_ * (nD / 24) + j_, WL, lane); \
        else if ((j_ -= nD / 24) < nC / 8) unit_c(p, layer, x_ * (nC / 8) + j_, WL, lane); }
#ifdef REP_F3B
      WU(nA + nD, { if (u < nA) unit_awin(p, u, WL, lane); else unit_d(p, u - nA, WL, lane); });
#endif
#ifdef REP_CMPB
      for (int ub = bid0(); ub < nCmp; ub += gridDim.x) unit_cmp_blk(p, layer, ub, (float*)smem_raw); __syncthreads();
#endif
      if (cb0 <= 0) { for (int ub = bid0(); ub < nCmp; ub += gridDim.x) unit_cmp_blk(p, layer, ub, (float*)smem_raw); __syncthreads(); }
      else if (cmpw) { unit_cmp_blk(p, layer, (int)blockIdx.x - cb0, (float*)smem_raw); __syncthreads(); }
      for (int r_ = (cmpw ? CMP_SKIP : 0), u_ = gw0(gwave) + r_ * nwave; u_ < nF; u_ += nwave) FLASH_UNIT(u_)
      if (cb0 > 0) for (int e_ = gw0(gwave); e_ < CMP_SKIP * nCmp * 4; e_ += nwave) { const int u_ = (e_ / (nCmp * 4)) * nwave + cw0 + (e_ % (nCmp * 4)); if (u_ < nF) FLASH_UNIT(u_) }
#undef FLASH_UNIT
    }
    GS((long)S * 128, item_bconv(p, layer, gid));
    WU(nc * 8, unit_bdt(p, layer, u, lane));
    PH_END
    GSYNC();
    PH_BEGIN
    TMARK(3)
    WU(nqt * 8, unit_acmp1(p, u, WL, lane));
    __syncthreads();
    PHASE_CB()
    __syncthreads();
    WU2(nc * 16, unit_bstates(p, u, WL2, lane));
#ifdef REP_P4
    __syncthreads();
    WU(nqt * 8, unit_acmp1(p, u, WL, lane));
    __syncthreads();
    PHASE_CB()
    __syncthreads();
    WU2(nc * 16, unit_bstates(p, u, WL2, lane));
#endif
    GS((long)S * 64, item_dmerge(p, gid));
    PH_END
    GSYNC();
    PH_BEGIN
    TMARK(4)
    {
      const int nU = nqt * 8, hw_ = nwave >> 1; const int gw_ = gw0(gwave);
      if (65536 * 2 != (int)gsz || (nU & 3)) { WU(nU, unit_acmp2(p, u, lane)); }
      else if (gw_ >= hw_) { for (int u_ = gw_ - hw_; u_ < (nU / 4) * 3; u_ += hw_) { const int u = __builtin_amdgcn_readfirstlane(u_); int lane = tx_() & 63; unit_acmp2(p, u, lane); } }
      else { for (int u_ = (nU / 4) * 3 + gw_; u_ < nU; u_ += hw_) { const int u = __builtin_amdgcn_readfirstlane(u_); int lane = tx_() & 63; unit_acmp2(p, u, lane); } } }
#ifdef REP_P5A
    WU(nqt * 8, unit_acmp2(p, u, lane));
#endif
    GS(65536, ph_b_scan(p, gid));
    PH_END
    GSYNC();
    PH_BEGIN
    TMARK(5)
#ifdef REP_BOUT
    for (int ub = bid0(); ub < nc * 8; ub += gridDim.x) unit_bout_blk<false>(p, layer, ub, smem_raw);
#endif
    for (int ub = bid0(); ub < nc * 8; ub += gridDim.x) unit_bout_blk(p, layer, ub, smem_raw);
    TMARK(7)
#ifdef REP_ASEL2
    for (;;) { __syncthreads(); if (threadIdx.x == 0) xbst[2] = atomicAdd(&p.bar[48 + layer * 8 + 7], 1u); __syncthreads(); const int ub = (int)xbst[2]; if (ub >= (S / 32) * 2) break; unit_asel_blk<false>(p, ub, (AselLds*)smem_raw); }
#endif
#ifdef REP_ASEL3
    for (;;) { __syncthreads(); if (threadIdx.x == 0) xbst[2] = atomicAdd(&p.bar[48 + layer * 8 + 7], 1u); __syncthreads(); const int ub = (int)xbst[2]; if (ub >= (S / 32) * 2) break; unit_asel_blk<false, true>(p, ub, (AselLds*)smem_raw); }
#endif
    for (;;) { __syncthreads(); if (threadIdx.x == 0) xbst[2] = atomicAdd(&p.bar[48 + layer * 8 + 6], 1u); __syncthreads(); const int ub = (int)xbst[2]; if (ub >= (S / 32) * 2) break; unit_asel_blk(p, ub, (AselLds*)smem_raw); }
    PH_END
    GSYNC();
    PH_BEGIN
    TMARK(8)
    for (int tl = bid0(); tl < (S / (64 * GMI)) * 8; tl += gridDim.x) { int mt = tl >> 3, nt = tl & 7; gemm_tile<1, GMI>(p, p.mix, NMIX, p.wt_out + (long)(layer & 1) * 1024 * 2304, NMIX, NMIX, mt * 64 * GMI, nt * 128, gsm); }
#ifdef REP_P8
    for (int tl = bid0(); tl < (S / (64 * GMI)) * 8; tl += gridDim.x) { int mt = tl >> 3, nt = tl & 7; gemm_tile<1, GMI>(p, p.mix, NMIX, p.wt_out + (long)(layer & 1) * 1024 * 2304, NMIX, NMIX, mt * 64 * GMI, nt * 128, gsm); }
#endif
    PH_END
    GSYNC();
    PH_BEGIN
    TMARK(9)
#ifdef REP_BAR
    for (int q_ = 0; q_ < 8; ++q_) GSYNC();
#endif
    PH_END
  }
  for (int t = gw0(gwave); t < S; t += nwave) { int lane = tx_() & 63; norm_row_wave(p, DEPTH, t, false, lane); }
#ifdef TSEL
  GSYNC();
  { float best = -1.f; int bi = 0; for (int k = 1; k < 10; ++k) if (!((TSEL >> k) & 1)) { const float us = (float)((unsigned long long*)p.bar)[k] * 0.01f; if (us > best) { best = us; bi = k; } }
    const float kk = 10.f * (float)bi + floorf(log2f(best + 1.f));
    GS((long)S * 1024, p.out[gid] = kk); }
#endif
}
#else
__device__ __forceinline__ void chk_update(unsigned* slot, float diff, float ref) {
  atomicMax(&slot[0], __float_as_uint(fabsf(diff))); atomicMax(&slot[1], __float_as_uint(fabsf(ref)));
}
#define CMPB(slot, a, b_) chk_update(sl + (slot), bf2f(a) - bf2f(b_), bf2f(b_))
#define CMPF(slot, a, b_) chk_update(sl + (slot), (a) - (b_), (b_))
__global__ void __launch_bounds__(256, 1) mega(KArgs ka) {
  KERNEL_PROLOGUE
  if (gtid < 64) p.bar[gtid] = 0u;
  unsigned* sl = p.bar;
  const int layer = 0;
  PHASE_P1(layer)
  grid.sync();
  PHASE_P2()
  GSYNC();
  GS((long)S * NMIX, p2.mix[gid] = p.mix[gid]);
  GSYNC();
  PHASE_FLASH3(layer)
  __syncthreads();
  for (int ub = bid0(); ub < 2 * (ncmp * 2 / 32); ub += gridDim.x) unit_cmp_blk(p, layer, ub, (float*)smem_raw);
  __syncthreads();
  GS((long)S * 128, item_bconv(p, layer, gid));
  WU(nc * 8, unit_bdt(p, layer, u, lane));
  GS((long)2 * ncmp * 256, ph_cmp_hid(p2, layer, gid));
  GS((long)S * 8, ph_a_win(p2, gid));
  GS((long)S * 8, ph_c(p2, layer, gid));
  GS((long)3 * S * 8, ph_d(p2, gid));
  GS((long)S * 4, ph_m(p2, layer, gid));
  GS((long)S * 1024, ph_b_conv(p2, layer, gid));
  GS((long)nc * 8, ph_b_dt2(p2, layer, gid));
  GSYNC();
  GS((long)2 * ncmp * 128, ph_cmp_out(p2, layer, gid));
  GSYNC();
  GS((long)2 * ncmp * 128, CMPB(20, p.kvc[gid], p2.kvc[gid]));
  GS((long)S * 1024, CMPB(22, p.xconv[gid], p2.xconv[gid]));
  GS((long)S * 8, { CMPF(24, p.dt[gid], p2.dt[gid]); CMPF(24, p.acs[gid], p2.acs[gid]); CMPF(24, p.wst[gid], p2.wst[gid]); });
  GSYNC();
  GS((long)2 * ncmp * 128, p2.kvc[gid] = p.kvc[gid]);
  GS((long)S * 1024, p2.xconv[gid] = p.xconv[gid]);
  GS((long)S * 8, { p2.dt[gid] = p.dt[gid]; p2.acs[gid] = p.acs[gid]; p2.wst[gid] = p.wst[gid]; });
  GSYNC();
  WU(nqt * 8, unit_acmp1(p, u, WL, lane));
  __syncthreads();
  PHASE_CB()
  __syncthreads();
  WU2(nc * 16, unit_bstates(p, u, WL2, lane));
  GS((long)S * 8, ph_a_cmp1(p2, gid));
  GS((long)nc * 2 * 128 * 128, ph_b_cb(p2, gid));
  GS((long)nc * 65536, ph_b_states(p2, gid));
  GSYNC();
  WU(nqt * 8, unit_acmp2(p, u, lane));
  GS((long)S * 2, ph_a_cmp2(p2, gid));
  GS((long)nc * 65536, CMPF(26, p.states[gid], p2.states[gid]));
  GS((long)nc * 2 * 128 * 128, { int s_ = (int)(gid & 127), l_ = (int)((gid >> 7) & 127); if (s_ <= l_) CMPF(18, p.cb[gid], p2.cb[gid]); });
  GSYNC();
  GS(65536, ph_b_scan(p, gid));
  GS(65536, ph_b_scan(p2, gid));
  GS((long)S * 512, { CMPB(0, p.ow[gid], p2.ow[gid]); CMPB(2, p.oc[gid], p2.oc[gid]); long t = gid >> 9, c = gid & 511; CMPB(4, p.mix[t * NMIX + MX_C + c], p2.mix[t * NMIX + MX_C + c]);
                      if (c < 256) CMPB(6, p.mix[t * NMIX + MX_M + c], p2.mix[t * NMIX + MX_M + c]); });
  GS((long)3 * S * 512, CMPB(8, p.dop[gid], p2.dop[gid]));
  GS((long)3 * S * 8, chk_update(sl + 10, p.dlse[gid] - p2.dlse[gid], 1.f));
  GS((long)S * 2 * 256, { long qg = gid >> 8; int bb = (int)(gid & 255); int q = (int)(qg >> 1), g_ = (int)(qg & 1); if (bb <= (q >> 6)) CMPF(12, p.imp[(((long)(q >> 5) * 2 + g_) * 256 + bb) * 32 + (q & 31)], p2.imp[gid]); });
  GSYNC();
  GS((long)S * 512, { long qg = gid >> 8; int bb = (int)(gid & 255); int q = (int)(qg >> 1), g_ = (int)(qg & 1); p2.imp[gid] = p.imp[(((long)(q >> 5) * 2 + g_) * 256 + bb) * 32 + (q & 31)]; });
  GSYNC();
  WU(S * 2 / 4, unit_topk4(p, u, lane));
  WU2(nc * 32, unit_bout(p, layer, u, WL2, lane));
  GS((long)S * 2, ph_a_topk(p2, gid));
  GS((long)S * 512, ph_b_out(p2, layer, gid));
  GSYNC();
  GS((long)S * 2, { int q = (int)(gid >> 1); int nv = (q >> 6) + 1; nv = nv > 16 ? 16 : nv; int bad = 0;
    for (int k = 0; k < 16; ++k) { int mine = p.idx[gid * 16 + k]; bool found = false; for (int k2 = 0; k2 < 16; ++k2) found |= (p2.idx[gid * 16 + k2] == mine); if (k < nv) bad += !found || mine < 0; else bad += (mine >= 0); }
    chk_update(sl + 14, (float)bad, 1.f); });
  GS((long)S * 512, CMPF(28, p.ybuf[gid], p2.ybuf[gid]));
  GSYNC();
  GS((long)S * 32, p2.idx[gid] = p.idx[gid]);
  GS((long)S * 512, p2.ybuf[gid] = p.ybuf[gid]);
  GSYNC();
  for (int ub = bid0(); ub < (S / 32) * 2; ub += gridDim.x) unit_asel_blk(p, ub, (AselLds*)smem_raw);
  for (;;) { __syncthreads(); if (threadIdx.x == 0) xbst[2] = atomicAdd(&p.bar[40 + layer], 1u); __syncthreads(); const int ub = (int)xbst[2]; if (ub >= nc * 8) break; unit_bout_blk(p, layer, ub, smem_raw); }
  GS((long)S * 8, ph_a_sel(p2, gid));
  GS((long)S * 2, ph_b_norm(p2, layer, gid));
  GSYNC();
  GS((long)S * 512, { long t = gid >> 9, c = gid & 511; CMPB(16, p.mix[t * NMIX + MX_A + c], p2.mix[t * NMIX + MX_A + c]); CMPB(30, p.mix[t * NMIX + MX_B + c], p2.mix[t * NMIX + MX_B + c]); });
  GSYNC();
  { float R = 0.f;
    for (int k = 0; k < 16; ++k) { float d = __uint_as_float(p.bar[2 * k]), r = __uint_as_float(p.bar[2 * k + 1]); float q = d / (r + 1e-20f); if (CHKSEL < 0 || CHKSEL == k) R = fmaxf(R, q); }
    GS((long)SEQ * 1024, p.out[gid] = 1e4f * R); }
}
#endif

__global__ void zz_tail_pad(float* o) { asm volatile(".rept 512\n\ts_nop 0\n\t.endr" ::: "memory"); if (o) o[0] = 0.f; }
__global__ void fill_code(float* o, float v, long n) { long i = blockIdx.x * 256L + threadIdx.x; if (i < n) o[i] = v; }
extern "C" void kernel_launch(void* const* d_in, const int* in_sizes, int n_in, void* d_out, int out_size, void* d_ws, size_t ws_size, hipStream_t stream) {
  KArgs ka; memset(&ka, 0, sizeof(ka));
  for (int i = 0; i < 20; ++i) ka.in[i] = d_in[i];
  ka.out = (float*)d_out; ka.ws = (char*)d_ws;
  Params hp, hp2; memset(&hp, 0, sizeof(hp)); const size_t need = fill_ws(hp, hp2, (char*)d_ws);
  if (need > ws_size) { fprintf(stderr, "workspace too small: need %zu have %zu\n", need, ws_size); return; }
  static int grid_blocks = 0;
  if (!grid_blocks) { int dev = 0, cus = 0, per_cu = 0; (void)hipGetDevice(&dev); (void)hipDeviceGetAttribute(&cus, hipDeviceAttributeMultiprocessorCount, dev);
    (void)hipOccupancyMaxActiveBlocksPerMultiprocessor(&per_cu, mega, 256, 0); if (per_cu > LB2) per_cu = LB2; if (per_cu < 1) per_cu = 1; grid_blocks = cus * per_cu; }
  (void)hipMemsetAsync(hp.bar, 0, 131072, stream);
  void* args[] = {&ka};
  hipError_t e = hipLaunchCooperativeKernel((void*)mega, dim3(grid_blocks), dim3(256), args, 0, stream);
  if (e != hipSuccess) { (void)hipGetLastError(); fill_code<<<(unsigned)(((long)SEQ * 1024 + 255) / 256), 256, 0, stream>>>((float*)d_out, 1000.f * (float)(int)e + (float)grid_blocks, (long)SEQ * 1024); }
}
```

```cpp
#include <hip/hip_runtime.h>
#include <hip/hip_cooperative_groups.h>
#include <cstdio>
#include <cstdint>
#include <cstring>
namespace cg = cooperative_groups;
#define HD_ __device__ __forceinline__
#ifndef CHKSEL
#define CHKSEL -1
#endif
#ifndef LB2
#define LB2 2
#endif
#ifndef HD_
#define HD_ inline
#endif
#ifdef SB_IS_FLOAT
typedef float SB;
HD_ float ldf(const SB* p) { return *p; }
HD_ void stf(SB* p, float v) { *p = v; }
#else
typedef unsigned short SB;
HD_ float bf2f(unsigned short b) { unsigned u = ((unsigned)b) << 16; float f; __builtin_memcpy(&f, &u, 4); return f; }
HD_ unsigned short f2bf(float f) { unsigned u; __builtin_memcpy(&u, &f, 4); u += 0x7fffu + ((u >> 16) & 1u); return (unsigned short)(u >> 16); }
HD_ float ldf(const SB* p) { return bf2f(*p); }
HD_ void stf(SB* p, float v) { *p = f2bf(v); }
#endif

#define DM 1024
#define NPROJ 5888
#define NMIX 2304
#define NSMALL 32
#define PA_Q 0
#define PA_KV 512
#define PB_X 1280
#define PC_Q 2304
#define PC_KV 2816
#define PD_Q 3072
#define PD_KV 4608
#define PM_Q 5632
#define MX_A 0
#define MX_B 512
#define MX_C 1024
#define MX_D 1536
#define MX_M 2048
#define TABA_N 2048
#define TABD_N 132

struct Params {
  int S; int pad0;
  const float *x, *mem; const int* pos;
  const float *pre_norm, *post_norm, *w_in, *w_out, *rel_bias, *cmp_pos, *cmp_w1, *cmp_w2, *conv_w, *conv_b, *dt_bias, *a_log, *b_d,
      *b_norm, *sinks, *m_norm, *m_wkv;
  float* out;
  unsigned short* wt_in;
  unsigned short* wt_out;
  unsigned short *w1t, *w2t;
  SB* h;
  SB* proj;
  float* small;
  SB* mix;
  float* y;
  float *rope_cs, *rope_sn;
  float *tabA, *tabD;
  SB* memkv;
  float* hid;
  SB* kvc;
  float* imp;
  float* cml;
  int* idx;
  SB *oc, *ow;
  SB* dop;
  float* dlse;
  SB* xconv;
  float *dt, *acs;
  float* wst;
  float* cb;
  float* states;
  float* ybuf;
  unsigned* bar;
};

HD_ float silu_f(float x) { return x / (1.f + expf(-x)); }
HD_ float sigmoid_f(float x) { return 1.f / (1.f + expf(-x)); }
HD_ float gelu_f(float x) { return 0.5f * x * (1.f + tanhf(0.7978845608028654f * (x + 0.044715f * x * x * x))); }
HD_ float softplus_f(float x) { return fmaxf(x, 0.f) + log1pf(expf(-fabsf(x))); }

HD_ int t5_bucket(int d) {
  if (d < 16) return d < 0 ? 0 : d;
  const int thr[15] = {22, 30, 40, 54, 73, 99, 134, 182, 246, 332, 450, 609, 825, 1117, 1513};
  int b = 16;
  for (int k = 0; k < 15; ++k) b += (d >= thr[k]) ? 1 : 0;
  return b;
}

HD_ void ph_rope(const Params& p, long gid) {
  int s = (int)(gid >> 5), i = (int)(gid & 31);
  float inv = powf(150000.f, -(float)i / 32.f);
  float ang = (float)p.pos[s] * inv;
  p.rope_cs[gid] = cosf(ang); p.rope_sn[gid] = sinf(ang);
}
HD_ void ph_tabs(const Params& p, long gid) {
  if (gid < 8 * TABA_N) { int h = (int)(gid / TABA_N), d = (int)(gid % TABA_N); p.tabA[gid] = p.rel_bias[t5_bucket(d) * 32 + h]; }
  else { long g2 = gid - 8 * TABA_N; int hh = (int)(g2 / TABD_N), d = (int)(g2 % TABD_N); int gi = hh >> 3;
    int dil = gi == 0 ? 1 : (gi == 1 ? 4 : 16); p.tabD[g2] = p.rel_bias[t5_bucket(d * dil) * 32 + 8 + hh]; }
}
HD_ void ph_memkv(const Params& p, long gid) {
  int e = (int)(gid & 511), m = (int)((gid >> 9) & 255), l = (int)(gid >> 17);
  const float* row = p.mem + (long)m * DM;
  float ss = 0.f; _Pragma("unroll 16") for (int d = 0; d < DM; ++d) ss += row[d] * row[d];
  float r = 1.f / sqrtf(ss / DM + 1e-6f);
  float acc = 0.f;
  _Pragma("unroll 16") for (int d = 0; d < DM; ++d) acc += row[d] * r * p.m_norm[l * DM + d] * p.m_wkv[((long)l * DM + d) * 512 + e];
  stf(&p.memkv[gid], acc);
}
HD_ void ph_norm_row(const Params& p, int layer, int t, bool do_h) {
  const float* xin = (layer == 0) ? p.x + (long)t * DM : p.out + (long)t * DM;
  float* xo = p.out + (long)t * DM;
  float r1 = 0.f;
  if (layer > 0) { const float* y = p.y + (long)t * DM; float ss = 0.f; for (int d = 0; d < DM; ++d) ss += y[d] * y[d]; r1 = 1.f / sqrtf(ss / DM + 1e-6f); }
  float ss2 = 0.f;
  for (int d = 0; d < DM; ++d) { float v = xin[d]; if (layer > 0) v += p.y[(long)t * DM + d] * r1 * p.post_norm[(layer - 1) * DM + d]; xo[d] = v; ss2 += v * v; }
  if (!do_h) return;
  float r2 = 1.f / sqrtf(ss2 / DM + 1e-6f);
  for (int d = 0; d < DM; ++d) stf(&p.h[(long)t * DM + d], xo[d] * r2 * p.pre_norm[layer * DM + d]);
}

HD_ void ph_cmp_hid(const Params& p, int layer, long gid) {
  int u = (int)(gid & 127), hk = (int)((gid >> 7) & 1); long r = gid >> 8; int ncmp = p.S / 16; int j = (int)(r % ncmp), kv = (int)(r / ncmp);
  const float* w1 = p.cmp_w1 + ((long)(layer * 2 + kv) * 2048) * 128;
  const float* pe = p.cmp_pos + (long)(layer * 2 + kv) * 32 * 64;
  float acc = 0.f;
  for (int t = 0; t < 32; ++t) { int tok = 16 * j + t;
    _Pragma("unroll 16") for (int d = 0; d < 64; ++d) { float v = pe[t * 64 + d]; if (tok < p.S) v += ldf(&p.proj[(long)tok * NPROJ + PA_KV + kv * 128 + hk * 64 + d]);
      acc += v * w1[(long)(t * 64 + d) * 128 + u]; } }
  p.hid[gid] = gelu_f(acc);
}
HD_ void ph_cmp_out(const Params& p, int layer, long gid) {
  int d = (int)(gid & 63), hk = (int)((gid >> 6) & 1); long r = gid >> 7; int ncmp = p.S / 16; int j = (int)(r % ncmp), kv = (int)(r / ncmp);
  const float* w2 = p.cmp_w2 + (long)(layer * 2 + kv) * 128 * 64;
  const float* hd = p.hid + (((long)kv * ncmp + j) * 2 + hk) * 128;
  float acc = 0.f; for (int u = 0; u < 128; ++u) acc += hd[u] * w2[u * 64 + d];
  stf(&p.kvc[gid], acc);
}
HD_ void ph_a_cmp1(const Params& p, long gid) {
  int h = (int)(gid & 7), q = (int)(gid >> 3), g = h >> 2; int ncmp = p.S / 16;
  int jn = (q >= 31) ? ((q - 31) / 16 + 1) : 0;
  const SB* kc = p.kvc; const SB* vc = p.kvc + (long)ncmp * 128;
  float qv[64], o[64]; for (int d = 0; d < 64; ++d) { qv[d] = ldf(&p.proj[(long)q * NPROJ + PA_Q + h * 64 + d]); o[d] = 0.f; }
  float m = -1e30f, l = 0.f;
  for (int j = 0; j < jn; ++j) { const SB* kr = &kc[((long)j * 2 + g) * 64]; const SB* vr = &vc[((long)j * 2 + g) * 64];
    float s = 0.f; for (int d = 0; d < 64; ++d) s += qv[d] * ldf(&kr[d]);
    int dist = q - (16 * j + 31); s = s * 0.125f + p.tabA[h * TABA_N + (dist < TABA_N ? dist : TABA_N - 1)];
    float mn = fmaxf(m, s), a = expf(m - mn), pr = expf(s - mn); l = l * a + pr; for (int d = 0; d < 64; ++d) o[d] = o[d] * a + pr * ldf(&vr[d]); m = mn; }
  float il = jn > 0 ? 1.f / l : 0.f; for (int d = 0; d < 64; ++d) stf(&p.oc[(long)q * 512 + h * 64 + d], o[d] * il);
  p.cml[gid * 2] = m; p.cml[gid * 2 + 1] = il;
}
HD_ void ph_a_cmp2(const Params& p, long gid) {
  int g = (int)(gid & 1), q = (int)(gid >> 1); int ncmp = p.S / 16;
  float* imp = p.imp + gid * 256; for (int b = 0; b < 256; ++b) imp[b] = 0.f;
  int jn = (q >= 31) ? ((q - 31) / 16 + 1) : 0; const SB* kc = p.kvc;
  for (int hh = 0; hh < 4; ++hh) { int h = g * 4 + hh; float qv[64]; for (int d = 0; d < 64; ++d) qv[d] = ldf(&p.proj[(long)q * NPROJ + PA_Q + h * 64 + d]);
    float m = p.cml[((long)q * 8 + h) * 2], il = p.cml[((long)q * 8 + h) * 2 + 1];
    for (int j = 0; j < jn; ++j) { const SB* kr = &kc[((long)j * 2 + g) * 64]; float s = 0.f; for (int d = 0; d < 64; ++d) s += qv[d] * ldf(&kr[d]);
      int dist = q - (16 * j + 31); s = s * 0.125f + p.tabA[h * TABA_N + (dist < TABA_N ? dist : TABA_N - 1)]; float pr = expf(s - m) * il;
      imp[j >> 2] += pr; if (j + 1 < ncmp) imp[(j + 1) >> 2] += pr; } }
}
HD_ void ph_a_topk(const Params& p, long gid) {
  int q = (int)(gid >> 1); float* imp = p.imp + gid * 256; int* idx = p.idx + gid * 16; int cur = q >> 6;
  imp[0] = 1e4f; imp[cur] = 1e4f;
  for (int k = 0; k < 16; ++k) { int best = -1; float bv = -1.f;
    for (int b = 0; b <= cur; ++b) { float v = imp[b]; if (v > bv) { bv = v; best = b; } }
    idx[k] = best; if (best >= 0) imp[best] = -2.f; }
}
HD_ void ph_a_win(const Params& p, long gid) {
  int h = (int)(gid & 7), q = (int)(gid >> 3), hk = h >> 2;
  float qv[64], o[64]; for (int d = 0; d < 64; ++d) { qv[d] = ldf(&p.proj[(long)q * NPROJ + PA_Q + h * 64 + d]); o[d] = 0.f; }
  float m = -1e30f, l = 0.f; int lo = q - 511 < 0 ? 0 : q - 511;
  for (int t = lo; t <= q; ++t) { const SB* kr = &p.proj[(long)t * NPROJ + PA_KV + 4 * 128 + hk * 64]; const SB* vr = kr + 128;
    float s = 0.f; for (int d = 0; d < 64; ++d) s += qv[d] * ldf(&kr[d]); s = s * 0.125f + p.tabA[h * TABA_N + (q - t)];
    float mn = fmaxf(m, s), a = expf(m - mn), pr = expf(s - mn); l = l * a + pr; for (int d = 0; d < 64; ++d) o[d] = o[d] * a + pr * ldf(&vr[d]); m = mn; }
  float il = 1.f / l; for (int d = 0; d < 64; ++d) stf(&p.ow[(long)q * 512 + h * 64 + d], o[d] * il);
}
HD_ void ph_a_sel(const Params& p, long gid) {
  int h = (int)(gid & 7), q = (int)(gid >> 3), hk = h >> 2; const int* idx = p.idx + ((long)q * 2 + hk) * 16;
  float qv[64], o[64]; for (int d = 0; d < 64; ++d) { qv[d] = ldf(&p.proj[(long)q * NPROJ + PA_Q + h * 64 + d]); o[d] = 0.f; }
  float m = -1e30f, l = 0.f;
  for (int k = 0; k < 16; ++k) { int b = idx[k]; if (b < 0) continue;
    for (int i = 0; i < 64; ++i) { int t = b * 64 + i; if (t > q) break;
      const SB* kr = &p.proj[(long)t * NPROJ + PA_KV + 2 * 128 + hk * 64]; const SB* vr = kr + 128;
      float s = 0.f; for (int d = 0; d < 64; ++d) s += qv[d] * ldf(&kr[d]); int dist = q - t; s = s * 0.125f + p.tabA[h * TABA_N + (dist < TABA_N ? dist : TABA_N - 1)];
      float mn = fmaxf(m, s), a = expf(m - mn), pr = expf(s - mn); l = l * a + pr; for (int d = 0; d < 64; ++d) o[d] = o[d] * a + pr * ldf(&vr[d]); m = mn; } }
  float il = 1.f / l; const float* gl = p.small + (long)q * NSMALL + h * 3;
  float g0 = sigmoid_f(gl[0]), g1 = sigmoid_f(gl[1]), g2 = sigmoid_f(gl[2]);
  for (int d = 0; d < 64; ++d) { long c = (long)q * 512 + h * 64 + d; float a = g0 * ldf(&p.oc[c]) + g1 * o[d] * il + g2 * ldf(&p.ow[c]);
    SB* mp = &p.mix[(long)q * NMIX + MX_A + h * 64 + d]; stf(mp, a * ldf(mp)); }
}
HD_ void ph_c(const Params& p, int layer, long gid) {
  int h = (int)(gid & 7), q = (int)(gid >> 3), hk = h >> 2;
  float qv[64], o[64]; for (int d = 0; d < 64; ++d) { qv[d] = ldf(&p.proj[(long)q * NPROJ + PC_Q + h * 64 + d]); o[d] = 0.f; }
  float m = p.sinks[layer * 8 + h], l = 1.f; int lo = q - 127 < 0 ? 0 : q - 127;
  for (int t = lo; t <= q; ++t) { const SB* kr = &p.proj[(long)t * NPROJ + PC_KV + hk * 64]; const SB* vr = kr + 128;
    float s = 0.f; for (int d = 0; d < 64; ++d) s += qv[d] * ldf(&kr[d]); s *= 0.125f;
    float mn = fmaxf(m, s), a = expf(m - mn), pr = expf(s - mn); l = l * a + pr; for (int d = 0; d < 64; ++d) o[d] = o[d] * a + pr * ldf(&vr[d]); m = mn; }
  float il = 1.f / l; for (int d = 0; d < 64; ++d) { SB* mp = &p.mix[(long)q * NMIX + MX_C + h * 64 + d]; stf(mp, o[d] * il * ldf(mp)); }
}
HD_ void ph_d(const Params& p, long gid) {
  int h = (int)(gid & 7); long r = gid >> 3; int q = (int)(r % p.S), gi = (int)(r / p.S); int dil = gi == 0 ? 1 : (gi == 1 ? 4 : 16);
  float qv[64], o[64]; for (int d = 0; d < 64; ++d) { qv[d] = ldf(&p.proj[(long)q * NPROJ + PD_Q + gi * 512 + h * 64 + d]); o[d] = 0.f; }
  float m = -1e30f, l = 0.f;
  for (int dd = 0; dd <= 128; ++dd) { int t = q - dil * dd; if (t < 0) break;
    const SB* kr = &p.proj[(long)t * NPROJ + PD_KV + h * 64]; const SB* vr = kr + 512;
    float s = 0.f; for (int d = 0; d < 64; ++d) s += qv[d] * ldf(&kr[d]); s = s * 0.125f + p.tabD[(gi * 8 + h) * TABD_N + dd];
    float mn = fmaxf(m, s), a = expf(m - mn), pr = expf(s - mn); l = l * a + pr; for (int d = 0; d < 64; ++d) o[d] = o[d] * a + pr * ldf(&vr[d]); m = mn; }
  float il = 1.f / l; for (int d = 0; d < 64; ++d) stf(&p.dop[((long)gi * p.S + q) * 512 + h * 64 + d], o[d] * il);
  p.dlse[((long)gi * p.S + q) * 8 + h] = m + logf(l);
}
HD_ void ph_d_merge(const Params& p, long gid) {
  int h = (int)(gid & 7), q = (int)(gid >> 3);
  float l0 = p.dlse[((long)0 * p.S + q) * 8 + h], l1 = p.dlse[((long)1 * p.S + q) * 8 + h], l2 = p.dlse[((long)2 * p.S + q) * 8 + h];
  float mm = fmaxf(l0, fmaxf(l1, l2)); float e0 = expf(l0 - mm), e1 = expf(l1 - mm), e2 = expf(l2 - mm), is = 1.f / (e0 + e1 + e2);
  for (int d = 0; d < 64; ++d) { long c = (long)q * 512 + h * 64 + d;
    float v = (e0 * ldf(&p.dop[c]) + e1 * ldf(&p.dop[(long)p.S * 512 + c]) + e2 * ldf(&p.dop[(long)2 * p.S * 512 + c])) * is;
    SB* mp = &p.mix[(long)q * NMIX + MX_D + h * 64 + d]; stf(mp, v * ldf(mp)); }
}
HD_ void ph_m(const Params& p, int layer, long gid) {
  int h = (int)(gid & 3), q = (int)(gid >> 2);
  float qv[64], o[64]; for (int d = 0; d < 64; ++d) { qv[d] = ldf(&p.proj[(long)q * NPROJ + PM_Q + h * 64 + d]); o[d] = 0.f; }
  float m = -1e30f, l = 0.f; const SB* kvb = p.memkv + (long)layer * 256 * 512;
  for (int t = 0; t < 256; ++t) { const SB* kr = kvb + (long)t * 512 + h * 64; const SB* vr = kr + 256;
    float s = 0.f; for (int d = 0; d < 64; ++d) s += qv[d] * ldf(&kr[d]); s *= 0.125f;
    float mn = fmaxf(m, s), a = expf(m - mn), pr = expf(s - mn); l = l * a + pr; for (int d = 0; d < 64; ++d) o[d] = o[d] * a + pr * ldf(&vr[d]); m = mn; }
  float il = 1.f / l; for (int d = 0; d < 64; ++d) { SB* mp = &p.mix[(long)q * NMIX + MX_M + h * 64 + d]; stf(mp, o[d] * il * ldf(mp)); }
}
HD_ void ph_b_conv(const Params& p, int layer, long gid) {
  int c = (int)(gid & 1023), t = (int)(gid >> 10); const float* w = p.conv_w + (long)layer * 4 * 1024;
  float acc = p.conv_b[layer * 1024 + c];
  for (int i = 0; i < 4; ++i) { int tt = t - 3 + i; if (tt >= 0) acc += w[i * 1024 + c] * ldf(&p.proj[(long)tt * NPROJ + PB_X + c]); }
  stf(&p.xconv[gid], silu_f(acc));
}
HD_ void ph_b_dt(const Params& p, int layer, long gid) {
  int hd = (int)(gid & 7), c = (int)(gid >> 3); float a = -expf(p.a_log[layer * 8 + hd]); float cs = 0.f;
  for (int l = 0; l < 128; ++l) { int t = c * 128 + l; float dt = softplus_f(p.small[(long)t * NSMALL + 24 + hd] + p.dt_bias[layer * 8 + hd]);
    cs += dt * a; p.dt[(long)t * 8 + hd] = dt; p.acs[(long)t * 8 + hd] = cs; }
}
HD_ void ph_b_cb(const Params& p, long gid) {
  int s = (int)(gid & 127), l = (int)((gid >> 7) & 127), g = (int)((gid >> 14) & 1), c = (int)(gid >> 15);
  if (s > l) { p.cb[gid] = 0.f; return; }
  const SB* cm = &p.xconv[(long)(c * 128 + l) * 1024 + 768 + g * 128]; const SB* bm = &p.xconv[(long)(c * 128 + s) * 1024 + 512 + g * 128];
  float acc = 0.f; for (int n = 0; n < 128; ++n) acc += ldf(&cm[n]) * ldf(&bm[n]);
  p.cb[gid] = acc;
}
HD_ void ph_b_states(const Params& p, long gid) {
  int n = (int)(gid & 127), pp = (int)((gid >> 7) & 63), hd = (int)((gid >> 13) & 7), c = (int)(gid >> 16), g = hd >> 2;
  float last = p.acs[(long)(c * 128 + 127) * 8 + hd]; float acc = 0.f;
  for (int l = 0; l < 128; ++l) { long t = c * 128 + l;
    acc += ldf(&p.xconv[t * 1024 + 512 + g * 128 + n]) * expf(last - p.acs[t * 8 + hd]) * ldf(&p.xconv[t * 1024 + hd * 64 + pp]) * p.dt[t * 8 + hd]; }
  p.states[gid] = acc;
}
HD_ void ph_b_scan(const Params& p, long gid) {
  int hd = (int)(gid >> 13); int nc = p.S / 128; float h = 0.f;
  for (int c0 = 0; c0 < nc; c0 += 8) { float st[8], dc[8];
    for (int i = 0; i < 8; ++i) { st[i] = p.states[(long)(c0 + i) * 65536 + gid]; dc[i] = p.acs[(long)((c0 + i) * 128 + 127) * 8 + hd]; }
    for (int i = 0; i < 8; ++i) { p.states[(long)(c0 + i) * 65536 + gid] = h; h = h * expf(dc[i]) + st[i]; } }
}
HD_ void ph_b_out(const Params& p, int layer, long gid) {
  int pp = (int)(gid & 63), hd = (int)((gid >> 6) & 7), t = (int)(gid >> 9), g = hd >> 2, c = t >> 7, l = t & 127;
  float al = p.acs[(long)t * 8 + hd]; float acc = 0.f;
  const float* cbr = &p.cb[(((long)c * 2 + g) * 128 + l) * 128];
  for (int s = 0; s <= l; ++s) { long ts = c * 128 + s; acc += cbr[s] * expf(al - p.acs[ts * 8 + hd]) * ldf(&p.xconv[ts * 1024 + hd * 64 + pp]) * p.dt[ts * 8 + hd]; }
  float acc2 = 0.f; const float* pr = &p.states[(long)c * 65536 + ((long)hd * 64 + pp) * 128]; const SB* cm = &p.xconv[(long)t * 1024 + 768 + g * 128];
  for (int n = 0; n < 128; ++n) acc2 += ldf(&cm[n]) * pr[n];
  p.ybuf[gid] = acc + expf(al) * acc2 + ldf(&p.xconv[(long)t * 1024 + hd * 64 + pp]) * p.b_d[layer * 8 + hd];
}
HD_ void ph_b_norm(const Params& p, int layer, long gid) {
  int g = (int)(gid & 1), t = (int)(gid >> 1); float ss = 0.f;
  for (int i = 0; i < 256; ++i) { float v = p.ybuf[(long)t * 512 + g * 256 + i] * ldf(&p.mix[(long)t * NMIX + MX_B + g * 256 + i]); ss += v * v; }
  float r = 1.f / sqrtf(ss / 256.f + 1e-6f);
  for (int i = 0; i < 256; ++i) { SB* mp = &p.mix[(long)t * NMIX + MX_B + g * 256 + i]; float v = p.ybuf[(long)t * 512 + g * 256 + i] * ldf(mp);
    stf(mp, v * r * p.b_norm[layer * 512 + g * 256 + i]); }
}

HD_ void ph_b_dt2(const Params& p, int layer, long gid) {
  int hd = (int)(gid & 7), c = (int)(gid >> 3); float a = -expf(p.a_log[layer * 8 + hd]); float cs = 0.f;
  for (int l = 0; l < 128; ++l) { int t = c * 128 + l; float dt = softplus_f(p.small[(long)t * NSMALL + 24 + hd] + p.dt_bias[layer * 8 + hd]);
    cs += dt * a; p.dt[(long)t * 8 + hd] = dt; p.acs[(long)t * 8 + hd] = cs; }
  for (int l = 0; l < 128; ++l) { long t = c * 128 + l; p.wst[t * 8 + hd] = p.dt[t * 8 + hd] * expf(cs - p.acs[t * 8 + hd]); }
}
HD_ void ph_b_states2(const Params& p, long gid) {
  int pp = (int)(gid & 63), n = (int)((gid >> 6) & 127), hd = (int)((gid >> 13) & 7), c = (int)(gid >> 16), g = hd >> 2;
  float acc = 0.f;
  _Pragma("unroll 16") for (int l = 0; l < 128; ++l) { long t = c * 128 + l; acc += ldf(&p.xconv[t * 1024 + 512 + g * 128 + n]) * p.wst[t * 8 + hd] * ldf(&p.xconv[t * 1024 + hd * 64 + pp]); }
  p.states[gid] = acc;
}
HD_ void ph_b_out2(const Params& p, int layer, long gid) {
  int pp = (int)(gid & 63), hd = (int)((gid >> 6) & 7), t = (int)(gid >> 9), g = hd >> 2, c = t >> 7, l = t & 127;
  float al = p.acs[(long)t * 8 + hd]; float acc = 0.f;
  const float* cbr = &p.cb[(((long)c * 2 + g) * 128 + l) * 128];
  _Pragma("unroll 8") for (int s = 0; s <= l; ++s) { long ts = c * 128 + s; acc += cbr[s] * expf(al - p.acs[ts * 8 + hd]) * p.dt[ts * 8 + hd] * ldf(&p.xconv[ts * 1024 + hd * 64 + pp]); }
  float acc2 = 0.f; const float* pr = &p.states[(long)c * 65536 + (long)hd * 8192 + pp]; const SB* cm = &p.xconv[(long)t * 1024 + 768 + g * 128];
  _Pragma("unroll 16") for (int n = 0; n < 128; ++n) acc2 += ldf(&cm[n]) * pr[n * 64];
  p.ybuf[gid] = acc + expf(al) * acc2 + ldf(&p.xconv[(long)t * 1024 + hd * 64 + pp]) * p.b_d[layer * 8 + hd];
}

typedef __attribute__((ext_vector_type(8))) short bf16x8;
typedef __attribute__((ext_vector_type(16))) float f32x16;
typedef short v4i16_t __attribute__((ext_vector_type(4)));
typedef __bf16 bf2_t __attribute__((ext_vector_type(2)));
typedef float f2_t __attribute__((ext_vector_type(2)));
typedef unsigned u32x4 __attribute__((ext_vector_type(4)));
#define LDS3 __attribute__((address_space(3)))
typedef __attribute__((address_space(1))) const void* gptr_t;
typedef __attribute__((address_space(3))) void* lptr_t;
#define L2E 1.4426950408889634f
#define LN2 0.6931471805599453f
#define QSC (0.125f * L2E)
#ifndef FTHR
#define FTHR 8.0f
#endif
#define NINF (-__builtin_huge_valf())

struct WaveLds { unsigned short v[4096]; float tab[640]; float xch[32]; float pad[32]; };

__device__ __forceinline__ unsigned pk2(float a, float b) { f2_t v = {a, b}; bf2_t r = __builtin_convertvector(v, bf2_t); return __builtin_bit_cast(unsigned, r); }
__device__ __forceinline__ int crow(int e, int hi) { return (e & 3) + 8 * (e >> 2) + 4 * hi; }
__device__ __forceinline__ bf16x8 pack8(const f32x16& s, int o) {
  u32x4 r; r[0] = pk2(s[o], s[o + 1]); r[1] = pk2(s[o + 2], s[o + 3]); r[2] = pk2(s[o + 4], s[o + 5]); r[3] = pk2(s[o + 6], s[o + 7]); return __builtin_bit_cast(bf16x8, r); }
__device__ __forceinline__ f32x16 zero16() { f32x16 z;
#pragma unroll
  for (int e = 0; e < 16; ++e) z[e] = 0.f; return z; }
#define MFMA32(a, b, c) __builtin_amdgcn_mfma_f32_32x32x16_bf16((a), (b), (c), 0, 0, 0)

__device__ __forceinline__ float xor32_f(float v) { const auto rr = __builtin_amdgcn_permlane32_swap(__float_as_uint(v), __float_as_uint(v), false, false); const int hi_ = (int)(threadIdx.x & 32u); return __uint_as_float(hi_ ? rr[0] : rr[1]); }
struct FlashState { f32x16 o0, o1; float m, l; };
__device__ __forceinline__ float wave_sum_f(float v) {
#pragma unroll
  for (int o = 32; o > 0; o >>= 1) v += __shfl_xor(v, o);
  return v; }

__device__ __forceinline__ void flash_core1(FlashState& st, f32x16& s, const unsigned short* vimg, float* xch, int lane) {
  const int r32 = lane & 31, hi = lane >> 5;
  float mx = s[0];
#pragma unroll
  for (int e = 1; e < 16; ++e) mx = fmaxf(mx, s[e]);
  mx = fmaxf(mx, xor32_f(mx));
  if (__any(mx > st.m + FTHR)) {
    const float mn = fmaxf(st.m, mx); const float al = __builtin_amdgcn_exp2f(st.m - mn); st.m = mn; st.l *= al; xch[r32] = al;
#pragma unroll
    for (int e = 0; e < 16; ++e) { const float a = xch[crow(e, hi)]; st.o0[e] *= a; st.o1[e] *= a; }
  }
  float ps = 0.f;
#pragma unroll
  for (int e = 0; e < 16; ++e) { s[e] = __builtin_amdgcn_exp2f(s[e] - st.m); ps += s[e]; }
  st.l += ps;
  const bf16x8 pa0 = pack8(s, 0), pa1 = pack8(s, 8);
  const unsigned short* vb = vimg + (4 * hi + ((lane & 15) >> 2)) * 32 + ((lane >> 4) & 1) * 16 + (lane & 3) * 4;
#pragma unroll
  for (int s2 = 0; s2 < 2; ++s2) {
#pragma unroll
    for (int db = 0; db < 2; ++db) {
      const v4i16_t lo = __builtin_amdgcn_ds_read_tr16_b64_v4i16((LDS3 v4i16_t*)(vb + db * 2048 + s2 * 512));
      const v4i16_t hh = __builtin_amdgcn_ds_read_tr16_b64_v4i16((LDS3 v4i16_t*)(vb + db * 2048 + s2 * 512 + 256));
      const bf16x8 vf = {lo[0], lo[1], lo[2], lo[3], hh[0], hh[1], hh[2], hh[3]};
      if (db == 0) st.o0 = MFMA32(s2 ? pa1 : pa0, vf, st.o0); else st.o1 = MFMA32(s2 ? pa1 : pa0, vf, st.o1);
    }
  }
}
__device__ __forceinline__ void flash_core1_lin(FlashState& st, f32x16& s, float qs, float bb, const unsigned short* vimg, float* xch, int lane) {
  const int r32 = lane & 31, hi = lane >> 5;
  float mr = s[0];
#pragma unroll
  for (int e = 1; e < 16; ++e) mr = fmaxf(mr, s[e]);
  float mx = __builtin_fmaf(mr, qs, bb);
  mx = fmaxf(mx, xor32_f(mx));
  if (__any(mx > st.m + FTHR)) {
    const float mn = fmaxf(st.m, mx); const float al = __builtin_amdgcn_exp2f(st.m - mn); st.m = mn; st.l *= al; xch[r32] = al;
#pragma unroll
    for (int e = 0; e < 16; ++e) { const float a = xch[crow(e, hi)]; st.o0[e] *= a; st.o1[e] *= a; }
  }
  const float bm = bb - st.m; float ps = 0.f;
#pragma unroll
  for (int e = 0; e < 16; ++e) { s[e] = __builtin_amdgcn_exp2f(__builtin_fmaf(s[e], qs, bm)); ps += s[e]; }
  st.l += ps;
  const bf16x8 pa0 = pack8(s, 0), pa1 = pack8(s, 8);
  const unsigned short* vb = vimg + (4 * hi + ((lane & 15) >> 2)) * 32 + ((lane >> 4) & 1) * 16 + (lane & 3) * 4;
#pragma unroll
  for (int s2 = 0; s2 < 2; ++s2) {
#pragma unroll
    for (int db = 0; db < 2; ++db) {
      const v4i16_t lo = __builtin_amdgcn_ds_read_tr16_b64_v4i16((LDS3 v4i16_t*)(vb + db * 2048 + s2 * 512));
      const v4i16_t hh = __builtin_amdgcn_ds_read_tr16_b64_v4i16((LDS3 v4i16_t*)(vb + db * 2048 + s2 * 512 + 256));
      const bf16x8 vf = {lo[0], lo[1], lo[2], lo[3], hh[0], hh[1], hh[2], hh[3]};
      if (db == 0) st.o0 = MFMA32(s2 ? pa1 : pa0, vf, st.o0); else st.o1 = MFMA32(s2 ? pa1 : pa0, vf, st.o1);
    }
  }
}
template <class VRow, class Fix>
__device__ __forceinline__ void flash_tile(FlashState& st, const bf16x8 (&qf)[4], const SB* kp, VRow vrow, Fix fix, WaveLds* L, int lane) {
  const int r32 = lane & 31, hi = lane >> 5;
  bf16x8 kf[4];
#pragma unroll
  for (int d0 = 0; d0 < 4; ++d0) kf[d0] = *(const bf16x8*)(kp + d0 * 16 + hi * 8);
#pragma unroll
  for (int i = 0; i < 4; ++i) { const int c = lane + 64 * i, key = c >> 3, ch = c & 7; const SB* vp = vrow(key); const uint4 vv = *(const uint4*)(vp + ch * 8);
    *(uint4*)&L->v[(ch >> 2) * 2048 + key * 32 + (ch & 3) * 8] = vv; }
  f32x16 s = zero16();
#pragma unroll
  for (int d0 = 0; d0 < 4; ++d0) s = MFMA32(kf[d0], qf[d0], s);
  fix(s);
  flash_core1(st, s, L->v, L->xch, lane);
}
__device__ __forceinline__ void flash_core2(FlashState& st, f32x16& s0, f32x16& s1, const unsigned short* vimg, float* xch, int lane) {
  const int r32 = lane & 31, hi = lane >> 5;
  float mx = fmaxf(s0[0], s1[0]);
#pragma unroll
  for (int e = 1; e < 16; ++e) mx = fmaxf(mx, fmaxf(s0[e], s1[e]));
  mx = fmaxf(mx, xor32_f(mx));
  if (__any(mx > st.m + FTHR)) {
    const float mn = fmaxf(st.m, mx); const float al = __builtin_amdgcn_exp2f(st.m - mn); st.m = mn; st.l *= al; xch[r32] = al;
#pragma unroll
    for (int e = 0; e < 16; ++e) { const float a = xch[crow(e, hi)]; st.o0[e] *= a; st.o1[e] *= a; }
  }
  float ps = 0.f;
#pragma unroll
  for (int e = 0; e < 16; ++e) { s0[e] = __builtin_amdgcn_exp2f(s0[e] - st.m); s1[e] = __builtin_amdgcn_exp2f(s1[e] - st.m); ps += s0[e] + s1[e]; }
  st.l += ps;
  bf16x8 pa[4]; pa[0] = pack8(s0, 0); pa[1] = pack8(s0, 8); pa[2] = pack8(s1, 0); pa[3] = pack8(s1, 8);
  const unsigned short* vb = vimg + (4 * hi + ((lane & 15) >> 2)) * 32 + ((lane >> 4) & 1) * 16 + (lane & 3) * 4;
#pragma unroll
  for (int kk = 0; kk < 4; ++kk) {
#pragma unroll
    for (int db = 0; db < 2; ++db) {
      const v4i16_t lo = __builtin_amdgcn_ds_read_tr16_b64_v4i16((LDS3 v4i16_t*)(vb + db * 2048 + kk * 512));
      const v4i16_t hh = __builtin_amdgcn_ds_read_tr16_b64_v4i16((LDS3 v4i16_t*)(vb + db * 2048 + kk * 512 + 256));
      const bf16x8 vf = {lo[0], lo[1], lo[2], lo[3], hh[0], hh[1], hh[2], hh[3]};
      if (db == 0) st.o0 = MFMA32(pa[kk], vf, st.o0); else st.o1 = MFMA32(pa[kk], vf, st.o1);
    }
  }
}
__device__ __forceinline__ void flash_core2_lin(FlashState& st, f32x16& s0, f32x16& s1, float qs, float bb, const unsigned short* vimg, float* xch, int lane) {
  const int r32 = lane & 31, hi = lane >> 5;
  float mr = fmaxf(s0[0], s1[0]);
#pragma unroll
  for (int e = 1; e < 16; ++e) mr = fmaxf(mr, fmaxf(s0[e], s1[e]));
  float mx = __builtin_fmaf(mr, qs, bb);
  mx = fmaxf(mx, xor32_f(mx));
  if (__any(mx > st.m + FTHR)) {
    const float mn = fmaxf(st.m, mx); const float al = __builtin_amdgcn_exp2f(st.m - mn); st.m = mn; st.l *= al; xch[r32] = al;
#pragma unroll
    for (int e = 0; e < 16; ++e) { const float a = xch[crow(e, hi)]; st.o0[e] *= a; st.o1[e] *= a; }
  }
  const float bm = bb - st.m; float ps = 0.f;
#pragma unroll
  for (int e = 0; e < 16; ++e) { s0[e] = __builtin_amdgcn_exp2f(__builtin_fmaf(s0[e], qs, bm)); s1[e] = __builtin_amdgcn_exp2f(__builtin_fmaf(s1[e], qs, bm)); ps += s0[e] + s1[e]; }
  st.l += ps;
  bf16x8 pa[4]; pa[0] = pack8(s0, 0); pa[1] = pack8(s0, 8); pa[2] = pack8(s1, 0); pa[3] = pack8(s1, 8);
  const unsigned short* vb = vimg + (4 * hi + ((lane & 15) >> 2)) * 32 + ((lane >> 4) & 1) * 16 + (lane & 3) * 4;
#pragma unroll
  for (int kk = 0; kk < 4; ++kk) {
#pragma unroll
    for (int db = 0; db < 2; ++db) {
      const v4i16_t lo = __builtin_amdgcn_ds_read_tr16_b64_v4i16((LDS3 v4i16_t*)(vb + db * 2048 + kk * 512));
      const v4i16_t hh = __builtin_amdgcn_ds_read_tr16_b64_v4i16((LDS3 v4i16_t*)(vb + db * 2048 + kk * 512 + 256));
      const bf16x8 vf = {lo[0], lo[1], lo[2], lo[3], hh[0], hh[1], hh[2], hh[3]};
      if (db == 0) st.o0 = MFMA32(pa[kk], vf, st.o0); else st.o1 = MFMA32(pa[kk], vf, st.o1);
    }
  }
}
#ifndef FT2
#define FT2 1
#endif
template <class VRow, class Fix0, class Fix1>
__device__ __forceinline__ void flash_tile2(FlashState& st, const bf16x8 (&qf)[4], const SB* kp0, const SB* kp1, VRow vrow, Fix0 fix0, Fix1 fix1, WaveLds* L, int lane) {
  if (!FT2) { flash_tile(st, qf, kp0, [&](int key) { return vrow(key); }, fix0, L, lane); flash_tile(st, qf, kp1, [&](int key) { return vrow(key + 32); }, fix1, L, lane); return; }
  const int hi = lane >> 5;
  bf16x8 kf0[4], kf1[4];
#pragma unroll
  for (int d0 = 0; d0 < 4; ++d0) { kf0[d0] = *(const bf16x8*)(kp0 + d0 * 16 + hi * 8); kf1[d0] = *(const bf16x8*)(kp1 + d0 * 16 + hi * 8); }
#pragma unroll
  for (int i = 0; i < 8; ++i) { const int c = lane + 64 * i, key = c >> 3, ch = c & 7; const SB* vp = vrow(key); const uint4 vv = *(const uint4*)(vp + ch * 8);
    *(uint4*)&L->v[(ch >> 2) * 2048 + key * 32 + (ch & 3) * 8] = vv; }
  f32x16 s0 = zero16(), s1 = zero16();
#pragma unroll
  for (int d0 = 0; d0 < 4; ++d0) { s0 = MFMA32(kf0[d0], qf[d0], s0); s1 = MFMA32(kf1[d0], qf[d0], s1); }
  fix0(s0); fix1(s1);
  flash_core2(st, s0, s1, L->v, L->xch, lane);
}
template <class KPtr, class VRow, class Fix>
__device__ __forceinline__ void flash_run(FlashState& st, const bf16x8 (&qf)[4], int t0, int t1, KPtr kptr, VRow vrow, Fix fix, WaveLds* L, int lane) {
  if (t0 >= t1) return;
  const int hi = lane >> 5; bf16x8 kfn[4];
#define FR_ISSUE(tt) { const int t_ = (tt); _Pragma("unroll") for (int i_ = 0; i_ < 4; ++i_) { const int db_ = i_ >> 1, key_ = (i_ & 1) * 16 + (lane >> 2), wi_ = lane & 3; \
      __builtin_amdgcn_global_load_lds((gptr_t)(vrow(t_, key_) + db_ * 32 + wi_ * 8), (lptr_t)&L->v[db_ * 2048 + (t_ & 1) * 1024 + (i_ & 1) * 512], 16, 0, 0); } \
    const SB* kp_ = kptr(t_); _Pragma("unroll") for (int d0_ = 0; d0_ < 4; ++d0_) kfn[d0_] = *(const bf16x8*)(kp_ + d0_ * 16 + hi * 8); }
  FR_ISSUE(t0)
  for (int t = t0; t < t1; ++t) {
    asm volatile("s_waitcnt vmcnt(0)" ::: "memory");
    bf16x8 kf[4];
#pragma unroll
    for (int d0 = 0; d0 < 4; ++d0) kf[d0] = kfn[d0];
    if (t + 1 < t1) FR_ISSUE(t + 1)
    f32x16 s = zero16();
#pragma unroll
    for (int d0 = 0; d0 < 4; ++d0) s = MFMA32(kf[d0], qf[d0], s);
    fix(t, s);
    flash_core1(st, s, L->v + (t & 1) * 1024, L->xch, lane);
  }
#undef FR_ISSUE
}
__device__ __forceinline__ float flash_finish(FlashState& st, WaveLds* L, int lane) {
  const int r32 = lane & 31, hi = lane >> 5;
  const float lt = st.l + xor32_f(st.l); const float inv = lt > 0.f ? 1.f / lt : 0.f;
  L->xch[r32] = inv;
#pragma unroll
  for (int e = 0; e < 16; ++e) { const float a = L->xch[crow(e, hi)]; st.o0[e] *= a; st.o1[e] *= a; }
  return (st.m + __builtin_amdgcn_logf(lt)) * LN2;
}
__device__ __forceinline__ void load_q(bf16x8 (&qf)[4], const SB* qp, int hi) {
#pragma unroll
  for (int d0 = 0; d0 < 4; ++d0) qf[d0] = *(const bf16x8*)(qp + d0 * 16 + hi * 8);
}
__device__ __forceinline__ void fix_tab(f32x16& s, const WaveLds* L, int base, int lane, bool chk, int kb) {
  const int r32 = lane & 31, hi = lane >> 5; const float* tp = L->tab + base + r32 + 32 - 4 * hi;
#pragma unroll
  for (int e = 0; e < 16; ++e) { const int kk = (e & 3) + 8 * (e >> 2); float v = s[e] * QSC + tp[-kk]; if (chk && (kb + kk + 4 * hi < 0)) v = NINF; s[e] = v; }
}

__device__ __forceinline__ void unit_c(const Params& p, int layer, int u, WaveLds* L, int lane) {
  const int h = u & 7, qt = u >> 3, q0 = qt * 32, hk = h >> 2, r32 = lane & 31, hi = lane >> 5;
  for (int x = lane; x < 192; x += 64) { const int dist = x - 32; L->tab[x] = (dist >= 0 && dist <= 127) ? 0.f : NINF; }
  bf16x8 qf[4]; load_q(qf, p.proj + (long)(q0 + r32) * NPROJ + PC_Q + h * 64, hi);
  FlashState st; st.o0 = zero16(); st.o1 = zero16(); st.m = p.sinks[layer * 8 + h] * L2E; st.l = hi ? 0.f : 1.f;
  const SB* kvb = p.proj + PC_KV + hk * 64; const bool chk = q0 < 128;
  flash_run(st, qf, 0, 5, [&](int t) { int tok = q0 - 128 + 32 * t + r32; tok = tok < 0 ? 0 : tok; return kvb + (long)tok * NPROJ; },
            [&](int t, int key) { int tk = q0 - 128 + 32 * t + key; tk = tk < 0 ? 0 : tk; return kvb + 128 + (long)tk * NPROJ; },
            [&](int t, f32x16& s) { fix_tab(s, L, 128 - 32 * t, lane, chk, q0 - 128 + 32 * t); }, L, lane);
  flash_finish(st, L, lane);
#pragma unroll
  for (int e = 0; e < 16; ++e) { SB* mp = p.mix + (long)(q0 + crow(e, hi)) * NMIX + MX_C + h * 64 + r32; mp[0] = f2bf(st.o0[e] * bf2f(mp[0])); mp[32] = f2bf(st.o1[e] * bf2f(mp[32])); }
}
__device__ __forceinline__ void unit_m(const Params& p, int layer, int u, WaveLds* L, int lane) {
  const int h = u & 3, qt = u >> 2, q0 = qt * 32, r32 = lane & 31, hi = lane >> 5;
  bf16x8 qf[4]; load_q(qf, p.proj + (long)(q0 + r32) * NPROJ + PM_Q + h * 64, hi);
  FlashState st; st.o0 = zero16(); st.o1 = zero16(); st.m = -1e30f; st.l = 0.f;
  const SB* kb = p.memkv + (long)layer * 256 * 512 + h * 64;
  flash_run(st, qf, 0, 8, [&](int t) { return kb + (long)(32 * t + r32) * 512; }, [&](int t, int key) { return kb + 256 + (long)(32 * t + key) * 512; },
            [&](int, f32x16& s) {
#pragma unroll
              for (int e = 0; e < 16; ++e) s[e] *= QSC; }, L, lane);
  flash_finish(st, L, lane);
#pragma unroll
  for (int e = 0; e < 16; ++e) { SB* mp = p.mix + (long)(q0 + crow(e, hi)) * NMIX + MX_M + h * 64 + r32; mp[0] = f2bf(st.o0[e] * bf2f(mp[0])); mp[32] = f2bf(st.o1[e] * bf2f(mp[32])); }
}
__device__ __forceinline__ void unit_awin(const Params& p, int u, WaveLds* L, int lane) {
  const int h = u & 7, qt = u >> 3, q0 = qt * 32, hk = h >> 2, r32 = lane & 31, hi = lane >> 5;
  for (int x = lane; x < 608; x += 64) { const int dist = x - 32; L->tab[x] = (dist >= 0 && dist <= 511) ? p.tabA[h * TABA_N + dist] * L2E : NINF; }
  bf16x8 qf[4]; load_q(qf, p.proj + (long)(q0 + r32) * NPROJ + PA_Q + h * 64, hi);
  FlashState st; st.o0 = zero16(); st.o1 = zero16(); st.m = -1e30f; st.l = 0.f;
  const SB* kvb = p.proj + PA_KV + 4 * 128 + hk * 64; const bool chk = q0 < 512;
  { int tfirst = 0; if (q0 < 512) tfirst = (512 - q0) / 32 - 0; if (tfirst > 16) tfirst = 16; if (q0 < 512 && (q0 - 512 + 32 * tfirst + 31) < 0) ++tfirst;
    flash_run(st, qf, tfirst, 17, [&](int t) { int tok = q0 - 512 + 32 * t + r32; tok = tok < 0 ? 0 : tok; return kvb + (long)tok * NPROJ; },
              [&](int t, int key) { int tk = q0 - 512 + 32 * t + key; tk = tk < 0 ? 0 : tk; return kvb + 128 + (long)tk * NPROJ; },
              [&](int t, f32x16& s) { fix_tab(s, L, 512 - 32 * t, lane, chk, q0 - 512 + 32 * t); }, L, lane); }
  flash_finish(st, L, lane);
#pragma unroll
  for (int e = 0; e < 16; ++e) { SB* op = p.ow + (long)(q0 + crow(e, hi)) * 512 + h * 64 + r32; op[0] = f2bf(st.o0[e]); op[32] = f2bf(st.o1[e]); }
}
__device__ __forceinline__ void unit_d(const Params& p, int u, WaveLds* L, int lane) {
  const int S = p.S, per = (S / 32) * 8; const int gi = u / per, u2 = u % per; const int h = u2 & 7, v = u2 >> 3;
  const int dil = gi == 0 ? 1 : (gi == 1 ? 4 : 16); const int it = v / dil, r = v % dil, i0 = it * 32;
  const int r32 = lane & 31, hi = lane >> 5;
  for (int x = lane; x < 192; x += 64) { const int dd = x - 32; L->tab[x] = (dd >= 0 && dd <= 128) ? p.tabD[(gi * 8 + h) * TABD_N + dd] * L2E : NINF; }
  bf16x8 qf[4]; load_q(qf, p.proj + (long)(r + dil * (i0 + r32)) * NPROJ + PD_Q + gi * 512 + h * 64, hi);
  FlashState st; st.o0 = zero16(); st.o1 = zero16(); st.m = -1e30f; st.l = 0.f;
  const SB* kvb = p.proj + PD_KV + h * 64; const bool chk = i0 < 128;
  flash_run(st, qf, 0, 5, [&](int t) { int j = i0 - 128 + 32 * t + r32; j = j < 0 ? 0 : j; return kvb + (long)(r + dil * j) * NPROJ; },
            [&](int t, int key) { int jj = i0 - 128 + 32 * t + key; jj = jj < 0 ? 0 : jj; return kvb + 512 + (long)(r + dil * jj) * NPROJ; },
            [&](int t, f32x16& s) { fix_tab(s, L, 128 - 32 * t, lane, chk, i0 - 128 + 32 * t); }, L, lane);
  const float lse = flash_finish(st, L, lane);
#pragma unroll
  for (int e = 0; e < 16; ++e) { const long tok = r + dil * (i0 + crow(e, hi)); SB* op = p.dop + ((long)gi * S + tok) * 512 + h * 64 + r32; op[0] = f2bf(st.o0[e]); op[32] = f2bf(st.o1[e]); }
  if (hi == 0) p.dlse[((long)gi * S + r + dil * (i0 + r32)) * 8 + h] = lse;
}
__device__ __forceinline__ void fix_cmp(f32x16& s, const Params& p, int h, int q0, int t, int lane) {
  const int r32 = lane & 31, hi = lane >> 5; const int dq = q0 + r32 - 31 - 16 * (32 * t + 4 * hi);
  const bool far = (q0 - 16 * (32 * t + 31) - 31) >= 1513; const float c31 = p.tabA[h * TABA_N + 2047] * L2E;
#pragma unroll
  for (int e = 0; e < 16; ++e) { const int kk = (e & 3) + 8 * (e >> 2); const int dist = dq - 16 * kk; float b;
    if (far) b = c31; else { const int dc = dist < 0 ? 0 : (dist > 2047 ? 2047 : dist); b = p.tabA[h * TABA_N + dc] * L2E; }
    s[e] = dist < 0 ? NINF : s[e] * QSC + b; }
}
__device__ __forceinline__ void unit_acmp1(const Params& p, int u, WaveLds* L, int lane) {
  const int h = u & 7, qt = (p.S / 32 - 1) - (u >> 3), q0 = qt * 32, g = h >> 2, r32 = lane & 31, hi = lane >> 5; const int ncmp = p.S / 16;
  bf16x8 qf[4]; load_q(qf, p.proj + (long)(q0 + r32) * NPROJ + PA_Q + h * 64, hi);
  FlashState st; st.o0 = zero16(); st.o1 = zero16(); st.m = -1e30f; st.l = 0.f;
  const int jn = q0 / 16 + 1, nt = (jn + 31) / 32; const SB* kc = p.kvc + g * 64; const SB* vc = p.kvc + (long)ncmp * 128 + g * 64;
  flash_run(st, qf, 0, nt, [&](int t) { int j = 32 * t + r32; j = j >= ncmp ? ncmp - 1 : j; return kc + (long)j * 128; },
            [&](int t, int key) { int jj = 32 * t + key; jj = jj >= ncmp ? ncmp - 1 : jj; return vc + (long)jj * 128; },
            [&](int t, f32x16& s) { fix_cmp(s, p, h, q0, t, lane); }, L, lane);
  const float lt = st.l + xor32_f(st.l); const float inv = lt > 0.f ? 1.f / lt : 0.f;
  flash_finish(st, L, lane);
#pragma unroll
  for (int e = 0; e < 16; ++e) { SB* op = p.oc + (long)(q0 + crow(e, hi)) * 512 + h * 64 + r32; op[0] = f2bf(st.o0[e]); op[32] = f2bf(st.o1[e]); }
  if (hi == 0) { p.cml[((long)(q0 + r32) * 8 + h) * 2] = st.m; p.cml[((long)(q0 + r32) * 8 + h) * 2 + 1] = inv; }
}
__device__ __forceinline__ void unit_acmp2(const Params& p, int u, int lane) {
  const int part = u & 3, g = (u >> 2) & 1, qt = (p.S / 32 - 1) - (u >> 3), q0 = qt * 32, r32 = lane & 31, hi = lane >> 5; const int ncmp = p.S / 16;
  const int jn = q0 / 16 + 1, nt = (jn + 31) / 32; const SB* kc = p.kvc + g * 64; float carry = 0.f;
  const int tper = (nt + 3) >> 2, tbeg = part * tper, tend = (tbeg + tper < nt) ? tbeg + tper : nt; if (tbeg >= nt) return;
  float* impq = p.imp + ((long)qt * 2 + g) * 256 * 32 + r32;
  const SB* qbase = p.proj + (long)(q0 + r32) * NPROJ + PA_Q + g * 256; const float* cmlq = p.cml + ((long)(q0 + r32) * 8 + g * 4) * 2;
  bf16x8 kfn[4]; { const int t = (tbeg > 0 ? tbeg - 1 : 0); int j = 32 * t + r32; j = j >= ncmp ? ncmp - 1 : j; const SB* kp = kc + (long)j * 128;
#pragma unroll
    for (int d0 = 0; d0 < 4; ++d0) kfn[d0] = *(const bf16x8*)(kp + d0 * 16 + hi * 8); }
  for (int t = (tbeg > 0 ? tbeg - 1 : 0); t < tend; ++t) {
    bf16x8 kf[4];
#pragma unroll
    for (int d0 = 0; d0 < 4; ++d0) kf[d0] = kfn[d0];
    if (t + 1 < tend) { int j = 32 * (t + 1) + r32; j = j >= ncmp ? ncmp - 1 : j; const SB* kp = kc + (long)j * 128;
#pragma unroll
      for (int d0 = 0; d0 < 4; ++d0) kfn[d0] = *(const bf16x8*)(kp + d0 * 16 + hi * 8); }
    float accA[4] = {0.f, 0.f, 0.f, 0.f}, accL[4] = {0.f, 0.f, 0.f, 0.f};
#pragma unroll 1
    for (int hh = 0; hh < 4; ++hh) { bf16x8 qf[4]; load_q(qf, qbase + hh * 64, hi); const float m = cmlq[hh * 2], il = cmlq[hh * 2 + 1];
      f32x16 s = zero16();
#pragma unroll
      for (int d0 = 0; d0 < 4; ++d0) s = MFMA32(kf[d0], qf[d0], s);
      fix_cmp(s, p, g * 4 + hh, q0, t, lane);
#pragma unroll
      for (int e = 0; e < 16; ++e) { const float pr = __builtin_amdgcn_exp2f(s[e] - m) * il; accA[e >> 2] += pr; if ((e & 3) == 3) accL[e >> 2] += pr; } }
    float oth[4];
#pragma unroll
    for (int eg = 0; eg < 4; ++eg) oth[eg] = xor32_f(accL[eg]);
#pragma unroll
    for (int eg = 0; eg < 4; ++eg) { const float prev = hi ? oth[eg] : (eg > 0 ? oth[eg > 0 ? eg - 1 : 0] : carry); if (t >= tbeg) impq[(8 * t + 2 * eg + hi) * 32] = 2.f * accA[eg] - accL[eg] + prev; }
    carry = oth[3]; }
}
#define DPP_F(v, ctrl, rm) __builtin_bit_cast(float, __builtin_amdgcn_update_dpp(__builtin_bit_cast(int, v), __builtin_bit_cast(int, v), ctrl, rm, 0xf, false))
#define DPP_I(v, ctrl, rm) __builtin_amdgcn_update_dpp(v, v, ctrl, rm, 0xf, false)
__device__ __forceinline__ float wave_max_f(float v) {
  v = fmaxf(v, DPP_F(v, 0xB1, 0xf)); v = fmaxf(v, DPP_F(v, 0x4E, 0xf)); v = fmaxf(v, DPP_F(v, 0x141, 0xf)); v = fmaxf(v, DPP_F(v, 0x140, 0xf));
  v = fmaxf(v, DPP_F(v, 0x142, 0xa)); v = fmaxf(v, DPP_F(v, 0x143, 0xc));
  return __builtin_bit_cast(float, __builtin_amdgcn_readlane(__builtin_bit_cast(int, v), 63)); }
__device__ __forceinline__ int imin_(int a, int b) { return a < b ? a : b; }
__device__ __forceinline__ int wave_min_i(int v) {
  v = imin_(v, DPP_I(v, 0xB1, 0xf)); v = imin_(v, DPP_I(v, 0x4E, 0xf)); v = imin_(v, DPP_I(v, 0x141, 0xf)); v = imin_(v, DPP_I(v, 0x140, 0xf));
  v = imin_(v, DPP_I(v, 0x142, 0xa)); v = imin_(v, DPP_I(v, 0x143, 0xc));
  return __builtin_amdgcn_readlane(v, 63); }
__device__ __forceinline__ void unit_topk(const Params& p, int u, int lane) {
  const int q = u >> 1, cur = q >> 6; const float* imp = p.imp + ((long)(q >> 5) * 2 + (u & 1)) * 256 * 32 + (q & 31); int* idx = p.idx + (long)u * 16;
  float v[4];
#pragma unroll
  for (int k = 0; k < 4; ++k) { const int b = lane + 64 * k; float x = (b <= cur) ? imp[b * 32] : -1.f; if (b == 0 || b == cur) x = 1e4f; v[k] = x; }
  int mine = -1;
  for (int k = 0; k < 16; ++k) {
    float lm = fmaxf(fmaxf(v[0], v[1]), fmaxf(v[2], v[3])); const float m = wave_max_f(lm);
    int cand = 0x7fffffff;
#pragma unroll
    for (int kk = 3; kk >= 0; --kk) if (v[kk] == m) cand = lane + 64 * kk;
    const int bsel = wave_min_i(cand);
#pragma unroll
    for (int kk = 0; kk < 4; ++kk) if (lane + 64 * kk == bsel) v[kk] = -2.f;
    if (lane == k) mine = (m >= 0.f) ? bsel : -1;
  }
  if (lane < 16) idx[lane] = mine;
}
template <bool STORE = true>
__device__ __forceinline__ void unit_asel(const Params& p, int u, WaveLds* L, int lane) {
  const int g = u & 1, q = u >> 1, r32 = lane & 31, hi = lane >> 5, hh = r32 & 3, h = g * 4 + hh;
  bf16x8 qf[4]; load_q(qf, p.proj + (long)q * NPROJ + PA_Q + h * 64, hi);
  FlashState st; st.o0 = zero16(); st.o1 = zero16(); st.m = -1e30f; st.l = 0.f;
  const int* idx = p.idx + (long)u * 16; const SB* kvb = p.proj + PA_KV + 2 * 128 + g * 64; const float c31 = p.tabA[h * TABA_N + 2047] * L2E;
  for (int k = 0; k < 16; ++k) { const int b = __builtin_amdgcn_readfirstlane(idx[k]); if (b < 0) continue;
    for (int kt = 0; kt < 2; ++kt) { const int t0 = b * 64 + kt * 32; if (t0 > q) continue;
      const bool far = (q - (t0 + 31)) >= 1513; const bool edge = (t0 + 31 > q);
      flash_tile(st, qf, kvb + (long)(t0 + r32) * NPROJ, [&](int key) { return kvb + 128 + (long)(t0 + key) * NPROJ; },
                 [&](f32x16& s) {
#pragma unroll
                   for (int e = 0; e < 16; ++e) { const int tk = t0 + (e & 3) + 8 * (e >> 2) + 4 * hi; const int dist = q - tk; float bsv;
                     if (far) bsv = c31; else { const int dc = dist < 0 ? 0 : (dist > 2047 ? 2047 : dist); bsv = p.tabA[h * TABA_N + dc] * L2E; }
                     float vv = s[e] * QSC + bsv; if (edge && dist < 0) vv = NINF; s[e] = vv; } }, L, lane); } }
  flash_finish(st, L, lane);
  if (!STORE) { asm volatile("" :: "v"(st.o0[0]), "v"(st.o1[3])); return; }
  if (hi == 0) {
#pragma unroll
    for (int e = 0; e < 4; ++e) { const int he = g * 4 + e; const float* gl = p.small + (long)q * NSMALL + he * 3;
      const float g0 = sigmoid_f(gl[0]), g1 = sigmoid_f(gl[1]), g2 = sigmoid_f(gl[2]);
#pragma unroll
      for (int db = 0; db < 2; ++db) { const long c = (long)q * 512 + he * 64 + db * 32 + r32; const float os = db ? st.o1[e] : st.o0[e];
        const float a = g0 * bf2f(p.oc[c]) + g1 * os + g2 * bf2f(p.ow[c]); SB* mp = p.mix + (long)q * NMIX + MX_A + he * 64 + db * 32 + r32; *mp = f2bf(a * bf2f(*mp)); } }
  }
}

struct WaveLds2 { unsigned short x[2048]; unsigned short b[2048]; float acs[128]; float dtv[128]; float xch[64]; };
template <bool SCALE, class RowScale>
__device__ __forceinline__ void stage_slab(unsigned short* dst, const SB* src, long ld, RowScale rs, int lane) {
#pragma unroll
  for (int i = 0; i < 4; ++i) { const int c = lane + 64 * i, row = c >> 3, ch = c & 7; uint4 vv = *(const uint4*)(src + (long)row * ld + ch * 8);
    if (SCALE) { const float sc = rs(row); unsigned w[4] = {vv.x, vv.y, vv.z, vv.w};
#pragma unroll
      for (int k = 0; k < 4; ++k) { const float lo = __uint_as_float(w[k] << 16) * sc, hi2 = __uint_as_float(w[k] & 0xffff0000u) * sc; w[k] = pk2(lo, hi2); }
      vv.x = w[0]; vv.y = w[1]; vv.z = w[2]; vv.w = w[3]; }
    *(uint4*)&dst[(ch >> 2) * 1024 + row * 32 + (ch & 3) * 8] = vv; }
}
__device__ __forceinline__ bf16x8 slab_frag(const unsigned short* img, int cb, int s2, int lane) {
  const int hi = lane >> 5; const unsigned short* vb = img + (4 * hi + ((lane & 15) >> 2)) * 32 + ((lane >> 4) & 1) * 16 + (lane & 3) * 4 + cb * 1024 + s2 * 512;
  const v4i16_t lo = __builtin_amdgcn_ds_read_tr16_b64_v4i16((LDS3 v4i16_t*)vb);
  const v4i16_t hh = __builtin_amdgcn_ds_read_tr16_b64_v4i16((LDS3 v4i16_t*)(vb + 256));
  return (bf16x8){lo[0], lo[1], lo[2], lo[3], hh[0], hh[1], hh[2], hh[3]};
}
__device__ __forceinline__ void unit_bstates(const Params& p, int u, WaveLds2* L, int lane) {
  const int nh = u & 1, hd = (u >> 1) & 7, c = u >> 4, g = hd >> 2, r32 = lane & 31, hi = lane >> 5;
  f32x16 acc[2][2];
#pragma unroll
  for (int i = 0; i < 2; ++i)
#pragma unroll
    for (int j = 0; j < 2; ++j) acc[i][j] = zero16();
  const SB* xb = p.xconv + (long)c * 128 * 1024; const float* wst = p.wst + (long)c * 128 * 8 + hd;
  for (int q4 = 0; q4 < 4; ++q4) {
    stage_slab<true>(L->x, xb + (long)(32 * q4) * 1024 + hd * 64, 1024, [&](int row) { return wst[(32 * q4 + row) * 8]; }, lane);
    stage_slab<false>(L->b, xb + (long)(32 * q4) * 1024 + 512 + g * 128 + nh * 64, 1024, [&](int) { return 1.f; }, lane);
#pragma unroll
    for (int s2 = 0; s2 < 2; ++s2) { bf16x8 af[2], bfr[2];
#pragma unroll
      for (int i = 0; i < 2; ++i) { af[i] = slab_frag(L->x, i, s2, lane); bfr[i] = slab_frag(L->b, i, s2, lane); }
#pragma unroll
      for (int i = 0; i < 2; ++i)
#pragma unroll
        for (int j = 0; j < 2; ++j) acc[i][j] = MFMA32(af[i], bfr[j], acc[i][j]); } }
  float* so = p.states + ((long)c * 8 + hd) * 8192 + nh * 64 + r32;
#pragma unroll
  for (int i = 0; i < 2; ++i)
#pragma unroll
    for (int j = 0; j < 2; ++j)
#pragma unroll
      for (int e = 0; e < 16; ++e) so[(long)(32 * i + crow(e, hi)) * 128 + 32 * j] = acc[i][j][e];
}
__device__ __forceinline__ void unit_bout(const Params& p, int layer, int u, WaveLds2* L, int lane) {
  const int lt = u & 3, hd = (u >> 2) & 7, c = u >> 5, g = hd >> 2, r32 = lane & 31, hi = lane >> 5;
  for (int x = lane; x < 128; x += 64) { L->acs[x] = p.acs[((long)c * 128 + x) * 8 + hd]; L->dtv[x] = p.dt[((long)c * 128 + x) * 8 + hd]; }
  f32x16 acc[2] = {zero16(), zero16()}, acc2[2] = {zero16(), zero16()};
  const SB* xb = p.xconv + (long)c * 128 * 1024; const int l = 32 * lt + r32; const float al = p.acs[((long)c * 128 + l) * 8 + hd];
  const float* cbr = p.cb + ((long)c * 2 + g) * 16384 + (long)l * 128;
  for (int sc = 0; sc <= lt; ++sc) {
    stage_slab<false>(L->x, xb + (long)(32 * sc) * 1024 + hd * 64, 1024, [&](int) { return 1.f; }, lane);
#pragma unroll
    for (int s2 = 0; s2 < 2; ++s2) { float mv[8];
#pragma unroll
      for (int jj = 0; jj < 2; ++jj) { const int s0 = 32 * sc + 16 * s2 + 8 * jj + 4 * hi; const float4 cv = *(const float4*)(cbr + s0); const float4 av = *(const float4*)(&L->acs[s0]); const float4 dv = *(const float4*)(&L->dtv[s0]);
        mv[4 * jj + 0] = (s0 + 0 <= l) ? cv.x * __expf(al - av.x) * dv.x : 0.f; mv[4 * jj + 1] = (s0 + 1 <= l) ? cv.y * __expf(al - av.y) * dv.y : 0.f;
        mv[4 * jj + 2] = (s0 + 2 <= l) ? cv.z * __expf(al - av.z) * dv.z : 0.f; mv[4 * jj + 3] = (s0 + 3 <= l) ? cv.w * __expf(al - av.w) * dv.w : 0.f; }
      u32x4 aw; aw[0] = pk2(mv[0], mv[1]); aw[1] = pk2(mv[2], mv[3]); aw[2] = pk2(mv[4], mv[5]); aw[3] = pk2(mv[6], mv[7]); const bf16x8 af = __builtin_bit_cast(bf16x8, aw);
#pragma unroll
      for (int pt = 0; pt < 2; ++pt) acc[pt] = MFMA32(af, slab_frag(L->x, pt, s2, lane), acc[pt]); } }
  const SB* cmr = xb + (long)l * 1024 + 768 + g * 128; const float* prv = p.states + ((long)c * 8 + hd) * 8192;
#pragma unroll 2
  for (int ks = 0; ks < 8; ++ks) { const bf16x8 af = *(const bf16x8*)(cmr + 16 * ks + 8 * hi);
#pragma unroll
    for (int pt = 0; pt < 2; ++pt) { const float* pr = prv + (long)(32 * pt + r32) * 128 + 16 * ks + 8 * hi; const float4 a0 = *(const float4*)pr, a1 = *(const float4*)(pr + 4);
      u32x4 bw; bw[0] = pk2(a0.x, a0.y); bw[1] = pk2(a0.z, a0.w); bw[2] = pk2(a1.x, a1.y); bw[3] = pk2(a1.z, a1.w);
      acc2[pt] = MFMA32(af, __builtin_bit_cast(bf16x8, bw), acc2[pt]); } }
  const float dsk = p.b_d[layer * 8 + hd];
#pragma unroll
  for (int e = 0; e < 16; ++e) { const int lr = 32 * lt + crow(e, hi); const float ea = __expf(L->acs[lr]); const long t = (long)c * 128 + lr;
#pragma unroll
    for (int pt = 0; pt < 2; ++pt) { const int pp = 32 * pt + r32; p.ybuf[t * 512 + hd * 64 + pp] = acc[pt][e] + ea * acc2[pt][e] + dsk * bf2f(xb[(long)lr * 1024 + hd * 64 + pp]); } }
}
__device__ __forceinline__ void unit_bnorm(const Params& p, int layer, int u, int lane) {
  const int g = u & 1; const long t = u >> 1; const float4 yv = *(const float4*)(p.ybuf + t * 512 + g * 256 + lane * 4);
  SB* mp = p.mix + t * NMIX + MX_B + g * 256 + lane * 4; const ushort4 zv = *(const ushort4*)mp;
  const float v0 = yv.x * bf2f(zv.x), v1 = yv.y * bf2f(zv.y), v2 = yv.z * bf2f(zv.z), v3 = yv.w * bf2f(zv.w);
  const float ss = wave_sum_f(v0 * v0 + v1 * v1 + v2 * v2 + v3 * v3); const float r = 1.f / sqrtf(ss * (1.f / 256.f) + 1e-6f);
  const float4 w = *(const float4*)(p.b_norm + layer * 512 + g * 256 + lane * 4);
  ushort4 o; o.x = f2bf(v0 * r * w.x); o.y = f2bf(v1 * r * w.y); o.z = f2bf(v2 * r * w.z); o.w = f2bf(v3 * r * w.w); *(ushort4*)mp = o;
}
__device__ __forceinline__ void unit_bdt(const Params& p, int layer, int u, int lane) {
  const int hd = u & 7, c = u >> 3; const float a = -expf(p.a_log[layer * 8 + hd]), bias = p.dt_bias[layer * 8 + hd]; const long t0 = (long)c * 128 + 2 * lane;
  const float d0 = softplus_f(p.small[t0 * NSMALL + 24 + hd] + bias), d1 = softplus_f(p.small[(t0 + 1) * NSMALL + 24 + hd] + bias);
  float run = (d0 + d1) * a;
#pragma unroll
  for (int o = 1; o < 64; o <<= 1) { const float v = __shfl_up(run, o); if (lane >= o) run += v; }
  const float tot = __shfl(run, 63); const float c1 = run, c0 = run - d1 * a;
  p.dt[t0 * 8 + hd] = d0; p.dt[(t0 + 1) * 8 + hd] = d1; p.acs[t0 * 8 + hd] = c0; p.acs[(t0 + 1) * 8 + hd] = c1;
  p.wst[t0 * 8 + hd] = d0 * expf(tot - c0); p.wst[(t0 + 1) * 8 + hd] = d1 * expf(tot - c1);
}
__device__ __forceinline__ void item_bconv(const Params& p, int layer, long gid) {
  const int cg = (int)(gid & 127) * 8; const long t = gid >> 7; const float* w = p.conv_w + (long)layer * 4 * 1024 + cg; const float* bb = p.conv_b + layer * 1024 + cg;
  const float4 b0 = *(const float4*)bb, b1 = *(const float4*)(bb + 4);
  float acc[8] = {b0.x, b0.y, b0.z, b0.w, b1.x, b1.y, b1.z, b1.w};
#pragma unroll
  for (int i = 0; i < 4; ++i) { const long tt = t - 3 + i; const long tc = tt < 0 ? 0 : tt; const float vm = tt < 0 ? 0.f : 1.f;
    const uint4 vv = *(const uint4*)(p.proj + tc * NPROJ + PB_X + cg); const unsigned wd[4] = {vv.x, vv.y, vv.z, vv.w};
    const float4 w0 = *(const float4*)(w + i * 1024), w1 = *(const float4*)(w + i * 1024 + 4); const float wv[8] = {w0.x, w0.y, w0.z, w0.w, w1.x, w1.y, w1.z, w1.w};
#pragma unroll
    for (int k = 0; k < 4; ++k) { acc[2 * k] += vm * wv[2 * k] * __uint_as_float(wd[k] << 16); acc[2 * k + 1] += vm * wv[2 * k + 1] * __uint_as_float(wd[k] & 0xffff0000u); } }
  uint4 o; o.x = pk2(silu_f(acc[0]), silu_f(acc[1])); o.y = pk2(silu_f(acc[2]), silu_f(acc[3])); o.z = pk2(silu_f(acc[4]), silu_f(acc[5])); o.w = pk2(silu_f(acc[6]), silu_f(acc[7]));
  *(uint4*)(p.xconv + t * 1024 + cg) = o;
}
__device__ __forceinline__ void unit_cmp(const Params& p, int layer, int u, int lane) {
  const int ncmp = p.S / 16, ntile = ncmp * 2 / 32; const int kv = u / ntile, rt = u % ntile, r32 = lane & 31, hi = lane >> 5;
  const int r = 32 * rt + r32, j = r >> 1, hk = r & 1;
  const unsigned short* w1t = p.w1t + (long)kv * 128 * 2048; const unsigned short* w2t = p.w2t + kv * 64 * 128; const float* pe = p.cmp_pos + (long)(layer * 2 + kv) * 32 * 64;
  const SB* src = p.proj + PA_KV + kv * 128 + hk * 64;
  f32x16 acc[4] = {zero16(), zero16(), zero16(), zero16()};
#pragma unroll 4
  for (int ks = 0; ks < 128; ++ks) { const int t = ks >> 2, d = (ks & 3) * 16 + 8 * hi; const long tok = 16 * j + t;
    const float4 p0 = *(const float4*)(pe + t * 64 + d), p1 = *(const float4*)(pe + t * 64 + d + 4); float v[8] = {p0.x, p0.y, p0.z, p0.w, p1.x, p1.y, p1.z, p1.w};
    { const long tokc = tok < p.S ? tok : (long)p.S - 1; const float vm = tok < p.S ? 1.f : 0.f;
      const uint4 vv = *(const uint4*)(src + tokc * NPROJ + d); const unsigned wd[4] = {vv.x, vv.y, vv.z, vv.w};
#pragma unroll
      for (int k = 0; k < 4; ++k) { v[2 * k] += vm * __uint_as_float(wd[k] << 16); v[2 * k + 1] += vm * __uint_as_float(wd[k] & 0xffff0000u); } }
    u32x4 bw; bw[0] = pk2(v[0], v[1]); bw[1] = pk2(v[2], v[3]); bw[2] = pk2(v[4], v[5]); bw[3] = pk2(v[6], v[7]); const bf16x8 bfr = __builtin_bit_cast(bf16x8, bw);
#pragma unroll
    for (int ut = 0; ut < 4; ++ut) { const bf16x8 af = *(const bf16x8*)(w1t + (long)(32 * ut + r32) * 2048 + 16 * ks + 8 * hi); acc[ut] = MFMA32(af, bfr, acc[ut]); } }
  f32x16 o2[2] = {zero16(), zero16()};
#pragma unroll
  for (int ut = 0; ut < 4; ++ut) {
#pragma unroll
    for (int e = 0; e < 16; ++e) acc[ut][e] = gelu_f(acc[ut][e]);
#pragma unroll
    for (int s2 = 0; s2 < 2; ++s2) { const bf16x8 hb = pack8(acc[ut], 8 * s2);
#pragma unroll
      for (int dt = 0; dt < 2; ++dt) { const unsigned short* wr = w2t + (32 * dt + r32) * 128 + 32 * ut + 16 * s2 + 4 * hi; const uint2 x0 = *(const uint2*)wr, x1 = *(const uint2*)(wr + 8);
        u32x4 aw; aw[0] = x0.x; aw[1] = x0.y; aw[2] = x1.x; aw[3] = x1.y; o2[dt] = MFMA32(__builtin_bit_cast(bf16x8, aw), hb, o2[dt]); } } }
  SB* dst = p.kvc + ((long)kv * ncmp * 2 + r) * 64;
#pragma unroll
  for (int dt = 0; dt < 2; ++dt)
#pragma unroll
    for (int e = 0; e < 16; ++e) dst[32 * dt + crow(e, hi)] = f2bf(o2[dt][e]);
}

template <class RowFn, class OutFn>
__device__ __forceinline__ void topk4_rows_o(const Params& p, RowFn rowfn, OutFn outfn, int lane) {
  float v[4][4]; int cur[4], mine[4];
#pragma unroll
  for (int r = 0; r < 4; ++r) { const int row = rowfn(r); const int q = row >> 1; cur[r] = q >> 6; const float* imp = p.imp + ((long)(q >> 5) * 2 + (row & 1)) * 256 * 32 + (q & 31); mine[r] = -1;
#pragma unroll
    for (int k = 0; k < 4; ++k) { const int b = lane + 64 * k; float x = (b <= cur[r]) ? imp[b * 32] : -1.f; if (b == 0 || b == cur[r]) x = 1e4f; v[r][k] = x; } }
  for (int k = 0; k < 16; ++k) {
    float m[4]; int cand[4];
#pragma unroll
    for (int r = 0; r < 4; ++r) m[r] = wave_max_f(fmaxf(fmaxf(v[r][0], v[r][1]), fmaxf(v[r][2], v[r][3])));
#pragma unroll
    for (int r = 0; r < 4; ++r) { int c = 0x7fffffff;
#pragma unroll
      for (int kk = 3; kk >= 0; --kk) if (v[r][kk] == m[r]) c = lane + 64 * kk;
      cand[r] = wave_min_i(c); }
#pragma unroll
    for (int r = 0; r < 4; ++r) {
#pragma unroll
      for (int kk = 0; kk < 4; ++kk) if (lane + 64 * kk == cand[r]) v[r][kk] = -2.f;
      if (lane == k) mine[r] = (m[r] >= 0.f) ? cand[r] : -1; }
  }
#pragma unroll
  for (int r = 0; r < 4; ++r) if (lane < 16) { p.idx[(long)rowfn(r) * 16 + lane] = mine[r]; outfn(r, mine[r]); }
}
template <class RowFn>
__device__ __forceinline__ void topk4_rows(const Params& p, RowFn rowfn, int lane) { topk4_rows_o(p, rowfn, [](int, int) {}, lane); }
__device__ __forceinline__ void unit_topk4(const Params& p, int u, int lane) { topk4_rows(p, [&](int r) { return u * 4 + r; }, lane); }
__device__ __forceinline__ void glds16_asm(const void* gsrc, unsigned lds_dst) {
  unsigned keep; asm volatile("s_mov_b32 %0, m0\n\ts_mov_b32 m0, %2\n\ts_nop 0\n\tglobal_load_lds_dwordx4 %1, off\n\ts_mov_b32 m0, %0" : "=&s"(keep) : "v"(gsrc), "s"(lds_dst) : "memory");
}
__device__ __forceinline__ unsigned lds_addr(const void* p) { return (unsigned)(size_t)(LDS3 const void*)p; }
struct AselLds { unsigned short k[3][4096]; unsigned short v[3][4096]; unsigned short q[4][2048]; unsigned sel[64][8]; unsigned anyb[8]; int nlist; int pad[7]; unsigned char blist[256]; float xch[4][32]; unsigned char bkt[1664]; float relS[128]; };
__device__ __forceinline__ void asel_issue(uint4 (&r)[4], const SB* kvb, int b, int tid) {
#pragma unroll
  for (int i = 0; i < 2; ++i) { const int idx = tid + 256 * i, row = idx >> 3, ch = idx & 7; const SB* src = kvb + (long)(b * 64 + row) * NPROJ + ch * 8; r[i] = *(const uint4*)src; r[2 + i] = *(const uint4*)(src + 128); }
}
__device__ __forceinline__ void asel_commit(const uint4 (&r)[4], AselLds* A, int stage, int tid) {
#pragma unroll
  for (int i = 0; i < 2; ++i) { const int idx = tid + 256 * i, row = idx >> 3, ch = idx & 7;
    *(uint4*)&A->k[stage][row * 64 + ((ch ^ (row & 7)) * 8)] = r[i];
    *(uint4*)&A->v[stage][(ch >> 2) * 2048 + row * 32 + (ch & 3) * 8] = r[2 + i]; }
}
__device__ __forceinline__ void asel_coltile(const Params& p, FlashState& S_, const unsigned short* qlds, AselLds* A, float* xch, int stage, int b, int cur, int q0, int qbase, int h, float c31, int lane) {
  const int r32 = lane & 31, hi = lane >> 5; const int ql = qbase + (r32 >> 2); const int q = q0 + ql;
  const bool selq = (A->sel[ql][b >> 5] >> (b & 31)) & 1u;
  if (!__any(selq)) return;
  bf16x8 qf[4];
#pragma unroll
  for (int d0 = 0; d0 < 4; ++d0) qf[d0] = *(const bf16x8*)&qlds[r32 * 64 + (((2 * d0 + hi) ^ ((r32 >> 1) & 7)) * 8)];
  const bool far = (q0 - (b * 64 + 63)) >= 1513; const bool edge = (b == cur);
#ifndef ASEL2
#define ASEL2 1
#endif
#if ASEL2
  bf16x8 kf0[4], kf1[4];
#pragma unroll
  for (int d0 = 0; d0 < 4; ++d0) { const int row0 = r32, row1 = 32 + r32;
    kf0[d0] = *(const bf16x8*)&A->k[stage][row0 * 64 + (((2 * d0 + hi) ^ ((row0 >> 1) & 7)) * 8)];
    kf1[d0] = *(const bf16x8*)&A->k[stage][row1 * 64 + (((2 * d0 + hi) ^ ((row1 >> 1) & 7)) * 8)]; }
  f32x16 s0 = zero16(), s1 = zero16();
#pragma unroll
  for (int d0 = 0; d0 < 4; ++d0) { s0 = MFMA32(kf0[d0], qf[d0], s0); s1 = MFMA32(kf1[d0], qf[d0], s1); }
  if (far) { flash_core2_lin(S_, s0, s1, selq ? QSC : 0.f, selq ? c31 : NINF, A->v[stage], xch, lane); return; }
#pragma unroll
  for (int e = 0; e < 16; ++e) { const int tk = b * 64 + (e & 3) + 8 * (e >> 2) + 4 * hi; const int dist = q - tk; float b0, b1;
    { const int d0c = dist < 0 ? 0 : (dist > 1663 ? 1663 : dist); const int d1 = dist - 32; const int d1c = d1 < 0 ? 0 : (d1 > 1663 ? 1663 : d1);
      b0 = A->relS[A->bkt[d0c] * 4 + (h & 3)]; b1 = A->relS[A->bkt[d1c] * 4 + (h & 3)]; }
    float v0 = s0[e] * QSC + b0, v1 = s1[e] * QSC + b1; if (!selq || (edge && dist < 0)) v0 = NINF; if (!selq || (edge && dist < 32)) v1 = NINF; s0[e] = v0; s1[e] = v1; }
  flash_core2(S_, s0, s1, A->v[stage], xch, lane);
}
#else
#pragma unroll 1
  for (int kt = 0; kt < 2; ++kt) { const int t0 = b * 64 + 32 * kt; if (edge && t0 > q0 + qbase + 7) continue;
    bf16x8 kf[4]; { const int row = 32 * kt + r32;
#pragma unroll
      for (int d0 = 0; d0 < 4; ++d0) kf[d0] = *(const bf16x8*)&A->k[stage][row * 64 + (((2 * d0 + hi) ^ ((row >> 1) & 7)) * 8)]; }
    f32x16 s = zero16();
#pragma unroll
    for (int d0 = 0; d0 < 4; ++d0) s = MFMA32(kf[d0], qf[d0], s);
    if (far) { flash_core1_lin(S_, s, selq ? QSC : 0.f, selq ? c31 : NINF, A->v[stage] + kt * 1024, xch, lane); continue; }
#pragma unroll
    for (int e = 0; e < 16; ++e) { const int tk = t0 + (e & 3) + 8 * (e >> 2) + 4 * hi; const int dist = q - tk;
      const int dc = dist < 0 ? 0 : (dist > 2047 ? 2047 : dist); const float bsv = p.tabA[h * TABA_N + dc] * L2E;
      float vv = s[e] * QSC + bsv; if (!selq || (edge && dist < 0)) vv = NINF; s[e] = vv; }
    flash_core1(S_, s, A->v[stage] + kt * 1024, xch, lane);
  }
}
#endif
__device__ __forceinline__ void asel_store(const Params& p, FlashState& S_, float* xch, int q0, int qbase, int g, int lane) {
  const int r32 = lane & 31, hi = lane >> 5;
  const float lt = S_.l + xor32_f(S_.l); const float inv = lt > 0.f ? 1.f / lt : 0.f; xch[r32] = inv;
#pragma unroll
  for (int e = 0; e < 16; ++e) { const int j = crow(e, hi); const float a = xch[j]; const int q = q0 + qbase + (j >> 2), he = g * 4 + (j & 3);
    const float* gl = p.small + (long)q * NSMALL + he * 3; const float g0 = sigmoid_f(gl[0]), g1 = sigmoid_f(gl[1]), g2 = sigmoid_f(gl[2]);
#pragma unroll
    for (int db = 0; db < 2; ++db) { const long c = (long)q * 512 + he * 64 + db * 32 + r32; const float os = (db ? S_.o1[e] : S_.o0[e]) * a;
      const float av = g0 * bf2f(p.oc[c]) + g1 * os + g2 * bf2f(p.ow[c]); SB* mp = p.mix + (long)q * NMIX + MX_A + he * 64 + db * 32 + r32; *mp = f2bf(av * bf2f(*mp)); } }
}
#ifndef ASEL16
#define ASEL16 1
#endif
typedef float f32x4_t __attribute__((ext_vector_type(4)));
#define MFMA16(a, b, c) __builtin_amdgcn_mfma_f32_16x16x32_bf16((a), (b), (c), 0, 0, 0)
struct Asel16 { f32x4_t o0, o1, o2, o3; float m, l; };
__device__ __forceinline__ float quadmax_f(float v) {
  const auto a = __builtin_amdgcn_permlane16_swap(__float_as_uint(v), __float_as_uint(v), false, false); v = fmaxf(__uint_as_float(a[0]), __uint_as_float(a[1]));
  const auto b = __builtin_amdgcn_permlane32_swap(__float_as_uint(v), __float_as_uint(v), false, false); return fmaxf(__uint_as_float(b[0]), __uint_as_float(b[1])); }
__device__ __forceinline__ float quadsum_f(float v) {
  const auto a = __builtin_amdgcn_permlane16_swap(__float_as_uint(v), __float_as_uint(v), false, false); v = __uint_as_float(a[0]) + __uint_as_float(a[1]);
  const auto b = __builtin_amdgcn_permlane32_swap(__float_as_uint(v), __float_as_uint(v), false, false); return __uint_as_float(b[0]) + __uint_as_float(b[1]); }
__device__ __forceinline__ bf16x8 pack44(const f32x4_t& a, const f32x4_t& b) {
  u32x4 r; r[0] = pk2(a[0], a[1]); r[1] = pk2(a[2], a[3]); r[2] = pk2(b[0], b[1]); r[3] = pk2(b[2], b[3]); return __builtin_bit_cast(bf16x8, r); }
template <int CT>
__device__ __forceinline__ void asel_coltile16(const Params& p, Asel16& S_, const unsigned short* qlds, AselLds* A, float* xch, int stage, int b, int cur, int q0, int qbase, float c31, int lane) {
  const int j = lane & 15, q4 = lane >> 4; const int ql = qbase + 4 * CT + (j >> 2); const int q = q0 + ql;
  const bool selq = (A->sel[ql][b >> 5] >> (b & 31)) & 1u;
  if (!__any(selq)) return;
  const bool far = (q0 - (b * 64 + 63)) >= 1513; const bool edge = (b == cur);
  const int qrow = 16 * CT + j;
  const bf16x8 qf0 = *(const bf16x8*)&qlds[qrow * 64 + (((q4) ^ ((qrow >> 1) & 7)) * 8)], qf1 = *(const bf16x8*)&qlds[qrow * 64 + (((4 + q4) ^ ((qrow >> 1) & 7)) * 8)];
  f32x4_t sc[4];
#pragma unroll
  for (int kt = 0; kt < 4; ++kt) { const int row = 16 * kt + j;
    const bf16x8 k0 = *(const bf16x8*)&A->k[stage][row * 64 + (((q4) ^ ((row >> 1) & 7)) * 8)], k1 = *(const bf16x8*)&A->k[stage][row * 64 + (((4 + q4) ^ ((row >> 1) & 7)) * 8)];
    f32x4_t z = {0.f, 0.f, 0.f, 0.f}; z = MFMA16(k0, qf0, z); sc[kt] = MFMA16(k1, qf1, z); }
  float qs, bb;
  if (far) { qs = selq ? QSC : 0.f; bb = selq ? c31 : NINF; }
  else {
    qs = 1.f; bb = 0.f;
#pragma unroll
    for (int kt = 0; kt < 4; ++kt) {
#pragma unroll
      for (int r = 0; r < 4; ++r) { const int tk = b * 64 + 16 * kt + 4 * q4 + r; const int dist = q - tk; const int dc = dist < 0 ? 0 : (dist > 1663 ? 1663 : dist);
        float v = sc[kt][r] * QSC + A->relS[A->bkt[dc] * 4 + (j & 3)]; if (!selq || (edge && dist < 0)) v = NINF; sc[kt][r] = v; } }
  }
  float mr = fmaxf(fmaxf(sc[0][0], sc[0][1]), fmaxf(sc[0][2], sc[0][3]));
#pragma unroll
  for (int kt = 1; kt < 4; ++kt) mr = fmaxf(mr, fmaxf(fmaxf(sc[kt][0], sc[kt][1]), fmaxf(sc[kt][2], sc[kt][3])));
  float mx = far ? __builtin_fmaf(mr, qs, bb) : mr;
  mx = quadmax_f(mx);
  if (__any(mx > S_.m + FTHR)) {
    const float mn = fmaxf(S_.m, mx); const float al = __builtin_amdgcn_exp2f(S_.m - mn); S_.m = mn; S_.l *= al; xch[16 * CT + j] = al;
    const f32x4_t a = *(const f32x4_t*)&xch[16 * CT + 4 * q4];
    S_.o0 *= a; S_.o1 *= a; S_.o2 *= a; S_.o3 *= a;
  }
  const float bm = bb - S_.m; float ps = 0.f;
#pragma unroll
  for (int kt = 0; kt < 4; ++kt) {
#pragma unroll
    for (int r = 0; r < 4; ++r) { const float e_ = __builtin_amdgcn_exp2f(__builtin_fmaf(sc[kt][r], qs, bm)); sc[kt][r] = e_; ps += e_; } }
  S_.l += ps;
  const bf16x8 pa0 = pack44(sc[0], sc[1]), pa1 = pack44(sc[2], sc[3]);
  const unsigned short* vb = A->v[stage] + (4 * q4 + (j >> 2)) * 32 + (j & 3) * 4;
#pragma unroll
  for (int c = 0; c < 2; ++c) {
#pragma unroll
    for (int dt = 0; dt < 4; ++dt) {
      const v4i16_t lo = __builtin_amdgcn_ds_read_tr16_b64_v4i16((LDS3 v4i16_t*)(vb + (dt >> 1) * 2048 + (dt & 1) * 16 + c * 1024));
      const v4i16_t hh = __builtin_amdgcn_ds_read_tr16_b64_v4i16((LDS3 v4i16_t*)(vb + (dt >> 1) * 2048 + (dt & 1) * 16 + c * 1024 + 512));
      const bf16x8 vf = {lo[0], lo[1], lo[2], lo[3], hh[0], hh[1], hh[2], hh[3]};
      const bf16x8 pa = c ? pa1 : pa0;
      if (dt == 0) S_.o0 = MFMA16(pa, vf, S_.o0); else if (dt == 1) S_.o1 = MFMA16(pa, vf, S_.o1); else if (dt == 2) S_.o2 = MFMA16(pa, vf, S_.o2); else S_.o3 = MFMA16(pa, vf, S_.o3);
    }
  }
}
template <int CT>
__device__ __forceinline__ void asel_store16(const Params& p, Asel16& S_, float* xch, int q0, int qbase, int g, int lane) {
  const int j = lane & 15, q4 = lane >> 4;
  const float lt = quadsum_f(S_.l); const float inv = lt > 0.f ? 1.f / lt : 0.f; xch[16 * CT + j] = inv;
  const f32x4_t a = *(const f32x4_t*)&xch[16 * CT + 4 * q4];
  const int q = q0 + qbase + 4 * CT + q4;
#pragma unroll
  for (int r = 0; r < 4; ++r) { const int he = g * 4 + r;
    const float* gl = p.small + (long)q * NSMALL + he * 3; const float g0 = sigmoid_f(gl[0]), g1 = sigmoid_f(gl[1]), g2 = sigmoid_f(gl[2]);
#pragma unroll
    for (int dt = 0; dt < 4; ++dt) { const long c = (long)q * 512 + he * 64 + dt * 16 + j; const float os = (dt == 0 ? S_.o0[r] : dt == 1 ? S_.o1[r] : dt == 2 ? S_.o2[r] : S_.o3[r]) * a[r];
      const float av = g0 * bf2f(p.oc[c]) + g1 * os + g2 * bf2f(p.ow[c]); SB* mp = p.mix + (long)q * NMIX + MX_A + he * 64 + dt * 16 + j; *mp = f2bf(av * bf2f(*mp)); } }
}
template <bool STORE = true, bool NOSTEPS = false>
__device__ __forceinline__ void unit_asel_blk(const Params& p, int u, AselLds* A) {
  int tid = threadIdx.x; asm volatile("" : "+v"(tid));
  const int lane = tid & 63, w = __builtin_amdgcn_readfirstlane(tid >> 6), r32 = lane & 31, hi = lane >> 5;
  const int g = u & 1, qt = (p.S / 32 - 1) - (u >> 1), q0 = qt * 32, cur = q0 >> 6;
  const SB* kvb = p.proj + PA_KV + 2 * 128 + g * 64;
  __syncthreads();
  for (int i = tid; i < 64 * 8 + 8; i += 256) ((unsigned*)A->sel)[i] = 0u;
  for (int i = tid; i < 1664; i += 256) A->bkt[i] = (unsigned char)t5_bucket(i);
  if (tid < 128) A->relS[tid] = p.rel_bias[(tid >> 2) * 32 + g * 4 + (tid & 3)] * L2E;
#ifndef ASEL_NO_TOPK
  topk4_rows(p, [&](int r) { return (q0 + 8 * w + r) * 2 + g; }, lane); topk4_rows(p, [&](int r) { return (q0 + 8 * w + 4 + r) * 2 + g; }, lane);
  asm volatile("s_waitcnt vmcnt(0)" ::: "memory");
#endif
  __syncthreads();
#pragma unroll
  for (int i = 0; i < 2; ++i) { const int e = tid + 256 * i, ql = e >> 4, kk = e & 15; const int b = __hip_atomic_load(&p.idx[((long)(q0 + ql) * 2 + g) * 16 + kk], __ATOMIC_RELAXED, __HIP_MEMORY_SCOPE_AGENT);
    if (b >= 0) { atomicOr(&A->sel[ql][b >> 5], 1u << (b & 31)); atomicOr(&A->anyb[b >> 5], 1u << (b & 31)); } }
  __syncthreads();
  if (tid < 64) {
    const unsigned wbits = A->anyb[lane >> 3]; const unsigned nib = (wbits >> ((lane & 7) * 4)) & 15u; const int cnt = __popc(nib);
    int pre = cnt;
#pragma unroll
    for (int o = 1; o < 64; o <<= 1) { const int v = __shfl_up(pre, o); if (lane >= o) pre += v; }
    int pos = pre - cnt;
#pragma unroll
    for (int k = 0; k < 4; ++k) if ((nib >> k) & 1u) A->blist[pos++] = (unsigned char)(lane * 4 + k);
    if (lane == 63) A->nlist = pre;
  }
  __syncthreads();
  const int nlist = NOSTEPS ? 0 : A->nlist;
  const int hh = r32 & 3, h = g * 4 + hh; const float c31 = p.tabA[h * TABA_N + 2047] * L2E;
#if ASEL16
  Asel16 t0, t1;
#else
  FlashState st0;
#endif
  { bf16x8 qf0[4]; load_q(qf0, p.proj + (long)(q0 + 8 * w + (r32 >> 2)) * NPROJ + PA_Q + h * 64, hi);
#pragma unroll
    for (int d0 = 0; d0 < 4; ++d0) *(bf16x8*)&A->q[w][r32 * 64 + (((2 * d0 + hi) ^ ((r32 >> 1) & 7)) * 8)] = qf0[d0]; }
#if ASEL16
  { const f32x4_t z4 = {0.f, 0.f, 0.f, 0.f}; t0.o0 = z4; t0.o1 = z4; t0.o2 = z4; t0.o3 = z4; t0.m = -1e30f; t0.l = 0.f; t1 = t0; }
#else
  st0.o0 = zero16(); st0.o1 = zero16(); st0.m = -1e30f; st0.l = 0.f;
#endif
  float* xch = A->xch[w];
#define ASEL_DMA(bb, stg) { const int b_ = (bb); _Pragma("unroll") for (int i_ = 0; i_ < 2; ++i_) { const int pk_ = 2 * w + i_; \
      { const int row_ = pk_ * 8 + (lane >> 3), pc_ = lane & 7; glds16_asm(kvb + (long)(b_ * 64 + row_) * NPROJ + ((pc_ ^ ((row_ >> 1) & 7)) * 8), (unsigned)__builtin_amdgcn_readfirstlane((int)lds_addr(&A->k[stg][pk_ * 512]))); } \
      { const int db_ = pk_ >> 2, row_ = (pk_ & 3) * 16 + (lane >> 2), wi_ = lane & 3; glds16_asm(kvb + 128 + (long)(b_ * 64 + row_) * NPROJ + db_ * 32 + wi_ * 8, (unsigned)__builtin_amdgcn_readfirstlane((int)lds_addr(&A->v[stg][db_ * 2048 + (pk_ & 3) * 512]))); } } }
  asm volatile("s_waitcnt vmcnt(0)" ::: "memory");
  if (nlist > 0) ASEL_DMA(A->blist[0], 0);
  if (nlist > 1) ASEL_DMA(A->blist[1], 1);
  int stage = 0;
  for (int it = 0; it < nlist; ++it) {
    const int b = A->blist[it];
    if (it + 1 < nlist) asm volatile("s_waitcnt vmcnt(4) lgkmcnt(0)\n\ts_barrier" ::: "memory"); else asm volatile("s_waitcnt vmcnt(0) lgkmcnt(0)\n\ts_barrier" ::: "memory");
    if (it + 2 < nlist) { const int s2_ = (stage == 0) ? 2 : stage - 1; ASEL_DMA(A->blist[it + 2], s2_); }
#if ASEL16
    asel_coltile16<0>(p, t0, A->q[w], A, xch, stage, b, cur, q0, 8 * w, c31, lane); asel_coltile16<1>(p, t1, A->q[w], A, xch, stage, b, cur, q0, 8 * w, c31, lane);
#else
    asel_coltile(p, st0, A->q[w], A, xch, stage, b, cur, q0, 8 * w, h, c31, lane);
#endif
    stage = (stage == 2) ? 0 : stage + 1;
  }
  asm volatile("s_waitcnt vmcnt(0)" ::: "memory");
#if ASEL16
  if (STORE) { asel_store16<0>(p, t0, xch, q0, 8 * w, g, lane); asel_store16<1>(p, t1, xch, q0, 8 * w, g, lane); } else asm volatile("" :: "v"(t0.o0[0]), "v"(t1.o1[2]), "v"(t0.l), "v"(t1.l));
#else
  if (STORE) asel_store(p, st0, xch, q0, 8 * w, g, lane); else asm volatile("" :: "v"(st0.o0[0]), "v"(st0.o1[5]), "v"(st0.l));
#endif
#undef ASEL_DMA
}
struct AselW { unsigned short k[4][4096]; unsigned short v[4][4096]; unsigned sel[32][8]; unsigned anyw[4][8]; int nl[4]; int pad[4]; unsigned char wl[4][256]; float xch[4][32]; unsigned char bkt[1664]; float relS[128]; };
__device__ __forceinline__ void glds16_s(const void* sbase, unsigned voff, unsigned lds_dst) {
  unsigned keep; asm volatile("s_mov_b32 %0, m0\n\ts_mov_b32 m0, %3\n\ts_nop 0\n\tglobal_load_lds_dwordx4 %2, %1\n\ts_mov_b32 m0, %0" : "=&s"(keep) : "s"(sbase), "v"(voff), "s"(lds_dst) : "memory");
}
__device__ __forceinline__ void aw_dma_k(const SB* kvb, int b, unsigned ldsk, unsigned koffE, unsigned koffO) {
  const char* base = (const char*)(kvb + (long)b * 64 * NPROJ);
#pragma unroll
  for (int pk = 0; pk < 8; ++pk) glds16_s(base + (long)pk * 8 * NPROJ * 2, (pk & 1) ? koffO : koffE, ldsk + pk * 1024);
}
__device__ __forceinline__ void aw_dma_v(const SB* kvb, int b, unsigned ldsv, unsigned voff) {
  const char* base = (const char*)(kvb + 128 + (long)b * 64 * NPROJ);
#pragma unroll
  for (int pk = 0; pk < 8; ++pk) glds16_s(base + (long)(pk & 3) * 16 * NPROJ * 2 + (pk >> 2) * 64, voff, ldsv + pk * 1024);
}
template <int CT>
__device__ __forceinline__ void aw_softmax(Asel16& S_, f32x4_t (&sc)[4], const AselW* A, float* xch, bool selq, bool far, bool edge, int q, int b, float c31, int lane) {
  const int j = lane & 15, q4 = lane >> 4;
  float qs, bb;
  if (far) { qs = selq ? QSC : 0.f; bb = selq ? c31 : NINF; }
  else { qs = 1.f; bb = 0.f;
#pragma unroll
    for (int kt = 0; kt < 4; ++kt) {
#pragma unroll
      for (int r = 0; r < 4; ++r) { const int tk = b * 64 + 16 * kt + 4 * q4 + r; const int dist = q - tk; const int dc = dist < 0 ? 0 : (dist > 1663 ? 1663 : dist);
        float v = sc[kt][r] * QSC + A->relS[A->bkt[dc] * 4 + (j & 3)]; if (!selq || (edge && dist < 0)) v = NINF; sc[kt][r] = v; } }
  }
  float mr = fmaxf(fmaxf(sc[0][0], sc[0][1]), fmaxf(sc[0][2], sc[0][3]));
#pragma unroll
  for (int kt = 1; kt < 4; ++kt) mr = fmaxf(mr, fmaxf(fmaxf(sc[kt][0], sc[kt][1]), fmaxf(sc[kt][2], sc[kt][3])));
  float mx = far ? __builtin_fmaf(mr, qs, bb) : mr;
  mx = quadmax_f(mx);
  if (__any(mx > S_.m + FTHR)) {
    const float mn = fmaxf(S_.m, mx); const float al = __builtin_amdgcn_exp2f(S_.m - mn); S_.m = mn; S_.l *= al; xch[16 * CT + j] = al;
    const f32x4_t a = *(const f32x4_t*)&xch[16 * CT + 4 * q4];
    S_.o0 *= a; S_.o1 *= a; S_.o2 *= a; S_.o3 *= a;
  }
  const float bm = bb - S_.m; float ps = 0.f;
#pragma unroll
  for (int kt = 0; kt < 4; ++kt) {
#pragma unroll
    for (int r = 0; r < 4; ++r) { const float e_ = __builtin_amdgcn_exp2f(__builtin_fmaf(sc[kt][r], qs, bm)); sc[kt][r] = e_; ps += e_; } }
  S_.l += ps;
}
template <bool A0, bool A1>
__device__ __forceinline__ void aw_step(Asel16& t0, Asel16& t1, AselW* A, int w, const bf16x8& qa0, const bf16x8& qa1, const bf16x8& qb0, const bf16x8& qb1, bool selq0, bool selq1,
                                        int b, bool more, int nb, int q0, int cur, float c31, const SB* kvb, unsigned ldsk, unsigned ldsv, unsigned koffE, unsigned koffO, unsigned voff, int lane) {
  const int j = lane & 15, q4 = lane >> 4;
  const bool far = (q0 - (b * 64 + 63)) >= 1513; const bool edge = (b == cur);
  float* xch = A->xch[w];
  asm volatile("s_waitcnt vmcnt(8)" ::: "memory");
  f32x4_t sa[4], sb[4];
  { bf16x8 k0[4], k1[4];
#pragma unroll
    for (int kt = 0; kt < 4; ++kt) { const int row = 16 * kt + j;
      k0[kt] = *(const bf16x8*)&A->k[w][row * 64 + (((q4) ^ ((row >> 1) & 7)) * 8)]; k1[kt] = *(const bf16x8*)&A->k[w][row * 64 + (((4 + q4) ^ ((row >> 1) & 7)) * 8)]; }
    asm volatile("s_waitcnt lgkmcnt(0)" ::: "memory");
    if (more) aw_dma_k(kvb, nb, ldsk, koffE, koffO);
#pragma unroll
    for (int kt = 0; kt < 4; ++kt) { const f32x4_t z = {0.f, 0.f, 0.f, 0.f};
      if (A0) { sa[kt] = MFMA16(k0[kt], qa0, z); sa[kt] = MFMA16(k1[kt], qa1, sa[kt]); }
      if (A1) { sb[kt] = MFMA16(k0[kt], qb0, z); sb[kt] = MFMA16(k1[kt], qb1, sb[kt]); } } }
  if (A0) aw_softmax<0>(t0, sa, A, xch, selq0, far, edge, q0 + 8 * w + (j >> 2), b, c31, lane);
  if (A1) aw_softmax<1>(t1, sb, A, xch, selq1, far, edge, q0 + 8 * w + 4 + (j >> 2), b, c31, lane);
  bf16x8 pa0, pa1, pb0, pb1;
  if (A0) { pa0 = pack44(sa[0], sa[1]); pa1 = pack44(sa[2], sa[3]); }
  if (A1) { pb0 = pack44(sb[0], sb[1]); pb1 = pack44(sb[2], sb[3]); }
  if (more) asm volatile("s_waitcnt vmcnt(8)" ::: "memory"); else asm volatile("s_waitcnt vmcnt(0)" ::: "memory");
  const unsigned short* vb = A->v[w] + (4 * q4 + (j >> 2)) * 32 + (j & 3) * 4;
#pragma unroll
  for (int c = 0; c < 2; ++c) {
#pragma unroll
    for (int dt = 0; dt < 4; ++dt) {
      const v4i16_t lo = __builtin_amdgcn_ds_read_tr16_b64_v4i16((LDS3 v4i16_t*)(vb + (dt >> 1) * 2048 + (dt & 1) * 16 + c * 1024));
      const v4i16_t hh = __builtin_amdgcn_ds_read_tr16_b64_v4i16((LDS3 v4i16_t*)(vb + (dt >> 1) * 2048 + (dt & 1) * 16 + c * 1024 + 512));
      const bf16x8 vf = {lo[0], lo[1], lo[2], lo[3], hh[0], hh[1], hh[2], hh[3]};
      if (A0) { const bf16x8 pa = c ? pa1 : pa0; if (dt == 0) t0.o0 = MFMA16(pa, vf, t0.o0); else if (dt == 1) t0.o1 = MFMA16(pa, vf, t0.o1); else if (dt == 2) t0.o2 = MFMA16(pa, vf, t0.o2); else t0.o3 = MFMA16(pa, vf, t0.o3); }
      if (A1) { const bf16x8 pb = c ? pb1 : pb0; if (dt == 0) t1.o0 = MFMA16(pb, vf, t1.o0); else if (dt == 1) t1.o1 = MFMA16(pb, vf, t1.o1); else if (dt == 2) t1.o2 = MFMA16(pb, vf, t1.o2); else t1.o3 = MFMA16(pb, vf, t1.o3); }
    }
  }
  asm volatile("s_waitcnt lgkmcnt(0)" ::: "memory");
  if (more) aw_dma_v(kvb, nb, ldsv, voff);
}
template <bool STORE = true>
__device__ __forceinline__ void unit_asel_w(const Params& p, int u, AselW* A) {
  int tid = threadIdx.x; asm volatile("" : "+v"(tid));
  const int lane = tid & 63, w = __builtin_amdgcn_readfirstlane(tid >> 6), j = lane & 15, q4 = lane >> 4;
  const int g = u & 1, qt = (p.S / 32 - 1) - (u >> 1), q0 = qt * 32, cur = q0 >> 6;
  const SB* kvb = p.proj + PA_KV + 2 * 128 + g * 64;
  __syncthreads();
  for (int i = tid; i < 1664; i += 256) A->bkt[i] = (unsigned char)t5_bucket(i);
  if (tid < 128) A->relS[tid] = p.rel_bias[(tid >> 2) * 32 + g * 4 + (tid & 3)] * L2E;
  A->sel[8 * w + (lane >> 3)][lane & 7] = 0u;
  asm volatile("s_waitcnt lgkmcnt(0)" ::: "memory");
  topk4_rows_o(p, [&](int r) { return (q0 + 8 * w + r) * 2 + g; }, [&](int r, int b) { if (b >= 0) atomicOr(&A->sel[8 * w + r][b >> 5], 1u << (b & 31)); }, lane);
  topk4_rows_o(p, [&](int r) { return (q0 + 8 * w + 4 + r) * 2 + g; }, [&](int r, int b) { if (b >= 0) atomicOr(&A->sel[8 * w + 4 + r][b >> 5], 1u << (b & 31)); }, lane);
  asm volatile("s_waitcnt lgkmcnt(0)" ::: "memory");
  if (lane < 8) { unsigned o = 0u;
#pragma unroll
    for (int r = 0; r < 8; ++r) o |= A->sel[8 * w + r][lane];
    A->anyw[w][lane] = o; }
  asm volatile("s_waitcnt lgkmcnt(0)" ::: "memory");
  { const unsigned wbits = A->anyw[w][lane >> 3]; const unsigned nib = (wbits >> ((lane & 7) * 4)) & 15u; const int cnt = __popc(nib);
    int pre = cnt;
#pragma unroll
    for (int o = 1; o < 64; o <<= 1) { const int v = __shfl_up(pre, o); if (lane >= o) pre += v; }
    int pos = pre - cnt;
#pragma unroll
    for (int k = 0; k < 4; ++k) if ((nib >> k) & 1u) A->wl[w][pos++] = (unsigned char)(lane * 4 + k);
    if (lane == 63) A->nl[w] = pre; }
  const int hq = g * 4 + (lane & 3); const float c31 = p.tabA[hq * TABA_N + 2047] * L2E;
  const SB* qpa = p.proj + (long)(q0 + 8 * w + (j >> 2)) * NPROJ + PA_Q + hq * 64 + 8 * q4; const SB* qpb = qpa + 4L * NPROJ;
  const bf16x8 qa0 = *(const bf16x8*)qpa, qa1 = *(const bf16x8*)(qpa + 32), qb0 = *(const bf16x8*)qpb, qb1 = *(const bf16x8*)(qpb + 32);
  Asel16 t0, t1;
  { const f32x4_t z4 = {0.f, 0.f, 0.f, 0.f}; t0.o0 = z4; t0.o1 = z4; t0.o2 = z4; t0.o3 = z4; t0.m = -1e30f; t0.l = 0.f; t1 = t0; }
  const unsigned koffE = (unsigned)((lane >> 3) * NPROJ * 2 + (((lane & 7) ^ (lane >> 4)) * 16)), koffO = (unsigned)((lane >> 3) * NPROJ * 2 + (((lane & 7) ^ (lane >> 4) ^ 4) * 16));
  const unsigned voff = (unsigned)((lane >> 2) * NPROJ * 2 + (lane & 3) * 16);
  const unsigned ldsk = (unsigned)__builtin_amdgcn_readfirstlane((int)lds_addr(&A->k[w][0])), ldsv = (unsigned)__builtin_amdgcn_readfirstlane((int)lds_addr(&A->v[w][0]));
  __syncthreads();
  const int nl = __builtin_amdgcn_readfirstlane(A->nl[w]);
  asm volatile("s_waitcnt vmcnt(0) lgkmcnt(0)" ::: "memory");
  if (nl > 0) { const int b0 = __builtin_amdgcn_readfirstlane((int)A->wl[w][0]); aw_dma_k(kvb, b0, ldsk, koffE, koffO); aw_dma_v(kvb, b0, ldsv, voff); }
  for (int i = 0; i < nl; ++i) {
    const int b = __builtin_amdgcn_readfirstlane((int)A->wl[w][i]); const bool more = i + 1 < nl; const int nb = more ? __builtin_amdgcn_readfirstlane((int)A->wl[w][i + 1]) : 0;
    const bool selq0 = (A->sel[8 * w + (j >> 2)][b >> 5] >> (b & 31)) & 1u, selq1 = (A->sel[8 * w + 4 + (j >> 2)][b >> 5] >> (b & 31)) & 1u;
    const bool a0 = __any(selq0), a1 = __any(selq1);
    if (a0 && a1) aw_step<true, true>(t0, t1, A, w, qa0, qa1, qb0, qb1, selq0, selq1, b, more, nb, q0, cur, c31, kvb, ldsk, ldsv, koffE, koffO, voff, lane);
    else if (a0) aw_step<true, false>(t0, t1, A, w, qa0, qa1, qb0, qb1, selq0, selq1, b, more, nb, q0, cur, c31, kvb, ldsk, ldsv, koffE, koffO, voff, lane);
    else aw_step<false, true>(t0, t1, A, w, qa0, qa1, qb0, qb1, selq0, selq1, b, more, nb, q0, cur, c31, kvb, ldsk, ldsv, koffE, koffO, voff, lane);
  }
  asm volatile("s_waitcnt vmcnt(0)" ::: "memory");
  float* xch = A->xch[w];
  if (STORE) { asel_store16<0>(p, t0, xch, q0, 8 * w, g, lane); asel_store16<1>(p, t1, xch, q0, 8 * w, g, lane); } else asm volatile("" :: "v"(t0.o0[0]), "v"(t1.o1[2]), "v"(t0.l), "v"(t1.l));
}
template <bool STORE = true>
__device__ __forceinline__ void unit_bout_blk(const Params& p, int layer, int ub, char* smem) {
  int tid = threadIdx.x; asm volatile("" : "+v"(tid));
  const int lane = tid & 63, w = __builtin_amdgcn_readfirstlane(tid >> 6), r32 = lane & 31, hi = lane >> 5;
  const int lt = ub & 3, g = (ub >> 2) & 1, c = ub >> 3, hd = g * 4 + w;
  WaveLds2* L = ((WaveLds2*)smem) + w;
  __syncthreads();
  for (int x = lane; x < 128; x += 64) { L->acs[x] = p.acs[((long)c * 128 + x) * 8 + hd]; L->dtv[x] = p.dt[((long)c * 128 + x) * 8 + hd]; }
  f32x16 acc[2] = {zero16(), zero16()}, acc2[2] = {zero16(), zero16()};
  const SB* xb = p.xconv + (long)c * 128 * 1024; const int l = 32 * lt + r32; const float al = p.acs[((long)c * 128 + l) * 8 + hd];
  const float* cbr = p.cb + ((long)c * 2 + g) * 16384 + (long)l * 128;
  for (int sc = 0; sc <= lt; ++sc) {
    stage_slab<false>(L->x, xb + (long)(32 * sc) * 1024 + hd * 64, 1024, [&](int) { return 1.f; }, lane);
#pragma unroll
    for (int s2 = 0; s2 < 2; ++s2) { float mv[8];
#pragma unroll
      for (int jj = 0; jj < 2; ++jj) { const int s0 = 32 * sc + 16 * s2 + 8 * jj + 4 * hi; const float4 cv = *(const float4*)(cbr + s0); const float4 av = *(const float4*)(&L->acs[s0]); const float4 dv = *(const float4*)(&L->dtv[s0]);
        mv[4 * jj + 0] = (s0 + 0 <= l) ? cv.x * __expf(al - av.x) * dv.x : 0.f; mv[4 * jj + 1] = (s0 + 1 <= l) ? cv.y * __expf(al - av.y) * dv.y : 0.f;
        mv[4 * jj + 2] = (s0 + 2 <= l) ? cv.z * __expf(al - av.z) * dv.z : 0.f; mv[4 * jj + 3] = (s0 + 3 <= l) ? cv.w * __expf(al - av.w) * dv.w : 0.f; }
      u32x4 aw; aw[0] = pk2(mv[0], mv[1]); aw[1] = pk2(mv[2], mv[3]); aw[2] = pk2(mv[4], mv[5]); aw[3] = pk2(mv[6], mv[7]); const bf16x8 af = __builtin_bit_cast(bf16x8, aw);
#pragma unroll
      for (int pt = 0; pt < 2; ++pt) acc[pt] = MFMA32(af, slab_frag(L->x, pt, s2, lane), acc[pt]); } }
  const SB* cmr = xb + (long)l * 1024 + 768 + g * 128; const float* prv = p.states + ((long)c * 8 + hd) * 8192;
#pragma unroll 2
  for (int ks = 0; ks < 8; ++ks) { const bf16x8 af = *(const bf16x8*)(cmr + 16 * ks + 8 * hi);
#pragma unroll
    for (int pt = 0; pt < 2; ++pt) { const float* pr = prv + (long)(32 * pt + r32) * 128 + 16 * ks + 8 * hi; const float4 a0 = *(const float4*)pr, a1 = *(const float4*)(pr + 4);
      u32x4 bw; bw[0] = pk2(a0.x, a0.y); bw[1] = pk2(a0.z, a0.w); bw[2] = pk2(a1.x, a1.y); bw[3] = pk2(a1.z, a1.w);
      acc2[pt] = MFMA32(af, __builtin_bit_cast(bf16x8, bw), acc2[pt]); } }
  const float dsk = p.b_d[layer * 8 + hd];
  float* yl = (float*)L;
#pragma unroll
  for (int e = 0; e < 16; ++e) { const int lr = crow(e, hi); const float ea = __expf(L->acs[32 * lt + lr]);
#pragma unroll
    for (int pt = 0; pt < 2; ++pt) { const int pp = 32 * pt + r32; yl[lr * 64 + pp] = acc[pt][e] + ea * acc2[pt][e] + dsk * bf2f(xb[(long)(32 * lt + lr) * 1024 + hd * 64 + pp]); } }
  __syncthreads();
  { const int row = tid >> 3, sub = tid & 7; const long t = (long)c * 128 + 32 * lt + row; SB* mp = p.mix + t * NMIX + MX_B + g * 256 + sub * 32;
    const float* ysrc = (const float*)(((WaveLds2*)smem) + (sub >> 1)) + row * 64 + (sub & 1) * 32;
    float vv[32]; float ss = 0.f;
#pragma unroll
    for (int i = 0; i < 4; ++i) { const uint4 zz = *(const uint4*)(mp + 8 * i); const unsigned zw[4] = {zz.x, zz.y, zz.z, zz.w};
#pragma unroll
      for (int k = 0; k < 4; ++k) { const float y0 = ysrc[8 * i + 2 * k] * __uint_as_float(zw[k] << 16), y1 = ysrc[8 * i + 2 * k + 1] * __uint_as_float(zw[k] & 0xffff0000u); vv[8 * i + 2 * k] = y0; vv[8 * i + 2 * k + 1] = y1; ss += y0 * y0 + y1 * y1; } }
    ss += __shfl_xor(ss, 1); ss += __shfl_xor(ss, 2); ss += __shfl_xor(ss, 4);
    const float r = 1.f / sqrtf(ss * (1.f / 256.f) + 1e-6f); const float* wn = p.b_norm + layer * 512 + g * 256 + sub * 32;
#pragma unroll
    for (int i = 0; i < 4; ++i) { uint4 o; o.x = pk2(vv[8 * i] * r * wn[8 * i], vv[8 * i + 1] * r * wn[8 * i + 1]); o.y = pk2(vv[8 * i + 2] * r * wn[8 * i + 2], vv[8 * i + 3] * r * wn[8 * i + 3]);
      o.z = pk2(vv[8 * i + 4] * r * wn[8 * i + 4], vv[8 * i + 5] * r * wn[8 * i + 5]); o.w = pk2(vv[8 * i + 6] * r * wn[8 * i + 6], vv[8 * i + 7] * r * wn[8 * i + 7]); if (STORE) *(uint4*)(mp + 8 * i) = o; else asm volatile("" :: "v"(o.x), "v"(o.w)); } }
}

__device__ __forceinline__ void unit_memkv(const Params& p, int u, int lane) {
  const int l = u >> 8, m = u & 255; const float* row = p.mem + (long)m * DM; const float* nw = p.m_norm + l * DM; const float* w = p.m_wkv + (long)l * DM * 512 + lane * 8;
  float ss = 0.f;
#pragma unroll
  for (int i = 0; i < 4; ++i) { const float4 v = *(const float4*)(row + i * 256 + lane * 4); ss += v.x * v.x + v.y * v.y + v.z * v.z + v.w * v.w; }
  ss = wave_sum_f(ss); const float r = 1.f / sqrtf(ss * (1.f / DM) + 1e-6f);
  float acc[8] = {0.f, 0.f, 0.f, 0.f, 0.f, 0.f, 0.f, 0.f};
#pragma unroll 8
  for (int d = 0; d < DM; ++d) { const float a = row[d] * r * nw[d]; const float4 w0 = *(const float4*)(w + (long)d * 512), w1 = *(const float4*)(w + (long)d * 512 + 4);
    acc[0] += a * w0.x; acc[1] += a * w0.y; acc[2] += a * w0.z; acc[3] += a * w0.w; acc[4] += a * w1.x; acc[5] += a * w1.y; acc[6] += a * w1.z; acc[7] += a * w1.w; }
  uint4 o; o.x = pk2(acc[0], acc[1]); o.y = pk2(acc[2], acc[3]); o.z = pk2(acc[4], acc[5]); o.w = pk2(acc[6], acc[7]);
  *(uint4*)(p.memkv + (long)u * 512 + lane * 8) = o;
}

__device__ __forceinline__ void item_dmerge(const Params& p, long gid) {
  const int c8 = (int)(gid & 63), h = c8 >> 3; const long q = gid >> 6; const long S = p.S;
  const float l0 = p.dlse[(0 * S + q) * 8 + h], l1 = p.dlse[(1 * S + q) * 8 + h], l2 = p.dlse[(2 * S + q) * 8 + h];
  const float mm = fmaxf(l0, fmaxf(l1, l2)); float e0 = __expf(l0 - mm), e1 = __expf(l1 - mm), e2 = __expf(l2 - mm); const float is = 1.f / (e0 + e1 + e2); e0 *= is; e1 *= is; e2 *= is;
  const long c = q * 512 + c8 * 8; const uint4 a = *(const uint4*)(p.dop + c), b = *(const uint4*)(p.dop + S * 512 + c), d = *(const uint4*)(p.dop + 2 * S * 512 + c);
  SB* mp = p.mix + q * NMIX + MX_D + c8 * 8; const uint4 z = *(const uint4*)mp;
  const unsigned aw[4] = {a.x, a.y, a.z, a.w}, bw[4] = {b.x, b.y, b.z, b.w}, dw[4] = {d.x, d.y, d.z, d.w}, zw[4] = {z.x, z.y, z.z, z.w}; unsigned ow[4];
#pragma unroll
  for (int k = 0; k < 4; ++k) {
    const float lo = (e0 * __uint_as_float(aw[k] << 16) + e1 * __uint_as_float(bw[k] << 16) + e2 * __uint_as_float(dw[k] << 16)) * __uint_as_float(zw[k] << 16);
    const float hi = (e0 * __uint_as_float(aw[k] & 0xffff0000u) + e1 * __uint_as_float(bw[k] & 0xffff0000u) + e2 * __uint_as_float(dw[k] & 0xffff0000u)) * __uint_as_float(zw[k] & 0xffff0000u);
    ow[k] = pk2(lo, hi); }
  uint4 o; o.x = ow[0]; o.y = ow[1]; o.z = ow[2]; o.w = ow[3]; *(uint4*)mp = o;
}

__device__ __forceinline__ void unit_cmp_blk(const Params& p, int layer, int u, float* red  ) {
  int tid = threadIdx.x; asm volatile("" : "+v"(tid));
  const int lane = tid & 63, w = __builtin_amdgcn_readfirstlane(tid >> 6), r32 = lane & 31, hi = lane >> 5;
  const int ncmp = p.S / 16, ntile = ncmp * 2 / 32; const int kv = u / ntile, rt = u % ntile;
  const int r = 32 * rt + r32, j = r >> 1, hk = r & 1;
  const unsigned short* w1t = p.w1t + (long)kv * 128 * 2048; const unsigned short* w2t = p.w2t + kv * 64 * 128; const float* pe = p.cmp_pos + (long)(layer * 2 + kv) * 32 * 64;
  const SB* src = p.proj + PA_KV + kv * 128 + hk * 64;
  f32x16 acc[4] = {zero16(), zero16(), zero16(), zero16()};
#pragma unroll 4
  for (int ks = 32 * w; ks < 32 * w + 32; ++ks) { const int t = ks >> 2, d = (ks & 3) * 16 + 8 * hi; const long tok = 16 * j + t;
    const float4 p0 = *(const float4*)(pe + t * 64 + d), p1 = *(const float4*)(pe + t * 64 + d + 4); float v[8] = {p0.x, p0.y, p0.z, p0.w, p1.x, p1.y, p1.z, p1.w};
    { const long tokc = tok < p.S ? tok : (long)p.S - 1; const float vm = tok < p.S ? 1.f : 0.f;
      const uint4 vv = *(const uint4*)(src + tokc * NPROJ + d); const unsigned wd[4] = {vv.x, vv.y, vv.z, vv.w};
#pragma unroll
      for (int k = 0; k < 4; ++k) { v[2 * k] += vm * __uint_as_float(wd[k] << 16); v[2 * k + 1] += vm * __uint_as_float(wd[k] & 0xffff0000u); } }
    u32x4 bw; bw[0] = pk2(v[0], v[1]); bw[1] = pk2(v[2], v[3]); bw[2] = pk2(v[4], v[5]); bw[3] = pk2(v[6], v[7]); const bf16x8 bfr = __builtin_bit_cast(bf16x8, bw);
#pragma unroll
    for (int ut = 0; ut < 4; ++ut) { const bf16x8 af = *(const bf16x8*)(w1t + (long)(32 * ut + r32) * 2048 + 16 * ks + 8 * hi); acc[ut] = MFMA32(af, bfr, acc[ut]); } }
  __syncthreads();
#pragma unroll
  for (int ut = 0; ut < 4; ++ut)
#pragma unroll
    for (int q4 = 0; q4 < 4; ++q4) *(float4*)&red[(((w * 4 + ut) * 4 + q4) * 64 + lane) * 4] = make_float4(acc[ut][4 * q4], acc[ut][4 * q4 + 1], acc[ut][4 * q4 + 2], acc[ut][4 * q4 + 3]);
  __syncthreads();
  f32x16 hsum = zero16();
#pragma unroll
  for (int w2 = 0; w2 < 4; ++w2)
#pragma unroll
    for (int q4 = 0; q4 < 4; ++q4) { const float4 t4 = *(const float4*)&red[(((w2 * 4 + w) * 4 + q4) * 64 + lane) * 4]; hsum[4 * q4] += t4.x; hsum[4 * q4 + 1] += t4.y; hsum[4 * q4 + 2] += t4.z; hsum[4 * q4 + 3] += t4.w; }
#pragma unroll
  for (int e = 0; e < 16; ++e) hsum[e] = gelu_f(hsum[e]);
  f32x16 o2[2] = {zero16(), zero16()};
#pragma unroll
  for (int s2 = 0; s2 < 2; ++s2) { const bf16x8 hb = pack8(hsum, 8 * s2);
#pragma unroll
    for (int dt = 0; dt < 2; ++dt) { const unsigned short* wr = w2t + (32 * dt + r32) * 128 + 32 * w + 16 * s2 + 4 * hi; const uint2 x0 = *(const uint2*)wr, x1 = *(const uint2*)(wr + 8);
      u32x4 aw; aw[0] = x0.x; aw[1] = x0.y; aw[2] = x1.x; aw[3] = x1.y; o2[dt] = MFMA32(__builtin_bit_cast(bf16x8, aw), hb, o2[dt]); } }
  __syncthreads();
#pragma unroll
  for (int dt = 0; dt < 2; ++dt)
#pragma unroll
    for (int q4 = 0; q4 < 4; ++q4) *(float4*)&red[(((w * 2 + dt) * 4 + q4) * 64 + lane) * 4] = make_float4(o2[dt][4 * q4], o2[dt][4 * q4 + 1], o2[dt][4 * q4 + 2], o2[dt][4 * q4 + 3]);
  __syncthreads();
  if (w < 2) {
    const int dt = w; SB* dst = p.kvc + ((long)kv * ncmp * 2 + r) * 64;
#pragma unroll
    for (int q4 = 0; q4 < 4; ++q4) { float4 s4 = make_float4(0.f, 0.f, 0.f, 0.f);
#pragma unroll
      for (int w2 = 0; w2 < 4; ++w2) { const float4 t4 = *(const float4*)&red[(((w2 * 2 + dt) * 4 + q4) * 64 + lane) * 4]; s4.x += t4.x; s4.y += t4.y; s4.z += t4.z; s4.w += t4.w; }
      dst[32 * dt + crow(4 * q4 + 0, hi)] = f2bf(s4.x); dst[32 * dt + crow(4 * q4 + 1, hi)] = f2bf(s4.y); dst[32 * dt + crow(4 * q4 + 2, hi)] = f2bf(s4.z); dst[32 * dt + crow(4 * q4 + 3, hi)] = f2bf(s4.w); } }
}

#define SEQ 16384
#define DEPTH 4

__device__ __forceinline__ int n2o(int n) {
  if (n < 1280) return n;
  if (n < 2304) return n - 1280 + 1816;
  if (n < 2816) return n - 2304 + 3360;
  if (n < 3072) return n - 2816 + 3872;
  if (n < 4608) return n - 3072 + 4640;
  if (n < 5632) return n - 4608 + 6176;
  if (n < 5888) return n - 5632 + 7712;
  n -= 5888;
  if (n < 512) return 1304 + n;
  if (n < 1024) return 2848 + n - 512;
  if (n < 1536) return 4128 + n - 1024;
  if (n < 2048) return 7200 + n - 1536;
  if (n < 2304) return 7968 + n - 2048;
  n -= 2304;
  if (n < 24) return 1280 + n;
  if (n < 32) return 2840 + n - 24;
  return -1;
}

template <bool MAP>
__device__ __forceinline__ void cvt_tile(const float* __restrict__ src, int lds_, unsigned short* __restrict__ dst, int ldd, int k0, int n0, float* tile  ) {
  int tid = threadIdx.x; asm volatile("" : "+v"(tid));
  __syncthreads();
#pragma unroll
  for (int e = 0; e < 16; ++e) { int idx = tid + 256 * e, kk = idx >> 6, nn = idx & 63; int oc = MAP ? n2o(n0 + nn) : (n0 + nn);
    tile[kk * 65 + nn] = (oc >= 0) ? src[(long)(k0 + kk) * lds_ + oc] : 0.f; }
  __syncthreads();
#pragma unroll
  for (int e = 0; e < 16; ++e) { int idx = tid + 256 * e, nn = idx >> 6, kk = idx & 63; dst[(long)(n0 + nn) * ldd + k0 + kk] = f2bf(tile[kk * 65 + nn]); }
}

__device__ __forceinline__ float wave_sum(float v) {
#pragma unroll
  for (int o = 32; o > 0; o >>= 1) v += __shfl_xor(v, o);
  return v;
}

__device__ __forceinline__ void norm_row_wave(const Params& p, int layer, int t, bool do_h, int lane) {
  const float* xin = (layer == 0) ? p.x + (long)t * DM : p.out + (long)t * DM;
  float4 xv[4], yv[4];
#pragma unroll
  for (int i = 0; i < 4; ++i) xv[i] = *(const float4*)(xin + i * 256 + lane * 4);
  if (layer > 0) {
    float ss = 0.f;
#pragma unroll
    for (int i = 0; i < 4; ++i) { yv[i] = *(const float4*)(p.y + (long)t * DM + i * 256 + lane * 4); ss += yv[i].x * yv[i].x + yv[i].y * yv[i].y + yv[i].z * yv[i].z + yv[i].w * yv[i].w; }
    ss = wave_sum(ss); float r1 = 1.f / sqrtf(ss / DM + 1e-6f);
#pragma unroll
    for (int i = 0; i < 4; ++i) { float4 w = *(const float4*)(p.post_norm + (layer - 1) * DM + i * 256 + lane * 4);
      xv[i].x += yv[i].x * r1 * w.x; xv[i].y += yv[i].y * r1 * w.y; xv[i].z += yv[i].z * r1 * w.z; xv[i].w += yv[i].w * r1 * w.w; }
  }
  float ss2 = 0.f;
#pragma unroll
  for (int i = 0; i < 4; ++i) { *(float4*)(p.out + (long)t * DM + i * 256 + lane * 4) = xv[i]; ss2 += xv[i].x * xv[i].x + xv[i].y * xv[i].y + xv[i].z * xv[i].z + xv[i].w * xv[i].w; }
  if (!do_h) return;
  ss2 = wave_sum(ss2); float r2 = 1.f / sqrtf(ss2 / DM + 1e-6f);
#pragma unroll
  for (int i = 0; i < 4; ++i) { float4 w = *(const float4*)(p.pre_norm + layer * DM + i * 256 + lane * 4);
    ushort4 o; o.x = f2bf(xv[i].x * r2 * w.x); o.y = f2bf(xv[i].y * r2 * w.y); o.z = f2bf(xv[i].z * r2 * w.z); o.w = f2bf(xv[i].w * r2 * w.w);
    *(ushort4*)(p.h + (long)t * DM + i * 256 + lane * 4) = o; }
}

#ifndef GMI
#define GMI 4
#endif
struct GemmSmem { unsigned short a[3][64 * GMI * 32]; unsigned short b[3][128 * 32]; };
__device__ __forceinline__ void glds16(const void* g, void* lds_wave_base) { __builtin_amdgcn_global_load_lds((gptr_t)g, (lptr_t)lds_wave_base, 16, 0, 0); }
template <int EPI, int MI, bool DRY = false>
__device__ __forceinline__ void gemm_tile(const Params& p, const unsigned short* __restrict__ A, int lda, const unsigned short* __restrict__ Bt, int ldb, int K, int m0, int n0, GemmSmem& sm, float* outp = nullptr) {
  int tid = threadIdx.x; asm volatile("" : "+v"(tid));
  const int lane = tid & 63, wid = __builtin_amdgcn_readfirstlane(tid >> 6), wr = wid >> 1, wc = wid & 1, r = lane & 31, h = lane >> 5;
  f32x16 acc[MI][2];
#pragma unroll
  for (int i = 0; i < MI; ++i)
#pragma unroll
    for (int j = 0; j < 2; ++j) acc[i][j] = zero16();
  const int prow = lane >> 2, pc = lane & 3;
  const unsigned short* ga[MI]; const unsigned short* gb[2];
#pragma unroll
  for (int i = 0; i < MI; ++i) { const int row = (wid * MI + i) * 16 + prow; ga[i] = A + (long)(m0 + row) * lda + ((pc ^ ((row >> 2) & 3)) * 8); }
#pragma unroll
  for (int i = 0; i < 2; ++i) { const int row = (wid * 2 + i) * 16 + prow; gb[i] = Bt + (long)(n0 + row) * ldb + ((pc ^ ((row >> 2) & 3)) * 8); }
#define GEMM_DMA(stg, ko) { _Pragma("unroll") for (int i_ = 0; i_ < MI; ++i_) glds16(ga[i_] + (ko), &sm.a[stg][(wid * MI + i_) * 512]); _Pragma("unroll") for (int i_ = 0; i_ < 2; ++i_) glds16(gb[i_] + (ko), &sm.b[stg][(wid * 2 + i_) * 512]); }
  __syncthreads();
  const int nk = K / 32;
  GEMM_DMA(0, 0)
  if (nk > 1) GEMM_DMA(1, 32)
  int cur = 0;
  for (int kt = 0; kt < nk; ++kt) {
    if (kt + 1 < nk) { if (MI == 4) asm volatile("s_waitcnt vmcnt(6) lgkmcnt(0)\n\ts_barrier" ::: "memory"); else asm volatile("s_waitcnt vmcnt(4) lgkmcnt(0)\n\ts_barrier" ::: "memory"); }
    else asm volatile("s_waitcnt vmcnt(0) lgkmcnt(0)\n\ts_barrier" ::: "memory");
    if (kt + 2 < nk) { const int s2_ = (cur == 0) ? 2 : cur - 1; GEMM_DMA(s2_, (kt + 2) * 32) }
#pragma unroll
    for (int ks = 0; ks < 2; ++ks) {
      bf16x8 af[MI], bfr[2];
#pragma unroll
      for (int i = 0; i < MI; ++i) { const int row = wr * (32 * MI) + i * 32 + r; af[i] = *(const bf16x8*)&sm.a[cur][row * 32 + (((2 * ks + h) ^ ((row >> 2) & 3)) * 8)]; }
#pragma unroll
      for (int j = 0; j < 2; ++j) { const int row = wc * 64 + j * 32 + r; bfr[j] = *(const bf16x8*)&sm.b[cur][row * 32 + (((2 * ks + h) ^ ((row >> 2) & 3)) * 8)]; }
#pragma unroll
      for (int i = 0; i < MI; ++i)
#pragma unroll
        for (int j = 0; j < 2; ++j) acc[i][j] = __builtin_amdgcn_mfma_f32_32x32x16_bf16(af[i], bfr[j], acc[i][j], 0, 0, 0);
    }
    cur = (cur == 2) ? 0 : cur + 1;
  }
#undef GEMM_DMA
  __syncthreads();
  if (DRY) {
#pragma unroll
    for (int i = 0; i < MI; ++i) asm volatile("" :: "v"(acc[i][0]), "v"(acc[i][1]));
    return; }
  const int ncol0 = n0 + wc * 64;
  const int mrow0 = m0 + wr * (32 * MI);
  if (EPI == 2) {
#pragma unroll
    for (int i = 0; i < MI; ++i)
#pragma unroll
      for (int j = 0; j < 2; ++j)
#pragma unroll
        for (int e = 0; e < 16; ++e) { int row = mrow0 + i * 32 + (e & 3) + 8 * (e >> 2) + 4 * h; outp[row * 128 + ncol0 + j * 32 + r] = acc[i][j][e]; }
  } else if (EPI == 1) {
#pragma unroll
    for (int i = 0; i < MI; ++i)
#pragma unroll
      for (int j = 0; j < 2; ++j)
#pragma unroll
        for (int e = 0; e < 16; ++e) { int row = mrow0 + i * 32 + (e & 3) + 8 * (e >> 2) + 4 * h; p.y[(long)row * DM + ncol0 + j * 32 + r] = acc[i][j][e]; }
  } else {
    if (ncol0 < 8192) {
      const bool toproj = ncol0 < NPROJ; const bool rope = toproj && (ncol0 >= PC_Q && ncol0 < PC_KV + 128);
      unsigned short* stg = ((unsigned short*)&sm) + wid * (64 * 72);
      SB* gdst = toproj ? (p.proj + ncol0) : (p.mix + (ncol0 - NPROJ)); const long gld = toproj ? NPROJ : NMIX;
#pragma unroll
      for (int hf = 0; hf < MI / 2; ++hf) {
#pragma unroll
        for (int i2 = 0; i2 < 2; ++i2) { const int i = hf * 2 + i2;
#pragma unroll
          for (int e = 0; e < 16; ++e) { const int rl = i2 * 32 + (e & 3) + 8 * (e >> 2) + 4 * h; float v0 = acc[i][0][e], v1 = acc[i][1][e];
            if (rope) { const int row = mrow0 + hf * 64 + rl; const float c = p.rope_cs[row * 32 + r], s = p.rope_sn[row * 32 + r]; const float t1 = v0, t2 = v1; v0 = t1 * c - t2 * s; v1 = t2 * c + t1 * s; }
            if (!toproj) { v0 = silu_f(v0); v1 = silu_f(v1); }
            stg[rl * 72 + r] = f2bf(v0); stg[rl * 72 + 32 + r] = f2bf(v1); } }
#pragma unroll
        for (int c8 = 0; c8 < 8; ++c8) { const int idx = lane + 64 * c8, rl = idx >> 3, ch = idx & 7; const uint4 vv = *(const uint4*)&stg[rl * 72 + ch * 8];
          *(uint4*)(gdst + (long)(mrow0 + hf * 64 + rl) * gld + ch * 8) = vv; }
      }
    } else if (ncol0 == 8192) {
#pragma unroll
      for (int i = 0; i < MI; ++i)
#pragma unroll
        for (int e = 0; e < 16; ++e) { int row = mrow0 + i * 32 + (e & 3) + 8 * (e >> 2) + 4 * h; p.small[(long)row * NSMALL + r] = acc[i][0][e]; }
    }
  }
}

__device__ __forceinline__ unsigned tx_() { unsigned t = threadIdx.x; asm volatile("" : "+v"(t)); return t; }
__device__ __forceinline__ int gw0(int) { return (int)((blockIdx.x * 256u + tx_()) >> 6); }
__device__ __forceinline__ int bid0() { int b = blockIdx.x; asm volatile("" : "+s"(b)); return b; }

#define XB_TMO      128
#define XB_XCNT(j)  (256  + 64 * (j))
#define XB_XSUB(j)  (1280 + 64 * (j))
#define XB_XGEN(j)  (2304 + 64 * (j))
#define XB_TOP      3328
#define XB_TOPGEN   3392
#define XCD_BAR_WORDS 3456
#define XB_SPIN_CAP (1u << 28)
__device__ __forceinline__ unsigned xb_ld(unsigned* p) { return __hip_atomic_load(p, __ATOMIC_RELAXED, __HIP_MEMORY_SCOPE_AGENT); }
__device__ __forceinline__ unsigned xb_add(unsigned* p, unsigned v) { return __hip_atomic_fetch_add(p, v, __ATOMIC_RELAXED, __HIP_MEMORY_SCOPE_AGENT); }
__device__ __forceinline__ unsigned xb_xcc_id() { return (unsigned)__builtin_amdgcn_s_getreg((3 << 11) | 20) & 0xFu; }
#define XB_SPIN(cond, bar) do { unsigned _sp = 0; while (cond) { __builtin_amdgcn_s_sleep(1); \
    if ((++_sp & 255u) == 0u) { if (xb_ld(&(bar)[XB_TMO])) break; if (_sp > XB_SPIN_CAP) { atomicAdd(&(bar)[XB_TMO], 1u); break; } } } } while (0)
struct XcdBarrier { unsigned* bar; unsigned x; volatile LDS3 unsigned* st; };
__device__ __forceinline__ XcdBarrier xcd_barrier_post(unsigned* bar, volatile LDS3 unsigned* st) {
  XcdBarrier b; b.bar = bar; b.x = xb_xcc_id(); b.st = st;
  if (threadIdx.x == 0) (void)xb_add(&bar[XB_XCNT(b.x)], 1u);
  return b;
}
__device__ __forceinline__ void xcd_barrier_complete(unsigned* bar, unsigned x, unsigned& nloc, unsigned& nx) {
  const unsigned G = gridDim.x; unsigned sum, cnt, mine, sp = 0u;
  for (;;) { sum = 0u; cnt = 0u; mine = 0u;
#pragma unroll
    for (unsigned j = 0; j < 16; ++j) { const unsigned c = xb_ld(&bar[XB_XCNT(j)]); sum += c; cnt += (c > 0u) ? 1u : 0u; mine = (j == x) ? c : mine; }
    if (sum == G) break;
    __builtin_amdgcn_s_sleep(1);
    if ((++sp & 255u) == 0u) { if (xb_ld(&bar[XB_TMO])) break; if (sp > XB_SPIN_CAP) { atomicAdd(&bar[XB_TMO], 1u); break; } } }
  nloc = mine > 0u ? mine : 1u; nx = cnt > 0u ? cnt : 1u;
}
__device__ __forceinline__ void xcd_barrier(const XcdBarrier& b) {
  asm volatile("s_waitcnt vmcnt(0)" ::: "memory");
  __syncthreads();
  if (threadIdx.x == 0) {
    unsigned* bar = b.bar;
    __builtin_amdgcn_s_waitcnt(0);
    unsigned nloc = b.st[0], nx = b.st[1];
    if (nloc == 0u) { xcd_barrier_complete(bar, b.x, nloc, nx); b.st[0] = nloc; b.st[1] = nx; }
    const unsigned old = xb_add(&bar[XB_XSUB(b.x)], 1u);
    const unsigned gen = old / nloc;
    if (old + 1u == (gen + 1u) * nloc) {
      __builtin_amdgcn_fence(__ATOMIC_RELEASE, "agent");
      asm volatile("s_waitcnt vmcnt(0)" ::: "memory");
      const unsigned og = xb_add(&bar[XB_TOP], 1u);
      const unsigned tg = og / nx;
      if (og + 1u == (tg + 1u) * nx) xb_add(&bar[XB_TOPGEN], 1u);
      else XB_SPIN(xb_ld(&bar[XB_TOPGEN]) == tg, bar);
      __builtin_amdgcn_fence(__ATOMIC_ACQUIRE, "agent");
      xb_add(&bar[XB_XGEN(b.x)], 1u);
      asm volatile("s_waitcnt vmcnt(0)" ::: "memory");
    } else {
      XB_SPIN(xb_ld(&bar[XB_XGEN(b.x)]) == gen, bar);
      __builtin_amdgcn_fence(__ATOMIC_ACQUIRE, "agent");
      asm volatile("s_waitcnt vmcnt(0)" ::: "memory");
    }
  }
  __syncthreads();
}

struct KArgs { const void* in[20]; float* out; char* ws; };
#ifdef SELFCHK
#define RUN_S 4096
#else
#define RUN_S SEQ
#endif
__host__ __device__ __forceinline__ size_t fill_ws(Params& p, Params& p2, char* w) {
  size_t off = 0;
#define TAKE(bytes) (w + ((off += (((size_t)(bytes)) + 255) & ~(size_t)255) - ((((size_t)(bytes)) + 255) & ~(size_t)255)))
  const size_t S = RUN_S, ncmp = S / 16, nc = S / 128;
  p.S = RUN_S;
  p.wt_in = (unsigned short*)TAKE(8320 * 1024 * 2); p.wt_out = (unsigned short*)TAKE(2 * 1024 * 2304 * 2); p.w1t = (unsigned short*)TAKE(2 * 128 * 2048 * 2); p.w2t = (unsigned short*)TAKE(2 * 64 * 128 * 2);
  p.h = (SB*)TAKE(S * 1024 * 2); p.ybuf = (float*)p.h;
  p.proj = (SB*)TAKE(S * NPROJ * 2); p.y = (float*)p.proj;
  p.small = (float*)TAKE(S * 32 * 4); p.mix = (SB*)TAKE(S * NMIX * 2);
  p.rope_cs = (float*)TAKE(S * 32 * 4); p.rope_sn = (float*)TAKE(S * 32 * 4); p.tabA = (float*)TAKE(8 * TABA_N * 4); p.tabD = (float*)TAKE(24 * TABD_N * 4);
  p.memkv = (SB*)TAKE(4 * 256 * 512 * 2); p.hid = (float*)TAKE(2 * ncmp * 256 * 4); p.kvc = (SB*)TAKE(2 * ncmp * 128 * 2);
  p.cml = (float*)TAKE(S * 16 * 4); p.idx = (int*)TAKE(S * 32 * 4); p.oc = (SB*)TAKE(S * 512 * 2); p.ow = (SB*)TAKE(S * 512 * 2);
  p.dop = (SB*)TAKE(3 * S * 512 * 2); p.dlse = (float*)TAKE(3 * S * 8 * 4); p.xconv = (SB*)TAKE(S * 1024 * 2);
  p.dt = (float*)TAKE(S * 8 * 4); p.acs = (float*)TAKE(S * 8 * 4); p.wst = (float*)TAKE(S * 8 * 4); p.cb = (float*)TAKE(nc * 2 * 128 * 128 * 4); p.states = (float*)TAKE(nc * 65536 * 4);
  p.bar = (unsigned*)TAKE(131072);
  p2 = p;
#ifdef SELFCHK
  p.imp = (float*)TAKE(S * 512 * 4);
  p2.mix = (SB*)TAKE(S * NMIX * 2); p2.ow = (SB*)TAKE(S * 512 * 2); p2.oc = (SB*)TAKE(S * 512 * 2); p2.dop = (SB*)TAKE(3 * S * 512 * 2); p2.dlse = (float*)TAKE(3 * S * 8 * 4);
  p2.cml = (float*)TAKE(S * 16 * 4); p2.imp = (float*)TAKE(S * 512 * 4); p2.idx = (int*)TAKE(S * 32 * 4); p2.cb = (float*)TAKE(nc * 2 * 128 * 128 * 4);
  p2.kvc = (SB*)TAKE(2 * ncmp * 128 * 2); p2.xconv = (SB*)TAKE(S * 1024 * 2); p2.dt = (float*)TAKE(S * 8 * 4); p2.acs = (float*)TAKE(S * 8 * 4); p2.wst = (float*)TAKE(S * 8 * 4);
  p2.states = (float*)TAKE(nc * 65536 * 4); p2.ybuf = (float*)TAKE(S * 512 * 4); p.ybuf = (float*)TAKE(S * 512 * 4);
#else
  p.imp = (float*)p.dop; p2 = p;
#endif
  return off;
}
__host__ __device__ __forceinline__ void fill_inputs(Params& p, const KArgs& a) {
  p.x = (const float*)a.in[0]; p.mem = (const float*)a.in[1]; p.pos = (const int*)a.in[2]; p.pre_norm = (const float*)a.in[3]; p.post_norm = (const float*)a.in[4];
  p.w_in = (const float*)a.in[5]; p.w_out = (const float*)a.in[6]; p.rel_bias = (const float*)a.in[7]; p.cmp_pos = (const float*)a.in[8]; p.cmp_w1 = (const float*)a.in[9];
  p.cmp_w2 = (const float*)a.in[10]; p.conv_w = (const float*)a.in[11]; p.conv_b = (const float*)a.in[12]; p.dt_bias = (const float*)a.in[13]; p.a_log = (const float*)a.in[14];
  p.b_d = (const float*)a.in[15]; p.b_norm = (const float*)a.in[16]; p.sinks = (const float*)a.in[17]; p.m_norm = (const float*)a.in[18]; p.m_wkv = (const float*)a.in[19];
  p.out = a.out;
}
#define GS(N, ...) { long g0_ = (long)blockIdx.x * 256 + tx_(); for (long gid = g0_; gid < (long)(N); gid += gsz) { __VA_ARGS__; } }
#define WU(N, ...) { for (int u_ = gw0(gwave); u_ < (int)(N); u_ += nwave) { const int u = __builtin_amdgcn_readfirstlane(u_); const unsigned tq_ = tx_(); int lane = tq_ & 63; \
    WaveLds* WL = ((WaveLds*)smem_raw) + __builtin_amdgcn_readfirstlane((int)(tq_ >> 6)); __VA_ARGS__; } }
#define GSYNC() xcd_barrier(xb)
#ifndef CMP_SKIP
#define CMP_SKIP 3
#endif
#define WUQ(slot, CH, N, ...) { unsigned* cq_ = &p.bar[4096 + (layer * 8 + (slot)) * 64 * 8 + (blockIdx.x & 7) * 64]; for (;;) { unsigned t_ = 0u; if ((tx_() & 63) == 0) t_ = atomicAdd(cq_, 1u); \
    const int c0_ = __builtin_amdgcn_readfirstlane((int)t_) * (CH); if ((c0_ * 8 + (int)(blockIdx.x & 7)) >= (int)(N)) break; \
    for (int ci_ = 0; ci_ < (CH); ++ci_) { const int u = (c0_ + ci_) * 8 + (int)(blockIdx.x & 7); if (u >= (int)(N)) break; const unsigned tq_ = tx_(); int lane = tq_ & 63; \
      WaveLds* WL = ((WaveLds*)smem_raw) + __builtin_amdgcn_readfirstlane((int)(tq_ >> 6)); (void)WL; __VA_ARGS__; } } }
#ifndef ASELW
#define ASELW 1
#endif
#if ASELW
#define ASEL_UNIT(pp, uu) unit_asel_w((pp), (uu), (AselW*)smem_raw)
#else
#define ASEL_UNIT(pp, uu) unit_asel_blk((pp), (uu), (AselLds*)smem_raw)
#endif
#define SMEM_A_ (sizeof(AselLds) > sizeof(AselW) ? sizeof(AselLds) : sizeof(AselW))
#define SMEM_BYTES (SMEM_A_ > sizeof(GemmSmem) ? ((SMEM_A_ + 15) & ~(size_t)15) : sizeof(GemmSmem))
#define gtid ((long)blockIdx.x * 256 + tx_())
#define gwave ((int)((blockIdx.x * 256u + tx_()) >> 6))
#define KERNEL_PROLOGUE \
  Params p, p2; p.pad0 = 0; fill_inputs(p, ka); fill_ws(p, p2, ka.ws); \
  cg::grid_group grid = cg::this_grid(); \
  __shared__ __attribute__((aligned(16))) char smem_raw[SMEM_BYTES + 16]; \
  volatile LDS3 unsigned* xbst = (volatile LDS3 unsigned*)(smem_raw + SMEM_BYTES); \
  if (threadIdx.x < 4) xbst[threadIdx.x] = 0u; \
  __syncthreads(); \
  XcdBarrier xb = xcd_barrier_post(p.bar, xbst); \
  GemmSmem& gsm = *(GemmSmem*)smem_raw; float* ftile = (float*)smem_raw; \
  const long gsz = (long)gridDim.x * 256; const int nwave = (int)(gsz >> 6); \
  const int S = p.S, ncmp = S / 16, nc = S / 128, nqt = S / 32; (void)ncmp; (void)nc; (void)nqt; (void)ftile; (void)gsm; \
  GS((long)S * 32, ph_rope(p, gid)); \
  GS(8 * TABA_N + 24 * TABD_N, ph_tabs(p, gid)); \
  WU(DEPTH * 256, unit_memkv(p, u, lane));
#define PHASE_NORM(layer) \
    for (int t = gw0(gwave); t < S; t += nwave) { int lane = tx_() & 63; norm_row_wave(p, layer, t, true, lane); }
#define PHASE_CVT(layer) \
    { const float* wi = p.w_in + (long)(layer) * 1024 * 8224; unsigned short* wob_ = p.wt_out + (long)((layer) & 1) * 1024 * 2304; \
      for (int tl = bid0(); tl < 16 * 130; tl += gridDim.x) cvt_tile<true>(wi, 8224, p.wt_in, 1024, (tl & 15) * 64, (tl >> 4) * 64, ftile); \
      const float* wo = p.w_out + (long)(layer) * 2304 * 1024; \
      for (int tl = bid0(); tl < 36 * 16; tl += gridDim.x) cvt_tile<false>(wo, 1024, wob_, 2304, (tl % 36) * 64, (tl / 36) * 64, ftile); \
      for (int tl = bid0(); tl < 2 * 64; tl += gridDim.x) { const int kv = tl >> 6, t6 = tl & 63; cvt_tile<false>(p.cmp_w1 + (long)((layer) * 2 + kv) * 2048 * 128, 128, p.w1t + (long)kv * 128 * 2048, 2048, (t6 >> 1) * 64, (t6 & 1) * 64, ftile); } \
      for (int tl = bid0(); tl < 2 * 2; tl += gridDim.x) { const int kv = tl >> 1; cvt_tile<false>(p.cmp_w2 + (long)((layer) * 2 + kv) * 128 * 64, 64, p.w2t + (long)kv * 64 * 128, 128, (tl & 1) * 64, 0, ftile); } }
#define PHASE_P1(layer) PHASE_NORM(layer) PHASE_CVT(layer)
#define PHASE_P2() \
    {   \
      const int x_ = bid0() & 7, li_ = bid0() >> 3, nl_ = (gridDim.x + 7) >> 3, mtiles_ = S / (64 * GMI), mper_ = mtiles_ / 8; \
      if ((mper_ & 7) != 0 || (gridDim.x & 7) != 0) { for (int tl = bid0(); tl < mtiles_ * 65; tl += gridDim.x) { int mt = tl % mtiles_, nt = tl / mtiles_; gemm_tile<0, GMI>(p, p.h, DM, p.wt_in, DM, DM, mt * 64 * GMI, nt * 128, gsm); } } \
      else for (int t_ = li_; t_ < mper_ * 65; t_ += nl_) { const int half_ = t_ / 520, r_ = t_ % 520; int ml_, nt_; \
        if (r_ < 512) { ml_ = r_ & 7; nt_ = (r_ >> 6) * 8 + ((r_ & 63) >> 3); } else { ml_ = r_ - 512; nt_ = 64; } \
        gemm_tile<0, GMI>(p, p.h, DM, p.wt_in, DM, DM, (x_ * mper_ + half_ * 8 + ml_) * 64 * GMI, nt_ * 128, gsm); } }
#define PHASE_FLASH3(layer) \
    { const int nA = nqt * 8, nM = nqt * 4, nD = 3 * nqt * 8, nC = nqt * 8; \
      WU(nA + nM + nD + nC, { if (u < nA) unit_awin(p, u, WL, lane); else if (u < nA + nM) unit_m(p, layer, u - nA, WL, lane); \
                              else if (u < nA + nM + nD) unit_d(p, u - nA - nM, WL, lane); else unit_c(p, layer, u - nA - nM - nD, WL, lane); }); }
#define WU2(N, ...) { for (int u_ = gw0(gwave); u_ < (int)(N); u_ += nwave) { const int u = __builtin_amdgcn_readfirstlane(u_); const unsigned tq_ = tx_(); int lane = tq_ & 63; \
    WaveLds2* WL2 = ((WaveLds2*)smem_raw) + __builtin_amdgcn_readfirstlane((int)(tq_ >> 6)); __VA_ARGS__; } }
#define PHASE_CB() \
    for (int tl = bid0(); tl < nc * 2; tl += gridDim.x) { const SB* xb_ = p.xconv + (long)(tl >> 1) * 128 * 1024 + (tl & 1) * 128; gemm_tile<2, 2>(p, xb_ + 768, 1024, xb_ + 512, 1024, 128, 0, 0, gsm, p.cb + (long)tl * 16384); }

#ifndef SELFCHK
#define PH_BEGIN { char* wsb_ = ka.ws; asm volatile("" : "+s"(wsb_)); Params p, p2_; p.pad0 = 0; fill_inputs(p, ka); fill_ws(p, p2_, wsb_); (void)p2_;
#define PH_END }
__global__ void __launch_bounds__(256, LB2) mega(KArgs ka) {
  KERNEL_PROLOGUE
#ifdef REP_PRO
  GS((long)S * 32, ph_rope(p, gid)); GS(8 * TABA_N + 24 * TABD_N, ph_tabs(p, gid)); WU(DEPTH * 256, unit_memkv(p, u, lane));
#endif
#ifdef TSEL
  unsigned long long tlast = __builtin_amdgcn_s_memrealtime();
#define TMARK(id) { if (gtid == 0) { const unsigned long long tn = __builtin_amdgcn_s_memrealtime(); ((unsigned long long*)p.bar)[id] += tn - tlast; tlast = tn; } }
#else
#define TMARK(id)
#endif
  for (int layer = 0; layer < DEPTH; ++layer) {
    PH_BEGIN
    PHASE_P1(layer)
#ifdef REP_P1
    PHASE_P1(layer)
#endif
    PH_END
    if (layer == 0) grid.sync(); else GSYNC();
    PH_BEGIN
    TMARK(1)
    PHASE_P2()
#ifdef REP_G
    PHASE_P2()
#endif
#ifdef REP_G2
    { const int x_ = bid0() & 7, li_ = bid0() >> 3, nl_ = (gridDim.x + 7) >> 3; for (int t_ = li_; t_ < 520; t_ += nl_) { int ml_, nt_; if (t_ < 512) { ml_ = t_ & 7; nt_ = (t_ >> 6) * 8 + ((t_ & 63) >> 3); } else { ml_ = t_ - 512; nt_ = 64; }
        gemm_tile<0, GMI, true>(p, p.h, DM, p.wt_in, DM, DM, (x_ * 8 + ml_) * 64 * GMI, nt_ * 128, gsm); } }
#endif
    PH_END
    GSYNC();
    PH_BEGIN
    TMARK(2)
    { const int nCmp = 2 * (ncmp * 2 / 32), nA = nqt * 8, nM = nqt * 4, nD = 3 * nqt * 8, nC = nqt * 8, nF = nA + nM + nD + nC;
      const int cb0 = (int)gridDim.x - nCmp; const bool cmpw = ((int)blockIdx.x >= cb0) && (cb0 > 0); const int cw0 = cb0 * 4;
#define FLASH_UNIT(uu) {   \
        const int v_ = __builtin_amdgcn_readfirstlane(uu); const int gw_ = v_ % nwave, rr_ = v_ / nwave; const int x_ = (gw_ >> 2) & 7, lw_ = ((gw_ >> 5) << 2) | (gw_ & 3); int j_ = rr_ * (nwave >> 3) + lw_; \
        const unsigned tq_ = tx_(); int lane = tq_ & 63; WaveLds* WL = ((WaveLds*)smem_raw) + __builtin_amdgcn_readfirstlane((int)(tq_ >> 6)); \
        if ((nwave & 31) != 0) { const int u = v_; if (u < nA) unit_awin(p, u, WL, lane); else if (u < nA + nM) unit_m(p, layer, u - nA, WL, lane); else if (u < nA + nM + nD) unit_d(p, u - nA - nM, WL, lane); else unit_c(p, layer, u - nA - nM - nD, WL, lane); } \
        else if (j_ < nA / 8) unit_awin(p, x_ * (nA / 8) + j_, WL, lane); \
        else if ((j_ -= nA / 8) < nM / 8) unit_m(p, layer, x_ * (nM / 8) + j_, WL, lane); \
        else if ((j_ -= nM / 8) < nD / 24) unit_d(p, x_ * (nD / 24) + j_, WL, lane); \
        else if ((j_ -= nD / 24) < nD / 24) unit_d(p, nD / 3 + x_ * (nD / 24) + j_, WL, lane); \
        else if ((j_ -= nD / 24) < nD / 24) unit_d(p, 2 * (nD / 3) + x_ * (nD / 24) + j_, WL, lane); \
        else if ((j_ -= nD / 24) < nC / 8) unit_c(p, layer, x_ * (nC / 8) + j_, WL, lane); }
#ifdef REP_F3B
      WU(nA + nD, { if (u < nA) unit_awin(p, u, WL, lane); else unit_d(p, u - nA, WL, lane); });
#endif
#ifdef REP_CMPB
      for (int ub = bid0(); ub < nCmp; ub += gridDim.x) unit_cmp_blk(p, layer, ub, (float*)smem_raw); __syncthreads();
#endif
      if (cb0 <= 0) { for (int ub = bid0(); ub < nCmp; ub += gridDim.x) unit_cmp_blk(p, layer, ub, (float*)smem_raw); __syncthreads(); }
      else if (cmpw) { unit_cmp_blk(p, layer, (int)blockIdx.x - cb0, (float*)smem_raw); __syncthreads(); }
      for (int r_ = (cmpw ? CMP_SKIP : 0), u_ = gw0(gwave) + r_ * nwave; u_ < nF; u_ += nwave) FLASH_UNIT(u_)
      if (cb0 > 0) for (int e_ = gw0(gwave); e_ < CMP_SKIP * nCmp * 4; e_ += nwave) { const int u_ = (e_ / (nCmp * 4)) * nwave + cw0 + (e_ % (nCmp * 4)); if (u_ < nF) FLASH_UNIT(u_) }
#undef FLASH_UNIT
    }
    GS((long)S * 128, item_bconv(p, layer, gid));
    WU(nc * 8, unit_bdt(p, layer, u, lane));
    PH_END
    GSYNC();
    PH_BEGIN
    TMARK(3)
    WU(nqt * 8, unit_acmp1(p, u, WL, lane));
    __syncthreads();
    PHASE_CB()
    __syncthreads();
    WU2(nc * 16, unit_bstates(p, u, WL2, lane));
#ifdef REP_P4
    __syncthreads();
    WU(nqt * 8, unit_acmp1(p, u, WL, lane));
    __syncthreads();
    PHASE_CB()
    __syncthreads();
    WU2(nc * 16, unit_bstates(p, u, WL2, lane));
#endif
    GS((long)S * 64, item_dmerge(p, gid));
    PH_END
    GSYNC();
    PH_BEGIN
    TMARK(4)
    {
      const int nU = nqt * 8, hw_ = nwave >> 1; const int gw_ = gw0(gwave);
      if (65536 * 2 != (int)gsz || (nU & 3)) { WU(nU, unit_acmp2(p, u, lane)); }
      else if (gw_ >= hw_) { for (int u_ = gw_ - hw_; u_ < (nU / 4) * 3; u_ += hw_) { const int u = __builtin_amdgcn_readfirstlane(u_); int lane = tx_() & 63; unit_acmp2(p, u, lane); } }
      else { for (int u_ = (nU / 4) * 3 + gw_; u_ < nU; u_ += hw_) { const int u = __builtin_amdgcn_readfirstlane(u_); int lane = tx_() & 63; unit_acmp2(p, u, lane); } } }
#ifdef REP_P5A
    WU(nqt * 8, unit_acmp2(p, u, lane));
#endif
    GS(65536, ph_b_scan(p, gid));
    PH_END
    GSYNC();
    PH_BEGIN
    TMARK(5)
#ifdef REP_BOUT
    for (int ub = bid0(); ub < nc * 8; ub += gridDim.x) unit_bout_blk<false>(p, layer, ub, smem_raw);
#endif
    for (int ub = bid0(); ub < nc * 8; ub += gridDim.x) unit_bout_blk(p, layer, ub, smem_raw);
    TMARK(7)
#ifdef REP_ASEL2
    for (;;) { __syncthreads(); if (threadIdx.x == 0) xbst[2] = atomicAdd(&p.bar[48 + layer * 8 + 7], 1u); __syncthreads(); const int ub = (int)xbst[2]; if (ub >= (S / 32) * 2) break; unit_asel_blk<false>(p, ub, (AselLds*)smem_raw); }
#endif
#ifdef REP_ASEL3
    for (;;) { __syncthreads(); if (threadIdx.x == 0) xbst[2] = atomicAdd(&p.bar[48 + layer * 8 + 7], 1u); __syncthreads(); const int ub = (int)xbst[2]; if (ub >= (S / 32) * 2) break; unit_asel_blk<false, true>(p, ub, (AselLds*)smem_raw); }
#endif
#ifndef ASEL_XQ
#define ASEL_XQ 1
#endif
#if ASEL_XQ
    { const int qc = (bid0() >> 2) & 1; bool own = true;
      for (;;) { __syncthreads();
        if (threadIdx.x == 0) { unsigned n = 0xffffffffu; int c = qc;
          if (own) { n = atomicAdd(&p.bar[48 + layer * 8 + 4 + qc], 1u); if (n >= (unsigned)(S / 32)) n = 0xffffffffu; }
          if (n == 0xffffffffu) { c = qc ^ 1; n = atomicAdd(&p.bar[48 + layer * 8 + 4 + c], 1u); if (n >= (unsigned)(S / 32)) n = 0xffffffffu; xbst[3] = 1u; } else xbst[3] = 0u;
          xbst[2] = (n == 0xffffffffu) ? 0xffffffffu : (2u * n + (unsigned)c); }
        __syncthreads(); const unsigned ubu = xbst[2]; if (xbst[3]) own = false; if (ubu == 0xffffffffu) break; ASEL_UNIT(p, (int)ubu); } }
#else
    for (;;) { __syncthreads(); if (threadIdx.x == 0) xbst[2] = atomicAdd(&p.bar[48 + layer * 8 + 6], 1u); __syncthreads(); const int ub = (int)xbst[2]; if (ub >= (S / 32) * 2) break; unit_asel_blk(p, ub, (AselLds*)smem_raw); }
#endif
    PH_END
    GSYNC();
    PH_BEGIN
    TMARK(8)
    for (int tl = bid0(); tl < (S / (64 * GMI)) * 8; tl += gridDim.x) { int mt = tl >> 3, nt = tl & 7; gemm_tile<1, GMI>(p, p.mix, NMIX, p.wt_out + (long)(layer & 1) * 1024 * 2304, NMIX, NMIX, mt * 64 * GMI, nt * 128, gsm); }
#ifdef REP_P8
    for (int tl = bid0(); tl < (S / (64 * GMI)) * 8; tl += gridDim.x) { int mt = tl >> 3, nt = tl & 7; gemm_tile<1, GMI>(p, p.mix, NMIX, p.wt_out + (long)(layer & 1) * 1024 * 2304, NMIX, NMIX, mt * 64 * GMI, nt * 128, gsm); }
#endif
    PH_END
    GSYNC();
    PH_BEGIN
    TMARK(9)
#ifdef REP_BAR
    for (int q_ = 0; q_ < 8; ++q_) GSYNC();
#endif
    PH_END
  }
  for (int t = gw0(gwave); t < S; t += nwave) { int lane = tx_() & 63; norm_row_wave(p, DEPTH, t, false, lane); }
#ifdef TSEL
  GSYNC();
  { float best = -1.f; int bi = 0; for (int k = 1; k < 10; ++k) if (!((TSEL >> k) & 1)) { const float us = (float)((unsigned long long*)p.bar)[k] * 0.01f; if (us > best) { best = us; bi = k; } }
    const float kk = 10.f * (float)bi + floorf(log2f(best + 1.f));
    GS((long)S * 1024, p.out[gid] = kk); }
#endif
}
#else
__device__ __forceinline__ void chk_update(unsigned* slot, float diff, float ref) {
  atomicMax(&slot[0], __float_as_uint(fabsf(diff))); atomicMax(&slot[1], __float_as_uint(fabsf(ref)));
}
#define CMPB(slot, a, b_) chk_update(sl + (slot), bf2f(a) - bf2f(b_), bf2f(b_))
#define CMPF(slot, a, b_) chk_update(sl + (slot), (a) - (b_), (b_))
__global__ void __launch_bounds__(256, 1) mega(KArgs ka) {
  KERNEL_PROLOGUE
  if (gtid < 64) p.bar[gtid] = 0u;
  unsigned* sl = p.bar;
  const int layer = 0;
  PHASE_P1(layer)
  grid.sync();
  PHASE_P2()
  GSYNC();
  GS((long)S * NMIX, p2.mix[gid] = p.mix[gid]);
  GSYNC();
  PHASE_FLASH3(layer)
  __syncthreads();
  for (int ub = bid0(); ub < 2 * (ncmp * 2 / 32); ub += gridDim.x) unit_cmp_blk(p, layer, ub, (float*)smem_raw);
  __syncthreads();
  GS((long)S * 128, item_bconv(p, layer, gid));
  WU(nc * 8, unit_bdt(p, layer, u, lane));
  GS((long)2 * ncmp * 256, ph_cmp_hid(p2, layer, gid));
  GS((long)S * 8, ph_a_win(p2, gid));
  GS((long)S * 8, ph_c(p2, layer, gid));
  GS((long)3 * S * 8, ph_d(p2, gid));
  GS((long)S * 4, ph_m(p2, layer, gid));
  GS((long)S * 1024, ph_b_conv(p2, layer, gid));
  GS((long)nc * 8, ph_b_dt2(p2, layer, gid));
  GSYNC();
  GS((long)2 * ncmp * 128, ph_cmp_out(p2, layer, gid));
  GSYNC();
  GS((long)2 * ncmp * 128, CMPB(20, p.kvc[gid], p2.kvc[gid]));
  GS((long)S * 1024, CMPB(22, p.xconv[gid], p2.xconv[gid]));
  GS((long)S * 8, { CMPF(24, p.dt[gid], p2.dt[gid]); CMPF(24, p.acs[gid], p2.acs[gid]); CMPF(24, p.wst[gid], p2.wst[gid]); });
  GSYNC();
  GS((long)2 * ncmp * 128, p2.kvc[gid] = p.kvc[gid]);
  GS((long)S * 1024, p2.xconv[gid] = p.xconv[gid]);
  GS((long)S * 8, { p2.dt[gid] = p.dt[gid]; p2.acs[gid] = p.acs[gid]; p2.wst[gid] = p.wst[gid]; });
  GSYNC();
  WU(nqt * 8, unit_acmp1(p, u, WL, lane));
  __syncthreads();
  PHASE_CB()
  __syncthreads();
  WU2(nc * 16, unit_bstates(p, u, WL2, lane));
  GS((long)S * 8, ph_a_cmp1(p2, gid));
  GS((long)nc * 2 * 128 * 128, ph_b_cb(p2, gid));
  GS((long)nc * 65536, ph_b_states(p2, gid));
  GSYNC();
  WU(nqt * 8, unit_acmp2(p, u, lane));
  GS((long)S * 2, ph_a_cmp2(p2, gid));
  GS((long)nc * 65536, CMPF(26, p.states[gid], p2.states[gid]));
  GS((long)nc * 2 * 128 * 128, { int s_ = (int)(gid & 127), l_ = (int)((gid >> 7) & 127); if (s_ <= l_) CMPF(18, p.cb[gid], p2.cb[gid]); });
  GSYNC();
  GS(65536, ph_b_scan(p, gid));
  GS(65536, ph_b_scan(p2, gid));
  GS((long)S * 512, { CMPB(0, p.ow[gid], p2.ow[gid]); CMPB(2, p.oc[gid], p2.oc[gid]); long t = gid >> 9, c = gid & 511; CMPB(4, p.mix[t * NMIX + MX_C + c], p2.mix[t * NMIX + MX_C + c]);
                      if (c < 256) CMPB(6, p.mix[t * NMIX + MX_M + c], p2.mix[t * NMIX + MX_M + c]); });
  GS((long)3 * S * 512, CMPB(8, p.dop[gid], p2.dop[gid]));
  GS((long)3 * S * 8, chk_update(sl + 10, p.dlse[gid] - p2.dlse[gid], 1.f));
  GS((long)S * 2 * 256, { long qg = gid >> 8; int bb = (int)(gid & 255); int q = (int)(qg >> 1), g_ = (int)(qg & 1); if (bb <= (q >> 6)) CMPF(12, p.imp[(((long)(q >> 5) * 2 + g_) * 256 + bb) * 32 + (q & 31)], p2.imp[gid]); });
  GSYNC();
  GS((long)S * 512, { long qg = gid >> 8; int bb = (int)(gid & 255); int q = (int)(qg >> 1), g_ = (int)(qg & 1); p2.imp[gid] = p.imp[(((long)(q >> 5) * 2 + g_) * 256 + bb) * 32 + (q & 31)]; });
  GSYNC();
  WU(S * 2 / 4, unit_topk4(p, u, lane));
  WU2(nc * 32, unit_bout(p, layer, u, WL2, lane));
  GS((long)S * 2, ph_a_topk(p2, gid));
  GS((long)S * 512, ph_b_out(p2, layer, gid));
  GSYNC();
  GS((long)S * 2, { int q = (int)(gid >> 1); int nv = (q >> 6) + 1; nv = nv > 16 ? 16 : nv; int bad = 0;
    for (int k = 0; k < 16; ++k) { int mine = p.idx[gid * 16 + k]; bool found = false; for (int k2 = 0; k2 < 16; ++k2) found |= (p2.idx[gid * 16 + k2] == mine); if (k < nv) bad += !found || mine < 0; else bad += (mine >= 0); }
    chk_update(sl + 14, (float)bad, 1.f); });
  GS((long)S * 512, CMPF(28, p.ybuf[gid], p2.ybuf[gid]));
  GSYNC();
  GS((long)S * 32, p2.idx[gid] = p.idx[gid]);
  GS((long)S * 512, p2.ybuf[gid] = p.ybuf[gid]);
  GSYNC();
  for (int ub = bid0(); ub < (S / 32) * 2; ub += gridDim.x) ASEL_UNIT(p, ub);
  for (;;) { __syncthreads(); if (threadIdx.x == 0) xbst[2] = atomicAdd(&p.bar[40 + layer], 1u); __syncthreads(); const int ub = (int)xbst[2]; if (ub >= nc * 8) break; unit_bout_blk(p, layer, ub, smem_raw); }
  GS((long)S * 8, ph_a_sel(p2, gid));
  GS((long)S * 2, ph_b_norm(p2, layer, gid));
  GSYNC();
  GS((long)S * 512, { long t = gid >> 9, c = gid & 511; CMPB(16, p.mix[t * NMIX + MX_A + c], p2.mix[t * NMIX + MX_A + c]); CMPB(30, p.mix[t * NMIX + MX_B + c], p2.mix[t * NMIX + MX_B + c]); });
  GSYNC();
  { float R = 0.f;
    for (int k = 0; k < 16; ++k) { float d = __uint_as_float(p.bar[2 * k]), r = __uint_as_float(p.bar[2 * k + 1]); float q = d / (r + 1e-20f); if (CHKSEL < 0 || CHKSEL == k) R = fmaxf(R, q); }
    GS((long)SEQ * 1024, p.out[gid] = 1e4f * R); }
}
#endif

__global__ void zz_tail_pad(float* o) { asm volatile(".rept 512\n\ts_nop 0\n\t.endr" ::: "memory"); if (o) o[0] = 0.f; }
__global__ void fill_code(float* o, float v, long n) { long i = blockIdx.x * 256L + threadIdx.x; if (i < n) o[i] = v; }
extern "C" void kernel_launch(void* const* d_in, const int* in_sizes, int n_in, void* d_out, int out_size, void* d_ws, size_t ws_size, hipStream_t stream) {
  KArgs ka; memset(&ka, 0, sizeof(ka));
  for (int i = 0; i < 20; ++i) ka.in[i] = d_in[i];
  ka.out = (float*)d_out; ka.ws = (char*)d_ws;
  Params hp, hp2; memset(&hp, 0, sizeof(hp)); const size_t need = fill_ws(hp, hp2, (char*)d_ws);
  if (need > ws_size) { fprintf(stderr, "workspace too small: need %zu have %zu\n", need, ws_size); return; }
  static int grid_blocks = 0;
  if (!grid_blocks) { int dev = 0, cus = 0, per_cu = 0; (void)hipGetDevice(&dev); (void)hipDeviceGetAttribute(&cus, hipDeviceAttributeMultiprocessorCount, dev);
    (void)hipOccupancyMaxActiveBlocksPerMultiprocessor(&per_cu, mega, 256, 0); if (per_cu > LB2) per_cu = LB2; if (per_cu < 1) per_cu = 1; grid_blocks = cus * per_cu; }
  (void)hipMemsetAsync(hp.bar, 0, 131072, stream);
  void* args[] = {&ka};
  hipError_t e = hipLaunchCooperativeKernel((void*)mega, dim3(grid_blocks), dim3(256), args, 0, stream);
  if (e != hipSuccess) { (void)hipGetLastError(); fill_code<<<(unsigned)(((long)SEQ * 1024 + 255) / 256), 256, 0, stream>>>((float*)d_out, 1000.f * (float)(int)e + (float)grid_blocks, (long)SEQ * 1024); }
}
```

```cpp
#include <hip/hip_runtime.h>
#include <hip/hip_cooperative_groups.h>
#include <cstdio>
#include <cstdint>
#include <cstring>
namespace cg = cooperative_groups;
#define HD_ __device__ __forceinline__
#ifndef CHKSEL
#define CHKSEL -1
#endif
#ifndef LB2
#define LB2 2
#endif
#ifndef HD_
#define HD_ inline
#endif
#ifdef SB_IS_FLOAT
typedef float SB;
HD_ float ldf(const SB* p) { return *p; }
HD_ void stf(SB* p, float v) { *p = v; }
#else
typedef unsigned short SB;
HD_ float bf2f(unsigned short b) { unsigned u = ((unsigned)b) << 16; float f; __builtin_memcpy(&f, &u, 4); return f; }
HD_ unsigned short f2bf(float f) { unsigned u; __builtin_memcpy(&u, &f, 4); u += 0x7fffu + ((u >> 16) & 1u); return (unsigned short)(u >> 16); }
HD_ float ldf(const SB* p) { return bf2f(*p); }
HD_ void stf(SB* p, float v) { *p = f2bf(v); }
#endif

#define DM 1024
#define NPROJ 5888
#define NMIX 2304
#define NSMALL 32
#define PA_Q 0
#define PA_KV 512
#define PB_X 1280
#define PC_Q 2304
#define PC_KV 2816
#define PD_Q 3072
#define PD_KV 4608
#define PM_Q 5632
#define MX_A 0
#define MX_B 512
#define MX_C 1024
#define MX_D 1536
#define MX_M 2048
#define TABA_N 2048
#define TABD_N 132

struct Params {
  int S; int pad0;
  const float *x, *mem; const int* pos;
  const float *pre_norm, *post_norm, *w_in, *w_out, *rel_bias, *cmp_pos, *cmp_w1, *cmp_w2, *conv_w, *conv_b, *dt_bias, *a_log, *b_d,
      *b_norm, *sinks, *m_norm, *m_wkv;
  float* out;
  unsigned short* wt_in;
  unsigned short* wt_out;
  unsigned short *w1t, *w2t;
  SB* h;
  SB* proj;
  float* small;
  SB* mix;
  float* y;
  float *rope_cs, *rope_sn;
  float *tabA, *tabD;
  SB* memkv;
  float* hid;
  SB* kvc;
  float* imp;
  float* cml;
  int* idx;
  SB *oc, *ow;
  SB* dop;
  float* dlse;
  SB* xconv;
  float *dt, *acs;
  float* wst;
  float* cb;
  float* states;
  float* ybuf;
  unsigned* bar;
};

HD_ float silu_f(float x) { return x / (1.f + expf(-x)); }
HD_ float sigmoid_f(float x) { return 1.f / (1.f + expf(-x)); }
HD_ float gelu_f(float x) { return 0.5f * x * (1.f + tanhf(0.7978845608028654f * (x + 0.044715f * x * x * x))); }
HD_ float softplus_f(float x) { return fmaxf(x, 0.f) + log1pf(expf(-fabsf(x))); }

HD_ int t5_bucket(int d) {
  if (d < 16) return d < 0 ? 0 : d;
  const int thr[15] = {22, 30, 40, 54, 73, 99, 134, 182, 246, 332, 450, 609, 825, 1117, 1513};
  int b = 16;
  for (int k = 0; k < 15; ++k) b += (d >= thr[k]) ? 1 : 0;
  return b;
}

HD_ void ph_rope(const Params& p, long gid) {
  int s = (int)(gid >> 5), i = (int)(gid & 31);
  float inv = powf(150000.f, -(float)i / 32.f);
  float ang = (float)p.pos[s] * inv;
  p.rope_cs[gid] = cosf(ang); p.rope_sn[gid] = sinf(ang);
}
HD_ void ph_tabs(const Params& p, long gid) {
  if (gid < 8 * TABA_N) { int h = (int)(gid / TABA_N), d = (int)(gid % TABA_N); p.tabA[gid] = p.rel_bias[t5_bucket(d) * 32 + h]; }
  else { long g2 = gid - 8 * TABA_N; int hh = (int)(g2 / TABD_N), d = (int)(g2 % TABD_N); int gi = hh >> 3;
    int dil = gi == 0 ? 1 : (gi == 1 ? 4 : 16); p.tabD[g2] = p.rel_bias[t5_bucket(d * dil) * 32 + 8 + hh]; }
}
HD_ void ph_memkv(const Params& p, long gid) {
  int e = (int)(gid & 511), m = (int)((gid >> 9) & 255), l = (int)(gid >> 17);
  const float* row = p.mem + (long)m * DM;
  float ss = 0.f; _Pragma("unroll 16") for (int d = 0; d < DM; ++d) ss += row[d] * row[d];
  float r = 1.f / sqrtf(ss / DM + 1e-6f);
  float acc = 0.f;
  _Pragma("unroll 16") for (int d = 0; d < DM; ++d) acc += row[d] * r * p.m_norm[l * DM + d] * p.m_wkv[((long)l * DM + d) * 512 + e];
  stf(&p.memkv[gid], acc);
}
HD_ void ph_norm_row(const Params& p, int layer, int t, bool do_h) {
  const float* xin = (layer == 0) ? p.x + (long)t * DM : p.out + (long)t * DM;
  float* xo = p.out + (long)t * DM;
  float r1 = 0.f;
  if (layer > 0) { const float* y = p.y + (long)t * DM; float ss = 0.f; for (int d = 0; d < DM; ++d) ss += y[d] * y[d]; r1 = 1.f / sqrtf(ss / DM + 1e-6f); }
  float ss2 = 0.f;
  for (int d = 0; d < DM; ++d) { float v = xin[d]; if (layer > 0) v += p.y[(long)t * DM + d] * r1 * p.post_norm[(layer - 1) * DM + d]; xo[d] = v; ss2 += v * v; }
  if (!do_h) return;
  float r2 = 1.f / sqrtf(ss2 / DM + 1e-6f);
  for (int d = 0; d < DM; ++d) stf(&p.h[(long)t * DM + d], xo[d] * r2 * p.pre_norm[layer * DM + d]);
}

HD_ void ph_cmp_hid(const Params& p, int layer, long gid) {
  int u = (int)(gid & 127), hk = (int)((gid >> 7) & 1); long r = gid >> 8; int ncmp = p.S / 16; int j = (int)(r % ncmp), kv = (int)(r / ncmp);
  const float* w1 = p.cmp_w1 + ((long)(layer * 2 + kv) * 2048) * 128;
  const float* pe = p.cmp_pos + (long)(layer * 2 + kv) * 32 * 64;
  float acc = 0.f;
  for (int t = 0; t < 32; ++t) { int tok = 16 * j + t;
    _Pragma("unroll 16") for (int d = 0; d < 64; ++d) { float v = pe[t * 64 + d]; if (tok < p.S) v += ldf(&p.proj[(long)tok * NPROJ + PA_KV + kv * 128 + hk * 64 + d]);
      acc += v * w1[(long)(t * 64 + d) * 128 + u]; } }
  p.hid[gid] = gelu_f(acc);
}
HD_ void ph_cmp_out(const Params& p, int layer, long gid) {
  int d = (int)(gid & 63), hk = (int)((gid >> 6) & 1); long r = gid >> 7; int ncmp = p.S / 16; int j = (int)(r % ncmp), kv = (int)(r / ncmp);
  const float* w2 = p.cmp_w2 + (long)(layer * 2 + kv) * 128 * 64;
  const float* hd = p.hid + (((long)kv * ncmp + j) * 2 + hk) * 128;
  float acc = 0.f; for (int u = 0; u < 128; ++u) acc += hd[u] * w2[u * 64 + d];
  stf(&p.kvc[gid], acc);
}
HD_ void ph_a_cmp1(const Params& p, long gid) {
  int h = (int)(gid & 7), q = (int)(gid >> 3), g = h >> 2; int ncmp = p.S / 16;
  int jn = (q >= 31) ? ((q - 31) / 16 + 1) : 0;
  const SB* kc = p.kvc; const SB* vc = p.kvc + (long)ncmp * 128;
  float qv[64], o[64]; for (int d = 0; d < 64; ++d) { qv[d] = ldf(&p.proj[(long)q * NPROJ + PA_Q + h * 64 + d]); o[d] = 0.f; }
  float m = -1e30f, l = 0.f;
  for (int j = 0; j < jn; ++j) { const SB* kr = &kc[((long)j * 2 + g) * 64]; const SB* vr = &vc[((long)j * 2 + g) * 64];
    float s = 0.f; for (int d = 0; d < 64; ++d) s += qv[d] * ldf(&kr[d]);
    int dist = q - (16 * j + 31); s = s * 0.125f + p.tabA[h * TABA_N + (dist < TABA_N ? dist : TABA_N - 1)];
    float mn = fmaxf(m, s), a = expf(m - mn), pr = expf(s - mn); l = l * a + pr; for (int d = 0; d < 64; ++d) o[d] = o[d] * a + pr * ldf(&vr[d]); m = mn; }
  float il = jn > 0 ? 1.f / l : 0.f; for (int d = 0; d < 64; ++d) stf(&p.oc[(long)q * 512 + h * 64 + d], o[d] * il);
  p.cml[gid * 2] = m; p.cml[gid * 2 + 1] = il;
}
HD_ void ph_a_cmp2(const Params& p, long gid) {
  int g = (int)(gid & 1), q = (int)(gid >> 1); int ncmp = p.S / 16;
  float* imp = p.imp + gid * 256; for (int b = 0; b < 256; ++b) imp[b] = 0.f;
  int jn = (q >= 31) ? ((q - 31) / 16 + 1) : 0; const SB* kc = p.kvc;
  for (int hh = 0; hh < 4; ++hh) { int h = g * 4 + hh; float qv[64]; for (int d = 0; d < 64; ++d) qv[d] = ldf(&p.proj[(long)q * NPROJ + PA_Q + h * 64 + d]);
    float m = p.cml[((long)q * 8 + h) * 2], il = p.cml[((long)q * 8 + h) * 2 + 1];
    for (int j = 0; j < jn; ++j) { const SB* kr = &kc[((long)j * 2 + g) * 64]; float s = 0.f; for (int d = 0; d < 64; ++d) s += qv[d] * ldf(&kr[d]);
      int dist = q - (16 * j + 31); s = s * 0.125f + p.tabA[h * TABA_N + (dist < TABA_N ? dist : TABA_N - 1)]; float pr = expf(s - m) * il;
      imp[j >> 2] += pr; if (j + 1 < ncmp) imp[(j + 1) >> 2] += pr; } }
}
HD_ void ph_a_topk(const Params& p, long gid) {
  int q = (int)(gid >> 1); float* imp = p.imp + gid * 256; int* idx = p.idx + gid * 16; int cur = q >> 6;
  imp[0] = 1e4f; imp[cur] = 1e4f;
  for (int k = 0; k < 16; ++k) { int best = -1; float bv = -1.f;
    for (int b = 0; b <= cur; ++b) { float v = imp[b]; if (v > bv) { bv = v; best = b; } }
    idx[k] = best; if (best >= 0) imp[best] = -2.f; }
}
HD_ void ph_a_win(const Params& p, long gid) {
  int h = (int)(gid & 7), q = (int)(gid >> 3), hk = h >> 2;
  float qv[64], o[64]; for (int d = 0; d < 64; ++d) { qv[d] = ldf(&p.proj[(long)q * NPROJ + PA_Q + h * 64 + d]); o[d] = 0.f; }
  float m = -1e30f, l = 0.f; int lo = q - 511 < 0 ? 0 : q - 511;
  for (int t = lo; t <= q; ++t) { const SB* kr = &p.proj[(long)t * NPROJ + PA_KV + 4 * 128 + hk * 64]; const SB* vr = kr + 128;
    float s = 0.f; for (int d = 0; d < 64; ++d) s += qv[d] * ldf(&kr[d]); s = s * 0.125f + p.tabA[h * TABA_N + (q - t)];
    float mn = fmaxf(m, s), a = expf(m - mn), pr = expf(s - mn); l = l * a + pr; for (int d = 0; d < 64; ++d) o[d] = o[d] * a + pr * ldf(&vr[d]); m = mn; }
  float il = 1.f / l; for (int d = 0; d < 64; ++d) stf(&p.ow[(long)q * 512 + h * 64 + d], o[d] * il);
}
HD_ void ph_a_sel(const Params& p, long gid) {
  int h = (int)(gid & 7), q = (int)(gid >> 3), hk = h >> 2; const int* idx = p.idx + ((long)q * 2 + hk) * 16;
  float qv[64], o[64]; for (int d = 0; d < 64; ++d) { qv[d] = ldf(&p.proj[(long)q * NPROJ + PA_Q + h * 64 + d]); o[d] = 0.f; }
  float m = -1e30f, l = 0.f;
  for (int k = 0; k < 16; ++k) { int b = idx[k]; if (b < 0) continue;
    for (int i = 0; i < 64; ++i) { int t = b * 64 + i; if (t > q) break;
      const SB* kr = &p.proj[(long)t * NPROJ + PA_KV + 2 * 128 + hk * 64]; const SB* vr = kr + 128;
      float s = 0.f; for (int d = 0; d < 64; ++d) s += qv[d] * ldf(&kr[d]); int dist = q - t; s = s * 0.125f + p.tabA[h * TABA_N + (dist < TABA_N ? dist : TABA_N - 1)];
      float mn = fmaxf(m, s), a = expf(m - mn), pr = expf(s - mn); l = l * a + pr; for (int d = 0; d < 64; ++d) o[d] = o[d] * a + pr * ldf(&vr[d]); m = mn; } }
  float il = 1.f / l; const float* gl = p.small + (long)q * NSMALL + h * 3;
  float g0 = sigmoid_f(gl[0]), g1 = sigmoid_f(gl[1]), g2 = sigmoid_f(gl[2]);
  for (int d = 0; d < 64; ++d) { long c = (long)q * 512 + h * 64 + d; float a = g0 * ldf(&p.oc[c]) + g1 * o[d] * il + g2 * ldf(&p.ow[c]);
    SB* mp = &p.mix[(long)q * NMIX + MX_A + h * 64 + d]; stf(mp, a * ldf(mp)); }
}
HD_ void ph_c(const Params& p, int layer, long gid) {
  int h = (int)(gid & 7), q = (int)(gid >> 3), hk = h >> 2;
  float qv[64], o[64]; for (int d = 0; d < 64; ++d) { qv[d] = ldf(&p.proj[(long)q * NPROJ + PC_Q + h * 64 + d]); o[d] = 0.f; }
  float m = p.sinks[layer * 8 + h], l = 1.f; int lo = q - 127 < 0 ? 0 : q - 127;
  for (int t = lo; t <= q; ++t) { const SB* kr = &p.proj[(long)t * NPROJ + PC_KV + hk * 64]; const SB* vr = kr + 128;
    float s = 0.f; for (int d = 0; d < 64; ++d) s += qv[d] * ldf(&kr[d]); s *= 0.125f;
    float mn = fmaxf(m, s), a = expf(m - mn), pr = expf(s - mn); l = l * a + pr; for (int d = 0; d < 64; ++d) o[d] = o[d] * a + pr * ldf(&vr[d]); m = mn; }
  float il = 1.f / l; for (int d = 0; d < 64; ++d) { SB* mp = &p.mix[(long)q * NMIX + MX_C + h * 64 + d]; stf(mp, o[d] * il * ldf(mp)); }
}
HD_ void ph_d(const Params& p, long gid) {
  int h = (int)(gid & 7); long r = gid >> 3; int q = (int)(r % p.S), gi = (int)(r / p.S); int dil = gi == 0 ? 1 : (gi == 1 ? 4 : 16);
  float qv[64], o[64]; for (int d = 0; d < 64; ++d) { qv[d] = ldf(&p.proj[(long)q * NPROJ + PD_Q + gi * 512 + h * 64 + d]); o[d] = 0.f; }
  float m = -1e30f, l = 0.f;
  for (int dd = 0; dd <= 128; ++dd) { int t = q - dil * dd; if (t < 0) break;
    const SB* kr = &p.proj[(long)t * NPROJ + PD_KV + h * 64]; const SB* vr = kr + 512;
    float s = 0.f; for (int d = 0; d < 64; ++d) s += qv[d] * ldf(&kr[d]); s = s * 0.125f + p.tabD[(gi * 8 + h) * TABD_N + dd];
    float mn = fmaxf(m, s), a = expf(m - mn), pr = expf(s - mn); l = l * a + pr; for (int d = 0; d < 64; ++d) o[d] = o[d] * a + pr * ldf(&vr[d]); m = mn; }
  float il = 1.f / l; for (int d = 0; d < 64; ++d) stf(&p.dop[((long)gi * p.S + q) * 512 + h * 64 + d], o[d] * il);
  p.dlse[((long)gi * p.S + q) * 8 + h] = m + logf(l);
}
HD_ void ph_d_merge(const Params& p, long gid) {
  int h = (int)(gid & 7), q = (int)(gid >> 3);
  float l0 = p.dlse[((long)0 * p.S + q) * 8 + h], l1 = p.dlse[((long)1 * p.S + q) * 8 + h], l2 = p.dlse[((long)2 * p.S + q) * 8 + h];
  float mm = fmaxf(l0, fmaxf(l1, l2)); float e0 = expf(l0 - mm), e1 = expf(l1 - mm), e2 = expf(l2 - mm), is = 1.f / (e0 + e1 + e2);
  for (int d = 0; d < 64; ++d) { long c = (long)q * 512 + h * 64 + d;
    float v = (e0 * ldf(&p.dop[c]) + e1 * ldf(&p.dop[(long)p.S * 512 + c]) + e2 * ldf(&p.dop[(long)2 * p.S * 512 + c])) * is;
    SB* mp = &p.mix[(long)q * NMIX + MX_D + h * 64 + d]; stf(mp, v * ldf(mp)); }
}
HD_ void ph_m(const Params& p, int layer, long gid) {
  int h = (int)(gid & 3), q = (int)(gid >> 2);
  float qv[64], o[64]; for (int d = 0; d < 64; ++d) { qv[d] = ldf(&p.proj[(long)q * NPROJ + PM_Q + h * 64 + d]); o[d] = 0.f; }
  float m = -1e30f, l = 0.f; const SB* kvb = p.memkv + (long)layer * 256 * 512;
  for (int t = 0; t < 256; ++t) { const SB* kr = kvb + (long)t * 512 + h * 64; const SB* vr = kr + 256;
    float s = 0.f; for (int d = 0; d < 64; ++d) s += qv[d] * ldf(&kr[d]); s *= 0.125f;
    float mn = fmaxf(m, s), a = expf(m - mn), pr = expf(s - mn); l = l * a + pr; for (int d = 0; d < 64; ++d) o[d] = o[d] * a + pr * ldf(&vr[d]); m = mn; }
  float il = 1.f / l; for (int d = 0; d < 64; ++d) { SB* mp = &p.mix[(long)q * NMIX + MX_M + h * 64 + d]; stf(mp, o[d] * il * ldf(mp)); }
}
HD_ void ph_b_conv(const Params& p, int layer, long gid) {
  int c = (int)(gid & 1023), t = (int)(gid >> 10); const float* w = p.conv_w + (long)layer * 4 * 1024;
  float acc = p.conv_b[layer * 1024 + c];
  for (int i = 0; i < 4; ++i) { int tt = t - 3 + i; if (tt >= 0) acc += w[i * 1024 + c] * ldf(&p.proj[(long)tt * NPROJ + PB_X + c]); }
  stf(&p.xconv[gid], silu_f(acc));
}
HD_ void ph_b_dt(const Params& p, int layer, long gid) {
  int hd = (int)(gid & 7), c = (int)(gid >> 3); float a = -expf(p.a_log[layer * 8 + hd]); float cs = 0.f;
  for (int l = 0; l < 128; ++l) { int t = c * 128 + l; float dt = softplus_f(p.small[(long)t * NSMALL + 24 + hd] + p.dt_bias[layer * 8 + hd]);
    cs += dt * a; p.dt[(long)t * 8 + hd] = dt; p.acs[(long)t * 8 + hd] = cs; }
}
HD_ void ph_b_cb(const Params& p, long gid) {
  int s = (int)(gid & 127), l = (int)((gid >> 7) & 127), g = (int)((gid >> 14) & 1), c = (int)(gid >> 15);
  if (s > l) { p.cb[gid] = 0.f; return; }
  const SB* cm = &p.xconv[(long)(c * 128 + l) * 1024 + 768 + g * 128]; const SB* bm = &p.xconv[(long)(c * 128 + s) * 1024 + 512 + g * 128];
  float acc = 0.f; for (int n = 0; n < 128; ++n) acc += ldf(&cm[n]) * ldf(&bm[n]);
  p.cb[gid] = acc;
}
HD_ void ph_b_states(const Params& p, long gid) {
  int n = (int)(gid & 127), pp = (int)((gid >> 7) & 63), hd = (int)((gid >> 13) & 7), c = (int)(gid >> 16), g = hd >> 2;
  float last = p.acs[(long)(c * 128 + 127) * 8 + hd]; float acc = 0.f;
  for (int l = 0; l < 128; ++l) { long t = c * 128 + l;
    acc += ldf(&p.xconv[t * 1024 + 512 + g * 128 + n]) * expf(last - p.acs[t * 8 + hd]) * ldf(&p.xconv[t * 1024 + hd * 64 + pp]) * p.dt[t * 8 + hd]; }
  p.states[gid] = acc;
}
HD_ void ph_b_scan(const Params& p, long gid) {
  int hd = (int)(gid >> 13); int nc = p.S / 128; float h = 0.f;
  for (int c0 = 0; c0 < nc; c0 += 8) { float st[8], dc[8];
    for (int i = 0; i < 8; ++i) { st[i] = p.states[(long)(c0 + i) * 65536 + gid]; dc[i] = p.acs[(long)((c0 + i) * 128 + 127) * 8 + hd]; }
    for (int i = 0; i < 8; ++i) { p.states[(long)(c0 + i) * 65536 + gid] = h; h = h * expf(dc[i]) + st[i]; } }
}
HD_ void ph_b_out(const Params& p, int layer, long gid) {
  int pp = (int)(gid & 63), hd = (int)((gid >> 6) & 7), t = (int)(gid >> 9), g = hd >> 2, c = t >> 7, l = t & 127;
  float al = p.acs[(long)t * 8 + hd]; float acc = 0.f;
  const float* cbr = &p.cb[(((long)c * 2 + g) * 128 + l) * 128];
  for (int s = 0; s <= l; ++s) { long ts = c * 128 + s; acc += cbr[s] * expf(al - p.acs[ts * 8 + hd]) * ldf(&p.xconv[ts * 1024 + hd * 64 + pp]) * p.dt[ts * 8 + hd]; }
  float acc2 = 0.f; const float* pr = &p.states[(long)c * 65536 + ((long)hd * 64 + pp) * 128]; const SB* cm = &p.xconv[(long)t * 1024 + 768 + g * 128];
  for (int n = 0; n < 128; ++n) acc2 += ldf(&cm[n]) * pr[n];
  p.ybuf[gid] = acc + expf(al) * acc2 + ldf(&p.xconv[(long)t * 1024 + hd * 64 + pp]) * p.b_d[layer * 8 + hd];
}
HD_ void ph_b_norm(const Params& p, int layer, long gid) {
  int g = (int)(gid & 1), t = (int)(gid >> 1); float ss = 0.f;
  for (int i = 0; i < 256; ++i) { float v = p.ybuf[(long)t * 512 + g * 256 + i] * ldf(&p.mix[(long)t * NMIX + MX_B + g * 256 + i]); ss += v * v; }
  float r = 1.f / sqrtf(ss / 256.f + 1e-6f);
  for (int i = 0; i < 256; ++i) { SB* mp = &p.mix[(long)t * NMIX + MX_B + g * 256 + i]; float v = p.ybuf[(long)t * 512 + g * 256 + i] * ldf(mp);
    stf(mp, v * r * p.b_norm[layer * 512 + g * 256 + i]); }
}

HD_ void ph_b_dt2(const Params& p, int layer, long gid) {
  int hd = (int)(gid & 7), c = (int)(gid >> 3); float a = -expf(p.a_log[layer * 8 + hd]); float cs = 0.f;
  for (int l = 0; l < 128; ++l) { int t = c * 128 + l; float dt = softplus_f(p.small[(long)t * NSMALL + 24 + hd] + p.dt_bias[layer * 8 + hd]);
    cs += dt * a; p.dt[(long)t * 8 + hd] = dt; p.acs[(long)t * 8 + hd] = cs; }
  for (int l = 0; l < 128; ++l) { long t = c * 128 + l; p.wst[t * 8 + hd] = p.dt[t * 8 + hd] * expf(cs - p.acs[t * 8 + hd]); }
}
HD_ void ph_b_states2(const Params& p, long gid) {
  int pp = (int)(gid & 63), n = (int)((gid >> 6) & 127), hd = (int)((gid >> 13) & 7), c = (int)(gid >> 16), g = hd >> 2;
  float acc = 0.f;
  _Pragma("unroll 16") for (int l = 0; l < 128; ++l) { long t = c * 128 + l; acc += ldf(&p.xconv[t * 1024 + 512 + g * 128 + n]) * p.wst[t * 8 + hd] * ldf(&p.xconv[t * 1024 + hd * 64 + pp]); }
  p.states[gid] = acc;
}
HD_ void ph_b_out2(const Params& p, int layer, long gid) {
  int pp = (int)(gid & 63), hd = (int)((gid >> 6) & 7), t = (int)(gid >> 9), g = hd >> 2, c = t >> 7, l = t & 127;
  float al = p.acs[(long)t * 8 + hd]; float acc = 0.f;
  const float* cbr = &p.cb[(((long)c * 2 + g) * 128 + l) * 128];
  _Pragma("unroll 8") for (int s = 0; s <= l; ++s) { long ts = c * 128 + s; acc += cbr[s] * expf(al - p.acs[ts * 8 + hd]) * p.dt[ts * 8 + hd] * ldf(&p.xconv[ts * 1024 + hd * 64 + pp]); }
  float acc2 = 0.f; const float* pr = &p.states[(long)c * 65536 + (long)hd * 8192 + pp]; const SB* cm = &p.xconv[(long)t * 1024 + 768 + g * 128];
  _Pragma("unroll 16") for (int n = 0; n < 128; ++n) acc2 += ldf(&cm[n]) * pr[n * 64];
  p.ybuf[gid] = acc + expf(al) * acc2 + ldf(&p.xconv[(long)t * 1024 + hd * 64 + pp]) * p.b_d[layer * 8 + hd];
}

typedef __attribute__((ext_vector_type(8))) short bf16x8;
typedef __attribute__((ext_vector_type(16))) float f32x16;
typedef short v4i16_t __attribute__((ext_vector_type(4)));
typedef __bf16 bf2_t __attribute__((ext_vector_type(2)));
typedef float f2_t __attribute__((ext_vector_type(2)));
typedef unsigned u32x4 __attribute__((ext_vector_type(4)));
#define LDS3 __attribute__((address_space(3)))
typedef __attribute__((address_space(1))) const void* gptr_t;
typedef __attribute__((address_space(3))) void* lptr_t;
#define L2E 1.4426950408889634f
#define LN2 0.6931471805599453f
#define QSC (0.125f * L2E)
#ifndef FTHR
#define FTHR 8.0f
#endif
#define NINF (-__builtin_huge_valf())

struct WaveLds { unsigned short v[4096]; float tab[640]; float xch[32]; float pad[32]; };

__device__ __forceinline__ unsigned pk2(float a, float b) { f2_t v = {a, b}; bf2_t r = __builtin_convertvector(v, bf2_t); return __builtin_bit_cast(unsigned, r); }
__device__ __forceinline__ int crow(int e, int hi) { return (e & 3) + 8 * (e >> 2) + 4 * hi; }
__device__ __forceinline__ bf16x8 pack8(const f32x16& s, int o) {
  u32x4 r; r[0] = pk2(s[o], s[o + 1]); r[1] = pk2(s[o + 2], s[o + 3]); r[2] = pk2(s[o + 4], s[o + 5]); r[3] = pk2(s[o + 6], s[o + 7]); return __builtin_bit_cast(bf16x8, r); }
__device__ __forceinline__ f32x16 zero16() { f32x16 z;
#pragma unroll
  for (int e = 0; e < 16; ++e) z[e] = 0.f; return z; }
#define MFMA32(a, b, c) __builtin_amdgcn_mfma_f32_32x32x16_bf16((a), (b), (c), 0, 0, 0)

__device__ __forceinline__ float xor32_f(float v) { const auto rr = __builtin_amdgcn_permlane32_swap(__float_as_uint(v), __float_as_uint(v), false, false); const int hi_ = (int)(threadIdx.x & 32u); return __uint_as_float(hi_ ? rr[0] : rr[1]); }
struct FlashState { f32x16 o0, o1; float m, l; };
__device__ __forceinline__ float wave_sum_f(float v) {
#pragma unroll
  for (int o = 32; o > 0; o >>= 1) v += __shfl_xor(v, o);
  return v; }

__device__ __forceinline__ void flash_core1(FlashState& st, f32x16& s, const unsigned short* vimg, float* xch, int lane) {
  const int r32 = lane & 31, hi = lane >> 5;
  float mx = s[0];
#pragma unroll
  for (int e = 1; e < 16; ++e) mx = fmaxf(mx, s[e]);
  mx = fmaxf(mx, xor32_f(mx));
  if (__any(mx > st.m + FTHR)) {
    const float mn = fmaxf(st.m, mx); const float al = __builtin_amdgcn_exp2f(st.m - mn); st.m = mn; st.l *= al; xch[r32] = al;
#pragma unroll
    for (int e = 0; e < 16; ++e) { const float a = xch[crow(e, hi)]; st.o0[e] *= a; st.o1[e] *= a; }
  }
  float ps = 0.f;
#pragma unroll
  for (int e = 0; e < 16; ++e) { s[e] = __builtin_amdgcn_exp2f(s[e] - st.m); ps += s[e]; }
  st.l += ps;
  const bf16x8 pa0 = pack8(s, 0), pa1 = pack8(s, 8);
  const unsigned short* vb = vimg + (4 * hi + ((lane & 15) >> 2)) * 32 + ((lane >> 4) & 1) * 16 + (lane & 3) * 4;
#pragma unroll
  for (int s2 = 0; s2 < 2; ++s2) {
#pragma unroll
    for (int db = 0; db < 2; ++db) {
      const v4i16_t lo = __builtin_amdgcn_ds_read_tr16_b64_v4i16((LDS3 v4i16_t*)(vb + db * 2048 + s2 * 512));
      const v4i16_t hh = __builtin_amdgcn_ds_read_tr16_b64_v4i16((LDS3 v4i16_t*)(vb + db * 2048 + s2 * 512 + 256));
      const bf16x8 vf = {lo[0], lo[1], lo[2], lo[3], hh[0], hh[1], hh[2], hh[3]};
      if (db == 0) st.o0 = MFMA32(s2 ? pa1 : pa0, vf, st.o0); else st.o1 = MFMA32(s2 ? pa1 : pa0, vf, st.o1);
    }
  }
}
__device__ __forceinline__ void flash_core1_lin(FlashState& st, f32x16& s, float qs, float bb, const unsigned short* vimg, float* xch, int lane) {
  const int r32 = lane & 31, hi = lane >> 5;
  float mr = s[0];
#pragma unroll
  for (int e = 1; e < 16; ++e) mr = fmaxf(mr, s[e]);
  float mx = __builtin_fmaf(mr, qs, bb);
  mx = fmaxf(mx, xor32_f(mx));
  if (__any(mx > st.m + FTHR)) {
    const float mn = fmaxf(st.m, mx); const float al = __builtin_amdgcn_exp2f(st.m - mn); st.m = mn; st.l *= al; xch[r32] = al;
#pragma unroll
    for (int e = 0; e < 16; ++e) { const float a = xch[crow(e, hi)]; st.o0[e] *= a; st.o1[e] *= a; }
  }
  const float bm = bb - st.m; float ps = 0.f;
#pragma unroll
  for (int e = 0; e < 16; ++e) { s[e] = __builtin_amdgcn_exp2f(__builtin_fmaf(s[e], qs, bm)); ps += s[e]; }
  st.l += ps;
  const bf16x8 pa0 = pack8(s, 0), pa1 = pack8(s, 8);
  const unsigned short* vb = vimg + (4 * hi + ((lane & 15) >> 2)) * 32 + ((lane >> 4) & 1) * 16 + (lane & 3) * 4;
#pragma unroll
  for (int s2 = 0; s2 < 2; ++s2) {
#pragma unroll
    for (int db = 0; db < 2; ++db) {
      const v4i16_t lo = __builtin_amdgcn_ds_read_tr16_b64_v4i16((LDS3 v4i16_t*)(vb + db * 2048 + s2 * 512));
      const v4i16_t hh = __builtin_amdgcn_ds_read_tr16_b64_v4i16((LDS3 v4i16_t*)(vb + db * 2048 + s2 * 512 + 256));
      const bf16x8 vf = {lo[0], lo[1], lo[2], lo[3], hh[0], hh[1], hh[2], hh[3]};
      if (db == 0) st.o0 = MFMA32(s2 ? pa1 : pa0, vf, st.o0); else st.o1 = MFMA32(s2 ? pa1 : pa0, vf, st.o1);
    }
  }
}
template <class VRow, class Fix>
__device__ __forceinline__ void flash_tile(FlashState& st, const bf16x8 (&qf)[4], const SB* kp, VRow vrow, Fix fix, WaveLds* L, int lane) {
  const int r32 = lane & 31, hi = lane >> 5;
  bf16x8 kf[4];
#pragma unroll
  for (int d0 = 0; d0 < 4; ++d0) kf[d0] = *(const bf16x8*)(kp + d0 * 16 + hi * 8);
#pragma unroll
  for (int i = 0; i < 4; ++i) { const int c = lane + 64 * i, key = c >> 3, ch = c & 7; const SB* vp = vrow(key); const uint4 vv = *(const uint4*)(vp + ch * 8);
    *(uint4*)&L->v[(ch >> 2) * 2048 + key * 32 + (ch & 3) * 8] = vv; }
  f32x16 s = zero16();
#pragma unroll
  for (int d0 = 0; d0 < 4; ++d0) s = MFMA32(kf[d0], qf[d0], s);
  fix(s);
  flash_core1(st, s, L->v, L->xch, lane);
}
__device__ __forceinline__ void flash_core2(FlashState& st, f32x16& s0, f32x16& s1, const unsigned short* vimg, float* xch, int lane) {
  const int r32 = lane & 31, hi = lane >> 5;
  float mx = fmaxf(s0[0], s1[0]);
#pragma unroll
  for (int e = 1; e < 16; ++e) mx = fmaxf(mx, fmaxf(s0[e], s1[e]));
  mx = fmaxf(mx, xor32_f(mx));
  if (__any(mx > st.m + FTHR)) {
    const float mn = fmaxf(st.m, mx); const float al = __builtin_amdgcn_exp2f(st.m - mn); st.m = mn; st.l *= al; xch[r32] = al;
#pragma unroll
    for (int e = 0; e < 16; ++e) { const float a = xch[crow(e, hi)]; st.o0[e] *= a; st.o1[e] *= a; }
  }
  float ps = 0.f;
#pragma unroll
  for (int e = 0; e < 16; ++e) { s0[e] = __builtin_amdgcn_exp2f(s0[e] - st.m); s1[e] = __builtin_amdgcn_exp2f(s1[e] - st.m); ps += s0[e] + s1[e]; }
  st.l += ps;
  bf16x8 pa[4]; pa[0] = pack8(s0, 0); pa[1] = pack8(s0, 8); pa[2] = pack8(s1, 0); pa[3] = pack8(s1, 8);
  const unsigned short* vb = vimg + (4 * hi + ((lane & 15) >> 2)) * 32 + ((lane >> 4) & 1) * 16 + (lane & 3) * 4;
#pragma unroll
  for (int kk = 0; kk < 4; ++kk) {
#pragma unroll
    for (int db = 0; db < 2; ++db) {
      const v4i16_t lo = __builtin_amdgcn_ds_read_tr16_b64_v4i16((LDS3 v4i16_t*)(vb + db * 2048 + kk * 512));
      const v4i16_t hh = __builtin_amdgcn_ds_read_tr16_b64_v4i16((LDS3 v4i16_t*)(vb + db * 2048 + kk * 512 + 256));
      const bf16x8 vf = {lo[0], lo[1], lo[2], lo[3], hh[0], hh[1], hh[2], hh[3]};
      if (db == 0) st.o0 = MFMA32(pa[kk], vf, st.o0); else st.o1 = MFMA32(pa[kk], vf, st.o1);
    }
  }
}
__device__ __forceinline__ void flash_core2_lin(FlashState& st, f32x16& s0, f32x16& s1, float qs, float bb, const unsigned short* vimg, float* xch, int lane) {
  const int r32 = lane & 31, hi = lane >> 5;
  float mr = fmaxf(s0[0], s1[0]);
#pragma unroll
  for (int e = 1; e < 16; ++e) mr = fmaxf(mr, fmaxf(s0[e], s1[e]));
  float mx = __builtin_fmaf(mr, qs, bb);
  mx = fmaxf(mx, xor32_f(mx));
  if (__any(mx > st.m + FTHR)) {
    const float mn = fmaxf(st.m, mx); const float al = __builtin_amdgcn_exp2f(st.m - mn); st.m = mn; st.l *= al; xch[r32] = al;
#pragma unroll
    for (int e = 0; e < 16; ++e) { const float a = xch[crow(e, hi)]; st.o0[e] *= a; st.o1[e] *= a; }
  }
  const float bm = bb - st.m; float ps = 0.f;
#pragma unroll
  for (int e = 0; e < 16; ++e) { s0[e] = __builtin_amdgcn_exp2f(__builtin_fmaf(s0[e], qs, bm)); s1[e] = __builtin_amdgcn_exp2f(__builtin_fmaf(s1[e], qs, bm)); ps += s0[e] + s1[e]; }
  st.l += ps;
  bf16x8 pa[4]; pa[0] = pack8(s0, 0); pa[1] = pack8(s0, 8); pa[2] = pack8(s1, 0); pa[3] = pack8(s1, 8);
  const unsigned short* vb = vimg + (4 * hi + ((lane & 15) >> 2)) * 32 + ((lane >> 4) & 1) * 16 + (lane & 3) * 4;
#pragma unroll
  for (int kk = 0; kk < 4; ++kk) {
#pragma unroll
    for (int db = 0; db < 2; ++db) {
      const v4i16_t lo = __builtin_amdgcn_ds_read_tr16_b64_v4i16((LDS3 v4i16_t*)(vb + db * 2048 + kk * 512));
      const v4i16_t hh = __builtin_amdgcn_ds_read_tr16_b64_v4i16((LDS3 v4i16_t*)(vb + db * 2048 + kk * 512 + 256));
      const bf16x8 vf = {lo[0], lo[1], lo[2], lo[3], hh[0], hh[1], hh[2], hh[3]};
      if (db == 0) st.o0 = MFMA32(pa[kk], vf, st.o0); else st.o1 = MFMA32(pa[kk], vf, st.o1);
    }
  }
}
#ifndef FT2
#define FT2 1
#endif
template <class VRow, class Fix0, class Fix1>
__device__ __forceinline__ void flash_tile2(FlashState& st, const bf16x8 (&qf)[4], const SB* kp0, const SB* kp1, VRow vrow, Fix0 fix0, Fix1 fix1, WaveLds* L, int lane) {
  if (!FT2) { flash_tile(st, qf, kp0, [&](int key) { return vrow(key); }, fix0, L, lane); flash_tile(st, qf, kp1, [&](int key) { return vrow(key + 32); }, fix1, L, lane); return; }
  const int hi = lane >> 5;
  bf16x8 kf0[4], kf1[4];
#pragma unroll
  for (int d0 = 0; d0 < 4; ++d0) { kf0[d0] = *(const bf16x8*)(kp0 + d0 * 16 + hi * 8); kf1[d0] = *(const bf16x8*)(kp1 + d0 * 16 + hi * 8); }
#pragma unroll
  for (int i = 0; i < 8; ++i) { const int c = lane + 64 * i, key = c >> 3, ch = c & 7; const SB* vp = vrow(key); const uint4 vv = *(const uint4*)(vp + ch * 8);
    *(uint4*)&L->v[(ch >> 2) * 2048 + key * 32 + (ch & 3) * 8] = vv; }
  f32x16 s0 = zero16(), s1 = zero16();
#pragma unroll
  for (int d0 = 0; d0 < 4; ++d0) { s0 = MFMA32(kf0[d0], qf[d0], s0); s1 = MFMA32(kf1[d0], qf[d0], s1); }
  fix0(s0); fix1(s1);
  flash_core2(st, s0, s1, L->v, L->xch, lane);
}
template <class KPtr, class VRow, class Fix>
__device__ __forceinline__ void flash_run(FlashState& st, const bf16x8 (&qf)[4], int t0, int t1, KPtr kptr, VRow vrow, Fix fix, WaveLds* L, int lane) {
  if (t0 >= t1) return;
  const int hi = lane >> 5; bf16x8 kfn[4];
#define FR_ISSUE(tt) { const int t_ = (tt); _Pragma("unroll") for (int i_ = 0; i_ < 4; ++i_) { const int db_ = i_ >> 1, key_ = (i_ & 1) * 16 + (lane >> 2), wi_ = lane & 3; \
      __builtin_amdgcn_global_load_lds((gptr_t)(vrow(t_, key_) + db_ * 32 + wi_ * 8), (lptr_t)&L->v[db_ * 2048 + (t_ & 1) * 1024 + (i_ & 1) * 512], 16, 0, 0); } \
    const SB* kp_ = kptr(t_); _Pragma("unroll") for (int d0_ = 0; d0_ < 4; ++d0_) kfn[d0_] = *(const bf16x8*)(kp_ + d0_ * 16 + hi * 8); }
  FR_ISSUE(t0)
  for (int t = t0; t < t1; ++t) {
    asm volatile("s_waitcnt vmcnt(0)" ::: "memory");
    bf16x8 kf[4];
#pragma unroll
    for (int d0 = 0; d0 < 4; ++d0) kf[d0] = kfn[d0];
    if (t + 1 < t1) FR_ISSUE(t + 1)
    f32x16 s = zero16();
#pragma unroll
    for (int d0 = 0; d0 < 4; ++d0) s = MFMA32(kf[d0], qf[d0], s);
    fix(t, s);
    flash_core1(st, s, L->v + (t & 1) * 1024, L->xch, lane);
  }
#undef FR_ISSUE
}
__device__ __forceinline__ float flash_finish(FlashState& st, WaveLds* L, int lane) {
  const int r32 = lane & 31, hi = lane >> 5;
  const float lt = st.l + xor32_f(st.l); const float inv = lt > 0.f ? 1.f / lt : 0.f;
  L->xch[r32] = inv;
#pragma unroll
  for (int e = 0; e < 16; ++e) { const float a = L->xch[crow(e, hi)]; st.o0[e] *= a; st.o1[e] *= a; }
  return (st.m + __builtin_amdgcn_logf(lt)) * LN2;
}
__device__ __forceinline__ void load_q(bf16x8 (&qf)[4], const SB* qp, int hi) {
#pragma unroll
  for (int d0 = 0; d0 < 4; ++d0) qf[d0] = *(const bf16x8*)(qp + d0 * 16 + hi * 8);
}
__device__ __forceinline__ void fix_tab(f32x16& s, const WaveLds* L, int base, int lane, bool chk, int kb) {
  const int r32 = lane & 31, hi = lane >> 5; const float* tp = L->tab + base + r32 + 32 - 4 * hi;
#pragma unroll
  for (int e = 0; e < 16; ++e) { const int kk = (e & 3) + 8 * (e >> 2); float v = s[e] * QSC + tp[-kk]; if (chk && (kb + kk + 4 * hi < 0)) v = NINF; s[e] = v; }
}

__device__ __forceinline__ void unit_c(const Params& p, int layer, int u, WaveLds* L, int lane) {
  const int h = u & 7, qt = u >> 3, q0 = qt * 32, hk = h >> 2, r32 = lane & 31, hi = lane >> 5;
  for (int x = lane; x < 192; x += 64) { const int dist = x - 32; L->tab[x] = (dist >= 0 && dist <= 127) ? 0.f : NINF; }
  bf16x8 qf[4]; load_q(qf, p.proj + (long)(q0 + r32) * NPROJ + PC_Q + h * 64, hi);
  FlashState st; st.o0 = zero16(); st.o1 = zero16(); st.m = p.sinks[layer * 8 + h] * L2E; st.l = hi ? 0.f : 1.f;
  const SB* kvb = p.proj + PC_KV + hk * 64; const bool chk = q0 < 128;
  flash_run(st, qf, 0, 5, [&](int t) { int tok = q0 - 128 + 32 * t + r32; tok = tok < 0 ? 0 : tok; return kvb + (long)tok * NPROJ; },
            [&](int t, int key) { int tk = q0 - 128 + 32 * t + key; tk = tk < 0 ? 0 : tk; return kvb + 128 + (long)tk * NPROJ; },
            [&](int t, f32x16& s) { fix_tab(s, L, 128 - 32 * t, lane, chk, q0 - 128 + 32 * t); }, L, lane);
  flash_finish(st, L, lane);
#pragma unroll
  for (int e = 0; e < 16; ++e) { SB* mp = p.mix + (long)(q0 + crow(e, hi)) * NMIX + MX_C + h * 64 + r32; mp[0] = f2bf(st.o0[e] * bf2f(mp[0])); mp[32] = f2bf(st.o1[e] * bf2f(mp[32])); }
}
__device__ __forceinline__ void unit_m(const Params& p, int layer, int u, WaveLds* L, int lane) {
  const int h = u & 3, qt = u >> 2, q0 = qt * 32, r32 = lane & 31, hi = lane >> 5;
  bf16x8 qf[4]; load_q(qf, p.proj + (long)(q0 + r32) * NPROJ + PM_Q + h * 64, hi);
  FlashState st; st.o0 = zero16(); st.o1 = zero16(); st.m = -1e30f; st.l = 0.f;
  const SB* kb = p.memkv + (long)layer * 256 * 512 + h * 64;
  flash_run(st, qf, 0, 8, [&](int t) { return kb + (long)(32 * t + r32) * 512; }, [&](int t, int key) { return kb + 256 + (long)(32 * t + key) * 512; },
            [&](int, f32x16& s) {
#pragma unroll
              for (int e = 0; e < 16; ++e) s[e] *= QSC; }, L, lane);
  flash_finish(st, L, lane);
#pragma unroll
  for (int e = 0; e < 16; ++e) { SB* mp = p.mix + (long)(q0 + crow(e, hi)) * NMIX + MX_M + h * 64 + r32; mp[0] = f2bf(st.o0[e] * bf2f(mp[0])); mp[32] = f2bf(st.o1[e] * bf2f(mp[32])); }
}
__device__ __forceinline__ void unit_awin(const Params& p, int u, WaveLds* L, int lane) {
  const int h = u & 7, qt = u >> 3, q0 = qt * 32, hk = h >> 2, r32 = lane & 31, hi = lane >> 5;
  { float tv[10];
#pragma unroll
    for (int i = 0; i < 10; ++i) { const int dist = lane + 64 * i - 32; const int dc = dist < 0 ? 0 : (dist > 511 ? 511 : dist); tv[i] = p.tabA[h * TABA_N + dc]; }
#pragma unroll
    for (int i = 0; i < 10; ++i) { const int x = lane + 64 * i, dist = x - 32; if (x < 608) L->tab[x] = (dist >= 0 && dist <= 511) ? tv[i] * L2E : NINF; } }
  bf16x8 qf[4]; load_q(qf, p.proj + (long)(q0 + r32) * NPROJ + PA_Q + h * 64, hi);
  FlashState st; st.o0 = zero16(); st.o1 = zero16(); st.m = -1e30f; st.l = 0.f;
  const SB* kvb = p.proj + PA_KV + 4 * 128 + hk * 64; const bool chk = q0 < 512;
  { int tfirst = 0; if (q0 < 512) tfirst = (512 - q0) / 32 - 0; if (tfirst > 16) tfirst = 16; if (q0 < 512 && (q0 - 512 + 32 * tfirst + 31) < 0) ++tfirst;
    flash_run(st, qf, tfirst, 17, [&](int t) { int tok = q0 - 512 + 32 * t + r32; tok = tok < 0 ? 0 : tok; return kvb + (long)tok * NPROJ; },
              [&](int t, int key) { int tk = q0 - 512 + 32 * t + key; tk = tk < 0 ? 0 : tk; return kvb + 128 + (long)tk * NPROJ; },
              [&](int t, f32x16& s) { fix_tab(s, L, 512 - 32 * t, lane, chk, q0 - 512 + 32 * t); }, L, lane); }
  flash_finish(st, L, lane);
#pragma unroll
  for (int e = 0; e < 16; ++e) { SB* op = p.ow + (long)(q0 + crow(e, hi)) * 512 + h * 64 + r32; op[0] = f2bf(st.o0[e]); op[32] = f2bf(st.o1[e]); }
}
__device__ __forceinline__ void unit_d(const Params& p, int u, WaveLds* L, int lane) {
  const int S = p.S, per = (S / 32) * 8; const int gi = u / per, u2 = u % per; const int h = u2 & 7, v = u2 >> 3;
  const int dil = gi == 0 ? 1 : (gi == 1 ? 4 : 16); const int it = v / dil, r = v % dil, i0 = it * 32;
  const int r32 = lane & 31, hi = lane >> 5;
  { float tv[3];
#pragma unroll
    for (int i = 0; i < 3; ++i) { const int dd = lane + 64 * i - 32; const int dc = dd < 0 ? 0 : (dd > 128 ? 128 : dd); tv[i] = p.tabD[(gi * 8 + h) * TABD_N + dc]; }
#pragma unroll
    for (int i = 0; i < 3; ++i) { const int x = lane + 64 * i, dd = x - 32; L->tab[x] = (dd >= 0 && dd <= 128) ? tv[i] * L2E : NINF; } }
  bf16x8 qf[4]; load_q(qf, p.proj + (long)(r + dil * (i0 + r32)) * NPROJ + PD_Q + gi * 512 + h * 64, hi);
  FlashState st; st.o0 = zero16(); st.o1 = zero16(); st.m = -1e30f; st.l = 0.f;
  const SB* kvb = p.proj + PD_KV + h * 64; const bool chk = i0 < 128;
  flash_run(st, qf, 0, 5, [&](int t) { int j = i0 - 128 + 32 * t + r32; j = j < 0 ? 0 : j; return kvb + (long)(r + dil * j) * NPROJ; },
            [&](int t, int key) { int jj = i0 - 128 + 32 * t + key; jj = jj < 0 ? 0 : jj; return kvb + 512 + (long)(r + dil * jj) * NPROJ; },
            [&](int t, f32x16& s) { fix_tab(s, L, 128 - 32 * t, lane, chk, i0 - 128 + 32 * t); }, L, lane);
  const float lse = flash_finish(st, L, lane);
#pragma unroll
  for (int e = 0; e < 16; ++e) { const long tok = r + dil * (i0 + crow(e, hi)); SB* op = p.dop + ((long)gi * S + tok) * 512 + h * 64 + r32; op[0] = f2bf(st.o0[e]); op[32] = f2bf(st.o1[e]); }
  if (hi == 0) p.dlse[((long)gi * S + r + dil * (i0 + r32)) * 8 + h] = lse;
}
__device__ __forceinline__ void fix_cmp(f32x16& s, const Params& p, int h, int q0, int t, int lane) {
  const int r32 = lane & 31, hi = lane >> 5; const int dq = q0 + r32 - 31 - 16 * (32 * t + 4 * hi);
  const bool far = (q0 - 16 * (32 * t + 31) - 31) >= 1513; const float c31 = p.tabA[h * TABA_N + 2047] * L2E;
#pragma unroll
  for (int e = 0; e < 16; ++e) { const int kk = (e & 3) + 8 * (e >> 2); const int dist = dq - 16 * kk; float b;
    if (far) b = c31; else { const int dc = dist < 0 ? 0 : (dist > 2047 ? 2047 : dist); b = p.tabA[h * TABA_N + dc] * L2E; }
    s[e] = dist < 0 ? NINF : s[e] * QSC + b; }
}
__device__ __forceinline__ void unit_acmp1(const Params& p, int u, WaveLds* L, int lane) {
  const int h = u & 7, qt = (p.S / 32 - 1) - (u >> 3), q0 = qt * 32, g = h >> 2, r32 = lane & 31, hi = lane >> 5; const int ncmp = p.S / 16;
  bf16x8 qf[4]; load_q(qf, p.proj + (long)(q0 + r32) * NPROJ + PA_Q + h * 64, hi);
  FlashState st; st.o0 = zero16(); st.o1 = zero16(); st.m = -1e30f; st.l = 0.f;
  const int jn = q0 / 16 + 1, nt = (jn + 31) / 32; const SB* kc = p.kvc + g * 64; const SB* vc = p.kvc + (long)ncmp * 128 + g * 64;
  flash_run(st, qf, 0, nt, [&](int t) { int j = 32 * t + r32; j = j >= ncmp ? ncmp - 1 : j; return kc + (long)j * 128; },
            [&](int t, int key) { int jj = 32 * t + key; jj = jj >= ncmp ? ncmp - 1 : jj; return vc + (long)jj * 128; },
            [&](int t, f32x16& s) { fix_cmp(s, p, h, q0, t, lane); }, L, lane);
  const float lt = st.l + xor32_f(st.l); const float inv = lt > 0.f ? 1.f / lt : 0.f;
  flash_finish(st, L, lane);
#pragma unroll
  for (int e = 0; e < 16; ++e) { SB* op = p.oc + (long)(q0 + crow(e, hi)) * 512 + h * 64 + r32; op[0] = f2bf(st.o0[e]); op[32] = f2bf(st.o1[e]); }
  if (hi == 0) { p.cml[((long)(q0 + r32) * 8 + h) * 2] = st.m; p.cml[((long)(q0 + r32) * 8 + h) * 2 + 1] = inv; }
}
__device__ __forceinline__ void unit_acmp2(const Params& p, int u, int lane) {
  const int part = u & 3, g = (u >> 2) & 1, qt = (p.S / 32 - 1) - (u >> 3), q0 = qt * 32, r32 = lane & 31, hi = lane >> 5; const int ncmp = p.S / 16;
  const int jn = q0 / 16 + 1, nt = (jn + 31) / 32; const SB* kc = p.kvc + g * 64; float carry = 0.f;
  const int tper = (nt + 3) >> 2, tbeg = part * tper, tend = (tbeg + tper < nt) ? tbeg + tper : nt; if (tbeg >= nt) return;
  float* impq = p.imp + ((long)qt * 2 + g) * 256 * 32 + r32;
  const SB* qbase = p.proj + (long)(q0 + r32) * NPROJ + PA_Q + g * 256; const float* cmlq = p.cml + ((long)(q0 + r32) * 8 + g * 4) * 2;
  bf16x8 kfn[4]; { const int t = (tbeg > 0 ? tbeg - 1 : 0); int j = 32 * t + r32; j = j >= ncmp ? ncmp - 1 : j; const SB* kp = kc + (long)j * 128;
#pragma unroll
    for (int d0 = 0; d0 < 4; ++d0) kfn[d0] = *(const bf16x8*)(kp + d0 * 16 + hi * 8); }
  for (int t = (tbeg > 0 ? tbeg - 1 : 0); t < tend; ++t) {
    bf16x8 kf[4];
#pragma unroll
    for (int d0 = 0; d0 < 4; ++d0) kf[d0] = kfn[d0];
    if (t + 1 < tend) { int j = 32 * (t + 1) + r32; j = j >= ncmp ? ncmp - 1 : j; const SB* kp = kc + (long)j * 128;
#pragma unroll
      for (int d0 = 0; d0 < 4; ++d0) kfn[d0] = *(const bf16x8*)(kp + d0 * 16 + hi * 8); }
    float accA[4] = {0.f, 0.f, 0.f, 0.f}, accL[4] = {0.f, 0.f, 0.f, 0.f};
#pragma unroll 1
    for (int hh = 0; hh < 4; ++hh) { bf16x8 qf[4]; load_q(qf, qbase + hh * 64, hi); const float m = cmlq[hh * 2], il = cmlq[hh * 2 + 1];
      f32x16 s = zero16();
#pragma unroll
      for (int d0 = 0; d0 < 4; ++d0) s = MFMA32(kf[d0], qf[d0], s);
      fix_cmp(s, p, g * 4 + hh, q0, t, lane);
#pragma unroll
      for (int e = 0; e < 16; ++e) { const float pr = __builtin_amdgcn_exp2f(s[e] - m) * il; accA[e >> 2] += pr; if ((e & 3) == 3) accL[e >> 2] += pr; } }
    float oth[4];
#pragma unroll
    for (int eg = 0; eg < 4; ++eg) oth[eg] = xor32_f(accL[eg]);
#pragma unroll
    for (int eg = 0; eg < 4; ++eg) { const float prev = hi ? oth[eg] : (eg > 0 ? oth[eg > 0 ? eg - 1 : 0] : carry); if (t >= tbeg) impq[(8 * t + 2 * eg + hi) * 32] = 2.f * accA[eg] - accL[eg] + prev; }
    carry = oth[3]; }
}
#define DPP_F(v, ctrl, rm) __builtin_bit_cast(float, __builtin_amdgcn_update_dpp(__builtin_bit_cast(int, v), __builtin_bit_cast(int, v), ctrl, rm, 0xf, false))
#define DPP_I(v, ctrl, rm) __builtin_amdgcn_update_dpp(v, v, ctrl, rm, 0xf, false)
__device__ __forceinline__ float wave_max_f(float v) {
  v = fmaxf(v, DPP_F(v, 0xB1, 0xf)); v = fmaxf(v, DPP_F(v, 0x4E, 0xf)); v = fmaxf(v, DPP_F(v, 0x141, 0xf)); v = fmaxf(v, DPP_F(v, 0x140, 0xf));
  v = fmaxf(v, DPP_F(v, 0x142, 0xa)); v = fmaxf(v, DPP_F(v, 0x143, 0xc));
  return __builtin_bit_cast(float, __builtin_amdgcn_readlane(__builtin_bit_cast(int, v), 63)); }
__device__ __forceinline__ int imin_(int a, int b) { return a < b ? a : b; }
__device__ __forceinline__ int wave_min_i(int v) {
  v = imin_(v, DPP_I(v, 0xB1, 0xf)); v = imin_(v, DPP_I(v, 0x4E, 0xf)); v = imin_(v, DPP_I(v, 0x141, 0xf)); v = imin_(v, DPP_I(v, 0x140, 0xf));
  v = imin_(v, DPP_I(v, 0x142, 0xa)); v = imin_(v, DPP_I(v, 0x143, 0xc));
  return __builtin_amdgcn_readlane(v, 63); }
__device__ __forceinline__ void unit_topk(const Params& p, int u, int lane) {
  const int q = u >> 1, cur = q >> 6; const float* imp = p.imp + ((long)(q >> 5) * 2 + (u & 1)) * 256 * 32 + (q & 31); int* idx = p.idx + (long)u * 16;
  float v[4];
#pragma unroll
  for (int k = 0; k < 4; ++k) { const int b = lane + 64 * k; float x = (b <= cur) ? imp[b * 32] : -1.f; if (b == 0 || b == cur) x = 1e4f; v[k] = x; }
  int mine = -1;
  for (int k = 0; k < 16; ++k) {
    float lm = fmaxf(fmaxf(v[0], v[1]), fmaxf(v[2], v[3])); const float m = wave_max_f(lm);
    int cand = 0x7fffffff;
#pragma unroll
    for (int kk = 3; kk >= 0; --kk) if (v[kk] == m) cand = lane + 64 * kk;
    const int bsel = wave_min_i(cand);
#pragma unroll
    for (int kk = 0; kk < 4; ++kk) if (lane + 64 * kk == bsel) v[kk] = -2.f;
    if (lane == k) mine = (m >= 0.f) ? bsel : -1;
  }
  if (lane < 16) idx[lane] = mine;
}
template <bool STORE = true>
__device__ __forceinline__ void unit_asel(const Params& p, int u, WaveLds* L, int lane) {
  const int g = u & 1, q = u >> 1, r32 = lane & 31, hi = lane >> 5, hh = r32 & 3, h = g * 4 + hh;
  bf16x8 qf[4]; load_q(qf, p.proj + (long)q * NPROJ + PA_Q + h * 64, hi);
  FlashState st; st.o0 = zero16(); st.o1 = zero16(); st.m = -1e30f; st.l = 0.f;
  const int* idx = p.idx + (long)u * 16; const SB* kvb = p.proj + PA_KV + 2 * 128 + g * 64; const float c31 = p.tabA[h * TABA_N + 2047] * L2E;
  for (int k = 0; k < 16; ++k) { const int b = __builtin_amdgcn_readfirstlane(idx[k]); if (b < 0) continue;
    for (int kt = 0; kt < 2; ++kt) { const int t0 = b * 64 + kt * 32; if (t0 > q) continue;
      const bool far = (q - (t0 + 31)) >= 1513; const bool edge = (t0 + 31 > q);
      flash_tile(st, qf, kvb + (long)(t0 + r32) * NPROJ, [&](int key) { return kvb + 128 + (long)(t0 + key) * NPROJ; },
                 [&](f32x16& s) {
#pragma unroll
                   for (int e = 0; e < 16; ++e) { const int tk = t0 + (e & 3) + 8 * (e >> 2) + 4 * hi; const int dist = q - tk; float bsv;
                     if (far) bsv = c31; else { const int dc = dist < 0 ? 0 : (dist > 2047 ? 2047 : dist); bsv = p.tabA[h * TABA_N + dc] * L2E; }
                     float vv = s[e] * QSC + bsv; if (edge && dist < 0) vv = NINF; s[e] = vv; } }, L, lane); } }
  flash_finish(st, L, lane);
  if (!STORE) { asm volatile("" :: "v"(st.o0[0]), "v"(st.o1[3])); return; }
  if (hi == 0) {
#pragma unroll
    for (int e = 0; e < 4; ++e) { const int he = g * 4 + e; const float* gl = p.small + (long)q * NSMALL + he * 3;
      const float g0 = sigmoid_f(gl[0]), g1 = sigmoid_f(gl[1]), g2 = sigmoid_f(gl[2]);
#pragma unroll
      for (int db = 0; db < 2; ++db) { const long c = (long)q * 512 + he * 64 + db * 32 + r32; const float os = db ? st.o1[e] : st.o0[e];
        const float a = g0 * bf2f(p.oc[c]) + g1 * os + g2 * bf2f(p.ow[c]); SB* mp = p.mix + (long)q * NMIX + MX_A + he * 64 + db * 32 + r32; *mp = f2bf(a * bf2f(*mp)); } }
  }
}

struct WaveLds2 { unsigned short x[2048]; unsigned short b[2048]; float acs[128]; float dtv[128]; float xch[64]; };
template <bool SCALE, class RowScale>
__device__ __forceinline__ void stage_slab(unsigned short* dst, const SB* src, long ld, RowScale rs, int lane) {
#pragma unroll
  for (int i = 0; i < 4; ++i) { const int c = lane + 64 * i, row = c >> 3, ch = c & 7; uint4 vv = *(const uint4*)(src + (long)row * ld + ch * 8);
    if (SCALE) { const float sc = rs(row); unsigned w[4] = {vv.x, vv.y, vv.z, vv.w};
#pragma unroll
      for (int k = 0; k < 4; ++k) { const float lo = __uint_as_float(w[k] << 16) * sc, hi2 = __uint_as_float(w[k] & 0xffff0000u) * sc; w[k] = pk2(lo, hi2); }
      vv.x = w[0]; vv.y = w[1]; vv.z = w[2]; vv.w = w[3]; }
    *(uint4*)&dst[(ch >> 2) * 1024 + row * 32 + (ch & 3) * 8] = vv; }
}
__device__ __forceinline__ bf16x8 slab_frag(const unsigned short* img, int cb, int s2, int lane) {
  const int hi = lane >> 5; const unsigned short* vb = img + (4 * hi + ((lane & 15) >> 2)) * 32 + ((lane >> 4) & 1) * 16 + (lane & 3) * 4 + cb * 1024 + s2 * 512;
  const v4i16_t lo = __builtin_amdgcn_ds_read_tr16_b64_v4i16((LDS3 v4i16_t*)vb);
  const v4i16_t hh = __builtin_amdgcn_ds_read_tr16_b64_v4i16((LDS3 v4i16_t*)(vb + 256));
  return (bf16x8){lo[0], lo[1], lo[2], lo[3], hh[0], hh[1], hh[2], hh[3]};
}
__device__ __forceinline__ void unit_bstates(const Params& p, int u, WaveLds2* L, int lane) {
  const int nh = u & 1, hd = (u >> 1) & 7, c = u >> 4, g = hd >> 2, r32 = lane & 31, hi = lane >> 5;
  f32x16 acc[2][2];
#pragma unroll
  for (int i = 0; i < 2; ++i)
#pragma unroll
    for (int j = 0; j < 2; ++j) acc[i][j] = zero16();
  const SB* xb = p.xconv + (long)c * 128 * 1024; const float* wst = p.wst + (long)c * 128 * 8 + hd;
  for (int q4 = 0; q4 < 4; ++q4) {
    stage_slab<true>(L->x, xb + (long)(32 * q4) * 1024 + hd * 64, 1024, [&](int row) { return wst[(32 * q4 + row) * 8]; }, lane);
    stage_slab<false>(L->b, xb + (long)(32 * q4) * 1024 + 512 + g * 128 + nh * 64, 1024, [&](int) { return 1.f; }, lane);
#pragma unroll
    for (int s2 = 0; s2 < 2; ++s2) { bf16x8 af[2], bfr[2];
#pragma unroll
      for (int i = 0; i < 2; ++i) { af[i] = slab_frag(L->x, i, s2, lane); bfr[i] = slab_frag(L->b, i, s2, lane); }
#pragma unroll
      for (int i = 0; i < 2; ++i)
#pragma unroll
        for (int j = 0; j < 2; ++j) acc[i][j] = MFMA32(af[i], bfr[j], acc[i][j]); } }
  float* so = p.states + ((long)c * 8 + hd) * 8192 + nh * 64 + r32;
#pragma unroll
  for (int i = 0; i < 2; ++i)
#pragma unroll
    for (int j = 0; j < 2; ++j)
#pragma unroll
      for (int e = 0; e < 16; ++e) so[(long)(32 * i + crow(e, hi)) * 128 + 32 * j] = acc[i][j][e];
}
__device__ __forceinline__ void unit_bout(const Params& p, int layer, int u, WaveLds2* L, int lane) {
  const int lt = u & 3, hd = (u >> 2) & 7, c = u >> 5, g = hd >> 2, r32 = lane & 31, hi = lane >> 5;
  for (int x = lane; x < 128; x += 64) { L->acs[x] = p.acs[((long)c * 128 + x) * 8 + hd]; L->dtv[x] = p.dt[((long)c * 128 + x) * 8 + hd]; }
  f32x16 acc[2] = {zero16(), zero16()}, acc2[2] = {zero16(), zero16()};
  const SB* xb = p.xconv + (long)c * 128 * 1024; const int l = 32 * lt + r32; const float al = p.acs[((long)c * 128 + l) * 8 + hd];
  const float* cbr = p.cb + ((long)c * 2 + g) * 16384 + (long)l * 128;
  for (int sc = 0; sc <= lt; ++sc) {
    stage_slab<false>(L->x, xb + (long)(32 * sc) * 1024 + hd * 64, 1024, [&](int) { return 1.f; }, lane);
#pragma unroll
    for (int s2 = 0; s2 < 2; ++s2) { float mv[8];
#pragma unroll
      for (int jj = 0; jj < 2; ++jj) { const int s0 = 32 * sc + 16 * s2 + 8 * jj + 4 * hi; const float4 cv = *(const float4*)(cbr + s0); const float4 av = *(const float4*)(&L->acs[s0]); const float4 dv = *(const float4*)(&L->dtv[s0]);
        mv[4 * jj + 0] = (s0 + 0 <= l) ? cv.x * __expf(al - av.x) * dv.x : 0.f; mv[4 * jj + 1] = (s0 + 1 <= l) ? cv.y * __expf(al - av.y) * dv.y : 0.f;
        mv[4 * jj + 2] = (s0 + 2 <= l) ? cv.z * __expf(al - av.z) * dv.z : 0.f; mv[4 * jj + 3] = (s0 + 3 <= l) ? cv.w * __expf(al - av.w) * dv.w : 0.f; }
      u32x4 aw; aw[0] = pk2(mv[0], mv[1]); aw[1] = pk2(mv[2], mv[3]); aw[2] = pk2(mv[4], mv[5]); aw[3] = pk2(mv[6], mv[7]); const bf16x8 af = __builtin_bit_cast(bf16x8, aw);
#pragma unroll
      for (int pt = 0; pt < 2; ++pt) acc[pt] = MFMA32(af, slab_frag(L->x, pt, s2, lane), acc[pt]); } }
  const SB* cmr = xb + (long)l * 1024 + 768 + g * 128; const float* prv = p.states + ((long)c * 8 + hd) * 8192;
#pragma unroll 2
  for (int ks = 0; ks < 8; ++ks) { const bf16x8 af = *(const bf16x8*)(cmr + 16 * ks + 8 * hi);
#pragma unroll
    for (int pt = 0; pt < 2; ++pt) { const float* pr = prv + (long)(32 * pt + r32) * 128 + 16 * ks + 8 * hi; const float4 a0 = *(const float4*)pr, a1 = *(const float4*)(pr + 4);
      u32x4 bw; bw[0] = pk2(a0.x, a0.y); bw[1] = pk2(a0.z, a0.w); bw[2] = pk2(a1.x, a1.y); bw[3] = pk2(a1.z, a1.w);
      acc2[pt] = MFMA32(af, __builtin_bit_cast(bf16x8, bw), acc2[pt]); } }
  const float dsk = p.b_d[layer * 8 + hd];
#pragma unroll
  for (int e = 0; e < 16; ++e) { const int lr = 32 * lt + crow(e, hi); const float ea = __expf(L->acs[lr]); const long t = (long)c * 128 + lr;
#pragma unroll
    for (int pt = 0; pt < 2; ++pt) { const int pp = 32 * pt + r32; p.ybuf[t * 512 + hd * 64 + pp] = acc[pt][e] + ea * acc2[pt][e] + dsk * bf2f(xb[(long)lr * 1024 + hd * 64 + pp]); } }
}
__device__ __forceinline__ void unit_bnorm(const Params& p, int layer, int u, int lane) {
  const int g = u & 1; const long t = u >> 1; const float4 yv = *(const float4*)(p.ybuf + t * 512 + g * 256 + lane * 4);
  SB* mp = p.mix + t * NMIX + MX_B + g * 256 + lane * 4; const ushort4 zv = *(const ushort4*)mp;
  const float v0 = yv.x * bf2f(zv.x), v1 = yv.y * bf2f(zv.y), v2 = yv.z * bf2f(zv.z), v3 = yv.w * bf2f(zv.w);
  const float ss = wave_sum_f(v0 * v0 + v1 * v1 + v2 * v2 + v3 * v3); const float r = 1.f / sqrtf(ss * (1.f / 256.f) + 1e-6f);
  const float4 w = *(const float4*)(p.b_norm + layer * 512 + g * 256 + lane * 4);
  ushort4 o; o.x = f2bf(v0 * r * w.x); o.y = f2bf(v1 * r * w.y); o.z = f2bf(v2 * r * w.z); o.w = f2bf(v3 * r * w.w); *(ushort4*)mp = o;
}
__device__ __forceinline__ void unit_bdt(const Params& p, int layer, int u, int lane) {
  const int hd = u & 7, c = u >> 3; const float a = -expf(p.a_log[layer * 8 + hd]), bias = p.dt_bias[layer * 8 + hd]; const long t0 = (long)c * 128 + 2 * lane;
  const float d0 = softplus_f(p.small[t0 * NSMALL + 24 + hd] + bias), d1 = softplus_f(p.small[(t0 + 1) * NSMALL + 24 + hd] + bias);
  float run = (d0 + d1) * a;
#pragma unroll
  for (int o = 1; o < 64; o <<= 1) { const float v = __shfl_up(run, o); if (lane >= o) run += v; }
  const float tot = __shfl(run, 63); const float c1 = run, c0 = run - d1 * a;
  p.dt[t0 * 8 + hd] = d0; p.dt[(t0 + 1) * 8 + hd] = d1; p.acs[t0 * 8 + hd] = c0; p.acs[(t0 + 1) * 8 + hd] = c1;
  p.wst[t0 * 8 + hd] = d0 * expf(tot - c0); p.wst[(t0 + 1) * 8 + hd] = d1 * expf(tot - c1);
}
__device__ __forceinline__ void item_bconv(const Params& p, int layer, long gid) {
  const int cg = (int)(gid & 127) * 8; const long t = gid >> 7; const float* w = p.conv_w + (long)layer * 4 * 1024 + cg; const float* bb = p.conv_b + layer * 1024 + cg;
  const float4 b0 = *(const float4*)bb, b1 = *(const float4*)(bb + 4);
  float acc[8] = {b0.x, b0.y, b0.z, b0.w, b1.x, b1.y, b1.z, b1.w};
#pragma unroll
  for (int i = 0; i < 4; ++i) { const long tt = t - 3 + i; const long tc = tt < 0 ? 0 : tt; const float vm = tt < 0 ? 0.f : 1.f;
    const uint4 vv = *(const uint4*)(p.proj + tc * NPROJ + PB_X + cg); const unsigned wd[4] = {vv.x, vv.y, vv.z, vv.w};
    const float4 w0 = *(const float4*)(w + i * 1024), w1 = *(const float4*)(w + i * 1024 + 4); const float wv[8] = {w0.x, w0.y, w0.z, w0.w, w1.x, w1.y, w1.z, w1.w};
#pragma unroll
    for (int k = 0; k < 4; ++k) { acc[2 * k] += vm * wv[2 * k] * __uint_as_float(wd[k] << 16); acc[2 * k + 1] += vm * wv[2 * k + 1] * __uint_as_float(wd[k] & 0xffff0000u); } }
  uint4 o; o.x = pk2(silu_f(acc[0]), silu_f(acc[1])); o.y = pk2(silu_f(acc[2]), silu_f(acc[3])); o.z = pk2(silu_f(acc[4]), silu_f(acc[5])); o.w = pk2(silu_f(acc[6]), silu_f(acc[7]));
  *(uint4*)(p.xconv + t * 1024 + cg) = o;
}
__device__ __forceinline__ void unit_cmp(const Params& p, int layer, int u, int lane) {
  const int ncmp = p.S / 16, ntile = ncmp * 2 / 32; const int kv = u / ntile, rt = u % ntile, r32 = lane & 31, hi = lane >> 5;
  const int r = 32 * rt + r32, j = r >> 1, hk = r & 1;
  const unsigned short* w1t = p.w1t + (long)kv * 128 * 2048; const unsigned short* w2t = p.w2t + kv * 64 * 128; const float* pe = p.cmp_pos + (long)(layer * 2 + kv) * 32 * 64;
  const SB* src = p.proj + PA_KV + kv * 128 + hk * 64;
  f32x16 acc[4] = {zero16(), zero16(), zero16(), zero16()};
#pragma unroll 4
  for (int ks = 0; ks < 128; ++ks) { const int t = ks >> 2, d = (ks & 3) * 16 + 8 * hi; const long tok = 16 * j + t;
    const float4 p0 = *(const float4*)(pe + t * 64 + d), p1 = *(const float4*)(pe + t * 64 + d + 4); float v[8] = {p0.x, p0.y, p0.z, p0.w, p1.x, p1.y, p1.z, p1.w};
    { const long tokc = tok < p.S ? tok : (long)p.S - 1; const float vm = tok < p.S ? 1.f : 0.f;
      const uint4 vv = *(const uint4*)(src + tokc * NPROJ + d); const unsigned wd[4] = {vv.x, vv.y, vv.z, vv.w};
#pragma unroll
      for (int k = 0; k < 4; ++k) { v[2 * k] += vm * __uint_as_float(wd[k] << 16); v[2 * k + 1] += vm * __uint_as_float(wd[k] & 0xffff0000u); } }
    u32x4 bw; bw[0] = pk2(v[0], v[1]); bw[1] = pk2(v[2], v[3]); bw[2] = pk2(v[4], v[5]); bw[3] = pk2(v[6], v[7]); const bf16x8 bfr = __builtin_bit_cast(bf16x8, bw);
#pragma unroll
    for (int ut = 0; ut < 4; ++ut) { const bf16x8 af = *(const bf16x8*)(w1t + (long)(32 * ut + r32) * 2048 + 16 * ks + 8 * hi); acc[ut] = MFMA32(af, bfr, acc[ut]); } }
  f32x16 o2[2] = {zero16(), zero16()};
#pragma unroll
  for (int ut = 0; ut < 4; ++ut) {
#pragma unroll
    for (int e = 0; e < 16; ++e) acc[ut][e] = gelu_f(acc[ut][e]);
#pragma unroll
    for (int s2 = 0; s2 < 2; ++s2) { const bf16x8 hb = pack8(acc[ut], 8 * s2);
#pragma unroll
      for (int dt = 0; dt < 2; ++dt) { const unsigned short* wr = w2t + (32 * dt + r32) * 128 + 32 * ut + 16 * s2 + 4 * hi; const uint2 x0 = *(const uint2*)wr, x1 = *(const uint2*)(wr + 8);
        u32x4 aw; aw[0] = x0.x; aw[1] = x0.y; aw[2] = x1.x; aw[3] = x1.y; o2[dt] = MFMA32(__builtin_bit_cast(bf16x8, aw), hb, o2[dt]); } } }
  SB* dst = p.kvc + ((long)kv * ncmp * 2 + r) * 64;
#pragma unroll
  for (int dt = 0; dt < 2; ++dt)
#pragma unroll
    for (int e = 0; e < 16; ++e) dst[32 * dt + crow(e, hi)] = f2bf(o2[dt][e]);
}

template <class RowFn, class OutFn>
__device__ __forceinline__ void topk4_rows_o(const Params& p, RowFn rowfn, OutFn outfn, int lane) {
  float v[4][4]; int cur[4], mine[4];
#pragma unroll
  for (int r = 0; r < 4; ++r) { const int row = rowfn(r); const int q = row >> 1; cur[r] = q >> 6; const float* imp = p.imp + ((long)(q >> 5) * 2 + (row & 1)) * 256 * 32 + (q & 31); mine[r] = -1;
#pragma unroll
    for (int k = 0; k < 4; ++k) { const int b = lane + 64 * k; float x = (b <= cur[r]) ? imp[b * 32] : -1.f; if (b == 0 || b == cur[r]) x = 1e4f; v[r][k] = x; } }
  for (int k = 0; k < 16; ++k) {
    float m[4]; int cand[4];
#pragma unroll
    for (int r = 0; r < 4; ++r) m[r] = wave_max_f(fmaxf(fmaxf(v[r][0], v[r][1]), fmaxf(v[r][2], v[r][3])));
#pragma unroll
    for (int r = 0; r < 4; ++r) { int c = 0x7fffffff;
#pragma unroll
      for (int kk = 3; kk >= 0; --kk) if (v[r][kk] == m[r]) c = lane + 64 * kk;
      cand[r] = wave_min_i(c); }
#pragma unroll
    for (int r = 0; r < 4; ++r) {
#pragma unroll
      for (int kk = 0; kk < 4; ++kk) if (lane + 64 * kk == cand[r]) v[r][kk] = -2.f;
      if (lane == k) mine[r] = (m[r] >= 0.f) ? cand[r] : -1; }
  }
#pragma unroll
  for (int r = 0; r < 4; ++r) if (lane < 16) { p.idx[(long)rowfn(r) * 16 + lane] = mine[r]; outfn(r, mine[r]); }
}
template <class RowFn>
__device__ __forceinline__ void topk4_rows(const Params& p, RowFn rowfn, int lane) { topk4_rows_o(p, rowfn, [](int, int) {}, lane); }
__device__ __forceinline__ void unit_topk4(const Params& p, int u, int lane) { topk4_rows(p, [&](int r) { return u * 4 + r; }, lane); }
__device__ __forceinline__ void glds16_asm(const void* gsrc, unsigned lds_dst) {
  unsigned keep; asm volatile("s_mov_b32 %0, m0\n\ts_mov_b32 m0, %2\n\ts_nop 0\n\tglobal_load_lds_dwordx4 %1, off\n\ts_mov_b32 m0, %0" : "=&s"(keep) : "v"(gsrc), "s"(lds_dst) : "memory");
}
__device__ __forceinline__ unsigned lds_addr(const void* p) { return (unsigned)(size_t)(LDS3 const void*)p; }
struct AselLds { unsigned short k[3][4096]; unsigned short v[3][4096]; unsigned short q[4][2048]; unsigned sel[64][8]; unsigned anyb[8]; int nlist; int pad[7]; unsigned char blist[256]; float xch[4][32]; unsigned char bkt[1664]; float relS[128]; };
__device__ __forceinline__ void asel_issue(uint4 (&r)[4], const SB* kvb, int b, int tid) {
#pragma unroll
  for (int i = 0; i < 2; ++i) { const int idx = tid + 256 * i, row = idx >> 3, ch = idx & 7; const SB* src = kvb + (long)(b * 64 + row) * NPROJ + ch * 8; r[i] = *(const uint4*)src; r[2 + i] = *(const uint4*)(src + 128); }
}
__device__ __forceinline__ void asel_commit(const uint4 (&r)[4], AselLds* A, int stage, int tid) {
#pragma unroll
  for (int i = 0; i < 2; ++i) { const int idx = tid + 256 * i, row = idx >> 3, ch = idx & 7;
    *(uint4*)&A->k[stage][row * 64 + ((ch ^ (row & 7)) * 8)] = r[i];
    *(uint4*)&A->v[stage][(ch >> 2) * 2048 + row * 32 + (ch & 3) * 8] = r[2 + i]; }
}
__device__ __forceinline__ void asel_coltile(const Params& p, FlashState& S_, const unsigned short* qlds, AselLds* A, float* xch, int stage, int b, int cur, int q0, int qbase, int h, float c31, int lane) {
  const int r32 = lane & 31, hi = lane >> 5; const int ql = qbase + (r32 >> 2); const int q = q0 + ql;
  const bool selq = (A->sel[ql][b >> 5] >> (b & 31)) & 1u;
  if (!__any(selq)) return;
  bf16x8 qf[4];
#pragma unroll
  for (int d0 = 0; d0 < 4; ++d0) qf[d0] = *(const bf16x8*)&qlds[r32 * 64 + (((2 * d0 + hi) ^ ((r32 >> 1) & 7)) * 8)];
  const bool far = (q0 - (b * 64 + 63)) >= 1513; const bool edge = (b == cur);
#ifndef ASEL2
#define ASEL2 1
#endif
#if ASEL2
  bf16x8 kf0[4], kf1[4];
#pragma unroll
  for (int d0 = 0; d0 < 4; ++d0) { const int row0 = r32, row1 = 32 + r32;
    kf0[d0] = *(const bf16x8*)&A->k[stage][row0 * 64 + (((2 * d0 + hi) ^ ((row0 >> 1) & 7)) * 8)];
    kf1[d0] = *(const bf16x8*)&A->k[stage][row1 * 64 + (((2 * d0 + hi) ^ ((row1 >> 1) & 7)) * 8)]; }
  f32x16 s0 = zero16(), s1 = zero16();
#pragma unroll
  for (int d0 = 0; d0 < 4; ++d0) { s0 = MFMA32(kf0[d0], qf[d0], s0); s1 = MFMA32(kf1[d0], qf[d0], s1); }
  if (far) { flash_core2_lin(S_, s0, s1, selq ? QSC : 0.f, selq ? c31 : NINF, A->v[stage], xch, lane); return; }
#pragma unroll
  for (int e = 0; e < 16; ++e) { const int tk = b * 64 + (e & 3) + 8 * (e >> 2) + 4 * hi; const int dist = q - tk; float b0, b1;
    { const int d0c = dist < 0 ? 0 : (dist > 1663 ? 1663 : dist); const int d1 = dist - 32; const int d1c = d1 < 0 ? 0 : (d1 > 1663 ? 1663 : d1);
      b0 = A->relS[A->bkt[d0c] * 4 + (h & 3)]; b1 = A->relS[A->bkt[d1c] * 4 + (h & 3)]; }
    float v0 = s0[e] * QSC + b0, v1 = s1[e] * QSC + b1; if (!selq || (edge && dist < 0)) v0 = NINF; if (!selq || (edge && dist < 32)) v1 = NINF; s0[e] = v0; s1[e] = v1; }
  flash_core2(S_, s0, s1, A->v[stage], xch, lane);
}
#else
#pragma unroll 1
  for (int kt = 0; kt < 2; ++kt) { const int t0 = b * 64 + 32 * kt; if (edge && t0 > q0 + qbase + 7) continue;
    bf16x8 kf[4]; { const int row = 32 * kt + r32;
#pragma unroll
      for (int d0 = 0; d0 < 4; ++d0) kf[d0] = *(const bf16x8*)&A->k[stage][row * 64 + (((2 * d0 + hi) ^ ((row >> 1) & 7)) * 8)]; }
    f32x16 s = zero16();
#pragma unroll
    for (int d0 = 0; d0 < 4; ++d0) s = MFMA32(kf[d0], qf[d0], s);
    if (far) { flash_core1_lin(S_, s, selq ? QSC : 0.f, selq ? c31 : NINF, A->v[stage] + kt * 1024, xch, lane); continue; }
#pragma unroll
    for (int e = 0; e < 16; ++e) { const int tk = t0 + (e & 3) + 8 * (e >> 2) + 4 * hi; const int dist = q - tk;
      const int dc = dist < 0 ? 0 : (dist > 2047 ? 2047 : dist); const float bsv = p.tabA[h * TABA_N + dc] * L2E;
      float vv = s[e] * QSC + bsv; if (!selq || (edge && dist < 0)) vv = NINF; s[e] = vv; }
    flash_core1(S_, s, A->v[stage] + kt * 1024, xch, lane);
  }
}
#endif
__device__ __forceinline__ void asel_store(const Params& p, FlashState& S_, float* xch, int q0, int qbase, int g, int lane) {
  const int r32 = lane & 31, hi = lane >> 5;
  const float lt = S_.l + xor32_f(S_.l); const float inv = lt > 0.f ? 1.f / lt : 0.f; xch[r32] = inv;
#pragma unroll
  for (int e = 0; e < 16; ++e) { const int j = crow(e, hi); const float a = xch[j]; const int q = q0 + qbase + (j >> 2), he = g * 4 + (j & 3);
    const float* gl = p.small + (long)q * NSMALL + he * 3; const float g0 = sigmoid_f(gl[0]), g1 = sigmoid_f(gl[1]), g2 = sigmoid_f(gl[2]);
#pragma unroll
    for (int db = 0; db < 2; ++db) { const long c = (long)q * 512 + he * 64 + db * 32 + r32; const float os = (db ? S_.o1[e] : S_.o0[e]) * a;
      const float av = g0 * bf2f(p.oc[c]) + g1 * os + g2 * bf2f(p.ow[c]); SB* mp = p.mix + (long)q * NMIX + MX_A + he * 64 + db * 32 + r32; *mp = f2bf(av * bf2f(*mp)); } }
}
#ifndef ASEL16
#define ASEL16 1
#endif
typedef float f32x4_t __attribute__((ext_vector_type(4)));
#define MFMA16(a, b, c) __builtin_amdgcn_mfma_f32_16x16x32_bf16((a), (b), (c), 0, 0, 0)
struct Asel16 { f32x4_t o0, o1, o2, o3; float m, l; };
__device__ __forceinline__ float quadmax_f(float v) {
  const auto a = __builtin_amdgcn_permlane16_swap(__float_as_uint(v), __float_as_uint(v), false, false); v = fmaxf(__uint_as_float(a[0]), __uint_as_float(a[1]));
  const auto b = __builtin_amdgcn_permlane32_swap(__float_as_uint(v), __float_as_uint(v), false, false); return fmaxf(__uint_as_float(b[0]), __uint_as_float(b[1])); }
__device__ __forceinline__ float quadsum_f(float v) {
  const auto a = __builtin_amdgcn_permlane16_swap(__float_as_uint(v), __float_as_uint(v), false, false); v = __uint_as_float(a[0]) + __uint_as_float(a[1]);
  const auto b = __builtin_amdgcn_permlane32_swap(__float_as_uint(v), __float_as_uint(v), false, false); return __uint_as_float(b[0]) + __uint_as_float(b[1]); }
__device__ __forceinline__ bf16x8 pack44(const f32x4_t& a, const f32x4_t& b) {
  u32x4 r; r[0] = pk2(a[0], a[1]); r[1] = pk2(a[2], a[3]); r[2] = pk2(b[0], b[1]); r[3] = pk2(b[2], b[3]); return __builtin_bit_cast(bf16x8, r); }
template <int CT>
__device__ __forceinline__ void asel_coltile16(const Params& p, Asel16& S_, const unsigned short* qlds, AselLds* A, float* xch, int stage, int b, int cur, int q0, int qbase, float c31, int lane) {
  const int j = lane & 15, q4 = lane >> 4; const int ql = qbase + 4 * CT + (j >> 2); const int q = q0 + ql;
  const bool selq = (A->sel[ql][b >> 5] >> (b & 31)) & 1u;
  if (!__any(selq)) return;
  const bool far = (q0 - (b * 64 + 63)) >= 1513; const bool edge = (b == cur);
  const int qrow = 16 * CT + j;
  const bf16x8 qf0 = *(const bf16x8*)&qlds[qrow * 64 + (((q4) ^ ((qrow >> 1) & 7)) * 8)], qf1 = *(const bf16x8*)&qlds[qrow * 64 + (((4 + q4) ^ ((qrow >> 1) & 7)) * 8)];
  f32x4_t sc[4];
#pragma unroll
  for (int kt = 0; kt < 4; ++kt) { const int row = 16 * kt + j;
    const bf16x8 k0 = *(const bf16x8*)&A->k[stage][row * 64 + (((q4) ^ ((row >> 1) & 7)) * 8)], k1 = *(const bf16x8*)&A->k[stage][row * 64 + (((4 + q4) ^ ((row >> 1) & 7)) * 8)];
    f32x4_t z = {0.f, 0.f, 0.f, 0.f}; z = MFMA16(k0, qf0, z); sc[kt] = MFMA16(k1, qf1, z); }
  float qs, bb;
  if (far) { qs = selq ? QSC : 0.f; bb = selq ? c31 : NINF; }
  else {
    qs = 1.f; bb = 0.f;
#pragma unroll
    for (int kt = 0; kt < 4; ++kt) {
#pragma unroll
      for (int r = 0; r < 4; ++r) { const int tk = b * 64 + 16 * kt + 4 * q4 + r; const int dist = q - tk; const int dc = dist < 0 ? 0 : (dist > 1663 ? 1663 : dist);
        float v = sc[kt][r] * QSC + A->relS[A->bkt[dc] * 4 + (j & 3)]; if (!selq || (edge && dist < 0)) v = NINF; sc[kt][r] = v; } }
  }
  float mr = fmaxf(fmaxf(sc[0][0], sc[0][1]), fmaxf(sc[0][2], sc[0][3]));
#pragma unroll
  for (int kt = 1; kt < 4; ++kt) mr = fmaxf(mr, fmaxf(fmaxf(sc[kt][0], sc[kt][1]), fmaxf(sc[kt][2], sc[kt][3])));
  float mx = far ? __builtin_fmaf(mr, qs, bb) : mr;
  mx = quadmax_f(mx);
  if (__any(mx > S_.m + FTHR)) {
    const float mn = fmaxf(S_.m, mx); const float al = __builtin_amdgcn_exp2f(S_.m - mn); S_.m = mn; S_.l *= al; xch[16 * CT + j] = al;
    const f32x4_t a = *(const f32x4_t*)&xch[16 * CT + 4 * q4];
    S_.o0 *= a; S_.o1 *= a; S_.o2 *= a; S_.o3 *= a;
  }
  const float bm = bb - S_.m; float ps = 0.f;
#pragma unroll
  for (int kt = 0; kt < 4; ++kt) {
#pragma unroll
    for (int r = 0; r < 4; ++r) { const float e_ = __builtin_amdgcn_exp2f(__builtin_fmaf(sc[kt][r], qs, bm)); sc[kt][r] = e_; ps += e_; } }
  S_.l += ps;
  const bf16x8 pa0 = pack44(sc[0], sc[1]), pa1 = pack44(sc[2], sc[3]);
  const unsigned short* vb = A->v[stage] + (4 * q4 + (j >> 2)) * 32 + (j & 3) * 4;
#pragma unroll
  for (int c = 0; c < 2; ++c) {
#pragma unroll
    for (int dt = 0; dt < 4; ++dt) {
      const v4i16_t lo = __builtin_amdgcn_ds_read_tr16_b64_v4i16((LDS3 v4i16_t*)(vb + (dt >> 1) * 2048 + (dt & 1) * 16 + c * 1024));
      const v4i16_t hh = __builtin_amdgcn_ds_read_tr16_b64_v4i16((LDS3 v4i16_t*)(vb + (dt >> 1) * 2048 + (dt & 1) * 16 + c * 1024 + 512));
      const bf16x8 vf = {lo[0], lo[1], lo[2], lo[3], hh[0], hh[1], hh[2], hh[3]};
      const bf16x8 pa = c ? pa1 : pa0;
      if (dt == 0) S_.o0 = MFMA16(pa, vf, S_.o0); else if (dt == 1) S_.o1 = MFMA16(pa, vf, S_.o1); else if (dt == 2) S_.o2 = MFMA16(pa, vf, S_.o2); else S_.o3 = MFMA16(pa, vf, S_.o3);
    }
  }
}
template <int CT>
__device__ __forceinline__ void asel_store16(const Params& p, Asel16& S_, float* xch, int q0, int qbase, int g, int lane) {
  const int j = lane & 15, q4 = lane >> 4;
  const float lt = quadsum_f(S_.l); const float inv = lt > 0.f ? 1.f / lt : 0.f; xch[16 * CT + j] = inv;
  const f32x4_t a = *(const f32x4_t*)&xch[16 * CT + 4 * q4];
  const int q = q0 + qbase + 4 * CT + q4;
#pragma unroll
  for (int r = 0; r < 4; ++r) { const int he = g * 4 + r;
    const float* gl = p.small + (long)q * NSMALL + he * 3; const float g0 = sigmoid_f(gl[0]), g1 = sigmoid_f(gl[1]), g2 = sigmoid_f(gl[2]);
#pragma unroll
    for (int dt = 0; dt < 4; ++dt) { const long c = (long)q * 512 + he * 64 + dt * 16 + j; const float os = (dt == 0 ? S_.o0[r] : dt == 1 ? S_.o1[r] : dt == 2 ? S_.o2[r] : S_.o3[r]) * a[r];
      const float av = g0 * bf2f(p.oc[c]) + g1 * os + g2 * bf2f(p.ow[c]); SB* mp = p.mix + (long)q * NMIX + MX_A + he * 64 + dt * 16 + j; *mp = f2bf(av * bf2f(*mp)); } }
}
template <bool STORE = true, bool NOSTEPS = false>
__device__ __forceinline__ void unit_asel_blk(const Params& p, int u, AselLds* A) {
  int tid = threadIdx.x; asm volatile("" : "+v"(tid));
  const int lane = tid & 63, w = __builtin_amdgcn_readfirstlane(tid >> 6), r32 = lane & 31, hi = lane >> 5;
  const int g = u & 1, qt = (p.S / 32 - 1) - (u >> 1), q0 = qt * 32, cur = q0 >> 6;
  const SB* kvb = p.proj + PA_KV + 2 * 128 + g * 64;
  __syncthreads();
  for (int i = tid; i < 64 * 8 + 8; i += 256) ((unsigned*)A->sel)[i] = 0u;
  for (int i = tid; i < 1664; i += 256) A->bkt[i] = (unsigned char)t5_bucket(i);
  if (tid < 128) A->relS[tid] = p.rel_bias[(tid >> 2) * 32 + g * 4 + (tid & 3)] * L2E;
#ifndef ASEL_NO_TOPK
  topk4_rows(p, [&](int r) { return (q0 + 8 * w + r) * 2 + g; }, lane); topk4_rows(p, [&](int r) { return (q0 + 8 * w + 4 + r) * 2 + g; }, lane);
  asm volatile("s_waitcnt vmcnt(0)" ::: "memory");
#endif
  __syncthreads();
#pragma unroll
  for (int i = 0; i < 2; ++i) { const int e = tid + 256 * i, ql = e >> 4, kk = e & 15; const int b = __hip_atomic_load(&p.idx[((long)(q0 + ql) * 2 + g) * 16 + kk], __ATOMIC_RELAXED, __HIP_MEMORY_SCOPE_AGENT);
    if (b >= 0) { atomicOr(&A->sel[ql][b >> 5], 1u << (b & 31)); atomicOr(&A->anyb[b >> 5], 1u << (b & 31)); } }
  __syncthreads();
  if (tid < 64) {
    const unsigned wbits = A->anyb[lane >> 3]; const unsigned nib = (wbits >> ((lane & 7) * 4)) & 15u; const int cnt = __popc(nib);
    int pre = cnt;
#pragma unroll
    for (int o = 1; o < 64; o <<= 1) { const int v = __shfl_up(pre, o); if (lane >= o) pre += v; }
    int pos = pre - cnt;
#pragma unroll
    for (int k = 0; k < 4; ++k) if ((nib >> k) & 1u) A->blist[pos++] = (unsigned char)(lane * 4 + k);
    if (lane == 63) A->nlist = pre;
  }
  __syncthreads();
  const int nlist = NOSTEPS ? 0 : A->nlist;
  const int hh = r32 & 3, h = g * 4 + hh; const float c31 = p.tabA[h * TABA_N + 2047] * L2E;
#if ASEL16
  Asel16 t0, t1;
#else
  FlashState st0;
#endif
  { bf16x8 qf0[4]; load_q(qf0, p.proj + (long)(q0 + 8 * w + (r32 >> 2)) * NPROJ + PA_Q + h * 64, hi);
#pragma unroll
    for (int d0 = 0; d0 < 4; ++d0) *(bf16x8*)&A->q[w][r32 * 64 + (((2 * d0 + hi) ^ ((r32 >> 1) & 7)) * 8)] = qf0[d0]; }
#if ASEL16
  { const f32x4_t z4 = {0.f, 0.f, 0.f, 0.f}; t0.o0 = z4; t0.o1 = z4; t0.o2 = z4; t0.o3 = z4; t0.m = -1e30f; t0.l = 0.f; t1 = t0; }
#else
  st0.o0 = zero16(); st0.o1 = zero16(); st0.m = -1e30f; st0.l = 0.f;
#endif
  float* xch = A->xch[w];
#define ASEL_DMA(bb, stg) { const int b_ = (bb); _Pragma("unroll") for (int i_ = 0; i_ < 2; ++i_) { const int pk_ = 2 * w + i_; \
      { const int row_ = pk_ * 8 + (lane >> 3), pc_ = lane & 7; glds16_asm(kvb + (long)(b_ * 64 + row_) * NPROJ + ((pc_ ^ ((row_ >> 1) & 7)) * 8), (unsigned)__builtin_amdgcn_readfirstlane((int)lds_addr(&A->k[stg][pk_ * 512]))); } \
      { const int db_ = pk_ >> 2, row_ = (pk_ & 3) * 16 + (lane >> 2), wi_ = lane & 3; glds16_asm(kvb + 128 + (long)(b_ * 64 + row_) * NPROJ + db_ * 32 + wi_ * 8, (unsigned)__builtin_amdgcn_readfirstlane((int)lds_addr(&A->v[stg][db_ * 2048 + (pk_ & 3) * 512]))); } } }
  asm volatile("s_waitcnt vmcnt(0)" ::: "memory");
  if (nlist > 0) ASEL_DMA(A->blist[0], 0);
  if (nlist > 1) ASEL_DMA(A->blist[1], 1);
  int stage = 0;
  for (int it = 0; it < nlist; ++it) {
    const int b = A->blist[it];
    if (it + 1 < nlist) asm volatile("s_waitcnt vmcnt(4) lgkmcnt(0)\n\ts_barrier" ::: "memory"); else asm volatile("s_waitcnt vmcnt(0) lgkmcnt(0)\n\ts_barrier" ::: "memory");
    if (it + 2 < nlist) { const int s2_ = (stage == 0) ? 2 : stage - 1; ASEL_DMA(A->blist[it + 2], s2_); }
#if ASEL16
    asel_coltile16<0>(p, t0, A->q[w], A, xch, stage, b, cur, q0, 8 * w, c31, lane); asel_coltile16<1>(p, t1, A->q[w], A, xch, stage, b, cur, q0, 8 * w, c31, lane);
#else
    asel_coltile(p, st0, A->q[w], A, xch, stage, b, cur, q0, 8 * w, h, c31, lane);
#endif
    stage = (stage == 2) ? 0 : stage + 1;
  }
  asm volatile("s_waitcnt vmcnt(0)" ::: "memory");
#if ASEL16
  if (STORE) { asel_store16<0>(p, t0, xch, q0, 8 * w, g, lane); asel_store16<1>(p, t1, xch, q0, 8 * w, g, lane); } else asm volatile("" :: "v"(t0.o0[0]), "v"(t1.o1[2]), "v"(t0.l), "v"(t1.l));
#else
  if (STORE) asel_store(p, st0, xch, q0, 8 * w, g, lane); else asm volatile("" :: "v"(st0.o0[0]), "v"(st0.o1[5]), "v"(st0.l));
#endif
#undef ASEL_DMA
}
struct AselW { unsigned short k[4][4096]; unsigned short v[4][4096]; unsigned sel[32][8]; unsigned anyw[4][8]; int nl[4]; int pad[4]; unsigned char wl[4][256]; float xch[4][32]; unsigned char bkt[1664]; float relS[256]; };
__device__ __forceinline__ void glds16_s(const void* sbase, unsigned voff, unsigned lds_dst) {
  unsigned keep; asm volatile("s_mov_b32 %0, m0\n\ts_mov_b32 m0, %3\n\ts_nop 0\n\tglobal_load_lds_dwordx4 %2, %1\n\ts_mov_b32 m0, %0" : "=&s"(keep) : "s"(sbase), "v"(voff), "s"(lds_dst) : "memory");
}
struct AwOff { unsigned o[8]; };
__device__ __forceinline__ void aw_dma8(const void* sbase, const AwOff& f, unsigned lds) {
  asm volatile(
    "s_mov_b32 m0, %9\n\ts_nop 0\n\tglobal_load_lds_dwordx4 %1, %0\n\t"
    "s_add_u32 m0, %9, 0x400\n\ts_nop 0\n\tglobal_load_lds_dwordx4 %2, %0\n\t"
    "s_add_u32 m0, %9, 0x800\n\ts_nop 0\n\tglobal_load_lds_dwordx4 %3, %0\n\t"
    "s_add_u32 m0, %9, 0xc00\n\ts_nop 0\n\tglobal_load_lds_dwordx4 %4, %0\n\t"
    "s_add_u32 m0, %9, 0x1000\n\ts_nop 0\n\tglobal_load_lds_dwordx4 %5, %0\n\t"
    "s_add_u32 m0, %9, 0x1400\n\ts_nop 0\n\tglobal_load_lds_dwordx4 %6, %0\n\t"
    "s_add_u32 m0, %9, 0x1800\n\ts_nop 0\n\tglobal_load_lds_dwordx4 %7, %0\n\t"
    "s_add_u32 m0, %9, 0x1c00\n\ts_nop 0\n\tglobal_load_lds_dwordx4 %8, %0"
    :: "s"(sbase), "v"(f.o[0]), "v"(f.o[1]), "v"(f.o[2]), "v"(f.o[3]), "v"(f.o[4]), "v"(f.o[5]), "v"(f.o[6]), "v"(f.o[7]), "s"(lds) : "memory", "m0", "scc");
}
template <int CT, bool far>
__device__ __forceinline__ void aw_softmax(Asel16& S_, f32x4_t (&sc)[4], const AselW* A, const float* rel, float* xch, bool selq, bool edge, int q, int b, float c31, int lane) {
  const int j = lane & 15, q4 = lane >> 4;
  float qs, bb;
  if (far) { qs = selq ? QSC : 0.f; bb = selq ? c31 : NINF; }
  else { qs = 1.f; bb = 0.f;
    int bi[4][4]; float be[4][4]; const int d0 = q - (b * 64 + 4 * q4);
#pragma unroll
    for (int kt = 0; kt < 4; ++kt) {
#pragma unroll
      for (int r = 0; r < 4; ++r) { const int dist = d0 - (16 * kt + r); const int dc = dist < 0 ? 0 : (dist > 1663 ? 1663 : dist); bi[kt][r] = A->bkt[dc]; } }
#pragma unroll
    for (int kt = 0; kt < 4; ++kt) asm volatile("" : "+v"(bi[kt][0]), "+v"(bi[kt][1]), "+v"(bi[kt][2]), "+v"(bi[kt][3]));
#pragma unroll
    for (int kt = 0; kt < 4; ++kt) {
#pragma unroll
      for (int r = 0; r < 4; ++r) be[kt][r] = rel[bi[kt][r] * 4 + (j & 3)]; }
#pragma unroll
    for (int kt = 0; kt < 4; ++kt) asm volatile("" : "+v"(be[kt][0]), "+v"(be[kt][1]), "+v"(be[kt][2]), "+v"(be[kt][3]));
#pragma unroll
    for (int kt = 0; kt < 4; ++kt) {
#pragma unroll
      for (int r = 0; r < 4; ++r) { const int dist = d0 - (16 * kt + r); float v = __builtin_fmaf(sc[kt][r], QSC, be[kt][r]); if (!selq || (edge && dist < 0)) v = NINF; sc[kt][r] = v; } }
  }
  float mr = fmaxf(fmaxf(sc[0][0], sc[0][1]), fmaxf(sc[0][2], sc[0][3]));
#pragma unroll
  for (int kt = 1; kt < 4; ++kt) mr = fmaxf(mr, fmaxf(fmaxf(sc[kt][0], sc[kt][1]), fmaxf(sc[kt][2], sc[kt][3])));
  float mx = far ? __builtin_fmaf(mr, qs, bb) : mr;
  mx = quadmax_f(mx);
  { const float mn = (mx > S_.m + FTHR) ? mx : S_.m;
    const float al = __builtin_amdgcn_exp2f(S_.m - mn); S_.m = mn; S_.l *= al; xch[16 * CT + j] = al;
    const f32x4_t a = *(const f32x4_t*)&xch[16 * CT + 4 * q4];
    S_.o0 *= a; S_.o1 *= a; S_.o2 *= a; S_.o3 *= a; }
  const float bm = bb - S_.m; float ps = 0.f;
#pragma unroll
  for (int kt = 0; kt < 4; ++kt) {
#pragma unroll
    for (int r = 0; r < 4; ++r) { const float e_ = __builtin_amdgcn_exp2f(__builtin_fmaf(sc[kt][r], qs, bm)); sc[kt][r] = e_; ps += e_; } }
  S_.l += ps;
}
template <bool A0, bool A1, bool far, bool HOT>
__device__ __forceinline__ void aw_step(Asel16& t0, Asel16& t1, AselW* A, int w, const bf16x8& qa0, const bf16x8& qa1, const bf16x8& qb0, const bf16x8& qb1, bool selq0, bool selq1,
                                        int b, bool more, int nb, int q0w, int cur, float c31, const float* rel, const SB* kvb, unsigned ldsk, unsigned ldsv, const AwOff& fk, const AwOff& fv, int lane) {
  const int j = lane & 15, q4 = lane >> 4;
  const bool edge = (b == cur);
  float* xch = A->xch[w];
  asm volatile("s_waitcnt vmcnt(8)" ::: "memory");
  f32x4_t sa[4], sb[4];
  { bf16x8 k0[4], k1[4];
#pragma unroll
    for (int kt = 0; kt < 4; ++kt) { const int row = 16 * kt + j;
      k0[kt] = *(const bf16x8*)&A->k[w][row * 64 + (((q4) ^ ((row >> 1) & 7)) * 8)]; k1[kt] = *(const bf16x8*)&A->k[w][row * 64 + (((4 + q4) ^ ((row >> 1) & 7)) * 8)]; }
    asm volatile("s_waitcnt lgkmcnt(0)" ::: "memory");
    if (more && !HOT) aw_dma8(kvb + (long)nb * 64 * NPROJ, fk, ldsk);
#pragma unroll
    for (int kt = 0; kt < 4; ++kt) { const f32x4_t z = {0.f, 0.f, 0.f, 0.f};
      if (A0) { sa[kt] = MFMA16(k0[kt], qa0, z); sa[kt] = MFMA16(k1[kt], qa1, sa[kt]); }
      if (A1) { sb[kt] = MFMA16(k0[kt], qb0, z); sb[kt] = MFMA16(k1[kt], qb1, sb[kt]); } } }
  if (A0) aw_softmax<0, far>(t0, sa, A, rel, xch, selq0, edge, q0w + (j >> 2), b, c31, lane);
  if (A1) aw_softmax<1, far>(t1, sb, A, rel, xch, selq1, edge, q0w + 4 + (j >> 2), b, c31, lane);
  bf16x8 pa0, pa1, pb0, pb1;
  if (A0) { pa0 = pack44(sa[0], sa[1]); pa1 = pack44(sa[2], sa[3]); }
  if (A1) { pb0 = pack44(sb[0], sb[1]); pb1 = pack44(sb[2], sb[3]); }
  if (more) asm volatile("s_waitcnt vmcnt(8)" ::: "memory"); else asm volatile("s_waitcnt vmcnt(0)" ::: "memory");
  const unsigned short* vb0 = A->v[w] + (4 * q4 + (j >> 2)) * 32 + (j & 3) * 4 + (q4 & 1) * 16; const unsigned short* vb1 = vb0 + 16 - (q4 & 1) * 32;
#pragma unroll
  for (int c = 0; c < 2; ++c) {
#pragma unroll
    for (int dt = 0; dt < 4; ++dt) {
      const unsigned short* vb = (dt & 1) ? vb1 : vb0;
      const v4i16_t lo = __builtin_amdgcn_ds_read_tr16_b64_v4i16((LDS3 v4i16_t*)(vb + (dt >> 1) * 2048 + c * 1024));
      const v4i16_t hh = __builtin_amdgcn_ds_read_tr16_b64_v4i16((LDS3 v4i16_t*)(vb + (dt >> 1) * 2048 + c * 1024 + 512));
      const bf16x8 vf = {lo[0], lo[1], lo[2], lo[3], hh[0], hh[1], hh[2], hh[3]};
      if (A0) { const bf16x8 pa = c ? pa1 : pa0; if (dt == 0) t0.o0 = MFMA16(pa, vf, t0.o0); else if (dt == 1) t0.o1 = MFMA16(pa, vf, t0.o1); else if (dt == 2) t0.o2 = MFMA16(pa, vf, t0.o2); else t0.o3 = MFMA16(pa, vf, t0.o3); }
      if (A1) { const bf16x8 pb = c ? pb1 : pb0; if (dt == 0) t1.o0 = MFMA16(pb, vf, t1.o0); else if (dt == 1) t1.o1 = MFMA16(pb, vf, t1.o1); else if (dt == 2) t1.o2 = MFMA16(pb, vf, t1.o2); else t1.o3 = MFMA16(pb, vf, t1.o3); }
    }
  }
  asm volatile("s_waitcnt lgkmcnt(0)" ::: "memory");
  if (more && !HOT) aw_dma8(kvb + (long)nb * 64 * NPROJ, fv, ldsv);
}
__device__ __forceinline__ void asel_w_tables(const Params& p, AselW* A) {
  const int tid = threadIdx.x;
  for (int i = tid; i < 1664; i += 256) A->bkt[i] = (unsigned char)t5_bucket(i);
  A->relS[tid] = p.rel_bias[((tid & 127) >> 2) * 32 + (tid >> 7) * 4 + (tid & 3)] * L2E;
}
template <bool STORE = true, bool HOT = false, bool NLZ = false>
__device__ __forceinline__ void asel_w_wave(const Params& p, int g, int q0w, AselW* A, int w, int lane) {
  const int j = lane & 15, q4 = lane >> 4; const int cur = q0w >> 6; const float* rel = A->relS + g * 128;
  const SB* kvb = p.proj + PA_KV + 2 * 128 + g * 64;
  A->sel[8 * w + (lane >> 3)][lane & 7] = 0u;
  asm volatile("s_waitcnt lgkmcnt(0)" ::: "memory");
  topk4_rows_o(p, [&](int r) { return (q0w + r) * 2 + g; }, [&](int r, int b) { if (b >= 0) atomicOr(&A->sel[8 * w + r][b >> 5], 1u << (b & 31)); }, lane);
  topk4_rows_o(p, [&](int r) { return (q0w + 4 + r) * 2 + g; }, [&](int r, int b) { if (b >= 0) atomicOr(&A->sel[8 * w + 4 + r][b >> 5], 1u << (b & 31)); }, lane);
  asm volatile("s_waitcnt lgkmcnt(0)" ::: "memory");
  if (lane < 8) { unsigned o = 0u;
#pragma unroll
    for (int r = 0; r < 8; ++r) o |= A->sel[8 * w + r][lane];
    A->anyw[w][lane] = o; }
  asm volatile("s_waitcnt lgkmcnt(0)" ::: "memory");
  { const unsigned wbits = A->anyw[w][lane >> 3]; const unsigned nib = (wbits >> ((lane & 7) * 4)) & 15u; const int cnt = __popc(nib);
    int pre = cnt;
#pragma unroll
    for (int o = 1; o < 64; o <<= 1) { const int v = __shfl_up(pre, o); if (lane >= o) pre += v; }
    int pos = pre - cnt;
#pragma unroll
    for (int k = 0; k < 4; ++k) if ((nib >> k) & 1u) A->wl[w][pos++] = (unsigned char)(lane * 4 + k);
    if (lane == 63) A->nl[w] = pre; }
  asm volatile("s_waitcnt lgkmcnt(0)" ::: "memory");
  const int hq = g * 4 + (lane & 3); const float c31 = p.tabA[hq * TABA_N + 2047] * L2E;
  const SB* qpa = p.proj + (long)(q0w + (j >> 2)) * NPROJ + PA_Q + hq * 64 + 8 * q4; const SB* qpb = qpa + 4L * NPROJ;
  const bf16x8 qa0 = *(const bf16x8*)qpa, qa1 = *(const bf16x8*)(qpa + 32), qb0 = *(const bf16x8*)qpb, qb1 = *(const bf16x8*)(qpb + 32);
  Asel16 t0, t1;
  { const f32x4_t z4 = {0.f, 0.f, 0.f, 0.f}; t0.o0 = z4; t0.o1 = z4; t0.o2 = z4; t0.o3 = z4; t0.m = -1e30f; t0.l = 0.f; t1 = t0; }
  AwOff fk, fv;
#pragma unroll
  for (int pk = 0; pk < 8; ++pk) { fk.o[pk] = (unsigned)((pk * 8 + (lane >> 3)) * NPROJ * 2 + (((lane & 7) ^ (lane >> 4) ^ ((pk & 1) * 4)) * 16));
    fv.o[pk] = (unsigned)(256 + ((pk & 3) * 16 + (lane >> 2)) * NPROJ * 2 + (pk >> 2) * 64 + (((lane & 3) ^ (((lane >> 4) & 1) << 1)) * 16)); }
  const unsigned ldsk = (unsigned)__builtin_amdgcn_readfirstlane((int)lds_addr(&A->k[w][0])), ldsv = (unsigned)__builtin_amdgcn_readfirstlane((int)lds_addr(&A->v[w][0]));
  const int nl = NLZ ? 0 : __builtin_amdgcn_readfirstlane(A->nl[w]);
  asm volatile("s_waitcnt vmcnt(0) lgkmcnt(0)" ::: "memory");
  if (nl > 0) { const int b0 = __builtin_amdgcn_readfirstlane((int)A->wl[w][0]); aw_dma8(kvb + (long)b0 * 64 * NPROJ, fk, ldsk); aw_dma8(kvb + (long)b0 * 64 * NPROJ, fv, ldsv); }
  for (int i = 0; i < nl; ++i) {
    const int b = __builtin_amdgcn_readfirstlane((int)A->wl[w][i]); const bool more = i + 1 < nl; const int nb = more ? __builtin_amdgcn_readfirstlane((int)A->wl[w][i + 1]) : 0;
    const bool selq0 = (A->sel[8 * w + (j >> 2)][b >> 5] >> (b & 31)) & 1u, selq1 = (A->sel[8 * w + 4 + (j >> 2)][b >> 5] >> (b & 31)) & 1u;
    const bool a0 = __any(selq0), a1 = __any(selq1);
    const bool far = (q0w - (b * 64 + 63)) >= 1513;
    if (far) {
      if (a0 && a1) aw_step<true, true, true, HOT>(t0, t1, A, w, qa0, qa1, qb0, qb1, selq0, selq1, b, more, nb, q0w, cur, c31, rel, kvb, ldsk, ldsv, fk, fv, lane);
      else if (a0) aw_step<true, false, true, HOT>(t0, t1, A, w, qa0, qa1, qb0, qb1, selq0, selq1, b, more, nb, q0w, cur, c31, rel, kvb, ldsk, ldsv, fk, fv, lane);
      else aw_step<false, true, true, HOT>(t0, t1, A, w, qa0, qa1, qb0, qb1, selq0, selq1, b, more, nb, q0w, cur, c31, rel, kvb, ldsk, ldsv, fk, fv, lane);
    } else {
      if (a0 && a1) aw_step<true, true, false, HOT>(t0, t1, A, w, qa0, qa1, qb0, qb1, selq0, selq1, b, more, nb, q0w, cur, c31, rel, kvb, ldsk, ldsv, fk, fv, lane);
      else if (a0) aw_step<true, false, false, HOT>(t0, t1, A, w, qa0, qa1, qb0, qb1, selq0, selq1, b, more, nb, q0w, cur, c31, rel, kvb, ldsk, ldsv, fk, fv, lane);
      else aw_step<false, true, false, HOT>(t0, t1, A, w, qa0, qa1, qb0, qb1, selq0, selq1, b, more, nb, q0w, cur, c31, rel, kvb, ldsk, ldsv, fk, fv, lane);
    }
  }
  asm volatile("s_waitcnt vmcnt(0)" ::: "memory");
  float* xch = A->xch[w];
  if (STORE) { asel_store16<0>(p, t0, xch, q0w, 0, g, lane); asel_store16<1>(p, t1, xch, q0w, 0, g, lane); } else asm volatile("" :: "v"(t0.o0[0]), "v"(t1.o1[2]), "v"(t0.l), "v"(t1.l));
}
template <bool STORE = true, bool HOT = false, bool NLZ = false>
__device__ __forceinline__ void unit_asel_w(const Params& p, int u, AselW* A) {
  int tid = threadIdx.x; asm volatile("" : "+v"(tid));
  const int lane = tid & 63, w = __builtin_amdgcn_readfirstlane(tid >> 6);
  __syncthreads(); asel_w_tables(p, A); __syncthreads();
  asel_w_wave<STORE, HOT, NLZ>(p, u & 1, ((p.S / 32 - 1) - (u >> 1)) * 32 + 8 * w, A, w, lane);
}
template <bool STORE = true>
__device__ __forceinline__ void unit_bout_blk(const Params& p, int layer, int ub, char* smem) {
  int tid = threadIdx.x; asm volatile("" : "+v"(tid));
  const int lane = tid & 63, w = __builtin_amdgcn_readfirstlane(tid >> 6), r32 = lane & 31, hi = lane >> 5;
  const int lt = ub & 3, g = (ub >> 2) & 1, c = ub >> 3, hd = g * 4 + w;
  WaveLds2* L = ((WaveLds2*)smem) + w;
  __syncthreads();
  for (int x = lane; x < 128; x += 64) { L->acs[x] = p.acs[((long)c * 128 + x) * 8 + hd]; L->dtv[x] = p.dt[((long)c * 128 + x) * 8 + hd]; }
  f32x16 acc[2] = {zero16(), zero16()}, acc2[2] = {zero16(), zero16()};
  const SB* xb = p.xconv + (long)c * 128 * 1024; const int l = 32 * lt + r32; const float al = p.acs[((long)c * 128 + l) * 8 + hd];
  const float* cbr = p.cb + ((long)c * 2 + g) * 16384 + (long)l * 128;
  for (int sc = 0; sc <= lt; ++sc) {
    stage_slab<false>(L->x, xb + (long)(32 * sc) * 1024 + hd * 64, 1024, [&](int) { return 1.f; }, lane);
#pragma unroll
    for (int s2 = 0; s2 < 2; ++s2) { float mv[8];
#pragma unroll
      for (int jj = 0; jj < 2; ++jj) { const int s0 = 32 * sc + 16 * s2 + 8 * jj + 4 * hi; const float4 cv = *(const float4*)(cbr + s0); const float4 av = *(const float4*)(&L->acs[s0]); const float4 dv = *(const float4*)(&L->dtv[s0]);
        mv[4 * jj + 0] = (s0 + 0 <= l) ? cv.x * __expf(al - av.x) * dv.x : 0.f; mv[4 * jj + 1] = (s0 + 1 <= l) ? cv.y * __expf(al - av.y) * dv.y : 0.f;
        mv[4 * jj + 2] = (s0 + 2 <= l) ? cv.z * __expf(al - av.z) * dv.z : 0.f; mv[4 * jj + 3] = (s0 + 3 <= l) ? cv.w * __expf(al - av.w) * dv.w : 0.f; }
      u32x4 aw; aw[0] = pk2(mv[0], mv[1]); aw[1] = pk2(mv[2], mv[3]); aw[2] = pk2(mv[4], mv[5]); aw[3] = pk2(mv[6], mv[7]); const bf16x8 af = __builtin_bit_cast(bf16x8, aw);
#pragma unroll
      for (int pt = 0; pt < 2; ++pt) acc[pt] = MFMA32(af, slab_frag(L->x, pt, s2, lane), acc[pt]); } }
  const SB* cmr = xb + (long)l * 1024 + 768 + g * 128; const float* prv = p.states + ((long)c * 8 + hd) * 8192;
#pragma unroll 2
  for (int ks = 0; ks < 8; ++ks) { const bf16x8 af = *(const bf16x8*)(cmr + 16 * ks + 8 * hi);
#pragma unroll
    for (int pt = 0; pt < 2; ++pt) { const float* pr = prv + (long)(32 * pt + r32) * 128 + 16 * ks + 8 * hi; const float4 a0 = *(const float4*)pr, a1 = *(const float4*)(pr + 4);
      u32x4 bw; bw[0] = pk2(a0.x, a0.y); bw[1] = pk2(a0.z, a0.w); bw[2] = pk2(a1.x, a1.y); bw[3] = pk2(a1.z, a1.w);
      acc2[pt] = MFMA32(af, __builtin_bit_cast(bf16x8, bw), acc2[pt]); } }
  const float dsk = p.b_d[layer * 8 + hd];
  float* yl = (float*)L;
#pragma unroll
  for (int e = 0; e < 16; ++e) { const int lr = crow(e, hi); const float ea = __expf(L->acs[32 * lt + lr]);
#pragma unroll
    for (int pt = 0; pt < 2; ++pt) { const int pp = 32 * pt + r32; yl[lr * 64 + pp] = acc[pt][e] + ea * acc2[pt][e] + dsk * bf2f(xb[(long)(32 * lt + lr) * 1024 + hd * 64 + pp]); } }
  __syncthreads();
  { const int row = tid >> 3, sub = tid & 7; const long t = (long)c * 128 + 32 * lt + row; SB* mp = p.mix + t * NMIX + MX_B + g * 256 + sub * 32;
    const float* ysrc = (const float*)(((WaveLds2*)smem) + (sub >> 1)) + row * 64 + (sub & 1) * 32;
    float vv[32]; float ss = 0.f;
#pragma unroll
    for (int i = 0; i < 4; ++i) { const uint4 zz = *(const uint4*)(mp + 8 * i); const unsigned zw[4] = {zz.x, zz.y, zz.z, zz.w};
#pragma unroll
      for (int k = 0; k < 4; ++k) { const float y0 = ysrc[8 * i + 2 * k] * __uint_as_float(zw[k] << 16), y1 = ysrc[8 * i + 2 * k + 1] * __uint_as_float(zw[k] & 0xffff0000u); vv[8 * i + 2 * k] = y0; vv[8 * i + 2 * k + 1] = y1; ss += y0 * y0 + y1 * y1; } }
    ss += __shfl_xor(ss, 1); ss += __shfl_xor(ss, 2); ss += __shfl_xor(ss, 4);
    const float r = 1.f / sqrtf(ss * (1.f / 256.f) + 1e-6f); const float* wn = p.b_norm + layer * 512 + g * 256 + sub * 32;
#pragma unroll
    for (int i = 0; i < 4; ++i) { uint4 o; o.x = pk2(vv[8 * i] * r * wn[8 * i], vv[8 * i + 1] * r * wn[8 * i + 1]); o.y = pk2(vv[8 * i + 2] * r * wn[8 * i + 2], vv[8 * i + 3] * r * wn[8 * i + 3]);
      o.z = pk2(vv[8 * i + 4] * r * wn[8 * i + 4], vv[8 * i + 5] * r * wn[8 * i + 5]); o.w = pk2(vv[8 * i + 6] * r * wn[8 * i + 6], vv[8 * i + 7] * r * wn[8 * i + 7]); if (STORE) *(uint4*)(mp + 8 * i) = o; else asm volatile("" :: "v"(o.x), "v"(o.w)); } }
}

__device__ __forceinline__ void unit_memkv(const Params& p, int u, int lane) {
  const int l = u >> 8, m = u & 255; const float* row = p.mem + (long)m * DM; const float* nw = p.m_norm + l * DM; const float* w = p.m_wkv + (long)l * DM * 512 + lane * 8;
  float ss = 0.f;
#pragma unroll
  for (int i = 0; i < 4; ++i) { const float4 v = *(const float4*)(row + i * 256 + lane * 4); ss += v.x * v.x + v.y * v.y + v.z * v.z + v.w * v.w; }
  ss = wave_sum_f(ss); const float r = 1.f / sqrtf(ss * (1.f / DM) + 1e-6f);
  float acc[8] = {0.f, 0.f, 0.f, 0.f, 0.f, 0.f, 0.f, 0.f};
#pragma unroll 8
  for (int d = 0; d < DM; ++d) { const float a = row[d] * r * nw[d]; const float4 w0 = *(const float4*)(w + (long)d * 512), w1 = *(const float4*)(w + (long)d * 512 + 4);
    acc[0] += a * w0.x; acc[1] += a * w0.y; acc[2] += a * w0.z; acc[3] += a * w0.w; acc[4] += a * w1.x; acc[5] += a * w1.y; acc[6] += a * w1.z; acc[7] += a * w1.w; }
  uint4 o; o.x = pk2(acc[0], acc[1]); o.y = pk2(acc[2], acc[3]); o.z = pk2(acc[4], acc[5]); o.w = pk2(acc[6], acc[7]);
  *(uint4*)(p.memkv + (long)u * 512 + lane * 8) = o;
}

__device__ __forceinline__ void item_dmerge(const Params& p, long gid) {
  const int c8 = (int)(gid & 63), h = c8 >> 3; const long q = gid >> 6; const long S = p.S;
  const float l0 = p.dlse[(0 * S + q) * 8 + h], l1 = p.dlse[(1 * S + q) * 8 + h], l2 = p.dlse[(2 * S + q) * 8 + h];
  const float mm = fmaxf(l0, fmaxf(l1, l2)); float e0 = __expf(l0 - mm), e1 = __expf(l1 - mm), e2 = __expf(l2 - mm); const float is = 1.f / (e0 + e1 + e2); e0 *= is; e1 *= is; e2 *= is;
  const long c = q * 512 + c8 * 8; const uint4 a = *(const uint4*)(p.dop + c), b = *(const uint4*)(p.dop + S * 512 + c), d = *(const uint4*)(p.dop + 2 * S * 512 + c);
  SB* mp = p.mix + q * NMIX + MX_D + c8 * 8; const uint4 z = *(const uint4*)mp;
  const unsigned aw[4] = {a.x, a.y, a.z, a.w}, bw[4] = {b.x, b.y, b.z, b.w}, dw[4] = {d.x, d.y, d.z, d.w}, zw[4] = {z.x, z.y, z.z, z.w}; unsigned ow[4];
#pragma unroll
  for (int k = 0; k < 4; ++k) {
    const float lo = (e0 * __uint_as_float(aw[k] << 16) + e1 * __uint_as_float(bw[k] << 16) + e2 * __uint_as_float(dw[k] << 16)) * __uint_as_float(zw[k] << 16);
    const float hi = (e0 * __uint_as_float(aw[k] & 0xffff0000u) + e1 * __uint_as_float(bw[k] & 0xffff0000u) + e2 * __uint_as_float(dw[k] & 0xffff0000u)) * __uint_as_float(zw[k] & 0xffff0000u);
    ow[k] = pk2(lo, hi); }
  uint4 o; o.x = ow[0]; o.y = ow[1]; o.z = ow[2]; o.w = ow[3]; *(uint4*)mp = o;
}

__device__ __forceinline__ void unit_cmp_blk(const Params& p, int layer, int u, float* red  ) {
  int tid = threadIdx.x; asm volatile("" : "+v"(tid));
  const int lane = tid & 63, w = __builtin_amdgcn_readfirstlane(tid >> 6), r32 = lane & 31, hi = lane >> 5;
  const int ncmp = p.S / 16, ntile = ncmp * 2 / 32; const int kv = u / ntile, rt = u % ntile;
  const int r = 32 * rt + r32, j = r >> 1, hk = r & 1;
  const unsigned short* w1t = p.w1t + (long)kv * 128 * 2048; const unsigned short* w2t = p.w2t + kv * 64 * 128; const float* pe = p.cmp_pos + (long)(layer * 2 + kv) * 32 * 64;
  const SB* src = p.proj + PA_KV + kv * 128 + hk * 64;
  f32x16 acc[4] = {zero16(), zero16(), zero16(), zero16()};
#pragma unroll 4
  for (int ks = 32 * w; ks < 32 * w + 32; ++ks) { const int t = ks >> 2, d = (ks & 3) * 16 + 8 * hi; const long tok = 16 * j + t;
    const float4 p0 = *(const float4*)(pe + t * 64 + d), p1 = *(const float4*)(pe + t * 64 + d + 4); float v[8] = {p0.x, p0.y, p0.z, p0.w, p1.x, p1.y, p1.z, p1.w};
    { const long tokc = tok < p.S ? tok : (long)p.S - 1; const float vm = tok < p.S ? 1.f : 0.f;
      const uint4 vv = *(const uint4*)(src + tokc * NPROJ + d); const unsigned wd[4] = {vv.x, vv.y, vv.z, vv.w};
#pragma unroll
      for (int k = 0; k < 4; ++k) { v[2 * k] += vm * __uint_as_float(wd[k] << 16); v[2 * k + 1] += vm * __uint_as_float(wd[k] & 0xffff0000u); } }
    u32x4 bw; bw[0] = pk2(v[0], v[1]); bw[1] = pk2(v[2], v[3]); bw[2] = pk2(v[4], v[5]); bw[3] = pk2(v[6], v[7]); const bf16x8 bfr = __builtin_bit_cast(bf16x8, bw);
#pragma unroll
    for (int ut = 0; ut < 4; ++ut) { const bf16x8 af = *(const bf16x8*)(w1t + (long)(32 * ut + r32) * 2048 + 16 * ks + 8 * hi); acc[ut] = MFMA32(af, bfr, acc[ut]); } }
  __syncthreads();
#pragma unroll
  for (int ut = 0; ut < 4; ++ut)
#pragma unroll
    for (int q4 = 0; q4 < 4; ++q4) *(float4*)&red[(((w * 4 + ut) * 4 + q4) * 64 + lane) * 4] = make_float4(acc[ut][4 * q4], acc[ut][4 * q4 + 1], acc[ut][4 * q4 + 2], acc[ut][4 * q4 + 3]);
  __syncthreads();
  f32x16 hsum = zero16();
#pragma unroll
  for (int w2 = 0; w2 < 4; ++w2)
#pragma unroll
    for (int q4 = 0; q4 < 4; ++q4) { const float4 t4 = *(const float4*)&red[(((w2 * 4 + w) * 4 + q4) * 64 + lane) * 4]; hsum[4 * q4] += t4.x; hsum[4 * q4 + 1] += t4.y; hsum[4 * q4 + 2] += t4.z; hsum[4 * q4 + 3] += t4.w; }
#pragma unroll
  for (int e = 0; e < 16; ++e) hsum[e] = gelu_f(hsum[e]);
  f32x16 o2[2] = {zero16(), zero16()};
#pragma unroll
  for (int s2 = 0; s2 < 2; ++s2) { const bf16x8 hb = pack8(hsum, 8 * s2);
#pragma unroll
    for (int dt = 0; dt < 2; ++dt) { const unsigned short* wr = w2t + (32 * dt + r32) * 128 + 32 * w + 16 * s2 + 4 * hi; const uint2 x0 = *(const uint2*)wr, x1 = *(const uint2*)(wr + 8);
      u32x4 aw; aw[0] = x0.x; aw[1] = x0.y; aw[2] = x1.x; aw[3] = x1.y; o2[dt] = MFMA32(__builtin_bit_cast(bf16x8, aw), hb, o2[dt]); } }
  __syncthreads();
#pragma unroll
  for (int dt = 0; dt < 2; ++dt)
#pragma unroll
    for (int q4 = 0; q4 < 4; ++q4) *(float4*)&red[(((w * 2 + dt) * 4 + q4) * 64 + lane) * 4] = make_float4(o2[dt][4 * q4], o2[dt][4 * q4 + 1], o2[dt][4 * q4 + 2], o2[dt][4 * q4 + 3]);
  __syncthreads();
  if (w < 2) {
    const int dt = w; SB* dst = p.kvc + ((long)kv * ncmp * 2 + r) * 64;
#pragma unroll
    for (int q4 = 0; q4 < 4; ++q4) { float4 s4 = make_float4(0.f, 0.f, 0.f, 0.f);
#pragma unroll
      for (int w2 = 0; w2 < 4; ++w2) { const float4 t4 = *(const float4*)&red[(((w2 * 2 + dt) * 4 + q4) * 64 + lane) * 4]; s4.x += t4.x; s4.y += t4.y; s4.z += t4.z; s4.w += t4.w; }
      dst[32 * dt + crow(4 * q4 + 0, hi)] = f2bf(s4.x); dst[32 * dt + crow(4 * q4 + 1, hi)] = f2bf(s4.y); dst[32 * dt + crow(4 * q4 + 2, hi)] = f2bf(s4.z); dst[32 * dt + crow(4 * q4 + 3, hi)] = f2bf(s4.w); } }
}

#define SEQ 16384
#define DEPTH 4

__device__ __forceinline__ int n2o(int n) {
  if (n < 1280) return n;
  if (n < 2304) return n - 1280 + 1816;
  if (n < 2816) return n - 2304 + 3360;
  if (n < 3072) return n - 2816 + 3872;
  if (n < 4608) return n - 3072 + 4640;
  if (n < 5632) return n - 4608 + 6176;
  if (n < 5888) return n - 5632 + 7712;
  n -= 5888;
  if (n < 512) return 1304 + n;
  if (n < 1024) return 2848 + n - 512;
  if (n < 1536) return 4128 + n - 1024;
  if (n < 2048) return 7200 + n - 1536;
  if (n < 2304) return 7968 + n - 2048;
  n -= 2304;
  if (n < 24) return 1280 + n;
  if (n < 32) return 2840 + n - 24;
  return -1;
}

template <bool MAP>
__device__ __forceinline__ void cvt_tile(const float* __restrict__ src, int lds_, unsigned short* __restrict__ dst, int ldd, int k0, int n0, float* tile  ) {
  int tid = threadIdx.x; asm volatile("" : "+v"(tid));
  __syncthreads();
#pragma unroll
  for (int e = 0; e < 16; ++e) { int idx = tid + 256 * e, kk = idx >> 6, nn = idx & 63; int oc = MAP ? n2o(n0 + nn) : (n0 + nn);
    tile[kk * 65 + nn] = (oc >= 0) ? src[(long)(k0 + kk) * lds_ + oc] : 0.f; }
  __syncthreads();
#pragma unroll
  for (int e = 0; e < 16; ++e) { int idx = tid + 256 * e, nn = idx >> 6, kk = idx & 63; dst[(long)(n0 + nn) * ldd + k0 + kk] = f2bf(tile[kk * 65 + nn]); }
}

__device__ __forceinline__ float wave_sum(float v) {
#pragma unroll
  for (int o = 32; o > 0; o >>= 1) v += __shfl_xor(v, o);
  return v;
}

__device__ __forceinline__ void norm_row_wave(const Params& p, int layer, int t, bool do_h, int lane) {
  const float* xin = (layer == 0) ? p.x + (long)t * DM : p.out + (long)t * DM;
  float4 xv[4], yv[4];
#pragma unroll
  for (int i = 0; i < 4; ++i) xv[i] = *(const float4*)(xin + i * 256 + lane * 4);
  if (layer > 0) {
    float ss = 0.f;
#pragma unroll
    for (int i = 0; i < 4; ++i) { yv[i] = *(const float4*)(p.y + (long)t * DM + i * 256 + lane * 4); ss += yv[i].x * yv[i].x + yv[i].y * yv[i].y + yv[i].z * yv[i].z + yv[i].w * yv[i].w; }
    ss = wave_sum(ss); float r1 = 1.f / sqrtf(ss / DM + 1e-6f);
#pragma unroll
    for (int i = 0; i < 4; ++i) { float4 w = *(const float4*)(p.post_norm + (layer - 1) * DM + i * 256 + lane * 4);
      xv[i].x += yv[i].x * r1 * w.x; xv[i].y += yv[i].y * r1 * w.y; xv[i].z += yv[i].z * r1 * w.z; xv[i].w += yv[i].w * r1 * w.w; }
  }
  float ss2 = 0.f;
#pragma unroll
  for (int i = 0; i < 4; ++i) { *(float4*)(p.out + (long)t * DM + i * 256 + lane * 4) = xv[i]; ss2 += xv[i].x * xv[i].x + xv[i].y * xv[i].y + xv[i].z * xv[i].z + xv[i].w * xv[i].w; }
  if (!do_h) return;
  ss2 = wave_sum(ss2); float r2 = 1.f / sqrtf(ss2 / DM + 1e-6f);
#pragma unroll
  for (int i = 0; i < 4; ++i) { float4 w = *(const float4*)(p.pre_norm + layer * DM + i * 256 + lane * 4);
    ushort4 o; o.x = f2bf(xv[i].x * r2 * w.x); o.y = f2bf(xv[i].y * r2 * w.y); o.z = f2bf(xv[i].z * r2 * w.z); o.w = f2bf(xv[i].w * r2 * w.w);
    *(ushort4*)(p.h + (long)t * DM + i * 256 + lane * 4) = o; }
}

#ifndef GMI
#define GMI 4
#endif
struct GemmSmem { unsigned short a[3][64 * GMI * 32]; unsigned short b[3][128 * 32]; };
__device__ __forceinline__ void glds16(const void* g, void* lds_wave_base) { __builtin_amdgcn_global_load_lds((gptr_t)g, (lptr_t)lds_wave_base, 16, 0, 0); }
template <int EPI, int MI, bool DRY = false>
__device__ __forceinline__ void gemm_tile(const Params& p, const unsigned short* __restrict__ A, int lda, const unsigned short* __restrict__ Bt, int ldb, int K, int m0, int n0, GemmSmem& sm, float* outp = nullptr) {
  int tid = threadIdx.x; asm volatile("" : "+v"(tid));
  const int lane = tid & 63, wid = __builtin_amdgcn_readfirstlane(tid >> 6), wr = wid >> 1, wc = wid & 1, r = lane & 31, h = lane >> 5;
  f32x16 acc[MI][2];
#pragma unroll
  for (int i = 0; i < MI; ++i)
#pragma unroll
    for (int j = 0; j < 2; ++j) acc[i][j] = zero16();
  const int prow = lane >> 2, pc = lane & 3;
  const unsigned short* ga[MI]; const unsigned short* gb[2];
#pragma unroll
  for (int i = 0; i < MI; ++i) { const int row = (wid * MI + i) * 16 + prow; ga[i] = A + (long)(m0 + row) * lda + ((pc ^ ((row >> 2) & 3)) * 8); }
#pragma unroll
  for (int i = 0; i < 2; ++i) { const int row = (wid * 2 + i) * 16 + prow; gb[i] = Bt + (long)(n0 + row) * ldb + ((pc ^ ((row >> 2) & 3)) * 8); }
#define GEMM_DMA(stg, ko) { _Pragma("unroll") for (int i_ = 0; i_ < MI; ++i_) glds16(ga[i_] + (ko), &sm.a[stg][(wid * MI + i_) * 512]); _Pragma("unroll") for (int i_ = 0; i_ < 2; ++i_) glds16(gb[i_] + (ko), &sm.b[stg][(wid * 2 + i_) * 512]); }
  __syncthreads();
  const int nk = K / 32;
  GEMM_DMA(0, 0)
  if (nk > 1) GEMM_DMA(1, 32)
  int cur = 0;
  for (int kt = 0; kt < nk; ++kt) {
    if (kt + 1 < nk) { if (MI == 4) asm volatile("s_waitcnt vmcnt(6) lgkmcnt(0)\n\ts_barrier" ::: "memory"); else asm volatile("s_waitcnt vmcnt(4) lgkmcnt(0)\n\ts_barrier" ::: "memory"); }
    else asm volatile("s_waitcnt vmcnt(0) lgkmcnt(0)\n\ts_barrier" ::: "memory");
    if (kt + 2 < nk) { const int s2_ = (cur == 0) ? 2 : cur - 1; GEMM_DMA(s2_, (kt + 2) * 32) }
#pragma unroll
    for (int ks = 0; ks < 2; ++ks) {
      bf16x8 af[MI], bfr[2];
#pragma unroll
      for (int i = 0; i < MI; ++i) { const int row = wr * (32 * MI) + i * 32 + r; af[i] = *(const bf16x8*)&sm.a[cur][row * 32 + (((2 * ks + h) ^ ((row >> 2) & 3)) * 8)]; }
#pragma unroll
      for (int j = 0; j < 2; ++j) { const int row = wc * 64 + j * 32 + r; bfr[j] = *(const bf16x8*)&sm.b[cur][row * 32 + (((2 * ks + h) ^ ((row >> 2) & 3)) * 8)]; }
#pragma unroll
      for (int i = 0; i < MI; ++i)
#pragma unroll
        for (int j = 0; j < 2; ++j) acc[i][j] = __builtin_amdgcn_mfma_f32_32x32x16_bf16(af[i], bfr[j], acc[i][j], 0, 0, 0);
    }
    cur = (cur == 2) ? 0 : cur + 1;
  }
#undef GEMM_DMA
  __syncthreads();
  if (DRY) {
#pragma unroll
    for (int i = 0; i < MI; ++i) asm volatile("" :: "v"(acc[i][0]), "v"(acc[i][1]));
    return; }
  const int ncol0 = n0 + wc * 64;
  const int mrow0 = m0 + wr * (32 * MI);
  if (EPI == 2) {
#pragma unroll
    for (int i = 0; i < MI; ++i)
#pragma unroll
      for (int j = 0; j < 2; ++j)
#pragma unroll
        for (int e = 0; e < 16; ++e) { int row = mrow0 + i * 32 + (e & 3) + 8 * (e >> 2) + 4 * h; outp[row * 128 + ncol0 + j * 32 + r] = acc[i][j][e]; }
  } else if (EPI == 1) {
#pragma unroll
    for (int i = 0; i < MI; ++i)
#pragma unroll
      for (int j = 0; j < 2; ++j)
#pragma unroll
        for (int e = 0; e < 16; ++e) { int row = mrow0 + i * 32 + (e & 3) + 8 * (e >> 2) + 4 * h; p.y[(long)row * DM + ncol0 + j * 32 + r] = acc[i][j][e]; }
  } else {
    if (ncol0 < 8192) {
      const bool toproj = ncol0 < NPROJ; const bool rope = toproj && (ncol0 >= PC_Q && ncol0 < PC_KV + 128);
      unsigned short* stg = ((unsigned short*)&sm) + wid * (64 * 72);
      SB* gdst = toproj ? (p.proj + ncol0) : (p.mix + (ncol0 - NPROJ)); const long gld = toproj ? NPROJ : NMIX;
#pragma unroll
      for (int hf = 0; hf < MI / 2; ++hf) {
#pragma unroll
        for (int i2 = 0; i2 < 2; ++i2) { const int i = hf * 2 + i2;
#pragma unroll
          for (int e = 0; e < 16; ++e) { const int rl = i2 * 32 + (e & 3) + 8 * (e >> 2) + 4 * h; float v0 = acc[i][0][e], v1 = acc[i][1][e];
            if (rope) { const int row = mrow0 + hf * 64 + rl; const float c = p.rope_cs[row * 32 + r], s = p.rope_sn[row * 32 + r]; const float t1 = v0, t2 = v1; v0 = t1 * c - t2 * s; v1 = t2 * c + t1 * s; }
            if (!toproj) { v0 = silu_f(v0); v1 = silu_f(v1); }
            stg[rl * 72 + r] = f2bf(v0); stg[rl * 72 + 32 + r] = f2bf(v1); } }
#pragma unroll
        for (int c8 = 0; c8 < 8; ++c8) { const int idx = lane + 64 * c8, rl = idx >> 3, ch = idx & 7; const uint4 vv = *(const uint4*)&stg[rl * 72 + ch * 8];
          *(uint4*)(gdst + (long)(mrow0 + hf * 64 + rl) * gld + ch * 8) = vv; }
      }
    } else if (ncol0 == 8192) {
#pragma unroll
      for (int i = 0; i < MI; ++i)
#pragma unroll
        for (int e = 0; e < 16; ++e) { int row = mrow0 + i * 32 + (e & 3) + 8 * (e >> 2) + 4 * h; p.small[(long)row * NSMALL + r] = acc[i][0][e]; }
    }
  }
}

__device__ __forceinline__ unsigned tx_() { unsigned t = threadIdx.x; asm volatile("" : "+v"(t)); return t; }
__device__ __forceinline__ int gw0(int) { return (int)((blockIdx.x * 256u + tx_()) >> 6); }
__device__ __forceinline__ int bid0() { int b = blockIdx.x; asm volatile("" : "+s"(b)); return b; }

#define XB_TMO      128
#define XB_XCNT(j)  (256  + 64 * (j))
#define XB_XSUB(j)  (1280 + 64 * (j))
#define XB_XGEN(j)  (2304 + 64 * (j))
#define XB_TOP      3328
#define XB_TOPGEN   3392
#define XCD_BAR_WORDS 3456
#define XB_SPIN_CAP (1u << 28)
__device__ __forceinline__ unsigned xb_ld(unsigned* p) { return __hip_atomic_load(p, __ATOMIC_RELAXED, __HIP_MEMORY_SCOPE_AGENT); }
__device__ __forceinline__ unsigned xb_add(unsigned* p, unsigned v) { return __hip_atomic_fetch_add(p, v, __ATOMIC_RELAXED, __HIP_MEMORY_SCOPE_AGENT); }
__device__ __forceinline__ unsigned xb_xcc_id() { return (unsigned)__builtin_amdgcn_s_getreg((3 << 11) | 20) & 0xFu; }
#define XB_SPIN(cond, bar) do { unsigned _sp = 0; while (cond) { __builtin_amdgcn_s_sleep(1); \
    if ((++_sp & 255u) == 0u) { if (xb_ld(&(bar)[XB_TMO])) break; if (_sp > XB_SPIN_CAP) { atomicAdd(&(bar)[XB_TMO], 1u); break; } } } } while (0)
struct XcdBarrier { unsigned* bar; unsigned x; volatile LDS3 unsigned* st; };
__device__ __forceinline__ XcdBarrier xcd_barrier_post(unsigned* bar, volatile LDS3 unsigned* st) {
  XcdBarrier b; b.bar = bar; b.x = xb_xcc_id(); b.st = st;
  if (threadIdx.x == 0) (void)xb_add(&bar[XB_XCNT(b.x)], 1u);
  return b;
}
__device__ __forceinline__ void xcd_barrier_complete(unsigned* bar, unsigned x, unsigned& nloc, unsigned& nx) {
  const unsigned G = gridDim.x; unsigned sum, cnt, mine, sp = 0u;
  for (;;) { sum = 0u; cnt = 0u; mine = 0u;
#pragma unroll
    for (unsigned j = 0; j < 16; ++j) { const unsigned c = xb_ld(&bar[XB_XCNT(j)]); sum += c; cnt += (c > 0u) ? 1u : 0u; mine = (j == x) ? c : mine; }
    if (sum == G) break;
    __builtin_amdgcn_s_sleep(1);
    if ((++sp & 255u) == 0u) { if (xb_ld(&bar[XB_TMO])) break; if (sp > XB_SPIN_CAP) { atomicAdd(&bar[XB_TMO], 1u); break; } } }
  nloc = mine > 0u ? mine : 1u; nx = cnt > 0u ? cnt : 1u;
}
__device__ __forceinline__ void xcd_barrier(const XcdBarrier& b) {
  asm volatile("s_waitcnt vmcnt(0)" ::: "memory");
  __syncthreads();
  if (threadIdx.x == 0) {
    unsigned* bar = b.bar;
    __builtin_amdgcn_s_waitcnt(0);
    unsigned nloc = b.st[0], nx = b.st[1];
    if (nloc == 0u) { xcd_barrier_complete(bar, b.x, nloc, nx); b.st[0] = nloc; b.st[1] = nx; }
    const unsigned old = xb_add(&bar[XB_XSUB(b.x)], 1u);
    const unsigned gen = old / nloc;
    if (old + 1u == (gen + 1u) * nloc) {
      __builtin_amdgcn_fence(__ATOMIC_RELEASE, "agent");
      asm volatile("s_waitcnt vmcnt(0)" ::: "memory");
      const unsigned og = xb_add(&bar[XB_TOP], 1u);
      const unsigned tg = og / nx;
      if (og + 1u == (tg + 1u) * nx) xb_add(&bar[XB_TOPGEN], 1u);
      else XB_SPIN(xb_ld(&bar[XB_TOPGEN]) == tg, bar);
      __builtin_amdgcn_fence(__ATOMIC_ACQUIRE, "agent");
      xb_add(&bar[XB_XGEN(b.x)], 1u);
      asm volatile("s_waitcnt vmcnt(0)" ::: "memory");
    } else {
      XB_SPIN(xb_ld(&bar[XB_XGEN(b.x)]) == gen, bar);
      __builtin_amdgcn_fence(__ATOMIC_ACQUIRE, "agent");
      asm volatile("s_waitcnt vmcnt(0)" ::: "memory");
    }
  }
  __syncthreads();
}

struct KArgs { const void* in[20]; float* out; char* ws; };
#ifdef SELFCHK
#define RUN_S 4096
#else
#define RUN_S SEQ
#endif
__host__ __device__ __forceinline__ size_t fill_ws(Params& p, Params& p2, char* w) {
  size_t off = 0;
#define TAKE(bytes) (w + ((off += (((size_t)(bytes)) + 255) & ~(size_t)255) - ((((size_t)(bytes)) + 255) & ~(size_t)255)))
  const size_t S = RUN_S, ncmp = S / 16, nc = S / 128;
  p.S = RUN_S;
  p.wt_in = (unsigned short*)TAKE(8320 * 1024 * 2); p.wt_out = (unsigned short*)TAKE(2 * 1024 * 2304 * 2); p.w1t = (unsigned short*)TAKE(2 * 128 * 2048 * 2); p.w2t = (unsigned short*)TAKE(2 * 64 * 128 * 2);
  p.h = (SB*)TAKE(S * 1024 * 2); p.ybuf = (float*)p.h;
  p.proj = (SB*)TAKE(S * NPROJ * 2); p.y = (float*)p.proj;
  p.small = (float*)TAKE(S * 32 * 4); p.mix = (SB*)TAKE(S * NMIX * 2);
  p.rope_cs = (float*)TAKE(S * 32 * 4); p.rope_sn = (float*)TAKE(S * 32 * 4); p.tabA = (float*)TAKE(8 * TABA_N * 4); p.tabD = (float*)TAKE(24 * TABD_N * 4);
  p.memkv = (SB*)TAKE(4 * 256 * 512 * 2); p.hid = (float*)TAKE(2 * ncmp * 256 * 4); p.kvc = (SB*)TAKE(2 * ncmp * 128 * 2);
  p.cml = (float*)TAKE(S * 16 * 4); p.idx = (int*)TAKE(S * 32 * 4); p.oc = (SB*)TAKE(S * 512 * 2); p.ow = (SB*)TAKE(S * 512 * 2);
  p.dop = (SB*)TAKE(3 * S * 512 * 2); p.dlse = (float*)TAKE(3 * S * 8 * 4); p.xconv = (SB*)TAKE(S * 1024 * 2);
  p.dt = (float*)TAKE(S * 8 * 4); p.acs = (float*)TAKE(S * 8 * 4); p.wst = (float*)TAKE(S * 8 * 4); p.cb = (float*)TAKE(nc * 2 * 128 * 128 * 4); p.states = (float*)TAKE(nc * 65536 * 4);
  p.bar = (unsigned*)TAKE(131072);
  p2 = p;
#ifdef SELFCHK
  p.imp = (float*)TAKE(S * 512 * 4);
  p2.mix = (SB*)TAKE(S * NMIX * 2); p2.ow = (SB*)TAKE(S * 512 * 2); p2.oc = (SB*)TAKE(S * 512 * 2); p2.dop = (SB*)TAKE(3 * S * 512 * 2); p2.dlse = (float*)TAKE(3 * S * 8 * 4);
  p2.cml = (float*)TAKE(S * 16 * 4); p2.imp = (float*)TAKE(S * 512 * 4); p2.idx = (int*)TAKE(S * 32 * 4); p2.cb = (float*)TAKE(nc * 2 * 128 * 128 * 4);
  p2.kvc = (SB*)TAKE(2 * ncmp * 128 * 2); p2.xconv = (SB*)TAKE(S * 1024 * 2); p2.dt = (float*)TAKE(S * 8 * 4); p2.acs = (float*)TAKE(S * 8 * 4); p2.wst = (float*)TAKE(S * 8 * 4);
  p2.states = (float*)TAKE(nc * 65536 * 4); p2.ybuf = (float*)TAKE(S * 512 * 4); p.ybuf = (float*)TAKE(S * 512 * 4);
#else
  p.imp = (float*)p.dop; p2 = p;
#endif
  return off;
}
__host__ __device__ __forceinline__ void fill_inputs(Params& p, const KArgs& a) {
  p.x = (const float*)a.in[0]; p.mem = (const float*)a.in[1]; p.pos = (const int*)a.in[2]; p.pre_norm = (const float*)a.in[3]; p.post_norm = (const float*)a.in[4];
  p.w_in = (const float*)a.in[5]; p.w_out = (const float*)a.in[6]; p.rel_bias = (const float*)a.in[7]; p.cmp_pos = (const float*)a.in[8]; p.cmp_w1 = (const float*)a.in[9];
  p.cmp_w2 = (const float*)a.in[10]; p.conv_w = (const float*)a.in[11]; p.conv_b = (const float*)a.in[12]; p.dt_bias = (const float*)a.in[13]; p.a_log = (const float*)a.in[14];
  p.b_d = (const float*)a.in[15]; p.b_norm = (const float*)a.in[16]; p.sinks = (const float*)a.in[17]; p.m_norm = (const float*)a.in[18]; p.m_wkv = (const float*)a.in[19];
  p.out = a.out;
}
#define GS(N, ...) { long g0_ = (long)blockIdx.x * 256 + tx_(); for (long gid = g0_; gid < (long)(N); gid += gsz) { __VA_ARGS__; } }
#define WU(N, ...) { for (int u_ = gw0(gwave); u_ < (int)(N); u_ += nwave) { const int u = __builtin_amdgcn_readfirstlane(u_); const unsigned tq_ = tx_(); int lane = tq_ & 63; \
    WaveLds* WL = ((WaveLds*)smem_raw) + __builtin_amdgcn_readfirstlane((int)(tq_ >> 6)); __VA_ARGS__; } }
#define GSYNC() xcd_barrier(xb)
#ifndef CMP_SKIP
#define CMP_SKIP 3
#endif
#define WUQ(slot, CH, N, ...) { unsigned* cq_ = &p.bar[4096 + (layer * 8 + (slot)) * 64 * 8 + (blockIdx.x & 7) * 64]; for (;;) { unsigned t_ = 0u; if ((tx_() & 63) == 0) t_ = atomicAdd(cq_, 1u); \
    const int c0_ = __builtin_amdgcn_readfirstlane((int)t_) * (CH); if ((c0_ * 8 + (int)(blockIdx.x & 7)) >= (int)(N)) break; \
    for (int ci_ = 0; ci_ < (CH); ++ci_) { const int u = (c0_ + ci_) * 8 + (int)(blockIdx.x & 7); if (u >= (int)(N)) break; const unsigned tq_ = tx_(); int lane = tq_ & 63; \
      WaveLds* WL = ((WaveLds*)smem_raw) + __builtin_amdgcn_readfirstlane((int)(tq_ >> 6)); (void)WL; __VA_ARGS__; } } }
#ifndef ASELW
#define ASELW 1
#endif
#if ASELW == 1
#define ASEL_UNIT(pp, uu) unit_asel_w((pp), (uu), (AselW*)smem_raw)
#else
#define ASEL_UNIT(pp, uu) unit_asel_blk((pp), (uu), (AselLds*)smem_raw)
#endif
#define SMEM_A_ (sizeof(AselLds) > sizeof(AselW) ? sizeof(AselLds) : sizeof(AselW))
#define SMEM_BYTES (SMEM_A_ > sizeof(GemmSmem) ? ((SMEM_A_ + 15) & ~(size_t)15) : sizeof(GemmSmem))
#define gtid ((long)blockIdx.x * 256 + tx_())
#define gwave ((int)((blockIdx.x * 256u + tx_()) >> 6))
#define KERNEL_PROLOGUE \
  Params p, p2; p.pad0 = 0; fill_inputs(p, ka); fill_ws(p, p2, ka.ws); \
  cg::grid_group grid = cg::this_grid(); \
  __shared__ __attribute__((aligned(16))) char smem_raw[SMEM_BYTES + 16]; \
  volatile LDS3 unsigned* xbst = (volatile LDS3 unsigned*)(smem_raw + SMEM_BYTES); \
  if (threadIdx.x < 4) xbst[threadIdx.x] = 0u; \
  __syncthreads(); \
  XcdBarrier xb = xcd_barrier_post(p.bar, xbst); \
  GemmSmem& gsm = *(GemmSmem*)smem_raw; float* ftile = (float*)smem_raw; \
  const long gsz = (long)gridDim.x * 256; const int nwave = (int)(gsz >> 6); \
  const int S = p.S, ncmp = S / 16, nc = S / 128, nqt = S / 32; (void)ncmp; (void)nc; (void)nqt; (void)ftile; (void)gsm; \
  GS((long)S * 32, ph_rope(p, gid)); \
  GS(8 * TABA_N + 24 * TABD_N, ph_tabs(p, gid)); \
  WU(DEPTH * 256, unit_memkv(p, u, lane));
#define PHASE_NORM(layer) \
    for (int t = gw0(gwave); t < S; t += nwave) { int lane = tx_() & 63; norm_row_wave(p, layer, t, true, lane); }
#define PHASE_CVT(layer) \
    { const float* wi = p.w_in + (long)(layer) * 1024 * 8224; unsigned short* wob_ = p.wt_out + (long)((layer) & 1) * 1024 * 2304; \
      for (int tl = bid0(); tl < 16 * 130; tl += gridDim.x) cvt_tile<true>(wi, 8224, p.wt_in, 1024, (tl & 15) * 64, (tl >> 4) * 64, ftile); \
      const float* wo = p.w_out + (long)(layer) * 2304 * 1024; \
      for (int tl = bid0(); tl < 36 * 16; tl += gridDim.x) cvt_tile<false>(wo, 1024, wob_, 2304, (tl % 36) * 64, (tl / 36) * 64, ftile); \
      for (int tl = bid0(); tl < 2 * 64; tl += gridDim.x) { const int kv = tl >> 6, t6 = tl & 63; cvt_tile<false>(p.cmp_w1 + (long)((layer) * 2 + kv) * 2048 * 128, 128, p.w1t + (long)kv * 128 * 2048, 2048, (t6 >> 1) * 64, (t6 & 1) * 64, ftile); } \
      for (int tl = bid0(); tl < 2 * 2; tl += gridDim.x) { const int kv = tl >> 1; cvt_tile<false>(p.cmp_w2 + (long)((layer) * 2 + kv) * 128 * 64, 64, p.w2t + (long)kv * 64 * 128, 128, (tl & 1) * 64, 0, ftile); } }
#define PHASE_P1(layer) PHASE_NORM(layer) PHASE_CVT(layer)
#define PHASE_P2() \
    {   \
      const int x_ = bid0() & 7, li_ = bid0() >> 3, nl_ = (gridDim.x + 7) >> 3, mtiles_ = S / (64 * GMI), mper_ = mtiles_ / 8; \
      if ((mper_ & 7) != 0 || (gridDim.x & 7) != 0) { for (int tl = bid0(); tl < mtiles_ * 65; tl += gridDim.x) { int mt = tl % mtiles_, nt = tl / mtiles_; gemm_tile<0, GMI>(p, p.h, DM, p.wt_in, DM, DM, mt * 64 * GMI, nt * 128, gsm); } } \
      else for (int t_ = li_; t_ < mper_ * 65; t_ += nl_) { const int half_ = t_ / 520, r_ = t_ % 520; int ml_, nt_; \
        if (r_ < 512) { ml_ = r_ & 7; nt_ = (r_ >> 6) * 8 + ((r_ & 63) >> 3); } else { ml_ = r_ - 512; nt_ = 64; } \
        gemm_tile<0, GMI>(p, p.h, DM, p.wt_in, DM, DM, (x_ * mper_ + half_ * 8 + ml_) * 64 * GMI, nt_ * 128, gsm); } }
#define PHASE_FLASH3(layer) \
    { const int nA = nqt * 8, nM = nqt * 4, nD = 3 * nqt * 8, nC = nqt * 8; \
      WU(nA + nM + nD + nC, { if (u < nA) unit_awin(p, u, WL, lane); else if (u < nA + nM) unit_m(p, layer, u - nA, WL, lane); \
                              else if (u < nA + nM + nD) unit_d(p, u - nA - nM, WL, lane); else unit_c(p, layer, u - nA - nM - nD, WL, lane); }); }
#define WU2(N, ...) { for (int u_ = gw0(gwave); u_ < (int)(N); u_ += nwave) { const int u = __builtin_amdgcn_readfirstlane(u_); const unsigned tq_ = tx_(); int lane = tq_ & 63; \
    WaveLds2* WL2 = ((WaveLds2*)smem_raw) + __builtin_amdgcn_readfirstlane((int)(tq_ >> 6)); __VA_ARGS__; } }
#define PHASE_CB() \
    for (int tl = bid0(); tl < nc * 2; tl += gridDim.x) { const SB* xb_ = p.xconv + (long)(tl >> 1) * 128 * 1024 + (tl & 1) * 128; gemm_tile<2, 2>(p, xb_ + 768, 1024, xb_ + 512, 1024, 128, 0, 0, gsm, p.cb + (long)tl * 16384); }

#ifndef SELFCHK
#define PH_BEGIN { char* wsb_ = ka.ws; asm volatile("" : "+s"(wsb_)); Params p, p2_; p.pad0 = 0; fill_inputs(p, ka); fill_ws(p, p2_, wsb_); (void)p2_;
#define PH_END }
__global__ void __launch_bounds__(256, LB2) mega(KArgs ka) {
  KERNEL_PROLOGUE
#ifdef REP_PRO
  GS((long)S * 32, ph_rope(p, gid)); GS(8 * TABA_N + 24 * TABD_N, ph_tabs(p, gid)); WU(DEPTH * 256, unit_memkv(p, u, lane));
#endif
#ifdef TSEL
  unsigned long long tlast = __builtin_amdgcn_s_memrealtime();
#define TMARK(id) { if (gtid == 0) { const unsigned long long tn = __builtin_amdgcn_s_memrealtime(); ((unsigned long long*)p.bar)[id] += tn - tlast; tlast = tn; } }
#else
#define TMARK(id)
#endif
  for (int layer = 0; layer < DEPTH; ++layer) {
    PH_BEGIN
    PHASE_P1(layer)
#ifdef REP_P1
    PHASE_P1(layer)
#endif
    PH_END
    if (layer == 0) grid.sync(); else GSYNC();
    PH_BEGIN
    TMARK(1)
    PHASE_P2()
#ifdef REP_G
    PHASE_P2()
#endif
#ifdef REP_G2
    { const int x_ = bid0() & 7, li_ = bid0() >> 3, nl_ = (gridDim.x + 7) >> 3; for (int t_ = li_; t_ < 520; t_ += nl_) { int ml_, nt_; if (t_ < 512) { ml_ = t_ & 7; nt_ = (t_ >> 6) * 8 + ((t_ & 63) >> 3); } else { ml_ = t_ - 512; nt_ = 64; }
        gemm_tile<0, GMI, true>(p, p.h, DM, p.wt_in, DM, DM, (x_ * 8 + ml_) * 64 * GMI, nt_ * 128, gsm); } }
#endif
    PH_END
    GSYNC();
    PH_BEGIN
    TMARK(2)
    { const int nCmp = 2 * (ncmp * 2 / 32), nA = nqt * 8, nM = nqt * 4, nD = 3 * nqt * 8, nC = nqt * 8, nF = nA + nM + nD + nC;
      const int cb0 = (int)gridDim.x - nCmp; const bool cmpw = ((int)blockIdx.x >= cb0) && (cb0 > 0); const int cw0 = cb0 * 4;
#define FLASH_UNIT(uu) {   \
        const int v_ = __builtin_amdgcn_readfirstlane(uu); const int gw_ = v_ % nwave, rr_ = v_ / nwave; const int x_ = (gw_ >> 2) & 7, lw_ = ((gw_ >> 5) << 2) | (gw_ & 3); int j_ = rr_ * (nwave >> 3) + lw_; \
        const unsigned tq_ = tx_(); int lane = tq_ & 63; WaveLds* WL = ((WaveLds*)smem_raw) + __builtin_amdgcn_readfirstlane((int)(tq_ >> 6)); \
        if ((nwave & 31) != 0) { const int u = v_; if (u < nA) unit_awin(p, u, WL, lane); else if (u < nA + nM) unit_m(p, layer, u - nA, WL, lane); else if (u < nA + nM + nD) unit_d(p, u - nA - nM, WL, lane); else unit_c(p, layer, u - nA - nM - nD, WL, lane); } \
        else if (j_ < nA / 8) unit_awin(p, x_ * (nA / 8) + j_, WL, lane); \
        else if ((j_ -= nA / 8) < nM / 8) unit_m(p, layer, x_ * (nM / 8) + j_, WL, lane); \
        else if ((j_ -= nM / 8) < nD / 24) unit_d(p, x_ * (nD / 24) + j_, WL, lane); \
        else if ((j_ -= nD / 24) < nD / 24) unit_d(p, nD / 3 + x_ * (nD / 24) + j_, WL, lane); \
        else if ((j_ -= nD / 24) < nD / 24) unit_d(p, 2 * (nD / 3) + x_ * (nD / 24) + j_, WL, lane); \
        else if ((j_ -= nD / 24) < nC / 8) unit_c(p, layer, x_ * (nC / 8) + j_, WL, lane); }
#ifdef REP_F3B
      WU(nA + nD, { if (u < nA) unit_awin(p, u, WL, lane); else unit_d(p, u - nA, WL, lane); });
#endif
#ifdef REP_CMPB
      for (int ub = bid0(); ub < nCmp; ub += gridDim.x) unit_cmp_blk(p, layer, ub, (float*)smem_raw); __syncthreads();
#endif
      if (cb0 <= 0) { for (int ub = bid0(); ub < nCmp; ub += gridDim.x) unit_cmp_blk(p, layer, ub, (float*)smem_raw); __syncthreads(); }
      else if (cmpw) { unit_cmp_blk(p, layer, (int)blockIdx.x - cb0, (float*)smem_raw); __syncthreads(); }
      for (int r_ = (cmpw ? CMP_SKIP : 0), u_ = gw0(gwave) + r_ * nwave; u_ < nF; u_ += nwave) FLASH_UNIT(u_)
      if (cb0 > 0) for (int e_ = gw0(gwave); e_ < CMP_SKIP * nCmp * 4; e_ += nwave) { const int u_ = (e_ / (nCmp * 4)) * nwave + cw0 + (e_ % (nCmp * 4)); if (u_ < nF) FLASH_UNIT(u_) }
#undef FLASH_UNIT
    }
    GS((long)S * 128, item_bconv(p, layer, gid));
    WU(nc * 8, unit_bdt(p, layer, u, lane));
    PH_END
    GSYNC();
    PH_BEGIN
    TMARK(3)
    WU(nqt * 8, unit_acmp1(p, u, WL, lane));
    __syncthreads();
    PHASE_CB()
    __syncthreads();
    WU2(nc * 16, unit_bstates(p, u, WL2, lane));
#ifdef REP_P4
    __syncthreads();
    WU(nqt * 8, unit_acmp1(p, u, WL, lane));
    __syncthreads();
    PHASE_CB()
    __syncthreads();
    WU2(nc * 16, unit_bstates(p, u, WL2, lane));
#endif
    GS((long)S * 64, item_dmerge(p, gid));
    PH_END
    GSYNC();
    PH_BEGIN
    TMARK(4)
    {
      const int nU = nqt * 8, hw_ = nwave >> 1; const int gw_ = gw0(gwave);
      if (65536 * 2 != (int)gsz || (nU & 3)) { WU(nU, unit_acmp2(p, u, lane)); }
      else if (gw_ >= hw_) { for (int u_ = gw_ - hw_; u_ < (nU / 4) * 3; u_ += hw_) { const int u = __builtin_amdgcn_readfirstlane(u_); int lane = tx_() & 63; unit_acmp2(p, u, lane); } }
      else { for (int u_ = (nU / 4) * 3 + gw_; u_ < nU; u_ += hw_) { const int u = __builtin_amdgcn_readfirstlane(u_); int lane = tx_() & 63; unit_acmp2(p, u, lane); } } }
#ifdef REP_P5A
    WU(nqt * 8, unit_acmp2(p, u, lane));
#endif
    GS(65536, ph_b_scan(p, gid));
    PH_END
    GSYNC();
    PH_BEGIN
    TMARK(5)
#ifdef REP_BOUT
    for (int ub = bid0(); ub < nc * 8; ub += gridDim.x) unit_bout_blk<false>(p, layer, ub, smem_raw);
#endif
    for (int ub = bid0(); ub < nc * 8; ub += gridDim.x) unit_bout_blk(p, layer, ub, smem_raw);
    TMARK(7)
#ifdef REP_ASELW
    for (;;) { __syncthreads(); if (threadIdx.x == 0) xbst[2] = atomicAdd(&p.bar[48 + layer * 8 + 7], 1u); __syncthreads(); const int ub = (int)xbst[2]; if (ub >= (S / 32) * 2) break; unit_asel_w<false, REP_ASELW == 2, REP_ASELW == 3>(p, ub, (AselW*)smem_raw); }
#endif
#ifdef REP_ASEL2
    for (;;) { __syncthreads(); if (threadIdx.x == 0) xbst[2] = atomicAdd(&p.bar[48 + layer * 8 + 7], 1u); __syncthreads(); const int ub = (int)xbst[2]; if (ub >= (S / 32) * 2) break; unit_asel_blk<false>(p, ub, (AselLds*)smem_raw); }
#endif
#ifdef REP_ASEL3
    for (;;) { __syncthreads(); if (threadIdx.x == 0) xbst[2] = atomicAdd(&p.bar[48 + layer * 8 + 7], 1u); __syncthreads(); const int ub = (int)xbst[2]; if (ub >= (S / 32) * 2) break; unit_asel_blk<false, true>(p, ub, (AselLds*)smem_raw); }
#endif
#ifndef ASEL_XQ
#define ASEL_XQ 1
#endif
#if ASEL_XQ
    {
      AselW* AW = (AselW*)smem_raw; __syncthreads(); asel_w_tables(p, AW); __syncthreads();
      const int tq_ = tx_(), ln_ = tq_ & 63, wv_ = __builtin_amdgcn_readfirstlane(tq_ >> 6); const int qc = (bid0() >> 2) & 1; bool own = true; const unsigned NWI = (unsigned)(S / 32) * 4u;
      for (;;) { unsigned n = 0xffffffffu; int c = qc;
        if (own) { if (ln_ == 0) n = atomicAdd(&p.bar[48 + layer * 8 + 4 + qc], 1u); n = (unsigned)__builtin_amdgcn_readfirstlane((int)n); if (n >= NWI) { n = 0xffffffffu; own = false; } }
        if (n == 0xffffffffu) { c = qc ^ 1; if (ln_ == 0) n = atomicAdd(&p.bar[48 + layer * 8 + 4 + c], 1u); n = (unsigned)__builtin_amdgcn_readfirstlane((int)n); if (n >= NWI) break; }
        asel_w_wave(p, c, ((S / 32 - 1) - (int)(n >> 2)) * 32 + 8 * (int)(n & 3u), AW, wv_, ln_); } }
#else
    for (;;) { __syncthreads(); if (threadIdx.x == 0) xbst[2] = atomicAdd(&p.bar[48 + layer * 8 + 6], 1u); __syncthreads(); const int ub = (int)xbst[2]; if (ub >= (S / 32) * 2) break; unit_asel_blk(p, ub, (AselLds*)smem_raw); }
#endif
    PH_END
    GSYNC();
    PH_BEGIN
    TMARK(8)
    for (int tl = bid0(); tl < (S / (64 * GMI)) * 8; tl += gridDim.x) { int mt = tl >> 3, nt = tl & 7; gemm_tile<1, GMI>(p, p.mix, NMIX, p.wt_out + (long)(layer & 1) * 1024 * 2304, NMIX, NMIX, mt * 64 * GMI, nt * 128, gsm); }
#ifdef REP_P8
    for (int tl = bid0(); tl < (S / (64 * GMI)) * 8; tl += gridDim.x) { int mt = tl >> 3, nt = tl & 7; gemm_tile<1, GMI>(p, p.mix, NMIX, p.wt_out + (long)(layer & 1) * 1024 * 2304, NMIX, NMIX, mt * 64 * GMI, nt * 128, gsm); }
#endif
    PH_END
    GSYNC();
    PH_BEGIN
    TMARK(9)
#ifdef REP_BAR
    for (int q_ = 0; q_ < 8; ++q_) GSYNC();
#endif
    PH_END
  }
  for (int t = gw0(gwave); t < S; t += nwave) { int lane = tx_() & 63; norm_row_wave(p, DEPTH, t, false, lane); }
#ifdef TSEL
  GSYNC();
  { float best = -1.f; int bi = 0; for (int k = 1; k < 10; ++k) if (!((TSEL >> k) & 1)) { const float us = (float)((unsigned long long*)p.bar)[k] * 0.01f; if (us > best) { best = us; bi = k; } }
    const float kk = 10.f * (float)bi + floorf(log2f(best + 1.f));
    GS((long)S * 1024, p.out[gid] = kk); }
#endif
}
#else
__device__ __forceinline__ void chk_update(unsigned* slot, float diff, float ref) {
  atomicMax(&slot[0], __float_as_uint(fabsf(diff))); atomicMax(&slot[1], __float_as_uint(fabsf(ref)));
}
#define CMPB(slot, a, b_) chk_update(sl + (slot), bf2f(a) - bf2f(b_), bf2f(b_))
#define CMPF(slot, a, b_) chk_update(sl + (slot), (a) - (b_), (b_))
__global__ void __launch_bounds__(256, 1) mega(KArgs ka) {
  KERNEL_PROLOGUE
  if (gtid < 64) p.bar[gtid] = 0u;
  unsigned* sl = p.bar;
  const int layer = 0;
  PHASE_P1(layer)
  grid.sync();
  PHASE_P2()
  GSYNC();
  GS((long)S * NMIX, p2.mix[gid] = p.mix[gid]);
  GSYNC();
  PHASE_FLASH3(layer)
  __syncthreads();
  for (int ub = bid0(); ub < 2 * (ncmp * 2 / 32); ub += gridDim.x) unit_cmp_blk(p, layer, ub, (float*)smem_raw);
  __syncthreads();
  GS((long)S * 128, item_bconv(p, layer, gid));
  WU(nc * 8, unit_bdt(p, layer, u, lane));
  GS((long)2 * ncmp * 256, ph_cmp_hid(p2, layer, gid));
  GS((long)S * 8, ph_a_win(p2, gid));
  GS((long)S * 8, ph_c(p2, layer, gid));
  GS((long)3 * S * 8, ph_d(p2, gid));
  GS((long)S * 4, ph_m(p2, layer, gid));
  GS((long)S * 1024, ph_b_conv(p2, layer, gid));
  GS((long)nc * 8, ph_b_dt2(p2, layer, gid));
  GSYNC();
  GS((long)2 * ncmp * 128, ph_cmp_out(p2, layer, gid));
  GSYNC();
  GS((long)2 * ncmp * 128, CMPB(20, p.kvc[gid], p2.kvc[gid]));
  GS((long)S * 1024, CMPB(22, p.xconv[gid], p2.xconv[gid]));
  GS((long)S * 8, { CMPF(24, p.dt[gid], p2.dt[gid]); CMPF(24, p.acs[gid], p2.acs[gid]); CMPF(24, p.wst[gid], p2.wst[gid]); });
  GSYNC();
  GS((long)2 * ncmp * 128, p2.kvc[gid] = p.kvc[gid]);
  GS((long)S * 1024, p2.xconv[gid] = p.xconv[gid]);
  GS((long)S * 8, { p2.dt[gid] = p.dt[gid]; p2.acs[gid] = p.acs[gid]; p2.wst[gid] = p.wst[gid]; });
  GSYNC();
  WU(nqt * 8, unit_acmp1(p, u, WL, lane));
  __syncthreads();
  PHASE_CB()
  __syncthreads();
  WU2(nc * 16, unit_bstates(p, u, WL2, lane));
  GS((long)S * 8, ph_a_cmp1(p2, gid));
  GS((long)nc * 2 * 128 * 128, ph_b_cb(p2, gid));
  GS((long)nc * 65536, ph_b_states(p2, gid));
  GSYNC();
  WU(nqt * 8, unit_acmp2(p, u, lane));
  GS((long)S * 2, ph_a_cmp2(p2, gid));
  GS((long)nc * 65536, CMPF(26, p.states[gid], p2.states[gid]));
  GS((long)nc * 2 * 128 * 128, { int s_ = (int)(gid & 127), l_ = (int)((gid >> 7) & 127); if (s_ <= l_) CMPF(18, p.cb[gid], p2.cb[gid]); });
  GSYNC();
  GS(65536, ph_b_scan(p, gid));
  GS(65536, ph_b_scan(p2, gid));
  GS((long)S * 512, { CMPB(0, p.ow[gid], p2.ow[gid]); CMPB(2, p.oc[gid], p2.oc[gid]); long t = gid >> 9, c = gid & 511; CMPB(4, p.mix[t * NMIX + MX_C + c], p2.mix[t * NMIX + MX_C + c]);
                      if (c < 256) CMPB(6, p.mix[t * NMIX + MX_M + c], p2.mix[t * NMIX + MX_M + c]); });
  GS((long)3 * S * 512, CMPB(8, p.dop[gid], p2.dop[gid]));
  GS((long)3 * S * 8, chk_update(sl + 10, p.dlse[gid] - p2.dlse[gid], 1.f));
  GS((long)S * 2 * 256, { long qg = gid >> 8; int bb = (int)(gid & 255); int q = (int)(qg >> 1), g_ = (int)(qg & 1); if (bb <= (q >> 6)) CMPF(12, p.imp[(((long)(q >> 5) * 2 + g_) * 256 + bb) * 32 + (q & 31)], p2.imp[gid]); });
  GSYNC();
  GS((long)S * 512, { long qg = gid >> 8; int bb = (int)(gid & 255); int q = (int)(qg >> 1), g_ = (int)(qg & 1); p2.imp[gid] = p.imp[(((long)(q >> 5) * 2 + g_) * 256 + bb) * 32 + (q & 31)]; });
  GSYNC();
  WU(S * 2 / 4, unit_topk4(p, u, lane));
  WU2(nc * 32, unit_bout(p, layer, u, WL2, lane));
  GS((long)S * 2, ph_a_topk(p2, gid));
  GS((long)S * 512, ph_b_out(p2, layer, gid));
  GSYNC();
  GS((long)S * 2, { int q = (int)(gid >> 1); int nv = (q >> 6) + 1; nv = nv > 16 ? 16 : nv; int bad = 0;
    for (int k = 0; k < 16; ++k) { int mine = p.idx[gid * 16 + k]; bool found = false; for (int k2 = 0; k2 < 16; ++k2) found |= (p2.idx[gid * 16 + k2] == mine); if (k < nv) bad += !found || mine < 0; else bad += (mine >= 0); }
    chk_update(sl + 14, (float)bad, 1.f); });
  GS((long)S * 512, CMPF(28, p.ybuf[gid], p2.ybuf[gid]));
  GSYNC();
  GS((long)S * 32, p2.idx[gid] = p.idx[gid]);
  GS((long)S * 512, p2.ybuf[gid] = p.ybuf[gid]);
  GSYNC();
  for (int ub = bid0(); ub < (S / 32) * 2; ub += gridDim.x) ASEL_UNIT(p, ub);
  for (;;) { __syncthreads(); if (threadIdx.x == 0) xbst[2] = atomicAdd(&p.bar[40 + layer], 1u); __syncthreads(); const int ub = (int)xbst[2]; if (ub >= nc * 8) break; unit_bout_blk(p, layer, ub, smem_raw); }
  GS((long)S * 8, ph_a_sel(p2, gid));
  GS((long)S * 2, ph_b_norm(p2, layer, gid));
  GSYNC();
  GS((long)S * 512, { long t = gid >> 9, c = gid & 511; CMPB(16, p.mix[t * NMIX + MX_A + c], p2.mix[t * NMIX + MX_A + c]); CMPB(30, p.mix[t * NMIX + MX_B + c], p2.mix[t * NMIX + MX_B + c]); });
  GSYNC();
  { float R = 0.f;
    for (int k = 0; k < 16; ++k) { float d = __uint_as_float(p.bar[2 * k]), r = __uint_as_float(p.bar[2 * k + 1]); float q = d / (r + 1e-20f); if (CHKSEL < 0 || CHKSEL == k) R = fmaxf(R, q); }
    GS((long)SEQ * 1024, p.out[gid] = 1e4f * R); }
}
#endif

__global__ void zz_tail_pad(float* o) { asm volatile(".rept 512\n\ts_nop 0\n\t.endr" ::: "memory"); if (o) o[0] = 0.f; }
__global__ void fill_code(float* o, float v, long n) { long i = blockIdx.x * 256L + threadIdx.x; if (i < n) o[i] = v; }
extern "C" void kernel_launch(void* const* d_in, const int* in_sizes, int n_in, void* d_out, int out_size, void* d_ws, size_t ws_size, hipStream_t stream) {
  KArgs ka; memset(&ka, 0, sizeof(ka));
  for (int i = 0; i < 20; ++i) ka.in[i] = d_in[i];
  ka.out = (float*)d_out; ka.ws = (char*)d_ws;
  Params hp, hp2; memset(&hp, 0, sizeof(hp)); const size_t need = fill_ws(hp, hp2, (char*)d_ws);
  if (need > ws_size) { fprintf(stderr, "workspace too small: need %zu have %zu\n", need, ws_size); return; }
  static int grid_blocks = 0;
  if (!grid_blocks) { int dev = 0, cus = 0, per_cu = 0; (void)hipGetDevice(&dev); (void)hipDeviceGetAttribute(&cus, hipDeviceAttributeMultiprocessorCount, dev);
    (void)hipOccupancyMaxActiveBlocksPerMultiprocessor(&per_cu, mega, 256, 0); if (per_cu > LB2) per_cu = LB2; if (per_cu < 1) per_cu = 1; grid_blocks = cus * per_cu; }
  (void)hipMemsetAsync(hp.bar, 0, 131072, stream);
  void* args[] = {&ka};
  hipError_t e = hipLaunchCooperativeKernel((void*)mega, dim3(grid_blocks), dim3(256), args, 0, stream);
  if (e != hipSuccess) { (void)hipGetLastError(); fill_code<<<(unsigned)(((long)SEQ * 1024 + 255) / 256), 256, 0, stream>>>((float*)d_out, 1000.f * (float)(int)e + (float)grid_blocks, (long)SEQ * 1024); }
}
```

```cpp
#include <hip/hip_runtime.h>
#include <hip/hip_cooperative_groups.h>
#include <cstdio>
#include <cstdint>
#include <cstring>
namespace cg = cooperative_groups;
#define HD_ __device__ __forceinline__
#ifndef CHKSEL
#define CHKSEL -1
#endif
#ifndef LB2
#define LB2 2
#endif
#ifndef HD_
#define HD_ inline
#endif
#ifdef SB_IS_FLOAT
typedef float SB;
HD_ float ldf(const SB* p) { return *p; }
HD_ void stf(SB* p, float v) { *p = v; }
#else
typedef unsigned short SB;
HD_ float bf2f(unsigned short b) { unsigned u = ((unsigned)b) << 16; float f; __builtin_memcpy(&f, &u, 4); return f; }
HD_ unsigned short f2bf(float f) { unsigned u; __builtin_memcpy(&u, &f, 4); u += 0x7fffu + ((u >> 16) & 1u); return (unsigned short)(u >> 16); }
HD_ float ldf(const SB* p) { return bf2f(*p); }
HD_ void stf(SB* p, float v) { *p = f2bf(v); }
#endif

#define DM 1024
#define NPROJ 5888
#define NMIX 2304
#define NSMALL 32
#define PA_Q 0
#define PA_KV 512
#define PB_X 1280
#define PC_Q 2304
#define PC_KV 2816
#define PD_Q 3072
#define PD_KV 4608
#define PM_Q 5632
#define MX_A 0
#define MX_B 512
#define MX_C 1024
#define MX_D 1536
#define MX_M 2048
#define TABA_N 2048
#define TABD_N 132

struct Params {
  int S; int pad0;
  const float *x, *mem; const int* pos;
  const float *pre_norm, *post_norm, *w_in, *w_out, *rel_bias, *cmp_pos, *cmp_w1, *cmp_w2, *conv_w, *conv_b, *dt_bias, *a_log, *b_d,
      *b_norm, *sinks, *m_norm, *m_wkv;
  float* out;
  unsigned short* wt_in;
  unsigned short* wt_out;
  unsigned short *w1t, *w2t;
  SB* h;
  SB* proj;
  float* small;
  SB* mix;
  float* y;
  float *rope_cs, *rope_sn;
  float *tabA, *tabD;
  SB* memkv;
  float* hid;
  SB* kvc;
  float* imp;
  float* cml;
  int* idx;
  SB *oc, *ow;
  SB* dop;
  float* dlse;
  SB* xconv;
  float *dt, *acs;
  float* wst;
  float* cb;
  float* states;
  float* ybuf;
  unsigned* bar;
};

HD_ float silu_f(float x) { return x / (1.f + expf(-x)); }
HD_ float sigmoid_f(float x) { return 1.f / (1.f + expf(-x)); }
HD_ float gelu_f(float x) { return 0.5f * x * (1.f + tanhf(0.7978845608028654f * (x + 0.044715f * x * x * x))); }
HD_ float softplus_f(float x) { return fmaxf(x, 0.f) + log1pf(expf(-fabsf(x))); }

HD_ int t5_bucket(int d) {
  if (d < 16) return d < 0 ? 0 : d;
  const int thr[15] = {22, 30, 40, 54, 73, 99, 134, 182, 246, 332, 450, 609, 825, 1117, 1513};
  int b = 16;
  for (int k = 0; k < 15; ++k) b += (d >= thr[k]) ? 1 : 0;
  return b;
}

HD_ void ph_rope(const Params& p, long gid) {
  int s = (int)(gid >> 5), i = (int)(gid & 31);
  float inv = powf(150000.f, -(float)i / 32.f);
  float ang = (float)p.pos[s] * inv;
  p.rope_cs[gid] = cosf(ang); p.rope_sn[gid] = sinf(ang);
}
HD_ void ph_tabs(const Params& p, long gid) {
  if (gid < 8 * TABA_N) { int h = (int)(gid / TABA_N), d = (int)(gid % TABA_N); p.tabA[gid] = p.rel_bias[t5_bucket(d) * 32 + h]; }
  else { long g2 = gid - 8 * TABA_N; int hh = (int)(g2 / TABD_N), d = (int)(g2 % TABD_N); int gi = hh >> 3;
    int dil = gi == 0 ? 1 : (gi == 1 ? 4 : 16); p.tabD[g2] = p.rel_bias[t5_bucket(d * dil) * 32 + 8 + hh]; }
}
HD_ void ph_memkv(const Params& p, long gid) {
  int e = (int)(gid & 511), m = (int)((gid >> 9) & 255), l = (int)(gid >> 17);
  const float* row = p.mem + (long)m * DM;
  float ss = 0.f; _Pragma("unroll 16") for (int d = 0; d < DM; ++d) ss += row[d] * row[d];
  float r = 1.f / sqrtf(ss / DM + 1e-6f);
  float acc = 0.f;
  _Pragma("unroll 16") for (int d = 0; d < DM; ++d) acc += row[d] * r * p.m_norm[l * DM + d] * p.m_wkv[((long)l * DM + d) * 512 + e];
  stf(&p.memkv[gid], acc);
}
HD_ void ph_norm_row(const Params& p, int layer, int t, bool do_h) {
  const float* xin = (layer == 0) ? p.x + (long)t * DM : p.out + (long)t * DM;
  float* xo = p.out + (long)t * DM;
  float r1 = 0.f;
  if (layer > 0) { const float* y = p.y + (long)t * DM; float ss = 0.f; for (int d = 0; d < DM; ++d) ss += y[d] * y[d]; r1 = 1.f / sqrtf(ss / DM + 1e-6f); }
  float ss2 = 0.f;
  for (int d = 0; d < DM; ++d) { float v = xin[d]; if (layer > 0) v += p.y[(long)t * DM + d] * r1 * p.post_norm[(layer - 1) * DM + d]; xo[d] = v; ss2 += v * v; }
  if (!do_h) return;
  float r2 = 1.f / sqrtf(ss2 / DM + 1e-6f);
  for (int d = 0; d < DM; ++d) stf(&p.h[(long)t * DM + d], xo[d] * r2 * p.pre_norm[layer * DM + d]);
}

HD_ void ph_cmp_hid(const Params& p, int layer, long gid) {
  int u = (int)(gid & 127), hk = (int)((gid >> 7) & 1); long r = gid >> 8; int ncmp = p.S / 16; int j = (int)(r % ncmp), kv = (int)(r / ncmp);
  const float* w1 = p.cmp_w1 + ((long)(layer * 2 + kv) * 2048) * 128;
  const float* pe = p.cmp_pos + (long)(layer * 2 + kv) * 32 * 64;
  float acc = 0.f;
  for (int t = 0; t < 32; ++t) { int tok = 16 * j + t;
    _Pragma("unroll 16") for (int d = 0; d < 64; ++d) { float v = pe[t * 64 + d]; if (tok < p.S) v += ldf(&p.proj[(long)tok * NPROJ + PA_KV + kv * 128 + hk * 64 + d]);
      acc += v * w1[(long)(t * 64 + d) * 128 + u]; } }
  p.hid[gid] = gelu_f(acc);
}
HD_ void ph_cmp_out(const Params& p, int layer, long gid) {
  int d = (int)(gid & 63), hk = (int)((gid >> 6) & 1); long r = gid >> 7; int ncmp = p.S / 16; int j = (int)(r % ncmp), kv = (int)(r / ncmp);
  const float* w2 = p.cmp_w2 + (long)(layer * 2 + kv) * 128 * 64;
  const float* hd = p.hid + (((long)kv * ncmp + j) * 2 + hk) * 128;
  float acc = 0.f; for (int u = 0; u < 128; ++u) acc += hd[u] * w2[u * 64 + d];
  stf(&p.kvc[gid], acc);
}
HD_ void ph_a_cmp1(const Params& p, long gid) {
  int h = (int)(gid & 7), q = (int)(gid >> 3), g = h >> 2; int ncmp = p.S / 16;
  int jn = (q >= 31) ? ((q - 31) / 16 + 1) : 0;
  const SB* kc = p.kvc; const SB* vc = p.kvc + (long)ncmp * 128;
  float qv[64], o[64]; for (int d = 0; d < 64; ++d) { qv[d] = ldf(&p.proj[(long)q * NPROJ + PA_Q + h * 64 + d]); o[d] = 0.f; }
  float m = -1e30f, l = 0.f;
  for (int j = 0; j < jn; ++j) { const SB* kr = &kc[((long)j * 2 + g) * 64]; const SB* vr = &vc[((long)j * 2 + g) * 64];
    float s = 0.f; for (int d = 0; d < 64; ++d) s += qv[d] * ldf(&kr[d]);
    int dist = q - (16 * j + 31); s = s * 0.125f + p.tabA[h * TABA_N + (dist < TABA_N ? dist : TABA_N - 1)];
    float mn = fmaxf(m, s), a = expf(m - mn), pr = expf(s - mn); l = l * a + pr; for (int d = 0; d < 64; ++d) o[d] = o[d] * a + pr * ldf(&vr[d]); m = mn; }
  float il = jn > 0 ? 1.f / l : 0.f; for (int d = 0; d < 64; ++d) stf(&p.oc[(long)q * 512 + h * 64 + d], o[d] * il);
  p.cml[gid * 2] = m; p.cml[gid * 2 + 1] = il;
}
HD_ void ph_a_cmp2(const Params& p, long gid) {
  int g = (int)(gid & 1), q = (int)(gid >> 1); int ncmp = p.S / 16;
  float* imp = p.imp + gid * 256; for (int b = 0; b < 256; ++b) imp[b] = 0.f;
  int jn = (q >= 31) ? ((q - 31) / 16 + 1) : 0; const SB* kc = p.kvc;
  for (int hh = 0; hh < 4; ++hh) { int h = g * 4 + hh; float qv[64]; for (int d = 0; d < 64; ++d) qv[d] = ldf(&p.proj[(long)q * NPROJ + PA_Q + h * 64 + d]);
    float m = p.cml[((long)q * 8 + h) * 2], il = p.cml[((long)q * 8 + h) * 2 + 1];
    for (int j = 0; j < jn; ++j) { const SB* kr = &kc[((long)j * 2 + g) * 64]; float s = 0.f; for (int d = 0; d < 64; ++d) s += qv[d] * ldf(&kr[d]);
      int dist = q - (16 * j + 31); s = s * 0.125f + p.tabA[h * TABA_N + (dist < TABA_N ? dist : TABA_N - 1)]; float pr = expf(s - m) * il;
      imp[j >> 2] += pr; if (j + 1 < ncmp) imp[(j + 1) >> 2] += pr; } }
}
HD_ void ph_a_topk(const Params& p, long gid) {
  int q = (int)(gid >> 1); float* imp = p.imp + gid * 256; int* idx = p.idx + gid * 16; int cur = q >> 6;
  imp[0] = 1e4f; imp[cur] = 1e4f;
  for (int k = 0; k < 16; ++k) { int best = -1; float bv = -1.f;
    for (int b = 0; b <= cur; ++b) { float v = imp[b]; if (v > bv) { bv = v; best = b; } }
    idx[k] = best; if (best >= 0) imp[best] = -2.f; }
}
HD_ void ph_a_win(const Params& p, long gid) {
  int h = (int)(gid & 7), q = (int)(gid >> 3), hk = h >> 2;
  float qv[64], o[64]; for (int d = 0; d < 64; ++d) { qv[d] = ldf(&p.proj[(long)q * NPROJ + PA_Q + h * 64 + d]); o[d] = 0.f; }
  float m = -1e30f, l = 0.f; int lo = q - 511 < 0 ? 0 : q - 511;
  for (int t = lo; t <= q; ++t) { const SB* kr = &p.proj[(long)t * NPROJ + PA_KV + 4 * 128 + hk * 64]; const SB* vr = kr + 128;
    float s = 0.f; for (int d = 0; d < 64; ++d) s += qv[d] * ldf(&kr[d]); s = s * 0.125f + p.tabA[h * TABA_N + (q - t)];
    float mn = fmaxf(m, s), a = expf(m - mn), pr = expf(s - mn); l = l * a + pr; for (int d = 0; d < 64; ++d) o[d] = o[d] * a + pr * ldf(&vr[d]); m = mn; }
  float il = 1.f / l; for (int d = 0; d < 64; ++d) stf(&p.ow[(long)q * 512 + h * 64 + d], o[d] * il);
}
HD_ void ph_a_sel(const Params& p, long gid) {
  int h = (int)(gid & 7), q = (int)(gid >> 3), hk = h >> 2; const int* idx = p.idx + ((long)q * 2 + hk) * 16;
  float qv[64], o[64]; for (int d = 0; d < 64; ++d) { qv[d] = ldf(&p.proj[(long)q * NPROJ + PA_Q + h * 64 + d]); o[d] = 0.f; }
  float m = -1e30f, l = 0.f;
  for (int k = 0; k < 16; ++k) { int b = idx[k]; if (b < 0) continue;
    for (int i = 0; i < 64; ++i) { int t = b * 64 + i; if (t > q) break;
      const SB* kr = &p.proj[(long)t * NPROJ + PA_KV + 2 * 128 + hk * 64]; const SB* vr = kr + 128;
      float s = 0.f; for (int d = 0; d < 64; ++d) s += qv[d] * ldf(&kr[d]); int dist = q - t; s = s * 0.125f + p.tabA[h * TABA_N + (dist < TABA_N ? dist : TABA_N - 1)];
      float mn = fmaxf(m, s), a = expf(m - mn), pr = expf(s - mn); l = l * a + pr; for (int d = 0; d < 64; ++d) o[d] = o[d] * a + pr * ldf(&vr[d]); m = mn; } }
  float il = 1.f / l; const float* gl = p.small + (long)q * NSMALL + h * 3;
  float g0 = sigmoid_f(gl[0]), g1 = sigmoid_f(gl[1]), g2 = sigmoid_f(gl[2]);
  for (int d = 0; d < 64; ++d) { long c = (long)q * 512 + h * 64 + d; float a = g0 * ldf(&p.oc[c]) + g1 * o[d] * il + g2 * ldf(&p.ow[c]);
    SB* mp = &p.mix[(long)q * NMIX + MX_A + h * 64 + d]; stf(mp, a * ldf(mp)); }
}
HD_ void ph_c(const Params& p, int layer, long gid) {
  int h = (int)(gid & 7), q = (int)(gid >> 3), hk = h >> 2;
  float qv[64], o[64]; for (int d = 0; d < 64; ++d) { qv[d] = ldf(&p.proj[(long)q * NPROJ + PC_Q + h * 64 + d]); o[d] = 0.f; }
  float m = p.sinks[layer * 8 + h], l = 1.f; int lo = q - 127 < 0 ? 0 : q - 127;
  for (int t = lo; t <= q; ++t) { const SB* kr = &p.proj[(long)t * NPROJ + PC_KV + hk * 64]; const SB* vr = kr + 128;
    float s = 0.f; for (int d = 0; d < 64; ++d) s += qv[d] * ldf(&kr[d]); s *= 0.125f;
    float mn = fmaxf(m, s), a = expf(m - mn), pr = expf(s - mn); l = l * a + pr; for (int d = 0; d < 64; ++d) o[d] = o[d] * a + pr * ldf(&vr[d]); m = mn; }
  float il = 1.f / l; for (int d = 0; d < 64; ++d) { SB* mp = &p.mix[(long)q * NMIX + MX_C + h * 64 + d]; stf(mp, o[d] * il * ldf(mp)); }
}
HD_ void ph_d(const Params& p, long gid) {
  int h = (int)(gid & 7); long r = gid >> 3; int q = (int)(r % p.S), gi = (int)(r / p.S); int dil = gi == 0 ? 1 : (gi == 1 ? 4 : 16);
  float qv[64], o[64]; for (int d = 0; d < 64; ++d) { qv[d] = ldf(&p.proj[(long)q * NPROJ + PD_Q + gi * 512 + h * 64 + d]); o[d] = 0.f; }
  float m = -1e30f, l = 0.f;
  for (int dd = 0; dd <= 128; ++dd) { int t = q - dil * dd; if (t < 0) break;
    const SB* kr = &p.proj[(long)t * NPROJ + PD_KV + h * 64]; const SB* vr = kr + 512;
    float s = 0.f; for (int d = 0; d < 64; ++d) s += qv[d] * ldf(&kr[d]); s = s * 0.125f + p.tabD[(gi * 8 + h) * TABD_N + dd];
    float mn = fmaxf(m, s), a = expf(m - mn), pr = expf(s - mn); l = l * a + pr; for (int d = 0; d < 64; ++d) o[d] = o[d] * a + pr * ldf(&vr[d]); m = mn; }
  float il = 1.f / l; for (int d = 0; d < 64; ++d) stf(&p.dop[((long)gi * p.S + q) * 512 + h * 64 + d], o[d] * il);
  p.dlse[((long)gi * p.S + q) * 8 + h] = m + logf(l);
}
HD_ void ph_d_merge(const Params& p, long gid) {
  int h = (int)(gid & 7), q = (int)(gid >> 3);
  float l0 = p.dlse[((long)0 * p.S + q) * 8 + h], l1 = p.dlse[((long)1 * p.S + q) * 8 + h], l2 = p.dlse[((long)2 * p.S + q) * 8 + h];
  float mm = fmaxf(l0, fmaxf(l1, l2)); float e0 = expf(l0 - mm), e1 = expf(l1 - mm), e2 = expf(l2 - mm), is = 1.f / (e0 + e1 + e2);
  for (int d = 0; d < 64; ++d) { long c = (long)q * 512 + h * 64 + d;
    float v = (e0 * ldf(&p.dop[c]) + e1 * ldf(&p.dop[(long)p.S * 512 + c]) + e2 * ldf(&p.dop[(long)2 * p.S * 512 + c])) * is;
    SB* mp = &p.mix[(long)q * NMIX + MX_D + h * 64 + d]; stf(mp, v * ldf(mp)); }
}
HD_ void ph_m(const Params& p, int layer, long gid) {
  int h = (int)(gid & 3), q = (int)(gid >> 2);
  float qv[64], o[64]; for (int d = 0; d < 64; ++d) { qv[d] = ldf(&p.proj[(long)q * NPROJ + PM_Q + h * 64 + d]); o[d] = 0.f; }
  float m = -1e30f, l = 0.f; const SB* kvb = p.memkv + (long)layer * 256 * 512;
  for (int t = 0; t < 256; ++t) { const SB* kr = kvb + (long)t * 512 + h * 64; const SB* vr = kr + 256;
    float s = 0.f; for (int d = 0; d < 64; ++d) s += qv[d] * ldf(&kr[d]); s *= 0.125f;
    float mn = fmaxf(m, s), a = expf(m - mn), pr = expf(s - mn); l = l * a + pr; for (int d = 0; d < 64; ++d) o[d] = o[d] * a + pr * ldf(&vr[d]); m = mn; }
  float il = 1.f / l; for (int d = 0; d < 64; ++d) { SB* mp = &p.mix[(long)q * NMIX + MX_M + h * 64 + d]; stf(mp, o[d] * il * ldf(mp)); }
}
HD_ void ph_b_conv(const Params& p, int layer, long gid) {
  int c = (int)(gid & 1023), t = (int)(gid >> 10); const float* w = p.conv_w + (long)layer * 4 * 1024;
  float acc = p.conv_b[layer * 1024 + c];
  for (int i = 0; i < 4; ++i) { int tt = t - 3 + i; if (tt >= 0) acc += w[i * 1024 + c] * ldf(&p.proj[(long)tt * NPROJ + PB_X + c]); }
  stf(&p.xconv[gid], silu_f(acc));
}
HD_ void ph_b_dt(const Params& p, int layer, long gid) {
  int hd = (int)(gid & 7), c = (int)(gid >> 3); float a = -expf(p.a_log[layer * 8 + hd]); float cs = 0.f;
  for (int l = 0; l < 128; ++l) { int t = c * 128 + l; float dt = softplus_f(p.small[(long)t * NSMALL + 24 + hd] + p.dt_bias[layer * 8 + hd]);
    cs += dt * a; p.dt[(long)t * 8 + hd] = dt; p.acs[(long)t * 8 + hd] = cs; }
}
HD_ void ph_b_cb(const Params& p, long gid) {
  int s = (int)(gid & 127), l = (int)((gid >> 7) & 127), g = (int)((gid >> 14) & 1), c = (int)(gid >> 15);
  if (s > l) { p.cb[gid] = 0.f; return; }
  const SB* cm = &p.xconv[(long)(c * 128 + l) * 1024 + 768 + g * 128]; const SB* bm = &p.xconv[(long)(c * 128 + s) * 1024 + 512 + g * 128];
  float acc = 0.f; for (int n = 0; n < 128; ++n) acc += ldf(&cm[n]) * ldf(&bm[n]);
  p.cb[gid] = acc;
}
HD_ void ph_b_states(const Params& p, long gid) {
  int n = (int)(gid & 127), pp = (int)((gid >> 7) & 63), hd = (int)((gid >> 13) & 7), c = (int)(gid >> 16), g = hd >> 2;
  float last = p.acs[(long)(c * 128 + 127) * 8 + hd]; float acc = 0.f;
  for (int l = 0; l < 128; ++l) { long t = c * 128 + l;
    acc += ldf(&p.xconv[t * 1024 + 512 + g * 128 + n]) * expf(last - p.acs[t * 8 + hd]) * ldf(&p.xconv[t * 1024 + hd * 64 + pp]) * p.dt[t * 8 + hd]; }
  p.states[gid] = acc;
}
HD_ void ph_b_scan(const Params& p, long gid) {
  int hd = (int)(gid >> 13); int nc = p.S / 128; float h = 0.f;
  for (int c0 = 0; c0 < nc; c0 += 8) { float st[8], dc[8];
    for (int i = 0; i < 8; ++i) { st[i] = p.states[(long)(c0 + i) * 65536 + gid]; dc[i] = p.acs[(long)((c0 + i) * 128 + 127) * 8 + hd]; }
    for (int i = 0; i < 8; ++i) { p.states[(long)(c0 + i) * 65536 + gid] = h; h = h * expf(dc[i]) + st[i]; } }
}
HD_ void ph_b_out(const Params& p, int layer, long gid) {
  int pp = (int)(gid & 63), hd = (int)((gid >> 6) & 7), t = (int)(gid >> 9), g = hd >> 2, c = t >> 7, l = t & 127;
  float al = p.acs[(long)t * 8 + hd]; float acc = 0.f;
  const float* cbr = &p.cb[(((long)c * 2 + g) * 128 + l) * 128];
  for (int s = 0; s <= l; ++s) { long ts = c * 128 + s; acc += cbr[s] * expf(al - p.acs[ts * 8 + hd]) * ldf(&p.xconv[ts * 1024 + hd * 64 + pp]) * p.dt[ts * 8 + hd]; }
  float acc2 = 0.f; const float* pr = &p.states[(long)c * 65536 + ((long)hd * 64 + pp) * 128]; const SB* cm = &p.xconv[(long)t * 1024 + 768 + g * 128];
  for (int n = 0; n < 128; ++n) acc2 += ldf(&cm[n]) * pr[n];
  p.ybuf[gid] = acc + expf(al) * acc2 + ldf(&p.xconv[(long)t * 1024 + hd * 64 + pp]) * p.b_d[layer * 8 + hd];
}
HD_ void ph_b_norm(const Params& p, int layer, long gid) {
  int g = (int)(gid & 1), t = (int)(gid >> 1); float ss = 0.f;
  for (int i = 0; i < 256; ++i) { float v = p.ybuf[(long)t * 512 + g * 256 + i] * ldf(&p.mix[(long)t * NMIX + MX_B + g * 256 + i]); ss += v * v; }
  float r = 1.f / sqrtf(ss / 256.f + 1e-6f);
  for (int i = 0; i < 256; ++i) { SB* mp = &p.mix[(long)t * NMIX + MX_B + g * 256 + i]; float v = p.ybuf[(long)t * 512 + g * 256 + i] * ldf(mp);
    stf(mp, v * r * p.b_norm[layer * 512 + g * 256 + i]); }
}

HD_ void ph_b_dt2(const Params& p, int layer, long gid) {
  int hd = (int)(gid & 7), c = (int)(gid >> 3); float a = -expf(p.a_log[layer * 8 + hd]); float cs = 0.f;
  for (int l = 0; l < 128; ++l) { int t = c * 128 + l; float dt = softplus_f(p.small[(long)t * NSMALL + 24 + hd] + p.dt_bias[layer * 8 + hd]);
    cs += dt * a; p.dt[(long)t * 8 + hd] = dt; p.acs[(long)t * 8 + hd] = cs; }
  for (int l = 0; l < 128; ++l) { long t = c * 128 + l; p.wst[t * 8 + hd] = p.dt[t * 8 + hd] * expf(cs - p.acs[t * 8 + hd]); }
}
HD_ void ph_b_states2(const Params& p, long gid) {
  int pp = (int)(gid & 63), n = (int)((gid >> 6) & 127), hd = (int)((gid >> 13) & 7), c = (int)(gid >> 16), g = hd >> 2;
  float acc = 0.f;
  _Pragma("unroll 16") for (int l = 0; l < 128; ++l) { long t = c * 128 + l; acc += ldf(&p.xconv[t * 1024 + 512 + g * 128 + n]) * p.wst[t * 8 + hd] * ldf(&p.xconv[t * 1024 + hd * 64 + pp]); }
  p.states[gid] = acc;
}
HD_ void ph_b_out2(const Params& p, int layer, long gid) {
  int pp = (int)(gid & 63), hd = (int)((gid >> 6) & 7), t = (int)(gid >> 9), g = hd >> 2, c = t >> 7, l = t & 127;
  float al = p.acs[(long)t * 8 + hd]; float acc = 0.f;
  const float* cbr = &p.cb[(((long)c * 2 + g) * 128 + l) * 128];
  _Pragma("unroll 8") for (int s = 0; s <= l; ++s) { long ts = c * 128 + s; acc += cbr[s] * expf(al - p.acs[ts * 8 + hd]) * p.dt[ts * 8 + hd] * ldf(&p.xconv[ts * 1024 + hd * 64 + pp]); }
  float acc2 = 0.f; const float* pr = &p.states[(long)c * 65536 + (long)hd * 8192 + pp]; const SB* cm = &p.xconv[(long)t * 1024 + 768 + g * 128];
  _Pragma("unroll 16") for (int n = 0; n < 128; ++n) acc2 += ldf(&cm[n]) * pr[n * 64];
  p.ybuf[gid] = acc + expf(al) * acc2 + ldf(&p.xconv[(long)t * 1024 + hd * 64 + pp]) * p.b_d[layer * 8 + hd];
}

typedef __attribute__((ext_vector_type(8))) short bf16x8;
typedef __attribute__((ext_vector_type(16))) float f32x16;
typedef short v4i16_t __attribute__((ext_vector_type(4)));
typedef __bf16 bf2_t __attribute__((ext_vector_type(2)));
typedef float f2_t __attribute__((ext_vector_type(2)));
typedef unsigned u32x4 __attribute__((ext_vector_type(4)));
#define LDS3 __attribute__((address_space(3)))
typedef __attribute__((address_space(1))) const void* gptr_t;
typedef __attribute__((address_space(3))) void* lptr_t;
#define L2E 1.4426950408889634f
#define LN2 0.6931471805599453f
#define QSC (0.125f * L2E)
#ifndef FTHR
#define FTHR 8.0f
#endif
#define NINF (-__builtin_huge_valf())
__device__ __forceinline__ float sigmoid_fast(float x) { return __builtin_amdgcn_rcpf(1.f + __builtin_amdgcn_exp2f(-x * L2E)); }
__device__ __forceinline__ float silu_fast(float x) { return x * sigmoid_fast(x); }

struct WaveLds { unsigned short v[4096]; float tab[640]; float xch[32]; float pad[32]; };

__device__ __forceinline__ unsigned pk2(float a, float b) { f2_t v = {a, b}; bf2_t r = __builtin_convertvector(v, bf2_t); return __builtin_bit_cast(unsigned, r); }
__device__ __forceinline__ int crow(int e, int hi) { return (e & 3) + 8 * (e >> 2) + 4 * hi; }
__device__ __forceinline__ bf16x8 pack8(const f32x16& s, int o) {
  u32x4 r; r[0] = pk2(s[o], s[o + 1]); r[1] = pk2(s[o + 2], s[o + 3]); r[2] = pk2(s[o + 4], s[o + 5]); r[3] = pk2(s[o + 6], s[o + 7]); return __builtin_bit_cast(bf16x8, r); }
__device__ __forceinline__ f32x16 zero16() { f32x16 z;
#pragma unroll
  for (int e = 0; e < 16; ++e) z[e] = 0.f; return z; }
#define MFMA32(a, b, c) __builtin_amdgcn_mfma_f32_32x32x16_bf16((a), (b), (c), 0, 0, 0)

__device__ __forceinline__ float xor32_f(float v) { const auto rr = __builtin_amdgcn_permlane32_swap(__float_as_uint(v), __float_as_uint(v), false, false); const int hi_ = (int)(threadIdx.x & 32u); return __uint_as_float(hi_ ? rr[0] : rr[1]); }
struct FlashState { f32x16 o0, o1; float m, l; };
__device__ __forceinline__ float wave_sum_f(float v) {
#pragma unroll
  for (int o = 32; o > 0; o >>= 1) v += __shfl_xor(v, o);
  return v; }

__device__ __forceinline__ void flash_core1(FlashState& st, f32x16& s, const unsigned short* vimg, float* xch, int lane) {
  const int r32 = lane & 31, hi = lane >> 5;
  float mx = s[0];
#pragma unroll
  for (int e = 1; e < 16; ++e) mx = fmaxf(mx, s[e]);
  mx = fmaxf(mx, xor32_f(mx));
  if (__any(mx > st.m + FTHR)) {
    const float mn = fmaxf(st.m, mx); const float al = __builtin_amdgcn_exp2f(st.m - mn); st.m = mn; st.l *= al; xch[r32] = al;
#pragma unroll
    for (int e = 0; e < 16; ++e) { const float a = xch[crow(e, hi)]; st.o0[e] *= a; st.o1[e] *= a; }
  }
  float ps = 0.f;
#pragma unroll
  for (int e = 0; e < 16; ++e) { s[e] = __builtin_amdgcn_exp2f(s[e] - st.m); ps += s[e]; }
  st.l += ps;
  const bf16x8 pa0 = pack8(s, 0), pa1 = pack8(s, 8);
  const unsigned short* vb = vimg + (4 * hi + ((lane & 15) >> 2)) * 32 + ((lane >> 4) & 1) * 16 + (lane & 3) * 4;
#pragma unroll
  for (int s2 = 0; s2 < 2; ++s2) {
#pragma unroll
    for (int db = 0; db < 2; ++db) {
      const v4i16_t lo = __builtin_amdgcn_ds_read_tr16_b64_v4i16((LDS3 v4i16_t*)(vb + db * 2048 + s2 * 512));
      const v4i16_t hh = __builtin_amdgcn_ds_read_tr16_b64_v4i16((LDS3 v4i16_t*)(vb + db * 2048 + s2 * 512 + 256));
      const bf16x8 vf = {lo[0], lo[1], lo[2], lo[3], hh[0], hh[1], hh[2], hh[3]};
      if (db == 0) st.o0 = MFMA32(s2 ? pa1 : pa0, vf, st.o0); else st.o1 = MFMA32(s2 ? pa1 : pa0, vf, st.o1);
    }
  }
}
__device__ __forceinline__ void flash_core1_lin(FlashState& st, f32x16& s, float qs, float bb, const unsigned short* vimg, float* xch, int lane) {
  const int r32 = lane & 31, hi = lane >> 5;
  float mr = s[0];
#pragma unroll
  for (int e = 1; e < 16; ++e) mr = fmaxf(mr, s[e]);
  float mx = __builtin_fmaf(mr, qs, bb);
  mx = fmaxf(mx, xor32_f(mx));
  if (__any(mx > st.m + FTHR)) {
    const float mn = fmaxf(st.m, mx); const float al = __builtin_amdgcn_exp2f(st.m - mn); st.m = mn; st.l *= al; xch[r32] = al;
#pragma unroll
    for (int e = 0; e < 16; ++e) { const float a = xch[crow(e, hi)]; st.o0[e] *= a; st.o1[e] *= a; }
  }
  const float bm = bb - st.m; float ps = 0.f;
#pragma unroll
  for (int e = 0; e < 16; ++e) { s[e] = __builtin_amdgcn_exp2f(__builtin_fmaf(s[e], qs, bm)); ps += s[e]; }
  st.l += ps;
  const bf16x8 pa0 = pack8(s, 0), pa1 = pack8(s, 8);
  const unsigned short* vb = vimg + (4 * hi + ((lane & 15) >> 2)) * 32 + ((lane >> 4) & 1) * 16 + (lane & 3) * 4;
#pragma unroll
  for (int s2 = 0; s2 < 2; ++s2) {
#pragma unroll
    for (int db = 0; db < 2; ++db) {
      const v4i16_t lo = __builtin_amdgcn_ds_read_tr16_b64_v4i16((LDS3 v4i16_t*)(vb + db * 2048 + s2 * 512));
      const v4i16_t hh = __builtin_amdgcn_ds_read_tr16_b64_v4i16((LDS3 v4i16_t*)(vb + db * 2048 + s2 * 512 + 256));
      const bf16x8 vf = {lo[0], lo[1], lo[2], lo[3], hh[0], hh[1], hh[2], hh[3]};
      if (db == 0) st.o0 = MFMA32(s2 ? pa1 : pa0, vf, st.o0); else st.o1 = MFMA32(s2 ? pa1 : pa0, vf, st.o1);
    }
  }
}
template <class VRow, class Fix>
__device__ __forceinline__ void flash_tile(FlashState& st, const bf16x8 (&qf)[4], const SB* kp, VRow vrow, Fix fix, WaveLds* L, int lane) {
  const int r32 = lane & 31, hi = lane >> 5;
  bf16x8 kf[4];
#pragma unroll
  for (int d0 = 0; d0 < 4; ++d0) kf[d0] = *(const bf16x8*)(kp + d0 * 16 + hi * 8);
#pragma unroll
  for (int i = 0; i < 4; ++i) { const int c = lane + 64 * i, key = c >> 3, ch = c & 7; const SB* vp = vrow(key); const uint4 vv = *(const uint4*)(vp + ch * 8);
    *(uint4*)&L->v[(ch >> 2) * 2048 + key * 32 + (ch & 3) * 8] = vv; }
  f32x16 s = zero16();
#pragma unroll
  for (int d0 = 0; d0 < 4; ++d0) s = MFMA32(kf[d0], qf[d0], s);
  fix(s);
  flash_core1(st, s, L->v, L->xch, lane);
}
__device__ __forceinline__ void flash_core2(FlashState& st, f32x16& s0, f32x16& s1, const unsigned short* vimg, float* xch, int lane) {
  const int r32 = lane & 31, hi = lane >> 5;
  float mx = fmaxf(s0[0], s1[0]);
#pragma unroll
  for (int e = 1; e < 16; ++e) mx = fmaxf(mx, fmaxf(s0[e], s1[e]));
  mx = fmaxf(mx, xor32_f(mx));
  if (__any(mx > st.m + FTHR)) {
    const float mn = fmaxf(st.m, mx); const float al = __builtin_amdgcn_exp2f(st.m - mn); st.m = mn; st.l *= al; xch[r32] = al;
#pragma unroll
    for (int e = 0; e < 16; ++e) { const float a = xch[crow(e, hi)]; st.o0[e] *= a; st.o1[e] *= a; }
  }
  float ps = 0.f;
#pragma unroll
  for (int e = 0; e < 16; ++e) { s0[e] = __builtin_amdgcn_exp2f(s0[e] - st.m); s1[e] = __builtin_amdgcn_exp2f(s1[e] - st.m); ps += s0[e] + s1[e]; }
  st.l += ps;
  bf16x8 pa[4]; pa[0] = pack8(s0, 0); pa[1] = pack8(s0, 8); pa[2] = pack8(s1, 0); pa[3] = pack8(s1, 8);
  const unsigned short* vb = vimg + (4 * hi + ((lane & 15) >> 2)) * 32 + ((lane >> 4) & 1) * 16 + (lane & 3) * 4;
#pragma unroll
  for (int kk = 0; kk < 4; ++kk) {
#pragma unroll
    for (int db = 0; db < 2; ++db) {
      const v4i16_t lo = __builtin_amdgcn_ds_read_tr16_b64_v4i16((LDS3 v4i16_t*)(vb + db * 2048 + kk * 512));
      const v4i16_t hh = __builtin_amdgcn_ds_read_tr16_b64_v4i16((LDS3 v4i16_t*)(vb + db * 2048 + kk * 512 + 256));
      const bf16x8 vf = {lo[0], lo[1], lo[2], lo[3], hh[0], hh[1], hh[2], hh[3]};
      if (db == 0) st.o0 = MFMA32(pa[kk], vf, st.o0); else st.o1 = MFMA32(pa[kk], vf, st.o1);
    }
  }
}
__device__ __forceinline__ void flash_core2_lin(FlashState& st, f32x16& s0, f32x16& s1, float qs, float bb, const unsigned short* vimg, float* xch, int lane) {
  const int r32 = lane & 31, hi = lane >> 5;
  float mr = fmaxf(s0[0], s1[0]);
#pragma unroll
  for (int e = 1; e < 16; ++e) mr = fmaxf(mr, fmaxf(s0[e], s1[e]));
  float mx = __builtin_fmaf(mr, qs, bb);
  mx = fmaxf(mx, xor32_f(mx));
  if (__any(mx > st.m + FTHR)) {
    const float mn = fmaxf(st.m, mx); const float al = __builtin_amdgcn_exp2f(st.m - mn); st.m = mn; st.l *= al; xch[r32] = al;
#pragma unroll
    for (int e = 0; e < 16; ++e) { const float a = xch[crow(e, hi)]; st.o0[e] *= a; st.o1[e] *= a; }
  }
  const float bm = bb - st.m; float ps = 0.f;
#pragma unroll
  for (int e = 0; e < 16; ++e) { s0[e] = __builtin_amdgcn_exp2f(__builtin_fmaf(s0[e], qs, bm)); s1[e] = __builtin_amdgcn_exp2f(__builtin_fmaf(s1[e], qs, bm)); ps += s0[e] + s1[e]; }
  st.l += ps;
  bf16x8 pa[4]; pa[0] = pack8(s0, 0); pa[1] = pack8(s0, 8); pa[2] = pack8(s1, 0); pa[3] = pack8(s1, 8);
  const unsigned short* vb = vimg + (4 * hi + ((lane & 15) >> 2)) * 32 + ((lane >> 4) & 1) * 16 + (lane & 3) * 4;
#pragma unroll
  for (int kk = 0; kk < 4; ++kk) {
#pragma unroll
    for (int db = 0; db < 2; ++db) {
      const v4i16_t lo = __builtin_amdgcn_ds_read_tr16_b64_v4i16((LDS3 v4i16_t*)(vb + db * 2048 + kk * 512));
      const v4i16_t hh = __builtin_amdgcn_ds_read_tr16_b64_v4i16((LDS3 v4i16_t*)(vb + db * 2048 + kk * 512 + 256));
      const bf16x8 vf = {lo[0], lo[1], lo[2], lo[3], hh[0], hh[1], hh[2], hh[3]};
      if (db == 0) st.o0 = MFMA32(pa[kk], vf, st.o0); else st.o1 = MFMA32(pa[kk], vf, st.o1);
    }
  }
}
#ifndef FT2
#define FT2 1
#endif
template <class VRow, class Fix0, class Fix1>
__device__ __forceinline__ void flash_tile2(FlashState& st, const bf16x8 (&qf)[4], const SB* kp0, const SB* kp1, VRow vrow, Fix0 fix0, Fix1 fix1, WaveLds* L, int lane) {
  if (!FT2) { flash_tile(st, qf, kp0, [&](int key) { return vrow(key); }, fix0, L, lane); flash_tile(st, qf, kp1, [&](int key) { return vrow(key + 32); }, fix1, L, lane); return; }
  const int hi = lane >> 5;
  bf16x8 kf0[4], kf1[4];
#pragma unroll
  for (int d0 = 0; d0 < 4; ++d0) { kf0[d0] = *(const bf16x8*)(kp0 + d0 * 16 + hi * 8); kf1[d0] = *(const bf16x8*)(kp1 + d0 * 16 + hi * 8); }
#pragma unroll
  for (int i = 0; i < 8; ++i) { const int c = lane + 64 * i, key = c >> 3, ch = c & 7; const SB* vp = vrow(key); const uint4 vv = *(const uint4*)(vp + ch * 8);
    *(uint4*)&L->v[(ch >> 2) * 2048 + key * 32 + (ch & 3) * 8] = vv; }
  f32x16 s0 = zero16(), s1 = zero16();
#pragma unroll
  for (int d0 = 0; d0 < 4; ++d0) { s0 = MFMA32(kf0[d0], qf[d0], s0); s1 = MFMA32(kf1[d0], qf[d0], s1); }
  fix0(s0); fix1(s1);
  flash_core2(st, s0, s1, L->v, L->xch, lane);
}
template <class KPtr, class VRow, class Fix>
__device__ __forceinline__ void flash_run(FlashState& st, const bf16x8 (&qf)[4], int t0, int t1, KPtr kptr, VRow vrow, Fix fix, WaveLds* L, int lane) {
  if (t0 >= t1) return;
  const int hi = lane >> 5; bf16x8 kfn[4];
#define FR_ISSUE(tt) { const int t_ = (tt); _Pragma("unroll") for (int i_ = 0; i_ < 4; ++i_) { const int db_ = i_ >> 1, key_ = (i_ & 1) * 16 + (lane >> 2), wi_ = lane & 3; \
      __builtin_amdgcn_global_load_lds((gptr_t)(vrow(t_, key_) + db_ * 32 + wi_ * 8), (lptr_t)&L->v[db_ * 2048 + (t_ & 1) * 1024 + (i_ & 1) * 512], 16, 0, 0); } \
    const SB* kp_ = kptr(t_); _Pragma("unroll") for (int d0_ = 0; d0_ < 4; ++d0_) kfn[d0_] = *(const bf16x8*)(kp_ + d0_ * 16 + hi * 8); }
  FR_ISSUE(t0)
  for (int t = t0; t < t1; ++t) {
    asm volatile("s_waitcnt vmcnt(0)" ::: "memory");
    bf16x8 kf[4];
#pragma unroll
    for (int d0 = 0; d0 < 4; ++d0) kf[d0] = kfn[d0];
    if (t + 1 < t1) FR_ISSUE(t + 1)
    f32x16 s = zero16();
#pragma unroll
    for (int d0 = 0; d0 < 4; ++d0) s = MFMA32(kf[d0], qf[d0], s);
    fix(t, s);
    flash_core1(st, s, L->v + (t & 1) * 1024, L->xch, lane);
  }
#undef FR_ISSUE
}
__device__ __forceinline__ float flash_finish(FlashState& st, WaveLds* L, int lane) {
  const int r32 = lane & 31, hi = lane >> 5;
  const float lt = st.l + xor32_f(st.l); const float inv = lt > 0.f ? 1.f / lt : 0.f;
  L->xch[r32] = inv;
#pragma unroll
  for (int e = 0; e < 16; ++e) { const float a = L->xch[crow(e, hi)]; st.o0[e] *= a; st.o1[e] *= a; }
  return (st.m + __builtin_amdgcn_logf(lt)) * LN2;
}
__device__ __forceinline__ void load_q(bf16x8 (&qf)[4], const SB* qp, int hi) {
#pragma unroll
  for (int d0 = 0; d0 < 4; ++d0) qf[d0] = *(const bf16x8*)(qp + d0 * 16 + hi * 8);
}
__device__ __forceinline__ void fix_tab(f32x16& s, const WaveLds* L, int base, int lane, bool chk, int kb) {
  const int r32 = lane & 31, hi = lane >> 5; const float* tp = L->tab + base + r32 + 32 - 4 * hi;
#pragma unroll
  for (int e = 0; e < 16; ++e) { const int kk = (e & 3) + 8 * (e >> 2); float v = s[e] * QSC + tp[-kk]; if (chk && (kb + kk + 4 * hi < 0)) v = NINF; s[e] = v; }
}

__device__ __forceinline__ void unit_c(const Params& p, int layer, int u, WaveLds* L, int lane) {
  const int h = u & 7, qt = u >> 3, q0 = qt * 32, hk = h >> 2, r32 = lane & 31, hi = lane >> 5;
  for (int x = lane; x < 192; x += 64) { const int dist = x - 32; L->tab[x] = (dist >= 0 && dist <= 127) ? 0.f : NINF; }
  bf16x8 qf[4]; load_q(qf, p.proj + (long)(q0 + r32) * NPROJ + PC_Q + h * 64, hi);
  FlashState st; st.o0 = zero16(); st.o1 = zero16(); st.m = p.sinks[layer * 8 + h] * L2E; st.l = hi ? 0.f : 1.f;
  const SB* kvb = p.proj + PC_KV + hk * 64; const bool chk = q0 < 128;
  flash_run(st, qf, 0, 5, [&](int t) { int tok = q0 - 128 + 32 * t + r32; tok = tok < 0 ? 0 : tok; return kvb + (long)tok * NPROJ; },
            [&](int t, int key) { int tk = q0 - 128 + 32 * t + key; tk = tk < 0 ? 0 : tk; return kvb + 128 + (long)tk * NPROJ; },
            [&](int t, f32x16& s) { fix_tab(s, L, 128 - 32 * t, lane, chk, q0 - 128 + 32 * t); }, L, lane);
  flash_finish(st, L, lane);
#pragma unroll
  for (int e = 0; e < 16; ++e) { SB* mp = p.mix + (long)(q0 + crow(e, hi)) * NMIX + MX_C + h * 64 + r32; mp[0] = f2bf(st.o0[e] * bf2f(mp[0])); mp[32] = f2bf(st.o1[e] * bf2f(mp[32])); }
}
__device__ __forceinline__ void unit_m(const Params& p, int layer, int u, WaveLds* L, int lane) {
  const int h = u & 3, qt = u >> 2, q0 = qt * 32, r32 = lane & 31, hi = lane >> 5;
  bf16x8 qf[4]; load_q(qf, p.proj + (long)(q0 + r32) * NPROJ + PM_Q + h * 64, hi);
  FlashState st; st.o0 = zero16(); st.o1 = zero16(); st.m = -1e30f; st.l = 0.f;
  const SB* kb = p.memkv + (long)layer * 256 * 512 + h * 64;
  flash_run(st, qf, 0, 8, [&](int t) { return kb + (long)(32 * t + r32) * 512; }, [&](int t, int key) { return kb + 256 + (long)(32 * t + key) * 512; },
            [&](int, f32x16& s) {
#pragma unroll
              for (int e = 0; e < 16; ++e) s[e] *= QSC; }, L, lane);
  flash_finish(st, L, lane);
#pragma unroll
  for (int e = 0; e < 16; ++e) { SB* mp = p.mix + (long)(q0 + crow(e, hi)) * NMIX + MX_M + h * 64 + r32; mp[0] = f2bf(st.o0[e] * bf2f(mp[0])); mp[32] = f2bf(st.o1[e] * bf2f(mp[32])); }
}
__device__ __forceinline__ void unit_awin(const Params& p, int u, WaveLds* L, int lane) {
  const int h = u & 7, qt = u >> 3, q0 = qt * 32, hk = h >> 2, r32 = lane & 31, hi = lane >> 5;
  { float tv[10];
#pragma unroll
    for (int i = 0; i < 10; ++i) { const int dist = lane + 64 * i - 32; const int dc = dist < 0 ? 0 : (dist > 511 ? 511 : dist); tv[i] = p.tabA[h * TABA_N + dc]; }
#pragma unroll
    for (int i = 0; i < 10; ++i) { const int x = lane + 64 * i, dist = x - 32; if (x < 608) L->tab[x] = (dist >= 0 && dist <= 511) ? tv[i] * L2E : NINF; } }
  bf16x8 qf[4]; load_q(qf, p.proj + (long)(q0 + r32) * NPROJ + PA_Q + h * 64, hi);
  FlashState st; st.o0 = zero16(); st.o1 = zero16(); st.m = -1e30f; st.l = 0.f;
  const SB* kvb = p.proj + PA_KV + 4 * 128 + hk * 64; const bool chk = q0 < 512;
  { int tfirst = 0; if (q0 < 512) tfirst = (512 - q0) / 32 - 0; if (tfirst > 16) tfirst = 16; if (q0 < 512 && (q0 - 512 + 32 * tfirst + 31) < 0) ++tfirst;
    flash_run(st, qf, tfirst, 17, [&](int t) { int tok = q0 - 512 + 32 * t + r32; tok = tok < 0 ? 0 : tok; return kvb + (long)tok * NPROJ; },
              [&](int t, int key) { int tk = q0 - 512 + 32 * t + key; tk = tk < 0 ? 0 : tk; return kvb + 128 + (long)tk * NPROJ; },
              [&](int t, f32x16& s) { fix_tab(s, L, 512 - 32 * t, lane, chk, q0 - 512 + 32 * t); }, L, lane); }
  flash_finish(st, L, lane);
#pragma unroll
  for (int e = 0; e < 16; ++e) { SB* op = p.ow + (long)(q0 + crow(e, hi)) * 512 + h * 64 + r32; op[0] = f2bf(st.o0[e]); op[32] = f2bf(st.o1[e]); }
}
__device__ __forceinline__ void unit_d(const Params& p, int u, WaveLds* L, int lane) {
  const int S = p.S, per = (S / 32) * 8; const int gi = u / per, u2 = u % per; const int h = u2 & 7, v = u2 >> 3;
  const int dil = gi == 0 ? 1 : (gi == 1 ? 4 : 16); const int it = v / dil, r = v % dil, i0 = it * 32;
  const int r32 = lane & 31, hi = lane >> 5;
  { float tv[3];
#pragma unroll
    for (int i = 0; i < 3; ++i) { const int dd = lane + 64 * i - 32; const int dc = dd < 0 ? 0 : (dd > 128 ? 128 : dd); tv[i] = p.tabD[(gi * 8 + h) * TABD_N + dc]; }
#pragma unroll
    for (int i = 0; i < 3; ++i) { const int x = lane + 64 * i, dd = x - 32; L->tab[x] = (dd >= 0 && dd <= 128) ? tv[i] * L2E : NINF; } }
  bf16x8 qf[4]; load_q(qf, p.proj + (long)(r + dil * (i0 + r32)) * NPROJ + PD_Q + gi * 512 + h * 64, hi);
  FlashState st; st.o0 = zero16(); st.o1 = zero16(); st.m = -1e30f; st.l = 0.f;
  const SB* kvb = p.proj + PD_KV + h * 64; const bool chk = i0 < 128;
  flash_run(st, qf, 0, 5, [&](int t) { int j = i0 - 128 + 32 * t + r32; j = j < 0 ? 0 : j; return kvb + (long)(r + dil * j) * NPROJ; },
            [&](int t, int key) { int jj = i0 - 128 + 32 * t + key; jj = jj < 0 ? 0 : jj; return kvb + 512 + (long)(r + dil * jj) * NPROJ; },
            [&](int t, f32x16& s) { fix_tab(s, L, 128 - 32 * t, lane, chk, i0 - 128 + 32 * t); }, L, lane);
  const float lse = flash_finish(st, L, lane);
#pragma unroll
  for (int e = 0; e < 16; ++e) { const long tok = r + dil * (i0 + crow(e, hi)); SB* op = p.dop + ((long)gi * S + tok) * 512 + h * 64 + r32; op[0] = f2bf(st.o0[e]); op[32] = f2bf(st.o1[e]); }
  if (hi == 0) p.dlse[((long)gi * S + r + dil * (i0 + r32)) * 8 + h] = lse;
}
__device__ __forceinline__ void fix_cmp(f32x16& s, const float* tabh, float c31, int q0, int t, int lane) {
  const int r32 = lane & 31, hi = lane >> 5; const int dq = q0 + r32 - 31 - 16 * (32 * t + 4 * hi);
  const bool far = (q0 - 16 * (32 * t + 31) - 31) >= 1513;
  if (far) {
#pragma unroll
    for (int e = 0; e < 16; ++e) s[e] = __builtin_fmaf(s[e], QSC, c31);
  } else {
    float bv[16];
#pragma unroll
    for (int e = 0; e < 16; ++e) { const int dist = dq - 16 * ((e & 3) + 8 * (e >> 2)); const int dc = dist < 0 ? 0 : (dist > 2047 ? 2047 : dist); bv[e] = tabh[dc]; }
#if 1
#pragma unroll
    for (int e = 0; e < 16; e += 4) asm volatile("" : "+v"(bv[e]), "+v"(bv[e + 1]), "+v"(bv[e + 2]), "+v"(bv[e + 3]));
#endif
#pragma unroll
    for (int e = 0; e < 16; ++e) { const int dist = dq - 16 * ((e & 3) + 8 * (e >> 2)); s[e] = dist < 0 ? NINF : __builtin_fmaf(s[e], QSC, bv[e] * L2E); }
  }
}
__device__ __forceinline__ void unit_acmp1(const Params& p, int u, WaveLds* L, int lane) {
  const int h = u & 7, qt = (p.S / 32 - 1) - (u >> 3), q0 = qt * 32, g = h >> 2, r32 = lane & 31, hi = lane >> 5; const int ncmp = p.S / 16;
  bf16x8 qf[4]; load_q(qf, p.proj + (long)(q0 + r32) * NPROJ + PA_Q + h * 64, hi);
  FlashState st; st.o0 = zero16(); st.o1 = zero16(); st.m = -1e30f; st.l = 0.f;
  const int jn = q0 / 16 + 1, nt = (jn + 31) / 32; const SB* kc = p.kvc + g * 64; const SB* vc = p.kvc + (long)ncmp * 128 + g * 64;
  const float* tabh = p.tabA + h * TABA_N; const float c31 = tabh[2047] * L2E;
  flash_run(st, qf, 0, nt, [&](int t) { int j = 32 * t + r32; j = j >= ncmp ? ncmp - 1 : j; return kc + (long)j * 128; },
            [&](int t, int key) { int jj = 32 * t + key; jj = jj >= ncmp ? ncmp - 1 : jj; return vc + (long)jj * 128; },
            [&](int t, f32x16& s) { fix_cmp(s, tabh, c31, q0, t, lane); }, L, lane);
  const float lt = st.l + xor32_f(st.l); const float inv = lt > 0.f ? 1.f / lt : 0.f;
  flash_finish(st, L, lane);
#pragma unroll
  for (int e = 0; e < 16; ++e) { SB* op = p.oc + (long)(q0 + crow(e, hi)) * 512 + h * 64 + r32; op[0] = f2bf(st.o0[e]); op[32] = f2bf(st.o1[e]); }
  if (hi == 0) { p.cml[((long)(q0 + r32) * 8 + h) * 2] = st.m; p.cml[((long)(q0 + r32) * 8 + h) * 2 + 1] = inv; }
}
__device__ __forceinline__ void unit_acmp2(const Params& p, int u, int lane) {
  const int part = u & 3, g = (u >> 2) & 1, qt = (p.S / 32 - 1) - (u >> 3), q0 = qt * 32, r32 = lane & 31, hi = lane >> 5; const int ncmp = p.S / 16;
  const int jn = q0 / 16 + 1, nt = (jn + 31) / 32; const SB* kc = p.kvc + g * 64; float carry = 0.f;
  const int tper = (nt + 3) >> 2, tbeg = part * tper, tend = (tbeg + tper < nt) ? tbeg + tper : nt; if (tbeg >= nt) return;
  float* impq = p.imp + ((long)qt * 2 + g) * 256 * 32 + r32;
  const SB* qbase = p.proj + (long)(q0 + r32) * NPROJ + PA_Q + g * 256; const float* cmlq = p.cml + ((long)(q0 + r32) * 8 + g * 4) * 2;
  bf16x8 qc[4]; load_q(qc, qbase, hi); float mc = cmlq[0], ilc = cmlq[1], c31c = p.tabA[(g * 4) * TABA_N + 2047] * L2E;
  bf16x8 kfn[4]; { const int t = (tbeg > 0 ? tbeg - 1 : 0); int j = 32 * t + r32; j = j >= ncmp ? ncmp - 1 : j; const SB* kp = kc + (long)j * 128;
#pragma unroll
    for (int d0 = 0; d0 < 4; ++d0) kfn[d0] = *(const bf16x8*)(kp + d0 * 16 + hi * 8); }
  for (int t = (tbeg > 0 ? tbeg - 1 : 0); t < tend; ++t) {
    bf16x8 kf[4];
#pragma unroll
    for (int d0 = 0; d0 < 4; ++d0) kf[d0] = kfn[d0];
    if (t + 1 < tend) { int j = 32 * (t + 1) + r32; j = j >= ncmp ? ncmp - 1 : j; const SB* kp = kc + (long)j * 128;
#pragma unroll
      for (int d0 = 0; d0 < 4; ++d0) kfn[d0] = *(const bf16x8*)(kp + d0 * 16 + hi * 8); }
    float accA[4] = {0.f, 0.f, 0.f, 0.f}, accL[4] = {0.f, 0.f, 0.f, 0.f};
#pragma unroll 1
    for (int hh = 0; hh < 4; ++hh) { const int hn = (hh + 1) & 3;
      bf16x8 qn[4]; load_q(qn, qbase + hn * 64, hi); const float mn = cmlq[hn * 2], iln = cmlq[hn * 2 + 1], c31n = p.tabA[(g * 4 + hn) * TABA_N + 2047];
      f32x16 s = zero16();
#pragma unroll
      for (int d0 = 0; d0 < 4; ++d0) s = MFMA32(kf[d0], qc[d0], s);
      fix_cmp(s, p.tabA + (g * 4 + hh) * TABA_N, c31c, q0, t, lane);
#pragma unroll
      for (int e = 0; e < 16; ++e) { const float pr = __builtin_amdgcn_exp2f(s[e] - mc) * ilc; accA[e >> 2] += pr; if ((e & 3) == 3) accL[e >> 2] += pr; }
#pragma unroll
      for (int d0 = 0; d0 < 4; ++d0) qc[d0] = qn[d0];
      mc = mn; ilc = iln; c31c = c31n * L2E; }
    float oth[4];
#pragma unroll
    for (int eg = 0; eg < 4; ++eg) oth[eg] = xor32_f(accL[eg]);
#pragma unroll
    for (int eg = 0; eg < 4; ++eg) { const float prev = hi ? oth[eg] : (eg > 0 ? oth[eg > 0 ? eg - 1 : 0] : carry); if (t >= tbeg) impq[(8 * t + 2 * eg + hi) * 32] = 2.f * accA[eg] - accL[eg] + prev; }
    carry = oth[3]; }
}
#define DPP_F(v, ctrl, rm) __builtin_bit_cast(float, __builtin_amdgcn_update_dpp(__builtin_bit_cast(int, v), __builtin_bit_cast(int, v), ctrl, rm, 0xf, false))
#define DPP_I(v, ctrl, rm) __builtin_amdgcn_update_dpp(v, v, ctrl, rm, 0xf, false)
__device__ __forceinline__ float wave_max_f(float v) {
  v = fmaxf(v, DPP_F(v, 0xB1, 0xf)); v = fmaxf(v, DPP_F(v, 0x4E, 0xf)); v = fmaxf(v, DPP_F(v, 0x141, 0xf)); v = fmaxf(v, DPP_F(v, 0x140, 0xf));
  v = fmaxf(v, DPP_F(v, 0x142, 0xa)); v = fmaxf(v, DPP_F(v, 0x143, 0xc));
  return __builtin_bit_cast(float, __builtin_amdgcn_readlane(__builtin_bit_cast(int, v), 63)); }
__device__ __forceinline__ int imin_(int a, int b) { return a < b ? a : b; }
__device__ __forceinline__ int wave_min_i(int v) {
  v = imin_(v, DPP_I(v, 0xB1, 0xf)); v = imin_(v, DPP_I(v, 0x4E, 0xf)); v = imin_(v, DPP_I(v, 0x141, 0xf)); v = imin_(v, DPP_I(v, 0x140, 0xf));
  v = imin_(v, DPP_I(v, 0x142, 0xa)); v = imin_(v, DPP_I(v, 0x143, 0xc));
  return __builtin_amdgcn_readlane(v, 63); }
__device__ __forceinline__ void unit_topk(const Params& p, int u, int lane) {
  const int q = u >> 1, cur = q >> 6; const float* imp = p.imp + ((long)(q >> 5) * 2 + (u & 1)) * 256 * 32 + (q & 31); int* idx = p.idx + (long)u * 16;
  float v[4];
#pragma unroll
  for (int k = 0; k < 4; ++k) { const int b = lane + 64 * k; float x = (b <= cur) ? imp[b * 32] : -1.f; if (b == 0 || b == cur) x = 1e4f; v[k] = x; }
  int mine = -1;
  for (int k = 0; k < 16; ++k) {
    float lm = fmaxf(fmaxf(v[0], v[1]), fmaxf(v[2], v[3])); const float m = wave_max_f(lm);
    int cand = 0x7fffffff;
#pragma unroll
    for (int kk = 3; kk >= 0; --kk) if (v[kk] == m) cand = lane + 64 * kk;
    const int bsel = wave_min_i(cand);
#pragma unroll
    for (int kk = 0; kk < 4; ++kk) if (lane + 64 * kk == bsel) v[kk] = -2.f;
    if (lane == k) mine = (m >= 0.f) ? bsel : -1;
  }
  if (lane < 16) idx[lane] = mine;
}
template <bool STORE = true>
__device__ __forceinline__ void unit_asel(const Params& p, int u, WaveLds* L, int lane) {
  const int g = u & 1, q = u >> 1, r32 = lane & 31, hi = lane >> 5, hh = r32 & 3, h = g * 4 + hh;
  bf16x8 qf[4]; load_q(qf, p.proj + (long)q * NPROJ + PA_Q + h * 64, hi);
  FlashState st; st.o0 = zero16(); st.o1 = zero16(); st.m = -1e30f; st.l = 0.f;
  const int* idx = p.idx + (long)u * 16; const SB* kvb = p.proj + PA_KV + 2 * 128 + g * 64; const float c31 = p.tabA[h * TABA_N + 2047] * L2E;
  for (int k = 0; k < 16; ++k) { const int b = __builtin_amdgcn_readfirstlane(idx[k]); if (b < 0) continue;
    for (int kt = 0; kt < 2; ++kt) { const int t0 = b * 64 + kt * 32; if (t0 > q) continue;
      const bool far = (q - (t0 + 31)) >= 1513; const bool edge = (t0 + 31 > q);
      flash_tile(st, qf, kvb + (long)(t0 + r32) * NPROJ, [&](int key) { return kvb + 128 + (long)(t0 + key) * NPROJ; },
                 [&](f32x16& s) {
#pragma unroll
                   for (int e = 0; e < 16; ++e) { const int tk = t0 + (e & 3) + 8 * (e >> 2) + 4 * hi; const int dist = q - tk; float bsv;
                     if (far) bsv = c31; else { const int dc = dist < 0 ? 0 : (dist > 2047 ? 2047 : dist); bsv = p.tabA[h * TABA_N + dc] * L2E; }
                     float vv = s[e] * QSC + bsv; if (edge && dist < 0) vv = NINF; s[e] = vv; } }, L, lane); } }
  flash_finish(st, L, lane);
  if (!STORE) { asm volatile("" :: "v"(st.o0[0]), "v"(st.o1[3])); return; }
  if (hi == 0) {
#pragma unroll
    for (int e = 0; e < 4; ++e) { const int he = g * 4 + e; const float* gl = p.small + (long)q * NSMALL + he * 3;
      const float g0 = sigmoid_fast(gl[0]), g1 = sigmoid_fast(gl[1]), g2 = sigmoid_fast(gl[2]);
#pragma unroll
      for (int db = 0; db < 2; ++db) { const long c = (long)q * 512 + he * 64 + db * 32 + r32; const float os = db ? st.o1[e] : st.o0[e];
        const float a = g0 * bf2f(p.oc[c]) + g1 * os + g2 * bf2f(p.ow[c]); SB* mp = p.mix + (long)q * NMIX + MX_A + he * 64 + db * 32 + r32; *mp = f2bf(a * bf2f(*mp)); } }
  }
}

struct WaveLds2 { unsigned short x[2048]; unsigned short b[2048]; float acs[128]; float dtv[128]; float xch[64]; };
template <bool SCALE, class RowScale>
__device__ __forceinline__ void stage_slab(unsigned short* dst, const SB* src, long ld, RowScale rs, int lane) {
#pragma unroll
  for (int i = 0; i < 4; ++i) { const int c = lane + 64 * i, row = c >> 3, ch = c & 7; uint4 vv = *(const uint4*)(src + (long)row * ld + ch * 8);
    if (SCALE) { const float sc = rs(row); unsigned w[4] = {vv.x, vv.y, vv.z, vv.w};
#pragma unroll
      for (int k = 0; k < 4; ++k) { const float lo = __uint_as_float(w[k] << 16) * sc, hi2 = __uint_as_float(w[k] & 0xffff0000u) * sc; w[k] = pk2(lo, hi2); }
      vv.x = w[0]; vv.y = w[1]; vv.z = w[2]; vv.w = w[3]; }
    *(uint4*)&dst[(ch >> 2) * 1024 + row * 32 + (ch & 3) * 8] = vv; }
}
__device__ __forceinline__ bf16x8 slab_frag(const unsigned short* img, int cb, int s2, int lane) {
  const int hi = lane >> 5; const unsigned short* vb = img + (4 * hi + ((lane & 15) >> 2)) * 32 + ((lane >> 4) & 1) * 16 + (lane & 3) * 4 + cb * 1024 + s2 * 512;
  const v4i16_t lo = __builtin_amdgcn_ds_read_tr16_b64_v4i16((LDS3 v4i16_t*)vb);
  const v4i16_t hh = __builtin_amdgcn_ds_read_tr16_b64_v4i16((LDS3 v4i16_t*)(vb + 256));
  return (bf16x8){lo[0], lo[1], lo[2], lo[3], hh[0], hh[1], hh[2], hh[3]};
}
__device__ __forceinline__ void unit_bstates(const Params& p, int u, WaveLds2* L, int lane) {
  const int nh = u & 1, hd = (u >> 1) & 7, c = u >> 4, g = hd >> 2, r32 = lane & 31, hi = lane >> 5;
  f32x16 acc[2][2];
#pragma unroll
  for (int i = 0; i < 2; ++i)
#pragma unroll
    for (int j = 0; j < 2; ++j) acc[i][j] = zero16();
  const SB* xb = p.xconv + (long)c * 128 * 1024; const float* wst = p.wst + (long)c * 128 * 8 + hd;
  for (int q4 = 0; q4 < 4; ++q4) {
    stage_slab<true>(L->x, xb + (long)(32 * q4) * 1024 + hd * 64, 1024, [&](int row) { return wst[(32 * q4 + row) * 8]; }, lane);
    stage_slab<false>(L->b, xb + (long)(32 * q4) * 1024 + 512 + g * 128 + nh * 64, 1024, [&](int) { return 1.f; }, lane);
#pragma unroll
    for (int s2 = 0; s2 < 2; ++s2) { bf16x8 af[2], bfr[2];
#pragma unroll
      for (int i = 0; i < 2; ++i) { af[i] = slab_frag(L->x, i, s2, lane); bfr[i] = slab_frag(L->b, i, s2, lane); }
#pragma unroll
      for (int i = 0; i < 2; ++i)
#pragma unroll
        for (int j = 0; j < 2; ++j) acc[i][j] = MFMA32(af[i], bfr[j], acc[i][j]); } }
  float* so = p.states + ((long)c * 8 + hd) * 8192 + nh * 64 + r32;
#pragma unroll
  for (int i = 0; i < 2; ++i)
#pragma unroll
    for (int j = 0; j < 2; ++j)
#pragma unroll
      for (int e = 0; e < 16; ++e) so[(long)(32 * i + crow(e, hi)) * 128 + 32 * j] = acc[i][j][e];
}
__device__ __forceinline__ void unit_bout(const Params& p, int layer, int u, WaveLds2* L, int lane) {
  const int lt = u & 3, hd = (u >> 2) & 7, c = u >> 5, g = hd >> 2, r32 = lane & 31, hi = lane >> 5;
  for (int x = lane; x < 128; x += 64) { L->acs[x] = p.acs[((long)c * 128 + x) * 8 + hd]; L->dtv[x] = p.dt[((long)c * 128 + x) * 8 + hd]; }
  f32x16 acc[2] = {zero16(), zero16()}, acc2[2] = {zero16(), zero16()};
  const SB* xb = p.xconv + (long)c * 128 * 1024; const int l = 32 * lt + r32; const float al = p.acs[((long)c * 128 + l) * 8 + hd];
  const float* cbr = p.cb + ((long)c * 2 + g) * 16384 + (long)l * 128;
  for (int sc = 0; sc <= lt; ++sc) {
    stage_slab<false>(L->x, xb + (long)(32 * sc) * 1024 + hd * 64, 1024, [&](int) { return 1.f; }, lane);
#pragma unroll
    for (int s2 = 0; s2 < 2; ++s2) { float mv[8];
#pragma unroll
      for (int jj = 0; jj < 2; ++jj) { const int s0 = 32 * sc + 16 * s2 + 8 * jj + 4 * hi; const float4 cv = *(const float4*)(cbr + s0); const float4 av = *(const float4*)(&L->acs[s0]); const float4 dv = *(const float4*)(&L->dtv[s0]);
        mv[4 * jj + 0] = (s0 + 0 <= l) ? cv.x * __expf(al - av.x) * dv.x : 0.f; mv[4 * jj + 1] = (s0 + 1 <= l) ? cv.y * __expf(al - av.y) * dv.y : 0.f;
        mv[4 * jj + 2] = (s0 + 2 <= l) ? cv.z * __expf(al - av.z) * dv.z : 0.f; mv[4 * jj + 3] = (s0 + 3 <= l) ? cv.w * __expf(al - av.w) * dv.w : 0.f; }
      u32x4 aw; aw[0] = pk2(mv[0], mv[1]); aw[1] = pk2(mv[2], mv[3]); aw[2] = pk2(mv[4], mv[5]); aw[3] = pk2(mv[6], mv[7]); const bf16x8 af = __builtin_bit_cast(bf16x8, aw);
#pragma unroll
      for (int pt = 0; pt < 2; ++pt) acc[pt] = MFMA32(af, slab_frag(L->x, pt, s2, lane), acc[pt]); } }
  const SB* cmr = xb + (long)l * 1024 + 768 + g * 128; const float* prv = p.states + ((long)c * 8 + hd) * 8192;
#pragma unroll 2
  for (int ks = 0; ks < 8; ++ks) { const bf16x8 af = *(const bf16x8*)(cmr + 16 * ks + 8 * hi);
#pragma unroll
    for (int pt = 0; pt < 2; ++pt) { const float* pr = prv + (long)(32 * pt + r32) * 128 + 16 * ks + 8 * hi; const float4 a0 = *(const float4*)pr, a1 = *(const float4*)(pr + 4);
      u32x4 bw; bw[0] = pk2(a0.x, a0.y); bw[1] = pk2(a0.z, a0.w); bw[2] = pk2(a1.x, a1.y); bw[3] = pk2(a1.z, a1.w);
      acc2[pt] = MFMA32(af, __builtin_bit_cast(bf16x8, bw), acc2[pt]); } }
  const float dsk = p.b_d[layer * 8 + hd];
#pragma unroll
  for (int e = 0; e < 16; ++e) { const int lr = 32 * lt + crow(e, hi); const float ea = __expf(L->acs[lr]); const long t = (long)c * 128 + lr;
#pragma unroll
    for (int pt = 0; pt < 2; ++pt) { const int pp = 32 * pt + r32; p.ybuf[t * 512 + hd * 64 + pp] = acc[pt][e] + ea * acc2[pt][e] + dsk * bf2f(xb[(long)lr * 1024 + hd * 64 + pp]); } }
}
__device__ __forceinline__ void unit_bnorm(const Params& p, int layer, int u, int lane) {
  const int g = u & 1; const long t = u >> 1; const float4 yv = *(const float4*)(p.ybuf + t * 512 + g * 256 + lane * 4);
  SB* mp = p.mix + t * NMIX + MX_B + g * 256 + lane * 4; const ushort4 zv = *(const ushort4*)mp;
  const float v0 = yv.x * bf2f(zv.x), v1 = yv.y * bf2f(zv.y), v2 = yv.z * bf2f(zv.z), v3 = yv.w * bf2f(zv.w);
  const float ss = wave_sum_f(v0 * v0 + v1 * v1 + v2 * v2 + v3 * v3); const float r = 1.f / sqrtf(ss * (1.f / 256.f) + 1e-6f);
  const float4 w = *(const float4*)(p.b_norm + layer * 512 + g * 256 + lane * 4);
  ushort4 o; o.x = f2bf(v0 * r * w.x); o.y = f2bf(v1 * r * w.y); o.z = f2bf(v2 * r * w.z); o.w = f2bf(v3 * r * w.w); *(ushort4*)mp = o;
}
__device__ __forceinline__ void unit_bdt(const Params& p, int layer, int u, int lane) {
  const int hd = u & 7, c = u >> 3; const float a = -expf(p.a_log[layer * 8 + hd]), bias = p.dt_bias[layer * 8 + hd]; const long t0 = (long)c * 128 + 2 * lane;
  const float d0 = softplus_f(p.small[t0 * NSMALL + 24 + hd] + bias), d1 = softplus_f(p.small[(t0 + 1) * NSMALL + 24 + hd] + bias);
  float run = (d0 + d1) * a;
#pragma unroll
  for (int o = 1; o < 64; o <<= 1) { const float v = __shfl_up(run, o); if (lane >= o) run += v; }
  const float tot = __shfl(run, 63); const float c1 = run, c0 = run - d1 * a;
  p.dt[t0 * 8 + hd] = d0; p.dt[(t0 + 1) * 8 + hd] = d1; p.acs[t0 * 8 + hd] = c0; p.acs[(t0 + 1) * 8 + hd] = c1;
  p.wst[t0 * 8 + hd] = d0 * expf(tot - c0); p.wst[(t0 + 1) * 8 + hd] = d1 * expf(tot - c1);
}
__device__ __forceinline__ void item_bconv(const Params& p, int layer, long gid) {
  const int cg = (int)(gid & 127) * 8; const long t = gid >> 7; const float* w = p.conv_w + (long)layer * 4 * 1024 + cg; const float* bb = p.conv_b + layer * 1024 + cg;
  const float4 b0 = *(const float4*)bb, b1 = *(const float4*)(bb + 4);
  float acc[8] = {b0.x, b0.y, b0.z, b0.w, b1.x, b1.y, b1.z, b1.w};
#pragma unroll
  for (int i = 0; i < 4; ++i) { const long tt = t - 3 + i; const long tc = tt < 0 ? 0 : tt; const float vm = tt < 0 ? 0.f : 1.f;
    const uint4 vv = *(const uint4*)(p.proj + tc * NPROJ + PB_X + cg); const unsigned wd[4] = {vv.x, vv.y, vv.z, vv.w};
    const float4 w0 = *(const float4*)(w + i * 1024), w1 = *(const float4*)(w + i * 1024 + 4); const float wv[8] = {w0.x, w0.y, w0.z, w0.w, w1.x, w1.y, w1.z, w1.w};
#pragma unroll
    for (int k = 0; k < 4; ++k) { acc[2 * k] += vm * wv[2 * k] * __uint_as_float(wd[k] << 16); acc[2 * k + 1] += vm * wv[2 * k + 1] * __uint_as_float(wd[k] & 0xffff0000u); } }
  uint4 o; o.x = pk2(silu_fast(acc[0]), silu_fast(acc[1])); o.y = pk2(silu_fast(acc[2]), silu_fast(acc[3])); o.z = pk2(silu_fast(acc[4]), silu_fast(acc[5])); o.w = pk2(silu_fast(acc[6]), silu_fast(acc[7]));
  *(uint4*)(p.xconv + t * 1024 + cg) = o;
}
__device__ __forceinline__ void unit_cmp(const Params& p, int layer, int u, int lane) {
  const int ncmp = p.S / 16, ntile = ncmp * 2 / 32; const int kv = u / ntile, rt = u % ntile, r32 = lane & 31, hi = lane >> 5;
  const int r = 32 * rt + r32, j = r >> 1, hk = r & 1;
  const unsigned short* w1t = p.w1t + (long)kv * 128 * 2048; const unsigned short* w2t = p.w2t + kv * 64 * 128; const float* pe = p.cmp_pos + (long)(layer * 2 + kv) * 32 * 64;
  const SB* src = p.proj + PA_KV + kv * 128 + hk * 64;
  f32x16 acc[4] = {zero16(), zero16(), zero16(), zero16()};
#pragma unroll 4
  for (int ks = 0; ks < 128; ++ks) { const int t = ks >> 2, d = (ks & 3) * 16 + 8 * hi; const long tok = 16 * j + t;
    const float4 p0 = *(const float4*)(pe + t * 64 + d), p1 = *(const float4*)(pe + t * 64 + d + 4); float v[8] = {p0.x, p0.y, p0.z, p0.w, p1.x, p1.y, p1.z, p1.w};
    { const long tokc = tok < p.S ? tok : (long)p.S - 1; const float vm = tok < p.S ? 1.f : 0.f;
      const uint4 vv = *(const uint4*)(src + tokc * NPROJ + d); const unsigned wd[4] = {vv.x, vv.y, vv.z, vv.w};
#pragma unroll
      for (int k = 0; k < 4; ++k) { v[2 * k] += vm * __uint_as_float(wd[k] << 16); v[2 * k + 1] += vm * __uint_as_float(wd[k] & 0xffff0000u); } }
    u32x4 bw; bw[0] = pk2(v[0], v[1]); bw[1] = pk2(v[2], v[3]); bw[2] = pk2(v[4], v[5]); bw[3] = pk2(v[6], v[7]); const bf16x8 bfr = __builtin_bit_cast(bf16x8, bw);
#pragma unroll
    for (int ut = 0; ut < 4; ++ut) { const bf16x8 af = *(const bf16x8*)(w1t + (long)(32 * ut + r32) * 2048 + 16 * ks + 8 * hi); acc[ut] = MFMA32(af, bfr, acc[ut]); } }
  f32x16 o2[2] = {zero16(), zero16()};
#pragma unroll
  for (int ut = 0; ut < 4; ++ut) {
#pragma unroll
    for (int e = 0; e < 16; ++e) acc[ut][e] = gelu_f(acc[ut][e]);
#pragma unroll
    for (int s2 = 0; s2 < 2; ++s2) { const bf16x8 hb = pack8(acc[ut], 8 * s2);
#pragma unroll
      for (int dt = 0; dt < 2; ++dt) { const unsigned short* wr = w2t + (32 * dt + r32) * 128 + 32 * ut + 16 * s2 + 4 * hi; const uint2 x0 = *(const uint2*)wr, x1 = *(const uint2*)(wr + 8);
        u32x4 aw; aw[0] = x0.x; aw[1] = x0.y; aw[2] = x1.x; aw[3] = x1.y; o2[dt] = MFMA32(__builtin_bit_cast(bf16x8, aw), hb, o2[dt]); } } }
  SB* dst = p.kvc + ((long)kv * ncmp * 2 + r) * 64;
#pragma unroll
  for (int dt = 0; dt < 2; ++dt)
#pragma unroll
    for (int e = 0; e < 16; ++e) dst[32 * dt + crow(e, hi)] = f2bf(o2[dt][e]);
}

__device__ __forceinline__ unsigned umax_(unsigned a, unsigned b) { return a > b ? a : b; }
#define DPP_U(v, ctrl, rm) (unsigned)__builtin_amdgcn_update_dpp((int)(v), (int)(v), ctrl, rm, 0xf, false)
__device__ __forceinline__ unsigned wave_max_u(unsigned v) {
  v = umax_(v, DPP_U(v, 0xB1, 0xf)); v = umax_(v, DPP_U(v, 0x4E, 0xf)); v = umax_(v, DPP_U(v, 0x141, 0xf)); v = umax_(v, DPP_U(v, 0x140, 0xf));
  v = umax_(v, DPP_U(v, 0x142, 0xa)); v = umax_(v, DPP_U(v, 0x143, 0xc));
  return (unsigned)__builtin_amdgcn_readlane((int)v, 63); }
template <int NR, class RowFn, class OutFn>
__device__ __forceinline__ void topkn_rows_o(const Params& p, RowFn rowfn, OutFn outfn, int lane) {
  unsigned v[NR][4]; int mine[NR];
#pragma unroll
  for (int r = 0; r < NR; ++r) { const int row = rowfn(r); const int q = row >> 1; const int cur = q >> 6; const float* imp = p.imp + ((long)(q >> 5) * 2 + (row & 1)) * 256 * 32 + (q & 31); mine[r] = -1;
#pragma unroll
    for (int k = 0; k < 4; ++k) { const int b = lane + 64 * k; float x = (b <= cur) ? imp[b * 32] : -1.f; if (b == 0 || b == cur) x = 1e4f;
      v[r][k] = (x >= 0.f) ? ((((__float_as_uint(x) >> 8) + 1u) << 8) | (unsigned)(255 - b)) : 0u; } }
  for (int k = 0; k < 16; ++k) {
    unsigned m[NR];
#pragma unroll
    for (int r = 0; r < NR; ++r) m[r] = wave_max_u(umax_(umax_(v[r][0], v[r][1]), umax_(v[r][2], v[r][3])));
#pragma unroll
    for (int r = 0; r < NR; ++r) {
#pragma unroll
      for (int kk = 0; kk < 4; ++kk) if (v[r][kk] == m[r]) v[r][kk] = 0u;
      if (lane == k) mine[r] = (m[r] != 0u) ? (int)(255u - (m[r] & 255u)) : -1; }
  }
#pragma unroll
  for (int r = 0; r < NR; ++r) if (lane < 16) { p.idx[(long)rowfn(r) * 16 + lane] = mine[r]; outfn(r, mine[r]); }
}
template <class RowFn, class OutFn>
__device__ __forceinline__ void topk4_rows_o(const Params& p, RowFn rowfn, OutFn outfn, int lane) { topkn_rows_o<4>(p, rowfn, outfn, lane); }
template <class RowFn>
__device__ __forceinline__ void topk4_rows(const Params& p, RowFn rowfn, int lane) { topk4_rows_o(p, rowfn, [](int, int) {}, lane); }
__device__ __forceinline__ void unit_topk4(const Params& p, int u, int lane) { topk4_rows(p, [&](int r) { return u * 4 + r; }, lane); }
__device__ __forceinline__ void glds16_asm(const void* gsrc, unsigned lds_dst) {
  unsigned keep; asm volatile("s_mov_b32 %0, m0\n\ts_mov_b32 m0, %2\n\ts_nop 0\n\tglobal_load_lds_dwordx4 %1, off\n\ts_mov_b32 m0, %0" : "=&s"(keep) : "v"(gsrc), "s"(lds_dst) : "memory");
}
__device__ __forceinline__ unsigned lds_addr(const void* p) { return (unsigned)(size_t)(LDS3 const void*)p; }
struct AselLds { unsigned short k[3][4096]; unsigned short v[3][4096]; unsigned short q[4][2048]; unsigned sel[64][8]; unsigned anyb[8]; int nlist; int pad[7]; unsigned char blist[256]; float xch[4][32]; unsigned char bkt[1664]; float relS[128]; };
__device__ __forceinline__ void asel_issue(uint4 (&r)[4], const SB* kvb, int b, int tid) {
#pragma unroll
  for (int i = 0; i < 2; ++i) { const int idx = tid + 256 * i, row = idx >> 3, ch = idx & 7; const SB* src = kvb + (long)(b * 64 + row) * NPROJ + ch * 8; r[i] = *(const uint4*)src; r[2 + i] = *(const uint4*)(src + 128); }
}
__device__ __forceinline__ void asel_commit(const uint4 (&r)[4], AselLds* A, int stage, int tid) {
#pragma unroll
  for (int i = 0; i < 2; ++i) { const int idx = tid + 256 * i, row = idx >> 3, ch = idx & 7;
    *(uint4*)&A->k[stage][row * 64 + ((ch ^ (row & 7)) * 8)] = r[i];
    *(uint4*)&A->v[stage][(ch >> 2) * 2048 + row * 32 + (ch & 3) * 8] = r[2 + i]; }
}
__device__ __forceinline__ void asel_coltile(const Params& p, FlashState& S_, const unsigned short* qlds, AselLds* A, float* xch, int stage, int b, int cur, int q0, int qbase, int h, float c31, int lane) {
  const int r32 = lane & 31, hi = lane >> 5; const int ql = qbase + (r32 >> 2); const int q = q0 + ql;
  const bool selq = (A->sel[ql][b >> 5] >> (b & 31)) & 1u;
  if (!__any(selq)) return;
  bf16x8 qf[4];
#pragma unroll
  for (int d0 = 0; d0 < 4; ++d0) qf[d0] = *(const bf16x8*)&qlds[r32 * 64 + (((2 * d0 + hi) ^ ((r32 >> 1) & 7)) * 8)];
  const bool far = (q0 - (b * 64 + 63)) >= 1513; const bool edge = (b == cur);
#ifndef ASEL2
#define ASEL2 1
#endif
#if ASEL2
  bf16x8 kf0[4], kf1[4];
#pragma unroll
  for (int d0 = 0; d0 < 4; ++d0) { const int row0 = r32, row1 = 32 + r32;
    kf0[d0] = *(const bf16x8*)&A->k[stage][row0 * 64 + (((2 * d0 + hi) ^ ((row0 >> 1) & 7)) * 8)];
    kf1[d0] = *(const bf16x8*)&A->k[stage][row1 * 64 + (((2 * d0 + hi) ^ ((row1 >> 1) & 7)) * 8)]; }
  f32x16 s0 = zero16(), s1 = zero16();
#pragma unroll
  for (int d0 = 0; d0 < 4; ++d0) { s0 = MFMA32(kf0[d0], qf[d0], s0); s1 = MFMA32(kf1[d0], qf[d0], s1); }
  if (far) { flash_core2_lin(S_, s0, s1, selq ? QSC : 0.f, selq ? c31 : NINF, A->v[stage], xch, lane); return; }
#pragma unroll
  for (int e = 0; e < 16; ++e) { const int tk = b * 64 + (e & 3) + 8 * (e >> 2) + 4 * hi; const int dist = q - tk; float b0, b1;
    { const int d0c = dist < 0 ? 0 : (dist > 1663 ? 1663 : dist); const int d1 = dist - 32; const int d1c = d1 < 0 ? 0 : (d1 > 1663 ? 1663 : d1);
      b0 = A->relS[A->bkt[d0c] * 4 + (h & 3)]; b1 = A->relS[A->bkt[d1c] * 4 + (h & 3)]; }
    float v0 = s0[e] * QSC + b0, v1 = s1[e] * QSC + b1; if (!selq || (edge && dist < 0)) v0 = NINF; if (!selq || (edge && dist < 32)) v1 = NINF; s0[e] = v0; s1[e] = v1; }
  flash_core2(S_, s0, s1, A->v[stage], xch, lane);
}
#else
#pragma unroll 1
  for (int kt = 0; kt < 2; ++kt) { const int t0 = b * 64 + 32 * kt; if (edge && t0 > q0 + qbase + 7) continue;
    bf16x8 kf[4]; { const int row = 32 * kt + r32;
#pragma unroll
      for (int d0 = 0; d0 < 4; ++d0) kf[d0] = *(const bf16x8*)&A->k[stage][row * 64 + (((2 * d0 + hi) ^ ((row >> 1) & 7)) * 8)]; }
    f32x16 s = zero16();
#pragma unroll
    for (int d0 = 0; d0 < 4; ++d0) s = MFMA32(kf[d0], qf[d0], s);
    if (far) { flash_core1_lin(S_, s, selq ? QSC : 0.f, selq ? c31 : NINF, A->v[stage] + kt * 1024, xch, lane); continue; }
#pragma unroll
    for (int e = 0; e < 16; ++e) { const int tk = t0 + (e & 3) + 8 * (e >> 2) + 4 * hi; const int dist = q - tk;
      const int dc = dist < 0 ? 0 : (dist > 2047 ? 2047 : dist); const float bsv = p.tabA[h * TABA_N + dc] * L2E;
      float vv = s[e] * QSC + bsv; if (!selq || (edge && dist < 0)) vv = NINF; s[e] = vv; }
    flash_core1(S_, s, A->v[stage] + kt * 1024, xch, lane);
  }
}
#endif
__device__ __forceinline__ void asel_store(const Params& p, FlashState& S_, float* xch, int q0, int qbase, int g, int lane) {
  const int r32 = lane & 31, hi = lane >> 5;
  const float lt = S_.l + xor32_f(S_.l); const float inv = lt > 0.f ? 1.f / lt : 0.f; xch[r32] = inv;
#pragma unroll
  for (int e = 0; e < 16; ++e) { const int j = crow(e, hi); const float a = xch[j]; const int q = q0 + qbase + (j >> 2), he = g * 4 + (j & 3);
    const float* gl = p.small + (long)q * NSMALL + he * 3; const float g0 = sigmoid_fast(gl[0]), g1 = sigmoid_fast(gl[1]), g2 = sigmoid_fast(gl[2]);
#pragma unroll
    for (int db = 0; db < 2; ++db) { const long c = (long)q * 512 + he * 64 + db * 32 + r32; const float os = (db ? S_.o1[e] : S_.o0[e]) * a;
      const float av = g0 * bf2f(p.oc[c]) + g1 * os + g2 * bf2f(p.ow[c]); SB* mp = p.mix + (long)q * NMIX + MX_A + he * 64 + db * 32 + r32; *mp = f2bf(av * bf2f(*mp)); } }
}
#ifndef ASEL16
#define ASEL16 1
#endif
typedef float f32x4_t __attribute__((ext_vector_type(4)));
#define MFMA16(a, b, c) __builtin_amdgcn_mfma_f32_16x16x32_bf16((a), (b), (c), 0, 0, 0)
struct Asel16 { f32x4_t o0, o1, o2, o3; float m, l; };
__device__ __forceinline__ float quadmax_f(float v) {
  const auto a = __builtin_amdgcn_permlane16_swap(__float_as_uint(v), __float_as_uint(v), false, false); v = fmaxf(__uint_as_float(a[0]), __uint_as_float(a[1]));
  const auto b = __builtin_amdgcn_permlane32_swap(__float_as_uint(v), __float_as_uint(v), false, false); return fmaxf(__uint_as_float(b[0]), __uint_as_float(b[1])); }
__device__ __forceinline__ float quadsum_f(float v) {
  const auto a = __builtin_amdgcn_permlane16_swap(__float_as_uint(v), __float_as_uint(v), false, false); v = __uint_as_float(a[0]) + __uint_as_float(a[1]);
  const auto b = __builtin_amdgcn_permlane32_swap(__float_as_uint(v), __float_as_uint(v), false, false); return __uint_as_float(b[0]) + __uint_as_float(b[1]); }
__device__ __forceinline__ bf16x8 pack44(const f32x4_t& a, const f32x4_t& b) {
  u32x4 r; r[0] = pk2(a[0], a[1]); r[1] = pk2(a[2], a[3]); r[2] = pk2(b[0], b[1]); r[3] = pk2(b[2], b[3]); return __builtin_bit_cast(bf16x8, r); }
template <int CT>
__device__ __forceinline__ void asel_coltile16(const Params& p, Asel16& S_, const unsigned short* qlds, AselLds* A, float* xch, int stage, int b, int cur, int q0, int qbase, float c31, int lane) {
  const int j = lane & 15, q4 = lane >> 4; const int ql = qbase + 4 * CT + (j >> 2); const int q = q0 + ql;
  const bool selq = (A->sel[ql][b >> 5] >> (b & 31)) & 1u;
  if (!__any(selq)) return;
  const bool far = (q0 - (b * 64 + 63)) >= 1513; const bool edge = (b == cur);
  const int qrow = 16 * CT + j;
  const bf16x8 qf0 = *(const bf16x8*)&qlds[qrow * 64 + (((q4) ^ ((qrow >> 1) & 7)) * 8)], qf1 = *(const bf16x8*)&qlds[qrow * 64 + (((4 + q4) ^ ((qrow >> 1) & 7)) * 8)];
  f32x4_t sc[4];
#pragma unroll
  for (int kt = 0; kt < 4; ++kt) { const int row = 16 * kt + j;
    const bf16x8 k0 = *(const bf16x8*)&A->k[stage][row * 64 + (((q4) ^ ((row >> 1) & 7)) * 8)], k1 = *(const bf16x8*)&A->k[stage][row * 64 + (((4 + q4) ^ ((row >> 1) & 7)) * 8)];
    f32x4_t z = {0.f, 0.f, 0.f, 0.f}; z = MFMA16(k0, qf0, z); sc[kt] = MFMA16(k1, qf1, z); }
  float qs, bb;
  if (far) { qs = selq ? QSC : 0.f; bb = selq ? c31 : NINF; }
  else {
    qs = 1.f; bb = 0.f;
#pragma unroll
    for (int kt = 0; kt < 4; ++kt) {
#pragma unroll
      for (int r = 0; r < 4; ++r) { const int tk = b * 64 + 16 * kt + 4 * q4 + r; const int dist = q - tk; const int dc = dist < 0 ? 0 : (dist > 1663 ? 1663 : dist);
        float v = sc[kt][r] * QSC + A->relS[A->bkt[dc] * 4 + (j & 3)]; if (!selq || (edge && dist < 0)) v = NINF; sc[kt][r] = v; } }
  }
  float mr = fmaxf(fmaxf(sc[0][0], sc[0][1]), fmaxf(sc[0][2], sc[0][3]));
#pragma unroll
  for (int kt = 1; kt < 4; ++kt) mr = fmaxf(mr, fmaxf(fmaxf(sc[kt][0], sc[kt][1]), fmaxf(sc[kt][2], sc[kt][3])));
  float mx = far ? __builtin_fmaf(mr, qs, bb) : mr;
  mx = quadmax_f(mx);
  if (__any(mx > S_.m + FTHR)) {
    const float mn = fmaxf(S_.m, mx); const float al = __builtin_amdgcn_exp2f(S_.m - mn); S_.m = mn; S_.l *= al; xch[16 * CT + j] = al;
    const f32x4_t a = *(const f32x4_t*)&xch[16 * CT + 4 * q4];
    S_.o0 *= a; S_.o1 *= a; S_.o2 *= a; S_.o3 *= a;
  }
  const float bm = bb - S_.m; float ps = 0.f;
#pragma unroll
  for (int kt = 0; kt < 4; ++kt) {
#pragma unroll
    for (int r = 0; r < 4; ++r) { const float e_ = __builtin_amdgcn_exp2f(__builtin_fmaf(sc[kt][r], qs, bm)); sc[kt][r] = e_; ps += e_; } }
  S_.l += ps;
  const bf16x8 pa0 = pack44(sc[0], sc[1]), pa1 = pack44(sc[2], sc[3]);
  const unsigned short* vb = A->v[stage] + (4 * q4 + (j >> 2)) * 32 + (j & 3) * 4;
#pragma unroll
  for (int c = 0; c < 2; ++c) {
#pragma unroll
    for (int dt = 0; dt < 4; ++dt) {
      const v4i16_t lo = __builtin_amdgcn_ds_read_tr16_b64_v4i16((LDS3 v4i16_t*)(vb + (dt >> 1) * 2048 + (dt & 1) * 16 + c * 1024));
      const v4i16_t hh = __builtin_amdgcn_ds_read_tr16_b64_v4i16((LDS3 v4i16_t*)(vb + (dt >> 1) * 2048 + (dt & 1) * 16 + c * 1024 + 512));
      const bf16x8 vf = {lo[0], lo[1], lo[2], lo[3], hh[0], hh[1], hh[2], hh[3]};
      const bf16x8 pa = c ? pa1 : pa0;
      if (dt == 0) S_.o0 = MFMA16(pa, vf, S_.o0); else if (dt == 1) S_.o1 = MFMA16(pa, vf, S_.o1); else if (dt == 2) S_.o2 = MFMA16(pa, vf, S_.o2); else S_.o3 = MFMA16(pa, vf, S_.o3);
    }
  }
}
template <int CT>
__device__ __forceinline__ void asel_store16(const Params& p, Asel16& S_, float* xch, int q0, int qbase, int g, int lane) {
  const int j = lane & 15, q4 = lane >> 4;
  const float lt = quadsum_f(S_.l); const float inv = lt > 0.f ? 1.f / lt : 0.f; xch[16 * CT + j] = inv;
  const f32x4_t a = *(const f32x4_t*)&xch[16 * CT + 4 * q4];
  const int q = q0 + qbase + 4 * CT + q4;
#pragma unroll
  for (int r = 0; r < 4; ++r) { const int he = g * 4 + r;
    const float* gl = p.small + (long)q * NSMALL + he * 3; const float g0 = sigmoid_fast(gl[0]), g1 = sigmoid_fast(gl[1]), g2 = sigmoid_fast(gl[2]);
#pragma unroll
    for (int dt = 0; dt < 4; ++dt) { const long c = (long)q * 512 + he * 64 + dt * 16 + j; const float os = (dt == 0 ? S_.o0[r] : dt == 1 ? S_.o1[r] : dt == 2 ? S_.o2[r] : S_.o3[r]) * a[r];
      const float av = g0 * bf2f(p.oc[c]) + g1 * os + g2 * bf2f(p.ow[c]); SB* mp = p.mix + (long)q * NMIX + MX_A + he * 64 + dt * 16 + j; *mp = f2bf(av * bf2f(*mp)); } }
}
template <bool STORE = true, bool NOSTEPS = false>
__device__ __forceinline__ void unit_asel_blk(const Params& p, int u, AselLds* A) {
  int tid = threadIdx.x; asm volatile("" : "+v"(tid));
  const int lane = tid & 63, w = __builtin_amdgcn_readfirstlane(tid >> 6), r32 = lane & 31, hi = lane >> 5;
  const int g = u & 1, qt = (p.S / 32 - 1) - (u >> 1), q0 = qt * 32, cur = q0 >> 6;
  const SB* kvb = p.proj + PA_KV + 2 * 128 + g * 64;
  __syncthreads();
  for (int i = tid; i < 64 * 8 + 8; i += 256) ((unsigned*)A->sel)[i] = 0u;
  for (int i = tid; i < 1664; i += 256) A->bkt[i] = (unsigned char)t5_bucket(i);
  if (tid < 128) A->relS[tid] = p.rel_bias[(tid >> 2) * 32 + g * 4 + (tid & 3)] * L2E;
#ifndef ASEL_NO_TOPK
  topk4_rows(p, [&](int r) { return (q0 + 8 * w + r) * 2 + g; }, lane); topk4_rows(p, [&](int r) { return (q0 + 8 * w + 4 + r) * 2 + g; }, lane);
  asm volatile("s_waitcnt vmcnt(0)" ::: "memory");
#endif
  __syncthreads();
#pragma unroll
  for (int i = 0; i < 2; ++i) { const int e = tid + 256 * i, ql = e >> 4, kk = e & 15; const int b = __hip_atomic_load(&p.idx[((long)(q0 + ql) * 2 + g) * 16 + kk], __ATOMIC_RELAXED, __HIP_MEMORY_SCOPE_AGENT);
    if (b >= 0) { atomicOr(&A->sel[ql][b >> 5], 1u << (b & 31)); atomicOr(&A->anyb[b >> 5], 1u << (b & 31)); } }
  __syncthreads();
  if (tid < 64) {
    const unsigned wbits = A->anyb[lane >> 3]; const unsigned nib = (wbits >> ((lane & 7) * 4)) & 15u; const int cnt = __popc(nib);
    int pre = cnt;
#pragma unroll
    for (int o = 1; o < 64; o <<= 1) { const int v = __shfl_up(pre, o); if (lane >= o) pre += v; }
    int pos = pre - cnt;
#pragma unroll
    for (int k = 0; k < 4; ++k) if ((nib >> k) & 1u) A->blist[pos++] = (unsigned char)(lane * 4 + k);
    if (lane == 63) A->nlist = pre;
  }
  __syncthreads();
  const int nlist = NOSTEPS ? 0 : A->nlist;
  const int hh = r32 & 3, h = g * 4 + hh; const float c31 = p.tabA[h * TABA_N + 2047] * L2E;
#if ASEL16
  Asel16 t0, t1;
#else
  FlashState st0;
#endif
  { bf16x8 qf0[4]; load_q(qf0, p.proj + (long)(q0 + 8 * w + (r32 >> 2)) * NPROJ + PA_Q + h * 64, hi);
#pragma unroll
    for (int d0 = 0; d0 < 4; ++d0) *(bf16x8*)&A->q[w][r32 * 64 + (((2 * d0 + hi) ^ ((r32 >> 1) & 7)) * 8)] = qf0[d0]; }
#if ASEL16
  { const f32x4_t z4 = {0.f, 0.f, 0.f, 0.f}; t0.o0 = z4; t0.o1 = z4; t0.o2 = z4; t0.o3 = z4; t0.m = -1e30f; t0.l = 0.f; t1 = t0; }
#else
  st0.o0 = zero16(); st0.o1 = zero16(); st0.m = -1e30f; st0.l = 0.f;
#endif
  float* xch = A->xch[w];
#define ASEL_DMA(bb, stg) { const int b_ = (bb); _Pragma("unroll") for (int i_ = 0; i_ < 2; ++i_) { const int pk_ = 2 * w + i_; \
      { const int row_ = pk_ * 8 + (lane >> 3), pc_ = lane & 7; glds16_asm(kvb + (long)(b_ * 64 + row_) * NPROJ + ((pc_ ^ ((row_ >> 1) & 7)) * 8), (unsigned)__builtin_amdgcn_readfirstlane((int)lds_addr(&A->k[stg][pk_ * 512]))); } \
      { const int db_ = pk_ >> 2, row_ = (pk_ & 3) * 16 + (lane >> 2), wi_ = lane & 3; glds16_asm(kvb + 128 + (long)(b_ * 64 + row_) * NPROJ + db_ * 32 + wi_ * 8, (unsigned)__builtin_amdgcn_readfirstlane((int)lds_addr(&A->v[stg][db_ * 2048 + (pk_ & 3) * 512]))); } } }
  asm volatile("s_waitcnt vmcnt(0)" ::: "memory");
  if (nlist > 0) ASEL_DMA(A->blist[0], 0);
  if (nlist > 1) ASEL_DMA(A->blist[1], 1);
  int stage = 0;
  for (int it = 0; it < nlist; ++it) {
    const int b = A->blist[it];
    if (it + 1 < nlist) asm volatile("s_waitcnt vmcnt(4) lgkmcnt(0)\n\ts_barrier" ::: "memory"); else asm volatile("s_waitcnt vmcnt(0) lgkmcnt(0)\n\ts_barrier" ::: "memory");
    if (it + 2 < nlist) { const int s2_ = (stage == 0) ? 2 : stage - 1; ASEL_DMA(A->blist[it + 2], s2_); }
#if ASEL16
    asel_coltile16<0>(p, t0, A->q[w], A, xch, stage, b, cur, q0, 8 * w, c31, lane); asel_coltile16<1>(p, t1, A->q[w], A, xch, stage, b, cur, q0, 8 * w, c31, lane);
#else
    asel_coltile(p, st0, A->q[w], A, xch, stage, b, cur, q0, 8 * w, h, c31, lane);
#endif
    stage = (stage == 2) ? 0 : stage + 1;
  }
  asm volatile("s_waitcnt vmcnt(0)" ::: "memory");
#if ASEL16
  if (STORE) { asel_store16<0>(p, t0, xch, q0, 8 * w, g, lane); asel_store16<1>(p, t1, xch, q0, 8 * w, g, lane); } else asm volatile("" :: "v"(t0.o0[0]), "v"(t1.o1[2]), "v"(t0.l), "v"(t1.l));
#else
  if (STORE) asel_store(p, st0, xch, q0, 8 * w, g, lane); else asm volatile("" :: "v"(st0.o0[0]), "v"(st0.o1[5]), "v"(st0.l));
#endif
#undef ASEL_DMA
}
struct AselW { unsigned short k[4][4096]; unsigned short v[4][4096]; unsigned sel[32][8]; unsigned anyw[4][8]; int nl[4]; int pad[4]; unsigned char wl[4][256]; float xch[4][32]; unsigned char bkt[1664]; float relS[256]; };
__device__ __forceinline__ void glds16_s(const void* sbase, unsigned voff, unsigned lds_dst) {
  unsigned keep; asm volatile("s_mov_b32 %0, m0\n\ts_mov_b32 m0, %3\n\ts_nop 0\n\tglobal_load_lds_dwordx4 %2, %1\n\ts_mov_b32 m0, %0" : "=&s"(keep) : "s"(sbase), "v"(voff), "s"(lds_dst) : "memory");
}
struct AwOff { unsigned o[8]; };
__device__ __forceinline__ void aw_dma8(const void* sbase, const AwOff& f, unsigned lds) {
  asm volatile(
    "s_mov_b32 m0, %9\n\ts_nop 0\n\tglobal_load_lds_dwordx4 %1, %0\n\t"
    "s_add_u32 m0, %9, 0x400\n\ts_nop 0\n\tglobal_load_lds_dwordx4 %2, %0\n\t"
    "s_add_u32 m0, %9, 0x800\n\ts_nop 0\n\tglobal_load_lds_dwordx4 %3, %0\n\t"
    "s_add_u32 m0, %9, 0xc00\n\ts_nop 0\n\tglobal_load_lds_dwordx4 %4, %0\n\t"
    "s_add_u32 m0, %9, 0x1000\n\ts_nop 0\n\tglobal_load_lds_dwordx4 %5, %0\n\t"
    "s_add_u32 m0, %9, 0x1400\n\ts_nop 0\n\tglobal_load_lds_dwordx4 %6, %0\n\t"
    "s_add_u32 m0, %9, 0x1800\n\ts_nop 0\n\tglobal_load_lds_dwordx4 %7, %0\n\t"
    "s_add_u32 m0, %9, 0x1c00\n\ts_nop 0\n\tglobal_load_lds_dwordx4 %8, %0"
    :: "s"(sbase), "v"(f.o[0]), "v"(f.o[1]), "v"(f.o[2]), "v"(f.o[3]), "v"(f.o[4]), "v"(f.o[5]), "v"(f.o[6]), "v"(f.o[7]), "s"(lds) : "memory", "m0", "scc");
}
template <int CT, bool far>
__device__ __forceinline__ void aw_softmax(Asel16& S_, f32x4_t (&sc)[4], const AselW* A, const float* rel, float* xch, bool selq, bool edge, int q, int b, float c31, int lane) {
  const int j = lane & 15, q4 = lane >> 4;
  float qs, bb;
  if (far) { qs = selq ? QSC : 0.f; bb = selq ? c31 : NINF; }
  else { qs = 1.f; bb = 0.f;
    int bi[4][4]; float be[4][4]; const int d0 = q - (b * 64 + 4 * q4);
#pragma unroll
    for (int kt = 0; kt < 4; ++kt) {
#pragma unroll
      for (int r = 0; r < 4; ++r) { const int dist = d0 - (16 * kt + r); const int dc = dist < 0 ? 0 : (dist > 1663 ? 1663 : dist); bi[kt][r] = A->bkt[dc]; } }
#pragma unroll
    for (int kt = 0; kt < 4; ++kt) asm volatile("" : "+v"(bi[kt][0]), "+v"(bi[kt][1]), "+v"(bi[kt][2]), "+v"(bi[kt][3]));
#pragma unroll
    for (int kt = 0; kt < 4; ++kt) {
#pragma unroll
      for (int r = 0; r < 4; ++r) be[kt][r] = rel[bi[kt][r] * 4 + (j & 3)]; }
#pragma unroll
    for (int kt = 0; kt < 4; ++kt) asm volatile("" : "+v"(be[kt][0]), "+v"(be[kt][1]), "+v"(be[kt][2]), "+v"(be[kt][3]));
#pragma unroll
    for (int kt = 0; kt < 4; ++kt) {
#pragma unroll
      for (int r = 0; r < 4; ++r) { const int dist = d0 - (16 * kt + r); float v = __builtin_fmaf(sc[kt][r], QSC, be[kt][r]); if (!selq || (edge && dist < 0)) v = NINF; sc[kt][r] = v; } }
  }
  float mr = fmaxf(fmaxf(sc[0][0], sc[0][1]), fmaxf(sc[0][2], sc[0][3]));
#pragma unroll
  for (int kt = 1; kt < 4; ++kt) mr = fmaxf(mr, fmaxf(fmaxf(sc[kt][0], sc[kt][1]), fmaxf(sc[kt][2], sc[kt][3])));
  float mx = far ? __builtin_fmaf(mr, qs, bb) : mr;
  mx = quadmax_f(mx);
  { const float mn = (mx > S_.m + FTHR) ? mx : S_.m;
    const float al = __builtin_amdgcn_exp2f(S_.m - mn); S_.m = mn; S_.l *= al; xch[16 * CT + j] = al;
    const f32x4_t a = *(const f32x4_t*)&xch[16 * CT + 4 * q4];
    S_.o0 *= a; S_.o1 *= a; S_.o2 *= a; S_.o3 *= a; }
  const float bm = bb - S_.m; float ps[4];
#pragma unroll
  for (int kt = 0; kt < 4; ++kt) {
#pragma unroll
    for (int r = 0; r < 4; ++r) { const float e_ = __builtin_amdgcn_exp2f(__builtin_fmaf(sc[kt][r], qs, bm)); sc[kt][r] = e_; ps[kt] = r ? ps[kt] + e_ : e_; } }
  S_.l += (ps[0] + ps[1]) + (ps[2] + ps[3]);
}
template <bool A0, bool A1, bool far, bool HOT>
__device__ __forceinline__ void aw_step(Asel16& t0, Asel16& t1, AselW* A, int w, const bf16x8& qa0, const bf16x8& qa1, const bf16x8& qb0, const bf16x8& qb1, bool selq0, bool selq1,
                                        int b, bool more, int nb, int q0w, int cur, float c31, const float* rel, const SB* kvb, unsigned ldsk, unsigned ldsv, const AwOff& fk, const AwOff& fv, int lane) {
  const int j = lane & 15, q4 = lane >> 4;
  const bool edge = (b == cur);
  float* xch = A->xch[w];
  asm volatile("s_waitcnt vmcnt(8)" ::: "memory");
  f32x4_t sa[4], sb[4];
  { bf16x8 k0[4], k1[4];
#pragma unroll
    for (int kt = 0; kt < 4; ++kt) { const int row = 16 * kt + j;
      k0[kt] = *(const bf16x8*)&A->k[w][row * 64 + (((q4) ^ ((row >> 1) & 7)) * 8)]; k1[kt] = *(const bf16x8*)&A->k[w][row * 64 + (((4 + q4) ^ ((row >> 1) & 7)) * 8)]; }
    asm volatile("s_waitcnt lgkmcnt(0)" ::: "memory");
    if (more && !HOT) aw_dma8(kvb + (long)nb * 64 * NPROJ, fk, ldsk);
#pragma unroll
    for (int kt = 0; kt < 4; ++kt) { const f32x4_t z = {0.f, 0.f, 0.f, 0.f};
      if (A0) { sa[kt] = MFMA16(k0[kt], qa0, z); sa[kt] = MFMA16(k1[kt], qa1, sa[kt]); }
      if (A1) { sb[kt] = MFMA16(k0[kt], qb0, z); sb[kt] = MFMA16(k1[kt], qb1, sb[kt]); } } }
  if (A0) aw_softmax<0, far>(t0, sa, A, rel, xch, selq0, edge, q0w + (j >> 2), b, c31, lane);
  if (A1) aw_softmax<1, far>(t1, sb, A, rel, xch, selq1, edge, q0w + 4 + (j >> 2), b, c31, lane);
  bf16x8 pa0, pa1, pb0, pb1;
  if (A0) { pa0 = pack44(sa[0], sa[1]); pa1 = pack44(sa[2], sa[3]); }
  if (A1) { pb0 = pack44(sb[0], sb[1]); pb1 = pack44(sb[2], sb[3]); }
  if (more) asm volatile("s_waitcnt vmcnt(8)" ::: "memory"); else asm volatile("s_waitcnt vmcnt(0)" ::: "memory");
  const unsigned short* vb0 = A->v[w] + (4 * q4 + (j >> 2)) * 32 + (j & 3) * 4 + (q4 & 1) * 16; const unsigned short* vb1 = vb0 + 16 - (q4 & 1) * 32;
#pragma unroll
  for (int c = 0; c < 2; ++c) {
#pragma unroll
    for (int dt = 0; dt < 4; ++dt) {
      const unsigned short* vb = (dt & 1) ? vb1 : vb0;
      const v4i16_t lo = __builtin_amdgcn_ds_read_tr16_b64_v4i16((LDS3 v4i16_t*)(vb + (dt >> 1) * 2048 + c * 1024));
      const v4i16_t hh = __builtin_amdgcn_ds_read_tr16_b64_v4i16((LDS3 v4i16_t*)(vb + (dt >> 1) * 2048 + c * 1024 + 512));
      const bf16x8 vf = {lo[0], lo[1], lo[2], lo[3], hh[0], hh[1], hh[2], hh[3]};
      if (A0) { const bf16x8 pa = c ? pa1 : pa0; if (dt == 0) t0.o0 = MFMA16(pa, vf, t0.o0); else if (dt == 1) t0.o1 = MFMA16(pa, vf, t0.o1); else if (dt == 2) t0.o2 = MFMA16(pa, vf, t0.o2); else t0.o3 = MFMA16(pa, vf, t0.o3); }
      if (A1) { const bf16x8 pb = c ? pb1 : pb0; if (dt == 0) t1.o0 = MFMA16(pb, vf, t1.o0); else if (dt == 1) t1.o1 = MFMA16(pb, vf, t1.o1); else if (dt == 2) t1.o2 = MFMA16(pb, vf, t1.o2); else t1.o3 = MFMA16(pb, vf, t1.o3); }
    }
  }
  asm volatile("s_waitcnt lgkmcnt(0)" ::: "memory");
  if (more && !HOT) aw_dma8(kvb + (long)nb * 64 * NPROJ, fv, ldsv);
}
__device__ __forceinline__ void asel_w_tables(const Params& p, AselW* A) {
  const int tid = threadIdx.x;
  for (int i = tid; i < 1664; i += 256) A->bkt[i] = (unsigned char)t5_bucket(i);
  A->relS[tid] = p.rel_bias[((tid & 127) >> 2) * 32 + (tid >> 7) * 4 + (tid & 3)] * L2E;
}
template <bool STORE = true, bool HOT = false, bool NLZ = false>
__device__ __forceinline__ void asel_w_wave(const Params& p, int g, int q0w, AselW* A, int w, int lane) {
  const int j = lane & 15, q4 = lane >> 4; const int cur = q0w >> 6; const float* rel = A->relS + g * 128;
  const SB* kvb = p.proj + PA_KV + 2 * 128 + g * 64;
  A->sel[8 * w + (lane >> 3)][lane & 7] = 0u;
  asm volatile("s_waitcnt lgkmcnt(0)" ::: "memory");
  topk4_rows_o(p, [&](int r) { return (q0w + r) * 2 + g; }, [&](int r, int b) { if (b >= 0) atomicOr(&A->sel[8 * w + r][b >> 5], 1u << (b & 31)); }, lane);
  topk4_rows_o(p, [&](int r) { return (q0w + 4 + r) * 2 + g; }, [&](int r, int b) { if (b >= 0) atomicOr(&A->sel[8 * w + 4 + r][b >> 5], 1u << (b & 31)); }, lane);
  asm volatile("s_waitcnt lgkmcnt(0)" ::: "memory");
  if (lane < 8) { unsigned o = 0u;
#pragma unroll
    for (int r = 0; r < 8; ++r) o |= A->sel[8 * w + r][lane];
    A->anyw[w][lane] = o; }
  asm volatile("s_waitcnt lgkmcnt(0)" ::: "memory");
  { const unsigned wbits = A->anyw[w][lane >> 3]; const unsigned nib = (wbits >> ((lane & 7) * 4)) & 15u; const int cnt = __popc(nib);
    int pre = cnt;
#pragma unroll
    for (int o = 1; o < 64; o <<= 1) { const int v = __shfl_up(pre, o); if (lane >= o) pre += v; }
    int pos = pre - cnt;
#pragma unroll
    for (int k = 0; k < 4; ++k) if ((nib >> k) & 1u) A->wl[w][pos++] = (unsigned char)(lane * 4 + k);
    if (lane == 63) A->nl[w] = pre; }
  asm volatile("s_waitcnt lgkmcnt(0)" ::: "memory");
  const int hq = g * 4 + (lane & 3); const float c31 = p.tabA[hq * TABA_N + 2047] * L2E;
  const SB* qpa = p.proj + (long)(q0w + (j >> 2)) * NPROJ + PA_Q + hq * 64 + 8 * q4; const SB* qpb = qpa + 4L * NPROJ;
  const bf16x8 qa0 = *(const bf16x8*)qpa, qa1 = *(const bf16x8*)(qpa + 32), qb0 = *(const bf16x8*)qpb, qb1 = *(const bf16x8*)(qpb + 32);
  Asel16 t0, t1;
  { const f32x4_t z4 = {0.f, 0.f, 0.f, 0.f}; t0.o0 = z4; t0.o1 = z4; t0.o2 = z4; t0.o3 = z4; t0.m = -1e30f; t0.l = 0.f; t1 = t0; }
  AwOff fk, fv;
#pragma unroll
  for (int pk = 0; pk < 8; ++pk) { fk.o[pk] = (unsigned)((pk * 8 + (lane >> 3)) * NPROJ * 2 + (((lane & 7) ^ (lane >> 4) ^ ((pk & 1) * 4)) * 16));
    fv.o[pk] = (unsigned)(256 + ((pk & 3) * 16 + (lane >> 2)) * NPROJ * 2 + (pk >> 2) * 64 + (((lane & 3) ^ (((lane >> 4) & 1) << 1)) * 16)); }
  const unsigned ldsk = (unsigned)__builtin_amdgcn_readfirstlane((int)lds_addr(&A->k[w][0])), ldsv = (unsigned)__builtin_amdgcn_readfirstlane((int)lds_addr(&A->v[w][0]));
  const int nl = NLZ ? 0 : __builtin_amdgcn_readfirstlane(A->nl[w]);
  asm volatile("s_waitcnt vmcnt(0) lgkmcnt(0)" ::: "memory");
  if (nl > 0) { const int b0 = __builtin_amdgcn_readfirstlane((int)A->wl[w][0]); aw_dma8(kvb + (long)b0 * 64 * NPROJ, fk, ldsk); aw_dma8(kvb + (long)b0 * 64 * NPROJ, fv, ldsv); }
  int b = __builtin_amdgcn_readfirstlane((int)A->wl[w][0]), nb = __builtin_amdgcn_readfirstlane((int)A->wl[w][1]);
  unsigned sw0 = A->sel[8 * w + (j >> 2)][b >> 5], sw1 = A->sel[8 * w + 4 + (j >> 2)][b >> 5];
  for (int i = 0; i < nl; ++i) {
    const bool more = i + 1 < nl;
    const unsigned nsw0 = *(volatile unsigned*)&A->sel[8 * w + (j >> 2)][nb >> 5], nsw1 = *(volatile unsigned*)&A->sel[8 * w + 4 + (j >> 2)][nb >> 5];
    const unsigned nnbv = *(volatile unsigned char*)&A->wl[w][(i + 2) & 255];
    const bool selq0 = (sw0 >> (b & 31)) & 1u, selq1 = (sw1 >> (b & 31)) & 1u;
    const bool a0 = __any(selq0), a1 = __any(selq1);
    const bool far = (q0w - (b * 64 + 63)) >= 1513;
    if (far) {
      if (a0 && a1) aw_step<true, true, true, HOT>(t0, t1, A, w, qa0, qa1, qb0, qb1, selq0, selq1, b, more, nb, q0w, cur, c31, rel, kvb, ldsk, ldsv, fk, fv, lane);
      else if (a0) aw_step<true, false, true, HOT>(t0, t1, A, w, qa0, qa1, qb0, qb1, selq0, selq1, b, more, nb, q0w, cur, c31, rel, kvb, ldsk, ldsv, fk, fv, lane);
      else aw_step<false, true, true, HOT>(t0, t1, A, w, qa0, qa1, qb0, qb1, selq0, selq1, b, more, nb, q0w, cur, c31, rel, kvb, ldsk, ldsv, fk, fv, lane);
    } else {
      if (a0 && a1) aw_step<true, true, false, HOT>(t0, t1, A, w, qa0, qa1, qb0, qb1, selq0, selq1, b, more, nb, q0w, cur, c31, rel, kvb, ldsk, ldsv, fk, fv, lane);
      else if (a0) aw_step<true, false, false, HOT>(t0, t1, A, w, qa0, qa1, qb0, qb1, selq0, selq1, b, more, nb, q0w, cur, c31, rel, kvb, ldsk, ldsv, fk, fv, lane);
      else aw_step<false, true, false, HOT>(t0, t1, A, w, qa0, qa1, qb0, qb1, selq0, selq1, b, more, nb, q0w, cur, c31, rel, kvb, ldsk, ldsv, fk, fv, lane);
    }
    b = nb; sw0 = nsw0; sw1 = nsw1; nb = __builtin_amdgcn_readfirstlane((int)nnbv);
  }
  asm volatile("s_waitcnt vmcnt(0)" ::: "memory");
  float* xch = A->xch[w];
  if (STORE) { asel_store16<0>(p, t0, xch, q0w, 0, g, lane); asel_store16<1>(p, t1, xch, q0w, 0, g, lane); } else asm volatile("" :: "v"(t0.o0[0]), "v"(t1.o1[2]), "v"(t0.l), "v"(t1.l));
}
template <bool STORE = true, bool HOT = false, bool NLZ = false>
__device__ __forceinline__ void unit_asel_w(const Params& p, int u, AselW* A) {
  int tid = threadIdx.x; asm volatile("" : "+v"(tid));
  const int lane = tid & 63, w = __builtin_amdgcn_readfirstlane(tid >> 6);
  __syncthreads(); asel_w_tables(p, A); __syncthreads();
  asel_w_wave<STORE, HOT, NLZ>(p, u & 1, ((p.S / 32 - 1) - (u >> 1)) * 32 + 8 * w, A, w, lane);
}
template <bool STORE = true>
__device__ __forceinline__ void unit_bout_blk(const Params& p, int layer, int ub, char* smem) {
  int tid = threadIdx.x; asm volatile("" : "+v"(tid));
  const int lane = tid & 63, w = __builtin_amdgcn_readfirstlane(tid >> 6), r32 = lane & 31, hi = lane >> 5;
  const int lt = ub & 3, g = (ub >> 2) & 1, c = ub >> 3, hd = g * 4 + w;
  WaveLds2* L = ((WaveLds2*)smem) + w;
  __syncthreads();
  for (int x = lane; x < 128; x += 64) { L->acs[x] = p.acs[((long)c * 128 + x) * 8 + hd]; L->dtv[x] = p.dt[((long)c * 128 + x) * 8 + hd]; }
  f32x16 acc[2] = {zero16(), zero16()}, acc2[2] = {zero16(), zero16()};
  const SB* xb = p.xconv + (long)c * 128 * 1024; const int l = 32 * lt + r32; const float al = p.acs[((long)c * 128 + l) * 8 + hd];
  const float* cbr = p.cb + ((long)c * 2 + g) * 16384 + (long)l * 128;
  for (int sc = 0; sc <= lt; ++sc) {
    stage_slab<false>(L->x, xb + (long)(32 * sc) * 1024 + hd * 64, 1024, [&](int) { return 1.f; }, lane);
#pragma unroll
    for (int s2 = 0; s2 < 2; ++s2) { float mv[8];
#pragma unroll
      for (int jj = 0; jj < 2; ++jj) { const int s0 = 32 * sc + 16 * s2 + 8 * jj + 4 * hi; const float4 cv = *(const float4*)(cbr + s0); const float4 av = *(const float4*)(&L->acs[s0]); const float4 dv = *(const float4*)(&L->dtv[s0]);
        mv[4 * jj + 0] = (s0 + 0 <= l) ? cv.x * __expf(al - av.x) * dv.x : 0.f; mv[4 * jj + 1] = (s0 + 1 <= l) ? cv.y * __expf(al - av.y) * dv.y : 0.f;
        mv[4 * jj + 2] = (s0 + 2 <= l) ? cv.z * __expf(al - av.z) * dv.z : 0.f; mv[4 * jj + 3] = (s0 + 3 <= l) ? cv.w * __expf(al - av.w) * dv.w : 0.f; }
      u32x4 aw; aw[0] = pk2(mv[0], mv[1]); aw[1] = pk2(mv[2], mv[3]); aw[2] = pk2(mv[4], mv[5]); aw[3] = pk2(mv[6], mv[7]); const bf16x8 af = __builtin_bit_cast(bf16x8, aw);
#pragma unroll
      for (int pt = 0; pt < 2; ++pt) acc[pt] = MFMA32(af, slab_frag(L->x, pt, s2, lane), acc[pt]); } }
  const SB* cmr = xb + (long)l * 1024 + 768 + g * 128; const float* prv = p.states + ((long)c * 8 + hd) * 8192;
#pragma unroll 2
  for (int ks = 0; ks < 8; ++ks) { const bf16x8 af = *(const bf16x8*)(cmr + 16 * ks + 8 * hi);
#pragma unroll
    for (int pt = 0; pt < 2; ++pt) { const float* pr = prv + (long)(32 * pt + r32) * 128 + 16 * ks + 8 * hi; const float4 a0 = *(const float4*)pr, a1 = *(const float4*)(pr + 4);
      u32x4 bw; bw[0] = pk2(a0.x, a0.y); bw[1] = pk2(a0.z, a0.w); bw[2] = pk2(a1.x, a1.y); bw[3] = pk2(a1.z, a1.w);
      acc2[pt] = MFMA32(af, __builtin_bit_cast(bf16x8, bw), acc2[pt]); } }
  const float dsk = p.b_d[layer * 8 + hd];
  float* yl = (float*)L;
#pragma unroll
  for (int e = 0; e < 16; ++e) { const int lr = crow(e, hi); const float ea = __expf(L->acs[32 * lt + lr]);
#pragma unroll
    for (int pt = 0; pt < 2; ++pt) { const int pp = 32 * pt + r32; yl[lr * 64 + pp] = acc[pt][e] + ea * acc2[pt][e] + dsk * bf2f(xb[(long)(32 * lt + lr) * 1024 + hd * 64 + pp]); } }
  __syncthreads();
  { const int row = tid >> 3, sub = tid & 7; const long t = (long)c * 128 + 32 * lt + row; SB* mp = p.mix + t * NMIX + MX_B + g * 256 + sub * 32;
    const float* ysrc = (const float*)(((WaveLds2*)smem) + (sub >> 1)) + row * 64 + (sub & 1) * 32;
    float vv[32]; float ss = 0.f;
#pragma unroll
    for (int i = 0; i < 4; ++i) { const uint4 zz = *(const uint4*)(mp + 8 * i); const unsigned zw[4] = {zz.x, zz.y, zz.z, zz.w};
#pragma unroll
      for (int k = 0; k < 4; ++k) { const float y0 = ysrc[8 * i + 2 * k] * __uint_as_float(zw[k] << 16), y1 = ysrc[8 * i + 2 * k + 1] * __uint_as_float(zw[k] & 0xffff0000u); vv[8 * i + 2 * k] = y0; vv[8 * i + 2 * k + 1] = y1; ss += y0 * y0 + y1 * y1; } }
    ss += __shfl_xor(ss, 1); ss += __shfl_xor(ss, 2); ss += __shfl_xor(ss, 4);
    const float r = 1.f / sqrtf(ss * (1.f / 256.f) + 1e-6f); const float* wn = p.b_norm + layer * 512 + g * 256 + sub * 32;
#pragma unroll
    for (int i = 0; i < 4; ++i) { uint4 o; o.x = pk2(vv[8 * i] * r * wn[8 * i], vv[8 * i + 1] * r * wn[8 * i + 1]); o.y = pk2(vv[8 * i + 2] * r * wn[8 * i + 2], vv[8 * i + 3] * r * wn[8 * i + 3]);
      o.z = pk2(vv[8 * i + 4] * r * wn[8 * i + 4], vv[8 * i + 5] * r * wn[8 * i + 5]); o.w = pk2(vv[8 * i + 6] * r * wn[8 * i + 6], vv[8 * i + 7] * r * wn[8 * i + 7]); if (STORE) *(uint4*)(mp + 8 * i) = o; else asm volatile("" :: "v"(o.x), "v"(o.w)); } }
}

__device__ __forceinline__ void unit_memkv(const Params& p, int u, int lane) {
  const int l = u >> 8, m = u & 255; const float* row = p.mem + (long)m * DM; const float* nw = p.m_norm + l * DM; const float* w = p.m_wkv + (long)l * DM * 512 + lane * 8;
  float ss = 0.f;
#pragma unroll
  for (int i = 0; i < 4; ++i) { const float4 v = *(const float4*)(row + i * 256 + lane * 4); ss += v.x * v.x + v.y * v.y + v.z * v.z + v.w * v.w; }
  ss = wave_sum_f(ss); const float r = 1.f / sqrtf(ss * (1.f / DM) + 1e-6f);
  float acc[8] = {0.f, 0.f, 0.f, 0.f, 0.f, 0.f, 0.f, 0.f};
#pragma unroll 8
  for (int d = 0; d < DM; ++d) { const float a = row[d] * r * nw[d]; const float4 w0 = *(const float4*)(w + (long)d * 512), w1 = *(const float4*)(w + (long)d * 512 + 4);
    acc[0] += a * w0.x; acc[1] += a * w0.y; acc[2] += a * w0.z; acc[3] += a * w0.w; acc[4] += a * w1.x; acc[5] += a * w1.y; acc[6] += a * w1.z; acc[7] += a * w1.w; }
  uint4 o; o.x = pk2(acc[0], acc[1]); o.y = pk2(acc[2], acc[3]); o.z = pk2(acc[4], acc[5]); o.w = pk2(acc[6], acc[7]);
  *(uint4*)(p.memkv + (long)u * 512 + lane * 8) = o;
}

__device__ __forceinline__ void item_dmerge(const Params& p, long gid) {
  const int c8 = (int)(gid & 63), h = c8 >> 3; const long q = gid >> 6; const long S = p.S;
  const float l0 = p.dlse[(0 * S + q) * 8 + h], l1 = p.dlse[(1 * S + q) * 8 + h], l2 = p.dlse[(2 * S + q) * 8 + h];
  const float mm = fmaxf(l0, fmaxf(l1, l2)); float e0 = __expf(l0 - mm), e1 = __expf(l1 - mm), e2 = __expf(l2 - mm); const float is = 1.f / (e0 + e1 + e2); e0 *= is; e1 *= is; e2 *= is;
  const long c = q * 512 + c8 * 8; const uint4 a = *(const uint4*)(p.dop + c), b = *(const uint4*)(p.dop + S * 512 + c), d = *(const uint4*)(p.dop + 2 * S * 512 + c);
  SB* mp = p.mix + q * NMIX + MX_D + c8 * 8; const uint4 z = *(const uint4*)mp;
  const unsigned aw[4] = {a.x, a.y, a.z, a.w}, bw[4] = {b.x, b.y, b.z, b.w}, dw[4] = {d.x, d.y, d.z, d.w}, zw[4] = {z.x, z.y, z.z, z.w}; unsigned ow[4];
#pragma unroll
  for (int k = 0; k < 4; ++k) {
    const float lo = (e0 * __uint_as_float(aw[k] << 16) + e1 * __uint_as_float(bw[k] << 16) + e2 * __uint_as_float(dw[k] << 16)) * __uint_as_float(zw[k] << 16);
    const float hi = (e0 * __uint_as_float(aw[k] & 0xffff0000u) + e1 * __uint_as_float(bw[k] & 0xffff0000u) + e2 * __uint_as_float(dw[k] & 0xffff0000u)) * __uint_as_float(zw[k] & 0xffff0000u);
    ow[k] = pk2(lo, hi); }
  uint4 o; o.x = ow[0]; o.y = ow[1]; o.z = ow[2]; o.w = ow[3]; *(uint4*)mp = o;
}

__device__ __forceinline__ void unit_cmp_blk(const Params& p, int layer, int u, float* red  ) {
  int tid = threadIdx.x; asm volatile("" : "+v"(tid));
  const int lane = tid & 63, w = __builtin_amdgcn_readfirstlane(tid >> 6), r32 = lane & 31, hi = lane >> 5;
  const int ncmp = p.S / 16, ntile = ncmp * 2 / 32; const int kv = u / ntile, rt = u % ntile;
  const int r = 32 * rt + r32, j = r >> 1, hk = r & 1;
  const unsigned short* w1t = p.w1t + (long)kv * 128 * 2048; const unsigned short* w2t = p.w2t + kv * 64 * 128; const float* pe = p.cmp_pos + (long)(layer * 2 + kv) * 32 * 64;
  const SB* src = p.proj + PA_KV + kv * 128 + hk * 64;
  f32x16 acc[4] = {zero16(), zero16(), zero16(), zero16()};
#pragma unroll 4
  for (int ks = 32 * w; ks < 32 * w + 32; ++ks) { const int t = ks >> 2, d = (ks & 3) * 16 + 8 * hi; const long tok = 16 * j + t;
    const float4 p0 = *(const float4*)(pe + t * 64 + d), p1 = *(const float4*)(pe + t * 64 + d + 4); float v[8] = {p0.x, p0.y, p0.z, p0.w, p1.x, p1.y, p1.z, p1.w};
    { const long tokc = tok < p.S ? tok : (long)p.S - 1; const float vm = tok < p.S ? 1.f : 0.f;
      const uint4 vv = *(const uint4*)(src + tokc * NPROJ + d); const unsigned wd[4] = {vv.x, vv.y, vv.z, vv.w};
#pragma unroll
      for (int k = 0; k < 4; ++k) { v[2 * k] += vm * __uint_as_float(wd[k] << 16); v[2 * k + 1] += vm * __uint_as_float(wd[k] & 0xffff0000u); } }
    u32x4 bw; bw[0] = pk2(v[0], v[1]); bw[1] = pk2(v[2], v[3]); bw[2] = pk2(v[4], v[5]); bw[3] = pk2(v[6], v[7]); const bf16x8 bfr = __builtin_bit_cast(bf16x8, bw);
#pragma unroll
    for (int ut = 0; ut < 4; ++ut) { const bf16x8 af = *(const bf16x8*)(w1t + (long)(32 * ut + r32) * 2048 + 16 * ks + 8 * hi); acc[ut] = MFMA32(af, bfr, acc[ut]); } }
  __syncthreads();
#pragma unroll
  for (int ut = 0; ut < 4; ++ut)
#pragma unroll
    for (int q4 = 0; q4 < 4; ++q4) *(float4*)&red[(((w * 4 + ut) * 4 + q4) * 64 + lane) * 4] = make_float4(acc[ut][4 * q4], acc[ut][4 * q4 + 1], acc[ut][4 * q4 + 2], acc[ut][4 * q4 + 3]);
  __syncthreads();
  f32x16 hsum = zero16();
#pragma unroll
  for (int w2 = 0; w2 < 4; ++w2)
#pragma unroll
    for (int q4 = 0; q4 < 4; ++q4) { const float4 t4 = *(const float4*)&red[(((w2 * 4 + w) * 4 + q4) * 64 + lane) * 4]; hsum[4 * q4] += t4.x; hsum[4 * q4 + 1] += t4.y; hsum[4 * q4 + 2] += t4.z; hsum[4 * q4 + 3] += t4.w; }
#pragma unroll
  for (int e = 0; e < 16; ++e) hsum[e] = gelu_f(hsum[e]);
  f32x16 o2[2] = {zero16(), zero16()};
#pragma unroll
  for (int s2 = 0; s2 < 2; ++s2) { const bf16x8 hb = pack8(hsum, 8 * s2);
#pragma unroll
    for (int dt = 0; dt < 2; ++dt) { const unsigned short* wr = w2t + (32 * dt + r32) * 128 + 32 * w + 16 * s2 + 4 * hi; const uint2 x0 = *(const uint2*)wr, x1 = *(const uint2*)(wr + 8);
      u32x4 aw; aw[0] = x0.x; aw[1] = x0.y; aw[2] = x1.x; aw[3] = x1.y; o2[dt] = MFMA32(__builtin_bit_cast(bf16x8, aw), hb, o2[dt]); } }
  __syncthreads();
#pragma unroll
  for (int dt = 0; dt < 2; ++dt)
#pragma unroll
    for (int q4 = 0; q4 < 4; ++q4) *(float4*)&red[(((w * 2 + dt) * 4 + q4) * 64 + lane) * 4] = make_float4(o2[dt][4 * q4], o2[dt][4 * q4 + 1], o2[dt][4 * q4 + 2], o2[dt][4 * q4 + 3]);
  __syncthreads();
  if (w < 2) {
    const int dt = w; SB* dst = p.kvc + ((long)kv * ncmp * 2 + r) * 64;
#pragma unroll
    for (int q4 = 0; q4 < 4; ++q4) { float4 s4 = make_float4(0.f, 0.f, 0.f, 0.f);
#pragma unroll
      for (int w2 = 0; w2 < 4; ++w2) { const float4 t4 = *(const float4*)&red[(((w2 * 2 + dt) * 4 + q4) * 64 + lane) * 4]; s4.x += t4.x; s4.y += t4.y; s4.z += t4.z; s4.w += t4.w; }
      dst[32 * dt + crow(4 * q4 + 0, hi)] = f2bf(s4.x); dst[32 * dt + crow(4 * q4 + 1, hi)] = f2bf(s4.y); dst[32 * dt + crow(4 * q4 + 2, hi)] = f2bf(s4.z); dst[32 * dt + crow(4 * q4 + 3, hi)] = f2bf(s4.w); } }
}

#define SEQ 16384
#define DEPTH 4

__device__ __forceinline__ int n2o(int n) {
  if (n < 1280) return n;
  if (n < 2304) return n - 1280 + 1816;
  if (n < 2816) return n - 2304 + 3360;
  if (n < 3072) return n - 2816 + 3872;
  if (n < 4608) return n - 3072 + 4640;
  if (n < 5632) return n - 4608 + 6176;
  if (n < 5888) return n - 5632 + 7712;
  n -= 5888;
  if (n < 512) return 1304 + n;
  if (n < 1024) return 2848 + n - 512;
  if (n < 1536) return 4128 + n - 1024;
  if (n < 2048) return 7200 + n - 1536;
  if (n < 2304) return 7968 + n - 2048;
  n -= 2304;
  if (n < 24) return 1280 + n;
  if (n < 32) return 2840 + n - 24;
  return -1;
}

template <bool MAP>
__device__ __forceinline__ void cvt_tile(const float* __restrict__ src, int lds_, unsigned short* __restrict__ dst, int ldd, int k0, int n0, float* tile  ) {
  int tid = threadIdx.x; asm volatile("" : "+v"(tid));
  __syncthreads();
#pragma unroll
  for (int e = 0; e < 16; ++e) { int idx = tid + 256 * e, kk = idx >> 6, nn = idx & 63; int oc = MAP ? n2o(n0 + nn) : (n0 + nn);
    tile[kk * 65 + nn] = (oc >= 0) ? src[(long)(k0 + kk) * lds_ + oc] : 0.f; }
  __syncthreads();
#pragma unroll
  for (int e = 0; e < 16; ++e) { int idx = tid + 256 * e, nn = idx >> 6, kk = idx & 63; dst[(long)(n0 + nn) * ldd + k0 + kk] = f2bf(tile[kk * 65 + nn]); }
}

__device__ __forceinline__ float wave_sum(float v) {
#pragma unroll
  for (int o = 32; o > 0; o >>= 1) v += __shfl_xor(v, o);
  return v;
}

__device__ __forceinline__ void norm_row_wave(const Params& p, int layer, int t, bool do_h, int lane) {
  const float* xin = (layer == 0) ? p.x + (long)t * DM : p.out + (long)t * DM;
  float4 xv[4], yv[4];
#pragma unroll
  for (int i = 0; i < 4; ++i) xv[i] = *(const float4*)(xin + i * 256 + lane * 4);
  if (layer > 0) {
    float ss = 0.f;
#pragma unroll
    for (int i = 0; i < 4; ++i) { yv[i] = *(const float4*)(p.y + (long)t * DM + i * 256 + lane * 4); ss += yv[i].x * yv[i].x + yv[i].y * yv[i].y + yv[i].z * yv[i].z + yv[i].w * yv[i].w; }
    ss = wave_sum(ss); float r1 = 1.f / sqrtf(ss / DM + 1e-6f);
#pragma unroll
    for (int i = 0; i < 4; ++i) { float4 w = *(const float4*)(p.post_norm + (layer - 1) * DM + i * 256 + lane * 4);
      xv[i].x += yv[i].x * r1 * w.x; xv[i].y += yv[i].y * r1 * w.y; xv[i].z += yv[i].z * r1 * w.z; xv[i].w += yv[i].w * r1 * w.w; }
  }
  float ss2 = 0.f;
#pragma unroll
  for (int i = 0; i < 4; ++i) { *(float4*)(p.out + (long)t * DM + i * 256 + lane * 4) = xv[i]; ss2 += xv[i].x * xv[i].x + xv[i].y * xv[i].y + xv[i].z * xv[i].z + xv[i].w * xv[i].w; }
  if (!do_h) return;
  ss2 = wave_sum(ss2); float r2 = 1.f / sqrtf(ss2 / DM + 1e-6f);
#pragma unroll
  for (int i = 0; i < 4; ++i) { float4 w = *(const float4*)(p.pre_norm + layer * DM + i * 256 + lane * 4);
    ushort4 o; o.x = f2bf(xv[i].x * r2 * w.x); o.y = f2bf(xv[i].y * r2 * w.y); o.z = f2bf(xv[i].z * r2 * w.z); o.w = f2bf(xv[i].w * r2 * w.w);
    *(ushort4*)(p.h + (long)t * DM + i * 256 + lane * 4) = o; }
}

#ifndef GMI
#define GMI 4
#endif
struct GemmSmem { unsigned short a[3][64 * GMI * 32]; unsigned short b[3][128 * 32]; };
__device__ __forceinline__ void glds16(const void* g, void* lds_wave_base) { __builtin_amdgcn_global_load_lds((gptr_t)g, (lptr_t)lds_wave_base, 16, 0, 0); }
template <int EPI, int MI, bool DRY = false>
__device__ __forceinline__ void gemm_tile(const Params& p, const unsigned short* __restrict__ A, int lda, const unsigned short* __restrict__ Bt, int ldb, int K, int m0, int n0, GemmSmem& sm, float* outp = nullptr) {
  int tid = threadIdx.x; asm volatile("" : "+v"(tid));
  const int lane = tid & 63, wid = __builtin_amdgcn_readfirstlane(tid >> 6), wr = wid >> 1, wc = wid & 1, r = lane & 31, h = lane >> 5;
  f32x16 acc[MI][2];
#pragma unroll
  for (int i = 0; i < MI; ++i)
#pragma unroll
    for (int j = 0; j < 2; ++j) acc[i][j] = zero16();
  const int prow = lane >> 2, pc = lane & 3;
  const unsigned short* ga[MI]; const unsigned short* gb[2];
#pragma unroll
  for (int i = 0; i < MI; ++i) { const int row = (wid * MI + i) * 16 + prow; ga[i] = A + (long)(m0 + row) * lda + ((pc ^ ((row >> 2) & 3)) * 8); }
#pragma unroll
  for (int i = 0; i < 2; ++i) { const int row = (wid * 2 + i) * 16 + prow; gb[i] = Bt + (long)(n0 + row) * ldb + ((pc ^ ((row >> 2) & 3)) * 8); }
#define GEMM_DMA(stg, ko) { _Pragma("unroll") for (int i_ = 0; i_ < MI; ++i_) glds16(ga[i_] + (ko), &sm.a[stg][(wid * MI + i_) * 512]); _Pragma("unroll") for (int i_ = 0; i_ < 2; ++i_) glds16(gb[i_] + (ko), &sm.b[stg][(wid * 2 + i_) * 512]); }
  __syncthreads();
  const int nk = K / 32;
  GEMM_DMA(0, 0)
  if (nk > 1) GEMM_DMA(1, 32)
  int cur = 0;
  for (int kt = 0; kt < nk; ++kt) {
    if (kt + 1 < nk) { if (MI == 4) asm volatile("s_waitcnt vmcnt(6) lgkmcnt(0)\n\ts_barrier" ::: "memory"); else asm volatile("s_waitcnt vmcnt(4) lgkmcnt(0)\n\ts_barrier" ::: "memory"); }
    else asm volatile("s_waitcnt vmcnt(0) lgkmcnt(0)\n\ts_barrier" ::: "memory");
    if (kt + 2 < nk) { const int s2_ = (cur == 0) ? 2 : cur - 1; GEMM_DMA(s2_, (kt + 2) * 32) }
#pragma unroll
    for (int ks = 0; ks < 2; ++ks) {
      bf16x8 af[MI], bfr[2];
#pragma unroll
      for (int i = 0; i < MI; ++i) { const int row = wr * (32 * MI) + i * 32 + r; af[i] = *(const bf16x8*)&sm.a[cur][row * 32 + (((2 * ks + h) ^ ((row >> 2) & 3)) * 8)]; }
#pragma unroll
      for (int j = 0; j < 2; ++j) { const int row = wc * 64 + j * 32 + r; bfr[j] = *(const bf16x8*)&sm.b[cur][row * 32 + (((2 * ks + h) ^ ((row >> 2) & 3)) * 8)]; }
#pragma unroll
      for (int i = 0; i < MI; ++i)
#pragma unroll
        for (int j = 0; j < 2; ++j) acc[i][j] = __builtin_amdgcn_mfma_f32_32x32x16_bf16(af[i], bfr[j], acc[i][j], 0, 0, 0);
    }
    cur = (cur == 2) ? 0 : cur + 1;
  }
#undef GEMM_DMA
  __syncthreads();
  if (DRY) {
#pragma unroll
    for (int i = 0; i < MI; ++i) asm volatile("" :: "v"(acc[i][0]), "v"(acc[i][1]));
    return; }
  const int ncol0 = n0 + wc * 64;
  const int mrow0 = m0 + wr * (32 * MI);
  if (EPI == 2) {
#pragma unroll
    for (int i = 0; i < MI; ++i)
#pragma unroll
      for (int j = 0; j < 2; ++j)
#pragma unroll
        for (int e = 0; e < 16; ++e) { int row = mrow0 + i * 32 + (e & 3) + 8 * (e >> 2) + 4 * h; outp[row * 128 + ncol0 + j * 32 + r] = acc[i][j][e]; }
  } else if (EPI == 1) {
#pragma unroll
    for (int i = 0; i < MI; ++i)
#pragma unroll
      for (int j = 0; j < 2; ++j)
#pragma unroll
        for (int e = 0; e < 16; ++e) { int row = mrow0 + i * 32 + (e & 3) + 8 * (e >> 2) + 4 * h; p.y[(long)row * DM + ncol0 + j * 32 + r] = acc[i][j][e]; }
  } else {
    if (ncol0 < 8192) {
      const bool toproj = ncol0 < NPROJ; const bool rope = toproj && (ncol0 >= PC_Q && ncol0 < PC_KV + 128);
      unsigned short* stg = ((unsigned short*)&sm) + wid * (64 * 72);
      SB* gdst = toproj ? (p.proj + ncol0) : (p.mix + (ncol0 - NPROJ)); const long gld = toproj ? NPROJ : NMIX;
#pragma unroll
      for (int hf = 0; hf < MI / 2; ++hf) {
#pragma unroll
        for (int i2 = 0; i2 < 2; ++i2) { const int i = hf * 2 + i2;
          if (rope) {
            float cc[16], sn[16];
#pragma unroll
            for (int e = 0; e < 16; ++e) { const int row = mrow0 + hf * 64 + i2 * 32 + (e & 3) + 8 * (e >> 2) + 4 * h; cc[e] = p.rope_cs[row * 32 + r]; sn[e] = p.rope_sn[row * 32 + r]; }
#pragma unroll
            for (int e = 0; e < 16; ++e) { const float t1 = acc[i][0][e], t2 = acc[i][1][e]; acc[i][0][e] = t1 * cc[e] - t2 * sn[e]; acc[i][1][e] = t2 * cc[e] + t1 * sn[e]; } }
#pragma unroll
          for (int e = 0; e < 16; ++e) { const int rl = i2 * 32 + (e & 3) + 8 * (e >> 2) + 4 * h; float v0 = acc[i][0][e], v1 = acc[i][1][e];
            if (!toproj) { v0 = silu_fast(v0); v1 = silu_fast(v1); }
            stg[rl * 72 + r] = f2bf(v0); stg[rl * 72 + 32 + r] = f2bf(v1); } }
#pragma unroll
        for (int c8 = 0; c8 < 8; ++c8) { const int idx = lane + 64 * c8, rl = idx >> 3, ch = idx & 7; const uint4 vv = *(const uint4*)&stg[rl * 72 + ch * 8];
          *(uint4*)(gdst + (long)(mrow0 + hf * 64 + rl) * gld + ch * 8) = vv; }
      }
    } else if (ncol0 == 8192) {
#pragma unroll
      for (int i = 0; i < MI; ++i)
#pragma unroll
        for (int e = 0; e < 16; ++e) { int row = mrow0 + i * 32 + (e & 3) + 8 * (e >> 2) + 4 * h; p.small[(long)row * NSMALL + r] = acc[i][0][e]; }
    }
  }
}

__device__ __forceinline__ unsigned tx_() { unsigned t = threadIdx.x; asm volatile("" : "+v"(t)); return t; }
__device__ __forceinline__ int gw0(int) { return (int)((blockIdx.x * 256u + tx_()) >> 6); }
__device__ __forceinline__ int bid0() { int b = blockIdx.x; asm volatile("" : "+s"(b)); return b; }

#define XB_TMO      128
#define XB_XCNT(j)  (256  + 64 * (j))
#define XB_XSUB(j)  (1280 + 64 * (j))
#define XB_XGEN(j)  (2304 + 64 * (j))
#define XB_TOP      3328
#define XB_TOPGEN   3392
#define XCD_BAR_WORDS 3456
#define XB_SPIN_CAP (1u << 28)
__device__ __forceinline__ unsigned xb_ld(unsigned* p) { return __hip_atomic_load(p, __ATOMIC_RELAXED, __HIP_MEMORY_SCOPE_AGENT); }
__device__ __forceinline__ unsigned xb_add(unsigned* p, unsigned v) { return __hip_atomic_fetch_add(p, v, __ATOMIC_RELAXED, __HIP_MEMORY_SCOPE_AGENT); }
__device__ __forceinline__ unsigned xb_xcc_id() { return (unsigned)__builtin_amdgcn_s_getreg((3 << 11) | 20) & 0xFu; }
#define XB_SPIN(cond, bar) do { unsigned _sp = 0; while (cond) { __builtin_amdgcn_s_sleep(1); \
    if ((++_sp & 255u) == 0u) { if (xb_ld(&(bar)[XB_TMO])) break; if (_sp > XB_SPIN_CAP) { atomicAdd(&(bar)[XB_TMO], 1u); break; } } } } while (0)
struct XcdBarrier { unsigned* bar; unsigned x; volatile LDS3 unsigned* st; };
__device__ __forceinline__ XcdBarrier xcd_barrier_post(unsigned* bar, volatile LDS3 unsigned* st) {
  XcdBarrier b; b.bar = bar; b.x = xb_xcc_id(); b.st = st;
  if (threadIdx.x == 0) (void)xb_add(&bar[XB_XCNT(b.x)], 1u);
  return b;
}
__device__ __forceinline__ void xcd_barrier_complete(unsigned* bar, unsigned x, unsigned& nloc, unsigned& nx) {
  const unsigned G = gridDim.x; unsigned sum, cnt, mine, sp = 0u;
  for (;;) { sum = 0u; cnt = 0u; mine = 0u;
#pragma unroll
    for (unsigned j = 0; j < 16; ++j) { const unsigned c = xb_ld(&bar[XB_XCNT(j)]); sum += c; cnt += (c > 0u) ? 1u : 0u; mine = (j == x) ? c : mine; }
    if (sum == G) break;
    __builtin_amdgcn_s_sleep(1);
    if ((++sp & 255u) == 0u) { if (xb_ld(&bar[XB_TMO])) break; if (sp > XB_SPIN_CAP) { atomicAdd(&bar[XB_TMO], 1u); break; } } }
  nloc = mine > 0u ? mine : 1u; nx = cnt > 0u ? cnt : 1u;
}
__device__ __forceinline__ void xcd_barrier(const XcdBarrier& b) {
  asm volatile("s_waitcnt vmcnt(0)" ::: "memory");
  __syncthreads();
  if (threadIdx.x == 0) {
    unsigned* bar = b.bar;
    __builtin_amdgcn_s_waitcnt(0);
    unsigned nloc = b.st[0], nx = b.st[1];
    if (nloc == 0u) { xcd_barrier_complete(bar, b.x, nloc, nx); b.st[0] = nloc; b.st[1] = nx; }
    const unsigned old = xb_add(&bar[XB_XSUB(b.x)], 1u);
    const unsigned gen = old / nloc;
    if (old + 1u == (gen + 1u) * nloc) {
      __builtin_amdgcn_fence(__ATOMIC_RELEASE, "agent");
      asm volatile("s_waitcnt vmcnt(0)" ::: "memory");
      const unsigned og = xb_add(&bar[XB_TOP], 1u);
      const unsigned tg = og / nx;
      if (og + 1u == (tg + 1u) * nx) xb_add(&bar[XB_TOPGEN], 1u);
      else XB_SPIN(xb_ld(&bar[XB_TOPGEN]) == tg, bar);
      __builtin_amdgcn_fence(__ATOMIC_ACQUIRE, "agent");
      xb_add(&bar[XB_XGEN(b.x)], 1u);
      asm volatile("s_waitcnt vmcnt(0)" ::: "memory");
    } else {
      XB_SPIN(xb_ld(&bar[XB_XGEN(b.x)]) == gen, bar);
      __builtin_amdgcn_fence(__ATOMIC_ACQUIRE, "agent");
      asm volatile("s_waitcnt vmcnt(0)" ::: "memory");
    }
  }
  __syncthreads();
}

struct KArgs { const void* in[20]; float* out; char* ws; };
#ifdef SELFCHK
#define RUN_S 4096
#else
#define RUN_S SEQ
#endif
__host__ __device__ __forceinline__ size_t fill_ws(Params& p, Params& p2, char* w) {
  size_t off = 0;
#define TAKE(bytes) (w + ((off += (((size_t)(bytes)) + 255) & ~(size_t)255) - ((((size_t)(bytes)) + 255) & ~(size_t)255)))
  const size_t S = RUN_S, ncmp = S / 16, nc = S / 128;
  p.S = RUN_S;
  p.wt_in = (unsigned short*)TAKE(8320 * 1024 * 2); p.wt_out = (unsigned short*)TAKE(2 * 1024 * 2304 * 2); p.w1t = (unsigned short*)TAKE(2 * 128 * 2048 * 2); p.w2t = (unsigned short*)TAKE(2 * 64 * 128 * 2);
  p.h = (SB*)TAKE(S * 1024 * 2); p.ybuf = (float*)p.h;
  p.proj = (SB*)TAKE(S * NPROJ * 2); p.y = (float*)p.proj;
  p.small = (float*)TAKE(S * 32 * 4); p.mix = (SB*)TAKE(S * NMIX * 2);
  p.rope_cs = (float*)TAKE(S * 32 * 4); p.rope_sn = (float*)TAKE(S * 32 * 4); p.tabA = (float*)TAKE(8 * TABA_N * 4); p.tabD = (float*)TAKE(24 * TABD_N * 4);
  p.memkv = (SB*)TAKE(4 * 256 * 512 * 2); p.hid = (float*)TAKE(2 * ncmp * 256 * 4); p.kvc = (SB*)TAKE(2 * ncmp * 128 * 2);
  p.cml = (float*)TAKE(S * 16 * 4); p.idx = (int*)TAKE(S * 32 * 4); p.oc = (SB*)TAKE(S * 512 * 2); p.ow = (SB*)TAKE(S * 512 * 2);
  p.dop = (SB*)TAKE(3 * S * 512 * 2); p.dlse = (float*)TAKE(3 * S * 8 * 4); p.xconv = (SB*)TAKE(S * 1024 * 2);
  p.dt = (float*)TAKE(S * 8 * 4); p.acs = (float*)TAKE(S * 8 * 4); p.wst = (float*)TAKE(S * 8 * 4); p.cb = (float*)TAKE(nc * 2 * 128 * 128 * 4); p.states = (float*)TAKE(nc * 65536 * 4);
  p.bar = (unsigned*)TAKE(131072);
  p2 = p;
#ifdef SELFCHK
  p.imp = (float*)TAKE(S * 512 * 4);
  p2.mix = (SB*)TAKE(S * NMIX * 2); p2.ow = (SB*)TAKE(S * 512 * 2); p2.oc = (SB*)TAKE(S * 512 * 2); p2.dop = (SB*)TAKE(3 * S * 512 * 2); p2.dlse = (float*)TAKE(3 * S * 8 * 4);
  p2.cml = (float*)TAKE(S * 16 * 4); p2.imp = (float*)TAKE(S * 512 * 4); p2.idx = (int*)TAKE(S * 32 * 4); p2.cb = (float*)TAKE(nc * 2 * 128 * 128 * 4);
  p2.kvc = (SB*)TAKE(2 * ncmp * 128 * 2); p2.xconv = (SB*)TAKE(S * 1024 * 2); p2.dt = (float*)TAKE(S * 8 * 4); p2.acs = (float*)TAKE(S * 8 * 4); p2.wst = (float*)TAKE(S * 8 * 4);
  p2.states = (float*)TAKE(nc * 65536 * 4); p2.ybuf = (float*)TAKE(S * 512 * 4); p.ybuf = (float*)TAKE(S * 512 * 4);
#else
  p.imp = (float*)p.dop; p2 = p;
#endif
  return off;
}
__host__ __device__ __forceinline__ void fill_inputs(Params& p, const KArgs& a) {
  p.x = (const float*)a.in[0]; p.mem = (const float*)a.in[1]; p.pos = (const int*)a.in[2]; p.pre_norm = (const float*)a.in[3]; p.post_norm = (const float*)a.in[4];
  p.w_in = (const float*)a.in[5]; p.w_out = (const float*)a.in[6]; p.rel_bias = (const float*)a.in[7]; p.cmp_pos = (const float*)a.in[8]; p.cmp_w1 = (const float*)a.in[9];
  p.cmp_w2 = (const float*)a.in[10]; p.conv_w = (const float*)a.in[11]; p.conv_b = (const float*)a.in[12]; p.dt_bias = (const float*)a.in[13]; p.a_log = (const float*)a.in[14];
  p.b_d = (const float*)a.in[15]; p.b_norm = (const float*)a.in[16]; p.sinks = (const float*)a.in[17]; p.m_norm = (const float*)a.in[18]; p.m_wkv = (const float*)a.in[19];
  p.out = a.out;
}
#define GS(N, ...) { long g0_ = (long)blockIdx.x * 256 + tx_(); for (long gid = g0_; gid < (long)(N); gid += gsz) { __VA_ARGS__; } }
#define WU(N, ...) { for (int u_ = gw0(gwave); u_ < (int)(N); u_ += nwave) { const int u = __builtin_amdgcn_readfirstlane(u_); const unsigned tq_ = tx_(); int lane = tq_ & 63; \
    WaveLds* WL = ((WaveLds*)smem_raw) + __builtin_amdgcn_readfirstlane((int)(tq_ >> 6)); __VA_ARGS__; } }
#define GSYNC() xcd_barrier(xb)
#ifndef CMP_SKIP
#define CMP_SKIP 3
#endif
#define WUQ(slot, CH, N, ...) { unsigned* cq_ = &p.bar[4096 + (layer * 8 + (slot)) * 64 * 8 + (blockIdx.x & 7) * 64]; for (;;) { unsigned t_ = 0u; if ((tx_() & 63) == 0) t_ = atomicAdd(cq_, 1u); \
    const int c0_ = __builtin_amdgcn_readfirstlane((int)t_) * (CH); if ((c0_ * 8 + (int)(blockIdx.x & 7)) >= (int)(N)) break; \
    for (int ci_ = 0; ci_ < (CH); ++ci_) { const int u = (c0_ + ci_) * 8 + (int)(blockIdx.x & 7); if (u >= (int)(N)) break; const unsigned tq_ = tx_(); int lane = tq_ & 63; \
      WaveLds* WL = ((WaveLds*)smem_raw) + __builtin_amdgcn_readfirstlane((int)(tq_ >> 6)); (void)WL; __VA_ARGS__; } } }
#ifndef ASELW
#define ASELW 1
#endif
#if ASELW == 1
#define ASEL_UNIT(pp, uu) unit_asel_w((pp), (uu), (AselW*)smem_raw)
#else
#define ASEL_UNIT(pp, uu) unit_asel_blk((pp), (uu), (AselLds*)smem_raw)
#endif
#define SMEM_A_ (sizeof(AselLds) > sizeof(AselW) ? sizeof(AselLds) : sizeof(AselW))
#define SMEM_BYTES (SMEM_A_ > sizeof(GemmSmem) ? ((SMEM_A_ + 15) & ~(size_t)15) : sizeof(GemmSmem))
#define gtid ((long)blockIdx.x * 256 + tx_())
#define gwave ((int)((blockIdx.x * 256u + tx_()) >> 6))
#define KERNEL_PROLOGUE \
  Params p, p2; p.pad0 = 0; fill_inputs(p, ka); fill_ws(p, p2, ka.ws); \
  cg::grid_group grid = cg::this_grid(); \
  __shared__ __attribute__((aligned(16))) char smem_raw[SMEM_BYTES + 16]; \
  volatile LDS3 unsigned* xbst = (volatile LDS3 unsigned*)(smem_raw + SMEM_BYTES); \
  if (threadIdx.x < 4) xbst[threadIdx.x] = 0u; \
  __syncthreads(); \
  XcdBarrier xb = xcd_barrier_post(p.bar, xbst); \
  GemmSmem& gsm = *(GemmSmem*)smem_raw; float* ftile = (float*)smem_raw; \
  const long gsz = (long)gridDim.x * 256; const int nwave = (int)(gsz >> 6); \
  const int S = p.S, ncmp = S / 16, nc = S / 128, nqt = S / 32; (void)ncmp; (void)nc; (void)nqt; (void)ftile; (void)gsm; \
  GS((long)S * 32, ph_rope(p, gid)); \
  GS(8 * TABA_N + 24 * TABD_N, ph_tabs(p, gid)); \
  WU(DEPTH * 256, unit_memkv(p, u, lane));
#define PHASE_NORM(layer) \
    for (int t = gw0(gwave); t < S; t += nwave) { int lane = tx_() & 63; norm_row_wave(p, layer, t, true, lane); }
#define PHASE_CVT(layer) \
    { const float* wi = p.w_in + (long)(layer) * 1024 * 8224; unsigned short* wob_ = p.wt_out + (long)((layer) & 1) * 1024 * 2304; \
      for (int tl = bid0(); tl < 16 * 130; tl += gridDim.x) cvt_tile<true>(wi, 8224, p.wt_in, 1024, (tl & 15) * 64, (tl >> 4) * 64, ftile); \
      const float* wo = p.w_out + (long)(layer) * 2304 * 1024; \
      for (int tl = bid0(); tl < 36 * 16; tl += gridDim.x) cvt_tile<false>(wo, 1024, wob_, 2304, (tl % 36) * 64, (tl / 36) * 64, ftile); \
      for (int tl = bid0(); tl < 2 * 64; tl += gridDim.x) { const int kv = tl >> 6, t6 = tl & 63; cvt_tile<false>(p.cmp_w1 + (long)((layer) * 2 + kv) * 2048 * 128, 128, p.w1t + (long)kv * 128 * 2048, 2048, (t6 >> 1) * 64, (t6 & 1) * 64, ftile); } \
      for (int tl = bid0(); tl < 2 * 2; tl += gridDim.x) { const int kv = tl >> 1; cvt_tile<false>(p.cmp_w2 + (long)((layer) * 2 + kv) * 128 * 64, 64, p.w2t + (long)kv * 64 * 128, 128, (tl & 1) * 64, 0, ftile); } }
#define PHASE_P1(layer) PHASE_NORM(layer) PHASE_CVT(layer)
#define PHASE_P2() \
    {   \
      const int x_ = bid0() & 7, li_ = bid0() >> 3, nl_ = (gridDim.x + 7) >> 3, mtiles_ = S / (64 * GMI), mper_ = mtiles_ / 8; \
      if ((mper_ & 7) != 0 || (gridDim.x & 7) != 0) { for (int tl = bid0(); tl < mtiles_ * 65; tl += gridDim.x) { int mt = tl % mtiles_, nt = tl / mtiles_; gemm_tile<0, GMI>(p, p.h, DM, p.wt_in, DM, DM, mt * 64 * GMI, nt * 128, gsm); } } \
      else for (int t_ = li_; t_ < mper_ * 65; t_ += nl_) { const int half_ = t_ / 520, r_ = t_ % 520; int ml_, nt_; \
        if (r_ < 512) { ml_ = r_ & 7; nt_ = (r_ >> 6) * 8 + ((r_ & 63) >> 3); } else { ml_ = r_ - 512; nt_ = 64; } \
        gemm_tile<0, GMI>(p, p.h, DM, p.wt_in, DM, DM, (x_ * mper_ + half_ * 8 + ml_) * 64 * GMI, nt_ * 128, gsm); } }
#define PHASE_FLASH3(layer) \
    { const int nA = nqt * 8, nM = nqt * 4, nD = 3 * nqt * 8, nC = nqt * 8; \
      WU(nA + nM + nD + nC, { if (u < nA) unit_awin(p, u, WL, lane); else if (u < nA + nM) unit_m(p, layer, u - nA, WL, lane); \
                              else if (u < nA + nM + nD) unit_d(p, u - nA - nM, WL, lane); else unit_c(p, layer, u - nA - nM - nD, WL, lane); }); }
#define WU2(N, ...) { for (int u_ = gw0(gwave); u_ < (int)(N); u_ += nwave) { const int u = __builtin_amdgcn_readfirstlane(u_); const unsigned tq_ = tx_(); int lane = tq_ & 63; \
    WaveLds2* WL2 = ((WaveLds2*)smem_raw) + __builtin_amdgcn_readfirstlane((int)(tq_ >> 6)); __VA_ARGS__; } }
#define PHASE_CB() \
    for (int tl = bid0(); tl < nc * 2; tl += gridDim.x) { const SB* xb_ = p.xconv + (long)(tl >> 1) * 128 * 1024 + (tl & 1) * 128; gemm_tile<2, 2>(p, xb_ + 768, 1024, xb_ + 512, 1024, 128, 0, 0, gsm, p.cb + (long)tl * 16384); }

#ifndef SELFCHK
#define PH_BEGIN { char* wsb_ = ka.ws; asm volatile("" : "+s"(wsb_)); Params p, p2_; p.pad0 = 0; fill_inputs(p, ka); fill_ws(p, p2_, wsb_); (void)p2_;
#define PH_END }
__global__ void __launch_bounds__(256, LB2) mega(KArgs ka) {
  KERNEL_PROLOGUE
#ifdef REP_PRO
  GS((long)S * 32, ph_rope(p, gid)); GS(8 * TABA_N + 24 * TABD_N, ph_tabs(p, gid)); WU(DEPTH * 256, unit_memkv(p, u, lane));
#endif
#ifdef TSEL
  unsigned long long tlast = __builtin_amdgcn_s_memrealtime();
#define TMARK(id) { if (gtid == 0) { const unsigned long long tn = __builtin_amdgcn_s_memrealtime(); ((unsigned long long*)p.bar)[id] += tn - tlast; tlast = tn; } }
#else
#define TMARK(id)
#endif
  for (int layer = 0; layer < DEPTH; ++layer) {
    PH_BEGIN
    PHASE_P1(layer)
#ifdef REP_P1
    PHASE_P1(layer)
#endif
    PH_END
    if (layer == 0) grid.sync(); else GSYNC();
    PH_BEGIN
    TMARK(1)
    PHASE_P2()
#ifdef REP_G
    PHASE_P2()
#endif
#ifdef REP_G2
    { const int x_ = bid0() & 7, li_ = bid0() >> 3, nl_ = (gridDim.x + 7) >> 3; for (int t_ = li_; t_ < 520; t_ += nl_) { int ml_, nt_; if (t_ < 512) { ml_ = t_ & 7; nt_ = (t_ >> 6) * 8 + ((t_ & 63) >> 3); } else { ml_ = t_ - 512; nt_ = 64; }
        gemm_tile<0, GMI, true>(p, p.h, DM, p.wt_in, DM, DM, (x_ * 8 + ml_) * 64 * GMI, nt_ * 128, gsm); } }
#endif
    PH_END
    GSYNC();
    PH_BEGIN
    TMARK(2)
    { const int nCmp = 2 * (ncmp * 2 / 32), nA = nqt * 8, nM = nqt * 4, nD = 3 * nqt * 8, nC = nqt * 8, nF = nA + nM + nD + nC;
      const int cb0 = (int)gridDim.x - nCmp; const bool cmpw = ((int)blockIdx.x >= cb0) && (cb0 > 0); const int cw0 = cb0 * 4;
#define FLASH_UNIT(uu) {   \
        const int v_ = __builtin_amdgcn_readfirstlane(uu); const int gw_ = v_ % nwave, rr_ = v_ / nwave; const int x_ = (gw_ >> 2) & 7, lw_ = ((gw_ >> 5) << 2) | (gw_ & 3); int j_ = rr_ * (nwave >> 3) + lw_; \
        const unsigned tq_ = tx_(); int lane = tq_ & 63; WaveLds* WL = ((WaveLds*)smem_raw) + __builtin_amdgcn_readfirstlane((int)(tq_ >> 6)); \
        if ((nwave & 31) != 0) { const int u = v_; if (u < nA) unit_awin(p, u, WL, lane); else if (u < nA + nM) unit_m(p, layer, u - nA, WL, lane); else if (u < nA + nM + nD) unit_d(p, u - nA - nM, WL, lane); else unit_c(p, layer, u - nA - nM - nD, WL, lane); } \
        else if (j_ < nA / 8) unit_awin(p, x_ * (nA / 8) + j_, WL, lane); \
        else if ((j_ -= nA / 8) < nM / 8) unit_m(p, layer, x_ * (nM / 8) + j_, WL, lane); \
        else if ((j_ -= nM / 8) < nD / 24) unit_d(p, x_ * (nD / 24) + j_, WL, lane); \
        else if ((j_ -= nD / 24) < nD / 24) unit_d(p, nD / 3 + x_ * (nD / 24) + j_, WL, lane); \
        else if ((j_ -= nD / 24) < nD / 24) unit_d(p, 2 * (nD / 3) + x_ * (nD / 24) + j_, WL, lane); \
        else if ((j_ -= nD / 24) < nC / 8) unit_c(p, layer, x_ * (nC / 8) + j_, WL, lane); }
#ifdef REP_F3B
      WU(nA + nD, { if (u < nA) unit_awin(p, u, WL, lane); else unit_d(p, u - nA, WL, lane); });
#endif
#ifdef REP_CMPB
      for (int ub = bid0(); ub < nCmp; ub += gridDim.x) unit_cmp_blk(p, layer, ub, (float*)smem_raw); __syncthreads();
#endif
      if (cb0 <= 0) { for (int ub = bid0(); ub < nCmp; ub += gridDim.x) unit_cmp_blk(p, layer, ub, (float*)smem_raw); __syncthreads(); }
      else if (cmpw) { unit_cmp_blk(p, layer, (int)blockIdx.x - cb0, (float*)smem_raw); __syncthreads(); }
      for (int r_ = (cmpw ? CMP_SKIP : 0), u_ = gw0(gwave) + r_ * nwave; u_ < nF; u_ += nwave) FLASH_UNIT(u_)
      if (cb0 > 0) for (int e_ = gw0(gwave); e_ < CMP_SKIP * nCmp * 4; e_ += nwave) { const int u_ = (e_ / (nCmp * 4)) * nwave + cw0 + (e_ % (nCmp * 4)); if (u_ < nF) FLASH_UNIT(u_) }
#undef FLASH_UNIT
    }
    GS((long)S * 128, item_bconv(p, layer, gid));
    WU(nc * 8, unit_bdt(p, layer, u, lane));
    PH_END
    GSYNC();
    PH_BEGIN
    TMARK(3)
    WU(nqt * 8, unit_acmp1(p, u, WL, lane));
    __syncthreads();
    PHASE_CB()
    __syncthreads();
    WU2(nc * 16, unit_bstates(p, u, WL2, lane));
#ifdef REP_P4
    __syncthreads();
    WU(nqt * 8, unit_acmp1(p, u, WL, lane));
    __syncthreads();
    PHASE_CB()
    __syncthreads();
    WU2(nc * 16, unit_bstates(p, u, WL2, lane));
#endif
    GS((long)S * 64, item_dmerge(p, gid));
    PH_END
    GSYNC();
    PH_BEGIN
    TMARK(4)
    {
      const int nU = nqt * 8, hw_ = nwave >> 1; const int gw_ = gw0(gwave);
      if (65536 * 2 != (int)gsz || (nU & 3)) { WU(nU, unit_acmp2(p, u, lane)); }
      else if (gw_ >= hw_) { for (int u_ = gw_ - hw_; u_ < (nU / 4) * 3; u_ += hw_) { const int u = __builtin_amdgcn_readfirstlane(u_); int lane = tx_() & 63; unit_acmp2(p, u, lane); } }
      else { for (int u_ = (nU / 4) * 3 + gw_; u_ < nU; u_ += hw_) { const int u = __builtin_amdgcn_readfirstlane(u_); int lane = tx_() & 63; unit_acmp2(p, u, lane); } } }
#ifdef REP_P5A
    WU(nqt * 8, unit_acmp2(p, u, lane));
#endif
    GS(65536, ph_b_scan(p, gid));
    PH_END
    GSYNC();
    PH_BEGIN
    TMARK(5)
#ifdef REP_BOUT
    for (int ub = bid0(); ub < nc * 8; ub += gridDim.x) unit_bout_blk<false>(p, layer, ub, smem_raw);
#endif
    for (int ub = bid0(); ub < nc * 8; ub += gridDim.x) unit_bout_blk(p, layer, ub, smem_raw);
    TMARK(7)
#ifdef REP_ASELW
    for (;;) { __syncthreads(); if (threadIdx.x == 0) xbst[2] = atomicAdd(&p.bar[48 + layer * 8 + 7], 1u); __syncthreads(); const int ub = (int)xbst[2]; if (ub >= (S / 32) * 2) break; unit_asel_w<false, REP_ASELW == 2, REP_ASELW == 3>(p, ub, (AselW*)smem_raw); }
#endif
#ifdef REP_ASEL2
    for (;;) { __syncthreads(); if (threadIdx.x == 0) xbst[2] = atomicAdd(&p.bar[48 + layer * 8 + 7], 1u); __syncthreads(); const int ub = (int)xbst[2]; if (ub >= (S / 32) * 2) break; unit_asel_blk<false>(p, ub, (AselLds*)smem_raw); }
#endif
#ifdef REP_ASEL3
    for (;;) { __syncthreads(); if (threadIdx.x == 0) xbst[2] = atomicAdd(&p.bar[48 + layer * 8 + 7], 1u); __syncthreads(); const int ub = (int)xbst[2]; if (ub >= (S / 32) * 2) break; unit_asel_blk<false, true>(p, ub, (AselLds*)smem_raw); }
#endif
#ifndef ASEL_XQ
#define ASEL_XQ 1
#endif
#if ASEL_XQ
    {
      AselW* AW = (AselW*)smem_raw; __syncthreads(); asel_w_tables(p, AW); __syncthreads();
      const int tq_ = tx_(), ln_ = tq_ & 63, wv_ = __builtin_amdgcn_readfirstlane(tq_ >> 6); const int qc = (bid0() >> 2) & 1; bool own = true; const unsigned NWI = (unsigned)(S / 32) * 4u;
      for (;;) { unsigned n = 0xffffffffu; int c = qc;
        if (own) { if (ln_ == 0) n = atomicAdd(&p.bar[48 + layer * 8 + 4 + qc], 1u); n = (unsigned)__builtin_amdgcn_readfirstlane((int)n); if (n >= NWI) { n = 0xffffffffu; own = false; } }
        if (n == 0xffffffffu) { c = qc ^ 1; if (ln_ == 0) n = atomicAdd(&p.bar[48 + layer * 8 + 4 + c], 1u); n = (unsigned)__builtin_amdgcn_readfirstlane((int)n); if (n >= NWI) break; }
        asel_w_wave(p, c, ((S / 32 - 1) - (int)(n >> 2)) * 32 + 8 * (int)(n & 3u), AW, wv_, ln_); } }
#else
    for (;;) { __syncthreads(); if (threadIdx.x == 0) xbst[2] = atomicAdd(&p.bar[48 + layer * 8 + 6], 1u); __syncthreads(); const int ub = (int)xbst[2]; if (ub >= (S / 32) * 2) break; unit_asel_blk(p, ub, (AselLds*)smem_raw); }
#endif
    PH_END
    GSYNC();
    PH_BEGIN
    TMARK(8)
    for (int tl = bid0(); tl < (S / (64 * GMI)) * 8; tl += gridDim.x) { int mt = tl >> 3, nt = tl & 7; gemm_tile<1, GMI>(p, p.mix, NMIX, p.wt_out + (long)(layer & 1) * 1024 * 2304, NMIX, NMIX, mt * 64 * GMI, nt * 128, gsm); }
#ifdef REP_P8
    for (int tl = bid0(); tl < (S / (64 * GMI)) * 8; tl += gridDim.x) { int mt = tl >> 3, nt = tl & 7; gemm_tile<1, GMI>(p, p.mix, NMIX, p.wt_out + (long)(layer & 1) * 1024 * 2304, NMIX, NMIX, mt * 64 * GMI, nt * 128, gsm); }
#endif
    PH_END
    GSYNC();
    PH_BEGIN
    TMARK(9)
#ifdef REP_BAR
    for (int q_ = 0; q_ < 8; ++q_) GSYNC();
#endif
    PH_END
  }
  for (int t = gw0(gwave); t < S; t += nwave) { int lane = tx_() & 63; norm_row_wave(p, DEPTH, t, false, lane); }
#ifdef TSEL
  GSYNC();
  { const float us = (float)((unsigned long long*)p.bar)[TSEL] * 0.01f;
    const float kk = __expf(rintf(__logf(us + 1.f) * 20.f) * 0.05f);
    GS((long)S * 1024, p.out[gid] = kk); }
#endif
}
#else
__device__ __forceinline__ void chk_update(unsigned* slot, float diff, float ref) {
  atomicMax(&slot[0], __float_as_uint(fabsf(diff))); atomicMax(&slot[1], __float_as_uint(fabsf(ref)));
}
#define CMPB(slot, a, b_) chk_update(sl + (slot), bf2f(a) - bf2f(b_), bf2f(b_))
#define CMPF(slot, a, b_) chk_update(sl + (slot), (a) - (b_), (b_))
__global__ void __launch_bounds__(256, 1) mega(KArgs ka) {
  KERNEL_PROLOGUE
  if (gtid < 64) p.bar[gtid] = 0u;
  unsigned* sl = p.bar;
  const int layer = 0;
  PHASE_P1(layer)
  grid.sync();
  PHASE_P2()
  GSYNC();
  GS((long)S * NMIX, p2.mix[gid] = p.mix[gid]);
  GSYNC();
  PHASE_FLASH3(layer)
  __syncthreads();
  for (int ub = bid0(); ub < 2 * (ncmp * 2 / 32); ub += gridDim.x) unit_cmp_blk(p, layer, ub, (float*)smem_raw);
  __syncthreads();
  GS((long)S * 128, item_bconv(p, layer, gid));
  WU(nc * 8, unit_bdt(p, layer, u, lane));
  GS((long)2 * ncmp * 256, ph_cmp_hid(p2, layer, gid));
  GS((long)S * 8, ph_a_win(p2, gid));
  GS((long)S * 8, ph_c(p2, layer, gid));
  GS((long)3 * S * 8, ph_d(p2, gid));
  GS((long)S * 4, ph_m(p2, layer, gid));
  GS((long)S * 1024, ph_b_conv(p2, layer, gid));
  GS((long)nc * 8, ph_b_dt2(p2, layer, gid));
  GSYNC();
  GS((long)2 * ncmp * 128, ph_cmp_out(p2, layer, gid));
  GSYNC();
  GS((long)2 * ncmp * 128, CMPB(20, p.kvc[gid], p2.kvc[gid]));
  GS((long)S * 1024, CMPB(22, p.xconv[gid], p2.xconv[gid]));
  GS((long)S * 8, { CMPF(24, p.dt[gid], p2.dt[gid]); CMPF(24, p.acs[gid], p2.acs[gid]); CMPF(24, p.wst[gid], p2.wst[gid]); });
  GSYNC();
  GS((long)2 * ncmp * 128, p2.kvc[gid] = p.kvc[gid]);
  GS((long)S * 1024, p2.xconv[gid] = p.xconv[gid]);
  GS((long)S * 8, { p2.dt[gid] = p.dt[gid]; p2.acs[gid] = p.acs[gid]; p2.wst[gid] = p.wst[gid]; });
  GSYNC();
  WU(nqt * 8, unit_acmp1(p, u, WL, lane));
  __syncthreads();
  PHASE_CB()
  __syncthreads();
  WU2(nc * 16, unit_bstates(p, u, WL2, lane));
  GS((long)S * 8, ph_a_cmp1(p2, gid));
  GS((long)nc * 2 * 128 * 128, ph_b_cb(p2, gid));
  GS((long)nc * 65536, ph_b_states(p2, gid));
  GSYNC();
  WU(nqt * 8, unit_acmp2(p, u, lane));
  GS((long)S * 2, ph_a_cmp2(p2, gid));
  GS((long)nc * 65536, CMPF(26, p.states[gid], p2.states[gid]));
  GS((long)nc * 2 * 128 * 128, { int s_ = (int)(gid & 127), l_ = (int)((gid >> 7) & 127); if (s_ <= l_) CMPF(18, p.cb[gid], p2.cb[gid]); });
  GSYNC();
  GS(65536, ph_b_scan(p, gid));
  GS(65536, ph_b_scan(p2, gid));
  GS((long)S * 512, { CMPB(0, p.ow[gid], p2.ow[gid]); CMPB(2, p.oc[gid], p2.oc[gid]); long t = gid >> 9, c = gid & 511; CMPB(4, p.mix[t * NMIX + MX_C + c], p2.mix[t * NMIX + MX_C + c]);
                      if (c < 256) CMPB(6, p.mix[t * NMIX + MX_M + c], p2.mix[t * NMIX + MX_M + c]); });
  GS((long)3 * S * 512, CMPB(8, p.dop[gid], p2.dop[gid]));
  GS((long)3 * S * 8, chk_update(sl + 10, p.dlse[gid] - p2.dlse[gid], 1.f));
  GS((long)S * 2 * 256, { long qg = gid >> 8; int bb = (int)(gid & 255); int q = (int)(qg >> 1), g_ = (int)(qg & 1); if (bb <= (q >> 6)) CMPF(12, p.imp[(((long)(q >> 5) * 2 + g_) * 256 + bb) * 32 + (q & 31)], p2.imp[gid]); });
  GSYNC();
  GS((long)S * 512, { long qg = gid >> 8; int bb = (int)(gid & 255); int q = (int)(qg >> 1), g_ = (int)(qg & 1); p2.imp[gid] = p.imp[(((long)(q >> 5) * 2 + g_) * 256 + bb) * 32 + (q & 31)]; });
  GSYNC();
  WU(S * 2 / 4, unit_topk4(p, u, lane));
  WU2(nc * 32, unit_bout(p, layer, u, WL2, lane));
  GS((long)S * 2, ph_a_topk(p2, gid));
  GS((long)S * 512, ph_b_out(p2, layer, gid));
  GSYNC();
  GS((long)S * 2, { int q = (int)(gid >> 1); int nv = (q >> 6) + 1; nv = nv > 16 ? 16 : nv; int bad = 0;
    for (int k = 0; k < 16; ++k) { int mine = p.idx[gid * 16 + k]; bool found = false; for (int k2 = 0; k2 < 16; ++k2) found |= (p2.idx[gid * 16 + k2] == mine); if (k < nv) bad += !found || mine < 0; else bad += (mine >= 0); }
    chk_update(sl + 14, (float)bad, 1.f); });
  GS((long)S * 512, CMPF(28, p.ybuf[gid], p2.ybuf[gid]));
  GSYNC();
  GS((long)S * 32, p2.idx[gid] = p.idx[gid]);
  GS((long)S * 512, p2.ybuf[gid] = p.ybuf[gid]);
  GSYNC();
  for (int ub = bid0(); ub < (S / 32) * 2; ub += gridDim.x) ASEL_UNIT(p, ub);
  for (;;) { __syncthreads(); if (threadIdx.x == 0) xbst[2] = atomicAdd(&p.bar[40 + layer], 1u); __syncthreads(); const int ub = (int)xbst[2]; if (ub >= nc * 8) break; unit_bout_blk(p, layer, ub, smem_raw); }
  GS((long)S * 8, ph_a_sel(p2, gid));
  GS((long)S * 2, ph_b_norm(p2, layer, gid));
  GSYNC();
  GS((long)S * 512, { long t = gid >> 9, c = gid & 511; CMPB(16, p.mix[t * NMIX + MX_A + c], p2.mix[t * NMIX + MX_A + c]); CMPB(30, p.mix[t * NMIX + MX_B + c], p2.mix[t * NMIX + MX_B + c]); });
  GSYNC();
  { float R = 0.f;
    for (int k = 0; k < 16; ++k) { float d = __uint_as_float(p.bar[2 * k]), r = __uint_as_float(p.bar[2 * k + 1]); float q = d / (r + 1e-20f); if (CHKSEL < 0 || CHKSEL == k) R = fmaxf(R, q); }
    GS((long)SEQ * 1024, p.out[gid] = 1e4f * R); }
}
#endif

__global__ void zz_tail_pad(float* o) { asm volatile(".rept 512\n\ts_nop 0\n\t.endr" ::: "memory"); if (o) o[0] = 0.f; }
__global__ void fill_code(float* o, float v, long n) { long i = blockIdx.x * 256L + threadIdx.x; if (i < n) o[i] = v; }
extern "C" void kernel_launch(void* const* d_in, const int* in_sizes, int n_in, void* d_out, int out_size, void* d_ws, size_t ws_size, hipStream_t stream) {
  KArgs ka; memset(&ka, 0, sizeof(ka));
  for (int i = 0; i < 20; ++i) ka.in[i] = d_in[i];
  ka.out = (float*)d_out; ka.ws = (char*)d_ws;
  Params hp, hp2; memset(&hp, 0, sizeof(hp)); const size_t need = fill_ws(hp, hp2, (char*)d_ws);
  if (need > ws_size) { fprintf(stderr, "workspace too small: need %zu have %zu\n", need, ws_size); return; }
  static int grid_blocks = 0;
  if (!grid_blocks) { int dev = 0, cus = 0, per_cu = 0; (void)hipGetDevice(&dev); (void)hipDeviceGetAttribute(&cus, hipDeviceAttributeMultiprocessorCount, dev);
    (void)hipOccupancyMaxActiveBlocksPerMultiprocessor(&per_cu, mega, 256, 0); if (per_cu > LB2) per_cu = LB2; if (per_cu < 1) per_cu = 1; grid_blocks = cus * per_cu; }
  (void)hipMemsetAsync(hp.bar, 0, 131072, stream);
  void* args[] = {&ka};
  hipError_t e = hipLaunchCooperativeKernel((void*)mega, dim3(grid_blocks), dim3(256), args, 0, stream);
  if (e != hipSuccess) { (void)hipGetLastError(); fill_code<<<(unsigned)(((long)SEQ * 1024 + 255) / 256), 256, 0, stream>>>((float*)d_out, 1000.f * (float)(int)e + (float)grid_blocks, (long)SEQ * 1024); }
}
```

```cpp
#include <hip/hip_runtime.h>
#include <hip/hip_cooperative_groups.h>
#include <cstdio>
#include <cstdint>
#include <cstring>
namespace cg = cooperative_groups;
#define HD_ __device__ __forceinline__
#ifndef CHKSEL
#define CHKSEL -1
#endif
#ifndef LB2
#define LB2 2
#endif
#ifndef HD_
#define HD_ inline
#endif
#ifdef SB_IS_FLOAT
typedef float SB;
HD_ float ldf(const SB* p) { return *p; }
HD_ void stf(SB* p, float v) { *p = v; }
#else
typedef unsigned short SB;
HD_ float bf2f(unsigned short b) { unsigned u = ((unsigned)b) << 16; float f; __builtin_memcpy(&f, &u, 4); return f; }
HD_ unsigned short f2bf(float f) { unsigned u; __builtin_memcpy(&u, &f, 4); u += 0x7fffu + ((u >> 16) & 1u); return (unsigned short)(u >> 16); }
HD_ float ldf(const SB* p) { return bf2f(*p); }
HD_ void stf(SB* p, float v) { *p = f2bf(v); }
#endif

#define DM 1024
#define NPROJ 5888
#define NMIX 2304
#define NSMALL 32
#define PA_Q 0
#define PA_KV 512
#define PB_X 1280
#define PC_Q 2304
#define PC_KV 2816
#define PD_Q 3072
#define PD_KV 4608
#define PM_Q 5632
#define MX_A 0
#define MX_B 512
#define MX_C 1024
#define MX_D 1536
#define MX_M 2048
#define TABA_N 2048
#define TABD_N 132

struct Params {
  int S; int pad0;
  const float *x, *mem; const int* pos;
  const float *pre_norm, *post_norm, *w_in, *w_out, *rel_bias, *cmp_pos, *cmp_w1, *cmp_w2, *conv_w, *conv_b, *dt_bias, *a_log, *b_d,
      *b_norm, *sinks, *m_norm, *m_wkv;
  float* out;
  unsigned short* wt_in;
  unsigned short* wt_out;
  unsigned short *w1t, *w2t;
  SB* h;
  SB* proj;
  float* small;
  SB* mix;
  float* y;
  float *rope_cs, *rope_sn;
  float *tabA, *tabD;
  SB* memkv;
  float* hid;
  SB* kvc;
  float* imp;
  float* cml;
  int* idx;
  SB *oc, *ow;
  SB* dop;
  float* dlse;
  SB* xconv;
  float *dt, *acs;
  float* wst;
  float* cb;
  float* states;
  float* ybuf;
  unsigned* bar;
};

HD_ float silu_f(float x) { return x / (1.f + expf(-x)); }
HD_ float sigmoid_f(float x) { return 1.f / (1.f + expf(-x)); }
HD_ float gelu_f(float x) { return 0.5f * x * (1.f + tanhf(0.7978845608028654f * (x + 0.044715f * x * x * x))); }
HD_ float softplus_f(float x) { return fmaxf(x, 0.f) + log1pf(expf(-fabsf(x))); }

HD_ int t5_bucket(int d) {
  if (d < 16) return d < 0 ? 0 : d;
  const int thr[15] = {22, 30, 40, 54, 73, 99, 134, 182, 246, 332, 450, 609, 825, 1117, 1513};
  int b = 16;
  for (int k = 0; k < 15; ++k) b += (d >= thr[k]) ? 1 : 0;
  return b;
}

HD_ void ph_rope(const Params& p, long gid) {
  int s = (int)(gid >> 5), i = (int)(gid & 31);
  float inv = powf(150000.f, -(float)i / 32.f);
  float ang = (float)p.pos[s] * inv;
  p.rope_cs[gid] = cosf(ang); p.rope_sn[gid] = sinf(ang);
}
HD_ void ph_tabs(const Params& p, long gid) {
  if (gid < 8 * TABA_N) { int h = (int)(gid / TABA_N), d = (int)(gid % TABA_N); p.tabA[gid] = p.rel_bias[t5_bucket(d) * 32 + h]; }
  else { long g2 = gid - 8 * TABA_N; int hh = (int)(g2 / TABD_N), d = (int)(g2 % TABD_N); int gi = hh >> 3;
    int dil = gi == 0 ? 1 : (gi == 1 ? 4 : 16); p.tabD[g2] = p.rel_bias[t5_bucket(d * dil) * 32 + 8 + hh]; }
}
HD_ void ph_memkv(const Params& p, long gid) {
  int e = (int)(gid & 511), m = (int)((gid >> 9) & 255), l = (int)(gid >> 17);
  const float* row = p.mem + (long)m * DM;
  float ss = 0.f; _Pragma("unroll 16") for (int d = 0; d < DM; ++d) ss += row[d] * row[d];
  float r = 1.f / sqrtf(ss / DM + 1e-6f);
  float acc = 0.f;
  _Pragma("unroll 16") for (int d = 0; d < DM; ++d) acc += row[d] * r * p.m_norm[l * DM + d] * p.m_wkv[((long)l * DM + d) * 512 + e];
  stf(&p.memkv[gid], acc);
}
HD_ void ph_norm_row(const Params& p, int layer, int t, bool do_h) {
  const float* xin = (layer == 0) ? p.x + (long)t * DM : p.out + (long)t * DM;
  float* xo = p.out + (long)t * DM;
  float r1 = 0.f;
  if (layer > 0) { const float* y = p.y + (long)t * DM; float ss = 0.f; for (int d = 0; d < DM; ++d) ss += y[d] * y[d]; r1 = 1.f / sqrtf(ss / DM + 1e-6f); }
  float ss2 = 0.f;
  for (int d = 0; d < DM; ++d) { float v = xin[d]; if (layer > 0) v += p.y[(long)t * DM + d] * r1 * p.post_norm[(layer - 1) * DM + d]; xo[d] = v; ss2 += v * v; }
  if (!do_h) return;
  float r2 = 1.f / sqrtf(ss2 / DM + 1e-6f);
  for (int d = 0; d < DM; ++d) stf(&p.h[(long)t * DM + d], xo[d] * r2 * p.pre_norm[layer * DM + d]);
}

HD_ void ph_cmp_hid(const Params& p, int layer, long gid) {
  int u = (int)(gid & 127), hk = (int)((gid >> 7) & 1); long r = gid >> 8; int ncmp = p.S / 16; int j = (int)(r % ncmp), kv = (int)(r / ncmp);
  const float* w1 = p.cmp_w1 + ((long)(layer * 2 + kv) * 2048) * 128;
  const float* pe = p.cmp_pos + (long)(layer * 2 + kv) * 32 * 64;
  float acc = 0.f;
  for (int t = 0; t < 32; ++t) { int tok = 16 * j + t;
    _Pragma("unroll 16") for (int d = 0; d < 64; ++d) { float v = pe[t * 64 + d]; if (tok < p.S) v += ldf(&p.proj[(long)tok * NPROJ + PA_KV + kv * 128 + hk * 64 + d]);
      acc += v * w1[(long)(t * 64 + d) * 128 + u]; } }
  p.hid[gid] = gelu_f(acc);
}
HD_ void ph_cmp_out(const Params& p, int layer, long gid) {
  int d = (int)(gid & 63), hk = (int)((gid >> 6) & 1); long r = gid >> 7; int ncmp = p.S / 16; int j = (int)(r % ncmp), kv = (int)(r / ncmp);
  const float* w2 = p.cmp_w2 + (long)(layer * 2 + kv) * 128 * 64;
  const float* hd = p.hid + (((long)kv * ncmp + j) * 2 + hk) * 128;
  float acc = 0.f; for (int u = 0; u < 128; ++u) acc += hd[u] * w2[u * 64 + d];
  stf(&p.kvc[gid], acc);
}
HD_ void ph_a_cmp1(const Params& p, long gid) {
  int h = (int)(gid & 7), q = (int)(gid >> 3), g = h >> 2; int ncmp = p.S / 16;
  int jn = (q >= 31) ? ((q - 31) / 16 + 1) : 0;
  const SB* kc = p.kvc; const SB* vc = p.kvc + (long)ncmp * 128;
  float qv[64], o[64]; for (int d = 0; d < 64; ++d) { qv[d] = ldf(&p.proj[(long)q * NPROJ + PA_Q + h * 64 + d]); o[d] = 0.f; }
  float m = -1e30f, l = 0.f;
  for (int j = 0; j < jn; ++j) { const SB* kr = &kc[((long)j * 2 + g) * 64]; const SB* vr = &vc[((long)j * 2 + g) * 64];
    float s = 0.f; for (int d = 0; d < 64; ++d) s += qv[d] * ldf(&kr[d]);
    int dist = q - (16 * j + 31); s = s * 0.125f + p.tabA[h * TABA_N + (dist < TABA_N ? dist : TABA_N - 1)];
    float mn = fmaxf(m, s), a = expf(m - mn), pr = expf(s - mn); l = l * a + pr; for (int d = 0; d < 64; ++d) o[d] = o[d] * a + pr * ldf(&vr[d]); m = mn; }
  float il = jn > 0 ? 1.f / l : 0.f; for (int d = 0; d < 64; ++d) stf(&p.oc[(long)q * 512 + h * 64 + d], o[d] * il);
  p.cml[gid * 2] = m; p.cml[gid * 2 + 1] = il;
}
HD_ void ph_a_cmp2(const Params& p, long gid) {
  int g = (int)(gid & 1), q = (int)(gid >> 1); int ncmp = p.S / 16;
  float* imp = p.imp + gid * 256; for (int b = 0; b < 256; ++b) imp[b] = 0.f;
  int jn = (q >= 31) ? ((q - 31) / 16 + 1) : 0; const SB* kc = p.kvc;
  for (int hh = 0; hh < 4; ++hh) { int h = g * 4 + hh; float qv[64]; for (int d = 0; d < 64; ++d) qv[d] = ldf(&p.proj[(long)q * NPROJ + PA_Q + h * 64 + d]);
    float m = p.cml[((long)q * 8 + h) * 2], il = p.cml[((long)q * 8 + h) * 2 + 1];
    for (int j = 0; j < jn; ++j) { const SB* kr = &kc[((long)j * 2 + g) * 64]; float s = 0.f; for (int d = 0; d < 64; ++d) s += qv[d] * ldf(&kr[d]);
      int dist = q - (16 * j + 31); s = s * 0.125f + p.tabA[h * TABA_N + (dist < TABA_N ? dist : TABA_N - 1)]; float pr = expf(s - m) * il;
      imp[j >> 2] += pr; if (j + 1 < ncmp) imp[(j + 1) >> 2] += pr; } }
}
HD_ void ph_a_topk(const Params& p, long gid) {
  int q = (int)(gid >> 1); float* imp = p.imp + gid * 256; int* idx = p.idx + gid * 16; int cur = q >> 6;
  imp[0] = 1e4f; imp[cur] = 1e4f;
  for (int k = 0; k < 16; ++k) { int best = -1; float bv = -1.f;
    for (int b = 0; b <= cur; ++b) { float v = imp[b]; if (v > bv) { bv = v; best = b; } }
    idx[k] = best; if (best >= 0) imp[best] = -2.f; }
}
HD_ void ph_a_win(const Params& p, long gid) {
  int h = (int)(gid & 7), q = (int)(gid >> 3), hk = h >> 2;
  float qv[64], o[64]; for (int d = 0; d < 64; ++d) { qv[d] = ldf(&p.proj[(long)q * NPROJ + PA_Q + h * 64 + d]); o[d] = 0.f; }
  float m = -1e30f, l = 0.f; int lo = q - 511 < 0 ? 0 : q - 511;
  for (int t = lo; t <= q; ++t) { const SB* kr = &p.proj[(long)t * NPROJ + PA_KV + 4 * 128 + hk * 64]; const SB* vr = kr + 128;
    float s = 0.f; for (int d = 0; d < 64; ++d) s += qv[d] * ldf(&kr[d]); s = s * 0.125f + p.tabA[h * TABA_N + (q - t)];
    float mn = fmaxf(m, s), a = expf(m - mn), pr = expf(s - mn); l = l * a + pr; for (int d = 0; d < 64; ++d) o[d] = o[d] * a + pr * ldf(&vr[d]); m = mn; }
  float il = 1.f / l; for (int d = 0; d < 64; ++d) stf(&p.ow[(long)q * 512 + h * 64 + d], o[d] * il);
}
HD_ void ph_a_sel(const Params& p, long gid) {
  int h = (int)(gid & 7), q = (int)(gid >> 3), hk = h >> 2; const int* idx = p.idx + ((long)q * 2 + hk) * 16;
  float qv[64], o[64]; for (int d = 0; d < 64; ++d) { qv[d] = ldf(&p.proj[(long)q * NPROJ + PA_Q + h * 64 + d]); o[d] = 0.f; }
  float m = -1e30f, l = 0.f;
  for (int k = 0; k < 16; ++k) { int b = idx[k]; if (b < 0) continue;
    for (int i = 0; i < 64; ++i) { int t = b * 64 + i; if (t > q) break;
      const SB* kr = &p.proj[(long)t * NPROJ + PA_KV + 2 * 128 + hk * 64]; const SB* vr = kr + 128;
      float s = 0.f; for (int d = 0; d < 64; ++d) s += qv[d] * ldf(&kr[d]); int dist = q - t; s = s * 0.125f + p.tabA[h * TABA_N + (dist < TABA_N ? dist : TABA_N - 1)];
      float mn = fmaxf(m, s), a = expf(m - mn), pr = expf(s - mn); l = l * a + pr; for (int d = 0; d < 64; ++d) o[d] = o[d] * a + pr * ldf(&vr[d]); m = mn; } }
  float il = 1.f / l; const float* gl = p.small + (long)q * NSMALL + h * 3;
  float g0 = sigmoid_f(gl[0]), g1 = sigmoid_f(gl[1]), g2 = sigmoid_f(gl[2]);
  for (int d = 0; d < 64; ++d) { long c = (long)q * 512 + h * 64 + d; float a = g0 * ldf(&p.oc[c]) + g1 * o[d] * il + g2 * ldf(&p.ow[c]);
    SB* mp = &p.mix[(long)q * NMIX + MX_A + h * 64 + d]; stf(mp, a * ldf(mp)); }
}
HD_ void ph_c(const Params& p, int layer, long gid) {
  int h = (int)(gid & 7), q = (int)(gid >> 3), hk = h >> 2;
  float qv[64], o[64]; for (int d = 0; d < 64; ++d) { qv[d] = ldf(&p.proj[(long)q * NPROJ + PC_Q + h * 64 + d]); o[d] = 0.f; }
  float m = p.sinks[layer * 8 + h], l = 1.f; int lo = q - 127 < 0 ? 0 : q - 127;
  for (int t = lo; t <= q; ++t) { const SB* kr = &p.proj[(long)t * NPROJ + PC_KV + hk * 64]; const SB* vr = kr + 128;
    float s = 0.f; for (int d = 0; d < 64; ++d) s += qv[d] * ldf(&kr[d]); s *= 0.125f;
    float mn = fmaxf(m, s), a = expf(m - mn), pr = expf(s - mn); l = l * a + pr; for (int d = 0; d < 64; ++d) o[d] = o[d] * a + pr * ldf(&vr[d]); m = mn; }
  float il = 1.f / l; for (int d = 0; d < 64; ++d) { SB* mp = &p.mix[(long)q * NMIX + MX_C + h * 64 + d]; stf(mp, o[d] * il * ldf(mp)); }
}
HD_ void ph_d(const Params& p, long gid) {
  int h = (int)(gid & 7); long r = gid >> 3; int q = (int)(r % p.S), gi = (int)(r / p.S); int dil = gi == 0 ? 1 : (gi == 1 ? 4 : 16);
  float qv[64], o[64]; for (int d = 0; d < 64; ++d) { qv[d] = ldf(&p.proj[(long)q * NPROJ + PD_Q + gi * 512 + h * 64 + d]); o[d] = 0.f; }
  float m = -1e30f, l = 0.f;
  for (int dd = 0; dd <= 128; ++dd) { int t = q - dil * dd; if (t < 0) break;
    const SB* kr = &p.proj[(long)t * NPROJ + PD_KV + h * 64]; const SB* vr = kr + 512;
    float s = 0.f; for (int d = 0; d < 64; ++d) s += qv[d] * ldf(&kr[d]); s = s * 0.125f + p.tabD[(gi * 8 + h) * TABD_N + dd];
    float mn = fmaxf(m, s), a = expf(m - mn), pr = expf(s - mn); l = l * a + pr; for (int d = 0; d < 64; ++d) o[d] = o[d] * a + pr * ldf(&vr[d]); m = mn; }
  float il = 1.f / l; for (int d = 0; d < 64; ++d) stf(&p.dop[((long)gi * p.S + q) * 512 + h * 64 + d], o[d] * il);
  p.dlse[((long)gi * p.S + q) * 8 + h] = m + logf(l);
}
HD_ void ph_d_merge(const Params& p, long gid) {
  int h = (int)(gid & 7), q = (int)(gid >> 3);
  float l0 = p.dlse[((long)0 * p.S + q) * 8 + h], l1 = p.dlse[((long)1 * p.S + q) * 8 + h], l2 = p.dlse[((long)2 * p.S + q) * 8 + h];
  float mm = fmaxf(l0, fmaxf(l1, l2)); float e0 = expf(l0 - mm), e1 = expf(l1 - mm), e2 = expf(l2 - mm), is = 1.f / (e0 + e1 + e2);
  for (int d = 0; d < 64; ++d) { long c = (long)q * 512 + h * 64 + d;
    float v = (e0 * ldf(&p.dop[c]) + e1 * ldf(&p.dop[(long)p.S * 512 + c]) + e2 * ldf(&p.dop[(long)2 * p.S * 512 + c])) * is;
    SB* mp = &p.mix[(long)q * NMIX + MX_D + h * 64 + d]; stf(mp, v * ldf(mp)); }
}
HD_ void ph_m(const Params& p, int layer, long gid) {
  int h = (int)(gid & 3), q = (int)(gid >> 2);
  float qv[64], o[64]; for (int d = 0; d < 64; ++d) { qv[d] = ldf(&p.proj[(long)q * NPROJ + PM_Q + h * 64 + d]); o[d] = 0.f; }
  float m = -1e30f, l = 0.f; const SB* kvb = p.memkv + (long)layer * 256 * 512;
  for (int t = 0; t < 256; ++t) { const SB* kr = kvb + (long)t * 512 + h * 64; const SB* vr = kr + 256;
    float s = 0.f; for (int d = 0; d < 64; ++d) s += qv[d] * ldf(&kr[d]); s *= 0.125f;
    float mn = fmaxf(m, s), a = expf(m - mn), pr = expf(s - mn); l = l * a + pr; for (int d = 0; d < 64; ++d) o[d] = o[d] * a + pr * ldf(&vr[d]); m = mn; }
  float il = 1.f / l; for (int d = 0; d < 64; ++d) { SB* mp = &p.mix[(long)q * NMIX + MX_M + h * 64 + d]; stf(mp, o[d] * il * ldf(mp)); }
}
HD_ void ph_b_conv(const Params& p, int layer, long gid) {
  int c = (int)(gid & 1023), t = (int)(gid >> 10); const float* w = p.conv_w + (long)layer * 4 * 1024;
  float acc = p.conv_b[layer * 1024 + c];
  for (int i = 0; i < 4; ++i) { int tt = t - 3 + i; if (tt >= 0) acc += w[i * 1024 + c] * ldf(&p.proj[(long)tt * NPROJ + PB_X + c]); }
  stf(&p.xconv[gid], silu_f(acc));
}
HD_ void ph_b_dt(const Params& p, int layer, long gid) {
  int hd = (int)(gid & 7), c = (int)(gid >> 3); float a = -expf(p.a_log[layer * 8 + hd]); float cs = 0.f;
  for (int l = 0; l < 128; ++l) { int t = c * 128 + l; float dt = softplus_f(p.small[(long)t * NSMALL + 24 + hd] + p.dt_bias[layer * 8 + hd]);
    cs += dt * a; p.dt[(long)t * 8 + hd] = dt; p.acs[(long)t * 8 + hd] = cs; }
}
HD_ void ph_b_cb(const Params& p, long gid) {
  int s = (int)(gid & 127), l = (int)((gid >> 7) & 127), g = (int)((gid >> 14) & 1), c = (int)(gid >> 15);
  if (s > l) { p.cb[gid] = 0.f; return; }
  const SB* cm = &p.xconv[(long)(c * 128 + l) * 1024 + 768 + g * 128]; const SB* bm = &p.xconv[(long)(c * 128 + s) * 1024 + 512 + g * 128];
  float acc = 0.f; for (int n = 0; n < 128; ++n) acc += ldf(&cm[n]) * ldf(&bm[n]);
  p.cb[gid] = acc;
}
HD_ void ph_b_states(const Params& p, long gid) {
  int n = (int)(gid & 127), pp = (int)((gid >> 7) & 63), hd = (int)((gid >> 13) & 7), c = (int)(gid >> 16), g = hd >> 2;
  float last = p.acs[(long)(c * 128 + 127) * 8 + hd]; float acc = 0.f;
  for (int l = 0; l < 128; ++l) { long t = c * 128 + l;
    acc += ldf(&p.xconv[t * 1024 + 512 + g * 128 + n]) * expf(last - p.acs[t * 8 + hd]) * ldf(&p.xconv[t * 1024 + hd * 64 + pp]) * p.dt[t * 8 + hd]; }
  p.states[gid] = acc;
}
HD_ void ph_b_scan(const Params& p, long gid) {
  int hd = (int)(gid >> 13); int nc = p.S / 128; float h = 0.f;
  for (int c0 = 0; c0 < nc; c0 += 8) { float st[8], dc[8];
    for (int i = 0; i < 8; ++i) { st[i] = p.states[(long)(c0 + i) * 65536 + gid]; dc[i] = p.acs[(long)((c0 + i) * 128 + 127) * 8 + hd]; }
    for (int i = 0; i < 8; ++i) { p.states[(long)(c0 + i) * 65536 + gid] = h; h = h * expf(dc[i]) + st[i]; } }
}
HD_ void ph_b_out(const Params& p, int layer, long gid) {
  int pp = (int)(gid & 63), hd = (int)((gid >> 6) & 7), t = (int)(gid >> 9), g = hd >> 2, c = t >> 7, l = t & 127;
  float al = p.acs[(long)t * 8 + hd]; float acc = 0.f;
  const float* cbr = &p.cb[(((long)c * 2 + g) * 128 + l) * 128];
  for (int s = 0; s <= l; ++s) { long ts = c * 128 + s; acc += cbr[s] * expf(al - p.acs[ts * 8 + hd]) * ldf(&p.xconv[ts * 1024 + hd * 64 + pp]) * p.dt[ts * 8 + hd]; }
  float acc2 = 0.f; const float* pr = &p.states[(long)c * 65536 + ((long)hd * 64 + pp) * 128]; const SB* cm = &p.xconv[(long)t * 1024 + 768 + g * 128];
  for (int n = 0; n < 128; ++n) acc2 += ldf(&cm[n]) * pr[n];
  p.ybuf[gid] = acc + expf(al) * acc2 + ldf(&p.xconv[(long)t * 1024 + hd * 64 + pp]) * p.b_d[layer * 8 + hd];
}
HD_ void ph_b_norm(const Params& p, int layer, long gid) {
  int g = (int)(gid & 1), t = (int)(gid >> 1); float ss = 0.f;
  for (int i = 0; i < 256; ++i) { float v = p.ybuf[(long)t * 512 + g * 256 + i] * ldf(&p.mix[(long)t * NMIX + MX_B + g * 256 + i]); ss += v * v; }
  float r = 1.f / sqrtf(ss / 256.f + 1e-6f);
  for (int i = 0; i < 256; ++i) { SB* mp = &p.mix[(long)t * NMIX + MX_B + g * 256 + i]; float v = p.ybuf[(long)t * 512 + g * 256 + i] * ldf(mp);
    stf(mp, v * r * p.b_norm[layer * 512 + g * 256 + i]); }
}

HD_ void ph_b_dt2(const Params& p, int layer, long gid) {
  int hd = (int)(gid & 7), c = (int)(gid >> 3); float a = -expf(p.a_log[layer * 8 + hd]); float cs = 0.f;
  for (int l = 0; l < 128; ++l) { int t = c * 128 + l; float dt = softplus_f(p.small[(long)t * NSMALL + 24 + hd] + p.dt_bias[layer * 8 + hd]);
    cs += dt * a; p.dt[(long)t * 8 + hd] = dt; p.acs[(long)t * 8 + hd] = cs; }
  for (int l = 0; l < 128; ++l) { long t = c * 128 + l; p.wst[t * 8 + hd] = p.dt[t * 8 + hd] * expf(cs - p.acs[t * 8 + hd]); }
}
HD_ void ph_b_states2(const Params& p, long gid) {
  int pp = (int)(gid & 63), n = (int)((gid >> 6) & 127), hd = (int)((gid >> 13) & 7), c = (int)(gid >> 16), g = hd >> 2;
  float acc = 0.f;
  _Pragma("unroll 16") for (int l = 0; l < 128; ++l) { long t = c * 128 + l; acc += ldf(&p.xconv[t * 1024 + 512 + g * 128 + n]) * p.wst[t * 8 + hd] * ldf(&p.xconv[t * 1024 + hd * 64 + pp]); }
  p.states[gid] = acc;
}
HD_ void ph_b_out2(const Params& p, int layer, long gid) {
  int pp = (int)(gid & 63), hd = (int)((gid >> 6) & 7), t = (int)(gid >> 9), g = hd >> 2, c = t >> 7, l = t & 127;
  float al = p.acs[(long)t * 8 + hd]; float acc = 0.f;
  const float* cbr = &p.cb[(((long)c * 2 + g) * 128 + l) * 128];
  _Pragma("unroll 8") for (int s = 0; s <= l; ++s) { long ts = c * 128 + s; acc += cbr[s] * expf(al - p.acs[ts * 8 + hd]) * p.dt[ts * 8 + hd] * ldf(&p.xconv[ts * 1024 + hd * 64 + pp]); }
  float acc2 = 0.f; const float* pr = &p.states[(long)c * 65536 + (long)hd * 8192 + pp]; const SB* cm = &p.xconv[(long)t * 1024 + 768 + g * 128];
  _Pragma("unroll 16") for (int n = 0; n < 128; ++n) acc2 += ldf(&cm[n]) * pr[n * 64];
  p.ybuf[gid] = acc + expf(al) * acc2 + ldf(&p.xconv[(long)t * 1024 + hd * 64 + pp]) * p.b_d[layer * 8 + hd];
}

typedef __attribute__((ext_vector_type(8))) short bf16x8;
typedef __attribute__((ext_vector_type(16))) float f32x16;
typedef short v4i16_t __attribute__((ext_vector_type(4)));
typedef __bf16 bf2_t __attribute__((ext_vector_type(2)));
typedef float f2_t __attribute__((ext_vector_type(2)));
typedef unsigned u32x4 __attribute__((ext_vector_type(4)));
#define LDS3 __attribute__((address_space(3)))
#define GLB1 __attribute__((address_space(1)))
typedef __attribute__((address_space(1))) const void* gptr_t;
typedef __attribute__((address_space(3))) void* lptr_t;
#define L2E 1.4426950408889634f
#define LN2 0.6931471805599453f
#define QSC (0.125f * L2E)
#ifndef FTHR
#define FTHR 8.0f
#endif
#define NINF (-__builtin_huge_valf())
__device__ __forceinline__ float sigmoid_fast(float x) { return __builtin_amdgcn_rcpf(1.f + __builtin_amdgcn_exp2f(-x * L2E)); }
__device__ __forceinline__ float silu_fast(float x) { return x * sigmoid_fast(x); }
__device__ __forceinline__ float gelu_fast(float x) { const float u = 0.7978845608028654f * (x + 0.044715f * x * x * x); const float th = 1.f - 2.f * __builtin_amdgcn_rcpf(1.f + __builtin_amdgcn_exp2f(2.f * L2E * u)); return 0.5f * x * (1.f + th); }

struct WaveLds { unsigned short v[4096]; float tab[640]; float xch[32]; float pad[32]; };

__device__ __forceinline__ unsigned pk2(float a, float b) { f2_t v = {a, b}; bf2_t r = __builtin_convertvector(v, bf2_t); return __builtin_bit_cast(unsigned, r); }
__device__ __forceinline__ int crow(int e, int hi) { return (e & 3) + 8 * (e >> 2) + 4 * hi; }
__device__ __forceinline__ bf16x8 pack8(const f32x16& s, int o) {
  u32x4 r; r[0] = pk2(s[o], s[o + 1]); r[1] = pk2(s[o + 2], s[o + 3]); r[2] = pk2(s[o + 4], s[o + 5]); r[3] = pk2(s[o + 6], s[o + 7]); return __builtin_bit_cast(bf16x8, r); }
__device__ __forceinline__ f32x16 zero16() { f32x16 z;
#pragma unroll
  for (int e = 0; e < 16; ++e) z[e] = 0.f; return z; }
#define MFMA32(a, b, c) __builtin_amdgcn_mfma_f32_32x32x16_bf16((a), (b), (c), 0, 0, 0)

__device__ __forceinline__ float xor32_f(float v) { const auto rr = __builtin_amdgcn_permlane32_swap(__float_as_uint(v), __float_as_uint(v), false, false); const int hi_ = (int)(threadIdx.x & 32u); return __uint_as_float(hi_ ? rr[0] : rr[1]); }
struct FlashState { f32x16 o0, o1; float m, l; };
__device__ __forceinline__ float wave_sum_f(float v) {
#pragma unroll
  for (int o = 32; o > 0; o >>= 1) v += __shfl_xor(v, o);
  return v; }

__device__ __forceinline__ void flash_core1(FlashState& st, f32x16& s, const unsigned short* vimg, float* xch, int lane) {
  const int r32 = lane & 31, hi = lane >> 5;
  float mx = s[0];
#pragma unroll
  for (int e = 1; e < 16; ++e) mx = fmaxf(mx, s[e]);
  mx = fmaxf(mx, xor32_f(mx));
  if (__any(mx > st.m + FTHR)) {
    const float mn = fmaxf(st.m, mx); const float al = __builtin_amdgcn_exp2f(st.m - mn); st.m = mn; st.l *= al; xch[r32] = al;
#pragma unroll
    for (int e = 0; e < 16; ++e) { const float a = xch[crow(e, hi)]; st.o0[e] *= a; st.o1[e] *= a; }
  }
  float ps = 0.f;
#pragma unroll
  for (int e = 0; e < 16; ++e) { s[e] = __builtin_amdgcn_exp2f(s[e] - st.m); ps += s[e]; }
  st.l += ps;
  const bf16x8 pa0 = pack8(s, 0), pa1 = pack8(s, 8);
  const unsigned short* vb = vimg + (4 * hi + ((lane & 15) >> 2)) * 32 + ((lane >> 4) & 1) * 16 + (lane & 3) * 4;
#pragma unroll
  for (int s2 = 0; s2 < 2; ++s2) {
#pragma unroll
    for (int db = 0; db < 2; ++db) {
      const v4i16_t lo = __builtin_amdgcn_ds_read_tr16_b64_v4i16((LDS3 v4i16_t*)(vb + db * 2048 + s2 * 512));
      const v4i16_t hh = __builtin_amdgcn_ds_read_tr16_b64_v4i16((LDS3 v4i16_t*)(vb + db * 2048 + s2 * 512 + 256));
      const bf16x8 vf = {lo[0], lo[1], lo[2], lo[3], hh[0], hh[1], hh[2], hh[3]};
      if (db == 0) st.o0 = MFMA32(s2 ? pa1 : pa0, vf, st.o0); else st.o1 = MFMA32(s2 ? pa1 : pa0, vf, st.o1);
    }
  }
}
__device__ __forceinline__ void flash_core1_lin(FlashState& st, f32x16& s, float qs, float bb, const unsigned short* vimg, float* xch, int lane) {
  const int r32 = lane & 31, hi = lane >> 5;
  float mr = s[0];
#pragma unroll
  for (int e = 1; e < 16; ++e) mr = fmaxf(mr, s[e]);
  float mx = __builtin_fmaf(mr, qs, bb);
  mx = fmaxf(mx, xor32_f(mx));
  if (__any(mx > st.m + FTHR)) {
    const float mn = fmaxf(st.m, mx); const float al = __builtin_amdgcn_exp2f(st.m - mn); st.m = mn; st.l *= al; xch[r32] = al;
#pragma unroll
    for (int e = 0; e < 16; ++e) { const float a = xch[crow(e, hi)]; st.o0[e] *= a; st.o1[e] *= a; }
  }
  const float bm = bb - st.m; float ps = 0.f;
#pragma unroll
  for (int e = 0; e < 16; ++e) { s[e] = __builtin_amdgcn_exp2f(__builtin_fmaf(s[e], qs, bm)); ps += s[e]; }
  st.l += ps;
  const bf16x8 pa0 = pack8(s, 0), pa1 = pack8(s, 8);
  const unsigned short* vb = vimg + (4 * hi + ((lane & 15) >> 2)) * 32 + ((lane >> 4) & 1) * 16 + (lane & 3) * 4;
#pragma unroll
  for (int s2 = 0; s2 < 2; ++s2) {
#pragma unroll
    for (int db = 0; db < 2; ++db) {
      const v4i16_t lo = __builtin_amdgcn_ds_read_tr16_b64_v4i16((LDS3 v4i16_t*)(vb + db * 2048 + s2 * 512));
      const v4i16_t hh = __builtin_amdgcn_ds_read_tr16_b64_v4i16((LDS3 v4i16_t*)(vb + db * 2048 + s2 * 512 + 256));
      const bf16x8 vf = {lo[0], lo[1], lo[2], lo[3], hh[0], hh[1], hh[2], hh[3]};
      if (db == 0) st.o0 = MFMA32(s2 ? pa1 : pa0, vf, st.o0); else st.o1 = MFMA32(s2 ? pa1 : pa0, vf, st.o1);
    }
  }
}
template <class VRow, class Fix>
__device__ __forceinline__ void flash_tile(FlashState& st, const bf16x8 (&qf)[4], const SB* kp, VRow vrow, Fix fix, WaveLds* L, int lane) {
  const int r32 = lane & 31, hi = lane >> 5;
  bf16x8 kf[4];
#pragma unroll
  for (int d0 = 0; d0 < 4; ++d0) kf[d0] = *(const bf16x8*)(kp + d0 * 16 + hi * 8);
#pragma unroll
  for (int i = 0; i < 4; ++i) { const int c = lane + 64 * i, key = c >> 3, ch = c & 7; const SB* vp = vrow(key); const uint4 vv = *(const uint4*)(vp + ch * 8);
    *(uint4*)&L->v[(ch >> 2) * 2048 + key * 32 + (ch & 3) * 8] = vv; }
  f32x16 s = zero16();
#pragma unroll
  for (int d0 = 0; d0 < 4; ++d0) s = MFMA32(kf[d0], qf[d0], s);
  fix(s);
  flash_core1(st, s, L->v, L->xch, lane);
}
__device__ __forceinline__ void flash_core2(FlashState& st, f32x16& s0, f32x16& s1, const unsigned short* vimg, float* xch, int lane) {
  const int r32 = lane & 31, hi = lane >> 5;
  float mx = fmaxf(s0[0], s1[0]);
#pragma unroll
  for (int e = 1; e < 16; ++e) mx = fmaxf(mx, fmaxf(s0[e], s1[e]));
  mx = fmaxf(mx, xor32_f(mx));
  if (__any(mx > st.m + FTHR)) {
    const float mn = fmaxf(st.m, mx); const float al = __builtin_amdgcn_exp2f(st.m - mn); st.m = mn; st.l *= al; xch[r32] = al;
#pragma unroll
    for (int e = 0; e < 16; ++e) { const float a = xch[crow(e, hi)]; st.o0[e] *= a; st.o1[e] *= a; }
  }
  float ps = 0.f;
#pragma unroll
  for (int e = 0; e < 16; ++e) { s0[e] = __builtin_amdgcn_exp2f(s0[e] - st.m); s1[e] = __builtin_amdgcn_exp2f(s1[e] - st.m); ps += s0[e] + s1[e]; }
  st.l += ps;
  bf16x8 pa[4]; pa[0] = pack8(s0, 0); pa[1] = pack8(s0, 8); pa[2] = pack8(s1, 0); pa[3] = pack8(s1, 8);
  const unsigned short* vb = vimg + (4 * hi + ((lane & 15) >> 2)) * 32 + ((lane >> 4) & 1) * 16 + (lane & 3) * 4;
#pragma unroll
  for (int kk = 0; kk < 4; ++kk) {
#pragma unroll
    for (int db = 0; db < 2; ++db) {
      const v4i16_t lo = __builtin_amdgcn_ds_read_tr16_b64_v4i16((LDS3 v4i16_t*)(vb + db * 2048 + kk * 512));
      const v4i16_t hh = __builtin_amdgcn_ds_read_tr16_b64_v4i16((LDS3 v4i16_t*)(vb + db * 2048 + kk * 512 + 256));
      const bf16x8 vf = {lo[0], lo[1], lo[2], lo[3], hh[0], hh[1], hh[2], hh[3]};
      if (db == 0) st.o0 = MFMA32(pa[kk], vf, st.o0); else st.o1 = MFMA32(pa[kk], vf, st.o1);
    }
  }
}
__device__ __forceinline__ void flash_core2_lin(FlashState& st, f32x16& s0, f32x16& s1, float qs, float bb, const unsigned short* vimg, float* xch, int lane) {
  const int r32 = lane & 31, hi = lane >> 5;
  float mr = fmaxf(s0[0], s1[0]);
#pragma unroll
  for (int e = 1; e < 16; ++e) mr = fmaxf(mr, fmaxf(s0[e], s1[e]));
  float mx = __builtin_fmaf(mr, qs, bb);
  mx = fmaxf(mx, xor32_f(mx));
  if (__any(mx > st.m + FTHR)) {
    const float mn = fmaxf(st.m, mx); const float al = __builtin_amdgcn_exp2f(st.m - mn); st.m = mn; st.l *= al; xch[r32] = al;
#pragma unroll
    for (int e = 0; e < 16; ++e) { const float a = xch[crow(e, hi)]; st.o0[e] *= a; st.o1[e] *= a; }
  }
  const float bm = bb - st.m; float ps = 0.f;
#pragma unroll
  for (int e = 0; e < 16; ++e) { s0[e] = __builtin_amdgcn_exp2f(__builtin_fmaf(s0[e], qs, bm)); s1[e] = __builtin_amdgcn_exp2f(__builtin_fmaf(s1[e], qs, bm)); ps += s0[e] + s1[e]; }
  st.l += ps;
  bf16x8 pa[4]; pa[0] = pack8(s0, 0); pa[1] = pack8(s0, 8); pa[2] = pack8(s1, 0); pa[3] = pack8(s1, 8);
  const unsigned short* vb = vimg + (4 * hi + ((lane & 15) >> 2)) * 32 + ((lane >> 4) & 1) * 16 + (lane & 3) * 4;
#pragma unroll
  for (int kk = 0; kk < 4; ++kk) {
#pragma unroll
    for (int db = 0; db < 2; ++db) {
      const v4i16_t lo = __builtin_amdgcn_ds_read_tr16_b64_v4i16((LDS3 v4i16_t*)(vb + db * 2048 + kk * 512));
      const v4i16_t hh = __builtin_amdgcn_ds_read_tr16_b64_v4i16((LDS3 v4i16_t*)(vb + db * 2048 + kk * 512 + 256));
      const bf16x8 vf = {lo[0], lo[1], lo[2], lo[3], hh[0], hh[1], hh[2], hh[3]};
      if (db == 0) st.o0 = MFMA32(pa[kk], vf, st.o0); else st.o1 = MFMA32(pa[kk], vf, st.o1);
    }
  }
}
#ifndef FT2
#define FT2 1
#endif
template <class VRow, class Fix0, class Fix1>
__device__ __forceinline__ void flash_tile2(FlashState& st, const bf16x8 (&qf)[4], const SB* kp0, const SB* kp1, VRow vrow, Fix0 fix0, Fix1 fix1, WaveLds* L, int lane) {
  if (!FT2) { flash_tile(st, qf, kp0, [&](int key) { return vrow(key); }, fix0, L, lane); flash_tile(st, qf, kp1, [&](int key) { return vrow(key + 32); }, fix1, L, lane); return; }
  const int hi = lane >> 5;
  bf16x8 kf0[4], kf1[4];
#pragma unroll
  for (int d0 = 0; d0 < 4; ++d0) { kf0[d0] = *(const bf16x8*)(kp0 + d0 * 16 + hi * 8); kf1[d0] = *(const bf16x8*)(kp1 + d0 * 16 + hi * 8); }
#pragma unroll
  for (int i = 0; i < 8; ++i) { const int c = lane + 64 * i, key = c >> 3, ch = c & 7; const SB* vp = vrow(key); const uint4 vv = *(const uint4*)(vp + ch * 8);
    *(uint4*)&L->v[(ch >> 2) * 2048 + key * 32 + (ch & 3) * 8] = vv; }
  f32x16 s0 = zero16(), s1 = zero16();
#pragma unroll
  for (int d0 = 0; d0 < 4; ++d0) { s0 = MFMA32(kf0[d0], qf[d0], s0); s1 = MFMA32(kf1[d0], qf[d0], s1); }
  fix0(s0); fix1(s1);
  flash_core2(st, s0, s1, L->v, L->xch, lane);
}
template <class KPtr, class VRow, class Fix>
__device__ __forceinline__ void flash_run(FlashState& st, const bf16x8 (&qf)[4], int t0, int t1, KPtr kptr, VRow vrow, Fix fix, WaveLds* L, int lane) {
  if (t0 >= t1) return;
  const int hi = lane >> 5; bf16x8 kfn[4];
#define FR_ISSUE(tt) { const int t_ = (tt); _Pragma("unroll") for (int i_ = 0; i_ < 4; ++i_) { const int db_ = i_ >> 1, key_ = (i_ & 1) * 16 + (lane >> 2), wi_ = lane & 3; \
      __builtin_amdgcn_global_load_lds((gptr_t)(vrow(t_, key_) + db_ * 32 + wi_ * 8), (lptr_t)&L->v[db_ * 2048 + (t_ & 1) * 1024 + (i_ & 1) * 512], 16, 0, 0); } \
    const SB* kp_ = kptr(t_); _Pragma("unroll") for (int d0_ = 0; d0_ < 4; ++d0_) kfn[d0_] = *(const GLB1 bf16x8*)(kp_ + d0_ * 16 + hi * 8); }
  FR_ISSUE(t0)
  for (int t = t0; t < t1; ++t) {
    asm volatile("s_waitcnt vmcnt(0)" ::: "memory");
    bf16x8 kf[4];
#pragma unroll
    for (int d0 = 0; d0 < 4; ++d0) kf[d0] = kfn[d0];
    if (t + 1 < t1) FR_ISSUE(t + 1)
    f32x16 s = zero16();
#pragma unroll
    for (int d0 = 0; d0 < 4; ++d0) s = MFMA32(kf[d0], qf[d0], s);
    fix(t, s);
    flash_core1(st, s, L->v + (t & 1) * 1024, L->xch, lane);
  }
#undef FR_ISSUE
}
__device__ __forceinline__ float flash_finish(FlashState& st, WaveLds* L, int lane) {
  const int r32 = lane & 31, hi = lane >> 5;
  const float lt = st.l + xor32_f(st.l); const float inv = lt > 0.f ? 1.f / lt : 0.f;
  L->xch[r32] = inv;
#pragma unroll
  for (int e = 0; e < 16; ++e) { const float a = L->xch[crow(e, hi)]; st.o0[e] *= a; st.o1[e] *= a; }
  return (st.m + __builtin_amdgcn_logf(lt)) * LN2;
}
__device__ __forceinline__ void load_q(bf16x8 (&qf)[4], const SB* qp, int hi) {
#pragma unroll
  for (int d0 = 0; d0 < 4; ++d0) qf[d0] = *(const GLB1 bf16x8*)(qp + d0 * 16 + hi * 8);
}
__device__ __forceinline__ void fix_tab(f32x16& s, const WaveLds* L, int base, int lane, bool chk, int kb) {
  const int r32 = lane & 31, hi = lane >> 5; const float* tp = L->tab + base + r32 + 32 - 4 * hi;
#pragma unroll
  for (int e = 0; e < 16; ++e) { const int kk = (e & 3) + 8 * (e >> 2); float v = s[e] * QSC + tp[-kk]; if (chk && (kb + kk + 4 * hi < 0)) v = NINF; s[e] = v; }
}

__device__ __forceinline__ void unit_c(const Params& p, int layer, int u, WaveLds* L, int lane) {
  const int h = u & 7, qt = u >> 3, q0 = qt * 32, hk = h >> 2, r32 = lane & 31, hi = lane >> 5;
  for (int x = lane; x < 192; x += 64) { const int dist = x - 32; L->tab[x] = (dist >= 0 && dist <= 127) ? 0.f : NINF; }
  bf16x8 qf[4]; load_q(qf, p.proj + (long)(q0 + r32) * NPROJ + PC_Q + h * 64, hi);
  FlashState st; st.o0 = zero16(); st.o1 = zero16(); st.m = p.sinks[layer * 8 + h] * L2E; st.l = hi ? 0.f : 1.f;
  const SB* kvb = p.proj + PC_KV + hk * 64; const bool chk = q0 < 128;
  flash_run(st, qf, 0, 5, [&](int t) { int tok = q0 - 128 + 32 * t + r32; tok = tok < 0 ? 0 : tok; return kvb + (long)tok * NPROJ; },
            [&](int t, int key) { int tk = q0 - 128 + 32 * t + key; tk = tk < 0 ? 0 : tk; return kvb + 128 + (long)tk * NPROJ; },
            [&](int t, f32x16& s) { fix_tab(s, L, 128 - 32 * t, lane, chk, q0 - 128 + 32 * t); }, L, lane);
  flash_finish(st, L, lane);
  { SB m0[16], m1[16];
#pragma unroll
    for (int e = 0; e < 16; ++e) { const SB* mp = p.mix + (long)(q0 + crow(e, hi)) * NMIX + MX_C + h * 64 + r32; m0[e] = mp[0]; m1[e] = mp[32]; }
#pragma unroll
    for (int e = 0; e < 16; ++e) { SB* mp = p.mix + (long)(q0 + crow(e, hi)) * NMIX + MX_C + h * 64 + r32; mp[0] = f2bf(st.o0[e] * bf2f(m0[e])); mp[32] = f2bf(st.o1[e] * bf2f(m1[e])); } }
}
__device__ __forceinline__ void unit_m(const Params& p, int layer, int u, WaveLds* L, int lane) {
  const int h = u & 3, qt = u >> 2, q0 = qt * 32, r32 = lane & 31, hi = lane >> 5;
  bf16x8 qf[4]; load_q(qf, p.proj + (long)(q0 + r32) * NPROJ + PM_Q + h * 64, hi);
  FlashState st; st.o0 = zero16(); st.o1 = zero16(); st.m = -1e30f; st.l = 0.f;
  const SB* kb = p.memkv + (long)layer * 256 * 512 + h * 64;
  flash_run(st, qf, 0, 8, [&](int t) { return kb + (long)(32 * t + r32) * 512; }, [&](int t, int key) { return kb + 256 + (long)(32 * t + key) * 512; },
            [&](int, f32x16& s) {
#pragma unroll
              for (int e = 0; e < 16; ++e) s[e] *= QSC; }, L, lane);
  flash_finish(st, L, lane);
  { SB m0[16], m1[16];
#pragma unroll
    for (int e = 0; e < 16; ++e) { const SB* mp = p.mix + (long)(q0 + crow(e, hi)) * NMIX + MX_M + h * 64 + r32; m0[e] = mp[0]; m1[e] = mp[32]; }
#pragma unroll
    for (int e = 0; e < 16; ++e) { SB* mp = p.mix + (long)(q0 + crow(e, hi)) * NMIX + MX_M + h * 64 + r32; mp[0] = f2bf(st.o0[e] * bf2f(m0[e])); mp[32] = f2bf(st.o1[e] * bf2f(m1[e])); } }
}
__device__ __forceinline__ void unit_awin(const Params& p, int u, WaveLds* L, int lane) {
  const int h = u & 7, qt = u >> 3, q0 = qt * 32, hk = h >> 2, r32 = lane & 31, hi = lane >> 5;
  { float tv[10];
#pragma unroll
    for (int i = 0; i < 10; ++i) { const int dist = lane + 64 * i - 32; const int dc = dist < 0 ? 0 : (dist > 511 ? 511 : dist); tv[i] = p.tabA[h * TABA_N + dc]; }
#pragma unroll
    for (int i = 0; i < 10; ++i) { const int x = lane + 64 * i, dist = x - 32; if (x < 608) L->tab[x] = (dist >= 0 && dist <= 511) ? tv[i] * L2E : NINF; } }
  bf16x8 qf[4]; load_q(qf, p.proj + (long)(q0 + r32) * NPROJ + PA_Q + h * 64, hi);
  FlashState st; st.o0 = zero16(); st.o1 = zero16(); st.m = -1e30f; st.l = 0.f;
  const SB* kvb = p.proj + PA_KV + 4 * 128 + hk * 64; const bool chk = q0 < 512;
  { int tfirst = 0; if (q0 < 512) tfirst = (512 - q0) / 32 - 0; if (tfirst > 16) tfirst = 16; if (q0 < 512 && (q0 - 512 + 32 * tfirst + 31) < 0) ++tfirst;
    flash_run(st, qf, tfirst, 17, [&](int t) { int tok = q0 - 512 + 32 * t + r32; tok = tok < 0 ? 0 : tok; return kvb + (long)tok * NPROJ; },
              [&](int t, int key) { int tk = q0 - 512 + 32 * t + key; tk = tk < 0 ? 0 : tk; return kvb + 128 + (long)tk * NPROJ; },
              [&](int t, f32x16& s) { fix_tab(s, L, 512 - 32 * t, lane, chk, q0 - 512 + 32 * t); }, L, lane); }
  flash_finish(st, L, lane);
#pragma unroll
  for (int e = 0; e < 16; ++e) { SB* op = p.ow + (long)(q0 + crow(e, hi)) * 512 + h * 64 + r32; op[0] = f2bf(st.o0[e]); op[32] = f2bf(st.o1[e]); }
}
__device__ __forceinline__ void unit_d(const Params& p, int u, WaveLds* L, int lane) {
  const int S = p.S, per = (S / 32) * 8; const int gi = u / per, u2 = u % per; const int h = u2 & 7, v = u2 >> 3;
  const int dil = gi == 0 ? 1 : (gi == 1 ? 4 : 16); const int it = v / dil, r = v % dil, i0 = it * 32;
  const int r32 = lane & 31, hi = lane >> 5;
  { float tv[3];
#pragma unroll
    for (int i = 0; i < 3; ++i) { const int dd = lane + 64 * i - 32; const int dc = dd < 0 ? 0 : (dd > 128 ? 128 : dd); tv[i] = p.tabD[(gi * 8 + h) * TABD_N + dc]; }
#pragma unroll
    for (int i = 0; i < 3; ++i) { const int x = lane + 64 * i, dd = x - 32; L->tab[x] = (dd >= 0 && dd <= 128) ? tv[i] * L2E : NINF; } }
  bf16x8 qf[4]; load_q(qf, p.proj + (long)(r + dil * (i0 + r32)) * NPROJ + PD_Q + gi * 512 + h * 64, hi);
  FlashState st; st.o0 = zero16(); st.o1 = zero16(); st.m = -1e30f; st.l = 0.f;
  const SB* kvb = p.proj + PD_KV + h * 64; const bool chk = i0 < 128;
  flash_run(st, qf, 0, 5, [&](int t) { int j = i0 - 128 + 32 * t + r32; j = j < 0 ? 0 : j; return kvb + (long)(r + dil * j) * NPROJ; },
            [&](int t, int key) { int jj = i0 - 128 + 32 * t + key; jj = jj < 0 ? 0 : jj; return kvb + 512 + (long)(r + dil * jj) * NPROJ; },
            [&](int t, f32x16& s) { fix_tab(s, L, 128 - 32 * t, lane, chk, i0 - 128 + 32 * t); }, L, lane);
  const float lse = flash_finish(st, L, lane);
#pragma unroll
  for (int e = 0; e < 16; ++e) { const long tok = r + dil * (i0 + crow(e, hi)); SB* op = p.dop + ((long)gi * S + tok) * 512 + h * 64 + r32; op[0] = f2bf(st.o0[e]); op[32] = f2bf(st.o1[e]); }
  if (hi == 0) p.dlse[((long)gi * S + r + dil * (i0 + r32)) * 8 + h] = lse;
}
__device__ __forceinline__ void fix_cmp(f32x16& s, const float* tabh, float c31, int q0, int t, int lane) {
  const int r32 = lane & 31, hi = lane >> 5; const int dq = q0 + r32 - 31 - 16 * (32 * t + 4 * hi);
  const bool far = (q0 - 16 * (32 * t + 31) - 31) >= 1513;
  if (far) {
#pragma unroll
    for (int e = 0; e < 16; ++e) s[e] = __builtin_fmaf(s[e], QSC, c31);
  } else {
    float bv[16];
#pragma unroll
    for (int e = 0; e < 16; ++e) { const int dist = dq - 16 * ((e & 3) + 8 * (e >> 2)); const int dc = dist < 0 ? 0 : (dist > 2047 ? 2047 : dist); bv[e] = tabh[dc]; }
#if 1
#pragma unroll
    for (int e = 0; e < 16; e += 4) asm volatile("" : "+v"(bv[e]), "+v"(bv[e + 1]), "+v"(bv[e + 2]), "+v"(bv[e + 3]));
#endif
#pragma unroll
    for (int e = 0; e < 16; ++e) { const int dist = dq - 16 * ((e & 3) + 8 * (e >> 2)); s[e] = dist < 0 ? NINF : __builtin_fmaf(s[e], QSC, bv[e] * L2E); }
  }
}
__device__ __forceinline__ void unit_acmp1(const Params& p, int u, WaveLds* L, int lane) {
  const int h = u & 7, qt = (p.S / 32 - 1) - (u >> 3), q0 = qt * 32, g = h >> 2, r32 = lane & 31, hi = lane >> 5; const int ncmp = p.S / 16;
  bf16x8 qf[4]; load_q(qf, p.proj + (long)(q0 + r32) * NPROJ + PA_Q + h * 64, hi);
  FlashState st; st.o0 = zero16(); st.o1 = zero16(); st.m = -1e30f; st.l = 0.f;
  const int jn = q0 / 16 + 1, nt = (jn + 31) / 32; const SB* kc = p.kvc + g * 64; const SB* vc = p.kvc + (long)ncmp * 128 + g * 64;
  const float* tabh = p.tabA + h * TABA_N; const float c31 = tabh[2047] * L2E;
  flash_run(st, qf, 0, nt, [&](int t) { int j = 32 * t + r32; j = j >= ncmp ? ncmp - 1 : j; return kc + (long)j * 128; },
            [&](int t, int key) { int jj = 32 * t + key; jj = jj >= ncmp ? ncmp - 1 : jj; return vc + (long)jj * 128; },
            [&](int t, f32x16& s) { fix_cmp(s, tabh, c31, q0, t, lane); }, L, lane);
  const float lt = st.l + xor32_f(st.l); const float inv = lt > 0.f ? 1.f / lt : 0.f;
  flash_finish(st, L, lane);
#pragma unroll
  for (int e = 0; e < 16; ++e) { SB* op = p.oc + (long)(q0 + crow(e, hi)) * 512 + h * 64 + r32; op[0] = f2bf(st.o0[e]); op[32] = f2bf(st.o1[e]); }
  if (hi == 0) { p.cml[((long)(q0 + r32) * 8 + h) * 2] = st.m; p.cml[((long)(q0 + r32) * 8 + h) * 2 + 1] = inv; }
}
__device__ __forceinline__ void unit_acmp2(const Params& p, int u, int lane) {
  const int part = u & 3, g = (u >> 2) & 1, qt = (p.S / 32 - 1) - (u >> 3), q0 = qt * 32, r32 = lane & 31, hi = lane >> 5; const int ncmp = p.S / 16;
  const int jn = q0 / 16 + 1, nt = (jn + 31) / 32; const SB* kc = p.kvc + g * 64; float carry = 0.f;
  const int tper = (nt + 3) >> 2, tbeg = part * tper, tend = (tbeg + tper < nt) ? tbeg + tper : nt; if (tbeg >= nt) return;
  float* impq = p.imp + ((long)qt * 2 + g) * 256 * 32 + r32;
  const SB* qbase = p.proj + (long)(q0 + r32) * NPROJ + PA_Q + g * 256; const float* cmlq = p.cml + ((long)(q0 + r32) * 8 + g * 4) * 2;
  bf16x8 qc[4]; load_q(qc, qbase, hi); float mc = cmlq[0], ilc = cmlq[1], c31c = p.tabA[(g * 4) * TABA_N + 2047] * L2E;
  bf16x8 kfn[4]; { const int t = (tbeg > 0 ? tbeg - 1 : 0); int j = 32 * t + r32; j = j >= ncmp ? ncmp - 1 : j; const SB* kp = kc + (long)j * 128;
#pragma unroll
    for (int d0 = 0; d0 < 4; ++d0) kfn[d0] = *(const GLB1 bf16x8*)(kp + d0 * 16 + hi * 8); }
  for (int t = (tbeg > 0 ? tbeg - 1 : 0); t < tend; ++t) {
    bf16x8 kf[4];
#pragma unroll
    for (int d0 = 0; d0 < 4; ++d0) kf[d0] = kfn[d0];
    if (t + 1 < tend) { int j = 32 * (t + 1) + r32; j = j >= ncmp ? ncmp - 1 : j; const SB* kp = kc + (long)j * 128;
#pragma unroll
      for (int d0 = 0; d0 < 4; ++d0) kfn[d0] = *(const GLB1 bf16x8*)(kp + d0 * 16 + hi * 8); }
    float accA[4] = {0.f, 0.f, 0.f, 0.f}, accL[4] = {0.f, 0.f, 0.f, 0.f};
#pragma unroll 1
    for (int hh = 0; hh < 4; ++hh) { const int hn = (hh + 1) & 3;
      bf16x8 qn[4]; load_q(qn, qbase + hn * 64, hi); const float mn = cmlq[hn * 2], iln = cmlq[hn * 2 + 1], c31n = p.tabA[(g * 4 + hn) * TABA_N + 2047];
      f32x16 s = zero16();
#pragma unroll
      for (int d0 = 0; d0 < 4; ++d0) s = MFMA32(kf[d0], qc[d0], s);
      fix_cmp(s, p.tabA + (g * 4 + hh) * TABA_N, c31c, q0, t, lane);
#pragma unroll
      for (int e = 0; e < 16; ++e) { const float pr = __builtin_amdgcn_exp2f(s[e] - mc) * ilc; accA[e >> 2] += pr; if ((e & 3) == 3) accL[e >> 2] += pr; }
#pragma unroll
      for (int d0 = 0; d0 < 4; ++d0) qc[d0] = qn[d0];
      mc = mn; ilc = iln; c31c = c31n * L2E; }
    float oth[4];
#pragma unroll
    for (int eg = 0; eg < 4; ++eg) oth[eg] = xor32_f(accL[eg]);
#pragma unroll
    for (int eg = 0; eg < 4; ++eg) { const float prev = hi ? oth[eg] : (eg > 0 ? oth[eg > 0 ? eg - 1 : 0] : carry); if (t >= tbeg) impq[(8 * t + 2 * eg + hi) * 32] = 2.f * accA[eg] - accL[eg] + prev; }
    carry = oth[3]; }
}
#define DPP_F(v, ctrl, rm) __builtin_bit_cast(float, __builtin_amdgcn_update_dpp(__builtin_bit_cast(int, v), __builtin_bit_cast(int, v), ctrl, rm, 0xf, false))
#define DPP_I(v, ctrl, rm) __builtin_amdgcn_update_dpp(v, v, ctrl, rm, 0xf, false)
__device__ __forceinline__ float wave_max_f(float v) {
  v = fmaxf(v, DPP_F(v, 0xB1, 0xf)); v = fmaxf(v, DPP_F(v, 0x4E, 0xf)); v = fmaxf(v, DPP_F(v, 0x141, 0xf)); v = fmaxf(v, DPP_F(v, 0x140, 0xf));
  v = fmaxf(v, DPP_F(v, 0x142, 0xa)); v = fmaxf(v, DPP_F(v, 0x143, 0xc));
  return __builtin_bit_cast(float, __builtin_amdgcn_readlane(__builtin_bit_cast(int, v), 63)); }
__device__ __forceinline__ int imin_(int a, int b) { return a < b ? a : b; }
__device__ __forceinline__ int wave_min_i(int v) {
  v = imin_(v, DPP_I(v, 0xB1, 0xf)); v = imin_(v, DPP_I(v, 0x4E, 0xf)); v = imin_(v, DPP_I(v, 0x141, 0xf)); v = imin_(v, DPP_I(v, 0x140, 0xf));
  v = imin_(v, DPP_I(v, 0x142, 0xa)); v = imin_(v, DPP_I(v, 0x143, 0xc));
  return __builtin_amdgcn_readlane(v, 63); }
__device__ __forceinline__ void unit_topk(const Params& p, int u, int lane) {
  const int q = u >> 1, cur = q >> 6; const float* imp = p.imp + ((long)(q >> 5) * 2 + (u & 1)) * 256 * 32 + (q & 31); int* idx = p.idx + (long)u * 16;
  float v[4];
#pragma unroll
  for (int k = 0; k < 4; ++k) { const int b = lane + 64 * k; float x = (b <= cur) ? imp[b * 32] : -1.f; if (b == 0 || b == cur) x = 1e4f; v[k] = x; }
  int mine = -1;
  for (int k = 0; k < 16; ++k) {
    float lm = fmaxf(fmaxf(v[0], v[1]), fmaxf(v[2], v[3])); const float m = wave_max_f(lm);
    int cand = 0x7fffffff;
#pragma unroll
    for (int kk = 3; kk >= 0; --kk) if (v[kk] == m) cand = lane + 64 * kk;
    const int bsel = wave_min_i(cand);
#pragma unroll
    for (int kk = 0; kk < 4; ++kk) if (lane + 64 * kk == bsel) v[kk] = -2.f;
    if (lane == k) mine = (m >= 0.f) ? bsel : -1;
  }
  if (lane < 16) idx[lane] = mine;
}
template <bool STORE = true>
__device__ __forceinline__ void unit_asel(const Params& p, int u, WaveLds* L, int lane) {
  const int g = u & 1, q = u >> 1, r32 = lane & 31, hi = lane >> 5, hh = r32 & 3, h = g * 4 + hh;
  bf16x8 qf[4]; load_q(qf, p.proj + (long)q * NPROJ + PA_Q + h * 64, hi);
  FlashState st; st.o0 = zero16(); st.o1 = zero16(); st.m = -1e30f; st.l = 0.f;
  const int* idx = p.idx + (long)u * 16; const SB* kvb = p.proj + PA_KV + 2 * 128 + g * 64; const float c31 = p.tabA[h * TABA_N + 2047] * L2E;
  for (int k = 0; k < 16; ++k) { const int b = __builtin_amdgcn_readfirstlane(idx[k]); if (b < 0) continue;
    for (int kt = 0; kt < 2; ++kt) { const int t0 = b * 64 + kt * 32; if (t0 > q) continue;
      const bool far = (q - (t0 + 31)) >= 1513; const bool edge = (t0 + 31 > q);
      flash_tile(st, qf, kvb + (long)(t0 + r32) * NPROJ, [&](int key) { return kvb + 128 + (long)(t0 + key) * NPROJ; },
                 [&](f32x16& s) {
#pragma unroll
                   for (int e = 0; e < 16; ++e) { const int tk = t0 + (e & 3) + 8 * (e >> 2) + 4 * hi; const int dist = q - tk; float bsv;
                     if (far) bsv = c31; else { const int dc = dist < 0 ? 0 : (dist > 2047 ? 2047 : dist); bsv = p.tabA[h * TABA_N + dc] * L2E; }
                     float vv = s[e] * QSC + bsv; if (edge && dist < 0) vv = NINF; s[e] = vv; } }, L, lane); } }
  flash_finish(st, L, lane);
  if (!STORE) { asm volatile("" :: "v"(st.o0[0]), "v"(st.o1[3])); return; }
  if (hi == 0) {
#pragma unroll
    for (int e = 0; e < 4; ++e) { const int he = g * 4 + e; const float* gl = p.small + (long)q * NSMALL + he * 3;
      const float g0 = sigmoid_fast(gl[0]), g1 = sigmoid_fast(gl[1]), g2 = sigmoid_fast(gl[2]);
#pragma unroll
      for (int db = 0; db < 2; ++db) { const long c = (long)q * 512 + he * 64 + db * 32 + r32; const float os = db ? st.o1[e] : st.o0[e];
        const float a = g0 * bf2f(p.oc[c]) + g1 * os + g2 * bf2f(p.ow[c]); SB* mp = p.mix + (long)q * NMIX + MX_A + he * 64 + db * 32 + r32; *mp = f2bf(a * bf2f(*mp)); } }
  }
}

struct WaveLds2 { unsigned short x[2048]; unsigned short b[2048]; float acs[128]; float dtv[128]; float xch[64]; };
template <bool SCALE, class RowScale>
__device__ __forceinline__ void stage_slab(unsigned short* dst, const SB* src, long ld, RowScale rs, int lane) {
#pragma unroll
  for (int i = 0; i < 4; ++i) { const int c = lane + 64 * i, row = c >> 3, ch = c & 7; const u32x4 gv = *(const GLB1 u32x4*)(src + (long)row * ld + ch * 8); uint4 vv; vv.x = gv[0]; vv.y = gv[1]; vv.z = gv[2]; vv.w = gv[3];
    if (SCALE) { const float sc = rs(row); unsigned w[4] = {vv.x, vv.y, vv.z, vv.w};
#pragma unroll
      for (int k = 0; k < 4; ++k) { const float lo = __uint_as_float(w[k] << 16) * sc, hi2 = __uint_as_float(w[k] & 0xffff0000u) * sc; w[k] = pk2(lo, hi2); }
      vv.x = w[0]; vv.y = w[1]; vv.z = w[2]; vv.w = w[3]; }
    *(uint4*)&dst[(ch >> 2) * 1024 + row * 32 + (ch & 3) * 8] = vv; }
}
__device__ __forceinline__ bf16x8 slab_frag(const unsigned short* img, int cb, int s2, int lane) {
  const int hi = lane >> 5; const unsigned short* vb = img + (4 * hi + ((lane & 15) >> 2)) * 32 + ((lane >> 4) & 1) * 16 + (lane & 3) * 4 + cb * 1024 + s2 * 512;
  const v4i16_t lo = __builtin_amdgcn_ds_read_tr16_b64_v4i16((LDS3 v4i16_t*)vb);
  const v4i16_t hh = __builtin_amdgcn_ds_read_tr16_b64_v4i16((LDS3 v4i16_t*)(vb + 256));
  return (bf16x8){lo[0], lo[1], lo[2], lo[3], hh[0], hh[1], hh[2], hh[3]};
}
__device__ __forceinline__ void unit_bstates(const Params& p, int u, WaveLds2* L, int lane) {
  const int nh = u & 1, hd = (u >> 1) & 7, c = u >> 4, g = hd >> 2, r32 = lane & 31, hi = lane >> 5;
  f32x16 acc[2][2];
#pragma unroll
  for (int i = 0; i < 2; ++i)
#pragma unroll
    for (int j = 0; j < 2; ++j) acc[i][j] = zero16();
  const SB* xb = p.xconv + (long)c * 128 * 1024; const float* wst = p.wst + (long)c * 128 * 8 + hd;
  u32x4 xn[4], bn[4]; float sn[4];
#define BST_LOAD(q_) { _Pragma("unroll") for (int i_ = 0; i_ < 4; ++i_) { const int c_ = lane + 64 * i_, row_ = c_ >> 3, ch_ = c_ & 7; \
      xn[i_] = *(const GLB1 u32x4*)(xb + (long)(32 * (q_) + row_) * 1024 + hd * 64 + ch_ * 8); bn[i_] = *(const GLB1 u32x4*)(xb + (long)(32 * (q_) + row_) * 1024 + 512 + g * 128 + nh * 64 + ch_ * 8); \
      sn[i_] = *(const GLB1 float*)&wst[(32 * (q_) + row_) * 8]; } }
  BST_LOAD(0)
  for (int q4 = 0; q4 < 4; ++q4) {
#pragma unroll
    for (int i = 0; i < 4; ++i) { const int c_ = lane + 64 * i, row = c_ >> 3, ch = c_ & 7; u32x4 w = xn[i];
#pragma unroll
      for (int k = 0; k < 4; ++k) { const float lo = __uint_as_float(w[k] << 16) * sn[i], hi2 = __uint_as_float(w[k] & 0xffff0000u) * sn[i]; w[k] = pk2(lo, hi2); }
      *(u32x4*)&L->x[(ch >> 2) * 1024 + row * 32 + (ch & 3) * 8] = w; *(u32x4*)&L->b[(ch >> 2) * 1024 + row * 32 + (ch & 3) * 8] = bn[i]; }
    { const int qn = q4 < 3 ? q4 + 1 : 3; BST_LOAD(qn) }
#pragma unroll
    for (int s2 = 0; s2 < 2; ++s2) { bf16x8 af[2], bfr[2];
#pragma unroll
      for (int i = 0; i < 2; ++i) { af[i] = slab_frag(L->x, i, s2, lane); bfr[i] = slab_frag(L->b, i, s2, lane); }
#pragma unroll
      for (int i = 0; i < 2; ++i)
#pragma unroll
        for (int j = 0; j < 2; ++j) acc[i][j] = MFMA32(af[i], bfr[j], acc[i][j]); } }
#undef BST_LOAD
  float* so = p.states + ((long)c * 8 + hd) * 8192 + nh * 64 + r32;
#pragma unroll
  for (int i = 0; i < 2; ++i)
#pragma unroll
    for (int j = 0; j < 2; ++j)
#pragma unroll
      for (int e = 0; e < 16; ++e) so[(long)(32 * i + crow(e, hi)) * 128 + 32 * j] = acc[i][j][e];
}
__device__ __forceinline__ void unit_bout(const Params& p, int layer, int u, WaveLds2* L, int lane) {
  const int lt = u & 3, hd = (u >> 2) & 7, c = u >> 5, g = hd >> 2, r32 = lane & 31, hi = lane >> 5;
  for (int x = lane; x < 128; x += 64) { L->acs[x] = p.acs[((long)c * 128 + x) * 8 + hd]; L->dtv[x] = p.dt[((long)c * 128 + x) * 8 + hd]; }
  f32x16 acc[2] = {zero16(), zero16()}, acc2[2] = {zero16(), zero16()};
  const SB* xb = p.xconv + (long)c * 128 * 1024; const int l = 32 * lt + r32; const float al = p.acs[((long)c * 128 + l) * 8 + hd];
  const float* cbr = p.cb + ((long)c * 2 + g) * 16384 + (long)l * 128;
  for (int sc = 0; sc <= lt; ++sc) {
    stage_slab<false>(L->x, xb + (long)(32 * sc) * 1024 + hd * 64, 1024, [&](int) { return 1.f; }, lane);
#pragma unroll
    for (int s2 = 0; s2 < 2; ++s2) { float mv[8];
#pragma unroll
      for (int jj = 0; jj < 2; ++jj) { const int s0 = 32 * sc + 16 * s2 + 8 * jj + 4 * hi; const float4 cv = *(const float4*)(cbr + s0); const float4 av = *(const float4*)(&L->acs[s0]); const float4 dv = *(const float4*)(&L->dtv[s0]);
        mv[4 * jj + 0] = (s0 + 0 <= l) ? cv.x * __expf(al - av.x) * dv.x : 0.f; mv[4 * jj + 1] = (s0 + 1 <= l) ? cv.y * __expf(al - av.y) * dv.y : 0.f;
        mv[4 * jj + 2] = (s0 + 2 <= l) ? cv.z * __expf(al - av.z) * dv.z : 0.f; mv[4 * jj + 3] = (s0 + 3 <= l) ? cv.w * __expf(al - av.w) * dv.w : 0.f; }
      u32x4 aw; aw[0] = pk2(mv[0], mv[1]); aw[1] = pk2(mv[2], mv[3]); aw[2] = pk2(mv[4], mv[5]); aw[3] = pk2(mv[6], mv[7]); const bf16x8 af = __builtin_bit_cast(bf16x8, aw);
#pragma unroll
      for (int pt = 0; pt < 2; ++pt) acc[pt] = MFMA32(af, slab_frag(L->x, pt, s2, lane), acc[pt]); } }
  const SB* cmr = xb + (long)l * 1024 + 768 + g * 128; const float* prv = p.states + ((long)c * 8 + hd) * 8192;
#pragma unroll 2
  for (int ks = 0; ks < 8; ++ks) { const bf16x8 af = *(const bf16x8*)(cmr + 16 * ks + 8 * hi);
#pragma unroll
    for (int pt = 0; pt < 2; ++pt) { const float* pr = prv + (long)(32 * pt + r32) * 128 + 16 * ks + 8 * hi; const float4 a0 = *(const float4*)pr, a1 = *(const float4*)(pr + 4);
      u32x4 bw; bw[0] = pk2(a0.x, a0.y); bw[1] = pk2(a0.z, a0.w); bw[2] = pk2(a1.x, a1.y); bw[3] = pk2(a1.z, a1.w);
      acc2[pt] = MFMA32(af, __builtin_bit_cast(bf16x8, bw), acc2[pt]); } }
  const float dsk = p.b_d[layer * 8 + hd];
#pragma unroll
  for (int e = 0; e < 16; ++e) { const int lr = 32 * lt + crow(e, hi); const float ea = __expf(L->acs[lr]); const long t = (long)c * 128 + lr;
#pragma unroll
    for (int pt = 0; pt < 2; ++pt) { const int pp = 32 * pt + r32; p.ybuf[t * 512 + hd * 64 + pp] = acc[pt][e] + ea * acc2[pt][e] + dsk * bf2f(xb[(long)lr * 1024 + hd * 64 + pp]); } }
}
__device__ __forceinline__ void unit_bnorm(const Params& p, int layer, int u, int lane) {
  const int g = u & 1; const long t = u >> 1; const float4 yv = *(const float4*)(p.ybuf + t * 512 + g * 256 + lane * 4);
  SB* mp = p.mix + t * NMIX + MX_B + g * 256 + lane * 4; const ushort4 zv = *(const ushort4*)mp;
  const float v0 = yv.x * bf2f(zv.x), v1 = yv.y * bf2f(zv.y), v2 = yv.z * bf2f(zv.z), v3 = yv.w * bf2f(zv.w);
  const float ss = wave_sum_f(v0 * v0 + v1 * v1 + v2 * v2 + v3 * v3); const float r = 1.f / sqrtf(ss * (1.f / 256.f) + 1e-6f);
  const float4 w = *(const float4*)(p.b_norm + layer * 512 + g * 256 + lane * 4);
  ushort4 o; o.x = f2bf(v0 * r * w.x); o.y = f2bf(v1 * r * w.y); o.z = f2bf(v2 * r * w.z); o.w = f2bf(v3 * r * w.w); *(ushort4*)mp = o;
}
__device__ __forceinline__ void unit_bdt(const Params& p, int layer, int u, int lane) {
  const int hd = u & 7, c = u >> 3; const float a = -expf(p.a_log[layer * 8 + hd]), bias = p.dt_bias[layer * 8 + hd]; const long t0 = (long)c * 128 + 2 * lane;
  const float d0 = softplus_f(p.small[t0 * NSMALL + 24 + hd] + bias), d1 = softplus_f(p.small[(t0 + 1) * NSMALL + 24 + hd] + bias);
  float run = (d0 + d1) * a;
#pragma unroll
  for (int o = 1; o < 64; o <<= 1) { const float v = __shfl_up(run, o); if (lane >= o) run += v; }
  const float tot = __shfl(run, 63); const float c1 = run, c0 = run - d1 * a;
  p.dt[t0 * 8 + hd] = d0; p.dt[(t0 + 1) * 8 + hd] = d1; p.acs[t0 * 8 + hd] = c0; p.acs[(t0 + 1) * 8 + hd] = c1;
  p.wst[t0 * 8 + hd] = d0 * expf(tot - c0); p.wst[(t0 + 1) * 8 + hd] = d1 * expf(tot - c1);
}
__device__ __forceinline__ void item_bconv(const Params& p, int layer, long gid) {
  const int cg = (int)(gid & 127) * 8; const long t = gid >> 7; const float* w = p.conv_w + (long)layer * 4 * 1024 + cg; const float* bb = p.conv_b + layer * 1024 + cg;
  const float4 b0 = *(const float4*)bb, b1 = *(const float4*)(bb + 4);
  float acc[8] = {b0.x, b0.y, b0.z, b0.w, b1.x, b1.y, b1.z, b1.w};
#pragma unroll
  for (int i = 0; i < 4; ++i) { const long tt = t - 3 + i; const long tc = tt < 0 ? 0 : tt; const float vm = tt < 0 ? 0.f : 1.f;
    const uint4 vv = *(const uint4*)(p.proj + tc * NPROJ + PB_X + cg); const unsigned wd[4] = {vv.x, vv.y, vv.z, vv.w};
    const float4 w0 = *(const float4*)(w + i * 1024), w1 = *(const float4*)(w + i * 1024 + 4); const float wv[8] = {w0.x, w0.y, w0.z, w0.w, w1.x, w1.y, w1.z, w1.w};
#pragma unroll
    for (int k = 0; k < 4; ++k) { acc[2 * k] += vm * wv[2 * k] * __uint_as_float(wd[k] << 16); acc[2 * k + 1] += vm * wv[2 * k + 1] * __uint_as_float(wd[k] & 0xffff0000u); } }
  uint4 o; o.x = pk2(silu_fast(acc[0]), silu_fast(acc[1])); o.y = pk2(silu_fast(acc[2]), silu_fast(acc[3])); o.z = pk2(silu_fast(acc[4]), silu_fast(acc[5])); o.w = pk2(silu_fast(acc[6]), silu_fast(acc[7]));
  *(uint4*)(p.xconv + t * 1024 + cg) = o;
}
__device__ __forceinline__ void scan_fast(const Params& p, long gid) {
  const int hd = (int)(gid >> 13); const int nc = p.S / 128; float h = 0.f;
  float st[16], dc[16];
#pragma unroll
  for (int i = 0; i < 16; ++i) { st[i] = p.states[(long)i * 65536 + gid]; dc[i] = p.acs[(long)(i * 128 + 127) * 8 + hd]; }
  for (int c0 = 0; c0 < nc; c0 += 16) {
    float sn[16], dn[16]; const int cn = (c0 + 16 < nc) ? c0 + 16 : c0;
#pragma unroll
    for (int i = 0; i < 16; ++i) { sn[i] = p.states[(long)(cn + i) * 65536 + gid]; dn[i] = p.acs[(long)((cn + i) * 128 + 127) * 8 + hd]; }
#pragma unroll
    for (int i = 0; i < 16; ++i) { p.states[(long)(c0 + i) * 65536 + gid] = h; h = __builtin_fmaf(h, __builtin_amdgcn_exp2f(dc[i] * L2E), st[i]); }
#pragma unroll
    for (int i = 0; i < 16; ++i) { st[i] = sn[i]; dc[i] = dn[i]; }
  }
}
__device__ __forceinline__ void unit_cmp(const Params& p, int layer, int u, int lane) {
  const int ncmp = p.S / 16, ntile = ncmp * 2 / 32; const int kv = u / ntile, rt = u % ntile, r32 = lane & 31, hi = lane >> 5;
  const int r = 32 * rt + r32, j = r >> 1, hk = r & 1;
  const unsigned short* w1t = p.w1t + (long)kv * 128 * 2048; const unsigned short* w2t = p.w2t + kv * 64 * 128; const float* pe = p.cmp_pos + (long)(layer * 2 + kv) * 32 * 64;
  const SB* src = p.proj + PA_KV + kv * 128 + hk * 64;
  f32x16 acc[4] = {zero16(), zero16(), zero16(), zero16()};
#pragma unroll 4
  for (int ks = 0; ks < 128; ++ks) { const int t = ks >> 2, d = (ks & 3) * 16 + 8 * hi; const long tok = 16 * j + t;
    const float4 p0 = *(const float4*)(pe + t * 64 + d), p1 = *(const float4*)(pe + t * 64 + d + 4); float v[8] = {p0.x, p0.y, p0.z, p0.w, p1.x, p1.y, p1.z, p1.w};
    { const long tokc = tok < p.S ? tok : (long)p.S - 1; const float vm = tok < p.S ? 1.f : 0.f;
      const uint4 vv = *(const uint4*)(src + tokc * NPROJ + d); const unsigned wd[4] = {vv.x, vv.y, vv.z, vv.w};
#pragma unroll
      for (int k = 0; k < 4; ++k) { v[2 * k] += vm * __uint_as_float(wd[k] << 16); v[2 * k + 1] += vm * __uint_as_float(wd[k] & 0xffff0000u); } }
    u32x4 bw; bw[0] = pk2(v[0], v[1]); bw[1] = pk2(v[2], v[3]); bw[2] = pk2(v[4], v[5]); bw[3] = pk2(v[6], v[7]); const bf16x8 bfr = __builtin_bit_cast(bf16x8, bw);
#pragma unroll
    for (int ut = 0; ut < 4; ++ut) { const bf16x8 af = *(const bf16x8*)(w1t + (long)(32 * ut + r32) * 2048 + 16 * ks + 8 * hi); acc[ut] = MFMA32(af, bfr, acc[ut]); } }
  f32x16 o2[2] = {zero16(), zero16()};
#pragma unroll
  for (int ut = 0; ut < 4; ++ut) {
#pragma unroll
    for (int e = 0; e < 16; ++e) acc[ut][e] = gelu_fast(acc[ut][e]);
#pragma unroll
    for (int s2 = 0; s2 < 2; ++s2) { const bf16x8 hb = pack8(acc[ut], 8 * s2);
#pragma unroll
      for (int dt = 0; dt < 2; ++dt) { const unsigned short* wr = w2t + (32 * dt + r32) * 128 + 32 * ut + 16 * s2 + 4 * hi; const uint2 x0 = *(const uint2*)wr, x1 = *(const uint2*)(wr + 8);
        u32x4 aw; aw[0] = x0.x; aw[1] = x0.y; aw[2] = x1.x; aw[3] = x1.y; o2[dt] = MFMA32(__builtin_bit_cast(bf16x8, aw), hb, o2[dt]); } } }
  SB* dst = p.kvc + ((long)kv * ncmp * 2 + r) * 64;
#pragma unroll
  for (int dt = 0; dt < 2; ++dt)
#pragma unroll
    for (int e = 0; e < 16; ++e) dst[32 * dt + crow(e, hi)] = f2bf(o2[dt][e]);
}

__device__ __forceinline__ unsigned umax_(unsigned a, unsigned b) { return a > b ? a : b; }
#define DPP_U(v, ctrl, rm) (unsigned)__builtin_amdgcn_update_dpp((int)(v), (int)(v), ctrl, rm, 0xf, false)
__device__ __forceinline__ unsigned wave_max_u(unsigned v) {
  v = umax_(v, DPP_U(v, 0xB1, 0xf)); v = umax_(v, DPP_U(v, 0x4E, 0xf)); v = umax_(v, DPP_U(v, 0x141, 0xf)); v = umax_(v, DPP_U(v, 0x140, 0xf));
  v = umax_(v, DPP_U(v, 0x142, 0xa)); v = umax_(v, DPP_U(v, 0x143, 0xc));
  return (unsigned)__builtin_amdgcn_readlane((int)v, 63); }
template <int NR, class RowFn, class OutFn>
__device__ __forceinline__ void topkn_rows_o(const Params& p, RowFn rowfn, OutFn outfn, int lane) {
  unsigned v[NR][4]; int mine[NR];
#pragma unroll
  for (int r = 0; r < NR; ++r) { const int row = rowfn(r); const int q = row >> 1; const int cur = q >> 6; const float* imp = p.imp + ((long)(q >> 5) * 2 + (row & 1)) * 256 * 32 + (q & 31); mine[r] = -1;
#pragma unroll
    for (int k = 0; k < 4; ++k) { const int b = lane + 64 * k; float x = (b <= cur) ? *(const GLB1 float*)&imp[b * 32] : -1.f; if (b == 0 || b == cur) x = 1e4f;
      v[r][k] = (x >= 0.f) ? ((((__float_as_uint(x) >> 8) + 1u) << 8) | (unsigned)(255 - b)) : 0u; } }
  for (int k = 0; k < 16; ++k) {
    unsigned m[NR];
#pragma unroll
    for (int r = 0; r < NR; ++r) m[r] = wave_max_u(umax_(umax_(v[r][0], v[r][1]), umax_(v[r][2], v[r][3])));
#pragma unroll
    for (int r = 0; r < NR; ++r) {
#pragma unroll
      for (int kk = 0; kk < 4; ++kk) if (v[r][kk] == m[r]) v[r][kk] = 0u;
      if (lane == k) mine[r] = (m[r] != 0u) ? (int)(255u - (m[r] & 255u)) : -1; }
  }
#pragma unroll
  for (int r = 0; r < NR; ++r) if (lane < 16) { p.idx[(long)rowfn(r) * 16 + lane] = mine[r]; outfn(r, mine[r]); }
}
template <class RowFn, class OutFn>
__device__ __forceinline__ void topk4_rows_o(const Params& p, RowFn rowfn, OutFn outfn, int lane) { topkn_rows_o<4>(p, rowfn, outfn, lane); }
template <class RowFn>
__device__ __forceinline__ void topk4_rows(const Params& p, RowFn rowfn, int lane) { topk4_rows_o(p, rowfn, [](int, int) {}, lane); }
__device__ __forceinline__ void unit_topk4(const Params& p, int u, int lane) { topk4_rows(p, [&](int r) { return u * 4 + r; }, lane); }
__device__ __forceinline__ void glds16_asm(const void* gsrc, unsigned lds_dst) {
  unsigned keep; asm volatile("s_mov_b32 %0, m0\n\ts_mov_b32 m0, %2\n\ts_nop 0\n\tglobal_load_lds_dwordx4 %1, off\n\ts_mov_b32 m0, %0" : "=&s"(keep) : "v"(gsrc), "s"(lds_dst) : "memory");
}
__device__ __forceinline__ unsigned lds_addr(const void* p) { return (unsigned)(size_t)(LDS3 const void*)p; }
struct AselLds { unsigned short k[3][4096]; unsigned short v[3][4096]; unsigned short q[4][2048]; unsigned sel[64][8]; unsigned anyb[8]; int nlist; int pad[7]; unsigned char blist[256]; float xch[4][32]; unsigned char bkt[1664]; float relS[128]; };
__device__ __forceinline__ void asel_issue(uint4 (&r)[4], const SB* kvb, int b, int tid) {
#pragma unroll
  for (int i = 0; i < 2; ++i) { const int idx = tid + 256 * i, row = idx >> 3, ch = idx & 7; const SB* src = kvb + (long)(b * 64 + row) * NPROJ + ch * 8; r[i] = *(const uint4*)src; r[2 + i] = *(const uint4*)(src + 128); }
}
__device__ __forceinline__ void asel_commit(const uint4 (&r)[4], AselLds* A, int stage, int tid) {
#pragma unroll
  for (int i = 0; i < 2; ++i) { const int idx = tid + 256 * i, row = idx >> 3, ch = idx & 7;
    *(uint4*)&A->k[stage][row * 64 + ((ch ^ (row & 7)) * 8)] = r[i];
    *(uint4*)&A->v[stage][(ch >> 2) * 2048 + row * 32 + (ch & 3) * 8] = r[2 + i]; }
}
__device__ __forceinline__ void asel_coltile(const Params& p, FlashState& S_, const unsigned short* qlds, AselLds* A, float* xch, int stage, int b, int cur, int q0, int qbase, int h, float c31, int lane) {
  const int r32 = lane & 31, hi = lane >> 5; const int ql = qbase + (r32 >> 2); const int q = q0 + ql;
  const bool selq = (A->sel[ql][b >> 5] >> (b & 31)) & 1u;
  if (!__any(selq)) return;
  bf16x8 qf[4];
#pragma unroll
  for (int d0 = 0; d0 < 4; ++d0) qf[d0] = *(const bf16x8*)&qlds[r32 * 64 + (((2 * d0 + hi) ^ ((r32 >> 1) & 7)) * 8)];
  const bool far = (q0 - (b * 64 + 63)) >= 1513; const bool edge = (b == cur);
#ifndef ASEL2
#define ASEL2 1
#endif
#if ASEL2
  bf16x8 kf0[4], kf1[4];
#pragma unroll
  for (int d0 = 0; d0 < 4; ++d0) { const int row0 = r32, row1 = 32 + r32;
    kf0[d0] = *(const bf16x8*)&A->k[stage][row0 * 64 + (((2 * d0 + hi) ^ ((row0 >> 1) & 7)) * 8)];
    kf1[d0] = *(const bf16x8*)&A->k[stage][row1 * 64 + (((2 * d0 + hi) ^ ((row1 >> 1) & 7)) * 8)]; }
  f32x16 s0 = zero16(), s1 = zero16();
#pragma unroll
  for (int d0 = 0; d0 < 4; ++d0) { s0 = MFMA32(kf0[d0], qf[d0], s0); s1 = MFMA32(kf1[d0], qf[d0], s1); }
  if (far) { flash_core2_lin(S_, s0, s1, selq ? QSC : 0.f, selq ? c31 : NINF, A->v[stage], xch, lane); return; }
#pragma unroll
  for (int e = 0; e < 16; ++e) { const int tk = b * 64 + (e & 3) + 8 * (e >> 2) + 4 * hi; const int dist = q - tk; float b0, b1;
    { const int d0c = dist < 0 ? 0 : (dist > 1663 ? 1663 : dist); const int d1 = dist - 32; const int d1c = d1 < 0 ? 0 : (d1 > 1663 ? 1663 : d1);
      b0 = A->relS[A->bkt[d0c] * 4 + (h & 3)]; b1 = A->relS[A->bkt[d1c] * 4 + (h & 3)]; }
    float v0 = s0[e] * QSC + b0, v1 = s1[e] * QSC + b1; if (!selq || (edge && dist < 0)) v0 = NINF; if (!selq || (edge && dist < 32)) v1 = NINF; s0[e] = v0; s1[e] = v1; }
  flash_core2(S_, s0, s1, A->v[stage], xch, lane);
}
#else
#pragma unroll 1
  for (int kt = 0; kt < 2; ++kt) { const int t0 = b * 64 + 32 * kt; if (edge && t0 > q0 + qbase + 7) continue;
    bf16x8 kf[4]; { const int row = 32 * kt + r32;
#pragma unroll
      for (int d0 = 0; d0 < 4; ++d0) kf[d0] = *(const bf16x8*)&A->k[stage][row * 64 + (((2 * d0 + hi) ^ ((row >> 1) & 7)) * 8)]; }
    f32x16 s = zero16();
#pragma unroll
    for (int d0 = 0; d0 < 4; ++d0) s = MFMA32(kf[d0], qf[d0], s);
    if (far) { flash_core1_lin(S_, s, selq ? QSC : 0.f, selq ? c31 : NINF, A->v[stage] + kt * 1024, xch, lane); continue; }
#pragma unroll
    for (int e = 0; e < 16; ++e) { const int tk = t0 + (e & 3) + 8 * (e >> 2) + 4 * hi; const int dist = q - tk;
      const int dc = dist < 0 ? 0 : (dist > 2047 ? 2047 : dist); const float bsv = p.tabA[h * TABA_N + dc] * L2E;
      float vv = s[e] * QSC + bsv; if (!selq || (edge && dist < 0)) vv = NINF; s[e] = vv; }
    flash_core1(S_, s, A->v[stage] + kt * 1024, xch, lane);
  }
}
#endif
__device__ __forceinline__ void asel_store(const Params& p, FlashState& S_, float* xch, int q0, int qbase, int g, int lane) {
  const int r32 = lane & 31, hi = lane >> 5;
  const float lt = S_.l + xor32_f(S_.l); const float inv = lt > 0.f ? 1.f / lt : 0.f; xch[r32] = inv;
#pragma unroll
  for (int e = 0; e < 16; ++e) { const int j = crow(e, hi); const float a = xch[j]; const int q = q0 + qbase + (j >> 2), he = g * 4 + (j & 3);
    const float* gl = p.small + (long)q * NSMALL + he * 3; const float g0 = sigmoid_fast(gl[0]), g1 = sigmoid_fast(gl[1]), g2 = sigmoid_fast(gl[2]);
#pragma unroll
    for (int db = 0; db < 2; ++db) { const long c = (long)q * 512 + he * 64 + db * 32 + r32; const float os = (db ? S_.o1[e] : S_.o0[e]) * a;
      const float av = g0 * bf2f(p.oc[c]) + g1 * os + g2 * bf2f(p.ow[c]); SB* mp = p.mix + (long)q * NMIX + MX_A + he * 64 + db * 32 + r32; *mp = f2bf(av * bf2f(*mp)); } }
}
#ifndef ASEL16
#define ASEL16 1
#endif
typedef float f32x4_t __attribute__((ext_vector_type(4)));
#define MFMA16(a, b, c) __builtin_amdgcn_mfma_f32_16x16x32_bf16((a), (b), (c), 0, 0, 0)
struct Asel16 { f32x4_t o0, o1, o2, o3; float m, l; };
__device__ __forceinline__ float quadmax_f(float v) {
  const auto a = __builtin_amdgcn_permlane16_swap(__float_as_uint(v), __float_as_uint(v), false, false); v = fmaxf(__uint_as_float(a[0]), __uint_as_float(a[1]));
  const auto b = __builtin_amdgcn_permlane32_swap(__float_as_uint(v), __float_as_uint(v), false, false); return fmaxf(__uint_as_float(b[0]), __uint_as_float(b[1])); }
__device__ __forceinline__ float quadsum_f(float v) {
  const auto a = __builtin_amdgcn_permlane16_swap(__float_as_uint(v), __float_as_uint(v), false, false); v = __uint_as_float(a[0]) + __uint_as_float(a[1]);
  const auto b = __builtin_amdgcn_permlane32_swap(__float_as_uint(v), __float_as_uint(v), false, false); return __uint_as_float(b[0]) + __uint_as_float(b[1]); }
__device__ __forceinline__ bf16x8 pack44(const f32x4_t& a, const f32x4_t& b) {
  u32x4 r; r[0] = pk2(a[0], a[1]); r[1] = pk2(a[2], a[3]); r[2] = pk2(b[0], b[1]); r[3] = pk2(b[2], b[3]); return __builtin_bit_cast(bf16x8, r); }
template <int CT>
__device__ __forceinline__ void asel_coltile16(const Params& p, Asel16& S_, const unsigned short* qlds, AselLds* A, float* xch, int stage, int b, int cur, int q0, int qbase, float c31, int lane) {
  const int j = lane & 15, q4 = lane >> 4; const int ql = qbase + 4 * CT + (j >> 2); const int q = q0 + ql;
  const bool selq = (A->sel[ql][b >> 5] >> (b & 31)) & 1u;
  if (!__any(selq)) return;
  const bool far = (q0 - (b * 64 + 63)) >= 1513; const bool edge = (b == cur);
  const int qrow = 16 * CT + j;
  const bf16x8 qf0 = *(const bf16x8*)&qlds[qrow * 64 + (((q4) ^ ((qrow >> 1) & 7)) * 8)], qf1 = *(const bf16x8*)&qlds[qrow * 64 + (((4 + q4) ^ ((qrow >> 1) & 7)) * 8)];
  f32x4_t sc[4];
#pragma unroll
  for (int kt = 0; kt < 4; ++kt) { const int row = 16 * kt + j;
    const bf16x8 k0 = *(const bf16x8*)&A->k[stage][row * 64 + (((q4) ^ ((row >> 1) & 7)) * 8)], k1 = *(const bf16x8*)&A->k[stage][row * 64 + (((4 + q4) ^ ((row >> 1) & 7)) * 8)];
    f32x4_t z = {0.f, 0.f, 0.f, 0.f}; z = MFMA16(k0, qf0, z); sc[kt] = MFMA16(k1, qf1, z); }
  float qs, bb;
  if (far) { qs = selq ? QSC : 0.f; bb = selq ? c31 : NINF; }
  else {
    qs = 1.f; bb = 0.f;
#pragma unroll
    for (int kt = 0; kt < 4; ++kt) {
#pragma unroll
      for (int r = 0; r < 4; ++r) { const int tk = b * 64 + 16 * kt + 4 * q4 + r; const int dist = q - tk; const int dc = dist < 0 ? 0 : (dist > 1663 ? 1663 : dist);
        float v = sc[kt][r] * QSC + A->relS[A->bkt[dc] * 4 + (j & 3)]; if (!selq || (edge && dist < 0)) v = NINF; sc[kt][r] = v; } }
  }
  float mr = fmaxf(fmaxf(sc[0][0], sc[0][1]), fmaxf(sc[0][2], sc[0][3]));
#pragma unroll
  for (int kt = 1; kt < 4; ++kt) mr = fmaxf(mr, fmaxf(fmaxf(sc[kt][0], sc[kt][1]), fmaxf(sc[kt][2], sc[kt][3])));
  float mx = far ? __builtin_fmaf(mr, qs, bb) : mr;
  mx = quadmax_f(mx);
  if (__any(mx > S_.m + FTHR)) {
    const float mn = fmaxf(S_.m, mx); const float al = __builtin_amdgcn_exp2f(S_.m - mn); S_.m = mn; S_.l *= al; xch[16 * CT + j] = al;
    const f32x4_t a = *(const f32x4_t*)&xch[16 * CT + 4 * q4];
    S_.o0 *= a; S_.o1 *= a; S_.o2 *= a; S_.o3 *= a;
  }
  const float bm = bb - S_.m; float ps = 0.f;
#pragma unroll
  for (int kt = 0; kt < 4; ++kt) {
#pragma unroll
    for (int r = 0; r < 4; ++r) { const float e_ = __builtin_amdgcn_exp2f(__builtin_fmaf(sc[kt][r], qs, bm)); sc[kt][r] = e_; ps += e_; } }
  S_.l += ps;
  const bf16x8 pa0 = pack44(sc[0], sc[1]), pa1 = pack44(sc[2], sc[3]);
  const unsigned short* vb = A->v[stage] + (4 * q4 + (j >> 2)) * 32 + (j & 3) * 4;
#pragma unroll
  for (int c = 0; c < 2; ++c) {
#pragma unroll
    for (int dt = 0; dt < 4; ++dt) {
      const v4i16_t lo = __builtin_amdgcn_ds_read_tr16_b64_v4i16((LDS3 v4i16_t*)(vb + (dt >> 1) * 2048 + (dt & 1) * 16 + c * 1024));
      const v4i16_t hh = __builtin_amdgcn_ds_read_tr16_b64_v4i16((LDS3 v4i16_t*)(vb + (dt >> 1) * 2048 + (dt & 1) * 16 + c * 1024 + 512));
      const bf16x8 vf = {lo[0], lo[1], lo[2], lo[3], hh[0], hh[1], hh[2], hh[3]};
      const bf16x8 pa = c ? pa1 : pa0;
      if (dt == 0) S_.o0 = MFMA16(pa, vf, S_.o0); else if (dt == 1) S_.o1 = MFMA16(pa, vf, S_.o1); else if (dt == 2) S_.o2 = MFMA16(pa, vf, S_.o2); else S_.o3 = MFMA16(pa, vf, S_.o3);
    }
  }
}
template <int CT>
__device__ __forceinline__ void asel_store16(const Params& p, Asel16& S_, float* xch, int q0, int qbase, int g, int lane) {
  const int j = lane & 15, q4 = lane >> 4;
  const float lt = quadsum_f(S_.l); const float inv = lt > 0.f ? 1.f / lt : 0.f; xch[16 * CT + j] = inv;
  const f32x4_t a = *(const f32x4_t*)&xch[16 * CT + 4 * q4];
  const int q = q0 + qbase + 4 * CT + q4;
  SB vc[4][4], vw[4][4], vm[4][4]; float gg[4][3];
#pragma unroll
  for (int r = 0; r < 4; ++r) { const int he = g * 4 + r; const float* gl = p.small + (long)q * NSMALL + he * 3; gg[r][0] = gl[0]; gg[r][1] = gl[1]; gg[r][2] = gl[2];
#pragma unroll
    for (int dt = 0; dt < 4; ++dt) { const long c = (long)q * 512 + he * 64 + dt * 16 + j; vc[r][dt] = p.oc[c]; vw[r][dt] = p.ow[c]; vm[r][dt] = p.mix[(long)q * NMIX + MX_A + he * 64 + dt * 16 + j]; } }
#pragma unroll
  for (int r = 0; r < 4; ++r) { const int he = g * 4 + r; const float g0 = sigmoid_fast(gg[r][0]), g1 = sigmoid_fast(gg[r][1]), g2 = sigmoid_fast(gg[r][2]);
#pragma unroll
    for (int dt = 0; dt < 4; ++dt) { const float os = (dt == 0 ? S_.o0[r] : dt == 1 ? S_.o1[r] : dt == 2 ? S_.o2[r] : S_.o3[r]) * a[r];
      const float av = g0 * bf2f(vc[r][dt]) + g1 * os + g2 * bf2f(vw[r][dt]); p.mix[(long)q * NMIX + MX_A + he * 64 + dt * 16 + j] = f2bf(av * bf2f(vm[r][dt])); } }
}
template <bool STORE = true, bool NOSTEPS = false>
__device__ __forceinline__ void unit_asel_blk(const Params& p, int u, AselLds* A) {
  int tid = threadIdx.x; asm volatile("" : "+v"(tid));
  const int lane = tid & 63, w = __builtin_amdgcn_readfirstlane(tid >> 6), r32 = lane & 31, hi = lane >> 5;
  const int g = u & 1, qt = (p.S / 32 - 1) - (u >> 1), q0 = qt * 32, cur = q0 >> 6;
  const SB* kvb = p.proj + PA_KV + 2 * 128 + g * 64;
  __syncthreads();
  for (int i = tid; i < 64 * 8 + 8; i += 256) ((unsigned*)A->sel)[i] = 0u;
  for (int i = tid; i < 1664; i += 256) A->bkt[i] = (unsigned char)t5_bucket(i);
  if (tid < 128) A->relS[tid] = p.rel_bias[(tid >> 2) * 32 + g * 4 + (tid & 3)] * L2E;
#ifndef ASEL_NO_TOPK
  topk4_rows(p, [&](int r) { return (q0 + 8 * w + r) * 2 + g; }, lane); topk4_rows(p, [&](int r) { return (q0 + 8 * w + 4 + r) * 2 + g; }, lane);
  asm volatile("s_waitcnt vmcnt(0)" ::: "memory");
#endif
  __syncthreads();
#pragma unroll
  for (int i = 0; i < 2; ++i) { const int e = tid + 256 * i, ql = e >> 4, kk = e & 15; const int b = __hip_atomic_load(&p.idx[((long)(q0 + ql) * 2 + g) * 16 + kk], __ATOMIC_RELAXED, __HIP_MEMORY_SCOPE_AGENT);
    if (b >= 0) { atomicOr(&A->sel[ql][b >> 5], 1u << (b & 31)); atomicOr(&A->anyb[b >> 5], 1u << (b & 31)); } }
  __syncthreads();
  if (tid < 64) {
    const unsigned wbits = A->anyb[lane >> 3]; const unsigned nib = (wbits >> ((lane & 7) * 4)) & 15u; const int cnt = __popc(nib);
    int pre = cnt;
#pragma unroll
    for (int o = 1; o < 64; o <<= 1) { const int v = __shfl_up(pre, o); if (lane >= o) pre += v; }
    int pos = pre - cnt;
#pragma unroll
    for (int k = 0; k < 4; ++k) if ((nib >> k) & 1u) A->blist[pos++] = (unsigned char)(lane * 4 + k);
    if (lane == 63) A->nlist = pre;
  }
  __syncthreads();
  const int nlist = NOSTEPS ? 0 : A->nlist;
  const int hh = r32 & 3, h = g * 4 + hh; const float c31 = p.tabA[h * TABA_N + 2047] * L2E;
#if ASEL16
  Asel16 t0, t1;
#else
  FlashState st0;
#endif
  { bf16x8 qf0[4]; load_q(qf0, p.proj + (long)(q0 + 8 * w + (r32 >> 2)) * NPROJ + PA_Q + h * 64, hi);
#pragma unroll
    for (int d0 = 0; d0 < 4; ++d0) *(bf16x8*)&A->q[w][r32 * 64 + (((2 * d0 + hi) ^ ((r32 >> 1) & 7)) * 8)] = qf0[d0]; }
#if ASEL16
  { const f32x4_t z4 = {0.f, 0.f, 0.f, 0.f}; t0.o0 = z4; t0.o1 = z4; t0.o2 = z4; t0.o3 = z4; t0.m = -1e30f; t0.l = 0.f; t1 = t0; }
#else
  st0.o0 = zero16(); st0.o1 = zero16(); st0.m = -1e30f; st0.l = 0.f;
#endif
  float* xch = A->xch[w];
#define ASEL_DMA(bb, stg) { const int b_ = (bb); _Pragma("unroll") for (int i_ = 0; i_ < 2; ++i_) { const int pk_ = 2 * w + i_; \
      { const int row_ = pk_ * 8 + (lane >> 3), pc_ = lane & 7; glds16_asm(kvb + (long)(b_ * 64 + row_) * NPROJ + ((pc_ ^ ((row_ >> 1) & 7)) * 8), (unsigned)__builtin_amdgcn_readfirstlane((int)lds_addr(&A->k[stg][pk_ * 512]))); } \
      { const int db_ = pk_ >> 2, row_ = (pk_ & 3) * 16 + (lane >> 2), wi_ = lane & 3; glds16_asm(kvb + 128 + (long)(b_ * 64 + row_) * NPROJ + db_ * 32 + wi_ * 8, (unsigned)__builtin_amdgcn_readfirstlane((int)lds_addr(&A->v[stg][db_ * 2048 + (pk_ & 3) * 512]))); } } }
  asm volatile("s_waitcnt vmcnt(0)" ::: "memory");
  if (nlist > 0) ASEL_DMA(A->blist[0], 0);
  if (nlist > 1) ASEL_DMA(A->blist[1], 1);
  int stage = 0;
  for (int it = 0; it < nlist; ++it) {
    const int b = A->blist[it];
    if (it + 1 < nlist) asm volatile("s_waitcnt vmcnt(4) lgkmcnt(0)\n\ts_barrier" ::: "memory"); else asm volatile("s_waitcnt vmcnt(0) lgkmcnt(0)\n\ts_barrier" ::: "memory");
    if (it + 2 < nlist) { const int s2_ = (stage == 0) ? 2 : stage - 1; ASEL_DMA(A->blist[it + 2], s2_); }
#if ASEL16
    asel_coltile16<0>(p, t0, A->q[w], A, xch, stage, b, cur, q0, 8 * w, c31, lane); asel_coltile16<1>(p, t1, A->q[w], A, xch, stage, b, cur, q0, 8 * w, c31, lane);
#else
    asel_coltile(p, st0, A->q[w], A, xch, stage, b, cur, q0, 8 * w, h, c31, lane);
#endif
    stage = (stage == 2) ? 0 : stage + 1;
  }
  asm volatile("s_waitcnt vmcnt(0)" ::: "memory");
#if ASEL16
  if (STORE) { asel_store16<0>(p, t0, xch, q0, 8 * w, g, lane); asel_store16<1>(p, t1, xch, q0, 8 * w, g, lane); } else asm volatile("" :: "v"(t0.o0[0]), "v"(t1.o1[2]), "v"(t0.l), "v"(t1.l));
#else
  if (STORE) asel_store(p, st0, xch, q0, 8 * w, g, lane); else asm volatile("" :: "v"(st0.o0[0]), "v"(st0.o1[5]), "v"(st0.l));
#endif
#undef ASEL_DMA
}
struct AselW { unsigned short k[4][4096]; unsigned short v[4][4096]; unsigned sel[32][8]; unsigned anyw[4][8]; int nl[4]; int pad[4]; unsigned char wl[4][256]; float xch[4][32]; unsigned char bkt[1664]; float relS[256]; };
__device__ __forceinline__ void glds16_s(const void* sbase, unsigned voff, unsigned lds_dst) {
  unsigned keep; asm volatile("s_mov_b32 %0, m0\n\ts_mov_b32 m0, %3\n\ts_nop 0\n\tglobal_load_lds_dwordx4 %2, %1\n\ts_mov_b32 m0, %0" : "=&s"(keep) : "s"(sbase), "v"(voff), "s"(lds_dst) : "memory");
}
struct AwOff { unsigned o[8]; };
__device__ __forceinline__ void aw_dma8(const void* sbase, const AwOff& f, unsigned lds) {
  asm volatile(
    "s_mov_b32 m0, %9\n\ts_nop 0\n\tglobal_load_lds_dwordx4 %1, %0\n\t"
    "s_add_u32 m0, %9, 0x400\n\ts_nop 0\n\tglobal_load_lds_dwordx4 %2, %0\n\t"
    "s_add_u32 m0, %9, 0x800\n\ts_nop 0\n\tglobal_load_lds_dwordx4 %3, %0\n\t"
    "s_add_u32 m0, %9, 0xc00\n\ts_nop 0\n\tglobal_load_lds_dwordx4 %4, %0\n\t"
    "s_add_u32 m0, %9, 0x1000\n\ts_nop 0\n\tglobal_load_lds_dwordx4 %5, %0\n\t"
    "s_add_u32 m0, %9, 0x1400\n\ts_nop 0\n\tglobal_load_lds_dwordx4 %6, %0\n\t"
    "s_add_u32 m0, %9, 0x1800\n\ts_nop 0\n\tglobal_load_lds_dwordx4 %7, %0\n\t"
    "s_add_u32 m0, %9, 0x1c00\n\ts_nop 0\n\tglobal_load_lds_dwordx4 %8, %0"
    :: "s"(sbase), "v"(f.o[0]), "v"(f.o[1]), "v"(f.o[2]), "v"(f.o[3]), "v"(f.o[4]), "v"(f.o[5]), "v"(f.o[6]), "v"(f.o[7]), "s"(lds) : "memory", "m0", "scc");
}
template <int CT, bool far>
__device__ __forceinline__ void aw_softmax(Asel16& S_, f32x4_t (&sc)[4], const AselW* A, const float* rel, float* xch, bool selq, bool edge, int q, int b, float c31, int lane) {
  const int j = lane & 15, q4 = lane >> 4;
  float qs, bb;
  if (far) { qs = selq ? QSC : 0.f; bb = selq ? c31 : NINF; }
  else { qs = 1.f; bb = 0.f;
    int bi[4][4]; float be[4][4]; const int d0 = q - (b * 64 + 4 * q4);
#pragma unroll
    for (int kt = 0; kt < 4; ++kt) {
#pragma unroll
      for (int r = 0; r < 4; ++r) { const int dist = d0 - (16 * kt + r); const int dc = dist < 0 ? 0 : (dist > 1663 ? 1663 : dist); bi[kt][r] = A->bkt[dc]; } }
#pragma unroll
    for (int kt = 0; kt < 4; ++kt) asm volatile("" : "+v"(bi[kt][0]), "+v"(bi[kt][1]), "+v"(bi[kt][2]), "+v"(bi[kt][3]));
#pragma unroll
    for (int kt = 0; kt < 4; ++kt) {
#pragma unroll
      for (int r = 0; r < 4; ++r) be[kt][r] = rel[bi[kt][r] * 4 + (j & 3)]; }
#pragma unroll
    for (int kt = 0; kt < 4; ++kt) asm volatile("" : "+v"(be[kt][0]), "+v"(be[kt][1]), "+v"(be[kt][2]), "+v"(be[kt][3]));
#pragma unroll
    for (int kt = 0; kt < 4; ++kt) {
#pragma unroll
      for (int r = 0; r < 4; ++r) { const int dist = d0 - (16 * kt + r); float v = __builtin_fmaf(sc[kt][r], QSC, be[kt][r]); if (!selq || (edge && dist < 0)) v = NINF; sc[kt][r] = v; } }
  }
  float mr = fmaxf(fmaxf(sc[0][0], sc[0][1]), fmaxf(sc[0][2], sc[0][3]));
#pragma unroll
  for (int kt = 1; kt < 4; ++kt) mr = fmaxf(mr, fmaxf(fmaxf(sc[kt][0], sc[kt][1]), fmaxf(sc[kt][2], sc[kt][3])));
  float mx = far ? __builtin_fmaf(mr, qs, bb) : mr;
  mx = quadmax_f(mx);
  { const float mn = (mx > S_.m + FTHR) ? mx : S_.m;
    const float al = __builtin_amdgcn_exp2f(S_.m - mn); S_.m = mn; S_.l *= al; xch[16 * CT + j] = al;
    const f32x4_t a = *(const f32x4_t*)&xch[16 * CT + 4 * q4];
    S_.o0 *= a; S_.o1 *= a; S_.o2 *= a; S_.o3 *= a; }
  const float bm = bb - S_.m; float ps[4];
#pragma unroll
  for (int kt = 0; kt < 4; ++kt) {
#pragma unroll
    for (int r = 0; r < 4; ++r) { const float e_ = __builtin_amdgcn_exp2f(__builtin_fmaf(sc[kt][r], qs, bm)); sc[kt][r] = e_; ps[kt] = r ? ps[kt] + e_ : e_; } }
  S_.l += (ps[0] + ps[1]) + (ps[2] + ps[3]);
}
template <bool A0, bool A1, bool far, bool HOT>
__device__ __forceinline__ void aw_step(Asel16& t0, Asel16& t1, AselW* A, int w, const bf16x8& qa0, const bf16x8& qa1, const bf16x8& qb0, const bf16x8& qb1, bool selq0, bool selq1,
                                        int b, bool more, int nb, int q0w, int cur, float c31, const float* rel, const SB* kvb, unsigned ldsk, unsigned ldsv, const AwOff& fk, const AwOff& fv, int lane) {
  const int j = lane & 15, q4 = lane >> 4;
  const bool edge = (b == cur);
  float* xch = A->xch[w];
  asm volatile("s_waitcnt vmcnt(8)" ::: "memory");
  f32x4_t sa[4], sb[4];
  { bf16x8 k0[4], k1[4];
#pragma unroll
    for (int kt = 0; kt < 4; ++kt) { const int row = 16 * kt + j;
      k0[kt] = *(const bf16x8*)&A->k[w][row * 64 + (((q4) ^ ((row >> 1) & 7)) * 8)]; k1[kt] = *(const bf16x8*)&A->k[w][row * 64 + (((4 + q4) ^ ((row >> 1) & 7)) * 8)]; }
    asm volatile("s_waitcnt lgkmcnt(0)" ::: "memory");
    if (more && !HOT) aw_dma8(kvb + (long)nb * 64 * NPROJ, fk, ldsk);
#pragma unroll
    for (int kt = 0; kt < 4; ++kt) { const f32x4_t z = {0.f, 0.f, 0.f, 0.f};
      if (A0) { sa[kt] = MFMA16(k0[kt], qa0, z); sa[kt] = MFMA16(k1[kt], qa1, sa[kt]); }
      if (A1) { sb[kt] = MFMA16(k0[kt], qb0, z); sb[kt] = MFMA16(k1[kt], qb1, sb[kt]); } } }
  if (A0) aw_softmax<0, far>(t0, sa, A, rel, xch, selq0, edge, q0w + (j >> 2), b, c31, lane);
  if (A1) aw_softmax<1, far>(t1, sb, A, rel, xch, selq1, edge, q0w + 4 + (j >> 2), b, c31, lane);
  bf16x8 pa0, pa1, pb0, pb1;
  if (A0) { pa0 = pack44(sa[0], sa[1]); pa1 = pack44(sa[2], sa[3]); }
  if (A1) { pb0 = pack44(sb[0], sb[1]); pb1 = pack44(sb[2], sb[3]); }
  if (more) asm volatile("s_waitcnt vmcnt(8)" ::: "memory"); else asm volatile("s_waitcnt vmcnt(0)" ::: "memory");
  const unsigned short* vb0 = A->v[w] + (4 * q4 + (j >> 2)) * 32 + (j & 3) * 4 + (q4 & 1) * 16; const unsigned short* vb1 = vb0 + 16 - (q4 & 1) * 32;
#pragma unroll
  for (int c = 0; c < 2; ++c) {
#pragma unroll
    for (int dt = 0; dt < 4; ++dt) {
      const unsigned short* vb = (dt & 1) ? vb1 : vb0;
      const v4i16_t lo = __builtin_amdgcn_ds_read_tr16_b64_v4i16((LDS3 v4i16_t*)(vb + (dt >> 1) * 2048 + c * 1024));
      const v4i16_t hh = __builtin_amdgcn_ds_read_tr16_b64_v4i16((LDS3 v4i16_t*)(vb + (dt >> 1) * 2048 + c * 1024 + 512));
      const bf16x8 vf = {lo[0], lo[1], lo[2], lo[3], hh[0], hh[1], hh[2], hh[3]};
      if (A0) { const bf16x8 pa = c ? pa1 : pa0; if (dt == 0) t0.o0 = MFMA16(pa, vf, t0.o0); else if (dt == 1) t0.o1 = MFMA16(pa, vf, t0.o1); else if (dt == 2) t0.o2 = MFMA16(pa, vf, t0.o2); else t0.o3 = MFMA16(pa, vf, t0.o3); }
      if (A1) { const bf16x8 pb = c ? pb1 : pb0; if (dt == 0) t1.o0 = MFMA16(pb, vf, t1.o0); else if (dt == 1) t1.o1 = MFMA16(pb, vf, t1.o1); else if (dt == 2) t1.o2 = MFMA16(pb, vf, t1.o2); else t1.o3 = MFMA16(pb, vf, t1.o3); }
    }
  }
  asm volatile("s_waitcnt lgkmcnt(0)" ::: "memory");
  if (more && !HOT) aw_dma8(kvb + (long)nb * 64 * NPROJ, fv, ldsv);
}
__device__ __forceinline__ void asel_w_tables(const Params& p, AselW* A) {
  const int tid = threadIdx.x;
  for (int i = tid; i < 1664; i += 256) A->bkt[i] = (unsigned char)t5_bucket(i);
  A->relS[tid] = p.rel_bias[((tid & 127) >> 2) * 32 + (tid >> 7) * 4 + (tid & 3)] * L2E;
}
template <bool STORE = true, bool HOT = false, bool NLZ = false>
__device__ __forceinline__ void asel_w_wave(const Params& p, int g, int q0w, AselW* A, int w, int lane) {
  const int j = lane & 15, q4 = lane >> 4; const int cur = q0w >> 6; const float* rel = A->relS + g * 128;
  const SB* kvb = p.proj + PA_KV + 2 * 128 + g * 64;
  A->sel[8 * w + (lane >> 3)][lane & 7] = 0u;
  asm volatile("s_waitcnt lgkmcnt(0)" ::: "memory");
  topk4_rows_o(p, [&](int r) { return (q0w + r) * 2 + g; }, [&](int r, int b) { if (b >= 0) atomicOr(&A->sel[8 * w + r][b >> 5], 1u << (b & 31)); }, lane);
  topk4_rows_o(p, [&](int r) { return (q0w + 4 + r) * 2 + g; }, [&](int r, int b) { if (b >= 0) atomicOr(&A->sel[8 * w + 4 + r][b >> 5], 1u << (b & 31)); }, lane);
  asm volatile("s_waitcnt lgkmcnt(0)" ::: "memory");
  if (lane < 8) { unsigned o = 0u;
#pragma unroll
    for (int r = 0; r < 8; ++r) o |= A->sel[8 * w + r][lane];
    A->anyw[w][lane] = o; }
  asm volatile("s_waitcnt lgkmcnt(0)" ::: "memory");
  { const unsigned wbits = A->anyw[w][lane >> 3]; const unsigned nib = (wbits >> ((lane & 7) * 4)) & 15u; const int cnt = __popc(nib);
    int pre = cnt;
#pragma unroll
    for (int o = 1; o < 64; o <<= 1) { const int v = __shfl_up(pre, o); if (lane >= o) pre += v; }
    int pos = pre - cnt;
#pragma unroll
    for (int k = 0; k < 4; ++k) if ((nib >> k) & 1u) A->wl[w][pos++] = (unsigned char)(lane * 4 + k);
    if (lane == 63) A->nl[w] = pre; }
  asm volatile("s_waitcnt lgkmcnt(0)" ::: "memory");
  const int hq = g * 4 + (lane & 3); const float c31 = p.tabA[hq * TABA_N + 2047] * L2E;
  const SB* qpa = p.proj + (long)(q0w + (j >> 2)) * NPROJ + PA_Q + hq * 64 + 8 * q4; const SB* qpb = qpa + 4L * NPROJ;
  const bf16x8 qa0 = *(const GLB1 bf16x8*)qpa, qa1 = *(const GLB1 bf16x8*)(qpa + 32), qb0 = *(const GLB1 bf16x8*)qpb, qb1 = *(const GLB1 bf16x8*)(qpb + 32);
  Asel16 t0, t1;
  { const f32x4_t z4 = {0.f, 0.f, 0.f, 0.f}; t0.o0 = z4; t0.o1 = z4; t0.o2 = z4; t0.o3 = z4; t0.m = -1e30f; t0.l = 0.f; t1 = t0; }
  AwOff fk, fv;
#pragma unroll
  for (int pk = 0; pk < 8; ++pk) { fk.o[pk] = (unsigned)((pk * 8 + (lane >> 3)) * NPROJ * 2 + (((lane & 7) ^ (lane >> 4) ^ ((pk & 1) * 4)) * 16));
    fv.o[pk] = (unsigned)(256 + ((pk & 3) * 16 + (lane >> 2)) * NPROJ * 2 + (pk >> 2) * 64 + (((lane & 3) ^ (((lane >> 4) & 1) << 1)) * 16)); }
  const unsigned ldsk = (unsigned)__builtin_amdgcn_readfirstlane((int)lds_addr(&A->k[w][0])), ldsv = (unsigned)__builtin_amdgcn_readfirstlane((int)lds_addr(&A->v[w][0]));
  const int nl = NLZ ? 0 : __builtin_amdgcn_readfirstlane(A->nl[w]);
  asm volatile("s_waitcnt vmcnt(0) lgkmcnt(0)" ::: "memory");
  if (nl > 0) { const int b0 = __builtin_amdgcn_readfirstlane((int)A->wl[w][0]); aw_dma8(kvb + (long)b0 * 64 * NPROJ, fk, ldsk); aw_dma8(kvb + (long)b0 * 64 * NPROJ, fv, ldsv); }
  int b = __builtin_amdgcn_readfirstlane((int)A->wl[w][0]), nb = __builtin_amdgcn_readfirstlane((int)A->wl[w][1]);
  unsigned sw0 = A->sel[8 * w + (j >> 2)][b >> 5], sw1 = A->sel[8 * w + 4 + (j >> 2)][b >> 5];
  for (int i = 0; i < nl; ++i) {
    const bool more = i + 1 < nl;
    const unsigned nsw0 = *(volatile unsigned*)&A->sel[8 * w + (j >> 2)][nb >> 5], nsw1 = *(volatile unsigned*)&A->sel[8 * w + 4 + (j >> 2)][nb >> 5];
    const unsigned nnbv = *(volatile unsigned char*)&A->wl[w][(i + 2) & 255];
    const bool selq0 = (sw0 >> (b & 31)) & 1u, selq1 = (sw1 >> (b & 31)) & 1u;
    const bool a0 = __any(selq0), a1 = __any(selq1);
    const bool far = (q0w - (b * 64 + 63)) >= 1513;
    if (far) {
      if (a0 && a1) aw_step<true, true, true, HOT>(t0, t1, A, w, qa0, qa1, qb0, qb1, selq0, selq1, b, more, nb, q0w, cur, c31, rel, kvb, ldsk, ldsv, fk, fv, lane);
      else if (a0) aw_step<true, false, true, HOT>(t0, t1, A, w, qa0, qa1, qb0, qb1, selq0, selq1, b, more, nb, q0w, cur, c31, rel, kvb, ldsk, ldsv, fk, fv, lane);
      else aw_step<false, true, true, HOT>(t0, t1, A, w, qa0, qa1, qb0, qb1, selq0, selq1, b, more, nb, q0w, cur, c31, rel, kvb, ldsk, ldsv, fk, fv, lane);
    } else {
      if (a0 && a1) aw_step<true, true, false, HOT>(t0, t1, A, w, qa0, qa1, qb0, qb1, selq0, selq1, b, more, nb, q0w, cur, c31, rel, kvb, ldsk, ldsv, fk, fv, lane);
      else if (a0) aw_step<true, false, false, HOT>(t0, t1, A, w, qa0, qa1, qb0, qb1, selq0, selq1, b, more, nb, q0w, cur, c31, rel, kvb, ldsk, ldsv, fk, fv, lane);
      else aw_step<false, true, false, HOT>(t0, t1, A, w, qa0, qa1, qb0, qb1, selq0, selq1, b, more, nb, q0w, cur, c31, rel, kvb, ldsk, ldsv, fk, fv, lane);
    }
    b = nb; sw0 = nsw0; sw1 = nsw1; nb = __builtin_amdgcn_readfirstlane((int)nnbv);
  }
  asm volatile("s_waitcnt vmcnt(0)" ::: "memory");
  float* xch = A->xch[w];
  if (STORE) { asel_store16<0>(p, t0, xch, q0w, 0, g, lane); asel_store16<1>(p, t1, xch, q0w, 0, g, lane); } else asm volatile("" :: "v"(t0.o0[0]), "v"(t1.o1[2]), "v"(t0.l), "v"(t1.l));
}
template <bool STORE = true, bool HOT = false, bool NLZ = false>
__device__ __forceinline__ void unit_asel_w(const Params& p, int u, AselW* A) {
  int tid = threadIdx.x; asm volatile("" : "+v"(tid));
  const int lane = tid & 63, w = __builtin_amdgcn_readfirstlane(tid >> 6);
  __syncthreads(); asel_w_tables(p, A); __syncthreads();
  asel_w_wave<STORE, HOT, NLZ>(p, u & 1, ((p.S / 32 - 1) - (u >> 1)) * 32 + 8 * w, A, w, lane);
}
template <bool STORE = true>
__device__ __forceinline__ void unit_bout_blk(const Params& p, int layer, int ub, char* smem) {
  int tid = threadIdx.x; asm volatile("" : "+v"(tid));
  const int lane = tid & 63, w = __builtin_amdgcn_readfirstlane(tid >> 6), r32 = lane & 31, hi = lane >> 5;
  const int lt = ub & 3, g = (ub >> 2) & 1, c = ub >> 3, hd = g * 4 + w;
  WaveLds2* L = ((WaveLds2*)smem) + w;
  __syncthreads();
  for (int x = lane; x < 128; x += 64) { L->acs[x] = p.acs[((long)c * 128 + x) * 8 + hd]; L->dtv[x] = p.dt[((long)c * 128 + x) * 8 + hd]; }
  f32x16 acc[2] = {zero16(), zero16()}, acc2[2] = {zero16(), zero16()};
  const SB* xb = p.xconv + (long)c * 128 * 1024; const int l = 32 * lt + r32; const float al = p.acs[((long)c * 128 + l) * 8 + hd];
  const float* cbr = p.cb + ((long)c * 2 + g) * 16384 + (long)l * 128;
  for (int sc = 0; sc <= lt; ++sc) {
    stage_slab<false>(L->x, xb + (long)(32 * sc) * 1024 + hd * 64, 1024, [&](int) { return 1.f; }, lane);
#pragma unroll
    for (int s2 = 0; s2 < 2; ++s2) { float mv[8];
#pragma unroll
      for (int jj = 0; jj < 2; ++jj) { const int s0 = 32 * sc + 16 * s2 + 8 * jj + 4 * hi; const float4 cv = *(const float4*)(cbr + s0); const float4 av = *(const float4*)(&L->acs[s0]); const float4 dv = *(const float4*)(&L->dtv[s0]);
        mv[4 * jj + 0] = (s0 + 0 <= l) ? cv.x * __expf(al - av.x) * dv.x : 0.f; mv[4 * jj + 1] = (s0 + 1 <= l) ? cv.y * __expf(al - av.y) * dv.y : 0.f;
        mv[4 * jj + 2] = (s0 + 2 <= l) ? cv.z * __expf(al - av.z) * dv.z : 0.f; mv[4 * jj + 3] = (s0 + 3 <= l) ? cv.w * __expf(al - av.w) * dv.w : 0.f; }
      u32x4 aw; aw[0] = pk2(mv[0], mv[1]); aw[1] = pk2(mv[2], mv[3]); aw[2] = pk2(mv[4], mv[5]); aw[3] = pk2(mv[6], mv[7]); const bf16x8 af = __builtin_bit_cast(bf16x8, aw);
#pragma unroll
      for (int pt = 0; pt < 2; ++pt) acc[pt] = MFMA32(af, slab_frag(L->x, pt, s2, lane), acc[pt]); } }
  const SB* cmr = xb + (long)l * 1024 + 768 + g * 128; const float* prv = p.states + ((long)c * 8 + hd) * 8192;
#pragma unroll 2
  for (int ks = 0; ks < 8; ++ks) { const bf16x8 af = *(const bf16x8*)(cmr + 16 * ks + 8 * hi);
#pragma unroll
    for (int pt = 0; pt < 2; ++pt) { const float* pr = prv + (long)(32 * pt + r32) * 128 + 16 * ks + 8 * hi; const float4 a0 = *(const float4*)pr, a1 = *(const float4*)(pr + 4);
      u32x4 bw; bw[0] = pk2(a0.x, a0.y); bw[1] = pk2(a0.z, a0.w); bw[2] = pk2(a1.x, a1.y); bw[3] = pk2(a1.z, a1.w);
      acc2[pt] = MFMA32(af, __builtin_bit_cast(bf16x8, bw), acc2[pt]); } }
  const float dsk = p.b_d[layer * 8 + hd];
  float* yl = (float*)L;
#pragma unroll
  for (int e = 0; e < 16; ++e) { const int lr = crow(e, hi); const float ea = __expf(L->acs[32 * lt + lr]);
#pragma unroll
    for (int pt = 0; pt < 2; ++pt) { const int pp = 32 * pt + r32; yl[lr * 64 + pp] = acc[pt][e] + ea * acc2[pt][e] + dsk * bf2f(xb[(long)(32 * lt + lr) * 1024 + hd * 64 + pp]); } }
  __syncthreads();
  { const int row = tid >> 3, sub = tid & 7; const long t = (long)c * 128 + 32 * lt + row; SB* mp = p.mix + t * NMIX + MX_B + g * 256 + sub * 32;
    const float* ysrc = (const float*)(((WaveLds2*)smem) + (sub >> 1)) + row * 64 + (sub & 1) * 32;
    float vv[32]; float ss = 0.f;
#pragma unroll
    for (int i = 0; i < 4; ++i) { const uint4 zz = *(const uint4*)(mp + 8 * i); const unsigned zw[4] = {zz.x, zz.y, zz.z, zz.w};
#pragma unroll
      for (int k = 0; k < 4; ++k) { const float y0 = ysrc[8 * i + 2 * k] * __uint_as_float(zw[k] << 16), y1 = ysrc[8 * i + 2 * k + 1] * __uint_as_float(zw[k] & 0xffff0000u); vv[8 * i + 2 * k] = y0; vv[8 * i + 2 * k + 1] = y1; ss += y0 * y0 + y1 * y1; } }
    ss += __shfl_xor(ss, 1); ss += __shfl_xor(ss, 2); ss += __shfl_xor(ss, 4);
    const float r = 1.f / sqrtf(ss * (1.f / 256.f) + 1e-6f); const float* wn = p.b_norm + layer * 512 + g * 256 + sub * 32;
#pragma unroll
    for (int i = 0; i < 4; ++i) { uint4 o; o.x = pk2(vv[8 * i] * r * wn[8 * i], vv[8 * i + 1] * r * wn[8 * i + 1]); o.y = pk2(vv[8 * i + 2] * r * wn[8 * i + 2], vv[8 * i + 3] * r * wn[8 * i + 3]);
      o.z = pk2(vv[8 * i + 4] * r * wn[8 * i + 4], vv[8 * i + 5] * r * wn[8 * i + 5]); o.w = pk2(vv[8 * i + 6] * r * wn[8 * i + 6], vv[8 * i + 7] * r * wn[8 * i + 7]); if (STORE) *(uint4*)(mp + 8 * i) = o; else asm volatile("" :: "v"(o.x), "v"(o.w)); } }
}

__device__ __forceinline__ void unit_memkv(const Params& p, int u, int lane) {
  const int l = u >> 8, m = u & 255; const float* row = p.mem + (long)m * DM; const float* nw = p.m_norm + l * DM; const float* w = p.m_wkv + (long)l * DM * 512 + lane * 8;
  float ss = 0.f;
#pragma unroll
  for (int i = 0; i < 4; ++i) { const float4 v = *(const float4*)(row + i * 256 + lane * 4); ss += v.x * v.x + v.y * v.y + v.z * v.z + v.w * v.w; }
  ss = wave_sum_f(ss); const float r = 1.f / sqrtf(ss * (1.f / DM) + 1e-6f);
  float acc[8] = {0.f, 0.f, 0.f, 0.f, 0.f, 0.f, 0.f, 0.f};
#pragma unroll 8
  for (int d = 0; d < DM; ++d) { const float a = row[d] * r * nw[d]; const float4 w0 = *(const float4*)(w + (long)d * 512), w1 = *(const float4*)(w + (long)d * 512 + 4);
    acc[0] += a * w0.x; acc[1] += a * w0.y; acc[2] += a * w0.z; acc[3] += a * w0.w; acc[4] += a * w1.x; acc[5] += a * w1.y; acc[6] += a * w1.z; acc[7] += a * w1.w; }
  uint4 o; o.x = pk2(acc[0], acc[1]); o.y = pk2(acc[2], acc[3]); o.z = pk2(acc[4], acc[5]); o.w = pk2(acc[6], acc[7]);
  *(uint4*)(p.memkv + (long)u * 512 + lane * 8) = o;
}

__device__ __forceinline__ void item_dmerge(const Params& p, long gid) {
  const int c8 = (int)(gid & 63), h = c8 >> 3; const long q = gid >> 6; const long S = p.S;
  const float l0 = p.dlse[(0 * S + q) * 8 + h], l1 = p.dlse[(1 * S + q) * 8 + h], l2 = p.dlse[(2 * S + q) * 8 + h];
  const float mm = fmaxf(l0, fmaxf(l1, l2)); float e0 = __expf(l0 - mm), e1 = __expf(l1 - mm), e2 = __expf(l2 - mm); const float is = 1.f / (e0 + e1 + e2); e0 *= is; e1 *= is; e2 *= is;
  const long c = q * 512 + c8 * 8; const uint4 a = *(const uint4*)(p.dop + c), b = *(const uint4*)(p.dop + S * 512 + c), d = *(const uint4*)(p.dop + 2 * S * 512 + c);
  SB* mp = p.mix + q * NMIX + MX_D + c8 * 8; const uint4 z = *(const uint4*)mp;
  const unsigned aw[4] = {a.x, a.y, a.z, a.w}, bw[4] = {b.x, b.y, b.z, b.w}, dw[4] = {d.x, d.y, d.z, d.w}, zw[4] = {z.x, z.y, z.z, z.w}; unsigned ow[4];
#pragma unroll
  for (int k = 0; k < 4; ++k) {
    const float lo = (e0 * __uint_as_float(aw[k] << 16) + e1 * __uint_as_float(bw[k] << 16) + e2 * __uint_as_float(dw[k] << 16)) * __uint_as_float(zw[k] << 16);
    const float hi = (e0 * __uint_as_float(aw[k] & 0xffff0000u) + e1 * __uint_as_float(bw[k] & 0xffff0000u) + e2 * __uint_as_float(dw[k] & 0xffff0000u)) * __uint_as_float(zw[k] & 0xffff0000u);
    ow[k] = pk2(lo, hi); }
  uint4 o; o.x = ow[0]; o.y = ow[1]; o.z = ow[2]; o.w = ow[3]; *(uint4*)mp = o;
}

__device__ __forceinline__ void unit_cmp_blk(const Params& p, int layer, int u, float* red  ) {
  int tid = threadIdx.x; asm volatile("" : "+v"(tid));
  const int lane = tid & 63, w = __builtin_amdgcn_readfirstlane(tid >> 6), r32 = lane & 31, hi = lane >> 5;
  const int ncmp = p.S / 16, ntile = ncmp * 2 / 32; const int kv = u / ntile, rt = u % ntile;
  const int r = 32 * rt + r32, j = r >> 1, hk = r & 1;
  const unsigned short* w1t = p.w1t + (long)kv * 128 * 2048; const unsigned short* w2t = p.w2t + kv * 64 * 128; const float* pe = p.cmp_pos + (long)(layer * 2 + kv) * 32 * 64;
  const SB* src = p.proj + PA_KV + kv * 128 + hk * 64;
  f32x16 acc[4] = {zero16(), zero16(), zero16(), zero16()};
  typedef float f32x4g __attribute__((ext_vector_type(4)));
  f32x4g p0n, p1n; u32x4 vvn; bf16x8 afn[4]; float vmn;
#define CMPB_LOAD(ks_) { const int t_ = (ks_) >> 2, d_ = ((ks_) & 3) * 16 + 8 * hi; const long tok_ = 16 * j + t_; const long tokc_ = tok_ < p.S ? tok_ : (long)p.S - 1; vmn = tok_ < p.S ? 1.f : 0.f; \
    p0n = *(const GLB1 f32x4g*)(pe + t_ * 64 + d_); p1n = *(const GLB1 f32x4g*)(pe + t_ * 64 + d_ + 4); vvn = *(const GLB1 u32x4*)(src + tokc_ * NPROJ + d_); \
    _Pragma("unroll") for (int ut_ = 0; ut_ < 4; ++ut_) afn[ut_] = *(const GLB1 bf16x8*)(w1t + (long)(32 * ut_ + r32) * 2048 + 16 * (ks_) + 8 * hi); }
  CMPB_LOAD(32 * w)
#pragma unroll 2
  for (int ks = 32 * w; ks < 32 * w + 32; ++ks) {
    const f32x4g p0 = p0n, p1 = p1n; const u32x4 vv = vvn; const float vm = vmn; bf16x8 af[4];
#pragma unroll
    for (int ut = 0; ut < 4; ++ut) af[ut] = afn[ut];
    { const int kn = (ks + 1 < 32 * w + 32) ? ks + 1 : ks; CMPB_LOAD(kn) }
    float v[8] = {p0[0], p0[1], p0[2], p0[3], p1[0], p1[1], p1[2], p1[3]};
#pragma unroll
    for (int k = 0; k < 4; ++k) { v[2 * k] += vm * __uint_as_float(vv[k] << 16); v[2 * k + 1] += vm * __uint_as_float(vv[k] & 0xffff0000u); }
    u32x4 bw; bw[0] = pk2(v[0], v[1]); bw[1] = pk2(v[2], v[3]); bw[2] = pk2(v[4], v[5]); bw[3] = pk2(v[6], v[7]); const bf16x8 bfr = __builtin_bit_cast(bf16x8, bw);
#pragma unroll
    for (int ut = 0; ut < 4; ++ut) acc[ut] = MFMA32(af[ut], bfr, acc[ut]); }
#undef CMPB_LOAD
  __syncthreads();
#pragma unroll
  for (int ut = 0; ut < 4; ++ut)
#pragma unroll
    for (int q4 = 0; q4 < 4; ++q4) *(float4*)&red[(((w * 4 + ut) * 4 + q4) * 64 + lane) * 4] = make_float4(acc[ut][4 * q4], acc[ut][4 * q4 + 1], acc[ut][4 * q4 + 2], acc[ut][4 * q4 + 3]);
  __syncthreads();
  f32x16 hsum = zero16();
#pragma unroll
  for (int w2 = 0; w2 < 4; ++w2)
#pragma unroll
    for (int q4 = 0; q4 < 4; ++q4) { const float4 t4 = *(const float4*)&red[(((w2 * 4 + w) * 4 + q4) * 64 + lane) * 4]; hsum[4 * q4] += t4.x; hsum[4 * q4 + 1] += t4.y; hsum[4 * q4 + 2] += t4.z; hsum[4 * q4 + 3] += t4.w; }
#pragma unroll
  for (int e = 0; e < 16; ++e) hsum[e] = gelu_fast(hsum[e]);
  f32x16 o2[2] = {zero16(), zero16()};
#pragma unroll
  for (int s2 = 0; s2 < 2; ++s2) { const bf16x8 hb = pack8(hsum, 8 * s2);
#pragma unroll
    for (int dt = 0; dt < 2; ++dt) { const unsigned short* wr = w2t + (32 * dt + r32) * 128 + 32 * w + 16 * s2 + 4 * hi; const uint2 x0 = *(const uint2*)wr, x1 = *(const uint2*)(wr + 8);
      u32x4 aw; aw[0] = x0.x; aw[1] = x0.y; aw[2] = x1.x; aw[3] = x1.y; o2[dt] = MFMA32(__builtin_bit_cast(bf16x8, aw), hb, o2[dt]); } }
  __syncthreads();
#pragma unroll
  for (int dt = 0; dt < 2; ++dt)
#pragma unroll
    for (int q4 = 0; q4 < 4; ++q4) *(float4*)&red[(((w * 2 + dt) * 4 + q4) * 64 + lane) * 4] = make_float4(o2[dt][4 * q4], o2[dt][4 * q4 + 1], o2[dt][4 * q4 + 2], o2[dt][4 * q4 + 3]);
  __syncthreads();
  if (w < 2) {
    const int dt = w; SB* dst = p.kvc + ((long)kv * ncmp * 2 + r) * 64;
#pragma unroll
    for (int q4 = 0; q4 < 4; ++q4) { float4 s4 = make_float4(0.f, 0.f, 0.f, 0.f);
#pragma unroll
      for (int w2 = 0; w2 < 4; ++w2) { const float4 t4 = *(const float4*)&red[(((w2 * 2 + dt) * 4 + q4) * 64 + lane) * 4]; s4.x += t4.x; s4.y += t4.y; s4.z += t4.z; s4.w += t4.w; }
      dst[32 * dt + crow(4 * q4 + 0, hi)] = f2bf(s4.x); dst[32 * dt + crow(4 * q4 + 1, hi)] = f2bf(s4.y); dst[32 * dt + crow(4 * q4 + 2, hi)] = f2bf(s4.z); dst[32 * dt + crow(4 * q4 + 3, hi)] = f2bf(s4.w); } }
}

#define SEQ 16384
#define DEPTH 4

__device__ __forceinline__ int n2o(int n) {
  if (n < 1280) return n;
  if (n < 2304) return n - 1280 + 1816;
  if (n < 2816) return n - 2304 + 3360;
  if (n < 3072) return n - 2816 + 3872;
  if (n < 4608) return n - 3072 + 4640;
  if (n < 5632) return n - 4608 + 6176;
  if (n < 5888) return n - 5632 + 7712;
  n -= 5888;
  if (n < 512) return 1304 + n;
  if (n < 1024) return 2848 + n - 512;
  if (n < 1536) return 4128 + n - 1024;
  if (n < 2048) return 7200 + n - 1536;
  if (n < 2304) return 7968 + n - 2048;
  n -= 2304;
  if (n < 24) return 1280 + n;
  if (n < 32) return 2840 + n - 24;
  return -1;
}

template <bool MAP>
__device__ __forceinline__ void cvt_tile(const float* __restrict__ src, int lds_, unsigned short* __restrict__ dst, int ldd, int k0, int n0, float* tile  ) {
  int tid = threadIdx.x; asm volatile("" : "+v"(tid));
  __syncthreads();
  float v[16];
#pragma unroll
  for (int e = 0; e < 16; ++e) { int idx = tid + 256 * e, kk = idx >> 6, nn = idx & 63; int oc = MAP ? n2o(n0 + nn) : (n0 + nn); v[e] = src[(long)(k0 + kk) * lds_ + (oc < 0 ? 0 : oc)]; }
#pragma unroll
  for (int e = 0; e < 16; ++e) { int idx = tid + 256 * e, kk = idx >> 6, nn = idx & 63; int oc = MAP ? n2o(n0 + nn) : (n0 + nn); tile[kk * 65 + nn] = (oc >= 0) ? v[e] : 0.f; }
  __syncthreads();
#pragma unroll
  for (int e = 0; e < 16; ++e) { int idx = tid + 256 * e, nn = idx >> 6, kk = idx & 63; dst[(long)(n0 + nn) * ldd + k0 + kk] = f2bf(tile[kk * 65 + nn]); }
}

__device__ __forceinline__ float wave_sum(float v) {
#pragma unroll
  for (int o = 32; o > 0; o >>= 1) v += __shfl_xor(v, o);
  return v;
}

__device__ __forceinline__ void norm_row_wave(const Params& p, int layer, int t, bool do_h, int lane) {
  const float* xin = (layer == 0) ? p.x + (long)t * DM : p.out + (long)t * DM;
  float4 xv[4], yv[4];
#pragma unroll
  for (int i = 0; i < 4; ++i) xv[i] = *(const float4*)(xin + i * 256 + lane * 4);
  if (layer > 0) {
    float ss = 0.f;
#pragma unroll
    for (int i = 0; i < 4; ++i) { yv[i] = *(const float4*)(p.y + (long)t * DM + i * 256 + lane * 4); ss += yv[i].x * yv[i].x + yv[i].y * yv[i].y + yv[i].z * yv[i].z + yv[i].w * yv[i].w; }
    ss = wave_sum(ss); float r1 = 1.f / sqrtf(ss / DM + 1e-6f);
#pragma unroll
    for (int i = 0; i < 4; ++i) { float4 w = *(const float4*)(p.post_norm + (layer - 1) * DM + i * 256 + lane * 4);
      xv[i].x += yv[i].x * r1 * w.x; xv[i].y += yv[i].y * r1 * w.y; xv[i].z += yv[i].z * r1 * w.z; xv[i].w += yv[i].w * r1 * w.w; }
  }
  float ss2 = 0.f;
#pragma unroll
  for (int i = 0; i < 4; ++i) { *(float4*)(p.out + (long)t * DM + i * 256 + lane * 4) = xv[i]; ss2 += xv[i].x * xv[i].x + xv[i].y * xv[i].y + xv[i].z * xv[i].z + xv[i].w * xv[i].w; }
  if (!do_h) return;
  ss2 = wave_sum(ss2); float r2 = 1.f / sqrtf(ss2 / DM + 1e-6f);
#pragma unroll
  for (int i = 0; i < 4; ++i) { float4 w = *(const float4*)(p.pre_norm + layer * DM + i * 256 + lane * 4);
    ushort4 o; o.x = f2bf(xv[i].x * r2 * w.x); o.y = f2bf(xv[i].y * r2 * w.y); o.z = f2bf(xv[i].z * r2 * w.z); o.w = f2bf(xv[i].w * r2 * w.w);
    *(ushort4*)(p.h + (long)t * DM + i * 256 + lane * 4) = o; }
}

#ifndef GMI
#define GMI 4
#endif
struct GemmSmem { unsigned short a[3][64 * GMI * 32]; unsigned short b[3][128 * 32]; };
__device__ __forceinline__ void glds16(const void* g, void* lds_wave_base) { __builtin_amdgcn_global_load_lds((gptr_t)g, (lptr_t)lds_wave_base, 16, 0, 0); }
template <int EPI, int MI, bool DRY = false>
__device__ __forceinline__ void gemm_tile(const Params& p, const unsigned short* __restrict__ A, int lda, const unsigned short* __restrict__ Bt, int ldb, int K, int m0, int n0, GemmSmem& sm, float* outp = nullptr) {
  int tid = threadIdx.x; asm volatile("" : "+v"(tid));
  const int lane = tid & 63, wid = __builtin_amdgcn_readfirstlane(tid >> 6), wr = wid >> 1, wc = wid & 1, r = lane & 31, h = lane >> 5;
  f32x16 acc[MI][2];
#pragma unroll
  for (int i = 0; i < MI; ++i)
#pragma unroll
    for (int j = 0; j < 2; ++j) acc[i][j] = zero16();
  const int prow = lane >> 2, pc = lane & 3;
  const unsigned short* ga[MI]; const unsigned short* gb[2];
#pragma unroll
  for (int i = 0; i < MI; ++i) { const int row = (wid * MI + i) * 16 + prow; ga[i] = A + (long)(m0 + row) * lda + ((pc ^ ((row >> 2) & 3)) * 8); }
#pragma unroll
  for (int i = 0; i < 2; ++i) { const int row = (wid * 2 + i) * 16 + prow; gb[i] = Bt + (long)(n0 + row) * ldb + ((pc ^ ((row >> 2) & 3)) * 8); }
#define GEMM_DMA(stg, ko) { _Pragma("unroll") for (int i_ = 0; i_ < MI; ++i_) glds16(ga[i_] + (ko), &sm.a[stg][(wid * MI + i_) * 512]); _Pragma("unroll") for (int i_ = 0; i_ < 2; ++i_) glds16(gb[i_] + (ko), &sm.b[stg][(wid * 2 + i_) * 512]); }
  __syncthreads();
  const int nk = K / 32;
  GEMM_DMA(0, 0)
  if (nk > 1) GEMM_DMA(1, 32)
  int cur = 0;
  for (int kt = 0; kt < nk; ++kt) {
    if (kt + 1 < nk) { if (MI == 4) asm volatile("s_waitcnt vmcnt(6) lgkmcnt(0)\n\ts_barrier" ::: "memory"); else asm volatile("s_waitcnt vmcnt(4) lgkmcnt(0)\n\ts_barrier" ::: "memory"); }
    else asm volatile("s_waitcnt vmcnt(0) lgkmcnt(0)\n\ts_barrier" ::: "memory");
    if (kt + 2 < nk) { const int s2_ = (cur == 0) ? 2 : cur - 1; GEMM_DMA(s2_, (kt + 2) * 32) }
#pragma unroll
    for (int ks = 0; ks < 2; ++ks) {
      bf16x8 af[MI], bfr[2];
#pragma unroll
      for (int i = 0; i < MI; ++i) { const int row = wr * (32 * MI) + i * 32 + r; af[i] = *(const bf16x8*)&sm.a[cur][row * 32 + (((2 * ks + h) ^ ((row >> 2) & 3)) * 8)]; }
#pragma unroll
      for (int j = 0; j < 2; ++j) { const int row = wc * 64 + j * 32 + r; bfr[j] = *(const bf16x8*)&sm.b[cur][row * 32 + (((2 * ks + h) ^ ((row >> 2) & 3)) * 8)]; }
#pragma unroll
      for (int i = 0; i < MI; ++i)
#pragma unroll
        for (int j = 0; j < 2; ++j) acc[i][j] = __builtin_amdgcn_mfma_f32_32x32x16_bf16(af[i], bfr[j], acc[i][j], 0, 0, 0);
    }
    cur = (cur == 2) ? 0 : cur + 1;
  }
#undef GEMM_DMA
  __syncthreads();
  if (DRY) {
#pragma unroll
    for (int i = 0; i < MI; ++i) asm volatile("" :: "v"(acc[i][0]), "v"(acc[i][1]));
    return; }
  const int ncol0 = n0 + wc * 64;
  const int mrow0 = m0 + wr * (32 * MI);
  if (EPI == 2) {
#pragma unroll
    for (int i = 0; i < MI; ++i)
#pragma unroll
      for (int j = 0; j < 2; ++j)
#pragma unroll
        for (int e = 0; e < 16; ++e) { int row = mrow0 + i * 32 + (e & 3) + 8 * (e >> 2) + 4 * h; outp[row * 128 + ncol0 + j * 32 + r] = acc[i][j][e]; }
  } else if (EPI == 1) {
#pragma unroll
    for (int i = 0; i < MI; ++i)
#pragma unroll
      for (int j = 0; j < 2; ++j)
#pragma unroll
        for (int e = 0; e < 16; ++e) { int row = mrow0 + i * 32 + (e & 3) + 8 * (e >> 2) + 4 * h; p.y[(long)row * DM + ncol0 + j * 32 + r] = acc[i][j][e]; }
  } else {
    if (ncol0 < 8192) {
      const bool toproj = ncol0 < NPROJ; const bool rope = toproj && (ncol0 >= PC_Q && ncol0 < PC_KV + 128);
      unsigned short* stg = ((unsigned short*)&sm) + wid * (64 * 72);
      SB* gdst = toproj ? (p.proj + ncol0) : (p.mix + (ncol0 - NPROJ)); const long gld = toproj ? NPROJ : NMIX;
#pragma unroll
      for (int hf = 0; hf < MI / 2; ++hf) {
#pragma unroll
        for (int i2 = 0; i2 < 2; ++i2) { const int i = hf * 2 + i2;
          if (rope) {
            float cc[16], sn[16];
#pragma unroll
            for (int e = 0; e < 16; ++e) { const int row = mrow0 + hf * 64 + i2 * 32 + (e & 3) + 8 * (e >> 2) + 4 * h; cc[e] = p.rope_cs[row * 32 + r]; sn[e] = p.rope_sn[row * 32 + r]; }
#pragma unroll
            for (int e = 0; e < 16; ++e) { const float t1 = acc[i][0][e], t2 = acc[i][1][e]; acc[i][0][e] = t1 * cc[e] - t2 * sn[e]; acc[i][1][e] = t2 * cc[e] + t1 * sn[e]; } }
#pragma unroll
          for (int e = 0; e < 16; ++e) { const int rl = i2 * 32 + (e & 3) + 8 * (e >> 2) + 4 * h; float v0 = acc[i][0][e], v1 = acc[i][1][e];
            if (!toproj) { v0 = silu_fast(v0); v1 = silu_fast(v1); }
            stg[rl * 72 + r] = f2bf(v0); stg[rl * 72 + 32 + r] = f2bf(v1); } }
#pragma unroll
        for (int c8 = 0; c8 < 8; ++c8) { const int idx = lane + 64 * c8, rl = idx >> 3, ch = idx & 7; const uint4 vv = *(const uint4*)&stg[rl * 72 + ch * 8];
          *(uint4*)(gdst + (long)(mrow0 + hf * 64 + rl) * gld + ch * 8) = vv; }
      }
    } else if (ncol0 == 8192) {
#pragma unroll
      for (int i = 0; i < MI; ++i)
#pragma unroll
        for (int e = 0; e < 16; ++e) { int row = mrow0 + i * 32 + (e & 3) + 8 * (e >> 2) + 4 * h; p.small[(long)row * NSMALL + r] = acc[i][0][e]; }
    }
  }
}

__device__ __forceinline__ unsigned tx_() { unsigned t = threadIdx.x; asm volatile("" : "+v"(t)); return t; }
__device__ __forceinline__ int gw0(int) { return (int)((blockIdx.x * 256u + tx_()) >> 6); }
__device__ __forceinline__ int bid0() { int b = blockIdx.x; asm volatile("" : "+s"(b)); return b; }

#define XB_TMO      128
#define XB_XCNT(j)  (256  + 64 * (j))
#define XB_XSUB(j)  (1280 + 64 * (j))
#define XB_XGEN(j)  (2304 + 64 * (j))
#define XB_TOP      3328
#define XB_TOPGEN   3392
#define XCD_BAR_WORDS 3456
#define XB_SPIN_CAP (1u << 28)
__device__ __forceinline__ unsigned xb_ld(unsigned* p) { return __hip_atomic_load(p, __ATOMIC_RELAXED, __HIP_MEMORY_SCOPE_AGENT); }
__device__ __forceinline__ unsigned xb_add(unsigned* p, unsigned v) { return __hip_atomic_fetch_add(p, v, __ATOMIC_RELAXED, __HIP_MEMORY_SCOPE_AGENT); }
__device__ __forceinline__ unsigned xb_xcc_id() { return (unsigned)__builtin_amdgcn_s_getreg((3 << 11) | 20) & 0xFu; }
#define XB_SPIN(cond, bar) do { unsigned _sp = 0; while (cond) { __builtin_amdgcn_s_sleep(1); \
    if ((++_sp & 255u) == 0u) { if (xb_ld(&(bar)[XB_TMO])) break; if (_sp > XB_SPIN_CAP) { atomicAdd(&(bar)[XB_TMO], 1u); break; } } } } while (0)
struct XcdBarrier { unsigned* bar; unsigned x; volatile LDS3 unsigned* st; };
__device__ __forceinline__ XcdBarrier xcd_barrier_post(unsigned* bar, volatile LDS3 unsigned* st) {
  XcdBarrier b; b.bar = bar; b.x = xb_xcc_id(); b.st = st;
  if (threadIdx.x == 0) (void)xb_add(&bar[XB_XCNT(b.x)], 1u);
  return b;
}
__device__ __forceinline__ void xcd_barrier_complete(unsigned* bar, unsigned x, unsigned& nloc, unsigned& nx) {
  const unsigned G = gridDim.x; unsigned sum, cnt, mine, sp = 0u;
  for (;;) { sum = 0u; cnt = 0u; mine = 0u;
#pragma unroll
    for (unsigned j = 0; j < 16; ++j) { const unsigned c = xb_ld(&bar[XB_XCNT(j)]); sum += c; cnt += (c > 0u) ? 1u : 0u; mine = (j == x) ? c : mine; }
    if (sum == G) break;
    __builtin_amdgcn_s_sleep(1);
    if ((++sp & 255u) == 0u) { if (xb_ld(&bar[XB_TMO])) break; if (sp > XB_SPIN_CAP) { atomicAdd(&bar[XB_TMO], 1u); break; } } }
  nloc = mine > 0u ? mine : 1u; nx = cnt > 0u ? cnt : 1u;
}
__device__ __forceinline__ void xcd_barrier(const XcdBarrier& b) {
  asm volatile("s_waitcnt vmcnt(0)" ::: "memory");
  __syncthreads();
  if (threadIdx.x == 0) {
    unsigned* bar = b.bar;
    __builtin_amdgcn_s_waitcnt(0);
    unsigned nloc = b.st[0], nx = b.st[1];
    if (nloc == 0u) { xcd_barrier_complete(bar, b.x, nloc, nx); b.st[0] = nloc; b.st[1] = nx; }
    const unsigned old = xb_add(&bar[XB_XSUB(b.x)], 1u);
    const unsigned gen = old / nloc;
    if (old + 1u == (gen + 1u) * nloc) {
      __builtin_amdgcn_fence(__ATOMIC_RELEASE, "agent");
      asm volatile("s_waitcnt vmcnt(0)" ::: "memory");
      const unsigned og = xb_add(&bar[XB_TOP], 1u);
      const unsigned tg = og / nx;
      if (og + 1u == (tg + 1u) * nx) xb_add(&bar[XB_TOPGEN], 1u);
      else XB_SPIN(xb_ld(&bar[XB_TOPGEN]) == tg, bar);
      __builtin_amdgcn_fence(__ATOMIC_ACQUIRE, "agent");
      xb_add(&bar[XB_XGEN(b.x)], 1u);
      asm volatile("s_waitcnt vmcnt(0)" ::: "memory");
    } else {
      XB_SPIN(xb_ld(&bar[XB_XGEN(b.x)]) == gen, bar);
      __builtin_amdgcn_fence(__ATOMIC_ACQUIRE, "agent");
      asm volatile("s_waitcnt vmcnt(0)" ::: "memory");
    }
  }
  __syncthreads();
}

struct KArgs { const void* in[20]; float* out; char* ws; };
#ifdef SELFCHK
#define RUN_S 4096
#else
#define RUN_S SEQ
#endif
__host__ __device__ __forceinline__ size_t fill_ws(Params& p, Params& p2, char* w) {
  size_t off = 0;
#define TAKE(bytes) (w + ((off += (((size_t)(bytes)) + 255) & ~(size_t)255) - ((((size_t)(bytes)) + 255) & ~(size_t)255)))
  const size_t S = RUN_S, ncmp = S / 16, nc = S / 128;
  p.S = RUN_S;
  p.wt_in = (unsigned short*)TAKE(8320 * 1024 * 2); p.wt_out = (unsigned short*)TAKE(2 * 1024 * 2304 * 2); p.w1t = (unsigned short*)TAKE(2 * 128 * 2048 * 2); p.w2t = (unsigned short*)TAKE(2 * 64 * 128 * 2);
  p.h = (SB*)TAKE(S * 1024 * 2); p.ybuf = (float*)p.h;
  p.proj = (SB*)TAKE(S * NPROJ * 2); p.y = (float*)p.proj;
  p.small = (float*)TAKE(S * 32 * 4); p.mix = (SB*)TAKE(S * NMIX * 2);
  p.rope_cs = (float*)TAKE(S * 32 * 4); p.rope_sn = (float*)TAKE(S * 32 * 4); p.tabA = (float*)TAKE(8 * TABA_N * 4); p.tabD = (float*)TAKE(24 * TABD_N * 4);
  p.memkv = (SB*)TAKE(4 * 256 * 512 * 2); p.hid = (float*)TAKE(2 * ncmp * 256 * 4); p.kvc = (SB*)TAKE(2 * ncmp * 128 * 2);
  p.cml = (float*)TAKE(S * 16 * 4); p.idx = (int*)TAKE(S * 32 * 4); p.oc = (SB*)TAKE(S * 512 * 2); p.ow = (SB*)TAKE(S * 512 * 2);
  p.dop = (SB*)TAKE(3 * S * 512 * 2); p.dlse = (float*)TAKE(3 * S * 8 * 4); p.xconv = (SB*)TAKE(S * 1024 * 2);
  p.dt = (float*)TAKE(S * 8 * 4); p.acs = (float*)TAKE(S * 8 * 4); p.wst = (float*)TAKE(S * 8 * 4); p.cb = (float*)TAKE(nc * 2 * 128 * 128 * 4); p.states = (float*)TAKE(nc * 65536 * 4);
  p.bar = (unsigned*)TAKE(131072);
  p2 = p;
#ifdef SELFCHK
  p.imp = (float*)TAKE(S * 512 * 4);
  p2.mix = (SB*)TAKE(S * NMIX * 2); p2.ow = (SB*)TAKE(S * 512 * 2); p2.oc = (SB*)TAKE(S * 512 * 2); p2.dop = (SB*)TAKE(3 * S * 512 * 2); p2.dlse = (float*)TAKE(3 * S * 8 * 4);
  p2.cml = (float*)TAKE(S * 16 * 4); p2.imp = (float*)TAKE(S * 512 * 4); p2.idx = (int*)TAKE(S * 32 * 4); p2.cb = (float*)TAKE(nc * 2 * 128 * 128 * 4);
  p2.kvc = (SB*)TAKE(2 * ncmp * 128 * 2); p2.xconv = (SB*)TAKE(S * 1024 * 2); p2.dt = (float*)TAKE(S * 8 * 4); p2.acs = (float*)TAKE(S * 8 * 4); p2.wst = (float*)TAKE(S * 8 * 4);
  p2.states = (float*)TAKE(nc * 65536 * 4); p2.ybuf = (float*)TAKE(S * 512 * 4); p.ybuf = (float*)TAKE(S * 512 * 4);
#else
  p.imp = (float*)p.dop; p2 = p;
#endif
  return off;
}
__host__ __device__ __forceinline__ void fill_inputs(Params& p, const KArgs& a) {
  p.x = (const float*)a.in[0]; p.mem = (const float*)a.in[1]; p.pos = (const int*)a.in[2]; p.pre_norm = (const float*)a.in[3]; p.post_norm = (const float*)a.in[4];
  p.w_in = (const float*)a.in[5]; p.w_out = (const float*)a.in[6]; p.rel_bias = (const float*)a.in[7]; p.cmp_pos = (const float*)a.in[8]; p.cmp_w1 = (const float*)a.in[9];
  p.cmp_w2 = (const float*)a.in[10]; p.conv_w = (const float*)a.in[11]; p.conv_b = (const float*)a.in[12]; p.dt_bias = (const float*)a.in[13]; p.a_log = (const float*)a.in[14];
  p.b_d = (const float*)a.in[15]; p.b_norm = (const float*)a.in[16]; p.sinks = (const float*)a.in[17]; p.m_norm = (const float*)a.in[18]; p.m_wkv = (const float*)a.in[19];
  p.out = a.out;
}
#define GS(N, ...) { long g0_ = (long)blockIdx.x * 256 + tx_(); for (long gid = g0_; gid < (long)(N); gid += gsz) { __VA_ARGS__; } }
#define WU(N, ...) { for (int u_ = gw0(gwave); u_ < (int)(N); u_ += nwave) { const int u = __builtin_amdgcn_readfirstlane(u_); const unsigned tq_ = tx_(); int lane = tq_ & 63; \
    WaveLds* WL = ((WaveLds*)smem_raw) + __builtin_amdgcn_readfirstlane((int)(tq_ >> 6)); __VA_ARGS__; } }
#define GSYNC() xcd_barrier(xb)
#ifndef CMP_SKIP
#define CMP_SKIP 2
#endif
#define WUQ(slot, CH, N, ...) { unsigned* cq_ = &p.bar[4096 + (layer * 8 + (slot)) * 64 * 8 + (blockIdx.x & 7) * 64]; for (;;) { unsigned t_ = 0u; if ((tx_() & 63) == 0) t_ = atomicAdd(cq_, 1u); \
    const int c0_ = __builtin_amdgcn_readfirstlane((int)t_) * (CH); if ((c0_ * 8 + (int)(blockIdx.x & 7)) >= (int)(N)) break; \
    for (int ci_ = 0; ci_ < (CH); ++ci_) { const int u = (c0_ + ci_) * 8 + (int)(blockIdx.x & 7); if (u >= (int)(N)) break; const unsigned tq_ = tx_(); int lane = tq_ & 63; \
      WaveLds* WL = ((WaveLds*)smem_raw) + __builtin_amdgcn_readfirstlane((int)(tq_ >> 6)); (void)WL; __VA_ARGS__; } } }
#ifndef ASELW
#define ASELW 1
#endif
#if ASELW == 1
#define ASEL_UNIT(pp, uu) unit_asel_w((pp), (uu), (AselW*)smem_raw)
#else
#define ASEL_UNIT(pp, uu) unit_asel_blk((pp), (uu), (AselLds*)smem_raw)
#endif
#define SMEM_A_ (sizeof(AselLds) > sizeof(AselW) ? sizeof(AselLds) : sizeof(AselW))
#define SMEM_BYTES (SMEM_A_ > sizeof(GemmSmem) ? ((SMEM_A_ + 15) & ~(size_t)15) : sizeof(GemmSmem))
#define gtid ((long)blockIdx.x * 256 + tx_())
#define gwave ((int)((blockIdx.x * 256u + tx_()) >> 6))
#define KERNEL_PROLOGUE \
  Params p, p2; p.pad0 = 0; fill_inputs(p, ka); fill_ws(p, p2, ka.ws); \
  cg::grid_group grid = cg::this_grid(); \
  __shared__ __attribute__((aligned(16))) char smem_raw[SMEM_BYTES + 16]; \
  volatile LDS3 unsigned* xbst = (volatile LDS3 unsigned*)(smem_raw + SMEM_BYTES); \
  if (threadIdx.x < 4) xbst[threadIdx.x] = 0u; \
  __syncthreads(); \
  XcdBarrier xb = xcd_barrier_post(p.bar, xbst); \
  GemmSmem& gsm = *(GemmSmem*)smem_raw; float* ftile = (float*)smem_raw; \
  const long gsz = (long)gridDim.x * 256; const int nwave = (int)(gsz >> 6); \
  const int S = p.S, ncmp = S / 16, nc = S / 128, nqt = S / 32; (void)ncmp; (void)nc; (void)nqt; (void)ftile; (void)gsm; \
  GS((long)S * 32, ph_rope(p, gid)); \
  GS(8 * TABA_N + 24 * TABD_N, ph_tabs(p, gid)); \
  WU(DEPTH * 256, unit_memkv(p, u, lane));
#define PHASE_NORM(layer) \
    for (int t = gw0(gwave); t < S; t += nwave) { int lane = tx_() & 63; norm_row_wave(p, layer, t, true, lane); }
#define PHASE_CVT(layer) \
    { const float* wi = p.w_in + (long)(layer) * 1024 * 8224; unsigned short* wob_ = p.wt_out + (long)((layer) & 1) * 1024 * 2304; \
      for (int tl = bid0(); tl < 16 * 130; tl += gridDim.x) cvt_tile<true>(wi, 8224, p.wt_in, 1024, (tl & 15) * 64, (tl >> 4) * 64, ftile); \
      const float* wo = p.w_out + (long)(layer) * 2304 * 1024; \
      for (int tl = bid0(); tl < 36 * 16; tl += gridDim.x) cvt_tile<false>(wo, 1024, wob_, 2304, (tl % 36) * 64, (tl / 36) * 64, ftile); \
      for (int tl = bid0(); tl < 2 * 64; tl += gridDim.x) { const int kv = tl >> 6, t6 = tl & 63; cvt_tile<false>(p.cmp_w1 + (long)((layer) * 2 + kv) * 2048 * 128, 128, p.w1t + (long)kv * 128 * 2048, 2048, (t6 >> 1) * 64, (t6 & 1) * 64, ftile); } \
      for (int tl = bid0(); tl < 2 * 2; tl += gridDim.x) { const int kv = tl >> 1; cvt_tile<false>(p.cmp_w2 + (long)((layer) * 2 + kv) * 128 * 64, 64, p.w2t + (long)kv * 64 * 128, 128, (tl & 1) * 64, 0, ftile); } }
#define PHASE_P1(layer) PHASE_NORM(layer) PHASE_CVT(layer)
#define PHASE_P2() \
    {   \
      const int x_ = bid0() & 7, li_ = bid0() >> 3, nl_ = (gridDim.x + 7) >> 3, mtiles_ = S / (64 * GMI), mper_ = mtiles_ / 8; \
      if ((mper_ & 7) != 0 || (gridDim.x & 7) != 0) { for (int tl = bid0(); tl < mtiles_ * 65; tl += gridDim.x) { int mt = tl % mtiles_, nt = tl / mtiles_; gemm_tile<0, GMI>(p, p.h, DM, p.wt_in, DM, DM, mt * 64 * GMI, nt * 128, gsm); } } \
      else for (int t_ = li_; t_ < mper_ * 65; t_ += nl_) { const int half_ = t_ / 520, r_ = t_ % 520; int ml_, nt_; \
        if (r_ < 512) { ml_ = r_ & 7; nt_ = (r_ >> 6) * 8 + ((r_ & 63) >> 3); } else { ml_ = r_ - 512; nt_ = 64; } \
        gemm_tile<0, GMI>(p, p.h, DM, p.wt_in, DM, DM, (x_ * mper_ + half_ * 8 + ml_) * 64 * GMI, nt_ * 128, gsm); } }
#define PHASE_FLASH3(layer) \
    { const int nA = nqt * 8, nM = nqt * 4, nD = 3 * nqt * 8, nC = nqt * 8; \
      WU(nA + nM + nD + nC, { if (u < nA) unit_awin(p, u, WL, lane); else if (u < nA + nM) unit_m(p, layer, u - nA, WL, lane); \
                              else if (u < nA + nM + nD) unit_d(p, u - nA - nM, WL, lane); else unit_c(p, layer, u - nA - nM - nD, WL, lane); }); }
#define WU2(N, ...) { for (int u_ = gw0(gwave); u_ < (int)(N); u_ += nwave) { const int u = __builtin_amdgcn_readfirstlane(u_); const unsigned tq_ = tx_(); int lane = tq_ & 63; \
    WaveLds2* WL2 = ((WaveLds2*)smem_raw) + __builtin_amdgcn_readfirstlane((int)(tq_ >> 6)); __VA_ARGS__; } }
#define PHASE_CB() \
    for (int tl = bid0(); tl < nc * 2; tl += gridDim.x) { const SB* xb_ = p.xconv + (long)(tl >> 1) * 128 * 1024 + (tl & 1) * 128; gemm_tile<2, 2>(p, xb_ + 768, 1024, xb_ + 512, 1024, 128, 0, 0, gsm, p.cb + (long)tl * 16384); }

#ifndef SELFCHK
#define PH_BEGIN { char* wsb_ = ka.ws; asm volatile("" : "+s"(wsb_)); Params p, p2_; p.pad0 = 0; fill_inputs(p, ka); fill_ws(p, p2_, wsb_); (void)p2_;
#define PH_END }
__global__ void __launch_bounds__(256, LB2) mega(KArgs ka) {
  KERNEL_PROLOGUE
#ifdef REP_PRO
  GS((long)S * 32, ph_rope(p, gid)); GS(8 * TABA_N + 24 * TABD_N, ph_tabs(p, gid)); WU(DEPTH * 256, unit_memkv(p, u, lane));
#endif
#ifdef TSEL
  unsigned long long tlast = __builtin_amdgcn_s_memrealtime();
#define TMARK(id) { if (gtid == 0) { const unsigned long long tn = __builtin_amdgcn_s_memrealtime(); ((unsigned long long*)p.bar)[id] += tn - tlast; tlast = tn; } }
#else
#define TMARK(id)
#endif
  for (int layer = 0; layer < DEPTH; ++layer) {
    PH_BEGIN
    PHASE_P1(layer)
#ifdef REP_P1
    PHASE_P1(layer)
#endif
    PH_END
    if (layer == 0) grid.sync(); else GSYNC();
    PH_BEGIN
    TMARK(1)
    PHASE_P2()
#ifdef REP_G
    PHASE_P2()
#endif
#ifdef REP_G2
    { const int x_ = bid0() & 7, li_ = bid0() >> 3, nl_ = (gridDim.x + 7) >> 3; for (int t_ = li_; t_ < 520; t_ += nl_) { int ml_, nt_; if (t_ < 512) { ml_ = t_ & 7; nt_ = (t_ >> 6) * 8 + ((t_ & 63) >> 3); } else { ml_ = t_ - 512; nt_ = 64; }
        gemm_tile<0, GMI, true>(p, p.h, DM, p.wt_in, DM, DM, (x_ * 8 + ml_) * 64 * GMI, nt_ * 128, gsm); } }
#endif
    PH_END
    GSYNC();
    PH_BEGIN
    TMARK(2)
    { const int nCmp = 2 * (ncmp * 2 / 32), nA = nqt * 8, nM = nqt * 4, nD = 3 * nqt * 8, nC = nqt * 8, nF = nA + nM + nD + nC;
      const int cb0 = (int)gridDim.x - nCmp; const bool cmpw = ((int)blockIdx.x >= cb0) && (cb0 > 0); const int cw0 = cb0 * 4;
#define FLASH_UNIT(uu) {   \
        const int v_ = __builtin_amdgcn_readfirstlane(uu); const int gw_ = v_ % nwave, rr_ = v_ / nwave; const int x_ = (gw_ >> 2) & 7, lw_ = ((gw_ >> 5) << 2) | (gw_ & 3); int j_ = rr_ * (nwave >> 3) + lw_; \
        const unsigned tq_ = tx_(); int lane = tq_ & 63; WaveLds* WL = ((WaveLds*)smem_raw) + __builtin_amdgcn_readfirstlane((int)(tq_ >> 6)); \
        if ((nwave & 31) != 0) { const int u = v_; if (u < nA) unit_awin(p, u, WL, lane); else if (u < nA + nM) unit_m(p, layer, u - nA, WL, lane); else if (u < nA + nM + nD) unit_d(p, u - nA - nM, WL, lane); else unit_c(p, layer, u - nA - nM - nD, WL, lane); } \
        else if (j_ < nA / 8) unit_awin(p, x_ * (nA / 8) + j_, WL, lane); \
        else if ((j_ -= nA / 8) < nM / 8) unit_m(p, layer, x_ * (nM / 8) + j_, WL, lane); \
        else if ((j_ -= nM / 8) < nD / 24) unit_d(p, x_ * (nD / 24) + j_, WL, lane); \
        else if ((j_ -= nD / 24) < nD / 24) unit_d(p, nD / 3 + x_ * (nD / 24) + j_, WL, lane); \
        else if ((j_ -= nD / 24) < nD / 24) unit_d(p, 2 * (nD / 3) + x_ * (nD / 24) + j_, WL, lane); \
        else if ((j_ -= nD / 24) < nC / 8) unit_c(p, layer, x_ * (nC / 8) + j_, WL, lane); }
#ifdef REP_F3B
      WU(nA + nD, { if (u < nA) unit_awin(p, u, WL, lane); else unit_d(p, u - nA, WL, lane); });
#endif
#ifdef REP_CMPB
      for (int ub = bid0(); ub < nCmp; ub += gridDim.x) unit_cmp_blk(p, layer, ub, (float*)smem_raw); __syncthreads();
#endif
      if (cb0 <= 0) { for (int ub = bid0(); ub < nCmp; ub += gridDim.x) unit_cmp_blk(p, layer, ub, (float*)smem_raw); __syncthreads(); }
      else if (cmpw) { unit_cmp_blk(p, layer, (int)blockIdx.x - cb0, (float*)smem_raw); __syncthreads(); }
      for (int r_ = (cmpw ? CMP_SKIP : 0), u_ = gw0(gwave) + r_ * nwave; u_ < nF; u_ += nwave) FLASH_UNIT(u_)
      if (cb0 > 0) for (int e_ = gw0(gwave); e_ < CMP_SKIP * nCmp * 4; e_ += nwave) { const int u_ = (e_ / (nCmp * 4)) * nwave + cw0 + (e_ % (nCmp * 4)); if (u_ < nF) FLASH_UNIT(u_) }
#undef FLASH_UNIT
    }
    GS((long)S * 128, item_bconv(p, layer, gid));
    WU(nc * 8, unit_bdt(p, layer, u, lane));
    PH_END
    GSYNC();
    PH_BEGIN
    TMARK(3)
    WU(nqt * 8, unit_acmp1(p, u, WL, lane));
    __syncthreads();
    PHASE_CB()
    __syncthreads();
    WU2(nc * 16, unit_bstates(p, u, WL2, lane));
#ifdef REP_P4
    __syncthreads();
    WU(nqt * 8, unit_acmp1(p, u, WL, lane));
    __syncthreads();
    PHASE_CB()
    __syncthreads();
    WU2(nc * 16, unit_bstates(p, u, WL2, lane));
#endif
    GS((long)S * 64, item_dmerge(p, gid));
    PH_END
    GSYNC();
    PH_BEGIN
    TMARK(4)
#ifndef P5UP
#define P5UP 4
#endif
    {
      const int nU = nqt * 8, hw_ = nwave >> 1; const int gw_ = gw0(gwave);
      if (65536 * 2 != (int)gsz || (nU & 7)) { WU(nU, unit_acmp2(p, u, lane)); }
      else if (gw_ >= hw_) { for (int u_ = gw_ - hw_; u_ < (nU / 8) * P5UP; u_ += hw_) { const int u = __builtin_amdgcn_readfirstlane(u_); int lane = tx_() & 63; unit_acmp2(p, u, lane); } }
      else { for (int u_ = (nU / 8) * P5UP + gw_; u_ < nU; u_ += hw_) { const int u = __builtin_amdgcn_readfirstlane(u_); int lane = tx_() & 63; unit_acmp2(p, u, lane); } } }
#ifdef REP_P5A
    WU(nqt * 8, unit_acmp2(p, u, lane));
#endif
    GS(65536, scan_fast(p, gid));
    PH_END
    GSYNC();
    PH_BEGIN
    TMARK(5)
#ifdef REP_BOUT
    for (int ub = bid0(); ub < nc * 8; ub += gridDim.x) unit_bout_blk<false>(p, layer, ub, smem_raw);
#endif
    for (int ub = bid0(); ub < nc * 8; ub += gridDim.x) unit_bout_blk(p, layer, ub, smem_raw);
    TMARK(7)
#ifdef REP_ASELW
    for (;;) { __syncthreads(); if (threadIdx.x == 0) xbst[2] = atomicAdd(&p.bar[48 + layer * 8 + 7], 1u); __syncthreads(); const int ub = (int)xbst[2]; if (ub >= (S / 32) * 2) break; unit_asel_w<false, REP_ASELW == 2, REP_ASELW == 3>(p, ub, (AselW*)smem_raw); }
#endif
#ifdef REP_ASEL2
    for (;;) { __syncthreads(); if (threadIdx.x == 0) xbst[2] = atomicAdd(&p.bar[48 + layer * 8 + 7], 1u); __syncthreads(); const int ub = (int)xbst[2]; if (ub >= (S / 32) * 2) break; unit_asel_blk<false>(p, ub, (AselLds*)smem_raw); }
#endif
#ifdef REP_ASEL3
    for (;;) { __syncthreads(); if (threadIdx.x == 0) xbst[2] = atomicAdd(&p.bar[48 + layer * 8 + 7], 1u); __syncthreads(); const int ub = (int)xbst[2]; if (ub >= (S / 32) * 2) break; unit_asel_blk<false, true>(p, ub, (AselLds*)smem_raw); }
#endif
#ifndef ASEL_XQ
#define ASEL_XQ 1
#endif
#if ASEL_XQ
    {
      AselW* AW = (AselW*)smem_raw; __syncthreads(); asel_w_tables(p, AW); __syncthreads();
      const int tq_ = tx_(), ln_ = tq_ & 63, wv_ = __builtin_amdgcn_readfirstlane(tq_ >> 6); const int qc = (bid0() >> 2) & 1; bool own = true; const unsigned NWI = (unsigned)(S / 32) * 4u;
      for (;;) { unsigned n = 0xffffffffu; int c = qc;
        if (own) { if (ln_ == 0) n = atomicAdd(&p.bar[48 + layer * 8 + 4 + qc], 1u); n = (unsigned)__builtin_amdgcn_readfirstlane((int)n); if (n >= NWI) { n = 0xffffffffu; own = false; } }
        if (n == 0xffffffffu) { c = qc ^ 1; if (ln_ == 0) n = atomicAdd(&p.bar[48 + layer * 8 + 4 + c], 1u); n = (unsigned)__builtin_amdgcn_readfirstlane((int)n); if (n >= NWI) break; }
        asel_w_wave(p, c, ((S / 32 - 1) - (int)(n >> 2)) * 32 + 8 * (int)(n & 3u), AW, wv_, ln_); } }
#else
    for (;;) { __syncthreads(); if (threadIdx.x == 0) xbst[2] = atomicAdd(&p.bar[48 + layer * 8 + 6], 1u); __syncthreads(); const int ub = (int)xbst[2]; if (ub >= (S / 32) * 2) break; unit_asel_blk(p, ub, (AselLds*)smem_raw); }
#endif
    PH_END
    GSYNC();
    PH_BEGIN
    TMARK(8)
    for (int tl = bid0(); tl < (S / (64 * GMI)) * 8; tl += gridDim.x) { int mt = tl >> 3, nt = tl & 7; gemm_tile<1, GMI>(p, p.mix, NMIX, p.wt_out + (long)(layer & 1) * 1024 * 2304, NMIX, NMIX, mt * 64 * GMI, nt * 128, gsm); }
#ifdef REP_P8
    for (int tl = bid0(); tl < (S / (64 * GMI)) * 8; tl += gridDim.x) { int mt = tl >> 3, nt = tl & 7; gemm_tile<1, GMI>(p, p.mix, NMIX, p.wt_out + (long)(layer & 1) * 1024 * 2304, NMIX, NMIX, mt * 64 * GMI, nt * 128, gsm); }
#endif
    PH_END
    GSYNC();
    PH_BEGIN
    TMARK(9)
#ifdef REP_BAR
    for (int q_ = 0; q_ < 8; ++q_) GSYNC();
#endif
    PH_END
  }
  for (int t = gw0(gwave); t < S; t += nwave) { int lane = tx_() & 63; norm_row_wave(p, DEPTH, t, false, lane); }
#ifdef TSEL
  GSYNC();
  { const float us = (float)((unsigned long long*)p.bar)[TSEL] * 0.01f;
    const float kk = __expf(rintf(__logf(us + 1.f) * 20.f) * 0.05f);
    GS((long)S * 1024, p.out[gid] = kk); }
#endif
}
#else
__device__ __forceinline__ void chk_update(unsigned* slot, float diff, float ref) {
  atomicMax(&slot[0], __float_as_uint(fabsf(diff))); atomicMax(&slot[1], __float_as_uint(fabsf(ref)));
}
#define CMPB(slot, a, b_) chk_update(sl + (slot), bf2f(a) - bf2f(b_), bf2f(b_))
#define CMPF(slot, a, b_) chk_update(sl + (slot), (a) - (b_), (b_))
__global__ void __launch_bounds__(256, 1) mega(KArgs ka) {
  KERNEL_PROLOGUE
  if (gtid < 64) p.bar[gtid] = 0u;
  unsigned* sl = p.bar;
  const int layer = 0;
  PHASE_P1(layer)
  grid.sync();
  PHASE_P2()
  GSYNC();
  GS((long)S * NMIX, p2.mix[gid] = p.mix[gid]);
  GSYNC();
  PHASE_FLASH3(layer)
  __syncthreads();
  for (int ub = bid0(); ub < 2 * (ncmp * 2 / 32); ub += gridDim.x) unit_cmp_blk(p, layer, ub, (float*)smem_raw);
  __syncthreads();
  GS((long)S * 128, item_bconv(p, layer, gid));
  WU(nc * 8, unit_bdt(p, layer, u, lane));
  GS((long)2 * ncmp * 256, ph_cmp_hid(p2, layer, gid));
  GS((long)S * 8, ph_a_win(p2, gid));
  GS((long)S * 8, ph_c(p2, layer, gid));
  GS((long)3 * S * 8, ph_d(p2, gid));
  GS((long)S * 4, ph_m(p2, layer, gid));
  GS((long)S * 1024, ph_b_conv(p2, layer, gid));
  GS((long)nc * 8, ph_b_dt2(p2, layer, gid));
  GSYNC();
  GS((long)2 * ncmp * 128, ph_cmp_out(p2, layer, gid));
  GSYNC();
  GS((long)2 * ncmp * 128, CMPB(20, p.kvc[gid], p2.kvc[gid]));
  GS((long)S * 1024, CMPB(22, p.xconv[gid], p2.xconv[gid]));
  GS((long)S * 8, { CMPF(24, p.dt[gid], p2.dt[gid]); CMPF(24, p.acs[gid], p2.acs[gid]); CMPF(24, p.wst[gid], p2.wst[gid]); });
  GSYNC();
  GS((long)2 * ncmp * 128, p2.kvc[gid] = p.kvc[gid]);
  GS((long)S * 1024, p2.xconv[gid] = p.xconv[gid]);
  GS((long)S * 8, { p2.dt[gid] = p.dt[gid]; p2.acs[gid] = p.acs[gid]; p2.wst[gid] = p.wst[gid]; });
  GSYNC();
  WU(nqt * 8, unit_acmp1(p, u, WL, lane));
  __syncthreads();
  PHASE_CB()
  __syncthreads();
  WU2(nc * 16, unit_bstates(p, u, WL2, lane));
  GS((long)S * 8, ph_a_cmp1(p2, gid));
  GS((long)nc * 2 * 128 * 128, ph_b_cb(p2, gid));
  GS((long)nc * 65536, ph_b_states(p2, gid));
  GSYNC();
  WU(nqt * 8, unit_acmp2(p, u, lane));
  GS((long)S * 2, ph_a_cmp2(p2, gid));
  GS((long)nc * 65536, CMPF(26, p.states[gid], p2.states[gid]));
  GS((long)nc * 2 * 128 * 128, { int s_ = (int)(gid & 127), l_ = (int)((gid >> 7) & 127); if (s_ <= l_) CMPF(18, p.cb[gid], p2.cb[gid]); });
  GSYNC();
  GS(65536, ph_b_scan(p, gid));
  GS(65536, ph_b_scan(p2, gid));
  GS((long)S * 512, { CMPB(0, p.ow[gid], p2.ow[gid]); CMPB(2, p.oc[gid], p2.oc[gid]); long t = gid >> 9, c = gid & 511; CMPB(4, p.mix[t * NMIX + MX_C + c], p2.mix[t * NMIX + MX_C + c]);
                      if (c < 256) CMPB(6, p.mix[t * NMIX + MX_M + c], p2.mix[t * NMIX + MX_M + c]); });
  GS((long)3 * S * 512, CMPB(8, p.dop[gid], p2.dop[gid]));
  GS((long)3 * S * 8, chk_update(sl + 10, p.dlse[gid] - p2.dlse[gid], 1.f));
  GS((long)S * 2 * 256, { long qg = gid >> 8; int bb = (int)(gid & 255); int q = (int)(qg >> 1), g_ = (int)(qg & 1); if (bb <= (q >> 6)) CMPF(12, p.imp[(((long)(q >> 5) * 2 + g_) * 256 + bb) * 32 + (q & 31)], p2.imp[gid]); });
  GSYNC();
  GS((long)S * 512, { long qg = gid >> 8; int bb = (int)(gid & 255); int q = (int)(qg >> 1), g_ = (int)(qg & 1); p2.imp[gid] = p.imp[(((long)(q >> 5) * 2 + g_) * 256 + bb) * 32 + (q & 31)]; });
  GSYNC();
  WU(S * 2 / 4, unit_topk4(p, u, lane));
  WU2(nc * 32, unit_bout(p, layer, u, WL2, lane));
  GS((long)S * 2, ph_a_topk(p2, gid));
  GS((long)S * 512, ph_b_out(p2, layer, gid));
  GSYNC();
  GS((long)S * 2, { int q = (int)(gid >> 1); int nv = (q >> 6) + 1; nv = nv > 16 ? 16 : nv; int bad = 0;
    for (int k = 0; k < 16; ++k) { int mine = p.idx[gid * 16 + k]; bool found = false; for (int k2 = 0; k2 < 16; ++k2) found |= (p2.idx[gid * 16 + k2] == mine); if (k < nv) bad += !found || mine < 0; else bad += (mine >= 0); }
    chk_update(sl + 14, (float)bad, 1.f); });
  GS((long)S * 512, CMPF(28, p.ybuf[gid], p2.ybuf[gid]));
  GSYNC();
  GS((long)S * 32, p2.idx[gid] = p.idx[gid]);
  GS((long)S * 512, p2.ybuf[gid] = p.ybuf[gid]);
  GSYNC();
  for (int ub = bid0(); ub < (S / 32) * 2; ub += gridDim.x) ASEL_UNIT(p, ub);
  for (;;) { __syncthreads(); if (threadIdx.x == 0) xbst[2] = atomicAdd(&p.bar[40 + layer], 1u); __syncthreads(); const int ub = (int)xbst[2]; if (ub >= nc * 8) break; unit_bout_blk(p, layer, ub, smem_raw); }
  GS((long)S * 8, ph_a_sel(p2, gid));
  GS((long)S * 2, ph_b_norm(p2, layer, gid));
  GSYNC();
  GS((long)S * 512, { long t = gid >> 9, c = gid & 511; CMPB(16, p.mix[t * NMIX + MX_A + c], p2.mix[t * NMIX + MX_A + c]); CMPB(30, p.mix[t * NMIX + MX_B + c], p2.mix[t * NMIX + MX_B + c]); });
  GSYNC();
  { float R = 0.f;
    for (int k = 0; k < 16; ++k) { float d = __uint_as_float(p.bar[2 * k]), r = __uint_as_float(p.bar[2 * k + 1]); float q = d / (r + 1e-20f); if (CHKSEL < 0 || CHKSEL == k) R = fmaxf(R, q); }
    GS((long)SEQ * 1024, p.out[gid] = 1e4f * R); }
}
#endif

__global__ void zz_tail_pad(float* o) { asm volatile(".rept 512\n\ts_nop 0\n\t.endr" ::: "memory"); if (o) o[0] = 0.f; }
__global__ void fill_code(float* o, float v, long n) { long i = blockIdx.x * 256L + threadIdx.x; if (i < n) o[i] = v; }
extern "C" void kernel_launch(void* const* d_in, const int* in_sizes, int n_in, void* d_out, int out_size, void* d_ws, size_t ws_size, hipStream_t stream) {
  KArgs ka; memset(&ka, 0, sizeof(ka));
  for (int i = 0; i < 20; ++i) ka.in[i] = d_in[i];
  ka.out = (float*)d_out; ka.ws = (char*)d_ws;
  Params hp, hp2; memset(&hp, 0, sizeof(hp)); const size_t need = fill_ws(hp, hp2, (char*)d_ws);
  if (need > ws_size) { fprintf(stderr, "workspace too small: need %zu have %zu\n", need, ws_size); return; }
  static int grid_blocks = 0;
  if (!grid_blocks) { int dev = 0, cus = 0, per_cu = 0; (void)hipGetDevice(&dev); (void)hipDeviceGetAttribute(&cus, hipDeviceAttributeMultiprocessorCount, dev);
    (void)hipOccupancyMaxActiveBlocksPerMultiprocessor(&per_cu, mega, 256, 0); if (per_cu > LB2) per_cu = LB2; if (per_cu < 1) per_cu = 1; grid_blocks = cus * per_cu; }
  (void)hipMemsetAsync(hp.bar, 0, 131072, stream);
  void* args[] = {&ka};
  hipError_t e = hipLaunchCooperativeKernel((void*)mega, dim3(grid_blocks), dim3(256), args, 0, stream);
  if (e != hipSuccess) { (void)hipGetLastError(); fill_code<<<(unsigned)(((long)SEQ * 1024 + 255) / 256), 256, 0, stream>>>((float*)d_out, 1000.f * (float)(int)e + (float)grid_blocks, (long)SEQ * 1024); }
}
```

```cpp
#include <hip/hip_runtime.h>
#include <hip/hip_cooperative_groups.h>
#include <cstdio>
#include <cstdint>
#include <cstring>
namespace cg = cooperative_groups;
#define HD_ __device__ __forceinline__
#ifndef CHKSEL
#define CHKSEL -1
#endif
#ifndef LB2
#define LB2 2
#endif
#ifndef HD_
#define HD_ inline
#endif
#ifdef SB_IS_FLOAT
typedef float SB;
HD_ float ldf(const SB* p) { return *p; }
HD_ void stf(SB* p, float v) { *p = v; }
#else
typedef unsigned short SB;
HD_ float bf2f(unsigned short b) { unsigned u = ((unsigned)b) << 16; float f; __builtin_memcpy(&f, &u, 4); return f; }
HD_ unsigned short f2bf(float f) { unsigned u; __builtin_memcpy(&u, &f, 4); u += 0x7fffu + ((u >> 16) & 1u); return (unsigned short)(u >> 16); }
HD_ float ldf(const SB* p) { return bf2f(*p); }
HD_ void stf(SB* p, float v) { *p = f2bf(v); }
#endif

#define DM 1024
#define NPROJ 5888
#define NMIX 2304
#define NSMALL 32
#define PA_Q 0
#define PA_KV 512
#define PB_X 1280
#define PC_Q 2304
#define PC_KV 2816
#define PD_Q 3072
#define PD_KV 4608
#define PM_Q 5632
#define MX_A 0
#define MX_B 512
#define MX_C 1024
#define MX_D 1536
#define MX_M 2048
#define TABA_N 2048
#define TABD_N 132

struct Params {
  int S; int pad0;
  const float *x, *mem; const int* pos;
  const float *pre_norm, *post_norm, *w_in, *w_out, *rel_bias, *cmp_pos, *cmp_w1, *cmp_w2, *conv_w, *conv_b, *dt_bias, *a_log, *b_d,
      *b_norm, *sinks, *m_norm, *m_wkv;
  float* out;
  unsigned short* wt_in;
  unsigned short* wt_out;
  unsigned short *w1t, *w2t;
  SB* h;
  SB* proj;
  float* small;
  SB* mix;
  float* y;
  float *rope_cs, *rope_sn;
  float *tabA, *tabD;
  SB* memkv;
  float* hid;
  SB* kvc;
  float* imp;
  float* cml;
  int* idx;
  SB *oc, *ow;
  SB* dop;
  float* dlse;
  SB* xconv;
  float *dt, *acs;
  float* wst;
  float* cb;
  float* states;
  float* ybuf;
  unsigned* bar;
};

HD_ float silu_f(float x) { return x / (1.f + expf(-x)); }
HD_ float sigmoid_f(float x) { return 1.f / (1.f + expf(-x)); }
HD_ float gelu_f(float x) { return 0.5f * x * (1.f + tanhf(0.7978845608028654f * (x + 0.044715f * x * x * x))); }
HD_ float softplus_f(float x) { return fmaxf(x, 0.f) + log1pf(expf(-fabsf(x))); }

HD_ int t5_bucket(int d) {
  if (d < 16) return d < 0 ? 0 : d;
  const int thr[15] = {22, 30, 40, 54, 73, 99, 134, 182, 246, 332, 450, 609, 825, 1117, 1513};
  int b = 16;
  for (int k = 0; k < 15; ++k) b += (d >= thr[k]) ? 1 : 0;
  return b;
}

HD_ void ph_rope(const Params& p, long gid) {
  int s = (int)(gid >> 5), i = (int)(gid & 31);
  float inv = powf(150000.f, -(float)i / 32.f);
  float ang = (float)p.pos[s] * inv;
  p.rope_cs[gid] = cosf(ang); p.rope_sn[gid] = sinf(ang);
}
HD_ void ph_tabs(const Params& p, long gid) {
  if (gid < 8 * TABA_N) { int h = (int)(gid / TABA_N), d = (int)(gid % TABA_N); p.tabA[gid] = p.rel_bias[t5_bucket(d) * 32 + h]; }
  else { long g2 = gid - 8 * TABA_N; int hh = (int)(g2 / TABD_N), d = (int)(g2 % TABD_N); int gi = hh >> 3;
    int dil = gi == 0 ? 1 : (gi == 1 ? 4 : 16); p.tabD[g2] = p.rel_bias[t5_bucket(d * dil) * 32 + 8 + hh]; }
}
HD_ void ph_memkv(const Params& p, long gid) {
  int e = (int)(gid & 511), m = (int)((gid >> 9) & 255), l = (int)(gid >> 17);
  const float* row = p.mem + (long)m * DM;
  float ss = 0.f; _Pragma("unroll 16") for (int d = 0; d < DM; ++d) ss += row[d] * row[d];
  float r = 1.f / sqrtf(ss / DM + 1e-6f);
  float acc = 0.f;
  _Pragma("unroll 16") for (int d = 0; d < DM; ++d) acc += row[d] * r * p.m_norm[l * DM + d] * p.m_wkv[((long)l * DM + d) * 512 + e];
  stf(&p.memkv[gid], acc);
}
HD_ void ph_norm_row(const Params& p, int layer, int t, bool do_h) {
  const float* xin = (layer == 0) ? p.x + (long)t * DM : p.out + (long)t * DM;
  float* xo = p.out + (long)t * DM;
  float r1 = 0.f;
  if (layer > 0) { const float* y = p.y + (long)t * DM; float ss = 0.f; for (int d = 0; d < DM; ++d) ss += y[d] * y[d]; r1 = 1.f / sqrtf(ss / DM + 1e-6f); }
  float ss2 = 0.f;
  for (int d = 0; d < DM; ++d) { float v = xin[d]; if (layer > 0) v += p.y[(long)t * DM + d] * r1 * p.post_norm[(layer - 1) * DM + d]; xo[d] = v; ss2 += v * v; }
  if (!do_h) return;
  float r2 = 1.f / sqrtf(ss2 / DM + 1e-6f);
  for (int d = 0; d < DM; ++d) stf(&p.h[(long)t * DM + d], xo[d] * r2 * p.pre_norm[layer * DM + d]);
}

HD_ void ph_cmp_hid(const Params& p, int layer, long gid) {
  int u = (int)(gid & 127), hk = (int)((gid >> 7) & 1); long r = gid >> 8; int ncmp = p.S / 16; int j = (int)(r % ncmp), kv = (int)(r / ncmp);
  const float* w1 = p.cmp_w1 + ((long)(layer * 2 + kv) * 2048) * 128;
  const float* pe = p.cmp_pos + (long)(layer * 2 + kv) * 32 * 64;
  float acc = 0.f;
  for (int t = 0; t < 32; ++t) { int tok = 16 * j + t;
    _Pragma("unroll 16") for (int d = 0; d < 64; ++d) { float v = pe[t * 64 + d]; if (tok < p.S) v += ldf(&p.proj[(long)tok * NPROJ + PA_KV + kv * 128 + hk * 64 + d]);
      acc += v * w1[(long)(t * 64 + d) * 128 + u]; } }
  p.hid[gid] = gelu_f(acc);
}
HD_ void ph_cmp_out(const Params& p, int layer, long gid) {
  int d = (int)(gid & 63), hk = (int)((gid >> 6) & 1); long r = gid >> 7; int ncmp = p.S / 16; int j = (int)(r % ncmp), kv = (int)(r / ncmp);
  const float* w2 = p.cmp_w2 + (long)(layer * 2 + kv) * 128 * 64;
  const float* hd = p.hid + (((long)kv * ncmp + j) * 2 + hk) * 128;
  float acc = 0.f; for (int u = 0; u < 128; ++u) acc += hd[u] * w2[u * 64 + d];
  stf(&p.kvc[gid], acc);
}
HD_ void ph_a_cmp1(const Params& p, long gid) {
  int h = (int)(gid & 7), q = (int)(gid >> 3), g = h >> 2; int ncmp = p.S / 16;
  int jn = (q >= 31) ? ((q - 31) / 16 + 1) : 0;
  const SB* kc = p.kvc; const SB* vc = p.kvc + (long)ncmp * 128;
  float qv[64], o[64]; for (int d = 0; d < 64; ++d) { qv[d] = ldf(&p.proj[(long)q * NPROJ + PA_Q + h * 64 + d]); o[d] = 0.f; }
  float m = -1e30f, l = 0.f;
  for (int j = 0; j < jn; ++j) { const SB* kr = &kc[((long)j * 2 + g) * 64]; const SB* vr = &vc[((long)j * 2 + g) * 64];
    float s = 0.f; for (int d = 0; d < 64; ++d) s += qv[d] * ldf(&kr[d]);
    int dist = q - (16 * j + 31); s = s * 0.125f + p.tabA[h * TABA_N + (dist < TABA_N ? dist : TABA_N - 1)];
    float mn = fmaxf(m, s), a = expf(m - mn), pr = expf(s - mn); l = l * a + pr; for (int d = 0; d < 64; ++d) o[d] = o[d] * a + pr * ldf(&vr[d]); m = mn; }
  float il = jn > 0 ? 1.f / l : 0.f; for (int d = 0; d < 64; ++d) stf(&p.oc[(long)q * 512 + h * 64 + d], o[d] * il);
  p.cml[gid * 2] = m; p.cml[gid * 2 + 1] = il;
}
HD_ void ph_a_cmp2(const Params& p, long gid) {
  int g = (int)(gid & 1), q = (int)(gid >> 1); int ncmp = p.S / 16;
  float* imp = p.imp + gid * 256; for (int b = 0; b < 256; ++b) imp[b] = 0.f;
  int jn = (q >= 31) ? ((q - 31) / 16 + 1) : 0; const SB* kc = p.kvc;
  for (int hh = 0; hh < 4; ++hh) { int h = g * 4 + hh; float qv[64]; for (int d = 0; d < 64; ++d) qv[d] = ldf(&p.proj[(long)q * NPROJ + PA_Q + h * 64 + d]);
    float m = p.cml[((long)q * 8 + h) * 2], il = p.cml[((long)q * 8 + h) * 2 + 1];
    for (int j = 0; j < jn; ++j) { const SB* kr = &kc[((long)j * 2 + g) * 64]; float s = 0.f; for (int d = 0; d < 64; ++d) s += qv[d] * ldf(&kr[d]);
      int dist = q - (16 * j + 31); s = s * 0.125f + p.tabA[h * TABA_N + (dist < TABA_N ? dist : TABA_N - 1)]; float pr = expf(s - m) * il;
      imp[j >> 2] += pr; if (j + 1 < ncmp) imp[(j + 1) >> 2] += pr; } }
}
HD_ void ph_a_topk(const Params& p, long gid) {
  int q = (int)(gid >> 1); float* imp = p.imp + gid * 256; int* idx = p.idx + gid * 16; int cur = q >> 6;
  imp[0] = 1e4f; imp[cur] = 1e4f;
  for (int k = 0; k < 16; ++k) { int best = -1; float bv = -1.f;
    for (int b = 0; b <= cur; ++b) { float v = imp[b]; if (v > bv) { bv = v; best = b; } }
    idx[k] = best; if (best >= 0) imp[best] = -2.f; }
}
HD_ void ph_a_win(const Params& p, long gid) {
  int h = (int)(gid & 7), q = (int)(gid >> 3), hk = h >> 2;
  float qv[64], o[64]; for (int d = 0; d < 64; ++d) { qv[d] = ldf(&p.proj[(long)q * NPROJ + PA_Q + h * 64 + d]); o[d] = 0.f; }
  float m = -1e30f, l = 0.f; int lo = q - 511 < 0 ? 0 : q - 511;
  for (int t = lo; t <= q; ++t) { const SB* kr = &p.proj[(long)t * NPROJ + PA_KV + 4 * 128 + hk * 64]; const SB* vr = kr + 128;
    float s = 0.f; for (int d = 0; d < 64; ++d) s += qv[d] * ldf(&kr[d]); s = s * 0.125f + p.tabA[h * TABA_N + (q - t)];
    float mn = fmaxf(m, s), a = expf(m - mn), pr = expf(s - mn); l = l * a + pr; for (int d = 0; d < 64; ++d) o[d] = o[d] * a + pr * ldf(&vr[d]); m = mn; }
  float il = 1.f / l; for (int d = 0; d < 64; ++d) stf(&p.ow[(long)q * 512 + h * 64 + d], o[d] * il);
}
HD_ void ph_a_sel(const Params& p, long gid) {
  int h = (int)(gid & 7), q = (int)(gid >> 3), hk = h >> 2; const int* idx = p.idx + ((long)q * 2 + hk) * 16;
  float qv[64], o[64]; for (int d = 0; d < 64; ++d) { qv[d] = ldf(&p.proj[(long)q * NPROJ + PA_Q + h * 64 + d]); o[d] = 0.f; }
  float m = -1e30f, l = 0.f;
  for (int k = 0; k < 16; ++k) { int b = idx[k]; if (b < 0) continue;
    for (int i = 0; i < 64; ++i) { int t = b * 64 + i; if (t > q) break;
      const SB* kr = &p.proj[(long)t * NPROJ + PA_KV + 2 * 128 + hk * 64]; const SB* vr = kr + 128;
      float s = 0.f; for (int d = 0; d < 64; ++d) s += qv[d] * ldf(&kr[d]); int dist = q - t; s = s * 0.125f + p.tabA[h * TABA_N + (dist < TABA_N ? dist : TABA_N - 1)];
      float mn = fmaxf(m, s), a = expf(m - mn), pr = expf(s - mn); l = l * a + pr; for (int d = 0; d < 64; ++d) o[d] = o[d] * a + pr * ldf(&vr[d]); m = mn; } }
  float il = 1.f / l; const float* gl = p.small + (long)q * NSMALL + h * 3;
  float g0 = sigmoid_f(gl[0]), g1 = sigmoid_f(gl[1]), g2 = sigmoid_f(gl[2]);
  for (int d = 0; d < 64; ++d) { long c = (long)q * 512 + h * 64 + d; float a = g0 * ldf(&p.oc[c]) + g1 * o[d] * il + g2 * ldf(&p.ow[c]);
    SB* mp = &p.mix[(long)q * NMIX + MX_A + h * 64 + d]; stf(mp, a * ldf(mp)); }
}
HD_ void ph_c(const Params& p, int layer, long gid) {
  int h = (int)(gid & 7), q = (int)(gid >> 3), hk = h >> 2;
  float qv[64], o[64]; for (int d = 0; d < 64; ++d) { qv[d] = ldf(&p.proj[(long)q * NPROJ + PC_Q + h * 64 + d]); o[d] = 0.f; }
  float m = p.sinks[layer * 8 + h], l = 1.f; int lo = q - 127 < 0 ? 0 : q - 127;
  for (int t = lo; t <= q; ++t) { const SB* kr = &p.proj[(long)t * NPROJ + PC_KV + hk * 64]; const SB* vr = kr + 128;
    float s = 0.f; for (int d = 0; d < 64; ++d) s += qv[d] * ldf(&kr[d]); s *= 0.125f;
    float mn = fmaxf(m, s), a = expf(m - mn), pr = expf(s - mn); l = l * a + pr; for (int d = 0; d < 64; ++d) o[d] = o[d] * a + pr * ldf(&vr[d]); m = mn; }
  float il = 1.f / l; for (int d = 0; d < 64; ++d) { SB* mp = &p.mix[(long)q * NMIX + MX_C + h * 64 + d]; stf(mp, o[d] * il * ldf(mp)); }
}
HD_ void ph_d(const Params& p, long gid) {
  int h = (int)(gid & 7); long r = gid >> 3; int q = (int)(r % p.S), gi = (int)(r / p.S); int dil = gi == 0 ? 1 : (gi == 1 ? 4 : 16);
  float qv[64], o[64]; for (int d = 0; d < 64; ++d) { qv[d] = ldf(&p.proj[(long)q * NPROJ + PD_Q + gi * 512 + h * 64 + d]); o[d] = 0.f; }
  float m = -1e30f, l = 0.f;
  for (int dd = 0; dd <= 128; ++dd) { int t = q - dil * dd; if (t < 0) break;
    const SB* kr = &p.proj[(long)t * NPROJ + PD_KV + h * 64]; const SB* vr = kr + 512;
    float s = 0.f; for (int d = 0; d < 64; ++d) s += qv[d] * ldf(&kr[d]); s = s * 0.125f + p.tabD[(gi * 8 + h) * TABD_N + dd];
    float mn = fmaxf(m, s), a = expf(m - mn), pr = expf(s - mn); l = l * a + pr; for (int d = 0; d < 64; ++d) o[d] = o[d] * a + pr * ldf(&vr[d]); m = mn; }
  float il = 1.f / l; for (int d = 0; d < 64; ++d) stf(&p.dop[((long)gi * p.S + q) * 512 + h * 64 + d], o[d] * il);
  p.dlse[((long)gi * p.S + q) * 8 + h] = m + logf(l);
}
HD_ void ph_d_merge(const Params& p, long gid) {
  int h = (int)(gid & 7), q = (int)(gid >> 3);
  float l0 = p.dlse[((long)0 * p.S + q) * 8 + h], l1 = p.dlse[((long)1 * p.S + q) * 8 + h], l2 = p.dlse[((long)2 * p.S + q) * 8 + h];
  float mm = fmaxf(l0, fmaxf(l1, l2)); float e0 = expf(l0 - mm), e1 = expf(l1 - mm), e2 = expf(l2 - mm), is = 1.f / (e0 + e1 + e2);
  for (int d = 0; d < 64; ++d) { long c = (long)q * 512 + h * 64 + d;
    float v = (e0 * ldf(&p.dop[c]) + e1 * ldf(&p.dop[(long)p.S * 512 + c]) + e2 * ldf(&p.dop[(long)2 * p.S * 512 + c])) * is;
    SB* mp = &p.mix[(long)q * NMIX + MX_D + h * 64 + d]; stf(mp, v * ldf(mp)); }
}
HD_ void ph_m(const Params& p, int layer, long gid) {
  int h = (int)(gid & 3), q = (int)(gid >> 2);
  float qv[64], o[64]; for (int d = 0; d < 64; ++d) { qv[d] = ldf(&p.proj[(long)q * NPROJ + PM_Q + h * 64 + d]); o[d] = 0.f; }
  float m = -1e30f, l = 0.f; const SB* kvb = p.memkv + (long)layer * 256 * 512;
  for (int t = 0; t < 256; ++t) { const SB* kr = kvb + (long)t * 512 + h * 64; const SB* vr = kr + 256;
    float s = 0.f; for (int d = 0; d < 64; ++d) s += qv[d] * ldf(&kr[d]); s *= 0.125f;
    float mn = fmaxf(m, s), a = expf(m - mn), pr = expf(s - mn); l = l * a + pr; for (int d = 0; d < 64; ++d) o[d] = o[d] * a + pr * ldf(&vr[d]); m = mn; }
  float il = 1.f / l; for (int d = 0; d < 64; ++d) { SB* mp = &p.mix[(long)q * NMIX + MX_M + h * 64 + d]; stf(mp, o[d] * il * ldf(mp)); }
}
HD_ void ph_b_conv(const Params& p, int layer, long gid) {
  int c = (int)(gid & 1023), t = (int)(gid >> 10); const float* w = p.conv_w + (long)layer * 4 * 1024;
  float acc = p.conv_b[layer * 1024 + c];
  for (int i = 0; i < 4; ++i) { int tt = t - 3 + i; if (tt >= 0) acc += w[i * 1024 + c] * ldf(&p.proj[(long)tt * NPROJ + PB_X + c]); }
  stf(&p.xconv[gid], silu_f(acc));
}
HD_ void ph_b_dt(const Params& p, int layer, long gid) {
  int hd = (int)(gid & 7), c = (int)(gid >> 3); float a = -expf(p.a_log[layer * 8 + hd]); float cs = 0.f;
  for (int l = 0; l < 128; ++l) { int t = c * 128 + l; float dt = softplus_f(p.small[(long)t * NSMALL + 24 + hd] + p.dt_bias[layer * 8 + hd]);
    cs += dt * a; p.dt[(long)t * 8 + hd] = dt; p.acs[(long)t * 8 + hd] = cs; }
}
HD_ void ph_b_cb(const Params& p, long gid) {
  int s = (int)(gid & 127), l = (int)((gid >> 7) & 127), g = (int)((gid >> 14) & 1), c = (int)(gid >> 15);
  if (s > l) { p.cb[gid] = 0.f; return; }
  const SB* cm = &p.xconv[(long)(c * 128 + l) * 1024 + 768 + g * 128]; const SB* bm = &p.xconv[(long)(c * 128 + s) * 1024 + 512 + g * 128];
  float acc = 0.f; for (int n = 0; n < 128; ++n) acc += ldf(&cm[n]) * ldf(&bm[n]);
  p.cb[gid] = acc;
}
HD_ void ph_b_states(const Params& p, long gid) {
  int n = (int)(gid & 127), pp = (int)((gid >> 7) & 63), hd = (int)((gid >> 13) & 7), c = (int)(gid >> 16), g = hd >> 2;
  float last = p.acs[(long)(c * 128 + 127) * 8 + hd]; float acc = 0.f;
  for (int l = 0; l < 128; ++l) { long t = c * 128 + l;
    acc += ldf(&p.xconv[t * 1024 + 512 + g * 128 + n]) * expf(last - p.acs[t * 8 + hd]) * ldf(&p.xconv[t * 1024 + hd * 64 + pp]) * p.dt[t * 8 + hd]; }
  p.states[gid] = acc;
}
HD_ void ph_b_scan(const Params& p, long gid) {
  int hd = (int)(gid >> 13); int nc = p.S / 128; float h = 0.f;
  for (int c0 = 0; c0 < nc; c0 += 8) { float st[8], dc[8];
    for (int i = 0; i < 8; ++i) { st[i] = p.states[(long)(c0 + i) * 65536 + gid]; dc[i] = p.acs[(long)((c0 + i) * 128 + 127) * 8 + hd]; }
    for (int i = 0; i < 8; ++i) { p.states[(long)(c0 + i) * 65536 + gid] = h; h = h * expf(dc[i]) + st[i]; } }
}
HD_ void ph_b_out(const Params& p, int layer, long gid) {
  int pp = (int)(gid & 63), hd = (int)((gid >> 6) & 7), t = (int)(gid >> 9), g = hd >> 2, c = t >> 7, l = t & 127;
  float al = p.acs[(long)t * 8 + hd]; float acc = 0.f;
  const float* cbr = &p.cb[(((long)c * 2 + g) * 128 + l) * 128];
  for (int s = 0; s <= l; ++s) { long ts = c * 128 + s; acc += cbr[s] * expf(al - p.acs[ts * 8 + hd]) * ldf(&p.xconv[ts * 1024 + hd * 64 + pp]) * p.dt[ts * 8 + hd]; }
  float acc2 = 0.f; const float* pr = &p.states[(long)c * 65536 + ((long)hd * 64 + pp) * 128]; const SB* cm = &p.xconv[(long)t * 1024 + 768 + g * 128];
  for (int n = 0; n < 128; ++n) acc2 += ldf(&cm[n]) * pr[n];
  p.ybuf[gid] = acc + expf(al) * acc2 + ldf(&p.xconv[(long)t * 1024 + hd * 64 + pp]) * p.b_d[layer * 8 + hd];
}
HD_ void ph_b_norm(const Params& p, int layer, long gid) {
  int g = (int)(gid & 1), t = (int)(gid >> 1); float ss = 0.f;
  for (int i = 0; i < 256; ++i) { float v = p.ybuf[(long)t * 512 + g * 256 + i] * ldf(&p.mix[(long)t * NMIX + MX_B + g * 256 + i]); ss += v * v; }
  float r = 1.f / sqrtf(ss / 256.f + 1e-6f);
  for (int i = 0; i < 256; ++i) { SB* mp = &p.mix[(long)t * NMIX + MX_B + g * 256 + i]; float v = p.ybuf[(long)t * 512 + g * 256 + i] * ldf(mp);
    stf(mp, v * r * p.b_norm[layer * 512 + g * 256 + i]); }
}

HD_ void ph_b_dt2(const Params& p, int layer, long gid) {
  int hd = (int)(gid & 7), c = (int)(gid >> 3); float a = -expf(p.a_log[layer * 8 + hd]); float cs = 0.f;
  for (int l = 0; l < 128; ++l) { int t = c * 128 + l; float dt = softplus_f(p.small[(long)t * NSMALL + 24 + hd] + p.dt_bias[layer * 8 + hd]);
    cs += dt * a; p.dt[(long)t * 8 + hd] = dt; p.acs[(long)t * 8 + hd] = cs; }
  for (int l = 0; l < 128; ++l) { long t = c * 128 + l; p.wst[t * 8 + hd] = p.dt[t * 8 + hd] * expf(cs - p.acs[t * 8 + hd]); }
}
HD_ void ph_b_states2(const Params& p, long gid) {
  int pp = (int)(gid & 63), n = (int)((gid >> 6) & 127), hd = (int)((gid >> 13) & 7), c = (int)(gid >> 16), g = hd >> 2;
  float acc = 0.f;
  _Pragma("unroll 16") for (int l = 0; l < 128; ++l) { long t = c * 128 + l; acc += ldf(&p.xconv[t * 1024 + 512 + g * 128 + n]) * p.wst[t * 8 + hd] * ldf(&p.xconv[t * 1024 + hd * 64 + pp]); }
  p.states[gid] = acc;
}
HD_ void ph_b_out2(const Params& p, int layer, long gid) {
  int pp = (int)(gid & 63), hd = (int)((gid >> 6) & 7), t = (int)(gid >> 9), g = hd >> 2, c = t >> 7, l = t & 127;
  float al = p.acs[(long)t * 8 + hd]; float acc = 0.f;
  const float* cbr = &p.cb[(((long)c * 2 + g) * 128 + l) * 128];
  _Pragma("unroll 8") for (int s = 0; s <= l; ++s) { long ts = c * 128 + s; acc += cbr[s] * expf(al - p.acs[ts * 8 + hd]) * p.dt[ts * 8 + hd] * ldf(&p.xconv[ts * 1024 + hd * 64 + pp]); }
  float acc2 = 0.f; const float* pr = &p.states[(long)c * 65536 + (long)hd * 8192 + pp]; const SB* cm = &p.xconv[(long)t * 1024 + 768 + g * 128];
  _Pragma("unroll 16") for (int n = 0; n < 128; ++n) acc2 += ldf(&cm[n]) * pr[n * 64];
  p.ybuf[gid] = acc + expf(al) * acc2 + ldf(&p.xconv[(long)t * 1024 + hd * 64 + pp]) * p.b_d[layer * 8 + hd];
}

typedef __attribute__((ext_vector_type(8))) short bf16x8;
typedef __attribute__((ext_vector_type(16))) float f32x16;
typedef short v4i16_t __attribute__((ext_vector_type(4)));
typedef __bf16 bf2_t __attribute__((ext_vector_type(2)));
typedef float f2_t __attribute__((ext_vector_type(2)));
typedef unsigned u32x4 __attribute__((ext_vector_type(4)));
#define LDS3 __attribute__((address_space(3)))
#define GLB1 __attribute__((address_space(1)))
typedef __attribute__((address_space(1))) const void* gptr_t;
typedef __attribute__((address_space(3))) void* lptr_t;
#define L2E 1.4426950408889634f
#define LN2 0.6931471805599453f
#define QSC (0.125f * L2E)
#ifndef FTHR
#define FTHR 8.0f
#endif
#define NINF (-__builtin_huge_valf())
__device__ __forceinline__ float sigmoid_fast(float x) { return __builtin_amdgcn_rcpf(1.f + __builtin_amdgcn_exp2f(-x * L2E)); }
__device__ __forceinline__ float silu_fast(float x) { return x * sigmoid_fast(x); }
__device__ __forceinline__ float gelu_fast(float x) { const float u = 0.7978845608028654f * (x + 0.044715f * x * x * x); const float th = 1.f - 2.f * __builtin_amdgcn_rcpf(1.f + __builtin_amdgcn_exp2f(2.f * L2E * u)); return 0.5f * x * (1.f + th); }

struct WaveLds { unsigned short v[4096]; float tab[640]; float xch[32]; float pad[32]; };

__device__ __forceinline__ unsigned pk2(float a, float b) { f2_t v = {a, b}; bf2_t r = __builtin_convertvector(v, bf2_t); return __builtin_bit_cast(unsigned, r); }
__device__ __forceinline__ int crow(int e, int hi) { return (e & 3) + 8 * (e >> 2) + 4 * hi; }
__device__ __forceinline__ bf16x8 pack8(const f32x16& s, int o) {
  u32x4 r; r[0] = pk2(s[o], s[o + 1]); r[1] = pk2(s[o + 2], s[o + 3]); r[2] = pk2(s[o + 4], s[o + 5]); r[3] = pk2(s[o + 6], s[o + 7]); return __builtin_bit_cast(bf16x8, r); }
__device__ __forceinline__ f32x16 zero16() { f32x16 z;
#pragma unroll
  for (int e = 0; e < 16; ++e) z[e] = 0.f; return z; }
#define MFMA32(a, b, c) __builtin_amdgcn_mfma_f32_32x32x16_bf16((a), (b), (c), 0, 0, 0)

__device__ __forceinline__ float xor32_f(float v) { const auto rr = __builtin_amdgcn_permlane32_swap(__float_as_uint(v), __float_as_uint(v), false, false); const int hi_ = (int)(threadIdx.x & 32u); return __uint_as_float(hi_ ? rr[0] : rr[1]); }
struct FlashState { f32x16 o0, o1; float m, l; };
__device__ __forceinline__ float wave_sum_f(float v) {
#pragma unroll
  for (int o = 32; o > 0; o >>= 1) v += __shfl_xor(v, o);
  return v; }

__device__ __forceinline__ void flash_core1(FlashState& st, f32x16& s, const unsigned short* vimg, float* xch, int lane) {
  const int r32 = lane & 31, hi = lane >> 5;
  float mx = s[0];
#pragma unroll
  for (int e = 1; e < 16; ++e) mx = fmaxf(mx, s[e]);
  mx = fmaxf(mx, xor32_f(mx));
  if (__any(mx > st.m + FTHR)) {
    const float mn = fmaxf(st.m, mx); const float al = __builtin_amdgcn_exp2f(st.m - mn); st.m = mn; st.l *= al; xch[r32] = al;
#pragma unroll
    for (int e = 0; e < 16; ++e) { const float a = xch[crow(e, hi)]; st.o0[e] *= a; st.o1[e] *= a; }
  }
  float ps = 0.f;
#pragma unroll
  for (int e = 0; e < 16; ++e) { s[e] = __builtin_amdgcn_exp2f(s[e] - st.m); ps += s[e]; }
  st.l += ps;
  const bf16x8 pa0 = pack8(s, 0), pa1 = pack8(s, 8);
  const unsigned short* vb = vimg + (4 * hi + ((lane & 15) >> 2)) * 32 + ((lane >> 4) & 1) * 16 + (lane & 3) * 4;
#pragma unroll
  for (int s2 = 0; s2 < 2; ++s2) {
#pragma unroll
    for (int db = 0; db < 2; ++db) {
      const v4i16_t lo = __builtin_amdgcn_ds_read_tr16_b64_v4i16((LDS3 v4i16_t*)(vb + db * 2048 + s2 * 512));
      const v4i16_t hh = __builtin_amdgcn_ds_read_tr16_b64_v4i16((LDS3 v4i16_t*)(vb + db * 2048 + s2 * 512 + 256));
      const bf16x8 vf = {lo[0], lo[1], lo[2], lo[3], hh[0], hh[1], hh[2], hh[3]};
      if (db == 0) st.o0 = MFMA32(s2 ? pa1 : pa0, vf, st.o0); else st.o1 = MFMA32(s2 ? pa1 : pa0, vf, st.o1);
    }
  }
}
__device__ __forceinline__ void flash_core1_lin(FlashState& st, f32x16& s, float qs, float bb, const unsigned short* vimg, float* xch, int lane) {
  const int r32 = lane & 31, hi = lane >> 5;
  float mr = s[0];
#pragma unroll
  for (int e = 1; e < 16; ++e) mr = fmaxf(mr, s[e]);
  float mx = __builtin_fmaf(mr, qs, bb);
  mx = fmaxf(mx, xor32_f(mx));
  if (__any(mx > st.m + FTHR)) {
    const float mn = fmaxf(st.m, mx); const float al = __builtin_amdgcn_exp2f(st.m - mn); st.m = mn; st.l *= al; xch[r32] = al;
#pragma unroll
    for (int e = 0; e < 16; ++e) { const float a = xch[crow(e, hi)]; st.o0[e] *= a; st.o1[e] *= a; }
  }
  const float bm = bb - st.m; float ps = 0.f;
#pragma unroll
  for (int e = 0; e < 16; ++e) { s[e] = __builtin_amdgcn_exp2f(__builtin_fmaf(s[e], qs, bm)); ps += s[e]; }
  st.l += ps;
  const bf16x8 pa0 = pack8(s, 0), pa1 = pack8(s, 8);
  const unsigned short* vb = vimg + (4 * hi + ((lane & 15) >> 2)) * 32 + ((lane >> 4) & 1) * 16 + (lane & 3) * 4;
#pragma unroll
  for (int s2 = 0; s2 < 2; ++s2) {
#pragma unroll
    for (int db = 0; db < 2; ++db) {
      const v4i16_t lo = __builtin_amdgcn_ds_read_tr16_b64_v4i16((LDS3 v4i16_t*)(vb + db * 2048 + s2 * 512));
      const v4i16_t hh = __builtin_amdgcn_ds_read_tr16_b64_v4i16((LDS3 v4i16_t*)(vb + db * 2048 + s2 * 512 + 256));
      const bf16x8 vf = {lo[0], lo[1], lo[2], lo[3], hh[0], hh[1], hh[2], hh[3]};
      if (db == 0) st.o0 = MFMA32(s2 ? pa1 : pa0, vf, st.o0); else st.o1 = MFMA32(s2 ? pa1 : pa0, vf, st.o1);
    }
  }
}
template <class VRow, class Fix>
__device__ __forceinline__ void flash_tile(FlashState& st, const bf16x8 (&qf)[4], const SB* kp, VRow vrow, Fix fix, WaveLds* L, int lane) {
  const int r32 = lane & 31, hi = lane >> 5;
  bf16x8 kf[4];
#pragma unroll
  for (int d0 = 0; d0 < 4; ++d0) kf[d0] = *(const bf16x8*)(kp + d0 * 16 + hi * 8);
#pragma unroll
  for (int i = 0; i < 4; ++i) { const int c = lane + 64 * i, key = c >> 3, ch = c & 7; const SB* vp = vrow(key); const uint4 vv = *(const uint4*)(vp + ch * 8);
    *(uint4*)&L->v[(ch >> 2) * 2048 + key * 32 + (ch & 3) * 8] = vv; }
  f32x16 s = zero16();
#pragma unroll
  for (int d0 = 0; d0 < 4; ++d0) s = MFMA32(kf[d0], qf[d0], s);
  fix(s);
  flash_core1(st, s, L->v, L->xch, lane);
}
__device__ __forceinline__ void flash_core2(FlashState& st, f32x16& s0, f32x16& s1, const unsigned short* vimg, float* xch, int lane) {
  const int r32 = lane & 31, hi = lane >> 5;
  float mx = fmaxf(s0[0], s1[0]);
#pragma unroll
  for (int e = 1; e < 16; ++e) mx = fmaxf(mx, fmaxf(s0[e], s1[e]));
  mx = fmaxf(mx, xor32_f(mx));
  if (__any(mx > st.m + FTHR)) {
    const float mn = fmaxf(st.m, mx); const float al = __builtin_amdgcn_exp2f(st.m - mn); st.m = mn; st.l *= al; xch[r32] = al;
#pragma unroll
    for (int e = 0; e < 16; ++e) { const float a = xch[crow(e, hi)]; st.o0[e] *= a; st.o1[e] *= a; }
  }
  float ps = 0.f;
#pragma unroll
  for (int e = 0; e < 16; ++e) { s0[e] = __builtin_amdgcn_exp2f(s0[e] - st.m); s1[e] = __builtin_amdgcn_exp2f(s1[e] - st.m); ps += s0[e] + s1[e]; }
  st.l += ps;
  bf16x8 pa[4]; pa[0] = pack8(s0, 0); pa[1] = pack8(s0, 8); pa[2] = pack8(s1, 0); pa[3] = pack8(s1, 8);
  const unsigned short* vb = vimg + (4 * hi + ((lane & 15) >> 2)) * 32 + ((lane >> 4) & 1) * 16 + (lane & 3) * 4;
#pragma unroll
  for (int kk = 0; kk < 4; ++kk) {
#pragma unroll
    for (int db = 0; db < 2; ++db) {
      const v4i16_t lo = __builtin_amdgcn_ds_read_tr16_b64_v4i16((LDS3 v4i16_t*)(vb + db * 2048 + kk * 512));
      const v4i16_t hh = __builtin_amdgcn_ds_read_tr16_b64_v4i16((LDS3 v4i16_t*)(vb + db * 2048 + kk * 512 + 256));
      const bf16x8 vf = {lo[0], lo[1], lo[2], lo[3], hh[0], hh[1], hh[2], hh[3]};
      if (db == 0) st.o0 = MFMA32(pa[kk], vf, st.o0); else st.o1 = MFMA32(pa[kk], vf, st.o1);
    }
  }
}
__device__ __forceinline__ void flash_core2_lin(FlashState& st, f32x16& s0, f32x16& s1, float qs, float bb, const unsigned short* vimg, float* xch, int lane) {
  const int r32 = lane & 31, hi = lane >> 5;
  float mr = fmaxf(s0[0], s1[0]);
#pragma unroll
  for (int e = 1; e < 16; ++e) mr = fmaxf(mr, fmaxf(s0[e], s1[e]));
  float mx = __builtin_fmaf(mr, qs, bb);
  mx = fmaxf(mx, xor32_f(mx));
  if (__any(mx > st.m + FTHR)) {
    const float mn = fmaxf(st.m, mx); const float al = __builtin_amdgcn_exp2f(st.m - mn); st.m = mn; st.l *= al; xch[r32] = al;
#pragma unroll
    for (int e = 0; e < 16; ++e) { const float a = xch[crow(e, hi)]; st.o0[e] *= a; st.o1[e] *= a; }
  }
  const float bm = bb - st.m; float ps = 0.f;
#pragma unroll
  for (int e = 0; e < 16; ++e) { s0[e] = __builtin_amdgcn_exp2f(__builtin_fmaf(s0[e], qs, bm)); s1[e] = __builtin_amdgcn_exp2f(__builtin_fmaf(s1[e], qs, bm)); ps += s0[e] + s1[e]; }
  st.l += ps;
  bf16x8 pa[4]; pa[0] = pack8(s0, 0); pa[1] = pack8(s0, 8); pa[2] = pack8(s1, 0); pa[3] = pack8(s1, 8);
  const unsigned short* vb = vimg + (4 * hi + ((lane & 15) >> 2)) * 32 + ((lane >> 4) & 1) * 16 + (lane & 3) * 4;
#pragma unroll
  for (int kk = 0; kk < 4; ++kk) {
#pragma unroll
    for (int db = 0; db < 2; ++db) {
      const v4i16_t lo = __builtin_amdgcn_ds_read_tr16_b64_v4i16((LDS3 v4i16_t*)(vb + db * 2048 + kk * 512));
      const v4i16_t hh = __builtin_amdgcn_ds_read_tr16_b64_v4i16((LDS3 v4i16_t*)(vb + db * 2048 + kk * 512 + 256));
      const bf16x8 vf = {lo[0], lo[1], lo[2], lo[3], hh[0], hh[1], hh[2], hh[3]};
      if (db == 0) st.o0 = MFMA32(pa[kk], vf, st.o0); else st.o1 = MFMA32(pa[kk], vf, st.o1);
    }
  }
}
#ifndef FT2
#define FT2 1
#endif
template <class VRow, class Fix0, class Fix1>
__device__ __forceinline__ void flash_tile2(FlashState& st, const bf16x8 (&qf)[4], const SB* kp0, const SB* kp1, VRow vrow, Fix0 fix0, Fix1 fix1, WaveLds* L, int lane) {
  if (!FT2) { flash_tile(st, qf, kp0, [&](int key) { return vrow(key); }, fix0, L, lane); flash_tile(st, qf, kp1, [&](int key) { return vrow(key + 32); }, fix1, L, lane); return; }
  const int hi = lane >> 5;
  bf16x8 kf0[4], kf1[4];
#pragma unroll
  for (int d0 = 0; d0 < 4; ++d0) { kf0[d0] = *(const bf16x8*)(kp0 + d0 * 16 + hi * 8); kf1[d0] = *(const bf16x8*)(kp1 + d0 * 16 + hi * 8); }
#pragma unroll
  for (int i = 0; i < 8; ++i) { const int c = lane + 64 * i, key = c >> 3, ch = c & 7; const SB* vp = vrow(key); const uint4 vv = *(const uint4*)(vp + ch * 8);
    *(uint4*)&L->v[(ch >> 2) * 2048 + key * 32 + (ch & 3) * 8] = vv; }
  f32x16 s0 = zero16(), s1 = zero16();
#pragma unroll
  for (int d0 = 0; d0 < 4; ++d0) { s0 = MFMA32(kf0[d0], qf[d0], s0); s1 = MFMA32(kf1[d0], qf[d0], s1); }
  fix0(s0); fix1(s1);
  flash_core2(st, s0, s1, L->v, L->xch, lane);
}
template <class KPtr, class VRow, class Fix>
__device__ __forceinline__ void flash_run(FlashState& st, const bf16x8 (&qf)[4], int t0, int t1, KPtr kptr, VRow vrow, Fix fix, WaveLds* L, int lane) {
  if (t0 >= t1) return;
  const int hi = lane >> 5; bf16x8 kfn[4];
#define FR_ISSUE(tt) { const int t_ = (tt); _Pragma("unroll") for (int i_ = 0; i_ < 4; ++i_) { const int db_ = i_ >> 1, key_ = (i_ & 1) * 16 + (lane >> 2), wi_ = lane & 3; \
      __builtin_amdgcn_global_load_lds((gptr_t)(vrow(t_, key_) + db_ * 32 + wi_ * 8), (lptr_t)&L->v[db_ * 2048 + (t_ & 1) * 1024 + (i_ & 1) * 512], 16, 0, 0); } \
    const SB* kp_ = kptr(t_); _Pragma("unroll") for (int d0_ = 0; d0_ < 4; ++d0_) kfn[d0_] = *(const GLB1 bf16x8*)(kp_ + d0_ * 16 + hi * 8); }
  FR_ISSUE(t0)
  for (int t = t0; t < t1; ++t) {
    asm volatile("s_waitcnt vmcnt(0)" ::: "memory");
    bf16x8 kf[4];
#pragma unroll
    for (int d0 = 0; d0 < 4; ++d0) kf[d0] = kfn[d0];
    if (t + 1 < t1) FR_ISSUE(t + 1)
    f32x16 s = zero16();
#pragma unroll
    for (int d0 = 0; d0 < 4; ++d0) s = MFMA32(kf[d0], qf[d0], s);
    fix(t, s);
    flash_core1(st, s, L->v + (t & 1) * 1024, L->xch, lane);
  }
#undef FR_ISSUE
}
__device__ __forceinline__ float flash_finish(FlashState& st, WaveLds* L, int lane) {
  const int r32 = lane & 31, hi = lane >> 5;
  const float lt = st.l + xor32_f(st.l); const float inv = lt > 0.f ? 1.f / lt : 0.f;
  L->xch[r32] = inv;
#pragma unroll
  for (int e = 0; e < 16; ++e) { const float a = L->xch[crow(e, hi)]; st.o0[e] *= a; st.o1[e] *= a; }
  return (st.m + __builtin_amdgcn_logf(lt)) * LN2;
}
__device__ __forceinline__ void load_q(bf16x8 (&qf)[4], const SB* qp, int hi) {
#pragma unroll
  for (int d0 = 0; d0 < 4; ++d0) qf[d0] = *(const GLB1 bf16x8*)(qp + d0 * 16 + hi * 8);
}
__device__ __forceinline__ void fix_tab(f32x16& s, const WaveLds* L, int base, int lane, bool chk, int kb) {
  const int r32 = lane & 31, hi = lane >> 5; const float* tp = L->tab + base + r32 + 32 - 4 * hi;
#pragma unroll
  for (int e = 0; e < 16; ++e) { const int kk = (e & 3) + 8 * (e >> 2); float v = s[e] * QSC + tp[-kk]; if (chk && (kb + kk + 4 * hi < 0)) v = NINF; s[e] = v; }
}

__device__ __forceinline__ void unit_c(const Params& p, int layer, int u, WaveLds* L, int lane) {
  const int h = u & 7, qt = u >> 3, q0 = qt * 32, hk = h >> 2, r32 = lane & 31, hi = lane >> 5;
  for (int x = lane; x < 192; x += 64) { const int dist = x - 32; L->tab[x] = (dist >= 0 && dist <= 127) ? 0.f : NINF; }
  bf16x8 qf[4]; load_q(qf, p.proj + (long)(q0 + r32) * NPROJ + PC_Q + h * 64, hi);
  FlashState st; st.o0 = zero16(); st.o1 = zero16(); st.m = p.sinks[layer * 8 + h] * L2E; st.l = hi ? 0.f : 1.f;
  const SB* kvb = p.proj + PC_KV + hk * 64; const bool chk = q0 < 128;
  flash_run(st, qf, 0, 5, [&](int t) { int tok = q0 - 128 + 32 * t + r32; tok = tok < 0 ? 0 : tok; return kvb + (long)tok * NPROJ; },
            [&](int t, int key) { int tk = q0 - 128 + 32 * t + key; tk = tk < 0 ? 0 : tk; return kvb + 128 + (long)tk * NPROJ; },
            [&](int t, f32x16& s) { fix_tab(s, L, 128 - 32 * t, lane, chk, q0 - 128 + 32 * t); }, L, lane);
  flash_finish(st, L, lane);
  { SB m0[16], m1[16];
#pragma unroll
    for (int e = 0; e < 16; ++e) { const SB* mp = p.mix + (long)(q0 + crow(e, hi)) * NMIX + MX_C + h * 64 + r32; m0[e] = mp[0]; m1[e] = mp[32]; }
#pragma unroll
    for (int e = 0; e < 16; ++e) { SB* mp = p.mix + (long)(q0 + crow(e, hi)) * NMIX + MX_C + h * 64 + r32; mp[0] = f2bf(st.o0[e] * bf2f(m0[e])); mp[32] = f2bf(st.o1[e] * bf2f(m1[e])); } }
}
__device__ __forceinline__ void unit_m(const Params& p, int layer, int u, WaveLds* L, int lane) {
  const int h = u & 3, qt = u >> 2, q0 = qt * 32, r32 = lane & 31, hi = lane >> 5;
  bf16x8 qf[4]; load_q(qf, p.proj + (long)(q0 + r32) * NPROJ + PM_Q + h * 64, hi);
  FlashState st; st.o0 = zero16(); st.o1 = zero16(); st.m = -1e30f; st.l = 0.f;
  const SB* kb = p.memkv + (long)layer * 256 * 512 + h * 64;
  flash_run(st, qf, 0, 8, [&](int t) { return kb + (long)(32 * t + r32) * 512; }, [&](int t, int key) { return kb + 256 + (long)(32 * t + key) * 512; },
            [&](int, f32x16& s) {
#pragma unroll
              for (int e = 0; e < 16; ++e) s[e] *= QSC; }, L, lane);
  flash_finish(st, L, lane);
  { SB m0[16], m1[16];
#pragma unroll
    for (int e = 0; e < 16; ++e) { const SB* mp = p.mix + (long)(q0 + crow(e, hi)) * NMIX + MX_M + h * 64 + r32; m0[e] = mp[0]; m1[e] = mp[32]; }
#pragma unroll
    for (int e = 0; e < 16; ++e) { SB* mp = p.mix + (long)(q0 + crow(e, hi)) * NMIX + MX_M + h * 64 + r32; mp[0] = f2bf(st.o0[e] * bf2f(m0[e])); mp[32] = f2bf(st.o1[e] * bf2f(m1[e])); } }
}
__device__ __forceinline__ void unit_awin(const Params& p, int u, WaveLds* L, int lane) {
  const int h = u & 7, qt = u >> 3, q0 = qt * 32, hk = h >> 2, r32 = lane & 31, hi = lane >> 5;
  { float tv[10];
#pragma unroll
    for (int i = 0; i < 10; ++i) { const int dist = lane + 64 * i - 32; const int dc = dist < 0 ? 0 : (dist > 511 ? 511 : dist); tv[i] = p.tabA[h * TABA_N + dc]; }
#pragma unroll
    for (int i = 0; i < 10; ++i) { const int x = lane + 64 * i, dist = x - 32; if (x < 608) L->tab[x] = (dist >= 0 && dist <= 511) ? tv[i] * L2E : NINF; } }
  bf16x8 qf[4]; load_q(qf, p.proj + (long)(q0 + r32) * NPROJ + PA_Q + h * 64, hi);
  FlashState st; st.o0 = zero16(); st.o1 = zero16(); st.m = -1e30f; st.l = 0.f;
  const SB* kvb = p.proj + PA_KV + 4 * 128 + hk * 64; const bool chk = q0 < 512;
  { int tfirst = 0; if (q0 < 512) tfirst = (512 - q0) / 32 - 0; if (tfirst > 16) tfirst = 16; if (q0 < 512 && (q0 - 512 + 32 * tfirst + 31) < 0) ++tfirst;
    flash_run(st, qf, tfirst, 17, [&](int t) { int tok = q0 - 512 + 32 * t + r32; tok = tok < 0 ? 0 : tok; return kvb + (long)tok * NPROJ; },
              [&](int t, int key) { int tk = q0 - 512 + 32 * t + key; tk = tk < 0 ? 0 : tk; return kvb + 128 + (long)tk * NPROJ; },
              [&](int t, f32x16& s) { fix_tab(s, L, 512 - 32 * t, lane, chk, q0 - 512 + 32 * t); }, L, lane); }
  flash_finish(st, L, lane);
#pragma unroll
  for (int e = 0; e < 16; ++e) { SB* op = p.ow + (long)(q0 + crow(e, hi)) * 512 + h * 64 + r32; op[0] = f2bf(st.o0[e]); op[32] = f2bf(st.o1[e]); }
}
__device__ __forceinline__ void unit_d(const Params& p, int u, WaveLds* L, int lane) {
  const int S = p.S, per = (S / 32) * 8; const int gi = u / per, u2 = u % per; const int h = u2 & 7, v = u2 >> 3;
  const int dil = gi == 0 ? 1 : (gi == 1 ? 4 : 16); const int it = v / dil, r = v % dil, i0 = it * 32;
  const int r32 = lane & 31, hi = lane >> 5;
  { float tv[3];
#pragma unroll
    for (int i = 0; i < 3; ++i) { const int dd = lane + 64 * i - 32; const int dc = dd < 0 ? 0 : (dd > 128 ? 128 : dd); tv[i] = p.tabD[(gi * 8 + h) * TABD_N + dc]; }
#pragma unroll
    for (int i = 0; i < 3; ++i) { const int x = lane + 64 * i, dd = x - 32; L->tab[x] = (dd >= 0 && dd <= 128) ? tv[i] * L2E : NINF; } }
  bf16x8 qf[4]; load_q(qf, p.proj + (long)(r + dil * (i0 + r32)) * NPROJ + PD_Q + gi * 512 + h * 64, hi);
  FlashState st; st.o0 = zero16(); st.o1 = zero16(); st.m = -1e30f; st.l = 0.f;
  const SB* kvb = p.proj + PD_KV + h * 64; const bool chk = i0 < 128;
  flash_run(st, qf, 0, 5, [&](int t) { int j = i0 - 128 + 32 * t + r32; j = j < 0 ? 0 : j; return kvb + (long)(r + dil * j) * NPROJ; },
            [&](int t, int key) { int jj = i0 - 128 + 32 * t + key; jj = jj < 0 ? 0 : jj; return kvb + 512 + (long)(r + dil * jj) * NPROJ; },
            [&](int t, f32x16& s) { fix_tab(s, L, 128 - 32 * t, lane, chk, i0 - 128 + 32 * t); }, L, lane);
  const float lse = flash_finish(st, L, lane);
#pragma unroll
  for (int e = 0; e < 16; ++e) { const long tok = r + dil * (i0 + crow(e, hi)); SB* op = p.dop + ((long)gi * S + tok) * 512 + h * 64 + r32; op[0] = f2bf(st.o0[e]); op[32] = f2bf(st.o1[e]); }
  if (hi == 0) p.dlse[((long)gi * S + r + dil * (i0 + r32)) * 8 + h] = lse;
}
__device__ __forceinline__ void fix_cmp(f32x16& s, const float* tabh, float c31, int q0, int t, int lane) {
  const int r32 = lane & 31, hi = lane >> 5; const int dq = q0 + r32 - 31 - 16 * (32 * t + 4 * hi);
  const bool far = (q0 - 16 * (32 * t + 31) - 31) >= 1513;
  if (far) {
#pragma unroll
    for (int e = 0; e < 16; ++e) s[e] = __builtin_fmaf(s[e], QSC, c31);
  } else {
    float bv[16];
#pragma unroll
    for (int e = 0; e < 16; ++e) { const int dist = dq - 16 * ((e & 3) + 8 * (e >> 2)); const int dc = dist < 0 ? 0 : (dist > 2047 ? 2047 : dist); bv[e] = tabh[dc]; }
#if 1
#pragma unroll
    for (int e = 0; e < 16; e += 4) asm volatile("" : "+v"(bv[e]), "+v"(bv[e + 1]), "+v"(bv[e + 2]), "+v"(bv[e + 3]));
#endif
#pragma unroll
    for (int e = 0; e < 16; ++e) { const int dist = dq - 16 * ((e & 3) + 8 * (e >> 2)); s[e] = dist < 0 ? NINF : __builtin_fmaf(s[e], QSC, bv[e] * L2E); }
  }
}
__device__ __forceinline__ void unit_acmp1(const Params& p, int u, WaveLds* L, int lane) {
  const int h = u & 7, qt = (p.S / 32 - 1) - (u >> 3), q0 = qt * 32, g = h >> 2, r32 = lane & 31, hi = lane >> 5; const int ncmp = p.S / 16;
  bf16x8 qf[4]; load_q(qf, p.proj + (long)(q0 + r32) * NPROJ + PA_Q + h * 64, hi);
  FlashState st; st.o0 = zero16(); st.o1 = zero16(); st.m = -1e30f; st.l = 0.f;
  const int jn = q0 / 16 + 1, nt = (jn + 31) / 32; const SB* kc = p.kvc + g * 64; const SB* vc = p.kvc + (long)ncmp * 128 + g * 64;
  const float* tabh = p.tabA + h * TABA_N; const float c31 = tabh[2047] * L2E;
  flash_run(st, qf, 0, nt, [&](int t) { int j = 32 * t + r32; j = j >= ncmp ? ncmp - 1 : j; return kc + (long)j * 128; },
            [&](int t, int key) { int jj = 32 * t + key; jj = jj >= ncmp ? ncmp - 1 : jj; return vc + (long)jj * 128; },
            [&](int t, f32x16& s) { fix_cmp(s, tabh, c31, q0, t, lane); }, L, lane);
  const float lt = st.l + xor32_f(st.l); const float inv = lt > 0.f ? 1.f / lt : 0.f;
  flash_finish(st, L, lane);
#pragma unroll
  for (int e = 0; e < 16; ++e) { SB* op = p.oc + (long)(q0 + crow(e, hi)) * 512 + h * 64 + r32; op[0] = f2bf(st.o0[e]); op[32] = f2bf(st.o1[e]); }
  if (hi == 0) { p.cml[((long)(q0 + r32) * 8 + h) * 2] = st.m; p.cml[((long)(q0 + r32) * 8 + h) * 2 + 1] = inv; }
}
__device__ __forceinline__ void unit_acmp2(const Params& p, int u, int lane) {
  const int part = u & 3, g = (u >> 2) & 1, qt = (p.S / 32 - 1) - (u >> 3), q0 = qt * 32, r32 = lane & 31, hi = lane >> 5; const int ncmp = p.S / 16;
  const int jn = q0 / 16 + 1, nt = (jn + 31) / 32; const SB* kc = p.kvc + g * 64; float carry = 0.f;
  const int tper = (nt + 3) >> 2, tbeg = part * tper, tend = (tbeg + tper < nt) ? tbeg + tper : nt; if (tbeg >= nt) return;
  float* impq = p.imp + ((long)qt * 2 + g) * 256 * 32 + r32;
  const SB* qbase = p.proj + (long)(q0 + r32) * NPROJ + PA_Q + g * 256; const float* cmlq = p.cml + ((long)(q0 + r32) * 8 + g * 4) * 2;
  bf16x8 qc[4]; load_q(qc, qbase, hi); float mc = cmlq[0], ilc = cmlq[1], c31c = p.tabA[(g * 4) * TABA_N + 2047] * L2E;
  bf16x8 kfn[4]; { const int t = (tbeg > 0 ? tbeg - 1 : 0); int j = 32 * t + r32; j = j >= ncmp ? ncmp - 1 : j; const SB* kp = kc + (long)j * 128;
#pragma unroll
    for (int d0 = 0; d0 < 4; ++d0) kfn[d0] = *(const GLB1 bf16x8*)(kp + d0 * 16 + hi * 8); }
  for (int t = (tbeg > 0 ? tbeg - 1 : 0); t < tend; ++t) {
    bf16x8 kf[4];
#pragma unroll
    for (int d0 = 0; d0 < 4; ++d0) kf[d0] = kfn[d0];
    if (t + 1 < tend) { int j = 32 * (t + 1) + r32; j = j >= ncmp ? ncmp - 1 : j; const SB* kp = kc + (long)j * 128;
#pragma unroll
      for (int d0 = 0; d0 < 4; ++d0) kfn[d0] = *(const GLB1 bf16x8*)(kp + d0 * 16 + hi * 8); }
    float accA[4] = {0.f, 0.f, 0.f, 0.f}, accL[4] = {0.f, 0.f, 0.f, 0.f};
#pragma unroll 1
    for (int hh = 0; hh < 4; ++hh) { const int hn = (hh + 1) & 3;
      bf16x8 qn[4]; load_q(qn, qbase + hn * 64, hi); const float mn = cmlq[hn * 2], iln = cmlq[hn * 2 + 1], c31n = p.tabA[(g * 4 + hn) * TABA_N + 2047];
      f32x16 s = zero16();
#pragma unroll
      for (int d0 = 0; d0 < 4; ++d0) s = MFMA32(kf[d0], qc[d0], s);
      fix_cmp(s, p.tabA + (g * 4 + hh) * TABA_N, c31c, q0, t, lane);
#pragma unroll
      for (int e = 0; e < 16; ++e) { const float pr = __builtin_amdgcn_exp2f(s[e] - mc) * ilc; accA[e >> 2] += pr; if ((e & 3) == 3) accL[e >> 2] += pr; }
#pragma unroll
      for (int d0 = 0; d0 < 4; ++d0) qc[d0] = qn[d0];
      mc = mn; ilc = iln; c31c = c31n * L2E; }
    float oth[4];
#pragma unroll
    for (int eg = 0; eg < 4; ++eg) oth[eg] = xor32_f(accL[eg]);
#pragma unroll
    for (int eg = 0; eg < 4; ++eg) { const float prev = hi ? oth[eg] : (eg > 0 ? oth[eg > 0 ? eg - 1 : 0] : carry); if (t >= tbeg) impq[(8 * t + 2 * eg + hi) * 32] = 2.f * accA[eg] - accL[eg] + prev; }
    carry = oth[3]; }
}
#define DPP_F(v, ctrl, rm) __builtin_bit_cast(float, __builtin_amdgcn_update_dpp(__builtin_bit_cast(int, v), __builtin_bit_cast(int, v), ctrl, rm, 0xf, false))
#define DPP_I(v, ctrl, rm) __builtin_amdgcn_update_dpp(v, v, ctrl, rm, 0xf, false)
__device__ __forceinline__ float wave_max_f(float v) {
  v = fmaxf(v, DPP_F(v, 0xB1, 0xf)); v = fmaxf(v, DPP_F(v, 0x4E, 0xf)); v = fmaxf(v, DPP_F(v, 0x141, 0xf)); v = fmaxf(v, DPP_F(v, 0x140, 0xf));
  v = fmaxf(v, DPP_F(v, 0x142, 0xa)); v = fmaxf(v, DPP_F(v, 0x143, 0xc));
  return __builtin_bit_cast(float, __builtin_amdgcn_readlane(__builtin_bit_cast(int, v), 63)); }
__device__ __forceinline__ int imin_(int a, int b) { return a < b ? a : b; }
__device__ __forceinline__ int wave_min_i(int v) {
  v = imin_(v, DPP_I(v, 0xB1, 0xf)); v = imin_(v, DPP_I(v, 0x4E, 0xf)); v = imin_(v, DPP_I(v, 0x141, 0xf)); v = imin_(v, DPP_I(v, 0x140, 0xf));
  v = imin_(v, DPP_I(v, 0x142, 0xa)); v = imin_(v, DPP_I(v, 0x143, 0xc));
  return __builtin_amdgcn_readlane(v, 63); }
__device__ __forceinline__ void unit_topk(const Params& p, int u, int lane) {
  const int q = u >> 1, cur = q >> 6; const float* imp = p.imp + ((long)(q >> 5) * 2 + (u & 1)) * 256 * 32 + (q & 31); int* idx = p.idx + (long)u * 16;
  float v[4];
#pragma unroll
  for (int k = 0; k < 4; ++k) { const int b = lane + 64 * k; float x = (b <= cur) ? imp[b * 32] : -1.f; if (b == 0 || b == cur) x = 1e4f; v[k] = x; }
  int mine = -1;
  for (int k = 0; k < 16; ++k) {
    float lm = fmaxf(fmaxf(v[0], v[1]), fmaxf(v[2], v[3])); const float m = wave_max_f(lm);
    int cand = 0x7fffffff;
#pragma unroll
    for (int kk = 3; kk >= 0; --kk) if (v[kk] == m) cand = lane + 64 * kk;
    const int bsel = wave_min_i(cand);
#pragma unroll
    for (int kk = 0; kk < 4; ++kk) if (lane + 64 * kk == bsel) v[kk] = -2.f;
    if (lane == k) mine = (m >= 0.f) ? bsel : -1;
  }
  if (lane < 16) idx[lane] = mine;
}
template <bool STORE = true>
__device__ __forceinline__ void unit_asel(const Params& p, int u, WaveLds* L, int lane) {
  const int g = u & 1, q = u >> 1, r32 = lane & 31, hi = lane >> 5, hh = r32 & 3, h = g * 4 + hh;
  bf16x8 qf[4]; load_q(qf, p.proj + (long)q * NPROJ + PA_Q + h * 64, hi);
  FlashState st; st.o0 = zero16(); st.o1 = zero16(); st.m = -1e30f; st.l = 0.f;
  const int* idx = p.idx + (long)u * 16; const SB* kvb = p.proj + PA_KV + 2 * 128 + g * 64; const float c31 = p.tabA[h * TABA_N + 2047] * L2E;
  for (int k = 0; k < 16; ++k) { const int b = __builtin_amdgcn_readfirstlane(idx[k]); if (b < 0) continue;
    for (int kt = 0; kt < 2; ++kt) { const int t0 = b * 64 + kt * 32; if (t0 > q) continue;
      const bool far = (q - (t0 + 31)) >= 1513; const bool edge = (t0 + 31 > q);
      flash_tile(st, qf, kvb + (long)(t0 + r32) * NPROJ, [&](int key) { return kvb + 128 + (long)(t0 + key) * NPROJ; },
                 [&](f32x16& s) {
#pragma unroll
                   for (int e = 0; e < 16; ++e) { const int tk = t0 + (e & 3) + 8 * (e >> 2) + 4 * hi; const int dist = q - tk; float bsv;
                     if (far) bsv = c31; else { const int dc = dist < 0 ? 0 : (dist > 2047 ? 2047 : dist); bsv = p.tabA[h * TABA_N + dc] * L2E; }
                     float vv = s[e] * QSC + bsv; if (edge && dist < 0) vv = NINF; s[e] = vv; } }, L, lane); } }
  flash_finish(st, L, lane);
  if (!STORE) { asm volatile("" :: "v"(st.o0[0]), "v"(st.o1[3])); return; }
  if (hi == 0) {
#pragma unroll
    for (int e = 0; e < 4; ++e) { const int he = g * 4 + e; const float* gl = p.small + (long)q * NSMALL + he * 3;
      const float g0 = sigmoid_fast(gl[0]), g1 = sigmoid_fast(gl[1]), g2 = sigmoid_fast(gl[2]);
#pragma unroll
      for (int db = 0; db < 2; ++db) { const long c = (long)q * 512 + he * 64 + db * 32 + r32; const float os = db ? st.o1[e] : st.o0[e];
        const float a = g0 * bf2f(p.oc[c]) + g1 * os + g2 * bf2f(p.ow[c]); SB* mp = p.mix + (long)q * NMIX + MX_A + he * 64 + db * 32 + r32; *mp = f2bf(a * bf2f(*mp)); } }
  }
}

struct WaveLds2 { unsigned short x[2048]; unsigned short b[2048]; float acs[128]; float dtv[128]; float xch[64]; };
template <bool SCALE, class RowScale>
__device__ __forceinline__ void stage_slab(unsigned short* dst, const SB* src, long ld, RowScale rs, int lane) {
#pragma unroll
  for (int i = 0; i < 4; ++i) { const int c = lane + 64 * i, row = c >> 3, ch = c & 7; const u32x4 gv = *(const GLB1 u32x4*)(src + (long)row * ld + ch * 8); uint4 vv; vv.x = gv[0]; vv.y = gv[1]; vv.z = gv[2]; vv.w = gv[3];
    if (SCALE) { const float sc = rs(row); unsigned w[4] = {vv.x, vv.y, vv.z, vv.w};
#pragma unroll
      for (int k = 0; k < 4; ++k) { const float lo = __uint_as_float(w[k] << 16) * sc, hi2 = __uint_as_float(w[k] & 0xffff0000u) * sc; w[k] = pk2(lo, hi2); }
      vv.x = w[0]; vv.y = w[1]; vv.z = w[2]; vv.w = w[3]; }
    *(uint4*)&dst[(ch >> 2) * 1024 + row * 32 + (ch & 3) * 8] = vv; }
}
__device__ __forceinline__ bf16x8 slab_frag(const unsigned short* img, int cb, int s2, int lane) {
  const int hi = lane >> 5; const unsigned short* vb = img + (4 * hi + ((lane & 15) >> 2)) * 32 + ((lane >> 4) & 1) * 16 + (lane & 3) * 4 + cb * 1024 + s2 * 512;
  const v4i16_t lo = __builtin_amdgcn_ds_read_tr16_b64_v4i16((LDS3 v4i16_t*)vb);
  const v4i16_t hh = __builtin_amdgcn_ds_read_tr16_b64_v4i16((LDS3 v4i16_t*)(vb + 256));
  return (bf16x8){lo[0], lo[1], lo[2], lo[3], hh[0], hh[1], hh[2], hh[3]};
}
__device__ __forceinline__ void unit_bstates(const Params& p, int u, WaveLds2* L, int lane) {
  const int nh = u & 1, hd = (u >> 1) & 7, c = u >> 4, g = hd >> 2, r32 = lane & 31, hi = lane >> 5;
  f32x16 acc[2][2];
#pragma unroll
  for (int i = 0; i < 2; ++i)
#pragma unroll
    for (int j = 0; j < 2; ++j) acc[i][j] = zero16();
  const SB* xb = p.xconv + (long)c * 128 * 1024; const float* wst = p.wst + (long)c * 128 * 8 + hd;
  u32x4 xn[4], bn[4]; float sn[4];
#define BST_LOAD(q_) { _Pragma("unroll") for (int i_ = 0; i_ < 4; ++i_) { const int c_ = lane + 64 * i_, row_ = c_ >> 3, ch_ = c_ & 7; \
      xn[i_] = *(const GLB1 u32x4*)(xb + (long)(32 * (q_) + row_) * 1024 + hd * 64 + ch_ * 8); bn[i_] = *(const GLB1 u32x4*)(xb + (long)(32 * (q_) + row_) * 1024 + 512 + g * 128 + nh * 64 + ch_ * 8); \
      sn[i_] = *(const GLB1 float*)&wst[(32 * (q_) + row_) * 8]; } }
  BST_LOAD(0)
  for (int q4 = 0; q4 < 4; ++q4) {
#pragma unroll
    for (int i = 0; i < 4; ++i) { const int c_ = lane + 64 * i, row = c_ >> 3, ch = c_ & 7; u32x4 w = xn[i];
#pragma unroll
      for (int k = 0; k < 4; ++k) { const float lo = __uint_as_float(w[k] << 16) * sn[i], hi2 = __uint_as_float(w[k] & 0xffff0000u) * sn[i]; w[k] = pk2(lo, hi2); }
      *(u32x4*)&L->x[(ch >> 2) * 1024 + row * 32 + (ch & 3) * 8] = w; *(u32x4*)&L->b[(ch >> 2) * 1024 + row * 32 + (ch & 3) * 8] = bn[i]; }
    { const int qn = q4 < 3 ? q4 + 1 : 3; BST_LOAD(qn) }
#pragma unroll
    for (int s2 = 0; s2 < 2; ++s2) { bf16x8 af[2], bfr[2];
#pragma unroll
      for (int i = 0; i < 2; ++i) { af[i] = slab_frag(L->x, i, s2, lane); bfr[i] = slab_frag(L->b, i, s2, lane); }
#pragma unroll
      for (int i = 0; i < 2; ++i)
#pragma unroll
        for (int j = 0; j < 2; ++j) acc[i][j] = MFMA32(af[i], bfr[j], acc[i][j]); } }
#undef BST_LOAD
  float* so = p.states + ((long)c * 8 + hd) * 8192 + nh * 64 + r32;
#pragma unroll
  for (int i = 0; i < 2; ++i)
#pragma unroll
    for (int j = 0; j < 2; ++j)
#pragma unroll
      for (int e = 0; e < 16; ++e) so[(long)(32 * i + crow(e, hi)) * 128 + 32 * j] = acc[i][j][e];
}
__device__ __forceinline__ void unit_bout(const Params& p, int layer, int u, WaveLds2* L, int lane) {
  const int lt = u & 3, hd = (u >> 2) & 7, c = u >> 5, g = hd >> 2, r32 = lane & 31, hi = lane >> 5;
  for (int x = lane; x < 128; x += 64) { L->acs[x] = p.acs[((long)c * 128 + x) * 8 + hd]; L->dtv[x] = p.dt[((long)c * 128 + x) * 8 + hd]; }
  f32x16 acc[2] = {zero16(), zero16()}, acc2[2] = {zero16(), zero16()};
  const SB* xb = p.xconv + (long)c * 128 * 1024; const int l = 32 * lt + r32; const float al = p.acs[((long)c * 128 + l) * 8 + hd];
  const float* cbr = p.cb + ((long)c * 2 + g) * 16384 + (long)l * 128;
  for (int sc = 0; sc <= lt; ++sc) {
    stage_slab<false>(L->x, xb + (long)(32 * sc) * 1024 + hd * 64, 1024, [&](int) { return 1.f; }, lane);
#pragma unroll
    for (int s2 = 0; s2 < 2; ++s2) { float mv[8];
#pragma unroll
      for (int jj = 0; jj < 2; ++jj) { const int s0 = 32 * sc + 16 * s2 + 8 * jj + 4 * hi; const float4 cv = *(const float4*)(cbr + s0); const float4 av = *(const float4*)(&L->acs[s0]); const float4 dv = *(const float4*)(&L->dtv[s0]);
        mv[4 * jj + 0] = (s0 + 0 <= l) ? cv.x * __expf(al - av.x) * dv.x : 0.f; mv[4 * jj + 1] = (s0 + 1 <= l) ? cv.y * __expf(al - av.y) * dv.y : 0.f;
        mv[4 * jj + 2] = (s0 + 2 <= l) ? cv.z * __expf(al - av.z) * dv.z : 0.f; mv[4 * jj + 3] = (s0 + 3 <= l) ? cv.w * __expf(al - av.w) * dv.w : 0.f; }
      u32x4 aw; aw[0] = pk2(mv[0], mv[1]); aw[1] = pk2(mv[2], mv[3]); aw[2] = pk2(mv[4], mv[5]); aw[3] = pk2(mv[6], mv[7]); const bf16x8 af = __builtin_bit_cast(bf16x8, aw);
#pragma unroll
      for (int pt = 0; pt < 2; ++pt) acc[pt] = MFMA32(af, slab_frag(L->x, pt, s2, lane), acc[pt]); } }
  const SB* cmr = xb + (long)l * 1024 + 768 + g * 128; const float* prv = p.states + ((long)c * 8 + hd) * 8192;
#pragma unroll 2
  for (int ks = 0; ks < 8; ++ks) { const bf16x8 af = *(const bf16x8*)(cmr + 16 * ks + 8 * hi);
#pragma unroll
    for (int pt = 0; pt < 2; ++pt) { const float* pr = prv + (long)(32 * pt + r32) * 128 + 16 * ks + 8 * hi; const float4 a0 = *(const float4*)pr, a1 = *(const float4*)(pr + 4);
      u32x4 bw; bw[0] = pk2(a0.x, a0.y); bw[1] = pk2(a0.z, a0.w); bw[2] = pk2(a1.x, a1.y); bw[3] = pk2(a1.z, a1.w);
      acc2[pt] = MFMA32(af, __builtin_bit_cast(bf16x8, bw), acc2[pt]); } }
  const float dsk = p.b_d[layer * 8 + hd];
#pragma unroll
  for (int e = 0; e < 16; ++e) { const int lr = 32 * lt + crow(e, hi); const float ea = __expf(L->acs[lr]); const long t = (long)c * 128 + lr;
#pragma unroll
    for (int pt = 0; pt < 2; ++pt) { const int pp = 32 * pt + r32; p.ybuf[t * 512 + hd * 64 + pp] = acc[pt][e] + ea * acc2[pt][e] + dsk * bf2f(xb[(long)lr * 1024 + hd * 64 + pp]); } }
}
__device__ __forceinline__ void unit_bnorm(const Params& p, int layer, int u, int lane) {
  const int g = u & 1; const long t = u >> 1; const float4 yv = *(const float4*)(p.ybuf + t * 512 + g * 256 + lane * 4);
  SB* mp = p.mix + t * NMIX + MX_B + g * 256 + lane * 4; const ushort4 zv = *(const ushort4*)mp;
  const float v0 = yv.x * bf2f(zv.x), v1 = yv.y * bf2f(zv.y), v2 = yv.z * bf2f(zv.z), v3 = yv.w * bf2f(zv.w);
  const float ss = wave_sum_f(v0 * v0 + v1 * v1 + v2 * v2 + v3 * v3); const float r = 1.f / sqrtf(ss * (1.f / 256.f) + 1e-6f);
  const float4 w = *(const float4*)(p.b_norm + layer * 512 + g * 256 + lane * 4);
  ushort4 o; o.x = f2bf(v0 * r * w.x); o.y = f2bf(v1 * r * w.y); o.z = f2bf(v2 * r * w.z); o.w = f2bf(v3 * r * w.w); *(ushort4*)mp = o;
}
__device__ __forceinline__ void unit_bdt(const Params& p, int layer, int u, int lane) {
  const int hd = u & 7, c = u >> 3; const float a = -expf(p.a_log[layer * 8 + hd]), bias = p.dt_bias[layer * 8 + hd]; const long t0 = (long)c * 128 + 2 * lane;
  const float d0 = softplus_f(p.small[t0 * NSMALL + 24 + hd] + bias), d1 = softplus_f(p.small[(t0 + 1) * NSMALL + 24 + hd] + bias);
  float run = (d0 + d1) * a;
#pragma unroll
  for (int o = 1; o < 64; o <<= 1) { const float v = __shfl_up(run, o); if (lane >= o) run += v; }
  const float tot = __shfl(run, 63); const float c1 = run, c0 = run - d1 * a;
  p.dt[t0 * 8 + hd] = d0; p.dt[(t0 + 1) * 8 + hd] = d1; p.acs[t0 * 8 + hd] = c0; p.acs[(t0 + 1) * 8 + hd] = c1;
  p.wst[t0 * 8 + hd] = d0 * expf(tot - c0); p.wst[(t0 + 1) * 8 + hd] = d1 * expf(tot - c1);
}
__device__ __forceinline__ void item_bconv(const Params& p, int layer, long gid) {
  const int cg = (int)(gid & 127) * 8; const long t = gid >> 7; const float* w = p.conv_w + (long)layer * 4 * 1024 + cg; const float* bb = p.conv_b + layer * 1024 + cg;
  const float4 b0 = *(const float4*)bb, b1 = *(const float4*)(bb + 4);
  float acc[8] = {b0.x, b0.y, b0.z, b0.w, b1.x, b1.y, b1.z, b1.w};
  u32x4 tv[4];
#pragma unroll
  for (int i = 0; i < 4; ++i) { const long tt = t - 3 + i; const long tc = tt < 0 ? 0 : tt; tv[i] = *(const GLB1 u32x4*)(p.proj + tc * NPROJ + PB_X + cg); }
#pragma unroll
  for (int i = 0; i < 4; ++i) { const long tt = t - 3 + i; const float vm = tt < 0 ? 0.f : 1.f;
    const float4 w0 = *(const float4*)(w + i * 1024), w1 = *(const float4*)(w + i * 1024 + 4); const float wv[8] = {w0.x, w0.y, w0.z, w0.w, w1.x, w1.y, w1.z, w1.w};
#pragma unroll
    for (int k = 0; k < 4; ++k) { acc[2 * k] += vm * wv[2 * k] * __uint_as_float(tv[i][k] << 16); acc[2 * k + 1] += vm * wv[2 * k + 1] * __uint_as_float(tv[i][k] & 0xffff0000u); } }
  uint4 o; o.x = pk2(silu_fast(acc[0]), silu_fast(acc[1])); o.y = pk2(silu_fast(acc[2]), silu_fast(acc[3])); o.z = pk2(silu_fast(acc[4]), silu_fast(acc[5])); o.w = pk2(silu_fast(acc[6]), silu_fast(acc[7]));
  *(uint4*)(p.xconv + t * 1024 + cg) = o;
}
__device__ __forceinline__ void scan_fast(const Params& p, long gid) {
  const int hd = (int)(gid >> 13); const int nc = p.S / 128; float h = 0.f;
  float st[16], dc[16];
#pragma unroll
  for (int i = 0; i < 16; ++i) { st[i] = p.states[(long)i * 65536 + gid]; dc[i] = p.acs[(long)(i * 128 + 127) * 8 + hd]; }
  for (int c0 = 0; c0 < nc; c0 += 16) {
    float sn[16], dn[16]; const int cn = (c0 + 16 < nc) ? c0 + 16 : c0;
#pragma unroll
    for (int i = 0; i < 16; ++i) { sn[i] = p.states[(long)(cn + i) * 65536 + gid]; dn[i] = p.acs[(long)((cn + i) * 128 + 127) * 8 + hd]; }
#pragma unroll
    for (int i = 0; i < 16; ++i) { p.states[(long)(c0 + i) * 65536 + gid] = h; h = __builtin_fmaf(h, __builtin_amdgcn_exp2f(dc[i] * L2E), st[i]); }
#pragma unroll
    for (int i = 0; i < 16; ++i) { st[i] = sn[i]; dc[i] = dn[i]; }
  }
}
__device__ __forceinline__ void unit_cmp(const Params& p, int layer, int u, int lane) {
  const int ncmp = p.S / 16, ntile = ncmp * 2 / 32; const int kv = u / ntile, rt = u % ntile, r32 = lane & 31, hi = lane >> 5;
  const int r = 32 * rt + r32, j = r >> 1, hk = r & 1;
  const unsigned short* w1t = p.w1t + (long)kv * 128 * 2048; const unsigned short* w2t = p.w2t + kv * 64 * 128; const float* pe = p.cmp_pos + (long)(layer * 2 + kv) * 32 * 64;
  const SB* src = p.proj + PA_KV + kv * 128 + hk * 64;
  f32x16 acc[4] = {zero16(), zero16(), zero16(), zero16()};
#pragma unroll 4
  for (int ks = 0; ks < 128; ++ks) { const int t = ks >> 2, d = (ks & 3) * 16 + 8 * hi; const long tok = 16 * j + t;
    const float4 p0 = *(const float4*)(pe + t * 64 + d), p1 = *(const float4*)(pe + t * 64 + d + 4); float v[8] = {p0.x, p0.y, p0.z, p0.w, p1.x, p1.y, p1.z, p1.w};
    { const long tokc = tok < p.S ? tok : (long)p.S - 1; const float vm = tok < p.S ? 1.f : 0.f;
      const uint4 vv = *(const uint4*)(src + tokc * NPROJ + d); const unsigned wd[4] = {vv.x, vv.y, vv.z, vv.w};
#pragma unroll
      for (int k = 0; k < 4; ++k) { v[2 * k] += vm * __uint_as_float(wd[k] << 16); v[2 * k + 1] += vm * __uint_as_float(wd[k] & 0xffff0000u); } }
    u32x4 bw; bw[0] = pk2(v[0], v[1]); bw[1] = pk2(v[2], v[3]); bw[2] = pk2(v[4], v[5]); bw[3] = pk2(v[6], v[7]); const bf16x8 bfr = __builtin_bit_cast(bf16x8, bw);
#pragma unroll
    for (int ut = 0; ut < 4; ++ut) { const bf16x8 af = *(const bf16x8*)(w1t + (long)(32 * ut + r32) * 2048 + 16 * ks + 8 * hi); acc[ut] = MFMA32(af, bfr, acc[ut]); } }
  f32x16 o2[2] = {zero16(), zero16()};
#pragma unroll
  for (int ut = 0; ut < 4; ++ut) {
#pragma unroll
    for (int e = 0; e < 16; ++e) acc[ut][e] = gelu_fast(acc[ut][e]);
#pragma unroll
    for (int s2 = 0; s2 < 2; ++s2) { const bf16x8 hb = pack8(acc[ut], 8 * s2);
#pragma unroll
      for (int dt = 0; dt < 2; ++dt) { const unsigned short* wr = w2t + (32 * dt + r32) * 128 + 32 * ut + 16 * s2 + 4 * hi; const uint2 x0 = *(const uint2*)wr, x1 = *(const uint2*)(wr + 8);
        u32x4 aw; aw[0] = x0.x; aw[1] = x0.y; aw[2] = x1.x; aw[3] = x1.y; o2[dt] = MFMA32(__builtin_bit_cast(bf16x8, aw), hb, o2[dt]); } } }
  SB* dst = p.kvc + ((long)kv * ncmp * 2 + r) * 64;
#pragma unroll
  for (int dt = 0; dt < 2; ++dt)
#pragma unroll
    for (int e = 0; e < 16; ++e) dst[32 * dt + crow(e, hi)] = f2bf(o2[dt][e]);
}

__device__ __forceinline__ unsigned umax_(unsigned a, unsigned b) { return a > b ? a : b; }
#define DPP_U(v, ctrl, rm) (unsigned)__builtin_amdgcn_update_dpp((int)(v), (int)(v), ctrl, rm, 0xf, false)
__device__ __forceinline__ unsigned wave_max_u(unsigned v) {
  v = umax_(v, DPP_U(v, 0xB1, 0xf)); v = umax_(v, DPP_U(v, 0x4E, 0xf)); v = umax_(v, DPP_U(v, 0x141, 0xf)); v = umax_(v, DPP_U(v, 0x140, 0xf));
  v = umax_(v, DPP_U(v, 0x142, 0xa)); v = umax_(v, DPP_U(v, 0x143, 0xc));
  return (unsigned)__builtin_amdgcn_readlane((int)v, 63); }
template <int NR, class RowFn, class OutFn>
__device__ __forceinline__ void topkn_rows_o(const Params& p, RowFn rowfn, OutFn outfn, int lane) {
  unsigned v[NR][4]; int mine[NR];
#pragma unroll
  for (int r = 0; r < NR; ++r) { const int row = rowfn(r); const int q = row >> 1; const int cur = q >> 6; const float* imp = p.imp + ((long)(q >> 5) * 2 + (row & 1)) * 256 * 32 + (q & 31); mine[r] = -1;
#pragma unroll
    for (int k = 0; k < 4; ++k) { const int b = lane + 64 * k; float x = (b <= cur) ? *(const GLB1 float*)&imp[b * 32] : -1.f; if (b == 0 || b == cur) x = 1e4f;
      v[r][k] = (x >= 0.f) ? ((((__float_as_uint(x) >> 8) + 1u) << 8) | (unsigned)(255 - b)) : 0u; } }
  for (int k = 0; k < 16; ++k) {
    unsigned m[NR];
#pragma unroll
    for (int r = 0; r < NR; ++r) m[r] = wave_max_u(umax_(umax_(v[r][0], v[r][1]), umax_(v[r][2], v[r][3])));
#pragma unroll
    for (int r = 0; r < NR; ++r) {
#pragma unroll
      for (int kk = 0; kk < 4; ++kk) if (v[r][kk] == m[r]) v[r][kk] = 0u;
      if (lane == k) mine[r] = (m[r] != 0u) ? (int)(255u - (m[r] & 255u)) : -1; }
  }
#pragma unroll
  for (int r = 0; r < NR; ++r) if (lane < 16) { p.idx[(long)rowfn(r) * 16 + lane] = mine[r]; outfn(r, mine[r]); }
}
template <class RowFn, class OutFn>
__device__ __forceinline__ void topk4_rows_o(const Params& p, RowFn rowfn, OutFn outfn, int lane) { topkn_rows_o<4>(p, rowfn, outfn, lane); }
template <class RowFn>
__device__ __forceinline__ void topk4_rows(const Params& p, RowFn rowfn, int lane) { topk4_rows_o(p, rowfn, [](int, int) {}, lane); }
__device__ __forceinline__ void unit_topk4(const Params& p, int u, int lane) { topk4_rows(p, [&](int r) { return u * 4 + r; }, lane); }
__device__ __forceinline__ void glds16_asm(const void* gsrc, unsigned lds_dst) {
  unsigned keep; asm volatile("s_mov_b32 %0, m0\n\ts_mov_b32 m0, %2\n\ts_nop 0\n\tglobal_load_lds_dwordx4 %1, off\n\ts_mov_b32 m0, %0" : "=&s"(keep) : "v"(gsrc), "s"(lds_dst) : "memory");
}
__device__ __forceinline__ unsigned lds_addr(const void* p) { return (unsigned)(size_t)(LDS3 const void*)p; }
struct AselLds { unsigned short k[3][4096]; unsigned short v[3][4096]; unsigned short q[4][2048]; unsigned sel[64][8]; unsigned anyb[8]; int nlist; int pad[7]; unsigned char blist[256]; float xch[4][32]; unsigned char bkt[1664]; float relS[128]; };
__device__ __forceinline__ void asel_issue(uint4 (&r)[4], const SB* kvb, int b, int tid) {
#pragma unroll
  for (int i = 0; i < 2; ++i) { const int idx = tid + 256 * i, row = idx >> 3, ch = idx & 7; const SB* src = kvb + (long)(b * 64 + row) * NPROJ + ch * 8; r[i] = *(const uint4*)src; r[2 + i] = *(const uint4*)(src + 128); }
}
__device__ __forceinline__ void asel_commit(const uint4 (&r)[4], AselLds* A, int stage, int tid) {
#pragma unroll
  for (int i = 0; i < 2; ++i) { const int idx = tid + 256 * i, row = idx >> 3, ch = idx & 7;
    *(uint4*)&A->k[stage][row * 64 + ((ch ^ (row & 7)) * 8)] = r[i];
    *(uint4*)&A->v[stage][(ch >> 2) * 2048 + row * 32 + (ch & 3) * 8] = r[2 + i]; }
}
__device__ __forceinline__ void asel_coltile(const Params& p, FlashState& S_, const unsigned short* qlds, AselLds* A, float* xch, int stage, int b, int cur, int q0, int qbase, int h, float c31, int lane) {
  const int r32 = lane & 31, hi = lane >> 5; const int ql = qbase + (r32 >> 2); const int q = q0 + ql;
  const bool selq = (A->sel[ql][b >> 5] >> (b & 31)) & 1u;
  if (!__any(selq)) return;
  bf16x8 qf[4];
#pragma unroll
  for (int d0 = 0; d0 < 4; ++d0) qf[d0] = *(const bf16x8*)&qlds[r32 * 64 + (((2 * d0 + hi) ^ ((r32 >> 1) & 7)) * 8)];
  const bool far = (q0 - (b * 64 + 63)) >= 1513; const bool edge = (b == cur);
#ifndef ASEL2
#define ASEL2 1
#endif
#if ASEL2
  bf16x8 kf0[4], kf1[4];
#pragma unroll
  for (int d0 = 0; d0 < 4; ++d0) { const int row0 = r32, row1 = 32 + r32;
    kf0[d0] = *(const bf16x8*)&A->k[stage][row0 * 64 + (((2 * d0 + hi) ^ ((row0 >> 1) & 7)) * 8)];
    kf1[d0] = *(const bf16x8*)&A->k[stage][row1 * 64 + (((2 * d0 + hi) ^ ((row1 >> 1) & 7)) * 8)]; }
  f32x16 s0 = zero16(), s1 = zero16();
#pragma unroll
  for (int d0 = 0; d0 < 4; ++d0) { s0 = MFMA32(kf0[d0], qf[d0], s0); s1 = MFMA32(kf1[d0], qf[d0], s1); }
  if (far) { flash_core2_lin(S_, s0, s1, selq ? QSC : 0.f, selq ? c31 : NINF, A->v[stage], xch, lane); return; }
#pragma unroll
  for (int e = 0; e < 16; ++e) { const int tk = b * 64 + (e & 3) + 8 * (e >> 2) + 4 * hi; const int dist = q - tk; float b0, b1;
    { const int d0c = dist < 0 ? 0 : (dist > 1663 ? 1663 : dist); const int d1 = dist - 32; const int d1c = d1 < 0 ? 0 : (d1 > 1663 ? 1663 : d1);
      b0 = A->relS[A->bkt[d0c] * 4 + (h & 3)]; b1 = A->relS[A->bkt[d1c] * 4 + (h & 3)]; }
    float v0 = s0[e] * QSC + b0, v1 = s1[e] * QSC + b1; if (!selq || (edge && dist < 0)) v0 = NINF; if (!selq || (edge && dist < 32)) v1 = NINF; s0[e] = v0; s1[e] = v1; }
  flash_core2(S_, s0, s1, A->v[stage], xch, lane);
}
#else
#pragma unroll 1
  for (int kt = 0; kt < 2; ++kt) { const int t0 = b * 64 + 32 * kt; if (edge && t0 > q0 + qbase + 7) continue;
    bf16x8 kf[4]; { const int row = 32 * kt + r32;
#pragma unroll
      for (int d0 = 0; d0 < 4; ++d0) kf[d0] = *(const bf16x8*)&A->k[stage][row * 64 + (((2 * d0 + hi) ^ ((row >> 1) & 7)) * 8)]; }
    f32x16 s = zero16();
#pragma unroll
    for (int d0 = 0; d0 < 4; ++d0) s = MFMA32(kf[d0], qf[d0], s);
    if (far) { flash_core1_lin(S_, s, selq ? QSC : 0.f, selq ? c31 : NINF, A->v[stage] + kt * 1024, xch, lane); continue; }
#pragma unroll
    for (int e = 0; e < 16; ++e) { const int tk = t0 + (e & 3) + 8 * (e >> 2) + 4 * hi; const int dist = q - tk;
      const int dc = dist < 0 ? 0 : (dist > 2047 ? 2047 : dist); const float bsv = p.tabA[h * TABA_N + dc] * L2E;
      float vv = s[e] * QSC + bsv; if (!selq || (edge && dist < 0)) vv = NINF; s[e] = vv; }
    flash_core1(S_, s, A->v[stage] + kt * 1024, xch, lane);
  }
}
#endif
__device__ __forceinline__ void asel_store(const Params& p, FlashState& S_, float* xch, int q0, int qbase, int g, int lane) {
  const int r32 = lane & 31, hi = lane >> 5;
  const float lt = S_.l + xor32_f(S_.l); const float inv = lt > 0.f ? 1.f / lt : 0.f; xch[r32] = inv;
#pragma unroll
  for (int e = 0; e < 16; ++e) { const int j = crow(e, hi); const float a = xch[j]; const int q = q0 + qbase + (j >> 2), he = g * 4 + (j & 3);
    const float* gl = p.small + (long)q * NSMALL + he * 3; const float g0 = sigmoid_fast(gl[0]), g1 = sigmoid_fast(gl[1]), g2 = sigmoid_fast(gl[2]);
#pragma unroll
    for (int db = 0; db < 2; ++db) { const long c = (long)q * 512 + he * 64 + db * 32 + r32; const float os = (db ? S_.o1[e] : S_.o0[e]) * a;
      const float av = g0 * bf2f(p.oc[c]) + g1 * os + g2 * bf2f(p.ow[c]); SB* mp = p.mix + (long)q * NMIX + MX_A + he * 64 + db * 32 + r32; *mp = f2bf(av * bf2f(*mp)); } }
}
#ifndef ASEL16
#define ASEL16 1
#endif
typedef float f32x4_t __attribute__((ext_vector_type(4)));
#define MFMA16(a, b, c) __builtin_amdgcn_mfma_f32_16x16x32_bf16((a), (b), (c), 0, 0, 0)
struct Asel16 { f32x4_t o0, o1, o2, o3; float m, l; };
__device__ __forceinline__ float quadmax_f(float v) {
  const auto a = __builtin_amdgcn_permlane16_swap(__float_as_uint(v), __float_as_uint(v), false, false); v = fmaxf(__uint_as_float(a[0]), __uint_as_float(a[1]));
  const auto b = __builtin_amdgcn_permlane32_swap(__float_as_uint(v), __float_as_uint(v), false, false); return fmaxf(__uint_as_float(b[0]), __uint_as_float(b[1])); }
__device__ __forceinline__ float quadsum_f(float v) {
  const auto a = __builtin_amdgcn_permlane16_swap(__float_as_uint(v), __float_as_uint(v), false, false); v = __uint_as_float(a[0]) + __uint_as_float(a[1]);
  const auto b = __builtin_amdgcn_permlane32_swap(__float_as_uint(v), __float_as_uint(v), false, false); return __uint_as_float(b[0]) + __uint_as_float(b[1]); }
__device__ __forceinline__ bf16x8 pack44(const f32x4_t& a, const f32x4_t& b) {
  u32x4 r; r[0] = pk2(a[0], a[1]); r[1] = pk2(a[2], a[3]); r[2] = pk2(b[0], b[1]); r[3] = pk2(b[2], b[3]); return __builtin_bit_cast(bf16x8, r); }
template <int CT>
__device__ __forceinline__ void asel_coltile16(const Params& p, Asel16& S_, const unsigned short* qlds, AselLds* A, float* xch, int stage, int b, int cur, int q0, int qbase, float c31, int lane) {
  const int j = lane & 15, q4 = lane >> 4; const int ql = qbase + 4 * CT + (j >> 2); const int q = q0 + ql;
  const bool selq = (A->sel[ql][b >> 5] >> (b & 31)) & 1u;
  if (!__any(selq)) return;
  const bool far = (q0 - (b * 64 + 63)) >= 1513; const bool edge = (b == cur);
  const int qrow = 16 * CT + j;
  const bf16x8 qf0 = *(const bf16x8*)&qlds[qrow * 64 + (((q4) ^ ((qrow >> 1) & 7)) * 8)], qf1 = *(const bf16x8*)&qlds[qrow * 64 + (((4 + q4) ^ ((qrow >> 1) & 7)) * 8)];
  f32x4_t sc[4];
#pragma unroll
  for (int kt = 0; kt < 4; ++kt) { const int row = 16 * kt + j;
    const bf16x8 k0 = *(const bf16x8*)&A->k[stage][row * 64 + (((q4) ^ ((row >> 1) & 7)) * 8)], k1 = *(const bf16x8*)&A->k[stage][row * 64 + (((4 + q4) ^ ((row >> 1) & 7)) * 8)];
    f32x4_t z = {0.f, 0.f, 0.f, 0.f}; z = MFMA16(k0, qf0, z); sc[kt] = MFMA16(k1, qf1, z); }
  float qs, bb;
  if (far) { qs = selq ? QSC : 0.f; bb = selq ? c31 : NINF; }
  else {
    qs = 1.f; bb = 0.f;
#pragma unroll
    for (int kt = 0; kt < 4; ++kt) {
#pragma unroll
      for (int r = 0; r < 4; ++r) { const int tk = b * 64 + 16 * kt + 4 * q4 + r; const int dist = q - tk; const int dc = dist < 0 ? 0 : (dist > 1663 ? 1663 : dist);
        float v = sc[kt][r] * QSC + A->relS[A->bkt[dc] * 4 + (j & 3)]; if (!selq || (edge && dist < 0)) v = NINF; sc[kt][r] = v; } }
  }
  float mr = fmaxf(fmaxf(sc[0][0], sc[0][1]), fmaxf(sc[0][2], sc[0][3]));
#pragma unroll
  for (int kt = 1; kt < 4; ++kt) mr = fmaxf(mr, fmaxf(fmaxf(sc[kt][0], sc[kt][1]), fmaxf(sc[kt][2], sc[kt][3])));
  float mx = far ? __builtin_fmaf(mr, qs, bb) : mr;
  mx = quadmax_f(mx);
  if (__any(mx > S_.m + FTHR)) {
    const float mn = fmaxf(S_.m, mx); const float al = __builtin_amdgcn_exp2f(S_.m - mn); S_.m = mn; S_.l *= al; xch[16 * CT + j] = al;
    const f32x4_t a = *(const f32x4_t*)&xch[16 * CT + 4 * q4];
    S_.o0 *= a; S_.o1 *= a; S_.o2 *= a; S_.o3 *= a;
  }
  const float bm = bb - S_.m; float ps = 0.f;
#pragma unroll
  for (int kt = 0; kt < 4; ++kt) {
#pragma unroll
    for (int r = 0; r < 4; ++r) { const float e_ = __builtin_amdgcn_exp2f(__builtin_fmaf(sc[kt][r], qs, bm)); sc[kt][r] = e_; ps += e_; } }
  S_.l += ps;
  const bf16x8 pa0 = pack44(sc[0], sc[1]), pa1 = pack44(sc[2], sc[3]);
  const unsigned short* vb = A->v[stage] + (4 * q4 + (j >> 2)) * 32 + (j & 3) * 4;
#pragma unroll
  for (int c = 0; c < 2; ++c) {
#pragma unroll
    for (int dt = 0; dt < 4; ++dt) {
      const v4i16_t lo = __builtin_amdgcn_ds_read_tr16_b64_v4i16((LDS3 v4i16_t*)(vb + (dt >> 1) * 2048 + (dt & 1) * 16 + c * 1024));
      const v4i16_t hh = __builtin_amdgcn_ds_read_tr16_b64_v4i16((LDS3 v4i16_t*)(vb + (dt >> 1) * 2048 + (dt & 1) * 16 + c * 1024 + 512));
      const bf16x8 vf = {lo[0], lo[1], lo[2], lo[3], hh[0], hh[1], hh[2], hh[3]};
      const bf16x8 pa = c ? pa1 : pa0;
      if (dt == 0) S_.o0 = MFMA16(pa, vf, S_.o0); else if (dt == 1) S_.o1 = MFMA16(pa, vf, S_.o1); else if (dt == 2) S_.o2 = MFMA16(pa, vf, S_.o2); else S_.o3 = MFMA16(pa, vf, S_.o3);
    }
  }
}
template <int CT>
__device__ __forceinline__ void asel_store16(const Params& p, Asel16& S_, float* xch, int q0, int qbase, int g, int lane) {
  const int j = lane & 15, q4 = lane >> 4;
  const float lt = quadsum_f(S_.l); const float inv = lt > 0.f ? 1.f / lt : 0.f; xch[16 * CT + j] = inv;
  const f32x4_t a = *(const f32x4_t*)&xch[16 * CT + 4 * q4];
  const int q = q0 + qbase + 4 * CT + q4;
  SB vc[4][4], vw[4][4], vm[4][4]; float gg[4][3];
#pragma unroll
  for (int r = 0; r < 4; ++r) { const int he = g * 4 + r; const float* gl = p.small + (long)q * NSMALL + he * 3; gg[r][0] = gl[0]; gg[r][1] = gl[1]; gg[r][2] = gl[2];
#pragma unroll
    for (int dt = 0; dt < 4; ++dt) { const long c = (long)q * 512 + he * 64 + dt * 16 + j; vc[r][dt] = p.oc[c]; vw[r][dt] = p.ow[c]; vm[r][dt] = p.mix[(long)q * NMIX + MX_A + he * 64 + dt * 16 + j]; } }
#pragma unroll
  for (int r = 0; r < 4; ++r) { const int he = g * 4 + r; const float g0 = sigmoid_fast(gg[r][0]), g1 = sigmoid_fast(gg[r][1]), g2 = sigmoid_fast(gg[r][2]);
#pragma unroll
    for (int dt = 0; dt < 4; ++dt) { const float os = (dt == 0 ? S_.o0[r] : dt == 1 ? S_.o1[r] : dt == 2 ? S_.o2[r] : S_.o3[r]) * a[r];
      const float av = g0 * bf2f(vc[r][dt]) + g1 * os + g2 * bf2f(vw[r][dt]); p.mix[(long)q * NMIX + MX_A + he * 64 + dt * 16 + j] = f2bf(av * bf2f(vm[r][dt])); } }
}
template <bool STORE = true, bool NOSTEPS = false>
__device__ __forceinline__ void unit_asel_blk(const Params& p, int u, AselLds* A) {
  int tid = threadIdx.x; asm volatile("" : "+v"(tid));
  const int lane = tid & 63, w = __builtin_amdgcn_readfirstlane(tid >> 6), r32 = lane & 31, hi = lane >> 5;
  const int g = u & 1, qt = (p.S / 32 - 1) - (u >> 1), q0 = qt * 32, cur = q0 >> 6;
  const SB* kvb = p.proj + PA_KV + 2 * 128 + g * 64;
  __syncthreads();
  for (int i = tid; i < 64 * 8 + 8; i += 256) ((unsigned*)A->sel)[i] = 0u;
  for (int i = tid; i < 1664; i += 256) A->bkt[i] = (unsigned char)t5_bucket(i);
  if (tid < 128) A->relS[tid] = p.rel_bias[(tid >> 2) * 32 + g * 4 + (tid & 3)] * L2E;
#ifndef ASEL_NO_TOPK
  topk4_rows(p, [&](int r) { return (q0 + 8 * w + r) * 2 + g; }, lane); topk4_rows(p, [&](int r) { return (q0 + 8 * w + 4 + r) * 2 + g; }, lane);
  asm volatile("s_waitcnt vmcnt(0)" ::: "memory");
#endif
  __syncthreads();
#pragma unroll
  for (int i = 0; i < 2; ++i) { const int e = tid + 256 * i, ql = e >> 4, kk = e & 15; const int b = __hip_atomic_load(&p.idx[((long)(q0 + ql) * 2 + g) * 16 + kk], __ATOMIC_RELAXED, __HIP_MEMORY_SCOPE_AGENT);
    if (b >= 0) { atomicOr(&A->sel[ql][b >> 5], 1u << (b & 31)); atomicOr(&A->anyb[b >> 5], 1u << (b & 31)); } }
  __syncthreads();
  if (tid < 64) {
    const unsigned wbits = A->anyb[lane >> 3]; const unsigned nib = (wbits >> ((lane & 7) * 4)) & 15u; const int cnt = __popc(nib);
    int pre = cnt;
#pragma unroll
    for (int o = 1; o < 64; o <<= 1) { const int v = __shfl_up(pre, o); if (lane >= o) pre += v; }
    int pos = pre - cnt;
#pragma unroll
    for (int k = 0; k < 4; ++k) if ((nib >> k) & 1u) A->blist[pos++] = (unsigned char)(lane * 4 + k);
    if (lane == 63) A->nlist = pre;
  }
  __syncthreads();
  const int nlist = NOSTEPS ? 0 : A->nlist;
  const int hh = r32 & 3, h = g * 4 + hh; const float c31 = p.tabA[h * TABA_N + 2047] * L2E;
#if ASEL16
  Asel16 t0, t1;
#else
  FlashState st0;
#endif
  { bf16x8 qf0[4]; load_q(qf0, p.proj + (long)(q0 + 8 * w + (r32 >> 2)) * NPROJ + PA_Q + h * 64, hi);
#pragma unroll
    for (int d0 = 0; d0 < 4; ++d0) *(bf16x8*)&A->q[w][r32 * 64 + (((2 * d0 + hi) ^ ((r32 >> 1) & 7)) * 8)] = qf0[d0]; }
#if ASEL16
  { const f32x4_t z4 = {0.f, 0.f, 0.f, 0.f}; t0.o0 = z4; t0.o1 = z4; t0.o2 = z4; t0.o3 = z4; t0.m = -1e30f; t0.l = 0.f; t1 = t0; }
#else
  st0.o0 = zero16(); st0.o1 = zero16(); st0.m = -1e30f; st0.l = 0.f;
#endif
  float* xch = A->xch[w];
#define ASEL_DMA(bb, stg) { const int b_ = (bb); _Pragma("unroll") for (int i_ = 0; i_ < 2; ++i_) { const int pk_ = 2 * w + i_; \
      { const int row_ = pk_ * 8 + (lane >> 3), pc_ = lane & 7; glds16_asm(kvb + (long)(b_ * 64 + row_) * NPROJ + ((pc_ ^ ((row_ >> 1) & 7)) * 8), (unsigned)__builtin_amdgcn_readfirstlane((int)lds_addr(&A->k[stg][pk_ * 512]))); } \
      { const int db_ = pk_ >> 2, row_ = (pk_ & 3) * 16 + (lane >> 2), wi_ = lane & 3; glds16_asm(kvb + 128 + (long)(b_ * 64 + row_) * NPROJ + db_ * 32 + wi_ * 8, (unsigned)__builtin_amdgcn_readfirstlane((int)lds_addr(&A->v[stg][db_ * 2048 + (pk_ & 3) * 512]))); } } }
  asm volatile("s_waitcnt vmcnt(0)" ::: "memory");
  if (nlist > 0) ASEL_DMA(A->blist[0], 0);
  if (nlist > 1) ASEL_DMA(A->blist[1], 1);
  int stage = 0;
  for (int it = 0; it < nlist; ++it) {
    const int b = A->blist[it];
    if (it + 1 < nlist) asm volatile("s_waitcnt vmcnt(4) lgkmcnt(0)\n\ts_barrier" ::: "memory"); else asm volatile("s_waitcnt vmcnt(0) lgkmcnt(0)\n\ts_barrier" ::: "memory");
    if (it + 2 < nlist) { const int s2_ = (stage == 0) ? 2 : stage - 1; ASEL_DMA(A->blist[it + 2], s2_); }
#if ASEL16
    asel_coltile16<0>(p, t0, A->q[w], A, xch, stage, b, cur, q0, 8 * w, c31, lane); asel_coltile16<1>(p, t1, A->q[w], A, xch, stage, b, cur, q0, 8 * w, c31, lane);
#else
    asel_coltile(p, st0, A->q[w], A, xch, stage, b, cur, q0, 8 * w, h, c31, lane);
#endif
    stage = (stage == 2) ? 0 : stage + 1;
  }
  asm volatile("s_waitcnt vmcnt(0)" ::: "memory");
#if ASEL16
  if (STORE) { asel_store16<0>(p, t0, xch, q0, 8 * w, g, lane); asel_store16<1>(p, t1, xch, q0, 8 * w, g, lane); } else asm volatile("" :: "v"(t0.o0[0]), "v"(t1.o1[2]), "v"(t0.l), "v"(t1.l));
#else
  if (STORE) asel_store(p, st0, xch, q0, 8 * w, g, lane); else asm volatile("" :: "v"(st0.o0[0]), "v"(st0.o1[5]), "v"(st0.l));
#endif
#undef ASEL_DMA
}
struct AselW { unsigned short k[4][4096]; unsigned short v[4][4096]; unsigned sel[32][8]; unsigned anyw[4][8]; int nl[4]; int pad[4]; unsigned char wl[4][256]; float xch[4][32]; unsigned char bkt[1664]; float relS[256]; };
__device__ __forceinline__ void glds16_s(const void* sbase, unsigned voff, unsigned lds_dst) {
  unsigned keep; asm volatile("s_mov_b32 %0, m0\n\ts_mov_b32 m0, %3\n\ts_nop 0\n\tglobal_load_lds_dwordx4 %2, %1\n\ts_mov_b32 m0, %0" : "=&s"(keep) : "s"(sbase), "v"(voff), "s"(lds_dst) : "memory");
}
struct AwOff { unsigned o[8]; };
__device__ __forceinline__ void aw_dma8(const void* sbase, const AwOff& f, unsigned lds) {
  asm volatile(
    "s_mov_b32 m0, %9\n\ts_nop 0\n\tglobal_load_lds_dwordx4 %1, %0\n\t"
    "s_add_u32 m0, %9, 0x400\n\ts_nop 0\n\tglobal_load_lds_dwordx4 %2, %0\n\t"
    "s_add_u32 m0, %9, 0x800\n\ts_nop 0\n\tglobal_load_lds_dwordx4 %3, %0\n\t"
    "s_add_u32 m0, %9, 0xc00\n\ts_nop 0\n\tglobal_load_lds_dwordx4 %4, %0\n\t"
    "s_add_u32 m0, %9, 0x1000\n\ts_nop 0\n\tglobal_load_lds_dwordx4 %5, %0\n\t"
    "s_add_u32 m0, %9, 0x1400\n\ts_nop 0\n\tglobal_load_lds_dwordx4 %6, %0\n\t"
    "s_add_u32 m0, %9, 0x1800\n\ts_nop 0\n\tglobal_load_lds_dwordx4 %7, %0\n\t"
    "s_add_u32 m0, %9, 0x1c00\n\ts_nop 0\n\tglobal_load_lds_dwordx4 %8, %0"
    :: "s"(sbase), "v"(f.o[0]), "v"(f.o[1]), "v"(f.o[2]), "v"(f.o[3]), "v"(f.o[4]), "v"(f.o[5]), "v"(f.o[6]), "v"(f.o[7]), "s"(lds) : "memory", "m0", "scc");
}
template <int CT, bool far>
__device__ __forceinline__ void aw_softmax(Asel16& S_, f32x4_t (&sc)[4], const AselW* A, const float* rel, float* xch, bool selq, bool edge, int q, int b, float c31, int lane) {
  const int j = lane & 15, q4 = lane >> 4;
  float qs, bb;
  if (far) { qs = selq ? QSC : 0.f; bb = selq ? c31 : NINF; }
  else { qs = 1.f; bb = 0.f;
    int bi[4][4]; float be[4][4]; const int d0 = q - (b * 64 + 4 * q4);
#pragma unroll
    for (int kt = 0; kt < 4; ++kt) {
#pragma unroll
      for (int r = 0; r < 4; ++r) { const int dist = d0 - (16 * kt + r); const int dc = dist < 0 ? 0 : (dist > 1663 ? 1663 : dist); bi[kt][r] = A->bkt[dc]; } }
#pragma unroll
    for (int kt = 0; kt < 4; ++kt) asm volatile("" : "+v"(bi[kt][0]), "+v"(bi[kt][1]), "+v"(bi[kt][2]), "+v"(bi[kt][3]));
#pragma unroll
    for (int kt = 0; kt < 4; ++kt) {
#pragma unroll
      for (int r = 0; r < 4; ++r) be[kt][r] = rel[bi[kt][r] * 4 + (j & 3)]; }
#pragma unroll
    for (int kt = 0; kt < 4; ++kt) asm volatile("" : "+v"(be[kt][0]), "+v"(be[kt][1]), "+v"(be[kt][2]), "+v"(be[kt][3]));
#pragma unroll
    for (int kt = 0; kt < 4; ++kt) {
#pragma unroll
      for (int r = 0; r < 4; ++r) { const int dist = d0 - (16 * kt + r); float v = __builtin_fmaf(sc[kt][r], QSC, be[kt][r]); if (!selq || (edge && dist < 0)) v = NINF; sc[kt][r] = v; } }
  }
  float mr = fmaxf(fmaxf(sc[0][0], sc[0][1]), fmaxf(sc[0][2], sc[0][3]));
#pragma unroll
  for (int kt = 1; kt < 4; ++kt) mr = fmaxf(mr, fmaxf(fmaxf(sc[kt][0], sc[kt][1]), fmaxf(sc[kt][2], sc[kt][3])));
  float mx = far ? __builtin_fmaf(mr, qs, bb) : mr;
  mx = quadmax_f(mx);
  { const float mn = (mx > S_.m + FTHR) ? mx : S_.m;
    const float al = __builtin_amdgcn_exp2f(S_.m - mn); S_.m = mn; S_.l *= al; xch[16 * CT + j] = al;
    const f32x4_t a = *(const f32x4_t*)&xch[16 * CT + 4 * q4];
    S_.o0 *= a; S_.o1 *= a; S_.o2 *= a; S_.o3 *= a; }
  const float bm = bb - S_.m; float ps[4];
#pragma unroll
  for (int kt = 0; kt < 4; ++kt) {
#pragma unroll
    for (int r = 0; r < 4; ++r) { const float e_ = __builtin_amdgcn_exp2f(__builtin_fmaf(sc[kt][r], qs, bm)); sc[kt][r] = e_; ps[kt] = r ? ps[kt] + e_ : e_; } }
  S_.l += (ps[0] + ps[1]) + (ps[2] + ps[3]);
}
template <bool A0, bool A1, bool far, bool HOT>
__device__ __forceinline__ void aw_step(Asel16& t0, Asel16& t1, AselW* A, int w, const bf16x8& qa0, const bf16x8& qa1, const bf16x8& qb0, const bf16x8& qb1, bool selq0, bool selq1,
                                        int b, bool more, int nb, int q0w, int cur, float c31, const float* rel, const SB* kvb, unsigned ldsk, unsigned ldsv, const AwOff& fk, const AwOff& fv, int lane) {
  const int j = lane & 15, q4 = lane >> 4;
  const bool edge = (b == cur);
  float* xch = A->xch[w];
  asm volatile("s_waitcnt vmcnt(8)" ::: "memory");
  f32x4_t sa[4], sb[4];
  { bf16x8 k0[4], k1[4];
#pragma unroll
    for (int kt = 0; kt < 4; ++kt) { const int row = 16 * kt + j;
      k0[kt] = *(const bf16x8*)&A->k[w][row * 64 + (((q4) ^ ((row >> 1) & 7)) * 8)]; k1[kt] = *(const bf16x8*)&A->k[w][row * 64 + (((4 + q4) ^ ((row >> 1) & 7)) * 8)]; }
    asm volatile("s_waitcnt lgkmcnt(0)" ::: "memory");
    if (more && !HOT) aw_dma8(kvb + (long)nb * 64 * NPROJ, fk, ldsk);
#pragma unroll
    for (int kt = 0; kt < 4; ++kt) { const f32x4_t z = {0.f, 0.f, 0.f, 0.f};
      if (A0) { sa[kt] = MFMA16(k0[kt], qa0, z); sa[kt] = MFMA16(k1[kt], qa1, sa[kt]); }
      if (A1) { sb[kt] = MFMA16(k0[kt], qb0, z); sb[kt] = MFMA16(k1[kt], qb1, sb[kt]); } } }
  if (A0) aw_softmax<0, far>(t0, sa, A, rel, xch, selq0, edge, q0w + (j >> 2), b, c31, lane);
  if (A1) aw_softmax<1, far>(t1, sb, A, rel, xch, selq1, edge, q0w + 4 + (j >> 2), b, c31, lane);
  bf16x8 pa0, pa1, pb0, pb1;
  if (A0) { pa0 = pack44(sa[0], sa[1]); pa1 = pack44(sa[2], sa[3]); }
  if (A1) { pb0 = pack44(sb[0], sb[1]); pb1 = pack44(sb[2], sb[3]); }
  if (more) asm volatile("s_waitcnt vmcnt(8)" ::: "memory"); else asm volatile("s_waitcnt vmcnt(0)" ::: "memory");
  const unsigned short* vb0 = A->v[w] + (4 * q4 + (j >> 2)) * 32 + (j & 3) * 4 + (q4 & 1) * 16; const unsigned short* vb1 = vb0 + 16 - (q4 & 1) * 32;
#pragma unroll
  for (int c = 0; c < 2; ++c) {
#pragma unroll
    for (int dt = 0; dt < 4; ++dt) {
      const unsigned short* vb = (dt & 1) ? vb1 : vb0;
      const v4i16_t lo = __builtin_amdgcn_ds_read_tr16_b64_v4i16((LDS3 v4i16_t*)(vb + (dt >> 1) * 2048 + c * 1024));
      const v4i16_t hh = __builtin_amdgcn_ds_read_tr16_b64_v4i16((LDS3 v4i16_t*)(vb + (dt >> 1) * 2048 + c * 1024 + 512));
      const bf16x8 vf = {lo[0], lo[1], lo[2], lo[3], hh[0], hh[1], hh[2], hh[3]};
      if (A0) { const bf16x8 pa = c ? pa1 : pa0; if (dt == 0) t0.o0 = MFMA16(pa, vf, t0.o0); else if (dt == 1) t0.o1 = MFMA16(pa, vf, t0.o1); else if (dt == 2) t0.o2 = MFMA16(pa, vf, t0.o2); else t0.o3 = MFMA16(pa, vf, t0.o3); }
      if (A1) { const bf16x8 pb = c ? pb1 : pb0; if (dt == 0) t1.o0 = MFMA16(pb, vf, t1.o0); else if (dt == 1) t1.o1 = MFMA16(pb, vf, t1.o1); else if (dt == 2) t1.o2 = MFMA16(pb, vf, t1.o2); else t1.o3 = MFMA16(pb, vf, t1.o3); }
    }
  }
  asm volatile("s_waitcnt lgkmcnt(0)" ::: "memory");
  if (more && !HOT) aw_dma8(kvb + (long)nb * 64 * NPROJ, fv, ldsv);
}
__device__ __forceinline__ void asel_w_tables(const Params& p, AselW* A) {
  const int tid = threadIdx.x;
  for (int i = tid; i < 1664; i += 256) A->bkt[i] = (unsigned char)t5_bucket(i);
  A->relS[tid] = p.rel_bias[((tid & 127) >> 2) * 32 + (tid >> 7) * 4 + (tid & 3)] * L2E;
}
template <bool STORE = true, bool HOT = false, bool NLZ = false>
__device__ __forceinline__ void asel_w_wave(const Params& p, int g, int q0w, AselW* A, int w, int lane) {
  const int j = lane & 15, q4 = lane >> 4; const int cur = q0w >> 6; const float* rel = A->relS + g * 128;
  const SB* kvb = p.proj + PA_KV + 2 * 128 + g * 64;
  A->sel[8 * w + (lane >> 3)][lane & 7] = 0u;
  asm volatile("s_waitcnt lgkmcnt(0)" ::: "memory");
  topk4_rows_o(p, [&](int r) { return (q0w + r) * 2 + g; }, [&](int r, int b) { if (b >= 0) atomicOr(&A->sel[8 * w + r][b >> 5], 1u << (b & 31)); }, lane);
  topk4_rows_o(p, [&](int r) { return (q0w + 4 + r) * 2 + g; }, [&](int r, int b) { if (b >= 0) atomicOr(&A->sel[8 * w + 4 + r][b >> 5], 1u << (b & 31)); }, lane);
  asm volatile("s_waitcnt lgkmcnt(0)" ::: "memory");
  if (lane < 8) { unsigned o = 0u;
#pragma unroll
    for (int r = 0; r < 8; ++r) o |= A->sel[8 * w + r][lane];
    A->anyw[w][lane] = o; }
  asm volatile("s_waitcnt lgkmcnt(0)" ::: "memory");
  { const unsigned wbits = A->anyw[w][lane >> 3]; const unsigned nib = (wbits >> ((lane & 7) * 4)) & 15u; const int cnt = __popc(nib);
    int pre = cnt;
#pragma unroll
    for (int o = 1; o < 64; o <<= 1) { const int v = __shfl_up(pre, o); if (lane >= o) pre += v; }
    int pos = pre - cnt;
#pragma unroll
    for (int k = 0; k < 4; ++k) if ((nib >> k) & 1u) A->wl[w][pos++] = (unsigned char)(lane * 4 + k);
    if (lane == 63) A->nl[w] = pre; }
  asm volatile("s_waitcnt lgkmcnt(0)" ::: "memory");
  const int hq = g * 4 + (lane & 3); const float c31 = p.tabA[hq * TABA_N + 2047] * L2E;
  const SB* qpa = p.proj + (long)(q0w + (j >> 2)) * NPROJ + PA_Q + hq * 64 + 8 * q4; const SB* qpb = qpa + 4L * NPROJ;
  const bf16x8 qa0 = *(const GLB1 bf16x8*)qpa, qa1 = *(const GLB1 bf16x8*)(qpa + 32), qb0 = *(const GLB1 bf16x8*)qpb, qb1 = *(const GLB1 bf16x8*)(qpb + 32);
  Asel16 t0, t1;
  { const f32x4_t z4 = {0.f, 0.f, 0.f, 0.f}; t0.o0 = z4; t0.o1 = z4; t0.o2 = z4; t0.o3 = z4; t0.m = -1e30f; t0.l = 0.f; t1 = t0; }
  AwOff fk, fv;
#pragma unroll
  for (int pk = 0; pk < 8; ++pk) { fk.o[pk] = (unsigned)((pk * 8 + (lane >> 3)) * NPROJ * 2 + (((lane & 7) ^ (lane >> 4) ^ ((pk & 1) * 4)) * 16));
    fv.o[pk] = (unsigned)(256 + ((pk & 3) * 16 + (lane >> 2)) * NPROJ * 2 + (pk >> 2) * 64 + (((lane & 3) ^ (((lane >> 4) & 1) << 1)) * 16)); }
  const unsigned ldsk = (unsigned)__builtin_amdgcn_readfirstlane((int)lds_addr(&A->k[w][0])), ldsv = (unsigned)__builtin_amdgcn_readfirstlane((int)lds_addr(&A->v[w][0]));
  const int nl = NLZ ? 0 : __builtin_amdgcn_readfirstlane(A->nl[w]);
  asm volatile("s_waitcnt vmcnt(0) lgkmcnt(0)" ::: "memory");
  if (nl > 0) { const int b0 = __builtin_amdgcn_readfirstlane((int)A->wl[w][0]); aw_dma8(kvb + (long)b0 * 64 * NPROJ, fk, ldsk); aw_dma8(kvb + (long)b0 * 64 * NPROJ, fv, ldsv); }
  int b = __builtin_amdgcn_readfirstlane((int)A->wl[w][0]), nb = __builtin_amdgcn_readfirstlane((int)A->wl[w][1]);
  unsigned sw0 = A->sel[8 * w + (j >> 2)][b >> 5], sw1 = A->sel[8 * w + 4 + (j >> 2)][b >> 5];
  for (int i = 0; i < nl; ++i) {
    const bool more = i + 1 < nl;
    const unsigned nsw0 = *(volatile unsigned*)&A->sel[8 * w + (j >> 2)][nb >> 5], nsw1 = *(volatile unsigned*)&A->sel[8 * w + 4 + (j >> 2)][nb >> 5];
    const unsigned nnbv = *(volatile unsigned char*)&A->wl[w][(i + 2) & 255];
    const bool selq0 = (sw0 >> (b & 31)) & 1u, selq1 = (sw1 >> (b & 31)) & 1u;
    const bool a0 = __any(selq0), a1 = __any(selq1);
    const bool far = (q0w - (b * 64 + 63)) >= 1513;
    if (far) {
      if (a0 && a1) aw_step<true, true, true, HOT>(t0, t1, A, w, qa0, qa1, qb0, qb1, selq0, selq1, b, more, nb, q0w, cur, c31, rel, kvb, ldsk, ldsv, fk, fv, lane);
      else if (a0) aw_step<true, false, true, HOT>(t0, t1, A, w, qa0, qa1, qb0, qb1, selq0, selq1, b, more, nb, q0w, cur, c31, rel, kvb, ldsk, ldsv, fk, fv, lane);
      else aw_step<false, true, true, HOT>(t0, t1, A, w, qa0, qa1, qb0, qb1, selq0, selq1, b, more, nb, q0w, cur, c31, rel, kvb, ldsk, ldsv, fk, fv, lane);
    } else {
      if (a0 && a1) aw_step<true, true, false, HOT>(t0, t1, A, w, qa0, qa1, qb0, qb1, selq0, selq1, b, more, nb, q0w, cur, c31, rel, kvb, ldsk, ldsv, fk, fv, lane);
      else if (a0) aw_step<true, false, false, HOT>(t0, t1, A, w, qa0, qa1, qb0, qb1, selq0, selq1, b, more, nb, q0w, cur, c31, rel, kvb, ldsk, ldsv, fk, fv, lane);
      else aw_step<false, true, false, HOT>(t0, t1, A, w, qa0, qa1, qb0, qb1, selq0, selq1, b, more, nb, q0w, cur, c31, rel, kvb, ldsk, ldsv, fk, fv, lane);
    }
    b = nb; sw0 = nsw0; sw1 = nsw1; nb = __builtin_amdgcn_readfirstlane((int)nnbv);
  }
  asm volatile("s_waitcnt vmcnt(0)" ::: "memory");
  float* xch = A->xch[w];
  if (STORE) { asel_store16<0>(p, t0, xch, q0w, 0, g, lane); asel_store16<1>(p, t1, xch, q0w, 0, g, lane); } else asm volatile("" :: "v"(t0.o0[0]), "v"(t1.o1[2]), "v"(t0.l), "v"(t1.l));
}
template <bool STORE = true, bool HOT = false, bool NLZ = false>
__device__ __forceinline__ void unit_asel_w(const Params& p, int u, AselW* A) {
  int tid = threadIdx.x; asm volatile("" : "+v"(tid));
  const int lane = tid & 63, w = __builtin_amdgcn_readfirstlane(tid >> 6);
  __syncthreads(); asel_w_tables(p, A); __syncthreads();
  asel_w_wave<STORE, HOT, NLZ>(p, u & 1, ((p.S / 32 - 1) - (u >> 1)) * 32 + 8 * w, A, w, lane);
}
template <bool STORE = true>
__device__ __forceinline__ void unit_bout_blk(const Params& p, int layer, int ub, char* smem) {
  int tid = threadIdx.x; asm volatile("" : "+v"(tid));
  const int lane = tid & 63, w = __builtin_amdgcn_readfirstlane(tid >> 6), r32 = lane & 31, hi = lane >> 5;
  const int lt = ub & 3, g = (ub >> 2) & 1, c = ub >> 3, hd = g * 4 + w;
  WaveLds2* L = ((WaveLds2*)smem) + w;
  __syncthreads();
  for (int x = lane; x < 128; x += 64) { L->acs[x] = p.acs[((long)c * 128 + x) * 8 + hd]; L->dtv[x] = p.dt[((long)c * 128 + x) * 8 + hd]; }
  f32x16 acc[2] = {zero16(), zero16()}, acc2[2] = {zero16(), zero16()};
  const SB* xb = p.xconv + (long)c * 128 * 1024; const int l = 32 * lt + r32; const float al = p.acs[((long)c * 128 + l) * 8 + hd];
  const float* cbr = p.cb + ((long)c * 2 + g) * 16384 + (long)l * 128;
  for (int sc = 0; sc <= lt; ++sc) {
    stage_slab<false>(L->x, xb + (long)(32 * sc) * 1024 + hd * 64, 1024, [&](int) { return 1.f; }, lane);
#pragma unroll
    for (int s2 = 0; s2 < 2; ++s2) { float mv[8];
#pragma unroll
      for (int jj = 0; jj < 2; ++jj) { const int s0 = 32 * sc + 16 * s2 + 8 * jj + 4 * hi; const f32x4_t cv4 = *(const GLB1 f32x4_t*)(cbr + s0); const float4 cv = make_float4(cv4[0], cv4[1], cv4[2], cv4[3]); const float4 av = *(const float4*)(&L->acs[s0]); const float4 dv = *(const float4*)(&L->dtv[s0]);
        mv[4 * jj + 0] = (s0 + 0 <= l) ? cv.x * __expf(al - av.x) * dv.x : 0.f; mv[4 * jj + 1] = (s0 + 1 <= l) ? cv.y * __expf(al - av.y) * dv.y : 0.f;
        mv[4 * jj + 2] = (s0 + 2 <= l) ? cv.z * __expf(al - av.z) * dv.z : 0.f; mv[4 * jj + 3] = (s0 + 3 <= l) ? cv.w * __expf(al - av.w) * dv.w : 0.f; }
      u32x4 aw; aw[0] = pk2(mv[0], mv[1]); aw[1] = pk2(mv[2], mv[3]); aw[2] = pk2(mv[4], mv[5]); aw[3] = pk2(mv[6], mv[7]); const bf16x8 af = __builtin_bit_cast(bf16x8, aw);
#pragma unroll
      for (int pt = 0; pt < 2; ++pt) acc[pt] = MFMA32(af, slab_frag(L->x, pt, s2, lane), acc[pt]); } }
  const SB* cmr = xb + (long)l * 1024 + 768 + g * 128; const float* prv = p.states + ((long)c * 8 + hd) * 8192;
#pragma unroll 2
  for (int ks = 0; ks < 8; ++ks) { const bf16x8 af = *(const GLB1 bf16x8*)(cmr + 16 * ks + 8 * hi);
#pragma unroll
    for (int pt = 0; pt < 2; ++pt) { const float* pr = prv + (long)(32 * pt + r32) * 128 + 16 * ks + 8 * hi; const f32x4_t a0 = *(const GLB1 f32x4_t*)pr, a1 = *(const GLB1 f32x4_t*)(pr + 4);
      u32x4 bw; bw[0] = pk2(a0[0], a0[1]); bw[1] = pk2(a0[2], a0[3]); bw[2] = pk2(a1[0], a1[1]); bw[3] = pk2(a1[2], a1[3]);
      acc2[pt] = MFMA32(af, __builtin_bit_cast(bf16x8, bw), acc2[pt]); } }
  const float dsk = p.b_d[layer * 8 + hd];
  float* yl = (float*)L;
  SB xsk[16][2];
#pragma unroll
  for (int e = 0; e < 16; ++e) { const int lr = crow(e, hi);
#pragma unroll
    for (int pt = 0; pt < 2; ++pt) xsk[e][pt] = *(const GLB1 SB*)&xb[(long)(32 * lt + lr) * 1024 + hd * 64 + 32 * pt + r32]; }
#pragma unroll
  for (int e = 0; e < 16; ++e) { const int lr = crow(e, hi); const float ea = __expf(L->acs[32 * lt + lr]);
#pragma unroll
    for (int pt = 0; pt < 2; ++pt) { const int pp = 32 * pt + r32; yl[lr * 64 + pp] = acc[pt][e] + ea * acc2[pt][e] + dsk * bf2f(xsk[e][pt]); } }
  __syncthreads();
  { const int row = tid >> 3, sub = tid & 7; const long t = (long)c * 128 + 32 * lt + row; SB* mp = p.mix + t * NMIX + MX_B + g * 256 + sub * 32;
    const float* ysrc = (const float*)(((WaveLds2*)smem) + (sub >> 1)) + row * 64 + (sub & 1) * 32;
    float vv[32]; float ss = 0.f;
#pragma unroll
    for (int i = 0; i < 4; ++i) { const uint4 zz = *(const uint4*)(mp + 8 * i); const unsigned zw[4] = {zz.x, zz.y, zz.z, zz.w};
#pragma unroll
      for (int k = 0; k < 4; ++k) { const float y0 = ysrc[8 * i + 2 * k] * __uint_as_float(zw[k] << 16), y1 = ysrc[8 * i + 2 * k + 1] * __uint_as_float(zw[k] & 0xffff0000u); vv[8 * i + 2 * k] = y0; vv[8 * i + 2 * k + 1] = y1; ss += y0 * y0 + y1 * y1; } }
    ss += __shfl_xor(ss, 1); ss += __shfl_xor(ss, 2); ss += __shfl_xor(ss, 4);
    const float r = 1.f / sqrtf(ss * (1.f / 256.f) + 1e-6f); const float* wn = p.b_norm + layer * 512 + g * 256 + sub * 32;
#pragma unroll
    for (int i = 0; i < 4; ++i) { uint4 o; o.x = pk2(vv[8 * i] * r * wn[8 * i], vv[8 * i + 1] * r * wn[8 * i + 1]); o.y = pk2(vv[8 * i + 2] * r * wn[8 * i + 2], vv[8 * i + 3] * r * wn[8 * i + 3]);
      o.z = pk2(vv[8 * i + 4] * r * wn[8 * i + 4], vv[8 * i + 5] * r * wn[8 * i + 5]); o.w = pk2(vv[8 * i + 6] * r * wn[8 * i + 6], vv[8 * i + 7] * r * wn[8 * i + 7]); if (STORE) *(uint4*)(mp + 8 * i) = o; else asm volatile("" :: "v"(o.x), "v"(o.w)); } }
}

__device__ __forceinline__ void unit_memkv(const Params& p, int u, int lane) {
  const int l = u >> 8, m = u & 255; const float* row = p.mem + (long)m * DM; const float* nw = p.m_norm + l * DM; const float* w = p.m_wkv + (long)l * DM * 512 + lane * 8;
  float ss = 0.f;
#pragma unroll
  for (int i = 0; i < 4; ++i) { const float4 v = *(const float4*)(row + i * 256 + lane * 4); ss += v.x * v.x + v.y * v.y + v.z * v.z + v.w * v.w; }
  ss = wave_sum_f(ss); const float r = 1.f / sqrtf(ss * (1.f / DM) + 1e-6f);
  float acc[8] = {0.f, 0.f, 0.f, 0.f, 0.f, 0.f, 0.f, 0.f};
#pragma unroll 8
  for (int d = 0; d < DM; ++d) { const float a = row[d] * r * nw[d]; const float4 w0 = *(const float4*)(w + (long)d * 512), w1 = *(const float4*)(w + (long)d * 512 + 4);
    acc[0] += a * w0.x; acc[1] += a * w0.y; acc[2] += a * w0.z; acc[3] += a * w0.w; acc[4] += a * w1.x; acc[5] += a * w1.y; acc[6] += a * w1.z; acc[7] += a * w1.w; }
  uint4 o; o.x = pk2(acc[0], acc[1]); o.y = pk2(acc[2], acc[3]); o.z = pk2(acc[4], acc[5]); o.w = pk2(acc[6], acc[7]);
  *(uint4*)(p.memkv + (long)u * 512 + lane * 8) = o;
}

__device__ __forceinline__ void item_dmerge(const Params& p, long gid) {
  const int c8 = (int)(gid & 63), h = c8 >> 3; const long q = gid >> 6; const long S = p.S;
  const long c = q * 512 + c8 * 8; SB* mp = p.mix + q * NMIX + MX_D + c8 * 8;
  const u32x4 ga = *(const GLB1 u32x4*)(p.dop + c), gb = *(const GLB1 u32x4*)(p.dop + S * 512 + c), gd = *(const GLB1 u32x4*)(p.dop + 2 * S * 512 + c), gz = *(const GLB1 u32x4*)mp;
  const float l0 = *(const GLB1 float*)&p.dlse[(0 * S + q) * 8 + h], l1 = *(const GLB1 float*)&p.dlse[(1 * S + q) * 8 + h], l2 = *(const GLB1 float*)&p.dlse[(2 * S + q) * 8 + h];
  const float mm = fmaxf(l0, fmaxf(l1, l2)); float e0 = __expf(l0 - mm), e1 = __expf(l1 - mm), e2 = __expf(l2 - mm); const float is = __builtin_amdgcn_rcpf(e0 + e1 + e2); e0 *= is; e1 *= is; e2 *= is;
  uint4 a, b, d, z; a.x = ga[0]; a.y = ga[1]; a.z = ga[2]; a.w = ga[3]; b.x = gb[0]; b.y = gb[1]; b.z = gb[2]; b.w = gb[3]; d.x = gd[0]; d.y = gd[1]; d.z = gd[2]; d.w = gd[3]; z.x = gz[0]; z.y = gz[1]; z.z = gz[2]; z.w = gz[3];
  const unsigned aw[4] = {a.x, a.y, a.z, a.w}, bw[4] = {b.x, b.y, b.z, b.w}, dw[4] = {d.x, d.y, d.z, d.w}, zw[4] = {z.x, z.y, z.z, z.w}; unsigned ow[4];
#pragma unroll
  for (int k = 0; k < 4; ++k) {
    const float lo = (e0 * __uint_as_float(aw[k] << 16) + e1 * __uint_as_float(bw[k] << 16) + e2 * __uint_as_float(dw[k] << 16)) * __uint_as_float(zw[k] << 16);
    const float hi = (e0 * __uint_as_float(aw[k] & 0xffff0000u) + e1 * __uint_as_float(bw[k] & 0xffff0000u) + e2 * __uint_as_float(dw[k] & 0xffff0000u)) * __uint_as_float(zw[k] & 0xffff0000u);
    ow[k] = pk2(lo, hi); }
  uint4 o; o.x = ow[0]; o.y = ow[1]; o.z = ow[2]; o.w = ow[3]; *(uint4*)mp = o;
}

__device__ __forceinline__ void unit_cmp_blk(const Params& p, int layer, int u, float* red  ) {
  int tid = threadIdx.x; asm volatile("" : "+v"(tid));
  const int lane = tid & 63, w = __builtin_amdgcn_readfirstlane(tid >> 6), r32 = lane & 31, hi = lane >> 5;
  const int ncmp = p.S / 16, ntile = ncmp * 2 / 32; const int kv = u / ntile, rt = u % ntile;
  const int r = 32 * rt + r32, j = r >> 1, hk = r & 1;
  const unsigned short* w1t = p.w1t + (long)kv * 128 * 2048; const unsigned short* w2t = p.w2t + kv * 64 * 128; const float* pe = p.cmp_pos + (long)(layer * 2 + kv) * 32 * 64;
  const SB* src = p.proj + PA_KV + kv * 128 + hk * 64;
  f32x16 acc[4] = {zero16(), zero16(), zero16(), zero16()};
  typedef float f32x4g __attribute__((ext_vector_type(4)));
  f32x4g p0n, p1n; u32x4 vvn; bf16x8 afn[4]; float vmn;
#define CMPB_LOAD(ks_) { const int t_ = (ks_) >> 2, d_ = ((ks_) & 3) * 16 + 8 * hi; const long tok_ = 16 * j + t_; const long tokc_ = tok_ < p.S ? tok_ : (long)p.S - 1; vmn = tok_ < p.S ? 1.f : 0.f; \
    p0n = *(const GLB1 f32x4g*)(pe + t_ * 64 + d_); p1n = *(const GLB1 f32x4g*)(pe + t_ * 64 + d_ + 4); vvn = *(const GLB1 u32x4*)(src + tokc_ * NPROJ + d_); \
    _Pragma("unroll") for (int ut_ = 0; ut_ < 4; ++ut_) afn[ut_] = *(const GLB1 bf16x8*)(w1t + (long)(32 * ut_ + r32) * 2048 + 16 * (ks_) + 8 * hi); }
  CMPB_LOAD(32 * w)
#pragma unroll 2
  for (int ks = 32 * w; ks < 32 * w + 32; ++ks) {
    const f32x4g p0 = p0n, p1 = p1n; const u32x4 vv = vvn; const float vm = vmn; bf16x8 af[4];
#pragma unroll
    for (int ut = 0; ut < 4; ++ut) af[ut] = afn[ut];
    { const int kn = (ks + 1 < 32 * w + 32) ? ks + 1 : ks; CMPB_LOAD(kn) }
    float v[8] = {p0[0], p0[1], p0[2], p0[3], p1[0], p1[1], p1[2], p1[3]};
#pragma unroll
    for (int k = 0; k < 4; ++k) { v[2 * k] += vm * __uint_as_float(vv[k] << 16); v[2 * k + 1] += vm * __uint_as_float(vv[k] & 0xffff0000u); }
    u32x4 bw; bw[0] = pk2(v[0], v[1]); bw[1] = pk2(v[2], v[3]); bw[2] = pk2(v[4], v[5]); bw[3] = pk2(v[6], v[7]); const bf16x8 bfr = __builtin_bit_cast(bf16x8, bw);
#pragma unroll
    for (int ut = 0; ut < 4; ++ut) acc[ut] = MFMA32(af[ut], bfr, acc[ut]); }
#undef CMPB_LOAD
  __syncthreads();
#pragma unroll
  for (int ut = 0; ut < 4; ++ut)
#pragma unroll
    for (int q4 = 0; q4 < 4; ++q4) *(float4*)&red[(((w * 4 + ut) * 4 + q4) * 64 + lane) * 4] = make_float4(acc[ut][4 * q4], acc[ut][4 * q4 + 1], acc[ut][4 * q4 + 2], acc[ut][4 * q4 + 3]);
  __syncthreads();
  f32x16 hsum = zero16();
#pragma unroll
  for (int w2 = 0; w2 < 4; ++w2)
#pragma unroll
    for (int q4 = 0; q4 < 4; ++q4) { const float4 t4 = *(const float4*)&red[(((w2 * 4 + w) * 4 + q4) * 64 + lane) * 4]; hsum[4 * q4] += t4.x; hsum[4 * q4 + 1] += t4.y; hsum[4 * q4 + 2] += t4.z; hsum[4 * q4 + 3] += t4.w; }
#pragma unroll
  for (int e = 0; e < 16; ++e) hsum[e] = gelu_fast(hsum[e]);
  f32x16 o2[2] = {zero16(), zero16()};
#pragma unroll
  for (int s2 = 0; s2 < 2; ++s2) { const bf16x8 hb = pack8(hsum, 8 * s2);
#pragma unroll
    for (int dt = 0; dt < 2; ++dt) { const unsigned short* wr = w2t + (32 * dt + r32) * 128 + 32 * w + 16 * s2 + 4 * hi; const uint2 x0 = *(const uint2*)wr, x1 = *(const uint2*)(wr + 8);
      u32x4 aw; aw[0] = x0.x; aw[1] = x0.y; aw[2] = x1.x; aw[3] = x1.y; o2[dt] = MFMA32(__builtin_bit_cast(bf16x8, aw), hb, o2[dt]); } }
  __syncthreads();
#pragma unroll
  for (int dt = 0; dt < 2; ++dt)
#pragma unroll
    for (int q4 = 0; q4 < 4; ++q4) *(float4*)&red[(((w * 2 + dt) * 4 + q4) * 64 + lane) * 4] = make_float4(o2[dt][4 * q4], o2[dt][4 * q4 + 1], o2[dt][4 * q4 + 2], o2[dt][4 * q4 + 3]);
  __syncthreads();
  if (w < 2) {
    const int dt = w; SB* dst = p.kvc + ((long)kv * ncmp * 2 + r) * 64;
#pragma unroll
    for (int q4 = 0; q4 < 4; ++q4) { float4 s4 = make_float4(0.f, 0.f, 0.f, 0.f);
#pragma unroll
      for (int w2 = 0; w2 < 4; ++w2) { const float4 t4 = *(const float4*)&red[(((w2 * 2 + dt) * 4 + q4) * 64 + lane) * 4]; s4.x += t4.x; s4.y += t4.y; s4.z += t4.z; s4.w += t4.w; }
      dst[32 * dt + crow(4 * q4 + 0, hi)] = f2bf(s4.x); dst[32 * dt + crow(4 * q4 + 1, hi)] = f2bf(s4.y); dst[32 * dt + crow(4 * q4 + 2, hi)] = f2bf(s4.z); dst[32 * dt + crow(4 * q4 + 3, hi)] = f2bf(s4.w); } }
}

#define SEQ 16384
#define DEPTH 4

__device__ __forceinline__ int n2o(int n) {
  if (n < 1280) return n;
  if (n < 2304) return n - 1280 + 1816;
  if (n < 2816) return n - 2304 + 3360;
  if (n < 3072) return n - 2816 + 3872;
  if (n < 4608) return n - 3072 + 4640;
  if (n < 5632) return n - 4608 + 6176;
  if (n < 5888) return n - 5632 + 7712;
  n -= 5888;
  if (n < 512) return 1304 + n;
  if (n < 1024) return 2848 + n - 512;
  if (n < 1536) return 4128 + n - 1024;
  if (n < 2048) return 7200 + n - 1536;
  if (n < 2304) return 7968 + n - 2048;
  n -= 2304;
  if (n < 24) return 1280 + n;
  if (n < 32) return 2840 + n - 24;
  return -1;
}

template <bool MAP>
__device__ __forceinline__ void cvt_tile(const float* __restrict__ src, int lds_, unsigned short* __restrict__ dst, int ldd, int k0, int n0, float* tile  ) {
  int tid = threadIdx.x; asm volatile("" : "+v"(tid));
  __syncthreads();
  float v[16];
#pragma unroll
  for (int e = 0; e < 16; ++e) { int idx = tid + 256 * e, kk = idx >> 6, nn = idx & 63; int oc = MAP ? n2o(n0 + nn) : (n0 + nn); v[e] = src[(long)(k0 + kk) * lds_ + (oc < 0 ? 0 : oc)]; }
#pragma unroll
  for (int e = 0; e < 16; ++e) { int idx = tid + 256 * e, kk = idx >> 6, nn = idx & 63; int oc = MAP ? n2o(n0 + nn) : (n0 + nn); tile[kk * 65 + nn] = (oc >= 0) ? v[e] : 0.f; }
  __syncthreads();
#pragma unroll
  for (int e = 0; e < 16; ++e) { int idx = tid + 256 * e, nn = idx >> 6, kk = idx & 63; dst[(long)(n0 + nn) * ldd + k0 + kk] = f2bf(tile[kk * 65 + nn]); }
}

__device__ __forceinline__ float wave_sum(float v) {
#pragma unroll
  for (int o = 32; o > 0; o >>= 1) v += __shfl_xor(v, o);
  return v;
}

__device__ __forceinline__ void norm_row_wave(const Params& p, int layer, int t, bool do_h, int lane) {
  const float* xin = (layer == 0) ? p.x + (long)t * DM : p.out + (long)t * DM;
  float4 xv[4], yv[4];
#pragma unroll
  for (int i = 0; i < 4; ++i) xv[i] = *(const float4*)(xin + i * 256 + lane * 4);
  if (layer > 0) {
    float ss = 0.f;
#pragma unroll
    for (int i = 0; i < 4; ++i) { yv[i] = *(const float4*)(p.y + (long)t * DM + i * 256 + lane * 4); ss += yv[i].x * yv[i].x + yv[i].y * yv[i].y + yv[i].z * yv[i].z + yv[i].w * yv[i].w; }
    ss = wave_sum(ss); float r1 = 1.f / sqrtf(ss / DM + 1e-6f);
#pragma unroll
    for (int i = 0; i < 4; ++i) { float4 w = *(const float4*)(p.post_norm + (layer - 1) * DM + i * 256 + lane * 4);
      xv[i].x += yv[i].x * r1 * w.x; xv[i].y += yv[i].y * r1 * w.y; xv[i].z += yv[i].z * r1 * w.z; xv[i].w += yv[i].w * r1 * w.w; }
  }
  float ss2 = 0.f;
#pragma unroll
  for (int i = 0; i < 4; ++i) { *(float4*)(p.out + (long)t * DM + i * 256 + lane * 4) = xv[i]; ss2 += xv[i].x * xv[i].x + xv[i].y * xv[i].y + xv[i].z * xv[i].z + xv[i].w * xv[i].w; }
  if (!do_h) return;
  ss2 = wave_sum(ss2); float r2 = 1.f / sqrtf(ss2 / DM + 1e-6f);
#pragma unroll
  for (int i = 0; i < 4; ++i) { float4 w = *(const float4*)(p.pre_norm + layer * DM + i * 256 + lane * 4);
    ushort4 o; o.x = f2bf(xv[i].x * r2 * w.x); o.y = f2bf(xv[i].y * r2 * w.y); o.z = f2bf(xv[i].z * r2 * w.z); o.w = f2bf(xv[i].w * r2 * w.w);
    *(ushort4*)(p.h + (long)t * DM + i * 256 + lane * 4) = o; }
}

#ifndef GMI
#define GMI 4
#endif
struct GemmSmem { unsigned short a[3][64 * GMI * 32]; unsigned short b[3][128 * 32]; };
__device__ __forceinline__ void glds16(const void* g, void* lds_wave_base) { __builtin_amdgcn_global_load_lds((gptr_t)g, (lptr_t)lds_wave_base, 16, 0, 0); }
template <int EPI, int MI, bool DRY = false>
__device__ __forceinline__ void gemm_tile(const Params& p, const unsigned short* __restrict__ A, int lda, const unsigned short* __restrict__ Bt, int ldb, int K, int m0, int n0, GemmSmem& sm, float* outp = nullptr) {
  int tid = threadIdx.x; asm volatile("" : "+v"(tid));
  const int lane = tid & 63, wid = __builtin_amdgcn_readfirstlane(tid >> 6), wr = wid >> 1, wc = wid & 1, r = lane & 31, h = lane >> 5;
  f32x16 acc[MI][2];
#pragma unroll
  for (int i = 0; i < MI; ++i)
#pragma unroll
    for (int j = 0; j < 2; ++j) acc[i][j] = zero16();
  const int prow = lane >> 2, pc = lane & 3;
  const unsigned short* ga[MI]; const unsigned short* gb[2];
#pragma unroll
  for (int i = 0; i < MI; ++i) { const int row = (wid * MI + i) * 16 + prow; ga[i] = A + (long)(m0 + row) * lda + ((pc ^ ((row >> 2) & 3)) * 8); }
#pragma unroll
  for (int i = 0; i < 2; ++i) { const int row = (wid * 2 + i) * 16 + prow; gb[i] = Bt + (long)(n0 + row) * ldb + ((pc ^ ((row >> 2) & 3)) * 8); }
#define GEMM_DMA(stg, ko) { _Pragma("unroll") for (int i_ = 0; i_ < MI; ++i_) glds16(ga[i_] + (ko), &sm.a[stg][(wid * MI + i_) * 512]); _Pragma("unroll") for (int i_ = 0; i_ < 2; ++i_) glds16(gb[i_] + (ko), &sm.b[stg][(wid * 2 + i_) * 512]); }
  __syncthreads();
  const int nk = K / 32;
  GEMM_DMA(0, 0)
  if (nk > 1) GEMM_DMA(1, 32)
  int cur = 0;
  for (int kt = 0; kt < nk; ++kt) {
    if (kt + 1 < nk) { if (MI == 4) asm volatile("s_waitcnt vmcnt(6) lgkmcnt(0)\n\ts_barrier" ::: "memory"); else asm volatile("s_waitcnt vmcnt(4) lgkmcnt(0)\n\ts_barrier" ::: "memory"); }
    else asm volatile("s_waitcnt vmcnt(0) lgkmcnt(0)\n\ts_barrier" ::: "memory");
    if (kt + 2 < nk) { const int s2_ = (cur == 0) ? 2 : cur - 1; GEMM_DMA(s2_, (kt + 2) * 32) }
#pragma unroll
    for (int ks = 0; ks < 2; ++ks) {
      bf16x8 af[MI], bfr[2];
#pragma unroll
      for (int i = 0; i < MI; ++i) { const int row = wr * (32 * MI) + i * 32 + r; af[i] = *(const bf16x8*)&sm.a[cur][row * 32 + (((2 * ks + h) ^ ((row >> 2) & 3)) * 8)]; }
#pragma unroll
      for (int j = 0; j < 2; ++j) { const int row = wc * 64 + j * 32 + r; bfr[j] = *(const bf16x8*)&sm.b[cur][row * 32 + (((2 * ks + h) ^ ((row >> 2) & 3)) * 8)]; }
#pragma unroll
      for (int i = 0; i < MI; ++i)
#pragma unroll
        for (int j = 0; j < 2; ++j) acc[i][j] = __builtin_amdgcn_mfma_f32_32x32x16_bf16(af[i], bfr[j], acc[i][j], 0, 0, 0);
    }
    cur = (cur == 2) ? 0 : cur + 1;
  }
#undef GEMM_DMA
  __syncthreads();
  if (DRY) {
#pragma unroll
    for (int i = 0; i < MI; ++i) asm volatile("" :: "v"(acc[i][0]), "v"(acc[i][1]));
    return; }
  const int ncol0 = n0 + wc * 64;
  const int mrow0 = m0 + wr * (32 * MI);
  if (EPI == 2) {
#pragma unroll
    for (int i = 0; i < MI; ++i)
#pragma unroll
      for (int j = 0; j < 2; ++j)
#pragma unroll
        for (int e = 0; e < 16; ++e) { int row = mrow0 + i * 32 + (e & 3) + 8 * (e >> 2) + 4 * h; outp[row * 128 + ncol0 + j * 32 + r] = acc[i][j][e]; }
  } else if (EPI == 1) {
#pragma unroll
    for (int i = 0; i < MI; ++i)
#pragma unroll
      for (int j = 0; j < 2; ++j)
#pragma unroll
        for (int e = 0; e < 16; ++e) { int row = mrow0 + i * 32 + (e & 3) + 8 * (e >> 2) + 4 * h; p.y[(long)row * DM + ncol0 + j * 32 + r] = acc[i][j][e]; }
  } else {
    if (ncol0 < 8192) {
      const bool toproj = ncol0 < NPROJ; const bool rope = toproj && (ncol0 >= PC_Q && ncol0 < PC_KV + 128);
      unsigned short* stg = ((unsigned short*)&sm) + wid * (64 * 72);
      SB* gdst = toproj ? (p.proj + ncol0) : (p.mix + (ncol0 - NPROJ)); const long gld = toproj ? NPROJ : NMIX;
#pragma unroll
      for (int hf = 0; hf < MI / 2; ++hf) {
#pragma unroll
        for (int i2 = 0; i2 < 2; ++i2) { const int i = hf * 2 + i2;
          if (rope) {
            float cc[16], sn[16];
#pragma unroll
            for (int e = 0; e < 16; ++e) { const int row = mrow0 + hf * 64 + i2 * 32 + (e & 3) + 8 * (e >> 2) + 4 * h; cc[e] = p.rope_cs[row * 32 + r]; sn[e] = p.rope_sn[row * 32 + r]; }
#pragma unroll
            for (int e = 0; e < 16; ++e) { const float t1 = acc[i][0][e], t2 = acc[i][1][e]; acc[i][0][e] = t1 * cc[e] - t2 * sn[e]; acc[i][1][e] = t2 * cc[e] + t1 * sn[e]; } }
#pragma unroll
          for (int e = 0; e < 16; ++e) { const int rl = i2 * 32 + (e & 3) + 8 * (e >> 2) + 4 * h; float v0 = acc[i][0][e], v1 = acc[i][1][e];
            if (!toproj) { v0 = silu_fast(v0); v1 = silu_fast(v1); }
            stg[rl * 72 + r] = f2bf(v0); stg[rl * 72 + 32 + r] = f2bf(v1); } }
#pragma unroll
        for (int c8 = 0; c8 < 8; ++c8) { const int idx = lane + 64 * c8, rl = idx >> 3, ch = idx & 7; const uint4 vv = *(const uint4*)&stg[rl * 72 + ch * 8];
          *(uint4*)(gdst + (long)(mrow0 + hf * 64 + rl) * gld + ch * 8) = vv; }
      }
    } else if (ncol0 == 8192) {
#pragma unroll
      for (int i = 0; i < MI; ++i)
#pragma unroll
        for (int e = 0; e < 16; ++e) { int row = mrow0 + i * 32 + (e & 3) + 8 * (e >> 2) + 4 * h; p.small[(long)row * NSMALL + r] = acc[i][0][e]; }
    }
  }
}

__device__ __forceinline__ unsigned tx_() { unsigned t = threadIdx.x; asm volatile("" : "+v"(t)); return t; }
__device__ __forceinline__ int gw0(int) { return (int)((blockIdx.x * 256u + tx_()) >> 6); }
__device__ __forceinline__ int bid0() { int b = blockIdx.x; asm volatile("" : "+s"(b)); return b; }

#define XB_TMO      128
#define XB_XCNT(j)  (256  + 64 * (j))
#define XB_XSUB(j)  (1280 + 64 * (j))
#define XB_XGEN(j)  (2304 + 64 * (j))
#define XB_TOP      3328
#define XB_TOPGEN   3392
#define XCD_BAR_WORDS 3456
#define XB_SPIN_CAP (1u << 28)
__device__ __forceinline__ unsigned xb_ld(unsigned* p) { return __hip_atomic_load(p, __ATOMIC_RELAXED, __HIP_MEMORY_SCOPE_AGENT); }
__device__ __forceinline__ unsigned xb_add(unsigned* p, unsigned v) { return __hip_atomic_fetch_add(p, v, __ATOMIC_RELAXED, __HIP_MEMORY_SCOPE_AGENT); }
__device__ __forceinline__ unsigned xb_xcc_id() { return (unsigned)__builtin_amdgcn_s_getreg((3 << 11) | 20) & 0xFu; }
#define XB_SPIN(cond, bar) do { unsigned _sp = 0; while (cond) { __builtin_amdgcn_s_sleep(1); \
    if ((++_sp & 255u) == 0u) { if (xb_ld(&(bar)[XB_TMO])) break; if (_sp > XB_SPIN_CAP) { atomicAdd(&(bar)[XB_TMO], 1u); break; } } } } while (0)
struct XcdBarrier { unsigned* bar; unsigned x; volatile LDS3 unsigned* st; };
__device__ __forceinline__ XcdBarrier xcd_barrier_post(unsigned* bar, volatile LDS3 unsigned* st) {
  XcdBarrier b; b.bar = bar; b.x = xb_xcc_id(); b.st = st;
  if (threadIdx.x == 0) (void)xb_add(&bar[XB_XCNT(b.x)], 1u);
  return b;
}
__device__ __forceinline__ void xcd_barrier_complete(unsigned* bar, unsigned x, unsigned& nloc, unsigned& nx) {
  const unsigned G = gridDim.x; unsigned sum, cnt, mine, sp = 0u;
  for (;;) { sum = 0u; cnt = 0u; mine = 0u;
#pragma unroll
    for (unsigned j = 0; j < 16; ++j) { const unsigned c = xb_ld(&bar[XB_XCNT(j)]); sum += c; cnt += (c > 0u) ? 1u : 0u; mine = (j == x) ? c : mine; }
    if (sum == G) break;
    __builtin_amdgcn_s_sleep(1);
    if ((++sp & 255u) == 0u) { if (xb_ld(&bar[XB_TMO])) break; if (sp > XB_SPIN_CAP) { atomicAdd(&bar[XB_TMO], 1u); break; } } }
  nloc = mine > 0u ? mine : 1u; nx = cnt > 0u ? cnt : 1u;
}
__device__ __forceinline__ void xcd_barrier(const XcdBarrier& b) {
  asm volatile("s_waitcnt vmcnt(0)" ::: "memory");
  __syncthreads();
  if (threadIdx.x == 0) {
    unsigned* bar = b.bar;
    __builtin_amdgcn_s_waitcnt(0);
    unsigned nloc = b.st[0], nx = b.st[1];
    if (nloc == 0u) { xcd_barrier_complete(bar, b.x, nloc, nx); b.st[0] = nloc; b.st[1] = nx; }
    const unsigned old = xb_add(&bar[XB_XSUB(b.x)], 1u);
    const unsigned gen = old / nloc;
    if (old + 1u == (gen + 1u) * nloc) {
      __builtin_amdgcn_fence(__ATOMIC_RELEASE, "agent");
      asm volatile("s_waitcnt vmcnt(0)" ::: "memory");
      const unsigned og = xb_add(&bar[XB_TOP], 1u);
      const unsigned tg = og / nx;
      if (og + 1u == (tg + 1u) * nx) xb_add(&bar[XB_TOPGEN], 1u);
      else XB_SPIN(xb_ld(&bar[XB_TOPGEN]) == tg, bar);
      __builtin_amdgcn_fence(__ATOMIC_ACQUIRE, "agent");
      xb_add(&bar[XB_XGEN(b.x)], 1u);
      asm volatile("s_waitcnt vmcnt(0)" ::: "memory");
    } else {
      XB_SPIN(xb_ld(&bar[XB_XGEN(b.x)]) == gen, bar);
      __builtin_amdgcn_fence(__ATOMIC_ACQUIRE, "agent");
      asm volatile("s_waitcnt vmcnt(0)" ::: "memory");
    }
  }
  __syncthreads();
}

struct KArgs { const void* in[20]; float* out; char* ws; };
#ifdef SELFCHK
#define RUN_S 4096
#else
#define RUN_S SEQ
#endif
__host__ __device__ __forceinline__ size_t fill_ws(Params& p, Params& p2, char* w) {
  size_t off = 0;
#define TAKE(bytes) (w + ((off += (((size_t)(bytes)) + 255) & ~(size_t)255) - ((((size_t)(bytes)) + 255) & ~(size_t)255)))
  const size_t S = RUN_S, ncmp = S / 16, nc = S / 128;
  p.S = RUN_S;
  p.wt_in = (unsigned short*)TAKE(8320 * 1024 * 2); p.wt_out = (unsigned short*)TAKE(2 * 1024 * 2304 * 2); p.w1t = (unsigned short*)TAKE(2 * 128 * 2048 * 2); p.w2t = (unsigned short*)TAKE(2 * 64 * 128 * 2);
  p.h = (SB*)TAKE(S * 1024 * 2); p.ybuf = (float*)p.h;
  p.proj = (SB*)TAKE(S * NPROJ * 2); p.y = (float*)p.proj;
  p.small = (float*)TAKE(S * 32 * 4); p.mix = (SB*)TAKE(S * NMIX * 2);
  p.rope_cs = (float*)TAKE(S * 32 * 4); p.rope_sn = (float*)TAKE(S * 32 * 4); p.tabA = (float*)TAKE(8 * TABA_N * 4); p.tabD = (float*)TAKE(24 * TABD_N * 4);
  p.memkv = (SB*)TAKE(4 * 256 * 512 * 2); p.hid = (float*)TAKE(2 * ncmp * 256 * 4); p.kvc = (SB*)TAKE(2 * ncmp * 128 * 2);
  p.cml = (float*)TAKE(S * 16 * 4); p.idx = (int*)TAKE(S * 32 * 4); p.oc = (SB*)TAKE(S * 512 * 2); p.ow = (SB*)TAKE(S * 512 * 2);
  p.dop = (SB*)TAKE(3 * S * 512 * 2); p.dlse = (float*)TAKE(3 * S * 8 * 4); p.xconv = (SB*)TAKE(S * 1024 * 2);
  p.dt = (float*)TAKE(S * 8 * 4); p.acs = (float*)TAKE(S * 8 * 4); p.wst = (float*)TAKE(S * 8 * 4); p.cb = (float*)TAKE(nc * 2 * 128 * 128 * 4); p.states = (float*)TAKE(nc * 65536 * 4);
  p.bar = (unsigned*)TAKE(131072);
  p2 = p;
#ifdef SELFCHK
  p.imp = (float*)TAKE(S * 512 * 4);
  p2.mix = (SB*)TAKE(S * NMIX * 2); p2.ow = (SB*)TAKE(S * 512 * 2); p2.oc = (SB*)TAKE(S * 512 * 2); p2.dop = (SB*)TAKE(3 * S * 512 * 2); p2.dlse = (float*)TAKE(3 * S * 8 * 4);
  p2.cml = (float*)TAKE(S * 16 * 4); p2.imp = (float*)TAKE(S * 512 * 4); p2.idx = (int*)TAKE(S * 32 * 4); p2.cb = (float*)TAKE(nc * 2 * 128 * 128 * 4);
  p2.kvc = (SB*)TAKE(2 * ncmp * 128 * 2); p2.xconv = (SB*)TAKE(S * 1024 * 2); p2.dt = (float*)TAKE(S * 8 * 4); p2.acs = (float*)TAKE(S * 8 * 4); p2.wst = (float*)TAKE(S * 8 * 4);
  p2.states = (float*)TAKE(nc * 65536 * 4); p2.ybuf = (float*)TAKE(S * 512 * 4); p.ybuf = (float*)TAKE(S * 512 * 4);
#else
  p.imp = (float*)p.dop; p2 = p;
#endif
  return off;
}
__host__ __device__ __forceinline__ void fill_inputs(Params& p, const KArgs& a) {
  p.x = (const float*)a.in[0]; p.mem = (const float*)a.in[1]; p.pos = (const int*)a.in[2]; p.pre_norm = (const float*)a.in[3]; p.post_norm = (const float*)a.in[4];
  p.w_in = (const float*)a.in[5]; p.w_out = (const float*)a.in[6]; p.rel_bias = (const float*)a.in[7]; p.cmp_pos = (const float*)a.in[8]; p.cmp_w1 = (const float*)a.in[9];
  p.cmp_w2 = (const float*)a.in[10]; p.conv_w = (const float*)a.in[11]; p.conv_b = (const float*)a.in[12]; p.dt_bias = (const float*)a.in[13]; p.a_log = (const float*)a.in[14];
  p.b_d = (const float*)a.in[15]; p.b_norm = (const float*)a.in[16]; p.sinks = (const float*)a.in[17]; p.m_norm = (const float*)a.in[18]; p.m_wkv = (const float*)a.in[19];
  p.out = a.out;
}
#define GS(N, ...) { long g0_ = (long)blockIdx.x * 256 + tx_(); for (long gid = g0_; gid < (long)(N); gid += gsz) { __VA_ARGS__; } }
#define WU(N, ...) { for (int u_ = gw0(gwave); u_ < (int)(N); u_ += nwave) { const int u = __builtin_amdgcn_readfirstlane(u_); const unsigned tq_ = tx_(); int lane = tq_ & 63; \
    WaveLds* WL = ((WaveLds*)smem_raw) + __builtin_amdgcn_readfirstlane((int)(tq_ >> 6)); __VA_ARGS__; } }
#define GSYNC() xcd_barrier(xb)
#ifndef CMP_SKIP
#define CMP_SKIP 2
#endif
#define WUQ(slot, CH, N, ...) { unsigned* cq_ = &p.bar[4096 + (layer * 8 + (slot)) * 64 * 8 + (blockIdx.x & 7) * 64]; for (;;) { unsigned t_ = 0u; if ((tx_() & 63) == 0) t_ = atomicAdd(cq_, 1u); \
    const int c0_ = __builtin_amdgcn_readfirstlane((int)t_) * (CH); if ((c0_ * 8 + (int)(blockIdx.x & 7)) >= (int)(N)) break; \
    for (int ci_ = 0; ci_ < (CH); ++ci_) { const int u = (c0_ + ci_) * 8 + (int)(blockIdx.x & 7); if (u >= (int)(N)) break; const unsigned tq_ = tx_(); int lane = tq_ & 63; \
      WaveLds* WL = ((WaveLds*)smem_raw) + __builtin_amdgcn_readfirstlane((int)(tq_ >> 6)); (void)WL; __VA_ARGS__; } } }
#ifndef ASELW
#define ASELW 1
#endif
#if ASELW == 1
#define ASEL_UNIT(pp, uu) unit_asel_w((pp), (uu), (AselW*)smem_raw)
#else
#define ASEL_UNIT(pp, uu) unit_asel_blk((pp), (uu), (AselLds*)smem_raw)
#endif
#define SMEM_A_ (sizeof(AselLds) > sizeof(AselW) ? sizeof(AselLds) : sizeof(AselW))
#define SMEM_BYTES (SMEM_A_ > sizeof(GemmSmem) ? ((SMEM_A_ + 15) & ~(size_t)15) : sizeof(GemmSmem))
#define gtid ((long)blockIdx.x * 256 + tx_())
#define gwave ((int)((blockIdx.x * 256u + tx_()) >> 6))
#define KERNEL_PROLOGUE \
  Params p, p2; p.pad0 = 0; fill_inputs(p, ka); fill_ws(p, p2, ka.ws); \
  cg::grid_group grid = cg::this_grid(); \
  __shared__ __attribute__((aligned(16))) char smem_raw[SMEM_BYTES + 16]; \
  volatile LDS3 unsigned* xbst = (volatile LDS3 unsigned*)(smem_raw + SMEM_BYTES); \
  if (threadIdx.x < 4) xbst[threadIdx.x] = 0u; \
  __syncthreads(); \
  XcdBarrier xb = xcd_barrier_post(p.bar, xbst); \
  GemmSmem& gsm = *(GemmSmem*)smem_raw; float* ftile = (float*)smem_raw; \
  const long gsz = (long)gridDim.x * 256; const int nwave = (int)(gsz >> 6); \
  const int S = p.S, ncmp = S / 16, nc = S / 128, nqt = S / 32; (void)ncmp; (void)nc; (void)nqt; (void)ftile; (void)gsm; \
  GS((long)S * 32, ph_rope(p, gid)); \
  GS(8 * TABA_N + 24 * TABD_N, ph_tabs(p, gid)); \
  WU(DEPTH * 256, unit_memkv(p, u, lane));
#define PHASE_NORM(layer) \
    for (int t = gw0(gwave); t < S; t += nwave) { int lane = tx_() & 63; norm_row_wave(p, layer, t, true, lane); }
#define PHASE_CVT(layer) \
    { const float* wi = p.w_in + (long)(layer) * 1024 * 8224; unsigned short* wob_ = p.wt_out + (long)((layer) & 1) * 1024 * 2304; \
      for (int tl = bid0(); tl < 16 * 130; tl += gridDim.x) cvt_tile<true>(wi, 8224, p.wt_in, 1024, (tl & 15) * 64, (tl >> 4) * 64, ftile); \
      const float* wo = p.w_out + (long)(layer) * 2304 * 1024; \
      for (int tl = bid0(); tl < 36 * 16; tl += gridDim.x) cvt_tile<false>(wo, 1024, wob_, 2304, (tl % 36) * 64, (tl / 36) * 64, ftile); \
      for (int tl = bid0(); tl < 2 * 64; tl += gridDim.x) { const int kv = tl >> 6, t6 = tl & 63; cvt_tile<false>(p.cmp_w1 + (long)((layer) * 2 + kv) * 2048 * 128, 128, p.w1t + (long)kv * 128 * 2048, 2048, (t6 >> 1) * 64, (t6 & 1) * 64, ftile); } \
      for (int tl = bid0(); tl < 2 * 2; tl += gridDim.x) { const int kv = tl >> 1; cvt_tile<false>(p.cmp_w2 + (long)((layer) * 2 + kv) * 128 * 64, 64, p.w2t + (long)kv * 64 * 128, 128, (tl & 1) * 64, 0, ftile); } }
#define PHASE_P1(layer) PHASE_NORM(layer) PHASE_CVT(layer)
#define PHASE_P2() \
    {   \
      const int x_ = bid0() & 7, li_ = bid0() >> 3, nl_ = (gridDim.x + 7) >> 3, mtiles_ = S / (64 * GMI), mper_ = mtiles_ / 8; \
      if ((mper_ & 7) != 0 || (gridDim.x & 7) != 0) { for (int tl = bid0(); tl < mtiles_ * 65; tl += gridDim.x) { int mt = tl % mtiles_, nt = tl / mtiles_; gemm_tile<0, GMI>(p, p.h, DM, p.wt_in, DM, DM, mt * 64 * GMI, nt * 128, gsm); } } \
      else for (int t_ = li_; t_ < mper_ * 65; t_ += nl_) { const int half_ = t_ / 520, r_ = t_ % 520; int ml_, nt_; \
        if (r_ < 512) { ml_ = r_ & 7; nt_ = (r_ >> 6) * 8 + ((r_ & 63) >> 3); } else { ml_ = r_ - 512; nt_ = 64; } \
        gemm_tile<0, GMI>(p, p.h, DM, p.wt_in, DM, DM, (x_ * mper_ + half_ * 8 + ml_) * 64 * GMI, nt_ * 128, gsm); } }
#define PHASE_FLASH3(layer) \
    { const int nA = nqt * 8, nM = nqt * 4, nD = 3 * nqt * 8, nC = nqt * 8; \
      WU(nA + nM + nD + nC, { if (u < nA) unit_awin(p, u, WL, lane); else if (u < nA + nM) unit_m(p, layer, u - nA, WL, lane); \
                              else if (u < nA + nM + nD) unit_d(p, u - nA - nM, WL, lane); else unit_c(p, layer, u - nA - nM - nD, WL, lane); }); }
#define WU2(N, ...) { for (int u_ = gw0(gwave); u_ < (int)(N); u_ += nwave) { const int u = __builtin_amdgcn_readfirstlane(u_); const unsigned tq_ = tx_(); int lane = tq_ & 63; \
    WaveLds2* WL2 = ((WaveLds2*)smem_raw) + __builtin_amdgcn_readfirstlane((int)(tq_ >> 6)); __VA_ARGS__; } }
#define PHASE_CB() \
    for (int tl = bid0(); tl < nc * 2; tl += gridDim.x) { const SB* xb_ = p.xconv + (long)(tl >> 1) * 128 * 1024 + (tl & 1) * 128; gemm_tile<2, 2>(p, xb_ + 768, 1024, xb_ + 512, 1024, 128, 0, 0, gsm, p.cb + (long)tl * 16384); }

#ifndef SELFCHK
#define PH_BEGIN { char* wsb_ = ka.ws; asm volatile("" : "+s"(wsb_)); Params p, p2_; p.pad0 = 0; fill_inputs(p, ka); fill_ws(p, p2_, wsb_); (void)p2_;
#define PH_END }
__global__ void __launch_bounds__(256, LB2) mega(KArgs ka) {
  KERNEL_PROLOGUE
#ifdef REP_PRO
  GS((long)S * 32, ph_rope(p, gid)); GS(8 * TABA_N + 24 * TABD_N, ph_tabs(p, gid)); WU(DEPTH * 256, unit_memkv(p, u, lane));
#endif
#ifdef TSEL
  unsigned long long tlast = __builtin_amdgcn_s_memrealtime();
#define TMARK(id) { if (gtid == 0) { const unsigned long long tn = __builtin_amdgcn_s_memrealtime(); ((unsigned long long*)p.bar)[id] += tn - tlast; tlast = tn; } }
#else
#define TMARK(id)
#endif
  for (int layer = 0; layer < DEPTH; ++layer) {
    PH_BEGIN
    PHASE_P1(layer)
#ifdef REP_P1
    PHASE_P1(layer)
#endif
    PH_END
    if (layer == 0) grid.sync(); else GSYNC();
    PH_BEGIN
    TMARK(1)
    PHASE_P2()
#ifdef REP_G
    PHASE_P2()
#endif
#ifdef REP_G2
    { const int x_ = bid0() & 7, li_ = bid0() >> 3, nl_ = (gridDim.x + 7) >> 3; for (int t_ = li_; t_ < 520; t_ += nl_) { int ml_, nt_; if (t_ < 512) { ml_ = t_ & 7; nt_ = (t_ >> 6) * 8 + ((t_ & 63) >> 3); } else { ml_ = t_ - 512; nt_ = 64; }
        gemm_tile<0, GMI, true>(p, p.h, DM, p.wt_in, DM, DM, (x_ * 8 + ml_) * 64 * GMI, nt_ * 128, gsm); } }
#endif
    PH_END
    GSYNC();
    PH_BEGIN
    TMARK(2)
    { const int nCmp = 2 * (ncmp * 2 / 32), nA = nqt * 8, nM = nqt * 4, nD = 3 * nqt * 8, nC = nqt * 8, nF = nA + nM + nD + nC;
      const int cb0 = (int)gridDim.x - nCmp; const bool cmpw = ((int)blockIdx.x >= cb0) && (cb0 > 0); const int cw0 = cb0 * 4;
#define FLASH_UNIT(uu) {   \
        const int v_ = __builtin_amdgcn_readfirstlane(uu); const int gw_ = v_ % nwave, rr_ = v_ / nwave; const int x_ = (gw_ >> 2) & 7, lw_ = ((gw_ >> 5) << 2) | (gw_ & 3); int j_ = rr_ * (nwave >> 3) + lw_; \
        const unsigned tq_ = tx_(); int lane = tq_ & 63; WaveLds* WL = ((WaveLds*)smem_raw) + __builtin_amdgcn_readfirstlane((int)(tq_ >> 6)); \
        if ((nwave & 31) != 0) { const int u = v_; if (u < nA) unit_awin(p, u, WL, lane); else if (u < nA + nM) unit_m(p, layer, u - nA, WL, lane); else if (u < nA + nM + nD) unit_d(p, u - nA - nM, WL, lane); else unit_c(p, layer, u - nA - nM - nD, WL, lane); } \
        else if (j_ < nA / 8) unit_awin(p, x_ * (nA / 8) + j_, WL, lane); \
        else if ((j_ -= nA / 8) < nM / 8) unit_m(p, layer, x_ * (nM / 8) + j_, WL, lane); \
        else if ((j_ -= nM / 8) < nD / 24) unit_d(p, x_ * (nD / 24) + j_, WL, lane); \
        else if ((j_ -= nD / 24) < nD / 24) unit_d(p, nD / 3 + x_ * (nD / 24) + j_, WL, lane); \
        else if ((j_ -= nD / 24) < nD / 24) unit_d(p, 2 * (nD / 3) + x_ * (nD / 24) + j_, WL, lane); \
        else if ((j_ -= nD / 24) < nC / 8) unit_c(p, layer, x_ * (nC / 8) + j_, WL, lane); }
#ifdef REP_F3B
      WU(nA + nD, { if (u < nA) unit_awin(p, u, WL, lane); else unit_d(p, u - nA, WL, lane); });
#endif
#ifdef REP_CMPB
      for (int ub = bid0(); ub < nCmp; ub += gridDim.x) unit_cmp_blk(p, layer, ub, (float*)smem_raw); __syncthreads();
#endif
      if (cb0 <= 0) { for (int ub = bid0(); ub < nCmp; ub += gridDim.x) unit_cmp_blk(p, layer, ub, (float*)smem_raw); __syncthreads(); }
      else if (cmpw) { unit_cmp_blk(p, layer, (int)blockIdx.x - cb0, (float*)smem_raw); __syncthreads(); }
      for (int r_ = (cmpw ? CMP_SKIP : 0), u_ = gw0(gwave) + r_ * nwave; u_ < nF; u_ += nwave) FLASH_UNIT(u_)
      if (cb0 > 0) for (int e_ = gw0(gwave); e_ < CMP_SKIP * nCmp * 4; e_ += nwave) { const int u_ = (e_ / (nCmp * 4)) * nwave + cw0 + (e_ % (nCmp * 4)); if (u_ < nF) FLASH_UNIT(u_) }
#undef FLASH_UNIT
    }
    GS((long)S * 128, item_bconv(p, layer, gid));
    WU(nc * 8, unit_bdt(p, layer, u, lane));
    PH_END
    GSYNC();
    PH_BEGIN
    TMARK(3)
    WU(nqt * 8, unit_acmp1(p, u, WL, lane));
    __syncthreads();
    PHASE_CB()
    __syncthreads();
    WU2(nc * 16, unit_bstates(p, u, WL2, lane));
#ifdef REP_P4
    __syncthreads();
    WU(nqt * 8, unit_acmp1(p, u, WL, lane));
    __syncthreads();
    PHASE_CB()
    __syncthreads();
    WU2(nc * 16, unit_bstates(p, u, WL2, lane));
#endif
    GS((long)S * 64, item_dmerge(p, gid));
    PH_END
    GSYNC();
    PH_BEGIN
    TMARK(4)
#ifndef P5UP
#define P5UP 4
#endif
    {
      const int nU = nqt * 8, hw_ = nwave >> 1; const int gw_ = gw0(gwave);
      if (65536 * 2 != (int)gsz || (nU & 7)) { WU(nU, unit_acmp2(p, u, lane)); }
      else if (gw_ >= hw_) { for (int u_ = gw_ - hw_; u_ < (nU / 8) * P5UP; u_ += hw_) { const int u = __builtin_amdgcn_readfirstlane(u_); int lane = tx_() & 63; unit_acmp2(p, u, lane); } }
      else { for (int u_ = (nU / 8) * P5UP + gw_; u_ < nU; u_ += hw_) { const int u = __builtin_amdgcn_readfirstlane(u_); int lane = tx_() & 63; unit_acmp2(p, u, lane); } } }
#ifdef REP_P5A
    WU(nqt * 8, unit_acmp2(p, u, lane));
#endif
    GS(65536, scan_fast(p, gid));
    PH_END
    GSYNC();
    PH_BEGIN
    TMARK(5)
#ifdef REP_BOUT
    for (int ub = bid0(); ub < nc * 8; ub += gridDim.x) unit_bout_blk<false>(p, layer, ub, smem_raw);
#endif
    for (int ub = bid0(); ub < nc * 8; ub += gridDim.x) unit_bout_blk(p, layer, ub, smem_raw);
    TMARK(7)
#ifdef REP_ASELW
    for (;;) { __syncthreads(); if (threadIdx.x == 0) xbst[2] = atomicAdd(&p.bar[48 + layer * 8 + 7], 1u); __syncthreads(); const int ub = (int)xbst[2]; if (ub >= (S / 32) * 2) break; unit_asel_w<false, REP_ASELW == 2, REP_ASELW == 3>(p, ub, (AselW*)smem_raw); }
#endif
#ifdef REP_ASEL2
    for (;;) { __syncthreads(); if (threadIdx.x == 0) xbst[2] = atomicAdd(&p.bar[48 + layer * 8 + 7], 1u); __syncthreads(); const int ub = (int)xbst[2]; if (ub >= (S / 32) * 2) break; unit_asel_blk<false>(p, ub, (AselLds*)smem_raw); }
#endif
#ifdef REP_ASEL3
    for (;;) { __syncthreads(); if (threadIdx.x == 0) xbst[2] = atomicAdd(&p.bar[48 + layer * 8 + 7], 1u); __syncthreads(); const int ub = (int)xbst[2]; if (ub >= (S / 32) * 2) break; unit_asel_blk<false, true>(p, ub, (AselLds*)smem_raw); }
#endif
#ifndef ASEL_XQ
#define ASEL_XQ 1
#endif
#if ASEL_XQ
    {
      AselW* AW = (AselW*)smem_raw; __syncthreads(); asel_w_tables(p, AW); __syncthreads();
      const int tq_ = tx_(), ln_ = tq_ & 63, wv_ = __builtin_amdgcn_readfirstlane(tq_ >> 6); const int qc = (bid0() >> 2) & 1; bool own = true; const unsigned NWI = (unsigned)(S / 32) * 4u;
      for (;;) { unsigned n = 0xffffffffu; int c = qc;
        if (own) { if (ln_ == 0) n = atomicAdd(&p.bar[48 + layer * 8 + 4 + qc], 1u); n = (unsigned)__builtin_amdgcn_readfirstlane((int)n); if (n >= NWI) { n = 0xffffffffu; own = false; } }
        if (n == 0xffffffffu) { c = qc ^ 1; if (ln_ == 0) n = atomicAdd(&p.bar[48 + layer * 8 + 4 + c], 1u); n = (unsigned)__builtin_amdgcn_readfirstlane((int)n); if (n >= NWI) break; }
        asel_w_wave(p, c, ((S / 32 - 1) - (int)(n >> 2)) * 32 + 8 * (int)(n & 3u), AW, wv_, ln_); } }
#else
    for (;;) { __syncthreads(); if (threadIdx.x == 0) xbst[2] = atomicAdd(&p.bar[48 + layer * 8 + 6], 1u); __syncthreads(); const int ub = (int)xbst[2]; if (ub >= (S / 32) * 2) break; unit_asel_blk(p, ub, (AselLds*)smem_raw); }
#endif
    PH_END
    GSYNC();
    PH_BEGIN
    TMARK(8)
    for (int tl = bid0(); tl < (S / (64 * GMI)) * 8; tl += gridDim.x) { int mt = tl >> 3, nt = tl & 7; gemm_tile<1, GMI>(p, p.mix, NMIX, p.wt_out + (long)(layer & 1) * 1024 * 2304, NMIX, NMIX, mt * 64 * GMI, nt * 128, gsm); }
#ifdef REP_P8
    for (int tl = bid0(); tl < (S / (64 * GMI)) * 8; tl += gridDim.x) { int mt = tl >> 3, nt = tl & 7; gemm_tile<1, GMI>(p, p.mix, NMIX, p.wt_out + (long)(layer & 1) * 1024 * 2304, NMIX, NMIX, mt * 64 * GMI, nt * 128, gsm); }
#endif
    PH_END
    GSYNC();
    PH_BEGIN
    TMARK(9)
#ifdef REP_BAR
    for (int q_ = 0; q_ < 8; ++q_) GSYNC();
#endif
    PH_END
  }
  for (int t = gw0(gwave); t < S; t += nwave) { int lane = tx_() & 63; norm_row_wave(p, DEPTH, t, false, lane); }
#ifdef TSEL
  GSYNC();
  { const float us = (float)((unsigned long long*)p.bar)[TSEL] * 0.01f;
    const float kk = __expf(rintf(__logf(us + 1.f) * 20.f) * 0.05f);
    GS((long)S * 1024, p.out[gid] = kk); }
#endif
}
#else
__device__ __forceinline__ void chk_update(unsigned* slot, float diff, float ref) {
  atomicMax(&slot[0], __float_as_uint(fabsf(diff))); atomicMax(&slot[1], __float_as_uint(fabsf(ref)));
}
#define CMPB(slot, a, b_) chk_update(sl + (slot), bf2f(a) - bf2f(b_), bf2f(b_))
#define CMPF(slot, a, b_) chk_update(sl + (slot), (a) - (b_), (b_))
__global__ void __launch_bounds__(256, 1) mega(KArgs ka) {
  KERNEL_PROLOGUE
  if (gtid < 64) p.bar[gtid] = 0u;
  unsigned* sl = p.bar;
  const int layer = 0;
  PHASE_P1(layer)
  grid.sync();
  PHASE_P2()
  GSYNC();
  GS((long)S * NMIX, p2.mix[gid] = p.mix[gid]);
  GSYNC();
  PHASE_FLASH3(layer)
  __syncthreads();
  for (int ub = bid0(); ub < 2 * (ncmp * 2 / 32); ub += gridDim.x) unit_cmp_blk(p, layer, ub, (float*)smem_raw);
  __syncthreads();
  GS((long)S * 128, item_bconv(p, layer, gid));
  WU(nc * 8, unit_bdt(p, layer, u, lane));
  GS((long)2 * ncmp * 256, ph_cmp_hid(p2, layer, gid));
  GS((long)S * 8, ph_a_win(p2, gid));
  GS((long)S * 8, ph_c(p2, layer, gid));
  GS((long)3 * S * 8, ph_d(p2, gid));
  GS((long)S * 4, ph_m(p2, layer, gid));
  GS((long)S * 1024, ph_b_conv(p2, layer, gid));
  GS((long)nc * 8, ph_b_dt2(p2, layer, gid));
  GSYNC();
  GS((long)2 * ncmp * 128, ph_cmp_out(p2, layer, gid));
  GSYNC();
  GS((long)2 * ncmp * 128, CMPB(20, p.kvc[gid], p2.kvc[gid]));
  GS((long)S * 1024, CMPB(22, p.xconv[gid], p2.xconv[gid]));
  GS((long)S * 8, { CMPF(24, p.dt[gid], p2.dt[gid]); CMPF(24, p.acs[gid], p2.acs[gid]); CMPF(24, p.wst[gid], p2.wst[gid]); });
  GSYNC();
  GS((long)2 * ncmp * 128, p2.kvc[gid] = p.kvc[gid]);
  GS((long)S * 1024, p2.xconv[gid] = p.xconv[gid]);
  GS((long)S * 8, { p2.dt[gid] = p.dt[gid]; p2.acs[gid] = p.acs[gid]; p2.wst[gid] = p.wst[gid]; });
  GSYNC();
  WU(nqt * 8, unit_acmp1(p, u, WL, lane));
  __syncthreads();
  PHASE_CB()
  __syncthreads();
  WU2(nc * 16, unit_bstates(p, u, WL2, lane));
  GS((long)S * 8, ph_a_cmp1(p2, gid));
  GS((long)nc * 2 * 128 * 128, ph_b_cb(p2, gid));
  GS((long)nc * 65536, ph_b_states(p2, gid));
  GSYNC();
  WU(nqt * 8, unit_acmp2(p, u, lane));
  GS((long)S * 2, ph_a_cmp2(p2, gid));
  GS((long)nc * 65536, CMPF(26, p.states[gid], p2.states[gid]));
  GS((long)nc * 2 * 128 * 128, { int s_ = (int)(gid & 127), l_ = (int)((gid >> 7) & 127); if (s_ <= l_) CMPF(18, p.cb[gid], p2.cb[gid]); });
  GSYNC();
  GS(65536, ph_b_scan(p, gid));
  GS(65536, ph_b_scan(p2, gid));
  GS((long)S * 512, { CMPB(0, p.ow[gid], p2.ow[gid]); CMPB(2, p.oc[gid], p2.oc[gid]); long t = gid >> 9, c = gid & 511; CMPB(4, p.mix[t * NMIX + MX_C + c], p2.mix[t * NMIX + MX_C + c]);
                      if (c < 256) CMPB(6, p.mix[t * NMIX + MX_M + c], p2.mix[t * NMIX + MX_M + c]); });
  GS((long)3 * S * 512, CMPB(8, p.dop[gid], p2.dop[gid]));
  GS((long)3 * S * 8, chk_update(sl + 10, p.dlse[gid] - p2.dlse[gid], 1.f));
  GS((long)S * 2 * 256, { long qg = gid >> 8; int bb = (int)(gid & 255); int q = (int)(qg >> 1), g_ = (int)(qg & 1); if (bb <= (q >> 6)) CMPF(12, p.imp[(((long)(q >> 5) * 2 + g_) * 256 + bb) * 32 + (q & 31)], p2.imp[gid]); });
  GSYNC();
  GS((long)S * 512, { long qg = gid >> 8; int bb = (int)(gid & 255); int q = (int)(qg >> 1), g_ = (int)(qg & 1); p2.imp[gid] = p.imp[(((long)(q >> 5) * 2 + g_) * 256 + bb) * 32 + (q & 31)]; });
  GSYNC();
  WU(S * 2 / 4, unit_topk4(p, u, lane));
  WU2(nc * 32, unit_bout(p, layer, u, WL2, lane));
  GS((long)S * 2, ph_a_topk(p2, gid));
  GS((long)S * 512, ph_b_out(p2, layer, gid));
  GSYNC();
  GS((long)S * 2, { int q = (int)(gid >> 1); int nv = (q >> 6) + 1; nv = nv > 16 ? 16 : nv; int bad = 0;
    for (int k = 0; k < 16; ++k) { int mine = p.idx[gid * 16 + k]; bool found = false; for (int k2 = 0; k2 < 16; ++k2) found |= (p2.idx[gid * 16 + k2] == mine); if (k < nv) bad += !found || mine < 0; else bad += (mine >= 0); }
    chk_update(sl + 14, (float)bad, 1.f); });
  GS((long)S * 512, CMPF(28, p.ybuf[gid], p2.ybuf[gid]));
  GSYNC();
  GS((long)S * 32, p2.idx[gid] = p.idx[gid]);
  GS((long)S * 512, p2.ybuf[gid] = p.ybuf[gid]);
  GSYNC();
  for (int ub = bid0(); ub < (S / 32) * 2; ub += gridDim.x) ASEL_UNIT(p, ub);
  for (;;) { __syncthreads(); if (threadIdx.x == 0) xbst[2] = atomicAdd(&p.bar[40 + layer], 1u); __syncthreads(); const int ub = (int)xbst[2]; if (ub >= nc * 8) break; unit_bout_blk(p, layer, ub, smem_raw); }
  GS((long)S * 8, ph_a_sel(p2, gid));
  GS((long)S * 2, ph_b_norm(p2, layer, gid));
  GSYNC();
  GS((long)S * 512, { long t = gid >> 9, c = gid & 511; CMPB(16, p.mix[t * NMIX + MX_A + c], p2.mix[t * NMIX + MX_A + c]); CMPB(30, p.mix[t * NMIX + MX_B + c], p2.mix[t * NMIX + MX_B + c]); });
  GSYNC();
  { float R = 0.f;
    for (int k = 0; k < 16; ++k) { float d = __uint_as_float(p.bar[2 * k]), r = __uint_as_float(p.bar[2 * k + 1]); float q = d / (r + 1e-20f); if (CHKSEL < 0 || CHKSEL == k) R = fmaxf(R, q); }
    GS((long)SEQ * 1024, p.out[gid] = 1e4f * R); }
}
#endif

__global__ void zz_tail_pad(float* o) { asm volatile(".rept 512\n\ts_nop 0\n\t.endr" ::: "memory"); if (o) o[0] = 0.f; }
__global__ void fill_code(float* o, float v, long n) { long i = blockIdx.x * 256L + threadIdx.x; if (i < n) o[i] = v; }
extern "C" void kernel_launch(void* const* d_in, const int* in_sizes, int n_in, void* d_out, int out_size, void* d_ws, size_t ws_size, hipStream_t stream) {
  KArgs ka; memset(&ka, 0, sizeof(ka));
  for (int i = 0; i < 20; ++i) ka.in[i] = d_in[i];
  ka.out = (float*)d_out; ka.ws = (char*)d_ws;
  Params hp, hp2; memset(&hp, 0, sizeof(hp)); const size_t need = fill_ws(hp, hp2, (char*)d_ws);
  if (need > ws_size) { fprintf(stderr, "workspace too small: need %zu have %zu\n", need, ws_size); return; }
  static int grid_blocks = 0;
  if (!grid_blocks) { int dev = 0, cus = 0, per_cu = 0; (void)hipGetDevice(&dev); (void)hipDeviceGetAttribute(&cus, hipDeviceAttributeMultiprocessorCount, dev);
    (void)hipOccupancyMaxActiveBlocksPerMultiprocessor(&per_cu, mega, 256, 0); if (per_cu > LB2) per_cu = LB2; if (per_cu < 1) per_cu = 1; grid_blocks = cus * per_cu; }
  (void)hipMemsetAsync(hp.bar, 0, 131072, stream);
  void* args[] = {&ka};
  hipError_t e = hipLaunchCooperativeKernel((void*)mega, dim3(grid_blocks), dim3(256), args, 0, stream);
  if (e != hipSuccess) { (void)hipGetLastError(); fill_code<<<(unsigned)(((long)SEQ * 1024 + 255) / 256), 256, 0, stream>>>((float*)d_out, 1000.f * (float)(int)e + (float)grid_blocks, (long)SEQ * 1024); }
}
```

```cpp
#include <hip/hip_runtime.h>
#include <hip/hip_cooperative_groups.h>
#include <cstdio>
#include <cstdint>
#include <cstring>
namespace cg = cooperative_groups;
#define HD_ __device__ __forceinline__
#ifndef CHKSEL
#define CHKSEL -1
#endif
#ifndef LB2
#define LB2 2
#endif
#ifndef HD_
#define HD_ inline
#endif
#ifdef SB_IS_FLOAT
typedef float SB;
HD_ float ldf(const SB* p) { return *p; }
HD_ void stf(SB* p, float v) { *p = v; }
#else
typedef unsigned short SB;
HD_ float bf2f(unsigned short b) { unsigned u = ((unsigned)b) << 16; float f; __builtin_memcpy(&f, &u, 4); return f; }
HD_ unsigned short f2bf(float f) { unsigned u; __builtin_memcpy(&u, &f, 4); u += 0x7fffu + ((u >> 16) & 1u); return (unsigned short)(u >> 16); }
HD_ float ldf(const SB* p) { return bf2f(*p); }
HD_ void stf(SB* p, float v) { *p = f2bf(v); }
#endif

#define DM 1024
#define NPROJ 5888
#define NMIX 2304
#define NSMALL 32
#define PA_Q 0
#define PA_KV 512
#define PB_X 1280
#define PC_Q 2304
#define PC_KV 2816
#define PD_Q 3072
#define PD_KV 4608
#define PM_Q 5632
#define MX_A 0
#define MX_B 512
#define MX_C 1024
#define MX_D 1536
#define MX_M 2048
#define TABA_N 2048
#define TABD_N 132

struct Params {
  int S; int pad0;
  const float *x, *mem; const int* pos;
  const float *pre_norm, *post_norm, *w_in, *w_out, *rel_bias, *cmp_pos, *cmp_w1, *cmp_w2, *conv_w, *conv_b, *dt_bias, *a_log, *b_d,
      *b_norm, *sinks, *m_norm, *m_wkv;
  float* out;
  unsigned short* wt_in;
  unsigned short* wt_out;
  unsigned short *w1t, *w2t;
  SB* h;
  SB* proj;
  float* small;
  SB* mix;
  float* y;
  float *rope_cs, *rope_sn;
  float *tabA, *tabD;
  SB* memkv;
  float* hid;
  SB* kvc;
  float* imp;
  float* cml;
  int* idx;
  SB *oc, *ow;
  SB* dop;
  float* dlse;
  SB* xconv;
  float *dt, *acs;
  float* wst;
  float* cb;
  float* states;
  float* ybuf;
  unsigned* bar;
};

HD_ float silu_f(float x) { return x / (1.f + expf(-x)); }
HD_ float sigmoid_f(float x) { return 1.f / (1.f + expf(-x)); }
HD_ float gelu_f(float x) { return 0.5f * x * (1.f + tanhf(0.7978845608028654f * (x + 0.044715f * x * x * x))); }
HD_ float softplus_f(float x) { return fmaxf(x, 0.f) + log1pf(expf(-fabsf(x))); }

HD_ int t5_bucket(int d) {
  if (d < 16) return d < 0 ? 0 : d;
  const int thr[15] = {22, 30, 40, 54, 73, 99, 134, 182, 246, 332, 450, 609, 825, 1117, 1513};
  int b = 16;
  for (int k = 0; k < 15; ++k) b += (d >= thr[k]) ? 1 : 0;
  return b;
}

HD_ void ph_rope(const Params& p, long gid) {
  int s = (int)(gid >> 5), i = (int)(gid & 31);
  float inv = powf(150000.f, -(float)i / 32.f);
  float ang = (float)p.pos[s] * inv;
  p.rope_cs[gid] = cosf(ang); p.rope_sn[gid] = sinf(ang);
}
HD_ void ph_tabs(const Params& p, long gid) {
  if (gid < 8 * TABA_N) { int h = (int)(gid / TABA_N), d = (int)(gid % TABA_N); p.tabA[gid] = p.rel_bias[t5_bucket(d) * 32 + h]; }
  else { long g2 = gid - 8 * TABA_N; int hh = (int)(g2 / TABD_N), d = (int)(g2 % TABD_N); int gi = hh >> 3;
    int dil = gi == 0 ? 1 : (gi == 1 ? 4 : 16); p.tabD[g2] = p.rel_bias[t5_bucket(d * dil) * 32 + 8 + hh]; }
}
HD_ void ph_memkv(const Params& p, long gid) {
  int e = (int)(gid & 511), m = (int)((gid >> 9) & 255), l = (int)(gid >> 17);
  const float* row = p.mem + (long)m * DM;
  float ss = 0.f; _Pragma("unroll 16") for (int d = 0; d < DM; ++d) ss += row[d] * row[d];
  float r = 1.f / sqrtf(ss / DM + 1e-6f);
  float acc = 0.f;
  _Pragma("unroll 16") for (int d = 0; d < DM; ++d) acc += row[d] * r * p.m_norm[l * DM + d] * p.m_wkv[((long)l * DM + d) * 512 + e];
  stf(&p.memkv[gid], acc);
}
HD_ void ph_norm_row(const Params& p, int layer, int t, bool do_h) {
  const float* xin = (layer == 0) ? p.x + (long)t * DM : p.out + (long)t * DM;
  float* xo = p.out + (long)t * DM;
  float r1 = 0.f;
  if (layer > 0) { const float* y = p.y + (long)t * DM; float ss = 0.f; for (int d = 0; d < DM; ++d) ss += y[d] * y[d]; r1 = 1.f / sqrtf(ss / DM + 1e-6f); }
  float ss2 = 0.f;
  for (int d = 0; d < DM; ++d) { float v = xin[d]; if (layer > 0) v += p.y[(long)t * DM + d] * r1 * p.post_norm[(layer - 1) * DM + d]; xo[d] = v; ss2 += v * v; }
  if (!do_h) return;
  float r2 = 1.f / sqrtf(ss2 / DM + 1e-6f);
  for (int d = 0; d < DM; ++d) stf(&p.h[(long)t * DM + d], xo[d] * r2 * p.pre_norm[layer * DM + d]);
}

HD_ void ph_cmp_hid(const Params& p, int layer, long gid) {
  int u = (int)(gid & 127), hk = (int)((gid >> 7) & 1); long r = gid >> 8; int ncmp = p.S / 16; int j = (int)(r % ncmp), kv = (int)(r / ncmp);
  const float* w1 = p.cmp_w1 + ((long)(layer * 2 + kv) * 2048) * 128;
  const float* pe = p.cmp_pos + (long)(layer * 2 + kv) * 32 * 64;
  float acc = 0.f;
  for (int t = 0; t < 32; ++t) { int tok = 16 * j + t;
    _Pragma("unroll 16") for (int d = 0; d < 64; ++d) { float v = pe[t * 64 + d]; if (tok < p.S) v += ldf(&p.proj[(long)tok * NPROJ + PA_KV + kv * 128 + hk * 64 + d]);
      acc += v * w1[(long)(t * 64 + d) * 128 + u]; } }
  p.hid[gid] = gelu_f(acc);
}
HD_ void ph_cmp_out(const Params& p, int layer, long gid) {
  int d = (int)(gid & 63), hk = (int)((gid >> 6) & 1); long r = gid >> 7; int ncmp = p.S / 16; int j = (int)(r % ncmp), kv = (int)(r / ncmp);
  const float* w2 = p.cmp_w2 + (long)(layer * 2 + kv) * 128 * 64;
  const float* hd = p.hid + (((long)kv * ncmp + j) * 2 + hk) * 128;
  float acc = 0.f; for (int u = 0; u < 128; ++u) acc += hd[u] * w2[u * 64 + d];
  stf(&p.kvc[gid], acc);
}
HD_ void ph_a_cmp1(const Params& p, long gid) {
  int h = (int)(gid & 7), q = (int)(gid >> 3), g = h >> 2; int ncmp = p.S / 16;
  int jn = (q >= 31) ? ((q - 31) / 16 + 1) : 0;
  const SB* kc = p.kvc; const SB* vc = p.kvc + (long)ncmp * 128;
  float qv[64], o[64]; for (int d = 0; d < 64; ++d) { qv[d] = ldf(&p.proj[(long)q * NPROJ + PA_Q + h * 64 + d]); o[d] = 0.f; }
  float m = -1e30f, l = 0.f;
  for (int j = 0; j < jn; ++j) { const SB* kr = &kc[((long)j * 2 + g) * 64]; const SB* vr = &vc[((long)j * 2 + g) * 64];
    float s = 0.f; for (int d = 0; d < 64; ++d) s += qv[d] * ldf(&kr[d]);
    int dist = q - (16 * j + 31); s = s * 0.125f + p.tabA[h * TABA_N + (dist < TABA_N ? dist : TABA_N - 1)];
    float mn = fmaxf(m, s), a = expf(m - mn), pr = expf(s - mn); l = l * a + pr; for (int d = 0; d < 64; ++d) o[d] = o[d] * a + pr * ldf(&vr[d]); m = mn; }
  float il = jn > 0 ? 1.f / l : 0.f; for (int d = 0; d < 64; ++d) stf(&p.oc[(long)q * 512 + h * 64 + d], o[d] * il);
  p.cml[gid * 2] = m; p.cml[gid * 2 + 1] = il;
}
HD_ void ph_a_cmp2(const Params& p, long gid) {
  int g = (int)(gid & 1), q = (int)(gid >> 1); int ncmp = p.S / 16;
  float* imp = p.imp + gid * 256; for (int b = 0; b < 256; ++b) imp[b] = 0.f;
  int jn = (q >= 31) ? ((q - 31) / 16 + 1) : 0; const SB* kc = p.kvc;
  for (int hh = 0; hh < 4; ++hh) { int h = g * 4 + hh; float qv[64]; for (int d = 0; d < 64; ++d) qv[d] = ldf(&p.proj[(long)q * NPROJ + PA_Q + h * 64 + d]);
    float m = p.cml[((long)q * 8 + h) * 2], il = p.cml[((long)q * 8 + h) * 2 + 1];
    for (int j = 0; j < jn; ++j) { const SB* kr = &kc[((long)j * 2 + g) * 64]; float s = 0.f; for (int d = 0; d < 64; ++d) s += qv[d] * ldf(&kr[d]);
      int dist = q - (16 * j + 31); s = s * 0.125f + p.tabA[h * TABA_N + (dist < TABA_N ? dist : TABA_N - 1)]; float pr = expf(s - m) * il;
      imp[j >> 2] += pr; if (j + 1 < ncmp) imp[(j + 1) >> 2] += pr; } }
}
HD_ void ph_a_topk(const Params& p, long gid) {
  int q = (int)(gid >> 1); float* imp = p.imp + gid * 256; int* idx = p.idx + gid * 16; int cur = q >> 6;
  imp[0] = 1e4f; imp[cur] = 1e4f;
  for (int k = 0; k < 16; ++k) { int best = -1; float bv = -1.f;
    for (int b = 0; b <= cur; ++b) { float v = imp[b]; if (v > bv) { bv = v; best = b; } }
    idx[k] = best; if (best >= 0) imp[best] = -2.f; }
}
HD_ void ph_a_win(const Params& p, long gid) {
  int h = (int)(gid & 7), q = (int)(gid >> 3), hk = h >> 2;
  float qv[64], o[64]; for (int d = 0; d < 64; ++d) { qv[d] = ldf(&p.proj[(long)q * NPROJ + PA_Q + h * 64 + d]); o[d] = 0.f; }
  float m = -1e30f, l = 0.f; int lo = q - 511 < 0 ? 0 : q - 511;
  for (int t = lo; t <= q; ++t) { const SB* kr = &p.proj[(long)t * NPROJ + PA_KV + 4 * 128 + hk * 64]; const SB* vr = kr + 128;
    float s = 0.f; for (int d = 0; d < 64; ++d) s += qv[d] * ldf(&kr[d]); s = s * 0.125f + p.tabA[h * TABA_N + (q - t)];
    float mn = fmaxf(m, s), a = expf(m - mn), pr = expf(s - mn); l = l * a + pr; for (int d = 0; d < 64; ++d) o[d] = o[d] * a + pr * ldf(&vr[d]); m = mn; }
  float il = 1.f / l; for (int d = 0; d < 64; ++d) stf(&p.ow[(long)q * 512 + h * 64 + d], o[d] * il);
}
HD_ void ph_a_sel(const Params& p, long gid) {
  int h = (int)(gid & 7), q = (int)(gid >> 3), hk = h >> 2; const int* idx = p.idx + ((long)q * 2 + hk) * 16;
  float qv[64], o[64]; for (int d = 0; d < 64; ++d) { qv[d] = ldf(&p.proj[(long)q * NPROJ + PA_Q + h * 64 + d]); o[d] = 0.f; }
  float m = -1e30f, l = 0.f;
  for (int k = 0; k < 16; ++k) { int b = idx[k]; if (b < 0) continue;
    for (int i = 0; i < 64; ++i) { int t = b * 64 + i; if (t > q) break;
      const SB* kr = &p.proj[(long)t * NPROJ + PA_KV + 2 * 128 + hk * 64]; const SB* vr = kr + 128;
      float s = 0.f; for (int d = 0; d < 64; ++d) s += qv[d] * ldf(&kr[d]); int dist = q - t; s = s * 0.125f + p.tabA[h * TABA_N + (dist < TABA_N ? dist : TABA_N - 1)];
      float mn = fmaxf(m, s), a = expf(m - mn), pr = expf(s - mn); l = l * a + pr; for (int d = 0; d < 64; ++d) o[d] = o[d] * a + pr * ldf(&vr[d]); m = mn; } }
  float il = 1.f / l; const float* gl = p.small + (long)q * NSMALL + h * 3;
  float g0 = sigmoid_f(gl[0]), g1 = sigmoid_f(gl[1]), g2 = sigmoid_f(gl[2]);
  for (int d = 0; d < 64; ++d) { long c = (long)q * 512 + h * 64 + d; float a = g0 * ldf(&p.oc[c]) + g1 * o[d] * il + g2 * ldf(&p.ow[c]);
    SB* mp = &p.mix[(long)q * NMIX + MX_A + h * 64 + d]; stf(mp, a * ldf(mp)); }
}
HD_ void ph_c(const Params& p, int layer, long gid) {
  int h = (int)(gid & 7), q = (int)(gid >> 3), hk = h >> 2;
  float qv[64], o[64]; for (int d = 0; d < 64; ++d) { qv[d] = ldf(&p.proj[(long)q * NPROJ + PC_Q + h * 64 + d]); o[d] = 0.f; }
  float m = p.sinks[layer * 8 + h], l = 1.f; int lo = q - 127 < 0 ? 0 : q - 127;
  for (int t = lo; t <= q; ++t) { const SB* kr = &p.proj[(long)t * NPROJ + PC_KV + hk * 64]; const SB* vr = kr + 128;
    float s = 0.f; for (int d = 0; d < 64; ++d) s += qv[d] * ldf(&kr[d]); s *= 0.125f;
    float mn = fmaxf(m, s), a = expf(m - mn), pr = expf(s - mn); l = l * a + pr; for (int d = 0; d < 64; ++d) o[d] = o[d] * a + pr * ldf(&vr[d]); m = mn; }
  float il = 1.f / l; for (int d = 0; d < 64; ++d) { SB* mp = &p.mix[(long)q * NMIX + MX_C + h * 64 + d]; stf(mp, o[d] * il * ldf(mp)); }
}
HD_ void ph_d(const Params& p, long gid) {
  int h = (int)(gid & 7); long r = gid >> 3; int q = (int)(r % p.S), gi = (int)(r / p.S); int dil = gi == 0 ? 1 : (gi == 1 ? 4 : 16);
  float qv[64], o[64]; for (int d = 0; d < 64; ++d) { qv[d] = ldf(&p.proj[(long)q * NPROJ + PD_Q + gi * 512 + h * 64 + d]); o[d] = 0.f; }
  float m = -1e30f, l = 0.f;
  for (int dd = 0; dd <= 128; ++dd) { int t = q - dil * dd; if (t < 0) break;
    const SB* kr = &p.proj[(long)t * NPROJ + PD_KV + h * 64]; const SB* vr = kr + 512;
    float s = 0.f; for (int d = 0; d < 64; ++d) s += qv[d] * ldf(&kr[d]); s = s * 0.125f + p.tabD[(gi * 8 + h) * TABD_N + dd];
    float mn = fmaxf(m, s), a = expf(m - mn), pr = expf(s - mn); l = l * a + pr; for (int d = 0; d < 64; ++d) o[d] = o[d] * a + pr * ldf(&vr[d]); m = mn; }
  float il = 1.f / l; for (int d = 0; d < 64; ++d) stf(&p.dop[((long)gi * p.S + q) * 512 + h * 64 + d], o[d] * il);
  p.dlse[((long)gi * p.S + q) * 8 + h] = m + logf(l);
}
HD_ void ph_d_merge(const Params& p, long gid) {
  int h = (int)(gid & 7), q = (int)(gid >> 3);
  float l0 = p.dlse[((long)0 * p.S + q) * 8 + h], l1 = p.dlse[((long)1 * p.S + q) * 8 + h], l2 = p.dlse[((long)2 * p.S + q) * 8 + h];
  float mm = fmaxf(l0, fmaxf(l1, l2)); float e0 = expf(l0 - mm), e1 = expf(l1 - mm), e2 = expf(l2 - mm), is = 1.f / (e0 + e1 + e2);
  for (int d = 0; d < 64; ++d) { long c = (long)q * 512 + h * 64 + d;
    float v = (e0 * ldf(&p.dop[c]) + e1 * ldf(&p.dop[(long)p.S * 512 + c]) + e2 * ldf(&p.dop[(long)2 * p.S * 512 + c])) * is;
    SB* mp = &p.mix[(long)q * NMIX + MX_D + h * 64 + d]; stf(mp, v * ldf(mp)); }
}
HD_ void ph_m(const Params& p, int layer, long gid) {
  int h = (int)(gid & 3), q = (int)(gid >> 2);
  float qv[64], o[64]; for (int d = 0; d < 64; ++d) { qv[d] = ldf(&p.proj[(long)q * NPROJ + PM_Q + h * 64 + d]); o[d] = 0.f; }
  float m = -1e30f, l = 0.f; const SB* kvb = p.memkv + (long)layer * 256 * 512;
  for (int t = 0; t < 256; ++t) { const SB* kr = kvb + (long)t * 512 + h * 64; const SB* vr = kr + 256;
    float s = 0.f; for (int d = 0; d < 64; ++d) s += qv[d] * ldf(&kr[d]); s *= 0.125f;
    float mn = fmaxf(m, s), a = expf(m - mn), pr = expf(s - mn); l = l * a + pr; for (int d = 0; d < 64; ++d) o[d] = o[d] * a + pr * ldf(&vr[d]); m = mn; }
  float il = 1.f / l; for (int d = 0; d < 64; ++d) { SB* mp = &p.mix[(long)q * NMIX + MX_M + h * 64 + d]; stf(mp, o[d] * il * ldf(mp)); }
}
HD_ void ph_b_conv(const Params& p, int layer, long gid) {
  int c = (int)(gid & 1023), t = (int)(gid >> 10); const float* w = p.conv_w + (long)layer * 4 * 1024;
  float acc = p.conv_b[layer * 1024 + c];
  for (int i = 0; i < 4; ++i) { int tt = t - 3 + i; if (tt >= 0) acc += w[i * 1024 + c] * ldf(&p.proj[(long)tt * NPROJ + PB_X + c]); }
  stf(&p.xconv[gid], silu_f(acc));
}
HD_ void ph_b_dt(const Params& p, int layer, long gid) {
  int hd = (int)(gid & 7), c = (int)(gid >> 3); float a = -expf(p.a_log[layer * 8 + hd]); float cs = 0.f;
  for (int l = 0; l < 128; ++l) { int t = c * 128 + l; float dt = softplus_f(p.small[(long)t * NSMALL + 24 + hd] + p.dt_bias[layer * 8 + hd]);
    cs += dt * a; p.dt[(long)t * 8 + hd] = dt; p.acs[(long)t * 8 + hd] = cs; }
}
HD_ void ph_b_cb(const Params& p, long gid) {
  int s = (int)(gid & 127), l = (int)((gid >> 7) & 127), g = (int)((gid >> 14) & 1), c = (int)(gid >> 15);
  if (s > l) { p.cb[gid] = 0.f; return; }
  const SB* cm = &p.xconv[(long)(c * 128 + l) * 1024 + 768 + g * 128]; const SB* bm = &p.xconv[(long)(c * 128 + s) * 1024 + 512 + g * 128];
  float acc = 0.f; for (int n = 0; n < 128; ++n) acc += ldf(&cm[n]) * ldf(&bm[n]);
  p.cb[gid] = acc;
}
HD_ void ph_b_states(const Params& p, long gid) {
  int n = (int)(gid & 127), pp = (int)((gid >> 7) & 63), hd = (int)((gid >> 13) & 7), c = (int)(gid >> 16), g = hd >> 2;
  float last = p.acs[(long)(c * 128 + 127) * 8 + hd]; float acc = 0.f;
  for (int l = 0; l < 128; ++l) { long t = c * 128 + l;
    acc += ldf(&p.xconv[t * 1024 + 512 + g * 128 + n]) * expf(last - p.acs[t * 8 + hd]) * ldf(&p.xconv[t * 1024 + hd * 64 + pp]) * p.dt[t * 8 + hd]; }
  p.states[gid] = acc;
}
HD_ void ph_b_scan(const Params& p, long gid) {
  int hd = (int)(gid >> 13); int nc = p.S / 128; float h = 0.f;
  for (int c0 = 0; c0 < nc; c0 += 8) { float st[8], dc[8];
    for (int i = 0; i < 8; ++i) { st[i] = p.states[(long)(c0 + i) * 65536 + gid]; dc[i] = p.acs[(long)((c0 + i) * 128 + 127) * 8 + hd]; }
    for (int i = 0; i < 8; ++i) { p.states[(long)(c0 + i) * 65536 + gid] = h; h = h * expf(dc[i]) + st[i]; } }
}
HD_ void ph_b_out(const Params& p, int layer, long gid) {
  int pp = (int)(gid & 63), hd = (int)((gid >> 6) & 7), t = (int)(gid >> 9), g = hd >> 2, c = t >> 7, l = t & 127;
  float al = p.acs[(long)t * 8 + hd]; float acc = 0.f;
  const float* cbr = &p.cb[(((long)c * 2 + g) * 128 + l) * 128];
  for (int s = 0; s <= l; ++s) { long ts = c * 128 + s; acc += cbr[s] * expf(al - p.acs[ts * 8 + hd]) * ldf(&p.xconv[ts * 1024 + hd * 64 + pp]) * p.dt[ts * 8 + hd]; }
  float acc2 = 0.f; const float* pr = &p.states[(long)c * 65536 + ((long)hd * 64 + pp) * 128]; const SB* cm = &p.xconv[(long)t * 1024 + 768 + g * 128];
  for (int n = 0; n < 128; ++n) acc2 += ldf(&cm[n]) * pr[n];
  p.ybuf[gid] = acc + expf(al) * acc2 + ldf(&p.xconv[(long)t * 1024 + hd * 64 + pp]) * p.b_d[layer * 8 + hd];
}
HD_ void ph_b_norm(const Params& p, int layer, long gid) {
  int g = (int)(gid & 1), t = (int)(gid >> 1); float ss = 0.f;
  for (int i = 0; i < 256; ++i) { float v = p.ybuf[(long)t * 512 + g * 256 + i] * ldf(&p.mix[(long)t * NMIX + MX_B + g * 256 + i]); ss += v * v; }
  float r = 1.f / sqrtf(ss / 256.f + 1e-6f);
  for (int i = 0; i < 256; ++i) { SB* mp = &p.mix[(long)t * NMIX + MX_B + g * 256 + i]; float v = p.ybuf[(long)t * 512 + g * 256 + i] * ldf(mp);
    stf(mp, v * r * p.b_norm[layer * 512 + g * 256 + i]); }
}

HD_ void ph_b_dt2(const Params& p, int layer, long gid) {
  int hd = (int)(gid & 7), c = (int)(gid >> 3); float a = -expf(p.a_log[layer * 8 + hd]); float cs = 0.f;
  for (int l = 0; l < 128; ++l) { int t = c * 128 + l; float dt = softplus_f(p.small[(long)t * NSMALL + 24 + hd] + p.dt_bias[layer * 8 + hd]);
    cs += dt * a; p.dt[(long)t * 8 + hd] = dt; p.acs[(long)t * 8 + hd] = cs; }
  for (int l = 0; l < 128; ++l) { long t = c * 128 + l; p.wst[t * 8 + hd] = p.dt[t * 8 + hd] * expf(cs - p.acs[t * 8 + hd]); }
}
HD_ void ph_b_states2(const Params& p, long gid) {
  int pp = (int)(gid & 63), n = (int)((gid >> 6) & 127), hd = (int)((gid >> 13) & 7), c = (int)(gid >> 16), g = hd >> 2;
  float acc = 0.f;
  _Pragma("unroll 16") for (int l = 0; l < 128; ++l) { long t = c * 128 + l; acc += ldf(&p.xconv[t * 1024 + 512 + g * 128 + n]) * p.wst[t * 8 + hd] * ldf(&p.xconv[t * 1024 + hd * 64 + pp]); }
  p.states[gid] = acc;
}
HD_ void ph_b_out2(const Params& p, int layer, long gid) {
  int pp = (int)(gid & 63), hd = (int)((gid >> 6) & 7), t = (int)(gid >> 9), g = hd >> 2, c = t >> 7, l = t & 127;
  float al = p.acs[(long)t * 8 + hd]; float acc = 0.f;
  const float* cbr = &p.cb[(((long)c * 2 + g) * 128 + l) * 128];
  _Pragma("unroll 8") for (int s = 0; s <= l; ++s) { long ts = c * 128 + s; acc += cbr[s] * expf(al - p.acs[ts * 8 + hd]) * p.dt[ts * 8 + hd] * ldf(&p.xconv[ts * 1024 + hd * 64 + pp]); }
  float acc2 = 0.f; const float* pr = &p.states[(long)c * 65536 + (long)hd * 8192 + pp]; const SB* cm = &p.xconv[(long)t * 1024 + 768 + g * 128];
  _Pragma("unroll 16") for (int n = 0; n < 128; ++n) acc2 += ldf(&cm[n]) * pr[n * 64];
  p.ybuf[gid] = acc + expf(al) * acc2 + ldf(&p.xconv[(long)t * 1024 + hd * 64 + pp]) * p.b_d[layer * 8 + hd];
}

typedef __attribute__((ext_vector_type(8))) short bf16x8;
typedef __attribute__((ext_vector_type(16))) float f32x16;
typedef short v4i16_t __attribute__((ext_vector_type(4)));
typedef __bf16 bf2_t __attribute__((ext_vector_type(2)));
typedef float f2_t __attribute__((ext_vector_type(2)));
typedef unsigned u32x4 __attribute__((ext_vector_type(4)));
#define LDS3 __attribute__((address_space(3)))
#define GLB1 __attribute__((address_space(1)))
typedef __attribute__((address_space(1))) const void* gptr_t;
typedef __attribute__((address_space(3))) void* lptr_t;
#define L2E 1.4426950408889634f
#define LN2 0.6931471805599453f
#define QSC (0.125f * L2E)
#ifndef FTHR
#define FTHR 8.0f
#endif
#define NINF (-__builtin_huge_valf())
__device__ __forceinline__ float sigmoid_fast(float x) { return __builtin_amdgcn_rcpf(1.f + __builtin_amdgcn_exp2f(-x * L2E)); }
__device__ __forceinline__ float silu_fast(float x) { return x * sigmoid_fast(x); }
__device__ __forceinline__ float gelu_fast(float x) { const float u = 0.7978845608028654f * (x + 0.044715f * x * x * x); const float th = 1.f - 2.f * __builtin_amdgcn_rcpf(1.f + __builtin_amdgcn_exp2f(2.f * L2E * u)); return 0.5f * x * (1.f + th); }

struct WaveLds { unsigned short v[4096]; float tab[640]; float xch[32]; float pad[32]; };

__device__ __forceinline__ unsigned pk2(float a, float b) { f2_t v = {a, b}; bf2_t r = __builtin_convertvector(v, bf2_t); return __builtin_bit_cast(unsigned, r); }
__device__ __forceinline__ int crow(int e, int hi) { return (e & 3) + 8 * (e >> 2) + 4 * hi; }
__device__ __forceinline__ bf16x8 pack8(const f32x16& s, int o) {
  u32x4 r; r[0] = pk2(s[o], s[o + 1]); r[1] = pk2(s[o + 2], s[o + 3]); r[2] = pk2(s[o + 4], s[o + 5]); r[3] = pk2(s[o + 6], s[o + 7]); return __builtin_bit_cast(bf16x8, r); }
__device__ __forceinline__ f32x16 zero16() { f32x16 z;
#pragma unroll
  for (int e = 0; e < 16; ++e) z[e] = 0.f; return z; }
#define MFMA32(a, b, c) __builtin_amdgcn_mfma_f32_32x32x16_bf16((a), (b), (c), 0, 0, 0)

__device__ __forceinline__ float xor32_f(float v) { const auto rr = __builtin_amdgcn_permlane32_swap(__float_as_uint(v), __float_as_uint(v), false, false); const int hi_ = (int)(threadIdx.x & 32u); return __uint_as_float(hi_ ? rr[0] : rr[1]); }
struct FlashState { f32x16 o0, o1; float m, l; };
__device__ __forceinline__ float wave_sum_f(float v) {
#pragma unroll
  for (int o = 32; o > 0; o >>= 1) v += __shfl_xor(v, o);
  return v; }

__device__ __forceinline__ void flash_core1(FlashState& st, f32x16& s, const unsigned short* vimg, float* xch, int lane) {
  const int r32 = lane & 31, hi = lane >> 5;
  float mx = s[0];
#pragma unroll
  for (int e = 1; e < 16; ++e) mx = fmaxf(mx, s[e]);
  mx = fmaxf(mx, xor32_f(mx));
  if (__any(mx > st.m + FTHR)) {
    const float mn = fmaxf(st.m, mx); const float al = __builtin_amdgcn_exp2f(st.m - mn); st.m = mn; st.l *= al; xch[r32] = al;
#pragma unroll
    for (int e = 0; e < 16; ++e) { const float a = xch[crow(e, hi)]; st.o0[e] *= a; st.o1[e] *= a; }
  }
  float ps = 0.f;
#pragma unroll
  for (int e = 0; e < 16; ++e) { s[e] = __builtin_amdgcn_exp2f(s[e] - st.m); ps += s[e]; }
  st.l += ps;
  const bf16x8 pa0 = pack8(s, 0), pa1 = pack8(s, 8);
  const unsigned short* vb = vimg + (4 * hi + ((lane & 15) >> 2)) * 32 + ((lane >> 4) & 1) * 16 + (lane & 3) * 4;
#pragma unroll
  for (int s2 = 0; s2 < 2; ++s2) {
#pragma unroll
    for (int db = 0; db < 2; ++db) {
      const v4i16_t lo = __builtin_amdgcn_ds_read_tr16_b64_v4i16((LDS3 v4i16_t*)(vb + db * 2048 + s2 * 512));
      const v4i16_t hh = __builtin_amdgcn_ds_read_tr16_b64_v4i16((LDS3 v4i16_t*)(vb + db * 2048 + s2 * 512 + 256));
      const bf16x8 vf = {lo[0], lo[1], lo[2], lo[3], hh[0], hh[1], hh[2], hh[3]};
      if (db == 0) st.o0 = MFMA32(s2 ? pa1 : pa0, vf, st.o0); else st.o1 = MFMA32(s2 ? pa1 : pa0, vf, st.o1);
    }
  }
}
__device__ __forceinline__ void flash_core1_lin(FlashState& st, f32x16& s, float qs, float bb, const unsigned short* vimg, float* xch, int lane) {
  const int r32 = lane & 31, hi = lane >> 5;
  float mr = s[0];
#pragma unroll
  for (int e = 1; e < 16; ++e) mr = fmaxf(mr, s[e]);
  float mx = __builtin_fmaf(mr, qs, bb);
  mx = fmaxf(mx, xor32_f(mx));
  if (__any(mx > st.m + FTHR)) {
    const float mn = fmaxf(st.m, mx); const float al = __builtin_amdgcn_exp2f(st.m - mn); st.m = mn; st.l *= al; xch[r32] = al;
#pragma unroll
    for (int e = 0; e < 16; ++e) { const float a = xch[crow(e, hi)]; st.o0[e] *= a; st.o1[e] *= a; }
  }
  const float bm = bb - st.m; float ps = 0.f;
#pragma unroll
  for (int e = 0; e < 16; ++e) { s[e] = __builtin_amdgcn_exp2f(__builtin_fmaf(s[e], qs, bm)); ps += s[e]; }
  st.l += ps;
  const bf16x8 pa0 = pack8(s, 0), pa1 = pack8(s, 8);
  const unsigned short* vb = vimg + (4 * hi + ((lane & 15) >> 2)) * 32 + ((lane >> 4) & 1) * 16 + (lane & 3) * 4;
#pragma unroll
  for (int s2 = 0; s2 < 2; ++s2) {
#pragma unroll
    for (int db = 0; db < 2; ++db) {
      const v4i16_t lo = __builtin_amdgcn_ds_read_tr16_b64_v4i16((LDS3 v4i16_t*)(vb + db * 2048 + s2 * 512));
      const v4i16_t hh = __builtin_amdgcn_ds_read_tr16_b64_v4i16((LDS3 v4i16_t*)(vb + db * 2048 + s2 * 512 + 256));
      const bf16x8 vf = {lo[0], lo[1], lo[2], lo[3], hh[0], hh[1], hh[2], hh[3]};
      if (db == 0) st.o0 = MFMA32(s2 ? pa1 : pa0, vf, st.o0); else st.o1 = MFMA32(s2 ? pa1 : pa0, vf, st.o1);
    }
  }
}
template <class VRow, class Fix>
__device__ __forceinline__ void flash_tile(FlashState& st, const bf16x8 (&qf)[4], const SB* kp, VRow vrow, Fix fix, WaveLds* L, int lane) {
  const int r32 = lane & 31, hi = lane >> 5;
  bf16x8 kf[4];
#pragma unroll
  for (int d0 = 0; d0 < 4; ++d0) kf[d0] = *(const bf16x8*)(kp + d0 * 16 + hi * 8);
#pragma unroll
  for (int i = 0; i < 4; ++i) { const int c = lane + 64 * i, key = c >> 3, ch = c & 7; const SB* vp = vrow(key); const uint4 vv = *(const uint4*)(vp + ch * 8);
    *(uint4*)&L->v[(ch >> 2) * 2048 + key * 32 + (ch & 3) * 8] = vv; }
  f32x16 s = zero16();
#pragma unroll
  for (int d0 = 0; d0 < 4; ++d0) s = MFMA32(kf[d0], qf[d0], s);
  fix(s);
  flash_core1(st, s, L->v, L->xch, lane);
}
__device__ __forceinline__ void flash_core2(FlashState& st, f32x16& s0, f32x16& s1, const unsigned short* vimg, float* xch, int lane) {
  const int r32 = lane & 31, hi = lane >> 5;
  float mx = fmaxf(s0[0], s1[0]);
#pragma unroll
  for (int e = 1; e < 16; ++e) mx = fmaxf(mx, fmaxf(s0[e], s1[e]));
  mx = fmaxf(mx, xor32_f(mx));
  if (__any(mx > st.m + FTHR)) {
    const float mn = fmaxf(st.m, mx); const float al = __builtin_amdgcn_exp2f(st.m - mn); st.m = mn; st.l *= al; xch[r32] = al;
#pragma unroll
    for (int e = 0; e < 16; ++e) { const float a = xch[crow(e, hi)]; st.o0[e] *= a; st.o1[e] *= a; }
  }
  float ps = 0.f;
#pragma unroll
  for (int e = 0; e < 16; ++e) { s0[e] = __builtin_amdgcn_exp2f(s0[e] - st.m); s1[e] = __builtin_amdgcn_exp2f(s1[e] - st.m); ps += s0[e] + s1[e]; }
  st.l += ps;
  bf16x8 pa[4]; pa[0] = pack8(s0, 0); pa[1] = pack8(s0, 8); pa[2] = pack8(s1, 0); pa[3] = pack8(s1, 8);
  const unsigned short* vb = vimg + (4 * hi + ((lane & 15) >> 2)) * 32 + ((lane >> 4) & 1) * 16 + (lane & 3) * 4;
#pragma unroll
  for (int kk = 0; kk < 4; ++kk) {
#pragma unroll
    for (int db = 0; db < 2; ++db) {
      const v4i16_t lo = __builtin_amdgcn_ds_read_tr16_b64_v4i16((LDS3 v4i16_t*)(vb + db * 2048 + kk * 512));
      const v4i16_t hh = __builtin_amdgcn_ds_read_tr16_b64_v4i16((LDS3 v4i16_t*)(vb + db * 2048 + kk * 512 + 256));
      const bf16x8 vf = {lo[0], lo[1], lo[2], lo[3], hh[0], hh[1], hh[2], hh[3]};
      if (db == 0) st.o0 = MFMA32(pa[kk], vf, st.o0); else st.o1 = MFMA32(pa[kk], vf, st.o1);
    }
  }
}
__device__ __forceinline__ void flash_core2_lin(FlashState& st, f32x16& s0, f32x16& s1, float qs, float bb, const unsigned short* vimg, float* xch, int lane) {
  const int r32 = lane & 31, hi = lane >> 5;
  float mr = fmaxf(s0[0], s1[0]);
#pragma unroll
  for (int e = 1; e < 16; ++e) mr = fmaxf(mr, fmaxf(s0[e], s1[e]));
  float mx = __builtin_fmaf(mr, qs, bb);
  mx = fmaxf(mx, xor32_f(mx));
  if (__any(mx > st.m + FTHR)) {
    const float mn = fmaxf(st.m, mx); const float al = __builtin_amdgcn_exp2f(st.m - mn); st.m = mn; st.l *= al; xch[r32] = al;
#pragma unroll
    for (int e = 0; e < 16; ++e) { const float a = xch[crow(e, hi)]; st.o0[e] *= a; st.o1[e] *= a; }
  }
  const float bm = bb - st.m; float ps = 0.f;
#pragma unroll
  for (int e = 0; e < 16; ++e) { s0[e] = __builtin_amdgcn_exp2f(__builtin_fmaf(s0[e], qs, bm)); s1[e] = __builtin_amdgcn_exp2f(__builtin_fmaf(s1[e], qs, bm)); ps += s0[e] + s1[e]; }
  st.l += ps;
  bf16x8 pa[4]; pa[0] = pack8(s0, 0); pa[1] = pack8(s0, 8); pa[2] = pack8(s1, 0); pa[3] = pack8(s1, 8);
  const unsigned short* vb = vimg + (4 * hi + ((lane & 15) >> 2)) * 32 + ((lane >> 4) & 1) * 16 + (lane & 3) * 4;
#pragma unroll
  for (int kk = 0; kk < 4; ++kk) {
#pragma unroll
    for (int db = 0; db < 2; ++db) {
      const v4i16_t lo = __builtin_amdgcn_ds_read_tr16_b64_v4i16((LDS3 v4i16_t*)(vb + db * 2048 + kk * 512));
      const v4i16_t hh = __builtin_amdgcn_ds_read_tr16_b64_v4i16((LDS3 v4i16_t*)(vb + db * 2048 + kk * 512 + 256));
      const bf16x8 vf = {lo[0], lo[1], lo[2], lo[3], hh[0], hh[1], hh[2], hh[3]};
      if (db == 0) st.o0 = MFMA32(pa[kk], vf, st.o0); else st.o1 = MFMA32(pa[kk], vf, st.o1);
    }
  }
}
#ifndef FT2
#define FT2 1
#endif
template <class VRow, class Fix0, class Fix1>
__device__ __forceinline__ void flash_tile2(FlashState& st, const bf16x8 (&qf)[4], const SB* kp0, const SB* kp1, VRow vrow, Fix0 fix0, Fix1 fix1, WaveLds* L, int lane) {
  if (!FT2) { flash_tile(st, qf, kp0, [&](int key) { return vrow(key); }, fix0, L, lane); flash_tile(st, qf, kp1, [&](int key) { return vrow(key + 32); }, fix1, L, lane); return; }
  const int hi = lane >> 5;
  bf16x8 kf0[4], kf1[4];
#pragma unroll
  for (int d0 = 0; d0 < 4; ++d0) { kf0[d0] = *(const bf16x8*)(kp0 + d0 * 16 + hi * 8); kf1[d0] = *(const bf16x8*)(kp1 + d0 * 16 + hi * 8); }
#pragma unroll
  for (int i = 0; i < 8; ++i) { const int c = lane + 64 * i, key = c >> 3, ch = c & 7; const SB* vp = vrow(key); const uint4 vv = *(const uint4*)(vp + ch * 8);
    *(uint4*)&L->v[(ch >> 2) * 2048 + key * 32 + (ch & 3) * 8] = vv; }
  f32x16 s0 = zero16(), s1 = zero16();
#pragma unroll
  for (int d0 = 0; d0 < 4; ++d0) { s0 = MFMA32(kf0[d0], qf[d0], s0); s1 = MFMA32(kf1[d0], qf[d0], s1); }
  fix0(s0); fix1(s1);
  flash_core2(st, s0, s1, L->v, L->xch, lane);
}
template <class KPtr, class VRow, class Fix>
__device__ __forceinline__ void flash_run(FlashState& st, const bf16x8 (&qf)[4], int t0, int t1, KPtr kptr, VRow vrow, Fix fix, WaveLds* L, int lane) {
  if (t0 >= t1) return;
  const int hi = lane >> 5; bf16x8 kfn[4];
#define FR_ISSUE(tt) { const int t_ = (tt); _Pragma("unroll") for (int i_ = 0; i_ < 4; ++i_) { const int db_ = i_ >> 1, key_ = (i_ & 1) * 16 + (lane >> 2), wi_ = lane & 3; \
      __builtin_amdgcn_global_load_lds((gptr_t)(vrow(t_, key_) + db_ * 32 + wi_ * 8), (lptr_t)&L->v[db_ * 2048 + (t_ & 1) * 1024 + (i_ & 1) * 512], 16, 0, 0); } \
    const SB* kp_ = kptr(t_); _Pragma("unroll") for (int d0_ = 0; d0_ < 4; ++d0_) kfn[d0_] = *(const GLB1 bf16x8*)(kp_ + d0_ * 16 + hi * 8); }
  FR_ISSUE(t0)
  for (int t = t0; t < t1; ++t) {
    asm volatile("s_waitcnt vmcnt(0)" ::: "memory");
    bf16x8 kf[4];
#pragma unroll
    for (int d0 = 0; d0 < 4; ++d0) kf[d0] = kfn[d0];
    if (t + 1 < t1) FR_ISSUE(t + 1)
    f32x16 s = zero16();
#pragma unroll
    for (int d0 = 0; d0 < 4; ++d0) s = MFMA32(kf[d0], qf[d0], s);
    fix(t, s);
    flash_core1(st, s, L->v + (t & 1) * 1024, L->xch, lane);
  }
#undef FR_ISSUE
}
__device__ __forceinline__ float flash_finish(FlashState& st, WaveLds* L, int lane) {
  const int r32 = lane & 31, hi = lane >> 5;
  const float lt = st.l + xor32_f(st.l); const float inv = lt > 0.f ? 1.f / lt : 0.f;
  L->xch[r32] = inv;
#pragma unroll
  for (int e = 0; e < 16; ++e) { const float a = L->xch[crow(e, hi)]; st.o0[e] *= a; st.o1[e] *= a; }
  return (st.m + __builtin_amdgcn_logf(lt)) * LN2;
}
__device__ __forceinline__ void load_q(bf16x8 (&qf)[4], const SB* qp, int hi) {
#pragma unroll
  for (int d0 = 0; d0 < 4; ++d0) qf[d0] = *(const GLB1 bf16x8*)(qp + d0 * 16 + hi * 8);
}
__device__ __forceinline__ void fix_tab(f32x16& s, const WaveLds* L, int base, int lane, bool chk, int kb) {
  const int r32 = lane & 31, hi = lane >> 5; const float* tp = L->tab + base + r32 + 32 - 4 * hi;
#pragma unroll
  for (int e = 0; e < 16; ++e) { const int kk = (e & 3) + 8 * (e >> 2); float v = s[e] * QSC + tp[-kk]; if (chk && (kb + kk + 4 * hi < 0)) v = NINF; s[e] = v; }
}

__device__ __forceinline__ void unit_c(const Params& p, int layer, int u, WaveLds* L, int lane) {
  const int h = u & 7, qt = u >> 3, q0 = qt * 32, hk = h >> 2, r32 = lane & 31, hi = lane >> 5;
  for (int x = lane; x < 192; x += 64) { const int dist = x - 32; L->tab[x] = (dist >= 0 && dist <= 127) ? 0.f : NINF; }
  bf16x8 qf[4]; load_q(qf, p.proj + (long)(q0 + r32) * NPROJ + PC_Q + h * 64, hi);
  FlashState st; st.o0 = zero16(); st.o1 = zero16(); st.m = p.sinks[layer * 8 + h] * L2E; st.l = hi ? 0.f : 1.f;
  const SB* kvb = p.proj + PC_KV + hk * 64; const bool chk = q0 < 128;
  flash_run(st, qf, 0, 5, [&](int t) { int tok = q0 - 128 + 32 * t + r32; tok = tok < 0 ? 0 : tok; return kvb + (long)tok * NPROJ; },
            [&](int t, int key) { int tk = q0 - 128 + 32 * t + key; tk = tk < 0 ? 0 : tk; return kvb + 128 + (long)tk * NPROJ; },
            [&](int t, f32x16& s) { fix_tab(s, L, 128 - 32 * t, lane, chk, q0 - 128 + 32 * t); }, L, lane);
  flash_finish(st, L, lane);
  { SB m0[16], m1[16];
#pragma unroll
    for (int e = 0; e < 16; ++e) { const SB* mp = p.mix + (long)(q0 + crow(e, hi)) * NMIX + MX_C + h * 64 + r32; m0[e] = mp[0]; m1[e] = mp[32]; }
#pragma unroll
    for (int e = 0; e < 16; ++e) { SB* mp = p.mix + (long)(q0 + crow(e, hi)) * NMIX + MX_C + h * 64 + r32; mp[0] = f2bf(st.o0[e] * bf2f(m0[e])); mp[32] = f2bf(st.o1[e] * bf2f(m1[e])); } }
}
__device__ __forceinline__ void unit_m(const Params& p, int layer, int u, WaveLds* L, int lane) {
  const int h = u & 3, qt = u >> 2, q0 = qt * 32, r32 = lane & 31, hi = lane >> 5;
  bf16x8 qf[4]; load_q(qf, p.proj + (long)(q0 + r32) * NPROJ + PM_Q + h * 64, hi);
  FlashState st; st.o0 = zero16(); st.o1 = zero16(); st.m = -1e30f; st.l = 0.f;
  const SB* kb = p.memkv + (long)layer * 256 * 512 + h * 64;
  flash_run(st, qf, 0, 8, [&](int t) { return kb + (long)(32 * t + r32) * 512; }, [&](int t, int key) { return kb + 256 + (long)(32 * t + key) * 512; },
            [&](int, f32x16& s) {
#pragma unroll
              for (int e = 0; e < 16; ++e) s[e] *= QSC; }, L, lane);
  flash_finish(st, L, lane);
  { SB m0[16], m1[16];
#pragma unroll
    for (int e = 0; e < 16; ++e) { const SB* mp = p.mix + (long)(q0 + crow(e, hi)) * NMIX + MX_M + h * 64 + r32; m0[e] = mp[0]; m1[e] = mp[32]; }
#pragma unroll
    for (int e = 0; e < 16; ++e) { SB* mp = p.mix + (long)(q0 + crow(e, hi)) * NMIX + MX_M + h * 64 + r32; mp[0] = f2bf(st.o0[e] * bf2f(m0[e])); mp[32] = f2bf(st.o1[e] * bf2f(m1[e])); } }
}
__device__ __forceinline__ void unit_awin(const Params& p, int u, WaveLds* L, int lane) {
  const int h = u & 7, qt = u >> 3, q0 = qt * 32, hk = h >> 2, r32 = lane & 31, hi = lane >> 5;
  { float tv[10];
#pragma unroll
    for (int i = 0; i < 10; ++i) { const int dist = lane + 64 * i - 32; const int dc = dist < 0 ? 0 : (dist > 511 ? 511 : dist); tv[i] = p.tabA[h * TABA_N + dc]; }
#pragma unroll
    for (int i = 0; i < 10; ++i) { const int x = lane + 64 * i, dist = x - 32; if (x < 608) L->tab[x] = (dist >= 0 && dist <= 511) ? tv[i] * L2E : NINF; } }
  bf16x8 qf[4]; load_q(qf, p.proj + (long)(q0 + r32) * NPROJ + PA_Q + h * 64, hi);
  FlashState st; st.o0 = zero16(); st.o1 = zero16(); st.m = -1e30f; st.l = 0.f;
  const SB* kvb = p.proj + PA_KV + 4 * 128 + hk * 64; const bool chk = q0 < 512;
  { int tfirst = 0; if (q0 < 512) tfirst = (512 - q0) / 32 - 0; if (tfirst > 16) tfirst = 16; if (q0 < 512 && (q0 - 512 + 32 * tfirst + 31) < 0) ++tfirst;
    flash_run(st, qf, tfirst, 17, [&](int t) { int tok = q0 - 512 + 32 * t + r32; tok = tok < 0 ? 0 : tok; return kvb + (long)tok * NPROJ; },
              [&](int t, int key) { int tk = q0 - 512 + 32 * t + key; tk = tk < 0 ? 0 : tk; return kvb + 128 + (long)tk * NPROJ; },
              [&](int t, f32x16& s) { fix_tab(s, L, 512 - 32 * t, lane, chk, q0 - 512 + 32 * t); }, L, lane); }
  flash_finish(st, L, lane);
#pragma unroll
  for (int e = 0; e < 16; ++e) { SB* op = p.ow + (long)(q0 + crow(e, hi)) * 512 + h * 64 + r32; op[0] = f2bf(st.o0[e]); op[32] = f2bf(st.o1[e]); }
}
__device__ __forceinline__ void unit_d(const Params& p, int u, WaveLds* L, int lane) {
  const int S = p.S, per = (S / 32) * 8; const int gi = u / per, u2 = u % per; const int h = u2 & 7, v = u2 >> 3;
  const int dil = gi == 0 ? 1 : (gi == 1 ? 4 : 16); const int it = v / dil, r = v % dil, i0 = it * 32;
  const int r32 = lane & 31, hi = lane >> 5;
  { float tv[3];
#pragma unroll
    for (int i = 0; i < 3; ++i) { const int dd = lane + 64 * i - 32; const int dc = dd < 0 ? 0 : (dd > 128 ? 128 : dd); tv[i] = p.tabD[(gi * 8 + h) * TABD_N + dc]; }
#pragma unroll
    for (int i = 0; i < 3; ++i) { const int x = lane + 64 * i, dd = x - 32; L->tab[x] = (dd >= 0 && dd <= 128) ? tv[i] * L2E : NINF; } }
  bf16x8 qf[4]; load_q(qf, p.proj + (long)(r + dil * (i0 + r32)) * NPROJ + PD_Q + gi * 512 + h * 64, hi);
  FlashState st; st.o0 = zero16(); st.o1 = zero16(); st.m = -1e30f; st.l = 0.f;
  const SB* kvb = p.proj + PD_KV + h * 64; const bool chk = i0 < 128;
  flash_run(st, qf, 0, 5, [&](int t) { int j = i0 - 128 + 32 * t + r32; j = j < 0 ? 0 : j; return kvb + (long)(r + dil * j) * NPROJ; },
            [&](int t, int key) { int jj = i0 - 128 + 32 * t + key; jj = jj < 0 ? 0 : jj; return kvb + 512 + (long)(r + dil * jj) * NPROJ; },
            [&](int t, f32x16& s) { fix_tab(s, L, 128 - 32 * t, lane, chk, i0 - 128 + 32 * t); }, L, lane);
  const float lse = flash_finish(st, L, lane);
#pragma unroll
  for (int e = 0; e < 16; ++e) { const long tok = r + dil * (i0 + crow(e, hi)); SB* op = p.dop + ((long)gi * S + tok) * 512 + h * 64 + r32; op[0] = f2bf(st.o0[e]); op[32] = f2bf(st.o1[e]); }
  if (hi == 0) p.dlse[((long)gi * S + r + dil * (i0 + r32)) * 8 + h] = lse;
}
__device__ __forceinline__ void fix_cmp(f32x16& s, const float* tabh, float c31, int q0, int t, int lane) {
  const int r32 = lane & 31, hi = lane >> 5; const int dq = q0 + r32 - 31 - 16 * (32 * t + 4 * hi);
  const bool far = (q0 - 16 * (32 * t + 31) - 31) >= 1513;
  if (far) {
#pragma unroll
    for (int e = 0; e < 16; ++e) s[e] = __builtin_fmaf(s[e], QSC, c31);
  } else {
    float bv[16];
#pragma unroll
    for (int e = 0; e < 16; ++e) { const int dist = dq - 16 * ((e & 3) + 8 * (e >> 2)); const int dc = dist < 0 ? 0 : (dist > 2047 ? 2047 : dist); bv[e] = tabh[dc]; }
#if 1
#pragma unroll
    for (int e = 0; e < 16; e += 4) asm volatile("" : "+v"(bv[e]), "+v"(bv[e + 1]), "+v"(bv[e + 2]), "+v"(bv[e + 3]));
#endif
#pragma unroll
    for (int e = 0; e < 16; ++e) { const int dist = dq - 16 * ((e & 3) + 8 * (e >> 2)); s[e] = dist < 0 ? NINF : __builtin_fmaf(s[e], QSC, bv[e] * L2E); }
  }
}
__device__ __forceinline__ void unit_acmp1(const Params& p, int u, WaveLds* L, int lane) {
  const int h = u & 7, qt = (p.S / 32 - 1) - (u >> 3), q0 = qt * 32, g = h >> 2, r32 = lane & 31, hi = lane >> 5; const int ncmp = p.S / 16;
  bf16x8 qf[4]; load_q(qf, p.proj + (long)(q0 + r32) * NPROJ + PA_Q + h * 64, hi);
  FlashState st; st.o0 = zero16(); st.o1 = zero16(); st.m = -1e30f; st.l = 0.f;
  const int jn = q0 / 16 + 1, nt = (jn + 31) / 32; const SB* kc = p.kvc + g * 64; const SB* vc = p.kvc + (long)ncmp * 128 + g * 64;
  const float* tabh = p.tabA + h * TABA_N; const float c31 = tabh[2047] * L2E;
  flash_run(st, qf, 0, nt, [&](int t) { int j = 32 * t + r32; j = j >= ncmp ? ncmp - 1 : j; return kc + (long)j * 128; },
            [&](int t, int key) { int jj = 32 * t + key; jj = jj >= ncmp ? ncmp - 1 : jj; return vc + (long)jj * 128; },
            [&](int t, f32x16& s) { fix_cmp(s, tabh, c31, q0, t, lane); }, L, lane);
  const float lt = st.l + xor32_f(st.l); const float inv = lt > 0.f ? 1.f / lt : 0.f;
  flash_finish(st, L, lane);
#pragma unroll
  for (int e = 0; e < 16; ++e) { SB* op = p.oc + (long)(q0 + crow(e, hi)) * 512 + h * 64 + r32; op[0] = f2bf(st.o0[e]); op[32] = f2bf(st.o1[e]); }
  if (hi == 0) { p.cml[((long)(q0 + r32) * 8 + h) * 2] = st.m; p.cml[((long)(q0 + r32) * 8 + h) * 2 + 1] = inv; }
}
__device__ __forceinline__ void unit_acmp2(const Params& p, int u, int lane) {
  const int part = u & 3, g = (u >> 2) & 1, qt = (p.S / 32 - 1) - (u >> 3), q0 = qt * 32, r32 = lane & 31, hi = lane >> 5; const int ncmp = p.S / 16;
  const int jn = q0 / 16 + 1, nt = (jn + 31) / 32; const SB* kc = p.kvc + g * 64; float carry = 0.f;
  const int tper = (nt + 3) >> 2, tbeg = part * tper, tend = (tbeg + tper < nt) ? tbeg + tper : nt; if (tbeg >= nt) return;
  float* impq = p.imp + ((long)qt * 2 + g) * 256 * 32 + r32;
  const SB* qbase = p.proj + (long)(q0 + r32) * NPROJ + PA_Q + g * 256; const float* cmlq = p.cml + ((long)(q0 + r32) * 8 + g * 4) * 2;
  bf16x8 qc[4]; load_q(qc, qbase, hi); float mc = cmlq[0], ilc = cmlq[1], c31c = p.tabA[(g * 4) * TABA_N + 2047] * L2E;
  bf16x8 kfn[4]; { const int t = (tbeg > 0 ? tbeg - 1 : 0); int j = 32 * t + r32; j = j >= ncmp ? ncmp - 1 : j; const SB* kp = kc + (long)j * 128;
#pragma unroll
    for (int d0 = 0; d0 < 4; ++d0) kfn[d0] = *(const GLB1 bf16x8*)(kp + d0 * 16 + hi * 8); }
  for (int t = (tbeg > 0 ? tbeg - 1 : 0); t < tend; ++t) {
    bf16x8 kf[4];
#pragma unroll
    for (int d0 = 0; d0 < 4; ++d0) kf[d0] = kfn[d0];
    if (t + 1 < tend) { int j = 32 * (t + 1) + r32; j = j >= ncmp ? ncmp - 1 : j; const SB* kp = kc + (long)j * 128;
#pragma unroll
      for (int d0 = 0; d0 < 4; ++d0) kfn[d0] = *(const GLB1 bf16x8*)(kp + d0 * 16 + hi * 8); }
    float accA[4] = {0.f, 0.f, 0.f, 0.f}, accL[4] = {0.f, 0.f, 0.f, 0.f};
#pragma unroll 1
    for (int hh = 0; hh < 4; ++hh) { const int hn = (hh + 1) & 3;
      bf16x8 qn[4]; load_q(qn, qbase + hn * 64, hi); const float mn = cmlq[hn * 2], iln = cmlq[hn * 2 + 1], c31n = p.tabA[(g * 4 + hn) * TABA_N + 2047];
      f32x16 s = zero16();
#pragma unroll
      for (int d0 = 0; d0 < 4; ++d0) s = MFMA32(kf[d0], qc[d0], s);
      fix_cmp(s, p.tabA + (g * 4 + hh) * TABA_N, c31c, q0, t, lane);
#pragma unroll
      for (int e = 0; e < 16; ++e) { const float pr = __builtin_amdgcn_exp2f(s[e] - mc) * ilc; accA[e >> 2] += pr; if ((e & 3) == 3) accL[e >> 2] += pr; }
#pragma unroll
      for (int d0 = 0; d0 < 4; ++d0) qc[d0] = qn[d0];
      mc = mn; ilc = iln; c31c = c31n * L2E; }
    float oth[4];
#pragma unroll
    for (int eg = 0; eg < 4; ++eg) oth[eg] = xor32_f(accL[eg]);
#pragma unroll
    for (int eg = 0; eg < 4; ++eg) { const float prev = hi ? oth[eg] : (eg > 0 ? oth[eg > 0 ? eg - 1 : 0] : carry); if (t >= tbeg) impq[(8 * t + 2 * eg + hi) * 32] = 2.f * accA[eg] - accL[eg] + prev; }
    carry = oth[3]; }
}
#define DPP_F(v, ctrl, rm) __builtin_bit_cast(float, __builtin_amdgcn_update_dpp(__builtin_bit_cast(int, v), __builtin_bit_cast(int, v), ctrl, rm, 0xf, false))
#define DPP_I(v, ctrl, rm) __builtin_amdgcn_update_dpp(v, v, ctrl, rm, 0xf, false)
__device__ __forceinline__ float wave_max_f(float v) {
  v = fmaxf(v, DPP_F(v, 0xB1, 0xf)); v = fmaxf(v, DPP_F(v, 0x4E, 0xf)); v = fmaxf(v, DPP_F(v, 0x141, 0xf)); v = fmaxf(v, DPP_F(v, 0x140, 0xf));
  v = fmaxf(v, DPP_F(v, 0x142, 0xa)); v = fmaxf(v, DPP_F(v, 0x143, 0xc));
  return __builtin_bit_cast(float, __builtin_amdgcn_readlane(__builtin_bit_cast(int, v), 63)); }
__device__ __forceinline__ int imin_(int a, int b) { return a < b ? a : b; }
__device__ __forceinline__ int wave_min_i(int v) {
  v = imin_(v, DPP_I(v, 0xB1, 0xf)); v = imin_(v, DPP_I(v, 0x4E, 0xf)); v = imin_(v, DPP_I(v, 0x141, 0xf)); v = imin_(v, DPP_I(v, 0x140, 0xf));
  v = imin_(v, DPP_I(v, 0x142, 0xa)); v = imin_(v, DPP_I(v, 0x143, 0xc));
  return __builtin_amdgcn_readlane(v, 63); }
__device__ __forceinline__ void unit_topk(const Params& p, int u, int lane) {
  const int q = u >> 1, cur = q >> 6; const float* imp = p.imp + ((long)(q >> 5) * 2 + (u & 1)) * 256 * 32 + (q & 31); int* idx = p.idx + (long)u * 16;
  float v[4];
#pragma unroll
  for (int k = 0; k < 4; ++k) { const int b = lane + 64 * k; float x = (b <= cur) ? imp[b * 32] : -1.f; if (b == 0 || b == cur) x = 1e4f; v[k] = x; }
  int mine = -1;
  for (int k = 0; k < 16; ++k) {
    float lm = fmaxf(fmaxf(v[0], v[1]), fmaxf(v[2], v[3])); const float m = wave_max_f(lm);
    int cand = 0x7fffffff;
#pragma unroll
    for (int kk = 3; kk >= 0; --kk) if (v[kk] == m) cand = lane + 64 * kk;
    const int bsel = wave_min_i(cand);
#pragma unroll
    for (int kk = 0; kk < 4; ++kk) if (lane + 64 * kk == bsel) v[kk] = -2.f;
    if (lane == k) mine = (m >= 0.f) ? bsel : -1;
  }
  if (lane < 16) idx[lane] = mine;
}
template <bool STORE = true>
__device__ __forceinline__ void unit_asel(const Params& p, int u, WaveLds* L, int lane) {
  const int g = u & 1, q = u >> 1, r32 = lane & 31, hi = lane >> 5, hh = r32 & 3, h = g * 4 + hh;
  bf16x8 qf[4]; load_q(qf, p.proj + (long)q * NPROJ + PA_Q + h * 64, hi);
  FlashState st; st.o0 = zero16(); st.o1 = zero16(); st.m = -1e30f; st.l = 0.f;
  const int* idx = p.idx + (long)u * 16; const SB* kvb = p.proj + PA_KV + 2 * 128 + g * 64; const float c31 = p.tabA[h * TABA_N + 2047] * L2E;
  for (int k = 0; k < 16; ++k) { const int b = __builtin_amdgcn_readfirstlane(idx[k]); if (b < 0) continue;
    for (int kt = 0; kt < 2; ++kt) { const int t0 = b * 64 + kt * 32; if (t0 > q) continue;
      const bool far = (q - (t0 + 31)) >= 1513; const bool edge = (t0 + 31 > q);
      flash_tile(st, qf, kvb + (long)(t0 + r32) * NPROJ, [&](int key) { return kvb + 128 + (long)(t0 + key) * NPROJ; },
                 [&](f32x16& s) {
#pragma unroll
                   for (int e = 0; e < 16; ++e) { const int tk = t0 + (e & 3) + 8 * (e >> 2) + 4 * hi; const int dist = q - tk; float bsv;
                     if (far) bsv = c31; else { const int dc = dist < 0 ? 0 : (dist > 2047 ? 2047 : dist); bsv = p.tabA[h * TABA_N + dc] * L2E; }
                     float vv = s[e] * QSC + bsv; if (edge && dist < 0) vv = NINF; s[e] = vv; } }, L, lane); } }
  flash_finish(st, L, lane);
  if (!STORE) { asm volatile("" :: "v"(st.o0[0]), "v"(st.o1[3])); return; }
  if (hi == 0) {
#pragma unroll
    for (int e = 0; e < 4; ++e) { const int he = g * 4 + e; const float* gl = p.small + (long)q * NSMALL + he * 3;
      const float g0 = sigmoid_fast(gl[0]), g1 = sigmoid_fast(gl[1]), g2 = sigmoid_fast(gl[2]);
#pragma unroll
      for (int db = 0; db < 2; ++db) { const long c = (long)q * 512 + he * 64 + db * 32 + r32; const float os = db ? st.o1[e] : st.o0[e];
        const float a = g0 * bf2f(p.oc[c]) + g1 * os + g2 * bf2f(p.ow[c]); SB* mp = p.mix + (long)q * NMIX + MX_A + he * 64 + db * 32 + r32; *mp = f2bf(a * bf2f(*mp)); } }
  }
}

struct WaveLds2 { unsigned short x[2048]; unsigned short b[2048]; float acs[128]; float dtv[128]; float xch[64]; };
template <bool SCALE, class RowScale>
__device__ __forceinline__ void stage_slab(unsigned short* dst, const SB* src, long ld, RowScale rs, int lane) {
#pragma unroll
  for (int i = 0; i < 4; ++i) { const int c = lane + 64 * i, row = c >> 3, ch = c & 7; const u32x4 gv = *(const GLB1 u32x4*)(src + (long)row * ld + ch * 8); uint4 vv; vv.x = gv[0]; vv.y = gv[1]; vv.z = gv[2]; vv.w = gv[3];
    if (SCALE) { const float sc = rs(row); unsigned w[4] = {vv.x, vv.y, vv.z, vv.w};
#pragma unroll
      for (int k = 0; k < 4; ++k) { const float lo = __uint_as_float(w[k] << 16) * sc, hi2 = __uint_as_float(w[k] & 0xffff0000u) * sc; w[k] = pk2(lo, hi2); }
      vv.x = w[0]; vv.y = w[1]; vv.z = w[2]; vv.w = w[3]; }
    *(uint4*)&dst[(ch >> 2) * 1024 + row * 32 + (ch & 3) * 8] = vv; }
}
__device__ __forceinline__ bf16x8 slab_frag(const unsigned short* img, int cb, int s2, int lane) {
  const int hi = lane >> 5; const unsigned short* vb = img + (4 * hi + ((lane & 15) >> 2)) * 32 + ((lane >> 4) & 1) * 16 + (lane & 3) * 4 + cb * 1024 + s2 * 512;
  const v4i16_t lo = __builtin_amdgcn_ds_read_tr16_b64_v4i16((LDS3 v4i16_t*)vb);
  const v4i16_t hh = __builtin_amdgcn_ds_read_tr16_b64_v4i16((LDS3 v4i16_t*)(vb + 256));
  return (bf16x8){lo[0], lo[1], lo[2], lo[3], hh[0], hh[1], hh[2], hh[3]};
}
__device__ __forceinline__ void unit_bstates(const Params& p, int u, WaveLds2* L, int lane) {
  const int nh = u & 1, hd = (u >> 1) & 7, c = u >> 4, g = hd >> 2, r32 = lane & 31, hi = lane >> 5;
  f32x16 acc[2][2];
#pragma unroll
  for (int i = 0; i < 2; ++i)
#pragma unroll
    for (int j = 0; j < 2; ++j) acc[i][j] = zero16();
  const SB* xb = p.xconv + (long)c * 128 * 1024; const float* wst = p.wst + (long)c * 128 * 8 + hd;
  u32x4 xn[4], bn[4]; float sn[4];
#define BST_LOAD(q_) { _Pragma("unroll") for (int i_ = 0; i_ < 4; ++i_) { const int c_ = lane + 64 * i_, row_ = c_ >> 3, ch_ = c_ & 7; \
      xn[i_] = *(const GLB1 u32x4*)(xb + (long)(32 * (q_) + row_) * 1024 + hd * 64 + ch_ * 8); bn[i_] = *(const GLB1 u32x4*)(xb + (long)(32 * (q_) + row_) * 1024 + 512 + g * 128 + nh * 64 + ch_ * 8); \
      sn[i_] = *(const GLB1 float*)&wst[(32 * (q_) + row_) * 8]; } }
  BST_LOAD(0)
  for (int q4 = 0; q4 < 4; ++q4) {
#pragma unroll
    for (int i = 0; i < 4; ++i) { const int c_ = lane + 64 * i, row = c_ >> 3, ch = c_ & 7; u32x4 w = xn[i];
#pragma unroll
      for (int k = 0; k < 4; ++k) { const float lo = __uint_as_float(w[k] << 16) * sn[i], hi2 = __uint_as_float(w[k] & 0xffff0000u) * sn[i]; w[k] = pk2(lo, hi2); }
      *(u32x4*)&L->x[(ch >> 2) * 1024 + row * 32 + (ch & 3) * 8] = w; *(u32x4*)&L->b[(ch >> 2) * 1024 + row * 32 + (ch & 3) * 8] = bn[i]; }
    { const int qn = q4 < 3 ? q4 + 1 : 3; BST_LOAD(qn) }
#pragma unroll
    for (int s2 = 0; s2 < 2; ++s2) { bf16x8 af[2], bfr[2];
#pragma unroll
      for (int i = 0; i < 2; ++i) { af[i] = slab_frag(L->x, i, s2, lane); bfr[i] = slab_frag(L->b, i, s2, lane); }
#pragma unroll
      for (int i = 0; i < 2; ++i)
#pragma unroll
        for (int j = 0; j < 2; ++j) acc[i][j] = MFMA32(af[i], bfr[j], acc[i][j]); } }
#undef BST_LOAD
  float* so = p.states + ((long)c * 8 + hd) * 8192 + nh * 64 + r32;
#pragma unroll
  for (int i = 0; i < 2; ++i)
#pragma unroll
    for (int j = 0; j < 2; ++j)
#pragma unroll
      for (int e = 0; e < 16; ++e) so[(long)(32 * i + crow(e, hi)) * 128 + 32 * j] = acc[i][j][e];
}
__device__ __forceinline__ void unit_bout(const Params& p, int layer, int u, WaveLds2* L, int lane) {
  const int lt = u & 3, hd = (u >> 2) & 7, c = u >> 5, g = hd >> 2, r32 = lane & 31, hi = lane >> 5;
  for (int x = lane; x < 128; x += 64) { L->acs[x] = p.acs[((long)c * 128 + x) * 8 + hd]; L->dtv[x] = p.dt[((long)c * 128 + x) * 8 + hd]; }
  f32x16 acc[2] = {zero16(), zero16()}, acc2[2] = {zero16(), zero16()};
  const SB* xb = p.xconv + (long)c * 128 * 1024; const int l = 32 * lt + r32; const float al = p.acs[((long)c * 128 + l) * 8 + hd];
  const float* cbr = p.cb + ((long)c * 2 + g) * 16384 + (long)l * 128;
  for (int sc = 0; sc <= lt; ++sc) {
    stage_slab<false>(L->x, xb + (long)(32 * sc) * 1024 + hd * 64, 1024, [&](int) { return 1.f; }, lane);
#pragma unroll
    for (int s2 = 0; s2 < 2; ++s2) { float mv[8];
#pragma unroll
      for (int jj = 0; jj < 2; ++jj) { const int s0 = 32 * sc + 16 * s2 + 8 * jj + 4 * hi; const float4 cv = *(const float4*)(cbr + s0); const float4 av = *(const float4*)(&L->acs[s0]); const float4 dv = *(const float4*)(&L->dtv[s0]);
        mv[4 * jj + 0] = (s0 + 0 <= l) ? cv.x * __expf(al - av.x) * dv.x : 0.f; mv[4 * jj + 1] = (s0 + 1 <= l) ? cv.y * __expf(al - av.y) * dv.y : 0.f;
        mv[4 * jj + 2] = (s0 + 2 <= l) ? cv.z * __expf(al - av.z) * dv.z : 0.f; mv[4 * jj + 3] = (s0 + 3 <= l) ? cv.w * __expf(al - av.w) * dv.w : 0.f; }
      u32x4 aw; aw[0] = pk2(mv[0], mv[1]); aw[1] = pk2(mv[2], mv[3]); aw[2] = pk2(mv[4], mv[5]); aw[3] = pk2(mv[6], mv[7]); const bf16x8 af = __builtin_bit_cast(bf16x8, aw);
#pragma unroll
      for (int pt = 0; pt < 2; ++pt) acc[pt] = MFMA32(af, slab_frag(L->x, pt, s2, lane), acc[pt]); } }
  const SB* cmr = xb + (long)l * 1024 + 768 + g * 128; const float* prv = p.states + ((long)c * 8 + hd) * 8192;
#pragma unroll 2
  for (int ks = 0; ks < 8; ++ks) { const bf16x8 af = *(const bf16x8*)(cmr + 16 * ks + 8 * hi);
#pragma unroll
    for (int pt = 0; pt < 2; ++pt) { const float* pr = prv + (long)(32 * pt + r32) * 128 + 16 * ks + 8 * hi; const float4 a0 = *(const float4*)pr, a1 = *(const float4*)(pr + 4);
      u32x4 bw; bw[0] = pk2(a0.x, a0.y); bw[1] = pk2(a0.z, a0.w); bw[2] = pk2(a1.x, a1.y); bw[3] = pk2(a1.z, a1.w);
      acc2[pt] = MFMA32(af, __builtin_bit_cast(bf16x8, bw), acc2[pt]); } }
  const float dsk = p.b_d[layer * 8 + hd];
#pragma unroll
  for (int e = 0; e < 16; ++e) { const int lr = 32 * lt + crow(e, hi); const float ea = __expf(L->acs[lr]); const long t = (long)c * 128 + lr;
#pragma unroll
    for (int pt = 0; pt < 2; ++pt) { const int pp = 32 * pt + r32; p.ybuf[t * 512 + hd * 64 + pp] = acc[pt][e] + ea * acc2[pt][e] + dsk * bf2f(xb[(long)lr * 1024 + hd * 64 + pp]); } }
}
__device__ __forceinline__ void unit_bnorm(const Params& p, int layer, int u, int lane) {
  const int g = u & 1; const long t = u >> 1; const float4 yv = *(const float4*)(p.ybuf + t * 512 + g * 256 + lane * 4);
  SB* mp = p.mix + t * NMIX + MX_B + g * 256 + lane * 4; const ushort4 zv = *(const ushort4*)mp;
  const float v0 = yv.x * bf2f(zv.x), v1 = yv.y * bf2f(zv.y), v2 = yv.z * bf2f(zv.z), v3 = yv.w * bf2f(zv.w);
  const float ss = wave_sum_f(v0 * v0 + v1 * v1 + v2 * v2 + v3 * v3); const float r = 1.f / sqrtf(ss * (1.f / 256.f) + 1e-6f);
  const float4 w = *(const float4*)(p.b_norm + layer * 512 + g * 256 + lane * 4);
  ushort4 o; o.x = f2bf(v0 * r * w.x); o.y = f2bf(v1 * r * w.y); o.z = f2bf(v2 * r * w.z); o.w = f2bf(v3 * r * w.w); *(ushort4*)mp = o;
}
__device__ __forceinline__ void unit_bdt(const Params& p, int layer, int u, int lane) {
  const int hd = u & 7, c = u >> 3; const float a = -expf(p.a_log[layer * 8 + hd]), bias = p.dt_bias[layer * 8 + hd]; const long t0 = (long)c * 128 + 2 * lane;
  const float d0 = softplus_f(p.small[t0 * NSMALL + 24 + hd] + bias), d1 = softplus_f(p.small[(t0 + 1) * NSMALL + 24 + hd] + bias);
  float run = (d0 + d1) * a;
#pragma unroll
  for (int o = 1; o < 64; o <<= 1) { const float v = __shfl_up(run, o); if (lane >= o) run += v; }
  const float tot = __shfl(run, 63); const float c1 = run, c0 = run - d1 * a;
  p.dt[t0 * 8 + hd] = d0; p.dt[(t0 + 1) * 8 + hd] = d1; p.acs[t0 * 8 + hd] = c0; p.acs[(t0 + 1) * 8 + hd] = c1;
  p.wst[t0 * 8 + hd] = d0 * expf(tot - c0); p.wst[(t0 + 1) * 8 + hd] = d1 * expf(tot - c1);
}
__device__ __forceinline__ void item_bconv(const Params& p, int layer, long gid) {
  const int cg = (int)(gid & 127) * 8; const long t = gid >> 7; const float* w = p.conv_w + (long)layer * 4 * 1024 + cg; const float* bb = p.conv_b + layer * 1024 + cg;
  const float4 b0 = *(const float4*)bb, b1 = *(const float4*)(bb + 4);
  float acc[8] = {b0.x, b0.y, b0.z, b0.w, b1.x, b1.y, b1.z, b1.w};
  u32x4 tv[4];
#pragma unroll
  for (int i = 0; i < 4; ++i) { const long tt = t - 3 + i; const long tc = tt < 0 ? 0 : tt; tv[i] = *(const GLB1 u32x4*)(p.proj + tc * NPROJ + PB_X + cg); }
#pragma unroll
  for (int i = 0; i < 4; ++i) { const long tt = t - 3 + i; const float vm = tt < 0 ? 0.f : 1.f;
    const float4 w0 = *(const float4*)(w + i * 1024), w1 = *(const float4*)(w + i * 1024 + 4); const float wv[8] = {w0.x, w0.y, w0.z, w0.w, w1.x, w1.y, w1.z, w1.w};
#pragma unroll
    for (int k = 0; k < 4; ++k) { acc[2 * k] += vm * wv[2 * k] * __uint_as_float(tv[i][k] << 16); acc[2 * k + 1] += vm * wv[2 * k + 1] * __uint_as_float(tv[i][k] & 0xffff0000u); } }
  uint4 o; o.x = pk2(silu_fast(acc[0]), silu_fast(acc[1])); o.y = pk2(silu_fast(acc[2]), silu_fast(acc[3])); o.z = pk2(silu_fast(acc[4]), silu_fast(acc[5])); o.w = pk2(silu_fast(acc[6]), silu_fast(acc[7]));
  *(uint4*)(p.xconv + t * 1024 + cg) = o;
}
__device__ __forceinline__ void scan_fast(const Params& p, long gid) {
  const int hd = (int)(gid >> 13); const int nc = p.S / 128; float h = 0.f;
  float st[16], dc[16];
#pragma unroll
  for (int i = 0; i < 16; ++i) { st[i] = p.states[(long)i * 65536 + gid]; dc[i] = p.acs[(long)(i * 128 + 127) * 8 + hd]; }
  for (int c0 = 0; c0 < nc; c0 += 16) {
    float sn[16], dn[16]; const int cn = (c0 + 16 < nc) ? c0 + 16 : c0;
#pragma unroll
    for (int i = 0; i < 16; ++i) { sn[i] = p.states[(long)(cn + i) * 65536 + gid]; dn[i] = p.acs[(long)((cn + i) * 128 + 127) * 8 + hd]; }
#pragma unroll
    for (int i = 0; i < 16; ++i) { p.states[(long)(c0 + i) * 65536 + gid] = h; h = __builtin_fmaf(h, __builtin_amdgcn_exp2f(dc[i] * L2E), st[i]); }
#pragma unroll
    for (int i = 0; i < 16; ++i) { st[i] = sn[i]; dc[i] = dn[i]; }
  }
}
__device__ __forceinline__ void unit_cmp(const Params& p, int layer, int u, int lane) {
  const int ncmp = p.S / 16, ntile = ncmp * 2 / 32; const int kv = u / ntile, rt = u % ntile, r32 = lane & 31, hi = lane >> 5;
  const int r = 32 * rt + r32, j = r >> 1, hk = r & 1;
  const unsigned short* w1t = p.w1t + (long)kv * 128 * 2048; const unsigned short* w2t = p.w2t + kv * 64 * 128; const float* pe = p.cmp_pos + (long)(layer * 2 + kv) * 32 * 64;
  const SB* src = p.proj + PA_KV + kv * 128 + hk * 64;
  f32x16 acc[4] = {zero16(), zero16(), zero16(), zero16()};
#pragma unroll 4
  for (int ks = 0; ks < 128; ++ks) { const int t = ks >> 2, d = (ks & 3) * 16 + 8 * hi; const long tok = 16 * j + t;
    const float4 p0 = *(const float4*)(pe + t * 64 + d), p1 = *(const float4*)(pe + t * 64 + d + 4); float v[8] = {p0.x, p0.y, p0.z, p0.w, p1.x, p1.y, p1.z, p1.w};
    { const long tokc = tok < p.S ? tok : (long)p.S - 1; const float vm = tok < p.S ? 1.f : 0.f;
      const uint4 vv = *(const uint4*)(src + tokc * NPROJ + d); const unsigned wd[4] = {vv.x, vv.y, vv.z, vv.w};
#pragma unroll
      for (int k = 0; k < 4; ++k) { v[2 * k] += vm * __uint_as_float(wd[k] << 16); v[2 * k + 1] += vm * __uint_as_float(wd[k] & 0xffff0000u); } }
    u32x4 bw; bw[0] = pk2(v[0], v[1]); bw[1] = pk2(v[2], v[3]); bw[2] = pk2(v[4], v[5]); bw[3] = pk2(v[6], v[7]); const bf16x8 bfr = __builtin_bit_cast(bf16x8, bw);
#pragma unroll
    for (int ut = 0; ut < 4; ++ut) { const bf16x8 af = *(const bf16x8*)(w1t + (long)(32 * ut + r32) * 2048 + 16 * ks + 8 * hi); acc[ut] = MFMA32(af, bfr, acc[ut]); } }
  f32x16 o2[2] = {zero16(), zero16()};
#pragma unroll
  for (int ut = 0; ut < 4; ++ut) {
#pragma unroll
    for (int e = 0; e < 16; ++e) acc[ut][e] = gelu_fast(acc[ut][e]);
#pragma unroll
    for (int s2 = 0; s2 < 2; ++s2) { const bf16x8 hb = pack8(acc[ut], 8 * s2);
#pragma unroll
      for (int dt = 0; dt < 2; ++dt) { const unsigned short* wr = w2t + (32 * dt + r32) * 128 + 32 * ut + 16 * s2 + 4 * hi; const uint2 x0 = *(const uint2*)wr, x1 = *(const uint2*)(wr + 8);
        u32x4 aw; aw[0] = x0.x; aw[1] = x0.y; aw[2] = x1.x; aw[3] = x1.y; o2[dt] = MFMA32(__builtin_bit_cast(bf16x8, aw), hb, o2[dt]); } } }
  SB* dst = p.kvc + ((long)kv * ncmp * 2 + r) * 64;
#pragma unroll
  for (int dt = 0; dt < 2; ++dt)
#pragma unroll
    for (int e = 0; e < 16; ++e) dst[32 * dt + crow(e, hi)] = f2bf(o2[dt][e]);
}

__device__ __forceinline__ unsigned umax_(unsigned a, unsigned b) { return a > b ? a : b; }
#define DPP_U(v, ctrl, rm) (unsigned)__builtin_amdgcn_update_dpp((int)(v), (int)(v), ctrl, rm, 0xf, false)
__device__ __forceinline__ unsigned wave_max_u(unsigned v) {
  v = umax_(v, DPP_U(v, 0xB1, 0xf)); v = umax_(v, DPP_U(v, 0x4E, 0xf)); v = umax_(v, DPP_U(v, 0x141, 0xf)); v = umax_(v, DPP_U(v, 0x140, 0xf));
  v = umax_(v, DPP_U(v, 0x142, 0xa)); v = umax_(v, DPP_U(v, 0x143, 0xc));
  return (unsigned)__builtin_amdgcn_readlane((int)v, 63); }
template <int NR, class RowFn, class OutFn>
__device__ __forceinline__ void topkn_rows_o(const Params& p, RowFn rowfn, OutFn outfn, int lane) {
  unsigned v[NR][4]; int mine[NR];
#pragma unroll
  for (int r = 0; r < NR; ++r) { const int row = rowfn(r); const int q = row >> 1; const int cur = q >> 6; const float* imp = p.imp + ((long)(q >> 5) * 2 + (row & 1)) * 256 * 32 + (q & 31); mine[r] = -1;
#pragma unroll
    for (int k = 0; k < 4; ++k) { const int b = lane + 64 * k; float x = (b <= cur) ? *(const GLB1 float*)&imp[b * 32] : -1.f; if (b == 0 || b == cur) x = 1e4f;
      v[r][k] = (x >= 0.f) ? ((((__float_as_uint(x) >> 8) + 1u) << 8) | (unsigned)(255 - b)) : 0u; } }
  for (int k = 0; k < 16; ++k) {
    unsigned m[NR];
#pragma unroll
    for (int r = 0; r < NR; ++r) m[r] = wave_max_u(umax_(umax_(v[r][0], v[r][1]), umax_(v[r][2], v[r][3])));
#pragma unroll
    for (int r = 0; r < NR; ++r) {
#pragma unroll
      for (int kk = 0; kk < 4; ++kk) if (v[r][kk] == m[r]) v[r][kk] = 0u;
      if (lane == k) mine[r] = (m[r] != 0u) ? (int)(255u - (m[r] & 255u)) : -1; }
  }
#pragma unroll
  for (int r = 0; r < NR; ++r) if (lane < 16) { p.idx[(long)rowfn(r) * 16 + lane] = mine[r]; outfn(r, mine[r]); }
}
template <class RowFn, class OutFn>
__device__ __forceinline__ void topk4_rows_o(const Params& p, RowFn rowfn, OutFn outfn, int lane) { topkn_rows_o<4>(p, rowfn, outfn, lane); }
template <class RowFn>
__device__ __forceinline__ void topk4_rows(const Params& p, RowFn rowfn, int lane) { topk4_rows_o(p, rowfn, [](int, int) {}, lane); }
__device__ __forceinline__ void unit_topk4(const Params& p, int u, int lane) { topk4_rows(p, [&](int r) { return u * 4 + r; }, lane); }
__device__ __forceinline__ void glds16_asm(const void* gsrc, unsigned lds_dst) {
  unsigned keep; asm volatile("s_mov_b32 %0, m0\n\ts_mov_b32 m0, %2\n\ts_nop 0\n\tglobal_load_lds_dwordx4 %1, off\n\ts_mov_b32 m0, %0" : "=&s"(keep) : "v"(gsrc), "s"(lds_dst) : "memory");
}
__device__ __forceinline__ unsigned lds_addr(const void* p) { return (unsigned)(size_t)(LDS3 const void*)p; }
struct AselLds { unsigned short k[3][4096]; unsigned short v[3][4096]; unsigned short q[4][2048]; unsigned sel[64][8]; unsigned anyb[8]; int nlist; int pad[7]; unsigned char blist[256]; float xch[4][32]; unsigned char bkt[1664]; float relS[128]; };
__device__ __forceinline__ void asel_issue(uint4 (&r)[4], const SB* kvb, int b, int tid) {
#pragma unroll
  for (int i = 0; i < 2; ++i) { const int idx = tid + 256 * i, row = idx >> 3, ch = idx & 7; const SB* src = kvb + (long)(b * 64 + row) * NPROJ + ch * 8; r[i] = *(const uint4*)src; r[2 + i] = *(const uint4*)(src + 128); }
}
__device__ __forceinline__ void asel_commit(const uint4 (&r)[4], AselLds* A, int stage, int tid) {
#pragma unroll
  for (int i = 0; i < 2; ++i) { const int idx = tid + 256 * i, row = idx >> 3, ch = idx & 7;
    *(uint4*)&A->k[stage][row * 64 + ((ch ^ (row & 7)) * 8)] = r[i];
    *(uint4*)&A->v[stage][(ch >> 2) * 2048 + row * 32 + (ch & 3) * 8] = r[2 + i]; }
}
__device__ __forceinline__ void asel_coltile(const Params& p, FlashState& S_, const unsigned short* qlds, AselLds* A, float* xch, int stage, int b, int cur, int q0, int qbase, int h, float c31, int lane) {
  const int r32 = lane & 31, hi = lane >> 5; const int ql = qbase + (r32 >> 2); const int q = q0 + ql;
  const bool selq = (A->sel[ql][b >> 5] >> (b & 31)) & 1u;
  if (!__any(selq)) return;
  bf16x8 qf[4];
#pragma unroll
  for (int d0 = 0; d0 < 4; ++d0) qf[d0] = *(const bf16x8*)&qlds[r32 * 64 + (((2 * d0 + hi) ^ ((r32 >> 1) & 7)) * 8)];
  const bool far = (q0 - (b * 64 + 63)) >= 1513; const bool edge = (b == cur);
#ifndef ASEL2
#define ASEL2 1
#endif
#if ASEL2
  bf16x8 kf0[4], kf1[4];
#pragma unroll
  for (int d0 = 0; d0 < 4; ++d0) { const int row0 = r32, row1 = 32 + r32;
    kf0[d0] = *(const bf16x8*)&A->k[stage][row0 * 64 + (((2 * d0 + hi) ^ ((row0 >> 1) & 7)) * 8)];
    kf1[d0] = *(const bf16x8*)&A->k[stage][row1 * 64 + (((2 * d0 + hi) ^ ((row1 >> 1) & 7)) * 8)]; }
  f32x16 s0 = zero16(), s1 = zero16();
#pragma unroll
  for (int d0 = 0; d0 < 4; ++d0) { s0 = MFMA32(kf0[d0], qf[d0], s0); s1 = MFMA32(kf1[d0], qf[d0], s1); }
  if (far) { flash_core2_lin(S_, s0, s1, selq ? QSC : 0.f, selq ? c31 : NINF, A->v[stage], xch, lane); return; }
#pragma unroll
  for (int e = 0; e < 16; ++e) { const int tk = b * 64 + (e & 3) + 8 * (e >> 2) + 4 * hi; const int dist = q - tk; float b0, b1;
    { const int d0c = dist < 0 ? 0 : (dist > 1663 ? 1663 : dist); const int d1 = dist - 32; const int d1c = d1 < 0 ? 0 : (d1 > 1663 ? 1663 : d1);
      b0 = A->relS[A->bkt[d0c] * 4 + (h & 3)]; b1 = A->relS[A->bkt[d1c] * 4 + (h & 3)]; }
    float v0 = s0[e] * QSC + b0, v1 = s1[e] * QSC + b1; if (!selq || (edge && dist < 0)) v0 = NINF; if (!selq || (edge && dist < 32)) v1 = NINF; s0[e] = v0; s1[e] = v1; }
  flash_core2(S_, s0, s1, A->v[stage], xch, lane);
}
#else
#pragma unroll 1
  for (int kt = 0; kt < 2; ++kt) { const int t0 = b * 64 + 32 * kt; if (edge && t0 > q0 + qbase + 7) continue;
    bf16x8 kf[4]; { const int row = 32 * kt + r32;
#pragma unroll
      for (int d0 = 0; d0 < 4; ++d0) kf[d0] = *(const bf16x8*)&A->k[stage][row * 64 + (((2 * d0 + hi) ^ ((row >> 1) & 7)) * 8)]; }
    f32x16 s = zero16();
#pragma unroll
    for (int d0 = 0; d0 < 4; ++d0) s = MFMA32(kf[d0], qf[d0], s);
    if (far) { flash_core1_lin(S_, s, selq ? QSC : 0.f, selq ? c31 : NINF, A->v[stage] + kt * 1024, xch, lane); continue; }
#pragma unroll
    for (int e = 0; e < 16; ++e) { const int tk = t0 + (e & 3) + 8 * (e >> 2) + 4 * hi; const int dist = q - tk;
      const int dc = dist < 0 ? 0 : (dist > 2047 ? 2047 : dist); const float bsv = p.tabA[h * TABA_N + dc] * L2E;
      float vv = s[e] * QSC + bsv; if (!selq || (edge && dist < 0)) vv = NINF; s[e] = vv; }
    flash_core1(S_, s, A->v[stage] + kt * 1024, xch, lane);
  }
}
#endif
__device__ __forceinline__ void asel_store(const Params& p, FlashState& S_, float* xch, int q0, int qbase, int g, int lane) {
  const int r32 = lane & 31, hi = lane >> 5;
  const float lt = S_.l + xor32_f(S_.l); const float inv = lt > 0.f ? 1.f / lt : 0.f; xch[r32] = inv;
#pragma unroll
  for (int e = 0; e < 16; ++e) { const int j = crow(e, hi); const float a = xch[j]; const int q = q0 + qbase + (j >> 2), he = g * 4 + (j & 3);
    const float* gl = p.small + (long)q * NSMALL + he * 3; const float g0 = sigmoid_fast(gl[0]), g1 = sigmoid_fast(gl[1]), g2 = sigmoid_fast(gl[2]);
#pragma unroll
    for (int db = 0; db < 2; ++db) { const long c = (long)q * 512 + he * 64 + db * 32 + r32; const float os = (db ? S_.o1[e] : S_.o0[e]) * a;
      const float av = g0 * bf2f(p.oc[c]) + g1 * os + g2 * bf2f(p.ow[c]); SB* mp = p.mix + (long)q * NMIX + MX_A + he * 64 + db * 32 + r32; *mp = f2bf(av * bf2f(*mp)); } }
}
#ifndef ASEL16
#define ASEL16 1
#endif
typedef float f32x4_t __attribute__((ext_vector_type(4)));
#define MFMA16(a, b, c) __builtin_amdgcn_mfma_f32_16x16x32_bf16((a), (b), (c), 0, 0, 0)
struct Asel16 { f32x4_t o0, o1, o2, o3; float m, l; };
__device__ __forceinline__ float quadmax_f(float v) {
  const auto a = __builtin_amdgcn_permlane16_swap(__float_as_uint(v), __float_as_uint(v), false, false); v = fmaxf(__uint_as_float(a[0]), __uint_as_float(a[1]));
  const auto b = __builtin_amdgcn_permlane32_swap(__float_as_uint(v), __float_as_uint(v), false, false); return fmaxf(__uint_as_float(b[0]), __uint_as_float(b[1])); }
__device__ __forceinline__ float quadsum_f(float v) {
  const auto a = __builtin_amdgcn_permlane16_swap(__float_as_uint(v), __float_as_uint(v), false, false); v = __uint_as_float(a[0]) + __uint_as_float(a[1]);
  const auto b = __builtin_amdgcn_permlane32_swap(__float_as_uint(v), __float_as_uint(v), false, false); return __uint_as_float(b[0]) + __uint_as_float(b[1]); }
__device__ __forceinline__ bf16x8 pack44(const f32x4_t& a, const f32x4_t& b) {
  u32x4 r; r[0] = pk2(a[0], a[1]); r[1] = pk2(a[2], a[3]); r[2] = pk2(b[0], b[1]); r[3] = pk2(b[2], b[3]); return __builtin_bit_cast(bf16x8, r); }
template <int CT>
__device__ __forceinline__ void asel_coltile16(const Params& p, Asel16& S_, const unsigned short* qlds, AselLds* A, float* xch, int stage, int b, int cur, int q0, int qbase, float c31, int lane) {
  const int j = lane & 15, q4 = lane >> 4; const int ql = qbase + 4 * CT + (j >> 2); const int q = q0 + ql;
  const bool selq = (A->sel[ql][b >> 5] >> (b & 31)) & 1u;
  if (!__any(selq)) return;
  const bool far = (q0 - (b * 64 + 63)) >= 1513; const bool edge = (b == cur);
  const int qrow = 16 * CT + j;
  const bf16x8 qf0 = *(const bf16x8*)&qlds[qrow * 64 + (((q4) ^ ((qrow >> 1) & 7)) * 8)], qf1 = *(const bf16x8*)&qlds[qrow * 64 + (((4 + q4) ^ ((qrow >> 1) & 7)) * 8)];
  f32x4_t sc[4];
#pragma unroll
  for (int kt = 0; kt < 4; ++kt) { const int row = 16 * kt + j;
    const bf16x8 k0 = *(const bf16x8*)&A->k[stage][row * 64 + (((q4) ^ ((row >> 1) & 7)) * 8)], k1 = *(const bf16x8*)&A->k[stage][row * 64 + (((4 + q4) ^ ((row >> 1) & 7)) * 8)];
    f32x4_t z = {0.f, 0.f, 0.f, 0.f}; z = MFMA16(k0, qf0, z); sc[kt] = MFMA16(k1, qf1, z); }
  float qs, bb;
  if (far) { qs = selq ? QSC : 0.f; bb = selq ? c31 : NINF; }
  else {
    qs = 1.f; bb = 0.f;
#pragma unroll
    for (int kt = 0; kt < 4; ++kt) {
#pragma unroll
      for (int r = 0; r < 4; ++r) { const int tk = b * 64 + 16 * kt + 4 * q4 + r; const int dist = q - tk; const int dc = dist < 0 ? 0 : (dist > 1663 ? 1663 : dist);
        float v = sc[kt][r] * QSC + A->relS[A->bkt[dc] * 4 + (j & 3)]; if (!selq || (edge && dist < 0)) v = NINF; sc[kt][r] = v; } }
  }
  float mr = fmaxf(fmaxf(sc[0][0], sc[0][1]), fmaxf(sc[0][2], sc[0][3]));
#pragma unroll
  for (int kt = 1; kt < 4; ++kt) mr = fmaxf(mr, fmaxf(fmaxf(sc[kt][0], sc[kt][1]), fmaxf(sc[kt][2], sc[kt][3])));
  float mx = far ? __builtin_fmaf(mr, qs, bb) : mr;
  mx = quadmax_f(mx);
  if (__any(mx > S_.m + FTHR)) {
    const float mn = fmaxf(S_.m, mx); const float al = __builtin_amdgcn_exp2f(S_.m - mn); S_.m = mn; S_.l *= al; xch[16 * CT + j] = al;
    const f32x4_t a = *(const f32x4_t*)&xch[16 * CT + 4 * q4];
    S_.o0 *= a; S_.o1 *= a; S_.o2 *= a; S_.o3 *= a;
  }
  const float bm = bb - S_.m; float ps = 0.f;
#pragma unroll
  for (int kt = 0; kt < 4; ++kt) {
#pragma unroll
    for (int r = 0; r < 4; ++r) { const float e_ = __builtin_amdgcn_exp2f(__builtin_fmaf(sc[kt][r], qs, bm)); sc[kt][r] = e_; ps += e_; } }
  S_.l += ps;
  const bf16x8 pa0 = pack44(sc[0], sc[1]), pa1 = pack44(sc[2], sc[3]);
  const unsigned short* vb = A->v[stage] + (4 * q4 + (j >> 2)) * 32 + (j & 3) * 4;
#pragma unroll
  for (int c = 0; c < 2; ++c) {
#pragma unroll
    for (int dt = 0; dt < 4; ++dt) {
      const v4i16_t lo = __builtin_amdgcn_ds_read_tr16_b64_v4i16((LDS3 v4i16_t*)(vb + (dt >> 1) * 2048 + (dt & 1) * 16 + c * 1024));
      const v4i16_t hh = __builtin_amdgcn_ds_read_tr16_b64_v4i16((LDS3 v4i16_t*)(vb + (dt >> 1) * 2048 + (dt & 1) * 16 + c * 1024 + 512));
      const bf16x8 vf = {lo[0], lo[1], lo[2], lo[3], hh[0], hh[1], hh[2], hh[3]};
      const bf16x8 pa = c ? pa1 : pa0;
      if (dt == 0) S_.o0 = MFMA16(pa, vf, S_.o0); else if (dt == 1) S_.o1 = MFMA16(pa, vf, S_.o1); else if (dt == 2) S_.o2 = MFMA16(pa, vf, S_.o2); else S_.o3 = MFMA16(pa, vf, S_.o3);
    }
  }
}
template <int CT>
__device__ __forceinline__ void asel_store16(const Params& p, Asel16& S_, float* xch, int q0, int qbase, int g, int lane) {
  const int j = lane & 15, q4 = lane >> 4;
  const float lt = quadsum_f(S_.l); const float inv = lt > 0.f ? 1.f / lt : 0.f; xch[16 * CT + j] = inv;
  const f32x4_t a = *(const f32x4_t*)&xch[16 * CT + 4 * q4];
  const int q = q0 + qbase + 4 * CT + q4;
  SB vc[4][4], vw[4][4], vm[4][4]; float gg[4][3];
#pragma unroll
  for (int r = 0; r < 4; ++r) { const int he = g * 4 + r; const float* gl = p.small + (long)q * NSMALL + he * 3; gg[r][0] = gl[0]; gg[r][1] = gl[1]; gg[r][2] = gl[2];
#pragma unroll
    for (int dt = 0; dt < 4; ++dt) { const long c = (long)q * 512 + he * 64 + dt * 16 + j; vc[r][dt] = p.oc[c]; vw[r][dt] = p.ow[c]; vm[r][dt] = p.mix[(long)q * NMIX + MX_A + he * 64 + dt * 16 + j]; } }
#pragma unroll
  for (int r = 0; r < 4; ++r) { const int he = g * 4 + r; const float g0 = sigmoid_fast(gg[r][0]), g1 = sigmoid_fast(gg[r][1]), g2 = sigmoid_fast(gg[r][2]);
#pragma unroll
    for (int dt = 0; dt < 4; ++dt) { const float os = (dt == 0 ? S_.o0[r] : dt == 1 ? S_.o1[r] : dt == 2 ? S_.o2[r] : S_.o3[r]) * a[r];
      const float av = g0 * bf2f(vc[r][dt]) + g1 * os + g2 * bf2f(vw[r][dt]); p.mix[(long)q * NMIX + MX_A + he * 64 + dt * 16 + j] = f2bf(av * bf2f(vm[r][dt])); } }
}
template <bool STORE = true, bool NOSTEPS = false>
__device__ __forceinline__ void unit_asel_blk(const Params& p, int u, AselLds* A) {
  int tid = threadIdx.x; asm volatile("" : "+v"(tid));
  const int lane = tid & 63, w = __builtin_amdgcn_readfirstlane(tid >> 6), r32 = lane & 31, hi = lane >> 5;
  const int g = u & 1, qt = (p.S / 32 - 1) - (u >> 1), q0 = qt * 32, cur = q0 >> 6;
  const SB* kvb = p.proj + PA_KV + 2 * 128 + g * 64;
  __syncthreads();
  for (int i = tid; i < 64 * 8 + 8; i += 256) ((unsigned*)A->sel)[i] = 0u;
  for (int i = tid; i < 1664; i += 256) A->bkt[i] = (unsigned char)t5_bucket(i);
  if (tid < 128) A->relS[tid] = p.rel_bias[(tid >> 2) * 32 + g * 4 + (tid & 3)] * L2E;
#ifndef ASEL_NO_TOPK
  topk4_rows(p, [&](int r) { return (q0 + 8 * w + r) * 2 + g; }, lane); topk4_rows(p, [&](int r) { return (q0 + 8 * w + 4 + r) * 2 + g; }, lane);
  asm volatile("s_waitcnt vmcnt(0)" ::: "memory");
#endif
  __syncthreads();
#pragma unroll
  for (int i = 0; i < 2; ++i) { const int e = tid + 256 * i, ql = e >> 4, kk = e & 15; const int b = __hip_atomic_load(&p.idx[((long)(q0 + ql) * 2 + g) * 16 + kk], __ATOMIC_RELAXED, __HIP_MEMORY_SCOPE_AGENT);
    if (b >= 0) { atomicOr(&A->sel[ql][b >> 5], 1u << (b & 31)); atomicOr(&A->anyb[b >> 5], 1u << (b & 31)); } }
  __syncthreads();
  if (tid < 64) {
    const unsigned wbits = A->anyb[lane >> 3]; const unsigned nib = (wbits >> ((lane & 7) * 4)) & 15u; const int cnt = __popc(nib);
    int pre = cnt;
#pragma unroll
    for (int o = 1; o < 64; o <<= 1) { const int v = __shfl_up(pre, o); if (lane >= o) pre += v; }
    int pos = pre - cnt;
#pragma unroll
    for (int k = 0; k < 4; ++k) if ((nib >> k) & 1u) A->blist[pos++] = (unsigned char)(lane * 4 + k);
    if (lane == 63) A->nlist = pre;
  }
  __syncthreads();
  const int nlist = NOSTEPS ? 0 : A->nlist;
  const int hh = r32 & 3, h = g * 4 + hh; const float c31 = p.tabA[h * TABA_N + 2047] * L2E;
#if ASEL16
  Asel16 t0, t1;
#else
  FlashState st0;
#endif
  { bf16x8 qf0[4]; load_q(qf0, p.proj + (long)(q0 + 8 * w + (r32 >> 2)) * NPROJ + PA_Q + h * 64, hi);
#pragma unroll
    for (int d0 = 0; d0 < 4; ++d0) *(bf16x8*)&A->q[w][r32 * 64 + (((2 * d0 + hi) ^ ((r32 >> 1) & 7)) * 8)] = qf0[d0]; }
#if ASEL16
  { const f32x4_t z4 = {0.f, 0.f, 0.f, 0.f}; t0.o0 = z4; t0.o1 = z4; t0.o2 = z4; t0.o3 = z4; t0.m = -1e30f; t0.l = 0.f; t1 = t0; }
#else
  st0.o0 = zero16(); st0.o1 = zero16(); st0.m = -1e30f; st0.l = 0.f;
#endif
  float* xch = A->xch[w];
#define ASEL_DMA(bb, stg) { const int b_ = (bb); _Pragma("unroll") for (int i_ = 0; i_ < 2; ++i_) { const int pk_ = 2 * w + i_; \
      { const int row_ = pk_ * 8 + (lane >> 3), pc_ = lane & 7; glds16_asm(kvb + (long)(b_ * 64 + row_) * NPROJ + ((pc_ ^ ((row_ >> 1) & 7)) * 8), (unsigned)__builtin_amdgcn_readfirstlane((int)lds_addr(&A->k[stg][pk_ * 512]))); } \
      { const int db_ = pk_ >> 2, row_ = (pk_ & 3) * 16 + (lane >> 2), wi_ = lane & 3; glds16_asm(kvb + 128 + (long)(b_ * 64 + row_) * NPROJ + db_ * 32 + wi_ * 8, (unsigned)__builtin_amdgcn_readfirstlane((int)lds_addr(&A->v[stg][db_ * 2048 + (pk_ & 3) * 512]))); } } }
  asm volatile("s_waitcnt vmcnt(0)" ::: "memory");
  if (nlist > 0) ASEL_DMA(A->blist[0], 0);
  if (nlist > 1) ASEL_DMA(A->blist[1], 1);
  int stage = 0;
  for (int it = 0; it < nlist; ++it) {
    const int b = A->blist[it];
    if (it + 1 < nlist) asm volatile("s_waitcnt vmcnt(4) lgkmcnt(0)\n\ts_barrier" ::: "memory"); else asm volatile("s_waitcnt vmcnt(0) lgkmcnt(0)\n\ts_barrier" ::: "memory");
    if (it + 2 < nlist) { const int s2_ = (stage == 0) ? 2 : stage - 1; ASEL_DMA(A->blist[it + 2], s2_); }
#if ASEL16
    asel_coltile16<0>(p, t0, A->q[w], A, xch, stage, b, cur, q0, 8 * w, c31, lane); asel_coltile16<1>(p, t1, A->q[w], A, xch, stage, b, cur, q0, 8 * w, c31, lane);
#else
    asel_coltile(p, st0, A->q[w], A, xch, stage, b, cur, q0, 8 * w, h, c31, lane);
#endif
    stage = (stage == 2) ? 0 : stage + 1;
  }
  asm volatile("s_waitcnt vmcnt(0)" ::: "memory");
#if ASEL16
  if (STORE) { asel_store16<0>(p, t0, xch, q0, 8 * w, g, lane); asel_store16<1>(p, t1, xch, q0, 8 * w, g, lane); } else asm volatile("" :: "v"(t0.o0[0]), "v"(t1.o1[2]), "v"(t0.l), "v"(t1.l));
#else
  if (STORE) asel_store(p, st0, xch, q0, 8 * w, g, lane); else asm volatile("" :: "v"(st0.o0[0]), "v"(st0.o1[5]), "v"(st0.l));
#endif
#undef ASEL_DMA
}
struct AselW { unsigned short k[4][4096]; unsigned short v[4][4096]; unsigned sel[32][8]; unsigned anyw[4][8]; int nl[4]; int pad[4]; unsigned char wl[4][256]; float xch[4][32]; unsigned char bkt[1664]; float relS[256]; };
__device__ __forceinline__ void glds16_s(const void* sbase, unsigned voff, unsigned lds_dst) {
  unsigned keep; asm volatile("s_mov_b32 %0, m0\n\ts_mov_b32 m0, %3\n\ts_nop 0\n\tglobal_load_lds_dwordx4 %2, %1\n\ts_mov_b32 m0, %0" : "=&s"(keep) : "s"(sbase), "v"(voff), "s"(lds_dst) : "memory");
}
struct AwOff { unsigned o[8]; };
__device__ __forceinline__ void aw_dma8(const void* sbase, const AwOff& f, unsigned lds) {
  asm volatile(
    "s_nop 4\n\t"
    "s_mov_b32 m0, %9\n\ts_nop 0\n\tglobal_load_lds_dwordx4 %1, %0\n\t"
    "s_add_u32 m0, %9, 0x400\n\ts_nop 0\n\tglobal_load_lds_dwordx4 %2, %0\n\t"
    "s_add_u32 m0, %9, 0x800\n\ts_nop 0\n\tglobal_load_lds_dwordx4 %3, %0\n\t"
    "s_add_u32 m0, %9, 0xc00\n\ts_nop 0\n\tglobal_load_lds_dwordx4 %4, %0\n\t"
    "s_add_u32 m0, %9, 0x1000\n\ts_nop 0\n\tglobal_load_lds_dwordx4 %5, %0\n\t"
    "s_add_u32 m0, %9, 0x1400\n\ts_nop 0\n\tglobal_load_lds_dwordx4 %6, %0\n\t"
    "s_add_u32 m0, %9, 0x1800\n\ts_nop 0\n\tglobal_load_lds_dwordx4 %7, %0\n\t"
    "s_add_u32 m0, %9, 0x1c00\n\ts_nop 0\n\tglobal_load_lds_dwordx4 %8, %0"
    :: "s"(sbase), "v"(f.o[0]), "v"(f.o[1]), "v"(f.o[2]), "v"(f.o[3]), "v"(f.o[4]), "v"(f.o[5]), "v"(f.o[6]), "v"(f.o[7]), "s"(lds) : "memory", "m0", "scc");
}
template <int CT, bool far>
__device__ __forceinline__ void aw_softmax(Asel16& S_, f32x4_t (&sc)[4], const AselW* A, const float* rel, float* xch, bool selq, bool edge, int q, int b, float c31, int lane) {
  const int j = lane & 15, q4 = lane >> 4;
  float qs, bb;
  if (far) { qs = selq ? QSC : 0.f; bb = selq ? c31 : NINF; }
  else { qs = 1.f; bb = 0.f;
    int bi[4][4]; float be[4][4]; const int d0 = q - (b * 64 + 4 * q4);
#pragma unroll
    for (int kt = 0; kt < 4; ++kt) {
#pragma unroll
      for (int r = 0; r < 4; ++r) { const int dist = d0 - (16 * kt + r); const int dc = dist < 0 ? 0 : (dist > 1663 ? 1663 : dist); bi[kt][r] = A->bkt[dc]; } }
#pragma unroll
    for (int kt = 0; kt < 4; ++kt) asm volatile("" : "+v"(bi[kt][0]), "+v"(bi[kt][1]), "+v"(bi[kt][2]), "+v"(bi[kt][3]));
#pragma unroll
    for (int kt = 0; kt < 4; ++kt) {
#pragma unroll
      for (int r = 0; r < 4; ++r) be[kt][r] = rel[bi[kt][r] * 4 + (j & 3)]; }
#pragma unroll
    for (int kt = 0; kt < 4; ++kt) asm volatile("" : "+v"(be[kt][0]), "+v"(be[kt][1]), "+v"(be[kt][2]), "+v"(be[kt][3]));
#pragma unroll
    for (int kt = 0; kt < 4; ++kt) {
#pragma unroll
      for (int r = 0; r < 4; ++r) { const int dist = d0 - (16 * kt + r); float v = __builtin_fmaf(sc[kt][r], QSC, be[kt][r]); if (!selq || (edge && dist < 0)) v = NINF; sc[kt][r] = v; } }
  }
  float mr = fmaxf(fmaxf(sc[0][0], sc[0][1]), fmaxf(sc[0][2], sc[0][3]));
#pragma unroll
  for (int kt = 1; kt < 4; ++kt) mr = fmaxf(mr, fmaxf(fmaxf(sc[kt][0], sc[kt][1]), fmaxf(sc[kt][2], sc[kt][3])));
  float mx = far ? __builtin_fmaf(mr, qs, bb) : mr;
  mx = quadmax_f(mx);
  if (__any(mx > S_.m + FTHR)) {
    const float mn = (mx > S_.m + FTHR) ? mx : S_.m;
    const float al = __builtin_amdgcn_exp2f(S_.m - mn); S_.m = mn; S_.l *= al; xch[16 * CT + j] = al;
    const f32x4_t a = *(const f32x4_t*)&xch[16 * CT + 4 * q4];
    S_.o0 *= a; S_.o1 *= a; S_.o2 *= a; S_.o3 *= a; }
  const float bm = bb - S_.m; float ps[4];
#pragma unroll
  for (int kt = 0; kt < 4; ++kt) {
#pragma unroll
    for (int r = 0; r < 4; ++r) { const float e_ = __builtin_amdgcn_exp2f(__builtin_fmaf(sc[kt][r], qs, bm)); sc[kt][r] = e_; ps[kt] = r ? ps[kt] + e_ : e_; } }
  S_.l += (ps[0] + ps[1]) + (ps[2] + ps[3]);
}
template <bool A0, bool A1, bool far, bool HOT>
__device__ __forceinline__ void aw_step(Asel16& t0, Asel16& t1, AselW* A, int w, const bf16x8& qa0, const bf16x8& qa1, const bf16x8& qb0, const bf16x8& qb1, bool selq0, bool selq1,
                                        int b, bool more, int nb, int q0w, int cur, float c31, const float* rel, const SB* kvb, unsigned ldsk, unsigned ldsv, const AwOff& fk, const AwOff& fv, int lane) {
  const int j = lane & 15, q4 = lane >> 4;
  const bool edge = (b == cur);
  float* xch = A->xch[w];
  asm volatile("s_waitcnt vmcnt(8)" ::: "memory");
  f32x4_t sa[4], sb[4];
  { bf16x8 k0[4], k1[4];
#pragma unroll
    for (int kt = 0; kt < 4; ++kt) { const int row = 16 * kt + j;
      k0[kt] = *(const bf16x8*)&A->k[w][row * 64 + (((q4) ^ ((row >> 1) & 7)) * 8)]; k1[kt] = *(const bf16x8*)&A->k[w][row * 64 + (((4 + q4) ^ ((row >> 1) & 7)) * 8)]; }
    asm volatile("s_waitcnt lgkmcnt(0)" ::: "memory");
    if (more && !HOT) aw_dma8(kvb + (long)nb * 64 * NPROJ, fk, ldsk);
#pragma unroll
    for (int kt = 0; kt < 4; ++kt) { const f32x4_t z = {0.f, 0.f, 0.f, 0.f};
      if (A0) { sa[kt] = MFMA16(k0[kt], qa0, z); sa[kt] = MFMA16(k1[kt], qa1, sa[kt]); }
      if (A1) { sb[kt] = MFMA16(k0[kt], qb0, z); sb[kt] = MFMA16(k1[kt], qb1, sb[kt]); } } }
  if (A0) aw_softmax<0, far>(t0, sa, A, rel, xch, selq0, edge, q0w + (j >> 2), b, c31, lane);
  if (A1) aw_softmax<1, far>(t1, sb, A, rel, xch, selq1, edge, q0w + 4 + (j >> 2), b, c31, lane);
  bf16x8 pa0, pa1, pb0, pb1;
  if (A0) { pa0 = pack44(sa[0], sa[1]); pa1 = pack44(sa[2], sa[3]); }
  if (A1) { pb0 = pack44(sb[0], sb[1]); pb1 = pack44(sb[2], sb[3]); }
  if (more) asm volatile("s_waitcnt vmcnt(8)" ::: "memory"); else asm volatile("s_waitcnt vmcnt(0)" ::: "memory");
  const unsigned short* vb0 = A->v[w] + (4 * q4 + (j >> 2)) * 32 + (j & 3) * 4 + (q4 & 1) * 16; const unsigned short* vb1 = vb0 + 16 - (q4 & 1) * 32;
#pragma unroll
  for (int c = 0; c < 2; ++c) {
#pragma unroll
    for (int dt = 0; dt < 4; ++dt) {
      const unsigned short* vb = (dt & 1) ? vb1 : vb0;
      const v4i16_t lo = __builtin_amdgcn_ds_read_tr16_b64_v4i16((LDS3 v4i16_t*)(vb + (dt >> 1) * 2048 + c * 1024));
      const v4i16_t hh = __builtin_amdgcn_ds_read_tr16_b64_v4i16((LDS3 v4i16_t*)(vb + (dt >> 1) * 2048 + c * 1024 + 512));
      const bf16x8 vf = {lo[0], lo[1], lo[2], lo[3], hh[0], hh[1], hh[2], hh[3]};
      if (A0) { const bf16x8 pa = c ? pa1 : pa0; if (dt == 0) t0.o0 = MFMA16(pa, vf, t0.o0); else if (dt == 1) t0.o1 = MFMA16(pa, vf, t0.o1); else if (dt == 2) t0.o2 = MFMA16(pa, vf, t0.o2); else t0.o3 = MFMA16(pa, vf, t0.o3); }
      if (A1) { const bf16x8 pb = c ? pb1 : pb0; if (dt == 0) t1.o0 = MFMA16(pb, vf, t1.o0); else if (dt == 1) t1.o1 = MFMA16(pb, vf, t1.o1); else if (dt == 2) t1.o2 = MFMA16(pb, vf, t1.o2); else t1.o3 = MFMA16(pb, vf, t1.o3); }
    }
  }
  asm volatile("s_waitcnt lgkmcnt(0)" ::: "memory");
  if (more && !HOT) aw_dma8(kvb + (long)nb * 64 * NPROJ, fv, ldsv);
}
__device__ __forceinline__ void asel_w_tables(const Params& p, AselW* A) {
  const int tid = threadIdx.x;
  for (int i = tid; i < 1664; i += 256) A->bkt[i] = (unsigned char)t5_bucket(i);
  A->relS[tid] = p.rel_bias[((tid & 127) >> 2) * 32 + (tid >> 7) * 4 + (tid & 3)] * L2E;
}
template <bool STORE = true, bool HOT = false, bool NLZ = false>
__device__ __forceinline__ void asel_w_wave(const Params& p, int g, int q0w, AselW* A, int w, int lane) {
  const int j = lane & 15, q4 = lane >> 4; const int cur = q0w >> 6; const float* rel = A->relS + g * 128;
  const SB* kvb = p.proj + PA_KV + 2 * 128 + g * 64;
  A->sel[8 * w + (lane >> 3)][lane & 7] = 0u;
  asm volatile("s_waitcnt lgkmcnt(0)" ::: "memory");
  topk4_rows_o(p, [&](int r) { return (q0w + r) * 2 + g; }, [&](int r, int b) { if (b >= 0) atomicOr(&A->sel[8 * w + r][b >> 5], 1u << (b & 31)); }, lane);
  topk4_rows_o(p, [&](int r) { return (q0w + 4 + r) * 2 + g; }, [&](int r, int b) { if (b >= 0) atomicOr(&A->sel[8 * w + 4 + r][b >> 5], 1u << (b & 31)); }, lane);
  asm volatile("s_waitcnt lgkmcnt(0)" ::: "memory");
  if (lane < 8) { unsigned o = 0u;
#pragma unroll
    for (int r = 0; r < 8; ++r) o |= A->sel[8 * w + r][lane];
    A->anyw[w][lane] = o; }
  asm volatile("s_waitcnt lgkmcnt(0)" ::: "memory");
  { const unsigned wbits = A->anyw[w][lane >> 3]; const unsigned nib = (wbits >> ((lane & 7) * 4)) & 15u; const int cnt = __popc(nib);
    int pre = cnt;
#pragma unroll
    for (int o = 1; o < 64; o <<= 1) { const int v = __shfl_up(pre, o); if (lane >= o) pre += v; }
    int pos = pre - cnt;
#pragma unroll
    for (int k = 0; k < 4; ++k) if ((nib >> k) & 1u) A->wl[w][pos++] = (unsigned char)(lane * 4 + k);
    if (lane == 63) A->nl[w] = pre; }
  asm volatile("s_waitcnt lgkmcnt(0)" ::: "memory");
  const int hq = g * 4 + (lane & 3); const float c31 = p.tabA[hq * TABA_N + 2047] * L2E;
  const SB* qpa = p.proj + (long)(q0w + (j >> 2)) * NPROJ + PA_Q + hq * 64 + 8 * q4; const SB* qpb = qpa + 4L * NPROJ;
  const bf16x8 qa0 = *(const GLB1 bf16x8*)qpa, qa1 = *(const GLB1 bf16x8*)(qpa + 32), qb0 = *(const GLB1 bf16x8*)qpb, qb1 = *(const GLB1 bf16x8*)(qpb + 32);
  Asel16 t0, t1;
  { const f32x4_t z4 = {0.f, 0.f, 0.f, 0.f}; t0.o0 = z4; t0.o1 = z4; t0.o2 = z4; t0.o3 = z4; t0.m = -1e30f; t0.l = 0.f; t1 = t0; }
  AwOff fk, fv;
#pragma unroll
  for (int pk = 0; pk < 8; ++pk) { fk.o[pk] = (unsigned)((pk * 8 + (lane >> 3)) * NPROJ * 2 + (((lane & 7) ^ (lane >> 4) ^ ((pk & 1) * 4)) * 16));
    fv.o[pk] = (unsigned)(256 + ((pk & 3) * 16 + (lane >> 2)) * NPROJ * 2 + (pk >> 2) * 64 + (((lane & 3) ^ (((lane >> 4) & 1) << 1)) * 16)); }
  const unsigned ldsk = (unsigned)__builtin_amdgcn_readfirstlane((int)lds_addr(&A->k[w][0])), ldsv = (unsigned)__builtin_amdgcn_readfirstlane((int)lds_addr(&A->v[w][0]));
  const int nl = NLZ ? 0 : __builtin_amdgcn_readfirstlane(A->nl[w]);
  asm volatile("s_waitcnt vmcnt(0) lgkmcnt(0)" ::: "memory");
  if (nl > 0) { const int b0 = __builtin_amdgcn_readfirstlane((int)A->wl[w][0]); aw_dma8(kvb + (long)b0 * 64 * NPROJ, fk, ldsk); aw_dma8(kvb + (long)b0 * 64 * NPROJ, fv, ldsv); }
  int b = __builtin_amdgcn_readfirstlane((int)A->wl[w][0]), nb = __builtin_amdgcn_readfirstlane((int)A->wl[w][1]);
  unsigned sw0 = A->sel[8 * w + (j >> 2)][b >> 5], sw1 = A->sel[8 * w + 4 + (j >> 2)][b >> 5];
  for (int i = 0; i < nl; ++i) {
    const bool more = i + 1 < nl;
    const unsigned nsw0 = *(volatile unsigned*)&A->sel[8 * w + (j >> 2)][nb >> 5], nsw1 = *(volatile unsigned*)&A->sel[8 * w + 4 + (j >> 2)][nb >> 5];
    const unsigned nnbv = *(volatile unsigned char*)&A->wl[w][(i + 2) & 255];
    const bool selq0 = (sw0 >> (b & 31)) & 1u, selq1 = (sw1 >> (b & 31)) & 1u;
    const bool a0 = __any(selq0), a1 = __any(selq1);
    const bool far = (q0w - (b * 64 + 63)) >= 1513;
    if (far) {
      if (a0 && a1) aw_step<true, true, true, HOT>(t0, t1, A, w, qa0, qa1, qb0, qb1, selq0, selq1, b, more, nb, q0w, cur, c31, rel, kvb, ldsk, ldsv, fk, fv, lane);
      else if (a0) aw_step<true, false, true, HOT>(t0, t1, A, w, qa0, qa1, qb0, qb1, selq0, selq1, b, more, nb, q0w, cur, c31, rel, kvb, ldsk, ldsv, fk, fv, lane);
      else aw_step<false, true, true, HOT>(t0, t1, A, w, qa0, qa1, qb0, qb1, selq0, selq1, b, more, nb, q0w, cur, c31, rel, kvb, ldsk, ldsv, fk, fv, lane);
    } else {
      if (a0 && a1) aw_step<true, true, false, HOT>(t0, t1, A, w, qa0, qa1, qb0, qb1, selq0, selq1, b, more, nb, q0w, cur, c31, rel, kvb, ldsk, ldsv, fk, fv, lane);
      else if (a0) aw_step<true, false, false, HOT>(t0, t1, A, w, qa0, qa1, qb0, qb1, selq0, selq1, b, more, nb, q0w, cur, c31, rel, kvb, ldsk, ldsv, fk, fv, lane);
      else aw_step<false, true, false, HOT>(t0, t1, A, w, qa0, qa1, qb0, qb1, selq0, selq1, b, more, nb, q0w, cur, c31, rel, kvb, ldsk, ldsv, fk, fv, lane);
    }
    b = nb; sw0 = nsw0; sw1 = nsw1; nb = __builtin_amdgcn_readfirstlane((int)nnbv);
  }
  asm volatile("s_waitcnt vmcnt(0)" ::: "memory");
  float* xch = A->xch[w];
  if (STORE) { asel_store16<0>(p, t0, xch, q0w, 0, g, lane); asel_store16<1>(p, t1, xch, q0w, 0, g, lane); } else asm volatile("" :: "v"(t0.o0[0]), "v"(t1.o1[2]), "v"(t0.l), "v"(t1.l));
}
template <bool STORE = true, bool HOT = false, bool NLZ = false>
__device__ __forceinline__ void unit_asel_w(const Params& p, int u, AselW* A) {
  int tid = threadIdx.x; asm volatile("" : "+v"(tid));
  const int lane = tid & 63, w = __builtin_amdgcn_readfirstlane(tid >> 6);
  __syncthreads(); asel_w_tables(p, A); __syncthreads();
  asel_w_wave<STORE, HOT, NLZ>(p, u & 1, ((p.S / 32 - 1) - (u >> 1)) * 32 + 8 * w, A, w, lane);
}
template <bool STORE = true>
__device__ __forceinline__ void unit_bout_blk(const Params& p, int layer, int ub, char* smem) {
  int tid = threadIdx.x; asm volatile("" : "+v"(tid));
  const int lane = tid & 63, w = __builtin_amdgcn_readfirstlane(tid >> 6), r32 = lane & 31, hi = lane >> 5;
  const int lt = ub & 3, g = (ub >> 2) & 1, c = ub >> 3, hd = g * 4 + w;
  WaveLds2* L = ((WaveLds2*)smem) + w;
  __syncthreads();
  for (int x = lane; x < 128; x += 64) { L->acs[x] = p.acs[((long)c * 128 + x) * 8 + hd]; L->dtv[x] = p.dt[((long)c * 128 + x) * 8 + hd]; }
  f32x16 acc[2] = {zero16(), zero16()}, acc2[2] = {zero16(), zero16()};
  const SB* xb = p.xconv + (long)c * 128 * 1024; const int l = 32 * lt + r32; const float al = p.acs[((long)c * 128 + l) * 8 + hd];
  const float* cbr = p.cb + ((long)c * 2 + g) * 16384 + (long)l * 128;
  for (int sc = 0; sc <= lt; ++sc) {
    stage_slab<false>(L->x, xb + (long)(32 * sc) * 1024 + hd * 64, 1024, [&](int) { return 1.f; }, lane);
#pragma unroll
    for (int s2 = 0; s2 < 2; ++s2) { float mv[8];
#pragma unroll
      for (int jj = 0; jj < 2; ++jj) { const int s0 = 32 * sc + 16 * s2 + 8 * jj + 4 * hi; const f32x4_t cv4 = *(const GLB1 f32x4_t*)(cbr + s0); const float4 cv = make_float4(cv4[0], cv4[1], cv4[2], cv4[3]); const float4 av = *(const float4*)(&L->acs[s0]); const float4 dv = *(const float4*)(&L->dtv[s0]);
        mv[4 * jj + 0] = (s0 + 0 <= l) ? cv.x * __expf(al - av.x) * dv.x : 0.f; mv[4 * jj + 1] = (s0 + 1 <= l) ? cv.y * __expf(al - av.y) * dv.y : 0.f;
        mv[4 * jj + 2] = (s0 + 2 <= l) ? cv.z * __expf(al - av.z) * dv.z : 0.f; mv[4 * jj + 3] = (s0 + 3 <= l) ? cv.w * __expf(al - av.w) * dv.w : 0.f; }
      u32x4 aw; aw[0] = pk2(mv[0], mv[1]); aw[1] = pk2(mv[2], mv[3]); aw[2] = pk2(mv[4], mv[5]); aw[3] = pk2(mv[6], mv[7]); const bf16x8 af = __builtin_bit_cast(bf16x8, aw);
#pragma unroll
      for (int pt = 0; pt < 2; ++pt) acc[pt] = MFMA32(af, slab_frag(L->x, pt, s2, lane), acc[pt]); } }
  const SB* cmr = xb + (long)l * 1024 + 768 + g * 128; const float* prv = p.states + ((long)c * 8 + hd) * 8192;
#pragma unroll 2
  for (int ks = 0; ks < 8; ++ks) { const bf16x8 af = *(const GLB1 bf16x8*)(cmr + 16 * ks + 8 * hi);
#pragma unroll
    for (int pt = 0; pt < 2; ++pt) { const float* pr = prv + (long)(32 * pt + r32) * 128 + 16 * ks + 8 * hi; const f32x4_t a0 = *(const GLB1 f32x4_t*)pr, a1 = *(const GLB1 f32x4_t*)(pr + 4);
      u32x4 bw; bw[0] = pk2(a0[0], a0[1]); bw[1] = pk2(a0[2], a0[3]); bw[2] = pk2(a1[0], a1[1]); bw[3] = pk2(a1[2], a1[3]);
      acc2[pt] = MFMA32(af, __builtin_bit_cast(bf16x8, bw), acc2[pt]); } }
  const float dsk = p.b_d[layer * 8 + hd];
  float* yl = (float*)L;
  SB xsk[16][2];
#pragma unroll
  for (int e = 0; e < 16; ++e) { const int lr = crow(e, hi);
#pragma unroll
    for (int pt = 0; pt < 2; ++pt) xsk[e][pt] = *(const GLB1 SB*)&xb[(long)(32 * lt + lr) * 1024 + hd * 64 + 32 * pt + r32]; }
#pragma unroll
  for (int e = 0; e < 16; ++e) { const int lr = crow(e, hi); const float ea = __expf(L->acs[32 * lt + lr]);
#pragma unroll
    for (int pt = 0; pt < 2; ++pt) { const int pp = 32 * pt + r32; yl[lr * 64 + pp] = acc[pt][e] + ea * acc2[pt][e] + dsk * bf2f(xsk[e][pt]); } }
  __syncthreads();
  { const int row = tid >> 3, sub = tid & 7; const long t = (long)c * 128 + 32 * lt + row; SB* mp = p.mix + t * NMIX + MX_B + g * 256 + sub * 32;
    const float* ysrc = (const float*)(((WaveLds2*)smem) + (sub >> 1)) + row * 64 + (sub & 1) * 32;
    float vv[32]; float ss = 0.f;
#pragma unroll
    for (int i = 0; i < 4; ++i) { const uint4 zz = *(const uint4*)(mp + 8 * i); const unsigned zw[4] = {zz.x, zz.y, zz.z, zz.w};
#pragma unroll
      for (int k = 0; k < 4; ++k) { const float y0 = ysrc[8 * i + 2 * k] * __uint_as_float(zw[k] << 16), y1 = ysrc[8 * i + 2 * k + 1] * __uint_as_float(zw[k] & 0xffff0000u); vv[8 * i + 2 * k] = y0; vv[8 * i + 2 * k + 1] = y1; ss += y0 * y0 + y1 * y1; } }
    ss += __shfl_xor(ss, 1); ss += __shfl_xor(ss, 2); ss += __shfl_xor(ss, 4);
    const float r = 1.f / sqrtf(ss * (1.f / 256.f) + 1e-6f); const float* wn = p.b_norm + layer * 512 + g * 256 + sub * 32;
#pragma unroll
    for (int i = 0; i < 4; ++i) { uint4 o; o.x = pk2(vv[8 * i] * r * wn[8 * i], vv[8 * i + 1] * r * wn[8 * i + 1]); o.y = pk2(vv[8 * i + 2] * r * wn[8 * i + 2], vv[8 * i + 3] * r * wn[8 * i + 3]);
      o.z = pk2(vv[8 * i + 4] * r * wn[8 * i + 4], vv[8 * i + 5] * r * wn[8 * i + 5]); o.w = pk2(vv[8 * i + 6] * r * wn[8 * i + 6], vv[8 * i + 7] * r * wn[8 * i + 7]); if (STORE) *(uint4*)(mp + 8 * i) = o; else asm volatile("" :: "v"(o.x), "v"(o.w)); } }
}

__device__ __forceinline__ void unit_memkv(const Params& p, int u2, int lane) {
  const int hf = u2 & 1, u = u2 >> 1; const int l = u >> 8, m = u & 255; const float* row = p.mem + (long)m * DM; const float* nw = p.m_norm + l * DM; const float* w = p.m_wkv + (long)l * DM * 512 + hf * 256 + lane * 4;
  float ss = 0.f;
#pragma unroll
  for (int i = 0; i < 4; ++i) { const float4 v = *(const float4*)(row + i * 256 + lane * 4); ss += v.x * v.x + v.y * v.y + v.z * v.z + v.w * v.w; }
  ss = wave_sum_f(ss); const float r = 1.f / sqrtf(ss * (1.f / DM) + 1e-6f);
  float acc[4] = {0.f, 0.f, 0.f, 0.f};
#pragma unroll 16
  for (int d = 0; d < DM; ++d) { const float a = row[d] * r * nw[d]; const float4 w0 = *(const float4*)(w + (long)d * 512);
    acc[0] += a * w0.x; acc[1] += a * w0.y; acc[2] += a * w0.z; acc[3] += a * w0.w; }
  uint2 o; o.x = pk2(acc[0], acc[1]); o.y = pk2(acc[2], acc[3]);
  *(uint2*)(p.memkv + (long)u * 512 + hf * 256 + lane * 4) = o;
}

__device__ __forceinline__ void item_dmerge(const Params& p, long gid) {
  const int c8 = (int)(gid & 63), h = c8 >> 3; const long q = gid >> 6; const long S = p.S;
  const long c = q * 512 + c8 * 8; SB* mp = p.mix + q * NMIX + MX_D + c8 * 8;
  const u32x4 ga = *(const GLB1 u32x4*)(p.dop + c), gb = *(const GLB1 u32x4*)(p.dop + S * 512 + c), gd = *(const GLB1 u32x4*)(p.dop + 2 * S * 512 + c), gz = *(const GLB1 u32x4*)mp;
  const float l0 = *(const GLB1 float*)&p.dlse[(0 * S + q) * 8 + h], l1 = *(const GLB1 float*)&p.dlse[(1 * S + q) * 8 + h], l2 = *(const GLB1 float*)&p.dlse[(2 * S + q) * 8 + h];
  const float mm = fmaxf(l0, fmaxf(l1, l2)); float e0 = __expf(l0 - mm), e1 = __expf(l1 - mm), e2 = __expf(l2 - mm); const float is = __builtin_amdgcn_rcpf(e0 + e1 + e2); e0 *= is; e1 *= is; e2 *= is;
  uint4 a, b, d, z; a.x = ga[0]; a.y = ga[1]; a.z = ga[2]; a.w = ga[3]; b.x = gb[0]; b.y = gb[1]; b.z = gb[2]; b.w = gb[3]; d.x = gd[0]; d.y = gd[1]; d.z = gd[2]; d.w = gd[3]; z.x = gz[0]; z.y = gz[1]; z.z = gz[2]; z.w = gz[3];
  const unsigned aw[4] = {a.x, a.y, a.z, a.w}, bw[4] = {b.x, b.y, b.z, b.w}, dw[4] = {d.x, d.y, d.z, d.w}, zw[4] = {z.x, z.y, z.z, z.w}; unsigned ow[4];
#pragma unroll
  for (int k = 0; k < 4; ++k) {
    const float lo = (e0 * __uint_as_float(aw[k] << 16) + e1 * __uint_as_float(bw[k] << 16) + e2 * __uint_as_float(dw[k] << 16)) * __uint_as_float(zw[k] << 16);
    const float hi = (e0 * __uint_as_float(aw[k] & 0xffff0000u) + e1 * __uint_as_float(bw[k] & 0xffff0000u) + e2 * __uint_as_float(dw[k] & 0xffff0000u)) * __uint_as_float(zw[k] & 0xffff0000u);
    ow[k] = pk2(lo, hi); }
  uint4 o; o.x = ow[0]; o.y = ow[1]; o.z = ow[2]; o.w = ow[3]; *(uint4*)mp = o;
}

__device__ __forceinline__ void unit_cmp_blk(const Params& p, int layer, int u, float* red  ) {
  int tid = threadIdx.x; asm volatile("" : "+v"(tid));
  const int lane = tid & 63, w = __builtin_amdgcn_readfirstlane(tid >> 6), r32 = lane & 31, hi = lane >> 5;
  const int ncmp = p.S / 16, ntile = ncmp * 2 / 32; const int kv = u / ntile, rt = u % ntile;
  const int r = 32 * rt + r32, j = r >> 1, hk = r & 1;
  const unsigned short* w1t = p.w1t + (long)kv * 128 * 2048; const unsigned short* w2t = p.w2t + kv * 64 * 128; const float* pe = p.cmp_pos + (long)(layer * 2 + kv) * 32 * 64;
  const SB* src = p.proj + PA_KV + kv * 128 + hk * 64;
  f32x16 acc[4] = {zero16(), zero16(), zero16(), zero16()};
  typedef float f32x4g __attribute__((ext_vector_type(4)));
  f32x4g p0n, p1n; u32x4 vvn; bf16x8 afn[4]; float vmn;
#define CMPB_LOAD(ks_) { const int t_ = (ks_) >> 2, d_ = ((ks_) & 3) * 16 + 8 * hi; const long tok_ = 16 * j + t_; const long tokc_ = tok_ < p.S ? tok_ : (long)p.S - 1; vmn = tok_ < p.S ? 1.f : 0.f; \
    p0n = *(const GLB1 f32x4g*)(pe + t_ * 64 + d_); p1n = *(const GLB1 f32x4g*)(pe + t_ * 64 + d_ + 4); vvn = *(const GLB1 u32x4*)(src + tokc_ * NPROJ + d_); \
    _Pragma("unroll") for (int ut_ = 0; ut_ < 4; ++ut_) afn[ut_] = *(const GLB1 bf16x8*)(w1t + (long)(32 * ut_ + r32) * 2048 + 16 * (ks_) + 8 * hi); }
  CMPB_LOAD(32 * w)
#pragma unroll 2
  for (int ks = 32 * w; ks < 32 * w + 32; ++ks) {
    const f32x4g p0 = p0n, p1 = p1n; const u32x4 vv = vvn; const float vm = vmn; bf16x8 af[4];
#pragma unroll
    for (int ut = 0; ut < 4; ++ut) af[ut] = afn[ut];
    { const int kn = (ks + 1 < 32 * w + 32) ? ks + 1 : ks; CMPB_LOAD(kn) }
    float v[8] = {p0[0], p0[1], p0[2], p0[3], p1[0], p1[1], p1[2], p1[3]};
#pragma unroll
    for (int k = 0; k < 4; ++k) { v[2 * k] += vm * __uint_as_float(vv[k] << 16); v[2 * k + 1] += vm * __uint_as_float(vv[k] & 0xffff0000u); }
    u32x4 bw; bw[0] = pk2(v[0], v[1]); bw[1] = pk2(v[2], v[3]); bw[2] = pk2(v[4], v[5]); bw[3] = pk2(v[6], v[7]); const bf16x8 bfr = __builtin_bit_cast(bf16x8, bw);
#pragma unroll
    for (int ut = 0; ut < 4; ++ut) acc[ut] = MFMA32(af[ut], bfr, acc[ut]); }
#undef CMPB_LOAD
  __syncthreads();
#pragma unroll
  for (int ut = 0; ut < 4; ++ut)
#pragma unroll
    for (int q4 = 0; q4 < 4; ++q4) *(float4*)&red[(((w * 4 + ut) * 4 + q4) * 64 + lane) * 4] = make_float4(acc[ut][4 * q4], acc[ut][4 * q4 + 1], acc[ut][4 * q4 + 2], acc[ut][4 * q4 + 3]);
  __syncthreads();
  f32x16 hsum = zero16();
#pragma unroll
  for (int w2 = 0; w2 < 4; ++w2)
#pragma unroll
    for (int q4 = 0; q4 < 4; ++q4) { const float4 t4 = *(const float4*)&red[(((w2 * 4 + w) * 4 + q4) * 64 + lane) * 4]; hsum[4 * q4] += t4.x; hsum[4 * q4 + 1] += t4.y; hsum[4 * q4 + 2] += t4.z; hsum[4 * q4 + 3] += t4.w; }
#pragma unroll
  for (int e = 0; e < 16; ++e) hsum[e] = gelu_fast(hsum[e]);
  f32x16 o2[2] = {zero16(), zero16()};
#pragma unroll
  for (int s2 = 0; s2 < 2; ++s2) { const bf16x8 hb = pack8(hsum, 8 * s2);
#pragma unroll
    for (int dt = 0; dt < 2; ++dt) { const unsigned short* wr = w2t + (32 * dt + r32) * 128 + 32 * w + 16 * s2 + 4 * hi; const uint2 x0 = *(const uint2*)wr, x1 = *(const uint2*)(wr + 8);
      u32x4 aw; aw[0] = x0.x; aw[1] = x0.y; aw[2] = x1.x; aw[3] = x1.y; o2[dt] = MFMA32(__builtin_bit_cast(bf16x8, aw), hb, o2[dt]); } }
  __syncthreads();
#pragma unroll
  for (int dt = 0; dt < 2; ++dt)
#pragma unroll
    for (int q4 = 0; q4 < 4; ++q4) *(float4*)&red[(((w * 2 + dt) * 4 + q4) * 64 + lane) * 4] = make_float4(o2[dt][4 * q4], o2[dt][4 * q4 + 1], o2[dt][4 * q4 + 2], o2[dt][4 * q4 + 3]);
  __syncthreads();
  if (w < 2) {
    const int dt = w; SB* dst = p.kvc + ((long)kv * ncmp * 2 + r) * 64;
#pragma unroll
    for (int q4 = 0; q4 < 4; ++q4) { float4 s4 = make_float4(0.f, 0.f, 0.f, 0.f);
#pragma unroll
      for (int w2 = 0; w2 < 4; ++w2) { const float4 t4 = *(const float4*)&red[(((w2 * 2 + dt) * 4 + q4) * 64 + lane) * 4]; s4.x += t4.x; s4.y += t4.y; s4.z += t4.z; s4.w += t4.w; }
      dst[32 * dt + crow(4 * q4 + 0, hi)] = f2bf(s4.x); dst[32 * dt + crow(4 * q4 + 1, hi)] = f2bf(s4.y); dst[32 * dt + crow(4 * q4 + 2, hi)] = f2bf(s4.z); dst[32 * dt + crow(4 * q4 + 3, hi)] = f2bf(s4.w); } }
}

#define SEQ 16384
#define DEPTH 4

__device__ __forceinline__ int n2o(int n) {
  if (n < 1280) return n;
  if (n < 2304) return n - 1280 + 1816;
  if (n < 2816) return n - 2304 + 3360;
  if (n < 3072) return n - 2816 + 3872;
  if (n < 4608) return n - 3072 + 4640;
  if (n < 5632) return n - 4608 + 6176;
  if (n < 5888) return n - 5632 + 7712;
  n -= 5888;
  if (n < 512) return 1304 + n;
  if (n < 1024) return 2848 + n - 512;
  if (n < 1536) return 4128 + n - 1024;
  if (n < 2048) return 7200 + n - 1536;
  if (n < 2304) return 7968 + n - 2048;
  n -= 2304;
  if (n < 24) return 1280 + n;
  if (n < 32) return 2840 + n - 24;
  return -1;
}

template <bool MAP>
__device__ __forceinline__ void cvt_tile(const float* __restrict__ src, int lds_, unsigned short* __restrict__ dst, int ldd, int k0, int n0, float* tile  ) {
  int tid = threadIdx.x; asm volatile("" : "+v"(tid));
  __syncthreads();
  float v[16];
#pragma unroll
  for (int e = 0; e < 16; ++e) { int idx = tid + 256 * e, kk = idx >> 6, nn = idx & 63; int oc = MAP ? n2o(n0 + nn) : (n0 + nn); v[e] = src[(long)(k0 + kk) * lds_ + (oc < 0 ? 0 : oc)]; }
#pragma unroll
  for (int e = 0; e < 16; ++e) { int idx = tid + 256 * e, kk = idx >> 6, nn = idx & 63; int oc = MAP ? n2o(n0 + nn) : (n0 + nn); tile[kk * 65 + nn] = (oc >= 0) ? v[e] : 0.f; }
  __syncthreads();
#pragma unroll
  for (int e = 0; e < 16; ++e) { int idx = tid + 256 * e, nn = idx >> 6, kk = idx & 63; dst[(long)(n0 + nn) * ldd + k0 + kk] = f2bf(tile[kk * 65 + nn]); }
}

__device__ __forceinline__ float wave_sum(float v) {
#pragma unroll
  for (int o = 32; o > 0; o >>= 1) v += __shfl_xor(v, o);
  return v;
}

__device__ __forceinline__ void norm_row_wave(const Params& p, int layer, int t, bool do_h, int lane) {
  const float* xin = (layer == 0) ? p.x + (long)t * DM : p.out + (long)t * DM;
  float4 xv[4], yv[4];
#pragma unroll
  for (int i = 0; i < 4; ++i) xv[i] = *(const float4*)(xin + i * 256 + lane * 4);
  if (layer > 0) {
    float ss = 0.f;
#pragma unroll
    for (int i = 0; i < 4; ++i) { yv[i] = *(const float4*)(p.y + (long)t * DM + i * 256 + lane * 4); ss += yv[i].x * yv[i].x + yv[i].y * yv[i].y + yv[i].z * yv[i].z + yv[i].w * yv[i].w; }
    ss = wave_sum(ss); float r1 = 1.f / sqrtf(ss / DM + 1e-6f);
#pragma unroll
    for (int i = 0; i < 4; ++i) { float4 w = *(const float4*)(p.post_norm + (layer - 1) * DM + i * 256 + lane * 4);
      xv[i].x += yv[i].x * r1 * w.x; xv[i].y += yv[i].y * r1 * w.y; xv[i].z += yv[i].z * r1 * w.z; xv[i].w += yv[i].w * r1 * w.w; }
  }
  float ss2 = 0.f;
#pragma unroll
  for (int i = 0; i < 4; ++i) { *(float4*)(p.out + (long)t * DM + i * 256 + lane * 4) = xv[i]; ss2 += xv[i].x * xv[i].x + xv[i].y * xv[i].y + xv[i].z * xv[i].z + xv[i].w * xv[i].w; }
  if (!do_h) return;
  ss2 = wave_sum(ss2); float r2 = 1.f / sqrtf(ss2 / DM + 1e-6f);
#pragma unroll
  for (int i = 0; i < 4; ++i) { float4 w = *(const float4*)(p.pre_norm + layer * DM + i * 256 + lane * 4);
    ushort4 o; o.x = f2bf(xv[i].x * r2 * w.x); o.y = f2bf(xv[i].y * r2 * w.y); o.z = f2bf(xv[i].z * r2 * w.z); o.w = f2bf(xv[i].w * r2 * w.w);
    *(ushort4*)(p.h + (long)t * DM + i * 256 + lane * 4) = o; }
}

#ifndef GMI
#define GMI 4
#endif
struct GemmSmem { unsigned short a[3][64 * GMI * 32]; unsigned short b[3][128 * 32]; };
__device__ __forceinline__ void glds16(const void* g, void* lds_wave_base) { __builtin_amdgcn_global_load_lds((gptr_t)g, (lptr_t)lds_wave_base, 16, 0, 0); }
template <int EPI, int MI, bool DRY = false>
__device__ __forceinline__ void gemm_tile(const Params& p, const unsigned short* __restrict__ A, int lda, const unsigned short* __restrict__ Bt, int ldb, int K, int m0, int n0, GemmSmem& sm, float* outp = nullptr) {
  int tid = threadIdx.x; asm volatile("" : "+v"(tid));
  const int lane = tid & 63, wid = __builtin_amdgcn_readfirstlane(tid >> 6), wr = wid >> 1, wc = wid & 1, r = lane & 31, h = lane >> 5;
  f32x16 acc[MI][2];
#pragma unroll
  for (int i = 0; i < MI; ++i)
#pragma unroll
    for (int j = 0; j < 2; ++j) acc[i][j] = zero16();
  const int prow = lane >> 2, pc = lane & 3;
  const unsigned short* ga[MI]; const unsigned short* gb[2];
#pragma unroll
  for (int i = 0; i < MI; ++i) { const int row = (wid * MI + i) * 16 + prow; ga[i] = A + (long)(m0 + row) * lda + ((pc ^ ((row >> 2) & 3)) * 8); }
#pragma unroll
  for (int i = 0; i < 2; ++i) { const int row = (wid * 2 + i) * 16 + prow; gb[i] = Bt + (long)(n0 + row) * ldb + ((pc ^ ((row >> 2) & 3)) * 8); }
#define GEMM_DMA(stg, ko) { _Pragma("unroll") for (int i_ = 0; i_ < MI; ++i_) glds16(ga[i_] + (ko), &sm.a[stg][(wid * MI + i_) * 512]); _Pragma("unroll") for (int i_ = 0; i_ < 2; ++i_) glds16(gb[i_] + (ko), &sm.b[stg][(wid * 2 + i_) * 512]); }
  __syncthreads();
  const int nk = K / 32;
  GEMM_DMA(0, 0)
  if (nk > 1) GEMM_DMA(1, 32)
  int cur = 0;
  for (int kt = 0; kt < nk; ++kt) {
    if (kt + 1 < nk) { if (MI == 4) asm volatile("s_waitcnt vmcnt(6) lgkmcnt(0)\n\ts_barrier" ::: "memory"); else asm volatile("s_waitcnt vmcnt(4) lgkmcnt(0)\n\ts_barrier" ::: "memory"); }
    else asm volatile("s_waitcnt vmcnt(0) lgkmcnt(0)\n\ts_barrier" ::: "memory");
    if (kt + 2 < nk) { const int s2_ = (cur == 0) ? 2 : cur - 1; GEMM_DMA(s2_, (kt + 2) * 32) }
#pragma unroll
    for (int ks = 0; ks < 2; ++ks) {
      bf16x8 af[MI], bfr[2];
#pragma unroll
      for (int i = 0; i < MI; ++i) { const int row = wr * (32 * MI) + i * 32 + r; af[i] = *(const bf16x8*)&sm.a[cur][row * 32 + (((2 * ks + h) ^ ((row >> 2) & 3)) * 8)]; }
#pragma unroll
      for (int j = 0; j < 2; ++j) { const int row = wc * 64 + j * 32 + r; bfr[j] = *(const bf16x8*)&sm.b[cur][row * 32 + (((2 * ks + h) ^ ((row >> 2) & 3)) * 8)]; }
#pragma unroll
      for (int i = 0; i < MI; ++i)
#pragma unroll
        for (int j = 0; j < 2; ++j) acc[i][j] = __builtin_amdgcn_mfma_f32_32x32x16_bf16(af[i], bfr[j], acc[i][j], 0, 0, 0);
    }
    cur = (cur == 2) ? 0 : cur + 1;
  }
#undef GEMM_DMA
  __syncthreads();
  if (DRY) {
#pragma unroll
    for (int i = 0; i < MI; ++i) asm volatile("" :: "v"(acc[i][0]), "v"(acc[i][1]));
    return; }
  const int ncol0 = n0 + wc * 64;
  const int mrow0 = m0 + wr * (32 * MI);
  if (EPI == 2) {
#pragma unroll
    for (int i = 0; i < MI; ++i)
#pragma unroll
      for (int j = 0; j < 2; ++j)
#pragma unroll
        for (int e = 0; e < 16; ++e) { int row = mrow0 + i * 32 + (e & 3) + 8 * (e >> 2) + 4 * h; outp[row * 128 + ncol0 + j * 32 + r] = acc[i][j][e]; }
  } else if (EPI == 1) {
#pragma unroll
    for (int i = 0; i < MI; ++i)
#pragma unroll
      for (int j = 0; j < 2; ++j)
#pragma unroll
        for (int e = 0; e < 16; ++e) { int row = mrow0 + i * 32 + (e & 3) + 8 * (e >> 2) + 4 * h; p.y[(long)row * DM + ncol0 + j * 32 + r] = acc[i][j][e]; }
  } else {
    if (ncol0 < 8192) {
      const bool toproj = ncol0 < NPROJ; const bool rope = toproj && (ncol0 >= PC_Q && ncol0 < PC_KV + 128);
      unsigned short* stg = ((unsigned short*)&sm) + wid * (64 * 72);
      SB* gdst = toproj ? (p.proj + ncol0) : (p.mix + (ncol0 - NPROJ)); const long gld = toproj ? NPROJ : NMIX;
#pragma unroll
      for (int hf = 0; hf < MI / 2; ++hf) {
#pragma unroll
        for (int i2 = 0; i2 < 2; ++i2) { const int i = hf * 2 + i2;
          if (rope) {
            float cc[16], sn[16];
#pragma unroll
            for (int e = 0; e < 16; ++e) { const int row = mrow0 + hf * 64 + i2 * 32 + (e & 3) + 8 * (e >> 2) + 4 * h; cc[e] = p.rope_cs[row * 32 + r]; sn[e] = p.rope_sn[row * 32 + r]; }
#pragma unroll
            for (int e = 0; e < 16; ++e) { const float t1 = acc[i][0][e], t2 = acc[i][1][e]; acc[i][0][e] = t1 * cc[e] - t2 * sn[e]; acc[i][1][e] = t2 * cc[e] + t1 * sn[e]; } }
#pragma unroll
          for (int e = 0; e < 16; ++e) { const int rl = i2 * 32 + (e & 3) + 8 * (e >> 2) + 4 * h; float v0 = acc[i][0][e], v1 = acc[i][1][e];
            if (!toproj) { v0 = silu_fast(v0); v1 = silu_fast(v1); }
            stg[rl * 72 + r] = f2bf(v0); stg[rl * 72 + 32 + r] = f2bf(v1); } }
#pragma unroll
        for (int c8 = 0; c8 < 8; ++c8) { const int idx = lane + 64 * c8, rl = idx >> 3, ch = idx & 7; const uint4 vv = *(const uint4*)&stg[rl * 72 + ch * 8];
          *(uint4*)(gdst + (long)(mrow0 + hf * 64 + rl) * gld + ch * 8) = vv; }
      }
    } else if (ncol0 == 8192) {
#pragma unroll
      for (int i = 0; i < MI; ++i)
#pragma unroll
        for (int e = 0; e < 16; ++e) { int row = mrow0 + i * 32 + (e & 3) + 8 * (e >> 2) + 4 * h; p.small[(long)row * NSMALL + r] = acc[i][0][e]; }
    }
  }
}

__device__ __forceinline__ unsigned tx_() { unsigned t = threadIdx.x; asm volatile("" : "+v"(t)); return t; }
__device__ __forceinline__ int gw0(int) { return (int)((blockIdx.x * 256u + tx_()) >> 6); }
__device__ __forceinline__ int bid0() { int b = blockIdx.x; asm volatile("" : "+s"(b)); return b; }

#define XB_TMO      128
#define XB_XCNT(j)  (256  + 64 * (j))
#define XB_XSUB(j)  (1280 + 64 * (j))
#define XB_XGEN(j)  (2304 + 64 * (j))
#define XB_TOP      3328
#define XB_TOPGEN   3392
#define XCD_BAR_WORDS 3456
#define XB_SPIN_CAP (1u << 28)
__device__ __forceinline__ unsigned xb_ld(unsigned* p) { return __hip_atomic_load(p, __ATOMIC_RELAXED, __HIP_MEMORY_SCOPE_AGENT); }
__device__ __forceinline__ unsigned xb_add(unsigned* p, unsigned v) { return __hip_atomic_fetch_add(p, v, __ATOMIC_RELAXED, __HIP_MEMORY_SCOPE_AGENT); }
__device__ __forceinline__ unsigned xb_xcc_id() { return (unsigned)__builtin_amdgcn_s_getreg((3 << 11) | 20) & 0xFu; }
#define XB_SPIN(cond, bar) do { unsigned _sp = 0; while (cond) { __builtin_amdgcn_s_sleep(1); \
    if ((++_sp & 255u) == 0u) { if (xb_ld(&(bar)[XB_TMO])) break; if (_sp > XB_SPIN_CAP) { atomicAdd(&(bar)[XB_TMO], 1u); break; } } } } while (0)
struct XcdBarrier { unsigned* bar; unsigned x; volatile LDS3 unsigned* st; };
__device__ __forceinline__ XcdBarrier xcd_barrier_post(unsigned* bar, volatile LDS3 unsigned* st) {
  XcdBarrier b; b.bar = bar; b.x = xb_xcc_id(); b.st = st;
  if (threadIdx.x == 0) (void)xb_add(&bar[XB_XCNT(b.x)], 1u);
  return b;
}
__device__ __forceinline__ void xcd_barrier_complete(unsigned* bar, unsigned x, unsigned& nloc, unsigned& nx) {
  const unsigned G = gridDim.x; unsigned sum, cnt, mine, sp = 0u;
  for (;;) { sum = 0u; cnt = 0u; mine = 0u;
#pragma unroll
    for (unsigned j = 0; j < 16; ++j) { const unsigned c = xb_ld(&bar[XB_XCNT(j)]); sum += c; cnt += (c > 0u) ? 1u : 0u; mine = (j == x) ? c : mine; }
    if (sum == G) break;
    __builtin_amdgcn_s_sleep(1);
    if ((++sp & 255u) == 0u) { if (xb_ld(&bar[XB_TMO])) break; if (sp > XB_SPIN_CAP) { atomicAdd(&bar[XB_TMO], 1u); break; } } }
  nloc = mine > 0u ? mine : 1u; nx = cnt > 0u ? cnt : 1u;
}
__device__ __forceinline__ void xcd_barrier(const XcdBarrier& b) {
  asm volatile("s_waitcnt vmcnt(0)" ::: "memory");
  __syncthreads();
  if (threadIdx.x == 0) {
    unsigned* bar = b.bar;
    __builtin_amdgcn_s_waitcnt(0);
    unsigned nloc = b.st[0], nx = b.st[1];
    if (nloc == 0u) { xcd_barrier_complete(bar, b.x, nloc, nx); b.st[0] = nloc; b.st[1] = nx; }
    const unsigned old = xb_add(&bar[XB_XSUB(b.x)], 1u);
    const unsigned gen = old / nloc;
    if (old + 1u == (gen + 1u) * nloc) {
      __builtin_amdgcn_fence(__ATOMIC_RELEASE, "agent");
      asm volatile("s_waitcnt vmcnt(0)" ::: "memory");
      const unsigned og = xb_add(&bar[XB_TOP], 1u);
      const unsigned tg = og / nx;
      if (og + 1u == (tg + 1u) * nx) xb_add(&bar[XB_TOPGEN], 1u);
      else XB_SPIN(xb_ld(&bar[XB_TOPGEN]) == tg, bar);
      __builtin_amdgcn_fence(__ATOMIC_ACQUIRE, "agent");
      xb_add(&bar[XB_XGEN(b.x)], 1u);
      asm volatile("s_waitcnt vmcnt(0)" ::: "memory");
    } else {
      XB_SPIN(xb_ld(&bar[XB_XGEN(b.x)]) == gen, bar);
      __builtin_amdgcn_fence(__ATOMIC_ACQUIRE, "agent");
      asm volatile("s_waitcnt vmcnt(0)" ::: "memory");
    }
  }
  __syncthreads();
}

struct KArgs { const void* in[20]; float* out; char* ws; };
#ifdef SELFCHK
#define RUN_S 4096
#else
#define RUN_S SEQ
#endif
__host__ __device__ __forceinline__ size_t fill_ws(Params& p, Params& p2, char* w) {
  size_t off = 0;
#define TAKE(bytes) (w + ((off += (((size_t)(bytes)) + 255) & ~(size_t)255) - ((((size_t)(bytes)) + 255) & ~(size_t)255)))
  const size_t S = RUN_S, ncmp = S / 16, nc = S / 128;
  p.S = RUN_S;
  p.wt_in = (unsigned short*)TAKE(8320 * 1024 * 2); p.wt_out = (unsigned short*)TAKE(2 * 1024 * 2304 * 2); p.w1t = (unsigned short*)TAKE(2 * 128 * 2048 * 2); p.w2t = (unsigned short*)TAKE(2 * 64 * 128 * 2);
  p.h = (SB*)TAKE(S * 1024 * 2); p.ybuf = (float*)p.h;
  p.proj = (SB*)TAKE(S * NPROJ * 2); p.y = (float*)p.proj;
  p.small = (float*)TAKE(S * 32 * 4); p.mix = (SB*)TAKE(S * NMIX * 2);
  p.rope_cs = (float*)TAKE(S * 32 * 4); p.rope_sn = (float*)TAKE(S * 32 * 4); p.tabA = (float*)TAKE(8 * TABA_N * 4); p.tabD = (float*)TAKE(24 * TABD_N * 4);
  p.memkv = (SB*)TAKE(4 * 256 * 512 * 2); p.hid = (float*)TAKE(2 * ncmp * 256 * 4); p.kvc = (SB*)TAKE(2 * ncmp * 128 * 2);
  p.cml = (float*)TAKE(S * 16 * 4); p.idx = (int*)TAKE(S * 32 * 4); p.oc = (SB*)TAKE(S * 512 * 2); p.ow = (SB*)TAKE(S * 512 * 2);
  p.dop = (SB*)TAKE(3 * S * 512 * 2); p.dlse = (float*)TAKE(3 * S * 8 * 4); p.xconv = (SB*)TAKE(S * 1024 * 2);
  p.dt = (float*)TAKE(S * 8 * 4); p.acs = (float*)TAKE(S * 8 * 4); p.wst = (float*)TAKE(S * 8 * 4); p.cb = (float*)TAKE(nc * 2 * 128 * 128 * 4); p.states = (float*)TAKE(nc * 65536 * 4);
  p.bar = (unsigned*)TAKE(131072);
  p2 = p;
#ifdef SELFCHK
  p.imp = (float*)TAKE(S * 512 * 4);
  p2.mix = (SB*)TAKE(S * NMIX * 2); p2.ow = (SB*)TAKE(S * 512 * 2); p2.oc = (SB*)TAKE(S * 512 * 2); p2.dop = (SB*)TAKE(3 * S * 512 * 2); p2.dlse = (float*)TAKE(3 * S * 8 * 4);
  p2.cml = (float*)TAKE(S * 16 * 4); p2.imp = (float*)TAKE(S * 512 * 4); p2.idx = (int*)TAKE(S * 32 * 4); p2.cb = (float*)TAKE(nc * 2 * 128 * 128 * 4);
  p2.kvc = (SB*)TAKE(2 * ncmp * 128 * 2); p2.xconv = (SB*)TAKE(S * 1024 * 2); p2.dt = (float*)TAKE(S * 8 * 4); p2.acs = (float*)TAKE(S * 8 * 4); p2.wst = (float*)TAKE(S * 8 * 4);
  p2.states = (float*)TAKE(nc * 65536 * 4); p2.ybuf = (float*)TAKE(S * 512 * 4); p.ybuf = (float*)TAKE(S * 512 * 4);
#else
  p.imp = (float*)p.dop; p2 = p;
#endif
  return off;
}
__host__ __device__ __forceinline__ void fill_inputs(Params& p, const KArgs& a) {
  p.x = (const float*)a.in[0]; p.mem = (const float*)a.in[1]; p.pos = (const int*)a.in[2]; p.pre_norm = (const float*)a.in[3]; p.post_norm = (const float*)a.in[4];
  p.w_in = (const float*)a.in[5]; p.w_out = (const float*)a.in[6]; p.rel_bias = (const float*)a.in[7]; p.cmp_pos = (const float*)a.in[8]; p.cmp_w1 = (const float*)a.in[9];
  p.cmp_w2 = (const float*)a.in[10]; p.conv_w = (const float*)a.in[11]; p.conv_b = (const float*)a.in[12]; p.dt_bias = (const float*)a.in[13]; p.a_log = (const float*)a.in[14];
  p.b_d = (const float*)a.in[15]; p.b_norm = (const float*)a.in[16]; p.sinks = (const float*)a.in[17]; p.m_norm = (const float*)a.in[18]; p.m_wkv = (const float*)a.in[19];
  p.out = a.out;
}
#define GS(N, ...) { long g0_ = (long)blockIdx.x * 256 + tx_(); for (long gid = g0_; gid < (long)(N); gid += gsz) { __VA_ARGS__; } }
#define WU(N, ...) { for (int u_ = gw0(gwave); u_ < (int)(N); u_ += nwave) { const int u = __builtin_amdgcn_readfirstlane(u_); const unsigned tq_ = tx_(); int lane = tq_ & 63; \
    WaveLds* WL = ((WaveLds*)smem_raw) + __builtin_amdgcn_readfirstlane((int)(tq_ >> 6)); __VA_ARGS__; } }
#define GSYNC() xcd_barrier(xb)
#ifndef CMP_SKIP
#define CMP_SKIP 2
#endif
#define WUQ(slot, CH, N, ...) { unsigned* cq_ = &p.bar[4096 + (layer * 8 + (slot)) * 64 * 8 + (blockIdx.x & 7) * 64]; for (;;) { unsigned t_ = 0u; if ((tx_() & 63) == 0) t_ = atomicAdd(cq_, 1u); \
    const int c0_ = __builtin_amdgcn_readfirstlane((int)t_) * (CH); if ((c0_ * 8 + (int)(blockIdx.x & 7)) >= (int)(N)) break; \
    for (int ci_ = 0; ci_ < (CH); ++ci_) { const int u = (c0_ + ci_) * 8 + (int)(blockIdx.x & 7); if (u >= (int)(N)) break; const unsigned tq_ = tx_(); int lane = tq_ & 63; \
      WaveLds* WL = ((WaveLds*)smem_raw) + __builtin_amdgcn_readfirstlane((int)(tq_ >> 6)); (void)WL; __VA_ARGS__; } } }
#ifndef ASELW
#define ASELW 1
#endif
#if ASELW == 1
#define ASEL_UNIT(pp, uu) unit_asel_w((pp), (uu), (AselW*)smem_raw)
#else
#define ASEL_UNIT(pp, uu) unit_asel_blk((pp), (uu), (AselLds*)smem_raw)
#endif
#define SMEM_A_ (sizeof(AselLds) > sizeof(AselW) ? sizeof(AselLds) : sizeof(AselW))
#define SMEM_BYTES (SMEM_A_ > sizeof(GemmSmem) ? ((SMEM_A_ + 15) & ~(size_t)15) : sizeof(GemmSmem))
#define gtid ((long)blockIdx.x * 256 + tx_())
#define gwave ((int)((blockIdx.x * 256u + tx_()) >> 6))
#define KERNEL_PROLOGUE \
  Params p, p2; p.pad0 = 0; fill_inputs(p, ka); fill_ws(p, p2, ka.ws); \
  cg::grid_group grid = cg::this_grid(); \
  __shared__ __attribute__((aligned(16))) char smem_raw[SMEM_BYTES + 16]; \
  volatile LDS3 unsigned* xbst = (volatile LDS3 unsigned*)(smem_raw + SMEM_BYTES); \
  if (threadIdx.x < 4) xbst[threadIdx.x] = 0u; \
  __syncthreads(); \
  XcdBarrier xb = xcd_barrier_post(p.bar, xbst); \
  GemmSmem& gsm = *(GemmSmem*)smem_raw; float* ftile = (float*)smem_raw; \
  const long gsz = (long)gridDim.x * 256; const int nwave = (int)(gsz >> 6); \
  const int S = p.S, ncmp = S / 16, nc = S / 128, nqt = S / 32; (void)ncmp; (void)nc; (void)nqt; (void)ftile; (void)gsm; \
  GS((long)S * 32, ph_rope(p, gid)); \
  GS(8 * TABA_N + 24 * TABD_N, ph_tabs(p, gid)); \
  WU(DEPTH * 256 * 2, unit_memkv(p, u, lane));
#define PHASE_NORM(layer) \
    for (int t = gw0(gwave); t < S; t += nwave) { int lane = tx_() & 63; norm_row_wave(p, layer, t, true, lane); }
#define PHASE_CVT(layer) \
    { const float* wi = p.w_in + (long)(layer) * 1024 * 8224; unsigned short* wob_ = p.wt_out + (long)((layer) & 1) * 1024 * 2304; \
      for (int tl = bid0(); tl < 16 * 130; tl += gridDim.x) cvt_tile<true>(wi, 8224, p.wt_in, 1024, (tl & 15) * 64, (tl >> 4) * 64, ftile); \
      const float* wo = p.w_out + (long)(layer) * 2304 * 1024; \
      for (int tl = bid0(); tl < 36 * 16; tl += gridDim.x) cvt_tile<false>(wo, 1024, wob_, 2304, (tl % 36) * 64, (tl / 36) * 64, ftile); \
      for (int tl = bid0(); tl < 2 * 64; tl += gridDim.x) { const int kv = tl >> 6, t6 = tl & 63; cvt_tile<false>(p.cmp_w1 + (long)((layer) * 2 + kv) * 2048 * 128, 128, p.w1t + (long)kv * 128 * 2048, 2048, (t6 >> 1) * 64, (t6 & 1) * 64, ftile); } \
      for (int tl = bid0(); tl < 2 * 2; tl += gridDim.x) { const int kv = tl >> 1; cvt_tile<false>(p.cmp_w2 + (long)((layer) * 2 + kv) * 128 * 64, 64, p.w2t + (long)kv * 64 * 128, 128, (tl & 1) * 64, 0, ftile); } }
#define PHASE_P1(layer) PHASE_NORM(layer) PHASE_CVT(layer)
#define PHASE_P2() \
    {   \
      const int x_ = bid0() & 7, li_ = bid0() >> 3, nl_ = (gridDim.x + 7) >> 3, mtiles_ = S / (64 * GMI), mper_ = mtiles_ / 8; \
      if ((mper_ & 7) != 0 || (gridDim.x & 7) != 0) { for (int tl = bid0(); tl < mtiles_ * 65; tl += gridDim.x) { int mt = tl % mtiles_, nt = tl / mtiles_; gemm_tile<0, GMI>(p, p.h, DM, p.wt_in, DM, DM, mt * 64 * GMI, nt * 128, gsm); } } \
      else for (int t_ = li_; t_ < mper_ * 65; t_ += nl_) { const int half_ = t_ / 520, r_ = t_ % 520; int ml_, nt_; \
        if (r_ < 512) { ml_ = r_ & 7; nt_ = (r_ >> 6) * 8 + ((r_ & 63) >> 3); } else { ml_ = r_ - 512; nt_ = 64; } \
        gemm_tile<0, GMI>(p, p.h, DM, p.wt_in, DM, DM, (x_ * mper_ + half_ * 8 + ml_) * 64 * GMI, nt_ * 128, gsm); } }
#define PHASE_FLASH3(layer) \
    { const int nA = nqt * 8, nM = nqt * 4, nD = 3 * nqt * 8, nC = nqt * 8; \
      WU(nA + nM + nD + nC, { if (u < nA) unit_awin(p, u, WL, lane); else if (u < nA + nM) unit_m(p, layer, u - nA, WL, lane); \
                              else if (u < nA + nM + nD) unit_d(p, u - nA - nM, WL, lane); else unit_c(p, layer, u - nA - nM - nD, WL, lane); }); }
#define WU2(N, ...) { for (int u_ = gw0(gwave); u_ < (int)(N); u_ += nwave) { const int u = __builtin_amdgcn_readfirstlane(u_); const unsigned tq_ = tx_(); int lane = tq_ & 63; \
    WaveLds2* WL2 = ((WaveLds2*)smem_raw) + __builtin_amdgcn_readfirstlane((int)(tq_ >> 6)); __VA_ARGS__; } }
#define PHASE_CB() \
    for (int tl = bid0(); tl < nc * 2; tl += gridDim.x) { const SB* xb_ = p.xconv + (long)(tl >> 1) * 128 * 1024 + (tl & 1) * 128; gemm_tile<2, 2>(p, xb_ + 768, 1024, xb_ + 512, 1024, 128, 0, 0, gsm, p.cb + (long)tl * 16384); }

#ifndef SELFCHK
#define PH_BEGIN { char* wsb_ = ka.ws; asm volatile("" : "+s"(wsb_)); Params p, p2_; p.pad0 = 0; fill_inputs(p, ka); fill_ws(p, p2_, wsb_); (void)p2_;
#define PH_END }
__global__ void __launch_bounds__(256, LB2) mega(KArgs ka) {
  KERNEL_PROLOGUE
#ifdef REP_PRO
  GS((long)S * 32, ph_rope(p, gid)); GS(8 * TABA_N + 24 * TABD_N, ph_tabs(p, gid)); WU(DEPTH * 256 * 2, unit_memkv(p, u, lane));
#endif
#ifdef TSEL
  unsigned long long tlast = __builtin_amdgcn_s_memrealtime();
#define TMARK(id) { if (gtid == 0) { const unsigned long long tn = __builtin_amdgcn_s_memrealtime(); ((unsigned long long*)p.bar)[id] += tn - tlast; tlast = tn; } }
#else
#define TMARK(id)
#endif
  for (int layer = 0; layer < DEPTH; ++layer) {
    PH_BEGIN
    PHASE_P1(layer)
#ifdef REP_P1
    PHASE_P1(layer)
#endif
    PH_END
    if (layer == 0) grid.sync(); else GSYNC();
    PH_BEGIN
    TMARK(1)
    PHASE_P2()
#ifdef REP_G
    PHASE_P2()
#endif
#ifdef REP_G2
    { const int x_ = bid0() & 7, li_ = bid0() >> 3, nl_ = (gridDim.x + 7) >> 3; for (int t_ = li_; t_ < 520; t_ += nl_) { int ml_, nt_; if (t_ < 512) { ml_ = t_ & 7; nt_ = (t_ >> 6) * 8 + ((t_ & 63) >> 3); } else { ml_ = t_ - 512; nt_ = 64; }
        gemm_tile<0, GMI, true>(p, p.h, DM, p.wt_in, DM, DM, (x_ * 8 + ml_) * 64 * GMI, nt_ * 128, gsm); } }
#endif
    PH_END
    GSYNC();
    PH_BEGIN
    TMARK(2)
    { const int nCmp = 2 * (ncmp * 2 / 32), nA = nqt * 8, nM = nqt * 4, nD = 3 * nqt * 8, nC = nqt * 8, nF = nA + nM + nD + nC;
      const int cb0 = (int)gridDim.x - nCmp; const bool cmpw = ((int)blockIdx.x >= cb0) && (cb0 > 0); const int cw0 = cb0 * 4;
#define FLASH_UNIT(uu) {   \
        const int v_ = __builtin_amdgcn_readfirstlane(uu); const int gw_ = v_ % nwave, rr_ = v_ / nwave; const int x_ = (gw_ >> 2) & 7, lw_ = ((gw_ >> 5) << 2) | (gw_ & 3); int j_ = rr_ * (nwave >> 3) + lw_; \
        const unsigned tq_ = tx_(); int lane = tq_ & 63; WaveLds* WL = ((WaveLds*)smem_raw) + __builtin_amdgcn_readfirstlane((int)(tq_ >> 6)); \
        if ((nwave & 31) != 0) { const int u = v_; if (u < nA) unit_awin(p, u, WL, lane); else if (u < nA + nM) unit_m(p, layer, u - nA, WL, lane); else if (u < nA + nM + nD) unit_d(p, u - nA - nM, WL, lane); else unit_c(p, layer, u - nA - nM - nD, WL, lane); } \
        else if (j_ < nA / 8) unit_awin(p, x_ * (nA / 8) + j_, WL, lane); \
        else if ((j_ -= nA / 8) < nM / 8) unit_m(p, layer, x_ * (nM / 8) + j_, WL, lane); \
        else if ((j_ -= nM / 8) < nD / 24) unit_d(p, x_ * (nD / 24) + j_, WL, lane); \
        else if ((j_ -= nD / 24) < nD / 24) unit_d(p, nD / 3 + x_ * (nD / 24) + j_, WL, lane); \
        else if ((j_ -= nD / 24) < nD / 24) unit_d(p, 2 * (nD / 3) + x_ * (nD / 24) + j_, WL, lane); \
        else if ((j_ -= nD / 24) < nC / 8) unit_c(p, layer, x_ * (nC / 8) + j_, WL, lane); }
#ifdef REP_F3B
      WU(nA + nD, { if (u < nA) unit_awin(p, u, WL, lane); else unit_d(p, u - nA, WL, lane); });
#endif
#ifdef REP_CMPB
      for (int ub = bid0(); ub < nCmp; ub += gridDim.x) unit_cmp_blk(p, layer, ub, (float*)smem_raw); __syncthreads();
#endif
      if (cb0 <= 0) { for (int ub = bid0(); ub < nCmp; ub += gridDim.x) unit_cmp_blk(p, layer, ub, (float*)smem_raw); __syncthreads(); }
      else if (cmpw) { unit_cmp_blk(p, layer, (int)blockIdx.x - cb0, (float*)smem_raw); __syncthreads(); }
      for (int r_ = (cmpw ? CMP_SKIP : 0), u_ = gw0(gwave) + r_ * nwave; u_ < nF; u_ += nwave) FLASH_UNIT(u_)
      if (cb0 > 0) for (int e_ = gw0(gwave); e_ < CMP_SKIP * nCmp * 4; e_ += nwave) { const int u_ = (e_ / (nCmp * 4)) * nwave + cw0 + (e_ % (nCmp * 4)); if (u_ < nF) FLASH_UNIT(u_) }
#undef FLASH_UNIT
    }
    GS((long)S * 128, item_bconv(p, layer, gid));
    WU(nc * 8, unit_bdt(p, layer, u, lane));
    PH_END
    GSYNC();
    PH_BEGIN
    TMARK(3)
    WU(nqt * 8, unit_acmp1(p, u, WL, lane));
    __syncthreads();
    PHASE_CB()
    __syncthreads();
    WU2(nc * 16, unit_bstates(p, u, WL2, lane));
#ifdef REP_P4
    __syncthreads();
    WU(nqt * 8, unit_acmp1(p, u, WL, lane));
    __syncthreads();
    PHASE_CB()
    __syncthreads();
    WU2(nc * 16, unit_bstates(p, u, WL2, lane));
#endif
    GS((long)S * 64, item_dmerge(p, gid));
    PH_END
    GSYNC();
    PH_BEGIN
    TMARK(4)
#ifndef P5UP
#define P5UP 4
#endif
    {
      const int nU = nqt * 8, hw_ = nwave >> 1; const int gw_ = gw0(gwave);
      if (65536 * 2 != (int)gsz || (nU & 7)) { WU(nU, unit_acmp2(p, u, lane)); }
      else if (gw_ >= hw_) { for (int u_ = gw_ - hw_; u_ < (nU / 8) * P5UP; u_ += hw_) { const int u = __builtin_amdgcn_readfirstlane(u_); int lane = tx_() & 63; unit_acmp2(p, u, lane); } }
      else { for (int u_ = (nU / 8) * P5UP + gw_; u_ < nU; u_ += hw_) { const int u = __builtin_amdgcn_readfirstlane(u_); int lane = tx_() & 63; unit_acmp2(p, u, lane); } } }
#ifdef REP_P5A
    WU(nqt * 8, unit_acmp2(p, u, lane));
#endif
    GS(65536, scan_fast(p, gid));
    PH_END
    GSYNC();
    PH_BEGIN
    TMARK(5)
#ifdef REP_BOUT
    for (int ub = bid0(); ub < nc * 8; ub += gridDim.x) unit_bout_blk<false>(p, layer, ub, smem_raw);
#endif
    for (int ub = bid0(); ub < nc * 8; ub += gridDim.x) unit_bout_blk(p, layer, ub, smem_raw);
    TMARK(7)
#ifdef REP_ASELW
    for (;;) { __syncthreads(); if (threadIdx.x == 0) xbst[2] = atomicAdd(&p.bar[48 + layer * 8 + 7], 1u); __syncthreads(); const int ub = (int)xbst[2]; if (ub >= (S / 32) * 2) break; unit_asel_w<false, REP_ASELW == 2, REP_ASELW == 3>(p, ub, (AselW*)smem_raw); }
#endif
#ifdef REP_ASEL2
    for (;;) { __syncthreads(); if (threadIdx.x == 0) xbst[2] = atomicAdd(&p.bar[48 + layer * 8 + 7], 1u); __syncthreads(); const int ub = (int)xbst[2]; if (ub >= (S / 32) * 2) break; unit_asel_blk<false>(p, ub, (AselLds*)smem_raw); }
#endif
#ifdef REP_ASEL3
    for (;;) { __syncthreads(); if (threadIdx.x == 0) xbst[2] = atomicAdd(&p.bar[48 + layer * 8 + 7], 1u); __syncthreads(); const int ub = (int)xbst[2]; if (ub >= (S / 32) * 2) break; unit_asel_blk<false, true>(p, ub, (AselLds*)smem_raw); }
#endif
#ifndef ASEL_XQ
#define ASEL_XQ 1
#endif
#if ASEL_XQ
    {
      AselW* AW = (AselW*)smem_raw; __syncthreads(); asel_w_tables(p, AW); __syncthreads();
      const int tq_ = tx_(), ln_ = tq_ & 63, wv_ = __builtin_amdgcn_readfirstlane(tq_ >> 6); const int qc = (bid0() >> 2) & 1; bool own = true; const unsigned NWI = (unsigned)(S / 32) * 4u;
      (void)qc; (void)own;
      for (;;) { unsigned n = 0u;
        if (ln_ == 0) n = atomicAdd(&p.bar[48 + layer * 8 + 4], 1u); n = (unsigned)__builtin_amdgcn_readfirstlane((int)n); if (n >= 2u * NWI) break;
        asel_w_wave(p, (int)((n >> 2) & 1u), ((S / 32 - 1) - (int)(n >> 3)) * 32 + 8 * (int)(n & 3u), AW, wv_, ln_); } }
#else
    for (;;) { __syncthreads(); if (threadIdx.x == 0) xbst[2] = atomicAdd(&p.bar[48 + layer * 8 + 6], 1u); __syncthreads(); const int ub = (int)xbst[2]; if (ub >= (S / 32) * 2) break; unit_asel_blk(p, ub, (AselLds*)smem_raw); }
#endif
    PH_END
    GSYNC();
    PH_BEGIN
    TMARK(8)
    { const int mtl_ = S / (64 * GMI); const bool xmap_ = ((gridDim.x & 7) == 0) && ((mtl_ & 7) == 0);
      for (int tl = bid0(); tl < mtl_ * 8; tl += gridDim.x) { int mt = tl >> 3, nt = tl & 7; if (xmap_) { const int x_ = tl & 7, li_ = tl >> 3; mt = x_ * (mtl_ >> 3) + (li_ >> 3); nt = li_ & 7; }
        gemm_tile<1, GMI>(p, p.mix, NMIX, p.wt_out + (long)(layer & 1) * 1024 * 2304, NMIX, NMIX, mt * 64 * GMI, nt * 128, gsm); } }
#ifdef REP_P8
    for (int tl = bid0(); tl < (S / (64 * GMI)) * 8; tl += gridDim.x) { int mt = tl >> 3, nt = tl & 7; gemm_tile<1, GMI>(p, p.mix, NMIX, p.wt_out + (long)(layer & 1) * 1024 * 2304, NMIX, NMIX, mt * 64 * GMI, nt * 128, gsm); }
#endif
    PH_END
    GSYNC();
    PH_BEGIN
    TMARK(9)
#ifdef REP_BAR
    for (int q_ = 0; q_ < 8; ++q_) GSYNC();
#endif
    PH_END
  }
  for (int t = gw0(gwave); t < S; t += nwave) { int lane = tx_() & 63; norm_row_wave(p, DEPTH, t, false, lane); }
#ifdef TSEL
  GSYNC();
  { const float us = (float)((unsigned long long*)p.bar)[TSEL] * 0.01f;
    const float kk = __expf(rintf(__logf(us + 1.f) * 20.f) * 0.05f);
    GS((long)S * 1024, p.out[gid] = kk); }
#endif
}
#else
__device__ __forceinline__ void chk_update(unsigned* slot, float diff, float ref) {
  atomicMax(&slot[0], __float_as_uint(fabsf(diff))); atomicMax(&slot[1], __float_as_uint(fabsf(ref)));
}
#define CMPB(slot, a, b_) chk_update(sl + (slot), bf2f(a) - bf2f(b_), bf2f(b_))
#define CMPF(slot, a, b_) chk_update(sl + (slot), (a) - (b_), (b_))
__global__ void __launch_bounds__(256, 1) mega(KArgs ka) {
  KERNEL_PROLOGUE
  if (gtid < 64) p.bar[gtid] = 0u;
  unsigned* sl = p.bar;
  const int layer = 0;
  PHASE_P1(layer)
  grid.sync();
  PHASE_P2()
  GSYNC();
  GS((long)S * NMIX, p2.mix[gid] = p.mix[gid]);
  GSYNC();
  PHASE_FLASH3(layer)
  __syncthreads();
  for (int ub = bid0(); ub < 2 * (ncmp * 2 / 32); ub += gridDim.x) unit_cmp_blk(p, layer, ub, (float*)smem_raw);
  __syncthreads();
  GS((long)S * 128, item_bconv(p, layer, gid));
  WU(nc * 8, unit_bdt(p, layer, u, lane));
  GS((long)2 * ncmp * 256, ph_cmp_hid(p2, layer, gid));
  GS((long)S * 8, ph_a_win(p2, gid));
  GS((long)S * 8, ph_c(p2, layer, gid));
  GS((long)3 * S * 8, ph_d(p2, gid));
  GS((long)S * 4, ph_m(p2, layer, gid));
  GS((long)S * 1024, ph_b_conv(p2, layer, gid));
  GS((long)nc * 8, ph_b_dt2(p2, layer, gid));
  GSYNC();
  GS((long)2 * ncmp * 128, ph_cmp_out(p2, layer, gid));
  GSYNC();
  GS((long)2 * ncmp * 128, CMPB(20, p.kvc[gid], p2.kvc[gid]));
  GS((long)S * 1024, CMPB(22, p.xconv[gid], p2.xconv[gid]));
  GS((long)S * 8, { CMPF(24, p.dt[gid], p2.dt[gid]); CMPF(24, p.acs[gid], p2.acs[gid]); CMPF(24, p.wst[gid], p2.wst[gid]); });
  GSYNC();
  GS((long)2 * ncmp * 128, p2.kvc[gid] = p.kvc[gid]);
  GS((long)S * 1024, p2.xconv[gid] = p.xconv[gid]);
  GS((long)S * 8, { p2.dt[gid] = p.dt[gid]; p2.acs[gid] = p.acs[gid]; p2.wst[gid] = p.wst[gid]; });
  GSYNC();
  WU(nqt * 8, unit_acmp1(p, u, WL, lane));
  __syncthreads();
  PHASE_CB()
  __syncthreads();
  WU2(nc * 16, unit_bstates(p, u, WL2, lane));
  GS((long)S * 8, ph_a_cmp1(p2, gid));
  GS((long)nc * 2 * 128 * 128, ph_b_cb(p2, gid));
  GS((long)nc * 65536, ph_b_states(p2, gid));
  GSYNC();
  WU(nqt * 8, unit_acmp2(p, u, lane));
  GS((long)S * 2, ph_a_cmp2(p2, gid));
  GS((long)nc * 65536, CMPF(26, p.states[gid], p2.states[gid]));
  GS((long)nc * 2 * 128 * 128, { int s_ = (int)(gid & 127), l_ = (int)((gid >> 7) & 127); if (s_ <= l_) CMPF(18, p.cb[gid], p2.cb[gid]); });
  GSYNC();
  GS(65536, ph_b_scan(p, gid));
  GS(65536, ph_b_scan(p2, gid));
  GS((long)S * 512, { CMPB(0, p.ow[gid], p2.ow[gid]); CMPB(2, p.oc[gid], p2.oc[gid]); long t = gid >> 9, c = gid & 511; CMPB(4, p.mix[t * NMIX + MX_C + c], p2.mix[t * NMIX + MX_C + c]);
                      if (c < 256) CMPB(6, p.mix[t * NMIX + MX_M + c], p2.mix[t * NMIX + MX_M + c]); });
  GS((long)3 * S * 512, CMPB(8, p.dop[gid], p2.dop[gid]));
  GS((long)3 * S * 8, chk_update(sl + 10, p.dlse[gid] - p2.dlse[gid], 1.f));
  GS((long)S * 2 * 256, { long qg = gid >> 8; int bb = (int)(gid & 255); int q = (int)(qg >> 1), g_ = (int)(qg & 1); if (bb <= (q >> 6)) CMPF(12, p.imp[(((long)(q >> 5) * 2 + g_) * 256 + bb) * 32 + (q & 31)], p2.imp[gid]); });
  GSYNC();
  GS((long)S * 512, { long qg = gid >> 8; int bb = (int)(gid & 255); int q = (int)(qg >> 1), g_ = (int)(qg & 1); p2.imp[gid] = p.imp[(((long)(q >> 5) * 2 + g_) * 256 + bb) * 32 + (q & 31)]; });
  GSYNC();
  WU(S * 2 / 4, unit_topk4(p, u, lane));
  WU2(nc * 32, unit_bout(p, layer, u, WL2, lane));
  GS((long)S * 2, ph_a_topk(p2, gid));
  GS((long)S * 512, ph_b_out(p2, layer, gid));
  GSYNC();
  GS((long)S * 2, { int q = (int)(gid >> 1); int nv = (q >> 6) + 1; nv = nv > 16 ? 16 : nv; int bad = 0;
    for (int k = 0; k < 16; ++k) { int mine = p.idx[gid * 16 + k]; bool found = false; for (int k2 = 0; k2 < 16; ++k2) found |= (p2.idx[gid * 16 + k2] == mine); if (k < nv) bad += !found || mine < 0; else bad += (mine >= 0); }
    chk_update(sl + 14, (float)bad, 1.f); });
  GS((long)S * 512, CMPF(28, p.ybuf[gid], p2.ybuf[gid]));
  GSYNC();
  GS((long)S * 32, p2.idx[gid] = p.idx[gid]);
  GS((long)S * 512, p2.ybuf[gid] = p.ybuf[gid]);
  GSYNC();
  for (int ub = bid0(); ub < (S / 32) * 2; ub += gridDim.x) ASEL_UNIT(p, ub);
  for (;;) { __syncthreads(); if (threadIdx.x == 0) xbst[2] = atomicAdd(&p.bar[40 + layer], 1u); __syncthreads(); const int ub = (int)xbst[2]; if (ub >= nc * 8) break; unit_bout_blk(p, layer, ub, smem_raw); }
  GS((long)S * 8, ph_a_sel(p2, gid));
  GS((long)S * 2, ph_b_norm(p2, layer, gid));
  GSYNC();
  GS((long)S * 512, { long t = gid >> 9, c = gid & 511; CMPB(16, p.mix[t * NMIX + MX_A + c], p2.mix[t * NMIX + MX_A + c]); CMPB(30, p.mix[t * NMIX + MX_B + c], p2.mix[t * NMIX + MX_B + c]); });
  GSYNC();
  { float R = 0.f;
    for (int k = 0; k < 16; ++k) { float d = __uint_as_float(p.bar[2 * k]), r = __uint_as_float(p.bar[2 * k + 1]); float q = d / (r + 1e-20f); if (CHKSEL < 0 || CHKSEL == k) R = fmaxf(R, q); }
    GS((long)SEQ * 1024, p.out[gid] = 1e4f * R); }
}
#endif

__global__ void zz_tail_pad(float* o) { asm volatile(".rept 512\n\ts_nop 0\n\t.endr" ::: "memory"); if (o) o[0] = 0.f; }
__global__ void fill_code(float* o, float v, long n) { long i = blockIdx.x * 256L + threadIdx.x; if (i < n) o[i] = v; }
extern "C" void kernel_launch(void* const* d_in, const int* in_sizes, int n_in, void* d_out, int out_size, void* d_ws, size_t ws_size, hipStream_t stream) {
  KArgs ka; memset(&ka, 0, sizeof(ka));
  for (int i = 0; i < 20; ++i) ka.in[i] = d_in[i];
  ka.out = (float*)d_out; ka.ws = (char*)d_ws;
  Params hp, hp2; memset(&hp, 0, sizeof(hp)); const size_t need = fill_ws(hp, hp2, (char*)d_ws);
  if (need > ws_size) { fprintf(stderr, "workspace too small: need %zu have %zu\n", need, ws_size); return; }
  static int grid_blocks = 0;
  if (!grid_blocks) { int dev = 0, cus = 0, per_cu = 0; (void)hipGetDevice(&dev); (void)hipDeviceGetAttribute(&cus, hipDeviceAttributeMultiprocessorCount, dev);
    (void)hipOccupancyMaxActiveBlocksPerMultiprocessor(&per_cu, mega, 256, 0); if (per_cu > LB2) per_cu = LB2; if (per_cu < 1) per_cu = 1; grid_blocks = cus * per_cu; }
  (void)hipMemsetAsync(hp.bar, 0, 131072, stream);
  void* args[] = {&ka};
  hipError_t e = hipLaunchCooperativeKernel((void*)mega, dim3(grid_blocks), dim3(256), args, 0, stream);
  if (e != hipSuccess) { (void)hipGetLastError(); fill_code<<<(unsigned)(((long)SEQ * 1024 + 255) / 256), 256, 0, stream>>>((float*)d_out, 1000.f * (float)(int)e + (float)grid_blocks, (long)SEQ * 1024); }
}
```
